# Optimizing an MI355X kernel written in HIP

```python
import math
import jax
import jax.numpy as jnp
from jax import lax
import numpy as np

D_MODEL = 1024
BATCH = 16
SEQ = 4096
DEPTH = 4

GRID_W = 64
CTX_LEN = 256

HY_CH = 256
RW_HEADS = 4
RW_HD = 64
RW_W = RW_HEADS * RW_HD
AT_HQ = 8
AT_HKV = 2
AT_G = AT_HQ // AT_HKV
AT_HD = 64
AT_W = AT_HQ * AT_HD
AT_KVW = AT_HKV * AT_HD
MIX_W = HY_CH + RW_W + AT_W

RW_DECAY_R = 64
RW_ICLR_R = 64
RW_GATE_R = 128
RW_LORA_W = 2 * RW_DECAY_R + 2 * RW_ICLR_R + RW_GATE_R
RW_GN_EPS = RW_HD * 1e-5

HY_EMB = 33
HY_BANDS = (HY_EMB - 1) // 2
HY_HID = 64
HY_SHIFT = 0.05
HY_MIN_DECAY = math.log(1e-2) / 1.5
HY_MAX_DECAY = math.log(1e-2) / 0.3

ATT_WINDOW = 128
ATT_BLOCK = 128
ROPE_BASE = 10000.0
NEG_INF = -1e30

PEER_HEADS = 8
PEER_NKEYS = 128
PEER_NEXP = PEER_NKEYS * PEER_NKEYS
PEER_DQ = 256
PEER_TOPK = 16
PEER_CHUNK = 128

OFF_HY = 0
OFF_RK = OFF_HY + 3 * HY_CH
OFF_LORA = OFF_RK + 3 * RW_W
OFF_AT = OFF_LORA + RW_LORA_W
IN_W = OFF_AT + AT_W + 2 * AT_KVW
CONV_COLS = OFF_LORA

kernel_name = 'hybrid_hyena_rwkv7_swa_peer_dit'


def rmsnorm(x, g, eps=1e-6):
    xf = x.astype(jnp.float32)
    y = xf * lax.rsqrt(jnp.mean(xf * xf, axis=-1, keepdims=True) + eps)
    return (y * g.astype(jnp.float32)).astype(x.dtype)


def short_conv3(u, w, b):
    up = jnp.pad(u, ((0, 0), (1, 1), (0, 0)))
    return up[:, :-2] * w[0] + up[:, 1:-1] * w[1] + up[:, 2:] * w[2] + b


def hyena_filter(L, w1, b1, w2, b2, w3, b3, freq):
    f32 = jnp.float32
    j = jnp.arange(L, dtype=f32)
    t = j / max(L - 1, 1)
    bands = jnp.linspace(1e-4, HY_BANDS - 1, HY_BANDS, dtype=f32)
    ang = 2.0 * math.pi * j[:, None] * bands[None, :] / L
    z = jnp.concatenate([t[:, None], jnp.cos(ang), -jnp.sin(ang)], axis=-1)
    h = jnp.sin(freq[0] * (z @ w1 + b1))
    h = jnp.sin(freq[1] * (h @ w2 + b2))
    h = (h @ w3 + b3).astype(f32).reshape(L, 2, HY_CH)
    deltas = jnp.abs(jnp.linspace(HY_MIN_DECAY, HY_MAX_DECAY, HY_CH, dtype=f32))
    window = jnp.exp(-t[:, None] * deltas[None, :]) + HY_SHIFT
    h = h * window[:, None, :]
    k = jnp.concatenate([h[:, 0], jnp.zeros((1, HY_CH), f32), h[:0:-1, 1]], axis=0)
    return k * lax.rsqrt(jnp.sum(k * k, axis=0, keepdims=True) + 1e-6)


def hyena_mix(z, filt, d_bias):
    f32 = jnp.float32
    L = z.shape[1]
    x0 = z[..., :HY_CH].astype(f32)
    x1 = z[..., HY_CH:2 * HY_CH].astype(f32)
    v = z[..., 2 * HY_CH:].astype(f32)
    u = x1 * v
    n = 2 * L
    y = jnp.fft.irfft(jnp.fft.rfft(u, n=n, axis=1) * jnp.fft.rfft(filt, n=n, axis=0)[None], n=n, axis=1)[:, :L]
    return (x0 * (y + u * d_bias)).astype(z.dtype)


def rwkv7_scan(r, w, k, v, a, b):
    B, L, H, N = r.shape

    def step(S, inp):
        r_t, w_t, k_t, v_t, a_t, b_t = inp
        sa = jnp.einsum('bhvk,bhk->bhv', S, a_t)
        S = S * w_t[:, :, None, :] + sa[..., None] * b_t[:, :, None, :] + v_t[..., None] * k_t[:, :, None, :]
        return S, jnp.einsum('bhvk,bhk->bhv', S, r_t)

    S0 = jnp.zeros((B, H, N, N), jnp.float32)
    xs = tuple(jnp.swapaxes(s, 0, 1) for s in (r, w, k, v, a, b))
    _, ys = lax.scan(step, S0, xs)
    return jnp.swapaxes(ys, 0, 1)


def rwkv7_mix(rkv_c, rkv_l, lora_c, lora_l, lp):
    f32 = jnp.float32
    B, Lc, _ = rkv_c.shape
    T = rkv_l.shape[1]
    Lt = Lc + T
    hs = (B, Lt, RW_HEADS, RW_HD)
    rkv = jnp.concatenate([rkv_c, rkv_l], axis=1).astype(f32)
    lora = jnp.concatenate([lora_c, lora_l], axis=1).astype(f32)
    r = rkv[..., :RW_W].reshape(hs)
    k = rkv[..., RW_W:2 * RW_W].reshape(hs)
    v = rkv[..., 2 * RW_W:].reshape(hs)
    kk = k * lp['rw_k_k'].astype(f32).reshape(RW_HEADS, RW_HD)
    kk = kk * lax.rsqrt(jnp.sum(kk * kk, axis=-1, keepdims=True) + 1e-12)
    k_a = lp['rw_k_a'].astype(f32).reshape(RW_HEADS, RW_HD)
    r_k = lp['rw_r_k'].astype(f32)
    perm = jnp.concatenate([jnp.arange(Lc - 1, -1, -1), Lc + jnp.arange(T - 1, -1, -1)])
    y_sum = jnp.zeros(hs, f32)
    bonus = jnp.zeros(hs, f32)
    for d in range(2):
        wd = lora[..., d * RW_DECAY_R:(d + 1) * RW_DECAY_R]
        ad = lora[..., 2 * RW_DECAY_R + d * RW_ICLR_R:2 * RW_DECAY_R + (d + 1) * RW_ICLR_R]
        w_log = -jax.nn.softplus(-(lp['rw_w0'][d] + jnp.tanh(wd) @ lp['rw_w_up'][d])) - 0.5
        decay = jnp.exp(-jnp.exp(w_log.astype(f32))).reshape(hs)
        a = jax.nn.sigmoid((lp['rw_a0'][d] + ad @ lp['rw_a_up'][d]).astype(f32)).reshape(hs)
        k_d = k * (1.0 + (a - 1.0) * k_a)
        seqs = (r, decay, k_d, v, -kk, kk * a)
        if d == 1:
            seqs = tuple(s[:, perm] for s in seqs)
        y = rwkv7_scan(*seqs)
        if d == 1:
            y = y[:, perm]
        y_sum = y_sum + y
        bonus = bonus + jnp.sum(r * k_d * r_k, axis=-1, keepdims=True) * v
    mu = jnp.mean(y_sum, axis=-1, keepdims=True)
    var = jnp.mean(jnp.square(y_sum - mu), axis=-1, keepdims=True)
    yn = (y_sum - mu) * lax.rsqrt(var + RW_GN_EPS)
    yn = yn * lp['rw_ln_w'].astype(f32).reshape(RW_HEADS, RW_HD) + lp['rw_ln_b'].astype(f32).reshape(RW_HEADS, RW_HD)
    g = jax.nn.sigmoid(lora[..., 2 * RW_DECAY_R + 2 * RW_ICLR_R:]) @ lp['rw_g_up']
    out = ((yn + bonus).reshape(B, Lt, RW_W) * g).astype(rkv_l.dtype)
    return out[:, :Lc], out[:, Lc:]


def axial_rope(x):
    f32 = jnp.float32
    T = x.shape[1]
    rows = T // GRID_W
    row = jnp.repeat(jnp.arange(rows), GRID_W).astype(f32)
    col = jnp.tile(jnp.arange(GRID_W), rows).astype(f32)
    half = AT_HD // 2
    quarter = half // 2
    inv = ROPE_BASE ** (-jnp.arange(quarter, dtype=f32) / quarter)

    def rot(xa, pos):
        ang = pos[:, None] * inv[None, :]
        cos = jnp.cos(ang)[None, :, None, :]
        sin = jnp.sin(ang)[None, :, None, :]
        x1, x2 = xa[..., :quarter], xa[..., quarter:]
        return jnp.concatenate([x1 * cos - x2 * sin, x2 * cos + x1 * sin], axis=-1)

    xf = x.astype(f32)
    return jnp.concatenate([rot(xf[..., :half], row), rot(xf[..., half:], col)], axis=-1).astype(x.dtype)


def split_attn(z):
    B, L, _ = z.shape
    a = z[..., OFF_AT:]
    q = a[..., :AT_W].reshape(B, L, AT_HQ, AT_HD)
    k = a[..., AT_W:AT_W + AT_KVW].reshape(B, L, AT_HKV, AT_HD)
    v = a[..., AT_W + AT_KVW:].reshape(B, L, AT_HKV, AT_HD)
    return q, k, v


def windowed_gqa(q, k, v, kc, vc, sink):
    B, T = q.shape[:2]
    Lc = kc.shape[1]
    nblk = T // ATT_BLOCK
    span = ATT_BLOCK + 2 * ATT_WINDOW
    scale = AT_HD ** -0.5
    kp = jnp.pad(k, ((0, 0), (ATT_WINDOW, ATT_WINDOW), (0, 0), (0, 0)))
    vp = jnp.pad(v, ((0, 0), (ATT_WINDOW, ATT_WINDOW), (0, 0), (0, 0)))
    sink_b = jnp.broadcast_to(sink.astype(jnp.float32)[None, :, :, None, None], (B, AT_HKV, AT_G, ATT_BLOCK, 1))

    def block(i):
        s0 = i * ATT_BLOCK
        qb = lax.dynamic_slice_in_dim(q, s0, ATT_BLOCK, axis=1)
        kb = lax.dynamic_slice_in_dim(kp, s0, span, axis=1)
        vb = lax.dynamic_slice_in_dim(vp, s0, span, axis=1)
        qpos = s0 + jnp.arange(ATT_BLOCK)
        kpos = s0 - ATT_WINDOW + jnp.arange(span)
        valid = (jnp.abs(qpos[:, None] - kpos[None, :]) <= ATT_WINDOW) & (kpos >= 0)[None, :] & (kpos < T)[None, :]
        s_lat = jnp.einsum('bqgjd,bkgd->bgjqk', qb, kb).astype(jnp.float32) * scale
        s_lat = jnp.where(valid, s_lat, NEG_INF)
        s_ctx = jnp.einsum('bqgjd,bkgd->bgjqk', qb, kc).astype(jnp.float32) * scale
        p = jax.nn.softmax(jnp.concatenate([s_lat, s_ctx, sink_b], axis=-1), axis=-1).astype(v.dtype)
        return (jnp.einsum('bgjqk,bkgd->bqgjd', p[..., :span], vb)
                + jnp.einsum('bgjqk,bkgd->bqgjd', p[..., span:span + Lc], vc))

    o = lax.map(block, jnp.arange(nblk))
    return jnp.swapaxes(o, 0, 1).reshape(B, T, AT_W)


def context_attention(qc, kc, vc, sink):
    B, Lc = qc.shape[:2]
    scale = AT_HD ** -0.5
    s = jnp.einsum('bqgjd,bkgd->bgjqk', qc, kc).astype(jnp.float32) * scale
    sink_b = jnp.broadcast_to(sink.astype(jnp.float32)[None, :, :, None, None], (B, AT_HKV, AT_G, Lc, 1))
    p = jax.nn.softmax(jnp.concatenate([s, sink_b], axis=-1), axis=-1)[..., :Lc].astype(vc.dtype)
    return jnp.einsum('bgjqk,bkgd->bqgjd', p, vc).reshape(B, Lc, AT_W)


def token_mixer(hl, hc, lp, need_ctx):
    B, T, _ = hl.shape
    Lc = hc.shape[1]
    zl = hl @ lp['w_in']
    zc = hc @ lp['w_in']
    sl = short_conv3(zl[..., :CONV_COLS], lp['conv_w'], lp['conv_b'])
    sc = short_conv3(zc[..., :CONV_COLS], lp['conv_w'], lp['conv_b'])
    filt_p = (lp['hy_w1'], lp['hy_b1'], lp['hy_w2'], lp['hy_b2'], lp['hy_w3'], lp['hy_b3'], lp['hy_freq'])
    hy_l = hyena_mix(sl[..., OFF_HY:OFF_RK], hyena_filter(T, *filt_p), lp['hy_bias'])
    rw_c, rw_l = rwkv7_mix(sc[..., OFF_RK:], sl[..., OFF_RK:], zc[..., OFF_LORA:OFF_AT], zl[..., OFF_LORA:OFF_AT], lp)
    ql, kl, vl = split_attn(zl)
    qc, kc, vc = split_attn(zc)
    sink = lp['attn_sink'].reshape(AT_HKV, AT_G)
    ql = axial_rope(ql).reshape(B, T, AT_HKV, AT_G, AT_HD)
    kl = axial_rope(kl)
    at_l = windowed_gqa(ql, kl, vl, kc, vc, sink)
    out_l = jnp.concatenate([rmsnorm(hy_l, lp['hy_out_g']), rw_l, rmsnorm(at_l, lp['at_out_g'])], axis=-1) @ lp['w_out']
    if not need_ctx:
        return out_l, None
    hy_c = hyena_mix(sc[..., OFF_HY:OFF_RK], hyena_filter(Lc, *filt_p), lp['hy_bias'])
    at_c = context_attention(qc.reshape(B, Lc, AT_HKV, AT_G, AT_HD), kc, vc, sink)
    out_c = jnp.concatenate([rmsnorm(hy_c, lp['hy_out_g']), rw_c, rmsnorm(at_c, lp['at_out_g'])], axis=-1) @ lp['w_out']
    return out_l, out_c


def peer_ffn(h, wq, k1, k2, u, v):
    n, d = h.shape
    hb = h.reshape(n // PEER_CHUNK, PEER_CHUNK, d)

    def chunk(xc):
        q = (xc @ wq).reshape(PEER_CHUNK, PEER_HEADS, 2, PEER_DQ // 2)
        s1 = jnp.einsum('chd,hnd->chn', q[:, :, 0], k1).astype(jnp.float32)
        s2 = jnp.einsum('chd,hnd->chn', q[:, :, 1], k2).astype(jnp.float32)
        v1, i1 = lax.top_k(s1, PEER_TOPK)
        v2, i2 = lax.top_k(s2, PEER_TOPK)
        cand = (v1[..., :, None] + v2[..., None, :]).reshape(PEER_CHUNK, PEER_HEADS, PEER_TOPK * PEER_TOPK)
        cidx = (i1[..., :, None] * PEER_NKEYS + i2[..., None, :]).reshape(PEER_CHUNK, PEER_HEADS, PEER_TOPK * PEER_TOPK)
        sc, pos = lax.top_k(cand, PEER_TOPK)
        eidx = jnp.take_along_axis(cidx, pos, axis=-1)
        gate = jax.nn.softmax(sc, axis=-1)
        act = jax.nn.gelu(jnp.einsum('cd,chkd->chk', xc, u[eidx]).astype(jnp.float32), approximate=False)
        return jnp.einsum('chk,chkd->cd', (gate * act).astype(xc.dtype), v[eidx])

    return lax.map(chunk, hb).reshape(n, d)


def setup_inputs(seed: int = 0) -> dict:
    key = jax.random.key(seed)
    ks = iter(jax.random.split(key, 48))
    f32 = jnp.float32

    def nrm(shape, scale):
        return jax.random.normal(next(ks), shape, f32) * scale

    def gain(shape):
        return 1.0 + nrm(shape, 0.05)

    D = D_MODEL
    return {
        'x': nrm((BATCH, SEQ, D), 1.0),
        'c': nrm((BATCH, D), 1.0),
        'ctx': nrm((BATCH, CTX_LEN, D), 1.0),
        'c_ctx': nrm((D,), 1.0),
        'mod_w': nrm((DEPTH, D, 6 * D), 0.01),
        'mod_b': nrm((DEPTH, 6 * D), 0.01),
        'norm1_g': gain((DEPTH, D)),
        'norm2_g': gain((DEPTH, D)),
        'w_in': nrm((DEPTH, D, IN_W), D ** -0.5),
        'conv_w': nrm((DEPTH, 3, CONV_COLS), 0.6),
        'conv_b': nrm((DEPTH, CONV_COLS), 0.01),
        'hy_w1': nrm((DEPTH, HY_EMB, HY_HID), HY_EMB ** -0.5),
        'hy_b1': nrm((DEPTH, HY_HID), 0.1),
        'hy_w2': nrm((DEPTH, HY_HID, HY_HID), HY_HID ** -0.5),
        'hy_b2': nrm((DEPTH, HY_HID), 0.1),
        'hy_w3': nrm((DEPTH, HY_HID, 2 * HY_CH), HY_HID ** -0.5),
        'hy_b3': nrm((DEPTH, 2 * HY_CH), 0.01),
        'hy_freq': 1.0 + nrm((DEPTH, 2, HY_HID), 0.1),
        'hy_bias': nrm((DEPTH, HY_CH), 0.5),
        'rw_w0': jax.random.uniform(next(ks), (DEPTH, 2, RW_W), f32, -6.0, 0.5),
        'rw_w_up': nrm((DEPTH, 2, RW_DECAY_R, RW_W), 0.1 * RW_DECAY_R ** -0.5),
        'rw_a0': nrm((DEPTH, 2, RW_W), 0.1),
        'rw_a_up': nrm((DEPTH, 2, RW_ICLR_R, RW_W), RW_ICLR_R ** -0.5),
        'rw_g_up': nrm((DEPTH, RW_GATE_R, RW_W), RW_GATE_R ** -0.5),
        'rw_k_k': 0.85 + nrm((DEPTH, RW_W), 0.05),
        'rw_k_a': gain((DEPTH, RW_W)),
        'rw_r_k': nrm((DEPTH, RW_HEADS, RW_HD), 0.1),
        'rw_ln_w': gain((DEPTH, RW_W)),
        'rw_ln_b': nrm((DEPTH, RW_W), 0.01),
        'attn_sink': nrm((DEPTH, AT_HQ), 0.5),
        'hy_out_g': gain((DEPTH, HY_CH)),
        'at_out_g': gain((DEPTH, AT_W)),
        'w_out': nrm((DEPTH, MIX_W, D), MIX_W ** -0.5),
        'peer_wq': nrm((DEPTH, D, PEER_HEADS * PEER_DQ), D ** -0.5),
        'peer_k1': nrm((DEPTH, PEER_HEADS, PEER_NKEYS, PEER_DQ // 2), (PEER_DQ // 2) ** -0.5),
        'peer_k2': nrm((DEPTH, PEER_HEADS, PEER_NKEYS, PEER_DQ // 2), (PEER_DQ // 2) ** -0.5),
        'peer_u': nrm((DEPTH, PEER_NEXP, D), D ** -0.5),
        'peer_v': nrm((DEPTH, PEER_NEXP, D), 1.0),
        'final_g': gain((D,)),
    }


def reference(x, c, ctx, c_ctx, mod_w, mod_b, norm1_g, norm2_g, w_in, conv_w, conv_b,
              hy_w1, hy_b1, hy_w2, hy_b2, hy_w3, hy_b3, hy_freq, hy_bias,
              rw_w0, rw_w_up, rw_a0, rw_a_up, rw_g_up, rw_k_k, rw_k_a, rw_r_k, rw_ln_w, rw_ln_b,
              attn_sink, hy_out_g, at_out_g, w_out,
              peer_wq, peer_k1, peer_k2, peer_u, peer_v, final_g):
    B, T, D = x.shape
    Lc = ctx.shape[1]
    c_s = jax.nn.silu(c)
    cc_s = jax.nn.silu(c_ctx)
    xl, xc = x, ctx
    for i in range(DEPTH):
        last = i == DEPTH - 1
        lp = dict(w_in=w_in[i], conv_w=conv_w[i], conv_b=conv_b[i],
                  hy_w1=hy_w1[i], hy_b1=hy_b1[i], hy_w2=hy_w2[i], hy_b2=hy_b2[i],
                  hy_w3=hy_w3[i], hy_b3=hy_b3[i], hy_freq=hy_freq[i], hy_bias=hy_bias[i],
                  rw_w0=rw_w0[i], rw_w_up=rw_w_up[i], rw_a0=rw_a0[i], rw_a_up=rw_a_up[i],
                  rw_g_up=rw_g_up[i], rw_k_k=rw_k_k[i], rw_k_a=rw_k_a[i], rw_r_k=rw_r_k[i],
                  rw_ln_w=rw_ln_w[i], rw_ln_b=rw_ln_b[i], attn_sink=attn_sink[i],
                  hy_out_g=hy_out_g[i], at_out_g=at_out_g[i], w_out=w_out[i])
        sh1, sc1, g1, sh2, sc2, g2 = jnp.split((c_s @ mod_w[i] + mod_b[i])[:, None, :], 6, axis=-1)
        csh1, csc1, cg1, csh2, csc2, cg2 = jnp.split(cc_s @ mod_w[i] + mod_b[i], 6, axis=-1)
        hl = rmsnorm(xl, norm1_g[i]) * (1.0 + sc1) + sh1
        hc = rmsnorm(xc, norm1_g[i]) * (1.0 + csc1) + csh1
        ml, mc = token_mixer(hl, hc, lp, not last)
        xl = xl + g1 * ml
        h2l = rmsnorm(xl, norm2_g[i]) * (1.0 + sc2) + sh2
        if last:
            fl = peer_ffn(h2l.reshape(B * T, D), peer_wq[i], peer_k1[i], peer_k2[i], peer_u[i], peer_v[i]).reshape(B, T, D)
        else:
            xc = xc + cg1 * mc
            h2c = rmsnorm(xc, norm2_g[i]) * (1.0 + csc2) + csh2
            tok = jnp.concatenate([h2l.reshape(B * T, D), h2c.reshape(B * Lc, D)], axis=0)
            f = peer_ffn(tok, peer_wq[i], peer_k1[i], peer_k2[i], peer_u[i], peer_v[i])
            fl = f[:B * T].reshape(B, T, D)
            xc = xc + cg2 * f[B * T:].reshape(B, Lc, D)
        xl = xl + g2 * fl
    return rmsnorm(xl, final_g)
```

```cpp
#include <hip/hip_runtime.h>
#include <stdint.h>

#define DEV __device__ __forceinline__
typedef unsigned short bf16_t;
typedef short bf16x8 __attribute__((ext_vector_type(8)));
typedef float f32x4 __attribute__((ext_vector_type(4)));
typedef float f32x16 __attribute__((ext_vector_type(16)));

#ifndef NLAYERS
#define NLAYERS 4
#endif
#ifndef EN_HY
#define EN_HY 1
#endif
#ifndef EN_RW
#define EN_RW 1
#endif
#ifndef EN_AT
#define EN_AT 1
#endif
#ifndef EN_MIX
#define EN_MIX 1
#endif
#ifndef EN_PEER
#define EN_PEER 1
#endif

constexpr int NB = 16, T = 4096, LC = 256, LT = 4352, D = 1024, NTOK = NB * LT, INW = 2688, DEPTH = 4;
constexpr int SMEM_BYTES = 49152;

struct P {
  const float *x, *c, *ctx, *c_ctx, *mod_w, *mod_b, *norm1_g, *norm2_g, *w_in, *conv_w, *conv_b;
  const float *hy_w1, *hy_b1, *hy_w2, *hy_b2, *hy_w3, *hy_b3, *hy_freq, *hy_bias;
  const float *rw_w0, *rw_w_up, *rw_a0, *rw_a_up, *rw_g_up, *rw_k_k, *rw_k_a, *rw_r_k, *rw_ln_w, *rw_ln_b;
  const float *attn_sink, *hy_out_g, *at_out_g, *w_out, *peer_wq, *peer_k1, *peer_k2, *peer_u, *peer_v, *final_g;
  float* out;
  unsigned* bar;
  float *modv, *SSQ, *rope, *FL, *FC, *TK;
  bf16_t *X, *H, *Y, *SC, *Z, *UTl, *UTc, *YTl, *YTc;
  bf16_t *W1t, *W2t, *Wft, *Wwt, *Wat, *Wgt, *PU, *PV;
};

DEV bf16_t f2bf(float f) { unsigned u = __float_as_uint(f); u += 0x7FFFu + ((u >> 16) & 1u); return (bf16_t)(u >> 16); }
DEV float bf2f(bf16_t h) { return __uint_as_float(((unsigned)h) << 16); }
DEV unsigned pack2(float a, float b) { return (unsigned)f2bf(a) | ((unsigned)f2bf(b) << 16); }
DEV float bflo(unsigned u) { return __uint_as_float(u << 16); }
DEV float bfhi(unsigned u) { return __uint_as_float(u & 0xFFFF0000u); }
DEV void unpack8(const uint4& u, float* v) {
  v[0] = bflo(u.x); v[1] = bfhi(u.x); v[2] = bflo(u.y); v[3] = bfhi(u.y);
  v[4] = bflo(u.z); v[5] = bfhi(u.z); v[6] = bflo(u.w); v[7] = bfhi(u.w);
}
DEV uint4 pack8(const float* v) { return make_uint4(pack2(v[0], v[1]), pack2(v[2], v[3]), pack2(v[4], v[5]), pack2(v[6], v[7])); }
DEV float sigmoidf_(float x) { return 1.f / (1.f + __expf(-x)); }

template <int CTRL, int ROWMASK>
DEV float dpp0(float x) {
  return __builtin_bit_cast(float, __builtin_amdgcn_update_dpp(0, __builtin_bit_cast(int, x), CTRL, ROWMASK, 0xF, false));
}
template <int CTRL, int ROWMASK>
DEV float dppself(float x) {
  int xi = __builtin_bit_cast(int, x);
  return __builtin_bit_cast(float, __builtin_amdgcn_update_dpp(xi, xi, CTRL, ROWMASK, 0xF, false));
}
DEV float readlane_f(float x, int l) { return __builtin_bit_cast(float, __builtin_amdgcn_readlane(__builtin_bit_cast(int, x), l)); }
DEV int lane_id() { return (int)__builtin_amdgcn_mbcnt_hi(~0u, __builtin_amdgcn_mbcnt_lo(~0u, 0u)); }
DEV float writelane_f(float val, int l, float old) { return lane_id() == l ? val : old; }
DEV int writelane_i(int val, int l, int old) { return lane_id() == l ? val : old; }
DEV float wave_sum(float x) {
  x += dpp0<0x111, 0xF>(x); x += dpp0<0x112, 0xF>(x); x += dpp0<0x114, 0xF>(x); x += dpp0<0x118, 0xF>(x);
  x += dpp0<0x142, 0xA>(x); x += dpp0<0x143, 0xC>(x);
  return readlane_f(x, 63);
}
DEV float wave_max(float x) {
  x = fmaxf(x, dppself<0x111, 0xF>(x)); x = fmaxf(x, dppself<0x112, 0xF>(x)); x = fmaxf(x, dppself<0x114, 0xF>(x));
  x = fmaxf(x, dppself<0x118, 0xF>(x)); x = fmaxf(x, dppself<0x142, 0xA>(x)); x = fmaxf(x, dppself<0x143, 0xC>(x));
  return readlane_f(x, 63);
}
DEV float row16_sum(float x) {
  x += dpp0<0xB1, 0xF>(x); x += dpp0<0x4E, 0xF>(x); x += dpp0<0x141, 0xF>(x); x += dpp0<0x140, 0xF>(x);
  return x;
}
DEV float row16_max(float x) {
  x = fmaxf(x, dppself<0xB1, 0xF>(x)); x = fmaxf(x, dppself<0x4E, 0xF>(x)); x = fmaxf(x, dppself<0x141, 0xF>(x));
  x = fmaxf(x, dppself<0x140, 0xF>(x));
  return x;
}
DEV float quad_sum(float x) { x += dpp0<0xB1, 0xF>(x); x += dpp0<0x4E, 0xF>(x); return x; }

DEV f32x4 mfma16(bf16x8 a, bf16x8 b, f32x4 c) { return __builtin_amdgcn_mfma_f32_16x16x32_bf16(a, b, c, 0, 0, 0); }
DEV f32x16 mfma32(bf16x8 a, bf16x8 b, f32x16 c) { return __builtin_amdgcn_mfma_f32_32x32x16_bf16(a, b, c, 0, 0, 0); }

template <class Epi>
DEV void gemm_tile(const bf16_t* __restrict__ A, int lda, const bf16_t* __restrict__ Bt, int ldb, int K, char* smem, Epi& epi) {
  typedef bf16_t Tile[128][40];
  Tile* As = (Tile*)smem;
  Tile* Bs = (Tile*)(smem + 20480);
  const int tid = threadIdx.x, lane = tid & 63, wid = tid >> 6, wr = wid >> 1, wc = wid & 1, fr = lane & 15, fq = lane >> 4;
  f32x4 acc[4][4];
#pragma unroll
  for (int m = 0; m < 4; ++m)
#pragma unroll
    for (int n = 0; n < 4; ++n) acc[m][n] = (f32x4){0.f, 0.f, 0.f, 0.f};
  const int r0 = tid >> 2, sg = tid & 3;
  const bf16_t* a0 = A + (size_t)r0 * lda + sg * 8;
  const bf16_t* a1 = a0 + (size_t)64 * lda;
  const bf16_t* b0 = Bt + (size_t)r0 * ldb + sg * 8;
  const bf16_t* b1 = b0 + (size_t)64 * ldb;
  uint4 ra0 = *(const uint4*)a0, ra1 = *(const uint4*)a1, rb0 = *(const uint4*)b0, rb1 = *(const uint4*)b1;
  __syncthreads();
  *(uint4*)&As[0][r0][sg * 8] = ra0; *(uint4*)&As[0][r0 + 64][sg * 8] = ra1;
  *(uint4*)&Bs[0][r0][sg * 8] = rb0; *(uint4*)&Bs[0][r0 + 64][sg * 8] = rb1;
  __syncthreads();
  const int nk = K >> 5;
  for (int kt = 0; kt < nk; ++kt) {
    const int cur = kt & 1;
    if (kt + 1 < nk) {
      const int ko = (kt + 1) * 32;
      ra0 = *(const uint4*)(a0 + ko); ra1 = *(const uint4*)(a1 + ko);
      rb0 = *(const uint4*)(b0 + ko); rb1 = *(const uint4*)(b1 + ko);
    }
    bf16x8 af[4], bfr[4];
#pragma unroll
    for (int m = 0; m < 4; ++m) af[m] = *(const bf16x8*)&As[cur][wr * 64 + m * 16 + fr][fq * 8];
#pragma unroll
    for (int n = 0; n < 4; ++n) bfr[n] = *(const bf16x8*)&Bs[cur][wc * 64 + n * 16 + fr][fq * 8];
#pragma unroll
    for (int m = 0; m < 4; ++m)
#pragma unroll
      for (int n = 0; n < 4; ++n) acc[m][n] = mfma16(af[m], bfr[n], acc[m][n]);
    if (kt + 1 < nk) {
      *(uint4*)&As[cur ^ 1][r0][sg * 8] = ra0; *(uint4*)&As[cur ^ 1][r0 + 64][sg * 8] = ra1;
      *(uint4*)&Bs[cur ^ 1][r0][sg * 8] = rb0; *(uint4*)&Bs[cur ^ 1][r0 + 64][sg * 8] = rb1;
    }
    __syncthreads();
  }
  epi(acc, wr, wc, fr, fq, smem);
}

DEV void ph_copy(const P& p) {
  const size_t n8 = (size_t)NTOK * D / 8;
  for (size_t i = (size_t)blockIdx.x * 256 + threadIdx.x; i < n8; i += (size_t)gridDim.x * 256) {
    size_t e = i * 8;
    int row = (int)(e / D), col = (int)(e % D);
    int b = row / LT, pp = row % LT;
    const float* src = pp < LC ? p.ctx + ((size_t)(b * LC + pp)) * D + col : p.x + ((size_t)(b * T + pp - LC)) * D + col;
    float4 v0 = *(const float4*)src, v1 = *(const float4*)(src + 4);
    uint4 o = make_uint4(pack2(v0.x, v0.y), pack2(v0.z, v0.w), pack2(v1.x, v1.y), pack2(v1.z, v1.w));
    *(uint4*)(p.X + e) = o;
  }
}

DEV void ph_rope(const P& p) {
  for (int i = blockIdx.x * 256 + threadIdx.x; i < 64 * 16; i += gridDim.x * 256) {
    int pos = i >> 4, k = i & 15;
    float inv = powf(10000.f, -(float)k / 16.f);
    float ang = (float)pos * inv;
    p.rope[2 * i] = cosf(ang); p.rope[2 * i + 1] = sinf(ang);
  }
}

DEV void modv_unit(const P& p, int unit, char* smem) {
  const int cc = unit % 24, layer = unit / 24;
  float (*cs)[128] = (float (*)[128])smem;
  const int col = cc * 256 + threadIdx.x;
  float acc[17];
#pragma unroll
  for (int r = 0; r < 17; ++r) acc[r] = 0.f;
  for (int ks = 0; ks < 8; ++ks) {
    __syncthreads();
    for (int i = threadIdx.x; i < 17 * 128; i += 256) {
      int r = i >> 7, e = i & 127;
      float v = r < 16 ? p.c[r * D + ks * 128 + e] : p.c_ctx[ks * 128 + e];
      cs[r][e] = v / (1.f + expf(-v));
    }
    __syncthreads();
    const float* w = p.mod_w + ((size_t)layer * D + ks * 128) * 6144 + col;
#pragma unroll 4
    for (int e = 0; e < 128; ++e) {
      float wv = w[(size_t)e * 6144];
#pragma unroll
      for (int r = 0; r < 17; ++r) acc[r] += cs[r][e] * wv;
    }
  }
  const float bias = p.mod_b[layer * 6144 + col];
#pragma unroll
  for (int r = 0; r < 17; ++r) p.modv[((size_t)layer * 17 + r) * 6144 + col] = acc[r] + bias;
}

DEV void transpose_unit(const float* __restrict__ src, bf16_t* __restrict__ dst, int R, int C, int tile, char* smem) {
  float (*t)[65] = (float (*)[65])smem;
  const int nct = C / 64;
  const int tr = tile / nct, tc = tile % nct;
  __syncthreads();
  for (int i = threadIdx.x; i < 4096; i += 256) { int r = i >> 6, c = i & 63; t[r][c] = src[(size_t)(tr * 64 + r) * C + tc * 64 + c]; }
  __syncthreads();
  for (int i = threadIdx.x; i < 4096; i += 256) { int c = i >> 6, r = i & 63; dst[(size_t)(tc * 64 + c) * R + tr * 64 + r] = f2bf(t[r][c]); }
}

DEV void wfold_unit(const P& p, int layer, int unit, char* smem) {
  const int hs = unit >> 5, ec = unit & 31, h = hs >> 1, s = hs & 1;
  const float* wq = p.peer_wq + (size_t)layer * D * 2048;
  const float* kk = (s ? p.peer_k2 : p.peer_k1) + ((size_t)layer * 8 + h) * 128 * 128;
  float (*kS)[65] = (float (*)[65])smem;
  float (*wS)[64] = (float (*)[64])(smem + 33280);
  const int key = threadIdx.x & 127, eh = threadIdx.x >> 7;
  float acc[16];
#pragma unroll
  for (int i = 0; i < 16; ++i) acc[i] = 0.f;
  for (int dh = 0; dh < 2; ++dh) {
    __syncthreads();
    for (int i = threadIdx.x; i < 128 * 64; i += 256) { int k2 = i >> 6, d = i & 63; kS[k2][d] = kk[k2 * 128 + dh * 64 + d]; }
    for (int i = threadIdx.x; i < 32 * 64; i += 256) {
      int e = i >> 6, d = i & 63;
      wS[e][d] = wq[(size_t)(ec * 32 + e) * 2048 + h * 256 + s * 128 + dh * 64 + d];
    }
    __syncthreads();
#pragma unroll 2
    for (int d = 0; d < 64; ++d) {
      float kv = kS[key][d];
#pragma unroll
      for (int i = 0; i < 16; ++i) acc[i] += kv * wS[eh * 16 + i][d];
    }
  }
  bf16_t* dst = p.Wft + ((size_t)(hs * 128 + key)) * D + ec * 32 + eh * 16;
#pragma unroll
  for (int i = 0; i < 16; i += 2) *(unsigned*)(dst + i) = pack2(acc[i], acc[i + 1]);
}

DEV void filt_unit(const P& p, int layer, int unit, char* smem) {
  int kind, j0, L;
  if (unit < 1024) { kind = 0; j0 = unit * 4; L = T; } else { kind = 1; j0 = (unit - 1024) * 4; L = LC; }
  float* zs = (float*)smem;
  float* h1 = zs + 4 * 36;
  float* h2 = h1 + 256;
  const int jj = threadIdx.x >> 6, o = threadIdx.x & 63;
  const int j = j0 + jj;
  const float fj = (float)j;
  const float t = fj / (float)(L - 1);
  __syncthreads();
  if (o < 33) {
    float z;
    if (o == 0) z = t;
    else {
      int i = (o - 1) & 15;
      float band = 1e-4f + (float)i * ((15.0f - 1e-4f) / 15.0f);
      float ang = 6.283185307179586f * fj * band / (float)L;
      z = (o <= 16) ? cosf(ang) : -sinf(ang);
    }
    zs[jj * 36 + o] = z;
  }
  __syncthreads();
  {
    const float* w1 = p.hy_w1 + layer * 33 * 64;
    float a = p.hy_b1[layer * 64 + o];
#pragma unroll 3
    for (int i = 0; i < 33; ++i) a += zs[jj * 36 + i] * w1[i * 64 + o];
    h1[jj * 64 + o] = sinf(p.hy_freq[layer * 128 + o] * a);
  }
  __syncthreads();
  {
    const float* w2 = p.hy_w2 + layer * 64 * 64;
    float a = p.hy_b2[layer * 64 + o];
#pragma unroll 4
    for (int i = 0; i < 64; ++i) a += h1[jj * 64 + i] * w2[i * 64 + o];
    h2[jj * 64 + o] = sinf(p.hy_freq[layer * 128 + 64 + o] * a);
  }
  __syncthreads();
  const float* w3 = p.hy_w3 + layer * 64 * 512;
  float* F = kind ? p.FC : p.FL;
  const float DMIN = -3.0701134573253945f, DMAX = -15.350567286626973f;
#pragma unroll 1
  for (int m = 0; m < 4; ++m) {
    int c = o + 64 * m;
    float af = p.hy_b3[layer * 512 + c], ab = p.hy_b3[layer * 512 + 256 + c];
#pragma unroll 4
    for (int i = 0; i < 64; ++i) { float hv = h2[jj * 64 + i]; af += hv * w3[i * 512 + c]; ab += hv * w3[i * 512 + 256 + c]; }
    float delta = fabsf(DMIN + (float)c * ((DMAX - DMIN) / 255.f));
    float win = expf(-t * delta) + 0.05f;
    af *= win; ab *= win;
    F[((size_t)c * 2 + 0) * L + j] = af;
    F[((size_t)c * 2 + 1) * L + j] = ab;
  }
}

constexpr int PREP_T0 = 672, PREP_T1 = PREP_T0 + 256, PREP_T2 = PREP_T1 + 8, PREP_T3 = PREP_T2 + 8, PREP_T4 = PREP_T3 + 8;
constexpr int PREP_WF = PREP_T4 + 512, PREP_N = PREP_WF + 1088;
DEV void ph_prep(const P& p, int layer, char* smem) {
  for (int u = blockIdx.x; u < PREP_N; u += gridDim.x) {
    if (u < PREP_T0) transpose_unit(p.w_in + (size_t)layer * D * INW, p.W1t, D, INW, u, smem);
    else if (u < PREP_T1) transpose_unit(p.w_out + (size_t)layer * D * D, p.W2t, D, D, u - PREP_T0, smem);
    else if (u < PREP_T2) { int q = u - PREP_T1, d = q >> 2; transpose_unit(p.rw_w_up + ((size_t)layer * 2 + d) * 64 * 256, p.Wwt + d * 256 * 64, 64, 256, q & 3, smem); }
    else if (u < PREP_T3) { int q = u - PREP_T2, d = q >> 2; transpose_unit(p.rw_a_up + ((size_t)layer * 2 + d) * 64 * 256, p.Wat + d * 256 * 64, 64, 256, q & 3, smem); }
    else if (u < PREP_T4) transpose_unit(p.rw_g_up + (size_t)layer * 128 * 256, p.Wgt, 128, 256, u - PREP_T3, smem);
    else if (u < PREP_WF) wfold_unit(p, layer, u - PREP_T4, smem);
    else filt_unit(p, layer, u - PREP_WF, smem);
  }
}

DEV void ph_norm(const P& p, int layer, int which) {
  const int gw = (blockIdx.x * 256 + threadIdx.x) >> 6, nw = gridDim.x * 4, lane = threadIdx.x & 63;
  const float* g = (which ? p.norm2_g : p.norm1_g) + layer * D;
  for (int row = gw; row < NTOK; row += nw) {
    int b = row / LT, pp = row % LT;
    int mr = pp < LC ? 16 : b;
    const float* mv = p.modv + ((size_t)layer * 17 + mr) * 6144 + (which ? 3072 : 0);
    const bf16_t* xr = p.X + (size_t)row * D;
    uint4 u0 = *(const uint4*)(xr + 8 * lane), u1 = *(const uint4*)(xr + 512 + 8 * lane);
    float v[16];
    unpack8(u0, v); unpack8(u1, v + 8);
    float ss = 0.f;
#pragma unroll
    for (int i = 0; i < 16; ++i) ss += v[i] * v[i];
    ss = wave_sum(ss);
    float rstd = rsqrtf(ss * (1.f / 1024.f) + 1e-6f);
    float o[16];
#pragma unroll
    for (int hh = 0; hh < 2; ++hh)
#pragma unroll
      for (int i = 0; i < 8; ++i) {
        int col = hh * 512 + 8 * lane + i;
        float y = v[hh * 8 + i] * rstd * g[col];
        o[hh * 8 + i] = y * (1.f + mv[1024 + col]) + mv[col];
      }
    bf16_t* hr = p.H + (size_t)row * D;
    *(uint4*)(hr + 8 * lane) = pack8(o);
    *(uint4*)(hr + 512 + 8 * lane) = pack8(o + 8);
  }
}

struct Epi1 {
  const P& p; int row0, col0;
  DEV void operator()(f32x4 (&acc)[4][4], int wr, int wc, int fr, int fq, char*) const {
    const int cw = col0 + wc * 64;
    const int rbase = row0 + wr * 64;
    const bool lat = (row0 % LT) >= LC;
    if (cw >= 1536 && cw < 1664) {
#pragma unroll
      for (int m = 0; m < 4; ++m)
#pragma unroll
        for (int n = 0; n < 4; ++n)
#pragma unroll
          for (int j = 0; j < 4; ++j) acc[m][n][j] = tanhf(acc[m][n][j]);
    } else if (cw >= 1792 && cw < 1920) {
#pragma unroll
      for (int m = 0; m < 4; ++m)
#pragma unroll
        for (int n = 0; n < 4; ++n)
#pragma unroll
          for (int j = 0; j < 4; ++j) acc[m][n][j] = sigmoidf_(acc[m][n][j]);
    } else if (cw >= 1920 && cw < 2560 && lat) {
#pragma unroll
      for (int m = 0; m < 4; ++m)
#pragma unroll
        for (int j = 0; j < 4; ++j) {
          int row = rbase + m * 16 + fq * 4 + j;
          int pl = (row % LT) - LC;
          int ri = pl >> 6, ci = pl & 63;
          float2 cr = *(const float2*)(p.rope + 2 * (ri * 16 + fr));
          float2 cc = *(const float2*)(p.rope + 2 * (ci * 16 + fr));
          float x1 = acc[m][0][j], x2 = acc[m][1][j];
          acc[m][0][j] = x1 * cr.x - x2 * cr.y; acc[m][1][j] = x2 * cr.x + x1 * cr.y;
          x1 = acc[m][2][j]; x2 = acc[m][3][j];
          acc[m][2][j] = x1 * cc.x - x2 * cc.y; acc[m][3][j] = x2 * cc.x + x1 * cc.y;
        }
    }
#pragma unroll
    for (int m = 0; m < 4; ++m)
#pragma unroll
      for (int j = 0; j < 4; ++j) {
        int row = rbase + m * 16 + fq * 4 + j;
        bf16_t* zr = p.Z + (size_t)row * INW + cw + fr;
#pragma unroll
        for (int n = 0; n < 4; ++n) zr[n * 16] = f2bf(acc[m][n][j]);
      }
  }
};
DEV void ph_gemm1(const P& p, char* smem) {
  const int nct = INW / 128;
  for (int u = blockIdx.x; u < (NTOK / 128) * nct; u += gridDim.x) {
    int rt = u / nct, ct = u % nct;
    Epi1 epi{p, rt * 128, ct * 128};
    gemm_tile(p.H + (size_t)rt * 128 * D, D, p.W1t + (size_t)ct * 128 * D, D, D, smem, epi);
  }
}

struct EpiLora {
  const P& p; int layer, q, row0, col0;
  DEV void operator()(f32x4 (&acc)[4][4], int wr, int wc, int fr, int fq, char*) const {
#pragma unroll
    for (int m = 0; m < 4; ++m)
#pragma unroll
      for (int n = 0; n < 4; ++n)
#pragma unroll
        for (int j = 0; j < 4; ++j) {
          int row = row0 + wr * 64 + m * 16 + fq * 4 + j;
          int col = col0 + wc * 64 + n * 16 + fr;
          float v = acc[m][n][j];
          if (q < 2) {
            v = 0.6065306597126334f * sigmoidf_(v + p.rw_w0[(layer * 2 + q) * 256 + col]);
            p.SC[(size_t)row * 1024 + q * 256 + col] = f2bf(v);
          } else if (q < 4) {
            v = sigmoidf_(v + p.rw_a0[(layer * 2 + (q - 2)) * 256 + col]);
            p.SC[(size_t)row * 1024 + q * 256 + col] = f2bf(v);
          } else {
            p.Y[(size_t)row * D + 256 + col] = f2bf(v);
          }
        }
  }
};
DEV void lora_unit(const P& p, int layer, int unit, char* smem) {
  const int q = unit / 1088, r = unit % 1088, rt = r >> 1, ct = r & 1;
  EpiLora epi{p, layer, q, rt * 128, ct * 128};
  const bf16_t* A; const bf16_t* Bt; int K;
  if (q < 2) { A = p.Z + 1536 + 64 * q; Bt = p.Wwt + q * 256 * 64; K = 64; }
  else if (q < 4) { A = p.Z + 1664 + 64 * (q - 2); Bt = p.Wat + (q - 2) * 256 * 64; K = 64; }
  else { A = p.Z + 1792; Bt = p.Wgt; K = 128; }
  gemm_tile(A + (size_t)rt * 128 * INW, INW, Bt + (size_t)ct * 128 * K, K, K, smem, epi);
}

DEV void ph_rwkv_prep(const P& p, int layer) {
  const int gw = (blockIdx.x * 256 + threadIdx.x) >> 6, nw = gridDim.x * 4, lane = threadIdx.x & 63;
  const float* cw = p.conv_w + (size_t)layer * 3 * 1536;
  const float* cb = p.conv_b + (size_t)layer * 1536;
  for (int row = gw; row < NTOK; row += nw) {
    int pp = row % LT;
    bool hasm = (pp != 0) && (pp != LC);
    bool hasp = (pp != LC - 1) && (pp != LT - 1);
    float res[3][4];
#pragma unroll
    for (int a = 0; a < 3; ++a) {
      int col = 768 + a * 256 + 4 * lane;
      const bf16_t* zc = p.Z + (size_t)row * INW + col;
      uint2 um = hasm ? *(const uint2*)(zc - INW) : make_uint2(0, 0);
      uint2 uc = *(const uint2*)zc;
      uint2 up = hasp ? *(const uint2*)(zc + INW) : make_uint2(0, 0);
      float vm[4] = {bflo(um.x), bfhi(um.x), bflo(um.y), bfhi(um.y)};
      float vc[4] = {bflo(uc.x), bfhi(uc.x), bflo(uc.y), bfhi(uc.y)};
      float vp[4] = {bflo(up.x), bfhi(up.x), bflo(up.y), bfhi(up.y)};
#pragma unroll
      for (int i = 0; i < 4; ++i) res[a][i] = cw[col + i] * vm[i] + cw[1536 + col + i] * vc[i] + cw[3072 + col + i] * vp[i] + cb[col + i];
    }
    float kk[4], ss = 0.f;
#pragma unroll
    for (int i = 0; i < 4; ++i) { kk[i] = res[1][i] * p.rw_k_k[layer * 256 + 4 * lane + i]; ss += kk[i] * kk[i]; }
    ss = row16_sum(ss);
    float rs = rsqrtf(ss + 1e-12f);
    bf16_t* hr = p.H + (size_t)row * D + 4 * lane;
#pragma unroll
    for (int a = 0; a < 3; ++a) *(uint2*)(hr + a * 256) = make_uint2(pack2(res[a][0], res[a][1]), pack2(res[a][2], res[a][3]));
    *(uint2*)(hr + 768) = make_uint2(pack2(kk[0] * rs, kk[1] * rs), pack2(kk[2] * rs, kk[3] * rs));
  }
}

struct ScanRaw { bf16_t r, k, kk, e, a, v; };
DEV void scan_unit(const P& p, int layer, int unit, char* smem) {
  const int dir = unit & 1, h = (unit >> 1) & 3, b = unit >> 3;
  const int wid = threadIdx.x >> 6, lane = threadIdx.x & 63;
  const int kq = lane & 3, rowl = lane >> 2, vrow = wid * 16 + rowl;
  float* st = (float*)smem + wid * 640;
  const float ka = p.rw_k_a[layer * 256 + h * 64 + lane];
  float S[16];
#pragma unroll
  for (int i = 0; i < 16; ++i) S[i] = 0.f;
  const size_t rowbase = (size_t)b * LT;
  auto posf = [&](int t) -> int { return dir == 0 ? t : (t < LC ? LC - 1 - t : LT - 1 - (t - LC)); };
  auto load4 = [&](int c, ScanRaw (&dst)[4]) {
#pragma unroll
    for (int i = 0; i < 4; ++i) {
      size_t row = rowbase + posf(c * 4 + i);
      const bf16_t* hp = p.H + row * D + h * 64;
      const bf16_t* sp = p.SC + row * 1024 + h * 64;
      dst[i].r = hp[lane]; dst[i].k = hp[256 + lane]; dst[i].v = hp[512 + vrow]; dst[i].kk = hp[768 + lane];
      dst[i].e = sp[dir * 256 + lane]; dst[i].a = sp[512 + dir * 256 + lane];
    }
  };
  auto comp4 = [&](int c, ScanRaw (&src)[4]) {
#pragma unroll
    for (int i = 0; i < 4; ++i) {
      const int t = c * 4 + i;
      float rr = bf2f(src[i].r), kr = bf2f(src[i].k), kkv = bf2f(src[i].kk), ev = bf2f(src[i].e), av = bf2f(src[i].a), vv = bf2f(src[i].v);
      float w = __expf(-ev), ap = -kkv, bp = kkv * av, kd = kr * (1.f + (av - 1.f) * ka);
      float* sb = st + (i & 1) * 320;
      sb[lane] = ap; sb[64 + lane] = w; sb[128 + lane] = bp; sb[192 + lane] = kd; sb[256 + lane] = rr;
      asm volatile("s_waitcnt lgkmcnt(0)" ::: "memory");
      float4 A4[4], W4[4], B4[4], K4[4], R4[4];
#pragma unroll
      for (int q = 0; q < 4; ++q) {
        A4[q] = *(const float4*)&sb[kq * 16 + 4 * q]; W4[q] = *(const float4*)&sb[64 + kq * 16 + 4 * q];
        B4[q] = *(const float4*)&sb[128 + kq * 16 + 4 * q]; K4[q] = *(const float4*)&sb[192 + kq * 16 + 4 * q];
        R4[q] = *(const float4*)&sb[256 + kq * 16 + 4 * q];
      }
      float s0 = 0.f, s1 = 0.f, s2 = 0.f, s3 = 0.f;
#pragma unroll
      for (int q = 0; q < 4; ++q) { s0 += S[4 * q] * A4[q].x; s1 += S[4 * q + 1] * A4[q].y; s2 += S[4 * q + 2] * A4[q].z; s3 += S[4 * q + 3] * A4[q].w; }
      float sa = quad_sum((s0 + s1) + (s2 + s3));
      float y0 = 0.f, y1 = 0.f, y2 = 0.f, y3 = 0.f;
#pragma unroll
      for (int q = 0; q < 4; ++q) {
        S[4 * q] = S[4 * q] * W4[q].x + (sa * B4[q].x + vv * K4[q].x); y0 += S[4 * q] * R4[q].x;
        S[4 * q + 1] = S[4 * q + 1] * W4[q].y + (sa * B4[q].y + vv * K4[q].y); y1 += S[4 * q + 1] * R4[q].y;
        S[4 * q + 2] = S[4 * q + 2] * W4[q].z + (sa * B4[q].z + vv * K4[q].z); y2 += S[4 * q + 2] * R4[q].z;
        S[4 * q + 3] = S[4 * q + 3] * W4[q].w + (sa * B4[q].w + vv * K4[q].w); y3 += S[4 * q + 3] * R4[q].w;
      }
      float y = quad_sum((y0 + y1) + (y2 + y3));
      if (kq == 0) p.Z[(rowbase + posf(t)) * INW + 768 + dir * 256 + h * 64 + vrow] = f2bf(y);
    }
  };
  ScanRaw A[4], B[4];
  load4(0, A);
  for (int c = 0; c < LT / 4; c += 2) {
    load4(c + 1, B);
    comp4(c, A);
    if (c + 2 < LT / 4) load4(c + 2, A);
    comp4(c + 1, B);
  }
}

DEV void ph_rwkv_post(const P& p, int layer) {
  const int gw = (blockIdx.x * 256 + threadIdx.x) >> 6, nw = gridDim.x * 4, lane = threadIdx.x & 63;
  for (int row = gw; row < NTOK; row += nw) {
    const int ch = 4 * lane;
    const bf16_t* zr = p.Z + (size_t)row * INW + 768 + ch;
    uint2 y0u = *(const uint2*)zr, y1u = *(const uint2*)(zr + 256);
    float y[4] = {bflo(y0u.x) + bflo(y1u.x), bfhi(y0u.x) + bfhi(y1u.x), bflo(y0u.y) + bflo(y1u.y), bfhi(y0u.y) + bfhi(y1u.y)};
    float mu = row16_sum(y[0] + y[1] + y[2] + y[3]) * (1.f / 64.f);
    float vs = 0.f;
#pragma unroll
    for (int i = 0; i < 4; ++i) { y[i] -= mu; vs += y[i] * y[i]; }
    float var = row16_sum(vs) * (1.f / 64.f);
    float rstd = rsqrtf(var + 64e-5f);
    const bf16_t* hr = p.H + (size_t)row * D + ch;
    uint2 ru = *(const uint2*)hr, ku = *(const uint2*)(hr + 256), vu = *(const uint2*)(hr + 512);
    const bf16_t* sr = p.SC + (size_t)row * 1024 + 512 + ch;
    uint2 a0u = *(const uint2*)sr, a1u = *(const uint2*)(sr + 256);
    float r[4] = {bflo(ru.x), bfhi(ru.x), bflo(ru.y), bfhi(ru.y)};
    float k[4] = {bflo(ku.x), bfhi(ku.x), bflo(ku.y), bfhi(ku.y)};
    float v[4] = {bflo(vu.x), bfhi(vu.x), bflo(vu.y), bfhi(vu.y)};
    float a0[4] = {bflo(a0u.x), bfhi(a0u.x), bflo(a0u.y), bfhi(a0u.y)};
    float a1[4] = {bflo(a1u.x), bfhi(a1u.x), bflo(a1u.y), bfhi(a1u.y)};
    float sd = 0.f;
#pragma unroll
    for (int i = 0; i < 4; ++i) {
      float kav = p.rw_k_a[layer * 256 + ch + i], rk = p.rw_r_k[layer * 256 + ch + i];
      float kd0 = k[i] * (1.f + (a0[i] - 1.f) * kav), kd1 = k[i] * (1.f + (a1[i] - 1.f) * kav);
      sd += r[i] * (kd0 + kd1) * rk;
    }
    sd = row16_sum(sd);
    bf16_t* yr = p.Y + (size_t)row * D + 256 + ch;
    uint2 gu = *(const uint2*)yr;
    float g[4] = {bflo(gu.x), bfhi(gu.x), bflo(gu.y), bfhi(gu.y)};
    float o[4];
#pragma unroll
    for (int i = 0; i < 4; ++i) {
      float yn = y[i] * rstd * p.rw_ln_w[layer * 256 + ch + i] + p.rw_ln_b[layer * 256 + ch + i];
      o[i] = (yn + sd * v[i]) * g[i];
#if !EN_RW
      o[i] = 0.f;
#endif
    }
    *(uint2*)yr = make_uint2(pack2(o[0], o[1]), pack2(o[2], o[3]));
  }
}

DEV void hyena_pre_unit(const P& p, int layer, int unit) {
  int kind, b, t0, L;
  if (unit < 1024) { kind = 0; b = unit >> 6; t0 = (unit & 63) * 64; L = T; } else { int u = unit - 1024; kind = 1; b = u >> 2; t0 = (u & 3) * 64; L = LC; }
  const int c = threadIdx.x;
  const size_t row0 = (size_t)b * LT + (kind ? 0 : LC);
  const float* cw = p.conv_w + (size_t)layer * 3 * 1536;
  const float* cb = p.conv_b + (size_t)layer * 1536;
  const float w1a = cw[256 + c], w1b = cw[1536 + 256 + c], w1c = cw[3072 + 256 + c], b1 = cb[256 + c];
  const float w2a = cw[512 + c], w2b = cw[1536 + 512 + c], w2c = cw[3072 + 512 + c], b2 = cb[512 + c];
  auto ld = [&](int t, int col) -> float { return (t >= 0 && t < L) ? bf2f(p.Z[(row0 + t) * INW + col]) : 0.f; };
  float x1m = ld(t0 - 1, 256 + c), x1c = ld(t0, 256 + c), vm = ld(t0 - 1, 512 + c), vc = ld(t0, 512 + c);
  bf16_t* dst = (kind ? p.UTc : p.UTl) + ((size_t)c * 16 + b) * L + t0;
#pragma unroll 1
  for (int i8 = 0; i8 < 8; ++i8) {
    float uo[8];
#pragma unroll
    for (int i = 0; i < 8; ++i) {
      int t = t0 + i8 * 8 + i;
      float x1n = ld(t + 1, 256 + c), vn = ld(t + 1, 512 + c);
      float a = w1a * x1m + w1b * x1c + w1c * x1n + b1;
      float bb = w2a * vm + w2b * vc + w2c * vn + b2;
      uo[i] = a * bb;
      x1m = x1c; x1c = x1n; vm = vc; vc = vn;
    }
    *(uint4*)(dst + 8 * i8) = pack8(uo);
  }
}

DEV void hyena_conv_unit(const P& p, int layer, int unit, char* smem) {
  int kind, c, tb, L;
  if (unit < 4096) { kind = 0; c = unit >> 4; tb = (unit & 15) * 256; L = T; } else { kind = 1; c = unit - 4096; tb = 0; L = LC; }
  const int tid = threadIdx.x, lane = tid & 63, wid = tid >> 6, fr = lane & 15, fq = lane >> 4;
  bf16_t* Cq = (bf16_t*)smem;
  bf16_t* Us = (bf16_t*)(smem + 8320);
  const float* F = (kind ? p.FC : p.FL) + (size_t)c * 2 * L;
  float* red = (float*)(smem + 16512);
  float scale;
  {
    float part = 0.f;
    for (int i = tid; i < 2 * L; i += 256) { float fv = F[i]; part += (i != L) ? fv * fv : 0.f; }
    part = wave_sum(part);
    if (lane == 0) red[wid] = part;
    __syncthreads();
    scale = rsqrtf(((red[0] + red[1]) + (red[2] + red[3])) + 1e-6f);
  }
  const bf16_t* U = (kind ? p.UTc : p.UTl) + (size_t)c * 16 * L;
  f32x4 acc[4];
#pragma unroll
  for (int m = 0; m < 4; ++m) acc[m] = (f32x4){0.f, 0.f, 0.f, 0.f};
  const int nch = L / 256;
  for (int ch = 0; ch < nch; ++ch) {
    const int sc = ch * 256;
    const int D0 = tb + 256 - sc;
    __syncthreads();
    for (int i = tid; i < 4160; i += 256) {
      int rho = i / 520, m = i % 520;
      int n = m - rho;
      int d = D0 - n;
      float v = 0.f;
      if (n >= 0 && d > -L && d < L) v = (d >= 0 ? F[d] : F[L - d]) * scale;
      Cq[((m >> 3) * 8 + rho) * 8 + (m & 7)] = f2bf(v);
    }
    for (int i = tid; i < 512; i += 256) {
      int b = i >> 5, sgm = i & 31;
      *(uint4*)&Us[(sgm * 16 + b) * 8] = *(const uint4*)(U + (size_t)b * L + sc + 8 * sgm);
    }
    __syncthreads();
#pragma unroll
    for (int kk = 0; kk < 8; ++kk) {
      bf16x8 bf = *(const bf16x8*)&Us[((4 * kk + fq) * 16 + fr) * 8];
#pragma unroll
      for (int m = 0; m < 4; ++m) {
        int it = wid * 4 + m;
        int base = 256 - 16 * it + 32 * kk + 8 * fq;
        int m0 = base - 8 * (fr >> 3);
        bf16x8 af = *(const bf16x8*)&Cq[((m0 >> 3) * 8 + (fr & 7)) * 8];
        acc[m] = mfma16(af, bf, acc[m]);
      }
    }
  }
  bf16_t* Yt = (kind ? p.YTc : p.YTl) + ((size_t)c * 16 + fr) * L + tb;
#pragma unroll
  for (int m = 0; m < 4; ++m) {
    int t = (wid * 4 + m) * 16 + fq * 4;
    *(uint2*)(Yt + t) = make_uint2(pack2(acc[m][0], acc[m][1]), pack2(acc[m][2], acc[m][3]));
  }
}

DEV void hyena_post_unit(const P& p, int layer, int unit, char* smem) {
  int kind, b, t0, L;
  if (unit < 1024) { kind = 0; b = unit >> 6; t0 = (unit & 63) * 64; L = T; } else { int u = unit - 1024; kind = 1; b = u >> 2; t0 = (u & 3) * 64; L = LC; }
  const int c = threadIdx.x, lane = c & 63, wid = c >> 6;
  const size_t row0 = (size_t)b * LT + (kind ? 0 : LC);
  bf16_t (*tile)[264] = (bf16_t (*)[264])smem;
  const float* cw = p.conv_w + (size_t)layer * 3 * 1536;
  const float wa = cw[c], wb = cw[1536 + c], wcc = cw[3072 + c], b0 = p.conv_b[layer * 1536 + c];
  const float bias = p.hy_bias[layer * 256 + c];
  const bf16_t* yt = (kind ? p.YTc : p.YTl) + ((size_t)c * 16 + b) * L + t0;
  const bf16_t* ut = (kind ? p.UTc : p.UTl) + ((size_t)c * 16 + b) * L + t0;
  auto ld = [&](int t) -> float { return (t >= 0 && t < L) ? bf2f(p.Z[(row0 + t) * INW + c]) : 0.f; };
  float xm = ld(t0 - 1), xc = ld(t0);
  __syncthreads();
#pragma unroll 1
  for (int i8 = 0; i8 < 8; ++i8) {
    uint4 yu = *(const uint4*)(yt + 8 * i8), uu = *(const uint4*)(ut + 8 * i8);
    float yv[8], uv[8];
    unpack8(yu, yv); unpack8(uu, uv);
#pragma unroll
    for (int i = 0; i < 8; ++i) {
      int t = t0 + i8 * 8 + i;
      float xn = ld(t + 1);
      float x0 = wa * xm + wb * xc + wcc * xn + b0;
      float o = x0 * (yv[i] + uv[i] * bias);
      tile[i8 * 8 + i][c] = f2bf(o);
      xm = xc; xc = xn;
    }
  }
  __syncthreads();
  for (int i = 0; i < 16; ++i) {
    int tl = wid * 16 + i;
    uint2 ou = *(const uint2*)&tile[tl][4 * lane];
    float o[4] = {bflo(ou.x), bfhi(ou.x), bflo(ou.y), bfhi(ou.y)};
    float ss = wave_sum(o[0] * o[0] + o[1] * o[1] + o[2] * o[2] + o[3] * o[3]);
    float rstd = rsqrtf(ss * (1.f / 256.f) + 1e-6f);
#pragma unroll
    for (int q = 0; q < 4; ++q) {
      o[q] = o[q] * rstd * p.hy_out_g[layer * 256 + 4 * lane + q];
#if !EN_HY
      o[q] = 0.f;
#endif
    }
    *(uint2*)(p.Y + (row0 + t0 + tl) * D + 4 * lane) = make_uint2(pack2(o[0], o[1]), pack2(o[2], o[3]));
  }
}

DEV void attn_unit(const P& p, int layer, int unit, char* smem) {
  const bool isctx = unit >= 4096;
  int b, qb, hq;
  if (!isctx) { b = unit >> 8; qb = (unit >> 3) & 31; hq = unit & 7; } else { int u = unit - 4096; b = u >> 4; qb = (u >> 3) & 1; hq = u & 7; }
  const int g = hq >> 2;
  const int tid = threadIdx.x, lane = tid & 63, wid = tid >> 6, qn = lane & 31, hh = lane >> 5;
  const int qpos = qb * 128 + wid * 32 + qn;
  const size_t qrow = (size_t)b * LT + (isctx ? qpos : LC + qpos);
  const bf16_t* qptr = p.Z + qrow * INW + 1920 + hq * 64;
  bf16x8 qf[4];
#pragma unroll
  for (int s = 0; s < 4; ++s) qf[s] = *(const bf16x8*)(qptr + 16 * s + 8 * hh);
  const float sink = p.attn_sink[layer * 8 + hq];
  float m_run = sink, l_run = 1.f;
  f32x16 o0, o1;
#pragma unroll
  for (int i = 0; i < 16; ++i) { o0[i] = 0.f; o1[i] = 0.f; }
  bf16_t (*Ks)[72] = (bf16_t (*)[72])smem;
  bf16_t (*Vt)[40] = (bf16_t (*)[40])(smem + 4608);
  const int ntl = isctx ? 0 : 12;
  const int ntiles = ntl + 8;
  for (int kt = 0; kt < ntiles; ++kt) {
    const bool ctxk = kt >= ntl;
    const int kbase = ctxk ? (kt - ntl) * 32 : qb * 128 - 128 + kt * 32;
    __syncthreads();
    {
      int key = tid >> 3, seg = tid & 7;
      int kp = kbase + key;
      uint4 kv = make_uint4(0, 0, 0, 0), vv = make_uint4(0, 0, 0, 0);
      if (ctxk || (kp >= 0 && kp < T)) {
        size_t krow = (size_t)b * LT + (ctxk ? kp : LC + kp);
        const bf16_t* src = p.Z + krow * INW + 1920 + 512 + g * 64 + seg * 8;
        kv = *(const uint4*)src; vv = *(const uint4*)(src + 128);
      }
      *(uint4*)&Ks[key][seg * 8] = kv;
      Vt[seg * 8 + 0][key] = (bf16_t)(vv.x & 0xFFFF); Vt[seg * 8 + 1][key] = (bf16_t)(vv.x >> 16);
      Vt[seg * 8 + 2][key] = (bf16_t)(vv.y & 0xFFFF); Vt[seg * 8 + 3][key] = (bf16_t)(vv.y >> 16);
      Vt[seg * 8 + 4][key] = (bf16_t)(vv.z & 0xFFFF); Vt[seg * 8 + 5][key] = (bf16_t)(vv.z >> 16);
      Vt[seg * 8 + 6][key] = (bf16_t)(vv.w & 0xFFFF); Vt[seg * 8 + 7][key] = (bf16_t)(vv.w >> 16);
    }
    __syncthreads();
    bool need = true;
    if (!ctxk) {
      int q0 = qb * 128 + wid * 32;
      if (kbase + 31 < q0 - 128 || kbase > q0 + 31 + 128 || kbase + 31 < 0 || kbase >= T) need = false;
    }
    if (need) {
      f32x16 s;
#pragma unroll
      for (int i = 0; i < 16; ++i) s[i] = 0.f;
#pragma unroll
      for (int ks = 0; ks < 4; ++ks) {
        bf16x8 kf = *(const bf16x8*)&Ks[qn][16 * ks + 8 * hh];
        s = mfma32(kf, qf[ks], s);
      }
      float mt = -3e38f;
#pragma unroll
      for (int rg = 0; rg < 16; ++rg) {
        float v = s[rg] * 0.125f;
        if (!ctxk) {
          int kp = kbase + (rg & 3) + 8 * (rg >> 2) + 4 * hh;
          int dl = qpos - kp;
          bool ok = (dl <= 128) && (dl >= -128) && (kp >= 0) && (kp < T);
          v = ok ? v : -1e30f;
        }
        s[rg] = v;
        mt = fmaxf(mt, v);
      }
      mt = fmaxf(mt, __shfl_xor(mt, 32));
      float m_new = fmaxf(m_run, mt);
      float corr = __expf(m_run - m_new);
      float ps = 0.f;
#pragma unroll
      for (int rg = 0; rg < 16; ++rg) { float pv = __expf(s[rg] - m_new); s[rg] = pv; ps += pv; }
      ps += __shfl_xor(ps, 32);
      l_run = l_run * corr + ps;
      m_run = m_new;
#pragma unroll
      for (int i = 0; i < 16; ++i) { o0[i] *= corr; o1[i] *= corr; }
#pragma unroll
      for (int sp = 0; sp < 2; ++sp) {
        bf16x8 pf;
#pragma unroll
        for (int j = 0; j < 8; ++j) pf[j] = (short)f2bf(s[8 * sp + j]);
        uint2 va = *(const uint2*)&Vt[qn][16 * sp + 4 * hh], vb = *(const uint2*)&Vt[qn][16 * sp + 8 + 4 * hh];
        uint2 vc = *(const uint2*)&Vt[32 + qn][16 * sp + 4 * hh], vd = *(const uint2*)&Vt[32 + qn][16 * sp + 8 + 4 * hh];
        uint4 w0 = make_uint4(va.x, va.y, vb.x, vb.y), w1 = make_uint4(vc.x, vc.y, vd.x, vd.y);
        bf16x8 v0 = __builtin_bit_cast(bf16x8, w0), v1 = __builtin_bit_cast(bf16x8, w1);
        o0 = mfma32(v0, pf, o0);
        o1 = mfma32(v1, pf, o1);
      }
    }
  }
  const float inv = 1.f / l_run;
  bf16_t* optr = p.Y + qrow * D + 512 + hq * 64;
#pragma unroll
  for (int rg = 0; rg < 4; ++rg) {
    int d0 = 8 * rg + 4 * hh;
    *(uint2*)(optr + d0) = make_uint2(pack2(o0[4 * rg] * inv, o0[4 * rg + 1] * inv), pack2(o0[4 * rg + 2] * inv, o0[4 * rg + 3] * inv));
    *(uint2*)(optr + 32 + d0) = make_uint2(pack2(o1[4 * rg] * inv, o1[4 * rg + 1] * inv), pack2(o1[4 * rg + 2] * inv, o1[4 * rg + 3] * inv));
  }
}

DEV void ph_attn_post(const P& p, int layer) {
  const int gw = (blockIdx.x * 256 + threadIdx.x) >> 6, nw = gridDim.x * 4, lane = threadIdx.x & 63;
  for (int row = gw; row < NTOK; row += nw) {
    bf16_t* yr = p.Y + (size_t)row * D + 512 + 8 * lane;
    uint4 u = *(const uint4*)yr;
    float v[8];
    unpack8(u, v);
    float ss = 0.f;
#pragma unroll
    for (int i = 0; i < 8; ++i) ss += v[i] * v[i];
    ss = wave_sum(ss);
    float rstd = rsqrtf(ss * (1.f / 512.f) + 1e-6f);
#pragma unroll
    for (int i = 0; i < 8; ++i) {
      v[i] = v[i] * rstd * p.at_out_g[layer * 512 + 8 * lane + i];
#if !EN_AT
      v[i] = 0.f;
#endif
    }
    *(uint4*)yr = pack8(v);
  }
}

struct Epi2 {
  const P& p; int layer, row0, col0;
  DEV void operator()(f32x4 (&acc)[4][4], int wr, int wc, int fr, int fq, char*) const {
    const int b = row0 / LT, pp = row0 % LT;
    const int mr = pp < LC ? 16 : b;
    const float* g1 = p.modv + ((size_t)layer * 17 + mr) * 6144 + 2048;
#pragma unroll
    for (int m = 0; m < 4; ++m)
#pragma unroll
      for (int j = 0; j < 4; ++j) {
        int row = row0 + wr * 64 + m * 16 + fq * 4 + j;
#pragma unroll
        for (int n = 0; n < 4; ++n) {
          int col = col0 + wc * 64 + n * 16 + fr;
          bf16_t* xp = p.X + (size_t)row * D + col;
          float v = bf2f(*xp) + g1[col] * acc[m][n][j];
#if EN_MIX
          *xp = f2bf(v);
#endif
        }
      }
  }
};
DEV void ph_gemm2(const P& p, int layer, char* smem) {
  for (int u = blockIdx.x; u < (NTOK / 128) * 8; u += gridDim.x) {
    int rt = u >> 3, ct = u & 7;
    Epi2 epi{p, layer, rt * 128, ct * 128};
    gemm_tile(p.Y + (size_t)rt * 128 * D, D, p.W2t + (size_t)ct * 128 * D, D, D, smem, epi);
  }
}

DEV void ph_peerconv(const P& p, int layer) {
  const size_t n8 = (size_t)16384 * 1024 / 8;
  const float* su = p.peer_u + (size_t)layer * 16384 * 1024;
  const float* sv = p.peer_v + (size_t)layer * 16384 * 1024;
  for (size_t i = (size_t)blockIdx.x * 256 + threadIdx.x; i < 2 * n8; i += (size_t)gridDim.x * 256) {
    const float* s = i < n8 ? su + i * 8 : sv + (i - n8) * 8;
    bf16_t* d = i < n8 ? p.PU + i * 8 : p.PV + (i - n8) * 8;
    float4 v0 = *(const float4*)s, v1 = *(const float4*)(s + 4);
    *(uint4*)d = make_uint4(pack2(v0.x, v0.y), pack2(v0.z, v0.w), pack2(v1.x, v1.y), pack2(v1.z, v1.w));
  }
}

struct Epi3 {
  const P& p; int row0, grp;
  DEV void operator()(f32x4 (&acc)[4][4], int wr, int wc, int fr, int fq, char* smem) const {
    float* sc = (float*)smem;
    const int tid = threadIdx.x;
    for (int pass = 0; pass < 2; ++pass) {
      __syncthreads();
      if (wr == pass) {
#pragma unroll
        for (int m = 0; m < 4; ++m)
#pragma unroll
          for (int n = 0; n < 4; ++n)
#pragma unroll
            for (int j = 0; j < 4; ++j) {
              int rl = m * 16 + fq * 4 + j, col = wc * 64 + n * 16 + fr;
              unsigned bits = (__float_as_uint(acc[m][n][j]) & ~127u) | (unsigned)col;
              sc[rl * 133 + (col >> 5) * 33 + (col & 31)] = __uint_as_float(bits);
            }
      }
      __syncthreads();
      const int rl = tid >> 2, q = tid & 3;
      float Ls[16];
#pragma unroll
      for (int i = 0; i < 16; ++i) Ls[i] = -3e38f;
      const float* src = sc + rl * 133 + q * 33;
      for (int i = 0; i < 32; ++i) {
        float x = src[i];
        if (x > Ls[15]) {
#pragma unroll
          for (int k = 0; k < 16; ++k) { float hi = fmaxf(Ls[k], x); x = fminf(Ls[k], x); Ls[k] = hi; }
        }
      }
      float Cs[16];
#pragma unroll
      for (int i = 0; i < 16; ++i) Cs[i] = fmaxf(Ls[i], dppself<0xB1, 0xF>(Ls[15 - i]));
#pragma unroll
      for (int d = 8; d >= 1; d >>= 1)
#pragma unroll
        for (int i = 0; i < 16; ++i)
          if ((i & d) == 0) { float hi = fmaxf(Cs[i], Cs[i + d]), lo = fminf(Cs[i], Cs[i + d]); Cs[i] = hi; Cs[i + d] = lo; }
      float Ds[16];
#pragma unroll
      for (int i = 0; i < 16; ++i) Ds[i] = fmaxf(Cs[i], dppself<0x4E, 0xF>(Cs[15 - i]));
      if (q == 0) {
        float* dst = p.TK + ((size_t)(row0 + pass * 64 + rl) * 16 + grp) * 16;
#pragma unroll
        for (int i = 0; i < 4; ++i) *(float4*)(dst + 4 * i) = make_float4(Ds[4 * i], Ds[4 * i + 1], Ds[4 * i + 2], Ds[4 * i + 3]);
      }
    }
  }
};
DEV void ph_gemm3(const P& p, char* smem) {
  for (int u = blockIdx.x; u < (NTOK / 128) * 16; u += gridDim.x) {
    int rt = u >> 4, ct = u & 15;
    Epi3 epi{p, rt * 128, ct};
    gemm_tile(p.H + (size_t)rt * 128 * D, D, p.Wft + (size_t)ct * 128 * D, D, D, smem, epi);
  }
}

DEV void ph_peer(const P& p, int layer) {
  const int gw = (blockIdx.x * 256 + threadIdx.x) >> 6, nw = gridDim.x * 4, lane = threadIdx.x & 63;
  for (int row = gw; row < NTOK; row += nw) {
    const float* tk = p.TK + (size_t)row * 256;
    float v1s[8]; float4 v2s[8];
#pragma unroll
    for (int h = 0; h < 8; ++h) { v1s[h] = tk[(2 * h) * 16 + (lane >> 2)]; v2s[h] = *(const float4*)(tk + (2 * h + 1) * 16 + 4 * (lane & 3)); }
    float scr[2] = {0.f, 0.f};
    int er[2] = {0, 0};
#pragma unroll
    for (int h = 0; h < 8; ++h) {
      float c0 = v1s[h] + v2s[h].x, c1 = v1s[h] + v2s[h].y, c2 = v1s[h] + v2s[h].z, c3 = v1s[h] + v2s[h].w;
      const int i1 = (int)(__float_as_uint(v1s[h]) & 127u);
      for (int r = 0; r < 16; ++r) {
        float m = fmaxf(fmaxf(c0, c1), fmaxf(c2, c3));
        float wm = wave_max(m);
        unsigned long long bal = __ballot(m == wm);
        int wl = __ffsll((long long)bal) - 1;
        int jsel = (c0 == wm) ? 0 : (c1 == wm) ? 1 : (c2 == wm) ? 2 : 3;
        float v2sel = jsel == 0 ? v2s[h].x : jsel == 1 ? v2s[h].y : jsel == 2 ? v2s[h].z : v2s[h].w;
        int el = i1 * 128 + (int)(__float_as_uint(v2sel) & 127u);
        int ew = __builtin_amdgcn_readlane(el, wl);
        if (lane == wl) {
          if (jsel == 0) c0 = -3e38f; else if (jsel == 1) c1 = -3e38f; else if (jsel == 2) c2 = -3e38f; else c3 = -3e38f;
        }
        const int sl = (h & 3) * 16 + r;
        scr[h >> 2] = writelane_f(wm, sl, scr[h >> 2]);
        er[h >> 2] = writelane_i(ew, sl, er[h >> 2]);
      }
    }
    float gate[2];
#pragma unroll
    for (int q = 0; q < 2; ++q) {
      float mx = row16_max(scr[q]);
      float ex = __expf(scr[q] - mx);
      float sm = row16_sum(ex);
      gate[q] = ex / sm;
    }
    const bf16_t* hr = p.H + (size_t)row * D;
    float hv[16];
    { uint4 u0 = *(const uint4*)(hr + 8 * lane), u1 = *(const uint4*)(hr + 512 + 8 * lane); unpack8(u0, hv); unpack8(u1, hv + 8); }
    float dots[2] = {0.f, 0.f};
#pragma unroll
    for (int q = 0; q < 2; ++q) {
      for (int k8 = 0; k8 < 8; ++k8) {
        uint4 ua[8], ub[8];
#pragma unroll
        for (int j = 0; j < 8; ++j) {
          int e = __builtin_amdgcn_readlane(er[q], k8 * 8 + j);
          const bf16_t* ur = p.PU + (size_t)e * 1024;
          ua[j] = *(const uint4*)(ur + 8 * lane); ub[j] = *(const uint4*)(ur + 512 + 8 * lane);
        }
#pragma unroll
        for (int j = 0; j < 8; ++j) {
          float f[16];
          unpack8(ua[j], f); unpack8(ub[j], f + 8);
          float d = 0.f;
#pragma unroll
          for (int i = 0; i < 16; ++i) d += f[i] * hv[i];
          d = wave_sum(d);
          dots[q] = writelane_f(d, k8 * 8 + j, dots[q]);
        }
      }
    }
    float wk[2];
#pragma unroll
    for (int q = 0; q < 2; ++q) {
      float x = dots[q];
      float act = 0.5f * x * (1.f + erff(x * 0.7071067811865476f));
      wk[q] = gate[q] * act;
    }
    float outv[16];
#pragma unroll
    for (int i = 0; i < 16; ++i) outv[i] = 0.f;
#pragma unroll
    for (int q = 0; q < 2; ++q) {
      for (int k8 = 0; k8 < 8; ++k8) {
        uint4 ua[8], ub[8];
        float ws[8];
#pragma unroll
        for (int j = 0; j < 8; ++j) {
          int e = __builtin_amdgcn_readlane(er[q], k8 * 8 + j);
          ws[j] = readlane_f(wk[q], k8 * 8 + j);
          const bf16_t* vr = p.PV + (size_t)e * 1024;
          ua[j] = *(const uint4*)(vr + 8 * lane); ub[j] = *(const uint4*)(vr + 512 + 8 * lane);
        }
#pragma unroll
        for (int j = 0; j < 8; ++j) {
          float f[16];
          unpack8(ua[j], f); unpack8(ub[j], f + 8);
#pragma unroll
          for (int i = 0; i < 16; ++i) outv[i] += ws[j] * f[i];
        }
      }
    }
    int b = row / LT, pp = row % LT;
    int mr = pp < LC ? 16 : b;
    const float* g2 = p.modv + ((size_t)layer * 17 + mr) * 6144 + 5120;
    bf16_t* xr = p.X + (size_t)row * D;
    float xv[16];
    { uint4 u0 = *(const uint4*)(xr + 8 * lane), u1 = *(const uint4*)(xr + 512 + 8 * lane); unpack8(u0, xv); unpack8(u1, xv + 8); }
#pragma unroll
    for (int hh = 0; hh < 2; ++hh)
#pragma unroll
      for (int i = 0; i < 8; ++i) xv[hh * 8 + i] += g2[hh * 512 + 8 * lane + i] * outv[hh * 8 + i];
#if EN_PEER
    *(uint4*)(xr + 8 * lane) = pack8(xv);
    *(uint4*)(xr + 512 + 8 * lane) = pack8(xv + 8);
#endif
  }
}

DEV void ph_final(const P& p) {
  const int gw = (blockIdx.x * 256 + threadIdx.x) >> 6, nw = gridDim.x * 4, lane = threadIdx.x & 63;
  for (int r = gw; r < NB * T; r += nw) {
    int b = r / T, t = r % T;
    const bf16_t* xr = p.X + ((size_t)b * LT + LC + t) * D;
    uint4 u0 = *(const uint4*)(xr + 8 * lane), u1 = *(const uint4*)(xr + 512 + 8 * lane);
    float v[16];
    unpack8(u0, v); unpack8(u1, v + 8);
    float ss = 0.f;
#pragma unroll
    for (int i = 0; i < 16; ++i) ss += v[i] * v[i];
    ss = wave_sum(ss);
    float rstd = rsqrtf(ss * (1.f / 1024.f) + 1e-6f);
    float* o = p.out + (size_t)r * D;
#pragma unroll
    for (int hh = 0; hh < 2; ++hh) {
      int col = hh * 512 + 8 * lane;
      float4 a = make_float4(v[hh * 8 + 0] * rstd * p.final_g[col + 0], v[hh * 8 + 1] * rstd * p.final_g[col + 1], v[hh * 8 + 2] * rstd * p.final_g[col + 2], v[hh * 8 + 3] * rstd * p.final_g[col + 3]);
      float4 c = make_float4(v[hh * 8 + 4] * rstd * p.final_g[col + 4], v[hh * 8 + 5] * rstd * p.final_g[col + 5], v[hh * 8 + 6] * rstd * p.final_g[col + 6], v[hh * 8 + 7] * rstd * p.final_g[col + 7]);
      *(float4*)(o + col) = a; *(float4*)(o + col + 4) = c;
    }
  }
}

enum { K_PRO = 0, K_PREP, K_NORM1, K_GEMM1, K_MIX_A, K_MIX_B, K_MIX_C, K_GEMM2, K_NORM2, K_GEMM3, K_PEER, K_FINAL };

template <int PH>
__global__ void __launch_bounds__(256, 2) k_phase(P p, int layer) {
  __shared__ __attribute__((aligned(16))) char smem[SMEM_BYTES];
  if constexpr (PH == K_PRO) {
    ph_copy(p);
    ph_rope(p);
    for (int u = blockIdx.x; u < 96; u += gridDim.x) modv_unit(p, u, smem);
  } else if constexpr (PH == K_PREP) {
    ph_prep(p, layer, smem);
  } else if constexpr (PH == K_NORM1) {
    ph_norm(p, layer, 0);
  } else if constexpr (PH == K_GEMM1) {
    ph_gemm1(p, smem);
  } else if constexpr (PH == K_MIX_A) {
    const int N = 1088 + 5440 + 4352;
    for (int u = blockIdx.x; u < N; u += gridDim.x) {
      if (u < 1088) hyena_pre_unit(p, layer, u);
      else if (u < 1088 + 5440) lora_unit(p, layer, u - 1088, smem);
      else attn_unit(p, layer, u - 1088 - 5440, smem);
    }
    ph_rwkv_prep(p, layer);
  } else if constexpr (PH == K_MIX_B) {
    const int N = 128 + 4352;
    for (int u = blockIdx.x; u < N; u += gridDim.x) {
      if (u < 128) scan_unit(p, layer, u, smem);
      else hyena_conv_unit(p, layer, u - 128, smem);
    }
  } else if constexpr (PH == K_MIX_C) {
    for (int u = blockIdx.x; u < 1088; u += gridDim.x) hyena_post_unit(p, layer, u, smem);
    ph_rwkv_post(p, layer);
    ph_attn_post(p, layer);
  } else if constexpr (PH == K_GEMM2) {
    ph_gemm2(p, layer, smem);
    ph_peerconv(p, layer);
  } else if constexpr (PH == K_NORM2) {
    ph_norm(p, layer, 1);
  } else if constexpr (PH == K_GEMM3) {
    ph_gemm3(p, smem);
  } else if constexpr (PH == K_PEER) {
    ph_peer(p, layer);
  } else if constexpr (PH == K_FINAL) {
    ph_final(p);
  }
}

static inline size_t al256(size_t x) { return (x + 255) & ~(size_t)255; }

extern "C" void kernel_launch(void* const* d_in, const int* in_sizes, int n_in, void* d_out, int out_size, void* d_ws, size_t ws_size,
                              hipStream_t stream) {
  (void)in_sizes; (void)n_in; (void)out_size; (void)ws_size;
  P p{};
  const float** f = (const float**)&p;
  for (int i = 0; i < 39; ++i) f[i] = (const float*)d_in[i];
  p.out = (float*)d_out;
  char* w = (char*)d_ws;
  size_t off = 0;
  auto take = [&](size_t bytes) { char* r = w + off; off += al256(bytes); return r; };
  p.bar = (unsigned*)take(16384);
  p.modv = (float*)take((size_t)DEPTH * 17 * 6144 * 4);
  p.SSQ = (float*)take((size_t)DEPTH * 2 * 256 * 4);
  const size_t zero_bytes = off;
  p.rope = (float*)take(64 * 16 * 2 * 4);
  p.X = (bf16_t*)take((size_t)NTOK * D * 2);
  p.H = (bf16_t*)take((size_t)NTOK * D * 2);
  p.Y = (bf16_t*)take((size_t)NTOK * D * 2);
  p.SC = (bf16_t*)take((size_t)NTOK * 1024 * 2);
  p.Z = (bf16_t*)take((size_t)NTOK * INW * 2);
  p.UTl = (bf16_t*)take((size_t)256 * 16 * T * 2);
  p.UTc = (bf16_t*)take((size_t)256 * 16 * LC * 2);
  p.YTl = (bf16_t*)take((size_t)256 * 16 * T * 2);
  p.YTc = (bf16_t*)take((size_t)256 * 16 * LC * 2);
  p.FL = (float*)take((size_t)256 * 2 * T * 4);
  p.FC = (float*)take((size_t)256 * 2 * LC * 4);
  p.W1t = (bf16_t*)take((size_t)INW * D * 2);
  p.W2t = (bf16_t*)take((size_t)D * D * 2);
  p.Wft = (bf16_t*)take((size_t)2048 * D * 2);
  p.Wwt = (bf16_t*)take((size_t)2 * 256 * 64 * 2);
  p.Wat = (bf16_t*)take((size_t)2 * 256 * 64 * 2);
  p.Wgt = (bf16_t*)take((size_t)256 * 128 * 2);
  p.TK = (float*)p.Z;
  p.PU = (bf16_t*)((char*)p.Z + al256((size_t)NTOK * 256 * 4));
  p.PV = p.PU + (size_t)16384 * 1024;

  (void)hipMemsetAsync(d_ws, 0, zero_bytes, stream);
  const int G = 1024;
  k_phase<K_PRO><<<G, 256, 0, stream>>>(p, 0);
  for (int l = 0; l < NLAYERS; ++l) {
    k_phase<K_PREP><<<G, 256, 0, stream>>>(p, l);
    k_phase<K_NORM1><<<G, 256, 0, stream>>>(p, l);
    k_phase<K_GEMM1><<<G, 256, 0, stream>>>(p, l);
    k_phase<K_MIX_A><<<G, 256, 0, stream>>>(p, l);
    k_phase<K_MIX_B><<<G, 256, 0, stream>>>(p, l);
    k_phase<K_MIX_C><<<G, 256, 0, stream>>>(p, l);
    k_phase<K_GEMM2><<<G, 256, 0, stream>>>(p, l);
    k_phase<K_NORM2><<<G, 256, 0, stream>>>(p, l);
    k_phase<K_GEMM3><<<G, 256, 0, stream>>>(p, l);
    k_phase<K_PEER><<<G, 256, 0, stream>>>(p, l);
  }
  k_phase<K_FINAL><<<G, 256, 0, stream>>>(p, 0);
}
```

```cpp
#include <hip/hip_runtime.h>
#include <stdint.h>

#define DEV __device__ __forceinline__
typedef unsigned short bf16_t;
typedef short bf16x8 __attribute__((ext_vector_type(8)));
typedef float f32x4 __attribute__((ext_vector_type(4)));
typedef float f32x16 __attribute__((ext_vector_type(16)));

#ifndef NLAYERS
#define NLAYERS 4
#endif
#ifndef EN_HY
#define EN_HY 1
#endif
#ifndef EN_RW
#define EN_RW 1
#endif
#ifndef EN_AT
#define EN_AT 1
#endif
#ifndef EN_MIX
#define EN_MIX 1
#endif
#ifndef EN_PEER
#define EN_PEER 1
#endif

constexpr int NB = 16, T = 4096, LC = 256, LT = 4352, D = 1024, NTOK = NB * LT, INW = 2688, DEPTH = 4;
constexpr int SMEM_BYTES = 49152;

struct P {
  const float *x, *c, *ctx, *c_ctx, *mod_w, *mod_b, *norm1_g, *norm2_g, *w_in, *conv_w, *conv_b;
  const float *hy_w1, *hy_b1, *hy_w2, *hy_b2, *hy_w3, *hy_b3, *hy_freq, *hy_bias;
  const float *rw_w0, *rw_w_up, *rw_a0, *rw_a_up, *rw_g_up, *rw_k_k, *rw_k_a, *rw_r_k, *rw_ln_w, *rw_ln_b;
  const float *attn_sink, *hy_out_g, *at_out_g, *w_out, *peer_wq, *peer_k1, *peer_k2, *peer_u, *peer_v, *final_g;
  float* out;
  unsigned* bar;
  float *modv, *SSQ, *rope, *FL, *FC, *TK;
  bf16_t *X, *H, *Y, *SC, *Z, *UTl, *UTc, *YTl, *YTc;
  bf16_t *W1t, *W2t, *Wft, *Wwt, *Wat, *Wgt, *PU, *PV;
};

DEV bf16_t f2bf(float f) { unsigned u = __float_as_uint(f); u += 0x7FFFu + ((u >> 16) & 1u); return (bf16_t)(u >> 16); }
DEV float bf2f(bf16_t h) { return __uint_as_float(((unsigned)h) << 16); }
DEV unsigned pack2(float a, float b) { return (unsigned)f2bf(a) | ((unsigned)f2bf(b) << 16); }
DEV float bflo(unsigned u) { return __uint_as_float(u << 16); }
DEV float bfhi(unsigned u) { return __uint_as_float(u & 0xFFFF0000u); }
DEV void unpack8(const uint4& u, float* v) {
  v[0] = bflo(u.x); v[1] = bfhi(u.x); v[2] = bflo(u.y); v[3] = bfhi(u.y);
  v[4] = bflo(u.z); v[5] = bfhi(u.z); v[6] = bflo(u.w); v[7] = bfhi(u.w);
}
DEV uint4 pack8(const float* v) { return make_uint4(pack2(v[0], v[1]), pack2(v[2], v[3]), pack2(v[4], v[5]), pack2(v[6], v[7])); }
DEV float sigmoidf_(float x) { return 1.f / (1.f + __expf(-x)); }

template <int CTRL, int ROWMASK>
DEV float dpp0(float x) {
  return __builtin_bit_cast(float, __builtin_amdgcn_update_dpp(0, __builtin_bit_cast(int, x), CTRL, ROWMASK, 0xF, false));
}
template <int CTRL, int ROWMASK>
DEV float dppself(float x) {
  int xi = __builtin_bit_cast(int, x);
  return __builtin_bit_cast(float, __builtin_amdgcn_update_dpp(xi, xi, CTRL, ROWMASK, 0xF, false));
}
DEV float readlane_f(float x, int l) { return __builtin_bit_cast(float, __builtin_amdgcn_readlane(__builtin_bit_cast(int, x), l)); }
DEV int lane_id() { return (int)__builtin_amdgcn_mbcnt_hi(~0u, __builtin_amdgcn_mbcnt_lo(~0u, 0u)); }
DEV float writelane_f(float val, int l, float old) { return lane_id() == l ? val : old; }
DEV int writelane_i(int val, int l, int old) { return lane_id() == l ? val : old; }
DEV float wave_sum(float x) {
  x += dpp0<0x111, 0xF>(x); x += dpp0<0x112, 0xF>(x); x += dpp0<0x114, 0xF>(x); x += dpp0<0x118, 0xF>(x);
  x += dpp0<0x142, 0xA>(x); x += dpp0<0x143, 0xC>(x);
  return readlane_f(x, 63);
}
DEV float wave_max(float x) {
  x = fmaxf(x, dppself<0x111, 0xF>(x)); x = fmaxf(x, dppself<0x112, 0xF>(x)); x = fmaxf(x, dppself<0x114, 0xF>(x));
  x = fmaxf(x, dppself<0x118, 0xF>(x)); x = fmaxf(x, dppself<0x142, 0xA>(x)); x = fmaxf(x, dppself<0x143, 0xC>(x));
  return readlane_f(x, 63);
}
DEV float row16_sum(float x) {
  x += dpp0<0xB1, 0xF>(x); x += dpp0<0x4E, 0xF>(x); x += dpp0<0x141, 0xF>(x); x += dpp0<0x140, 0xF>(x);
  return x;
}
DEV float row16_max(float x) {
  x = fmaxf(x, dppself<0xB1, 0xF>(x)); x = fmaxf(x, dppself<0x4E, 0xF>(x)); x = fmaxf(x, dppself<0x141, 0xF>(x));
  x = fmaxf(x, dppself<0x140, 0xF>(x));
  return x;
}
DEV float quad_sum(float x) { x += dpp0<0xB1, 0xF>(x); x += dpp0<0x4E, 0xF>(x); return x; }

DEV f32x4 mfma16(bf16x8 a, bf16x8 b, f32x4 c) { return __builtin_amdgcn_mfma_f32_16x16x32_bf16(a, b, c, 0, 0, 0); }
DEV f32x16 mfma32(bf16x8 a, bf16x8 b, f32x16 c) { return __builtin_amdgcn_mfma_f32_32x32x16_bf16(a, b, c, 0, 0, 0); }


#define XB_TMO      128
#define XB_XCNT(j)  (256  + 64 * (j))
#define XB_XSUB(j)  (1280 + 64 * (j))
#define XB_XGEN(j)  (2304 + 64 * (j))
#define XB_TOP      3328
#define XB_TOPGEN   3392
#define XCD_BAR_WORDS 3456
#define XB_SPIN_CAP (1u << 23)
#define LAS __attribute__((address_space(3)))

__device__ __forceinline__ unsigned xb_ld(unsigned* p)              { return __hip_atomic_load(p, __ATOMIC_RELAXED, __HIP_MEMORY_SCOPE_AGENT); }
__device__ __forceinline__ unsigned xb_add(unsigned* p, unsigned v) { return __hip_atomic_fetch_add(p, v, __ATOMIC_RELAXED, __HIP_MEMORY_SCOPE_AGENT); }
__device__ __forceinline__ unsigned xb_xcc_id() { return (unsigned)__builtin_amdgcn_s_getreg((3 << 11) | 20) & 0xFu; }
#define XB_SPIN(cond, bar) do { unsigned _sp = 0; while (cond) { __builtin_amdgcn_s_sleep(1); \
    if ((++_sp & 255u) == 0u) { if (xb_ld(&(bar)[XB_TMO])) break; if (_sp > XB_SPIN_CAP) { atomicAdd(&(bar)[XB_TMO], 1u); break; } } } } while (0)

struct XcdBarrier {
    unsigned* bar; unsigned x;
    volatile LAS unsigned* st;
};
__device__ __forceinline__ XcdBarrier xcd_barrier_post(unsigned* bar, volatile LAS unsigned* st) {
    XcdBarrier b; b.bar = bar; b.x = xb_xcc_id(); b.st = st;
    if (threadIdx.x == 0) (void)xb_add(&bar[XB_XCNT(b.x)], 1u);
    return b;
}
__device__ __forceinline__ void xcd_barrier_complete(unsigned* bar, unsigned x, unsigned& nloc, unsigned& nx) {
    const unsigned G = gridDim.x * gridDim.y * gridDim.z;
    unsigned sum, cnt, mine, sp = 0u;
    for (;;) {
        sum = 0u; cnt = 0u; mine = 0u;
#pragma unroll
        for (unsigned j = 0; j < 16; ++j) { const unsigned c = xb_ld(&bar[XB_XCNT(j)]); sum += c; cnt += (c > 0u) ? 1u : 0u; mine = (j == x) ? c : mine; }
        if (sum == G) break;
        __builtin_amdgcn_s_sleep(1);
        if ((++sp & 255u) == 0u) { if (xb_ld(&bar[XB_TMO])) break; if (sp > XB_SPIN_CAP) { atomicAdd(&bar[XB_TMO], 1u); break; } }
    }
    nloc = mine > 0u ? mine : 1u; nx = cnt > 0u ? cnt : 1u;
}
__device__ __forceinline__ void xcd_barrier(const XcdBarrier& b) {
    asm volatile("s_waitcnt vmcnt(0)" ::: "memory");
    __syncthreads();
    if (threadIdx.x == 0) {
        unsigned* bar = b.bar;
        __builtin_amdgcn_s_waitcnt(0);
        unsigned nloc = b.st[0], nx = b.st[1];
        if (nloc == 0u) { xcd_barrier_complete(bar, b.x, nloc, nx); b.st[0] = nloc; b.st[1] = nx; }
        const unsigned old = xb_add(&bar[XB_XSUB(b.x)], 1u);
        const unsigned gen = old / nloc;
        if (old + 1u == (gen + 1u) * nloc) {
            __builtin_amdgcn_fence(__ATOMIC_RELEASE, "agent");
            asm volatile("s_waitcnt vmcnt(0)" ::: "memory");
            const unsigned og = xb_add(&bar[XB_TOP], 1u);
            const unsigned tg = og / nx;
            if (og + 1u == (tg + 1u) * nx) xb_add(&bar[XB_TOPGEN], 1u);
            else XB_SPIN(xb_ld(&bar[XB_TOPGEN]) == tg, bar);
            __builtin_amdgcn_fence(__ATOMIC_ACQUIRE, "agent");
            xb_add(&bar[XB_XGEN(b.x)], 1u);
            asm volatile("s_waitcnt vmcnt(0)" ::: "memory");
        } else {
            XB_SPIN(xb_ld(&bar[XB_XGEN(b.x)]) == gen, bar);
            __builtin_amdgcn_fence(__ATOMIC_ACQUIRE, "agent");
            asm volatile("s_waitcnt vmcnt(0)" ::: "memory");
        }
    }
    __syncthreads();
}

template <class Tp> DEV Tp* opq(Tp* q) { asm volatile("" : "+s"(q)); return q; }
DEV int tid_() { int t = threadIdx.x; asm volatile("" : "+v"(t)); return t; }
DEV int bid_() { int b = blockIdx.x; asm volatile("" : "+s"(b)); return b; }

template <class Epi>
DEV void gemm_tile(const bf16_t* __restrict__ A, int lda, const bf16_t* __restrict__ Bt, int ldb, int K, char* smem, Epi& epi) {
  typedef bf16_t Tile[128][40];
  Tile* As = (Tile*)smem;
  Tile* Bs = (Tile*)(smem + 20480);
  const int tid = tid_(), lane = tid & 63, wid = tid >> 6, wr = wid >> 1, wc = wid & 1, fr = lane & 15, fq = lane >> 4;
  f32x4 acc[4][4];
#pragma unroll
  for (int m = 0; m < 4; ++m)
#pragma unroll
    for (int n = 0; n < 4; ++n) acc[m][n] = (f32x4){0.f, 0.f, 0.f, 0.f};
  const int r0 = tid >> 2, sg = tid & 3;
  const bf16_t* a0 = A + (size_t)r0 * lda + sg * 8;
  const bf16_t* a1 = a0 + (size_t)64 * lda;
  const bf16_t* b0 = Bt + (size_t)r0 * ldb + sg * 8;
  const bf16_t* b1 = b0 + (size_t)64 * ldb;
  uint4 ra0 = *(const uint4*)a0, ra1 = *(const uint4*)a1, rb0 = *(const uint4*)b0, rb1 = *(const uint4*)b1;
  __syncthreads();
  *(uint4*)&As[0][r0][sg * 8] = ra0; *(uint4*)&As[0][r0 + 64][sg * 8] = ra1;
  *(uint4*)&Bs[0][r0][sg * 8] = rb0; *(uint4*)&Bs[0][r0 + 64][sg * 8] = rb1;
  __syncthreads();
  const int nk = K >> 5;
  for (int kt = 0; kt < nk; ++kt) {
    const int cur = kt & 1;
    if (kt + 1 < nk) {
      const int ko = (kt + 1) * 32;
      ra0 = *(const uint4*)(a0 + ko); ra1 = *(const uint4*)(a1 + ko);
      rb0 = *(const uint4*)(b0 + ko); rb1 = *(const uint4*)(b1 + ko);
    }
    bf16x8 af[4], bfr[4];
#pragma unroll
    for (int m = 0; m < 4; ++m) af[m] = *(const bf16x8*)&As[cur][wr * 64 + m * 16 + fr][fq * 8];
#pragma unroll
    for (int n = 0; n < 4; ++n) bfr[n] = *(const bf16x8*)&Bs[cur][wc * 64 + n * 16 + fr][fq * 8];
#pragma unroll
    for (int m = 0; m < 4; ++m)
#pragma unroll
      for (int n = 0; n < 4; ++n) acc[m][n] = mfma16(af[m], bfr[n], acc[m][n]);
    if (kt + 1 < nk) {
      *(uint4*)&As[cur ^ 1][r0][sg * 8] = ra0; *(uint4*)&As[cur ^ 1][r0 + 64][sg * 8] = ra1;
      *(uint4*)&Bs[cur ^ 1][r0][sg * 8] = rb0; *(uint4*)&Bs[cur ^ 1][r0 + 64][sg * 8] = rb1;
    }
    __syncthreads();
  }
  epi(acc, wr, wc, fr, fq, smem);
}

DEV void ph_copy(const P& p) {
  const size_t n8 = (size_t)NTOK * D / 8;
  const float* pctx = opq(p.ctx); const float* px = opq(p.x);
  for (size_t i = (size_t)bid_() * 256 + tid_(); i < n8; i += (size_t)gridDim.x * 256) {
    size_t e = i * 8;
    int row = (int)(e / D), col = (int)(e % D);
    int b = row / LT, pp = row % LT;
    const float* src = pp < LC ? pctx + ((size_t)(b * LC + pp)) * D + col : px + ((size_t)(b * T + pp - LC)) * D + col;
    float4 v0 = *(const float4*)src, v1 = *(const float4*)(src + 4);
    uint4 o = make_uint4(pack2(v0.x, v0.y), pack2(v0.z, v0.w), pack2(v1.x, v1.y), pack2(v1.z, v1.w));
    *(uint4*)(p.X + e) = o;
  }
}

DEV void ph_rope(const P& p) {
  for (int i = bid_() * 256 + tid_(); i < 64 * 16; i += gridDim.x * 256) {
    int pos = i >> 4, k = i & 15;
    float inv = powf(10000.f, -(float)k / 16.f);
    float ang = (float)pos * inv;
    p.rope[2 * i] = cosf(ang); p.rope[2 * i + 1] = sinf(ang);
  }
}

DEV void modv_unit(const P& p, int unit, char* smem) {
  const int cc = unit % 24, layer = unit / 24;
  float (*cs)[128] = (float (*)[128])smem;
  const int col = cc * 256 + tid_();
  const float* pc = opq(p.c); const float* pcc = opq(p.c_ctx);
  float acc[17];
#pragma unroll
  for (int r = 0; r < 17; ++r) acc[r] = 0.f;
  for (int ks = 0; ks < 8; ++ks) {
    __syncthreads();
    for (int i = tid_(); i < 17 * 128; i += 256) {
      int r = i >> 7, e = i & 127;
      float v = r < 16 ? pc[r * D + ks * 128 + e] : pcc[ks * 128 + e];
      cs[r][e] = v / (1.f + expf(-v));
    }
    __syncthreads();
    const float* w = p.mod_w + ((size_t)layer * D + ks * 128) * 6144 + col;
#pragma unroll 4
    for (int e = 0; e < 128; ++e) {
      float wv = w[(size_t)e * 6144];
#pragma unroll
      for (int r = 0; r < 17; ++r) acc[r] += cs[r][e] * wv;
    }
  }
  const float bias = p.mod_b[layer * 6144 + col];
#pragma unroll
  for (int r = 0; r < 17; ++r) p.modv[((size_t)layer * 17 + r) * 6144 + col] = acc[r] + bias;
}

DEV void transpose_unit(const float* __restrict__ src, bf16_t* __restrict__ dst, int R, int C, int tile, char* smem) {
  float (*t)[65] = (float (*)[65])smem;
  const int nct = C / 64;
  const int tr = tile / nct, tc = tile % nct;
  __syncthreads();
  for (int i = tid_(); i < 4096; i += 256) { int r = i >> 6, c = i & 63; t[r][c] = src[(size_t)(tr * 64 + r) * C + tc * 64 + c]; }
  __syncthreads();
  for (int i = tid_(); i < 4096; i += 256) { int c = i >> 6, r = i & 63; dst[(size_t)(tc * 64 + c) * R + tr * 64 + r] = f2bf(t[r][c]); }
}

DEV void wfold_unit(const P& p, int layer, int unit, char* smem) {
  const int hs = unit >> 5, ec = unit & 31, h = hs >> 1, s = hs & 1;
  const float* wq = p.peer_wq + (size_t)layer * D * 2048;
  const float* kk = (s ? opq(p.peer_k2) : opq(p.peer_k1)) + ((size_t)layer * 8 + h) * 128 * 128;
  float (*kS)[65] = (float (*)[65])smem;
  float (*wS)[64] = (float (*)[64])(smem + 33280);
  const int key = tid_() & 127, eh = tid_() >> 7;
  float acc[16];
#pragma unroll
  for (int i = 0; i < 16; ++i) acc[i] = 0.f;
  for (int dh = 0; dh < 2; ++dh) {
    __syncthreads();
    for (int i = tid_(); i < 128 * 64; i += 256) { int k2 = i >> 6, d = i & 63; kS[k2][d] = kk[k2 * 128 + dh * 64 + d]; }
    for (int i = tid_(); i < 32 * 64; i += 256) {
      int e = i >> 6, d = i & 63;
      wS[e][d] = wq[(size_t)(ec * 32 + e) * 2048 + h * 256 + s * 128 + dh * 64 + d];
    }
    __syncthreads();
#pragma unroll 2
    for (int d = 0; d < 64; ++d) {
      float kv = kS[key][d];
#pragma unroll
      for (int i = 0; i < 16; ++i) acc[i] += kv * wS[eh * 16 + i][d];
    }
  }
  bf16_t* dst = p.Wft + ((size_t)(hs * 128 + key)) * D + ec * 32 + eh * 16;
#pragma unroll
  for (int i = 0; i < 16; i += 2) *(unsigned*)(dst + i) = pack2(acc[i], acc[i + 1]);
}

DEV void filt_unit(const P& p, int layer, int unit, char* smem) {
  int kind, j0, L;
  if (unit < 1024) { kind = 0; j0 = unit * 4; L = T; } else { kind = 1; j0 = (unit - 1024) * 4; L = LC; }
  float* zs = (float*)smem;
  float* h1 = zs + 4 * 36;
  float* h2 = h1 + 256;
  const int jj = tid_() >> 6, o = tid_() & 63;
  const int j = j0 + jj;
  const float fj = (float)j;
  const float t = fj / (float)(L - 1);
  __syncthreads();
  if (o < 33) {
    float z;
    if (o == 0) z = t;
    else {
      int i = (o - 1) & 15;
      float band = 1e-4f + (float)i * ((15.0f - 1e-4f) / 15.0f);
      float ang = 6.283185307179586f * fj * band / (float)L;
      z = (o <= 16) ? cosf(ang) : -sinf(ang);
    }
    zs[jj * 36 + o] = z;
  }
  __syncthreads();
  {
    const float* w1 = p.hy_w1 + layer * 33 * 64;
    float a = p.hy_b1[layer * 64 + o];
#pragma unroll 3
    for (int i = 0; i < 33; ++i) a += zs[jj * 36 + i] * w1[i * 64 + o];
    h1[jj * 64 + o] = sinf(p.hy_freq[layer * 128 + o] * a);
  }
  __syncthreads();
  {
    const float* w2 = p.hy_w2 + layer * 64 * 64;
    float a = p.hy_b2[layer * 64 + o];
#pragma unroll 4
    for (int i = 0; i < 64; ++i) a += h1[jj * 64 + i] * w2[i * 64 + o];
    h2[jj * 64 + o] = sinf(p.hy_freq[layer * 128 + 64 + o] * a);
  }
  __syncthreads();
  const float* w3 = p.hy_w3 + layer * 64 * 512;
  float* F = kind ? opq(p.FC) : opq(p.FL);
  const float DMIN = -3.0701134573253945f, DMAX = -15.350567286626973f;
#pragma unroll 1
  for (int m = 0; m < 4; ++m) {
    int c = o + 64 * m;
    float af = p.hy_b3[layer * 512 + c], ab = p.hy_b3[layer * 512 + 256 + c];
#pragma unroll 4
    for (int i = 0; i < 64; ++i) { float hv = h2[jj * 64 + i]; af += hv * w3[i * 512 + c]; ab += hv * w3[i * 512 + 256 + c]; }
    float delta = fabsf(DMIN + (float)c * ((DMAX - DMIN) / 255.f));
    float win = expf(-t * delta) + 0.05f;
    af *= win; ab *= win;
    F[((size_t)c * 2 + 0) * L + j] = af;
    F[((size_t)c * 2 + 1) * L + j] = ab;
  }
}

constexpr int PREP_T0 = 672, PREP_T1 = PREP_T0 + 256, PREP_T2 = PREP_T1 + 8, PREP_T3 = PREP_T2 + 8, PREP_T4 = PREP_T3 + 8;
constexpr int PREP_WF = PREP_T4 + 512, PREP_N = PREP_WF + 1088;
DEV void ph_prep(const P& p, int layer, char* smem) {
  for (int u = bid_(); u < PREP_N; u += gridDim.x) {
    if (u < PREP_T0) transpose_unit(p.w_in + (size_t)layer * D * INW, p.W1t, D, INW, u, smem);
    else if (u < PREP_T1) transpose_unit(p.w_out + (size_t)layer * D * D, p.W2t, D, D, u - PREP_T0, smem);
    else if (u < PREP_T2) { int q = u - PREP_T1, d = q >> 2; transpose_unit(p.rw_w_up + ((size_t)layer * 2 + d) * 64 * 256, p.Wwt + d * 256 * 64, 64, 256, q & 3, smem); }
    else if (u < PREP_T3) { int q = u - PREP_T2, d = q >> 2; transpose_unit(p.rw_a_up + ((size_t)layer * 2 + d) * 64 * 256, p.Wat + d * 256 * 64, 64, 256, q & 3, smem); }
    else if (u < PREP_T4) transpose_unit(p.rw_g_up + (size_t)layer * 128 * 256, p.Wgt, 128, 256, u - PREP_T3, smem);
    else if (u < PREP_WF) wfold_unit(p, layer, u - PREP_T4, smem);
    else filt_unit(p, layer, u - PREP_WF, smem);
  }
}

DEV void ph_norm(const P& p, int layer, int which) {
  const int gw = (bid_() * 256 + tid_()) >> 6, nw = gridDim.x * 4, lane = tid_() & 63;
  const float* g = (which ? p.norm2_g : p.norm1_g) + layer * D;
  for (int row = gw; row < NTOK; row += nw) {
    int b = row / LT, pp = row % LT;
    int mr = pp < LC ? 16 : b;
    const float* mv = p.modv + ((size_t)layer * 17 + mr) * 6144 + (which ? 3072 : 0);
    const bf16_t* xr = p.X + (size_t)row * D;
    uint4 u0 = *(const uint4*)(xr + 8 * lane), u1 = *(const uint4*)(xr + 512 + 8 * lane);
    float v[16];
    unpack8(u0, v); unpack8(u1, v + 8);
    float ss = 0.f;
#pragma unroll
    for (int i = 0; i < 16; ++i) ss += v[i] * v[i];
    ss = wave_sum(ss);
    float rstd = rsqrtf(ss * (1.f / 1024.f) + 1e-6f);
    float o[16];
#pragma unroll
    for (int hh = 0; hh < 2; ++hh)
#pragma unroll
      for (int i = 0; i < 8; ++i) {
        int col = hh * 512 + 8 * lane + i;
        float y = v[hh * 8 + i] * rstd * g[col];
        o[hh * 8 + i] = y * (1.f + mv[1024 + col]) + mv[col];
      }
    bf16_t* hr = p.H + (size_t)row * D;
    *(uint4*)(hr + 8 * lane) = pack8(o);
    *(uint4*)(hr + 512 + 8 * lane) = pack8(o + 8);
  }
}

struct Epi1 {
  const P& p; int row0, col0;
  DEV void operator()(f32x4 (&acc)[4][4], int wr, int wc, int fr, int fq, char*) const {
    const int cw = col0 + wc * 64;
    const int rbase = row0 + wr * 64;
    const bool lat = (row0 % LT) >= LC;
    if (cw >= 1536 && cw < 1664) {
#pragma unroll
      for (int m = 0; m < 4; ++m)
#pragma unroll
        for (int n = 0; n < 4; ++n)
#pragma unroll
          for (int j = 0; j < 4; ++j) acc[m][n][j] = tanhf(acc[m][n][j]);
    } else if (cw >= 1792 && cw < 1920) {
#pragma unroll
      for (int m = 0; m < 4; ++m)
#pragma unroll
        for (int n = 0; n < 4; ++n)
#pragma unroll
          for (int j = 0; j < 4; ++j) acc[m][n][j] = sigmoidf_(acc[m][n][j]);
    } else if (cw >= 1920 && cw < 2560 && lat) {
#pragma unroll
      for (int m = 0; m < 4; ++m)
#pragma unroll
        for (int j = 0; j < 4; ++j) {
          int row = rbase + m * 16 + fq * 4 + j;
          int pl = (row % LT) - LC;
          int ri = pl >> 6, ci = pl & 63;
          float2 cr = *(const float2*)(p.rope + 2 * (ri * 16 + fr));
          float2 cc = *(const float2*)(p.rope + 2 * (ci * 16 + fr));
          float x1 = acc[m][0][j], x2 = acc[m][1][j];
          acc[m][0][j] = x1 * cr.x - x2 * cr.y; acc[m][1][j] = x2 * cr.x + x1 * cr.y;
          x1 = acc[m][2][j]; x2 = acc[m][3][j];
          acc[m][2][j] = x1 * cc.x - x2 * cc.y; acc[m][3][j] = x2 * cc.x + x1 * cc.y;
        }
    }
#pragma unroll
    for (int m = 0; m < 4; ++m)
#pragma unroll
      for (int j = 0; j < 4; ++j) {
        int row = rbase + m * 16 + fq * 4 + j;
        bf16_t* zr = p.Z + (size_t)row * INW + cw + fr;
#pragma unroll
        for (int n = 0; n < 4; ++n) zr[n * 16] = f2bf(acc[m][n][j]);
      }
  }
};
DEV void ph_gemm1(const P& p, char* smem) {
  const int nct = INW / 128;
  for (int u = bid_(); u < (NTOK / 128) * nct; u += gridDim.x) {
    int rt = u / nct, ct = u % nct;
    Epi1 epi{p, rt * 128, ct * 128};
    gemm_tile(p.H + (size_t)rt * 128 * D, D, p.W1t + (size_t)ct * 128 * D, D, D, smem, epi);
  }
}

struct EpiLora {
  const P& p; int layer, q, row0, col0;
  DEV void operator()(f32x4 (&acc)[4][4], int wr, int wc, int fr, int fq, char*) const {
#pragma unroll
    for (int m = 0; m < 4; ++m)
#pragma unroll
      for (int n = 0; n < 4; ++n)
#pragma unroll
        for (int j = 0; j < 4; ++j) {
          int row = row0 + wr * 64 + m * 16 + fq * 4 + j;
          int col = col0 + wc * 64 + n * 16 + fr;
          float v = acc[m][n][j];
          if (q < 2) {
            v = 0.6065306597126334f * sigmoidf_(v + p.rw_w0[(layer * 2 + q) * 256 + col]);
            p.SC[(size_t)row * 1024 + q * 256 + col] = f2bf(v);
          } else if (q < 4) {
            v = sigmoidf_(v + p.rw_a0[(layer * 2 + (q - 2)) * 256 + col]);
            p.SC[(size_t)row * 1024 + q * 256 + col] = f2bf(v);
          } else {
            p.Y[(size_t)row * D + 256 + col] = f2bf(v);
          }
        }
  }
};
DEV void lora_unit(const P& p, int layer, int unit, char* smem) {
  const int q = unit / 1088, r = unit % 1088, rt = r >> 1, ct = r & 1;
  EpiLora epi{p, layer, q, rt * 128, ct * 128};
  const bf16_t* A; const bf16_t* Bt; int K;
  if (q < 2) { A = p.Z + 1536 + 64 * q; Bt = p.Wwt + q * 256 * 64; K = 64; }
  else if (q < 4) { A = p.Z + 1664 + 64 * (q - 2); Bt = p.Wat + (q - 2) * 256 * 64; K = 64; }
  else { A = p.Z + 1792; Bt = p.Wgt; K = 128; }
  gemm_tile(A + (size_t)rt * 128 * INW, INW, Bt + (size_t)ct * 128 * K, K, K, smem, epi);
}

DEV void ph_rwkv_prep(const P& p, int layer) {
  const int gw = (bid_() * 256 + tid_()) >> 6, nw = gridDim.x * 4, lane = tid_() & 63;
  const float* cw = p.conv_w + (size_t)layer * 3 * 1536;
  const float* cb = p.conv_b + (size_t)layer * 1536;
  for (int row = gw; row < NTOK; row += nw) {
    int pp = row % LT;
    bool hasm = (pp != 0) && (pp != LC);
    bool hasp = (pp != LC - 1) && (pp != LT - 1);
    float res[3][4];
#pragma unroll
    for (int a = 0; a < 3; ++a) {
      int col = 768 + a * 256 + 4 * lane;
      const bf16_t* zc = p.Z + (size_t)row * INW + col;
      uint2 um = hasm ? *(const uint2*)(zc - INW) : make_uint2(0, 0);
      uint2 uc = *(const uint2*)zc;
      uint2 up = hasp ? *(const uint2*)(zc + INW) : make_uint2(0, 0);
      float vm[4] = {bflo(um.x), bfhi(um.x), bflo(um.y), bfhi(um.y)};
      float vc[4] = {bflo(uc.x), bfhi(uc.x), bflo(uc.y), bfhi(uc.y)};
      float vp[4] = {bflo(up.x), bfhi(up.x), bflo(up.y), bfhi(up.y)};
#pragma unroll
      for (int i = 0; i < 4; ++i) res[a][i] = cw[col + i] * vm[i] + cw[1536 + col + i] * vc[i] + cw[3072 + col + i] * vp[i] + cb[col + i];
    }
    float kk[4], ss = 0.f;
#pragma unroll
    for (int i = 0; i < 4; ++i) { kk[i] = res[1][i] * p.rw_k_k[layer * 256 + 4 * lane + i]; ss += kk[i] * kk[i]; }
    ss = row16_sum(ss);
    float rs = rsqrtf(ss + 1e-12f);
    bf16_t* hr = p.H + (size_t)row * D + 4 * lane;
#pragma unroll
    for (int a = 0; a < 3; ++a) *(uint2*)(hr + a * 256) = make_uint2(pack2(res[a][0], res[a][1]), pack2(res[a][2], res[a][3]));
    *(uint2*)(hr + 768) = make_uint2(pack2(kk[0] * rs, kk[1] * rs), pack2(kk[2] * rs, kk[3] * rs));
  }
}

struct ScanRaw { bf16_t r, k, kk, e, a, v; };
DEV void scan_unit(const P& p, int layer, int unit, char* smem) {
  const int dir = unit & 1, h = (unit >> 1) & 3, b = unit >> 3;
  const int wid = tid_() >> 6, lane = tid_() & 63;
  const int kq = lane & 3, rowl = lane >> 2, vrow = wid * 16 + rowl;
  float* st = (float*)smem + wid * 640;
  const float ka = p.rw_k_a[layer * 256 + h * 64 + lane];
  float S[16];
#pragma unroll
  for (int i = 0; i < 16; ++i) S[i] = 0.f;
  const size_t rowbase = (size_t)b * LT;
  auto posf = [&](int t) -> int { return dir == 0 ? t : (t < LC ? LC - 1 - t : LT - 1 - (t - LC)); };
  auto load4 = [&](int c, ScanRaw (&dst)[4]) {
#pragma unroll
    for (int i = 0; i < 4; ++i) {
      size_t row = rowbase + posf(c * 4 + i);
      const bf16_t* hp = p.H + row * D + h * 64;
      const bf16_t* sp = p.SC + row * 1024 + h * 64;
      dst[i].r = hp[lane]; dst[i].k = hp[256 + lane]; dst[i].v = hp[512 + vrow]; dst[i].kk = hp[768 + lane];
      dst[i].e = sp[dir * 256 + lane]; dst[i].a = sp[512 + dir * 256 + lane];
    }
  };
  auto comp4 = [&](int c, ScanRaw (&src)[4]) {
#pragma unroll
    for (int i = 0; i < 4; ++i) {
      const int t = c * 4 + i;
      float rr = bf2f(src[i].r), kr = bf2f(src[i].k), kkv = bf2f(src[i].kk), ev = bf2f(src[i].e), av = bf2f(src[i].a), vv = bf2f(src[i].v);
      float w = __expf(-ev), ap = -kkv, bp = kkv * av, kd = kr * (1.f + (av - 1.f) * ka);
      float* sb = st + (i & 1) * 320;
      sb[lane] = ap; sb[64 + lane] = w; sb[128 + lane] = bp; sb[192 + lane] = kd; sb[256 + lane] = rr;
      asm volatile("s_waitcnt lgkmcnt(0)" ::: "memory");
      float4 A4[4], W4[4], B4[4], K4[4], R4[4];
#pragma unroll
      for (int q = 0; q < 4; ++q) {
        A4[q] = *(const float4*)&sb[kq * 16 + 4 * q]; W4[q] = *(const float4*)&sb[64 + kq * 16 + 4 * q];
        B4[q] = *(const float4*)&sb[128 + kq * 16 + 4 * q]; K4[q] = *(const float4*)&sb[192 + kq * 16 + 4 * q];
        R4[q] = *(const float4*)&sb[256 + kq * 16 + 4 * q];
      }
      float s0 = 0.f, s1 = 0.f, s2 = 0.f, s3 = 0.f;
#pragma unroll
      for (int q = 0; q < 4; ++q) { s0 += S[4 * q] * A4[q].x; s1 += S[4 * q + 1] * A4[q].y; s2 += S[4 * q + 2] * A4[q].z; s3 += S[4 * q + 3] * A4[q].w; }
      float sa = quad_sum((s0 + s1) + (s2 + s3));
      float y0 = 0.f, y1 = 0.f, y2 = 0.f, y3 = 0.f;
#pragma unroll
      for (int q = 0; q < 4; ++q) {
        S[4 * q] = S[4 * q] * W4[q].x + (sa * B4[q].x + vv * K4[q].x); y0 += S[4 * q] * R4[q].x;
        S[4 * q + 1] = S[4 * q + 1] * W4[q].y + (sa * B4[q].y + vv * K4[q].y); y1 += S[4 * q + 1] * R4[q].y;
        S[4 * q + 2] = S[4 * q + 2] * W4[q].z + (sa * B4[q].z + vv * K4[q].z); y2 += S[4 * q + 2] * R4[q].z;
        S[4 * q + 3] = S[4 * q + 3] * W4[q].w + (sa * B4[q].w + vv * K4[q].w); y3 += S[4 * q + 3] * R4[q].w;
      }
      float y = quad_sum((y0 + y1) + (y2 + y3));
      if (kq == 0) p.Z[(rowbase + posf(t)) * INW + 768 + dir * 256 + h * 64 + vrow] = f2bf(y);
    }
  };
  ScanRaw A[4], B[4];
  load4(0, A);
  for (int c = 0; c < LT / 4; c += 2) {
    load4(c + 1, B);
    comp4(c, A);
    if (c + 2 < LT / 4) load4(c + 2, A);
    comp4(c + 1, B);
  }
}

DEV void ph_rwkv_post(const P& p, int layer) {
  const int gw = (bid_() * 256 + tid_()) >> 6, nw = gridDim.x * 4, lane = tid_() & 63;
  for (int row = gw; row < NTOK; row += nw) {
    const int ch = 4 * lane;
    const bf16_t* zr = p.Z + (size_t)row * INW + 768 + ch;
    uint2 y0u = *(const uint2*)zr, y1u = *(const uint2*)(zr + 256);
    float y[4] = {bflo(y0u.x) + bflo(y1u.x), bfhi(y0u.x) + bfhi(y1u.x), bflo(y0u.y) + bflo(y1u.y), bfhi(y0u.y) + bfhi(y1u.y)};
    float mu = row16_sum(y[0] + y[1] + y[2] + y[3]) * (1.f / 64.f);
    float vs = 0.f;
#pragma unroll
    for (int i = 0; i < 4; ++i) { y[i] -= mu; vs += y[i] * y[i]; }
    float var = row16_sum(vs) * (1.f / 64.f);
    float rstd = rsqrtf(var + 64e-5f);
    const bf16_t* hr = p.H + (size_t)row * D + ch;
    uint2 ru = *(const uint2*)hr, ku = *(const uint2*)(hr + 256), vu = *(const uint2*)(hr + 512);
    const bf16_t* sr = p.SC + (size_t)row * 1024 + 512 + ch;
    uint2 a0u = *(const uint2*)sr, a1u = *(const uint2*)(sr + 256);
    float r[4] = {bflo(ru.x), bfhi(ru.x), bflo(ru.y), bfhi(ru.y)};
    float k[4] = {bflo(ku.x), bfhi(ku.x), bflo(ku.y), bfhi(ku.y)};
    float v[4] = {bflo(vu.x), bfhi(vu.x), bflo(vu.y), bfhi(vu.y)};
    float a0[4] = {bflo(a0u.x), bfhi(a0u.x), bflo(a0u.y), bfhi(a0u.y)};
    float a1[4] = {bflo(a1u.x), bfhi(a1u.x), bflo(a1u.y), bfhi(a1u.y)};
    float sd = 0.f;
#pragma unroll
    for (int i = 0; i < 4; ++i) {
      float kav = p.rw_k_a[layer * 256 + ch + i], rk = p.rw_r_k[layer * 256 + ch + i];
      float kd0 = k[i] * (1.f + (a0[i] - 1.f) * kav), kd1 = k[i] * (1.f + (a1[i] - 1.f) * kav);
      sd += r[i] * (kd0 + kd1) * rk;
    }
    sd = row16_sum(sd);
    bf16_t* yr = p.Y + (size_t)row * D + 256 + ch;
    uint2 gu = *(const uint2*)yr;
    float g[4] = {bflo(gu.x), bfhi(gu.x), bflo(gu.y), bfhi(gu.y)};
    float o[4];
#pragma unroll
    for (int i = 0; i < 4; ++i) {
      float yn = y[i] * rstd * p.rw_ln_w[layer * 256 + ch + i] + p.rw_ln_b[layer * 256 + ch + i];
      o[i] = (yn + sd * v[i]) * g[i];
#if !EN_RW
      o[i] = 0.f;
#endif
    }
    *(uint2*)yr = make_uint2(pack2(o[0], o[1]), pack2(o[2], o[3]));
  }
}

DEV void hyena_pre_unit(const P& p, int layer, int unit) {
  int kind, b, t0, L;
  if (unit < 1024) { kind = 0; b = unit >> 6; t0 = (unit & 63) * 64; L = T; } else { int u = unit - 1024; kind = 1; b = u >> 2; t0 = (u & 3) * 64; L = LC; }
  const int c = tid_();
  const size_t row0 = (size_t)b * LT + (kind ? 0 : LC);
  const float* cw = p.conv_w + (size_t)layer * 3 * 1536;
  const float* cb = p.conv_b + (size_t)layer * 1536;
  const float w1a = cw[256 + c], w1b = cw[1536 + 256 + c], w1c = cw[3072 + 256 + c], b1 = cb[256 + c];
  const float w2a = cw[512 + c], w2b = cw[1536 + 512 + c], w2c = cw[3072 + 512 + c], b2 = cb[512 + c];
  auto ld = [&](int t, int col) -> float { return (t >= 0 && t < L) ? bf2f(p.Z[(row0 + t) * INW + col]) : 0.f; };
  float x1m = ld(t0 - 1, 256 + c), x1c = ld(t0, 256 + c), vm = ld(t0 - 1, 512 + c), vc = ld(t0, 512 + c);
  bf16_t* dst = (kind ? opq(p.UTc) : opq(p.UTl)) + ((size_t)c * 16 + b) * L + t0;
#pragma unroll 1
  for (int i8 = 0; i8 < 8; ++i8) {
    float uo[8];
#pragma unroll
    for (int i = 0; i < 8; ++i) {
      int t = t0 + i8 * 8 + i;
      float x1n = ld(t + 1, 256 + c), vn = ld(t + 1, 512 + c);
      float a = w1a * x1m + w1b * x1c + w1c * x1n + b1;
      float bb = w2a * vm + w2b * vc + w2c * vn + b2;
      uo[i] = a * bb;
      x1m = x1c; x1c = x1n; vm = vc; vc = vn;
    }
    *(uint4*)(dst + 8 * i8) = pack8(uo);
  }
}

DEV void hyena_conv_unit(const P& p, int layer, int unit, char* smem) {
  int kind, c, tb, L;
  if (unit < 4096) { kind = 0; c = unit >> 4; tb = (unit & 15) * 256; L = T; } else { kind = 1; c = unit - 4096; tb = 0; L = LC; }
  const int tid = tid_(), lane = tid & 63, wid = tid >> 6, fr = lane & 15, fq = lane >> 4;
  bf16_t* Cq = (bf16_t*)smem;
  bf16_t* Us = (bf16_t*)(smem + 8320);
  const float* F = (kind ? opq(p.FC) : opq(p.FL)) + (size_t)c * 2 * L;
  float* red = (float*)(smem + 16512);
  float scale;
  {
    float part = 0.f;
    for (int i = tid; i < 2 * L; i += 256) { float fv = F[i]; part += (i != L) ? fv * fv : 0.f; }
    part = wave_sum(part);
    if (lane == 0) red[wid] = part;
    __syncthreads();
    scale = rsqrtf(((red[0] + red[1]) + (red[2] + red[3])) + 1e-6f);
  }
  const bf16_t* U = (kind ? opq(p.UTc) : opq(p.UTl)) + (size_t)c * 16 * L;
  f32x4 acc[4];
#pragma unroll
  for (int m = 0; m < 4; ++m) acc[m] = (f32x4){0.f, 0.f, 0.f, 0.f};
  const int nch = L / 256;
  for (int ch = 0; ch < nch; ++ch) {
    const int sc = ch * 256;
    const int D0 = tb + 256 - sc;
    __syncthreads();
    for (int i = tid; i < 4160; i += 256) {
      int rho = i / 520, m = i % 520;
      int n = m - rho;
      int d = D0 - n;
      float v = 0.f;
      if (n >= 0 && d > -L && d < L) v = (d >= 0 ? F[d] : F[L - d]) * scale;
      Cq[((m >> 3) * 8 + rho) * 8 + (m & 7)] = f2bf(v);
    }
    for (int i = tid; i < 512; i += 256) {
      int b = i >> 5, sgm = i & 31;
      *(uint4*)&Us[(sgm * 16 + b) * 8] = *(const uint4*)(U + (size_t)b * L + sc + 8 * sgm);
    }
    __syncthreads();
#pragma unroll
    for (int kk = 0; kk < 8; ++kk) {
      bf16x8 bf = *(const bf16x8*)&Us[((4 * kk + fq) * 16 + fr) * 8];
#pragma unroll
      for (int m = 0; m < 4; ++m) {
        int it = wid * 4 + m;
        int base = 256 - 16 * it + 32 * kk + 8 * fq;
        int m0 = base - 8 * (fr >> 3);
        bf16x8 af = *(const bf16x8*)&Cq[((m0 >> 3) * 8 + (fr & 7)) * 8];
        acc[m] = mfma16(af, bf, acc[m]);
      }
    }
  }
  bf16_t* Yt = (kind ? opq(p.YTc) : opq(p.YTl)) + ((size_t)c * 16 + fr) * L + tb;
#pragma unroll
  for (int m = 0; m < 4; ++m) {
    int t = (wid * 4 + m) * 16 + fq * 4;
    *(uint2*)(Yt + t) = make_uint2(pack2(acc[m][0], acc[m][1]), pack2(acc[m][2], acc[m][3]));
  }
}

DEV void hyena_post_unit(const P& p, int layer, int unit, char* smem) {
  int kind, b, t0, L;
  if (unit < 1024) { kind = 0; b = unit >> 6; t0 = (unit & 63) * 64; L = T; } else { int u = unit - 1024; kind = 1; b = u >> 2; t0 = (u & 3) * 64; L = LC; }
  const int c = tid_(), lane = c & 63, wid = c >> 6;
  const size_t row0 = (size_t)b * LT + (kind ? 0 : LC);
  bf16_t (*tile)[264] = (bf16_t (*)[264])smem;
  const float* cw = p.conv_w + (size_t)layer * 3 * 1536;
  const float wa = cw[c], wb = cw[1536 + c], wcc = cw[3072 + c], b0 = p.conv_b[layer * 1536 + c];
  const float bias = p.hy_bias[layer * 256 + c];
  const bf16_t* yt = (kind ? opq(p.YTc) : opq(p.YTl)) + ((size_t)c * 16 + b) * L + t0;
  const bf16_t* ut = (kind ? opq(p.UTc) : opq(p.UTl)) + ((size_t)c * 16 + b) * L + t0;
  auto ld = [&](int t) -> float { return (t >= 0 && t < L) ? bf2f(p.Z[(row0 + t) * INW + c]) : 0.f; };
  float xm = ld(t0 - 1), xc = ld(t0);
  __syncthreads();
#pragma unroll 1
  for (int i8 = 0; i8 < 8; ++i8) {
    uint4 yu = *(const uint4*)(yt + 8 * i8), uu = *(const uint4*)(ut + 8 * i8);
    float yv[8], uv[8];
    unpack8(yu, yv); unpack8(uu, uv);
#pragma unroll
    for (int i = 0; i < 8; ++i) {
      int t = t0 + i8 * 8 + i;
      float xn = ld(t + 1);
      float x0 = wa * xm + wb * xc + wcc * xn + b0;
      float o = x0 * (yv[i] + uv[i] * bias);
      tile[i8 * 8 + i][c] = f2bf(o);
      xm = xc; xc = xn;
    }
  }
  __syncthreads();
  for (int i = 0; i < 16; ++i) {
    int tl = wid * 16 + i;
    uint2 ou = *(const uint2*)&tile[tl][4 * lane];
    float o[4] = {bflo(ou.x), bfhi(ou.x), bflo(ou.y), bfhi(ou.y)};
    float ss = wave_sum(o[0] * o[0] + o[1] * o[1] + o[2] * o[2] + o[3] * o[3]);
    float rstd = rsqrtf(ss * (1.f / 256.f) + 1e-6f);
#pragma unroll
    for (int q = 0; q < 4; ++q) {
      o[q] = o[q] * rstd * p.hy_out_g[layer * 256 + 4 * lane + q];
#if !EN_HY
      o[q] = 0.f;
#endif
    }
    *(uint2*)(p.Y + (row0 + t0 + tl) * D + 4 * lane) = make_uint2(pack2(o[0], o[1]), pack2(o[2], o[3]));
  }
}

DEV void attn_unit(const P& p, int layer, int unit, char* smem) {
  const bool isctx = unit >= 4096;
  int b, qb, hq;
  if (!isctx) { b = unit >> 8; qb = (unit >> 3) & 31; hq = unit & 7; } else { int u = unit - 4096; b = u >> 4; qb = (u >> 3) & 1; hq = u & 7; }
  const int g = hq >> 2;
  const int tid = tid_(), lane = tid & 63, wid = tid >> 6, qn = lane & 31, hh = lane >> 5;
  const int qpos = qb * 128 + wid * 32 + qn;
  const size_t qrow = (size_t)b * LT + (isctx ? qpos : LC + qpos);
  const bf16_t* qptr = p.Z + qrow * INW + 1920 + hq * 64;
  bf16x8 qf[4];
#pragma unroll
  for (int s = 0; s < 4; ++s) qf[s] = *(const bf16x8*)(qptr + 16 * s + 8 * hh);
  const float sink = p.attn_sink[layer * 8 + hq];
  float m_run = sink, l_run = 1.f;
  f32x16 o0, o1;
#pragma unroll
  for (int i = 0; i < 16; ++i) { o0[i] = 0.f; o1[i] = 0.f; }
  bf16_t (*Ks)[72] = (bf16_t (*)[72])smem;
  bf16_t (*Vt)[40] = (bf16_t (*)[40])(smem + 4608);
  const int ntl = isctx ? 0 : 12;
  const int ntiles = ntl + 8;
  for (int kt = 0; kt < ntiles; ++kt) {
    const bool ctxk = kt >= ntl;
    const int kbase = ctxk ? (kt - ntl) * 32 : qb * 128 - 128 + kt * 32;
    __syncthreads();
    {
      int key = tid >> 3, seg = tid & 7;
      int kp = kbase + key;
      uint4 kv = make_uint4(0, 0, 0, 0), vv = make_uint4(0, 0, 0, 0);
      if (ctxk || (kp >= 0 && kp < T)) {
        size_t krow = (size_t)b * LT + (ctxk ? kp : LC + kp);
        const bf16_t* src = p.Z + krow * INW + 1920 + 512 + g * 64 + seg * 8;
        kv = *(const uint4*)src; vv = *(const uint4*)(src + 128);
      }
      *(uint4*)&Ks[key][seg * 8] = kv;
      Vt[seg * 8 + 0][key] = (bf16_t)(vv.x & 0xFFFF); Vt[seg * 8 + 1][key] = (bf16_t)(vv.x >> 16);
      Vt[seg * 8 + 2][key] = (bf16_t)(vv.y & 0xFFFF); Vt[seg * 8 + 3][key] = (bf16_t)(vv.y >> 16);
      Vt[seg * 8 + 4][key] = (bf16_t)(vv.z & 0xFFFF); Vt[seg * 8 + 5][key] = (bf16_t)(vv.z >> 16);
      Vt[seg * 8 + 6][key] = (bf16_t)(vv.w & 0xFFFF); Vt[seg * 8 + 7][key] = (bf16_t)(vv.w >> 16);
    }
    __syncthreads();
    bool need = true;
    if (!ctxk) {
      int q0 = qb * 128 + wid * 32;
      if (kbase + 31 < q0 - 128 || kbase > q0 + 31 + 128 || kbase + 31 < 0 || kbase >= T) need = false;
    }
    if (need) {
      f32x16 s;
#pragma unroll
      for (int i = 0; i < 16; ++i) s[i] = 0.f;
#pragma unroll
      for (int ks = 0; ks < 4; ++ks) {
        bf16x8 kf = *(const bf16x8*)&Ks[qn][16 * ks + 8 * hh];
        s = mfma32(kf, qf[ks], s);
      }
      float mt = -3e38f;
#pragma unroll
      for (int rg = 0; rg < 16; ++rg) {
        float v = s[rg] * 0.125f;
        if (!ctxk) {
          int kp = kbase + (rg & 3) + 8 * (rg >> 2) + 4 * hh;
          int dl = qpos - kp;
          bool ok = (dl <= 128) && (dl >= -128) && (kp >= 0) && (kp < T);
          v = ok ? v : -1e30f;
        }
        s[rg] = v;
        mt = fmaxf(mt, v);
      }
      mt = fmaxf(mt, __shfl_xor(mt, 32));
      float m_new = fmaxf(m_run, mt);
      float corr = __expf(m_run - m_new);
      float ps = 0.f;
#pragma unroll
      for (int rg = 0; rg < 16; ++rg) { float pv = __expf(s[rg] - m_new); s[rg] = pv; ps += pv; }
      ps += __shfl_xor(ps, 32);
      l_run = l_run * corr + ps;
      m_run = m_new;
#pragma unroll
      for (int i = 0; i < 16; ++i) { o0[i] *= corr; o1[i] *= corr; }
#pragma unroll
      for (int sp = 0; sp < 2; ++sp) {
        bf16x8 pf;
#pragma unroll
        for (int j = 0; j < 8; ++j) pf[j] = (short)f2bf(s[8 * sp + j]);
        uint2 va = *(const uint2*)&Vt[qn][16 * sp + 4 * hh], vb = *(const uint2*)&Vt[qn][16 * sp + 8 + 4 * hh];
        uint2 vc = *(const uint2*)&Vt[32 + qn][16 * sp + 4 * hh], vd = *(const uint2*)&Vt[32 + qn][16 * sp + 8 + 4 * hh];
        uint4 w0 = make_uint4(va.x, va.y, vb.x, vb.y), w1 = make_uint4(vc.x, vc.y, vd.x, vd.y);
        bf16x8 v0 = __builtin_bit_cast(bf16x8, w0), v1 = __builtin_bit_cast(bf16x8, w1);
        o0 = mfma32(v0, pf, o0);
        o1 = mfma32(v1, pf, o1);
      }
    }
  }
  const float inv = 1.f / l_run;
  bf16_t* optr = p.Y + qrow * D + 512 + hq * 64;
#pragma unroll
  for (int rg = 0; rg < 4; ++rg) {
    int d0 = 8 * rg + 4 * hh;
    *(uint2*)(optr + d0) = make_uint2(pack2(o0[4 * rg] * inv, o0[4 * rg + 1] * inv), pack2(o0[4 * rg + 2] * inv, o0[4 * rg + 3] * inv));
    *(uint2*)(optr + 32 + d0) = make_uint2(pack2(o1[4 * rg] * inv, o1[4 * rg + 1] * inv), pack2(o1[4 * rg + 2] * inv, o1[4 * rg + 3] * inv));
  }
}

DEV void ph_attn_post(const P& p, int layer) {
  const int gw = (bid_() * 256 + tid_()) >> 6, nw = gridDim.x * 4, lane = tid_() & 63;
  for (int row = gw; row < NTOK; row += nw) {
    bf16_t* yr = p.Y + (size_t)row * D + 512 + 8 * lane;
    uint4 u = *(const uint4*)yr;
    float v[8];
    unpack8(u, v);
    float ss = 0.f;
#pragma unroll
    for (int i = 0; i < 8; ++i) ss += v[i] * v[i];
    ss = wave_sum(ss);
    float rstd = rsqrtf(ss * (1.f / 512.f) + 1e-6f);
#pragma unroll
    for (int i = 0; i < 8; ++i) {
      v[i] = v[i] * rstd * p.at_out_g[layer * 512 + 8 * lane + i];
#if !EN_AT
      v[i] = 0.f;
#endif
    }
    *(uint4*)yr = pack8(v);
  }
}

struct Epi2 {
  const P& p; int layer, row0, col0;
  DEV void operator()(f32x4 (&acc)[4][4], int wr, int wc, int fr, int fq, char*) const {
    const int b = row0 / LT, pp = row0 % LT;
    const int mr = pp < LC ? 16 : b;
    const float* g1 = p.modv + ((size_t)layer * 17 + mr) * 6144 + 2048;
#pragma unroll
    for (int m = 0; m < 4; ++m)
#pragma unroll
      for (int j = 0; j < 4; ++j) {
        int row = row0 + wr * 64 + m * 16 + fq * 4 + j;
#pragma unroll
        for (int n = 0; n < 4; ++n) {
          int col = col0 + wc * 64 + n * 16 + fr;
          bf16_t* xp = p.X + (size_t)row * D + col;
          float v = bf2f(*xp) + g1[col] * acc[m][n][j];
#if EN_MIX
          *xp = f2bf(v);
#endif
        }
      }
  }
};
DEV void ph_gemm2(const P& p, int layer, char* smem) {
  for (int u = bid_(); u < (NTOK / 128) * 8; u += gridDim.x) {
    int rt = u >> 3, ct = u & 7;
    Epi2 epi{p, layer, rt * 128, ct * 128};
    gemm_tile(p.Y + (size_t)rt * 128 * D, D, p.W2t + (size_t)ct * 128 * D, D, D, smem, epi);
  }
}

DEV void ph_peerconv(const P& p, int layer) {
  const size_t n8 = (size_t)16384 * 1024 / 8;
  const float* su = opq(p.peer_u) + (size_t)layer * 16384 * 1024;
  const float* sv = opq(p.peer_v) + (size_t)layer * 16384 * 1024;
  bf16_t* pu = opq(p.PU); bf16_t* pv = opq(p.PV);
  for (size_t i = (size_t)bid_() * 256 + tid_(); i < 2 * n8; i += (size_t)gridDim.x * 256) {
    const float* s = i < n8 ? su + i * 8 : sv + (i - n8) * 8;
    bf16_t* d = i < n8 ? pu + i * 8 : pv + (i - n8) * 8;
    float4 v0 = *(const float4*)s, v1 = *(const float4*)(s + 4);
    *(uint4*)d = make_uint4(pack2(v0.x, v0.y), pack2(v0.z, v0.w), pack2(v1.x, v1.y), pack2(v1.z, v1.w));
  }
}

struct Epi3 {
  const P& p; int row0, grp;
  DEV void operator()(f32x4 (&acc)[4][4], int wr, int wc, int fr, int fq, char* smem) const {
    float* sc = (float*)smem;
    const int tid = tid_();
    for (int pass = 0; pass < 2; ++pass) {
      __syncthreads();
      if (wr == pass) {
#pragma unroll
        for (int m = 0; m < 4; ++m)
#pragma unroll
          for (int n = 0; n < 4; ++n)
#pragma unroll
            for (int j = 0; j < 4; ++j) {
              int rl = m * 16 + fq * 4 + j, col = wc * 64 + n * 16 + fr;
              unsigned bits = (__float_as_uint(acc[m][n][j]) & ~127u) | (unsigned)col;
              sc[rl * 133 + (col >> 5) * 33 + (col & 31)] = __uint_as_float(bits);
            }
      }
      __syncthreads();
      const int rl = tid >> 2, q = tid & 3;
      float Ls[16];
#pragma unroll
      for (int i = 0; i < 16; ++i) Ls[i] = -3e38f;
      const float* src = sc + rl * 133 + q * 33;
      for (int i = 0; i < 32; ++i) {
        float x = src[i];
        if (x > Ls[15]) {
#pragma unroll
          for (int k = 0; k < 16; ++k) { float hi = fmaxf(Ls[k], x); x = fminf(Ls[k], x); Ls[k] = hi; }
        }
      }
      float Cs[16];
#pragma unroll
      for (int i = 0; i < 16; ++i) Cs[i] = fmaxf(Ls[i], dppself<0xB1, 0xF>(Ls[15 - i]));
#pragma unroll
      for (int d = 8; d >= 1; d >>= 1)
#pragma unroll
        for (int i = 0; i < 16; ++i)
          if ((i & d) == 0) { float hi = fmaxf(Cs[i], Cs[i + d]), lo = fminf(Cs[i], Cs[i + d]); Cs[i] = hi; Cs[i + d] = lo; }
      float Ds[16];
#pragma unroll
      for (int i = 0; i < 16; ++i) Ds[i] = fmaxf(Cs[i], dppself<0x4E, 0xF>(Cs[15 - i]));
      if (q == 0) {
        float* dst = p.TK + ((size_t)(row0 + pass * 64 + rl) * 16 + grp) * 16;
#pragma unroll
        for (int i = 0; i < 4; ++i) *(float4*)(dst + 4 * i) = make_float4(Ds[4 * i], Ds[4 * i + 1], Ds[4 * i + 2], Ds[4 * i + 3]);
      }
    }
  }
};
DEV void ph_gemm3(const P& p, char* smem) {
  for (int u = bid_(); u < (NTOK / 128) * 16; u += gridDim.x) {
    int rt = u >> 4, ct = u & 15;
    Epi3 epi{p, rt * 128, ct};
    gemm_tile(p.H + (size_t)rt * 128 * D, D, p.Wft + (size_t)ct * 128 * D, D, D, smem, epi);
  }
}

DEV void peer_select4(const float* tk, int hbase, int lane, float& scr, int& er) {
#pragma unroll 1
  for (int hq = 0; hq < 4; ++hq) {
    const int h = hbase + hq;
    const float v1 = tk[(2 * h) * 16 + (lane >> 2)];
    const float4 v2 = *(const float4*)(tk + (2 * h + 1) * 16 + 4 * (lane & 3));
    float c0 = v1 + v2.x, c1 = v1 + v2.y, c2 = v1 + v2.z, c3 = v1 + v2.w;
    const int i1 = (int)(__float_as_uint(v1) & 127u);
#pragma unroll 1
    for (int r = 0; r < 16; ++r) {
      float m = fmaxf(fmaxf(c0, c1), fmaxf(c2, c3));
      float wm = wave_max(m);
      unsigned long long bal = __ballot(m == wm);
      int wl = __ffsll((long long)bal) - 1;
      int jsel = (c0 == wm) ? 0 : (c1 == wm) ? 1 : (c2 == wm) ? 2 : 3;
      float v2sel = jsel == 0 ? v2.x : jsel == 1 ? v2.y : jsel == 2 ? v2.z : v2.w;
      int el = i1 * 128 + (int)(__float_as_uint(v2sel) & 127u);
      int ew = __builtin_amdgcn_readlane(el, wl);
      if (lane == wl) {
        if (jsel == 0) c0 = -3e38f; else if (jsel == 1) c1 = -3e38f; else if (jsel == 2) c2 = -3e38f; else c3 = -3e38f;
      }
      const int sl = hq * 16 + r;
      scr = (lane == sl) ? wm : scr;
      er = (lane == sl) ? ew : er;
    }
  }
}
DEV float peer_udots(const P& p, int er, const float* hv, int lane) {
  float dots = 0.f;
#pragma unroll 1
  for (int k8 = 0; k8 < 8; ++k8) {
    uint4 ua[8], ub[8];
#pragma unroll
    for (int j = 0; j < 8; ++j) {
      int e = __builtin_amdgcn_readlane(er, k8 * 8 + j);
      const bf16_t* ur = p.PU + (size_t)e * 1024;
      ua[j] = *(const uint4*)(ur + 8 * lane); ub[j] = *(const uint4*)(ur + 512 + 8 * lane);
    }
#pragma unroll
    for (int j = 0; j < 8; ++j) {
      float f[16];
      unpack8(ua[j], f); unpack8(ub[j], f + 8);
      float d = 0.f;
#pragma unroll
      for (int i = 0; i < 16; ++i) d += f[i] * hv[i];
      d = wave_sum(d);
      dots = (lane == k8 * 8 + j) ? d : dots;
    }
  }
  return dots;
}
DEV void peer_vacc(const P& p, int er, float wk, float* outv, int lane) {
#pragma unroll 1
  for (int k8 = 0; k8 < 8; ++k8) {
    uint4 ua[8], ub[8];
    float ws[8];
#pragma unroll
    for (int j = 0; j < 8; ++j) {
      int e = __builtin_amdgcn_readlane(er, k8 * 8 + j);
      ws[j] = readlane_f(wk, k8 * 8 + j);
      const bf16_t* vr = p.PV + (size_t)e * 1024;
      ua[j] = *(const uint4*)(vr + 8 * lane); ub[j] = *(const uint4*)(vr + 512 + 8 * lane);
    }
#pragma unroll
    for (int j = 0; j < 8; ++j) {
      float f[16];
      unpack8(ua[j], f); unpack8(ub[j], f + 8);
#pragma unroll
      for (int i = 0; i < 16; ++i) outv[i] += ws[j] * f[i];
    }
  }
}
DEV float peer_gate(float scr) {
  float mx = row16_max(scr);
  float ex = __expf(scr - mx);
  float sm = row16_sum(ex);
  return ex / sm;
}
DEV float gelu_exact(float x) { return 0.5f * x * (1.f + erff(x * 0.7071067811865476f)); }

DEV void ph_peer(const P& p, int layer) {
  const int gw = (bid_() * 256 + tid_()) >> 6, nw = gridDim.x * 4, lane = tid_() & 63;
#pragma unroll 1
  for (int row = gw; row < NTOK; row += nw) {
    const float* tk = p.TK + (size_t)row * 256;
    float scr0 = 0.f, scr1 = 0.f;
    int er0 = 0, er1 = 0;
    peer_select4(tk, 0, lane, scr0, er0);
    peer_select4(tk, 4, lane, scr1, er1);
    const float gate0 = peer_gate(scr0), gate1 = peer_gate(scr1);
    const bf16_t* hr = p.H + (size_t)row * D;
    float hv[16];
    { uint4 u0 = *(const uint4*)(hr + 8 * lane), u1 = *(const uint4*)(hr + 512 + 8 * lane); unpack8(u0, hv); unpack8(u1, hv + 8); }
    const float wk0 = gate0 * gelu_exact(peer_udots(p, er0, hv, lane));
    const float wk1 = gate1 * gelu_exact(peer_udots(p, er1, hv, lane));
    float outv[16];
#pragma unroll
    for (int i = 0; i < 16; ++i) outv[i] = 0.f;
    peer_vacc(p, er0, wk0, outv, lane);
    peer_vacc(p, er1, wk1, outv, lane);
    int b = row / LT, pp = row % LT;
    int mr = pp < LC ? 16 : b;
    const float* g2 = p.modv + ((size_t)layer * 17 + mr) * 6144 + 5120;
    bf16_t* xr = p.X + (size_t)row * D;
    float xv[16];
    { uint4 u0 = *(const uint4*)(xr + 8 * lane), u1 = *(const uint4*)(xr + 512 + 8 * lane); unpack8(u0, xv); unpack8(u1, xv + 8); }
#pragma unroll
    for (int hh = 0; hh < 2; ++hh)
#pragma unroll
      for (int i = 0; i < 8; ++i) xv[hh * 8 + i] += g2[hh * 512 + 8 * lane + i] * outv[hh * 8 + i];
#if EN_PEER
    *(uint4*)(xr + 8 * lane) = pack8(xv);
    *(uint4*)(xr + 512 + 8 * lane) = pack8(xv + 8);
#endif
  }
}

DEV void ph_final(const P& p) {
  const int gw = (bid_() * 256 + tid_()) >> 6, nw = gridDim.x * 4, lane = tid_() & 63;
  for (int r = gw; r < NB * T; r += nw) {
    int b = r / T, t = r % T;
    const bf16_t* xr = p.X + ((size_t)b * LT + LC + t) * D;
    uint4 u0 = *(const uint4*)(xr + 8 * lane), u1 = *(const uint4*)(xr + 512 + 8 * lane);
    float v[16];
    unpack8(u0, v); unpack8(u1, v + 8);
    float ss = 0.f;
#pragma unroll
    for (int i = 0; i < 16; ++i) ss += v[i] * v[i];
    ss = wave_sum(ss);
    float rstd = rsqrtf(ss * (1.f / 1024.f) + 1e-6f);
    float* o = p.out + (size_t)r * D;
#pragma unroll
    for (int hh = 0; hh < 2; ++hh) {
      int col = hh * 512 + 8 * lane;
      float4 a = make_float4(v[hh * 8 + 0] * rstd * p.final_g[col + 0], v[hh * 8 + 1] * rstd * p.final_g[col + 1], v[hh * 8 + 2] * rstd * p.final_g[col + 2], v[hh * 8 + 3] * rstd * p.final_g[col + 3]);
      float4 c = make_float4(v[hh * 8 + 4] * rstd * p.final_g[col + 4], v[hh * 8 + 5] * rstd * p.final_g[col + 5], v[hh * 8 + 6] * rstd * p.final_g[col + 6], v[hh * 8 + 7] * rstd * p.final_g[col + 7]);
      *(float4*)(o + col) = a; *(float4*)(o + col + 4) = c;
    }
  }
}

DEV void mixB(const P& p, int layer, char* smem) {
  if (gridDim.x >= 256) {
    if (bid_() < 128) { scan_unit(p, layer, bid_(), smem); return; }
    const int nb = gridDim.x - 128;
    for (int u = bid_() - 128; u < 8704; u += nb) {
      if (u < 4352) hyena_conv_unit(p, layer, u, smem); else attn_unit(p, layer, u - 4352, smem);
    }
  } else {
    for (int u = bid_(); u < 128 + 8704; u += gridDim.x) {
      if (u < 128) scan_unit(p, layer, u, smem);
      else if (u < 128 + 4352) hyena_conv_unit(p, layer, u - 128, smem);
      else attn_unit(p, layer, u - 128 - 4352, smem);
    }
  }
}
DEV void mixA(const P& p, int layer, char* smem) {
  for (int u = bid_(); u < 1088 + 5440; u += gridDim.x) {
    if (u < 1088) hyena_pre_unit(p, layer, u); else lora_unit(p, layer, u - 1088, smem);
  }
  ph_rwkv_prep(p, layer);
}
DEV void mixC(const P& p, int layer, char* smem) {
  for (int u = bid_(); u < 1088; u += gridDim.x) hyena_post_unit(p, layer, u, smem);
  ph_rwkv_post(p, layer);
  ph_attn_post(p, layer);
}

__global__ void __launch_bounds__(256, 2) k_mega(P p) {
  __shared__ __attribute__((aligned(16))) char smem_all[SMEM_BYTES + 16];
  char* smem = smem_all;
  volatile LAS unsigned* xbw = (volatile LAS unsigned*)(smem_all + SMEM_BYTES);
  if (threadIdx.x == 0) { xbw[0] = 0u; xbw[1] = 0u; xbw[2] = 0u; xbw[3] = 0u; }
  __syncthreads();
  XcdBarrier bar = xcd_barrier_post(p.bar, xbw);
#ifndef NO_PRO
  ph_copy(p);
  ph_rope(p);
  for (int u = blockIdx.x; u < 96; u += gridDim.x) modv_unit(p, u, smem);
#endif
#ifndef NO_PREP
  ph_prep(p, 0, smem);
#endif
  xcd_barrier(bar);
  for (int layer = 0; layer < NLAYERS; ++layer) {
#ifndef NO_NORM
    ph_norm(p, layer, 0);
#endif
    xcd_barrier(bar);
#ifndef NO_GEMM1
    ph_gemm1(p, smem);
#endif
    xcd_barrier(bar);
#ifndef NO_MIXA
    mixA(p, layer, smem);
#endif
    xcd_barrier(bar);
#ifndef NO_MIXB
    mixB(p, layer, smem);
#endif
    xcd_barrier(bar);
#ifndef NO_MIXC
    mixC(p, layer, smem);
#endif
    xcd_barrier(bar);
#ifndef NO_GEMM2
    ph_gemm2(p, layer, smem);
    ph_peerconv(p, layer);
#endif
    xcd_barrier(bar);
#ifndef NO_NORM
    ph_norm(p, layer, 1);
#endif
    xcd_barrier(bar);
#ifndef NO_GEMM3
    ph_gemm3(p, smem);
#endif
    xcd_barrier(bar);
#ifndef NO_PEER
    ph_peer(p, layer);
#endif
#ifndef NO_PREP
    if (layer + 1 < NLAYERS) ph_prep(p, layer + 1, smem);
#endif
    xcd_barrier(bar);
  }
  ph_final(p);
}

enum { K_PRO = 0, K_PREP, K_NORM1, K_GEMM1, K_MIX_A, K_MIX_B, K_MIX_C, K_GEMM2, K_NORM2, K_GEMM3, K_PEER, K_FINAL };

template <int PH>
__global__ void __launch_bounds__(256, 2) k_phase(P p, int layer) {
  __shared__ __attribute__((aligned(16))) char smem[SMEM_BYTES];
  if constexpr (PH == K_PRO) {
    ph_copy(p);
    ph_rope(p);
    for (int u = blockIdx.x; u < 96; u += gridDim.x) modv_unit(p, u, smem);
  } else if constexpr (PH == K_PREP) {
    ph_prep(p, layer, smem);
  } else if constexpr (PH == K_NORM1) {
    ph_norm(p, layer, 0);
  } else if constexpr (PH == K_GEMM1) {
    ph_gemm1(p, smem);
  } else if constexpr (PH == K_MIX_A) {
    mixA(p, layer, smem);
  } else if constexpr (PH == K_MIX_B) {
    mixB(p, layer, smem);
  } else if constexpr (PH == K_MIX_C) {
    mixC(p, layer, smem);
  } else if constexpr (PH == K_GEMM2) {
    ph_gemm2(p, layer, smem);
    ph_peerconv(p, layer);
  } else if constexpr (PH == K_NORM2) {
    ph_norm(p, layer, 1);
  } else if constexpr (PH == K_GEMM3) {
    ph_gemm3(p, smem);
  } else if constexpr (PH == K_PEER) {
    ph_peer(p, layer);
  } else if constexpr (PH == K_FINAL) {
    ph_final(p);
  }
}

static inline size_t al256(size_t x) { return (x + 255) & ~(size_t)255; }

extern "C" void kernel_launch(void* const* d_in, const int* in_sizes, int n_in, void* d_out, int out_size, void* d_ws, size_t ws_size,
                              hipStream_t stream) {
  (void)in_sizes; (void)n_in; (void)out_size; (void)ws_size;
  P p{};
  const float** f = (const float**)&p;
  for (int i = 0; i < 39; ++i) f[i] = (const float*)d_in[i];
  p.out = (float*)d_out;
  char* w = (char*)d_ws;
  size_t off = 0;
  auto take = [&](size_t bytes) { char* r = w + off; off += al256(bytes); return r; };
  p.bar = (unsigned*)take(16384);
  p.modv = (float*)take((size_t)DEPTH * 17 * 6144 * 4);
  p.SSQ = (float*)take((size_t)DEPTH * 2 * 256 * 4);
  const size_t zero_bytes = off;
  p.rope = (float*)take(64 * 16 * 2 * 4);
  p.X = (bf16_t*)take((size_t)NTOK * D * 2);
  p.H = (bf16_t*)take((size_t)NTOK * D * 2);
  p.Y = (bf16_t*)take((size_t)NTOK * D * 2);
  p.SC = (bf16_t*)take((size_t)NTOK * 1024 * 2);
  p.Z = (bf16_t*)take((size_t)NTOK * INW * 2);
  p.UTl = (bf16_t*)take((size_t)256 * 16 * T * 2);
  p.UTc = (bf16_t*)take((size_t)256 * 16 * LC * 2);
  p.YTl = (bf16_t*)take((size_t)256 * 16 * T * 2);
  p.YTc = (bf16_t*)take((size_t)256 * 16 * LC * 2);
  p.FL = (float*)take((size_t)256 * 2 * T * 4);
  p.FC = (float*)take((size_t)256 * 2 * LC * 4);
  p.W1t = (bf16_t*)take((size_t)INW * D * 2);
  p.W2t = (bf16_t*)take((size_t)D * D * 2);
  p.Wft = (bf16_t*)take((size_t)2048 * D * 2);
  p.Wwt = (bf16_t*)take((size_t)2 * 256 * 64 * 2);
  p.Wat = (bf16_t*)take((size_t)2 * 256 * 64 * 2);
  p.Wgt = (bf16_t*)take((size_t)256 * 128 * 2);
  p.TK = (float*)p.Z;
  p.PU = (bf16_t*)((char*)p.Z + al256((size_t)NTOK * 256 * 4));
  p.PV = p.PU + (size_t)16384 * 1024;

  (void)hipMemsetAsync(d_ws, 0, zero_bytes, stream);
#ifndef MK_MULTI
  static int grid = 0;
  if (!grid) {
    int dev = 0, cus = 0, per_cu = 0;
    (void)hipGetDevice(&dev);
    (void)hipDeviceGetAttribute(&cus, hipDeviceAttributeMultiprocessorCount, dev);
    (void)hipOccupancyMaxActiveBlocksPerMultiprocessor(&per_cu, k_mega, 256, 0);
    if (cus <= 0) cus = 256;
    if (per_cu > 2) per_cu = 2;
    if (per_cu < 1) per_cu = 1;
    grid = cus * per_cu;
  }
  k_mega<<<grid, 256, 0, stream>>>(p);
  return;
#endif
  const int G = 1024;
  k_phase<K_PRO><<<G, 256, 0, stream>>>(p, 0);
  for (int l = 0; l < NLAYERS; ++l) {
    k_phase<K_PREP><<<G, 256, 0, stream>>>(p, l);
    k_phase<K_NORM1><<<G, 256, 0, stream>>>(p, l);
    k_phase<K_GEMM1><<<G, 256, 0, stream>>>(p, l);
    k_phase<K_MIX_A><<<G, 256, 0, stream>>>(p, l);
    k_phase<K_MIX_B><<<G, 256, 0, stream>>>(p, l);
    k_phase<K_MIX_C><<<G, 256, 0, stream>>>(p, l);
    k_phase<K_GEMM2><<<G, 256, 0, stream>>>(p, l);
    k_phase<K_NORM2><<<G, 256, 0, stream>>>(p, l);
    k_phase<K_GEMM3><<<G, 256, 0, stream>>>(p, l);
    k_phase<K_PEER><<<G, 256, 0, stream>>>(p, l);
  }
  k_phase<K_FINAL><<<G, 256, 0, stream>>>(p, 0);
}
```

```cpp
#include <hip/hip_runtime.h>
#include <stdint.h>

#define DEV __device__ __forceinline__
typedef unsigned short bf16_t;
typedef short bf16x8 __attribute__((ext_vector_type(8)));
typedef float f32x4 __attribute__((ext_vector_type(4)));
typedef float f32x16 __attribute__((ext_vector_type(16)));

#ifndef NLAYERS
#define NLAYERS 4
#endif
#ifndef EN_HY
#define EN_HY 1
#endif
#ifndef EN_RW
#define EN_RW 1
#endif
#ifndef EN_AT
#define EN_AT 1
#endif
#ifndef EN_MIX
#define EN_MIX 1
#endif
#ifndef EN_PEER
#define EN_PEER 1
#endif

constexpr int NB = 16, T = 4096, LC = 256, LT = 4352, D = 1024, NTOK = NB * LT, INW = 2688, DEPTH = 4;
constexpr int SMEM_BYTES = 49152;

struct P {
  const float *x, *c, *ctx, *c_ctx, *mod_w, *mod_b, *norm1_g, *norm2_g, *w_in, *conv_w, *conv_b;
  const float *hy_w1, *hy_b1, *hy_w2, *hy_b2, *hy_w3, *hy_b3, *hy_freq, *hy_bias;
  const float *rw_w0, *rw_w_up, *rw_a0, *rw_a_up, *rw_g_up, *rw_k_k, *rw_k_a, *rw_r_k, *rw_ln_w, *rw_ln_b;
  const float *attn_sink, *hy_out_g, *at_out_g, *w_out, *peer_wq, *peer_k1, *peer_k2, *peer_u, *peer_v, *final_g;
  float* out;
  unsigned* bar;
  float *modv, *SSQ, *rope, *FL, *FC, *TK;
  bf16_t *X, *H, *Y, *SC, *Z, *UTl, *UTc, *YTl, *YTc;
  bf16_t *W1t, *W2t, *Wft, *Wwt, *Wat, *Wgt;
  unsigned char *PU, *PV;
  float *PSU, *PSV;
};

DEV bf16_t f2bf(float f) { unsigned u = __float_as_uint(f); u += 0x7FFFu + ((u >> 16) & 1u); return (bf16_t)(u >> 16); }
DEV float bf2f(bf16_t h) { return __uint_as_float(((unsigned)h) << 16); }
DEV unsigned pack2(float a, float b) { return (unsigned)f2bf(a) | ((unsigned)f2bf(b) << 16); }
DEV float bflo(unsigned u) { return __uint_as_float(u << 16); }
DEV float bfhi(unsigned u) { return __uint_as_float(u & 0xFFFF0000u); }
DEV void unpack8(const uint4& u, float* v) {
  v[0] = bflo(u.x); v[1] = bfhi(u.x); v[2] = bflo(u.y); v[3] = bfhi(u.y);
  v[4] = bflo(u.z); v[5] = bfhi(u.z); v[6] = bflo(u.w); v[7] = bfhi(u.w);
}
DEV uint4 pack8(const float* v) { return make_uint4(pack2(v[0], v[1]), pack2(v[2], v[3]), pack2(v[4], v[5]), pack2(v[6], v[7])); }
DEV float sigmoidf_(float x) { return 1.f / (1.f + __expf(-x)); }

template <int CTRL, int ROWMASK>
DEV float dpp0(float x) {
  return __builtin_bit_cast(float, __builtin_amdgcn_update_dpp(0, __builtin_bit_cast(int, x), CTRL, ROWMASK, 0xF, false));
}
template <int CTRL, int ROWMASK>
DEV float dppself(float x) {
  int xi = __builtin_bit_cast(int, x);
  return __builtin_bit_cast(float, __builtin_amdgcn_update_dpp(xi, xi, CTRL, ROWMASK, 0xF, false));
}
DEV float readlane_f(float x, int l) { return __builtin_bit_cast(float, __builtin_amdgcn_readlane(__builtin_bit_cast(int, x), l)); }
DEV int lane_id() { return (int)__builtin_amdgcn_mbcnt_hi(~0u, __builtin_amdgcn_mbcnt_lo(~0u, 0u)); }
DEV float writelane_f(float val, int l, float old) { return lane_id() == l ? val : old; }
DEV int writelane_i(int val, int l, int old) { return lane_id() == l ? val : old; }
DEV float wave_sum(float x) {
  x += dpp0<0x111, 0xF>(x); x += dpp0<0x112, 0xF>(x); x += dpp0<0x114, 0xF>(x); x += dpp0<0x118, 0xF>(x);
  x += dpp0<0x142, 0xA>(x); x += dpp0<0x143, 0xC>(x);
  return readlane_f(x, 63);
}
DEV float wave_max(float x) {
  x = fmaxf(x, dppself<0x111, 0xF>(x)); x = fmaxf(x, dppself<0x112, 0xF>(x)); x = fmaxf(x, dppself<0x114, 0xF>(x));
  x = fmaxf(x, dppself<0x118, 0xF>(x)); x = fmaxf(x, dppself<0x142, 0xA>(x)); x = fmaxf(x, dppself<0x143, 0xC>(x));
  return readlane_f(x, 63);
}
DEV float row16_sum(float x) {
  x += dpp0<0xB1, 0xF>(x); x += dpp0<0x4E, 0xF>(x); x += dpp0<0x141, 0xF>(x); x += dpp0<0x140, 0xF>(x);
  return x;
}
DEV float row16_max(float x) {
  x = fmaxf(x, dppself<0xB1, 0xF>(x)); x = fmaxf(x, dppself<0x4E, 0xF>(x)); x = fmaxf(x, dppself<0x141, 0xF>(x));
  x = fmaxf(x, dppself<0x140, 0xF>(x));
  return x;
}
DEV float quad_sum(float x) { x += dpp0<0xB1, 0xF>(x); x += dpp0<0x4E, 0xF>(x); return x; }

DEV f32x4 mfma16(bf16x8 a, bf16x8 b, f32x4 c) { return __builtin_amdgcn_mfma_f32_16x16x32_bf16(a, b, c, 0, 0, 0); }
DEV f32x16 mfma32(bf16x8 a, bf16x8 b, f32x16 c) { return __builtin_amdgcn_mfma_f32_32x32x16_bf16(a, b, c, 0, 0, 0); }


#define XB_TMO      128
#define XB_XCNT(j)  (256  + 64 * (j))
#define XB_XSUB(j)  (1280 + 64 * (j))
#define XB_XGEN(j)  (2304 + 64 * (j))
#define XB_TOP      3328
#define XB_TOPGEN   3392
#define XCD_BAR_WORDS 3456
#define XB_SPIN_CAP (1u << 23)
#define LAS __attribute__((address_space(3)))

__device__ __forceinline__ unsigned xb_ld(unsigned* p)              { return __hip_atomic_load(p, __ATOMIC_RELAXED, __HIP_MEMORY_SCOPE_AGENT); }
__device__ __forceinline__ unsigned xb_add(unsigned* p, unsigned v) { return __hip_atomic_fetch_add(p, v, __ATOMIC_RELAXED, __HIP_MEMORY_SCOPE_AGENT); }
__device__ __forceinline__ unsigned xb_xcc_id() { return (unsigned)__builtin_amdgcn_s_getreg((3 << 11) | 20) & 0xFu; }
#define XB_SPIN(cond, bar) do { unsigned _sp = 0; while (cond) { __builtin_amdgcn_s_sleep(1); \
    if ((++_sp & 255u) == 0u) { if (xb_ld(&(bar)[XB_TMO])) break; if (_sp > XB_SPIN_CAP) { atomicAdd(&(bar)[XB_TMO], 1u); break; } } } } while (0)

struct XcdBarrier {
    unsigned* bar; unsigned x;
    volatile LAS unsigned* st;
};
__device__ __forceinline__ XcdBarrier xcd_barrier_post(unsigned* bar, volatile LAS unsigned* st) {
    XcdBarrier b; b.bar = bar; b.x = xb_xcc_id(); b.st = st;
    if (threadIdx.x == 0) (void)xb_add(&bar[XB_XCNT(b.x)], 1u);
    return b;
}
__device__ __forceinline__ void xcd_barrier_complete(unsigned* bar, unsigned x, unsigned& nloc, unsigned& nx) {
    const unsigned G = gridDim.x * gridDim.y * gridDim.z;
    unsigned sum, cnt, mine, sp = 0u;
    for (;;) {
        sum = 0u; cnt = 0u; mine = 0u;
#pragma unroll
        for (unsigned j = 0; j < 16; ++j) { const unsigned c = xb_ld(&bar[XB_XCNT(j)]); sum += c; cnt += (c > 0u) ? 1u : 0u; mine = (j == x) ? c : mine; }
        if (sum == G) break;
        __builtin_amdgcn_s_sleep(1);
        if ((++sp & 255u) == 0u) { if (xb_ld(&bar[XB_TMO])) break; if (sp > XB_SPIN_CAP) { atomicAdd(&bar[XB_TMO], 1u); break; } }
    }
    nloc = mine > 0u ? mine : 1u; nx = cnt > 0u ? cnt : 1u;
}
__device__ __forceinline__ void xcd_barrier(const XcdBarrier& b) {
    asm volatile("s_waitcnt vmcnt(0)" ::: "memory");
    __syncthreads();
    if (threadIdx.x == 0) {
        unsigned* bar = b.bar;
        __builtin_amdgcn_s_waitcnt(0);
        unsigned nloc = b.st[0], nx = b.st[1];
        if (nloc == 0u) { xcd_barrier_complete(bar, b.x, nloc, nx); b.st[0] = nloc; b.st[1] = nx; }
        const unsigned old = xb_add(&bar[XB_XSUB(b.x)], 1u);
        const unsigned gen = old / nloc;
        if (old + 1u == (gen + 1u) * nloc) {
            __builtin_amdgcn_fence(__ATOMIC_RELEASE, "agent");
            asm volatile("s_waitcnt vmcnt(0)" ::: "memory");
            const unsigned og = xb_add(&bar[XB_TOP], 1u);
            const unsigned tg = og / nx;
            if (og + 1u == (tg + 1u) * nx) xb_add(&bar[XB_TOPGEN], 1u);
            else XB_SPIN(xb_ld(&bar[XB_TOPGEN]) == tg, bar);
            __builtin_amdgcn_fence(__ATOMIC_ACQUIRE, "agent");
            xb_add(&bar[XB_XGEN(b.x)], 1u);
            asm volatile("s_waitcnt vmcnt(0)" ::: "memory");
        } else {
            XB_SPIN(xb_ld(&bar[XB_XGEN(b.x)]) == gen, bar);
            __builtin_amdgcn_fence(__ATOMIC_ACQUIRE, "agent");
            asm volatile("s_waitcnt vmcnt(0)" ::: "memory");
        }
    }
    __syncthreads();
}

template <class Tp> DEV Tp* opq(Tp* q) { asm volatile("" : "+s"(q)); return q; }
DEV int tid_() { int t = threadIdx.x; asm volatile("" : "+v"(t)); return t; }
DEV int bid_() { int b = blockIdx.x; asm volatile("" : "+s"(b)); return b; }

template <class Epi>
DEV void gemm_tile(const bf16_t* __restrict__ A, int lda, const bf16_t* __restrict__ Bt, int ldb, int K, char* smem, Epi& epi) {
  typedef bf16_t Tile[128][40];
  Tile* As = (Tile*)smem;
  Tile* Bs = (Tile*)(smem + 20480);
  const int tid = tid_(), lane = tid & 63, wid = tid >> 6, wr = wid >> 1, wc = wid & 1, fr = lane & 15, fq = lane >> 4;
  f32x4 acc[4][4];
#pragma unroll
  for (int m = 0; m < 4; ++m)
#pragma unroll
    for (int n = 0; n < 4; ++n) acc[m][n] = (f32x4){0.f, 0.f, 0.f, 0.f};
  const int r0 = tid >> 2, sg = tid & 3;
  const bf16_t* a0 = A + (size_t)r0 * lda + sg * 8;
  const bf16_t* a1 = a0 + (size_t)64 * lda;
  const bf16_t* b0 = Bt + (size_t)r0 * ldb + sg * 8;
  const bf16_t* b1 = b0 + (size_t)64 * ldb;
  uint4 ra0 = *(const uint4*)a0, ra1 = *(const uint4*)a1, rb0 = *(const uint4*)b0, rb1 = *(const uint4*)b1;
  __syncthreads();
  *(uint4*)&As[0][r0][sg * 8] = ra0; *(uint4*)&As[0][r0 + 64][sg * 8] = ra1;
  *(uint4*)&Bs[0][r0][sg * 8] = rb0; *(uint4*)&Bs[0][r0 + 64][sg * 8] = rb1;
  __syncthreads();
  const int nk = K >> 5;
  for (int kt = 0; kt < nk; ++kt) {
    const int cur = kt & 1;
    if (kt + 1 < nk) {
      const int ko = (kt + 1) * 32;
      ra0 = *(const uint4*)(a0 + ko); ra1 = *(const uint4*)(a1 + ko);
      rb0 = *(const uint4*)(b0 + ko); rb1 = *(const uint4*)(b1 + ko);
    }
    bf16x8 af[4], bfr[4];
#pragma unroll
    for (int m = 0; m < 4; ++m) af[m] = *(const bf16x8*)&As[cur][wr * 64 + m * 16 + fr][fq * 8];
#pragma unroll
    for (int n = 0; n < 4; ++n) bfr[n] = *(const bf16x8*)&Bs[cur][wc * 64 + n * 16 + fr][fq * 8];
#pragma unroll
    for (int m = 0; m < 4; ++m)
#pragma unroll
      for (int n = 0; n < 4; ++n) acc[m][n] = mfma16(af[m], bfr[n], acc[m][n]);
    if (kt + 1 < nk) {
      *(uint4*)&As[cur ^ 1][r0][sg * 8] = ra0; *(uint4*)&As[cur ^ 1][r0 + 64][sg * 8] = ra1;
      *(uint4*)&Bs[cur ^ 1][r0][sg * 8] = rb0; *(uint4*)&Bs[cur ^ 1][r0 + 64][sg * 8] = rb1;
    }
    __syncthreads();
  }
  epi(acc, wr, wc, fr, fq, smem);
}

DEV void ph_copy(const P& p) {
  const size_t n8 = (size_t)NTOK * D / 8;
  const float* pctx = opq(p.ctx); const float* px = opq(p.x);
  for (size_t i = (size_t)bid_() * 256 + tid_(); i < n8; i += (size_t)gridDim.x * 256) {
    size_t e = i * 8;
    int row = (int)(e / D), col = (int)(e % D);
    int b = row / LT, pp = row % LT;
    const float* src = pp < LC ? pctx + ((size_t)(b * LC + pp)) * D + col : px + ((size_t)(b * T + pp - LC)) * D + col;
    float4 v0 = *(const float4*)src, v1 = *(const float4*)(src + 4);
    uint4 o = make_uint4(pack2(v0.x, v0.y), pack2(v0.z, v0.w), pack2(v1.x, v1.y), pack2(v1.z, v1.w));
    *(uint4*)(p.X + e) = o;
  }
}

DEV void ph_rope(const P& p) {
  for (int i = bid_() * 256 + tid_(); i < 64 * 16; i += gridDim.x * 256) {
    int pos = i >> 4, k = i & 15;
    float inv = powf(10000.f, -(float)k / 16.f);
    float ang = (float)pos * inv;
    p.rope[2 * i] = cosf(ang); p.rope[2 * i + 1] = sinf(ang);
  }
}

DEV void modv_unit(const P& p, int unit, char* smem) {
  const int cc = unit % 24, layer = unit / 24;
  float (*cs)[128] = (float (*)[128])smem;
  const int col = cc * 256 + tid_();
  const float* pc = opq(p.c); const float* pcc = opq(p.c_ctx);
  float acc[17];
#pragma unroll
  for (int r = 0; r < 17; ++r) acc[r] = 0.f;
  for (int ks = 0; ks < 8; ++ks) {
    __syncthreads();
    for (int i = tid_(); i < 17 * 128; i += 256) {
      int r = i >> 7, e = i & 127;
      float v = r < 16 ? pc[r * D + ks * 128 + e] : pcc[ks * 128 + e];
      cs[r][e] = v / (1.f + expf(-v));
    }
    __syncthreads();
    const float* w = p.mod_w + ((size_t)layer * D + ks * 128) * 6144 + col;
#pragma unroll 4
    for (int e = 0; e < 128; ++e) {
      float wv = w[(size_t)e * 6144];
#pragma unroll
      for (int r = 0; r < 17; ++r) acc[r] += cs[r][e] * wv;
    }
  }
  const float bias = p.mod_b[layer * 6144 + col];
#pragma unroll
  for (int r = 0; r < 17; ++r) p.modv[((size_t)layer * 17 + r) * 6144 + col] = acc[r] + bias;
}

DEV void transpose_unit(const float* __restrict__ src, bf16_t* __restrict__ dst, int R, int C, int tile, char* smem) {
  float (*t)[65] = (float (*)[65])smem;
  const int nct = C / 64;
  const int tr = tile / nct, tc = tile % nct;
  __syncthreads();
  for (int i = tid_(); i < 4096; i += 256) { int r = i >> 6, c = i & 63; t[r][c] = src[(size_t)(tr * 64 + r) * C + tc * 64 + c]; }
  __syncthreads();
  for (int i = tid_(); i < 4096; i += 256) { int c = i >> 6, r = i & 63; dst[(size_t)(tc * 64 + c) * R + tr * 64 + r] = f2bf(t[r][c]); }
}

DEV void wfold_unit(const P& p, int layer, int unit, char* smem) {
  const int hs = unit >> 5, ec = unit & 31, h = hs >> 1, s = hs & 1;
  const float* wq = p.peer_wq + (size_t)layer * D * 2048;
  const float* kk = (s ? opq(p.peer_k2) : opq(p.peer_k1)) + ((size_t)layer * 8 + h) * 128 * 128;
  float (*kS)[65] = (float (*)[65])smem;
  float (*wS)[64] = (float (*)[64])(smem + 33280);
  const int key = tid_() & 127, eh = tid_() >> 7;
  float acc[16];
#pragma unroll
  for (int i = 0; i < 16; ++i) acc[i] = 0.f;
  for (int dh = 0; dh < 2; ++dh) {
    __syncthreads();
    for (int i = tid_(); i < 128 * 64; i += 256) { int k2 = i >> 6, d = i & 63; kS[k2][d] = kk[k2 * 128 + dh * 64 + d]; }
    for (int i = tid_(); i < 32 * 64; i += 256) {
      int e = i >> 6, d = i & 63;
      wS[e][d] = wq[(size_t)(ec * 32 + e) * 2048 + h * 256 + s * 128 + dh * 64 + d];
    }
    __syncthreads();
#pragma unroll 2
    for (int d = 0; d < 64; ++d) {
      float kv = kS[key][d];
#pragma unroll
      for (int i = 0; i < 16; ++i) acc[i] += kv * wS[eh * 16 + i][d];
    }
  }
  bf16_t* dst = p.Wft + ((size_t)(hs * 128 + key)) * D + ec * 32 + eh * 16;
#pragma unroll
  for (int i = 0; i < 16; i += 2) *(unsigned*)(dst + i) = pack2(acc[i], acc[i + 1]);
}

DEV void filt_unit(const P& p, int layer, int unit, char* smem) {
  int kind, j0, L;
  if (unit < 1024) { kind = 0; j0 = unit * 4; L = T; } else { kind = 1; j0 = (unit - 1024) * 4; L = LC; }
  float* zs = (float*)smem;
  float* h1 = zs + 4 * 36;
  float* h2 = h1 + 256;
  const int jj = tid_() >> 6, o = tid_() & 63;
  const int j = j0 + jj;
  const float fj = (float)j;
  const float t = fj / (float)(L - 1);
  __syncthreads();
  if (o < 33) {
    float z;
    if (o == 0) z = t;
    else {
      int i = (o - 1) & 15;
      float band = 1e-4f + (float)i * ((15.0f - 1e-4f) / 15.0f);
      float ang = 6.283185307179586f * fj * band / (float)L;
      z = (o <= 16) ? cosf(ang) : -sinf(ang);
    }
    zs[jj * 36 + o] = z;
  }
  __syncthreads();
  {
    const float* w1 = p.hy_w1 + layer * 33 * 64;
    float a = p.hy_b1[layer * 64 + o];
#pragma unroll 3
    for (int i = 0; i < 33; ++i) a += zs[jj * 36 + i] * w1[i * 64 + o];
    h1[jj * 64 + o] = sinf(p.hy_freq[layer * 128 + o] * a);
  }
  __syncthreads();
  {
    const float* w2 = p.hy_w2 + layer * 64 * 64;
    float a = p.hy_b2[layer * 64 + o];
#pragma unroll 4
    for (int i = 0; i < 64; ++i) a += h1[jj * 64 + i] * w2[i * 64 + o];
    h2[jj * 64 + o] = sinf(p.hy_freq[layer * 128 + 64 + o] * a);
  }
  __syncthreads();
  const float* w3 = p.hy_w3 + layer * 64 * 512;
  float* F = kind ? opq(p.FC) : opq(p.FL);
  const float DMIN = -3.0701134573253945f, DMAX = -15.350567286626973f;
#pragma unroll 1
  for (int m = 0; m < 4; ++m) {
    int c = o + 64 * m;
    float af = p.hy_b3[layer * 512 + c], ab = p.hy_b3[layer * 512 + 256 + c];
#pragma unroll 4
    for (int i = 0; i < 64; ++i) { float hv = h2[jj * 64 + i]; af += hv * w3[i * 512 + c]; ab += hv * w3[i * 512 + 256 + c]; }
    float delta = fabsf(DMIN + (float)c * ((DMAX - DMIN) / 255.f));
    float win = expf(-t * delta) + 0.05f;
    af *= win; ab *= win;
    F[((size_t)c * 2 + 0) * L + j] = af;
    F[((size_t)c * 2 + 1) * L + j] = ab;
  }
}

constexpr int PREP_T0 = 672, PREP_T1 = PREP_T0 + 256, PREP_T2 = PREP_T1 + 8, PREP_T3 = PREP_T2 + 8, PREP_T4 = PREP_T3 + 8;
constexpr int PREP_WF = PREP_T4 + 512, PREP_N = PREP_WF + 1088;
DEV void ph_prep(const P& p, int layer, char* smem) {
  for (int u = bid_(); u < PREP_N; u += gridDim.x) {
    if (u < PREP_T0) transpose_unit(p.w_in + (size_t)layer * D * INW, p.W1t, D, INW, u, smem);
    else if (u < PREP_T1) transpose_unit(p.w_out + (size_t)layer * D * D, p.W2t, D, D, u - PREP_T0, smem);
    else if (u < PREP_T2) { int q = u - PREP_T1, d = q >> 2; transpose_unit(p.rw_w_up + ((size_t)layer * 2 + d) * 64 * 256, p.Wwt + d * 256 * 64, 64, 256, q & 3, smem); }
    else if (u < PREP_T3) { int q = u - PREP_T2, d = q >> 2; transpose_unit(p.rw_a_up + ((size_t)layer * 2 + d) * 64 * 256, p.Wat + d * 256 * 64, 64, 256, q & 3, smem); }
    else if (u < PREP_T4) transpose_unit(p.rw_g_up + (size_t)layer * 128 * 256, p.Wgt, 128, 256, u - PREP_T3, smem);
    else if (u < PREP_WF) wfold_unit(p, layer, u - PREP_T4, smem);
    else filt_unit(p, layer, u - PREP_WF, smem);
  }
}

DEV void ph_norm(const P& p, int layer, int which) {
  const int gw = (bid_() * 256 + tid_()) >> 6, nw = gridDim.x * 4, lane = tid_() & 63;
  const float* g = (which ? p.norm2_g : p.norm1_g) + layer * D;
  for (int row = gw; row < NTOK; row += nw) {
    int b = row / LT, pp = row % LT;
    int mr = pp < LC ? 16 : b;
    const float* mv = p.modv + ((size_t)layer * 17 + mr) * 6144 + (which ? 3072 : 0);
    const bf16_t* xr = p.X + (size_t)row * D;
    uint4 u0 = *(const uint4*)(xr + 8 * lane), u1 = *(const uint4*)(xr + 512 + 8 * lane);
    float v[16];
    unpack8(u0, v); unpack8(u1, v + 8);
    float ss = 0.f;
#pragma unroll
    for (int i = 0; i < 16; ++i) ss += v[i] * v[i];
    ss = wave_sum(ss);
    float rstd = rsqrtf(ss * (1.f / 1024.f) + 1e-6f);
    float o[16];
#pragma unroll
    for (int hh = 0; hh < 2; ++hh)
#pragma unroll
      for (int i = 0; i < 8; ++i) {
        int col = hh * 512 + 8 * lane + i;
        float y = v[hh * 8 + i] * rstd * g[col];
        o[hh * 8 + i] = y * (1.f + mv[1024 + col]) + mv[col];
      }
    bf16_t* hr = p.H + (size_t)row * D;
    *(uint4*)(hr + 8 * lane) = pack8(o);
    *(uint4*)(hr + 512 + 8 * lane) = pack8(o + 8);
  }
}

struct Epi1 {
  const P& p; int row0, col0;
  DEV void operator()(f32x4 (&acc)[4][4], int wr, int wc, int fr, int fq, char*) const {
    const int cw = col0 + wc * 64;
    const int rbase = row0 + wr * 64;
    const bool lat = (row0 % LT) >= LC;
    if (cw >= 1536 && cw < 1664) {
#pragma unroll
      for (int m = 0; m < 4; ++m)
#pragma unroll
        for (int n = 0; n < 4; ++n)
#pragma unroll
          for (int j = 0; j < 4; ++j) acc[m][n][j] = tanhf(acc[m][n][j]);
    } else if (cw >= 1792 && cw < 1920) {
#pragma unroll
      for (int m = 0; m < 4; ++m)
#pragma unroll
        for (int n = 0; n < 4; ++n)
#pragma unroll
          for (int j = 0; j < 4; ++j) acc[m][n][j] = sigmoidf_(acc[m][n][j]);
    } else if (cw >= 1920 && cw < 2560 && lat) {
#pragma unroll
      for (int m = 0; m < 4; ++m)
#pragma unroll
        for (int j = 0; j < 4; ++j) {
          int row = rbase + m * 16 + fq * 4 + j;
          int pl = (row % LT) - LC;
          int ri = pl >> 6, ci = pl & 63;
          float2 cr = *(const float2*)(p.rope + 2 * (ri * 16 + fr));
          float2 cc = *(const float2*)(p.rope + 2 * (ci * 16 + fr));
          float x1 = acc[m][0][j], x2 = acc[m][1][j];
          acc[m][0][j] = x1 * cr.x - x2 * cr.y; acc[m][1][j] = x2 * cr.x + x1 * cr.y;
          x1 = acc[m][2][j]; x2 = acc[m][3][j];
          acc[m][2][j] = x1 * cc.x - x2 * cc.y; acc[m][3][j] = x2 * cc.x + x1 * cc.y;
        }
    }
#pragma unroll
    for (int m = 0; m < 4; ++m)
#pragma unroll
      for (int j = 0; j < 4; ++j) {
        int row = rbase + m * 16 + fq * 4 + j;
        bf16_t* zr = p.Z + (size_t)row * INW + cw + fr;
#pragma unroll
        for (int n = 0; n < 4; ++n) zr[n * 16] = f2bf(acc[m][n][j]);
      }
  }
};
DEV void ph_gemm1(const P& p, char* smem) {
  const int nct = INW / 128;
  for (int u = bid_(); u < (NTOK / 128) * nct; u += gridDim.x) {
    int rt = u / nct, ct = u % nct;
    Epi1 epi{p, rt * 128, ct * 128};
    gemm_tile(p.H + (size_t)rt * 128 * D, D, p.W1t + (size_t)ct * 128 * D, D, D, smem, epi);
  }
}

struct EpiLora {
  const P& p; int layer, q, row0, col0;
  DEV void operator()(f32x4 (&acc)[4][4], int wr, int wc, int fr, int fq, char*) const {
#pragma unroll
    for (int m = 0; m < 4; ++m)
#pragma unroll
      for (int n = 0; n < 4; ++n)
#pragma unroll
        for (int j = 0; j < 4; ++j) {
          int row = row0 + wr * 64 + m * 16 + fq * 4 + j;
          int col = col0 + wc * 64 + n * 16 + fr;
          float v = acc[m][n][j];
          if (q < 2) {
            v = 0.6065306597126334f * sigmoidf_(v + p.rw_w0[(layer * 2 + q) * 256 + col]);
            p.SC[(size_t)row * 1024 + q * 256 + col] = f2bf(v);
          } else if (q < 4) {
            v = sigmoidf_(v + p.rw_a0[(layer * 2 + (q - 2)) * 256 + col]);
            p.SC[(size_t)row * 1024 + q * 256 + col] = f2bf(v);
          } else {
            p.Y[(size_t)row * D + 256 + col] = f2bf(v);
          }
        }
  }
};
DEV void lora_unit(const P& p, int layer, int unit, char* smem) {
  const int q = unit / 1088, r = unit % 1088, rt = r >> 1, ct = r & 1;
  EpiLora epi{p, layer, q, rt * 128, ct * 128};
  const bf16_t* A; const bf16_t* Bt; int K;
  if (q < 2) { A = p.Z + 1536 + 64 * q; Bt = p.Wwt + q * 256 * 64; K = 64; }
  else if (q < 4) { A = p.Z + 1664 + 64 * (q - 2); Bt = p.Wat + (q - 2) * 256 * 64; K = 64; }
  else { A = p.Z + 1792; Bt = p.Wgt; K = 128; }
  gemm_tile(A + (size_t)rt * 128 * INW, INW, Bt + (size_t)ct * 128 * K, K, K, smem, epi);
}

DEV void ph_rwkv_prep(const P& p, int layer) {
  const int gw = (bid_() * 256 + tid_()) >> 6, nw = gridDim.x * 4, lane = tid_() & 63;
  const float* cw = p.conv_w + (size_t)layer * 3 * 1536;
  const float* cb = p.conv_b + (size_t)layer * 1536;
  for (int row = gw; row < NTOK; row += nw) {
    int pp = row % LT;
    bool hasm = (pp != 0) && (pp != LC);
    bool hasp = (pp != LC - 1) && (pp != LT - 1);
    float res[3][4];
#pragma unroll
    for (int a = 0; a < 3; ++a) {
      int col = 768 + a * 256 + 4 * lane;
      const bf16_t* zc = p.Z + (size_t)row * INW + col;
      uint2 um = hasm ? *(const uint2*)(zc - INW) : make_uint2(0, 0);
      uint2 uc = *(const uint2*)zc;
      uint2 up = hasp ? *(const uint2*)(zc + INW) : make_uint2(0, 0);
      float vm[4] = {bflo(um.x), bfhi(um.x), bflo(um.y), bfhi(um.y)};
      float vc[4] = {bflo(uc.x), bfhi(uc.x), bflo(uc.y), bfhi(uc.y)};
      float vp[4] = {bflo(up.x), bfhi(up.x), bflo(up.y), bfhi(up.y)};
#pragma unroll
      for (int i = 0; i < 4; ++i) res[a][i] = cw[col + i] * vm[i] + cw[1536 + col + i] * vc[i] + cw[3072 + col + i] * vp[i] + cb[col + i];
    }
    float kk[4], ss = 0.f;
#pragma unroll
    for (int i = 0; i < 4; ++i) { kk[i] = res[1][i] * p.rw_k_k[layer * 256 + 4 * lane + i]; ss += kk[i] * kk[i]; }
    ss = row16_sum(ss);
    float rs = rsqrtf(ss + 1e-12f);
    bf16_t* hr = p.H + (size_t)row * D + 4 * lane;
#pragma unroll
    for (int a = 0; a < 3; ++a) *(uint2*)(hr + a * 256) = make_uint2(pack2(res[a][0], res[a][1]), pack2(res[a][2], res[a][3]));
    *(uint2*)(hr + 768) = make_uint2(pack2(kk[0] * rs, kk[1] * rs), pack2(kk[2] * rs, kk[3] * rs));
  }
}

struct ScanRaw { bf16_t r, k, kk, e, a, v; };
DEV void scan_unit(const P& p, int layer, int unit, char* smem) {
  const int dir = unit & 1, h = (unit >> 1) & 3, b = unit >> 3;
  const int wid = tid_() >> 6, lane = tid_() & 63;
  const int kq = lane & 3, rowl = lane >> 2, vrow = wid * 16 + rowl;
  float* st = (float*)smem + wid * 640;
  const float ka = p.rw_k_a[layer * 256 + h * 64 + lane];
  float S[16];
#pragma unroll
  for (int i = 0; i < 16; ++i) S[i] = 0.f;
  const size_t rowbase = (size_t)b * LT;
  auto posf = [&](int t) -> int { return dir == 0 ? t : (t < LC ? LC - 1 - t : LT - 1 - (t - LC)); };
  auto load4 = [&](int c, ScanRaw (&dst)[4]) {
#pragma unroll
    for (int i = 0; i < 4; ++i) {
      size_t row = rowbase + posf(c * 4 + i);
      const bf16_t* hp = p.H + row * D + h * 64;
      const bf16_t* sp = p.SC + row * 1024 + h * 64;
      dst[i].r = hp[lane]; dst[i].k = hp[256 + lane]; dst[i].v = hp[512 + vrow]; dst[i].kk = hp[768 + lane];
      dst[i].e = sp[dir * 256 + lane]; dst[i].a = sp[512 + dir * 256 + lane];
    }
  };
  auto comp4 = [&](int c, ScanRaw (&src)[4]) {
#pragma unroll
    for (int i = 0; i < 4; ++i) {
      const int t = c * 4 + i;
      float rr = bf2f(src[i].r), kr = bf2f(src[i].k), kkv = bf2f(src[i].kk), ev = bf2f(src[i].e), av = bf2f(src[i].a), vv = bf2f(src[i].v);
      float w = __expf(-ev), ap = -kkv, bp = kkv * av, kd = kr * (1.f + (av - 1.f) * ka);
      float* sb = st + (i & 1) * 320;
      sb[lane] = ap; sb[64 + lane] = w; sb[128 + lane] = bp; sb[192 + lane] = kd; sb[256 + lane] = rr;
      asm volatile("s_waitcnt lgkmcnt(0)" ::: "memory");
      float4 A4[4], W4[4], B4[4], K4[4], R4[4];
#pragma unroll
      for (int q = 0; q < 4; ++q) {
        A4[q] = *(const float4*)&sb[kq * 16 + 4 * q]; W4[q] = *(const float4*)&sb[64 + kq * 16 + 4 * q];
        B4[q] = *(const float4*)&sb[128 + kq * 16 + 4 * q]; K4[q] = *(const float4*)&sb[192 + kq * 16 + 4 * q];
        R4[q] = *(const float4*)&sb[256 + kq * 16 + 4 * q];
      }
      float s0 = 0.f, s1 = 0.f, s2 = 0.f, s3 = 0.f;
#pragma unroll
      for (int q = 0; q < 4; ++q) { s0 += S[4 * q] * A4[q].x; s1 += S[4 * q + 1] * A4[q].y; s2 += S[4 * q + 2] * A4[q].z; s3 += S[4 * q + 3] * A4[q].w; }
      float sa = quad_sum((s0 + s1) + (s2 + s3));
      float y0 = 0.f, y1 = 0.f, y2 = 0.f, y3 = 0.f;
#pragma unroll
      for (int q = 0; q < 4; ++q) {
        S[4 * q] = S[4 * q] * W4[q].x + (sa * B4[q].x + vv * K4[q].x); y0 += S[4 * q] * R4[q].x;
        S[4 * q + 1] = S[4 * q + 1] * W4[q].y + (sa * B4[q].y + vv * K4[q].y); y1 += S[4 * q + 1] * R4[q].y;
        S[4 * q + 2] = S[4 * q + 2] * W4[q].z + (sa * B4[q].z + vv * K4[q].z); y2 += S[4 * q + 2] * R4[q].z;
        S[4 * q + 3] = S[4 * q + 3] * W4[q].w + (sa * B4[q].w + vv * K4[q].w); y3 += S[4 * q + 3] * R4[q].w;
      }
      float y = quad_sum((y0 + y1) + (y2 + y3));
      if (kq == 0) p.Z[(rowbase + posf(t)) * INW + 768 + dir * 256 + h * 64 + vrow] = f2bf(y);
    }
  };
  ScanRaw A[4], B[4];
  load4(0, A);
  for (int c = 0; c < LT / 4; c += 2) {
    load4(c + 1, B);
    comp4(c, A);
    if (c + 2 < LT / 4) load4(c + 2, A);
    comp4(c + 1, B);
  }
}

DEV void ph_rwkv_post(const P& p, int layer) {
  const int gw = (bid_() * 256 + tid_()) >> 6, nw = gridDim.x * 4, lane = tid_() & 63;
  for (int row = gw; row < NTOK; row += nw) {
    const int ch = 4 * lane;
    const bf16_t* zr = p.Z + (size_t)row * INW + 768 + ch;
    uint2 y0u = *(const uint2*)zr, y1u = *(const uint2*)(zr + 256);
    float y[4] = {bflo(y0u.x) + bflo(y1u.x), bfhi(y0u.x) + bfhi(y1u.x), bflo(y0u.y) + bflo(y1u.y), bfhi(y0u.y) + bfhi(y1u.y)};
    float mu = row16_sum(y[0] + y[1] + y[2] + y[3]) * (1.f / 64.f);
    float vs = 0.f;
#pragma unroll
    for (int i = 0; i < 4; ++i) { y[i] -= mu; vs += y[i] * y[i]; }
    float var = row16_sum(vs) * (1.f / 64.f);
    float rstd = rsqrtf(var + 64e-5f);
    const bf16_t* hr = p.H + (size_t)row * D + ch;
    uint2 ru = *(const uint2*)hr, ku = *(const uint2*)(hr + 256), vu = *(const uint2*)(hr + 512);
    const bf16_t* sr = p.SC + (size_t)row * 1024 + 512 + ch;
    uint2 a0u = *(const uint2*)sr, a1u = *(const uint2*)(sr + 256);
    float r[4] = {bflo(ru.x), bfhi(ru.x), bflo(ru.y), bfhi(ru.y)};
    float k[4] = {bflo(ku.x), bfhi(ku.x), bflo(ku.y), bfhi(ku.y)};
    float v[4] = {bflo(vu.x), bfhi(vu.x), bflo(vu.y), bfhi(vu.y)};
    float a0[4] = {bflo(a0u.x), bfhi(a0u.x), bflo(a0u.y), bfhi(a0u.y)};
    float a1[4] = {bflo(a1u.x), bfhi(a1u.x), bflo(a1u.y), bfhi(a1u.y)};
    float sd = 0.f;
#pragma unroll
    for (int i = 0; i < 4; ++i) {
      float kav = p.rw_k_a[layer * 256 + ch + i], rk = p.rw_r_k[layer * 256 + ch + i];
      float kd0 = k[i] * (1.f + (a0[i] - 1.f) * kav), kd1 = k[i] * (1.f + (a1[i] - 1.f) * kav);
      sd += r[i] * (kd0 + kd1) * rk;
    }
    sd = row16_sum(sd);
    bf16_t* yr = p.Y + (size_t)row * D + 256 + ch;
    uint2 gu = *(const uint2*)yr;
    float g[4] = {bflo(gu.x), bfhi(gu.x), bflo(gu.y), bfhi(gu.y)};
    float o[4];
#pragma unroll
    for (int i = 0; i < 4; ++i) {
      float yn = y[i] * rstd * p.rw_ln_w[layer * 256 + ch + i] + p.rw_ln_b[layer * 256 + ch + i];
      o[i] = (yn + sd * v[i]) * g[i];
#if !EN_RW
      o[i] = 0.f;
#endif
    }
    *(uint2*)yr = make_uint2(pack2(o[0], o[1]), pack2(o[2], o[3]));
  }
}

DEV void hyena_pre_unit(const P& p, int layer, int unit) {
  int kind, b, t0, L;
  if (unit < 1024) { kind = 0; b = unit >> 6; t0 = (unit & 63) * 64; L = T; } else { int u = unit - 1024; kind = 1; b = u >> 2; t0 = (u & 3) * 64; L = LC; }
  const int c = tid_();
  const size_t row0 = (size_t)b * LT + (kind ? 0 : LC);
  const float* cw = p.conv_w + (size_t)layer * 3 * 1536;
  const float* cb = p.conv_b + (size_t)layer * 1536;
  const float w1a = cw[256 + c], w1b = cw[1536 + 256 + c], w1c = cw[3072 + 256 + c], b1 = cb[256 + c];
  const float w2a = cw[512 + c], w2b = cw[1536 + 512 + c], w2c = cw[3072 + 512 + c], b2 = cb[512 + c];
  auto ld = [&](int t, int col) -> float { return (t >= 0 && t < L) ? bf2f(p.Z[(row0 + t) * INW + col]) : 0.f; };
  float x1m = ld(t0 - 1, 256 + c), x1c = ld(t0, 256 + c), vm = ld(t0 - 1, 512 + c), vc = ld(t0, 512 + c);
  bf16_t* dst = (kind ? opq(p.UTc) : opq(p.UTl)) + ((size_t)c * 16 + b) * L + t0;
#pragma unroll 1
  for (int i8 = 0; i8 < 8; ++i8) {
    float uo[8];
#pragma unroll
    for (int i = 0; i < 8; ++i) {
      int t = t0 + i8 * 8 + i;
      float x1n = ld(t + 1, 256 + c), vn = ld(t + 1, 512 + c);
      float a = w1a * x1m + w1b * x1c + w1c * x1n + b1;
      float bb = w2a * vm + w2b * vc + w2c * vn + b2;
      uo[i] = a * bb;
      x1m = x1c; x1c = x1n; vm = vc; vc = vn;
    }
    *(uint4*)(dst + 8 * i8) = pack8(uo);
  }
}

DEV void hyena_conv_unit(const P& p, int layer, int unit, char* smem) {
  int kind, c, tb, L;
  if (unit < 4096) { kind = 0; c = unit >> 4; tb = (unit & 15) * 256; L = T; } else { kind = 1; c = unit - 4096; tb = 0; L = LC; }
  const int tid = tid_(), lane = tid & 63, wid = tid >> 6, fr = lane & 15, fq = lane >> 4;
  bf16_t* Cq = (bf16_t*)smem;
  bf16_t* Us = (bf16_t*)(smem + 8320);
  const float* F = (kind ? opq(p.FC) : opq(p.FL)) + (size_t)c * 2 * L;
  float* red = (float*)(smem + 16512);
  float scale;
  {
    float part = 0.f;
    for (int i = tid; i < 2 * L; i += 256) { float fv = F[i]; part += (i != L) ? fv * fv : 0.f; }
    part = wave_sum(part);
    if (lane == 0) red[wid] = part;
    __syncthreads();
    scale = rsqrtf(((red[0] + red[1]) + (red[2] + red[3])) + 1e-6f);
  }
  const bf16_t* U = (kind ? opq(p.UTc) : opq(p.UTl)) + (size_t)c * 16 * L;
  f32x4 acc[4];
#pragma unroll
  for (int m = 0; m < 4; ++m) acc[m] = (f32x4){0.f, 0.f, 0.f, 0.f};
  const int nch = L / 256;
  for (int ch = 0; ch < nch; ++ch) {
    const int sc = ch * 256;
    const int D0 = tb + 256 - sc;
    __syncthreads();
    for (int i = tid; i < 4160; i += 256) {
      int rho = i / 520, m = i % 520;
      int n = m - rho;
      int d = D0 - n;
      float v = 0.f;
      if (n >= 0 && d > -L && d < L) v = (d >= 0 ? F[d] : F[L - d]) * scale;
      Cq[((m >> 3) * 8 + rho) * 8 + (m & 7)] = f2bf(v);
    }
    for (int i = tid; i < 512; i += 256) {
      int b = i >> 5, sgm = i & 31;
      *(uint4*)&Us[(sgm * 16 + b) * 8] = *(const uint4*)(U + (size_t)b * L + sc + 8 * sgm);
    }
    __syncthreads();
#pragma unroll
    for (int kk = 0; kk < 8; ++kk) {
      bf16x8 bf = *(const bf16x8*)&Us[((4 * kk + fq) * 16 + fr) * 8];
#pragma unroll
      for (int m = 0; m < 4; ++m) {
        int it = wid * 4 + m;
        int base = 256 - 16 * it + 32 * kk + 8 * fq;
        int m0 = base - 8 * (fr >> 3);
        bf16x8 af = *(const bf16x8*)&Cq[((m0 >> 3) * 8 + (fr & 7)) * 8];
        acc[m] = mfma16(af, bf, acc[m]);
      }
    }
  }
  bf16_t* Yt = (kind ? opq(p.YTc) : opq(p.YTl)) + ((size_t)c * 16 + fr) * L + tb;
#pragma unroll
  for (int m = 0; m < 4; ++m) {
    int t = (wid * 4 + m) * 16 + fq * 4;
    *(uint2*)(Yt + t) = make_uint2(pack2(acc[m][0], acc[m][1]), pack2(acc[m][2], acc[m][3]));
  }
}

DEV void hyena_post_unit(const P& p, int layer, int unit, char* smem) {
  int kind, b, t0, L;
  if (unit < 1024) { kind = 0; b = unit >> 6; t0 = (unit & 63) * 64; L = T; } else { int u = unit - 1024; kind = 1; b = u >> 2; t0 = (u & 3) * 64; L = LC; }
  const int c = tid_(), lane = c & 63, wid = c >> 6;
  const size_t row0 = (size_t)b * LT + (kind ? 0 : LC);
  bf16_t (*tile)[264] = (bf16_t (*)[264])smem;
  const float* cw = p.conv_w + (size_t)layer * 3 * 1536;
  const float wa = cw[c], wb = cw[1536 + c], wcc = cw[3072 + c], b0 = p.conv_b[layer * 1536 + c];
  const float bias = p.hy_bias[layer * 256 + c];
  const bf16_t* yt = (kind ? opq(p.YTc) : opq(p.YTl)) + ((size_t)c * 16 + b) * L + t0;
  const bf16_t* ut = (kind ? opq(p.UTc) : opq(p.UTl)) + ((size_t)c * 16 + b) * L + t0;
  auto ld = [&](int t) -> float { return (t >= 0 && t < L) ? bf2f(p.Z[(row0 + t) * INW + c]) : 0.f; };
  float xm = ld(t0 - 1), xc = ld(t0);
  __syncthreads();
#pragma unroll 1
  for (int i8 = 0; i8 < 8; ++i8) {
    uint4 yu = *(const uint4*)(yt + 8 * i8), uu = *(const uint4*)(ut + 8 * i8);
    float yv[8], uv[8];
    unpack8(yu, yv); unpack8(uu, uv);
#pragma unroll
    for (int i = 0; i < 8; ++i) {
      int t = t0 + i8 * 8 + i;
      float xn = ld(t + 1);
      float x0 = wa * xm + wb * xc + wcc * xn + b0;
      float o = x0 * (yv[i] + uv[i] * bias);
      tile[i8 * 8 + i][c] = f2bf(o);
      xm = xc; xc = xn;
    }
  }
  __syncthreads();
  for (int i = 0; i < 16; ++i) {
    int tl = wid * 16 + i;
    uint2 ou = *(const uint2*)&tile[tl][4 * lane];
    float o[4] = {bflo(ou.x), bfhi(ou.x), bflo(ou.y), bfhi(ou.y)};
    float ss = wave_sum(o[0] * o[0] + o[1] * o[1] + o[2] * o[2] + o[3] * o[3]);
    float rstd = rsqrtf(ss * (1.f / 256.f) + 1e-6f);
#pragma unroll
    for (int q = 0; q < 4; ++q) {
      o[q] = o[q] * rstd * p.hy_out_g[layer * 256 + 4 * lane + q];
#if !EN_HY
      o[q] = 0.f;
#endif
    }
    *(uint2*)(p.Y + (row0 + t0 + tl) * D + 4 * lane) = make_uint2(pack2(o[0], o[1]), pack2(o[2], o[3]));
  }
}

DEV void attn_unit(const P& p, int layer, int unit, char* smem) {
  const bool isctx = unit >= 4096;
  int b, qb, hq;
  if (!isctx) { b = unit >> 8; qb = (unit >> 3) & 31; hq = unit & 7; } else { int u = unit - 4096; b = u >> 4; qb = (u >> 3) & 1; hq = u & 7; }
  const int g = hq >> 2;
  const int tid = tid_(), lane = tid & 63, wid = tid >> 6, qn = lane & 31, hh = lane >> 5;
  const int qpos = qb * 128 + wid * 32 + qn;
  const size_t qrow = (size_t)b * LT + (isctx ? qpos : LC + qpos);
  const bf16_t* qptr = p.Z + qrow * INW + 1920 + hq * 64;
  bf16x8 qf[4];
#pragma unroll
  for (int s = 0; s < 4; ++s) qf[s] = *(const bf16x8*)(qptr + 16 * s + 8 * hh);
  const float sink = p.attn_sink[layer * 8 + hq];
  float m_run = sink, l_run = 1.f;
  f32x16 o0, o1;
#pragma unroll
  for (int i = 0; i < 16; ++i) { o0[i] = 0.f; o1[i] = 0.f; }
  bf16_t (*Ks)[72] = (bf16_t (*)[72])smem;
  bf16_t (*Vt)[40] = (bf16_t (*)[40])(smem + 4608);
  const int ntl = isctx ? 0 : 12;
  const int ntiles = ntl + 8;
  for (int kt = 0; kt < ntiles; ++kt) {
    const bool ctxk = kt >= ntl;
    const int kbase = ctxk ? (kt - ntl) * 32 : qb * 128 - 128 + kt * 32;
    __syncthreads();
    {
      int key = tid >> 3, seg = tid & 7;
      int kp = kbase + key;
      uint4 kv = make_uint4(0, 0, 0, 0), vv = make_uint4(0, 0, 0, 0);
      if (ctxk || (kp >= 0 && kp < T)) {
        size_t krow = (size_t)b * LT + (ctxk ? kp : LC + kp);
        const bf16_t* src = p.Z + krow * INW + 1920 + 512 + g * 64 + seg * 8;
        kv = *(const uint4*)src; vv = *(const uint4*)(src + 128);
      }
      *(uint4*)&Ks[key][seg * 8] = kv;
      Vt[seg * 8 + 0][key] = (bf16_t)(vv.x & 0xFFFF); Vt[seg * 8 + 1][key] = (bf16_t)(vv.x >> 16);
      Vt[seg * 8 + 2][key] = (bf16_t)(vv.y & 0xFFFF); Vt[seg * 8 + 3][key] = (bf16_t)(vv.y >> 16);
      Vt[seg * 8 + 4][key] = (bf16_t)(vv.z & 0xFFFF); Vt[seg * 8 + 5][key] = (bf16_t)(vv.z >> 16);
      Vt[seg * 8 + 6][key] = (bf16_t)(vv.w & 0xFFFF); Vt[seg * 8 + 7][key] = (bf16_t)(vv.w >> 16);
    }
    __syncthreads();
    bool need = true;
    if (!ctxk) {
      int q0 = qb * 128 + wid * 32;
      if (kbase + 31 < q0 - 128 || kbase > q0 + 31 + 128 || kbase + 31 < 0 || kbase >= T) need = false;
    }
    if (need) {
      f32x16 s;
#pragma unroll
      for (int i = 0; i < 16; ++i) s[i] = 0.f;
#pragma unroll
      for (int ks = 0; ks < 4; ++ks) {
        bf16x8 kf = *(const bf16x8*)&Ks[qn][16 * ks + 8 * hh];
        s = mfma32(kf, qf[ks], s);
      }
      float mt = -3e38f;
#pragma unroll
      for (int rg = 0; rg < 16; ++rg) {
        float v = s[rg] * 0.125f;
        if (!ctxk) {
          int kp = kbase + (rg & 3) + 8 * (rg >> 2) + 4 * hh;
          int dl = qpos - kp;
          bool ok = (dl <= 128) && (dl >= -128) && (kp >= 0) && (kp < T);
          v = ok ? v : -1e30f;
        }
        s[rg] = v;
        mt = fmaxf(mt, v);
      }
      mt = fmaxf(mt, __shfl_xor(mt, 32));
      float m_new = fmaxf(m_run, mt);
      float corr = __expf(m_run - m_new);
      float ps = 0.f;
#pragma unroll
      for (int rg = 0; rg < 16; ++rg) { float pv = __expf(s[rg] - m_new); s[rg] = pv; ps += pv; }
      ps += __shfl_xor(ps, 32);
      l_run = l_run * corr + ps;
      m_run = m_new;
#pragma unroll
      for (int i = 0; i < 16; ++i) { o0[i] *= corr; o1[i] *= corr; }
#pragma unroll
      for (int sp = 0; sp < 2; ++sp) {
        bf16x8 pf;
#pragma unroll
        for (int j = 0; j < 8; ++j) pf[j] = (short)f2bf(s[8 * sp + j]);
        uint2 va = *(const uint2*)&Vt[qn][16 * sp + 4 * hh], vb = *(const uint2*)&Vt[qn][16 * sp + 8 + 4 * hh];
        uint2 vc = *(const uint2*)&Vt[32 + qn][16 * sp + 4 * hh], vd = *(const uint2*)&Vt[32 + qn][16 * sp + 8 + 4 * hh];
        uint4 w0 = make_uint4(va.x, va.y, vb.x, vb.y), w1 = make_uint4(vc.x, vc.y, vd.x, vd.y);
        bf16x8 v0 = __builtin_bit_cast(bf16x8, w0), v1 = __builtin_bit_cast(bf16x8, w1);
        o0 = mfma32(v0, pf, o0);
        o1 = mfma32(v1, pf, o1);
      }
    }
  }
  const float inv = 1.f / l_run;
  bf16_t* optr = p.Y + qrow * D + 512 + hq * 64;
#pragma unroll
  for (int rg = 0; rg < 4; ++rg) {
    int d0 = 8 * rg + 4 * hh;
    *(uint2*)(optr + d0) = make_uint2(pack2(o0[4 * rg] * inv, o0[4 * rg + 1] * inv), pack2(o0[4 * rg + 2] * inv, o0[4 * rg + 3] * inv));
    *(uint2*)(optr + 32 + d0) = make_uint2(pack2(o1[4 * rg] * inv, o1[4 * rg + 1] * inv), pack2(o1[4 * rg + 2] * inv, o1[4 * rg + 3] * inv));
  }
}

DEV void ph_attn_post(const P& p, int layer) {
  const int gw = (bid_() * 256 + tid_()) >> 6, nw = gridDim.x * 4, lane = tid_() & 63;
  for (int row = gw; row < NTOK; row += nw) {
    bf16_t* yr = p.Y + (size_t)row * D + 512 + 8 * lane;
    uint4 u = *(const uint4*)yr;
    float v[8];
    unpack8(u, v);
    float ss = 0.f;
#pragma unroll
    for (int i = 0; i < 8; ++i) ss += v[i] * v[i];
    ss = wave_sum(ss);
    float rstd = rsqrtf(ss * (1.f / 512.f) + 1e-6f);
#pragma unroll
    for (int i = 0; i < 8; ++i) {
      v[i] = v[i] * rstd * p.at_out_g[layer * 512 + 8 * lane + i];
#if !EN_AT
      v[i] = 0.f;
#endif
    }
    *(uint4*)yr = pack8(v);
  }
}

struct Epi2 {
  const P& p; int layer, row0, col0;
  DEV void operator()(f32x4 (&acc)[4][4], int wr, int wc, int fr, int fq, char*) const {
    const int b = row0 / LT, pp = row0 % LT;
    const int mr = pp < LC ? 16 : b;
    const float* g1 = p.modv + ((size_t)layer * 17 + mr) * 6144 + 2048;
#pragma unroll
    for (int m = 0; m < 4; ++m)
#pragma unroll
      for (int j = 0; j < 4; ++j) {
        int row = row0 + wr * 64 + m * 16 + fq * 4 + j;
#pragma unroll
        for (int n = 0; n < 4; ++n) {
          int col = col0 + wc * 64 + n * 16 + fr;
          bf16_t* xp = p.X + (size_t)row * D + col;
          float v = bf2f(*xp) + g1[col] * acc[m][n][j];
#if EN_MIX
          *xp = f2bf(v);
#endif
        }
      }
  }
};
DEV void ph_gemm2(const P& p, int layer, char* smem) {
  for (int u = bid_(); u < (NTOK / 128) * 8; u += gridDim.x) {
    int rt = u >> 3, ct = u & 7;
    Epi2 epi{p, layer, rt * 128, ct * 128};
    gemm_tile(p.Y + (size_t)rt * 128 * D, D, p.W2t + (size_t)ct * 128 * D, D, D, smem, epi);
  }
}

typedef float f32x2 __attribute__((ext_vector_type(2)));
DEV void ph_peerconv(const P& p, int layer) {
  const int gw = (bid_() * 256 + tid_()) >> 6, nw = gridDim.x * 4, lane = tid_() & 63;
  const float* su = opq(p.peer_u) + (size_t)layer * 16384 * 1024;
  const float* sv = opq(p.peer_v) + (size_t)layer * 16384 * 1024;
  unsigned char* pu = opq(p.PU); unsigned char* pv = opq(p.PV);
  float* psu = opq(p.PSU); float* psv = opq(p.PSV);
#pragma unroll 1
  for (int r = gw; r < 32768; r += nw) {
    const bool isv = r >= 16384;
    const int e = r & 16383;
    const float* src = (isv ? sv : su) + (size_t)e * 1024 + 16 * lane;
    float4 f0 = *(const float4*)src, f1 = *(const float4*)(src + 4), f2 = *(const float4*)(src + 8), f3 = *(const float4*)(src + 12);
    float am = fmaxf(fmaxf(fmaxf(fabsf(f0.x), fabsf(f0.y)), fmaxf(fabsf(f0.z), fabsf(f0.w))), fmaxf(fmaxf(fabsf(f1.x), fabsf(f1.y)), fmaxf(fabsf(f1.z), fabsf(f1.w))));
    am = fmaxf(am, fmaxf(fmaxf(fmaxf(fabsf(f2.x), fabsf(f2.y)), fmaxf(fabsf(f2.z), fabsf(f2.w))), fmaxf(fmaxf(fabsf(f3.x), fabsf(f3.y)), fmaxf(fabsf(f3.z), fabsf(f3.w)))));
    am = wave_max(am);
    const float sc = am > 0.f ? 224.f / am : 1.f;
    int w0 = __builtin_amdgcn_cvt_pk_fp8_f32(f0.x * sc, f0.y * sc, 0, false); w0 = __builtin_amdgcn_cvt_pk_fp8_f32(f0.z * sc, f0.w * sc, w0, true);
    int w1 = __builtin_amdgcn_cvt_pk_fp8_f32(f1.x * sc, f1.y * sc, 0, false); w1 = __builtin_amdgcn_cvt_pk_fp8_f32(f1.z * sc, f1.w * sc, w1, true);
    int w2 = __builtin_amdgcn_cvt_pk_fp8_f32(f2.x * sc, f2.y * sc, 0, false); w2 = __builtin_amdgcn_cvt_pk_fp8_f32(f2.z * sc, f2.w * sc, w2, true);
    int w3 = __builtin_amdgcn_cvt_pk_fp8_f32(f3.x * sc, f3.y * sc, 0, false); w3 = __builtin_amdgcn_cvt_pk_fp8_f32(f3.z * sc, f3.w * sc, w3, true);
    *(uint4*)((isv ? pv : pu) + (size_t)e * 1024 + 16 * lane) = make_uint4((unsigned)w0, (unsigned)w1, (unsigned)w2, (unsigned)w3);
    if (lane == 0) (isv ? psv : psu)[e] = am > 0.f ? am * (1.f / 224.f) : 1.f;
  }
}
DEV void unpack16_fp8(const uint4& u, float* f) {
  f32x2 t;
  t = __builtin_amdgcn_cvt_pk_f32_fp8((int)u.x, false); f[0] = t[0]; f[1] = t[1];
  t = __builtin_amdgcn_cvt_pk_f32_fp8((int)u.x, true); f[2] = t[0]; f[3] = t[1];
  t = __builtin_amdgcn_cvt_pk_f32_fp8((int)u.y, false); f[4] = t[0]; f[5] = t[1];
  t = __builtin_amdgcn_cvt_pk_f32_fp8((int)u.y, true); f[6] = t[0]; f[7] = t[1];
  t = __builtin_amdgcn_cvt_pk_f32_fp8((int)u.z, false); f[8] = t[0]; f[9] = t[1];
  t = __builtin_amdgcn_cvt_pk_f32_fp8((int)u.z, true); f[10] = t[0]; f[11] = t[1];
  t = __builtin_amdgcn_cvt_pk_f32_fp8((int)u.w, false); f[12] = t[0]; f[13] = t[1];
  t = __builtin_amdgcn_cvt_pk_f32_fp8((int)u.w, true); f[14] = t[0]; f[15] = t[1];
}

struct Epi3 {
  const P& p; int row0, grp;
  DEV void operator()(f32x4 (&acc)[4][4], int wr, int wc, int fr, int fq, char* smem) const {
    float* sc = (float*)smem;
    const int tid = tid_();
    for (int pass = 0; pass < 2; ++pass) {
      __syncthreads();
      if (wr == pass) {
#pragma unroll
        for (int m = 0; m < 4; ++m)
#pragma unroll
          for (int n = 0; n < 4; ++n)
#pragma unroll
            for (int j = 0; j < 4; ++j) {
              int rl = m * 16 + fq * 4 + j, col = wc * 64 + n * 16 + fr;
              unsigned bits = (__float_as_uint(acc[m][n][j]) & ~127u) | (unsigned)col;
              sc[rl * 133 + (col >> 5) * 33 + (col & 31)] = __uint_as_float(bits);
            }
      }
      __syncthreads();
      const int rl = tid >> 2, q = tid & 3;
      float Ls[16];
#pragma unroll
      for (int i = 0; i < 16; ++i) Ls[i] = -3e38f;
      const float* src = sc + rl * 133 + q * 33;
      for (int i = 0; i < 32; ++i) {
        float x = src[i];
        if (x > Ls[15]) {
#pragma unroll
          for (int k = 0; k < 16; ++k) { float hi = fmaxf(Ls[k], x); x = fminf(Ls[k], x); Ls[k] = hi; }
        }
      }
      float Cs[16];
#pragma unroll
      for (int i = 0; i < 16; ++i) Cs[i] = fmaxf(Ls[i], dppself<0xB1, 0xF>(Ls[15 - i]));
#pragma unroll
      for (int d = 8; d >= 1; d >>= 1)
#pragma unroll
        for (int i = 0; i < 16; ++i)
          if ((i & d) == 0) { float hi = fmaxf(Cs[i], Cs[i + d]), lo = fminf(Cs[i], Cs[i + d]); Cs[i] = hi; Cs[i + d] = lo; }
      float Ds[16];
#pragma unroll
      for (int i = 0; i < 16; ++i) Ds[i] = fmaxf(Cs[i], dppself<0x4E, 0xF>(Cs[15 - i]));
      if (q == 0) {
        float* dst = p.TK + ((size_t)(row0 + pass * 64 + rl) * 16 + grp) * 16;
#pragma unroll
        for (int i = 0; i < 4; ++i) *(float4*)(dst + 4 * i) = make_float4(Ds[4 * i], Ds[4 * i + 1], Ds[4 * i + 2], Ds[4 * i + 3]);
      }
    }
  }
};
DEV void ph_gemm3(const P& p, char* smem) {
  for (int u = bid_(); u < (NTOK / 128) * 16; u += gridDim.x) {
    int rt = u >> 4, ct = u & 15;
    Epi3 epi{p, rt * 128, ct};
    gemm_tile(p.H + (size_t)rt * 128 * D, D, p.Wft + (size_t)ct * 128 * D, D, D, smem, epi);
  }
}

DEV void peer_select4(const float* tk, int hbase, int lane, float& scr, int& er) {
#pragma unroll 1
  for (int hq = 0; hq < 4; ++hq) {
    const int h = hbase + hq;
    const float v1 = tk[(2 * h) * 16 + (lane >> 2)];
    const float4 v2 = *(const float4*)(tk + (2 * h + 1) * 16 + 4 * (lane & 3));
    float c0 = v1 + v2.x, c1 = v1 + v2.y, c2 = v1 + v2.z, c3 = v1 + v2.w;
    const int i1 = (int)(__float_as_uint(v1) & 127u);
#pragma unroll 1
    for (int r = 0; r < 16; ++r) {
      float m = fmaxf(fmaxf(c0, c1), fmaxf(c2, c3));
      float wm = wave_max(m);
      unsigned long long bal = __ballot(m == wm);
      int wl = __ffsll((long long)bal) - 1;
      int jsel = (c0 == wm) ? 0 : (c1 == wm) ? 1 : (c2 == wm) ? 2 : 3;
      float v2sel = jsel == 0 ? v2.x : jsel == 1 ? v2.y : jsel == 2 ? v2.z : v2.w;
      int el = i1 * 128 + (int)(__float_as_uint(v2sel) & 127u);
      int ew = __builtin_amdgcn_readlane(el, wl);
      if (lane == wl) {
        if (jsel == 0) c0 = -3e38f; else if (jsel == 1) c1 = -3e38f; else if (jsel == 2) c2 = -3e38f; else c3 = -3e38f;
      }
      const int sl = hq * 16 + r;
      scr = (lane == sl) ? wm : scr;
      er = (lane == sl) ? ew : er;
    }
  }
}
DEV float peer_udots(const P& p, int er, const float* hv, int lane) {
  float dots = 0.f;
#pragma unroll 1
  for (int k16 = 0; k16 < 4; ++k16) {
    uint4 ua[16];
    float sc[16];
#pragma unroll
    for (int j = 0; j < 16; ++j) {
      int e = __builtin_amdgcn_readlane(er, k16 * 16 + j);
      ua[j] = *(const uint4*)(p.PU + (size_t)e * 1024 + 16 * lane);
      sc[j] = p.PSU[e];
    }
#pragma unroll
    for (int j = 0; j < 16; ++j) {
      float f[16];
      unpack16_fp8(ua[j], f);
      float d0 = 0.f, d1 = 0.f;
#pragma unroll
      for (int i = 0; i < 16; i += 2) { d0 += f[i] * hv[i]; d1 += f[i + 1] * hv[i + 1]; }
      float d = wave_sum(d0 + d1) * sc[j];
      dots = (lane == k16 * 16 + j) ? d : dots;
    }
  }
  return dots;
}
DEV void peer_vacc(const P& p, int er, float wk, float* outv, int lane) {
#pragma unroll 1
  for (int k16 = 0; k16 < 4; ++k16) {
    uint4 ua[16];
    float ws[16];
#pragma unroll
    for (int j = 0; j < 16; ++j) {
      int e = __builtin_amdgcn_readlane(er, k16 * 16 + j);
      ua[j] = *(const uint4*)(p.PV + (size_t)e * 1024 + 16 * lane);
      ws[j] = readlane_f(wk, k16 * 16 + j) * p.PSV[e];
    }
#pragma unroll
    for (int j = 0; j < 16; ++j) {
      float f[16];
      unpack16_fp8(ua[j], f);
#pragma unroll
      for (int i = 0; i < 16; ++i) outv[i] += ws[j] * f[i];
    }
  }
}
DEV float peer_gate(float scr) {
  float mx = row16_max(scr);
  float ex = __expf(scr - mx);
  float sm = row16_sum(ex);
  return ex / sm;
}
DEV float gelu_exact(float x) { return 0.5f * x * (1.f + erff(x * 0.7071067811865476f)); }

DEV void ph_peer(const P& p, int layer, bool dowrite = true) {
  const int gw = (bid_() * 256 + tid_()) >> 6, nw = gridDim.x * 4, lane = tid_() & 63;
#pragma unroll 1
  for (int row = gw; row < NTOK; row += nw) {
    const float* tk = p.TK + (size_t)row * 256;
    float scr0 = 0.f, scr1 = 0.f;
    int er0 = 0, er1 = 0;
    peer_select4(tk, 0, lane, scr0, er0);
    peer_select4(tk, 4, lane, scr1, er1);
    const float gate0 = peer_gate(scr0), gate1 = peer_gate(scr1);
    const bf16_t* hr = p.H + (size_t)row * D;
    float hv[16];
    { uint4 u0 = *(const uint4*)(hr + 16 * lane), u1 = *(const uint4*)(hr + 16 * lane + 8); unpack8(u0, hv); unpack8(u1, hv + 8); }
    const float wk0 = gate0 * gelu_exact(peer_udots(p, er0, hv, lane));
    const float wk1 = gate1 * gelu_exact(peer_udots(p, er1, hv, lane));
    float outv[16];
#pragma unroll
    for (int i = 0; i < 16; ++i) outv[i] = 0.f;
    peer_vacc(p, er0, wk0, outv, lane);
    peer_vacc(p, er1, wk1, outv, lane);
    int b = row / LT, pp = row % LT;
    int mr = pp < LC ? 16 : b;
    const float* g2 = p.modv + ((size_t)layer * 17 + mr) * 6144 + 5120;
    bf16_t* xr = p.X + (size_t)row * D;
    float xv[16];
    { uint4 u0 = *(const uint4*)(xr + 16 * lane), u1 = *(const uint4*)(xr + 16 * lane + 8); unpack8(u0, xv); unpack8(u1, xv + 8); }
#pragma unroll
    for (int i = 0; i < 16; ++i) xv[i] += g2[16 * lane + i] * outv[i];
#if EN_PEER
    if (dowrite) {
      *(uint4*)(xr + 16 * lane) = pack8(xv);
      *(uint4*)(xr + 16 * lane + 8) = pack8(xv + 8);
    } else {
      float tsum = 0.f;
#pragma unroll
      for (int i = 0; i < 16; ++i) tsum += xv[i];
      asm volatile("" ::"v"(tsum));
    }
#endif
  }
}

DEV void ph_final(const P& p) {
  const int gw = (bid_() * 256 + tid_()) >> 6, nw = gridDim.x * 4, lane = tid_() & 63;
  for (int r = gw; r < NB * T; r += nw) {
    int b = r / T, t = r % T;
    const bf16_t* xr = p.X + ((size_t)b * LT + LC + t) * D;
    uint4 u0 = *(const uint4*)(xr + 8 * lane), u1 = *(const uint4*)(xr + 512 + 8 * lane);
    float v[16];
    unpack8(u0, v); unpack8(u1, v + 8);
    float ss = 0.f;
#pragma unroll
    for (int i = 0; i < 16; ++i) ss += v[i] * v[i];
    ss = wave_sum(ss);
    float rstd = rsqrtf(ss * (1.f / 1024.f) + 1e-6f);
    float* o = p.out + (size_t)r * D;
#pragma unroll
    for (int hh = 0; hh < 2; ++hh) {
      int col = hh * 512 + 8 * lane;
      float4 a = make_float4(v[hh * 8 + 0] * rstd * p.final_g[col + 0], v[hh * 8 + 1] * rstd * p.final_g[col + 1], v[hh * 8 + 2] * rstd * p.final_g[col + 2], v[hh * 8 + 3] * rstd * p.final_g[col + 3]);
      float4 c = make_float4(v[hh * 8 + 4] * rstd * p.final_g[col + 4], v[hh * 8 + 5] * rstd * p.final_g[col + 5], v[hh * 8 + 6] * rstd * p.final_g[col + 6], v[hh * 8 + 7] * rstd * p.final_g[col + 7]);
      *(float4*)(o + col) = a; *(float4*)(o + col + 4) = c;
    }
  }
}

DEV void mixB(const P& p, int layer, char* smem) {
  if (gridDim.x >= 256) {
    if (bid_() < 128) { scan_unit(p, layer, bid_(), smem); return; }
    const int nb = gridDim.x - 128;
    for (int u = bid_() - 128; u < 8704; u += nb) {
      if (u < 4352) hyena_conv_unit(p, layer, u, smem); else attn_unit(p, layer, u - 4352, smem);
    }
  } else {
    for (int u = bid_(); u < 128 + 8704; u += gridDim.x) {
      if (u < 128) scan_unit(p, layer, u, smem);
      else if (u < 128 + 4352) hyena_conv_unit(p, layer, u - 128, smem);
      else attn_unit(p, layer, u - 128 - 4352, smem);
    }
  }
}
DEV void mixA(const P& p, int layer, char* smem) {
  for (int u = bid_(); u < 1088 + 5440; u += gridDim.x) {
    if (u < 1088) hyena_pre_unit(p, layer, u); else lora_unit(p, layer, u - 1088, smem);
  }
  ph_rwkv_prep(p, layer);
}
DEV void mixC(const P& p, int layer, char* smem) {
  for (int u = bid_(); u < 1088; u += gridDim.x) hyena_post_unit(p, layer, u, smem);
  ph_rwkv_post(p, layer);
  ph_attn_post(p, layer);
}

__global__ void __launch_bounds__(256, 2) k_mega(P p) {
  __shared__ __attribute__((aligned(16))) char smem_all[SMEM_BYTES + 16];
  char* smem = smem_all;
  volatile LAS unsigned* xbw = (volatile LAS unsigned*)(smem_all + SMEM_BYTES);
  if (threadIdx.x == 0) { xbw[0] = 0u; xbw[1] = 0u; xbw[2] = 0u; xbw[3] = 0u; }
  __syncthreads();
  XcdBarrier bar = xcd_barrier_post(p.bar, xbw);
#ifndef NO_PRO
  ph_copy(p);
  ph_rope(p);
  for (int u = blockIdx.x; u < 96; u += gridDim.x) modv_unit(p, u, smem);
#endif
#ifndef NO_PREP
  ph_prep(p, 0, smem);
#endif
  xcd_barrier(bar);
  for (int layer = 0; layer < NLAYERS; ++layer) {
#ifndef NO_NORM
    ph_norm(p, layer, 0);
#endif
    xcd_barrier(bar);
#ifdef PROBE_GEMM
    ph_gemm1(p, smem);
#endif
#ifndef NO_GEMM1
    ph_gemm1(p, smem);
#endif
    xcd_barrier(bar);
#ifndef NO_MIXA
    mixA(p, layer, smem);
#endif
    xcd_barrier(bar);
#ifdef PROBE_MIXB
    mixB(p, layer, smem);
#endif
#ifndef NO_MIXB
    mixB(p, layer, smem);
#endif
    xcd_barrier(bar);
#ifndef NO_MIXC
    mixC(p, layer, smem);
#endif
    xcd_barrier(bar);
#ifndef NO_GEMM2
    ph_gemm2(p, layer, smem);
    ph_peerconv(p, layer);
#endif
    xcd_barrier(bar);
#ifndef NO_NORM
    ph_norm(p, layer, 1);
#endif
    xcd_barrier(bar);
#ifdef PROBE_GEMM
    ph_gemm3(p, smem);
#endif
#ifndef NO_GEMM3
    ph_gemm3(p, smem);
#endif
    xcd_barrier(bar);
#ifdef PROBE_PEER
    ph_peer(p, layer, false);
#endif
#ifndef NO_PEER
    ph_peer(p, layer);
#endif
#ifndef NO_PREP
    if (layer + 1 < NLAYERS) ph_prep(p, layer + 1, smem);
#endif
    xcd_barrier(bar);
  }
  ph_final(p);
}

enum { K_PRO = 0, K_PREP, K_NORM1, K_GEMM1, K_MIX_A, K_MIX_B, K_MIX_C, K_GEMM2, K_NORM2, K_GEMM3, K_PEER, K_FINAL };

template <int PH>
__global__ void __launch_bounds__(256, 2) k_phase(P p, int layer) {
  __shared__ __attribute__((aligned(16))) char smem[SMEM_BYTES];
  if constexpr (PH == K_PRO) {
    ph_copy(p);
    ph_rope(p);
    for (int u = blockIdx.x; u < 96; u += gridDim.x) modv_unit(p, u, smem);
  } else if constexpr (PH == K_PREP) {
    ph_prep(p, layer, smem);
  } else if constexpr (PH == K_NORM1) {
    ph_norm(p, layer, 0);
  } else if constexpr (PH == K_GEMM1) {
    ph_gemm1(p, smem);
  } else if constexpr (PH == K_MIX_A) {
    mixA(p, layer, smem);
  } else if constexpr (PH == K_MIX_B) {
    mixB(p, layer, smem);
  } else if constexpr (PH == K_MIX_C) {
    mixC(p, layer, smem);
  } else if constexpr (PH == K_GEMM2) {
    ph_gemm2(p, layer, smem);
    ph_peerconv(p, layer);
  } else if constexpr (PH == K_NORM2) {
    ph_norm(p, layer, 1);
  } else if constexpr (PH == K_GEMM3) {
    ph_gemm3(p, smem);
  } else if constexpr (PH == K_PEER) {
    ph_peer(p, layer);
  } else if constexpr (PH == K_FINAL) {
    ph_final(p);
  }
}

static inline size_t al256(size_t x) { return (x + 255) & ~(size_t)255; }

extern "C" void kernel_launch(void* const* d_in, const int* in_sizes, int n_in, void* d_out, int out_size, void* d_ws, size_t ws_size,
                              hipStream_t stream) {
  (void)in_sizes; (void)n_in; (void)out_size; (void)ws_size;
  P p{};
  const float** f = (const float**)&p;
  for (int i = 0; i < 39; ++i) f[i] = (const float*)d_in[i];
  p.out = (float*)d_out;
  char* w = (char*)d_ws;
  size_t off = 0;
  auto take = [&](size_t bytes) { char* r = w + off; off += al256(bytes); return r; };
  p.bar = (unsigned*)take(16384);
  p.modv = (float*)take((size_t)DEPTH * 17 * 6144 * 4);
  p.SSQ = (float*)take((size_t)DEPTH * 2 * 256 * 4);
  const size_t zero_bytes = off;
  p.rope = (float*)take(64 * 16 * 2 * 4);
  p.X = (bf16_t*)take((size_t)NTOK * D * 2);
  p.H = (bf16_t*)take((size_t)NTOK * D * 2);
  p.Y = (bf16_t*)take((size_t)NTOK * D * 2);
  p.SC = (bf16_t*)take((size_t)NTOK * 1024 * 2);
  p.Z = (bf16_t*)take((size_t)NTOK * INW * 2);
  p.UTl = (bf16_t*)take((size_t)256 * 16 * T * 2);
  p.UTc = (bf16_t*)take((size_t)256 * 16 * LC * 2);
  p.YTl = (bf16_t*)take((size_t)256 * 16 * T * 2);
  p.YTc = (bf16_t*)take((size_t)256 * 16 * LC * 2);
  p.FL = (float*)take((size_t)256 * 2 * T * 4);
  p.FC = (float*)take((size_t)256 * 2 * LC * 4);
  p.W1t = (bf16_t*)take((size_t)INW * D * 2);
  p.W2t = (bf16_t*)take((size_t)D * D * 2);
  p.Wft = (bf16_t*)take((size_t)2048 * D * 2);
  p.Wwt = (bf16_t*)take((size_t)2 * 256 * 64 * 2);
  p.Wat = (bf16_t*)take((size_t)2 * 256 * 64 * 2);
  p.Wgt = (bf16_t*)take((size_t)256 * 128 * 2);
  p.TK = (float*)p.Z;
  p.PU = (unsigned char*)p.Z + al256((size_t)NTOK * 256 * 4);
  p.PV = p.PU + (size_t)16384 * 1024;
  p.PSU = (float*)(p.PV + (size_t)16384 * 1024);
  p.PSV = p.PSU + 16384;

  (void)hipMemsetAsync(d_ws, 0, zero_bytes, stream);
#ifndef MK_MULTI
  static int grid = 0;
  if (!grid) {
    int dev = 0, cus = 0, per_cu = 0;
    (void)hipGetDevice(&dev);
    (void)hipDeviceGetAttribute(&cus, hipDeviceAttributeMultiprocessorCount, dev);
    (void)hipOccupancyMaxActiveBlocksPerMultiprocessor(&per_cu, k_mega, 256, 0);
    if (cus <= 0) cus = 256;
    if (per_cu > 2) per_cu = 2;
    if (per_cu < 1) per_cu = 1;
    grid = cus * per_cu;
  }
  k_mega<<<grid, 256, 0, stream>>>(p);
  return;
#endif
  const int G = 1024;
  k_phase<K_PRO><<<G, 256, 0, stream>>>(p, 0);
  for (int l = 0; l < NLAYERS; ++l) {
    k_phase<K_PREP><<<G, 256, 0, stream>>>(p, l);
    k_phase<K_NORM1><<<G, 256, 0, stream>>>(p, l);
    k_phase<K_GEMM1><<<G, 256, 0, stream>>>(p, l);
    k_phase<K_MIX_A><<<G, 256, 0, stream>>>(p, l);
    k_phase<K_MIX_B><<<G, 256, 0, stream>>>(p, l);
    k_phase<K_MIX_C><<<G, 256, 0, stream>>>(p, l);
    k_phase<K_GEMM2><<<G, 256, 0, stream>>>(p, l);
    k_phase<K_NORM2><<<G, 256, 0, stream>>>(p, l);
    k_phase<K_GEMM3><<<G, 256, 0, stream>>>(p, l);
    k_phase<K_PEER><<<G, 256, 0, stream>>>(p, l);
  }
  k_phase<K_FINAL><<<G, 256, 0, stream>>>(p, 0);
}
```

```cpp
#include <hip/hip_runtime.h>
#include <stdint.h>

#define DEV __device__ __forceinline__
typedef unsigned short bf16_t;
typedef short bf16x8 __attribute__((ext_vector_type(8)));
typedef float f32x2 __attribute__((ext_vector_type(2)));
typedef float f32x4 __attribute__((ext_vector_type(4)));
typedef float f32x16 __attribute__((ext_vector_type(16)));

#ifndef NLAYERS
#define NLAYERS 4
#endif
#ifndef EN_HY
#define EN_HY 1
#endif
#ifndef EN_RW
#define EN_RW 1
#endif
#ifndef EN_AT
#define EN_AT 1
#endif
#ifndef EN_MIX
#define EN_MIX 1
#endif
#ifndef EN_PEER
#define EN_PEER 1
#endif

constexpr int NB = 16, T = 4096, LC = 256, LT = 4352, D = 1024, NTOK = NB * LT, INW = 2688, DEPTH = 4;
constexpr int SMEM_BYTES = 65536;

struct P {
  const float *x, *c, *ctx, *c_ctx, *mod_w, *mod_b, *norm1_g, *norm2_g, *w_in, *conv_w, *conv_b;
  const float *hy_w1, *hy_b1, *hy_w2, *hy_b2, *hy_w3, *hy_b3, *hy_freq, *hy_bias;
  const float *rw_w0, *rw_w_up, *rw_a0, *rw_a_up, *rw_g_up, *rw_k_k, *rw_k_a, *rw_r_k, *rw_ln_w, *rw_ln_b;
  const float *attn_sink, *hy_out_g, *at_out_g, *w_out, *peer_wq, *peer_k1, *peer_k2, *peer_u, *peer_v, *final_g;
  float* out;
  unsigned* bar;
  float *modv, *SSQ, *rope, *FL, *FC, *TK;
  unsigned *wq, *cuclaim;
  bf16_t *X, *H, *Y, *SC, *Z, *UTl, *UTc, *YTl, *YTc;
  bf16_t *W1t, *W2t, *Wft, *Wwt, *Wat, *Wgt;
  unsigned char *PU, *PV;
  float *PSU, *PSV;
};

DEV bf16_t f2bf(float f) { unsigned u = __float_as_uint(f); u += 0x7FFFu + ((u >> 16) & 1u); return (bf16_t)(u >> 16); }
DEV float bf2f(bf16_t h) { return __uint_as_float(((unsigned)h) << 16); }
DEV unsigned pack2(float a, float b) { return (unsigned)f2bf(a) | ((unsigned)f2bf(b) << 16); }
DEV float bflo(unsigned u) { return __uint_as_float(u << 16); }
DEV float bfhi(unsigned u) { return __uint_as_float(u & 0xFFFF0000u); }
DEV void unpack8(const uint4& u, float* v) {
  v[0] = bflo(u.x); v[1] = bfhi(u.x); v[2] = bflo(u.y); v[3] = bfhi(u.y);
  v[4] = bflo(u.z); v[5] = bfhi(u.z); v[6] = bflo(u.w); v[7] = bfhi(u.w);
}
DEV uint4 pack8(const float* v) { return make_uint4(pack2(v[0], v[1]), pack2(v[2], v[3]), pack2(v[4], v[5]), pack2(v[6], v[7])); }
DEV float sigmoidf_(float x) { return 1.f / (1.f + __expf(-x)); }

template <int CTRL, int ROWMASK>
DEV float dpp0(float x) {
  return __builtin_bit_cast(float, __builtin_amdgcn_update_dpp(0, __builtin_bit_cast(int, x), CTRL, ROWMASK, 0xF, false));
}
template <int CTRL, int ROWMASK>
DEV float dppself(float x) {
  int xi = __builtin_bit_cast(int, x);
  return __builtin_bit_cast(float, __builtin_amdgcn_update_dpp(xi, xi, CTRL, ROWMASK, 0xF, false));
}
DEV float readlane_f(float x, int l) { return __builtin_bit_cast(float, __builtin_amdgcn_readlane(__builtin_bit_cast(int, x), l)); }
DEV int lane_id() { return (int)__builtin_amdgcn_mbcnt_hi(~0u, __builtin_amdgcn_mbcnt_lo(~0u, 0u)); }
DEV float writelane_f(float val, int l, float old) { return lane_id() == l ? val : old; }
DEV int writelane_i(int val, int l, int old) { return lane_id() == l ? val : old; }
DEV float wave_sum(float x) {
  x += dpp0<0x111, 0xF>(x); x += dpp0<0x112, 0xF>(x); x += dpp0<0x114, 0xF>(x); x += dpp0<0x118, 0xF>(x);
  x += dpp0<0x142, 0xA>(x); x += dpp0<0x143, 0xC>(x);
  return readlane_f(x, 63);
}
DEV float wave_max(float x) {
  x = fmaxf(x, dppself<0x111, 0xF>(x)); x = fmaxf(x, dppself<0x112, 0xF>(x)); x = fmaxf(x, dppself<0x114, 0xF>(x));
  x = fmaxf(x, dppself<0x118, 0xF>(x)); x = fmaxf(x, dppself<0x142, 0xA>(x)); x = fmaxf(x, dppself<0x143, 0xC>(x));
  return readlane_f(x, 63);
}
DEV float row16_sum(float x) {
  x += dpp0<0xB1, 0xF>(x); x += dpp0<0x4E, 0xF>(x); x += dpp0<0x141, 0xF>(x); x += dpp0<0x140, 0xF>(x);
  return x;
}
DEV float row16_max(float x) {
  x = fmaxf(x, dppself<0xB1, 0xF>(x)); x = fmaxf(x, dppself<0x4E, 0xF>(x)); x = fmaxf(x, dppself<0x141, 0xF>(x));
  x = fmaxf(x, dppself<0x140, 0xF>(x));
  return x;
}
DEV float quad_sum(float x) { x += dpp0<0xB1, 0xF>(x); x += dpp0<0x4E, 0xF>(x); return x; }

DEV f32x4 mfma16(bf16x8 a, bf16x8 b, f32x4 c) { return __builtin_amdgcn_mfma_f32_16x16x32_bf16(a, b, c, 0, 0, 0); }
DEV f32x16 mfma32(bf16x8 a, bf16x8 b, f32x16 c) { return __builtin_amdgcn_mfma_f32_32x32x16_bf16(a, b, c, 0, 0, 0); }


#define XB_TMO      128
#define XB_XCNT(j)  (256  + 64 * (j))
#define XB_XSUB(j)  (1280 + 64 * (j))
#define XB_XGEN(j)  (2304 + 64 * (j))
#define XB_TOP      3328
#define XB_TOPGEN   3392
#define XCD_BAR_WORDS 3456
#define XB_SPIN_CAP (1u << 23)
#define LAS __attribute__((address_space(3)))

__device__ __forceinline__ unsigned xb_ld(unsigned* p)              { return __hip_atomic_load(p, __ATOMIC_RELAXED, __HIP_MEMORY_SCOPE_AGENT); }
__device__ __forceinline__ unsigned xb_add(unsigned* p, unsigned v) { return __hip_atomic_fetch_add(p, v, __ATOMIC_RELAXED, __HIP_MEMORY_SCOPE_AGENT); }
__device__ __forceinline__ unsigned xb_xcc_id() { return (unsigned)__builtin_amdgcn_s_getreg((3 << 11) | 20) & 0xFu; }
#define XB_SPIN(cond, bar) do { unsigned _sp = 0; while (cond) { __builtin_amdgcn_s_sleep(1); \
    if ((++_sp & 255u) == 0u) { if (xb_ld(&(bar)[XB_TMO])) break; if (_sp > XB_SPIN_CAP) { atomicAdd(&(bar)[XB_TMO], 1u); break; } } } } while (0)

struct XcdBarrier {
    unsigned* bar; unsigned x;
    volatile LAS unsigned* st;
};
__device__ __forceinline__ XcdBarrier xcd_barrier_post(unsigned* bar, volatile LAS unsigned* st) {
    XcdBarrier b; b.bar = bar; b.x = xb_xcc_id(); b.st = st;
    if (threadIdx.x == 0) (void)xb_add(&bar[XB_XCNT(b.x)], 1u);
    return b;
}
__device__ __forceinline__ void xcd_barrier_complete(unsigned* bar, unsigned x, unsigned& nloc, unsigned& nx) {
    const unsigned G = gridDim.x * gridDim.y * gridDim.z;
    unsigned sum, cnt, mine, sp = 0u;
    for (;;) {
        sum = 0u; cnt = 0u; mine = 0u;
#pragma unroll
        for (unsigned j = 0; j < 16; ++j) { const unsigned c = xb_ld(&bar[XB_XCNT(j)]); sum += c; cnt += (c > 0u) ? 1u : 0u; mine = (j == x) ? c : mine; }
        if (sum == G) break;
        __builtin_amdgcn_s_sleep(1);
        if ((++sp & 255u) == 0u) { if (xb_ld(&bar[XB_TMO])) break; if (sp > XB_SPIN_CAP) { atomicAdd(&bar[XB_TMO], 1u); break; } }
    }
    nloc = mine > 0u ? mine : 1u; nx = cnt > 0u ? cnt : 1u;
}
__device__ __forceinline__ void xcd_barrier(const XcdBarrier& b) {
    asm volatile("s_waitcnt vmcnt(0)" ::: "memory");
    __syncthreads();
    if (threadIdx.x == 0) {
        unsigned* bar = b.bar;
        __builtin_amdgcn_s_waitcnt(0);
        unsigned nloc = b.st[0], nx = b.st[1];
        if (nloc == 0u) { xcd_barrier_complete(bar, b.x, nloc, nx); b.st[0] = nloc; b.st[1] = nx; }
        const unsigned old = xb_add(&bar[XB_XSUB(b.x)], 1u);
        const unsigned gen = old / nloc;
        if (old + 1u == (gen + 1u) * nloc) {
            __builtin_amdgcn_fence(__ATOMIC_RELEASE, "agent");
            asm volatile("s_waitcnt vmcnt(0)" ::: "memory");
            const unsigned og = xb_add(&bar[XB_TOP], 1u);
            const unsigned tg = og / nx;
            if (og + 1u == (tg + 1u) * nx) xb_add(&bar[XB_TOPGEN], 1u);
            else XB_SPIN(xb_ld(&bar[XB_TOPGEN]) == tg, bar);
            __builtin_amdgcn_fence(__ATOMIC_ACQUIRE, "agent");
            xb_add(&bar[XB_XGEN(b.x)], 1u);
            asm volatile("s_waitcnt vmcnt(0)" ::: "memory");
        } else {
            XB_SPIN(xb_ld(&bar[XB_XGEN(b.x)]) == gen, bar);
            __builtin_amdgcn_fence(__ATOMIC_ACQUIRE, "agent");
            asm volatile("s_waitcnt vmcnt(0)" ::: "memory");
        }
    }
    __syncthreads();
}

template <class Tp> DEV Tp* opq(Tp* q) { asm volatile("" : "+s"(q)); return q; }
DEV int tid_() { int t = threadIdx.x; asm volatile("" : "+v"(t)); return t; }
DEV int bid_() { int b = blockIdx.x; asm volatile("" : "+s"(b)); return b; }

DEV void glds16(const void* gsrc, char* lds_lane_ptr) {
  __builtin_amdgcn_global_load_lds((const unsigned*)gsrc, (__attribute__((address_space(3))) unsigned*)lds_lane_ptr, 16, 0, 0);
}
template <class Epi>
DEV void gemm_tile(const bf16_t* __restrict__ A, int lda, const bf16_t* __restrict__ Bt, int ldb, int K, char* smem, Epi& epi) {
  const int tid = tid_(), lane = tid & 63, wid = tid >> 6, wr = wid >> 1, wc = wid & 1, fr = lane & 15, fq = lane >> 4;
  f32x4 acc[4][4];
#pragma unroll
  for (int m = 0; m < 4; ++m)
#pragma unroll
    for (int n = 0; n < 4; ++n) acc[m][n] = (f32x4){0.f, 0.f, 0.f, 0.f};
  const int drow0 = 8 * wid + (lane >> 3), dpc = lane & 7;
  auto issue = [&](int kt, int buf) {
    char* sa = smem + buf * 32768;
    char* sb = sa + 16384;
#pragma unroll
    for (int i = 0; i < 4; ++i) {
      const int row = drow0 + 32 * i;
      const int kc = dpc ^ ((row >> 1) & 7);
      glds16(A + (size_t)row * lda + kt * 64 + kc * 8, sa + (i * 4 + wid) * 1024 + lane * 16);
      glds16(Bt + (size_t)row * ldb + kt * 64 + kc * 8, sb + (i * 4 + wid) * 1024 + lane * 16);
    }
  };
  __syncthreads();
  issue(0, 0);
  const int nk = K >> 6;
  const int sw = (fr >> 1) & 7;
  const int aoff = (wr * 64 + fr) * 128, boff = (wc * 64 + fr) * 128;
  for (int kt = 0; kt < nk; ++kt) {
    asm volatile("s_waitcnt vmcnt(0)" ::: "memory");
    __syncthreads();
    if (kt + 1 < nk) issue(kt + 1, (kt + 1) & 1);
    const char* sa = smem + (kt & 1) * 32768;
    const char* sb = sa + 16384;
#pragma unroll
    for (int kh = 0; kh < 2; ++kh) {
      const int pc = ((kh * 4 + fq) ^ sw) * 16;
      bf16x8 af[4], bfr[4];
#pragma unroll
      for (int m = 0; m < 4; ++m) af[m] = *(const bf16x8*)(sa + aoff + m * 2048 + pc);
#pragma unroll
      for (int n = 0; n < 4; ++n) bfr[n] = *(const bf16x8*)(sb + boff + n * 2048 + pc);
#pragma unroll
      for (int m = 0; m < 4; ++m)
#pragma unroll
        for (int n = 0; n < 4; ++n) acc[m][n] = mfma16(af[m], bfr[n], acc[m][n]);
    }
  }
  __syncthreads();
  epi(acc, wr, wc, fr, fq, smem);
}
DEV void stage_tile_bf16(const f32x4 (&acc)[4][4], char* smem, int wid, int fr, int fq) {
  bf16_t (*t)[72] = (bf16_t (*)[72])(smem + wid * 9216);
#pragma unroll
  for (int m = 0; m < 4; ++m)
#pragma unroll
    for (int n = 0; n < 4; ++n)
#pragma unroll
      for (int j = 0; j < 4; ++j) t[m * 16 + fq * 4 + j][n * 16 + fr] = f2bf(acc[m][n][j]);
  asm volatile("s_waitcnt lgkmcnt(0)" ::: "memory");
}

DEV void ph_copy(const P& p) {
  const size_t n8 = (size_t)NTOK * D / 8;
  const float* pctx = opq(p.ctx); const float* px = opq(p.x);
  for (size_t i = (size_t)bid_() * 256 + tid_(); i < n8; i += (size_t)gridDim.x * 256) {
    size_t e = i * 8;
    int row = (int)(e / D), col = (int)(e % D);
    int b = row / LT, pp = row % LT;
    const float* src = pp < LC ? pctx + ((size_t)(b * LC + pp)) * D + col : px + ((size_t)(b * T + pp - LC)) * D + col;
    float4 v0 = *(const float4*)src, v1 = *(const float4*)(src + 4);
    uint4 o = make_uint4(pack2(v0.x, v0.y), pack2(v0.z, v0.w), pack2(v1.x, v1.y), pack2(v1.z, v1.w));
    *(uint4*)(p.X + e) = o;
  }
}

DEV void ph_rope(const P& p) {
  for (int i = bid_() * 256 + tid_(); i < 64 * 16; i += gridDim.x * 256) {
    int pos = i >> 4, k = i & 15;
    float inv = powf(10000.f, -(float)k / 16.f);
    float ang = (float)pos * inv;
    p.rope[2 * i] = cosf(ang); p.rope[2 * i + 1] = sinf(ang);
  }
}

DEV void modv_unit(const P& p, int unit, char* smem) {
  const int cc = unit % 24, layer = unit / 24;
  float (*cs)[128] = (float (*)[128])smem;
  const int col = cc * 256 + tid_();
  const float* pc = opq(p.c); const float* pcc = opq(p.c_ctx);
  float acc[17];
#pragma unroll
  for (int r = 0; r < 17; ++r) acc[r] = 0.f;
  for (int ks = 0; ks < 8; ++ks) {
    __syncthreads();
    for (int i = tid_(); i < 17 * 128; i += 256) {
      int r = i >> 7, e = i & 127;
      float v = r < 16 ? pc[r * D + ks * 128 + e] : pcc[ks * 128 + e];
      cs[r][e] = v / (1.f + expf(-v));
    }
    __syncthreads();
    const float* w = p.mod_w + ((size_t)layer * D + ks * 128) * 6144 + col;
#pragma unroll 4
    for (int e = 0; e < 128; ++e) {
      float wv = w[(size_t)e * 6144];
#pragma unroll
      for (int r = 0; r < 17; ++r) acc[r] += cs[r][e] * wv;
    }
  }
  const float bias = p.mod_b[layer * 6144 + col];
#pragma unroll
  for (int r = 0; r < 17; ++r) p.modv[((size_t)layer * 17 + r) * 6144 + col] = acc[r] + bias;
}

DEV void transpose_unit(const float* __restrict__ src, bf16_t* __restrict__ dst, int R, int C, int tile, char* smem) {
  float (*t)[65] = (float (*)[65])smem;
  const int nct = C / 64;
  const int tr = tile / nct, tc = tile % nct;
  __syncthreads();
  for (int i = tid_(); i < 4096; i += 256) { int r = i >> 6, c = i & 63; t[r][c] = src[(size_t)(tr * 64 + r) * C + tc * 64 + c]; }
  __syncthreads();
  for (int i = tid_(); i < 4096; i += 256) { int c = i >> 6, r = i & 63; dst[(size_t)(tc * 64 + c) * R + tr * 64 + r] = f2bf(t[r][c]); }
}

DEV void wfold_unit(const P& p, int layer, int unit, char* smem) {
  const int hs = unit >> 5, ec = unit & 31, h = hs >> 1, s = hs & 1;
  const float* wq = p.peer_wq + (size_t)layer * D * 2048;
  const float* kk = (s ? opq(p.peer_k2) : opq(p.peer_k1)) + ((size_t)layer * 8 + h) * 128 * 128;
  float (*kS)[65] = (float (*)[65])smem;
  float (*wS)[64] = (float (*)[64])(smem + 33280);
  const int key = tid_() & 127, eh = tid_() >> 7;
  float acc[16];
#pragma unroll
  for (int i = 0; i < 16; ++i) acc[i] = 0.f;
  for (int dh = 0; dh < 2; ++dh) {
    __syncthreads();
    for (int i = tid_(); i < 128 * 64; i += 256) { int k2 = i >> 6, d = i & 63; kS[k2][d] = kk[k2 * 128 + dh * 64 + d]; }
    for (int i = tid_(); i < 32 * 64; i += 256) {
      int e = i >> 6, d = i & 63;
      wS[e][d] = wq[(size_t)(ec * 32 + e) * 2048 + h * 256 + s * 128 + dh * 64 + d];
    }
    __syncthreads();
#pragma unroll 2
    for (int d = 0; d < 64; ++d) {
      float kv = kS[key][d];
#pragma unroll
      for (int i = 0; i < 16; ++i) acc[i] += kv * wS[eh * 16 + i][d];
    }
  }
  bf16_t* dst = p.Wft + ((size_t)(hs * 128 + key)) * D + ec * 32 + eh * 16;
#pragma unroll
  for (int i = 0; i < 16; i += 2) *(unsigned*)(dst + i) = pack2(acc[i], acc[i + 1]);
}

DEV void filt_unit(const P& p, int layer, int unit, char* smem) {
  int kind, j0, L;
  if (unit < 1024) { kind = 0; j0 = unit * 4; L = T; } else { kind = 1; j0 = (unit - 1024) * 4; L = LC; }
  float* zs = (float*)smem;
  float* h1 = zs + 4 * 36;
  float* h2 = h1 + 256;
  const int jj = tid_() >> 6, o = tid_() & 63;
  const int j = j0 + jj;
  const float fj = (float)j;
  const float t = fj / (float)(L - 1);
  __syncthreads();
  if (o < 33) {
    float z;
    if (o == 0) z = t;
    else {
      int i = (o - 1) & 15;
      float band = 1e-4f + (float)i * ((15.0f - 1e-4f) / 15.0f);
      float ang = 6.283185307179586f * fj * band / (float)L;
      z = (o <= 16) ? cosf(ang) : -sinf(ang);
    }
    zs[jj * 36 + o] = z;
  }
  __syncthreads();
  {
    const float* w1 = p.hy_w1 + layer * 33 * 64;
    float a = p.hy_b1[layer * 64 + o];
#pragma unroll 3
    for (int i = 0; i < 33; ++i) a += zs[jj * 36 + i] * w1[i * 64 + o];
    h1[jj * 64 + o] = sinf(p.hy_freq[layer * 128 + o] * a);
  }
  __syncthreads();
  {
    const float* w2 = p.hy_w2 + layer * 64 * 64;
    float a = p.hy_b2[layer * 64 + o];
#pragma unroll 4
    for (int i = 0; i < 64; ++i) a += h1[jj * 64 + i] * w2[i * 64 + o];
    h2[jj * 64 + o] = sinf(p.hy_freq[layer * 128 + 64 + o] * a);
  }
  __syncthreads();
  const float* w3 = p.hy_w3 + layer * 64 * 512;
  float* F = kind ? opq(p.FC) : opq(p.FL);
  const float DMIN = -3.0701134573253945f, DMAX = -15.350567286626973f;
#pragma unroll 1
  for (int m = 0; m < 4; ++m) {
    int c = o + 64 * m;
    float af = p.hy_b3[layer * 512 + c], ab = p.hy_b3[layer * 512 + 256 + c];
#pragma unroll 4
    for (int i = 0; i < 64; ++i) { float hv = h2[jj * 64 + i]; af += hv * w3[i * 512 + c]; ab += hv * w3[i * 512 + 256 + c]; }
    float delta = fabsf(DMIN + (float)c * ((DMAX - DMIN) / 255.f));
    float win = expf(-t * delta) + 0.05f;
    af *= win; ab *= win;
    F[((size_t)c * 2 + 0) * L + j] = af;
    F[((size_t)c * 2 + 1) * L + j] = ab;
  }
}

constexpr int PREP_T0 = 672, PREP_T1 = PREP_T0 + 256, PREP_T2 = PREP_T1 + 8, PREP_T3 = PREP_T2 + 8, PREP_T4 = PREP_T3 + 8;
constexpr int PREP_WF = PREP_T4 + 512, PREP_N = PREP_WF + 1088;
DEV void ph_prep(const P& p, int layer, char* smem) {
  for (int u = bid_(); u < PREP_N; u += gridDim.x) {
    if (u < PREP_T0) transpose_unit(p.w_in + (size_t)layer * D * INW, p.W1t, D, INW, u, smem);
    else if (u < PREP_T1) transpose_unit(p.w_out + (size_t)layer * D * D, p.W2t, D, D, u - PREP_T0, smem);
    else if (u < PREP_T2) { int q = u - PREP_T1, d = q >> 2; transpose_unit(p.rw_w_up + ((size_t)layer * 2 + d) * 64 * 256, p.Wwt + d * 256 * 64, 64, 256, q & 3, smem); }
    else if (u < PREP_T3) { int q = u - PREP_T2, d = q >> 2; transpose_unit(p.rw_a_up + ((size_t)layer * 2 + d) * 64 * 256, p.Wat + d * 256 * 64, 64, 256, q & 3, smem); }
    else if (u < PREP_T4) transpose_unit(p.rw_g_up + (size_t)layer * 128 * 256, p.Wgt, 128, 256, u - PREP_T3, smem);
    else if (u < PREP_WF) wfold_unit(p, layer, u - PREP_T4, smem);
    else filt_unit(p, layer, u - PREP_WF, smem);
  }
}

DEV void ph_norm(const P& p, int layer, int which) {
  const int gw = (bid_() * 256 + tid_()) >> 6, nw = gridDim.x * 4, lane = tid_() & 63;
  const float* g = (which ? p.norm2_g : p.norm1_g) + layer * D;
  for (int row = gw; row < NTOK; row += nw) {
    int b = row / LT, pp = row % LT;
    int mr = pp < LC ? 16 : b;
    const float* mv = p.modv + ((size_t)layer * 17 + mr) * 6144 + (which ? 3072 : 0);
    const bf16_t* xr = p.X + (size_t)row * D;
    uint4 u0 = *(const uint4*)(xr + 8 * lane), u1 = *(const uint4*)(xr + 512 + 8 * lane);
    float v[16];
    unpack8(u0, v); unpack8(u1, v + 8);
    float ss = 0.f;
#pragma unroll
    for (int i = 0; i < 16; ++i) ss += v[i] * v[i];
    ss = wave_sum(ss);
    float rstd = rsqrtf(ss * (1.f / 1024.f) + 1e-6f);
    float o[16];
#pragma unroll
    for (int hh = 0; hh < 2; ++hh)
#pragma unroll
      for (int i = 0; i < 8; ++i) {
        int col = hh * 512 + 8 * lane + i;
        float y = v[hh * 8 + i] * rstd * g[col];
        o[hh * 8 + i] = y * (1.f + mv[1024 + col]) + mv[col];
      }
    bf16_t* hr = p.H + (size_t)row * D;
    *(uint4*)(hr + 8 * lane) = pack8(o);
    *(uint4*)(hr + 512 + 8 * lane) = pack8(o + 8);
  }
}

struct Epi1 {
  const P& p; int row0, col0;
  DEV void operator()(f32x4 (&acc)[4][4], int wr, int wc, int fr, int fq, char* smem) const {
    const int cw = col0 + wc * 64;
    const int rbase = row0 + wr * 64;
    const bool lat = (row0 % LT) >= LC;
    if (cw >= 1536 && cw < 1664) {
#pragma unroll
      for (int m = 0; m < 4; ++m)
#pragma unroll
        for (int n = 0; n < 4; ++n)
#pragma unroll
          for (int j = 0; j < 4; ++j) acc[m][n][j] = tanhf(acc[m][n][j]);
    } else if (cw >= 1792 && cw < 1920) {
#pragma unroll
      for (int m = 0; m < 4; ++m)
#pragma unroll
        for (int n = 0; n < 4; ++n)
#pragma unroll
          for (int j = 0; j < 4; ++j) acc[m][n][j] = sigmoidf_(acc[m][n][j]);
    } else if (cw >= 1920 && cw < 2560 && lat) {
#pragma unroll
      for (int m = 0; m < 4; ++m)
#pragma unroll
        for (int j = 0; j < 4; ++j) {
          int row = rbase + m * 16 + fq * 4 + j;
          int pl = (row % LT) - LC;
          int ri = pl >> 6, ci = pl & 63;
          float2 cr = *(const float2*)(p.rope + 2 * (ri * 16 + fr));
          float2 cc = *(const float2*)(p.rope + 2 * (ci * 16 + fr));
          float x1 = acc[m][0][j], x2 = acc[m][1][j];
          acc[m][0][j] = x1 * cr.x - x2 * cr.y; acc[m][1][j] = x2 * cr.x + x1 * cr.y;
          x1 = acc[m][2][j]; x2 = acc[m][3][j];
          acc[m][2][j] = x1 * cc.x - x2 * cc.y; acc[m][3][j] = x2 * cc.x + x1 * cc.y;
        }
    }
    const int wid = wr * 2 + wc, lane = fq * 16 + fr;
    stage_tile_bf16(acc, smem, wid, fr, fq);
    const bf16_t (*t)[72] = (const bf16_t (*)[72])(smem + wid * 9216);
#pragma unroll
    for (int i = 0; i < 8; ++i) {
      const int rl = i * 8 + (lane >> 3), ch = lane & 7;
      *(uint4*)(p.Z + (size_t)(rbase + rl) * INW + cw + ch * 8) = *(const uint4*)&t[rl][ch * 8];
    }
  }
};
DEV void ph_gemm1(const P& p, char* smem) {
  const int nct = INW / 128;
  for (int u = bid_(); u < (NTOK / 128) * nct; u += gridDim.x) {
    int rt = u / nct, ct = u % nct;
    Epi1 epi{p, rt * 128, ct * 128};
    gemm_tile(p.H + (size_t)rt * 128 * D, D, p.W1t + (size_t)ct * 128 * D, D, D, smem, epi);
  }
}

struct EpiLora {
  const P& p; int layer, q, row0, col0;
  DEV void operator()(f32x4 (&acc)[4][4], int wr, int wc, int fr, int fq, char*) const {
#pragma unroll
    for (int m = 0; m < 4; ++m)
#pragma unroll
      for (int n = 0; n < 4; ++n)
#pragma unroll
        for (int j = 0; j < 4; ++j) {
          int row = row0 + wr * 64 + m * 16 + fq * 4 + j;
          int col = col0 + wc * 64 + n * 16 + fr;
          float v = acc[m][n][j];
          if (q < 2) {
            v = 0.6065306597126334f * sigmoidf_(v + p.rw_w0[(layer * 2 + q) * 256 + col]);
            p.SC[(size_t)row * 1024 + col * 4 + q] = f2bf(v);
          } else if (q < 4) {
            v = sigmoidf_(v + p.rw_a0[(layer * 2 + (q - 2)) * 256 + col]);
            p.SC[(size_t)row * 1024 + col * 4 + q] = f2bf(v);
          } else {
            p.Y[(size_t)row * D + 256 + col] = f2bf(v);
          }
        }
  }
};
DEV void lora_unit(const P& p, int layer, int unit, char* smem) {
  const int q = unit / 1088, r = unit % 1088, rt = r >> 1, ct = r & 1;
  EpiLora epi{p, layer, q, rt * 128, ct * 128};
  const bf16_t* A; const bf16_t* Bt; int K;
  if (q < 2) { A = p.Z + 1536 + 64 * q; Bt = p.Wwt + q * 256 * 64; K = 64; }
  else if (q < 4) { A = p.Z + 1664 + 64 * (q - 2); Bt = p.Wat + (q - 2) * 256 * 64; K = 64; }
  else { A = p.Z + 1792; Bt = p.Wgt; K = 128; }
  gemm_tile(A + (size_t)rt * 128 * INW, INW, Bt + (size_t)ct * 128 * K, K, K, smem, epi);
}

DEV void ph_rwkv_prep(const P& p, int layer) {
  const int gw = (bid_() * 256 + tid_()) >> 6, nw = gridDim.x * 4, lane = tid_() & 63;
  const float* cw = p.conv_w + (size_t)layer * 3 * 1536;
  const float* cb = p.conv_b + (size_t)layer * 1536;
  for (int row = gw; row < NTOK; row += nw) {
    int pp = row % LT;
    bool hasm = (pp != 0) && (pp != LC);
    bool hasp = (pp != LC - 1) && (pp != LT - 1);
    float res[3][4];
#pragma unroll
    for (int a = 0; a < 3; ++a) {
      int col = 768 + a * 256 + 4 * lane;
      const bf16_t* zc = p.Z + (size_t)row * INW + col;
      uint2 um = hasm ? *(const uint2*)(zc - INW) : make_uint2(0, 0);
      uint2 uc = *(const uint2*)zc;
      uint2 up = hasp ? *(const uint2*)(zc + INW) : make_uint2(0, 0);
      float vm[4] = {bflo(um.x), bfhi(um.x), bflo(um.y), bfhi(um.y)};
      float vc[4] = {bflo(uc.x), bfhi(uc.x), bflo(uc.y), bfhi(uc.y)};
      float vp[4] = {bflo(up.x), bfhi(up.x), bflo(up.y), bfhi(up.y)};
#pragma unroll
      for (int i = 0; i < 4; ++i) res[a][i] = cw[col + i] * vm[i] + cw[1536 + col + i] * vc[i] + cw[3072 + col + i] * vp[i] + cb[col + i];
    }
    float kk[4], ss = 0.f;
#pragma unroll
    for (int i = 0; i < 4; ++i) { kk[i] = res[1][i] * p.rw_k_k[layer * 256 + 4 * lane + i]; ss += kk[i] * kk[i]; }
    ss = row16_sum(ss);
    float rs = rsqrtf(ss + 1e-12f);
    bf16_t* hr = p.H + (size_t)row * D + 16 * lane;
    *(uint4*)hr = make_uint4(pack2(res[0][0], res[1][0]), pack2(kk[0] * rs, res[2][0]), pack2(res[0][1], res[1][1]), pack2(kk[1] * rs, res[2][1]));
    *(uint4*)(hr + 8) = make_uint4(pack2(res[0][2], res[1][2]), pack2(kk[2] * rs, res[2][2]), pack2(res[0][3], res[1][3]), pack2(kk[3] * rs, res[2][3]));
  }
}

struct ScanRaw { uint2 h, s; };
struct ScanRegs { f32x2 A[4], W[4], B[4], K[4], R[4]; float v; };
DEV float oct_sum(float x) { x += dpp0<0xB1, 0xF>(x); x += dpp0<0x4E, 0xF>(x); x += dpp0<0x141, 0xF>(x); return x; }
DEV void scan_unit(const P& p, int layer, int unit, char* smem) {
  const int half = unit & 1, dir = (unit >> 1) & 1, h = (unit >> 2) & 3, b = unit >> 4;
  const int tid = tid_(), wid = tid >> 6, lane = tid & 63;
  const int k8 = lane & 7, vrow = half * 32 + wid * 8 + (lane >> 3);
  float* st = (float*)smem + wid * 768;
  const float ka = p.rw_k_a[layer * 256 + h * 64 + lane];
  f32x2 S[4];
#pragma unroll
  for (int i = 0; i < 4; ++i) S[i] = (f32x2){0.f, 0.f};
  const size_t rowbase = (size_t)b * LT;
  const bf16_t* hb = p.H + rowbase * 1024 + (h * 64 + lane) * 4;
  const bf16_t* sb = p.SC + rowbase * 1024 + (h * 64 + lane) * 4;
  bf16_t* yb = p.Z + rowbase * INW + 768 + dir * 256 + h * 64 + vrow;
  auto posf = [&](int t) -> int { return dir == 0 ? t : (t < LC ? LC - 1 - t : LT - 1 - (t - LC)); };
  auto load4 = [&](int c, ScanRaw (&dst)[4]) {
#pragma unroll
    for (int i = 0; i < 4; ++i) {
      size_t off = (size_t)posf(c * 4 + i) * 1024;
      dst[i].h = *(const uint2*)(hb + off); dst[i].s = *(const uint2*)(sb + off);
    }
  };
  auto stage = [&](const ScanRaw& x, int buf) {
    float rr = bflo(x.h.x), kr = bfhi(x.h.x), kkv = bflo(x.h.y), vv = bfhi(x.h.y);
    float ev = dir ? bfhi(x.s.x) : bflo(x.s.x), av = dir ? bfhi(x.s.y) : bflo(x.s.y);
    float w = __expf(-ev), ap = -kkv, bp = kkv * av, kd = kr * (1.f + (av - 1.f) * ka);
    float* q = st + buf * 384;
    q[lane] = ap; q[64 + lane] = w; q[128 + lane] = bp; q[192 + lane] = kd; q[256 + lane] = rr; q[320 + lane] = vv;
  };
  auto rd = [&](int buf, ScanRegs& g) {
    const float* q = st + buf * 384 + 8 * k8;
    float4 t0, t1;
    t0 = *(const float4*)q; t1 = *(const float4*)(q + 4);
    g.A[0] = (f32x2){t0.x, t0.y}; g.A[1] = (f32x2){t0.z, t0.w}; g.A[2] = (f32x2){t1.x, t1.y}; g.A[3] = (f32x2){t1.z, t1.w};
    t0 = *(const float4*)(q + 64); t1 = *(const float4*)(q + 68);
    g.W[0] = (f32x2){t0.x, t0.y}; g.W[1] = (f32x2){t0.z, t0.w}; g.W[2] = (f32x2){t1.x, t1.y}; g.W[3] = (f32x2){t1.z, t1.w};
    t0 = *(const float4*)(q + 128); t1 = *(const float4*)(q + 132);
    g.B[0] = (f32x2){t0.x, t0.y}; g.B[1] = (f32x2){t0.z, t0.w}; g.B[2] = (f32x2){t1.x, t1.y}; g.B[3] = (f32x2){t1.z, t1.w};
    t0 = *(const float4*)(q + 192); t1 = *(const float4*)(q + 196);
    g.K[0] = (f32x2){t0.x, t0.y}; g.K[1] = (f32x2){t0.z, t0.w}; g.K[2] = (f32x2){t1.x, t1.y}; g.K[3] = (f32x2){t1.z, t1.w};
    t0 = *(const float4*)(q + 256); t1 = *(const float4*)(q + 260);
    g.R[0] = (f32x2){t0.x, t0.y}; g.R[1] = (f32x2){t0.z, t0.w}; g.R[2] = (f32x2){t1.x, t1.y}; g.R[3] = (f32x2){t1.z, t1.w};
    g.v = st[buf * 384 + 320 + vrow];
  };
  auto compute = [&](const ScanRegs& g, int t) {
    f32x2 s2 = S[0] * g.A[0];
    s2 += S[1] * g.A[1]; s2 += S[2] * g.A[2]; s2 += S[3] * g.A[3];
    const float sa = oct_sum(s2[0] + s2[1]);
    const f32x2 sa2 = (f32x2){sa, sa}, vv2 = (f32x2){g.v, g.v};
#pragma unroll
    for (int i = 0; i < 4; ++i) S[i] = S[i] * g.W[i] + (sa2 * g.B[i] + vv2 * g.K[i]);
    f32x2 y2 = S[0] * g.R[0];
    y2 += S[1] * g.R[1]; y2 += S[2] * g.R[2]; y2 += S[3] * g.R[3];
    const float y = oct_sum(y2[0] + y2[1]);
    if (k8 == 0) yb[(size_t)posf(t) * INW] = f2bf(y);
  };
  constexpr int NC = LT / 4;
  ScanRaw R0[4], R1[4], R2[4], R3[4];
  ScanRegs g0, g1;
  auto chunk = [&](ScanRaw (&Rc)[4], ScanRaw (&Rn)[4], int t0, bool hasnext) {
    stage(Rc[1], 1); rd(1, g1); compute(g0, t0);
    stage(Rc[2], 0); rd(0, g0); compute(g1, t0 + 1);
    stage(Rc[3], 1); rd(1, g1); compute(g0, t0 + 2);
    if (hasnext) { stage(Rn[0], 0); rd(0, g0); }
    compute(g1, t0 + 3);
  };
  __builtin_amdgcn_s_setprio(3);
  load4(0, R0); load4(1, R1); load4(2, R2);
  stage(R0[0], 0);
  rd(0, g0);
#pragma unroll 1
  for (int c = 0; c < NC; c += 4) {
    load4(c + 3, R3);
    chunk(R0, R1, c * 4, true);
    const bool more = (c + 4 < NC);
    if (more) load4(c + 4, R0);
    chunk(R1, R2, c * 4 + 4, true);
    if (more) load4(c + 5, R1);
    chunk(R2, R3, c * 4 + 8, true);
    if (more) load4(c + 6, R2);
    chunk(R3, R0, c * 4 + 12, more);
  }
  __builtin_amdgcn_s_setprio(0);
}

DEV void ph_rwkv_post(const P& p, int layer) {
  const int gw = (bid_() * 256 + tid_()) >> 6, nw = gridDim.x * 4, lane = tid_() & 63;
  for (int row = gw; row < NTOK; row += nw) {
    const int ch = 4 * lane;
    const bf16_t* zr = p.Z + (size_t)row * INW + 768 + ch;
    uint2 y0u = *(const uint2*)zr, y1u = *(const uint2*)(zr + 256);
    float y[4] = {bflo(y0u.x) + bflo(y1u.x), bfhi(y0u.x) + bfhi(y1u.x), bflo(y0u.y) + bflo(y1u.y), bfhi(y0u.y) + bfhi(y1u.y)};
    float mu = row16_sum(y[0] + y[1] + y[2] + y[3]) * (1.f / 64.f);
    float vs = 0.f;
#pragma unroll
    for (int i = 0; i < 4; ++i) { y[i] -= mu; vs += y[i] * y[i]; }
    float var = row16_sum(vs) * (1.f / 64.f);
    float rstd = rsqrtf(var + 64e-5f);
    const bf16_t* hr = p.H + (size_t)row * D + 4 * ch;
    uint4 h0 = *(const uint4*)hr, h1 = *(const uint4*)(hr + 8);
    const bf16_t* sr = p.SC + (size_t)row * 1024 + 4 * ch;
    uint4 s0 = *(const uint4*)sr, s1 = *(const uint4*)(sr + 8);
    float r[4] = {bflo(h0.x), bflo(h0.z), bflo(h1.x), bflo(h1.z)};
    float k[4] = {bfhi(h0.x), bfhi(h0.z), bfhi(h1.x), bfhi(h1.z)};
    float v[4] = {bfhi(h0.y), bfhi(h0.w), bfhi(h1.y), bfhi(h1.w)};
    float a0[4] = {bflo(s0.y), bflo(s0.w), bflo(s1.y), bflo(s1.w)};
    float a1[4] = {bfhi(s0.y), bfhi(s0.w), bfhi(s1.y), bfhi(s1.w)};
    float sd = 0.f;
#pragma unroll
    for (int i = 0; i < 4; ++i) {
      float kav = p.rw_k_a[layer * 256 + ch + i], rk = p.rw_r_k[layer * 256 + ch + i];
      float kd0 = k[i] * (1.f + (a0[i] - 1.f) * kav), kd1 = k[i] * (1.f + (a1[i] - 1.f) * kav);
      sd += r[i] * (kd0 + kd1) * rk;
    }
    sd = row16_sum(sd);
    bf16_t* yr = p.Y + (size_t)row * D + 256 + ch;
    uint2 gu = *(const uint2*)yr;
    float g[4] = {bflo(gu.x), bfhi(gu.x), bflo(gu.y), bfhi(gu.y)};
    float o[4];
#pragma unroll
    for (int i = 0; i < 4; ++i) {
      float yn = y[i] * rstd * p.rw_ln_w[layer * 256 + ch + i] + p.rw_ln_b[layer * 256 + ch + i];
      o[i] = (yn + sd * v[i]) * g[i];
#if !EN_RW
      o[i] = 0.f;
#endif
    }
    *(uint2*)yr = make_uint2(pack2(o[0], o[1]), pack2(o[2], o[3]));
  }
}

DEV void hyena_pre_unit(const P& p, int layer, int unit) {
  int kind, b, t0, L;
  if (unit < 1024) { kind = 0; b = unit >> 6; t0 = (unit & 63) * 64; L = T; } else { int u = unit - 1024; kind = 1; b = u >> 2; t0 = (u & 3) * 64; L = LC; }
  const int c = tid_();
  const size_t row0 = (size_t)b * LT + (kind ? 0 : LC);
  const float* cw = p.conv_w + (size_t)layer * 3 * 1536;
  const float* cb = p.conv_b + (size_t)layer * 1536;
  const float w1a = cw[256 + c], w1b = cw[1536 + 256 + c], w1c = cw[3072 + 256 + c], b1 = cb[256 + c];
  const float w2a = cw[512 + c], w2b = cw[1536 + 512 + c], w2c = cw[3072 + 512 + c], b2 = cb[512 + c];
  auto ld = [&](int t, int col) -> float { return (t >= 0 && t < L) ? bf2f(p.Z[(row0 + t) * INW + col]) : 0.f; };
  float x1m = ld(t0 - 1, 256 + c), x1c = ld(t0, 256 + c), vm = ld(t0 - 1, 512 + c), vc = ld(t0, 512 + c);
  bf16_t* dst = (kind ? opq(p.UTc) : opq(p.UTl)) + ((size_t)c * 16 + b) * L + t0;
#pragma unroll 1
  for (int i8 = 0; i8 < 8; ++i8) {
    float uo[8];
#pragma unroll
    for (int i = 0; i < 8; ++i) {
      int t = t0 + i8 * 8 + i;
      float x1n = ld(t + 1, 256 + c), vn = ld(t + 1, 512 + c);
      float a = w1a * x1m + w1b * x1c + w1c * x1n + b1;
      float bb = w2a * vm + w2b * vc + w2c * vn + b2;
      uo[i] = a * bb;
      x1m = x1c; x1c = x1n; vm = vc; vc = vn;
    }
    *(uint4*)(dst + 8 * i8) = pack8(uo);
  }
}

DEV void hyena_conv_unit(const P& p, int layer, int unit, char* smem) {
  int kind, c, tb, L;
  if (unit < 4096) { kind = 0; c = unit >> 4; tb = (unit & 15) * 256; L = T; } else { kind = 1; c = unit - 4096; tb = 0; L = LC; }
  const int tid = tid_(), lane = tid & 63, wid = tid >> 6, fr = lane & 15, fq = lane >> 4;
  float* red = (float*)(smem + 2 * 16512);
  const float* F = (kind ? opq(p.FC) : opq(p.FL)) + (size_t)c * 2 * L;
  float scale;
  {
    float part = 0.f;
    for (int i = tid; i < 2 * L; i += 256) { float fv = F[i]; part += (i != L) ? fv * fv : 0.f; }
    part = wave_sum(part);
    __syncthreads();
    if (lane == 0) red[wid] = part;
    __syncthreads();
    scale = rsqrtf(((red[0] + red[1]) + (red[2] + red[3])) + 1e-6f);
  }
  const bf16_t* U = (kind ? opq(p.UTc) : opq(p.UTl)) + (size_t)c * 16 * L;
  f32x4 acc[4];
#pragma unroll
  for (int m = 0; m < 4; ++m) acc[m] = (f32x4){0.f, 0.f, 0.f, 0.f};
  const int nch = L / 256;
  float fw0, fw1, fw2;
  uint4 ru0, ru1;
  auto ldchunk = [&](int ch) {
    const int sc = ch * 256;
    const int D0 = tb + 256 - sc;
    auto tap = [&](int n) -> float {
      int d = D0 - n;
      float v = 0.f;
      if (d > -L && d < L) v = (d >= 0 ? F[d] : F[L - d]);
      return v;
    };
    fw0 = tap(tid); fw1 = tap(tid + 256); fw2 = (tid < 8) ? tap(tid + 512) : 0.f;
    const int bb = tid >> 4, sg0 = tid & 15;
    ru0 = *(const uint4*)(U + (size_t)bb * L + sc + 8 * sg0);
    ru1 = *(const uint4*)(U + (size_t)bb * L + sc + 8 * (sg0 + 16));
  };
  auto stchunk = [&](int buf) {
    bf16_t* Cq = (bf16_t*)(smem + buf * 16512);
    bf16_t* Us = (bf16_t*)(smem + buf * 16512 + 8320);
    const bf16_t h0 = f2bf(fw0 * scale), h1 = f2bf(fw1 * scale), h2 = f2bf(fw2 * scale);
#pragma unroll
    for (int rho = 0; rho < 8; ++rho) {
      int m = tid + rho;
      Cq[((m >> 3) * 8 + rho) * 8 + (m & 7)] = h0;
      m = tid + 256 + rho;
      if (m < 520) Cq[((m >> 3) * 8 + rho) * 8 + (m & 7)] = h1;
      m = tid + 512 + rho;
      if (tid < 8 && m < 520) Cq[((m >> 3) * 8 + rho) * 8 + (m & 7)] = h2;
    }
    if (tid < 8) {
#pragma unroll
      for (int rho = 1; rho < 8; ++rho) if (tid < rho) Cq[(rho) * 8 + tid] = 0;
    }
    const int bb = tid >> 4, sg0 = tid & 15;
    *(uint4*)&Us[(sg0 * 16 + bb) * 8] = ru0;
    *(uint4*)&Us[((sg0 + 16) * 16 + bb) * 8] = ru1;
  };
  ldchunk(0);
#pragma unroll 1
  for (int ch = 0; ch < nch; ++ch) {
    const int buf = ch & 1;
    stchunk(buf);
    __syncthreads();
    if (ch + 1 < nch) ldchunk(ch + 1);
    const bf16_t* Cq = (const bf16_t*)(smem + buf * 16512);
    const bf16_t* Us = (const bf16_t*)(smem + buf * 16512 + 8320);
#pragma unroll
    for (int kk = 0; kk < 8; ++kk) {
      bf16x8 bf = *(const bf16x8*)&Us[((4 * kk + fq) * 16 + fr) * 8];
#pragma unroll
      for (int m = 0; m < 4; ++m) {
        int it = wid * 4 + m;
        int base = 256 - 16 * it + 32 * kk + 8 * fq;
        int m0 = base - 8 * (fr >> 3);
        bf16x8 af = *(const bf16x8*)&Cq[((m0 >> 3) * 8 + (fr & 7)) * 8];
        acc[m] = mfma16(af, bf, acc[m]);
      }
    }
  }
  __syncthreads();
  bf16_t* Yt = (kind ? opq(p.YTc) : opq(p.YTl)) + ((size_t)c * 16 + fr) * L + tb;
#pragma unroll
  for (int m = 0; m < 4; ++m) {
    int t = (wid * 4 + m) * 16 + fq * 4;
    *(uint2*)(Yt + t) = make_uint2(pack2(acc[m][0], acc[m][1]), pack2(acc[m][2], acc[m][3]));
  }
}

DEV void hyena_post_unit(const P& p, int layer, int unit, char* smem) {
  int kind, b, t0, L;
  if (unit < 1024) { kind = 0; b = unit >> 6; t0 = (unit & 63) * 64; L = T; } else { int u = unit - 1024; kind = 1; b = u >> 2; t0 = (u & 3) * 64; L = LC; }
  const int c = tid_(), lane = c & 63, wid = c >> 6;
  const size_t row0 = (size_t)b * LT + (kind ? 0 : LC);
  bf16_t (*tile)[264] = (bf16_t (*)[264])smem;
  const float* cw = p.conv_w + (size_t)layer * 3 * 1536;
  const float wa = cw[c], wb = cw[1536 + c], wcc = cw[3072 + c], b0 = p.conv_b[layer * 1536 + c];
  const float bias = p.hy_bias[layer * 256 + c];
  const bf16_t* yt = (kind ? opq(p.YTc) : opq(p.YTl)) + ((size_t)c * 16 + b) * L + t0;
  const bf16_t* ut = (kind ? opq(p.UTc) : opq(p.UTl)) + ((size_t)c * 16 + b) * L + t0;
  auto ld = [&](int t) -> float { return (t >= 0 && t < L) ? bf2f(p.Z[(row0 + t) * INW + c]) : 0.f; };
  float xm = ld(t0 - 1), xc = ld(t0);
  __syncthreads();
#pragma unroll 1
  for (int i8 = 0; i8 < 8; ++i8) {
    uint4 yu = *(const uint4*)(yt + 8 * i8), uu = *(const uint4*)(ut + 8 * i8);
    float yv[8], uv[8];
    unpack8(yu, yv); unpack8(uu, uv);
#pragma unroll
    for (int i = 0; i < 8; ++i) {
      int t = t0 + i8 * 8 + i;
      float xn = ld(t + 1);
      float x0 = wa * xm + wb * xc + wcc * xn + b0;
      float o = x0 * (yv[i] + uv[i] * bias);
      tile[i8 * 8 + i][c] = f2bf(o);
      xm = xc; xc = xn;
    }
  }
  __syncthreads();
  for (int i = 0; i < 16; ++i) {
    int tl = wid * 16 + i;
    uint2 ou = *(const uint2*)&tile[tl][4 * lane];
    float o[4] = {bflo(ou.x), bfhi(ou.x), bflo(ou.y), bfhi(ou.y)};
    float ss = wave_sum(o[0] * o[0] + o[1] * o[1] + o[2] * o[2] + o[3] * o[3]);
    float rstd = rsqrtf(ss * (1.f / 256.f) + 1e-6f);
#pragma unroll
    for (int q = 0; q < 4; ++q) {
      o[q] = o[q] * rstd * p.hy_out_g[layer * 256 + 4 * lane + q];
#if !EN_HY
      o[q] = 0.f;
#endif
    }
    *(uint2*)(p.Y + (row0 + t0 + tl) * D + 4 * lane) = make_uint2(pack2(o[0], o[1]), pack2(o[2], o[3]));
  }
}

DEV void attn_unit(const P& p, int layer, int unit, char* smem) {
  const bool isctx = unit >= 4096;
  int b, qb, hq;
  if (!isctx) { b = unit >> 8; qb = (unit >> 3) & 31; hq = unit & 7; } else { int u = unit - 4096; b = u >> 4; qb = (u >> 3) & 1; hq = u & 7; }
  const int g = hq >> 2;
  const int tid = tid_(), lane = tid & 63, wid = tid >> 6, qn = lane & 31, hh = lane >> 5;
  const int qpos = qb * 128 + wid * 32 + qn;
  const size_t qrow = (size_t)b * LT + (isctx ? qpos : LC + qpos);
  const bf16_t* qptr = p.Z + qrow * INW + 1920 + hq * 64;
  bf16x8 qf[4];
#pragma unroll
  for (int s = 0; s < 4; ++s) qf[s] = *(const bf16x8*)(qptr + 16 * s + 8 * hh);
  const float sink = p.attn_sink[layer * 8 + hq];
  float m_run = sink, l_run = 1.f;
  f32x16 o0, o1;
#pragma unroll
  for (int i = 0; i < 16; ++i) { o0[i] = 0.f; o1[i] = 0.f; }
  typedef bf16_t KTile[64][72];
  KTile* Ks = (KTile*)smem;
  KTile* Vt = (KTile*)(smem + 18432);
  const int ntl = isctx ? 0 : 6;
  const int ntiles = ntl + 4;
  const int skey = tid >> 3, sseg = tid & 7;
  const bf16_t* kvbase = p.Z + (size_t)b * LT * INW + 1920 + 512 + g * 64 + sseg * 8;
  uint4 rk0, rk1, rv0, rv1;
  auto ldtile = [&](int kt) {
    const bool ctxk = kt >= ntl;
    const int kbase = ctxk ? (kt - ntl) * 64 : qb * 128 - 128 + kt * 64;
    const int kp0 = kbase + skey, kp1 = kp0 + 32;
    rk0 = rk1 = rv0 = rv1 = make_uint4(0, 0, 0, 0);
    if (ctxk || (kp0 >= 0 && kp0 < T)) { const bf16_t* src = kvbase + (size_t)(ctxk ? kp0 : LC + kp0) * INW; rk0 = *(const uint4*)src; rv0 = *(const uint4*)(src + 128); }
    if (ctxk || (kp1 >= 0 && kp1 < T)) { const bf16_t* src = kvbase + (size_t)(ctxk ? kp1 : LC + kp1) * INW; rk1 = *(const uint4*)src; rv1 = *(const uint4*)(src + 128); }
  };
  auto sttile = [&](int buf) {
    *(uint4*)&Ks[buf][skey][sseg * 8] = rk0;
    *(uint4*)&Ks[buf][skey + 32][sseg * 8] = rk1;
    bf16_t (*vt)[72] = Vt[buf];
    vt[sseg * 8 + 0][skey] = (bf16_t)(rv0.x & 0xFFFF); vt[sseg * 8 + 1][skey] = (bf16_t)(rv0.x >> 16);
    vt[sseg * 8 + 2][skey] = (bf16_t)(rv0.y & 0xFFFF); vt[sseg * 8 + 3][skey] = (bf16_t)(rv0.y >> 16);
    vt[sseg * 8 + 4][skey] = (bf16_t)(rv0.z & 0xFFFF); vt[sseg * 8 + 5][skey] = (bf16_t)(rv0.z >> 16);
    vt[sseg * 8 + 6][skey] = (bf16_t)(rv0.w & 0xFFFF); vt[sseg * 8 + 7][skey] = (bf16_t)(rv0.w >> 16);
    vt[sseg * 8 + 0][skey + 32] = (bf16_t)(rv1.x & 0xFFFF); vt[sseg * 8 + 1][skey + 32] = (bf16_t)(rv1.x >> 16);
    vt[sseg * 8 + 2][skey + 32] = (bf16_t)(rv1.y & 0xFFFF); vt[sseg * 8 + 3][skey + 32] = (bf16_t)(rv1.y >> 16);
    vt[sseg * 8 + 4][skey + 32] = (bf16_t)(rv1.z & 0xFFFF); vt[sseg * 8 + 5][skey + 32] = (bf16_t)(rv1.z >> 16);
    vt[sseg * 8 + 6][skey + 32] = (bf16_t)(rv1.w & 0xFFFF); vt[sseg * 8 + 7][skey + 32] = (bf16_t)(rv1.w >> 16);
  };
  ldtile(0);
#pragma unroll 1
  for (int kt = 0; kt < ntiles; ++kt) {
    const int buf = kt & 1;
    sttile(buf);
    __syncthreads();
    if (kt + 1 < ntiles) ldtile(kt + 1);
    const bool ctxk = kt >= ntl;
    const int kbase = ctxk ? (kt - ntl) * 64 : qb * 128 - 128 + kt * 64;
#pragma unroll
    for (int sub = 0; sub < 2; ++sub) {
      const int kb2 = kbase + sub * 32;
      bool need = true;
      if (!ctxk) {
        int q0 = qb * 128 + wid * 32;
        if (kb2 + 31 < q0 - 128 || kb2 > q0 + 31 + 128 || kb2 + 31 < 0 || kb2 >= T) need = false;
      }
      if (need) {
        f32x16 sv;
#pragma unroll
        for (int i = 0; i < 16; ++i) sv[i] = 0.f;
#pragma unroll
        for (int ks = 0; ks < 4; ++ks) {
          bf16x8 kf = *(const bf16x8*)&Ks[buf][sub * 32 + qn][16 * ks + 8 * hh];
          sv = mfma32(kf, qf[ks], sv);
        }
        float mt = -3e38f;
#pragma unroll
        for (int rg = 0; rg < 16; ++rg) {
          float v = sv[rg] * 0.125f;
          if (!ctxk) {
            int kp = kb2 + (rg & 3) + 8 * (rg >> 2) + 4 * hh;
            int dl = qpos - kp;
            bool ok = (dl <= 128) && (dl >= -128) && (kp >= 0) && (kp < T);
            v = ok ? v : -1e30f;
          }
          sv[rg] = v;
          mt = fmaxf(mt, v);
        }
        mt = fmaxf(mt, __shfl_xor(mt, 32));
        float m_new = fmaxf(m_run, mt);
        float corr = __expf(m_run - m_new);
        float ps = 0.f;
#pragma unroll
        for (int rg = 0; rg < 16; ++rg) { float pv = __expf(sv[rg] - m_new); sv[rg] = pv; ps += pv; }
        ps += __shfl_xor(ps, 32);
        l_run = l_run * corr + ps;
        m_run = m_new;
#pragma unroll
        for (int i = 0; i < 16; ++i) { o0[i] *= corr; o1[i] *= corr; }
#pragma unroll
        for (int sp = 0; sp < 2; ++sp) {
          bf16x8 pf;
#pragma unroll
          for (int j = 0; j < 8; ++j) pf[j] = (short)f2bf(sv[8 * sp + j]);
          const int kc = sub * 32 + 16 * sp + 4 * hh;
          uint2 va = *(const uint2*)&Vt[buf][qn][kc], vb = *(const uint2*)&Vt[buf][qn][kc + 8];
          uint2 vc = *(const uint2*)&Vt[buf][32 + qn][kc], vd = *(const uint2*)&Vt[buf][32 + qn][kc + 8];
          uint4 w0 = make_uint4(va.x, va.y, vb.x, vb.y), w1 = make_uint4(vc.x, vc.y, vd.x, vd.y);
          bf16x8 v0 = __builtin_bit_cast(bf16x8, w0), v1 = __builtin_bit_cast(bf16x8, w1);
          o0 = mfma32(v0, pf, o0);
          o1 = mfma32(v1, pf, o1);
        }
      }
    }
  }
  __syncthreads();
  const float inv = 1.f / l_run;
  bf16_t* optr = p.Y + qrow * D + 512 + hq * 64;
#pragma unroll
  for (int rg = 0; rg < 4; ++rg) {
    int d0 = 8 * rg + 4 * hh;
    *(uint2*)(optr + d0) = make_uint2(pack2(o0[4 * rg] * inv, o0[4 * rg + 1] * inv), pack2(o0[4 * rg + 2] * inv, o0[4 * rg + 3] * inv));
    *(uint2*)(optr + 32 + d0) = make_uint2(pack2(o1[4 * rg] * inv, o1[4 * rg + 1] * inv), pack2(o1[4 * rg + 2] * inv, o1[4 * rg + 3] * inv));
  }
}

DEV void ph_attn_post(const P& p, int layer) {
  const int gw = (bid_() * 256 + tid_()) >> 6, nw = gridDim.x * 4, lane = tid_() & 63;
  for (int row = gw; row < NTOK; row += nw) {
    bf16_t* yr = p.Y + (size_t)row * D + 512 + 8 * lane;
    uint4 u = *(const uint4*)yr;
    float v[8];
    unpack8(u, v);
    float ss = 0.f;
#pragma unroll
    for (int i = 0; i < 8; ++i) ss += v[i] * v[i];
    ss = wave_sum(ss);
    float rstd = rsqrtf(ss * (1.f / 512.f) + 1e-6f);
#pragma unroll
    for (int i = 0; i < 8; ++i) {
      v[i] = v[i] * rstd * p.at_out_g[layer * 512 + 8 * lane + i];
#if !EN_AT
      v[i] = 0.f;
#endif
    }
    *(uint4*)yr = pack8(v);
  }
}

struct Epi2 {
  const P& p; int layer, row0, col0;
  DEV void operator()(f32x4 (&acc)[4][4], int wr, int wc, int fr, int fq, char* smem) const {
    const int b = row0 / LT, pp = row0 % LT;
    const int mr = pp < LC ? 16 : b;
    const float* g1 = p.modv + ((size_t)layer * 17 + mr) * 6144 + 2048 + col0 + wc * 64;
#pragma unroll
    for (int n = 0; n < 4; ++n) {
      const float gv = g1[n * 16 + fr];
#pragma unroll
      for (int m = 0; m < 4; ++m)
#pragma unroll
        for (int j = 0; j < 4; ++j) acc[m][n][j] *= gv;
    }
    const int wid = wr * 2 + wc, lane = fq * 16 + fr;
    stage_tile_bf16(acc, smem, wid, fr, fq);
    const bf16_t (*t)[72] = (const bf16_t (*)[72])(smem + wid * 9216);
#pragma unroll
    for (int i = 0; i < 8; ++i) {
      const int rl = i * 8 + (lane >> 3), ch = lane & 7;
      bf16_t* xp = p.X + (size_t)(row0 + wr * 64 + rl) * D + col0 + wc * 64 + ch * 8;
      float xv[8], dv[8];
      uint4 xu = *(const uint4*)xp, du = *(const uint4*)&t[rl][ch * 8];
      unpack8(xu, xv); unpack8(du, dv);
#pragma unroll
      for (int q = 0; q < 8; ++q) xv[q] += dv[q];
#if EN_MIX
      *(uint4*)xp = pack8(xv);
#endif
    }
  }
};
DEV void ph_gemm2(const P& p, int layer, char* smem) {
  for (int u = bid_(); u < (NTOK / 128) * 8; u += gridDim.x) {
    int rt = u >> 3, ct = u & 7;
    Epi2 epi{p, layer, rt * 128, ct * 128};
    gemm_tile(p.Y + (size_t)rt * 128 * D, D, p.W2t + (size_t)ct * 128 * D, D, D, smem, epi);
  }
}

DEV void ph_peerconv(const P& p, int layer) {
  const int gw = (bid_() * 256 + tid_()) >> 6, nw = gridDim.x * 4, lane = tid_() & 63;
  const float* su = opq(p.peer_u) + (size_t)layer * 16384 * 1024;
  const float* sv = opq(p.peer_v) + (size_t)layer * 16384 * 1024;
  unsigned char* pu = opq(p.PU); unsigned char* pv = opq(p.PV);
  float* psu = opq(p.PSU); float* psv = opq(p.PSV);
#pragma unroll 1
  for (int r = gw; r < 32768; r += nw) {
    const bool isv = r >= 16384;
    const int e = r & 16383;
    const float* src = (isv ? sv : su) + (size_t)e * 1024 + 16 * lane;
    float4 f0 = *(const float4*)src, f1 = *(const float4*)(src + 4), f2 = *(const float4*)(src + 8), f3 = *(const float4*)(src + 12);
    float am = fmaxf(fmaxf(fmaxf(fabsf(f0.x), fabsf(f0.y)), fmaxf(fabsf(f0.z), fabsf(f0.w))), fmaxf(fmaxf(fabsf(f1.x), fabsf(f1.y)), fmaxf(fabsf(f1.z), fabsf(f1.w))));
    am = fmaxf(am, fmaxf(fmaxf(fmaxf(fabsf(f2.x), fabsf(f2.y)), fmaxf(fabsf(f2.z), fabsf(f2.w))), fmaxf(fmaxf(fabsf(f3.x), fabsf(f3.y)), fmaxf(fabsf(f3.z), fabsf(f3.w)))));
    am = wave_max(am);
    const float sc = am > 0.f ? 224.f / am : 1.f;
    int w0 = __builtin_amdgcn_cvt_pk_fp8_f32(f0.x * sc, f0.y * sc, 0, false); w0 = __builtin_amdgcn_cvt_pk_fp8_f32(f0.z * sc, f0.w * sc, w0, true);
    int w1 = __builtin_amdgcn_cvt_pk_fp8_f32(f1.x * sc, f1.y * sc, 0, false); w1 = __builtin_amdgcn_cvt_pk_fp8_f32(f1.z * sc, f1.w * sc, w1, true);
    int w2 = __builtin_amdgcn_cvt_pk_fp8_f32(f2.x * sc, f2.y * sc, 0, false); w2 = __builtin_amdgcn_cvt_pk_fp8_f32(f2.z * sc, f2.w * sc, w2, true);
    int w3 = __builtin_amdgcn_cvt_pk_fp8_f32(f3.x * sc, f3.y * sc, 0, false); w3 = __builtin_amdgcn_cvt_pk_fp8_f32(f3.z * sc, f3.w * sc, w3, true);
    *(uint4*)((isv ? pv : pu) + (size_t)e * 1024 + 16 * lane) = make_uint4((unsigned)w0, (unsigned)w1, (unsigned)w2, (unsigned)w3);
    if (lane == 0) (isv ? psv : psu)[e] = am > 0.f ? am * (1.f / 224.f) : 1.f;
  }
}
DEV void unpack16_fp8(const uint4& u, float* f) {
  f32x2 t;
  t = __builtin_amdgcn_cvt_pk_f32_fp8((int)u.x, false); f[0] = t[0]; f[1] = t[1];
  t = __builtin_amdgcn_cvt_pk_f32_fp8((int)u.x, true); f[2] = t[0]; f[3] = t[1];
  t = __builtin_amdgcn_cvt_pk_f32_fp8((int)u.y, false); f[4] = t[0]; f[5] = t[1];
  t = __builtin_amdgcn_cvt_pk_f32_fp8((int)u.y, true); f[6] = t[0]; f[7] = t[1];
  t = __builtin_amdgcn_cvt_pk_f32_fp8((int)u.z, false); f[8] = t[0]; f[9] = t[1];
  t = __builtin_amdgcn_cvt_pk_f32_fp8((int)u.z, true); f[10] = t[0]; f[11] = t[1];
  t = __builtin_amdgcn_cvt_pk_f32_fp8((int)u.w, false); f[12] = t[0]; f[13] = t[1];
  t = __builtin_amdgcn_cvt_pk_f32_fp8((int)u.w, true); f[14] = t[0]; f[15] = t[1];
}

struct Epi3 {
  const P& p; int row0, grp;
  DEV void operator()(f32x4 (&acc)[4][4], int wr, int wc, int fr, int fq, char* smem) const {
    float* sc = (float*)smem;
    const int tid = tid_();
    for (int pass = 0; pass < 2; ++pass) {
      __syncthreads();
      if (wr == pass) {
#pragma unroll
        for (int m = 0; m < 4; ++m)
#pragma unroll
          for (int n = 0; n < 4; ++n)
#pragma unroll
            for (int j = 0; j < 4; ++j) {
              int rl = m * 16 + fq * 4 + j, col = wc * 64 + n * 16 + fr;
              unsigned bits = (__float_as_uint(acc[m][n][j]) & ~127u) | (unsigned)col;
              sc[rl * 133 + (col >> 5) * 33 + (col & 31)] = __uint_as_float(bits);
            }
      }
      __syncthreads();
      const int rl = tid >> 2, q = tid & 3;
      float Ls[16];
#pragma unroll
      for (int i = 0; i < 16; ++i) Ls[i] = -3e38f;
      const float* src = sc + rl * 133 + q * 33;
      for (int i = 0; i < 32; ++i) {
        float x = src[i];
        if (x > Ls[15]) {
#pragma unroll
          for (int k = 0; k < 16; ++k) { float hi = fmaxf(Ls[k], x); x = fminf(Ls[k], x); Ls[k] = hi; }
        }
      }
      float Cs[16];
#pragma unroll
      for (int i = 0; i < 16; ++i) Cs[i] = fmaxf(Ls[i], dppself<0xB1, 0xF>(Ls[15 - i]));
#pragma unroll
      for (int d = 8; d >= 1; d >>= 1)
#pragma unroll
        for (int i = 0; i < 16; ++i)
          if ((i & d) == 0) { float hi = fmaxf(Cs[i], Cs[i + d]), lo = fminf(Cs[i], Cs[i + d]); Cs[i] = hi; Cs[i + d] = lo; }
      float Ds[16];
#pragma unroll
      for (int i = 0; i < 16; ++i) Ds[i] = fmaxf(Cs[i], dppself<0x4E, 0xF>(Cs[15 - i]));
      if (q == 0) {
        float* dst = p.TK + ((size_t)(row0 + pass * 64 + rl) * 16 + grp) * 16;
#pragma unroll
        for (int i = 0; i < 4; ++i) *(float4*)(dst + 4 * i) = make_float4(Ds[4 * i], Ds[4 * i + 1], Ds[4 * i + 2], Ds[4 * i + 3]);
      }
    }
  }
};
DEV void ph_gemm3(const P& p, char* smem) {
  for (int u = bid_(); u < (NTOK / 128) * 16; u += gridDim.x) {
    int rt = u >> 4, ct = u & 15;
    Epi3 epi{p, rt * 128, ct};
    gemm_tile(p.H + (size_t)rt * 128 * D, D, p.Wft + (size_t)ct * 128 * D, D, D, smem, epi);
  }
}

DEV void peer_select4(const float* tk, int hbase, int lane, float& scr, int& er) {
#pragma unroll 1
  for (int hq = 0; hq < 4; ++hq) {
    const int h = hbase + hq;
    const float v1 = tk[(2 * h) * 16 + (lane >> 2)];
    const float4 v2 = *(const float4*)(tk + (2 * h + 1) * 16 + 4 * (lane & 3));
    float c0 = v1 + v2.x, c1 = v1 + v2.y, c2 = v1 + v2.z, c3 = v1 + v2.w;
    const int i1 = (int)(__float_as_uint(v1) & 127u);
#pragma unroll 1
    for (int r = 0; r < 16; ++r) {
      float m = fmaxf(fmaxf(c0, c1), fmaxf(c2, c3));
      float wm = wave_max(m);
      unsigned long long bal = __ballot(m == wm);
      int wl = __ffsll((long long)bal) - 1;
      int jsel = (c0 == wm) ? 0 : (c1 == wm) ? 1 : (c2 == wm) ? 2 : 3;
      float v2sel = jsel == 0 ? v2.x : jsel == 1 ? v2.y : jsel == 2 ? v2.z : v2.w;
      int el = i1 * 128 + (int)(__float_as_uint(v2sel) & 127u);
      int ew = __builtin_amdgcn_readlane(el, wl);
      if (lane == wl) {
        if (jsel == 0) c0 = -3e38f; else if (jsel == 1) c1 = -3e38f; else if (jsel == 2) c2 = -3e38f; else c3 = -3e38f;
      }
      const int sl = hq * 16 + r;
      scr = (lane == sl) ? wm : scr;
      er = (lane == sl) ? ew : er;
    }
  }
}
DEV float peer_udots(const P& p, int er, const float* hv, int lane) {
  float dots = 0.f;
#pragma unroll 1
  for (int k16 = 0; k16 < 4; ++k16) {
    uint4 ua[16];
    float sc[16];
#pragma unroll
    for (int j = 0; j < 16; ++j) {
      int e = __builtin_amdgcn_readlane(er, k16 * 16 + j);
      ua[j] = *(const uint4*)(p.PU + (size_t)e * 1024 + 16 * lane);
      sc[j] = p.PSU[e];
    }
#pragma unroll
    for (int j = 0; j < 16; ++j) {
      float f[16];
      unpack16_fp8(ua[j], f);
      float d0 = 0.f, d1 = 0.f;
#pragma unroll
      for (int i = 0; i < 16; i += 2) { d0 += f[i] * hv[i]; d1 += f[i + 1] * hv[i + 1]; }
      float d = wave_sum(d0 + d1) * sc[j];
      dots = (lane == k16 * 16 + j) ? d : dots;
    }
  }
  return dots;
}
DEV void peer_vacc(const P& p, int er, float wk, float* outv, int lane) {
#pragma unroll 1
  for (int k16 = 0; k16 < 4; ++k16) {
    uint4 ua[16];
    float ws[16];
#pragma unroll
    for (int j = 0; j < 16; ++j) {
      int e = __builtin_amdgcn_readlane(er, k16 * 16 + j);
      ua[j] = *(const uint4*)(p.PV + (size_t)e * 1024 + 16 * lane);
      ws[j] = readlane_f(wk, k16 * 16 + j) * p.PSV[e];
    }
#pragma unroll
    for (int j = 0; j < 16; ++j) {
      float f[16];
      unpack16_fp8(ua[j], f);
#pragma unroll
      for (int i = 0; i < 16; ++i) outv[i] += ws[j] * f[i];
    }
  }
}
DEV float peer_gate(float scr) {
  float mx = row16_max(scr);
  float ex = __expf(scr - mx);
  float sm = row16_sum(ex);
  return ex / sm;
}
DEV float gelu_exact(float x) { return 0.5f * x * (1.f + erff(x * 0.7071067811865476f)); }

DEV void ph_peer(const P& p, int layer, bool dowrite = true) {
  const int gw = (bid_() * 256 + tid_()) >> 6, nw = gridDim.x * 4, lane = tid_() & 63;
#pragma unroll 1
  for (int row = gw; row < NTOK; row += nw) {
    const float* tk = p.TK + (size_t)row * 256;
    float scr0 = 0.f, scr1 = 0.f;
    int er0 = 0, er1 = 0;
    peer_select4(tk, 0, lane, scr0, er0);
    peer_select4(tk, 4, lane, scr1, er1);
    const float gate0 = peer_gate(scr0), gate1 = peer_gate(scr1);
    const bf16_t* hr = p.H + (size_t)row * D;
    float hv[16];
    { uint4 u0 = *(const uint4*)(hr + 16 * lane), u1 = *(const uint4*)(hr + 16 * lane + 8); unpack8(u0, hv); unpack8(u1, hv + 8); }
    const float wk0 = gate0 * gelu_exact(peer_udots(p, er0, hv, lane));
    const float wk1 = gate1 * gelu_exact(peer_udots(p, er1, hv, lane));
    float outv[16];
#pragma unroll
    for (int i = 0; i < 16; ++i) outv[i] = 0.f;
    peer_vacc(p, er0, wk0, outv, lane);
    peer_vacc(p, er1, wk1, outv, lane);
    int b = row / LT, pp = row % LT;
    int mr = pp < LC ? 16 : b;
    const float* g2 = p.modv + ((size_t)layer * 17 + mr) * 6144 + 5120;
    bf16_t* xr = p.X + (size_t)row * D;
    float xv[16];
    { uint4 u0 = *(const uint4*)(xr + 16 * lane), u1 = *(const uint4*)(xr + 16 * lane + 8); unpack8(u0, xv); unpack8(u1, xv + 8); }
#pragma unroll
    for (int i = 0; i < 16; ++i) xv[i] += g2[16 * lane + i] * outv[i];
#if EN_PEER
    if (dowrite) {
      *(uint4*)(xr + 16 * lane) = pack8(xv);
      *(uint4*)(xr + 16 * lane + 8) = pack8(xv + 8);
    } else {
      float tsum = 0.f;
#pragma unroll
      for (int i = 0; i < 16; ++i) tsum += xv[i];
      asm volatile("" ::"v"(tsum));
    }
#endif
  }
}

DEV void ph_final(const P& p) {
  const int gw = (bid_() * 256 + tid_()) >> 6, nw = gridDim.x * 4, lane = tid_() & 63;
  for (int r = gw; r < NB * T; r += nw) {
    int b = r / T, t = r % T;
    const bf16_t* xr = p.X + ((size_t)b * LT + LC + t) * D;
    uint4 u0 = *(const uint4*)(xr + 8 * lane), u1 = *(const uint4*)(xr + 512 + 8 * lane);
    float v[16];
    unpack8(u0, v); unpack8(u1, v + 8);
    float ss = 0.f;
#pragma unroll
    for (int i = 0; i < 16; ++i) ss += v[i] * v[i];
    ss = wave_sum(ss);
    float rstd = rsqrtf(ss * (1.f / 1024.f) + 1e-6f);
    float* o = p.out + (size_t)r * D;
#pragma unroll
    for (int hh = 0; hh < 2; ++hh) {
      int col = hh * 512 + 8 * lane;
      float4 a = make_float4(v[hh * 8 + 0] * rstd * p.final_g[col + 0], v[hh * 8 + 1] * rstd * p.final_g[col + 1], v[hh * 8 + 2] * rstd * p.final_g[col + 2], v[hh * 8 + 3] * rstd * p.final_g[col + 3]);
      float4 c = make_float4(v[hh * 8 + 4] * rstd * p.final_g[col + 4], v[hh * 8 + 5] * rstd * p.final_g[col + 5], v[hh * 8 + 6] * rstd * p.final_g[col + 6], v[hh * 8 + 7] * rstd * p.final_g[col + 7]);
      *(float4*)(o + col) = a; *(float4*)(o + col + 4) = c;
    }
  }
}

DEV unsigned hw_cu_key() {
  const unsigned hwid = (unsigned)__builtin_amdgcn_s_getreg(((8 - 1) << 11) | (8 << 6) | 4);
  return (xb_xcc_id() << 8) | (hwid & 0xFFu);
}
DEV void mixB(const P& p, int layer, char* smem, volatile LAS unsigned* slot) {
  unsigned* qa = p.wq + layer * 64;
  unsigned* qs = qa + 16;
  unsigned* claim = p.cuclaim + layer * 4096;
  __syncthreads();
  if (tid_() == 0) {
    unsigned u = 0xFFFFFFFFu;
    if (atomicAdd(&claim[hw_cu_key() & 4095u], 1u) == 0u) u = atomicAdd(qs, 1u);
    *slot = u;
  }
  __syncthreads();
  {
    const unsigned u = *slot;
    if (u < 256u) scan_unit(p, layer, (int)u, smem);
  }
  for (;;) {
    __syncthreads();
    if (tid_() == 0) *slot = atomicAdd(qa, 1u);
    __syncthreads();
    const int u = (int)*slot;
    if (u >= 8704) break;
    if (u < 4352) attn_unit(p, layer, u, smem); else hyena_conv_unit(p, layer, u - 4352, smem);
  }
  for (;;) {
    __syncthreads();
    if (tid_() == 0) *slot = atomicAdd(qs, 1u);
    __syncthreads();
    const unsigned u = *slot;
    if (u >= 256u) break;
    scan_unit(p, layer, (int)u, smem);
  }
}
DEV void mixA(const P& p, int layer, char* smem) {
  for (int u = bid_(); u < 1088 + 5440; u += gridDim.x) {
    if (u < 1088) hyena_pre_unit(p, layer, u); else lora_unit(p, layer, u - 1088, smem);
  }
  ph_rwkv_prep(p, layer);
}
DEV void mixC(const P& p, int layer, char* smem) {
  for (int u = bid_(); u < 1088; u += gridDim.x) hyena_post_unit(p, layer, u, smem);
  ph_rwkv_post(p, layer);
  ph_attn_post(p, layer);
}

__global__ void __launch_bounds__(256, 2) k_mega(P p) {
  extern __shared__ __attribute__((aligned(16))) char smem_all[];
  char* smem = smem_all;
  volatile LAS unsigned* xbw = (volatile LAS unsigned*)(smem_all + SMEM_BYTES);
  if (threadIdx.x == 0) { xbw[0] = 0u; xbw[1] = 0u; xbw[2] = 0u; xbw[3] = 0u; }
  __syncthreads();
  XcdBarrier bar = xcd_barrier_post(p.bar, xbw);
#ifndef NO_PRO
  ph_copy(p);
  ph_rope(p);
  for (int u = blockIdx.x; u < 96; u += gridDim.x) modv_unit(p, u, smem);
#endif
#ifndef NO_PREP
  ph_prep(p, 0, smem);
#endif
  xcd_barrier(bar);
  for (int layer = 0; layer < NLAYERS; ++layer) {
#ifndef NO_NORM
    ph_norm(p, layer, 0);
#endif
    xcd_barrier(bar);
#ifdef PROBE_GEMM
    ph_gemm1(p, smem);
#endif
#ifndef NO_GEMM1
    ph_gemm1(p, smem);
#endif
    xcd_barrier(bar);
#ifndef NO_MIXA
    mixA(p, layer, smem);
#endif
    xcd_barrier(bar);
#ifndef NO_MIXB
    mixB(p, layer, smem, (volatile LAS unsigned*)(smem_all + SMEM_BYTES + 16));
#endif
    xcd_barrier(bar);
#ifndef NO_MIXC
    mixC(p, layer, smem);
#endif
    xcd_barrier(bar);
#ifndef NO_GEMM2
    ph_gemm2(p, layer, smem);
    ph_peerconv(p, layer);
#endif
    xcd_barrier(bar);
#ifndef NO_NORM
    ph_norm(p, layer, 1);
#endif
    xcd_barrier(bar);
#ifdef PROBE_GEMM
    ph_gemm3(p, smem);
#endif
#ifndef NO_GEMM3
    ph_gemm3(p, smem);
#endif
    xcd_barrier(bar);
#ifdef PROBE_PEER
    ph_peer(p, layer, false);
#endif
#ifndef NO_PEER
    ph_peer(p, layer);
#endif
#ifndef NO_PREP
    if (layer + 1 < NLAYERS) ph_prep(p, layer + 1, smem);
#endif
    xcd_barrier(bar);
  }
  ph_final(p);
}

static inline size_t al256(size_t x) { return (x + 255) & ~(size_t)255; }

extern "C" void kernel_launch(void* const* d_in, const int* in_sizes, int n_in, void* d_out, int out_size, void* d_ws, size_t ws_size,
                              hipStream_t stream) {
  (void)in_sizes; (void)n_in; (void)out_size; (void)ws_size;
  P p{};
  const float** f = (const float**)&p;
  for (int i = 0; i < 39; ++i) f[i] = (const float*)d_in[i];
  p.out = (float*)d_out;
  char* w = (char*)d_ws;
  size_t off = 0;
  auto take = [&](size_t bytes) { char* r = w + off; off += al256(bytes); return r; };
  p.bar = (unsigned*)take(16384);
  p.modv = (float*)take((size_t)DEPTH * 17 * 6144 * 4);
  p.SSQ = (float*)take((size_t)DEPTH * 2 * 256 * 4);
  p.wq = (unsigned*)take(1024);
  p.cuclaim = (unsigned*)take((size_t)DEPTH * 4096 * 4);
  const size_t zero_bytes = off;
  p.rope = (float*)take(64 * 16 * 2 * 4);
  p.X = (bf16_t*)take((size_t)NTOK * D * 2);
  p.H = (bf16_t*)take((size_t)NTOK * D * 2);
  p.Y = (bf16_t*)take((size_t)NTOK * D * 2);
  p.SC = (bf16_t*)take((size_t)NTOK * 1024 * 2);
  p.Z = (bf16_t*)take((size_t)NTOK * INW * 2);
  p.UTl = (bf16_t*)take((size_t)256 * 16 * T * 2);
  p.UTc = (bf16_t*)take((size_t)256 * 16 * LC * 2);
  p.YTl = (bf16_t*)take((size_t)256 * 16 * T * 2);
  p.YTc = (bf16_t*)take((size_t)256 * 16 * LC * 2);
  p.FL = (float*)take((size_t)256 * 2 * T * 4);
  p.FC = (float*)take((size_t)256 * 2 * LC * 4);
  p.W1t = (bf16_t*)take((size_t)INW * D * 2);
  p.W2t = (bf16_t*)take((size_t)D * D * 2);
  p.Wft = (bf16_t*)take((size_t)2048 * D * 2);
  p.Wwt = (bf16_t*)take((size_t)2 * 256 * 64 * 2);
  p.Wat = (bf16_t*)take((size_t)2 * 256 * 64 * 2);
  p.Wgt = (bf16_t*)take((size_t)256 * 128 * 2);
  p.TK = (float*)p.Z;
  p.PU = (unsigned char*)p.Z + al256((size_t)NTOK * 256 * 4);
  p.PV = p.PU + (size_t)16384 * 1024;
  p.PSU = (float*)(p.PV + (size_t)16384 * 1024);
  p.PSV = p.PSU + 16384;

  (void)hipMemsetAsync(d_ws, 0, zero_bytes, stream);
  constexpr size_t kDynLds = SMEM_BYTES + 32;
  static int grid = 0;
  if (!grid) {
    int dev = 0, cus = 0, per_cu = 0;
    (void)hipGetDevice(&dev);
    (void)hipDeviceGetAttribute(&cus, hipDeviceAttributeMultiprocessorCount, dev);
    (void)hipFuncSetAttribute((const void*)k_mega, hipFuncAttributeMaxDynamicSharedMemorySize, (int)kDynLds);
    (void)hipOccupancyMaxActiveBlocksPerMultiprocessor(&per_cu, k_mega, 256, kDynLds);
    if (cus <= 0) cus = 256;
    if (per_cu > 2) per_cu = 2;
    if (per_cu < 1) per_cu = 1;
    grid = cus * per_cu;
  }
  k_mega<<<grid, 256, kDynLds, stream>>>(p);
}
```

```cpp
#include <hip/hip_runtime.h>
#include <stdint.h>

#define DEV __device__ __forceinline__
typedef unsigned short bf16_t;
typedef short bf16x8 __attribute__((ext_vector_type(8)));
typedef float f32x2 __attribute__((ext_vector_type(2)));
constexpr size_t PSLICE = (size_t)16384 * 128;
typedef float f32x4 __attribute__((ext_vector_type(4)));
typedef float f32x16 __attribute__((ext_vector_type(16)));

#ifndef NLAYERS
#define NLAYERS 4
#endif
#ifndef EN_HY
#define EN_HY 1
#endif
#ifndef EN_RW
#define EN_RW 1
#endif
#ifndef EN_AT
#define EN_AT 1
#endif
#ifndef EN_MIX
#define EN_MIX 1
#endif
#ifndef EN_PEER
#define EN_PEER 1
#endif

constexpr int NB = 16, T = 4096, LC = 256, LT = 4352, D = 1024, NTOK = NB * LT, INW = 2688, DEPTH = 4;
constexpr int SMEM_BYTES = 65536;

struct P {
  const float *x, *c, *ctx, *c_ctx, *mod_w, *mod_b, *norm1_g, *norm2_g, *w_in, *conv_w, *conv_b;
  const float *hy_w1, *hy_b1, *hy_w2, *hy_b2, *hy_w3, *hy_b3, *hy_freq, *hy_bias;
  const float *rw_w0, *rw_w_up, *rw_a0, *rw_a_up, *rw_g_up, *rw_k_k, *rw_k_a, *rw_r_k, *rw_ln_w, *rw_ln_b;
  const float *attn_sink, *hy_out_g, *at_out_g, *w_out, *peer_wq, *peer_k1, *peer_k2, *peer_u, *peer_v, *final_g;
  float* out;
  unsigned* bar;
  float *modv, *SSQ, *rope, *FL, *FC, *TK;
  unsigned *wq, *cuclaim;
  bf16_t *X, *H, *Y, *SC, *Z, *UTl, *UTc, *YTl, *YTc;
  bf16_t *W1t, *W2t, *Wft, *Wwt, *Wat, *Wgt;
  unsigned char *PU, *PV;
  float *PSU, *PSV, *GT, *PD;
  unsigned short* EL;
};

DEV bf16_t f2bf(float f) { unsigned u = __float_as_uint(f); u += 0x7FFFu + ((u >> 16) & 1u); return (bf16_t)(u >> 16); }
DEV float bf2f(bf16_t h) { return __uint_as_float(((unsigned)h) << 16); }
DEV unsigned pack2(float a, float b) { return (unsigned)f2bf(a) | ((unsigned)f2bf(b) << 16); }
DEV float bflo(unsigned u) { return __uint_as_float(u << 16); }
DEV float bfhi(unsigned u) { return __uint_as_float(u & 0xFFFF0000u); }
DEV void unpack8(const uint4& u, float* v) {
  v[0] = bflo(u.x); v[1] = bfhi(u.x); v[2] = bflo(u.y); v[3] = bfhi(u.y);
  v[4] = bflo(u.z); v[5] = bfhi(u.z); v[6] = bflo(u.w); v[7] = bfhi(u.w);
}
DEV uint4 pack8(const float* v) { return make_uint4(pack2(v[0], v[1]), pack2(v[2], v[3]), pack2(v[4], v[5]), pack2(v[6], v[7])); }
DEV float sigmoidf_(float x) { return 1.f / (1.f + __expf(-x)); }

template <int CTRL, int ROWMASK>
DEV float dpp0(float x) {
  return __builtin_bit_cast(float, __builtin_amdgcn_update_dpp(0, __builtin_bit_cast(int, x), CTRL, ROWMASK, 0xF, false));
}
template <int CTRL, int ROWMASK>
DEV float dppself(float x) {
  int xi = __builtin_bit_cast(int, x);
  return __builtin_bit_cast(float, __builtin_amdgcn_update_dpp(xi, xi, CTRL, ROWMASK, 0xF, false));
}
DEV float readlane_f(float x, int l) { return __builtin_bit_cast(float, __builtin_amdgcn_readlane(__builtin_bit_cast(int, x), l)); }
DEV int lane_id() { return (int)__builtin_amdgcn_mbcnt_hi(~0u, __builtin_amdgcn_mbcnt_lo(~0u, 0u)); }
DEV float writelane_f(float val, int l, float old) { return lane_id() == l ? val : old; }
DEV int writelane_i(int val, int l, int old) { return lane_id() == l ? val : old; }
DEV float wave_sum(float x) {
  x += dpp0<0x111, 0xF>(x); x += dpp0<0x112, 0xF>(x); x += dpp0<0x114, 0xF>(x); x += dpp0<0x118, 0xF>(x);
  x += dpp0<0x142, 0xA>(x); x += dpp0<0x143, 0xC>(x);
  return readlane_f(x, 63);
}
DEV float wave_max(float x) {
  x = fmaxf(x, dppself<0x111, 0xF>(x)); x = fmaxf(x, dppself<0x112, 0xF>(x)); x = fmaxf(x, dppself<0x114, 0xF>(x));
  x = fmaxf(x, dppself<0x118, 0xF>(x)); x = fmaxf(x, dppself<0x142, 0xA>(x)); x = fmaxf(x, dppself<0x143, 0xC>(x));
  return readlane_f(x, 63);
}
DEV float row16_sum(float x) {
  x += dpp0<0xB1, 0xF>(x); x += dpp0<0x4E, 0xF>(x); x += dpp0<0x141, 0xF>(x); x += dpp0<0x140, 0xF>(x);
  return x;
}
DEV float row16_max(float x) {
  x = fmaxf(x, dppself<0xB1, 0xF>(x)); x = fmaxf(x, dppself<0x4E, 0xF>(x)); x = fmaxf(x, dppself<0x141, 0xF>(x));
  x = fmaxf(x, dppself<0x140, 0xF>(x));
  return x;
}
DEV float quad_sum(float x) { x += dpp0<0xB1, 0xF>(x); x += dpp0<0x4E, 0xF>(x); return x; }

DEV f32x4 mfma16(bf16x8 a, bf16x8 b, f32x4 c) { return __builtin_amdgcn_mfma_f32_16x16x32_bf16(a, b, c, 0, 0, 0); }
DEV f32x16 mfma32(bf16x8 a, bf16x8 b, f32x16 c) { return __builtin_amdgcn_mfma_f32_32x32x16_bf16(a, b, c, 0, 0, 0); }


#define XB_TMO      128
#define XB_XCNT(j)  (256  + 64 * (j))
#define XB_XSUB(j)  (1280 + 64 * (j))
#define XB_XGEN(j)  (2304 + 64 * (j))
#define XB_TOP      3328
#define XB_TOPGEN   3392
#define XCD_BAR_WORDS 3456
#define XB_SPIN_CAP (1u << 23)
#define LAS __attribute__((address_space(3)))

__device__ __forceinline__ unsigned xb_ld(unsigned* p)              { return __hip_atomic_load(p, __ATOMIC_RELAXED, __HIP_MEMORY_SCOPE_AGENT); }
__device__ __forceinline__ unsigned xb_add(unsigned* p, unsigned v) { return __hip_atomic_fetch_add(p, v, __ATOMIC_RELAXED, __HIP_MEMORY_SCOPE_AGENT); }
__device__ __forceinline__ unsigned xb_xcc_id() { return (unsigned)__builtin_amdgcn_s_getreg((3 << 11) | 20) & 0xFu; }
#define XB_SPIN(cond, bar) do { unsigned _sp = 0; while (cond) { __builtin_amdgcn_s_sleep(1); \
    if ((++_sp & 255u) == 0u) { if (xb_ld(&(bar)[XB_TMO])) break; if (_sp > XB_SPIN_CAP) { atomicAdd(&(bar)[XB_TMO], 1u); break; } } } } while (0)

struct XcdBarrier {
    unsigned* bar; unsigned x;
    volatile LAS unsigned* st;
};
__device__ __forceinline__ XcdBarrier xcd_barrier_post(unsigned* bar, volatile LAS unsigned* st) {
    XcdBarrier b; b.bar = bar; b.x = xb_xcc_id(); b.st = st;
    if (threadIdx.x == 0) (void)xb_add(&bar[XB_XCNT(b.x)], 1u);
    return b;
}
__device__ __forceinline__ void xcd_barrier_complete(unsigned* bar, unsigned x, unsigned& nloc, unsigned& nx) {
    const unsigned G = gridDim.x * gridDim.y * gridDim.z;
    unsigned sum, cnt, mine, sp = 0u;
    for (;;) {
        sum = 0u; cnt = 0u; mine = 0u;
#pragma unroll
        for (unsigned j = 0; j < 16; ++j) { const unsigned c = xb_ld(&bar[XB_XCNT(j)]); sum += c; cnt += (c > 0u) ? 1u : 0u; mine = (j == x) ? c : mine; }
        if (sum == G) break;
        __builtin_amdgcn_s_sleep(1);
        if ((++sp & 255u) == 0u) { if (xb_ld(&bar[XB_TMO])) break; if (sp > XB_SPIN_CAP) { atomicAdd(&bar[XB_TMO], 1u); break; } }
    }
    nloc = mine > 0u ? mine : 1u; nx = cnt > 0u ? cnt : 1u;
}
__device__ __forceinline__ void xcd_barrier(const XcdBarrier& b) {
    asm volatile("s_waitcnt vmcnt(0)" ::: "memory");
    __syncthreads();
    if (threadIdx.x == 0) {
        unsigned* bar = b.bar;
        __builtin_amdgcn_s_waitcnt(0);
        unsigned nloc = b.st[0], nx = b.st[1];
        if (nloc == 0u) { xcd_barrier_complete(bar, b.x, nloc, nx); b.st[0] = nloc; b.st[1] = nx; }
        const unsigned old = xb_add(&bar[XB_XSUB(b.x)], 1u);
        const unsigned gen = old / nloc;
        if (old + 1u == (gen + 1u) * nloc) {
            __builtin_amdgcn_fence(__ATOMIC_RELEASE, "agent");
            asm volatile("s_waitcnt vmcnt(0)" ::: "memory");
            const unsigned og = xb_add(&bar[XB_TOP], 1u);
            const unsigned tg = og / nx;
            if (og + 1u == (tg + 1u) * nx) xb_add(&bar[XB_TOPGEN], 1u);
            else XB_SPIN(xb_ld(&bar[XB_TOPGEN]) == tg, bar);
            __builtin_amdgcn_fence(__ATOMIC_ACQUIRE, "agent");
            xb_add(&bar[XB_XGEN(b.x)], 1u);
            asm volatile("s_waitcnt vmcnt(0)" ::: "memory");
        } else {
            XB_SPIN(xb_ld(&bar[XB_XGEN(b.x)]) == gen, bar);
            __builtin_amdgcn_fence(__ATOMIC_ACQUIRE, "agent");
            asm volatile("s_waitcnt vmcnt(0)" ::: "memory");
        }
    }
    __syncthreads();
}

template <class Tp> DEV Tp* opq(Tp* q) { asm volatile("" : "+s"(q)); return q; }
DEV int tid_() { int t = threadIdx.x; asm volatile("" : "+v"(t)); return t; }
DEV int bid_() { int b = blockIdx.x; asm volatile("" : "+s"(b)); return b; }

DEV void glds16(const void* gsrc, char* lds_lane_ptr) {
  __builtin_amdgcn_global_load_lds((const unsigned*)gsrc, (__attribute__((address_space(3))) unsigned*)lds_lane_ptr, 16, 0, 0);
}
template <class Epi>
DEV void gemm_tile(const bf16_t* __restrict__ A, int lda, const bf16_t* __restrict__ Bt, int ldb, int K, char* smem, Epi& epi) {
  const int tid = tid_(), lane = tid & 63, wid = tid >> 6, wr = wid >> 1, wc = wid & 1, fr = lane & 15, fq = lane >> 4;
  f32x4 acc[4][4];
#pragma unroll
  for (int m = 0; m < 4; ++m)
#pragma unroll
    for (int n = 0; n < 4; ++n) acc[m][n] = (f32x4){0.f, 0.f, 0.f, 0.f};
  const int drow0 = 8 * wid + (lane >> 3), dpc = lane & 7;
  auto issue = [&](int kt, int buf) {
    char* sa = smem + buf * 32768;
    char* sb = sa + 16384;
#pragma unroll
    for (int i = 0; i < 4; ++i) {
      const int row = drow0 + 32 * i;
      const int kc = dpc ^ ((row >> 1) & 7);
      glds16(A + (size_t)row * lda + kt * 64 + kc * 8, sa + (i * 4 + wid) * 1024 + lane * 16);
      glds16(Bt + (size_t)row * ldb + kt * 64 + kc * 8, sb + (i * 4 + wid) * 1024 + lane * 16);
    }
  };
  __syncthreads();
  issue(0, 0);
  const int nk = K >> 6;
  const int sw = (fr >> 1) & 7;
  const int aoff = (wr * 64 + fr) * 128, boff = (wc * 64 + fr) * 128;
  for (int kt = 0; kt < nk; ++kt) {
    asm volatile("s_waitcnt vmcnt(0)" ::: "memory");
    __syncthreads();
    if (kt + 1 < nk) issue(kt + 1, (kt + 1) & 1);
    const char* sa = smem + (kt & 1) * 32768;
    const char* sb = sa + 16384;
#pragma unroll
    for (int kh = 0; kh < 2; ++kh) {
      const int pc = ((kh * 4 + fq) ^ sw) * 16;
      bf16x8 af[4], bfr[4];
#pragma unroll
      for (int m = 0; m < 4; ++m) af[m] = *(const bf16x8*)(sa + aoff + m * 2048 + pc);
#pragma unroll
      for (int n = 0; n < 4; ++n) bfr[n] = *(const bf16x8*)(sb + boff + n * 2048 + pc);
#pragma unroll
      for (int m = 0; m < 4; ++m)
#pragma unroll
        for (int n = 0; n < 4; ++n) acc[m][n] = mfma16(af[m], bfr[n], acc[m][n]);
    }
  }
  __syncthreads();
  epi(acc, wr, wc, fr, fq, smem);
}
DEV void stage_tile_bf16(const f32x4 (&acc)[4][4], char* smem, int wid, int fr, int fq) {
  bf16_t (*t)[72] = (bf16_t (*)[72])(smem + wid * 9216);
#pragma unroll
  for (int m = 0; m < 4; ++m)
#pragma unroll
    for (int n = 0; n < 4; ++n)
#pragma unroll
      for (int j = 0; j < 4; ++j) t[m * 16 + fq * 4 + j][n * 16 + fr] = f2bf(acc[m][n][j]);
  asm volatile("s_waitcnt lgkmcnt(0)" ::: "memory");
}

DEV void ph_copy(const P& p) {
  const size_t n8 = (size_t)NTOK * D / 8;
  const float* pctx = opq(p.ctx); const float* px = opq(p.x);
  for (size_t i = (size_t)bid_() * 256 + tid_(); i < n8; i += (size_t)gridDim.x * 256) {
    size_t e = i * 8;
    int row = (int)(e / D), col = (int)(e % D);
    int b = row / LT, pp = row % LT;
    const float* src = pp < LC ? pctx + ((size_t)(b * LC + pp)) * D + col : px + ((size_t)(b * T + pp - LC)) * D + col;
    float4 v0 = *(const float4*)src, v1 = *(const float4*)(src + 4);
    uint4 o = make_uint4(pack2(v0.x, v0.y), pack2(v0.z, v0.w), pack2(v1.x, v1.y), pack2(v1.z, v1.w));
    *(uint4*)(p.X + e) = o;
  }
}

DEV void ph_rope(const P& p) {
  for (int i = bid_() * 256 + tid_(); i < 64 * 16; i += gridDim.x * 256) {
    int pos = i >> 4, k = i & 15;
    float inv = powf(10000.f, -(float)k / 16.f);
    float ang = (float)pos * inv;
    p.rope[2 * i] = cosf(ang); p.rope[2 * i + 1] = sinf(ang);
  }
}

DEV void modv_unit(const P& p, int unit, char* smem) {
  const int cc = unit % 24, layer = unit / 24;
  float (*cs)[128] = (float (*)[128])smem;
  const int col = cc * 256 + tid_();
  const float* pc = opq(p.c); const float* pcc = opq(p.c_ctx);
  float acc[17];
#pragma unroll
  for (int r = 0; r < 17; ++r) acc[r] = 0.f;
  for (int ks = 0; ks < 8; ++ks) {
    __syncthreads();
    for (int i = tid_(); i < 17 * 128; i += 256) {
      int r = i >> 7, e = i & 127;
      float v = r < 16 ? pc[r * D + ks * 128 + e] : pcc[ks * 128 + e];
      cs[r][e] = v / (1.f + expf(-v));
    }
    __syncthreads();
    const float* w = p.mod_w + ((size_t)layer * D + ks * 128) * 6144 + col;
#pragma unroll 4
    for (int e = 0; e < 128; ++e) {
      float wv = w[(size_t)e * 6144];
#pragma unroll
      for (int r = 0; r < 17; ++r) acc[r] += cs[r][e] * wv;
    }
  }
  const float bias = p.mod_b[layer * 6144 + col];
#pragma unroll
  for (int r = 0; r < 17; ++r) p.modv[((size_t)layer * 17 + r) * 6144 + col] = acc[r] + bias;
}

DEV void transpose_unit(const float* __restrict__ src, bf16_t* __restrict__ dst, int R, int C, int tile, char* smem) {
  float (*t)[65] = (float (*)[65])smem;
  const int nct = C / 64;
  const int tr = tile / nct, tc = tile % nct;
  __syncthreads();
  for (int i = tid_(); i < 4096; i += 256) { int r = i >> 6, c = i & 63; t[r][c] = src[(size_t)(tr * 64 + r) * C + tc * 64 + c]; }
  __syncthreads();
  for (int i = tid_(); i < 4096; i += 256) { int c = i >> 6, r = i & 63; dst[(size_t)(tc * 64 + c) * R + tr * 64 + r] = f2bf(t[r][c]); }
}

DEV void wfold_unit(const P& p, int layer, int unit, char* smem) {
  const int hs = unit >> 5, ec = unit & 31, h = hs >> 1, s = hs & 1;
  const float* wq = p.peer_wq + (size_t)layer * D * 2048;
  const float* kk = (s ? opq(p.peer_k2) : opq(p.peer_k1)) + ((size_t)layer * 8 + h) * 128 * 128;
  float (*kS)[65] = (float (*)[65])smem;
  float (*wS)[64] = (float (*)[64])(smem + 33280);
  const int key = tid_() & 127, eh = tid_() >> 7;
  float acc[16];
#pragma unroll
  for (int i = 0; i < 16; ++i) acc[i] = 0.f;
  for (int dh = 0; dh < 2; ++dh) {
    __syncthreads();
    for (int i = tid_(); i < 128 * 64; i += 256) { int k2 = i >> 6, d = i & 63; kS[k2][d] = kk[k2 * 128 + dh * 64 + d]; }
    for (int i = tid_(); i < 32 * 64; i += 256) {
      int e = i >> 6, d = i & 63;
      wS[e][d] = wq[(size_t)(ec * 32 + e) * 2048 + h * 256 + s * 128 + dh * 64 + d];
    }
    __syncthreads();
#pragma unroll 2
    for (int d = 0; d < 64; ++d) {
      float kv = kS[key][d];
#pragma unroll
      for (int i = 0; i < 16; ++i) acc[i] += kv * wS[eh * 16 + i][d];
    }
  }
  bf16_t* dst = p.Wft + ((size_t)(hs * 128 + key)) * D + ec * 32 + eh * 16;
#pragma unroll
  for (int i = 0; i < 16; i += 2) *(unsigned*)(dst + i) = pack2(acc[i], acc[i + 1]);
}

DEV void filt_unit(const P& p, int layer, int unit, char* smem) {
  int kind, j0, L;
  if (unit < 1024) { kind = 0; j0 = unit * 4; L = T; } else { kind = 1; j0 = (unit - 1024) * 4; L = LC; }
  float* zs = (float*)smem;
  float* h1 = zs + 4 * 36;
  float* h2 = h1 + 256;
  const int jj = tid_() >> 6, o = tid_() & 63;
  const int j = j0 + jj;
  const float fj = (float)j;
  const float t = fj / (float)(L - 1);
  __syncthreads();
  if (o < 33) {
    float z;
    if (o == 0) z = t;
    else {
      int i = (o - 1) & 15;
      float band = 1e-4f + (float)i * ((15.0f - 1e-4f) / 15.0f);
      float ang = 6.283185307179586f * fj * band / (float)L;
      z = (o <= 16) ? cosf(ang) : -sinf(ang);
    }
    zs[jj * 36 + o] = z;
  }
  __syncthreads();
  {
    const float* w1 = p.hy_w1 + layer * 33 * 64;
    float a = p.hy_b1[layer * 64 + o];
#pragma unroll 3
    for (int i = 0; i < 33; ++i) a += zs[jj * 36 + i] * w1[i * 64 + o];
    h1[jj * 64 + o] = sinf(p.hy_freq[layer * 128 + o] * a);
  }
  __syncthreads();
  {
    const float* w2 = p.hy_w2 + layer * 64 * 64;
    float a = p.hy_b2[layer * 64 + o];
#pragma unroll 4
    for (int i = 0; i < 64; ++i) a += h1[jj * 64 + i] * w2[i * 64 + o];
    h2[jj * 64 + o] = sinf(p.hy_freq[layer * 128 + 64 + o] * a);
  }
  __syncthreads();
  const float* w3 = p.hy_w3 + layer * 64 * 512;
  float* F = kind ? opq(p.FC) : opq(p.FL);
  const float DMIN = -3.0701134573253945f, DMAX = -15.350567286626973f;
#pragma unroll 1
  for (int m = 0; m < 4; ++m) {
    int c = o + 64 * m;
    float af = p.hy_b3[layer * 512 + c], ab = p.hy_b3[layer * 512 + 256 + c];
#pragma unroll 4
    for (int i = 0; i < 64; ++i) { float hv = h2[jj * 64 + i]; af += hv * w3[i * 512 + c]; ab += hv * w3[i * 512 + 256 + c]; }
    float delta = fabsf(DMIN + (float)c * ((DMAX - DMIN) / 255.f));
    float win = expf(-t * delta) + 0.05f;
    af *= win; ab *= win;
    F[((size_t)c * 2 + 0) * L + j] = af;
    F[((size_t)c * 2 + 1) * L + j] = ab;
  }
}

constexpr int PREP_T0 = 672, PREP_T1 = PREP_T0 + 256, PREP_T2 = PREP_T1 + 8, PREP_T3 = PREP_T2 + 8, PREP_T4 = PREP_T3 + 8;
constexpr int PREP_WF = PREP_T4 + 512, PREP_N = PREP_WF + 1088;
DEV void ph_prep(const P& p, int layer, char* smem) {
  for (int u = bid_(); u < PREP_N; u += gridDim.x) {
    if (u < PREP_T0) transpose_unit(p.w_in + (size_t)layer * D * INW, p.W1t, D, INW, u, smem);
    else if (u < PREP_T1) transpose_unit(p.w_out + (size_t)layer * D * D, p.W2t, D, D, u - PREP_T0, smem);
    else if (u < PREP_T2) { int q = u - PREP_T1, d = q >> 2; transpose_unit(p.rw_w_up + ((size_t)layer * 2 + d) * 64 * 256, p.Wwt + d * 256 * 64, 64, 256, q & 3, smem); }
    else if (u < PREP_T3) { int q = u - PREP_T2, d = q >> 2; transpose_unit(p.rw_a_up + ((size_t)layer * 2 + d) * 64 * 256, p.Wat + d * 256 * 64, 64, 256, q & 3, smem); }
    else if (u < PREP_T4) transpose_unit(p.rw_g_up + (size_t)layer * 128 * 256, p.Wgt, 128, 256, u - PREP_T3, smem);
    else if (u < PREP_WF) wfold_unit(p, layer, u - PREP_T4, smem);
    else filt_unit(p, layer, u - PREP_WF, smem);
  }
}

DEV void ph_norm(const P& p, int layer, int which) {
  const int gw = (bid_() * 256 + tid_()) >> 6, nw = gridDim.x * 4, lane = tid_() & 63;
  const float* g = (which ? p.norm2_g : p.norm1_g) + layer * D;
  for (int row = gw; row < NTOK; row += nw) {
    int b = row / LT, pp = row % LT;
    int mr = pp < LC ? 16 : b;
    const float* mv = p.modv + ((size_t)layer * 17 + mr) * 6144 + (which ? 3072 : 0);
    const bf16_t* xr = p.X + (size_t)row * D;
    uint4 u0 = *(const uint4*)(xr + 8 * lane), u1 = *(const uint4*)(xr + 512 + 8 * lane);
    float v[16];
    unpack8(u0, v); unpack8(u1, v + 8);
    float ss = 0.f;
#pragma unroll
    for (int i = 0; i < 16; ++i) ss += v[i] * v[i];
    ss = wave_sum(ss);
    float rstd = rsqrtf(ss * (1.f / 1024.f) + 1e-6f);
    float o[16];
#pragma unroll
    for (int hh = 0; hh < 2; ++hh)
#pragma unroll
      for (int i = 0; i < 8; ++i) {
        int col = hh * 512 + 8 * lane + i;
        float y = v[hh * 8 + i] * rstd * g[col];
        o[hh * 8 + i] = y * (1.f + mv[1024 + col]) + mv[col];
      }
    bf16_t* hr = p.H + (size_t)row * D;
    *(uint4*)(hr + 8 * lane) = pack8(o);
    *(uint4*)(hr + 512 + 8 * lane) = pack8(o + 8);
  }
}

struct Epi1 {
  const P& p; int row0, col0;
  DEV void operator()(f32x4 (&acc)[4][4], int wr, int wc, int fr, int fq, char* smem) const {
    const int cw = col0 + wc * 64;
    const int rbase = row0 + wr * 64;
    const bool lat = (row0 % LT) >= LC;
    if (cw >= 1536 && cw < 1664) {
#pragma unroll
      for (int m = 0; m < 4; ++m)
#pragma unroll
        for (int n = 0; n < 4; ++n)
#pragma unroll
          for (int j = 0; j < 4; ++j) acc[m][n][j] = tanhf(acc[m][n][j]);
    } else if (cw >= 1792 && cw < 1920) {
#pragma unroll
      for (int m = 0; m < 4; ++m)
#pragma unroll
        for (int n = 0; n < 4; ++n)
#pragma unroll
          for (int j = 0; j < 4; ++j) acc[m][n][j] = sigmoidf_(acc[m][n][j]);
    } else if (cw >= 1920 && cw < 2560 && lat) {
#pragma unroll
      for (int m = 0; m < 4; ++m)
#pragma unroll
        for (int j = 0; j < 4; ++j) {
          int row = rbase + m * 16 + fq * 4 + j;
          int pl = (row % LT) - LC;
          int ri = pl >> 6, ci = pl & 63;
          float2 cr = *(const float2*)(p.rope + 2 * (ri * 16 + fr));
          float2 cc = *(const float2*)(p.rope + 2 * (ci * 16 + fr));
          float x1 = acc[m][0][j], x2 = acc[m][1][j];
          acc[m][0][j] = x1 * cr.x - x2 * cr.y; acc[m][1][j] = x2 * cr.x + x1 * cr.y;
          x1 = acc[m][2][j]; x2 = acc[m][3][j];
          acc[m][2][j] = x1 * cc.x - x2 * cc.y; acc[m][3][j] = x2 * cc.x + x1 * cc.y;
        }
    }
    const int wid = wr * 2 + wc, lane = fq * 16 + fr;
    stage_tile_bf16(acc, smem, wid, fr, fq);
    const bf16_t (*t)[72] = (const bf16_t (*)[72])(smem + wid * 9216);
#pragma unroll
    for (int i = 0; i < 8; ++i) {
      const int rl = i * 8 + (lane >> 3), ch = lane & 7;
      *(uint4*)(p.Z + (size_t)(rbase + rl) * INW + cw + ch * 8) = *(const uint4*)&t[rl][ch * 8];
    }
  }
};
DEV void ph_gemm1(const P& p, char* smem) {
  const int nct = INW / 128;
  for (int u = bid_(); u < (NTOK / 128) * nct; u += gridDim.x) {
    int rt = u / nct, ct = u % nct;
    Epi1 epi{p, rt * 128, ct * 128};
    gemm_tile(p.H + (size_t)rt * 128 * D, D, p.W1t + (size_t)ct * 128 * D, D, D, smem, epi);
  }
}

struct EpiLora {
  const P& p; int layer, q, row0, col0;
  DEV void operator()(f32x4 (&acc)[4][4], int wr, int wc, int fr, int fq, char*) const {
#pragma unroll
    for (int m = 0; m < 4; ++m)
#pragma unroll
      for (int n = 0; n < 4; ++n)
#pragma unroll
        for (int j = 0; j < 4; ++j) {
          int row = row0 + wr * 64 + m * 16 + fq * 4 + j;
          int col = col0 + wc * 64 + n * 16 + fr;
          float v = acc[m][n][j];
          if (q < 2) {
            v = 0.6065306597126334f * sigmoidf_(v + p.rw_w0[(layer * 2 + q) * 256 + col]);
            p.SC[(size_t)row * 1024 + col * 4 + q] = f2bf(v);
          } else if (q < 4) {
            v = sigmoidf_(v + p.rw_a0[(layer * 2 + (q - 2)) * 256 + col]);
            p.SC[(size_t)row * 1024 + col * 4 + q] = f2bf(v);
          } else {
            p.Y[(size_t)row * D + 256 + col] = f2bf(v);
          }
        }
  }
};
DEV void lora_unit(const P& p, int layer, int unit, char* smem) {
  const int q = unit / 1088, r = unit % 1088, rt = r >> 1, ct = r & 1;
  EpiLora epi{p, layer, q, rt * 128, ct * 128};
  const bf16_t* A; const bf16_t* Bt; int K;
  if (q < 2) { A = p.Z + 1536 + 64 * q; Bt = p.Wwt + q * 256 * 64; K = 64; }
  else if (q < 4) { A = p.Z + 1664 + 64 * (q - 2); Bt = p.Wat + (q - 2) * 256 * 64; K = 64; }
  else { A = p.Z + 1792; Bt = p.Wgt; K = 128; }
  gemm_tile(A + (size_t)rt * 128 * INW, INW, Bt + (size_t)ct * 128 * K, K, K, smem, epi);
}

DEV void ph_rwkv_prep(const P& p, int layer) {
  const int gw = (bid_() * 256 + tid_()) >> 6, nw = gridDim.x * 4, lane = tid_() & 63;
  const float* cw = p.conv_w + (size_t)layer * 3 * 1536;
  const float* cb = p.conv_b + (size_t)layer * 1536;
  for (int row = gw; row < NTOK; row += nw) {
    int pp = row % LT;
    bool hasm = (pp != 0) && (pp != LC);
    bool hasp = (pp != LC - 1) && (pp != LT - 1);
    float res[3][4];
#pragma unroll
    for (int a = 0; a < 3; ++a) {
      int col = 768 + a * 256 + 4 * lane;
      const bf16_t* zc = p.Z + (size_t)row * INW + col;
      uint2 um = hasm ? *(const uint2*)(zc - INW) : make_uint2(0, 0);
      uint2 uc = *(const uint2*)zc;
      uint2 up = hasp ? *(const uint2*)(zc + INW) : make_uint2(0, 0);
      float vm[4] = {bflo(um.x), bfhi(um.x), bflo(um.y), bfhi(um.y)};
      float vc[4] = {bflo(uc.x), bfhi(uc.x), bflo(uc.y), bfhi(uc.y)};
      float vp[4] = {bflo(up.x), bfhi(up.x), bflo(up.y), bfhi(up.y)};
#pragma unroll
      for (int i = 0; i < 4; ++i) res[a][i] = cw[col + i] * vm[i] + cw[1536 + col + i] * vc[i] + cw[3072 + col + i] * vp[i] + cb[col + i];
    }
    float kk[4], ss = 0.f;
#pragma unroll
    for (int i = 0; i < 4; ++i) { kk[i] = res[1][i] * p.rw_k_k[layer * 256 + 4 * lane + i]; ss += kk[i] * kk[i]; }
    ss = row16_sum(ss);
    float rs = rsqrtf(ss + 1e-12f);
    bf16_t* hr = p.H + (size_t)row * D + 16 * lane;
    *(uint4*)hr = make_uint4(pack2(res[0][0], res[1][0]), pack2(kk[0] * rs, res[2][0]), pack2(res[0][1], res[1][1]), pack2(kk[1] * rs, res[2][1]));
    *(uint4*)(hr + 8) = make_uint4(pack2(res[0][2], res[1][2]), pack2(kk[2] * rs, res[2][2]), pack2(res[0][3], res[1][3]), pack2(kk[3] * rs, res[2][3]));
  }
}

struct ScanRaw { uint2 h, s; };
struct ScanRegs { f32x2 A[4], W[4], B[4], K[4], R[4]; float v; };
DEV float oct_sum(float x) { x += dpp0<0xB1, 0xF>(x); x += dpp0<0x4E, 0xF>(x); x += dpp0<0x141, 0xF>(x); return x; }
DEV void scan_unit(const P& p, int layer, int unit, char* smem) {
  const int half = unit & 1, dir = (unit >> 1) & 1, h = (unit >> 2) & 3, b = unit >> 4;
  const int tid = tid_(), wid = tid >> 6, lane = tid & 63;
  const int k8 = lane & 7, vrow = half * 32 + wid * 8 + (lane >> 3);
  float* st = (float*)smem + wid * 768;
  const float ka = p.rw_k_a[layer * 256 + h * 64 + lane];
  f32x2 S[4];
#pragma unroll
  for (int i = 0; i < 4; ++i) S[i] = (f32x2){0.f, 0.f};
  const size_t rowbase = (size_t)b * LT;
  const bf16_t* hb = p.H + rowbase * 1024 + (h * 64 + lane) * 4;
  const bf16_t* sb = p.SC + rowbase * 1024 + (h * 64 + lane) * 4;
  bf16_t* yb = p.Z + rowbase * INW + 768 + dir * 256 + h * 64 + vrow;
  auto posf = [&](int t) -> int { return dir == 0 ? t : (t < LC ? LC - 1 - t : LT - 1 - (t - LC)); };
  auto load4 = [&](int c, ScanRaw (&dst)[4]) {
#pragma unroll
    for (int i = 0; i < 4; ++i) {
      size_t off = (size_t)posf(c * 4 + i) * 1024;
      dst[i].h = *(const uint2*)(hb + off); dst[i].s = *(const uint2*)(sb + off);
    }
  };
  auto stage = [&](const ScanRaw& x, int buf) {
    float rr = bflo(x.h.x), kr = bfhi(x.h.x), kkv = bflo(x.h.y), vv = bfhi(x.h.y);
    float ev = dir ? bfhi(x.s.x) : bflo(x.s.x), av = dir ? bfhi(x.s.y) : bflo(x.s.y);
    float w = __expf(-ev), ap = -kkv, bp = kkv * av, kd = kr * (1.f + (av - 1.f) * ka);
    float* q = st + buf * 384;
    q[lane] = ap; q[64 + lane] = w; q[128 + lane] = bp; q[192 + lane] = kd; q[256 + lane] = rr; q[320 + lane] = vv;
  };
  auto rd = [&](int buf, ScanRegs& g) {
    const float* q = st + buf * 384 + 8 * k8;
    float4 t0, t1;
    t0 = *(const float4*)q; t1 = *(const float4*)(q + 4);
    g.A[0] = (f32x2){t0.x, t0.y}; g.A[1] = (f32x2){t0.z, t0.w}; g.A[2] = (f32x2){t1.x, t1.y}; g.A[3] = (f32x2){t1.z, t1.w};
    t0 = *(const float4*)(q + 64); t1 = *(const float4*)(q + 68);
    g.W[0] = (f32x2){t0.x, t0.y}; g.W[1] = (f32x2){t0.z, t0.w}; g.W[2] = (f32x2){t1.x, t1.y}; g.W[3] = (f32x2){t1.z, t1.w};
    t0 = *(const float4*)(q + 128); t1 = *(const float4*)(q + 132);
    g.B[0] = (f32x2){t0.x, t0.y}; g.B[1] = (f32x2){t0.z, t0.w}; g.B[2] = (f32x2){t1.x, t1.y}; g.B[3] = (f32x2){t1.z, t1.w};
    t0 = *(const float4*)(q + 192); t1 = *(const float4*)(q + 196);
    g.K[0] = (f32x2){t0.x, t0.y}; g.K[1] = (f32x2){t0.z, t0.w}; g.K[2] = (f32x2){t1.x, t1.y}; g.K[3] = (f32x2){t1.z, t1.w};
    t0 = *(const float4*)(q + 256); t1 = *(const float4*)(q + 260);
    g.R[0] = (f32x2){t0.x, t0.y}; g.R[1] = (f32x2){t0.z, t0.w}; g.R[2] = (f32x2){t1.x, t1.y}; g.R[3] = (f32x2){t1.z, t1.w};
    g.v = st[buf * 384 + 320 + vrow];
  };
  auto compute = [&](const ScanRegs& g, int t) {
    f32x2 s2 = S[0] * g.A[0];
    s2 += S[1] * g.A[1]; s2 += S[2] * g.A[2]; s2 += S[3] * g.A[3];
    const float sa = oct_sum(s2[0] + s2[1]);
    const f32x2 sa2 = (f32x2){sa, sa}, vv2 = (f32x2){g.v, g.v};
#pragma unroll
    for (int i = 0; i < 4; ++i) S[i] = S[i] * g.W[i] + (sa2 * g.B[i] + vv2 * g.K[i]);
    f32x2 y2 = S[0] * g.R[0];
    y2 += S[1] * g.R[1]; y2 += S[2] * g.R[2]; y2 += S[3] * g.R[3];
    const float y = oct_sum(y2[0] + y2[1]);
    if (k8 == 0) yb[(size_t)posf(t) * INW] = f2bf(y);
  };
  constexpr int NC = LT / 4;
  ScanRaw R0[4], R1[4], R2[4], R3[4];
  ScanRegs g0, g1;
  auto chunk = [&](ScanRaw (&Rc)[4], ScanRaw (&Rn)[4], int t0, bool hasnext) {
    stage(Rc[1], 1); rd(1, g1); compute(g0, t0);
    stage(Rc[2], 0); rd(0, g0); compute(g1, t0 + 1);
    stage(Rc[3], 1); rd(1, g1); compute(g0, t0 + 2);
    if (hasnext) { stage(Rn[0], 0); rd(0, g0); }
    compute(g1, t0 + 3);
  };
  __builtin_amdgcn_s_setprio(3);
  load4(0, R0); load4(1, R1); load4(2, R2);
  stage(R0[0], 0);
  rd(0, g0);
#pragma unroll 1
  for (int c = 0; c < NC; c += 4) {
    load4(c + 3, R3);
    chunk(R0, R1, c * 4, true);
    const bool more = (c + 4 < NC);
    if (more) load4(c + 4, R0);
    chunk(R1, R2, c * 4 + 4, true);
    if (more) load4(c + 5, R1);
    chunk(R2, R3, c * 4 + 8, true);
    if (more) load4(c + 6, R2);
    chunk(R3, R0, c * 4 + 12, more);
  }
  __builtin_amdgcn_s_setprio(0);
}

DEV void ph_rwkv_post(const P& p, int layer) {
  const int gw = (bid_() * 256 + tid_()) >> 6, nw = gridDim.x * 4, lane = tid_() & 63;
  for (int row = gw; row < NTOK; row += nw) {
    const int ch = 4 * lane;
    const bf16_t* zr = p.Z + (size_t)row * INW + 768 + ch;
    uint2 y0u = *(const uint2*)zr, y1u = *(const uint2*)(zr + 256);
    float y[4] = {bflo(y0u.x) + bflo(y1u.x), bfhi(y0u.x) + bfhi(y1u.x), bflo(y0u.y) + bflo(y1u.y), bfhi(y0u.y) + bfhi(y1u.y)};
    float mu = row16_sum(y[0] + y[1] + y[2] + y[3]) * (1.f / 64.f);
    float vs = 0.f;
#pragma unroll
    for (int i = 0; i < 4; ++i) { y[i] -= mu; vs += y[i] * y[i]; }
    float var = row16_sum(vs) * (1.f / 64.f);
    float rstd = rsqrtf(var + 64e-5f);
    const bf16_t* hr = p.H + (size_t)row * D + 4 * ch;
    uint4 h0 = *(const uint4*)hr, h1 = *(const uint4*)(hr + 8);
    const bf16_t* sr = p.SC + (size_t)row * 1024 + 4 * ch;
    uint4 s0 = *(const uint4*)sr, s1 = *(const uint4*)(sr + 8);
    float r[4] = {bflo(h0.x), bflo(h0.z), bflo(h1.x), bflo(h1.z)};
    float k[4] = {bfhi(h0.x), bfhi(h0.z), bfhi(h1.x), bfhi(h1.z)};
    float v[4] = {bfhi(h0.y), bfhi(h0.w), bfhi(h1.y), bfhi(h1.w)};
    float a0[4] = {bflo(s0.y), bflo(s0.w), bflo(s1.y), bflo(s1.w)};
    float a1[4] = {bfhi(s0.y), bfhi(s0.w), bfhi(s1.y), bfhi(s1.w)};
    float sd = 0.f;
#pragma unroll
    for (int i = 0; i < 4; ++i) {
      float kav = p.rw_k_a[layer * 256 + ch + i], rk = p.rw_r_k[layer * 256 + ch + i];
      float kd0 = k[i] * (1.f + (a0[i] - 1.f) * kav), kd1 = k[i] * (1.f + (a1[i] - 1.f) * kav);
      sd += r[i] * (kd0 + kd1) * rk;
    }
    sd = row16_sum(sd);
    bf16_t* yr = p.Y + (size_t)row * D + 256 + ch;
    uint2 gu = *(const uint2*)yr;
    float g[4] = {bflo(gu.x), bfhi(gu.x), bflo(gu.y), bfhi(gu.y)};
    float o[4];
#pragma unroll
    for (int i = 0; i < 4; ++i) {
      float yn = y[i] * rstd * p.rw_ln_w[layer * 256 + ch + i] + p.rw_ln_b[layer * 256 + ch + i];
      o[i] = (yn + sd * v[i]) * g[i];
#if !EN_RW
      o[i] = 0.f;
#endif
    }
    *(uint2*)yr = make_uint2(pack2(o[0], o[1]), pack2(o[2], o[3]));
  }
}

DEV void hyena_pre_unit(const P& p, int layer, int unit) {
  int kind, b, t0, L;
  if (unit < 1024) { kind = 0; b = unit >> 6; t0 = (unit & 63) * 64; L = T; } else { int u = unit - 1024; kind = 1; b = u >> 2; t0 = (u & 3) * 64; L = LC; }
  const int c = tid_();
  const size_t row0 = (size_t)b * LT + (kind ? 0 : LC);
  const float* cw = p.conv_w + (size_t)layer * 3 * 1536;
  const float* cb = p.conv_b + (size_t)layer * 1536;
  const float w1a = cw[256 + c], w1b = cw[1536 + 256 + c], w1c = cw[3072 + 256 + c], b1 = cb[256 + c];
  const float w2a = cw[512 + c], w2b = cw[1536 + 512 + c], w2c = cw[3072 + 512 + c], b2 = cb[512 + c];
  auto ld = [&](int t, int col) -> float { return (t >= 0 && t < L) ? bf2f(p.Z[(row0 + t) * INW + col]) : 0.f; };
  float x1m = ld(t0 - 1, 256 + c), x1c = ld(t0, 256 + c), vm = ld(t0 - 1, 512 + c), vc = ld(t0, 512 + c);
  bf16_t* dst = (kind ? opq(p.UTc) : opq(p.UTl)) + ((size_t)c * 16 + b) * L + t0;
#pragma unroll 1
  for (int i8 = 0; i8 < 8; ++i8) {
    float uo[8];
#pragma unroll
    for (int i = 0; i < 8; ++i) {
      int t = t0 + i8 * 8 + i;
      float x1n = ld(t + 1, 256 + c), vn = ld(t + 1, 512 + c);
      float a = w1a * x1m + w1b * x1c + w1c * x1n + b1;
      float bb = w2a * vm + w2b * vc + w2c * vn + b2;
      uo[i] = a * bb;
      x1m = x1c; x1c = x1n; vm = vc; vc = vn;
    }
    *(uint4*)(dst + 8 * i8) = pack8(uo);
  }
}

DEV void hyena_conv_unit(const P& p, int layer, int unit, char* smem) {
  int kind, c, tb, L;
  if (unit < 4096) { kind = 0; c = unit >> 4; tb = (unit & 15) * 256; L = T; } else { kind = 1; c = unit - 4096; tb = 0; L = LC; }
  const int tid = tid_(), lane = tid & 63, wid = tid >> 6, fr = lane & 15, fq = lane >> 4;
  float* red = (float*)(smem + 2 * 16512);
  const float* F = (kind ? opq(p.FC) : opq(p.FL)) + (size_t)c * 2 * L;
  float scale;
  {
    float part = 0.f;
    for (int i = tid; i < 2 * L; i += 256) { float fv = F[i]; part += (i != L) ? fv * fv : 0.f; }
    part = wave_sum(part);
    __syncthreads();
    if (lane == 0) red[wid] = part;
    __syncthreads();
    scale = rsqrtf(((red[0] + red[1]) + (red[2] + red[3])) + 1e-6f);
  }
  const bf16_t* U = (kind ? opq(p.UTc) : opq(p.UTl)) + (size_t)c * 16 * L;
  f32x4 acc[4];
#pragma unroll
  for (int m = 0; m < 4; ++m) acc[m] = (f32x4){0.f, 0.f, 0.f, 0.f};
  const int nch = L / 256;
  float fw0, fw1, fw2;
  uint4 ru0, ru1;
  auto ldchunk = [&](int ch) {
    const int sc = ch * 256;
    const int D0 = tb + 256 - sc;
    auto tap = [&](int n) -> float {
      int d = D0 - n;
      float v = 0.f;
      if (d > -L && d < L) v = (d >= 0 ? F[d] : F[L - d]);
      return v;
    };
    fw0 = tap(tid); fw1 = tap(tid + 256); fw2 = (tid < 8) ? tap(tid + 512) : 0.f;
    const int bb = tid >> 4, sg0 = tid & 15;
    ru0 = *(const uint4*)(U + (size_t)bb * L + sc + 8 * sg0);
    ru1 = *(const uint4*)(U + (size_t)bb * L + sc + 8 * (sg0 + 16));
  };
  auto stchunk = [&](int buf) {
    bf16_t* Cq = (bf16_t*)(smem + buf * 16512);
    bf16_t* Us = (bf16_t*)(smem + buf * 16512 + 8320);
    const bf16_t h0 = f2bf(fw0 * scale), h1 = f2bf(fw1 * scale), h2 = f2bf(fw2 * scale);
#pragma unroll
    for (int rho = 0; rho < 8; ++rho) {
      int m = tid + rho;
      Cq[((m >> 3) * 8 + rho) * 8 + (m & 7)] = h0;
      m = tid + 256 + rho;
      if (m < 520) Cq[((m >> 3) * 8 + rho) * 8 + (m & 7)] = h1;
      m = tid + 512 + rho;
      if (tid < 8 && m < 520) Cq[((m >> 3) * 8 + rho) * 8 + (m & 7)] = h2;
    }
    if (tid < 8) {
#pragma unroll
      for (int rho = 1; rho < 8; ++rho) if (tid < rho) Cq[(rho) * 8 + tid] = 0;
    }
    const int bb = tid >> 4, sg0 = tid & 15;
    *(uint4*)&Us[(sg0 * 16 + bb) * 8] = ru0;
    *(uint4*)&Us[((sg0 + 16) * 16 + bb) * 8] = ru1;
  };
  ldchunk(0);
#pragma unroll 1
  for (int ch = 0; ch < nch; ++ch) {
    const int buf = ch & 1;
    stchunk(buf);
    __syncthreads();
    if (ch + 1 < nch) ldchunk(ch + 1);
    const bf16_t* Cq = (const bf16_t*)(smem + buf * 16512);
    const bf16_t* Us = (const bf16_t*)(smem + buf * 16512 + 8320);
#pragma unroll
    for (int kk = 0; kk < 8; ++kk) {
      bf16x8 bf = *(const bf16x8*)&Us[((4 * kk + fq) * 16 + fr) * 8];
#pragma unroll
      for (int m = 0; m < 4; ++m) {
        int it = wid * 4 + m;
        int base = 256 - 16 * it + 32 * kk + 8 * fq;
        int m0 = base - 8 * (fr >> 3);
        bf16x8 af = *(const bf16x8*)&Cq[((m0 >> 3) * 8 + (fr & 7)) * 8];
        acc[m] = mfma16(af, bf, acc[m]);
      }
    }
  }
  __syncthreads();
  bf16_t* Yt = (kind ? opq(p.YTc) : opq(p.YTl)) + ((size_t)c * 16 + fr) * L + tb;
#pragma unroll
  for (int m = 0; m < 4; ++m) {
    int t = (wid * 4 + m) * 16 + fq * 4;
    *(uint2*)(Yt + t) = make_uint2(pack2(acc[m][0], acc[m][1]), pack2(acc[m][2], acc[m][3]));
  }
}

DEV void hyena_post_unit(const P& p, int layer, int unit, char* smem) {
  int kind, b, t0, L;
  if (unit < 1024) { kind = 0; b = unit >> 6; t0 = (unit & 63) * 64; L = T; } else { int u = unit - 1024; kind = 1; b = u >> 2; t0 = (u & 3) * 64; L = LC; }
  const int c = tid_(), lane = c & 63, wid = c >> 6;
  const size_t row0 = (size_t)b * LT + (kind ? 0 : LC);
  bf16_t (*tile)[264] = (bf16_t (*)[264])smem;
  const float* cw = p.conv_w + (size_t)layer * 3 * 1536;
  const float wa = cw[c], wb = cw[1536 + c], wcc = cw[3072 + c], b0 = p.conv_b[layer * 1536 + c];
  const float bias = p.hy_bias[layer * 256 + c];
  const bf16_t* yt = (kind ? opq(p.YTc) : opq(p.YTl)) + ((size_t)c * 16 + b) * L + t0;
  const bf16_t* ut = (kind ? opq(p.UTc) : opq(p.UTl)) + ((size_t)c * 16 + b) * L + t0;
  auto ld = [&](int t) -> float { return (t >= 0 && t < L) ? bf2f(p.Z[(row0 + t) * INW + c]) : 0.f; };
  float xm = ld(t0 - 1), xc = ld(t0);
  __syncthreads();
#pragma unroll 1
  for (int i8 = 0; i8 < 8; ++i8) {
    uint4 yu = *(const uint4*)(yt + 8 * i8), uu = *(const uint4*)(ut + 8 * i8);
    float yv[8], uv[8];
    unpack8(yu, yv); unpack8(uu, uv);
#pragma unroll
    for (int i = 0; i < 8; ++i) {
      int t = t0 + i8 * 8 + i;
      float xn = ld(t + 1);
      float x0 = wa * xm + wb * xc + wcc * xn + b0;
      float o = x0 * (yv[i] + uv[i] * bias);
      tile[i8 * 8 + i][c] = f2bf(o);
      xm = xc; xc = xn;
    }
  }
  __syncthreads();
  for (int i = 0; i < 16; ++i) {
    int tl = wid * 16 + i;
    uint2 ou = *(const uint2*)&tile[tl][4 * lane];
    float o[4] = {bflo(ou.x), bfhi(ou.x), bflo(ou.y), bfhi(ou.y)};
    float ss = wave_sum(o[0] * o[0] + o[1] * o[1] + o[2] * o[2] + o[3] * o[3]);
    float rstd = rsqrtf(ss * (1.f / 256.f) + 1e-6f);
#pragma unroll
    for (int q = 0; q < 4; ++q) {
      o[q] = o[q] * rstd * p.hy_out_g[layer * 256 + 4 * lane + q];
#if !EN_HY
      o[q] = 0.f;
#endif
    }
    *(uint2*)(p.Y + (row0 + t0 + tl) * D + 4 * lane) = make_uint2(pack2(o[0], o[1]), pack2(o[2], o[3]));
  }
}

DEV void attn_unit(const P& p, int layer, int unit, char* smem) {
  const bool isctx = unit >= 4096;
  int b, qb, hq;
  if (!isctx) { b = unit >> 8; qb = (unit >> 3) & 31; hq = unit & 7; } else { int u = unit - 4096; b = u >> 4; qb = (u >> 3) & 1; hq = u & 7; }
  const int g = hq >> 2;
  const int tid = tid_(), lane = tid & 63, wid = tid >> 6, qn = lane & 31, hh = lane >> 5;
  const int qpos = qb * 128 + wid * 32 + qn;
  const size_t qrow = (size_t)b * LT + (isctx ? qpos : LC + qpos);
  const bf16_t* qptr = p.Z + qrow * INW + 1920 + hq * 64;
  bf16x8 qf[4];
#pragma unroll
  for (int s = 0; s < 4; ++s) qf[s] = *(const bf16x8*)(qptr + 16 * s + 8 * hh);
  const float sink = p.attn_sink[layer * 8 + hq];
  float m_run = sink, l_run = 1.f;
  f32x16 o0, o1;
#pragma unroll
  for (int i = 0; i < 16; ++i) { o0[i] = 0.f; o1[i] = 0.f; }
  typedef bf16_t KTile[64][72];
  KTile* Ks = (KTile*)smem;
  KTile* Vt = (KTile*)(smem + 18432);
  const int ntl = isctx ? 0 : 6;
  const int ntiles = ntl + 4;
  const int skey = tid >> 3, sseg = tid & 7;
  const bf16_t* kvbase = p.Z + (size_t)b * LT * INW + 1920 + 512 + g * 64 + sseg * 8;
  uint4 rk0, rk1, rv0, rv1;
  auto ldtile = [&](int kt) {
    const bool ctxk = kt >= ntl;
    const int kbase = ctxk ? (kt - ntl) * 64 : qb * 128 - 128 + kt * 64;
    const int kp0 = kbase + skey, kp1 = kp0 + 32;
    rk0 = rk1 = rv0 = rv1 = make_uint4(0, 0, 0, 0);
    if (ctxk || (kp0 >= 0 && kp0 < T)) { const bf16_t* src = kvbase + (size_t)(ctxk ? kp0 : LC + kp0) * INW; rk0 = *(const uint4*)src; rv0 = *(const uint4*)(src + 128); }
    if (ctxk || (kp1 >= 0 && kp1 < T)) { const bf16_t* src = kvbase + (size_t)(ctxk ? kp1 : LC + kp1) * INW; rk1 = *(const uint4*)src; rv1 = *(const uint4*)(src + 128); }
  };
  auto sttile = [&](int buf) {
    *(uint4*)&Ks[buf][skey][sseg * 8] = rk0;
    *(uint4*)&Ks[buf][skey + 32][sseg * 8] = rk1;
    bf16_t (*vt)[72] = Vt[buf];
    vt[sseg * 8 + 0][skey] = (bf16_t)(rv0.x & 0xFFFF); vt[sseg * 8 + 1][skey] = (bf16_t)(rv0.x >> 16);
    vt[sseg * 8 + 2][skey] = (bf16_t)(rv0.y & 0xFFFF); vt[sseg * 8 + 3][skey] = (bf16_t)(rv0.y >> 16);
    vt[sseg * 8 + 4][skey] = (bf16_t)(rv0.z & 0xFFFF); vt[sseg * 8 + 5][skey] = (bf16_t)(rv0.z >> 16);
    vt[sseg * 8 + 6][skey] = (bf16_t)(rv0.w & 0xFFFF); vt[sseg * 8 + 7][skey] = (bf16_t)(rv0.w >> 16);
    vt[sseg * 8 + 0][skey + 32] = (bf16_t)(rv1.x & 0xFFFF); vt[sseg * 8 + 1][skey + 32] = (bf16_t)(rv1.x >> 16);
    vt[sseg * 8 + 2][skey + 32] = (bf16_t)(rv1.y & 0xFFFF); vt[sseg * 8 + 3][skey + 32] = (bf16_t)(rv1.y >> 16);
    vt[sseg * 8 + 4][skey + 32] = (bf16_t)(rv1.z & 0xFFFF); vt[sseg * 8 + 5][skey + 32] = (bf16_t)(rv1.z >> 16);
    vt[sseg * 8 + 6][skey + 32] = (bf16_t)(rv1.w & 0xFFFF); vt[sseg * 8 + 7][skey + 32] = (bf16_t)(rv1.w >> 16);
  };
  ldtile(0);
#pragma unroll 1
  for (int kt = 0; kt < ntiles; ++kt) {
    const int buf = kt & 1;
    sttile(buf);
    __syncthreads();
    if (kt + 1 < ntiles) ldtile(kt + 1);
    const bool ctxk = kt >= ntl;
    const int kbase = ctxk ? (kt - ntl) * 64 : qb * 128 - 128 + kt * 64;
#pragma unroll
    for (int sub = 0; sub < 2; ++sub) {
      const int kb2 = kbase + sub * 32;
      bool need = true;
      if (!ctxk) {
        int q0 = qb * 128 + wid * 32;
        if (kb2 + 31 < q0 - 128 || kb2 > q0 + 31 + 128 || kb2 + 31 < 0 || kb2 >= T) need = false;
      }
      if (need) {
        f32x16 sv;
#pragma unroll
        for (int i = 0; i < 16; ++i) sv[i] = 0.f;
#pragma unroll
        for (int ks = 0; ks < 4; ++ks) {
          bf16x8 kf = *(const bf16x8*)&Ks[buf][sub * 32 + qn][16 * ks + 8 * hh];
          sv = mfma32(kf, qf[ks], sv);
        }
        float mt = -3e38f;
#pragma unroll
        for (int rg = 0; rg < 16; ++rg) {
          float v = sv[rg] * 0.125f;
          if (!ctxk) {
            int kp = kb2 + (rg & 3) + 8 * (rg >> 2) + 4 * hh;
            int dl = qpos - kp;
            bool ok = (dl <= 128) && (dl >= -128) && (kp >= 0) && (kp < T);
            v = ok ? v : -1e30f;
          }
          sv[rg] = v;
          mt = fmaxf(mt, v);
        }
        mt = fmaxf(mt, __shfl_xor(mt, 32));
        float m_new = fmaxf(m_run, mt);
        float corr = __expf(m_run - m_new);
        float ps = 0.f;
#pragma unroll
        for (int rg = 0; rg < 16; ++rg) { float pv = __expf(sv[rg] - m_new); sv[rg] = pv; ps += pv; }
        ps += __shfl_xor(ps, 32);
        l_run = l_run * corr + ps;
        m_run = m_new;
#pragma unroll
        for (int i = 0; i < 16; ++i) { o0[i] *= corr; o1[i] *= corr; }
#pragma unroll
        for (int sp = 0; sp < 2; ++sp) {
          bf16x8 pf;
#pragma unroll
          for (int j = 0; j < 8; ++j) pf[j] = (short)f2bf(sv[8 * sp + j]);
          const int kc = sub * 32 + 16 * sp + 4 * hh;
          uint2 va = *(const uint2*)&Vt[buf][qn][kc], vb = *(const uint2*)&Vt[buf][qn][kc + 8];
          uint2 vc = *(const uint2*)&Vt[buf][32 + qn][kc], vd = *(const uint2*)&Vt[buf][32 + qn][kc + 8];
          uint4 w0 = make_uint4(va.x, va.y, vb.x, vb.y), w1 = make_uint4(vc.x, vc.y, vd.x, vd.y);
          bf16x8 v0 = __builtin_bit_cast(bf16x8, w0), v1 = __builtin_bit_cast(bf16x8, w1);
          o0 = mfma32(v0, pf, o0);
          o1 = mfma32(v1, pf, o1);
        }
      }
    }
  }
  __syncthreads();
  const float inv = 1.f / l_run;
  bf16_t* optr = p.Y + qrow * D + 512 + hq * 64;
#pragma unroll
  for (int rg = 0; rg < 4; ++rg) {
    int d0 = 8 * rg + 4 * hh;
    *(uint2*)(optr + d0) = make_uint2(pack2(o0[4 * rg] * inv, o0[4 * rg + 1] * inv), pack2(o0[4 * rg + 2] * inv, o0[4 * rg + 3] * inv));
    *(uint2*)(optr + 32 + d0) = make_uint2(pack2(o1[4 * rg] * inv, o1[4 * rg + 1] * inv), pack2(o1[4 * rg + 2] * inv, o1[4 * rg + 3] * inv));
  }
}

DEV void ph_attn_post(const P& p, int layer) {
  const int gw = (bid_() * 256 + tid_()) >> 6, nw = gridDim.x * 4, lane = tid_() & 63;
  for (int row = gw; row < NTOK; row += nw) {
    bf16_t* yr = p.Y + (size_t)row * D + 512 + 8 * lane;
    uint4 u = *(const uint4*)yr;
    float v[8];
    unpack8(u, v);
    float ss = 0.f;
#pragma unroll
    for (int i = 0; i < 8; ++i) ss += v[i] * v[i];
    ss = wave_sum(ss);
    float rstd = rsqrtf(ss * (1.f / 512.f) + 1e-6f);
#pragma unroll
    for (int i = 0; i < 8; ++i) {
      v[i] = v[i] * rstd * p.at_out_g[layer * 512 + 8 * lane + i];
#if !EN_AT
      v[i] = 0.f;
#endif
    }
    *(uint4*)yr = pack8(v);
  }
}

struct Epi2 {
  const P& p; int layer, row0, col0;
  DEV void operator()(f32x4 (&acc)[4][4], int wr, int wc, int fr, int fq, char* smem) const {
    const int b = row0 / LT, pp = row0 % LT;
    const int mr = pp < LC ? 16 : b;
    const float* g1 = p.modv + ((size_t)layer * 17 + mr) * 6144 + 2048 + col0 + wc * 64;
#pragma unroll
    for (int n = 0; n < 4; ++n) {
      const float gv = g1[n * 16 + fr];
#pragma unroll
      for (int m = 0; m < 4; ++m)
#pragma unroll
        for (int j = 0; j < 4; ++j) acc[m][n][j] *= gv;
    }
    const int wid = wr * 2 + wc, lane = fq * 16 + fr;
    stage_tile_bf16(acc, smem, wid, fr, fq);
    const bf16_t (*t)[72] = (const bf16_t (*)[72])(smem + wid * 9216);
#pragma unroll
    for (int i = 0; i < 8; ++i) {
      const int rl = i * 8 + (lane >> 3), ch = lane & 7;
      bf16_t* xp = p.X + (size_t)(row0 + wr * 64 + rl) * D + col0 + wc * 64 + ch * 8;
      float xv[8], dv[8];
      uint4 xu = *(const uint4*)xp, du = *(const uint4*)&t[rl][ch * 8];
      unpack8(xu, xv); unpack8(du, dv);
#pragma unroll
      for (int q = 0; q < 8; ++q) xv[q] += dv[q];
#if EN_MIX
      *(uint4*)xp = pack8(xv);
#endif
    }
  }
};
DEV void ph_gemm2(const P& p, int layer, char* smem) {
  for (int u = bid_(); u < (NTOK / 128) * 8; u += gridDim.x) {
    int rt = u >> 3, ct = u & 7;
    Epi2 epi{p, layer, rt * 128, ct * 128};
    gemm_tile(p.Y + (size_t)rt * 128 * D, D, p.W2t + (size_t)ct * 128 * D, D, D, smem, epi);
  }
}

DEV void ph_peerconv(const P& p, int layer) {
  const int gw = (bid_() * 256 + tid_()) >> 6, nw = gridDim.x * 4, lane = tid_() & 63;
  const float* su = opq(p.peer_u) + (size_t)layer * 16384 * 1024;
  const float* sv = opq(p.peer_v) + (size_t)layer * 16384 * 1024;
  unsigned char* pu = opq(p.PU); unsigned char* pv = opq(p.PV);
  float* psu = opq(p.PSU); float* psv = opq(p.PSV);
#pragma unroll 1
  for (int r = gw; r < 32768; r += nw) {
    const bool isv = r >= 16384;
    const int e = r & 16383;
    const float* src = (isv ? sv : su) + (size_t)e * 1024 + 16 * lane;
    float4 f0 = *(const float4*)src, f1 = *(const float4*)(src + 4), f2 = *(const float4*)(src + 8), f3 = *(const float4*)(src + 12);
    float am = fmaxf(fmaxf(fmaxf(fabsf(f0.x), fabsf(f0.y)), fmaxf(fabsf(f0.z), fabsf(f0.w))), fmaxf(fmaxf(fabsf(f1.x), fabsf(f1.y)), fmaxf(fabsf(f1.z), fabsf(f1.w))));
    am = fmaxf(am, fmaxf(fmaxf(fmaxf(fabsf(f2.x), fabsf(f2.y)), fmaxf(fabsf(f2.z), fabsf(f2.w))), fmaxf(fmaxf(fabsf(f3.x), fabsf(f3.y)), fmaxf(fabsf(f3.z), fabsf(f3.w)))));
    am = wave_max(am);
    const float sc = am > 0.f ? 224.f / am : 1.f;
    int w0 = __builtin_amdgcn_cvt_pk_fp8_f32(f0.x * sc, f0.y * sc, 0, false); w0 = __builtin_amdgcn_cvt_pk_fp8_f32(f0.z * sc, f0.w * sc, w0, true);
    int w1 = __builtin_amdgcn_cvt_pk_fp8_f32(f1.x * sc, f1.y * sc, 0, false); w1 = __builtin_amdgcn_cvt_pk_fp8_f32(f1.z * sc, f1.w * sc, w1, true);
    int w2 = __builtin_amdgcn_cvt_pk_fp8_f32(f2.x * sc, f2.y * sc, 0, false); w2 = __builtin_amdgcn_cvt_pk_fp8_f32(f2.z * sc, f2.w * sc, w2, true);
    int w3 = __builtin_amdgcn_cvt_pk_fp8_f32(f3.x * sc, f3.y * sc, 0, false); w3 = __builtin_amdgcn_cvt_pk_fp8_f32(f3.z * sc, f3.w * sc, w3, true);
    *(uint4*)((isv ? pv : pu) + (size_t)(lane >> 3) * PSLICE + (size_t)e * 128 + 16 * (lane & 7)) = make_uint4((unsigned)w0, (unsigned)w1, (unsigned)w2, (unsigned)w3);
    if (lane == 0) (isv ? psv : psu)[e] = am > 0.f ? am * (1.f / 224.f) : 1.f;
  }
}
DEV void unpack16_fp8x2(const uint4& u, f32x2* f) {
  f[0] = __builtin_amdgcn_cvt_pk_f32_fp8((int)u.x, false); f[1] = __builtin_amdgcn_cvt_pk_f32_fp8((int)u.x, true);
  f[2] = __builtin_amdgcn_cvt_pk_f32_fp8((int)u.y, false); f[3] = __builtin_amdgcn_cvt_pk_f32_fp8((int)u.y, true);
  f[4] = __builtin_amdgcn_cvt_pk_f32_fp8((int)u.z, false); f[5] = __builtin_amdgcn_cvt_pk_f32_fp8((int)u.z, true);
  f[6] = __builtin_amdgcn_cvt_pk_f32_fp8((int)u.w, false); f[7] = __builtin_amdgcn_cvt_pk_f32_fp8((int)u.w, true);
}
DEV void unpack16_fp8(const uint4& u, float* f) {
  f32x2 t;
  t = __builtin_amdgcn_cvt_pk_f32_fp8((int)u.x, false); f[0] = t[0]; f[1] = t[1];
  t = __builtin_amdgcn_cvt_pk_f32_fp8((int)u.x, true); f[2] = t[0]; f[3] = t[1];
  t = __builtin_amdgcn_cvt_pk_f32_fp8((int)u.y, false); f[4] = t[0]; f[5] = t[1];
  t = __builtin_amdgcn_cvt_pk_f32_fp8((int)u.y, true); f[6] = t[0]; f[7] = t[1];
  t = __builtin_amdgcn_cvt_pk_f32_fp8((int)u.z, false); f[8] = t[0]; f[9] = t[1];
  t = __builtin_amdgcn_cvt_pk_f32_fp8((int)u.z, true); f[10] = t[0]; f[11] = t[1];
  t = __builtin_amdgcn_cvt_pk_f32_fp8((int)u.w, false); f[12] = t[0]; f[13] = t[1];
  t = __builtin_amdgcn_cvt_pk_f32_fp8((int)u.w, true); f[14] = t[0]; f[15] = t[1];
}

struct Epi3 {
  const P& p; int row0, grp;
  DEV void operator()(f32x4 (&acc)[4][4], int wr, int wc, int fr, int fq, char* smem) const {
    float* sc = (float*)smem;
    const int tid = tid_();
    for (int pass = 0; pass < 2; ++pass) {
      __syncthreads();
      if (wr == pass) {
#pragma unroll
        for (int m = 0; m < 4; ++m)
#pragma unroll
          for (int n = 0; n < 4; ++n)
#pragma unroll
            for (int j = 0; j < 4; ++j) {
              int rl = m * 16 + fq * 4 + j, col = wc * 64 + n * 16 + fr;
              unsigned bits = (__float_as_uint(acc[m][n][j]) & ~127u) | (unsigned)col;
              sc[rl * 133 + (col >> 5) * 33 + (col & 31)] = __uint_as_float(bits);
            }
      }
      __syncthreads();
      const int rl = tid >> 2, q = tid & 3;
      float Ls[16];
#pragma unroll
      for (int i = 0; i < 16; ++i) Ls[i] = -3e38f;
      const float* src = sc + rl * 133 + q * 33;
      for (int i = 0; i < 32; ++i) {
        float x = src[i];
        if (x > Ls[15]) {
#pragma unroll
          for (int k = 0; k < 16; ++k) { float hi = fmaxf(Ls[k], x); x = fminf(Ls[k], x); Ls[k] = hi; }
        }
      }
      float Cs[16];
#pragma unroll
      for (int i = 0; i < 16; ++i) Cs[i] = fmaxf(Ls[i], dppself<0xB1, 0xF>(Ls[15 - i]));
#pragma unroll
      for (int d = 8; d >= 1; d >>= 1)
#pragma unroll
        for (int i = 0; i < 16; ++i)
          if ((i & d) == 0) { float hi = fmaxf(Cs[i], Cs[i + d]), lo = fminf(Cs[i], Cs[i + d]); Cs[i] = hi; Cs[i + d] = lo; }
      float Ds[16];
#pragma unroll
      for (int i = 0; i < 16; ++i) Ds[i] = fmaxf(Cs[i], dppself<0x4E, 0xF>(Cs[15 - i]));
#pragma unroll
      for (int d = 8; d >= 1; d >>= 1)
#pragma unroll
        for (int i = 0; i < 16; ++i)
          if ((i & d) == 0) { float hi = fmaxf(Ds[i], Ds[i + d]), lo = fminf(Ds[i], Ds[i + d]); Ds[i] = hi; Ds[i + d] = lo; }
      if (q == 0) {
        float* dst = p.TK + ((size_t)(row0 + pass * 64 + rl) * 16 + grp) * 16;
#pragma unroll
        for (int i = 0; i < 4; ++i) *(float4*)(dst + 4 * i) = make_float4(Ds[4 * i], Ds[4 * i + 1], Ds[4 * i + 2], Ds[4 * i + 3]);
      }
    }
  }
};
DEV void ph_gemm3(const P& p, char* smem) {
  for (int u = bid_(); u < (NTOK / 128) * 16; u += gridDim.x) {
    int rt = u >> 4, ct = u & 15;
    Epi3 epi{p, rt * 128, ct};
    gemm_tile(p.H + (size_t)rt * 128 * D, D, p.Wft + (size_t)ct * 128 * D, D, D, smem, epi);
  }
}

DEV float peer_gate(float scr) {
  float mx = row16_max(scr);
  float ex = __expf(scr - mx);
  float sm = row16_sum(ex);
  return ex / sm;
}
DEV float gelu_exact(float x) { return 0.5f * x * (1.f + erff(x * 0.7071067811865476f)); }

DEV void ph_peer_select(const P& p) {
  const int gw = (bid_() * 256 + tid_()) >> 6, nw = gridDim.x * 4, lane = tid_() & 63;
  int ci, cj;
  {
    const int c = lane;
    if (c < 16) { ci = 0; cj = c; } else if (c < 24) { ci = 1; cj = c - 16; } else if (c < 29) { ci = 2; cj = c - 24; }
    else if (c < 33) { ci = 3; cj = c - 29; } else if (c < 36) { ci = 4; cj = c - 33; } else if (c < 38) { ci = 5; cj = c - 36; }
    else if (c < 40) { ci = 6; cj = c - 38; } else if (c < 42) { ci = 7; cj = c - 40; } else { ci = (c - 42 + 8) & 15; cj = 0; }
  }
  const bool cand = lane < 50;
#pragma unroll 1
  for (int row = gw; row < NTOK; row += nw) {
    const float* tk = p.TK + (size_t)row * 256;
#pragma unroll 1
    for (int h = 0; h < 8; ++h) {
      const float v1 = tk[(2 * h) * 16 + ci], v2 = tk[(2 * h + 1) * 16 + cj];
      float val = v1 + v2;
      val = __uint_as_float((__float_as_uint(val) & ~63u) | (unsigned)lane);
      val = cand ? val : -3e38f;
      int rank = 0;
#pragma unroll 10
      for (int c2 = 0; c2 < 50; ++c2) rank += (readlane_f(val, c2) > val) ? 1 : 0;
      const bool sel = cand && rank < 16;
      const float mx = wave_max(val);
      const float ex = sel ? __expf(val - mx) : 0.f;
      const float sm = wave_sum(ex);
      if (sel) {
        const int e = (int)(__float_as_uint(v1) & 127u) * 128 + (int)(__float_as_uint(v2) & 127u);
        p.EL[(size_t)row * 128 + h * 16 + rank] = (unsigned short)e;
        p.GT[(size_t)row * 128 + h * 16 + rank] = ex / sm;
      }
    }
  }
}

DEV void peer_u_item(const P& p, int x, int tok, int lane) {
  const int r = lane >> 3, c = lane & 7;
  const bf16_t* hr = p.H + (size_t)tok * D + x * 128 + c * 16;
  float hv[16];
  { uint4 u0 = *(const uint4*)hr, u1 = *(const uint4*)(hr + 8); unpack8(u0, hv); unpack8(u1, hv + 8); }
  f32x2 hv2[8];
#pragma unroll
  for (int i = 0; i < 8; ++i) hv2[i] = (f32x2){hv[2 * i], hv[2 * i + 1]};
  const uint4* elp = (const uint4*)(p.EL + (size_t)tok * 128 + r * 16);
  const uint4 e0 = elp[0], e1 = elp[1];
  const unsigned ew[8] = {e0.x, e0.y, e0.z, e0.w, e1.x, e1.y, e1.z, e1.w};
  const unsigned char* ub = p.PU + (size_t)x * PSLICE + c * 16;
  float keep0 = 0.f, keep1 = 0.f;
#pragma unroll
  for (int jh = 0; jh < 2; ++jh) {
    uint4 ua[8];
#pragma unroll
    for (int j = 0; j < 8; ++j) {
      const unsigned w = ew[jh * 4 + (j >> 1)];
      const unsigned e = (j & 1) ? (w >> 16) : (w & 0xFFFFu);
      ua[j] = *(const uint4*)(ub + (size_t)e * 128);
    }
#pragma unroll
    for (int j = 0; j < 8; ++j) {
      f32x2 f[8];
      unpack16_fp8x2(ua[j], f);
      f32x2 d2 = f[0] * hv2[0];
#pragma unroll
      for (int i = 1; i < 8; ++i) d2 += f[i] * hv2[i];
      const float d = oct_sum(d2[0] + d2[1]);
      if (jh == 0) keep0 = (c == j) ? d : keep0; else keep1 = (c == j) ? d : keep1;
    }
  }
  float* pd = p.PD + ((size_t)x * NTOK + tok) * 128 + r * 16 + c;
  pd[0] = keep0; pd[8] = keep1;
}
DEV void ph_peer_w(const P& p) {
  for (size_t i = (size_t)bid_() * 256 + tid_(); i < (size_t)NTOK * 128; i += (size_t)gridDim.x * 256) {
    float d = 0.f;
#pragma unroll
    for (int x = 0; x < 8; ++x) d += p.PD[(size_t)x * NTOK * 128 + i];
    const int e = p.EL[i];
    p.GT[i] = p.GT[i] * gelu_exact(d * p.PSU[e]) * p.PSV[e];
  }
}
DEV void peer_v_item(const P& p, int layer, int x, int tok, int lane, float* wbuf) {
  const int r = lane >> 3, c = lane & 7;
  const uint4* elp = (const uint4*)(p.EL + (size_t)tok * 128 + r * 16);
  const uint4 e0 = elp[0], e1 = elp[1];
  const unsigned ew[8] = {e0.x, e0.y, e0.z, e0.w, e1.x, e1.y, e1.z, e1.w};
  const float4* wtp = (const float4*)(p.GT + (size_t)tok * 128 + r * 16);
  const float4 w0 = wtp[0], w1 = wtp[1], w2 = wtp[2], w3 = wtp[3];
  const float wsv[16] = {w0.x, w0.y, w0.z, w0.w, w1.x, w1.y, w1.z, w1.w, w2.x, w2.y, w2.z, w2.w, w3.x, w3.y, w3.z, w3.w};
  const unsigned char* vb = p.PV + (size_t)x * PSLICE + c * 16;
  f32x2 acc2[8];
#pragma unroll
  for (int i = 0; i < 8; ++i) acc2[i] = (f32x2){0.f, 0.f};
#pragma unroll
  for (int jh = 0; jh < 2; ++jh) {
    uint4 ua[8];
#pragma unroll
    for (int j = 0; j < 8; ++j) {
      const unsigned w = ew[jh * 4 + (j >> 1)];
      const unsigned e = (j & 1) ? (w >> 16) : (w & 0xFFFFu);
      ua[j] = *(const uint4*)(vb + (size_t)e * 128);
    }
#pragma unroll
    for (int j = 0; j < 8; ++j) {
      f32x2 f[8];
      unpack16_fp8x2(ua[j], f);
      const f32x2 w2 = (f32x2){wsv[jh * 8 + j], wsv[jh * 8 + j]};
#pragma unroll
      for (int i = 0; i < 8; ++i) acc2[i] += w2 * f[i];
    }
  }
  float acc[16];
#pragma unroll
  for (int i = 0; i < 8; ++i) { acc[2 * i] = acc2[i][0]; acc[2 * i + 1] = acc2[i][1]; }
  float* slab = wbuf + (r * 8 + c) * 16;
  *(float4*)(slab) = make_float4(acc[0], acc[1], acc[2], acc[3]);
  *(float4*)(slab + 4) = make_float4(acc[4], acc[5], acc[6], acc[7]);
  *(float4*)(slab + 8) = make_float4(acc[8], acc[9], acc[10], acc[11]);
  *(float4*)(slab + 12) = make_float4(acc[12], acc[13], acc[14], acc[15]);
  asm volatile("s_waitcnt lgkmcnt(0)" ::: "memory");
  float o0 = 0.f, o1 = 0.f;
#pragma unroll
  for (int rr = 0; rr < 8; ++rr) {
    const float2 t = *(const float2*)(wbuf + (rr * 8 + (lane >> 3)) * 16 + 2 * (lane & 7));
    o0 += t.x; o1 += t.y;
  }
  asm volatile("s_waitcnt lgkmcnt(0)" ::: "memory");
  const int b = tok / LT, pp = tok % LT;
  const int mr = pp < LC ? 16 : b;
  const int col = x * 128 + 2 * lane;
  const float* g2 = p.modv + ((size_t)layer * 17 + mr) * 6144 + 5120 + col;
  unsigned* xp = (unsigned*)(p.X + (size_t)tok * D + col);
  const unsigned xu = *xp;
#if EN_PEER
  *xp = pack2(bflo(xu) + g2[0] * o0, bfhi(xu) + g2[1] * o1);
#endif
}
template <int WHICH>
DEV void ph_peer_gather(const P& p, int layer, char* smem, volatile LAS unsigned* slot) {
  const int tid = tid_(), lane = tid & 63, wid = tid >> 6;
  unsigned* q = p.wq + 1024 + layer * 256 + WHICH * 128;
  const int my = (int)(xb_xcc_id() & 7u);
  float* wbuf = (float*)smem + wid * 1024;
#pragma unroll 1
  for (int rot = 0; rot < 8; ++rot) {
    const int x = (my + rot) & 7;
    for (;;) {
      __syncthreads();
      if (tid == 0) *slot = atomicAdd(q + x * 16, 1u);
      __syncthreads();
      const int it = (int)*slot;
      if (it >= NTOK / 16) break;
#pragma unroll 1
      for (int i = 0; i < 4; ++i) {
        const int tok = it * 16 + wid * 4 + i;
        if (WHICH == 0) peer_u_item(p, x, tok, lane); else peer_v_item(p, layer, x, tok, lane, wbuf);
      }
    }
  }
}

DEV void ph_final(const P& p) {
  const int gw = (bid_() * 256 + tid_()) >> 6, nw = gridDim.x * 4, lane = tid_() & 63;
  for (int r = gw; r < NB * T; r += nw) {
    int b = r / T, t = r % T;
    const bf16_t* xr = p.X + ((size_t)b * LT + LC + t) * D;
    uint4 u0 = *(const uint4*)(xr + 8 * lane), u1 = *(const uint4*)(xr + 512 + 8 * lane);
    float v[16];
    unpack8(u0, v); unpack8(u1, v + 8);
    float ss = 0.f;
#pragma unroll
    for (int i = 0; i < 16; ++i) ss += v[i] * v[i];
    ss = wave_sum(ss);
    float rstd = rsqrtf(ss * (1.f / 1024.f) + 1e-6f);
    float* o = p.out + (size_t)r * D;
#pragma unroll
    for (int hh = 0; hh < 2; ++hh) {
      int col = hh * 512 + 8 * lane;
      float4 a = make_float4(v[hh * 8 + 0] * rstd * p.final_g[col + 0], v[hh * 8 + 1] * rstd * p.final_g[col + 1], v[hh * 8 + 2] * rstd * p.final_g[col + 2], v[hh * 8 + 3] * rstd * p.final_g[col + 3]);
      float4 c = make_float4(v[hh * 8 + 4] * rstd * p.final_g[col + 4], v[hh * 8 + 5] * rstd * p.final_g[col + 5], v[hh * 8 + 6] * rstd * p.final_g[col + 6], v[hh * 8 + 7] * rstd * p.final_g[col + 7]);
      *(float4*)(o + col) = a; *(float4*)(o + col + 4) = c;
    }
  }
}

DEV unsigned hw_cu_key() {
  const unsigned hwid = (unsigned)__builtin_amdgcn_s_getreg(((8 - 1) << 11) | (8 << 6) | 4);
  return (xb_xcc_id() << 8) | (hwid & 0xFFu);
}
DEV void mixB(const P& p, int layer, char* smem, volatile LAS unsigned* slot) {
  unsigned* qa = p.wq + layer * 64;
  unsigned* qs = qa + 16;
  unsigned* claim = p.cuclaim + layer * 4096;
  __syncthreads();
  if (tid_() == 0) {
    unsigned u = 0xFFFFFFFFu;
    if (atomicAdd(&claim[hw_cu_key() & 4095u], 1u) == 0u) u = atomicAdd(qs, 1u);
    *slot = u;
  }
  __syncthreads();
  {
    const unsigned u = *slot;
    if (u < 256u) scan_unit(p, layer, (int)u, smem);
  }
  for (;;) {
    __syncthreads();
    if (tid_() == 0) *slot = atomicAdd(qa, 1u);
    __syncthreads();
    const int u = (int)*slot;
    if (u >= 8704) break;
    if (u < 4352) attn_unit(p, layer, u, smem); else hyena_conv_unit(p, layer, u - 4352, smem);
  }
  for (;;) {
    __syncthreads();
    if (tid_() == 0) *slot = atomicAdd(qs, 1u);
    __syncthreads();
    const unsigned u = *slot;
    if (u >= 256u) break;
    scan_unit(p, layer, (int)u, smem);
  }
}
DEV void mixA(const P& p, int layer, char* smem) {
  for (int u = bid_(); u < 1088 + 5440; u += gridDim.x) {
    if (u < 1088) hyena_pre_unit(p, layer, u); else lora_unit(p, layer, u - 1088, smem);
  }
  ph_rwkv_prep(p, layer);
}
DEV void mixC(const P& p, int layer, char* smem) {
  for (int u = bid_(); u < 1088; u += gridDim.x) hyena_post_unit(p, layer, u, smem);
  ph_rwkv_post(p, layer);
  ph_attn_post(p, layer);
}

__global__ void __launch_bounds__(256, 2) k_mega(P p) {
  extern __shared__ __attribute__((aligned(16))) char smem_all[];
  char* smem = smem_all;
  volatile LAS unsigned* xbw = (volatile LAS unsigned*)(smem_all + SMEM_BYTES);
  if (threadIdx.x == 0) { xbw[0] = 0u; xbw[1] = 0u; xbw[2] = 0u; xbw[3] = 0u; }
  __syncthreads();
  XcdBarrier bar = xcd_barrier_post(p.bar, xbw);
#ifndef NO_PRO
  ph_copy(p);
  ph_rope(p);
  for (int u = blockIdx.x; u < 96; u += gridDim.x) modv_unit(p, u, smem);
#endif
#ifndef NO_PREP
  ph_prep(p, 0, smem);
#endif
  xcd_barrier(bar);
  for (int layer = 0; layer < NLAYERS; ++layer) {
#ifndef NO_NORM
    ph_norm(p, layer, 0);
#endif
    xcd_barrier(bar);
#ifdef PROBE_GEMM
    ph_gemm1(p, smem);
#endif
#ifndef NO_GEMM1
    ph_gemm1(p, smem);
#endif
    xcd_barrier(bar);
#ifndef NO_MIXA
    mixA(p, layer, smem);
#endif
    xcd_barrier(bar);
#ifndef NO_MIXB
    mixB(p, layer, smem, (volatile LAS unsigned*)(smem_all + SMEM_BYTES + 16));
#endif
    xcd_barrier(bar);
#ifndef NO_MIXC
    mixC(p, layer, smem);
#endif
    xcd_barrier(bar);
#ifndef NO_GEMM2
    ph_gemm2(p, layer, smem);
    ph_peerconv(p, layer);
#endif
    xcd_barrier(bar);
#ifndef NO_NORM
    ph_norm(p, layer, 1);
#endif
    xcd_barrier(bar);
#ifdef PROBE_GEMM
    ph_gemm3(p, smem);
#endif
#ifndef NO_GEMM3
    ph_gemm3(p, smem);
#endif
    xcd_barrier(bar);
    ph_peer_select(p);
    xcd_barrier(bar);
    ph_peer_gather<0>(p, layer, smem, (volatile LAS unsigned*)(smem_all + SMEM_BYTES + 16));
    xcd_barrier(bar);
    ph_peer_w(p);
    xcd_barrier(bar);
    ph_peer_gather<1>(p, layer, smem, (volatile LAS unsigned*)(smem_all + SMEM_BYTES + 16));
#ifndef NO_PREP
    if (layer + 1 < NLAYERS) ph_prep(p, layer + 1, smem);
#endif
    xcd_barrier(bar);
  }
  ph_final(p);
}

static inline size_t al256(size_t x) { return (x + 255) & ~(size_t)255; }

extern "C" void kernel_launch(void* const* d_in, const int* in_sizes, int n_in, void* d_out, int out_size, void* d_ws, size_t ws_size,
                              hipStream_t stream) {
  (void)in_sizes; (void)n_in; (void)out_size; (void)ws_size;
  P p{};
  const float** f = (const float**)&p;
  for (int i = 0; i < 39; ++i) f[i] = (const float*)d_in[i];
  p.out = (float*)d_out;
  char* w = (char*)d_ws;
  size_t off = 0;
  auto take = [&](size_t bytes) { char* r = w + off; off += al256(bytes); return r; };
  p.bar = (unsigned*)take(16384);
  p.modv = (float*)take((size_t)DEPTH * 17 * 6144 * 4);
  p.SSQ = (float*)take((size_t)DEPTH * 2 * 256 * 4);
  p.wq = (unsigned*)take(4096 + DEPTH * 1024);
  p.cuclaim = (unsigned*)take((size_t)DEPTH * 4096 * 4);
  const size_t zero_bytes = off;
  p.rope = (float*)take(64 * 16 * 2 * 4);
  p.X = (bf16_t*)take((size_t)NTOK * D * 2);
  p.H = (bf16_t*)take((size_t)NTOK * D * 2);
  p.Y = (bf16_t*)take((size_t)NTOK * D * 2);
  p.SC = (bf16_t*)take((size_t)NTOK * 1024 * 2);
  p.Z = (bf16_t*)take((size_t)NTOK * INW * 2);
  p.UTl = (bf16_t*)take((size_t)256 * 16 * T * 2);
  p.UTc = (bf16_t*)take((size_t)256 * 16 * LC * 2);
  p.YTl = (bf16_t*)take((size_t)256 * 16 * T * 2);
  p.YTc = (bf16_t*)take((size_t)256 * 16 * LC * 2);
  p.FL = (float*)take((size_t)256 * 2 * T * 4);
  p.FC = (float*)take((size_t)256 * 2 * LC * 4);
  p.W1t = (bf16_t*)take((size_t)INW * D * 2);
  p.W2t = (bf16_t*)take((size_t)D * D * 2);
  p.Wft = (bf16_t*)take((size_t)2048 * D * 2);
  p.Wwt = (bf16_t*)take((size_t)2 * 256 * 64 * 2);
  p.Wat = (bf16_t*)take((size_t)2 * 256 * 64 * 2);
  p.Wgt = (bf16_t*)take((size_t)256 * 128 * 2);
  p.TK = (float*)p.Z;
  p.PU = (unsigned char*)p.Z + al256((size_t)NTOK * 256 * 4);
  p.PV = p.PU + (size_t)16384 * 1024;
  p.PSU = (float*)(p.PV + (size_t)16384 * 1024);
  p.PSV = p.PSU + 16384;
  p.GT = p.PSV + 16384;
  p.EL = (unsigned short*)(p.GT + (size_t)NTOK * 128);
  p.PD = (float*)p.Y;

  (void)hipMemsetAsync(d_ws, 0, zero_bytes, stream);
  constexpr size_t kDynLds = SMEM_BYTES + 32;
  static int grid = 0;
  if (!grid) {
    int dev = 0, cus = 0, per_cu = 0;
    (void)hipGetDevice(&dev);
    (void)hipDeviceGetAttribute(&cus, hipDeviceAttributeMultiprocessorCount, dev);
    (void)hipFuncSetAttribute((const void*)k_mega, hipFuncAttributeMaxDynamicSharedMemorySize, (int)kDynLds);
    (void)hipOccupancyMaxActiveBlocksPerMultiprocessor(&per_cu, k_mega, 256, kDynLds);
    if (cus <= 0) cus = 256;
    if (per_cu > 2) per_cu = 2;
    if (per_cu < 1) per_cu = 1;
    grid = cus * per_cu;
  }
  k_mega<<<grid, 256, kDynLds, stream>>>(p);
}
```

```cpp
#include <hip/hip_runtime.h>
#include <stdint.h>

#define DEV __device__ __forceinline__
typedef unsigned short bf16_t;
typedef short bf16x8 __attribute__((ext_vector_type(8)));
typedef float f32x2 __attribute__((ext_vector_type(2)));
constexpr size_t PSLICE = (size_t)16384 * 128;
typedef float f32x4 __attribute__((ext_vector_type(4)));
typedef float f32x16 __attribute__((ext_vector_type(16)));

#ifndef NLAYERS
#define NLAYERS 4
#endif
#ifndef EN_HY
#define EN_HY 1
#endif
#ifndef EN_RW
#define EN_RW 1
#endif
#ifndef EN_AT
#define EN_AT 1
#endif
#ifndef EN_MIX
#define EN_MIX 1
#endif
#ifndef EN_PEER
#define EN_PEER 1
#endif

constexpr int NB = 16, T = 4096, LC = 256, LT = 4352, D = 1024, NTOK = NB * LT, INW = 2688, DEPTH = 4;
constexpr int SMEM_BYTES = 65536;

struct P {
  const float *x, *c, *ctx, *c_ctx, *mod_w, *mod_b, *norm1_g, *norm2_g, *w_in, *conv_w, *conv_b;
  const float *hy_w1, *hy_b1, *hy_w2, *hy_b2, *hy_w3, *hy_b3, *hy_freq, *hy_bias;
  const float *rw_w0, *rw_w_up, *rw_a0, *rw_a_up, *rw_g_up, *rw_k_k, *rw_k_a, *rw_r_k, *rw_ln_w, *rw_ln_b;
  const float *attn_sink, *hy_out_g, *at_out_g, *w_out, *peer_wq, *peer_k1, *peer_k2, *peer_u, *peer_v, *final_g;
  float* out;
  unsigned* bar;
  float *modv, *SSQ, *rope, *FL, *FC, *TK;
  unsigned *wq, *cuclaim;
  bf16_t *X, *H, *Y, *SC, *Z, *UTl, *UTc, *YTl, *YTc;
  bf16_t *W1t, *W2t, *Wft, *Wwt, *Wat, *Wgt;
  unsigned char *PU, *PV;
  float *PSU, *PSV, *GT, *PD;
  unsigned short* EL;
};

typedef __bf16 hwbf2 __attribute__((ext_vector_type(2)));
DEV unsigned pack2(float a, float b) { f32x2 f = {a, b}; hwbf2 r = __builtin_convertvector(f, hwbf2); return __builtin_bit_cast(unsigned, r); }
DEV bf16_t f2bf(float f) { return (bf16_t)(pack2(f, 0.f) & 0xFFFFu); }
DEV float bf2f(bf16_t h) { return __uint_as_float(((unsigned)h) << 16); }
DEV float bflo(unsigned u) { return __uint_as_float(u << 16); }
DEV float bfhi(unsigned u) { return __uint_as_float(u & 0xFFFF0000u); }
DEV void unpack8(const uint4& u, float* v) {
  v[0] = bflo(u.x); v[1] = bfhi(u.x); v[2] = bflo(u.y); v[3] = bfhi(u.y);
  v[4] = bflo(u.z); v[5] = bfhi(u.z); v[6] = bflo(u.w); v[7] = bfhi(u.w);
}
DEV uint4 pack8(const float* v) { return make_uint4(pack2(v[0], v[1]), pack2(v[2], v[3]), pack2(v[4], v[5]), pack2(v[6], v[7])); }
DEV float sigmoidf_(float x) { return 1.f / (1.f + __expf(-x)); }

template <int CTRL, int ROWMASK>
DEV float dpp0(float x) {
  return __builtin_bit_cast(float, __builtin_amdgcn_update_dpp(0, __builtin_bit_cast(int, x), CTRL, ROWMASK, 0xF, false));
}
template <int CTRL, int ROWMASK>
DEV float dppself(float x) {
  int xi = __builtin_bit_cast(int, x);
  return __builtin_bit_cast(float, __builtin_amdgcn_update_dpp(xi, xi, CTRL, ROWMASK, 0xF, false));
}
DEV float readlane_f(float x, int l) { return __builtin_bit_cast(float, __builtin_amdgcn_readlane(__builtin_bit_cast(int, x), l)); }
DEV int lane_id() { return (int)__builtin_amdgcn_mbcnt_hi(~0u, __builtin_amdgcn_mbcnt_lo(~0u, 0u)); }
DEV float writelane_f(float val, int l, float old) { return lane_id() == l ? val : old; }
DEV int writelane_i(int val, int l, int old) { return lane_id() == l ? val : old; }
DEV float wave_sum(float x) {
  x += dpp0<0x111, 0xF>(x); x += dpp0<0x112, 0xF>(x); x += dpp0<0x114, 0xF>(x); x += dpp0<0x118, 0xF>(x);
  x += dpp0<0x142, 0xA>(x); x += dpp0<0x143, 0xC>(x);
  return readlane_f(x, 63);
}
DEV float wave_max(float x) {
  x = fmaxf(x, dppself<0x111, 0xF>(x)); x = fmaxf(x, dppself<0x112, 0xF>(x)); x = fmaxf(x, dppself<0x114, 0xF>(x));
  x = fmaxf(x, dppself<0x118, 0xF>(x)); x = fmaxf(x, dppself<0x142, 0xA>(x)); x = fmaxf(x, dppself<0x143, 0xC>(x));
  return readlane_f(x, 63);
}
DEV float row16_sum(float x) {
  x += dpp0<0xB1, 0xF>(x); x += dpp0<0x4E, 0xF>(x); x += dpp0<0x141, 0xF>(x); x += dpp0<0x140, 0xF>(x);
  return x;
}
DEV float row16_max(float x) {
  x = fmaxf(x, dppself<0xB1, 0xF>(x)); x = fmaxf(x, dppself<0x4E, 0xF>(x)); x = fmaxf(x, dppself<0x141, 0xF>(x));
  x = fmaxf(x, dppself<0x140, 0xF>(x));
  return x;
}
DEV float quad_sum(float x) { x += dpp0<0xB1, 0xF>(x); x += dpp0<0x4E, 0xF>(x); return x; }

DEV f32x4 mfma16(bf16x8 a, bf16x8 b, f32x4 c) { return __builtin_amdgcn_mfma_f32_16x16x32_bf16(a, b, c, 0, 0, 0); }
DEV f32x16 mfma32(bf16x8 a, bf16x8 b, f32x16 c) { return __builtin_amdgcn_mfma_f32_32x32x16_bf16(a, b, c, 0, 0, 0); }


#define XB_TMO      128
#define XB_XCNT(j)  (256  + 64 * (j))
#define XB_XSUB(j)  (1280 + 64 * (j))
#define XB_XGEN(j)  (2304 + 64 * (j))
#define XB_TOP      3328
#define XB_TOPGEN   3392
#define XCD_BAR_WORDS 3456
#define XB_SPIN_CAP (1u << 23)
#define LAS __attribute__((address_space(3)))

__device__ __forceinline__ unsigned xb_ld(unsigned* p)              { return __hip_atomic_load(p, __ATOMIC_RELAXED, __HIP_MEMORY_SCOPE_AGENT); }
__device__ __forceinline__ unsigned xb_add(unsigned* p, unsigned v) { return __hip_atomic_fetch_add(p, v, __ATOMIC_RELAXED, __HIP_MEMORY_SCOPE_AGENT); }
__device__ __forceinline__ unsigned xb_xcc_id() { return (unsigned)__builtin_amdgcn_s_getreg((3 << 11) | 20) & 0xFu; }
#define XB_SPIN(cond, bar) do { unsigned _sp = 0; while (cond) { __builtin_amdgcn_s_sleep(1); \
    if ((++_sp & 255u) == 0u) { if (xb_ld(&(bar)[XB_TMO])) break; if (_sp > XB_SPIN_CAP) { atomicAdd(&(bar)[XB_TMO], 1u); break; } } } } while (0)

struct XcdBarrier {
    unsigned* bar; unsigned x;
    volatile LAS unsigned* st;
};
__device__ __forceinline__ XcdBarrier xcd_barrier_post(unsigned* bar, volatile LAS unsigned* st) {
    XcdBarrier b; b.bar = bar; b.x = xb_xcc_id(); b.st = st;
    if (threadIdx.x == 0) (void)xb_add(&bar[XB_XCNT(b.x)], 1u);
    return b;
}
__device__ __forceinline__ void xcd_barrier_complete(unsigned* bar, unsigned x, unsigned& nloc, unsigned& nx) {
    const unsigned G = gridDim.x * gridDim.y * gridDim.z;
    unsigned sum, cnt, mine, sp = 0u;
    for (;;) {
        sum = 0u; cnt = 0u; mine = 0u;
#pragma unroll
        for (unsigned j = 0; j < 16; ++j) { const unsigned c = xb_ld(&bar[XB_XCNT(j)]); sum += c; cnt += (c > 0u) ? 1u : 0u; mine = (j == x) ? c : mine; }
        if (sum == G) break;
        __builtin_amdgcn_s_sleep(1);
        if ((++sp & 255u) == 0u) { if (xb_ld(&bar[XB_TMO])) break; if (sp > XB_SPIN_CAP) { atomicAdd(&bar[XB_TMO], 1u); break; } }
    }
    nloc = mine > 0u ? mine : 1u; nx = cnt > 0u ? cnt : 1u;
}
__device__ __forceinline__ void xcd_barrier(const XcdBarrier& b) {
    asm volatile("s_waitcnt vmcnt(0)" ::: "memory");
    __syncthreads();
    if (threadIdx.x == 0) {
        unsigned* bar = b.bar;
        __builtin_amdgcn_s_waitcnt(0);
        unsigned nloc = b.st[0], nx = b.st[1];
        if (nloc == 0u) { xcd_barrier_complete(bar, b.x, nloc, nx); b.st[0] = nloc; b.st[1] = nx; }
        const unsigned old = xb_add(&bar[XB_XSUB(b.x)], 1u);
        const unsigned gen = old / nloc;
        if (old + 1u == (gen + 1u) * nloc) {
            __builtin_amdgcn_fence(__ATOMIC_RELEASE, "agent");
            asm volatile("s_waitcnt vmcnt(0)" ::: "memory");
            const unsigned og = xb_add(&bar[XB_TOP], 1u);
            const unsigned tg = og / nx;
            if (og + 1u == (tg + 1u) * nx) xb_add(&bar[XB_TOPGEN], 1u);
            else XB_SPIN(xb_ld(&bar[XB_TOPGEN]) == tg, bar);
            __builtin_amdgcn_fence(__ATOMIC_ACQUIRE, "agent");
            xb_add(&bar[XB_XGEN(b.x)], 1u);
            asm volatile("s_waitcnt vmcnt(0)" ::: "memory");
        } else {
            XB_SPIN(xb_ld(&bar[XB_XGEN(b.x)]) == gen, bar);
            __builtin_amdgcn_fence(__ATOMIC_ACQUIRE, "agent");
            asm volatile("s_waitcnt vmcnt(0)" ::: "memory");
        }
    }
    __syncthreads();
}

template <class Tp> DEV Tp* opq(Tp* q) { asm volatile("" : "+s"(q)); return q; }
DEV int tid_() { int t = threadIdx.x; asm volatile("" : "+v"(t)); return t; }
DEV int bid_() { int b = blockIdx.x; asm volatile("" : "+s"(b)); return b; }

DEV void glds16(const void* gsrc, char* lds_lane_ptr) {
  __builtin_amdgcn_global_load_lds((const unsigned*)gsrc, (__attribute__((address_space(3))) unsigned*)lds_lane_ptr, 16, 0, 0);
}
template <class Epi>
DEV void gemm_tile(const bf16_t* __restrict__ A, int lda, const bf16_t* __restrict__ Bt, int ldb, int K, char* smem, Epi& epi) {
  const int tid = tid_(), lane = tid & 63, wid = tid >> 6, wr = wid >> 1, wc = wid & 1, fr = lane & 15, fq = lane >> 4;
  f32x4 acc[4][4];
#pragma unroll
  for (int m = 0; m < 4; ++m)
#pragma unroll
    for (int n = 0; n < 4; ++n) acc[m][n] = (f32x4){0.f, 0.f, 0.f, 0.f};
  const int drow0 = 8 * wid + (lane >> 3), dpc = lane & 7;
  auto issue = [&](int kt, int buf) {
    char* sa = smem + buf * 32768;
    char* sb = sa + 16384;
#pragma unroll
    for (int i = 0; i < 4; ++i) {
      const int row = drow0 + 32 * i;
      const int kc = dpc ^ ((row >> 1) & 7);
      glds16(A + (size_t)row * lda + kt * 64 + kc * 8, sa + (i * 4 + wid) * 1024 + lane * 16);
      glds16(Bt + (size_t)row * ldb + kt * 64 + kc * 8, sb + (i * 4 + wid) * 1024 + lane * 16);
    }
  };
  __syncthreads();
  issue(0, 0);
  const int nk = K >> 6;
  const int sw = (fr >> 1) & 7;
  const int aoff = (wr * 64 + fr) * 128, boff = (wc * 64 + fr) * 128;
  for (int kt = 0; kt < nk; ++kt) {
    asm volatile("s_waitcnt vmcnt(0)" ::: "memory");
    __syncthreads();
    if (kt + 1 < nk) issue(kt + 1, (kt + 1) & 1);
    const char* sa = smem + (kt & 1) * 32768;
    const char* sb = sa + 16384;
#pragma unroll
    for (int kh = 0; kh < 2; ++kh) {
      const int pc = ((kh * 4 + fq) ^ sw) * 16;
      bf16x8 af[4], bfr[4];
#pragma unroll
      for (int m = 0; m < 4; ++m) af[m] = *(const bf16x8*)(sa + aoff + m * 2048 + pc);
#pragma unroll
      for (int n = 0; n < 4; ++n) bfr[n] = *(const bf16x8*)(sb + boff + n * 2048 + pc);
#pragma unroll
      for (int m = 0; m < 4; ++m)
#pragma unroll
        for (int n = 0; n < 4; ++n) acc[m][n] = mfma16(af[m], bfr[n], acc[m][n]);
    }
  }
  __syncthreads();
  epi(acc, wr, wc, fr, fq, smem);
}
DEV void stage_tile_bf16(const f32x4 (&acc)[4][4], char* smem, int wid, int fr, int fq) {
  bf16_t (*t)[72] = (bf16_t (*)[72])(smem + wid * 9216);
#pragma unroll
  for (int m = 0; m < 4; ++m)
#pragma unroll
    for (int n = 0; n < 4; ++n)
#pragma unroll
      for (int j = 0; j < 4; ++j) t[m * 16 + fq * 4 + j][n * 16 + fr] = f2bf(acc[m][n][j]);
  asm volatile("s_waitcnt lgkmcnt(0)" ::: "memory");
}

DEV void ph_copy(const P& p) {
  const size_t n8 = (size_t)NTOK * D / 8;
  const float* pctx = opq(p.ctx); const float* px = opq(p.x);
  for (size_t i = (size_t)bid_() * 256 + tid_(); i < n8; i += (size_t)gridDim.x * 256) {
    size_t e = i * 8;
    int row = (int)(e / D), col = (int)(e % D);
    int b = row / LT, pp = row % LT;
    const float* src = pp < LC ? pctx + ((size_t)(b * LC + pp)) * D + col : px + ((size_t)(b * T + pp - LC)) * D + col;
    float4 v0 = *(const float4*)src, v1 = *(const float4*)(src + 4);
    uint4 o = make_uint4(pack2(v0.x, v0.y), pack2(v0.z, v0.w), pack2(v1.x, v1.y), pack2(v1.z, v1.w));
    *(uint4*)(p.X + e) = o;
  }
}

DEV void ph_rope(const P& p) {
  for (int i = bid_() * 256 + tid_(); i < 64 * 16; i += gridDim.x * 256) {
    int pos = i >> 4, k = i & 15;
    float inv = powf(10000.f, -(float)k / 16.f);
    float ang = (float)pos * inv;
    p.rope[2 * i] = cosf(ang); p.rope[2 * i + 1] = sinf(ang);
  }
}

DEV void modv_unit(const P& p, int unit, char* smem) {
  const int cc = unit % 24, layer = unit / 24;
  float (*cs)[128] = (float (*)[128])smem;
  const int col = cc * 256 + tid_();
  const float* pc = opq(p.c); const float* pcc = opq(p.c_ctx);
  float acc[17];
#pragma unroll
  for (int r = 0; r < 17; ++r) acc[r] = 0.f;
  for (int ks = 0; ks < 8; ++ks) {
    __syncthreads();
    for (int i = tid_(); i < 17 * 128; i += 256) {
      int r = i >> 7, e = i & 127;
      float v = r < 16 ? pc[r * D + ks * 128 + e] : pcc[ks * 128 + e];
      cs[r][e] = v / (1.f + expf(-v));
    }
    __syncthreads();
    const float* w = p.mod_w + ((size_t)layer * D + ks * 128) * 6144 + col;
#pragma unroll 4
    for (int e = 0; e < 128; ++e) {
      float wv = w[(size_t)e * 6144];
#pragma unroll
      for (int r = 0; r < 17; ++r) acc[r] += cs[r][e] * wv;
    }
  }
  const float bias = p.mod_b[layer * 6144 + col];
#pragma unroll
  for (int r = 0; r < 17; ++r) p.modv[((size_t)layer * 17 + r) * 6144 + col] = acc[r] + bias;
}

DEV void transpose_unit(const float* __restrict__ src, bf16_t* __restrict__ dst, int R, int C, int tile, char* smem) {
  float (*t)[65] = (float (*)[65])smem;
  const int nct = C / 64;
  const int tr = tile / nct, tc = tile % nct;
  __syncthreads();
  for (int i = tid_(); i < 4096; i += 256) { int r = i >> 6, c = i & 63; t[r][c] = src[(size_t)(tr * 64 + r) * C + tc * 64 + c]; }
  __syncthreads();
  for (int i = tid_(); i < 4096; i += 256) { int c = i >> 6, r = i & 63; dst[(size_t)(tc * 64 + c) * R + tr * 64 + r] = f2bf(t[r][c]); }
}

DEV void wfold_unit(const P& p, int layer, int unit, char* smem) {
  const int hs = unit >> 5, ec = unit & 31, h = hs >> 1, s = hs & 1;
  const float* wq = p.peer_wq + (size_t)layer * D * 2048;
  const float* kk = (s ? opq(p.peer_k2) : opq(p.peer_k1)) + ((size_t)layer * 8 + h) * 128 * 128;
  float (*kS)[65] = (float (*)[65])smem;
  float (*wS)[64] = (float (*)[64])(smem + 33280);
  const int key = tid_() & 127, eh = tid_() >> 7;
  float acc[16];
#pragma unroll
  for (int i = 0; i < 16; ++i) acc[i] = 0.f;
  for (int dh = 0; dh < 2; ++dh) {
    __syncthreads();
    for (int i = tid_(); i < 128 * 64; i += 256) { int k2 = i >> 6, d = i & 63; kS[k2][d] = kk[k2 * 128 + dh * 64 + d]; }
    for (int i = tid_(); i < 32 * 64; i += 256) {
      int e = i >> 6, d = i & 63;
      wS[e][d] = wq[(size_t)(ec * 32 + e) * 2048 + h * 256 + s * 128 + dh * 64 + d];
    }
    __syncthreads();
#pragma unroll 2
    for (int d = 0; d < 64; ++d) {
      float kv = kS[key][d];
#pragma unroll
      for (int i = 0; i < 16; ++i) acc[i] += kv * wS[eh * 16 + i][d];
    }
  }
  bf16_t* dst = p.Wft + ((size_t)(hs * 128 + key)) * D + ec * 32 + eh * 16;
#pragma unroll
  for (int i = 0; i < 16; i += 2) *(unsigned*)(dst + i) = pack2(acc[i], acc[i + 1]);
}

DEV void filt_unit(const P& p, int layer, int unit, char* smem) {
  int kind, j0, L;
  if (unit < 1024) { kind = 0; j0 = unit * 4; L = T; } else { kind = 1; j0 = (unit - 1024) * 4; L = LC; }
  float* zs = (float*)smem;
  float* h1 = zs + 4 * 36;
  float* h2 = h1 + 256;
  const int jj = tid_() >> 6, o = tid_() & 63;
  const int j = j0 + jj;
  const float fj = (float)j;
  const float t = fj / (float)(L - 1);
  __syncthreads();
  if (o < 33) {
    float z;
    if (o == 0) z = t;
    else {
      int i = (o - 1) & 15;
      float band = 1e-4f + (float)i * ((15.0f - 1e-4f) / 15.0f);
      float ang = 6.283185307179586f * fj * band / (float)L;
      z = (o <= 16) ? cosf(ang) : -sinf(ang);
    }
    zs[jj * 36 + o] = z;
  }
  __syncthreads();
  {
    const float* w1 = p.hy_w1 + layer * 33 * 64;
    float a = p.hy_b1[layer * 64 + o];
#pragma unroll 3
    for (int i = 0; i < 33; ++i) a += zs[jj * 36 + i] * w1[i * 64 + o];
    h1[jj * 64 + o] = sinf(p.hy_freq[layer * 128 + o] * a);
  }
  __syncthreads();
  {
    const float* w2 = p.hy_w2 + layer * 64 * 64;
    float a = p.hy_b2[layer * 64 + o];
#pragma unroll 4
    for (int i = 0; i < 64; ++i) a += h1[jj * 64 + i] * w2[i * 64 + o];
    h2[jj * 64 + o] = sinf(p.hy_freq[layer * 128 + 64 + o] * a);
  }
  __syncthreads();
  const float* w3 = p.hy_w3 + layer * 64 * 512;
  float* F = kind ? opq(p.FC) : opq(p.FL);
  const float DMIN = -3.0701134573253945f, DMAX = -15.350567286626973f;
#pragma unroll 1
  for (int m = 0; m < 4; ++m) {
    int c = o + 64 * m;
    float af = p.hy_b3[layer * 512 + c], ab = p.hy_b3[layer * 512 + 256 + c];
#pragma unroll 4
    for (int i = 0; i < 64; ++i) { float hv = h2[jj * 64 + i]; af += hv * w3[i * 512 + c]; ab += hv * w3[i * 512 + 256 + c]; }
    float delta = fabsf(DMIN + (float)c * ((DMAX - DMIN) / 255.f));
    float win = expf(-t * delta) + 0.05f;
    af *= win; ab *= win;
    F[((size_t)c * 2 + 0) * L + j] = af;
    F[((size_t)c * 2 + 1) * L + j] = ab;
  }
}

constexpr int PREP_T0 = 672, PREP_T1 = PREP_T0 + 256, PREP_T2 = PREP_T1 + 8, PREP_T3 = PREP_T2 + 8, PREP_T4 = PREP_T3 + 8;
constexpr int PREP_WF = PREP_T4 + 512, PREP_N = PREP_WF + 1088;
DEV void ph_prep(const P& p, int layer, char* smem) {
  for (int u = bid_(); u < PREP_N; u += gridDim.x) {
    if (u < PREP_T0) transpose_unit(p.w_in + (size_t)layer * D * INW, p.W1t, D, INW, u, smem);
    else if (u < PREP_T1) transpose_unit(p.w_out + (size_t)layer * D * D, p.W2t, D, D, u - PREP_T0, smem);
    else if (u < PREP_T2) { int q = u - PREP_T1, d = q >> 2; transpose_unit(p.rw_w_up + ((size_t)layer * 2 + d) * 64 * 256, p.Wwt + d * 256 * 64, 64, 256, q & 3, smem); }
    else if (u < PREP_T3) { int q = u - PREP_T2, d = q >> 2; transpose_unit(p.rw_a_up + ((size_t)layer * 2 + d) * 64 * 256, p.Wat + d * 256 * 64, 64, 256, q & 3, smem); }
    else if (u < PREP_T4) transpose_unit(p.rw_g_up + (size_t)layer * 128 * 256, p.Wgt, 128, 256, u - PREP_T3, smem);
    else if (u < PREP_WF) wfold_unit(p, layer, u - PREP_T4, smem);
    else filt_unit(p, layer, u - PREP_WF, smem);
  }
}

DEV void ph_norm(const P& p, int layer, int which) {
  const int gw = (bid_() * 256 + tid_()) >> 6, nw = gridDim.x * 4, lane = tid_() & 63;
  const float* g = (which ? p.norm2_g : p.norm1_g) + layer * D;
  for (int row = gw; row < NTOK; row += nw) {
    int b = row / LT, pp = row % LT;
    int mr = pp < LC ? 16 : b;
    const float* mv = p.modv + ((size_t)layer * 17 + mr) * 6144 + (which ? 3072 : 0);
    const bf16_t* xr = p.X + (size_t)row * D;
    uint4 u0 = *(const uint4*)(xr + 8 * lane), u1 = *(const uint4*)(xr + 512 + 8 * lane);
    float v[16];
    unpack8(u0, v); unpack8(u1, v + 8);
    float ss = 0.f;
#pragma unroll
    for (int i = 0; i < 16; ++i) ss += v[i] * v[i];
    ss = wave_sum(ss);
    float rstd = rsqrtf(ss * (1.f / 1024.f) + 1e-6f);
    float o[16];
#pragma unroll
    for (int hh = 0; hh < 2; ++hh)
#pragma unroll
      for (int i = 0; i < 8; ++i) {
        int col = hh * 512 + 8 * lane + i;
        float y = v[hh * 8 + i] * rstd * g[col];
        o[hh * 8 + i] = y * (1.f + mv[1024 + col]) + mv[col];
      }
    bf16_t* hr = p.H + (size_t)row * D;
    *(uint4*)(hr + 8 * lane) = pack8(o);
    *(uint4*)(hr + 512 + 8 * lane) = pack8(o + 8);
  }
}

struct Epi1 {
  const P& p; int row0, col0;
  DEV void operator()(f32x4 (&acc)[4][4], int wr, int wc, int fr, int fq, char* smem) const {
    const int cw = col0 + wc * 64;
    const int rbase = row0 + wr * 64;
    const bool lat = (row0 % LT) >= LC;
    if (cw >= 1536 && cw < 1664) {
#pragma unroll
      for (int m = 0; m < 4; ++m)
#pragma unroll
        for (int n = 0; n < 4; ++n)
#pragma unroll
          for (int j = 0; j < 4; ++j) acc[m][n][j] = tanhf(acc[m][n][j]);
    } else if (cw >= 1792 && cw < 1920) {
#pragma unroll
      for (int m = 0; m < 4; ++m)
#pragma unroll
        for (int n = 0; n < 4; ++n)
#pragma unroll
          for (int j = 0; j < 4; ++j) acc[m][n][j] = sigmoidf_(acc[m][n][j]);
    } else if (cw >= 1920 && cw < 2560 && lat) {
#pragma unroll
      for (int m = 0; m < 4; ++m)
#pragma unroll
        for (int j = 0; j < 4; ++j) {
          int row = rbase + m * 16 + fq * 4 + j;
          int pl = (row % LT) - LC;
          int ri = pl >> 6, ci = pl & 63;
          float2 cr = *(const float2*)(p.rope + 2 * (ri * 16 + fr));
          float2 cc = *(const float2*)(p.rope + 2 * (ci * 16 + fr));
          float x1 = acc[m][0][j], x2 = acc[m][1][j];
          acc[m][0][j] = x1 * cr.x - x2 * cr.y; acc[m][1][j] = x2 * cr.x + x1 * cr.y;
          x1 = acc[m][2][j]; x2 = acc[m][3][j];
          acc[m][2][j] = x1 * cc.x - x2 * cc.y; acc[m][3][j] = x2 * cc.x + x1 * cc.y;
        }
    }
    const int wid = wr * 2 + wc, lane = fq * 16 + fr;
    stage_tile_bf16(acc, smem, wid, fr, fq);
    const bf16_t (*t)[72] = (const bf16_t (*)[72])(smem + wid * 9216);
#pragma unroll
    for (int i = 0; i < 8; ++i) {
      const int rl = i * 8 + (lane >> 3), ch = lane & 7;
      *(uint4*)(p.Z + (size_t)(rbase + rl) * INW + cw + ch * 8) = *(const uint4*)&t[rl][ch * 8];
    }
  }
};
DEV void ph_gemm1(const P& p, char* smem) {
  const int nct = INW / 128;
  for (int u = bid_(); u < (NTOK / 128) * nct; u += gridDim.x) {
    int rt = u / nct, ct = u % nct;
    Epi1 epi{p, rt * 128, ct * 128};
    gemm_tile(p.H + (size_t)rt * 128 * D, D, p.W1t + (size_t)ct * 128 * D, D, D, smem, epi);
  }
}

struct EpiLora {
  const P& p; int layer, q, row0, col0;
  DEV void operator()(f32x4 (&acc)[4][4], int wr, int wc, int fr, int fq, char*) const {
#pragma unroll
    for (int m = 0; m < 4; ++m)
#pragma unroll
      for (int n = 0; n < 4; ++n)
#pragma unroll
        for (int j = 0; j < 4; ++j) {
          int row = row0 + wr * 64 + m * 16 + fq * 4 + j;
          int col = col0 + wc * 64 + n * 16 + fr;
          float v = acc[m][n][j];
          if (q < 2) {
            v = 0.6065306597126334f * sigmoidf_(v + p.rw_w0[(layer * 2 + q) * 256 + col]);
            p.SC[(size_t)row * 1024 + col * 4 + q] = f2bf(v);
          } else if (q < 4) {
            v = sigmoidf_(v + p.rw_a0[(layer * 2 + (q - 2)) * 256 + col]);
            p.SC[(size_t)row * 1024 + col * 4 + q] = f2bf(v);
          } else {
            p.Y[(size_t)row * D + 256 + col] = f2bf(v);
          }
        }
  }
};
DEV void lora_unit(const P& p, int layer, int unit, char* smem) {
  const int q = unit / 1088, r = unit % 1088, rt = r >> 1, ct = r & 1;
  EpiLora epi{p, layer, q, rt * 128, ct * 128};
  const bf16_t* A; const bf16_t* Bt; int K;
  if (q < 2) { A = p.Z + 1536 + 64 * q; Bt = p.Wwt + q * 256 * 64; K = 64; }
  else if (q < 4) { A = p.Z + 1664 + 64 * (q - 2); Bt = p.Wat + (q - 2) * 256 * 64; K = 64; }
  else { A = p.Z + 1792; Bt = p.Wgt; K = 128; }
  gemm_tile(A + (size_t)rt * 128 * INW, INW, Bt + (size_t)ct * 128 * K, K, K, smem, epi);
}

DEV void ph_rwkv_prep(const P& p, int layer) {
  const int gw = (bid_() * 256 + tid_()) >> 6, nw = gridDim.x * 4, lane = tid_() & 63;
  const float* cw = p.conv_w + (size_t)layer * 3 * 1536;
  const float* cb = p.conv_b + (size_t)layer * 1536;
  for (int row = gw; row < NTOK; row += nw) {
    int pp = row % LT;
    bool hasm = (pp != 0) && (pp != LC);
    bool hasp = (pp != LC - 1) && (pp != LT - 1);
    float res[3][4];
#pragma unroll
    for (int a = 0; a < 3; ++a) {
      int col = 768 + a * 256 + 4 * lane;
      const bf16_t* zc = p.Z + (size_t)row * INW + col;
      uint2 um = hasm ? *(const uint2*)(zc - INW) : make_uint2(0, 0);
      uint2 uc = *(const uint2*)zc;
      uint2 up = hasp ? *(const uint2*)(zc + INW) : make_uint2(0, 0);
      float vm[4] = {bflo(um.x), bfhi(um.x), bflo(um.y), bfhi(um.y)};
      float vc[4] = {bflo(uc.x), bfhi(uc.x), bflo(uc.y), bfhi(uc.y)};
      float vp[4] = {bflo(up.x), bfhi(up.x), bflo(up.y), bfhi(up.y)};
#pragma unroll
      for (int i = 0; i < 4; ++i) res[a][i] = cw[col + i] * vm[i] + cw[1536 + col + i] * vc[i] + cw[3072 + col + i] * vp[i] + cb[col + i];
    }
    float kk[4], ss = 0.f;
#pragma unroll
    for (int i = 0; i < 4; ++i) { kk[i] = res[1][i] * p.rw_k_k[layer * 256 + 4 * lane + i]; ss += kk[i] * kk[i]; }
    ss = row16_sum(ss);
    float rs = rsqrtf(ss + 1e-12f);
    bf16_t* hr = p.H + (size_t)row * D + 16 * lane;
    *(uint4*)hr = make_uint4(pack2(res[0][0], res[1][0]), pack2(kk[0] * rs, res[2][0]), pack2(res[0][1], res[1][1]), pack2(kk[1] * rs, res[2][1]));
    *(uint4*)(hr + 8) = make_uint4(pack2(res[0][2], res[1][2]), pack2(kk[2] * rs, res[2][2]), pack2(res[0][3], res[1][3]), pack2(kk[3] * rs, res[2][3]));
  }
}

struct ScanRaw { uint2 h, s; };
struct ScanRegs { f32x2 A[4], W[4], B[4], K[4], R[4]; float v; };
DEV float oct_sum(float x) { x += dpp0<0xB1, 0xF>(x); x += dpp0<0x4E, 0xF>(x); x += dpp0<0x141, 0xF>(x); return x; }
DEV void scan_unit(const P& p, int layer, int unit, char* smem) {
  const int half = unit & 1, dir = (unit >> 1) & 1, h = (unit >> 2) & 3, b = unit >> 4;
  const int tid = tid_(), wid = tid >> 6, lane = tid & 63;
  const int k8 = lane & 7, vrow = half * 32 + wid * 8 + (lane >> 3);
  float* st = (float*)smem + wid * 768;
  const float ka = p.rw_k_a[layer * 256 + h * 64 + lane];
  f32x2 S[4];
#pragma unroll
  for (int i = 0; i < 4; ++i) S[i] = (f32x2){0.f, 0.f};
  const size_t rowbase = (size_t)b * LT;
  const bf16_t* hb = p.H + rowbase * 1024 + (h * 64 + lane) * 4;
  const bf16_t* sb = p.SC + rowbase * 1024 + (h * 64 + lane) * 4;
  bf16_t* yb = p.Z + rowbase * INW + 768 + dir * 256 + h * 64 + vrow;
  auto posf = [&](int t) -> int { return dir == 0 ? t : (t < LC ? LC - 1 - t : LT - 1 - (t - LC)); };
  auto load4 = [&](int c, ScanRaw (&dst)[4]) {
#pragma unroll
    for (int i = 0; i < 4; ++i) {
      size_t off = (size_t)posf(c * 4 + i) * 1024;
      dst[i].h = *(const uint2*)(hb + off); dst[i].s = *(const uint2*)(sb + off);
    }
  };
  auto stage = [&](const ScanRaw& x, int buf) {
    float rr = bflo(x.h.x), kr = bfhi(x.h.x), kkv = bflo(x.h.y), vv = bfhi(x.h.y);
    float ev = dir ? bfhi(x.s.x) : bflo(x.s.x), av = dir ? bfhi(x.s.y) : bflo(x.s.y);
    float w = __expf(-ev), ap = -kkv, bp = kkv * av, kd = kr * (1.f + (av - 1.f) * ka);
    float* q = st + buf * 384;
    q[lane] = ap; q[64 + lane] = w; q[128 + lane] = bp; q[192 + lane] = kd; q[256 + lane] = rr; q[320 + lane] = vv;
  };
  auto rd = [&](int buf, ScanRegs& g) {
    const float* q = st + buf * 384 + 8 * k8;
    float4 t0, t1;
    t0 = *(const float4*)q; t1 = *(const float4*)(q + 4);
    g.A[0] = (f32x2){t0.x, t0.y}; g.A[1] = (f32x2){t0.z, t0.w}; g.A[2] = (f32x2){t1.x, t1.y}; g.A[3] = (f32x2){t1.z, t1.w};
    t0 = *(const float4*)(q + 64); t1 = *(const float4*)(q + 68);
    g.W[0] = (f32x2){t0.x, t0.y}; g.W[1] = (f32x2){t0.z, t0.w}; g.W[2] = (f32x2){t1.x, t1.y}; g.W[3] = (f32x2){t1.z, t1.w};
    t0 = *(const float4*)(q + 128); t1 = *(const float4*)(q + 132);
    g.B[0] = (f32x2){t0.x, t0.y}; g.B[1] = (f32x2){t0.z, t0.w}; g.B[2] = (f32x2){t1.x, t1.y}; g.B[3] = (f32x2){t1.z, t1.w};
    t0 = *(const float4*)(q + 192); t1 = *(const float4*)(q + 196);
    g.K[0] = (f32x2){t0.x, t0.y}; g.K[1] = (f32x2){t0.z, t0.w}; g.K[2] = (f32x2){t1.x, t1.y}; g.K[3] = (f32x2){t1.z, t1.w};
    t0 = *(const float4*)(q + 256); t1 = *(const float4*)(q + 260);
    g.R[0] = (f32x2){t0.x, t0.y}; g.R[1] = (f32x2){t0.z, t0.w}; g.R[2] = (f32x2){t1.x, t1.y}; g.R[3] = (f32x2){t1.z, t1.w};
    g.v = st[buf * 384 + 320 + vrow];
  };
  auto compute = [&](const ScanRegs& g, int t) {
    f32x2 s2 = S[0] * g.A[0];
    s2 += S[1] * g.A[1]; s2 += S[2] * g.A[2]; s2 += S[3] * g.A[3];
    const float sa = oct_sum(s2[0] + s2[1]);
    const f32x2 sa2 = (f32x2){sa, sa}, vv2 = (f32x2){g.v, g.v};
#pragma unroll
    for (int i = 0; i < 4; ++i) S[i] = S[i] * g.W[i] + (sa2 * g.B[i] + vv2 * g.K[i]);
    f32x2 y2 = S[0] * g.R[0];
    y2 += S[1] * g.R[1]; y2 += S[2] * g.R[2]; y2 += S[3] * g.R[3];
    const float y = oct_sum(y2[0] + y2[1]);
    if (k8 == 0) yb[(size_t)posf(t) * INW] = f2bf(y);
  };
  constexpr int NC = LT / 4;
  ScanRaw R0[4], R1[4], R2[4], R3[4];
  ScanRegs g0, g1;
  auto chunk = [&](ScanRaw (&Rc)[4], ScanRaw (&Rn)[4], int t0, bool hasnext) {
    stage(Rc[1], 1); rd(1, g1); compute(g0, t0);
    stage(Rc[2], 0); rd(0, g0); compute(g1, t0 + 1);
    stage(Rc[3], 1); rd(1, g1); compute(g0, t0 + 2);
    if (hasnext) { stage(Rn[0], 0); rd(0, g0); }
    compute(g1, t0 + 3);
  };
  __builtin_amdgcn_s_setprio(3);
  load4(0, R0); load4(1, R1); load4(2, R2);
  stage(R0[0], 0);
  rd(0, g0);
#pragma unroll 1
  for (int c = 0; c < NC; c += 4) {
    load4(c + 3, R3);
    chunk(R0, R1, c * 4, true);
    const bool more = (c + 4 < NC);
    if (more) load4(c + 4, R0);
    chunk(R1, R2, c * 4 + 4, true);
    if (more) load4(c + 5, R1);
    chunk(R2, R3, c * 4 + 8, true);
    if (more) load4(c + 6, R2);
    chunk(R3, R0, c * 4 + 12, more);
  }
  __builtin_amdgcn_s_setprio(0);
}

DEV bf16x8 frag_join(uint2 lo, uint2 hi) { uint4 w = make_uint4(lo.x, lo.y, hi.x, hi.y); return __builtin_bit_cast(bf16x8, w); }
DEV void scanc_unit(const P& p, int layer, int unit, char* smem) {
  const int dir = unit & 1, h = (unit >> 1) & 3, b = unit >> 3;
  const int tid = tid_(), w = tid >> 6, lane = tid & 63, fr = lane & 15, fq = lane >> 4;
  bf16_t (*At)[72] = (bf16_t (*)[72])(smem);
  bf16_t (*Rt)[72] = (bf16_t (*)[72])(smem + 2304);
  bf16_t (*Bt)[72] = (bf16_t (*)[72])(smem + 4608);
  bf16_t (*Kt)[72] = (bf16_t (*)[72])(smem + 6912);
  bf16_t (*BKT)[40] = (bf16_t (*)[40])(smem + 9216);
  bf16_t (*VV)[16] = (bf16_t (*)[16])(smem + 14336);
  float* G16 = (float*)(smem + 16384);
  bf16_t* IMG0 = (bf16_t*)(smem + 16640);
  bf16_t* IMG1 = (bf16_t*)(smem + 20864);
  bf16_t* IMG2 = (bf16_t*)(smem + 21888);
  bf16_t* TT = (bf16_t*)(smem + 17792);
  bf16_t* ARK = (bf16_t*)(smem + 18816);
  bf16_t* AAK = (bf16_t*)(smem + 19840);
  __syncthreads();
  for (int i = tid; i < 1568; i += 256) ((unsigned*)IMG0)[i] = 0u;
  const float ka = p.rw_k_a[layer * 256 + h * 64 + lane];
  const size_t rowbase = (size_t)b * LT;
  const bf16_t* hb = p.H + rowbase * 1024 + (h * 64 + lane) * 4;
  const bf16_t* sb = p.SC + rowbase * 1024 + (h * 64 + lane) * 4;
  bf16_t* yb = p.Z + rowbase * INW + 768 + dir * 256 + h * 64 + w * 16 + fr;
  auto posf = [&](int t) -> int { return dir == 0 ? t : (t < LC ? LC - 1 - t : LT - 1 - (t - LC)); };
  uint2 sc[16], hr[4];
  auto load_raw = [&](int c) {
#pragma unroll
    for (int i = 0; i < 16; ++i) sc[i] = *(const uint2*)(sb + (size_t)posf(c * 16 + i) * 1024);
#pragma unroll
    for (int q = 0; q < 4; ++q) hr[q] = *(const uint2*)(hb + (size_t)posf(c * 16 + w * 4 + q) * 1024);
  };
  f32x4 acc[4];
#pragma unroll
  for (int kt = 0; kt < 4; ++kt) acc[kt] = (f32x4){0.f, 0.f, 0.f, 0.f};
  load_raw(0);
#pragma unroll 1
  for (int c = 0; c < LT / 16; ++c) {
    {
      float Erun = 0.f;
#pragma unroll
      for (int i = 0; i < 16; ++i) {
        const float ev = dir ? bfhi(sc[i].x) : bflo(sc[i].x);
        const float Eprev = Erun;
        Erun += ev;
        if ((i >> 2) == w) {
          const uint2 hrec = hr[i & 3];
          const float rr = bflo(hrec.x), kr = bfhi(hrec.x), kkv = bflo(hrec.y);
          const float av = dir ? bfhi(sc[i].y) : bflo(sc[i].y);
          const float gp = __expf(-Eprev), gi = __expf(-Erun), ig = __expf(Erun);
          const float at = -kkv * gp, rt = rr * gi, bt = kkv * av * ig, kt2 = kr * (1.f + (av - 1.f) * ka) * ig;
          const unsigned ar = pack2(at, rt), bk = pack2(bt, kt2);
          At[i][lane] = (bf16_t)(ar & 0xFFFFu); Rt[i][lane] = (bf16_t)(ar >> 16);
          Bt[i][lane] = (bf16_t)(bk & 0xFFFFu); Kt[i][lane] = (bf16_t)(bk >> 16);
          BKT[lane][(i >> 2) * 8 + (i & 3)] = (bf16_t)(bk & 0xFFFFu);
          BKT[lane][(i >> 2) * 8 + 4 + (i & 3)] = (bf16_t)(bk >> 16);
          VV[lane][(i >> 2) * 4 + (i & 3)] = (bf16_t)(hrec.y >> 16);
          if (i == 15) G16[lane] = gi;
        }
      }
    }
    if (c + 1 < LT / 16) load_raw(c + 1);
    __syncthreads();
    {
      const bf16_t (*X)[72] = (w < 2) ? At : Rt;
      const bf16_t (*Y)[72] = (w & 1) ? Kt : Bt;
      f32x4 cm = (f32x4){0.f, 0.f, 0.f, 0.f};
#pragma unroll
      for (int s = 0; s < 2; ++s) {
        bf16x8 af = *(const bf16x8*)&X[fr][32 * s + 8 * fq];
        bf16x8 bm = *(const bf16x8*)&Y[fr][32 * s + 8 * fq];
        cm = mfma16(af, bm, cm);
      }
#pragma unroll
      for (int jj = 0; jj < 4; ++jj) {
        const int i = 4 * fq + jj;
        const bool keep = (w < 2) ? (fr < i) : (fr <= i);
        cm[jj] = keep ? cm[jj] : 0.f;
      }
      const int io = (fr >> 2) * 8 + (fr & 3);
      auto wr_img = [&](bf16_t* img, const f32x4& Xv, int hi) {
#pragma unroll
        for (int jj = 0; jj < 4; ++jj) img[(4 * fq + jj) * 32 + io + hi] = f2bf(Xv[jj]);
      };
      if (w == 1) wr_img(AAK, cm, 0);
      else if (w == 2) wr_img(ARK, cm, 0);
      else if (w == 3) wr_img(ARK, cm, 4);
      else {
        auto bfrag = [&](const f32x4& Xv) { return frag_join(make_uint2(pack2(Xv[0], Xv[1]), pack2(Xv[2], Xv[3])), make_uint2(0u, 0u)); };
        auto afr = [&](const bf16_t* img) { return *(const bf16x8*)&img[(fr * 4 + fq) * 8]; };
        const f32x4 Z4 = (f32x4){0.f, 0.f, 0.f, 0.f};
        wr_img(IMG0, cm, 0);
        asm volatile("" ::: "memory");
        f32x4 A2 = mfma16(afr(IMG0), bfrag(cm), Z4);
        wr_img(IMG1, A2, 0);
        asm volatile("" ::: "memory");
        f32x4 A4 = mfma16(afr(IMG1), bfrag(A2), Z4);
        wr_img(IMG2, A4, 0);
        asm volatile("" ::: "memory");
        f32x4 Rm = mfma16(afr(IMG2), bfrag(A4), Z4);
#pragma unroll
        for (int jj = 0; jj < 4; ++jj) Rm[jj] += (fr == 4 * fq + jj) ? 1.f : 0.f;
        Rm = mfma16(afr(IMG2), bfrag(Rm), Rm);
        Rm = mfma16(afr(IMG1), bfrag(Rm), Rm);
        Rm = mfma16(afr(IMG0), bfrag(Rm), Rm);
        wr_img(TT, Rm, 0);
      }
    }
    __syncthreads();
    {
      bf16x8 Sb[2];
#pragma unroll
      for (int s = 0; s < 2; ++s) {
        uint4 t = make_uint4(pack2(acc[2 * s][0], acc[2 * s][1]), pack2(acc[2 * s][2], acc[2 * s][3]),
                             pack2(acc[2 * s + 1][0], acc[2 * s + 1][1]), pack2(acc[2 * s + 1][2], acc[2 * s + 1][3]));
        Sb[s] = __builtin_bit_cast(bf16x8, t);
      }
      const uint2 vv = *(const uint2*)&VV[w * 16 + fr][fq * 4];
      const bf16x8 Vlow = frag_join(vv, make_uint2(0u, 0u));
      f32x4 P = (f32x4){0.f, 0.f, 0.f, 0.f};
#pragma unroll
      for (int s = 0; s < 2; ++s) {
        bf16x8 af = frag_join(*(const uint2*)&At[fr][32 * s + 4 * fq], *(const uint2*)&At[fr][32 * s + 16 + 4 * fq]);
        P = mfma16(af, Sb[s], P);
      }
      P = mfma16(*(const bf16x8*)&AAK[(fr * 4 + fq) * 8], Vlow, P);
      const bf16x8 Pb = frag_join(make_uint2(pack2(P[0], P[1]), pack2(P[2], P[3])), make_uint2(0u, 0u));
      f32x4 U = mfma16(*(const bf16x8*)&TT[(fr * 4 + fq) * 8], Pb, (f32x4){0.f, 0.f, 0.f, 0.f});
      const bf16x8 UV = frag_join(make_uint2(pack2(U[0], U[1]), pack2(U[2], U[3])), vv);
      f32x4 Yv = (f32x4){0.f, 0.f, 0.f, 0.f};
#pragma unroll
      for (int s = 0; s < 2; ++s) {
        bf16x8 af = frag_join(*(const uint2*)&Rt[fr][32 * s + 4 * fq], *(const uint2*)&Rt[fr][32 * s + 16 + 4 * fq]);
        Yv = mfma16(af, Sb[s], Yv);
      }
      Yv = mfma16(*(const bf16x8*)&ARK[(fr * 4 + fq) * 8], UV, Yv);
#pragma unroll
      for (int jj = 0; jj < 4; ++jj) yb[(size_t)posf(c * 16 + 4 * fq + jj) * INW] = f2bf(Yv[jj]);
#pragma unroll
      for (int kt = 0; kt < 4; ++kt) {
        f32x4 t = mfma16(*(const bf16x8*)&BKT[16 * kt + fr][fq * 8], UV, acc[kt]);
        const float4 g4 = *(const float4*)&G16[16 * kt + 4 * fq];
        t[0] *= g4.x; t[1] *= g4.y; t[2] *= g4.z; t[3] *= g4.w;
        acc[kt] = t;
      }
    }
    __syncthreads();
  }
}

DEV void ph_rwkv_post(const P& p, int layer) {
  const int gw = (bid_() * 256 + tid_()) >> 6, nw = gridDim.x * 4, lane = tid_() & 63;
  for (int row = gw; row < NTOK; row += nw) {
    const int ch = 4 * lane;
    const bf16_t* zr = p.Z + (size_t)row * INW + 768 + ch;
    uint2 y0u = *(const uint2*)zr, y1u = *(const uint2*)(zr + 256);
    float y[4] = {bflo(y0u.x) + bflo(y1u.x), bfhi(y0u.x) + bfhi(y1u.x), bflo(y0u.y) + bflo(y1u.y), bfhi(y0u.y) + bfhi(y1u.y)};
    float mu = row16_sum(y[0] + y[1] + y[2] + y[3]) * (1.f / 64.f);
    float vs = 0.f;
#pragma unroll
    for (int i = 0; i < 4; ++i) { y[i] -= mu; vs += y[i] * y[i]; }
    float var = row16_sum(vs) * (1.f / 64.f);
    float rstd = rsqrtf(var + 64e-5f);
    const bf16_t* hr = p.H + (size_t)row * D + 4 * ch;
    uint4 h0 = *(const uint4*)hr, h1 = *(const uint4*)(hr + 8);
    const bf16_t* sr = p.SC + (size_t)row * 1024 + 4 * ch;
    uint4 s0 = *(const uint4*)sr, s1 = *(const uint4*)(sr + 8);
    float r[4] = {bflo(h0.x), bflo(h0.z), bflo(h1.x), bflo(h1.z)};
    float k[4] = {bfhi(h0.x), bfhi(h0.z), bfhi(h1.x), bfhi(h1.z)};
    float v[4] = {bfhi(h0.y), bfhi(h0.w), bfhi(h1.y), bfhi(h1.w)};
    float a0[4] = {bflo(s0.y), bflo(s0.w), bflo(s1.y), bflo(s1.w)};
    float a1[4] = {bfhi(s0.y), bfhi(s0.w), bfhi(s1.y), bfhi(s1.w)};
    float sd = 0.f;
#pragma unroll
    for (int i = 0; i < 4; ++i) {
      float kav = p.rw_k_a[layer * 256 + ch + i], rk = p.rw_r_k[layer * 256 + ch + i];
      float kd0 = k[i] * (1.f + (a0[i] - 1.f) * kav), kd1 = k[i] * (1.f + (a1[i] - 1.f) * kav);
      sd += r[i] * (kd0 + kd1) * rk;
    }
    sd = row16_sum(sd);
    bf16_t* yr = p.Y + (size_t)row * D + 256 + ch;
    uint2 gu = *(const uint2*)yr;
    float g[4] = {bflo(gu.x), bfhi(gu.x), bflo(gu.y), bfhi(gu.y)};
    float o[4];
#pragma unroll
    for (int i = 0; i < 4; ++i) {
      float yn = y[i] * rstd * p.rw_ln_w[layer * 256 + ch + i] + p.rw_ln_b[layer * 256 + ch + i];
      o[i] = (yn + sd * v[i]) * g[i];
#if !EN_RW
      o[i] = 0.f;
#endif
    }
    *(uint2*)yr = make_uint2(pack2(o[0], o[1]), pack2(o[2], o[3]));
  }
}

DEV void hyena_pre_unit(const P& p, int layer, int unit) {
  int kind, b, t0, L;
  if (unit < 1024) { kind = 0; b = unit >> 6; t0 = (unit & 63) * 64; L = T; } else { int u = unit - 1024; kind = 1; b = u >> 2; t0 = (u & 3) * 64; L = LC; }
  const int c = tid_();
  const size_t row0 = (size_t)b * LT + (kind ? 0 : LC);
  const float* cw = p.conv_w + (size_t)layer * 3 * 1536;
  const float* cb = p.conv_b + (size_t)layer * 1536;
  const float w1a = cw[256 + c], w1b = cw[1536 + 256 + c], w1c = cw[3072 + 256 + c], b1 = cb[256 + c];
  const float w2a = cw[512 + c], w2b = cw[1536 + 512 + c], w2c = cw[3072 + 512 + c], b2 = cb[512 + c];
  auto ld = [&](int t, int col) -> float { return (t >= 0 && t < L) ? bf2f(p.Z[(row0 + t) * INW + col]) : 0.f; };
  float x1m = ld(t0 - 1, 256 + c), x1c = ld(t0, 256 + c), vm = ld(t0 - 1, 512 + c), vc = ld(t0, 512 + c);
  bf16_t* dst = (kind ? opq(p.UTc) : opq(p.UTl)) + ((size_t)c * 16 + b) * L + t0;
#pragma unroll 1
  for (int i8 = 0; i8 < 8; ++i8) {
    float uo[8];
#pragma unroll
    for (int i = 0; i < 8; ++i) {
      int t = t0 + i8 * 8 + i;
      float x1n = ld(t + 1, 256 + c), vn = ld(t + 1, 512 + c);
      float a = w1a * x1m + w1b * x1c + w1c * x1n + b1;
      float bb = w2a * vm + w2b * vc + w2c * vn + b2;
      uo[i] = a * bb;
      x1m = x1c; x1c = x1n; vm = vc; vc = vn;
    }
    *(uint4*)(dst + 8 * i8) = pack8(uo);
  }
}

DEV void hyena_conv_unit(const P& p, int layer, int unit, char* smem) {
  int kind, c, tb, L;
  if (unit < 4096) { kind = 0; c = unit >> 4; tb = (unit & 15) * 256; L = T; } else { kind = 1; c = unit - 4096; tb = 0; L = LC; }
  const int tid = tid_(), lane = tid & 63, wid = tid >> 6, fr = lane & 15, fq = lane >> 4;
  float* red = (float*)(smem + 2 * 16512);
  const float* F = (kind ? opq(p.FC) : opq(p.FL)) + (size_t)c * 2 * L;
  float scale;
  {
    float part = 0.f;
    for (int i = tid; i < 2 * L; i += 256) { float fv = F[i]; part += (i != L) ? fv * fv : 0.f; }
    part = wave_sum(part);
    __syncthreads();
    if (lane == 0) red[wid] = part;
    __syncthreads();
    scale = rsqrtf(((red[0] + red[1]) + (red[2] + red[3])) + 1e-6f);
  }
  const bf16_t* U = (kind ? opq(p.UTc) : opq(p.UTl)) + (size_t)c * 16 * L;
  f32x4 acc[4];
#pragma unroll
  for (int m = 0; m < 4; ++m) acc[m] = (f32x4){0.f, 0.f, 0.f, 0.f};
  const int nch = L / 256;
  float fw0, fw1, fw2;
  uint4 ru0, ru1;
  auto ldchunk = [&](int ch) {
    const int sc = ch * 256;
    const int D0 = tb + 256 - sc;
    auto tap = [&](int n) -> float {
      int d = D0 - n;
      float v = 0.f;
      if (d > -L && d < L) v = (d >= 0 ? F[d] : F[L - d]);
      return v;
    };
    fw0 = tap(tid); fw1 = tap(tid + 256); fw2 = (tid < 8) ? tap(tid + 512) : 0.f;
    const int bb = tid >> 4, sg0 = tid & 15;
    ru0 = *(const uint4*)(U + (size_t)bb * L + sc + 8 * sg0);
    ru1 = *(const uint4*)(U + (size_t)bb * L + sc + 8 * (sg0 + 16));
  };
  auto stchunk = [&](int buf) {
    bf16_t* Cq = (bf16_t*)(smem + buf * 16512);
    bf16_t* Us = (bf16_t*)(smem + buf * 16512 + 8320);
    const bf16_t h0 = f2bf(fw0 * scale), h1 = f2bf(fw1 * scale), h2 = f2bf(fw2 * scale);
#pragma unroll
    for (int rho = 0; rho < 8; ++rho) {
      int m = tid + rho;
      Cq[((m >> 3) * 8 + rho) * 8 + (m & 7)] = h0;
      m = tid + 256 + rho;
      if (m < 520) Cq[((m >> 3) * 8 + rho) * 8 + (m & 7)] = h1;
      m = tid + 512 + rho;
      if (tid < 8 && m < 520) Cq[((m >> 3) * 8 + rho) * 8 + (m & 7)] = h2;
    }
    if (tid < 8) {
#pragma unroll
      for (int rho = 1; rho < 8; ++rho) if (tid < rho) Cq[(rho) * 8 + tid] = 0;
    }
    const int bb = tid >> 4, sg0 = tid & 15;
    *(uint4*)&Us[(sg0 * 16 + bb) * 8] = ru0;
    *(uint4*)&Us[((sg0 + 16) * 16 + bb) * 8] = ru1;
  };
  ldchunk(0);
#pragma unroll 1
  for (int ch = 0; ch < nch; ++ch) {
    const int buf = ch & 1;
    stchunk(buf);
    __syncthreads();
    if (ch + 1 < nch) ldchunk(ch + 1);
    const bf16_t* Cq = (const bf16_t*)(smem + buf * 16512);
    const bf16_t* Us = (const bf16_t*)(smem + buf * 16512 + 8320);
#pragma unroll
    for (int kk = 0; kk < 8; ++kk) {
      bf16x8 bf = *(const bf16x8*)&Us[((4 * kk + fq) * 16 + fr) * 8];
#pragma unroll
      for (int m = 0; m < 4; ++m) {
        int it = wid * 4 + m;
        int base = 256 - 16 * it + 32 * kk + 8 * fq;
        int m0 = base - 8 * (fr >> 3);
        bf16x8 af = *(const bf16x8*)&Cq[((m0 >> 3) * 8 + (fr & 7)) * 8];
        acc[m] = mfma16(af, bf, acc[m]);
      }
    }
  }
  __syncthreads();
  bf16_t* Yt = (kind ? opq(p.YTc) : opq(p.YTl)) + ((size_t)c * 16 + fr) * L + tb;
#pragma unroll
  for (int m = 0; m < 4; ++m) {
    int t = (wid * 4 + m) * 16 + fq * 4;
    *(uint2*)(Yt + t) = make_uint2(pack2(acc[m][0], acc[m][1]), pack2(acc[m][2], acc[m][3]));
  }
}

DEV void hyena_post_unit(const P& p, int layer, int unit, char* smem) {
  int kind, b, t0, L;
  if (unit < 1024) { kind = 0; b = unit >> 6; t0 = (unit & 63) * 64; L = T; } else { int u = unit - 1024; kind = 1; b = u >> 2; t0 = (u & 3) * 64; L = LC; }
  const int c = tid_(), lane = c & 63, wid = c >> 6;
  const size_t row0 = (size_t)b * LT + (kind ? 0 : LC);
  bf16_t (*tile)[264] = (bf16_t (*)[264])smem;
  const float* cw = p.conv_w + (size_t)layer * 3 * 1536;
  const float wa = cw[c], wb = cw[1536 + c], wcc = cw[3072 + c], b0 = p.conv_b[layer * 1536 + c];
  const float bias = p.hy_bias[layer * 256 + c];
  const bf16_t* yt = (kind ? opq(p.YTc) : opq(p.YTl)) + ((size_t)c * 16 + b) * L + t0;
  const bf16_t* ut = (kind ? opq(p.UTc) : opq(p.UTl)) + ((size_t)c * 16 + b) * L + t0;
  auto ld = [&](int t) -> float { return (t >= 0 && t < L) ? bf2f(p.Z[(row0 + t) * INW + c]) : 0.f; };
  float xm = ld(t0 - 1), xc = ld(t0);
  __syncthreads();
#pragma unroll 1
  for (int i8 = 0; i8 < 8; ++i8) {
    uint4 yu = *(const uint4*)(yt + 8 * i8), uu = *(const uint4*)(ut + 8 * i8);
    float yv[8], uv[8];
    unpack8(yu, yv); unpack8(uu, uv);
#pragma unroll
    for (int i = 0; i < 8; ++i) {
      int t = t0 + i8 * 8 + i;
      float xn = ld(t + 1);
      float x0 = wa * xm + wb * xc + wcc * xn + b0;
      float o = x0 * (yv[i] + uv[i] * bias);
      tile[i8 * 8 + i][c] = f2bf(o);
      xm = xc; xc = xn;
    }
  }
  __syncthreads();
  for (int i = 0; i < 16; ++i) {
    int tl = wid * 16 + i;
    uint2 ou = *(const uint2*)&tile[tl][4 * lane];
    float o[4] = {bflo(ou.x), bfhi(ou.x), bflo(ou.y), bfhi(ou.y)};
    float ss = wave_sum(o[0] * o[0] + o[1] * o[1] + o[2] * o[2] + o[3] * o[3]);
    float rstd = rsqrtf(ss * (1.f / 256.f) + 1e-6f);
#pragma unroll
    for (int q = 0; q < 4; ++q) {
      o[q] = o[q] * rstd * p.hy_out_g[layer * 256 + 4 * lane + q];
#if !EN_HY
      o[q] = 0.f;
#endif
    }
    *(uint2*)(p.Y + (row0 + t0 + tl) * D + 4 * lane) = make_uint2(pack2(o[0], o[1]), pack2(o[2], o[3]));
  }
}

DEV void attn_unit(const P& p, int layer, int unit, char* smem) {
  const bool isctx = unit >= 4096;
  int b, qb, hq;
  if (!isctx) { b = unit >> 8; qb = (unit >> 3) & 31; hq = unit & 7; } else { int u = unit - 4096; b = u >> 4; qb = (u >> 3) & 1; hq = u & 7; }
  const int g = hq >> 2;
  const int tid = tid_(), lane = tid & 63, wid = tid >> 6, qn = lane & 31, hh = lane >> 5;
  const int qpos = qb * 128 + wid * 32 + qn;
  const size_t qrow = (size_t)b * LT + (isctx ? qpos : LC + qpos);
  const bf16_t* qptr = p.Z + qrow * INW + 1920 + hq * 64;
  bf16x8 qf[4];
#pragma unroll
  for (int s = 0; s < 4; ++s) qf[s] = *(const bf16x8*)(qptr + 16 * s + 8 * hh);
  const float sink = p.attn_sink[layer * 8 + hq];
  float m_run = sink, l_run = 1.f;
  f32x16 o0, o1;
#pragma unroll
  for (int i = 0; i < 16; ++i) { o0[i] = 0.f; o1[i] = 0.f; }
  typedef bf16_t KTile[64][72];
  KTile* Ks = (KTile*)smem;
  KTile* Vt = (KTile*)(smem + 18432);
  const int ntl = isctx ? 0 : 6;
  const int ntiles = ntl + 4;
  const int skey = tid >> 3, sseg = tid & 7;
  const bf16_t* kvbase = p.Z + (size_t)b * LT * INW + 1920 + 512 + g * 64 + sseg * 8;
  uint4 rk0, rk1, rv0, rv1;
  auto ldtile = [&](int kt) {
    const bool ctxk = kt >= ntl;
    const int kbase = ctxk ? (kt - ntl) * 64 : qb * 128 - 128 + kt * 64;
    const int kp0 = kbase + skey, kp1 = kp0 + 32;
    rk0 = rk1 = rv0 = rv1 = make_uint4(0, 0, 0, 0);
    if (ctxk || (kp0 >= 0 && kp0 < T)) { const bf16_t* src = kvbase + (size_t)(ctxk ? kp0 : LC + kp0) * INW; rk0 = *(const uint4*)src; rv0 = *(const uint4*)(src + 128); }
    if (ctxk || (kp1 >= 0 && kp1 < T)) { const bf16_t* src = kvbase + (size_t)(ctxk ? kp1 : LC + kp1) * INW; rk1 = *(const uint4*)src; rv1 = *(const uint4*)(src + 128); }
  };
  auto sttile = [&](int buf) {
    *(uint4*)&Ks[buf][skey][sseg * 8] = rk0;
    *(uint4*)&Ks[buf][skey + 32][sseg * 8] = rk1;
    bf16_t (*vt)[72] = Vt[buf];
    vt[sseg * 8 + 0][skey] = (bf16_t)(rv0.x & 0xFFFF); vt[sseg * 8 + 1][skey] = (bf16_t)(rv0.x >> 16);
    vt[sseg * 8 + 2][skey] = (bf16_t)(rv0.y & 0xFFFF); vt[sseg * 8 + 3][skey] = (bf16_t)(rv0.y >> 16);
    vt[sseg * 8 + 4][skey] = (bf16_t)(rv0.z & 0xFFFF); vt[sseg * 8 + 5][skey] = (bf16_t)(rv0.z >> 16);
    vt[sseg * 8 + 6][skey] = (bf16_t)(rv0.w & 0xFFFF); vt[sseg * 8 + 7][skey] = (bf16_t)(rv0.w >> 16);
    vt[sseg * 8 + 0][skey + 32] = (bf16_t)(rv1.x & 0xFFFF); vt[sseg * 8 + 1][skey + 32] = (bf16_t)(rv1.x >> 16);
    vt[sseg * 8 + 2][skey + 32] = (bf16_t)(rv1.y & 0xFFFF); vt[sseg * 8 + 3][skey + 32] = (bf16_t)(rv1.y >> 16);
    vt[sseg * 8 + 4][skey + 32] = (bf16_t)(rv1.z & 0xFFFF); vt[sseg * 8 + 5][skey + 32] = (bf16_t)(rv1.z >> 16);
    vt[sseg * 8 + 6][skey + 32] = (bf16_t)(rv1.w & 0xFFFF); vt[sseg * 8 + 7][skey + 32] = (bf16_t)(rv1.w >> 16);
  };
  ldtile(0);
#pragma unroll 1
  for (int kt = 0; kt < ntiles; ++kt) {
    const int buf = kt & 1;
    sttile(buf);
    __syncthreads();
    if (kt + 1 < ntiles) ldtile(kt + 1);
    const bool ctxk = kt >= ntl;
    const int kbase = ctxk ? (kt - ntl) * 64 : qb * 128 - 128 + kt * 64;
#pragma unroll
    for (int sub = 0; sub < 2; ++sub) {
      const int kb2 = kbase + sub * 32;
      bool need = true;
      if (!ctxk) {
        int q0 = qb * 128 + wid * 32;
        if (kb2 + 31 < q0 - 128 || kb2 > q0 + 31 + 128 || kb2 + 31 < 0 || kb2 >= T) need = false;
      }
      if (need) {
        f32x16 sv;
#pragma unroll
        for (int i = 0; i < 16; ++i) sv[i] = 0.f;
#pragma unroll
        for (int ks = 0; ks < 4; ++ks) {
          bf16x8 kf = *(const bf16x8*)&Ks[buf][sub * 32 + qn][16 * ks + 8 * hh];
          sv = mfma32(kf, qf[ks], sv);
        }
        float mt = -3e38f;
#pragma unroll
        for (int rg = 0; rg < 16; ++rg) {
          float v = sv[rg] * 0.125f;
          if (!ctxk) {
            int kp = kb2 + (rg & 3) + 8 * (rg >> 2) + 4 * hh;
            int dl = qpos - kp;
            bool ok = (dl <= 128) && (dl >= -128) && (kp >= 0) && (kp < T);
            v = ok ? v : -1e30f;
          }
          sv[rg] = v;
          mt = fmaxf(mt, v);
        }
        mt = fmaxf(mt, __shfl_xor(mt, 32));
        float m_new = fmaxf(m_run, mt);
        float corr = __expf(m_run - m_new);
        float ps = 0.f;
#pragma unroll
        for (int rg = 0; rg < 16; ++rg) { float pv = __expf(sv[rg] - m_new); sv[rg] = pv; ps += pv; }
        ps += __shfl_xor(ps, 32);
        l_run = l_run * corr + ps;
        m_run = m_new;
#pragma unroll
        for (int i = 0; i < 16; ++i) { o0[i] *= corr; o1[i] *= corr; }
#pragma unroll
        for (int sp = 0; sp < 2; ++sp) {
          bf16x8 pf;
#pragma unroll
          for (int j = 0; j < 8; ++j) pf[j] = (short)f2bf(sv[8 * sp + j]);
          const int kc = sub * 32 + 16 * sp + 4 * hh;
          uint2 va = *(const uint2*)&Vt[buf][qn][kc], vb = *(const uint2*)&Vt[buf][qn][kc + 8];
          uint2 vc = *(const uint2*)&Vt[buf][32 + qn][kc], vd = *(const uint2*)&Vt[buf][32 + qn][kc + 8];
          uint4 w0 = make_uint4(va.x, va.y, vb.x, vb.y), w1 = make_uint4(vc.x, vc.y, vd.x, vd.y);
          bf16x8 v0 = __builtin_bit_cast(bf16x8, w0), v1 = __builtin_bit_cast(bf16x8, w1);
          o0 = mfma32(v0, pf, o0);
          o1 = mfma32(v1, pf, o1);
        }
      }
    }
  }
  __syncthreads();
  const float inv = 1.f / l_run;
  bf16_t* optr = p.Y + qrow * D + 512 + hq * 64;
#pragma unroll
  for (int rg = 0; rg < 4; ++rg) {
    int d0 = 8 * rg + 4 * hh;
    *(uint2*)(optr + d0) = make_uint2(pack2(o0[4 * rg] * inv, o0[4 * rg + 1] * inv), pack2(o0[4 * rg + 2] * inv, o0[4 * rg + 3] * inv));
    *(uint2*)(optr + 32 + d0) = make_uint2(pack2(o1[4 * rg] * inv, o1[4 * rg + 1] * inv), pack2(o1[4 * rg + 2] * inv, o1[4 * rg + 3] * inv));
  }
}

DEV void ph_attn_post(const P& p, int layer) {
  const int gw = (bid_() * 256 + tid_()) >> 6, nw = gridDim.x * 4, lane = tid_() & 63;
  for (int row = gw; row < NTOK; row += nw) {
    bf16_t* yr = p.Y + (size_t)row * D + 512 + 8 * lane;
    uint4 u = *(const uint4*)yr;
    float v[8];
    unpack8(u, v);
    float ss = 0.f;
#pragma unroll
    for (int i = 0; i < 8; ++i) ss += v[i] * v[i];
    ss = wave_sum(ss);
    float rstd = rsqrtf(ss * (1.f / 512.f) + 1e-6f);
#pragma unroll
    for (int i = 0; i < 8; ++i) {
      v[i] = v[i] * rstd * p.at_out_g[layer * 512 + 8 * lane + i];
#if !EN_AT
      v[i] = 0.f;
#endif
    }
    *(uint4*)yr = pack8(v);
  }
}

struct Epi2 {
  const P& p; int layer, row0, col0;
  DEV void operator()(f32x4 (&acc)[4][4], int wr, int wc, int fr, int fq, char* smem) const {
    const int b = row0 / LT, pp = row0 % LT;
    const int mr = pp < LC ? 16 : b;
    const float* g1 = p.modv + ((size_t)layer * 17 + mr) * 6144 + 2048 + col0 + wc * 64;
#pragma unroll
    for (int n = 0; n < 4; ++n) {
      const float gv = g1[n * 16 + fr];
#pragma unroll
      for (int m = 0; m < 4; ++m)
#pragma unroll
        for (int j = 0; j < 4; ++j) acc[m][n][j] *= gv;
    }
    const int wid = wr * 2 + wc, lane = fq * 16 + fr;
    stage_tile_bf16(acc, smem, wid, fr, fq);
    const bf16_t (*t)[72] = (const bf16_t (*)[72])(smem + wid * 9216);
#pragma unroll
    for (int i = 0; i < 8; ++i) {
      const int rl = i * 8 + (lane >> 3), ch = lane & 7;
      bf16_t* xp = p.X + (size_t)(row0 + wr * 64 + rl) * D + col0 + wc * 64 + ch * 8;
      float xv[8], dv[8];
      uint4 xu = *(const uint4*)xp, du = *(const uint4*)&t[rl][ch * 8];
      unpack8(xu, xv); unpack8(du, dv);
#pragma unroll
      for (int q = 0; q < 8; ++q) xv[q] += dv[q];
#if EN_MIX
      *(uint4*)xp = pack8(xv);
#endif
    }
  }
};
DEV void ph_gemm2(const P& p, int layer, char* smem) {
  for (int u = bid_(); u < (NTOK / 128) * 8; u += gridDim.x) {
    int rt = u >> 3, ct = u & 7;
    Epi2 epi{p, layer, rt * 128, ct * 128};
    gemm_tile(p.Y + (size_t)rt * 128 * D, D, p.W2t + (size_t)ct * 128 * D, D, D, smem, epi);
  }
}

DEV void ph_peerconv(const P& p, int layer) {
  const int gw = (bid_() * 256 + tid_()) >> 6, nw = gridDim.x * 4, lane = tid_() & 63;
  const float* su = opq(p.peer_u) + (size_t)layer * 16384 * 1024;
  const float* sv = opq(p.peer_v) + (size_t)layer * 16384 * 1024;
  unsigned char* pu = opq(p.PU); unsigned char* pv = opq(p.PV);
  float* psu = opq(p.PSU); float* psv = opq(p.PSV);
#pragma unroll 1
  for (int r = gw; r < 32768; r += nw) {
    const bool isv = r >= 16384;
    const int e = r & 16383;
    const float* src = (isv ? sv : su) + (size_t)e * 1024 + 16 * lane;
    float4 f0 = *(const float4*)src, f1 = *(const float4*)(src + 4), f2 = *(const float4*)(src + 8), f3 = *(const float4*)(src + 12);
    float am = fmaxf(fmaxf(fmaxf(fabsf(f0.x), fabsf(f0.y)), fmaxf(fabsf(f0.z), fabsf(f0.w))), fmaxf(fmaxf(fabsf(f1.x), fabsf(f1.y)), fmaxf(fabsf(f1.z), fabsf(f1.w))));
    am = fmaxf(am, fmaxf(fmaxf(fmaxf(fabsf(f2.x), fabsf(f2.y)), fmaxf(fabsf(f2.z), fabsf(f2.w))), fmaxf(fmaxf(fabsf(f3.x), fabsf(f3.y)), fmaxf(fabsf(f3.z), fabsf(f3.w)))));
    am = wave_max(am);
    const float sc = am > 0.f ? 224.f / am : 1.f;
    int w0 = __builtin_amdgcn_cvt_pk_fp8_f32(f0.x * sc, f0.y * sc, 0, false); w0 = __builtin_amdgcn_cvt_pk_fp8_f32(f0.z * sc, f0.w * sc, w0, true);
    int w1 = __builtin_amdgcn_cvt_pk_fp8_f32(f1.x * sc, f1.y * sc, 0, false); w1 = __builtin_amdgcn_cvt_pk_fp8_f32(f1.z * sc, f1.w * sc, w1, true);
    int w2 = __builtin_amdgcn_cvt_pk_fp8_f32(f2.x * sc, f2.y * sc, 0, false); w2 = __builtin_amdgcn_cvt_pk_fp8_f32(f2.z * sc, f2.w * sc, w2, true);
    int w3 = __builtin_amdgcn_cvt_pk_fp8_f32(f3.x * sc, f3.y * sc, 0, false); w3 = __builtin_amdgcn_cvt_pk_fp8_f32(f3.z * sc, f3.w * sc, w3, true);
    *(uint4*)((isv ? pv : pu) + (size_t)(lane >> 3) * PSLICE + (size_t)e * 128 + 16 * (lane & 7)) = make_uint4((unsigned)w0, (unsigned)w1, (unsigned)w2, (unsigned)w3);
    if (lane == 0) (isv ? psv : psu)[e] = am > 0.f ? am * (1.f / 224.f) : 1.f;
  }
}
DEV void unpack16_fp8x2(const uint4& u, f32x2* f) {
  f[0] = __builtin_amdgcn_cvt_pk_f32_fp8((int)u.x, false); f[1] = __builtin_amdgcn_cvt_pk_f32_fp8((int)u.x, true);
  f[2] = __builtin_amdgcn_cvt_pk_f32_fp8((int)u.y, false); f[3] = __builtin_amdgcn_cvt_pk_f32_fp8((int)u.y, true);
  f[4] = __builtin_amdgcn_cvt_pk_f32_fp8((int)u.z, false); f[5] = __builtin_amdgcn_cvt_pk_f32_fp8((int)u.z, true);
  f[6] = __builtin_amdgcn_cvt_pk_f32_fp8((int)u.w, false); f[7] = __builtin_amdgcn_cvt_pk_f32_fp8((int)u.w, true);
}
DEV void unpack16_fp8(const uint4& u, float* f) {
  f32x2 t;
  t = __builtin_amdgcn_cvt_pk_f32_fp8((int)u.x, false); f[0] = t[0]; f[1] = t[1];
  t = __builtin_amdgcn_cvt_pk_f32_fp8((int)u.x, true); f[2] = t[0]; f[3] = t[1];
  t = __builtin_amdgcn_cvt_pk_f32_fp8((int)u.y, false); f[4] = t[0]; f[5] = t[1];
  t = __builtin_amdgcn_cvt_pk_f32_fp8((int)u.y, true); f[6] = t[0]; f[7] = t[1];
  t = __builtin_amdgcn_cvt_pk_f32_fp8((int)u.z, false); f[8] = t[0]; f[9] = t[1];
  t = __builtin_amdgcn_cvt_pk_f32_fp8((int)u.z, true); f[10] = t[0]; f[11] = t[1];
  t = __builtin_amdgcn_cvt_pk_f32_fp8((int)u.w, false); f[12] = t[0]; f[13] = t[1];
  t = __builtin_amdgcn_cvt_pk_f32_fp8((int)u.w, true); f[14] = t[0]; f[15] = t[1];
}

struct Epi3 {
  const P& p; int row0, grp;
  DEV void operator()(f32x4 (&acc)[4][4], int wr, int wc, int fr, int fq, char* smem) const {
    float* sc = (float*)smem;
    const int tid = tid_();
    for (int pass = 0; pass < 2; ++pass) {
      __syncthreads();
      if (wr == pass) {
#pragma unroll
        for (int m = 0; m < 4; ++m)
#pragma unroll
          for (int n = 0; n < 4; ++n)
#pragma unroll
            for (int j = 0; j < 4; ++j) {
              int rl = m * 16 + fq * 4 + j, col = wc * 64 + n * 16 + fr;
              unsigned bits = (__float_as_uint(acc[m][n][j]) & ~127u) | (unsigned)col;
              sc[rl * 133 + (col >> 5) * 33 + (col & 31)] = __uint_as_float(bits);
            }
      }
      __syncthreads();
      const int rl = tid >> 2, q = tid & 3;
      float Ls[16];
#pragma unroll
      for (int i = 0; i < 16; ++i) Ls[i] = -3e38f;
      const float* src = sc + rl * 133 + q * 33;
      for (int i = 0; i < 32; ++i) {
        float x = src[i];
        if (x > Ls[15]) {
#pragma unroll
          for (int k = 0; k < 16; ++k) { float hi = fmaxf(Ls[k], x); x = fminf(Ls[k], x); Ls[k] = hi; }
        }
      }
      float Cs[16];
#pragma unroll
      for (int i = 0; i < 16; ++i) Cs[i] = fmaxf(Ls[i], dppself<0xB1, 0xF>(Ls[15 - i]));
#pragma unroll
      for (int d = 8; d >= 1; d >>= 1)
#pragma unroll
        for (int i = 0; i < 16; ++i)
          if ((i & d) == 0) { float hi = fmaxf(Cs[i], Cs[i + d]), lo = fminf(Cs[i], Cs[i + d]); Cs[i] = hi; Cs[i + d] = lo; }
      float Ds[16];
#pragma unroll
      for (int i = 0; i < 16; ++i) Ds[i] = fmaxf(Cs[i], dppself<0x4E, 0xF>(Cs[15 - i]));
#pragma unroll
      for (int d = 8; d >= 1; d >>= 1)
#pragma unroll
        for (int i = 0; i < 16; ++i)
          if ((i & d) == 0) { float hi = fmaxf(Ds[i], Ds[i + d]), lo = fminf(Ds[i], Ds[i + d]); Ds[i] = hi; Ds[i + d] = lo; }
      if (q == 0) {
        float* dst = p.TK + ((size_t)(row0 + pass * 64 + rl) * 16 + grp) * 16;
#pragma unroll
        for (int i = 0; i < 4; ++i) *(float4*)(dst + 4 * i) = make_float4(Ds[4 * i], Ds[4 * i + 1], Ds[4 * i + 2], Ds[4 * i + 3]);
      }
    }
  }
};
DEV void ph_gemm3(const P& p, char* smem) {
  for (int u = bid_(); u < (NTOK / 128) * 16; u += gridDim.x) {
    int rt = u >> 4, ct = u & 15;
    Epi3 epi{p, rt * 128, ct};
    gemm_tile(p.H + (size_t)rt * 128 * D, D, p.Wft + (size_t)ct * 128 * D, D, D, smem, epi);
  }
}

DEV float peer_gate(float scr) {
  float mx = row16_max(scr);
  float ex = __expf(scr - mx);
  float sm = row16_sum(ex);
  return ex / sm;
}
DEV float gelu_exact(float x) { return 0.5f * x * (1.f + erff(x * 0.7071067811865476f)); }

DEV void ph_peer_select(const P& p) {
  const int gw = (bid_() * 256 + tid_()) >> 6, nw = gridDim.x * 4, lane = tid_() & 63;
  int ci, cj;
  {
    const int c = lane;
    if (c < 16) { ci = 0; cj = c; } else if (c < 24) { ci = 1; cj = c - 16; } else if (c < 29) { ci = 2; cj = c - 24; }
    else if (c < 33) { ci = 3; cj = c - 29; } else if (c < 36) { ci = 4; cj = c - 33; } else if (c < 38) { ci = 5; cj = c - 36; }
    else if (c < 40) { ci = 6; cj = c - 38; } else if (c < 42) { ci = 7; cj = c - 40; } else { ci = (c - 42 + 8) & 15; cj = 0; }
  }
  const bool cand = lane < 50;
#pragma unroll 1
  for (int row = gw; row < NTOK; row += nw) {
    const float* tk = p.TK + (size_t)row * 256;
#pragma unroll 1
    for (int h = 0; h < 8; ++h) {
      const float v1 = tk[(2 * h) * 16 + ci], v2 = tk[(2 * h + 1) * 16 + cj];
      float val = v1 + v2;
      val = __uint_as_float((__float_as_uint(val) & ~63u) | (unsigned)lane);
      val = cand ? val : -3e38f;
      int rank = 0;
#pragma unroll 10
      for (int c2 = 0; c2 < 50; ++c2) rank += (readlane_f(val, c2) > val) ? 1 : 0;
      const bool sel = cand && rank < 16;
      const float mx = wave_max(val);
      const float ex = sel ? __expf(val - mx) : 0.f;
      const float sm = wave_sum(ex);
      if (sel) {
        const int e = (int)(__float_as_uint(v1) & 127u) * 128 + (int)(__float_as_uint(v2) & 127u);
        p.EL[(size_t)row * 128 + h * 16 + rank] = (unsigned short)e;
        p.GT[(size_t)row * 128 + h * 16 + rank] = ex / sm;
      }
    }
  }
}

DEV void peer_u_item(const P& p, int x, int tok, int lane) {
  const int r = lane >> 3, c = lane & 7;
  const bf16_t* hr = p.H + (size_t)tok * D + x * 128 + c * 16;
  float hv[16];
  { uint4 u0 = *(const uint4*)hr, u1 = *(const uint4*)(hr + 8); unpack8(u0, hv); unpack8(u1, hv + 8); }
  f32x2 hv2[8];
#pragma unroll
  for (int i = 0; i < 8; ++i) hv2[i] = (f32x2){hv[2 * i], hv[2 * i + 1]};
  const uint4* elp = (const uint4*)(p.EL + (size_t)tok * 128 + r * 16);
  const uint4 e0 = elp[0], e1 = elp[1];
  const unsigned ew[8] = {e0.x, e0.y, e0.z, e0.w, e1.x, e1.y, e1.z, e1.w};
  const unsigned char* ub = p.PU + (size_t)x * PSLICE + c * 16;
  float keep0 = 0.f, keep1 = 0.f;
#pragma unroll
  for (int jh = 0; jh < 2; ++jh) {
    uint4 ua[8];
#pragma unroll
    for (int j = 0; j < 8; ++j) {
      const unsigned w = ew[jh * 4 + (j >> 1)];
      const unsigned e = (j & 1) ? (w >> 16) : (w & 0xFFFFu);
      ua[j] = *(const uint4*)(ub + (size_t)e * 128);
    }
#pragma unroll
    for (int j = 0; j < 8; ++j) {
      f32x2 f[8];
      unpack16_fp8x2(ua[j], f);
      f32x2 d2 = f[0] * hv2[0];
#pragma unroll
      for (int i = 1; i < 8; ++i) d2 += f[i] * hv2[i];
      const float d = oct_sum(d2[0] + d2[1]);
      if (jh == 0) keep0 = (c == j) ? d : keep0; else keep1 = (c == j) ? d : keep1;
    }
  }
  float* pd = p.PD + ((size_t)x * NTOK + tok) * 128 + r * 16 + c;
  pd[0] = keep0; pd[8] = keep1;
}
DEV void ph_peer_w(const P& p) {
  for (size_t i = (size_t)bid_() * 256 + tid_(); i < (size_t)NTOK * 128; i += (size_t)gridDim.x * 256) {
    float d = 0.f;
#pragma unroll
    for (int x = 0; x < 8; ++x) d += p.PD[(size_t)x * NTOK * 128 + i];
    const int e = p.EL[i];
    p.GT[i] = p.GT[i] * gelu_exact(d * p.PSU[e]) * p.PSV[e];
  }
}
DEV void peer_v_item(const P& p, int layer, int x, int tok, int lane, float* wbuf) {
  const int r = lane >> 3, c = lane & 7;
  const uint4* elp = (const uint4*)(p.EL + (size_t)tok * 128 + r * 16);
  const uint4 e0 = elp[0], e1 = elp[1];
  const unsigned ew[8] = {e0.x, e0.y, e0.z, e0.w, e1.x, e1.y, e1.z, e1.w};
  const float4* wtp = (const float4*)(p.GT + (size_t)tok * 128 + r * 16);
  const float4 w0 = wtp[0], w1 = wtp[1], w2 = wtp[2], w3 = wtp[3];
  const float wsv[16] = {w0.x, w0.y, w0.z, w0.w, w1.x, w1.y, w1.z, w1.w, w2.x, w2.y, w2.z, w2.w, w3.x, w3.y, w3.z, w3.w};
  const unsigned char* vb = p.PV + (size_t)x * PSLICE + c * 16;
  f32x2 acc2[8];
#pragma unroll
  for (int i = 0; i < 8; ++i) acc2[i] = (f32x2){0.f, 0.f};
#pragma unroll
  for (int jh = 0; jh < 2; ++jh) {
    uint4 ua[8];
#pragma unroll
    for (int j = 0; j < 8; ++j) {
      const unsigned w = ew[jh * 4 + (j >> 1)];
      const unsigned e = (j & 1) ? (w >> 16) : (w & 0xFFFFu);
      ua[j] = *(const uint4*)(vb + (size_t)e * 128);
    }
#pragma unroll
    for (int j = 0; j < 8; ++j) {
      f32x2 f[8];
      unpack16_fp8x2(ua[j], f);
      const f32x2 w2 = (f32x2){wsv[jh * 8 + j], wsv[jh * 8 + j]};
#pragma unroll
      for (int i = 0; i < 8; ++i) acc2[i] += w2 * f[i];
    }
  }
  float acc[16];
#pragma unroll
  for (int i = 0; i < 8; ++i) { acc[2 * i] = acc2[i][0]; acc[2 * i + 1] = acc2[i][1]; }
  float* slab = wbuf + (r * 8 + c) * 16;
  *(float4*)(slab) = make_float4(acc[0], acc[1], acc[2], acc[3]);
  *(float4*)(slab + 4) = make_float4(acc[4], acc[5], acc[6], acc[7]);
  *(float4*)(slab + 8) = make_float4(acc[8], acc[9], acc[10], acc[11]);
  *(float4*)(slab + 12) = make_float4(acc[12], acc[13], acc[14], acc[15]);
  asm volatile("s_waitcnt lgkmcnt(0)" ::: "memory");
  float o0 = 0.f, o1 = 0.f;
#pragma unroll
  for (int rr = 0; rr < 8; ++rr) {
    const float2 t = *(const float2*)(wbuf + (rr * 8 + (lane >> 3)) * 16 + 2 * (lane & 7));
    o0 += t.x; o1 += t.y;
  }
  asm volatile("s_waitcnt lgkmcnt(0)" ::: "memory");
  const int b = tok / LT, pp = tok % LT;
  const int mr = pp < LC ? 16 : b;
  const int col = x * 128 + 2 * lane;
  const float* g2 = p.modv + ((size_t)layer * 17 + mr) * 6144 + 5120 + col;
  unsigned* xp = (unsigned*)(p.X + (size_t)tok * D + col);
  const unsigned xu = *xp;
#if EN_PEER
  *xp = pack2(bflo(xu) + g2[0] * o0, bfhi(xu) + g2[1] * o1);
#endif
}
template <int WHICH>
DEV void ph_peer_gather(const P& p, int layer, char* smem, volatile LAS unsigned* slot) {
  const int tid = tid_(), lane = tid & 63, wid = tid >> 6;
  unsigned* q = p.wq + 1024 + layer * 256 + WHICH * 128;
  const int my = (int)(xb_xcc_id() & 7u);
  float* wbuf = (float*)smem + wid * 1024;
#pragma unroll 1
  for (int rot = 0; rot < 8; ++rot) {
    const int x = (my + rot) & 7;
    for (;;) {
      __syncthreads();
      if (tid == 0) *slot = atomicAdd(q + x * 16, 1u);
      __syncthreads();
      const int it = (int)*slot;
      if (it >= NTOK / 16) break;
#pragma unroll 1
      for (int i = 0; i < 4; ++i) {
        const int tok = it * 16 + wid * 4 + i;
        if (WHICH == 0) peer_u_item(p, x, tok, lane); else peer_v_item(p, layer, x, tok, lane, wbuf);
      }
    }
  }
}

DEV void ph_final(const P& p) {
  const int gw = (bid_() * 256 + tid_()) >> 6, nw = gridDim.x * 4, lane = tid_() & 63;
  for (int r = gw; r < NB * T; r += nw) {
    int b = r / T, t = r % T;
    const bf16_t* xr = p.X + ((size_t)b * LT + LC + t) * D;
    uint4 u0 = *(const uint4*)(xr + 8 * lane), u1 = *(const uint4*)(xr + 512 + 8 * lane);
    float v[16];
    unpack8(u0, v); unpack8(u1, v + 8);
    float ss = 0.f;
#pragma unroll
    for (int i = 0; i < 16; ++i) ss += v[i] * v[i];
    ss = wave_sum(ss);
    float rstd = rsqrtf(ss * (1.f / 1024.f) + 1e-6f);
    float* o = p.out + (size_t)r * D;
#pragma unroll
    for (int hh = 0; hh < 2; ++hh) {
      int col = hh * 512 + 8 * lane;
      float4 a = make_float4(v[hh * 8 + 0] * rstd * p.final_g[col + 0], v[hh * 8 + 1] * rstd * p.final_g[col + 1], v[hh * 8 + 2] * rstd * p.final_g[col + 2], v[hh * 8 + 3] * rstd * p.final_g[col + 3]);
      float4 c = make_float4(v[hh * 8 + 4] * rstd * p.final_g[col + 4], v[hh * 8 + 5] * rstd * p.final_g[col + 5], v[hh * 8 + 6] * rstd * p.final_g[col + 6], v[hh * 8 + 7] * rstd * p.final_g[col + 7]);
      *(float4*)(o + col) = a; *(float4*)(o + col + 4) = c;
    }
  }
}

DEV unsigned hw_cu_key() {
  const unsigned hwid = (unsigned)__builtin_amdgcn_s_getreg(((8 - 1) << 11) | (8 << 6) | 4);
  return (xb_xcc_id() << 8) | (hwid & 0xFFu);
}
DEV void mixB(const P& p, int layer, char* smem, volatile LAS unsigned* slot) {
  unsigned* qa = p.wq + layer * 64;
  unsigned* qs = qa + 16;
  unsigned* claim = p.cuclaim + layer * 4096;
  __syncthreads();
  if (tid_() == 0) {
    unsigned u = 0xFFFFFFFFu;
    if (atomicAdd(&claim[hw_cu_key() & 4095u], 1u) == 0u) u = atomicAdd(qs, 1u);
    *slot = u;
  }
  __syncthreads();
  {
    const unsigned u = *slot;
    if (u < 128u) scanc_unit(p, layer, (int)u, smem);
  }
  for (;;) {
    __syncthreads();
    if (tid_() == 0) *slot = atomicAdd(qa, 1u);
    __syncthreads();
    const int u = (int)*slot;
    if (u >= 8704) break;
    if (u < 4352) attn_unit(p, layer, u, smem); else hyena_conv_unit(p, layer, u - 4352, smem);
  }
  for (;;) {
    __syncthreads();
    if (tid_() == 0) *slot = atomicAdd(qs, 1u);
    __syncthreads();
    const unsigned u = *slot;
    if (u >= 128u) break;
    scanc_unit(p, layer, (int)u, smem);
  }
}
DEV void mixA(const P& p, int layer, char* smem) {
  for (int u = bid_(); u < 1088 + 5440; u += gridDim.x) {
    if (u < 1088) hyena_pre_unit(p, layer, u); else lora_unit(p, layer, u - 1088, smem);
  }
  ph_rwkv_prep(p, layer);
}
DEV void mixC(const P& p, int layer, char* smem) {
  for (int u = bid_(); u < 1088; u += gridDim.x) hyena_post_unit(p, layer, u, smem);
  ph_rwkv_post(p, layer);
  ph_attn_post(p, layer);
}

__global__ void __launch_bounds__(256, 2) k_mega(P p) {
  extern __shared__ __attribute__((aligned(16))) char smem_all[];
  char* smem = smem_all;
  volatile LAS unsigned* xbw = (volatile LAS unsigned*)(smem_all + SMEM_BYTES);
  if (threadIdx.x == 0) { xbw[0] = 0u; xbw[1] = 0u; xbw[2] = 0u; xbw[3] = 0u; }
  __syncthreads();
  XcdBarrier bar = xcd_barrier_post(p.bar, xbw);
#ifndef NO_PRO
  ph_copy(p);
  ph_rope(p);
  for (int u = blockIdx.x; u < 96; u += gridDim.x) modv_unit(p, u, smem);
#endif
#ifndef NO_PREP
  ph_prep(p, 0, smem);
#endif
  xcd_barrier(bar);
  for (int layer = 0; layer < NLAYERS; ++layer) {
#ifndef NO_NORM
    ph_norm(p, layer, 0);
#endif
    xcd_barrier(bar);
#ifdef PROBE_GEMM
    ph_gemm1(p, smem);
#endif
#ifndef NO_GEMM1
    ph_gemm1(p, smem);
#endif
    xcd_barrier(bar);
#ifndef NO_MIXA
    mixA(p, layer, smem);
#endif
    xcd_barrier(bar);
#ifndef NO_MIXB
    mixB(p, layer, smem, (volatile LAS unsigned*)(smem_all + SMEM_BYTES + 16));
#endif
    xcd_barrier(bar);
#ifndef NO_MIXC
    mixC(p, layer, smem);
#endif
    xcd_barrier(bar);
#ifndef NO_GEMM2
    ph_gemm2(p, layer, smem);
    ph_peerconv(p, layer);
#endif
    xcd_barrier(bar);
#ifndef NO_NORM
    ph_norm(p, layer, 1);
#endif
    xcd_barrier(bar);
#ifdef PROBE_GEMM
    ph_gemm3(p, smem);
#endif
#ifndef NO_GEMM3
    ph_gemm3(p, smem);
#endif
    xcd_barrier(bar);
    ph_peer_select(p);
    xcd_barrier(bar);
    ph_peer_gather<0>(p, layer, smem, (volatile LAS unsigned*)(smem_all + SMEM_BYTES + 16));
    xcd_barrier(bar);
    ph_peer_w(p);
    xcd_barrier(bar);
    ph_peer_gather<1>(p, layer, smem, (volatile LAS unsigned*)(smem_all + SMEM_BYTES + 16));
#ifndef NO_PREP
    if (layer + 1 < NLAYERS) ph_prep(p, layer + 1, smem);
#endif
    xcd_barrier(bar);
  }
  ph_final(p);
}

static inline size_t al256(size_t x) { return (x + 255) & ~(size_t)255; }

extern "C" void kernel_launch(void* const* d_in, const int* in_sizes, int n_in, void* d_out, int out_size, void* d_ws, size_t ws_size,
                              hipStream_t stream) {
  (void)in_sizes; (void)n_in; (void)out_size; (void)ws_size;
  P p{};
  const float** f = (const float**)&p;
  for (int i = 0; i < 39; ++i) f[i] = (const float*)d_in[i];
  p.out = (float*)d_out;
  char* w = (char*)d_ws;
  size_t off = 0;
  auto take = [&](size_t bytes) { char* r = w + off; off += al256(bytes); return r; };
  p.bar = (unsigned*)take(16384);
  p.modv = (float*)take((size_t)DEPTH * 17 * 6144 * 4);
  p.SSQ = (float*)take((size_t)DEPTH * 2 * 256 * 4);
  p.wq = (unsigned*)take(4096 + DEPTH * 1024);
  p.cuclaim = (unsigned*)take((size_t)DEPTH * 4096 * 4);
  const size_t zero_bytes = off;
  p.rope = (float*)take(64 * 16 * 2 * 4);
  p.X = (bf16_t*)take((size_t)NTOK * D * 2);
  p.H = (bf16_t*)take((size_t)NTOK * D * 2);
  p.Y = (bf16_t*)take((size_t)NTOK * D * 2);
  p.SC = (bf16_t*)take((size_t)NTOK * 1024 * 2);
  p.Z = (bf16_t*)take((size_t)NTOK * INW * 2);
  p.UTl = (bf16_t*)take((size_t)256 * 16 * T * 2);
  p.UTc = (bf16_t*)take((size_t)256 * 16 * LC * 2);
  p.YTl = (bf16_t*)take((size_t)256 * 16 * T * 2);
  p.YTc = (bf16_t*)take((size_t)256 * 16 * LC * 2);
  p.FL = (float*)take((size_t)256 * 2 * T * 4);
  p.FC = (float*)take((size_t)256 * 2 * LC * 4);
  p.W1t = (bf16_t*)take((size_t)INW * D * 2);
  p.W2t = (bf16_t*)take((size_t)D * D * 2);
  p.Wft = (bf16_t*)take((size_t)2048 * D * 2);
  p.Wwt = (bf16_t*)take((size_t)2 * 256 * 64 * 2);
  p.Wat = (bf16_t*)take((size_t)2 * 256 * 64 * 2);
  p.Wgt = (bf16_t*)take((size_t)256 * 128 * 2);
  p.TK = (float*)p.Z;
  p.PU = (unsigned char*)p.Z + al256((size_t)NTOK * 256 * 4);
  p.PV = p.PU + (size_t)16384 * 1024;
  p.PSU = (float*)(p.PV + (size_t)16384 * 1024);
  p.PSV = p.PSU + 16384;
  p.GT = p.PSV + 16384;
  p.EL = (unsigned short*)(p.GT + (size_t)NTOK * 128);
  p.PD = (float*)p.Y;

  (void)hipMemsetAsync(d_ws, 0, zero_bytes, stream);
  constexpr size_t kDynLds = SMEM_BYTES + 32;
  static int grid = 0;
  if (!grid) {
    int dev = 0, cus = 0, per_cu = 0;
    (void)hipGetDevice(&dev);
    (void)hipDeviceGetAttribute(&cus, hipDeviceAttributeMultiprocessorCount, dev);
    (void)hipFuncSetAttribute((const void*)k_mega, hipFuncAttributeMaxDynamicSharedMemorySize, (int)kDynLds);
    (void)hipOccupancyMaxActiveBlocksPerMultiprocessor(&per_cu, k_mega, 256, kDynLds);
    if (cus <= 0) cus = 256;
    if (per_cu > 2) per_cu = 2;
    if (per_cu < 1) per_cu = 1;
    grid = cus * per_cu;
  }
  k_mega<<<grid, 256, kDynLds, stream>>>(p);
}
```

```cpp
#include <hip/hip_runtime.h>
#include <stdint.h>

#define DEV __device__ __forceinline__
typedef unsigned short bf16_t;
typedef short bf16x8 __attribute__((ext_vector_type(8)));
typedef float f32x2 __attribute__((ext_vector_type(2)));
constexpr size_t PSLICE = (size_t)16384 * 128;
typedef float f32x4 __attribute__((ext_vector_type(4)));
typedef float f32x16 __attribute__((ext_vector_type(16)));

#ifndef NLAYERS
#define NLAYERS 4
#endif
#ifndef EN_HY
#define EN_HY 1
#endif
#ifndef EN_RW
#define EN_RW 1
#endif
#ifndef EN_AT
#define EN_AT 1
#endif
#ifndef EN_MIX
#define EN_MIX 1
#endif
#ifndef EN_PEER
#define EN_PEER 1
#endif

constexpr int NB = 16, T = 4096, LC = 256, LT = 4352, D = 1024, NTOK = NB * LT, INW = 2688, DEPTH = 4;
constexpr int SMEM_BYTES = 65536;

struct P {
  const float *x, *c, *ctx, *c_ctx, *mod_w, *mod_b, *norm1_g, *norm2_g, *w_in, *conv_w, *conv_b;
  const float *hy_w1, *hy_b1, *hy_w2, *hy_b2, *hy_w3, *hy_b3, *hy_freq, *hy_bias;
  const float *rw_w0, *rw_w_up, *rw_a0, *rw_a_up, *rw_g_up, *rw_k_k, *rw_k_a, *rw_r_k, *rw_ln_w, *rw_ln_b;
  const float *attn_sink, *hy_out_g, *at_out_g, *w_out, *peer_wq, *peer_k1, *peer_k2, *peer_u, *peer_v, *final_g;
  float* out;
  unsigned* bar;
  float *modv, *SSQ, *rope, *FL, *FC, *TK;
  unsigned *wq, *cuclaim;
  bf16_t *X, *H, *Y, *SC, *Z, *UTl, *UTc, *YTl, *YTc;
  bf16_t *W1t, *W2t, *Wft, *Wlt, *Wgt;
  unsigned char *PU, *PV;
  float *PSU, *PSV, *GT, *PD;
  unsigned short* EL;
};

typedef __bf16 hwbf2 __attribute__((ext_vector_type(2)));
DEV unsigned pack2(float a, float b) { f32x2 f = {a, b}; hwbf2 r = __builtin_convertvector(f, hwbf2); return __builtin_bit_cast(unsigned, r); }
DEV bf16_t f2bf(float f) { return (bf16_t)(pack2(f, 0.f) & 0xFFFFu); }
DEV float bf2f(bf16_t h) { return __uint_as_float(((unsigned)h) << 16); }
DEV float bflo(unsigned u) { return __uint_as_float(u << 16); }
DEV float bfhi(unsigned u) { return __uint_as_float(u & 0xFFFF0000u); }
DEV void unpack8(const uint4& u, float* v) {
  v[0] = bflo(u.x); v[1] = bfhi(u.x); v[2] = bflo(u.y); v[3] = bfhi(u.y);
  v[4] = bflo(u.z); v[5] = bfhi(u.z); v[6] = bflo(u.w); v[7] = bfhi(u.w);
}
DEV uint4 pack8(const float* v) { return make_uint4(pack2(v[0], v[1]), pack2(v[2], v[3]), pack2(v[4], v[5]), pack2(v[6], v[7])); }
DEV float sigmoidf_(float x) { return __builtin_amdgcn_rcpf(1.f + __expf(-x)); }

template <int CTRL, int ROWMASK>
DEV float dpp0(float x) {
  return __builtin_bit_cast(float, __builtin_amdgcn_update_dpp(0, __builtin_bit_cast(int, x), CTRL, ROWMASK, 0xF, false));
}
template <int CTRL, int ROWMASK>
DEV float dppself(float x) {
  int xi = __builtin_bit_cast(int, x);
  return __builtin_bit_cast(float, __builtin_amdgcn_update_dpp(xi, xi, CTRL, ROWMASK, 0xF, false));
}
DEV float readlane_f(float x, int l) { return __builtin_bit_cast(float, __builtin_amdgcn_readlane(__builtin_bit_cast(int, x), l)); }
DEV int lane_id() { return (int)__builtin_amdgcn_mbcnt_hi(~0u, __builtin_amdgcn_mbcnt_lo(~0u, 0u)); }
DEV float writelane_f(float val, int l, float old) { return lane_id() == l ? val : old; }
DEV int writelane_i(int val, int l, int old) { return lane_id() == l ? val : old; }
DEV float wave_sum(float x) {
  x += dpp0<0x111, 0xF>(x); x += dpp0<0x112, 0xF>(x); x += dpp0<0x114, 0xF>(x); x += dpp0<0x118, 0xF>(x);
  x += dpp0<0x142, 0xA>(x); x += dpp0<0x143, 0xC>(x);
  return readlane_f(x, 63);
}
DEV float wave_max(float x) {
  x = fmaxf(x, dppself<0x111, 0xF>(x)); x = fmaxf(x, dppself<0x112, 0xF>(x)); x = fmaxf(x, dppself<0x114, 0xF>(x));
  x = fmaxf(x, dppself<0x118, 0xF>(x)); x = fmaxf(x, dppself<0x142, 0xA>(x)); x = fmaxf(x, dppself<0x143, 0xC>(x));
  return readlane_f(x, 63);
}
DEV float row16_sum(float x) {
  x += dpp0<0xB1, 0xF>(x); x += dpp0<0x4E, 0xF>(x); x += dpp0<0x141, 0xF>(x); x += dpp0<0x140, 0xF>(x);
  return x;
}
DEV float row16_max(float x) {
  x = fmaxf(x, dppself<0xB1, 0xF>(x)); x = fmaxf(x, dppself<0x4E, 0xF>(x)); x = fmaxf(x, dppself<0x141, 0xF>(x));
  x = fmaxf(x, dppself<0x140, 0xF>(x));
  return x;
}
DEV float quad_sum(float x) { x += dpp0<0xB1, 0xF>(x); x += dpp0<0x4E, 0xF>(x); return x; }

DEV f32x4 mfma16(bf16x8 a, bf16x8 b, f32x4 c) { return __builtin_amdgcn_mfma_f32_16x16x32_bf16(a, b, c, 0, 0, 0); }
DEV f32x16 mfma32(bf16x8 a, bf16x8 b, f32x16 c) { return __builtin_amdgcn_mfma_f32_32x32x16_bf16(a, b, c, 0, 0, 0); }


#define XB_TMO      128
#define XB_XCNT(j)  (256  + 64 * (j))
#define XB_XSUB(j)  (1280 + 64 * (j))
#define XB_XGEN(j)  (2304 + 64 * (j))
#define XB_TOP      3328
#define XB_TOPGEN   3392
#define XCD_BAR_WORDS 3456
#define XB_SPIN_CAP (1u << 23)
#define LAS __attribute__((address_space(3)))

__device__ __forceinline__ unsigned xb_ld(unsigned* p)              { return __hip_atomic_load(p, __ATOMIC_RELAXED, __HIP_MEMORY_SCOPE_AGENT); }
__device__ __forceinline__ unsigned xb_add(unsigned* p, unsigned v) { return __hip_atomic_fetch_add(p, v, __ATOMIC_RELAXED, __HIP_MEMORY_SCOPE_AGENT); }
__device__ __forceinline__ unsigned xb_xcc_id() { return (unsigned)__builtin_amdgcn_s_getreg((3 << 11) | 20) & 0xFu; }
#define XB_SPIN(cond, bar) do { unsigned _sp = 0; while (cond) { __builtin_amdgcn_s_sleep(1); \
    if ((++_sp & 255u) == 0u) { if (xb_ld(&(bar)[XB_TMO])) break; if (_sp > XB_SPIN_CAP) { atomicAdd(&(bar)[XB_TMO], 1u); break; } } } } while (0)

struct XcdBarrier {
    unsigned* bar; unsigned x;
    volatile LAS unsigned* st;
};
__device__ __forceinline__ XcdBarrier xcd_barrier_post(unsigned* bar, volatile LAS unsigned* st) {
    XcdBarrier b; b.bar = bar; b.x = xb_xcc_id(); b.st = st;
    if (threadIdx.x == 0) (void)xb_add(&bar[XB_XCNT(b.x)], 1u);
    return b;
}
__device__ __forceinline__ void xcd_barrier_complete(unsigned* bar, unsigned x, unsigned& nloc, unsigned& nx) {
    const unsigned G = gridDim.x * gridDim.y * gridDim.z;
    unsigned sum, cnt, mine, sp = 0u;
    for (;;) {
        sum = 0u; cnt = 0u; mine = 0u;
#pragma unroll
        for (unsigned j = 0; j < 16; ++j) { const unsigned c = xb_ld(&bar[XB_XCNT(j)]); sum += c; cnt += (c > 0u) ? 1u : 0u; mine = (j == x) ? c : mine; }
        if (sum == G) break;
        __builtin_amdgcn_s_sleep(1);
        if ((++sp & 255u) == 0u) { if (xb_ld(&bar[XB_TMO])) break; if (sp > XB_SPIN_CAP) { atomicAdd(&bar[XB_TMO], 1u); break; } }
    }
    nloc = mine > 0u ? mine : 1u; nx = cnt > 0u ? cnt : 1u;
}
__device__ __forceinline__ void xcd_barrier(const XcdBarrier& b) {
    asm volatile("s_waitcnt vmcnt(0)" ::: "memory");
    __syncthreads();
    if (threadIdx.x == 0) {
        unsigned* bar = b.bar;
        __builtin_amdgcn_s_waitcnt(0);
        unsigned nloc = b.st[0], nx = b.st[1];
        if (nloc == 0u) { xcd_barrier_complete(bar, b.x, nloc, nx); b.st[0] = nloc; b.st[1] = nx; }
        const unsigned old = xb_add(&bar[XB_XSUB(b.x)], 1u);
        const unsigned gen = old / nloc;
        if (old + 1u == (gen + 1u) * nloc) {
            __builtin_amdgcn_fence(__ATOMIC_RELEASE, "agent");
            asm volatile("s_waitcnt vmcnt(0)" ::: "memory");
            const unsigned og = xb_add(&bar[XB_TOP], 1u);
            const unsigned tg = og / nx;
            if (og + 1u == (tg + 1u) * nx) xb_add(&bar[XB_TOPGEN], 1u);
            else XB_SPIN(xb_ld(&bar[XB_TOPGEN]) == tg, bar);
            __builtin_amdgcn_fence(__ATOMIC_ACQUIRE, "agent");
            xb_add(&bar[XB_XGEN(b.x)], 1u);
            asm volatile("s_waitcnt vmcnt(0)" ::: "memory");
        } else {
            XB_SPIN(xb_ld(&bar[XB_XGEN(b.x)]) == gen, bar);
            __builtin_amdgcn_fence(__ATOMIC_ACQUIRE, "agent");
            asm volatile("s_waitcnt vmcnt(0)" ::: "memory");
        }
    }
    __syncthreads();
}

template <class Tp> DEV Tp* opq(Tp* q) { asm volatile("" : "+s"(q)); return q; }
DEV int tid_() { int t = threadIdx.x; asm volatile("" : "+v"(t)); return t; }
DEV int bid_() { int b = blockIdx.x; asm volatile("" : "+s"(b)); return b; }

DEV void glds16(const void* gsrc, char* lds_lane_ptr) {
  __builtin_amdgcn_global_load_lds((const unsigned*)gsrc, (__attribute__((address_space(3))) unsigned*)lds_lane_ptr, 16, 0, 0);
}
template <class Epi>
DEV void gemm_tile(const bf16_t* __restrict__ A, int lda, const bf16_t* __restrict__ Bt, int ldb, int K, char* smem, Epi& epi) {
  const int tid = tid_(), lane = tid & 63, wid = tid >> 6, wr = wid >> 1, wc = wid & 1, fr = lane & 15, fq = lane >> 4;
  f32x4 acc[4][4];
#pragma unroll
  for (int m = 0; m < 4; ++m)
#pragma unroll
    for (int n = 0; n < 4; ++n) acc[m][n] = (f32x4){0.f, 0.f, 0.f, 0.f};
  const int drow0 = 8 * wid + (lane >> 3), dpc = lane & 7;
  auto issue = [&](int kt, int buf) {
    char* sa = smem + buf * 32768;
    char* sb = sa + 16384;
#pragma unroll
    for (int i = 0; i < 4; ++i) {
      const int row = drow0 + 32 * i;
      const int kc = dpc ^ ((row >> 1) & 7);
      glds16(A + (size_t)row * lda + kt * 64 + kc * 8, sa + (i * 4 + wid) * 1024 + lane * 16);
      glds16(Bt + (size_t)row * ldb + kt * 64 + kc * 8, sb + (i * 4 + wid) * 1024 + lane * 16);
    }
  };
  __syncthreads();
  issue(0, 0);
  const int nk = K >> 6;
  const int sw = (fr >> 1) & 7;
  const int aoff = (wr * 64 + fr) * 128, boff = (wc * 64 + fr) * 128;
  for (int kt = 0; kt < nk; ++kt) {
    asm volatile("s_waitcnt vmcnt(0)" ::: "memory");
    __syncthreads();
    if (kt + 1 < nk) issue(kt + 1, (kt + 1) & 1);
    const char* sa = smem + (kt & 1) * 32768;
    const char* sb = sa + 16384;
#pragma unroll
    for (int kh = 0; kh < 2; ++kh) {
      const int pc = ((kh * 4 + fq) ^ sw) * 16;
      bf16x8 af[4], bfr[4];
#pragma unroll
      for (int m = 0; m < 4; ++m) af[m] = *(const bf16x8*)(sa + aoff + m * 2048 + pc);
#pragma unroll
      for (int n = 0; n < 4; ++n) bfr[n] = *(const bf16x8*)(sb + boff + n * 2048 + pc);
#pragma unroll
      for (int m = 0; m < 4; ++m)
#pragma unroll
        for (int n = 0; n < 4; ++n) acc[m][n] = mfma16(af[m], bfr[n], acc[m][n]);
    }
  }
  __syncthreads();
  epi(acc, wr, wc, fr, fq, smem);
}
DEV void stage_tile_bf16(const f32x4 (&acc)[4][4], char* smem, int wid, int fr, int fq) {
  bf16_t (*t)[72] = (bf16_t (*)[72])(smem + wid * 9216);
#pragma unroll
  for (int m = 0; m < 4; ++m)
#pragma unroll
    for (int n = 0; n < 4; ++n)
#pragma unroll
      for (int j = 0; j < 4; ++j) t[m * 16 + fq * 4 + j][n * 16 + fr] = f2bf(acc[m][n][j]);
  asm volatile("s_waitcnt lgkmcnt(0)" ::: "memory");
}

DEV void ph_copy(const P& p) {
  const size_t n8 = (size_t)NTOK * D / 8;
  const float* pctx = opq(p.ctx); const float* px = opq(p.x);
  for (size_t i = (size_t)bid_() * 256 + tid_(); i < n8; i += (size_t)gridDim.x * 256) {
    size_t e = i * 8;
    int row = (int)(e / D), col = (int)(e % D);
    int b = row / LT, pp = row % LT;
    const float* src = pp < LC ? pctx + ((size_t)(b * LC + pp)) * D + col : px + ((size_t)(b * T + pp - LC)) * D + col;
    float4 v0 = *(const float4*)src, v1 = *(const float4*)(src + 4);
    uint4 o = make_uint4(pack2(v0.x, v0.y), pack2(v0.z, v0.w), pack2(v1.x, v1.y), pack2(v1.z, v1.w));
    *(uint4*)(p.X + e) = o;
  }
}

DEV void ph_rope(const P& p) {
  for (int i = bid_() * 256 + tid_(); i < 64 * 16; i += gridDim.x * 256) {
    int pos = i >> 4, k = i & 15;
    float inv = powf(10000.f, -(float)k / 16.f);
    float ang = (float)pos * inv;
    p.rope[2 * i] = cosf(ang); p.rope[2 * i + 1] = sinf(ang);
  }
}

DEV void modv_unit(const P& p, int unit, char* smem) {
  const int cc = unit % 24, layer = unit / 24;
  float (*cs)[128] = (float (*)[128])smem;
  const int col = cc * 256 + tid_();
  const float* pc = opq(p.c); const float* pcc = opq(p.c_ctx);
  float acc[17];
#pragma unroll
  for (int r = 0; r < 17; ++r) acc[r] = 0.f;
  for (int ks = 0; ks < 8; ++ks) {
    __syncthreads();
    for (int i = tid_(); i < 17 * 128; i += 256) {
      int r = i >> 7, e = i & 127;
      float v = r < 16 ? pc[r * D + ks * 128 + e] : pcc[ks * 128 + e];
      cs[r][e] = v / (1.f + expf(-v));
    }
    __syncthreads();
    const float* w = p.mod_w + ((size_t)layer * D + ks * 128) * 6144 + col;
#pragma unroll 4
    for (int e = 0; e < 128; ++e) {
      float wv = w[(size_t)e * 6144];
#pragma unroll
      for (int r = 0; r < 17; ++r) acc[r] += cs[r][e] * wv;
    }
  }
  const float bias = p.mod_b[layer * 6144 + col];
#pragma unroll
  for (int r = 0; r < 17; ++r) p.modv[((size_t)layer * 17 + r) * 6144 + col] = acc[r] + bias;
}

DEV void transpose_unit(const float* __restrict__ src, bf16_t* __restrict__ dst, int R, int C, int tile, char* smem) {
  float (*t)[65] = (float (*)[65])smem;
  const int nct = C / 64;
  const int tr = tile / nct, tc = tile % nct;
  __syncthreads();
  for (int i = tid_(); i < 4096; i += 256) { int r = i >> 6, c = i & 63; t[r][c] = src[(size_t)(tr * 64 + r) * C + tc * 64 + c]; }
  __syncthreads();
  for (int i = tid_(); i < 4096; i += 256) { int c = i >> 6, r = i & 63; dst[(size_t)(tc * 64 + c) * R + tr * 64 + r] = f2bf(t[r][c]); }
}

DEV void wfold_unit(const P& p, int layer, int unit, char* smem) {
  const int hs = unit >> 5, ec = unit & 31, h = hs >> 1, s = hs & 1;
  const float* wq = p.peer_wq + (size_t)layer * D * 2048;
  const float* kk = (s ? opq(p.peer_k2) : opq(p.peer_k1)) + ((size_t)layer * 8 + h) * 128 * 128;
  float (*kS)[65] = (float (*)[65])smem;
  float (*wS)[64] = (float (*)[64])(smem + 33280);
  const int key = tid_() & 127, eh = tid_() >> 7;
  float acc[16];
#pragma unroll
  for (int i = 0; i < 16; ++i) acc[i] = 0.f;
  for (int dh = 0; dh < 2; ++dh) {
    __syncthreads();
    for (int i = tid_(); i < 128 * 64; i += 256) { int k2 = i >> 6, d = i & 63; kS[k2][d] = kk[k2 * 128 + dh * 64 + d]; }
    for (int i = tid_(); i < 32 * 64; i += 256) {
      int e = i >> 6, d = i & 63;
      wS[e][d] = wq[(size_t)(ec * 32 + e) * 2048 + h * 256 + s * 128 + dh * 64 + d];
    }
    __syncthreads();
#pragma unroll 2
    for (int d = 0; d < 64; ++d) {
      float kv = kS[key][d];
#pragma unroll
      for (int i = 0; i < 16; ++i) acc[i] += kv * wS[eh * 16 + i][d];
    }
  }
  bf16_t* dst = p.Wft + ((size_t)(hs * 128 + key)) * D + ec * 32 + eh * 16;
#pragma unroll
  for (int i = 0; i < 16; i += 2) *(unsigned*)(dst + i) = pack2(acc[i], acc[i + 1]);
}

DEV void filt_unit(const P& p, int layer, int unit, char* smem) {
  int kind, j0, L;
  if (unit < 1024) { kind = 0; j0 = unit * 4; L = T; } else { kind = 1; j0 = (unit - 1024) * 4; L = LC; }
  float* zs = (float*)smem;
  float* h1 = zs + 4 * 36;
  float* h2 = h1 + 256;
  const int jj = tid_() >> 6, o = tid_() & 63;
  const int j = j0 + jj;
  const float fj = (float)j;
  const float t = fj / (float)(L - 1);
  __syncthreads();
  if (o < 33) {
    float z;
    if (o == 0) z = t;
    else {
      int i = (o - 1) & 15;
      float band = 1e-4f + (float)i * ((15.0f - 1e-4f) / 15.0f);
      float ang = 6.283185307179586f * fj * band / (float)L;
      z = (o <= 16) ? cosf(ang) : -sinf(ang);
    }
    zs[jj * 36 + o] = z;
  }
  __syncthreads();
  {
    const float* w1 = p.hy_w1 + layer * 33 * 64;
    float a = p.hy_b1[layer * 64 + o];
#pragma unroll 3
    for (int i = 0; i < 33; ++i) a += zs[jj * 36 + i] * w1[i * 64 + o];
    h1[jj * 64 + o] = sinf(p.hy_freq[layer * 128 + o] * a);
  }
  __syncthreads();
  {
    const float* w2 = p.hy_w2 + layer * 64 * 64;
    float a = p.hy_b2[layer * 64 + o];
#pragma unroll 4
    for (int i = 0; i < 64; ++i) a += h1[jj * 64 + i] * w2[i * 64 + o];
    h2[jj * 64 + o] = sinf(p.hy_freq[layer * 128 + 64 + o] * a);
  }
  __syncthreads();
  const float* w3 = p.hy_w3 + layer * 64 * 512;
  float* F = kind ? opq(p.FC) : opq(p.FL);
  const float DMIN = -3.0701134573253945f, DMAX = -15.350567286626973f;
#pragma unroll 1
  for (int m = 0; m < 4; ++m) {
    int c = o + 64 * m;
    float af = p.hy_b3[layer * 512 + c], ab = p.hy_b3[layer * 512 + 256 + c];
#pragma unroll 4
    for (int i = 0; i < 64; ++i) { float hv = h2[jj * 64 + i]; af += hv * w3[i * 512 + c]; ab += hv * w3[i * 512 + 256 + c]; }
    float delta = fabsf(DMIN + (float)c * ((DMAX - DMIN) / 255.f));
    float win = expf(-t * delta) + 0.05f;
    af *= win; ab *= win;
    F[((size_t)c * 2 + 0) * L + j] = af;
    F[((size_t)c * 2 + 1) * L + j] = ab;
  }
}

constexpr int PREP_T0 = 672, PREP_T1 = PREP_T0 + 256, PREP_T2 = PREP_T1 + 8, PREP_T3 = PREP_T2 + 8, PREP_T4 = PREP_T3 + 8;
constexpr int PREP_WF = PREP_T4 + 512, PREP_N = PREP_WF + 1088;
DEV void ph_prep(const P& p, int layer, char* smem) {
  for (int u = bid_(); u < PREP_N; u += gridDim.x) {
    if (u < PREP_T0) transpose_unit(p.w_in + (size_t)layer * D * INW, p.W1t, D, INW, u, smem);
    else if (u < PREP_T1) transpose_unit(p.w_out + (size_t)layer * D * D, p.W2t, D, D, u - PREP_T0, smem);
    else if (u < PREP_T3) {
      const int u0 = u - PREP_T1;
      for (int i = tid_(); i < 64 * 256; i += 256) {
        const int np = u0 * 64 + (i >> 8), kp = i & 255;
        const int q = np & 3, chan = np >> 2, qp = kp >> 6, kk = kp & 63;
        float v = 0.f;
        if (qp == q) v = (q < 2 ? opq(p.rw_w_up) : opq(p.rw_a_up))[(((size_t)layer * 2 + (q & 1)) * 64 + kk) * 256 + chan];
        p.Wlt[(size_t)np * 256 + kp] = f2bf(v);
      }
    }
    else if (u < PREP_T4) transpose_unit(p.rw_g_up + (size_t)layer * 128 * 256, p.Wgt, 128, 256, u - PREP_T3, smem);
    else if (u < PREP_WF) wfold_unit(p, layer, u - PREP_T4, smem);
    else filt_unit(p, layer, u - PREP_WF, smem);
  }
}

DEV void ph_norm(const P& p, int layer, int which) {
  const int gw = (bid_() * 256 + tid_()) >> 6, nw = gridDim.x * 4, lane = tid_() & 63;
  const float* g = (which ? p.norm2_g : p.norm1_g) + layer * D;
  for (int row = gw; row < NTOK; row += nw) {
    int b = row / LT, pp = row % LT;
    int mr = pp < LC ? 16 : b;
    const float* mv = p.modv + ((size_t)layer * 17 + mr) * 6144 + (which ? 3072 : 0);
    const bf16_t* xr = p.X + (size_t)row * D;
    uint4 u0 = *(const uint4*)(xr + 8 * lane), u1 = *(const uint4*)(xr + 512 + 8 * lane);
    float v[16];
    unpack8(u0, v); unpack8(u1, v + 8);
    float ss = 0.f;
#pragma unroll
    for (int i = 0; i < 16; ++i) ss += v[i] * v[i];
    ss = wave_sum(ss);
    float rstd = rsqrtf(ss * (1.f / 1024.f) + 1e-6f);
    float o[16];
#pragma unroll
    for (int hh = 0; hh < 2; ++hh)
#pragma unroll
      for (int i = 0; i < 8; ++i) {
        int col = hh * 512 + 8 * lane + i;
        float y = v[hh * 8 + i] * rstd * g[col];
        o[hh * 8 + i] = y * (1.f + mv[1024 + col]) + mv[col];
      }
    bf16_t* hr = p.H + (size_t)row * D;
    *(uint4*)(hr + 8 * lane) = pack8(o);
    *(uint4*)(hr + 512 + 8 * lane) = pack8(o + 8);
  }
}

DEV bool gemm_unit(int it, int nct, int& rt, int& ct) {
  const int nslot = gridDim.x >> 3;
  const int x = bid_() & 7, sl = bid_() >> 3;
  if (sl >= nslot) return false;
  const int v = it * nslot + sl;
  if (v >= 68 * nct) return false;
  const int rg = v / (8 * nct), rem = v - rg * 8 * nct;
  const int rows = (rg == 8) ? 4 : 8;
  ct = rem / rows;
  rt = x * 68 + rg * 8 + (rem - ct * rows);
  return true;
}
struct Epi1 {
  const P& p; int row0, col0;
  DEV void operator()(f32x4 (&acc)[4][4], int wr, int wc, int fr, int fq, char* smem) const {
    const int cw = col0 + wc * 64;
    const int rbase = row0 + wr * 64;
    const bool lat = (row0 % LT) >= LC;
    if (cw >= 1536 && cw < 1664) {
#pragma unroll
      for (int m = 0; m < 4; ++m)
#pragma unroll
        for (int n = 0; n < 4; ++n)
#pragma unroll
          for (int j = 0; j < 4; ++j) acc[m][n][j] = tanhf(acc[m][n][j]);
    } else if (cw >= 1792 && cw < 1920) {
#pragma unroll
      for (int m = 0; m < 4; ++m)
#pragma unroll
        for (int n = 0; n < 4; ++n)
#pragma unroll
          for (int j = 0; j < 4; ++j) acc[m][n][j] = sigmoidf_(acc[m][n][j]);
    } else if (cw >= 1920 && cw < 2560 && lat) {
#pragma unroll
      for (int m = 0; m < 4; ++m)
#pragma unroll
        for (int j = 0; j < 4; ++j) {
          int row = rbase + m * 16 + fq * 4 + j;
          int pl = (row % LT) - LC;
          int ri = pl >> 6, ci = pl & 63;
          float2 cr = *(const float2*)(p.rope + 2 * (ri * 16 + fr));
          float2 cc = *(const float2*)(p.rope + 2 * (ci * 16 + fr));
          float x1 = acc[m][0][j], x2 = acc[m][1][j];
          acc[m][0][j] = x1 * cr.x - x2 * cr.y; acc[m][1][j] = x2 * cr.x + x1 * cr.y;
          x1 = acc[m][2][j]; x2 = acc[m][3][j];
          acc[m][2][j] = x1 * cc.x - x2 * cc.y; acc[m][3][j] = x2 * cc.x + x1 * cc.y;
        }
    }
    const int wid = wr * 2 + wc, lane = fq * 16 + fr;
    stage_tile_bf16(acc, smem, wid, fr, fq);
    const bf16_t (*t)[72] = (const bf16_t (*)[72])(smem + wid * 9216);
#pragma unroll
    for (int i = 0; i < 8; ++i) {
      const int rl = i * 8 + (lane >> 3), ch = lane & 7;
      *(uint4*)(p.Z + (size_t)(rbase + rl) * INW + cw + ch * 8) = *(const uint4*)&t[rl][ch * 8];
    }
  }
};
DEV void ph_gemm1(const P& p, char* smem) {
  const int nct = INW / 128;
  int rt, ct;
  for (int it = 0; gemm_unit(it, nct, rt, ct); ++it) {
    Epi1 epi{p, rt * 128, ct * 128};
    gemm_tile(p.H + (size_t)rt * 128 * D, D, p.W1t + (size_t)ct * 128 * D, D, D, smem, epi);
  }
}

struct EpiLoraA {
  const P& p; int layer, row0, col0;
  DEV void operator()(f32x4 (&acc)[4][4], int wr, int wc, int fr, int fq, char* smem) const {
    const int q = fr & 3;
    const float scale = q < 2 ? 0.6065306597126334f : 1.f;
    const float* bias0 = (q < 2 ? opq(p.rw_w0) : opq(p.rw_a0)) + (layer * 2 + (q & 1)) * 256;
#pragma unroll
    for (int n = 0; n < 4; ++n) {
      const int chan = (col0 + wc * 64 + n * 16 + fr) >> 2;
      const float bias = bias0[chan];
#pragma unroll
      for (int m = 0; m < 4; ++m)
#pragma unroll
        for (int j = 0; j < 4; ++j) acc[m][n][j] = scale * sigmoidf_(acc[m][n][j] + bias);
    }
    const int wid = wr * 2 + wc, lane = fq * 16 + fr;
    stage_tile_bf16(acc, smem, wid, fr, fq);
    const bf16_t (*t)[72] = (const bf16_t (*)[72])(smem + wid * 9216);
#pragma unroll
    for (int i = 0; i < 8; ++i) {
      const int rl = i * 8 + (lane >> 3), ch = lane & 7;
      *(uint4*)(p.SC + (size_t)(row0 + wr * 64 + rl) * 1024 + col0 + wc * 64 + ch * 8) = *(const uint4*)&t[rl][ch * 8];
    }
  }
};
struct EpiLoraG {
  const P& p; int row0, col0;
  DEV void operator()(f32x4 (&acc)[4][4], int wr, int wc, int fr, int fq, char* smem) const {
    const int wid = wr * 2 + wc, lane = fq * 16 + fr;
    stage_tile_bf16(acc, smem, wid, fr, fq);
    const bf16_t (*t)[72] = (const bf16_t (*)[72])(smem + wid * 9216);
#pragma unroll
    for (int i = 0; i < 8; ++i) {
      const int rl = i * 8 + (lane >> 3), ch = lane & 7;
      *(uint4*)(p.Y + (size_t)(row0 + wr * 64 + rl) * D + 256 + col0 + wc * 64 + ch * 8) = *(const uint4*)&t[rl][ch * 8];
    }
  }
};
DEV void ph_lora(const P& p, int layer, char* smem) {
  int rt, ct;
  for (int it = 0; gemm_unit(it, 10, rt, ct); ++it) {
    if (ct < 8) {
      EpiLoraA epi{p, layer, rt * 128, ct * 128};
      gemm_tile(p.Z + (size_t)rt * 128 * INW + 1536, INW, p.Wlt + (size_t)ct * 128 * 256, 256, 256, smem, epi);
    } else {
      EpiLoraG epi{p, rt * 128, (ct - 8) * 128};
      gemm_tile(p.Z + (size_t)rt * 128 * INW + 1792, INW, p.Wgt + (size_t)(ct - 8) * 128 * 128, 128, 128, smem, epi);
    }
  }
}

DEV void ph_rwkv_prep(const P& p, int layer) {
  const int gw = (bid_() * 256 + tid_()) >> 6, nw = gridDim.x * 4, lane = tid_() & 63;
  const float* cw = p.conv_w + (size_t)layer * 3 * 1536;
  const float* cb = p.conv_b + (size_t)layer * 1536;
  for (int row = gw; row < NTOK; row += nw) {
    int pp = row % LT;
    bool hasm = (pp != 0) && (pp != LC);
    bool hasp = (pp != LC - 1) && (pp != LT - 1);
    float res[3][4];
#pragma unroll
    for (int a = 0; a < 3; ++a) {
      int col = 768 + a * 256 + 4 * lane;
      const bf16_t* zc = p.Z + (size_t)row * INW + col;
      uint2 um = hasm ? *(const uint2*)(zc - INW) : make_uint2(0, 0);
      uint2 uc = *(const uint2*)zc;
      uint2 up = hasp ? *(const uint2*)(zc + INW) : make_uint2(0, 0);
      float vm[4] = {bflo(um.x), bfhi(um.x), bflo(um.y), bfhi(um.y)};
      float vc[4] = {bflo(uc.x), bfhi(uc.x), bflo(uc.y), bfhi(uc.y)};
      float vp[4] = {bflo(up.x), bfhi(up.x), bflo(up.y), bfhi(up.y)};
#pragma unroll
      for (int i = 0; i < 4; ++i) res[a][i] = cw[col + i] * vm[i] + cw[1536 + col + i] * vc[i] + cw[3072 + col + i] * vp[i] + cb[col + i];
    }
    float kk[4], ss = 0.f;
#pragma unroll
    for (int i = 0; i < 4; ++i) { kk[i] = res[1][i] * p.rw_k_k[layer * 256 + 4 * lane + i]; ss += kk[i] * kk[i]; }
    ss = row16_sum(ss);
    float rs = rsqrtf(ss + 1e-12f);
    bf16_t* hr = p.H + (size_t)row * D + 16 * lane;
    *(uint4*)hr = make_uint4(pack2(res[0][0], res[1][0]), pack2(kk[0] * rs, res[2][0]), pack2(res[0][1], res[1][1]), pack2(kk[1] * rs, res[2][1]));
    *(uint4*)(hr + 8) = make_uint4(pack2(res[0][2], res[1][2]), pack2(kk[2] * rs, res[2][2]), pack2(res[0][3], res[1][3]), pack2(kk[3] * rs, res[2][3]));
  }
}

struct ScanRaw { uint2 h, s; };
struct ScanRegs { f32x2 A[4], W[4], B[4], K[4], R[4]; float v; };
DEV float oct_sum(float x) { x += dpp0<0xB1, 0xF>(x); x += dpp0<0x4E, 0xF>(x); x += dpp0<0x141, 0xF>(x); return x; }
DEV void scan_unit(const P& p, int layer, int unit, char* smem) {
  const int half = unit & 1, dir = (unit >> 1) & 1, h = (unit >> 2) & 3, b = unit >> 4;
  const int tid = tid_(), wid = tid >> 6, lane = tid & 63;
  const int k8 = lane & 7, vrow = half * 32 + wid * 8 + (lane >> 3);
  float* st = (float*)smem + wid * 768;
  const float ka = p.rw_k_a[layer * 256 + h * 64 + lane];
  f32x2 S[4];
#pragma unroll
  for (int i = 0; i < 4; ++i) S[i] = (f32x2){0.f, 0.f};
  const size_t rowbase = (size_t)b * LT;
  const bf16_t* hb = p.H + rowbase * 1024 + (h * 64 + lane) * 4;
  const bf16_t* sb = p.SC + rowbase * 1024 + (h * 64 + lane) * 4;
  bf16_t* yb = p.Z + rowbase * INW + 768 + dir * 256 + h * 64 + vrow;
  auto posf = [&](int t) -> int { return dir == 0 ? t : (t < LC ? LC - 1 - t : LT - 1 - (t - LC)); };
  auto load4 = [&](int c, ScanRaw (&dst)[4]) {
#pragma unroll
    for (int i = 0; i < 4; ++i) {
      size_t off = (size_t)posf(c * 4 + i) * 1024;
      dst[i].h = *(const uint2*)(hb + off); dst[i].s = *(const uint2*)(sb + off);
    }
  };
  auto stage = [&](const ScanRaw& x, int buf) {
    float rr = bflo(x.h.x), kr = bfhi(x.h.x), kkv = bflo(x.h.y), vv = bfhi(x.h.y);
    float ev = dir ? bfhi(x.s.x) : bflo(x.s.x), av = dir ? bfhi(x.s.y) : bflo(x.s.y);
    float w = __expf(-ev), ap = -kkv, bp = kkv * av, kd = kr * (1.f + (av - 1.f) * ka);
    float* q = st + buf * 384;
    q[lane] = ap; q[64 + lane] = w; q[128 + lane] = bp; q[192 + lane] = kd; q[256 + lane] = rr; q[320 + lane] = vv;
  };
  auto rd = [&](int buf, ScanRegs& g) {
    const float* q = st + buf * 384 + 8 * k8;
    float4 t0, t1;
    t0 = *(const float4*)q; t1 = *(const float4*)(q + 4);
    g.A[0] = (f32x2){t0.x, t0.y}; g.A[1] = (f32x2){t0.z, t0.w}; g.A[2] = (f32x2){t1.x, t1.y}; g.A[3] = (f32x2){t1.z, t1.w};
    t0 = *(const float4*)(q + 64); t1 = *(const float4*)(q + 68);
    g.W[0] = (f32x2){t0.x, t0.y}; g.W[1] = (f32x2){t0.z, t0.w}; g.W[2] = (f32x2){t1.x, t1.y}; g.W[3] = (f32x2){t1.z, t1.w};
    t0 = *(const float4*)(q + 128); t1 = *(const float4*)(q + 132);
    g.B[0] = (f32x2){t0.x, t0.y}; g.B[1] = (f32x2){t0.z, t0.w}; g.B[2] = (f32x2){t1.x, t1.y}; g.B[3] = (f32x2){t1.z, t1.w};
    t0 = *(const float4*)(q + 192); t1 = *(const float4*)(q + 196);
    g.K[0] = (f32x2){t0.x, t0.y}; g.K[1] = (f32x2){t0.z, t0.w}; g.K[2] = (f32x2){t1.x, t1.y}; g.K[3] = (f32x2){t1.z, t1.w};
    t0 = *(const float4*)(q + 256); t1 = *(const float4*)(q + 260);
    g.R[0] = (f32x2){t0.x, t0.y}; g.R[1] = (f32x2){t0.z, t0.w}; g.R[2] = (f32x2){t1.x, t1.y}; g.R[3] = (f32x2){t1.z, t1.w};
    g.v = st[buf * 384 + 320 + vrow];
  };
  auto compute = [&](const ScanRegs& g, int t) {
    f32x2 s2 = S[0] * g.A[0];
    s2 += S[1] * g.A[1]; s2 += S[2] * g.A[2]; s2 += S[3] * g.A[3];
    const float sa = oct_sum(s2[0] + s2[1]);
    const f32x2 sa2 = (f32x2){sa, sa}, vv2 = (f32x2){g.v, g.v};
#pragma unroll
    for (int i = 0; i < 4; ++i) S[i] = S[i] * g.W[i] + (sa2 * g.B[i] + vv2 * g.K[i]);
    f32x2 y2 = S[0] * g.R[0];
    y2 += S[1] * g.R[1]; y2 += S[2] * g.R[2]; y2 += S[3] * g.R[3];
    const float y = oct_sum(y2[0] + y2[1]);
    if (k8 == 0) yb[(size_t)posf(t) * INW] = f2bf(y);
  };
  constexpr int NC = LT / 4;
  ScanRaw R0[4], R1[4], R2[4], R3[4];
  ScanRegs g0, g1;
  auto chunk = [&](ScanRaw (&Rc)[4], ScanRaw (&Rn)[4], int t0, bool hasnext) {
    stage(Rc[1], 1); rd(1, g1); compute(g0, t0);
    stage(Rc[2], 0); rd(0, g0); compute(g1, t0 + 1);
    stage(Rc[3], 1); rd(1, g1); compute(g0, t0 + 2);
    if (hasnext) { stage(Rn[0], 0); rd(0, g0); }
    compute(g1, t0 + 3);
  };
  __builtin_amdgcn_s_setprio(3);
  load4(0, R0); load4(1, R1); load4(2, R2);
  stage(R0[0], 0);
  rd(0, g0);
#pragma unroll 1
  for (int c = 0; c < NC; c += 4) {
    load4(c + 3, R3);
    chunk(R0, R1, c * 4, true);
    const bool more = (c + 4 < NC);
    if (more) load4(c + 4, R0);
    chunk(R1, R2, c * 4 + 4, true);
    if (more) load4(c + 5, R1);
    chunk(R2, R3, c * 4 + 8, true);
    if (more) load4(c + 6, R2);
    chunk(R3, R0, c * 4 + 12, more);
  }
  __builtin_amdgcn_s_setprio(0);
}

DEV bf16x8 frag_join(uint2 lo, uint2 hi) { uint4 w = make_uint4(lo.x, lo.y, hi.x, hi.y); return __builtin_bit_cast(bf16x8, w); }
DEV void scanc_unit(const P& p, int layer, int unit, char* smem) {
  const int dir = unit & 1, h = (unit >> 1) & 3, b = unit >> 3;
  const int tid = tid_(), w = tid >> 6, lane = tid & 63, fr = lane & 15, fq = lane >> 4;
  bf16_t (*At)[72] = (bf16_t (*)[72])(smem);
  bf16_t (*Rt)[72] = (bf16_t (*)[72])(smem + 2304);
  bf16_t (*Bt)[72] = (bf16_t (*)[72])(smem + 4608);
  bf16_t (*Kt)[72] = (bf16_t (*)[72])(smem + 6912);
  bf16_t (*BKT)[40] = (bf16_t (*)[40])(smem + 9216);
  bf16_t (*VV)[16] = (bf16_t (*)[16])(smem + 14336);
  float* G16 = (float*)(smem + 16384);
  bf16_t* IMG0 = (bf16_t*)(smem + 16640);
  bf16_t* IMG1 = (bf16_t*)(smem + 20864);
  bf16_t* IMG2 = (bf16_t*)(smem + 21888);
  bf16_t* TT = (bf16_t*)(smem + 17792);
  bf16_t* ARK = (bf16_t*)(smem + 18816);
  bf16_t* AAK = (bf16_t*)(smem + 19840);
  __syncthreads();
  for (int i = tid; i < 1568; i += 256) ((unsigned*)IMG0)[i] = 0u;
  const float ka = p.rw_k_a[layer * 256 + h * 64 + lane];
  const size_t rowbase = (size_t)b * LT;
  const bf16_t* hb = p.H + rowbase * 1024 + (h * 64 + lane) * 4;
  const bf16_t* sb = p.SC + rowbase * 1024 + (h * 64 + lane) * 4;
  bf16_t* yb = p.Z + rowbase * INW + 768 + dir * 256 + h * 64 + w * 16 + fr;
  auto posf = [&](int t) -> int { return dir == 0 ? t : (t < LC ? LC - 1 - t : LT - 1 - (t - LC)); };
  uint2 sc[16], hr[4];
  auto load_raw = [&](int c) {
#pragma unroll
    for (int i = 0; i < 16; ++i) sc[i] = *(const uint2*)(sb + (size_t)posf(c * 16 + i) * 1024);
#pragma unroll
    for (int q = 0; q < 4; ++q) hr[q] = *(const uint2*)(hb + (size_t)posf(c * 16 + w * 4 + q) * 1024);
  };
  f32x4 acc[4];
#pragma unroll
  for (int kt = 0; kt < 4; ++kt) acc[kt] = (f32x4){0.f, 0.f, 0.f, 0.f};
  load_raw(0);
#pragma unroll 1
  for (int c = 0; c < LT / 16; ++c) {
    {
      float Erun = 0.f;
#pragma unroll
      for (int i = 0; i < 16; ++i) {
        const float ev = dir ? bfhi(sc[i].x) : bflo(sc[i].x);
        const float Eprev = Erun;
        Erun += ev;
        if ((i >> 2) == w) {
          const uint2 hrec = hr[i & 3];
          const float rr = bflo(hrec.x), kr = bfhi(hrec.x), kkv = bflo(hrec.y);
          const float av = dir ? bfhi(sc[i].y) : bflo(sc[i].y);
          const float gp = __expf(-Eprev), gi = __expf(-Erun), ig = __expf(Erun);
          const float at = -kkv * gp, rt = rr * gi, bt = kkv * av * ig, kt2 = kr * (1.f + (av - 1.f) * ka) * ig;
          const unsigned ar = pack2(at, rt), bk = pack2(bt, kt2);
          At[i][lane] = (bf16_t)(ar & 0xFFFFu); Rt[i][lane] = (bf16_t)(ar >> 16);
          Bt[i][lane] = (bf16_t)(bk & 0xFFFFu); Kt[i][lane] = (bf16_t)(bk >> 16);
          BKT[lane][(i >> 2) * 8 + (i & 3)] = (bf16_t)(bk & 0xFFFFu);
          BKT[lane][(i >> 2) * 8 + 4 + (i & 3)] = (bf16_t)(bk >> 16);
          VV[lane][(i >> 2) * 4 + (i & 3)] = (bf16_t)(hrec.y >> 16);
          if (i == 15) G16[lane] = gi;
        }
      }
    }
    if (c + 1 < LT / 16) load_raw(c + 1);
    __syncthreads();
    {
      const bf16_t (*X)[72] = (w < 2) ? At : Rt;
      const bf16_t (*Y)[72] = (w & 1) ? Kt : Bt;
      f32x4 cm = (f32x4){0.f, 0.f, 0.f, 0.f};
#pragma unroll
      for (int s = 0; s < 2; ++s) {
        bf16x8 af = *(const bf16x8*)&X[fr][32 * s + 8 * fq];
        bf16x8 bm = *(const bf16x8*)&Y[fr][32 * s + 8 * fq];
        cm = mfma16(af, bm, cm);
      }
#pragma unroll
      for (int jj = 0; jj < 4; ++jj) {
        const int i = 4 * fq + jj;
        const bool keep = (w < 2) ? (fr < i) : (fr <= i);
        cm[jj] = keep ? cm[jj] : 0.f;
      }
      const int io = (fr >> 2) * 8 + (fr & 3);
      auto wr_img = [&](bf16_t* img, const f32x4& Xv, int hi) {
#pragma unroll
        for (int jj = 0; jj < 4; ++jj) img[(4 * fq + jj) * 32 + io + hi] = f2bf(Xv[jj]);
      };
      if (w == 1) wr_img(AAK, cm, 0);
      else if (w == 2) wr_img(ARK, cm, 0);
      else if (w == 3) wr_img(ARK, cm, 4);
      else {
        auto bfrag = [&](const f32x4& Xv) { return frag_join(make_uint2(pack2(Xv[0], Xv[1]), pack2(Xv[2], Xv[3])), make_uint2(0u, 0u)); };
        auto afr = [&](const bf16_t* img) { return *(const bf16x8*)&img[(fr * 4 + fq) * 8]; };
        const f32x4 Z4 = (f32x4){0.f, 0.f, 0.f, 0.f};
        wr_img(IMG0, cm, 0);
        asm volatile("" ::: "memory");
        f32x4 A2 = mfma16(afr(IMG0), bfrag(cm), Z4);
        wr_img(IMG1, A2, 0);
        asm volatile("" ::: "memory");
        f32x4 A4 = mfma16(afr(IMG1), bfrag(A2), Z4);
        wr_img(IMG2, A4, 0);
        asm volatile("" ::: "memory");
        f32x4 Rm = mfma16(afr(IMG2), bfrag(A4), Z4);
#pragma unroll
        for (int jj = 0; jj < 4; ++jj) Rm[jj] += (fr == 4 * fq + jj) ? 1.f : 0.f;
        Rm = mfma16(afr(IMG2), bfrag(Rm), Rm);
        Rm = mfma16(afr(IMG1), bfrag(Rm), Rm);
        Rm = mfma16(afr(IMG0), bfrag(Rm), Rm);
        wr_img(TT, Rm, 0);
      }
    }
    __syncthreads();
    {
      bf16x8 Sb[2];
#pragma unroll
      for (int s = 0; s < 2; ++s) {
        uint4 t = make_uint4(pack2(acc[2 * s][0], acc[2 * s][1]), pack2(acc[2 * s][2], acc[2 * s][3]),
                             pack2(acc[2 * s + 1][0], acc[2 * s + 1][1]), pack2(acc[2 * s + 1][2], acc[2 * s + 1][3]));
        Sb[s] = __builtin_bit_cast(bf16x8, t);
      }
      const uint2 vv = *(const uint2*)&VV[w * 16 + fr][fq * 4];
      const bf16x8 Vlow = frag_join(vv, make_uint2(0u, 0u));
      f32x4 P = (f32x4){0.f, 0.f, 0.f, 0.f};
#pragma unroll
      for (int s = 0; s < 2; ++s) {
        bf16x8 af = frag_join(*(const uint2*)&At[fr][32 * s + 4 * fq], *(const uint2*)&At[fr][32 * s + 16 + 4 * fq]);
        P = mfma16(af, Sb[s], P);
      }
      P = mfma16(*(const bf16x8*)&AAK[(fr * 4 + fq) * 8], Vlow, P);
      const bf16x8 Pb = frag_join(make_uint2(pack2(P[0], P[1]), pack2(P[2], P[3])), make_uint2(0u, 0u));
      f32x4 U = mfma16(*(const bf16x8*)&TT[(fr * 4 + fq) * 8], Pb, (f32x4){0.f, 0.f, 0.f, 0.f});
      const bf16x8 UV = frag_join(make_uint2(pack2(U[0], U[1]), pack2(U[2], U[3])), vv);
      f32x4 Yv = (f32x4){0.f, 0.f, 0.f, 0.f};
#pragma unroll
      for (int s = 0; s < 2; ++s) {
        bf16x8 af = frag_join(*(const uint2*)&Rt[fr][32 * s + 4 * fq], *(const uint2*)&Rt[fr][32 * s + 16 + 4 * fq]);
        Yv = mfma16(af, Sb[s], Yv);
      }
      Yv = mfma16(*(const bf16x8*)&ARK[(fr * 4 + fq) * 8], UV, Yv);
#pragma unroll
      for (int jj = 0; jj < 4; ++jj) yb[(size_t)posf(c * 16 + 4 * fq + jj) * INW] = f2bf(Yv[jj]);
#pragma unroll
      for (int kt = 0; kt < 4; ++kt) {
        f32x4 t = mfma16(*(const bf16x8*)&BKT[16 * kt + fr][fq * 8], UV, acc[kt]);
        const float4 g4 = *(const float4*)&G16[16 * kt + 4 * fq];
        t[0] *= g4.x; t[1] *= g4.y; t[2] *= g4.z; t[3] *= g4.w;
        acc[kt] = t;
      }
    }
    __syncthreads();
  }
}

DEV void ph_rwkv_post(const P& p, int layer) {
  const int gw = (bid_() * 256 + tid_()) >> 6, nw = gridDim.x * 4, lane = tid_() & 63;
  for (int row = gw; row < NTOK; row += nw) {
    const int ch = 4 * lane;
    const bf16_t* zr = p.Z + (size_t)row * INW + 768 + ch;
    uint2 y0u = *(const uint2*)zr, y1u = *(const uint2*)(zr + 256);
    float y[4] = {bflo(y0u.x) + bflo(y1u.x), bfhi(y0u.x) + bfhi(y1u.x), bflo(y0u.y) + bflo(y1u.y), bfhi(y0u.y) + bfhi(y1u.y)};
    float mu = row16_sum(y[0] + y[1] + y[2] + y[3]) * (1.f / 64.f);
    float vs = 0.f;
#pragma unroll
    for (int i = 0; i < 4; ++i) { y[i] -= mu; vs += y[i] * y[i]; }
    float var = row16_sum(vs) * (1.f / 64.f);
    float rstd = rsqrtf(var + 64e-5f);
    const bf16_t* hr = p.H + (size_t)row * D + 4 * ch;
    uint4 h0 = *(const uint4*)hr, h1 = *(const uint4*)(hr + 8);
    const bf16_t* sr = p.SC + (size_t)row * 1024 + 4 * ch;
    uint4 s0 = *(const uint4*)sr, s1 = *(const uint4*)(sr + 8);
    float r[4] = {bflo(h0.x), bflo(h0.z), bflo(h1.x), bflo(h1.z)};
    float k[4] = {bfhi(h0.x), bfhi(h0.z), bfhi(h1.x), bfhi(h1.z)};
    float v[4] = {bfhi(h0.y), bfhi(h0.w), bfhi(h1.y), bfhi(h1.w)};
    float a0[4] = {bflo(s0.y), bflo(s0.w), bflo(s1.y), bflo(s1.w)};
    float a1[4] = {bfhi(s0.y), bfhi(s0.w), bfhi(s1.y), bfhi(s1.w)};
    float sd = 0.f;
#pragma unroll
    for (int i = 0; i < 4; ++i) {
      float kav = p.rw_k_a[layer * 256 + ch + i], rk = p.rw_r_k[layer * 256 + ch + i];
      float kd0 = k[i] * (1.f + (a0[i] - 1.f) * kav), kd1 = k[i] * (1.f + (a1[i] - 1.f) * kav);
      sd += r[i] * (kd0 + kd1) * rk;
    }
    sd = row16_sum(sd);
    bf16_t* yr = p.Y + (size_t)row * D + 256 + ch;
    uint2 gu = *(const uint2*)yr;
    float g[4] = {bflo(gu.x), bfhi(gu.x), bflo(gu.y), bfhi(gu.y)};
    float o[4];
#pragma unroll
    for (int i = 0; i < 4; ++i) {
      float yn = y[i] * rstd * p.rw_ln_w[layer * 256 + ch + i] + p.rw_ln_b[layer * 256 + ch + i];
      o[i] = (yn + sd * v[i]) * g[i];
#if !EN_RW
      o[i] = 0.f;
#endif
    }
    *(uint2*)yr = make_uint2(pack2(o[0], o[1]), pack2(o[2], o[3]));
  }
}

DEV void hyena_pre_unit(const P& p, int layer, int unit) {
  int kind, b, t0, L;
  if (unit < 1024) { kind = 0; b = unit >> 6; t0 = (unit & 63) * 64; L = T; } else { int u = unit - 1024; kind = 1; b = u >> 2; t0 = (u & 3) * 64; L = LC; }
  const int c = tid_();
  const size_t row0 = (size_t)b * LT + (kind ? 0 : LC);
  const float* cw = p.conv_w + (size_t)layer * 3 * 1536;
  const float* cb = p.conv_b + (size_t)layer * 1536;
  const float w1a = cw[256 + c], w1b = cw[1536 + 256 + c], w1c = cw[3072 + 256 + c], b1 = cb[256 + c];
  const float w2a = cw[512 + c], w2b = cw[1536 + 512 + c], w2c = cw[3072 + 512 + c], b2 = cb[512 + c];
  auto ld = [&](int t, int col) -> float { return (t >= 0 && t < L) ? bf2f(p.Z[(row0 + t) * INW + col]) : 0.f; };
  float x1m = ld(t0 - 1, 256 + c), x1c = ld(t0, 256 + c), vm = ld(t0 - 1, 512 + c), vc = ld(t0, 512 + c);
  bf16_t* dst = (kind ? opq(p.UTc) : opq(p.UTl)) + ((size_t)c * 16 + b) * L + t0;
#pragma unroll 1
  for (int i8 = 0; i8 < 8; ++i8) {
    float uo[8];
#pragma unroll
    for (int i = 0; i < 8; ++i) {
      int t = t0 + i8 * 8 + i;
      float x1n = ld(t + 1, 256 + c), vn = ld(t + 1, 512 + c);
      float a = w1a * x1m + w1b * x1c + w1c * x1n + b1;
      float bb = w2a * vm + w2b * vc + w2c * vn + b2;
      uo[i] = a * bb;
      x1m = x1c; x1c = x1n; vm = vc; vc = vn;
    }
    *(uint4*)(dst + 8 * i8) = pack8(uo);
  }
}

DEV void hyena_conv_unit(const P& p, int layer, int unit, char* smem) {
  int kind, c, tb, L;
  if (unit < 4096) { kind = 0; c = unit >> 4; tb = (unit & 15) * 256; L = T; } else { kind = 1; c = unit - 4096; tb = 0; L = LC; }
  const int tid = tid_(), lane = tid & 63, wid = tid >> 6, fr = lane & 15, fq = lane >> 4;
  float* red = (float*)(smem + 2 * 16512);
  const float* F = (kind ? opq(p.FC) : opq(p.FL)) + (size_t)c * 2 * L;
  float scale;
  {
    float part = 0.f;
    for (int i = tid; i < 2 * L; i += 256) { float fv = F[i]; part += (i != L) ? fv * fv : 0.f; }
    part = wave_sum(part);
    __syncthreads();
    if (lane == 0) red[wid] = part;
    __syncthreads();
    scale = rsqrtf(((red[0] + red[1]) + (red[2] + red[3])) + 1e-6f);
  }
  const bf16_t* U = (kind ? opq(p.UTc) : opq(p.UTl)) + (size_t)c * 16 * L;
  f32x4 acc[4];
#pragma unroll
  for (int m = 0; m < 4; ++m) acc[m] = (f32x4){0.f, 0.f, 0.f, 0.f};
  const int nch = L / 256;
  float fw0, fw1, fw2;
  uint4 ru0, ru1;
  auto ldchunk = [&](int ch) {
    const int sc = ch * 256;
    const int D0 = tb + 256 - sc;
    auto tap = [&](int n) -> float {
      int d = D0 - n;
      float v = 0.f;
      if (d > -L && d < L) v = (d >= 0 ? F[d] : F[L - d]);
      return v;
    };
    fw0 = tap(tid); fw1 = tap(tid + 256); fw2 = (tid < 8) ? tap(tid + 512) : 0.f;
    const int bb = tid >> 4, sg0 = tid & 15;
    ru0 = *(const uint4*)(U + (size_t)bb * L + sc + 8 * sg0);
    ru1 = *(const uint4*)(U + (size_t)bb * L + sc + 8 * (sg0 + 16));
  };
  auto stchunk = [&](int buf) {
    bf16_t* Cq = (bf16_t*)(smem + buf * 16512);
    bf16_t* Us = (bf16_t*)(smem + buf * 16512 + 8320);
    const bf16_t h0 = f2bf(fw0 * scale), h1 = f2bf(fw1 * scale), h2 = f2bf(fw2 * scale);
#pragma unroll
    for (int rho = 0; rho < 8; ++rho) {
      int m = tid + rho;
      Cq[((m >> 3) * 8 + rho) * 8 + (m & 7)] = h0;
      m = tid + 256 + rho;
      if (m < 520) Cq[((m >> 3) * 8 + rho) * 8 + (m & 7)] = h1;
      m = tid + 512 + rho;
      if (tid < 8 && m < 520) Cq[((m >> 3) * 8 + rho) * 8 + (m & 7)] = h2;
    }
    if (tid < 8) {
#pragma unroll
      for (int rho = 1; rho < 8; ++rho) if (tid < rho) Cq[(rho) * 8 + tid] = 0;
    }
    const int bb = tid >> 4, sg0 = tid & 15;
    *(uint4*)&Us[(sg0 * 16 + bb) * 8] = ru0;
    *(uint4*)&Us[((sg0 + 16) * 16 + bb) * 8] = ru1;
  };
  ldchunk(0);
#pragma unroll 1
  for (int ch = 0; ch < nch; ++ch) {
    const int buf = ch & 1;
    stchunk(buf);
    __syncthreads();
    if (ch + 1 < nch) ldchunk(ch + 1);
    const bf16_t* Cq = (const bf16_t*)(smem + buf * 16512);
    const bf16_t* Us = (const bf16_t*)(smem + buf * 16512 + 8320);
#pragma unroll
    for (int kk = 0; kk < 8; ++kk) {
      bf16x8 bf = *(const bf16x8*)&Us[((4 * kk + fq) * 16 + fr) * 8];
#pragma unroll
      for (int m = 0; m < 4; ++m) {
        int it = wid * 4 + m;
        int base = 256 - 16 * it + 32 * kk + 8 * fq;
        int m0 = base - 8 * (fr >> 3);
        bf16x8 af = *(const bf16x8*)&Cq[((m0 >> 3) * 8 + (fr & 7)) * 8];
        acc[m] = mfma16(af, bf, acc[m]);
      }
    }
  }
  __syncthreads();
  bf16_t* Yt = (kind ? opq(p.YTc) : opq(p.YTl)) + ((size_t)c * 16 + fr) * L + tb;
#pragma unroll
  for (int m = 0; m < 4; ++m) {
    int t = (wid * 4 + m) * 16 + fq * 4;
    *(uint2*)(Yt + t) = make_uint2(pack2(acc[m][0], acc[m][1]), pack2(acc[m][2], acc[m][3]));
  }
}

DEV void hyena_post_unit(const P& p, int layer, int unit, char* smem) {
  int kind, b, t0, L;
  if (unit < 1024) { kind = 0; b = unit >> 6; t0 = (unit & 63) * 64; L = T; } else { int u = unit - 1024; kind = 1; b = u >> 2; t0 = (u & 3) * 64; L = LC; }
  const int c = tid_(), lane = c & 63, wid = c >> 6;
  const size_t row0 = (size_t)b * LT + (kind ? 0 : LC);
  bf16_t (*tile)[264] = (bf16_t (*)[264])smem;
  const float* cw = p.conv_w + (size_t)layer * 3 * 1536;
  const float wa = cw[c], wb = cw[1536 + c], wcc = cw[3072 + c], b0 = p.conv_b[layer * 1536 + c];
  const float bias = p.hy_bias[layer * 256 + c];
  const bf16_t* yt = (kind ? opq(p.YTc) : opq(p.YTl)) + ((size_t)c * 16 + b) * L + t0;
  const bf16_t* ut = (kind ? opq(p.UTc) : opq(p.UTl)) + ((size_t)c * 16 + b) * L + t0;
  auto ld = [&](int t) -> float { return (t >= 0 && t < L) ? bf2f(p.Z[(row0 + t) * INW + c]) : 0.f; };
  float xm = ld(t0 - 1), xc = ld(t0);
  __syncthreads();
#pragma unroll 1
  for (int i8 = 0; i8 < 8; ++i8) {
    uint4 yu = *(const uint4*)(yt + 8 * i8), uu = *(const uint4*)(ut + 8 * i8);
    float yv[8], uv[8];
    unpack8(yu, yv); unpack8(uu, uv);
#pragma unroll
    for (int i = 0; i < 8; ++i) {
      int t = t0 + i8 * 8 + i;
      float xn = ld(t + 1);
      float x0 = wa * xm + wb * xc + wcc * xn + b0;
      float o = x0 * (yv[i] + uv[i] * bias);
      tile[i8 * 8 + i][c] = f2bf(o);
      xm = xc; xc = xn;
    }
  }
  __syncthreads();
  for (int i = 0; i < 16; ++i) {
    int tl = wid * 16 + i;
    uint2 ou = *(const uint2*)&tile[tl][4 * lane];
    float o[4] = {bflo(ou.x), bfhi(ou.x), bflo(ou.y), bfhi(ou.y)};
    float ss = wave_sum(o[0] * o[0] + o[1] * o[1] + o[2] * o[2] + o[3] * o[3]);
    float rstd = rsqrtf(ss * (1.f / 256.f) + 1e-6f);
#pragma unroll
    for (int q = 0; q < 4; ++q) {
      o[q] = o[q] * rstd * p.hy_out_g[layer * 256 + 4 * lane + q];
#if !EN_HY
      o[q] = 0.f;
#endif
    }
    *(uint2*)(p.Y + (row0 + t0 + tl) * D + 4 * lane) = make_uint2(pack2(o[0], o[1]), pack2(o[2], o[3]));
  }
}

DEV void attn_unit(const P& p, int layer, int unit, char* smem) {
  const bool isctx = unit >= 4096;
  int b, qb, hq;
  if (!isctx) { b = unit >> 8; qb = (unit >> 3) & 31; hq = unit & 7; } else { int u = unit - 4096; b = u >> 4; qb = (u >> 3) & 1; hq = u & 7; }
  const int g = hq >> 2;
  const int tid = tid_(), lane = tid & 63, wid = tid >> 6, qn = lane & 31, hh = lane >> 5;
  const int qpos = qb * 128 + wid * 32 + qn;
  const size_t qrow = (size_t)b * LT + (isctx ? qpos : LC + qpos);
  const bf16_t* qptr = p.Z + qrow * INW + 1920 + hq * 64;
  bf16x8 qf[4];
#pragma unroll
  for (int s = 0; s < 4; ++s) qf[s] = *(const bf16x8*)(qptr + 16 * s + 8 * hh);
  const float sink = p.attn_sink[layer * 8 + hq];
  float m_run = sink, l_run = 1.f;
  f32x16 o0, o1;
#pragma unroll
  for (int i = 0; i < 16; ++i) { o0[i] = 0.f; o1[i] = 0.f; }
  typedef bf16_t KTile[64][72];
  KTile* Ks = (KTile*)smem;
  KTile* Vt = (KTile*)(smem + 18432);
  const int ntl = isctx ? 0 : 6;
  const int ntiles = ntl + 4;
  const int skey = tid >> 3, sseg = tid & 7;
  const bf16_t* kvbase = p.Z + (size_t)b * LT * INW + 1920 + 512 + g * 64 + sseg * 8;
  uint4 rk0, rk1, rv0, rv1;
  auto ldtile = [&](int kt) {
    const bool ctxk = kt >= ntl;
    const int kbase = ctxk ? (kt - ntl) * 64 : qb * 128 - 128 + kt * 64;
    const int kp0 = kbase + skey, kp1 = kp0 + 32;
    rk0 = rk1 = rv0 = rv1 = make_uint4(0, 0, 0, 0);
    if (ctxk || (kp0 >= 0 && kp0 < T)) { const bf16_t* src = kvbase + (size_t)(ctxk ? kp0 : LC + kp0) * INW; rk0 = *(const uint4*)src; rv0 = *(const uint4*)(src + 128); }
    if (ctxk || (kp1 >= 0 && kp1 < T)) { const bf16_t* src = kvbase + (size_t)(ctxk ? kp1 : LC + kp1) * INW; rk1 = *(const uint4*)src; rv1 = *(const uint4*)(src + 128); }
  };
  auto sttile = [&](int buf) {
    *(uint4*)&Ks[buf][skey][sseg * 8] = rk0;
    *(uint4*)&Ks[buf][skey + 32][sseg * 8] = rk1;
    bf16_t (*vt)[72] = Vt[buf];
    vt[sseg * 8 + 0][skey] = (bf16_t)(rv0.x & 0xFFFF); vt[sseg * 8 + 1][skey] = (bf16_t)(rv0.x >> 16);
    vt[sseg * 8 + 2][skey] = (bf16_t)(rv0.y & 0xFFFF); vt[sseg * 8 + 3][skey] = (bf16_t)(rv0.y >> 16);
    vt[sseg * 8 + 4][skey] = (bf16_t)(rv0.z & 0xFFFF); vt[sseg * 8 + 5][skey] = (bf16_t)(rv0.z >> 16);
    vt[sseg * 8 + 6][skey] = (bf16_t)(rv0.w & 0xFFFF); vt[sseg * 8 + 7][skey] = (bf16_t)(rv0.w >> 16);
    vt[sseg * 8 + 0][skey + 32] = (bf16_t)(rv1.x & 0xFFFF); vt[sseg * 8 + 1][skey + 32] = (bf16_t)(rv1.x >> 16);
    vt[sseg * 8 + 2][skey + 32] = (bf16_t)(rv1.y & 0xFFFF); vt[sseg * 8 + 3][skey + 32] = (bf16_t)(rv1.y >> 16);
    vt[sseg * 8 + 4][skey + 32] = (bf16_t)(rv1.z & 0xFFFF); vt[sseg * 8 + 5][skey + 32] = (bf16_t)(rv1.z >> 16);
    vt[sseg * 8 + 6][skey + 32] = (bf16_t)(rv1.w & 0xFFFF); vt[sseg * 8 + 7][skey + 32] = (bf16_t)(rv1.w >> 16);
  };
  ldtile(0);
#pragma unroll 1
  for (int kt = 0; kt < ntiles; ++kt) {
    const int buf = kt & 1;
    sttile(buf);
    __syncthreads();
    if (kt + 1 < ntiles) ldtile(kt + 1);
    const bool ctxk = kt >= ntl;
    const int kbase = ctxk ? (kt - ntl) * 64 : qb * 128 - 128 + kt * 64;
#pragma unroll
    for (int sub = 0; sub < 2; ++sub) {
      const int kb2 = kbase + sub * 32;
      bool need = true;
      if (!ctxk) {
        int q0 = qb * 128 + wid * 32;
        if (kb2 + 31 < q0 - 128 || kb2 > q0 + 31 + 128 || kb2 + 31 < 0 || kb2 >= T) need = false;
      }
      if (need) {
        f32x16 sv;
#pragma unroll
        for (int i = 0; i < 16; ++i) sv[i] = 0.f;
#pragma unroll
        for (int ks = 0; ks < 4; ++ks) {
          bf16x8 kf = *(const bf16x8*)&Ks[buf][sub * 32 + qn][16 * ks + 8 * hh];
          sv = mfma32(kf, qf[ks], sv);
        }
        float mt = -3e38f;
#pragma unroll
        for (int rg = 0; rg < 16; ++rg) {
          float v = sv[rg] * 0.125f;
          if (!ctxk) {
            int kp = kb2 + (rg & 3) + 8 * (rg >> 2) + 4 * hh;
            int dl = qpos - kp;
            bool ok = (dl <= 128) && (dl >= -128) && (kp >= 0) && (kp < T);
            v = ok ? v : -1e30f;
          }
          sv[rg] = v;
          mt = fmaxf(mt, v);
        }
        mt = fmaxf(mt, __shfl_xor(mt, 32));
        float m_new = fmaxf(m_run, mt);
        float corr = __expf(m_run - m_new);
        float ps = 0.f;
#pragma unroll
        for (int rg = 0; rg < 16; ++rg) { float pv = __expf(sv[rg] - m_new); sv[rg] = pv; ps += pv; }
        ps += __shfl_xor(ps, 32);
        l_run = l_run * corr + ps;
        m_run = m_new;
#pragma unroll
        for (int i = 0; i < 16; ++i) { o0[i] *= corr; o1[i] *= corr; }
#pragma unroll
        for (int sp = 0; sp < 2; ++sp) {
          bf16x8 pf;
#pragma unroll
          for (int j = 0; j < 8; ++j) pf[j] = (short)f2bf(sv[8 * sp + j]);
          const int kc = sub * 32 + 16 * sp + 4 * hh;
          uint2 va = *(const uint2*)&Vt[buf][qn][kc], vb = *(const uint2*)&Vt[buf][qn][kc + 8];
          uint2 vc = *(const uint2*)&Vt[buf][32 + qn][kc], vd = *(const uint2*)&Vt[buf][32 + qn][kc + 8];
          uint4 w0 = make_uint4(va.x, va.y, vb.x, vb.y), w1 = make_uint4(vc.x, vc.y, vd.x, vd.y);
          bf16x8 v0 = __builtin_bit_cast(bf16x8, w0), v1 = __builtin_bit_cast(bf16x8, w1);
          o0 = mfma32(v0, pf, o0);
          o1 = mfma32(v1, pf, o1);
        }
      }
    }
  }
  __syncthreads();
  const float inv = 1.f / l_run;
  bf16_t* optr = p.Y + qrow * D + 512 + hq * 64;
#pragma unroll
  for (int rg = 0; rg < 4; ++rg) {
    int d0 = 8 * rg + 4 * hh;
    *(uint2*)(optr + d0) = make_uint2(pack2(o0[4 * rg] * inv, o0[4 * rg + 1] * inv), pack2(o0[4 * rg + 2] * inv, o0[4 * rg + 3] * inv));
    *(uint2*)(optr + 32 + d0) = make_uint2(pack2(o1[4 * rg] * inv, o1[4 * rg + 1] * inv), pack2(o1[4 * rg + 2] * inv, o1[4 * rg + 3] * inv));
  }
}

DEV void ph_attn_post(const P& p, int layer) {
  const int gw = (bid_() * 256 + tid_()) >> 6, nw = gridDim.x * 4, lane = tid_() & 63;
  for (int row = gw; row < NTOK; row += nw) {
    bf16_t* yr = p.Y + (size_t)row * D + 512 + 8 * lane;
    uint4 u = *(const uint4*)yr;
    float v[8];
    unpack8(u, v);
    float ss = 0.f;
#pragma unroll
    for (int i = 0; i < 8; ++i) ss += v[i] * v[i];
    ss = wave_sum(ss);
    float rstd = rsqrtf(ss * (1.f / 512.f) + 1e-6f);
#pragma unroll
    for (int i = 0; i < 8; ++i) {
      v[i] = v[i] * rstd * p.at_out_g[layer * 512 + 8 * lane + i];
#if !EN_AT
      v[i] = 0.f;
#endif
    }
    *(uint4*)yr = pack8(v);
  }
}

struct Epi2 {
  const P& p; int layer, row0, col0;
  DEV void operator()(f32x4 (&acc)[4][4], int wr, int wc, int fr, int fq, char* smem) const {
    const int b = row0 / LT, pp = row0 % LT;
    const int mr = pp < LC ? 16 : b;
    const float* g1 = p.modv + ((size_t)layer * 17 + mr) * 6144 + 2048 + col0 + wc * 64;
#pragma unroll
    for (int n = 0; n < 4; ++n) {
      const float gv = g1[n * 16 + fr];
#pragma unroll
      for (int m = 0; m < 4; ++m)
#pragma unroll
        for (int j = 0; j < 4; ++j) acc[m][n][j] *= gv;
    }
    const int wid = wr * 2 + wc, lane = fq * 16 + fr;
    stage_tile_bf16(acc, smem, wid, fr, fq);
    const bf16_t (*t)[72] = (const bf16_t (*)[72])(smem + wid * 9216);
#pragma unroll
    for (int i = 0; i < 8; ++i) {
      const int rl = i * 8 + (lane >> 3), ch = lane & 7;
      bf16_t* xp = p.X + (size_t)(row0 + wr * 64 + rl) * D + col0 + wc * 64 + ch * 8;
      float xv[8], dv[8];
      uint4 xu = *(const uint4*)xp, du = *(const uint4*)&t[rl][ch * 8];
      unpack8(xu, xv); unpack8(du, dv);
#pragma unroll
      for (int q = 0; q < 8; ++q) xv[q] += dv[q];
#if EN_MIX
      *(uint4*)xp = pack8(xv);
#endif
    }
  }
};
DEV void ph_gemm2(const P& p, int layer, char* smem) {
  int rt, ct;
  for (int it = 0; gemm_unit(it, 8, rt, ct); ++it) {
    Epi2 epi{p, layer, rt * 128, ct * 128};
    gemm_tile(p.Y + (size_t)rt * 128 * D, D, p.W2t + (size_t)ct * 128 * D, D, D, smem, epi);
  }
}

DEV void ph_peerconv(const P& p, int layer) {
  const int gw = (bid_() * 256 + tid_()) >> 6, nw = gridDim.x * 4, lane = tid_() & 63;
  const float* su = opq(p.peer_u) + (size_t)layer * 16384 * 1024;
  const float* sv = opq(p.peer_v) + (size_t)layer * 16384 * 1024;
  unsigned char* pu = opq(p.PU); unsigned char* pv = opq(p.PV);
  float* psu = opq(p.PSU); float* psv = opq(p.PSV);
#pragma unroll 1
  for (int r = gw; r < 32768; r += nw) {
    const bool isv = r >= 16384;
    const int e = r & 16383;
    const float* src = (isv ? sv : su) + (size_t)e * 1024 + 16 * lane;
    float4 f0 = *(const float4*)src, f1 = *(const float4*)(src + 4), f2 = *(const float4*)(src + 8), f3 = *(const float4*)(src + 12);
    float am = fmaxf(fmaxf(fmaxf(fabsf(f0.x), fabsf(f0.y)), fmaxf(fabsf(f0.z), fabsf(f0.w))), fmaxf(fmaxf(fabsf(f1.x), fabsf(f1.y)), fmaxf(fabsf(f1.z), fabsf(f1.w))));
    am = fmaxf(am, fmaxf(fmaxf(fmaxf(fabsf(f2.x), fabsf(f2.y)), fmaxf(fabsf(f2.z), fabsf(f2.w))), fmaxf(fmaxf(fabsf(f3.x), fabsf(f3.y)), fmaxf(fabsf(f3.z), fabsf(f3.w)))));
    am = wave_max(am);
    const float sc = am > 0.f ? 224.f / am : 1.f;
    int w0 = __builtin_amdgcn_cvt_pk_fp8_f32(f0.x * sc, f0.y * sc, 0, false); w0 = __builtin_amdgcn_cvt_pk_fp8_f32(f0.z * sc, f0.w * sc, w0, true);
    int w1 = __builtin_amdgcn_cvt_pk_fp8_f32(f1.x * sc, f1.y * sc, 0, false); w1 = __builtin_amdgcn_cvt_pk_fp8_f32(f1.z * sc, f1.w * sc, w1, true);
    int w2 = __builtin_amdgcn_cvt_pk_fp8_f32(f2.x * sc, f2.y * sc, 0, false); w2 = __builtin_amdgcn_cvt_pk_fp8_f32(f2.z * sc, f2.w * sc, w2, true);
    int w3 = __builtin_amdgcn_cvt_pk_fp8_f32(f3.x * sc, f3.y * sc, 0, false); w3 = __builtin_amdgcn_cvt_pk_fp8_f32(f3.z * sc, f3.w * sc, w3, true);
    *(uint4*)((isv ? pv : pu) + (size_t)(lane >> 3) * PSLICE + (size_t)e * 128 + 16 * (lane & 7)) = make_uint4((unsigned)w0, (unsigned)w1, (unsigned)w2, (unsigned)w3);
    if (lane == 0) (isv ? psv : psu)[e] = am > 0.f ? am * (1.f / 224.f) : 1.f;
  }
}
DEV void unpack16_fp8x2(const uint4& u, f32x2* f) {
  f[0] = __builtin_amdgcn_cvt_pk_f32_fp8((int)u.x, false); f[1] = __builtin_amdgcn_cvt_pk_f32_fp8((int)u.x, true);
  f[2] = __builtin_amdgcn_cvt_pk_f32_fp8((int)u.y, false); f[3] = __builtin_amdgcn_cvt_pk_f32_fp8((int)u.y, true);
  f[4] = __builtin_amdgcn_cvt_pk_f32_fp8((int)u.z, false); f[5] = __builtin_amdgcn_cvt_pk_f32_fp8((int)u.z, true);
  f[6] = __builtin_amdgcn_cvt_pk_f32_fp8((int)u.w, false); f[7] = __builtin_amdgcn_cvt_pk_f32_fp8((int)u.w, true);
}
DEV void unpack16_fp8(const uint4& u, float* f) {
  f32x2 t;
  t = __builtin_amdgcn_cvt_pk_f32_fp8((int)u.x, false); f[0] = t[0]; f[1] = t[1];
  t = __builtin_amdgcn_cvt_pk_f32_fp8((int)u.x, true); f[2] = t[0]; f[3] = t[1];
  t = __builtin_amdgcn_cvt_pk_f32_fp8((int)u.y, false); f[4] = t[0]; f[5] = t[1];
  t = __builtin_amdgcn_cvt_pk_f32_fp8((int)u.y, true); f[6] = t[0]; f[7] = t[1];
  t = __builtin_amdgcn_cvt_pk_f32_fp8((int)u.z, false); f[8] = t[0]; f[9] = t[1];
  t = __builtin_amdgcn_cvt_pk_f32_fp8((int)u.z, true); f[10] = t[0]; f[11] = t[1];
  t = __builtin_amdgcn_cvt_pk_f32_fp8((int)u.w, false); f[12] = t[0]; f[13] = t[1];
  t = __builtin_amdgcn_cvt_pk_f32_fp8((int)u.w, true); f[14] = t[0]; f[15] = t[1];
}

struct Epi3 {
  const P& p; int row0, grp;
  DEV void operator()(f32x4 (&acc)[4][4], int wr, int wc, int fr, int fq, char* smem) const {
    float* sc = (float*)smem;
    const int tid = tid_();
    for (int pass = 0; pass < 2; ++pass) {
      __syncthreads();
      if (wr == pass) {
#pragma unroll
        for (int m = 0; m < 4; ++m)
#pragma unroll
          for (int n = 0; n < 4; ++n)
#pragma unroll
            for (int j = 0; j < 4; ++j) {
              int rl = m * 16 + fq * 4 + j, col = wc * 64 + n * 16 + fr;
              unsigned bits = (__float_as_uint(acc[m][n][j]) & ~127u) | (unsigned)col;
              sc[rl * 133 + (col >> 5) * 33 + (col & 31)] = __uint_as_float(bits);
            }
      }
      __syncthreads();
      const int rl = tid >> 2, q = tid & 3;
      float Ls[16];
#pragma unroll
      for (int i = 0; i < 16; ++i) Ls[i] = -3e38f;
      const float* src = sc + rl * 133 + q * 33;
      for (int i = 0; i < 32; ++i) {
        float x = src[i];
        if (x > Ls[15]) {
#pragma unroll
          for (int k = 0; k < 16; ++k) { float hi = fmaxf(Ls[k], x); x = fminf(Ls[k], x); Ls[k] = hi; }
        }
      }
      float Cs[16];
#pragma unroll
      for (int i = 0; i < 16; ++i) Cs[i] = fmaxf(Ls[i], dppself<0xB1, 0xF>(Ls[15 - i]));
#pragma unroll
      for (int d = 8; d >= 1; d >>= 1)
#pragma unroll
        for (int i = 0; i < 16; ++i)
          if ((i & d) == 0) { float hi = fmaxf(Cs[i], Cs[i + d]), lo = fminf(Cs[i], Cs[i + d]); Cs[i] = hi; Cs[i + d] = lo; }
      float Ds[16];
#pragma unroll
      for (int i = 0; i < 16; ++i) Ds[i] = fmaxf(Cs[i], dppself<0x4E, 0xF>(Cs[15 - i]));
#pragma unroll
      for (int d = 8; d >= 1; d >>= 1)
#pragma unroll
        for (int i = 0; i < 16; ++i)
          if ((i & d) == 0) { float hi = fmaxf(Ds[i], Ds[i + d]), lo = fminf(Ds[i], Ds[i + d]); Ds[i] = hi; Ds[i + d] = lo; }
      if (q == 0) {
        float* dst = p.TK + ((size_t)(row0 + pass * 64 + rl) * 16 + grp) * 16;
#pragma unroll
        for (int i = 0; i < 4; ++i) *(float4*)(dst + 4 * i) = make_float4(Ds[4 * i], Ds[4 * i + 1], Ds[4 * i + 2], Ds[4 * i + 3]);
      }
    }
  }
};
DEV void ph_gemm3(const P& p, char* smem) {
  int rt, ct;
  for (int it = 0; gemm_unit(it, 16, rt, ct); ++it) {
    Epi3 epi{p, rt * 128, ct};
    gemm_tile(p.H + (size_t)rt * 128 * D, D, p.Wft + (size_t)ct * 128 * D, D, D, smem, epi);
  }
}

DEV float peer_gate(float scr) {
  float mx = row16_max(scr);
  float ex = __expf(scr - mx);
  float sm = row16_sum(ex);
  return ex / sm;
}
DEV float gelu_exact(float x) { return 0.5f * x * (1.f + erff(x * 0.7071067811865476f)); }

DEV void ph_peer_select(const P& p) {
  const int gw = (bid_() * 256 + tid_()) >> 6, nw = gridDim.x * 4, lane = tid_() & 63;
  int ci, cj;
  {
    const int c = lane;
    if (c < 16) { ci = 0; cj = c; } else if (c < 24) { ci = 1; cj = c - 16; } else if (c < 29) { ci = 2; cj = c - 24; }
    else if (c < 33) { ci = 3; cj = c - 29; } else if (c < 36) { ci = 4; cj = c - 33; } else if (c < 38) { ci = 5; cj = c - 36; }
    else if (c < 40) { ci = 6; cj = c - 38; } else if (c < 42) { ci = 7; cj = c - 40; } else { ci = (c - 42 + 8) & 15; cj = 0; }
  }
  const bool cand = lane < 50;
  float v1s[8], v2s[8];
  auto ldtk = [&](int row) {
    const float* tk = p.TK + (size_t)row * 256;
#pragma unroll
    for (int h = 0; h < 8; ++h) { v1s[h] = tk[(2 * h) * 16 + ci]; v2s[h] = tk[(2 * h + 1) * 16 + cj]; }
  };
  if (gw < NTOK) ldtk(gw);
#pragma unroll 1
  for (int row = gw; row < NTOK; row += nw) {
    float c1[8], c2[8];
#pragma unroll
    for (int h = 0; h < 8; ++h) { c1[h] = v1s[h]; c2[h] = v2s[h]; }
    if (row + nw < NTOK) ldtk(row + nw);
#pragma unroll
    for (int h = 0; h < 8; ++h) {
      const float v1 = c1[h], v2 = c2[h];
      float val = v1 + v2;
      val = __uint_as_float((__float_as_uint(val) & ~63u) | (unsigned)lane);
      val = cand ? val : -3e38f;
      int rank = 0;
#pragma unroll
      for (int q = 0; q < 50; ++q) rank += (readlane_f(val, q) > val) ? 1 : 0;
      const bool sel = cand && rank < 16;
      const float mx = wave_max(val);
      const float ex = sel ? __expf(val - mx) : 0.f;
      const float sm = wave_sum(ex);
      if (sel) {
        const int e = (int)(__float_as_uint(v1) & 127u) * 128 + (int)(__float_as_uint(v2) & 127u);
        p.EL[(size_t)row * 128 + h * 16 + rank] = (unsigned short)e;
        p.GT[(size_t)row * 128 + h * 16 + rank] = ex / sm;
      }
    }
  }
}

struct PeerPre { uint4 e0, e1, a0, a1, a2, a3; };
DEV unsigned peer_eid(const PeerPre& s, int j) {
  const unsigned w = (j < 8) ? ((j >> 1) == 0 ? s.e0.x : (j >> 1) == 1 ? s.e0.y : (j >> 1) == 2 ? s.e0.z : s.e0.w)
                             : (((j - 8) >> 1) == 0 ? s.e1.x : ((j - 8) >> 1) == 1 ? s.e1.y : ((j - 8) >> 1) == 2 ? s.e1.z : s.e1.w);
  return (j & 1) ? (w >> 16) : (w & 0xFFFFu);
}
template <int WHICH>
DEV void peer_wave_run(const P& p, int layer, int x, int tok0, int lane, float* wbuf) {
  const int r = lane >> 3, c = lane & 7;
  const unsigned char* tb = (WHICH == 0 ? p.PU : p.PV) + (size_t)x * PSLICE + c * 16;
  PeerPre S[3];
  uint4 R[2][16];
  auto ld_pre = [&](int tok, PeerPre& s) {
    const uint4* elp = (const uint4*)(p.EL + (size_t)tok * 128 + r * 16);
    s.e0 = elp[0]; s.e1 = elp[1];
    if (WHICH == 0) {
      const bf16_t* hr = p.H + (size_t)tok * D + x * 128 + c * 16;
      s.a0 = *(const uint4*)hr; s.a1 = *(const uint4*)(hr + 8);
    } else {
      const uint4* wtp = (const uint4*)(p.GT + (size_t)tok * 128 + r * 16);
      s.a0 = wtp[0]; s.a1 = wtp[1]; s.a2 = wtp[2]; s.a3 = wtp[3];
    }
  };
  auto issue = [&](const PeerPre& s, uint4 (&rows)[16]) {
#pragma unroll
    for (int j = 0; j < 16; ++j) rows[j] = *(const uint4*)(tb + (size_t)peer_eid(s, j) * 128);
  };
  auto comp = [&](int tok, const PeerPre& s, const uint4 (&rows)[16]) {
    if (WHICH == 0) {
      float hv[16];
      unpack8(s.a0, hv); unpack8(s.a1, hv + 8);
      f32x2 hv2[8];
#pragma unroll
      for (int i = 0; i < 8; ++i) hv2[i] = (f32x2){hv[2 * i], hv[2 * i + 1]};
      float keep0 = 0.f, keep1 = 0.f;
#pragma unroll
      for (int j = 0; j < 16; ++j) {
        f32x2 f[8];
        unpack16_fp8x2(rows[j], f);
        f32x2 d2 = f[0] * hv2[0];
#pragma unroll
        for (int i = 1; i < 8; ++i) d2 += f[i] * hv2[i];
        const float d = oct_sum(d2[0] + d2[1]);
        if (j < 8) keep0 = (c == j) ? d : keep0; else keep1 = (c == j - 8) ? d : keep1;
      }
      float* pd = p.PD + ((size_t)x * NTOK + tok) * 128 + r * 16 + c;
      pd[0] = keep0; pd[8] = keep1;
    } else {
      const float wsv[16] = {__uint_as_float(s.a0.x), __uint_as_float(s.a0.y), __uint_as_float(s.a0.z), __uint_as_float(s.a0.w),
                             __uint_as_float(s.a1.x), __uint_as_float(s.a1.y), __uint_as_float(s.a1.z), __uint_as_float(s.a1.w),
                             __uint_as_float(s.a2.x), __uint_as_float(s.a2.y), __uint_as_float(s.a2.z), __uint_as_float(s.a2.w),
                             __uint_as_float(s.a3.x), __uint_as_float(s.a3.y), __uint_as_float(s.a3.z), __uint_as_float(s.a3.w)};
      f32x2 acc2[8];
#pragma unroll
      for (int i = 0; i < 8; ++i) acc2[i] = (f32x2){0.f, 0.f};
#pragma unroll
      for (int j = 0; j < 16; ++j) {
        f32x2 f[8];
        unpack16_fp8x2(rows[j], f);
        const f32x2 w2 = (f32x2){wsv[j], wsv[j]};
#pragma unroll
        for (int i = 0; i < 8; ++i) acc2[i] += w2 * f[i];
      }
      float* slab = wbuf + (r * 8 + c) * 16;
      *(float4*)(slab) = make_float4(acc2[0][0], acc2[0][1], acc2[1][0], acc2[1][1]);
      *(float4*)(slab + 4) = make_float4(acc2[2][0], acc2[2][1], acc2[3][0], acc2[3][1]);
      *(float4*)(slab + 8) = make_float4(acc2[4][0], acc2[4][1], acc2[5][0], acc2[5][1]);
      *(float4*)(slab + 12) = make_float4(acc2[6][0], acc2[6][1], acc2[7][0], acc2[7][1]);
      asm volatile("s_waitcnt lgkmcnt(0)" ::: "memory");
      float o0 = 0.f, o1 = 0.f;
#pragma unroll
      for (int rr = 0; rr < 8; ++rr) {
        const float2 t = *(const float2*)(wbuf + (rr * 8 + (lane >> 3)) * 16 + 2 * (lane & 7));
        o0 += t.x; o1 += t.y;
      }
      asm volatile("s_waitcnt lgkmcnt(0)" ::: "memory");
      const int b = tok / LT, pp = tok % LT;
      const int mr = pp < LC ? 16 : b;
      const int col = x * 128 + 2 * lane;
      const float* g2 = p.modv + ((size_t)layer * 17 + mr) * 6144 + 5120 + col;
      unsigned* xp = (unsigned*)(p.X + (size_t)tok * D + col);
      const unsigned xu = *xp;
#if EN_PEER
      *xp = pack2(bflo(xu) + g2[0] * o0, bfhi(xu) + g2[1] * o1);
#endif
    }
  };
  ld_pre(tok0, S[0]);
  ld_pre(tok0 + 1, S[1]);
  issue(S[0], R[0]);
  ld_pre(tok0 + 2, S[2]);
#pragma unroll
  for (int t = 0; t < 8; ++t) {
    if (t + 1 < 8) issue(S[(t + 1) % 3], R[(t + 1) & 1]);
    comp(tok0 + t, S[t % 3], R[t & 1]);
    if (t + 3 < 8) ld_pre(tok0 + t + 3, S[t % 3]);
  }
}
DEV void ph_peer_w(const P& p) {
  for (size_t i = (size_t)bid_() * 256 + tid_(); i < (size_t)NTOK * 128; i += (size_t)gridDim.x * 256) {
    float d = 0.f;
#pragma unroll
    for (int x = 0; x < 8; ++x) d += p.PD[(size_t)x * NTOK * 128 + i];
    const int e = p.EL[i];
    p.GT[i] = p.GT[i] * gelu_exact(d * p.PSU[e]) * p.PSV[e];
  }
}
template <int WHICH>
DEV void ph_peer_gather(const P& p, int layer, char* smem, volatile LAS unsigned* slot) {
  const int tid = tid_(), lane = tid & 63, wid = tid >> 6;
  unsigned* q = p.wq + 1024 + layer * 256 + WHICH * 128;
  const int my = (int)(xb_xcc_id() & 7u);
  float* wbuf = (float*)smem + wid * 1024;
#pragma unroll 1
  for (int rot = 0; rot < 8; ++rot) {
    const int x = (my + rot) & 7;
    for (;;) {
      __syncthreads();
      if (tid == 0) *slot = atomicAdd(q + x * 16, 1u);
      __syncthreads();
      const int it = (int)*slot;
      if (it >= NTOK / 32) break;
      peer_wave_run<WHICH>(p, layer, x, it * 32 + wid * 8, lane, wbuf);
    }
  }
}

DEV void ph_final(const P& p) {
  const int gw = (bid_() * 256 + tid_()) >> 6, nw = gridDim.x * 4, lane = tid_() & 63;
  for (int r = gw; r < NB * T; r += nw) {
    int b = r / T, t = r % T;
    const bf16_t* xr = p.X + ((size_t)b * LT + LC + t) * D;
    uint4 u0 = *(const uint4*)(xr + 8 * lane), u1 = *(const uint4*)(xr + 512 + 8 * lane);
    float v[16];
    unpack8(u0, v); unpack8(u1, v + 8);
    float ss = 0.f;
#pragma unroll
    for (int i = 0; i < 16; ++i) ss += v[i] * v[i];
    ss = wave_sum(ss);
    float rstd = rsqrtf(ss * (1.f / 1024.f) + 1e-6f);
    float* o = p.out + (size_t)r * D;
#pragma unroll
    for (int hh = 0; hh < 2; ++hh) {
      int col = hh * 512 + 8 * lane;
      float4 a = make_float4(v[hh * 8 + 0] * rstd * p.final_g[col + 0], v[hh * 8 + 1] * rstd * p.final_g[col + 1], v[hh * 8 + 2] * rstd * p.final_g[col + 2], v[hh * 8 + 3] * rstd * p.final_g[col + 3]);
      float4 c = make_float4(v[hh * 8 + 4] * rstd * p.final_g[col + 4], v[hh * 8 + 5] * rstd * p.final_g[col + 5], v[hh * 8 + 6] * rstd * p.final_g[col + 6], v[hh * 8 + 7] * rstd * p.final_g[col + 7]);
      *(float4*)(o + col) = a; *(float4*)(o + col + 4) = c;
    }
  }
}

DEV unsigned hw_cu_key() {
  const unsigned hwid = (unsigned)__builtin_amdgcn_s_getreg(((8 - 1) << 11) | (8 << 6) | 4);
  return (xb_xcc_id() << 8) | (hwid & 0xFFu);
}
DEV void mixB(const P& p, int layer, char* smem, volatile LAS unsigned* slot) {
  unsigned* qa = p.wq + layer * 64;
  unsigned* qs = qa + 16;
  unsigned* claim = p.cuclaim + layer * 4096;
  __syncthreads();
  if (tid_() == 0) {
    unsigned u = 0xFFFFFFFFu;
    if (atomicAdd(&claim[hw_cu_key() & 4095u], 1u) == 0u) u = atomicAdd(qs, 1u);
    *slot = u;
  }
  __syncthreads();
  {
    const unsigned u = *slot;
    if (u < 128u) scanc_unit(p, layer, (int)u, smem);
  }
  for (;;) {
    __syncthreads();
    if (tid_() == 0) *slot = atomicAdd(qa, 1u);
    __syncthreads();
    const int u = (int)*slot;
    if (u >= 8704) break;
    if (u < 4352) attn_unit(p, layer, u, smem); else hyena_conv_unit(p, layer, u - 4352, smem);
  }
  for (;;) {
    __syncthreads();
    if (tid_() == 0) *slot = atomicAdd(qs, 1u);
    __syncthreads();
    const unsigned u = *slot;
    if (u >= 128u) break;
    scanc_unit(p, layer, (int)u, smem);
  }
}
DEV void mixA(const P& p, int layer, char* smem) {
  for (int u = bid_(); u < 1088; u += gridDim.x) hyena_pre_unit(p, layer, u);
  ph_lora(p, layer, smem);
  ph_rwkv_prep(p, layer);
}
DEV void mixC(const P& p, int layer, char* smem) {
  for (int u = bid_(); u < 1088; u += gridDim.x) hyena_post_unit(p, layer, u, smem);
  ph_rwkv_post(p, layer);
  ph_attn_post(p, layer);
}

__global__ void __launch_bounds__(256, 2) k_mega(P p) {
  extern __shared__ __attribute__((aligned(16))) char smem_all[];
  char* smem = smem_all;
  volatile LAS unsigned* xbw = (volatile LAS unsigned*)(smem_all + SMEM_BYTES);
  if (threadIdx.x == 0) { xbw[0] = 0u; xbw[1] = 0u; xbw[2] = 0u; xbw[3] = 0u; }
  __syncthreads();
  XcdBarrier bar = xcd_barrier_post(p.bar, xbw);
#ifndef NO_PRO
  ph_copy(p);
  ph_rope(p);
  for (int u = blockIdx.x; u < 96; u += gridDim.x) modv_unit(p, u, smem);
#endif
#ifndef NO_PREP
  ph_prep(p, 0, smem);
#endif
  xcd_barrier(bar);
  for (int layer = 0; layer < NLAYERS; ++layer) {
#ifndef NO_NORM
    ph_norm(p, layer, 0);
#endif
    xcd_barrier(bar);
#ifdef PROBE_GEMM
    ph_gemm1(p, smem);
#endif
#ifndef NO_GEMM1
    ph_gemm1(p, smem);
#endif
    xcd_barrier(bar);
#ifndef NO_MIXA
    mixA(p, layer, smem);
#endif
    xcd_barrier(bar);
#ifndef NO_MIXB
    mixB(p, layer, smem, (volatile LAS unsigned*)(smem_all + SMEM_BYTES + 16));
#endif
    xcd_barrier(bar);
#ifndef NO_MIXC
    mixC(p, layer, smem);
#endif
    xcd_barrier(bar);
#ifndef NO_GEMM2
    ph_gemm2(p, layer, smem);
    ph_peerconv(p, layer);
#endif
    xcd_barrier(bar);
#ifndef NO_NORM
    ph_norm(p, layer, 1);
#endif
    xcd_barrier(bar);
#ifdef PROBE_GEMM
    ph_gemm3(p, smem);
#endif
#ifndef NO_GEMM3
    ph_gemm3(p, smem);
#endif
    xcd_barrier(bar);
    ph_peer_select(p);
    xcd_barrier(bar);
    ph_peer_gather<0>(p, layer, smem, (volatile LAS unsigned*)(smem_all + SMEM_BYTES + 16));
    xcd_barrier(bar);
    ph_peer_w(p);
    xcd_barrier(bar);
    ph_peer_gather<1>(p, layer, smem, (volatile LAS unsigned*)(smem_all + SMEM_BYTES + 16));
#ifndef NO_PREP
    if (layer + 1 < NLAYERS) ph_prep(p, layer + 1, smem);
#endif
    xcd_barrier(bar);
  }
  ph_final(p);
}

static inline size_t al256(size_t x) { return (x + 255) & ~(size_t)255; }

extern "C" void kernel_launch(void* const* d_in, const int* in_sizes, int n_in, void* d_out, int out_size, void* d_ws, size_t ws_size,
                              hipStream_t stream) {
  (void)in_sizes; (void)n_in; (void)out_size; (void)ws_size;
  P p{};
  const float** f = (const float**)&p;
  for (int i = 0; i < 39; ++i) f[i] = (const float*)d_in[i];
  p.out = (float*)d_out;
  char* w = (char*)d_ws;
  size_t off = 0;
  auto take = [&](size_t bytes) { char* r = w + off; off += al256(bytes); return r; };
  p.bar = (unsigned*)take(16384);
  p.modv = (float*)take((size_t)DEPTH * 17 * 6144 * 4);
  p.SSQ = (float*)take((size_t)DEPTH * 2 * 256 * 4);
  p.wq = (unsigned*)take(4096 + DEPTH * 1024);
  p.cuclaim = (unsigned*)take((size_t)DEPTH * 4096 * 4);
  const size_t zero_bytes = off;
  p.rope = (float*)take(64 * 16 * 2 * 4);
  p.X = (bf16_t*)take((size_t)NTOK * D * 2);
  p.H = (bf16_t*)take((size_t)NTOK * D * 2);
  p.Y = (bf16_t*)take((size_t)NTOK * D * 2);
  p.SC = (bf16_t*)take((size_t)NTOK * 1024 * 2);
  p.Z = (bf16_t*)take((size_t)NTOK * INW * 2);
  p.UTl = (bf16_t*)take((size_t)256 * 16 * T * 2);
  p.UTc = (bf16_t*)take((size_t)256 * 16 * LC * 2);
  p.YTl = (bf16_t*)take((size_t)256 * 16 * T * 2);
  p.YTc = (bf16_t*)take((size_t)256 * 16 * LC * 2);
  p.FL = (float*)take((size_t)256 * 2 * T * 4);
  p.FC = (float*)take((size_t)256 * 2 * LC * 4);
  p.W1t = (bf16_t*)take((size_t)INW * D * 2);
  p.W2t = (bf16_t*)take((size_t)D * D * 2);
  p.Wft = (bf16_t*)take((size_t)2048 * D * 2);
  p.Wlt = (bf16_t*)take((size_t)1024 * 256 * 2);
  p.Wgt = (bf16_t*)take((size_t)256 * 128 * 2);
  p.TK = (float*)p.Z;
  p.PU = (unsigned char*)p.Z + al256((size_t)NTOK * 256 * 4);
  p.PV = p.PU + (size_t)16384 * 1024;
  p.PSU = (float*)(p.PV + (size_t)16384 * 1024);
  p.PSV = p.PSU + 16384;
  p.GT = p.PSV + 16384;
  p.EL = (unsigned short*)(p.GT + (size_t)NTOK * 128);
  p.PD = (float*)p.Y;

  (void)hipMemsetAsync(d_ws, 0, zero_bytes, stream);
  constexpr size_t kDynLds = SMEM_BYTES + 32;
  static int grid = 0;
  if (!grid) {
    int dev = 0, cus = 0, per_cu = 0;
    (void)hipGetDevice(&dev);
    (void)hipDeviceGetAttribute(&cus, hipDeviceAttributeMultiprocessorCount, dev);
    (void)hipFuncSetAttribute((const void*)k_mega, hipFuncAttributeMaxDynamicSharedMemorySize, (int)kDynLds);
    (void)hipOccupancyMaxActiveBlocksPerMultiprocessor(&per_cu, k_mega, 256, kDynLds);
    if (cus <= 0) cus = 256;
    if (per_cu > 2) per_cu = 2;
    if (per_cu < 1) per_cu = 1;
    grid = cus * per_cu;
  }
  k_mega<<<grid, 256, kDynLds, stream>>>(p);
}
```

```cpp
#include <hip/hip_runtime.h>
#include <stdint.h>

#define DEV __device__ __forceinline__
typedef unsigned short bf16_t;
typedef short bf16x8 __attribute__((ext_vector_type(8)));
typedef float f32x2 __attribute__((ext_vector_type(2)));
constexpr size_t PSLICE = (size_t)16384 * 128;
typedef float f32x4 __attribute__((ext_vector_type(4)));
typedef float f32x16 __attribute__((ext_vector_type(16)));

#ifndef NLAYERS
#define NLAYERS 4
#endif
#ifndef EN_HY
#define EN_HY 1
#endif
#ifndef EN_RW
#define EN_RW 1
#endif
#ifndef EN_AT
#define EN_AT 1
#endif
#ifndef EN_MIX
#define EN_MIX 1
#endif
#ifndef EN_PEER
#define EN_PEER 1
#endif

constexpr int NB = 16, T = 4096, LC = 256, LT = 4352, D = 1024, NTOK = NB * LT, INW = 2688, DEPTH = 4;
constexpr int SMEM_BYTES = 65536;

struct P {
  const float *x, *c, *ctx, *c_ctx, *mod_w, *mod_b, *norm1_g, *norm2_g, *w_in, *conv_w, *conv_b;
  const float *hy_w1, *hy_b1, *hy_w2, *hy_b2, *hy_w3, *hy_b3, *hy_freq, *hy_bias;
  const float *rw_w0, *rw_w_up, *rw_a0, *rw_a_up, *rw_g_up, *rw_k_k, *rw_k_a, *rw_r_k, *rw_ln_w, *rw_ln_b;
  const float *attn_sink, *hy_out_g, *at_out_g, *w_out, *peer_wq, *peer_k1, *peer_k2, *peer_u, *peer_v, *final_g;
  float* out;
  unsigned* bar;
  float *modv, *SSQ, *rope, *FL, *FC, *TK;
  unsigned *wq, *cuclaim;
  bf16_t *X, *H, *Y, *SC, *Z, *UTl, *UTc, *YTl, *YTc;
  bf16_t *W1t, *W2t, *Wft, *Wlt, *Wgt;
  unsigned char *PU, *PV;
  float *PSU, *PSV, *GT, *PD;
  unsigned short* EL;
};

typedef __bf16 hwbf2 __attribute__((ext_vector_type(2)));
DEV unsigned pack2(float a, float b) { f32x2 f = {a, b}; hwbf2 r = __builtin_convertvector(f, hwbf2); return __builtin_bit_cast(unsigned, r); }
DEV bf16_t f2bf(float f) { return (bf16_t)(pack2(f, 0.f) & 0xFFFFu); }
DEV float bf2f(bf16_t h) { return __uint_as_float(((unsigned)h) << 16); }
DEV float bflo(unsigned u) { return __uint_as_float(u << 16); }
DEV float bfhi(unsigned u) { return __uint_as_float(u & 0xFFFF0000u); }
DEV void unpack8(const uint4& u, float* v) {
  v[0] = bflo(u.x); v[1] = bfhi(u.x); v[2] = bflo(u.y); v[3] = bfhi(u.y);
  v[4] = bflo(u.z); v[5] = bfhi(u.z); v[6] = bflo(u.w); v[7] = bfhi(u.w);
}
DEV uint4 pack8(const float* v) { return make_uint4(pack2(v[0], v[1]), pack2(v[2], v[3]), pack2(v[4], v[5]), pack2(v[6], v[7])); }
DEV float sigmoidf_(float x) { return __builtin_amdgcn_rcpf(1.f + __expf(-x)); }

template <int CTRL, int ROWMASK>
DEV float dpp0(float x) {
  return __builtin_bit_cast(float, __builtin_amdgcn_update_dpp(0, __builtin_bit_cast(int, x), CTRL, ROWMASK, 0xF, false));
}
template <int CTRL, int ROWMASK>
DEV float dppself(float x) {
  int xi = __builtin_bit_cast(int, x);
  return __builtin_bit_cast(float, __builtin_amdgcn_update_dpp(xi, xi, CTRL, ROWMASK, 0xF, false));
}
DEV float readlane_f(float x, int l) { return __builtin_bit_cast(float, __builtin_amdgcn_readlane(__builtin_bit_cast(int, x), l)); }
DEV int lane_id() { return (int)__builtin_amdgcn_mbcnt_hi(~0u, __builtin_amdgcn_mbcnt_lo(~0u, 0u)); }
DEV float writelane_f(float val, int l, float old) { return lane_id() == l ? val : old; }
DEV int writelane_i(int val, int l, int old) { return lane_id() == l ? val : old; }
DEV float wave_sum(float x) {
  x += dpp0<0x111, 0xF>(x); x += dpp0<0x112, 0xF>(x); x += dpp0<0x114, 0xF>(x); x += dpp0<0x118, 0xF>(x);
  x += dpp0<0x142, 0xA>(x); x += dpp0<0x143, 0xC>(x);
  return readlane_f(x, 63);
}
DEV float wave_max(float x) {
  x = fmaxf(x, dppself<0x111, 0xF>(x)); x = fmaxf(x, dppself<0x112, 0xF>(x)); x = fmaxf(x, dppself<0x114, 0xF>(x));
  x = fmaxf(x, dppself<0x118, 0xF>(x)); x = fmaxf(x, dppself<0x142, 0xA>(x)); x = fmaxf(x, dppself<0x143, 0xC>(x));
  return readlane_f(x, 63);
}
DEV float row16_sum(float x) {
  x += dpp0<0xB1, 0xF>(x); x += dpp0<0x4E, 0xF>(x); x += dpp0<0x141, 0xF>(x); x += dpp0<0x140, 0xF>(x);
  return x;
}
DEV float row16_max(float x) {
  x = fmaxf(x, dppself<0xB1, 0xF>(x)); x = fmaxf(x, dppself<0x4E, 0xF>(x)); x = fmaxf(x, dppself<0x141, 0xF>(x));
  x = fmaxf(x, dppself<0x140, 0xF>(x));
  return x;
}
DEV float quad_sum(float x) { x += dpp0<0xB1, 0xF>(x); x += dpp0<0x4E, 0xF>(x); return x; }

DEV f32x4 mfma16(bf16x8 a, bf16x8 b, f32x4 c) { return __builtin_amdgcn_mfma_f32_16x16x32_bf16(a, b, c, 0, 0, 0); }
DEV f32x16 mfma32(bf16x8 a, bf16x8 b, f32x16 c) { return __builtin_amdgcn_mfma_f32_32x32x16_bf16(a, b, c, 0, 0, 0); }


#define XB_TMO      128
#define XB_XCNT(j)  (256  + 64 * (j))
#define XB_XSUB(j)  (1280 + 64 * (j))
#define XB_XGEN(j)  (2304 + 64 * (j))
#define XB_TOP      3328
#define XB_TOPGEN   3392
#define XCD_BAR_WORDS 3456
#define XB_SPIN_CAP (1u << 23)
#define LAS __attribute__((address_space(3)))

__device__ __forceinline__ unsigned xb_ld(unsigned* p)              { return __hip_atomic_load(p, __ATOMIC_RELAXED, __HIP_MEMORY_SCOPE_AGENT); }
__device__ __forceinline__ unsigned xb_add(unsigned* p, unsigned v) { return __hip_atomic_fetch_add(p, v, __ATOMIC_RELAXED, __HIP_MEMORY_SCOPE_AGENT); }
__device__ __forceinline__ unsigned xb_xcc_id() { return (unsigned)__builtin_amdgcn_s_getreg((3 << 11) | 20) & 0xFu; }
#define XB_SPIN(cond, bar) do { unsigned _sp = 0; while (cond) { __builtin_amdgcn_s_sleep(1); \
    if ((++_sp & 255u) == 0u) { if (xb_ld(&(bar)[XB_TMO])) break; if (_sp > XB_SPIN_CAP) { atomicAdd(&(bar)[XB_TMO], 1u); break; } } } } while (0)

struct XcdBarrier {
    unsigned* bar; unsigned x;
    volatile LAS unsigned* st;
};
__device__ __forceinline__ XcdBarrier xcd_barrier_post(unsigned* bar, volatile LAS unsigned* st) {
    XcdBarrier b; b.bar = bar; b.x = xb_xcc_id(); b.st = st;
    if (threadIdx.x == 0) (void)xb_add(&bar[XB_XCNT(b.x)], 1u);
    return b;
}
__device__ __forceinline__ void xcd_barrier_complete(unsigned* bar, unsigned x, unsigned& nloc, unsigned& nx) {
    const unsigned G = gridDim.x * gridDim.y * gridDim.z;
    unsigned sum, cnt, mine, sp = 0u;
    for (;;) {
        sum = 0u; cnt = 0u; mine = 0u;
#pragma unroll
        for (unsigned j = 0; j < 16; ++j) { const unsigned c = xb_ld(&bar[XB_XCNT(j)]); sum += c; cnt += (c > 0u) ? 1u : 0u; mine = (j == x) ? c : mine; }
        if (sum == G) break;
        __builtin_amdgcn_s_sleep(1);
        if ((++sp & 255u) == 0u) { if (xb_ld(&bar[XB_TMO])) break; if (sp > XB_SPIN_CAP) { atomicAdd(&bar[XB_TMO], 1u); break; } }
    }
    nloc = mine > 0u ? mine : 1u; nx = cnt > 0u ? cnt : 1u;
}
__device__ __forceinline__ void xcd_barrier(const XcdBarrier& b) {
    asm volatile("s_waitcnt vmcnt(0)" ::: "memory");
    __syncthreads();
    if (threadIdx.x == 0) {
        unsigned* bar = b.bar;
        __builtin_amdgcn_s_waitcnt(0);
        unsigned nloc = b.st[0], nx = b.st[1];
        if (nloc == 0u) { xcd_barrier_complete(bar, b.x, nloc, nx); b.st[0] = nloc; b.st[1] = nx; }
        const unsigned old = xb_add(&bar[XB_XSUB(b.x)], 1u);
        const unsigned gen = old / nloc;
        if (old + 1u == (gen + 1u) * nloc) {
            __builtin_amdgcn_fence(__ATOMIC_RELEASE, "agent");
            asm volatile("s_waitcnt vmcnt(0)" ::: "memory");
            const unsigned og = xb_add(&bar[XB_TOP], 1u);
            const unsigned tg = og / nx;
            if (og + 1u == (tg + 1u) * nx) xb_add(&bar[XB_TOPGEN], 1u);
            else XB_SPIN(xb_ld(&bar[XB_TOPGEN]) == tg, bar);
            __builtin_amdgcn_fence(__ATOMIC_ACQUIRE, "agent");
            xb_add(&bar[XB_XGEN(b.x)], 1u);
            asm volatile("s_waitcnt vmcnt(0)" ::: "memory");
        } else {
            XB_SPIN(xb_ld(&bar[XB_XGEN(b.x)]) == gen, bar);
            __builtin_amdgcn_fence(__ATOMIC_ACQUIRE, "agent");
            asm volatile("s_waitcnt vmcnt(0)" ::: "memory");
        }
    }
    __syncthreads();
}

template <class Tp> DEV Tp* opq(Tp* q) { asm volatile("" : "+s"(q)); return q; }
DEV int tid_() { int t = threadIdx.x; asm volatile("" : "+v"(t)); return t; }
DEV int bid_() { int b = blockIdx.x; asm volatile("" : "+s"(b)); return b; }

DEV void glds16(const void* gsrc, char* lds_lane_ptr) {
  __builtin_amdgcn_global_load_lds((const unsigned*)gsrc, (__attribute__((address_space(3))) unsigned*)lds_lane_ptr, 16, 0, 0);
}
template <class Epi>
DEV void gemm_tile(const bf16_t* __restrict__ A, int lda, const bf16_t* __restrict__ Bt, int ldb, int K, char* smem, Epi& epi) {
  const int tid = tid_(), lane = tid & 63, wid = tid >> 6, wr = wid >> 1, wc = wid & 1, fr = lane & 15, fq = lane >> 4;
  f32x4 acc[4][4];
#pragma unroll
  for (int m = 0; m < 4; ++m)
#pragma unroll
    for (int n = 0; n < 4; ++n) acc[m][n] = (f32x4){0.f, 0.f, 0.f, 0.f};
  const int drow0 = 8 * wid + (lane >> 3), dpc = lane & 7;
  auto issue = [&](int kt, int buf) {
    char* sa = smem + buf * 32768;
    char* sb = sa + 16384;
#pragma unroll
    for (int i = 0; i < 4; ++i) {
      const int row = drow0 + 32 * i;
      const int kc = dpc ^ ((row >> 1) & 7);
      glds16(A + (size_t)row * lda + kt * 64 + kc * 8, sa + (i * 4 + wid) * 1024 + lane * 16);
      glds16(Bt + (size_t)row * ldb + kt * 64 + kc * 8, sb + (i * 4 + wid) * 1024 + lane * 16);
    }
  };
  __syncthreads();
  issue(0, 0);
  const int nk = K >> 6;
  const int sw = (fr >> 1) & 7;
  const int aoff = (wr * 64 + fr) * 128, boff = (wc * 64 + fr) * 128;
  for (int kt = 0; kt < nk; ++kt) {
    asm volatile("s_waitcnt vmcnt(0)" ::: "memory");
    __syncthreads();
    if (kt + 1 < nk) issue(kt + 1, (kt + 1) & 1);
    const char* sa = smem + (kt & 1) * 32768;
    const char* sb = sa + 16384;
#pragma unroll
    for (int kh = 0; kh < 2; ++kh) {
      const int pc = ((kh * 4 + fq) ^ sw) * 16;
      bf16x8 af[4], bfr[4];
#pragma unroll
      for (int m = 0; m < 4; ++m) af[m] = *(const bf16x8*)(sa + aoff + m * 2048 + pc);
#pragma unroll
      for (int n = 0; n < 4; ++n) bfr[n] = *(const bf16x8*)(sb + boff + n * 2048 + pc);
#pragma unroll
      for (int m = 0; m < 4; ++m)
#pragma unroll
        for (int n = 0; n < 4; ++n) acc[m][n] = mfma16(af[m], bfr[n], acc[m][n]);
    }
  }
  __syncthreads();
  epi(acc, wr, wc, fr, fq, smem);
}
DEV void stage_tile_bf16(const f32x4 (&acc)[4][4], char* smem, int wid, int fr, int fq) {
  bf16_t (*t)[72] = (bf16_t (*)[72])(smem + wid * 9216);
#pragma unroll
  for (int m = 0; m < 4; ++m)
#pragma unroll
    for (int n = 0; n < 4; ++n)
#pragma unroll
      for (int j = 0; j < 4; ++j) t[m * 16 + fq * 4 + j][n * 16 + fr] = f2bf(acc[m][n][j]);
  asm volatile("s_waitcnt lgkmcnt(0)" ::: "memory");
}

DEV void ph_copy(const P& p) {
  const size_t n8 = (size_t)NTOK * D / 8;
  const float* pctx = opq(p.ctx); const float* px = opq(p.x);
  for (size_t i = (size_t)bid_() * 256 + tid_(); i < n8; i += (size_t)gridDim.x * 256) {
    size_t e = i * 8;
    int row = (int)(e / D), col = (int)(e % D);
    int b = row / LT, pp = row % LT;
    const float* src = pp < LC ? pctx + ((size_t)(b * LC + pp)) * D + col : px + ((size_t)(b * T + pp - LC)) * D + col;
    float4 v0 = *(const float4*)src, v1 = *(const float4*)(src + 4);
    uint4 o = make_uint4(pack2(v0.x, v0.y), pack2(v0.z, v0.w), pack2(v1.x, v1.y), pack2(v1.z, v1.w));
    *(uint4*)(p.X + e) = o;
  }
}

DEV void ph_rope(const P& p) {
  for (int i = bid_() * 256 + tid_(); i < 64 * 16; i += gridDim.x * 256) {
    int pos = i >> 4, k = i & 15;
    float inv = powf(10000.f, -(float)k / 16.f);
    float ang = (float)pos * inv;
    p.rope[2 * i] = cosf(ang); p.rope[2 * i + 1] = sinf(ang);
  }
}

DEV void modv_unit(const P& p, int unit, char* smem) {
  const int cc = unit % 24, layer = unit / 24;
  float (*cs)[128] = (float (*)[128])smem;
  const int col = cc * 256 + tid_();
  const float* pc = opq(p.c); const float* pcc = opq(p.c_ctx);
  float acc[17];
#pragma unroll
  for (int r = 0; r < 17; ++r) acc[r] = 0.f;
  for (int ks = 0; ks < 8; ++ks) {
    __syncthreads();
    for (int i = tid_(); i < 17 * 128; i += 256) {
      int r = i >> 7, e = i & 127;
      float v = r < 16 ? pc[r * D + ks * 128 + e] : pcc[ks * 128 + e];
      cs[r][e] = v / (1.f + expf(-v));
    }
    __syncthreads();
    const float* w = p.mod_w + ((size_t)layer * D + ks * 128) * 6144 + col;
#pragma unroll 4
    for (int e = 0; e < 128; ++e) {
      float wv = w[(size_t)e * 6144];
#pragma unroll
      for (int r = 0; r < 17; ++r) acc[r] += cs[r][e] * wv;
    }
  }
  const float bias = p.mod_b[layer * 6144 + col];
#pragma unroll
  for (int r = 0; r < 17; ++r) p.modv[((size_t)layer * 17 + r) * 6144 + col] = acc[r] + bias;
}

DEV void transpose_unit(const float* __restrict__ src, bf16_t* __restrict__ dst, int R, int C, int tile, char* smem) {
  float (*t)[65] = (float (*)[65])smem;
  const int nct = C / 64;
  const int tr = tile / nct, tc = tile % nct;
  __syncthreads();
  for (int i = tid_(); i < 4096; i += 256) { int r = i >> 6, c = i & 63; t[r][c] = src[(size_t)(tr * 64 + r) * C + tc * 64 + c]; }
  __syncthreads();
  for (int i = tid_(); i < 4096; i += 256) { int c = i >> 6, r = i & 63; dst[(size_t)(tc * 64 + c) * R + tr * 64 + r] = f2bf(t[r][c]); }
}

DEV void wfold_unit(const P& p, int layer, int unit, char* smem) {
  const int hs = unit >> 5, ec = unit & 31, h = hs >> 1, s = hs & 1;
  const float* wq = p.peer_wq + (size_t)layer * D * 2048;
  const float* kk = (s ? opq(p.peer_k2) : opq(p.peer_k1)) + ((size_t)layer * 8 + h) * 128 * 128;
  float (*kS)[65] = (float (*)[65])smem;
  float (*wS)[64] = (float (*)[64])(smem + 33280);
  const int key = tid_() & 127, eh = tid_() >> 7;
  float acc[16];
#pragma unroll
  for (int i = 0; i < 16; ++i) acc[i] = 0.f;
  for (int dh = 0; dh < 2; ++dh) {
    __syncthreads();
    for (int i = tid_(); i < 128 * 64; i += 256) { int k2 = i >> 6, d = i & 63; kS[k2][d] = kk[k2 * 128 + dh * 64 + d]; }
    for (int i = tid_(); i < 32 * 64; i += 256) {
      int e = i >> 6, d = i & 63;
      wS[e][d] = wq[(size_t)(ec * 32 + e) * 2048 + h * 256 + s * 128 + dh * 64 + d];
    }
    __syncthreads();
#pragma unroll 2
    for (int d = 0; d < 64; ++d) {
      float kv = kS[key][d];
#pragma unroll
      for (int i = 0; i < 16; ++i) acc[i] += kv * wS[eh * 16 + i][d];
    }
  }
  bf16_t* dst = p.Wft + ((size_t)(hs * 128 + key)) * D + ec * 32 + eh * 16;
#pragma unroll
  for (int i = 0; i < 16; i += 2) *(unsigned*)(dst + i) = pack2(acc[i], acc[i + 1]);
}

DEV void filt_unit(const P& p, int layer, int unit, char* smem) {
  int kind, j0, L;
  if (unit < 1024) { kind = 0; j0 = unit * 4; L = T; } else { kind = 1; j0 = (unit - 1024) * 4; L = LC; }
  float* zs = (float*)smem;
  float* h1 = zs + 4 * 36;
  float* h2 = h1 + 256;
  const int jj = tid_() >> 6, o = tid_() & 63;
  const int j = j0 + jj;
  const float fj = (float)j;
  const float t = fj / (float)(L - 1);
  __syncthreads();
  if (o < 33) {
    float z;
    if (o == 0) z = t;
    else {
      int i = (o - 1) & 15;
      float band = 1e-4f + (float)i * ((15.0f - 1e-4f) / 15.0f);
      float ang = 6.283185307179586f * fj * band / (float)L;
      z = (o <= 16) ? cosf(ang) : -sinf(ang);
    }
    zs[jj * 36 + o] = z;
  }
  __syncthreads();
  {
    const float* w1 = p.hy_w1 + layer * 33 * 64;
    float a = p.hy_b1[layer * 64 + o];
#pragma unroll 3
    for (int i = 0; i < 33; ++i) a += zs[jj * 36 + i] * w1[i * 64 + o];
    h1[jj * 64 + o] = sinf(p.hy_freq[layer * 128 + o] * a);
  }
  __syncthreads();
  {
    const float* w2 = p.hy_w2 + layer * 64 * 64;
    float a = p.hy_b2[layer * 64 + o];
#pragma unroll 4
    for (int i = 0; i < 64; ++i) a += h1[jj * 64 + i] * w2[i * 64 + o];
    h2[jj * 64 + o] = sinf(p.hy_freq[layer * 128 + 64 + o] * a);
  }
  __syncthreads();
  const float* w3 = p.hy_w3 + layer * 64 * 512;
  float* F = kind ? opq(p.FC) : opq(p.FL);
  const float DMIN = -3.0701134573253945f, DMAX = -15.350567286626973f;
#pragma unroll 1
  for (int m = 0; m < 4; ++m) {
    int c = o + 64 * m;
    float af = p.hy_b3[layer * 512 + c], ab = p.hy_b3[layer * 512 + 256 + c];
#pragma unroll 4
    for (int i = 0; i < 64; ++i) { float hv = h2[jj * 64 + i]; af += hv * w3[i * 512 + c]; ab += hv * w3[i * 512 + 256 + c]; }
    float delta = fabsf(DMIN + (float)c * ((DMAX - DMIN) / 255.f));
    float win = expf(-t * delta) + 0.05f;
    af *= win; ab *= win;
    F[((size_t)c * 2 + 0) * L + j] = af;
    F[((size_t)c * 2 + 1) * L + j] = ab;
  }
}

constexpr int PREP_T0 = 672, PREP_T1 = PREP_T0 + 256, PREP_T2 = PREP_T1 + 8, PREP_T3 = PREP_T2 + 8, PREP_T4 = PREP_T3 + 8;
constexpr int PREP_WF = PREP_T4 + 512, PREP_N = PREP_WF + 1088;
DEV void ph_prep(const P& p, int layer, char* smem) {
  for (int u = bid_(); u < PREP_N; u += gridDim.x) {
    if (u < PREP_T0) transpose_unit(p.w_in + (size_t)layer * D * INW, p.W1t, D, INW, u, smem);
    else if (u < PREP_T1) transpose_unit(p.w_out + (size_t)layer * D * D, p.W2t, D, D, u - PREP_T0, smem);
    else if (u < PREP_T3) {
      const int u0 = u - PREP_T1;
      for (int i = tid_(); i < 64 * 256; i += 256) {
        const int np = u0 * 64 + (i >> 8), kp = i & 255;
        const int ps = np & 3, chan = np >> 2, qp = kp >> 6, kk = kp & 63;
        const int is_a = ps & 1, d = ps >> 1;
        float v = 0.f;
        if (qp == (is_a ? 2 + d : d)) v = (is_a ? opq(p.rw_a_up) : opq(p.rw_w_up))[(((size_t)layer * 2 + d) * 64 + kk) * 256 + chan];
        p.Wlt[(size_t)np * 256 + kp] = f2bf(v);
      }
    }
    else if (u < PREP_T4) transpose_unit(p.rw_g_up + (size_t)layer * 128 * 256, p.Wgt, 128, 256, u - PREP_T3, smem);
    else if (u < PREP_WF) wfold_unit(p, layer, u - PREP_T4, smem);
    else filt_unit(p, layer, u - PREP_WF, smem);
  }
}

DEV void ph_norm(const P& p, int layer, int which) {
  const int gw = (bid_() * 256 + tid_()) >> 6, nw = gridDim.x * 4, lane = tid_() & 63;
  const float* g = (which ? p.norm2_g : p.norm1_g) + layer * D;
  for (int row = gw; row < NTOK; row += nw) {
    int b = row / LT, pp = row % LT;
    int mr = pp < LC ? 16 : b;
    const float* mv = p.modv + ((size_t)layer * 17 + mr) * 6144 + (which ? 3072 : 0);
    const bf16_t* xr = p.X + (size_t)row * D;
    uint4 u0 = *(const uint4*)(xr + 8 * lane), u1 = *(const uint4*)(xr + 512 + 8 * lane);
    float v[16];
    unpack8(u0, v); unpack8(u1, v + 8);
    float ss = 0.f;
#pragma unroll
    for (int i = 0; i < 16; ++i) ss += v[i] * v[i];
    ss = wave_sum(ss);
    float rstd = rsqrtf(ss * (1.f / 1024.f) + 1e-6f);
    float o[16];
#pragma unroll
    for (int hh = 0; hh < 2; ++hh)
#pragma unroll
      for (int i = 0; i < 8; ++i) {
        int col = hh * 512 + 8 * lane + i;
        float y = v[hh * 8 + i] * rstd * g[col];
        o[hh * 8 + i] = y * (1.f + mv[1024 + col]) + mv[col];
      }
    bf16_t* hr = p.H + (size_t)row * D;
    *(uint4*)(hr + 8 * lane) = pack8(o);
    *(uint4*)(hr + 512 + 8 * lane) = pack8(o + 8);
  }
}

DEV bool gemm_unit(int it, int nct, int& rt, int& ct) {
  const int nslot = gridDim.x >> 3;
  const int x = bid_() & 7, sl = bid_() >> 3;
  if (sl >= nslot) return false;
  const int v = it * nslot + sl;
  if (v >= 68 * nct) return false;
  const int rg = v / (8 * nct), rem = v - rg * 8 * nct;
  const int rows = (rg == 8) ? 4 : 8;
  ct = rem / rows;
  rt = x * 68 + rg * 8 + (rem - ct * rows);
  return true;
}
struct Epi1 {
  const P& p; int row0, col0;
  DEV void operator()(f32x4 (&acc)[4][4], int wr, int wc, int fr, int fq, char* smem) const {
    const int cw = col0 + wc * 64;
    const int rbase = row0 + wr * 64;
    const bool lat = (row0 % LT) >= LC;
    if (cw >= 1536 && cw < 1664) {
#pragma unroll
      for (int m = 0; m < 4; ++m)
#pragma unroll
        for (int n = 0; n < 4; ++n)
#pragma unroll
          for (int j = 0; j < 4; ++j) acc[m][n][j] = tanhf(acc[m][n][j]);
    } else if (cw >= 1792 && cw < 1920) {
#pragma unroll
      for (int m = 0; m < 4; ++m)
#pragma unroll
        for (int n = 0; n < 4; ++n)
#pragma unroll
          for (int j = 0; j < 4; ++j) acc[m][n][j] = sigmoidf_(acc[m][n][j]);
    } else if (cw >= 1920 && cw < 2560 && lat) {
#pragma unroll
      for (int m = 0; m < 4; ++m)
#pragma unroll
        for (int j = 0; j < 4; ++j) {
          int row = rbase + m * 16 + fq * 4 + j;
          int pl = (row % LT) - LC;
          int ri = pl >> 6, ci = pl & 63;
          float2 cr = *(const float2*)(p.rope + 2 * (ri * 16 + fr));
          float2 cc = *(const float2*)(p.rope + 2 * (ci * 16 + fr));
          float x1 = acc[m][0][j], x2 = acc[m][1][j];
          acc[m][0][j] = x1 * cr.x - x2 * cr.y; acc[m][1][j] = x2 * cr.x + x1 * cr.y;
          x1 = acc[m][2][j]; x2 = acc[m][3][j];
          acc[m][2][j] = x1 * cc.x - x2 * cc.y; acc[m][3][j] = x2 * cc.x + x1 * cc.y;
        }
    }
    const int wid = wr * 2 + wc, lane = fq * 16 + fr;
    stage_tile_bf16(acc, smem, wid, fr, fq);
    const bf16_t (*t)[72] = (const bf16_t (*)[72])(smem + wid * 9216);
#pragma unroll
    for (int i = 0; i < 8; ++i) {
      const int rl = i * 8 + (lane >> 3), ch = lane & 7;
      *(uint4*)(p.Z + (size_t)(rbase + rl) * INW + cw + ch * 8) = *(const uint4*)&t[rl][ch * 8];
    }
  }
};
DEV void ph_gemm1(const P& p, char* smem) {
  const int nct = INW / 128;
  int rt, ct;
  for (int it = 0; gemm_unit(it, nct, rt, ct); ++it) {
    Epi1 epi{p, rt * 128, ct * 128};
    gemm_tile(p.H + (size_t)rt * 128 * D, D, p.W1t + (size_t)ct * 128 * D, D, D, smem, epi);
  }
}

struct EpiLoraA {
  const P& p; int layer, row0, col0;
  DEV void operator()(f32x4 (&acc)[4][4], int wr, int wc, int fr, int fq, char* smem) const {
    const int ps = fr & 3, is_a = ps & 1, dd = ps >> 1;
    const float scale = is_a ? 1.f : 0.6065306597126334f;
    const float* bias0 = (is_a ? opq(p.rw_a0) : opq(p.rw_w0)) + (layer * 2 + dd) * 256;
#pragma unroll
    for (int n = 0; n < 4; ++n) {
      const int chan = (col0 + wc * 64 + n * 16 + fr) >> 2;
      const float bias = bias0[chan];
#pragma unroll
      for (int m = 0; m < 4; ++m)
#pragma unroll
        for (int j = 0; j < 4; ++j) acc[m][n][j] = scale * sigmoidf_(acc[m][n][j] + bias);
    }
    const int wid = wr * 2 + wc, lane = fq * 16 + fr;
    stage_tile_bf16(acc, smem, wid, fr, fq);
    const bf16_t (*t)[72] = (const bf16_t (*)[72])(smem + wid * 9216);
#pragma unroll
    for (int i = 0; i < 8; ++i) {
      const int rl = i * 8 + (lane >> 3), ch = lane & 7;
      *(uint4*)(p.SC + (size_t)(row0 + wr * 64 + rl) * 1024 + col0 + wc * 64 + ch * 8) = *(const uint4*)&t[rl][ch * 8];
    }
  }
};
struct EpiLoraG {
  const P& p; int row0, col0;
  DEV void operator()(f32x4 (&acc)[4][4], int wr, int wc, int fr, int fq, char* smem) const {
    const int wid = wr * 2 + wc, lane = fq * 16 + fr;
    stage_tile_bf16(acc, smem, wid, fr, fq);
    const bf16_t (*t)[72] = (const bf16_t (*)[72])(smem + wid * 9216);
#pragma unroll
    for (int i = 0; i < 8; ++i) {
      const int rl = i * 8 + (lane >> 3), ch = lane & 7;
      *(uint4*)(p.Y + (size_t)(row0 + wr * 64 + rl) * D + 256 + col0 + wc * 64 + ch * 8) = *(const uint4*)&t[rl][ch * 8];
    }
  }
};
DEV void ph_lora(const P& p, int layer, char* smem) {
  int rt, ct;
  for (int it = 0; gemm_unit(it, 10, rt, ct); ++it) {
    if (ct < 8) {
      EpiLoraA epi{p, layer, rt * 128, ct * 128};
      gemm_tile(p.Z + (size_t)rt * 128 * INW + 1536, INW, p.Wlt + (size_t)ct * 128 * 256, 256, 256, smem, epi);
    } else {
      EpiLoraG epi{p, rt * 128, (ct - 8) * 128};
      gemm_tile(p.Z + (size_t)rt * 128 * INW + 1792, INW, p.Wgt + (size_t)(ct - 8) * 128 * 128, 128, 128, smem, epi);
    }
  }
}

DEV void ph_rwkv_prep(const P& p, int layer) {
  const int gw = (bid_() * 256 + tid_()) >> 6, nw = gridDim.x * 4, lane = tid_() & 63;
  const float* cw = p.conv_w + (size_t)layer * 3 * 1536;
  const float* cb = p.conv_b + (size_t)layer * 1536;
  for (int row = gw; row < NTOK; row += nw) {
    int pp = row % LT;
    bool hasm = (pp != 0) && (pp != LC);
    bool hasp = (pp != LC - 1) && (pp != LT - 1);
    float res[3][4];
#pragma unroll
    for (int a = 0; a < 3; ++a) {
      int col = 768 + a * 256 + 4 * lane;
      const bf16_t* zc = p.Z + (size_t)row * INW + col;
      uint2 um = hasm ? *(const uint2*)(zc - INW) : make_uint2(0, 0);
      uint2 uc = *(const uint2*)zc;
      uint2 up = hasp ? *(const uint2*)(zc + INW) : make_uint2(0, 0);
      float vm[4] = {bflo(um.x), bfhi(um.x), bflo(um.y), bfhi(um.y)};
      float vc[4] = {bflo(uc.x), bfhi(uc.x), bflo(uc.y), bfhi(uc.y)};
      float vp[4] = {bflo(up.x), bfhi(up.x), bflo(up.y), bfhi(up.y)};
#pragma unroll
      for (int i = 0; i < 4; ++i) res[a][i] = cw[col + i] * vm[i] + cw[1536 + col + i] * vc[i] + cw[3072 + col + i] * vp[i] + cb[col + i];
    }
    float kk[4], ss = 0.f;
#pragma unroll
    for (int i = 0; i < 4; ++i) { kk[i] = res[1][i] * p.rw_k_k[layer * 256 + 4 * lane + i]; ss += kk[i] * kk[i]; }
    ss = row16_sum(ss);
    float rs = rsqrtf(ss + 1e-12f);
    bf16_t* hr = p.H + (size_t)row * D + 16 * lane;
    *(uint4*)hr = make_uint4(pack2(res[0][0], res[1][0]), pack2(kk[0] * rs, res[2][0]), pack2(res[0][1], res[1][1]), pack2(kk[1] * rs, res[2][1]));
    *(uint4*)(hr + 8) = make_uint4(pack2(res[0][2], res[1][2]), pack2(kk[2] * rs, res[2][2]), pack2(res[0][3], res[1][3]), pack2(kk[3] * rs, res[2][3]));
  }
}

DEV float oct_sum(float x) { x += dpp0<0xB1, 0xF>(x); x += dpp0<0x4E, 0xF>(x); x += dpp0<0x141, 0xF>(x); return x; }
DEV bf16x8 frag_join(uint2 lo, uint2 hi) { uint4 w = make_uint4(lo.x, lo.y, hi.x, hi.y); return __builtin_bit_cast(bf16x8, w); }
constexpr int SCS_SET = 16640, SCS_IMG = 3 * SCS_SET, SCS_W0 = SCS_IMG + 2 * 3072;
DEV void scanc_unit(const P& p, int layer, int unit, char* smem) {
  const int dir = unit & 1, h = (unit >> 1) & 3, b = unit >> 3;
  const int tid = tid_(), w = tid >> 6, lane = tid & 63, fr = lane & 15, fq = lane >> 4;
  bf16_t* IMG0 = (bf16_t*)(smem + SCS_W0);
  bf16_t* IMG1 = IMG0 + 512;
  bf16_t* IMG2 = IMG0 + 1024;
  __syncthreads();
  for (int i = tid; i < (2 * 3072 + 3072) / 4; i += 256) ((unsigned*)(smem + SCS_IMG))[i] = 0u;
  const float ka = p.rw_k_a[layer * 256 + h * 64 + lane];
  const size_t rowbase = (size_t)b * LT;
  const bf16_t* hb = p.H + rowbase * 1024 + (h * 64 + lane) * 4;
  const bf16_t* sb = p.SC + rowbase * 1024 + (h * 64 + lane) * 4;
  bf16_t* yb = p.Z + rowbase * INW + 768 + dir * 256 + h * 64 + w * 16 + fr;
  auto posf = [&](int t) -> int { return dir == 0 ? t : (t < LC ? LC - 1 - t : LT - 1 - (t - LC)); };
  constexpr int NCH = LT / 16;
  struct Raw { unsigned sc[16]; uint2 hr[6]; };
  const char* sbd = (const char*)sb + 4 * dir;
  const int wl = (w == 0) ? 0 : w - 1;
  auto load_raw = [&](int c, Raw& rw) {
#pragma unroll
    for (int i = 0; i < 16; ++i) rw.sc[i] = *(const unsigned*)(sbd + (size_t)posf(c * 16 + i) * 2048);
#pragma unroll
    for (int q = 0; q < 6; ++q) {
      const int i = wl + 3 * q;
      rw.hr[q] = *(const uint2*)(hb + (size_t)posf(c * 16 + (i < 16 ? i : 15)) * 1024);
    }
  };
  auto stage1 = [&](int set, const Raw& rw) {
    if (w != 0) {
      char* base = smem + set * SCS_SET;
      bf16_t (*At)[72] = (bf16_t (*)[72])(base);
      bf16_t (*Rt)[72] = (bf16_t (*)[72])(base + 2304);
      bf16_t (*Bt)[72] = (bf16_t (*)[72])(base + 4608);
      bf16_t (*Kt)[72] = (bf16_t (*)[72])(base + 6912);
      bf16_t (*BKT)[40] = (bf16_t (*)[40])(base + 9216);
      bf16_t (*VV)[16] = (bf16_t (*)[16])(base + 14336);
      float* G16 = (float*)(base + 16384);
      float Erun = 0.f;
#pragma unroll
      for (int i = 0; i < 16; ++i) {
        const float ev = bflo(rw.sc[i]);
        const float Eprev = Erun;
        Erun += ev;
        if ((i % 3) == w - 1) {
          const uint2 hrec = rw.hr[i / 3];
          const float rr = bflo(hrec.x), kr = bfhi(hrec.x), kkv = bflo(hrec.y);
          const float av = bfhi(rw.sc[i]);
          const float gp = __expf(-Eprev), gi = __expf(-Erun), ig = __expf(Erun);
          const float at = -kkv * gp, rt = rr * gi, bt = kkv * av * ig, kt2 = kr * (1.f + (av - 1.f) * ka) * ig;
          const unsigned ar = pack2(at, rt), bk = pack2(bt, kt2);
          At[i][lane] = (bf16_t)(ar & 0xFFFFu); Rt[i][lane] = (bf16_t)(ar >> 16);
          Bt[i][lane] = (bf16_t)(bk & 0xFFFFu); Kt[i][lane] = (bf16_t)(bk >> 16);
          BKT[lane][(i >> 2) * 8 + (i & 3)] = (bf16_t)(bk & 0xFFFFu);
          BKT[lane][(i >> 2) * 8 + 4 + (i & 3)] = (bf16_t)(bk >> 16);
          VV[lane][(i >> 2) * 4 + (i & 3)] = (bf16_t)(hrec.y >> 16);
          if (i == 15) G16[lane] = gi;
        }
      }
    }
  };
  auto stage2 = [&](int set, int iset) {
    char* base = smem + set * SCS_SET;
    const bf16_t (*At)[72] = (const bf16_t (*)[72])(base);
    const bf16_t (*Rt)[72] = (const bf16_t (*)[72])(base + 2304);
    const bf16_t (*Bt)[72] = (const bf16_t (*)[72])(base + 4608);
    const bf16_t (*Kt)[72] = (const bf16_t (*)[72])(base + 6912);
    bf16_t* TT = (bf16_t*)(smem + SCS_IMG + iset * 3072);
    bf16_t* ARK = TT + 512;
    bf16_t* AAK = TT + 1024;
    const bf16_t (*X)[72] = (w < 2) ? At : Rt;
    const bf16_t (*Y)[72] = (w & 1) ? Kt : Bt;
    f32x4 cm = (f32x4){0.f, 0.f, 0.f, 0.f};
#pragma unroll
    for (int s = 0; s < 2; ++s) {
      bf16x8 af = *(const bf16x8*)&X[fr][32 * s + 8 * fq];
      bf16x8 bm = *(const bf16x8*)&Y[fr][32 * s + 8 * fq];
      cm = mfma16(af, bm, cm);
    }
#pragma unroll
    for (int jj = 0; jj < 4; ++jj) {
      const int i = 4 * fq + jj;
      const bool keep = (w < 2) ? (fr < i) : (fr <= i);
      cm[jj] = keep ? cm[jj] : 0.f;
    }
    const int io = (fr >> 2) * 8 + (fr & 3);
    auto wr_img = [&](bf16_t* img, const f32x4& Xv, int hi) {
#pragma unroll
      for (int jj = 0; jj < 4; ++jj) img[(4 * fq + jj) * 32 + io + hi] = f2bf(Xv[jj]);
    };
    if (w == 1) wr_img(AAK, cm, 0);
    else if (w == 2) wr_img(ARK, cm, 0);
    else if (w == 3) wr_img(ARK, cm, 4);
    else {
      auto bfrag = [&](const f32x4& Xv) { return frag_join(make_uint2(pack2(Xv[0], Xv[1]), pack2(Xv[2], Xv[3])), make_uint2(0u, 0u)); };
      auto afr = [&](const bf16_t* img) { return *(const bf16x8*)&img[(fr * 4 + fq) * 8]; };
      const f32x4 Z4 = (f32x4){0.f, 0.f, 0.f, 0.f};
      wr_img(IMG0, cm, 0);
      asm volatile("" ::: "memory");
      f32x4 A2 = mfma16(afr(IMG0), bfrag(cm), Z4);
      wr_img(IMG1, A2, 0);
      asm volatile("" ::: "memory");
      f32x4 A4 = mfma16(afr(IMG1), bfrag(A2), Z4);
      wr_img(IMG2, A4, 0);
      asm volatile("" ::: "memory");
      f32x4 Rm = mfma16(afr(IMG2), bfrag(A4), Z4);
#pragma unroll
      for (int jj = 0; jj < 4; ++jj) Rm[jj] += (fr == 4 * fq + jj) ? 1.f : 0.f;
      Rm = mfma16(afr(IMG2), bfrag(Rm), Rm);
      Rm = mfma16(afr(IMG1), bfrag(Rm), Rm);
      Rm = mfma16(afr(IMG0), bfrag(Rm), Rm);
      wr_img(TT, Rm, 0);
    }
  };
  f32x4 acc[4];
#pragma unroll
  for (int kt = 0; kt < 4; ++kt) acc[kt] = (f32x4){0.f, 0.f, 0.f, 0.f};
  auto part2 = [&](int c, int set, int iset) {
    char* base = smem + set * SCS_SET;
    const bf16_t (*At)[72] = (const bf16_t (*)[72])(base);
    const bf16_t (*Rt)[72] = (const bf16_t (*)[72])(base + 2304);
    const bf16_t (*BKT)[40] = (const bf16_t (*)[40])(base + 9216);
    const bf16_t (*VV)[16] = (const bf16_t (*)[16])(base + 14336);
    const float* G16 = (const float*)(base + 16384);
    const bf16_t* TT = (const bf16_t*)(smem + SCS_IMG + iset * 3072);
    const bf16_t* ARK = TT + 512;
    const bf16_t* AAK = TT + 1024;
    bf16x8 Sb[2];
#pragma unroll
    for (int s = 0; s < 2; ++s) {
      uint4 t = make_uint4(pack2(acc[2 * s][0], acc[2 * s][1]), pack2(acc[2 * s][2], acc[2 * s][3]),
                           pack2(acc[2 * s + 1][0], acc[2 * s + 1][1]), pack2(acc[2 * s + 1][2], acc[2 * s + 1][3]));
      Sb[s] = __builtin_bit_cast(bf16x8, t);
    }
    const uint2 vv = *(const uint2*)&VV[w * 16 + fr][fq * 4];
    const bf16x8 Vlow = frag_join(vv, make_uint2(0u, 0u));
    f32x4 Pm = (f32x4){0.f, 0.f, 0.f, 0.f};
#pragma unroll
    for (int s = 0; s < 2; ++s) {
      bf16x8 af = frag_join(*(const uint2*)&At[fr][32 * s + 4 * fq], *(const uint2*)&At[fr][32 * s + 16 + 4 * fq]);
      Pm = mfma16(af, Sb[s], Pm);
    }
    Pm = mfma16(*(const bf16x8*)&AAK[(fr * 4 + fq) * 8], Vlow, Pm);
    const bf16x8 Pb = frag_join(make_uint2(pack2(Pm[0], Pm[1]), pack2(Pm[2], Pm[3])), make_uint2(0u, 0u));
    f32x4 U = mfma16(*(const bf16x8*)&TT[(fr * 4 + fq) * 8], Pb, (f32x4){0.f, 0.f, 0.f, 0.f});
    const bf16x8 UV = frag_join(make_uint2(pack2(U[0], U[1]), pack2(U[2], U[3])), vv);
    f32x4 Yv = (f32x4){0.f, 0.f, 0.f, 0.f};
#pragma unroll
    for (int s = 0; s < 2; ++s) {
      bf16x8 af = frag_join(*(const uint2*)&Rt[fr][32 * s + 4 * fq], *(const uint2*)&Rt[fr][32 * s + 16 + 4 * fq]);
      Yv = mfma16(af, Sb[s], Yv);
    }
    Yv = mfma16(*(const bf16x8*)&ARK[(fr * 4 + fq) * 8], UV, Yv);
#pragma unroll
    for (int jj = 0; jj < 4; ++jj) yb[(size_t)posf(c * 16 + 4 * fq + jj) * INW] = f2bf(Yv[jj]);
#pragma unroll
    for (int kt = 0; kt < 4; ++kt) {
      f32x4 t = mfma16(*(const bf16x8*)&BKT[16 * kt + fr][fq * 8], UV, acc[kt]);
      const float4 g4 = *(const float4*)&G16[16 * kt + 4 * fq];
      t[0] *= g4.x; t[1] *= g4.y; t[2] *= g4.z; t[3] *= g4.w;
      acc[kt] = t;
    }
  };
  Raw r0, r1;
  load_raw(0, r0); load_raw(1, r1);
  stage1(0, r0);
  load_raw(2, r0);
  __syncthreads();
  stage2(0, 0);
  stage1(1, r1);
  load_raw(3, r1);
  __syncthreads();
  int s0 = 0, s1 = 1, s2 = 2;
  auto iter = [&](int c, Raw& rw) {
    if (c + 1 < NCH) stage2(s1, (c + 1) & 1);
    part2(c, s0, c & 1);
    if (c + 2 < NCH) {
      stage1(s2, rw);
      if (c + 4 < NCH) load_raw(c + 4, rw);
    }
    asm volatile("s_waitcnt lgkmcnt(0)" ::: "memory");
    __builtin_amdgcn_s_barrier();
    asm volatile("" ::: "memory");
    const int t = s0; s0 = s1; s1 = s2; s2 = t;
  };
#pragma unroll 1
  for (int c = 0; c < NCH; c += 2) {
    iter(c, r0); iter(c + 1, r1);
  }
}

DEV void ph_rwkv_post(const P& p, int layer) {
  const int gw = (bid_() * 256 + tid_()) >> 6, nw = gridDim.x * 4, lane = tid_() & 63;
  for (int row = gw; row < NTOK; row += nw) {
    const int ch = 4 * lane;
    const bf16_t* zr = p.Z + (size_t)row * INW + 768 + ch;
    uint2 y0u = *(const uint2*)zr, y1u = *(const uint2*)(zr + 256);
    float y[4] = {bflo(y0u.x) + bflo(y1u.x), bfhi(y0u.x) + bfhi(y1u.x), bflo(y0u.y) + bflo(y1u.y), bfhi(y0u.y) + bfhi(y1u.y)};
    float mu = row16_sum(y[0] + y[1] + y[2] + y[3]) * (1.f / 64.f);
    float vs = 0.f;
#pragma unroll
    for (int i = 0; i < 4; ++i) { y[i] -= mu; vs += y[i] * y[i]; }
    float var = row16_sum(vs) * (1.f / 64.f);
    float rstd = rsqrtf(var + 64e-5f);
    const bf16_t* hr = p.H + (size_t)row * D + 4 * ch;
    uint4 h0 = *(const uint4*)hr, h1 = *(const uint4*)(hr + 8);
    const bf16_t* sr = p.SC + (size_t)row * 1024 + 4 * ch;
    uint4 s0 = *(const uint4*)sr, s1 = *(const uint4*)(sr + 8);
    float r[4] = {bflo(h0.x), bflo(h0.z), bflo(h1.x), bflo(h1.z)};
    float k[4] = {bfhi(h0.x), bfhi(h0.z), bfhi(h1.x), bfhi(h1.z)};
    float v[4] = {bfhi(h0.y), bfhi(h0.w), bfhi(h1.y), bfhi(h1.w)};
    float a0[4] = {bfhi(s0.x), bfhi(s0.z), bfhi(s1.x), bfhi(s1.z)};
    float a1[4] = {bfhi(s0.y), bfhi(s0.w), bfhi(s1.y), bfhi(s1.w)};
    float sd = 0.f;
#pragma unroll
    for (int i = 0; i < 4; ++i) {
      float kav = p.rw_k_a[layer * 256 + ch + i], rk = p.rw_r_k[layer * 256 + ch + i];
      float kd0 = k[i] * (1.f + (a0[i] - 1.f) * kav), kd1 = k[i] * (1.f + (a1[i] - 1.f) * kav);
      sd += r[i] * (kd0 + kd1) * rk;
    }
    sd = row16_sum(sd);
    bf16_t* yr = p.Y + (size_t)row * D + 256 + ch;
    uint2 gu = *(const uint2*)yr;
    float g[4] = {bflo(gu.x), bfhi(gu.x), bflo(gu.y), bfhi(gu.y)};
    float o[4];
#pragma unroll
    for (int i = 0; i < 4; ++i) {
      float yn = y[i] * rstd * p.rw_ln_w[layer * 256 + ch + i] + p.rw_ln_b[layer * 256 + ch + i];
      o[i] = (yn + sd * v[i]) * g[i];
#if !EN_RW
      o[i] = 0.f;
#endif
    }
    *(uint2*)yr = make_uint2(pack2(o[0], o[1]), pack2(o[2], o[3]));
  }
}

DEV void hyena_pre_unit(const P& p, int layer, int unit) {
  int kind, b, t0, L;
  if (unit < 1024) { kind = 0; b = unit >> 6; t0 = (unit & 63) * 64; L = T; } else { int u = unit - 1024; kind = 1; b = u >> 2; t0 = (u & 3) * 64; L = LC; }
  const int c = tid_();
  const size_t row0 = (size_t)b * LT + (kind ? 0 : LC);
  const float* cw = p.conv_w + (size_t)layer * 3 * 1536;
  const float* cb = p.conv_b + (size_t)layer * 1536;
  const float w1a = cw[256 + c], w1b = cw[1536 + 256 + c], w1c = cw[3072 + 256 + c], b1 = cb[256 + c];
  const float w2a = cw[512 + c], w2b = cw[1536 + 512 + c], w2c = cw[3072 + 512 + c], b2 = cb[512 + c];
  auto ld = [&](int t, int col) -> float { return (t >= 0 && t < L) ? bf2f(p.Z[(row0 + t) * INW + col]) : 0.f; };
  float x1m = ld(t0 - 1, 256 + c), x1c = ld(t0, 256 + c), vm = ld(t0 - 1, 512 + c), vc = ld(t0, 512 + c);
  bf16_t* dst = (kind ? opq(p.UTc) : opq(p.UTl)) + ((size_t)c * 16 + b) * L + t0;
#pragma unroll 1
  for (int i8 = 0; i8 < 8; ++i8) {
    float uo[8];
#pragma unroll
    for (int i = 0; i < 8; ++i) {
      int t = t0 + i8 * 8 + i;
      float x1n = ld(t + 1, 256 + c), vn = ld(t + 1, 512 + c);
      float a = w1a * x1m + w1b * x1c + w1c * x1n + b1;
      float bb = w2a * vm + w2b * vc + w2c * vn + b2;
      uo[i] = a * bb;
      x1m = x1c; x1c = x1n; vm = vc; vc = vn;
    }
    *(uint4*)(dst + 8 * i8) = pack8(uo);
  }
}

DEV void hyena_conv_unit(const P& p, int layer, int unit, char* smem) {
  int kind, c, tb, L;
  if (unit < 4096) { kind = 0; c = unit >> 4; tb = (unit & 15) * 256; L = T; } else { kind = 1; c = unit - 4096; tb = 0; L = LC; }
  const int tid = tid_(), lane = tid & 63, wid = tid >> 6, fr = lane & 15, fq = lane >> 4;
  float* red = (float*)(smem + 2 * 16512);
  const float* F = (kind ? opq(p.FC) : opq(p.FL)) + (size_t)c * 2 * L;
  float scale;
  {
    float part = 0.f;
    for (int i = tid; i < 2 * L; i += 256) { float fv = F[i]; part += (i != L) ? fv * fv : 0.f; }
    part = wave_sum(part);
    __syncthreads();
    if (lane == 0) red[wid] = part;
    __syncthreads();
    scale = rsqrtf(((red[0] + red[1]) + (red[2] + red[3])) + 1e-6f);
  }
  const bf16_t* U = (kind ? opq(p.UTc) : opq(p.UTl)) + (size_t)c * 16 * L;
  f32x4 acc[4];
#pragma unroll
  for (int m = 0; m < 4; ++m) acc[m] = (f32x4){0.f, 0.f, 0.f, 0.f};
  const int nch = L / 256;
  float fw0, fw1, fw2;
  uint4 ru0, ru1;
  auto ldchunk = [&](int ch) {
    const int sc = ch * 256;
    const int D0 = tb + 256 - sc;
    auto tap = [&](int n) -> float {
      int d = D0 - n;
      float v = 0.f;
      if (d > -L && d < L) v = (d >= 0 ? F[d] : F[L - d]);
      return v;
    };
    fw0 = tap(tid); fw1 = tap(tid + 256); fw2 = (tid < 8) ? tap(tid + 512) : 0.f;
    const int bb = tid >> 4, sg0 = tid & 15;
    ru0 = *(const uint4*)(U + (size_t)bb * L + sc + 8 * sg0);
    ru1 = *(const uint4*)(U + (size_t)bb * L + sc + 8 * (sg0 + 16));
  };
  auto stchunk = [&](int buf) {
    bf16_t* Cq = (bf16_t*)(smem + buf * 16512);
    bf16_t* Us = (bf16_t*)(smem + buf * 16512 + 8320);
    const bf16_t h0 = f2bf(fw0 * scale), h1 = f2bf(fw1 * scale), h2 = f2bf(fw2 * scale);
#pragma unroll
    for (int rho = 0; rho < 8; ++rho) {
      int m = tid + rho;
      Cq[((m >> 3) * 8 + rho) * 8 + (m & 7)] = h0;
      m = tid + 256 + rho;
      if (m < 520) Cq[((m >> 3) * 8 + rho) * 8 + (m & 7)] = h1;
      m = tid + 512 + rho;
      if (tid < 8 && m < 520) Cq[((m >> 3) * 8 + rho) * 8 + (m & 7)] = h2;
    }
    if (tid < 8) {
#pragma unroll
      for (int rho = 1; rho < 8; ++rho) if (tid < rho) Cq[(rho) * 8 + tid] = 0;
    }
    const int bb = tid >> 4, sg0 = tid & 15;
    *(uint4*)&Us[(sg0 * 16 + bb) * 8] = ru0;
    *(uint4*)&Us[((sg0 + 16) * 16 + bb) * 8] = ru1;
  };
  ldchunk(0);
#pragma unroll 1
  for (int ch = 0; ch < nch; ++ch) {
    const int buf = ch & 1;
    stchunk(buf);
    __syncthreads();
    if (ch + 1 < nch) ldchunk(ch + 1);
    const bf16_t* Cq = (const bf16_t*)(smem + buf * 16512);
    const bf16_t* Us = (const bf16_t*)(smem + buf * 16512 + 8320);
#pragma unroll
    for (int kk = 0; kk < 8; ++kk) {
      bf16x8 bf = *(const bf16x8*)&Us[((4 * kk + fq) * 16 + fr) * 8];
#pragma unroll
      for (int m = 0; m < 4; ++m) {
        int it = wid * 4 + m;
        int base = 256 - 16 * it + 32 * kk + 8 * fq;
        int m0 = base - 8 * (fr >> 3);
        bf16x8 af = *(const bf16x8*)&Cq[((m0 >> 3) * 8 + (fr & 7)) * 8];
        acc[m] = mfma16(af, bf, acc[m]);
      }
    }
  }
  __syncthreads();
  bf16_t* Yt = (kind ? opq(p.YTc) : opq(p.YTl)) + ((size_t)c * 16 + fr) * L + tb;
#pragma unroll
  for (int m = 0; m < 4; ++m) {
    int t = (wid * 4 + m) * 16 + fq * 4;
    *(uint2*)(Yt + t) = make_uint2(pack2(acc[m][0], acc[m][1]), pack2(acc[m][2], acc[m][3]));
  }
}

DEV void hyena_post_unit(const P& p, int layer, int unit, char* smem) {
  int kind, b, t0, L;
  if (unit < 1024) { kind = 0; b = unit >> 6; t0 = (unit & 63) * 64; L = T; } else { int u = unit - 1024; kind = 1; b = u >> 2; t0 = (u & 3) * 64; L = LC; }
  const int c = tid_(), lane = c & 63, wid = c >> 6;
  const size_t row0 = (size_t)b * LT + (kind ? 0 : LC);
  bf16_t (*tile)[264] = (bf16_t (*)[264])smem;
  const float* cw = p.conv_w + (size_t)layer * 3 * 1536;
  const float wa = cw[c], wb = cw[1536 + c], wcc = cw[3072 + c], b0 = p.conv_b[layer * 1536 + c];
  const float bias = p.hy_bias[layer * 256 + c];
  const bf16_t* yt = (kind ? opq(p.YTc) : opq(p.YTl)) + ((size_t)c * 16 + b) * L + t0;
  const bf16_t* ut = (kind ? opq(p.UTc) : opq(p.UTl)) + ((size_t)c * 16 + b) * L + t0;
  auto ld = [&](int t) -> float { return (t >= 0 && t < L) ? bf2f(p.Z[(row0 + t) * INW + c]) : 0.f; };
  float xm = ld(t0 - 1), xc = ld(t0);
  __syncthreads();
#pragma unroll 1
  for (int i8 = 0; i8 < 8; ++i8) {
    uint4 yu = *(const uint4*)(yt + 8 * i8), uu = *(const uint4*)(ut + 8 * i8);
    float yv[8], uv[8];
    unpack8(yu, yv); unpack8(uu, uv);
#pragma unroll
    for (int i = 0; i < 8; ++i) {
      int t = t0 + i8 * 8 + i;
      float xn = ld(t + 1);
      float x0 = wa * xm + wb * xc + wcc * xn + b0;
      float o = x0 * (yv[i] + uv[i] * bias);
      tile[i8 * 8 + i][c] = f2bf(o);
      xm = xc; xc = xn;
    }
  }
  __syncthreads();
  for (int i = 0; i < 16; ++i) {
    int tl = wid * 16 + i;
    uint2 ou = *(const uint2*)&tile[tl][4 * lane];
    float o[4] = {bflo(ou.x), bfhi(ou.x), bflo(ou.y), bfhi(ou.y)};
    float ss = wave_sum(o[0] * o[0] + o[1] * o[1] + o[2] * o[2] + o[3] * o[3]);
    float rstd = rsqrtf(ss * (1.f / 256.f) + 1e-6f);
#pragma unroll
    for (int q = 0; q < 4; ++q) {
      o[q] = o[q] * rstd * p.hy_out_g[layer * 256 + 4 * lane + q];
#if !EN_HY
      o[q] = 0.f;
#endif
    }
    *(uint2*)(p.Y + (row0 + t0 + tl) * D + 4 * lane) = make_uint2(pack2(o[0], o[1]), pack2(o[2], o[3]));
  }
}

DEV void attn_unit(const P& p, int layer, int unit, char* smem) {
  const bool isctx = unit >= 4096;
  int b, qb, hq;
  if (!isctx) { b = unit >> 8; qb = (unit >> 3) & 31; hq = unit & 7; } else { int u = unit - 4096; b = u >> 4; qb = (u >> 3) & 1; hq = u & 7; }
  const int g = hq >> 2;
  const int tid = tid_(), lane = tid & 63, wid = tid >> 6, qn = lane & 31, hh = lane >> 5;
  const int qpos = qb * 128 + wid * 32 + qn;
  const size_t qrow = (size_t)b * LT + (isctx ? qpos : LC + qpos);
  const bf16_t* qptr = p.Z + qrow * INW + 1920 + hq * 64;
  bf16x8 qf[4];
#pragma unroll
  for (int s = 0; s < 4; ++s) qf[s] = *(const bf16x8*)(qptr + 16 * s + 8 * hh);
  const float sink = p.attn_sink[layer * 8 + hq];
  float m_run = sink, l_run = 1.f;
  f32x16 o0, o1;
#pragma unroll
  for (int i = 0; i < 16; ++i) { o0[i] = 0.f; o1[i] = 0.f; }
  typedef bf16_t KTile[64][72];
  KTile* Ks = (KTile*)smem;
  KTile* Vt = (KTile*)(smem + 18432);
  const int ntl = isctx ? 0 : 6;
  const int ntiles = ntl + 4;
  const int skey = tid >> 3, sseg = tid & 7;
  const bf16_t* kvbase = p.Z + (size_t)b * LT * INW + 1920 + 512 + g * 64 + sseg * 8;
  uint4 rk0, rk1, rv0, rv1;
  auto ldtile = [&](int kt) {
    const bool ctxk = kt >= ntl;
    const int kbase = ctxk ? (kt - ntl) * 64 : qb * 128 - 128 + kt * 64;
    const int kp0 = kbase + skey, kp1 = kp0 + 32;
    rk0 = rk1 = rv0 = rv1 = make_uint4(0, 0, 0, 0);
    if (ctxk || (kp0 >= 0 && kp0 < T)) { const bf16_t* src = kvbase + (size_t)(ctxk ? kp0 : LC + kp0) * INW; rk0 = *(const uint4*)src; rv0 = *(const uint4*)(src + 128); }
    if (ctxk || (kp1 >= 0 && kp1 < T)) { const bf16_t* src = kvbase + (size_t)(ctxk ? kp1 : LC + kp1) * INW; rk1 = *(const uint4*)src; rv1 = *(const uint4*)(src + 128); }
  };
  auto sttile = [&](int buf) {
    *(uint4*)&Ks[buf][skey][sseg * 8] = rk0;
    *(uint4*)&Ks[buf][skey + 32][sseg * 8] = rk1;
    bf16_t (*vt)[72] = Vt[buf];
    vt[sseg * 8 + 0][skey] = (bf16_t)(rv0.x & 0xFFFF); vt[sseg * 8 + 1][skey] = (bf16_t)(rv0.x >> 16);
    vt[sseg * 8 + 2][skey] = (bf16_t)(rv0.y & 0xFFFF); vt[sseg * 8 + 3][skey] = (bf16_t)(rv0.y >> 16);
    vt[sseg * 8 + 4][skey] = (bf16_t)(rv0.z & 0xFFFF); vt[sseg * 8 + 5][skey] = (bf16_t)(rv0.z >> 16);
    vt[sseg * 8 + 6][skey] = (bf16_t)(rv0.w & 0xFFFF); vt[sseg * 8 + 7][skey] = (bf16_t)(rv0.w >> 16);
    vt[sseg * 8 + 0][skey + 32] = (bf16_t)(rv1.x & 0xFFFF); vt[sseg * 8 + 1][skey + 32] = (bf16_t)(rv1.x >> 16);
    vt[sseg * 8 + 2][skey + 32] = (bf16_t)(rv1.y & 0xFFFF); vt[sseg * 8 + 3][skey + 32] = (bf16_t)(rv1.y >> 16);
    vt[sseg * 8 + 4][skey + 32] = (bf16_t)(rv1.z & 0xFFFF); vt[sseg * 8 + 5][skey + 32] = (bf16_t)(rv1.z >> 16);
    vt[sseg * 8 + 6][skey + 32] = (bf16_t)(rv1.w & 0xFFFF); vt[sseg * 8 + 7][skey + 32] = (bf16_t)(rv1.w >> 16);
  };
  ldtile(0);
#pragma unroll 1
  for (int kt = 0; kt < ntiles; ++kt) {
    const int buf = kt & 1;
    sttile(buf);
    __syncthreads();
    if (kt + 1 < ntiles) ldtile(kt + 1);
    const bool ctxk = kt >= ntl;
    const int kbase = ctxk ? (kt - ntl) * 64 : qb * 128 - 128 + kt * 64;
#pragma unroll
    for (int sub = 0; sub < 2; ++sub) {
      const int kb2 = kbase + sub * 32;
      bool need = true;
      if (!ctxk) {
        int q0 = qb * 128 + wid * 32;
        if (kb2 + 31 < q0 - 128 || kb2 > q0 + 31 + 128 || kb2 + 31 < 0 || kb2 >= T) need = false;
      }
      if (need) {
        f32x16 sv;
#pragma unroll
        for (int i = 0; i < 16; ++i) sv[i] = 0.f;
#pragma unroll
        for (int ks = 0; ks < 4; ++ks) {
          bf16x8 kf = *(const bf16x8*)&Ks[buf][sub * 32 + qn][16 * ks + 8 * hh];
          sv = mfma32(kf, qf[ks], sv);
        }
        float mt = -3e38f;
#pragma unroll
        for (int rg = 0; rg < 16; ++rg) {
          float v = sv[rg] * 0.125f;
          if (!ctxk) {
            int kp = kb2 + (rg & 3) + 8 * (rg >> 2) + 4 * hh;
            int dl = qpos - kp;
            bool ok = (dl <= 128) && (dl >= -128) && (kp >= 0) && (kp < T);
            v = ok ? v : -1e30f;
          }
          sv[rg] = v;
          mt = fmaxf(mt, v);
        }
        mt = fmaxf(mt, __shfl_xor(mt, 32));
        float m_new = fmaxf(m_run, mt);
        float corr = __expf(m_run - m_new);
        float ps = 0.f;
#pragma unroll
        for (int rg = 0; rg < 16; ++rg) { float pv = __expf(sv[rg] - m_new); sv[rg] = pv; ps += pv; }
        ps += __shfl_xor(ps, 32);
        l_run = l_run * corr + ps;
        m_run = m_new;
#pragma unroll
        for (int i = 0; i < 16; ++i) { o0[i] *= corr; o1[i] *= corr; }
#pragma unroll
        for (int sp = 0; sp < 2; ++sp) {
          bf16x8 pf;
#pragma unroll
          for (int j = 0; j < 8; ++j) pf[j] = (short)f2bf(sv[8 * sp + j]);
          const int kc = sub * 32 + 16 * sp + 4 * hh;
          uint2 va = *(const uint2*)&Vt[buf][qn][kc], vb = *(const uint2*)&Vt[buf][qn][kc + 8];
          uint2 vc = *(const uint2*)&Vt[buf][32 + qn][kc], vd = *(const uint2*)&Vt[buf][32 + qn][kc + 8];
          uint4 w0 = make_uint4(va.x, va.y, vb.x, vb.y), w1 = make_uint4(vc.x, vc.y, vd.x, vd.y);
          bf16x8 v0 = __builtin_bit_cast(bf16x8, w0), v1 = __builtin_bit_cast(bf16x8, w1);
          o0 = mfma32(v0, pf, o0);
          o1 = mfma32(v1, pf, o1);
        }
      }
    }
  }
  __syncthreads();
  const float inv = 1.f / l_run;
  bf16_t* optr = p.Y + qrow * D + 512 + hq * 64;
#pragma unroll
  for (int rg = 0; rg < 4; ++rg) {
    int d0 = 8 * rg + 4 * hh;
    *(uint2*)(optr + d0) = make_uint2(pack2(o0[4 * rg] * inv, o0[4 * rg + 1] * inv), pack2(o0[4 * rg + 2] * inv, o0[4 * rg + 3] * inv));
    *(uint2*)(optr + 32 + d0) = make_uint2(pack2(o1[4 * rg] * inv, o1[4 * rg + 1] * inv), pack2(o1[4 * rg + 2] * inv, o1[4 * rg + 3] * inv));
  }
}

DEV void ph_attn_post(const P& p, int layer) {
  const int gw = (bid_() * 256 + tid_()) >> 6, nw = gridDim.x * 4, lane = tid_() & 63;
  for (int row = gw; row < NTOK; row += nw) {
    bf16_t* yr = p.Y + (size_t)row * D + 512 + 8 * lane;
    uint4 u = *(const uint4*)yr;
    float v[8];
    unpack8(u, v);
    float ss = 0.f;
#pragma unroll
    for (int i = 0; i < 8; ++i) ss += v[i] * v[i];
    ss = wave_sum(ss);
    float rstd = rsqrtf(ss * (1.f / 512.f) + 1e-6f);
#pragma unroll
    for (int i = 0; i < 8; ++i) {
      v[i] = v[i] * rstd * p.at_out_g[layer * 512 + 8 * lane + i];
#if !EN_AT
      v[i] = 0.f;
#endif
    }
    *(uint4*)yr = pack8(v);
  }
}

struct Epi2 {
  const P& p; int layer, row0, col0;
  DEV void operator()(f32x4 (&acc)[4][4], int wr, int wc, int fr, int fq, char* smem) const {
    const int b = row0 / LT, pp = row0 % LT;
    const int mr = pp < LC ? 16 : b;
    const float* g1 = p.modv + ((size_t)layer * 17 + mr) * 6144 + 2048 + col0 + wc * 64;
#pragma unroll
    for (int n = 0; n < 4; ++n) {
      const float gv = g1[n * 16 + fr];
#pragma unroll
      for (int m = 0; m < 4; ++m)
#pragma unroll
        for (int j = 0; j < 4; ++j) acc[m][n][j] *= gv;
    }
    const int wid = wr * 2 + wc, lane = fq * 16 + fr;
    stage_tile_bf16(acc, smem, wid, fr, fq);
    const bf16_t (*t)[72] = (const bf16_t (*)[72])(smem + wid * 9216);
#pragma unroll
    for (int i = 0; i < 8; ++i) {
      const int rl = i * 8 + (lane >> 3), ch = lane & 7;
      bf16_t* xp = p.X + (size_t)(row0 + wr * 64 + rl) * D + col0 + wc * 64 + ch * 8;
      float xv[8], dv[8];
      uint4 xu = *(const uint4*)xp, du = *(const uint4*)&t[rl][ch * 8];
      unpack8(xu, xv); unpack8(du, dv);
#pragma unroll
      for (int q = 0; q < 8; ++q) xv[q] += dv[q];
#if EN_MIX
      *(uint4*)xp = pack8(xv);
#endif
    }
  }
};
DEV void ph_gemm2(const P& p, int layer, char* smem) {
  int rt, ct;
  for (int it = 0; gemm_unit(it, 8, rt, ct); ++it) {
    Epi2 epi{p, layer, rt * 128, ct * 128};
    gemm_tile(p.Y + (size_t)rt * 128 * D, D, p.W2t + (size_t)ct * 128 * D, D, D, smem, epi);
  }
}

DEV void ph_peerconv(const P& p, int layer) {
  const int gw = (bid_() * 256 + tid_()) >> 6, nw = gridDim.x * 4, lane = tid_() & 63;
  const float* su = opq(p.peer_u) + (size_t)layer * 16384 * 1024;
  const float* sv = opq(p.peer_v) + (size_t)layer * 16384 * 1024;
  unsigned char* pu = opq(p.PU); unsigned char* pv = opq(p.PV);
  float* psu = opq(p.PSU); float* psv = opq(p.PSV);
#pragma unroll 1
  for (int r = gw; r < 32768; r += nw) {
    const bool isv = r >= 16384;
    const int e = r & 16383;
    const float* src = (isv ? sv : su) + (size_t)e * 1024 + 16 * lane;
    float4 f0 = *(const float4*)src, f1 = *(const float4*)(src + 4), f2 = *(const float4*)(src + 8), f3 = *(const float4*)(src + 12);
    float am = fmaxf(fmaxf(fmaxf(fabsf(f0.x), fabsf(f0.y)), fmaxf(fabsf(f0.z), fabsf(f0.w))), fmaxf(fmaxf(fabsf(f1.x), fabsf(f1.y)), fmaxf(fabsf(f1.z), fabsf(f1.w))));
    am = fmaxf(am, fmaxf(fmaxf(fmaxf(fabsf(f2.x), fabsf(f2.y)), fmaxf(fabsf(f2.z), fabsf(f2.w))), fmaxf(fmaxf(fabsf(f3.x), fabsf(f3.y)), fmaxf(fabsf(f3.z), fabsf(f3.w)))));
    am = wave_max(am);
    const float sc = am > 0.f ? 224.f / am : 1.f;
    int w0 = __builtin_amdgcn_cvt_pk_fp8_f32(f0.x * sc, f0.y * sc, 0, false); w0 = __builtin_amdgcn_cvt_pk_fp8_f32(f0.z * sc, f0.w * sc, w0, true);
    int w1 = __builtin_amdgcn_cvt_pk_fp8_f32(f1.x * sc, f1.y * sc, 0, false); w1 = __builtin_amdgcn_cvt_pk_fp8_f32(f1.z * sc, f1.w * sc, w1, true);
    int w2 = __builtin_amdgcn_cvt_pk_fp8_f32(f2.x * sc, f2.y * sc, 0, false); w2 = __builtin_amdgcn_cvt_pk_fp8_f32(f2.z * sc, f2.w * sc, w2, true);
    int w3 = __builtin_amdgcn_cvt_pk_fp8_f32(f3.x * sc, f3.y * sc, 0, false); w3 = __builtin_amdgcn_cvt_pk_fp8_f32(f3.z * sc, f3.w * sc, w3, true);
    *(uint4*)((isv ? pv : pu) + (size_t)(lane >> 3) * PSLICE + (size_t)e * 128 + 16 * (lane & 7)) = make_uint4((unsigned)w0, (unsigned)w1, (unsigned)w2, (unsigned)w3);
    if (lane == 0) (isv ? psv : psu)[e] = am > 0.f ? am * (1.f / 224.f) : 1.f;
  }
}
DEV void unpack16_fp8x2(const uint4& u, f32x2* f) {
  f[0] = __builtin_amdgcn_cvt_pk_f32_fp8((int)u.x, false); f[1] = __builtin_amdgcn_cvt_pk_f32_fp8((int)u.x, true);
  f[2] = __builtin_amdgcn_cvt_pk_f32_fp8((int)u.y, false); f[3] = __builtin_amdgcn_cvt_pk_f32_fp8((int)u.y, true);
  f[4] = __builtin_amdgcn_cvt_pk_f32_fp8((int)u.z, false); f[5] = __builtin_amdgcn_cvt_pk_f32_fp8((int)u.z, true);
  f[6] = __builtin_amdgcn_cvt_pk_f32_fp8((int)u.w, false); f[7] = __builtin_amdgcn_cvt_pk_f32_fp8((int)u.w, true);
}
DEV void unpack16_fp8(const uint4& u, float* f) {
  f32x2 t;
  t = __builtin_amdgcn_cvt_pk_f32_fp8((int)u.x, false); f[0] = t[0]; f[1] = t[1];
  t = __builtin_amdgcn_cvt_pk_f32_fp8((int)u.x, true); f[2] = t[0]; f[3] = t[1];
  t = __builtin_amdgcn_cvt_pk_f32_fp8((int)u.y, false); f[4] = t[0]; f[5] = t[1];
  t = __builtin_amdgcn_cvt_pk_f32_fp8((int)u.y, true); f[6] = t[0]; f[7] = t[1];
  t = __builtin_amdgcn_cvt_pk_f32_fp8((int)u.z, false); f[8] = t[0]; f[9] = t[1];
  t = __builtin_amdgcn_cvt_pk_f32_fp8((int)u.z, true); f[10] = t[0]; f[11] = t[1];
  t = __builtin_amdgcn_cvt_pk_f32_fp8((int)u.w, false); f[12] = t[0]; f[13] = t[1];
  t = __builtin_amdgcn_cvt_pk_f32_fp8((int)u.w, true); f[14] = t[0]; f[15] = t[1];
}

struct Epi3 {
  const P& p; int row0, grp;
  DEV void operator()(f32x4 (&acc)[4][4], int wr, int wc, int fr, int fq, char* smem) const {
    float* sc = (float*)smem;
    const int tid = tid_();
    for (int pass = 0; pass < 2; ++pass) {
      __syncthreads();
      if (wr == pass) {
#pragma unroll
        for (int m = 0; m < 4; ++m)
#pragma unroll
          for (int n = 0; n < 4; ++n)
#pragma unroll
            for (int j = 0; j < 4; ++j) {
              int rl = m * 16 + fq * 4 + j, col = wc * 64 + n * 16 + fr;
              unsigned bits = (__float_as_uint(acc[m][n][j]) & ~127u) | (unsigned)col;
              sc[rl * 133 + (col >> 5) * 33 + (col & 31)] = __uint_as_float(bits);
            }
      }
      __syncthreads();
      const int rl = tid >> 2, q = tid & 3;
      float Ls[16];
#pragma unroll
      for (int i = 0; i < 16; ++i) Ls[i] = -3e38f;
      const float* src = sc + rl * 133 + q * 33;
      for (int i = 0; i < 32; ++i) {
        float x = src[i];
        if (x > Ls[15]) {
#pragma unroll
          for (int k = 0; k < 16; ++k) { float hi = fmaxf(Ls[k], x); x = fminf(Ls[k], x); Ls[k] = hi; }
        }
      }
      float Cs[16];
#pragma unroll
      for (int i = 0; i < 16; ++i) Cs[i] = fmaxf(Ls[i], dppself<0xB1, 0xF>(Ls[15 - i]));
#pragma unroll
      for (int d = 8; d >= 1; d >>= 1)
#pragma unroll
        for (int i = 0; i < 16; ++i)
          if ((i & d) == 0) { float hi = fmaxf(Cs[i], Cs[i + d]), lo = fminf(Cs[i], Cs[i + d]); Cs[i] = hi; Cs[i + d] = lo; }
      float Ds[16];
#pragma unroll
      for (int i = 0; i < 16; ++i) Ds[i] = fmaxf(Cs[i], dppself<0x4E, 0xF>(Cs[15 - i]));
#pragma unroll
      for (int d = 8; d >= 1; d >>= 1)
#pragma unroll
        for (int i = 0; i < 16; ++i)
          if ((i & d) == 0) { float hi = fmaxf(Ds[i], Ds[i + d]), lo = fminf(Ds[i], Ds[i + d]); Ds[i] = hi; Ds[i + d] = lo; }
      if (q == 0) {
        float* dst = p.TK + ((size_t)(row0 + pass * 64 + rl) * 16 + grp) * 16;
#pragma unroll
        for (int i = 0; i < 4; ++i) *(float4*)(dst + 4 * i) = make_float4(Ds[4 * i], Ds[4 * i + 1], Ds[4 * i + 2], Ds[4 * i + 3]);
      }
    }
  }
};
DEV void ph_gemm3(const P& p, char* smem) {
  int rt, ct;
  for (int it = 0; gemm_unit(it, 16, rt, ct); ++it) {
    Epi3 epi{p, rt * 128, ct};
    gemm_tile(p.H + (size_t)rt * 128 * D, D, p.Wft + (size_t)ct * 128 * D, D, D, smem, epi);
  }
}

DEV float peer_gate(float scr) {
  float mx = row16_max(scr);
  float ex = __expf(scr - mx);
  float sm = row16_sum(ex);
  return ex / sm;
}
DEV float gelu_exact(float x) { return 0.5f * x * (1.f + erff(x * 0.7071067811865476f)); }

DEV void ph_peer_select(const P& p) {
  const int gw = (bid_() * 256 + tid_()) >> 6, nw = gridDim.x * 4, lane = tid_() & 63;
  int ci, cj;
  {
    const int c = lane;
    if (c < 16) { ci = 0; cj = c; } else if (c < 24) { ci = 1; cj = c - 16; } else if (c < 29) { ci = 2; cj = c - 24; }
    else if (c < 33) { ci = 3; cj = c - 29; } else if (c < 36) { ci = 4; cj = c - 33; } else if (c < 38) { ci = 5; cj = c - 36; }
    else if (c < 40) { ci = 6; cj = c - 38; } else if (c < 42) { ci = 7; cj = c - 40; } else { ci = (c - 42 + 8) & 15; cj = 0; }
  }
  const bool cand = lane < 50;
  float v1s[8], v2s[8];
  auto ldtk = [&](int row) {
    const float* tk = p.TK + (size_t)row * 256;
#pragma unroll
    for (int h = 0; h < 8; ++h) { v1s[h] = tk[(2 * h) * 16 + ci]; v2s[h] = tk[(2 * h + 1) * 16 + cj]; }
  };
  if (gw < NTOK) ldtk(gw);
#pragma unroll 1
  for (int row = gw; row < NTOK; row += nw) {
    float c1[8], c2[8];
#pragma unroll
    for (int h = 0; h < 8; ++h) { c1[h] = v1s[h]; c2[h] = v2s[h]; }
    if (row + nw < NTOK) ldtk(row + nw);
#pragma unroll
    for (int h = 0; h < 8; ++h) {
      const float v1 = c1[h], v2 = c2[h];
      float val = v1 + v2;
      val = __uint_as_float((__float_as_uint(val) & ~63u) | (unsigned)lane);
      val = cand ? val : -3e38f;
      int rank = 0;
#pragma unroll
      for (int q = 0; q < 50; ++q) rank += (readlane_f(val, q) > val) ? 1 : 0;
      const bool sel = cand && rank < 16;
      const float mx = wave_max(val);
      const float ex = sel ? __expf(val - mx) : 0.f;
      const float sm = wave_sum(ex);
      if (sel) {
        const int e = (int)(__float_as_uint(v1) & 127u) * 128 + (int)(__float_as_uint(v2) & 127u);
        p.EL[(size_t)row * 128 + h * 16 + rank] = (unsigned short)e;
        p.GT[(size_t)row * 128 + h * 16 + rank] = ex / sm;
      }
    }
  }
}

struct PeerPre { uint4 e0, e1, a0, a1, a2, a3; };
DEV unsigned peer_eid(const PeerPre& s, int j) {
  const unsigned w = (j < 8) ? ((j >> 1) == 0 ? s.e0.x : (j >> 1) == 1 ? s.e0.y : (j >> 1) == 2 ? s.e0.z : s.e0.w)
                             : (((j - 8) >> 1) == 0 ? s.e1.x : ((j - 8) >> 1) == 1 ? s.e1.y : ((j - 8) >> 1) == 2 ? s.e1.z : s.e1.w);
  return (j & 1) ? (w >> 16) : (w & 0xFFFFu);
}
template <int WHICH>
DEV void peer_wave_run(const P& p, int layer, int x, int tok0, int lane, float* wbuf) {
  const int r = lane >> 3, c = lane & 7;
  const unsigned char* tb = (WHICH == 0 ? p.PU : p.PV) + (size_t)x * PSLICE + c * 16;
  PeerPre S[3];
  uint4 R[16];
  auto ld_pre = [&](int tok, PeerPre& s) {
    const uint4* elp = (const uint4*)(p.EL + (size_t)tok * 128 + r * 16);
    s.e0 = elp[0]; s.e1 = elp[1];
    if (WHICH == 0) {
      const bf16_t* hr = p.H + (size_t)tok * D + x * 128 + c * 16;
      s.a0 = *(const uint4*)hr; s.a1 = *(const uint4*)(hr + 8);
    } else {
      const uint4* wtp = (const uint4*)(p.GT + (size_t)tok * 128 + r * 16);
      s.a0 = wtp[0]; s.a1 = wtp[1]; s.a2 = wtp[2]; s.a3 = wtp[3];
    }
  };
  auto comp = [&](int tok, const PeerPre& s, const PeerPre& sn, bool more) {
    if (WHICH == 0) {
      float hv[16];
      unpack8(s.a0, hv); unpack8(s.a1, hv + 8);
      f32x2 hv2[8];
#pragma unroll
      for (int i = 0; i < 8; ++i) hv2[i] = (f32x2){hv[2 * i], hv[2 * i + 1]};
      float keep0 = 0.f, keep1 = 0.f;
#pragma unroll
      for (int j = 0; j < 16; ++j) {
        f32x2 f[8];
        unpack16_fp8x2(R[j], f);
        if (more) R[j] = *(const uint4*)(tb + (size_t)peer_eid(sn, j) * 128);
        f32x2 d2 = f[0] * hv2[0];
#pragma unroll
        for (int i = 1; i < 8; ++i) d2 += f[i] * hv2[i];
        const float d = oct_sum(d2[0] + d2[1]);
        if (j < 8) keep0 = (c == j) ? d : keep0; else keep1 = (c == j - 8) ? d : keep1;
      }
      float* pd = p.PD + ((size_t)x * NTOK + tok) * 128 + r * 16 + c;
      pd[0] = keep0; pd[8] = keep1;
    } else {
      const float wsv[16] = {__uint_as_float(s.a0.x), __uint_as_float(s.a0.y), __uint_as_float(s.a0.z), __uint_as_float(s.a0.w),
                             __uint_as_float(s.a1.x), __uint_as_float(s.a1.y), __uint_as_float(s.a1.z), __uint_as_float(s.a1.w),
                             __uint_as_float(s.a2.x), __uint_as_float(s.a2.y), __uint_as_float(s.a2.z), __uint_as_float(s.a2.w),
                             __uint_as_float(s.a3.x), __uint_as_float(s.a3.y), __uint_as_float(s.a3.z), __uint_as_float(s.a3.w)};
      f32x2 acc2[8];
#pragma unroll
      for (int i = 0; i < 8; ++i) acc2[i] = (f32x2){0.f, 0.f};
#pragma unroll
      for (int j = 0; j < 16; ++j) {
        f32x2 f[8];
        unpack16_fp8x2(R[j], f);
        if (more) R[j] = *(const uint4*)(tb + (size_t)peer_eid(sn, j) * 128);
        const f32x2 w2 = (f32x2){wsv[j], wsv[j]};
#pragma unroll
        for (int i = 0; i < 8; ++i) acc2[i] += w2 * f[i];
      }
      float* slab = wbuf + (r * 8 + c) * 16;
      *(float4*)(slab) = make_float4(acc2[0][0], acc2[0][1], acc2[1][0], acc2[1][1]);
      *(float4*)(slab + 4) = make_float4(acc2[2][0], acc2[2][1], acc2[3][0], acc2[3][1]);
      *(float4*)(slab + 8) = make_float4(acc2[4][0], acc2[4][1], acc2[5][0], acc2[5][1]);
      *(float4*)(slab + 12) = make_float4(acc2[6][0], acc2[6][1], acc2[7][0], acc2[7][1]);
      asm volatile("s_waitcnt lgkmcnt(0)" ::: "memory");
      float o0 = 0.f, o1 = 0.f;
#pragma unroll
      for (int rr = 0; rr < 8; ++rr) {
        const float2 t = *(const float2*)(wbuf + (rr * 8 + (lane >> 3)) * 16 + 2 * (lane & 7));
        o0 += t.x; o1 += t.y;
      }
      asm volatile("s_waitcnt lgkmcnt(0)" ::: "memory");
      const int b = tok / LT, pp = tok % LT;
      const int mr = pp < LC ? 16 : b;
      const int col = x * 128 + 2 * lane;
      const float* g2 = p.modv + ((size_t)layer * 17 + mr) * 6144 + 5120 + col;
      unsigned* xp = (unsigned*)(p.X + (size_t)tok * D + col);
      const unsigned xu = *xp;
#if EN_PEER
      *xp = pack2(bflo(xu) + g2[0] * o0, bfhi(xu) + g2[1] * o1);
#endif
    }
  };
  ld_pre(tok0, S[0]);
  ld_pre(tok0 + 1, S[1]);
#pragma unroll
  for (int j = 0; j < 16; ++j) R[j] = *(const uint4*)(tb + (size_t)peer_eid(S[0], j) * 128);
  ld_pre(tok0 + 2, S[2]);
#pragma unroll
  for (int t = 0; t < 8; ++t) {
    comp(tok0 + t, S[t % 3], S[(t + 1) % 3], t + 1 < 8);
    if (t + 3 < 8) ld_pre(tok0 + t + 3, S[t % 3]);
  }
}
DEV void ph_peer_w(const P& p) {
  for (size_t i = (size_t)bid_() * 256 + tid_(); i < (size_t)NTOK * 128; i += (size_t)gridDim.x * 256) {
    float d = 0.f;
#pragma unroll
    for (int x = 0; x < 8; ++x) d += p.PD[(size_t)x * NTOK * 128 + i];
    const int e = p.EL[i];
    p.GT[i] = p.GT[i] * gelu_exact(d * p.PSU[e]) * p.PSV[e];
  }
}
template <int WHICH>
DEV void ph_peer_gather(const P& p, int layer, char* smem, volatile LAS unsigned* slot) {
  const int tid = tid_(), lane = tid & 63, wid = tid >> 6;
  unsigned* q = p.wq + 1024 + layer * 256 + WHICH * 128;
  const int my = (int)(xb_xcc_id() & 7u);
  float* wbuf = (float*)smem + wid * 1024;
#pragma unroll 1
  for (int rot = 0; rot < 8; ++rot) {
    const int x = (my + rot) & 7;
    for (;;) {
      __syncthreads();
      if (tid == 0) *slot = atomicAdd(q + x * 16, 1u);
      __syncthreads();
      const int it = (int)*slot;
      if (it >= NTOK / 32) break;
      peer_wave_run<WHICH>(p, layer, x, it * 32 + wid * 8, lane, wbuf);
    }
  }
}

DEV void ph_final(const P& p) {
  const int gw = (bid_() * 256 + tid_()) >> 6, nw = gridDim.x * 4, lane = tid_() & 63;
  for (int r = gw; r < NB * T; r += nw) {
    int b = r / T, t = r % T;
    const bf16_t* xr = p.X + ((size_t)b * LT + LC + t) * D;
    uint4 u0 = *(const uint4*)(xr + 8 * lane), u1 = *(const uint4*)(xr + 512 + 8 * lane);
    float v[16];
    unpack8(u0, v); unpack8(u1, v + 8);
    float ss = 0.f;
#pragma unroll
    for (int i = 0; i < 16; ++i) ss += v[i] * v[i];
    ss = wave_sum(ss);
    float rstd = rsqrtf(ss * (1.f / 1024.f) + 1e-6f);
    float* o = p.out + (size_t)r * D;
#pragma unroll
    for (int hh = 0; hh < 2; ++hh) {
      int col = hh * 512 + 8 * lane;
      float4 a = make_float4(v[hh * 8 + 0] * rstd * p.final_g[col + 0], v[hh * 8 + 1] * rstd * p.final_g[col + 1], v[hh * 8 + 2] * rstd * p.final_g[col + 2], v[hh * 8 + 3] * rstd * p.final_g[col + 3]);
      float4 c = make_float4(v[hh * 8 + 4] * rstd * p.final_g[col + 4], v[hh * 8 + 5] * rstd * p.final_g[col + 5], v[hh * 8 + 6] * rstd * p.final_g[col + 6], v[hh * 8 + 7] * rstd * p.final_g[col + 7]);
      *(float4*)(o + col) = a; *(float4*)(o + col + 4) = c;
    }
  }
}

DEV unsigned hw_cu_key() {
  const unsigned hwid = (unsigned)__builtin_amdgcn_s_getreg(((8 - 1) << 11) | (8 << 6) | 4);
  return (xb_xcc_id() << 8) | (hwid & 0xFFu);
}
DEV void mixB(const P& p, int layer, char* smem, volatile LAS unsigned* slot) {
  unsigned* qa = p.wq + layer * 64;
  unsigned* qs = qa + 16;
  unsigned* claim = p.cuclaim + layer * 4096;
  __syncthreads();
  if (tid_() == 0) {
    unsigned u = 0xFFFFFFFFu;
    if (atomicAdd(&claim[hw_cu_key() & 4095u], 1u) == 0u) u = atomicAdd(qs, 1u);
    *slot = u;
  }
  __syncthreads();
  {
    const unsigned u = *slot;
    if (u < 128u) scanc_unit(p, layer, (int)u, smem);
  }
  for (;;) {
    __syncthreads();
    if (tid_() == 0) *slot = atomicAdd(qa, 1u);
    __syncthreads();
    const int u = (int)*slot;
    if (u >= 8704) break;
    if (u < 4352) attn_unit(p, layer, u, smem); else hyena_conv_unit(p, layer, u - 4352, smem);
  }
  for (;;) {
    __syncthreads();
    if (tid_() == 0) *slot = atomicAdd(qs, 1u);
    __syncthreads();
    const unsigned u = *slot;
    if (u >= 128u) break;
    scanc_unit(p, layer, (int)u, smem);
  }
}
DEV void mixA(const P& p, int layer, char* smem) {
  for (int u = bid_(); u < 1088; u += gridDim.x) hyena_pre_unit(p, layer, u);
  ph_lora(p, layer, smem);
  ph_rwkv_prep(p, layer);
}
DEV void mixC(const P& p, int layer, char* smem) {
  for (int u = bid_(); u < 1088; u += gridDim.x) hyena_post_unit(p, layer, u, smem);
  ph_rwkv_post(p, layer);
  ph_attn_post(p, layer);
}

__global__ void __launch_bounds__(256, 2) k_mega(P p) {
  extern __shared__ __attribute__((aligned(16))) char smem_all[];
  char* smem = smem_all;
  volatile LAS unsigned* xbw = (volatile LAS unsigned*)(smem_all + SMEM_BYTES);
  if (threadIdx.x == 0) { xbw[0] = 0u; xbw[1] = 0u; xbw[2] = 0u; xbw[3] = 0u; }
  __syncthreads();
  XcdBarrier bar = xcd_barrier_post(p.bar, xbw);
#ifndef NO_PRO
  ph_copy(p);
  ph_rope(p);
  for (int u = blockIdx.x; u < 96; u += gridDim.x) modv_unit(p, u, smem);
#endif
#ifndef NO_PREP
  ph_prep(p, 0, smem);
#endif
  xcd_barrier(bar);
  for (int layer = 0; layer < NLAYERS; ++layer) {
#ifndef NO_NORM
    ph_norm(p, layer, 0);
#endif
    xcd_barrier(bar);
#ifdef PROBE_GEMM
    ph_gemm1(p, smem);
#endif
#ifndef NO_GEMM1
    ph_gemm1(p, smem);
#endif
    xcd_barrier(bar);
#ifndef NO_MIXA
    mixA(p, layer, smem);
#endif
    xcd_barrier(bar);
#ifndef NO_MIXB
    mixB(p, layer, smem, (volatile LAS unsigned*)(smem_all + SMEM_BYTES + 16));
#endif
    xcd_barrier(bar);
#ifndef NO_MIXC
    mixC(p, layer, smem);
#endif
    xcd_barrier(bar);
#ifndef NO_GEMM2
    ph_gemm2(p, layer, smem);
    ph_peerconv(p, layer);
#endif
    xcd_barrier(bar);
#ifndef NO_NORM
    ph_norm(p, layer, 1);
#endif
    xcd_barrier(bar);
#ifdef PROBE_GEMM
    ph_gemm3(p, smem);
#endif
#ifndef NO_GEMM3
    ph_gemm3(p, smem);
#endif
    xcd_barrier(bar);
    ph_peer_select(p);
    xcd_barrier(bar);
    ph_peer_gather<0>(p, layer, smem, (volatile LAS unsigned*)(smem_all + SMEM_BYTES + 16));
    xcd_barrier(bar);
    ph_peer_w(p);
    xcd_barrier(bar);
    ph_peer_gather<1>(p, layer, smem, (volatile LAS unsigned*)(smem_all + SMEM_BYTES + 16));
#ifndef NO_PREP
    if (layer + 1 < NLAYERS) ph_prep(p, layer + 1, smem);
#endif
    xcd_barrier(bar);
  }
  ph_final(p);
}

static inline size_t al256(size_t x) { return (x + 255) & ~(size_t)255; }

extern "C" void kernel_launch(void* const* d_in, const int* in_sizes, int n_in, void* d_out, int out_size, void* d_ws, size_t ws_size,
                              hipStream_t stream) {
  (void)in_sizes; (void)n_in; (void)out_size; (void)ws_size;
  P p{};
  const float** f = (const float**)&p;
  for (int i = 0; i < 39; ++i) f[i] = (const float*)d_in[i];
  p.out = (float*)d_out;
  char* w = (char*)d_ws;
  size_t off = 0;
  auto take = [&](size_t bytes) { char* r = w + off; off += al256(bytes); return r; };
  p.bar = (unsigned*)take(16384);
  p.modv = (float*)take((size_t)DEPTH * 17 * 6144 * 4);
  p.SSQ = (float*)take((size_t)DEPTH * 2 * 256 * 4);
  p.wq = (unsigned*)take(4096 + DEPTH * 1024);
  p.cuclaim = (unsigned*)take((size_t)DEPTH * 4096 * 4);
  const size_t zero_bytes = off;
  p.rope = (float*)take(64 * 16 * 2 * 4);
  p.X = (bf16_t*)take((size_t)NTOK * D * 2);
  p.H = (bf16_t*)take((size_t)NTOK * D * 2);
  p.Y = (bf16_t*)take((size_t)NTOK * D * 2);
  p.SC = (bf16_t*)take((size_t)NTOK * 1024 * 2);
  p.Z = (bf16_t*)take((size_t)NTOK * INW * 2);
  p.UTl = (bf16_t*)take((size_t)256 * 16 * T * 2);
  p.UTc = (bf16_t*)take((size_t)256 * 16 * LC * 2);
  p.YTl = (bf16_t*)take((size_t)256 * 16 * T * 2);
  p.YTc = (bf16_t*)take((size_t)256 * 16 * LC * 2);
  p.FL = (float*)take((size_t)256 * 2 * T * 4);
  p.FC = (float*)take((size_t)256 * 2 * LC * 4);
  p.W1t = (bf16_t*)take((size_t)INW * D * 2);
  p.W2t = (bf16_t*)take((size_t)D * D * 2);
  p.Wft = (bf16_t*)take((size_t)2048 * D * 2);
  p.Wlt = (bf16_t*)take((size_t)1024 * 256 * 2);
  p.Wgt = (bf16_t*)take((size_t)256 * 128 * 2);
  p.TK = (float*)p.Z;
  p.PU = (unsigned char*)p.Z + al256((size_t)NTOK * 256 * 4);
  p.PV = p.PU + (size_t)16384 * 1024;
  p.PSU = (float*)(p.PV + (size_t)16384 * 1024);
  p.PSV = p.PSU + 16384;
  p.GT = p.PSV + 16384;
  p.EL = (unsigned short*)(p.GT + (size_t)NTOK * 128);
  p.PD = (float*)p.Y;

  (void)hipMemsetAsync(d_ws, 0, zero_bytes, stream);
  constexpr size_t kDynLds = SMEM_BYTES + 32;
  static int grid = 0;
  if (!grid) {
    int dev = 0, cus = 0, per_cu = 0;
    (void)hipGetDevice(&dev);
    (void)hipDeviceGetAttribute(&cus, hipDeviceAttributeMultiprocessorCount, dev);
    (void)hipFuncSetAttribute((const void*)k_mega, hipFuncAttributeMaxDynamicSharedMemorySize, (int)kDynLds);
    (void)hipOccupancyMaxActiveBlocksPerMultiprocessor(&per_cu, k_mega, 256, kDynLds);
    if (cus <= 0) cus = 256;
    if (per_cu > 2) per_cu = 2;
    if (per_cu < 1) per_cu = 1;
    grid = cus * per_cu;
  }
  k_mega<<<grid, 256, kDynLds, stream>>>(p);
}
```

```cpp
#include <hip/hip_runtime.h>
#include <stdint.h>
#include <type_traits>

#define DEV __device__ __forceinline__
typedef unsigned short bf16_t;
typedef short bf16x8 __attribute__((ext_vector_type(8)));
typedef float f32x2 __attribute__((ext_vector_type(2)));
constexpr size_t PSLICE = (size_t)16384 * 128;
typedef float f32x4 __attribute__((ext_vector_type(4)));
typedef float f32x16 __attribute__((ext_vector_type(16)));

#ifndef NLAYERS
#define NLAYERS 4
#endif
#ifndef EN_HY
#define EN_HY 1
#endif
#ifndef EN_RW
#define EN_RW 1
#endif
#ifndef EN_AT
#define EN_AT 1
#endif
#ifndef EN_MIX
#define EN_MIX 1
#endif
#ifndef EN_PEER
#define EN_PEER 1
#endif

constexpr int NB = 16, T = 4096, LC = 256, LT = 4352, D = 1024, NTOK = NB * LT, INW = 2688, DEPTH = 4;
constexpr int SMEM_BYTES = 65536;

struct P {
  const float *x, *c, *ctx, *c_ctx, *mod_w, *mod_b, *norm1_g, *norm2_g, *w_in, *conv_w, *conv_b;
  const float *hy_w1, *hy_b1, *hy_w2, *hy_b2, *hy_w3, *hy_b3, *hy_freq, *hy_bias;
  const float *rw_w0, *rw_w_up, *rw_a0, *rw_a_up, *rw_g_up, *rw_k_k, *rw_k_a, *rw_r_k, *rw_ln_w, *rw_ln_b;
  const float *attn_sink, *hy_out_g, *at_out_g, *w_out, *peer_wq, *peer_k1, *peer_k2, *peer_u, *peer_v, *final_g;
  float* out;
  unsigned* bar;
  float *modv, *SSQ, *rope, *FL, *FC, *TK;
  unsigned *wq, *cuclaim;
  bf16_t *X, *H, *Y, *SC, *Z, *UTl, *UTc, *YTl, *YTc;
  bf16_t *W1t, *W2t, *Wft, *Wlt, *Wgt;
  unsigned char *PU, *PV;
  float *PSU, *PSV, *GT, *PD;
  unsigned short* EL;
};

typedef __bf16 hwbf2 __attribute__((ext_vector_type(2)));
DEV unsigned pack2(float a, float b) { f32x2 f = {a, b}; hwbf2 r = __builtin_convertvector(f, hwbf2); return __builtin_bit_cast(unsigned, r); }
DEV bf16_t f2bf(float f) { return (bf16_t)(pack2(f, 0.f) & 0xFFFFu); }
DEV float bf2f(bf16_t h) { return __uint_as_float(((unsigned)h) << 16); }
DEV float bflo(unsigned u) { return __uint_as_float(u << 16); }
DEV float bfhi(unsigned u) { return __uint_as_float(u & 0xFFFF0000u); }
DEV void unpack8(const uint4& u, float* v) {
  v[0] = bflo(u.x); v[1] = bfhi(u.x); v[2] = bflo(u.y); v[3] = bfhi(u.y);
  v[4] = bflo(u.z); v[5] = bfhi(u.z); v[6] = bflo(u.w); v[7] = bfhi(u.w);
}
DEV uint4 pack8(const float* v) { return make_uint4(pack2(v[0], v[1]), pack2(v[2], v[3]), pack2(v[4], v[5]), pack2(v[6], v[7])); }
DEV float sigmoidf_(float x) { return __builtin_amdgcn_rcpf(1.f + __expf(-x)); }

template <int CTRL, int ROWMASK>
DEV float dpp0(float x) {
  return __builtin_bit_cast(float, __builtin_amdgcn_update_dpp(0, __builtin_bit_cast(int, x), CTRL, ROWMASK, 0xF, false));
}
template <int CTRL, int ROWMASK>
DEV float dppself(float x) {
  int xi = __builtin_bit_cast(int, x);
  return __builtin_bit_cast(float, __builtin_amdgcn_update_dpp(xi, xi, CTRL, ROWMASK, 0xF, false));
}
DEV float readlane_f(float x, int l) { return __builtin_bit_cast(float, __builtin_amdgcn_readlane(__builtin_bit_cast(int, x), l)); }
DEV int lane_id() { return (int)__builtin_amdgcn_mbcnt_hi(~0u, __builtin_amdgcn_mbcnt_lo(~0u, 0u)); }
DEV float writelane_f(float val, int l, float old) { return lane_id() == l ? val : old; }
DEV int writelane_i(int val, int l, int old) { return lane_id() == l ? val : old; }
DEV float wave_sum(float x) {
  x += dpp0<0x111, 0xF>(x); x += dpp0<0x112, 0xF>(x); x += dpp0<0x114, 0xF>(x); x += dpp0<0x118, 0xF>(x);
  x += dpp0<0x142, 0xA>(x); x += dpp0<0x143, 0xC>(x);
  return readlane_f(x, 63);
}
DEV float wave_max(float x) {
  x = fmaxf(x, dppself<0x111, 0xF>(x)); x = fmaxf(x, dppself<0x112, 0xF>(x)); x = fmaxf(x, dppself<0x114, 0xF>(x));
  x = fmaxf(x, dppself<0x118, 0xF>(x)); x = fmaxf(x, dppself<0x142, 0xA>(x)); x = fmaxf(x, dppself<0x143, 0xC>(x));
  return readlane_f(x, 63);
}
DEV float row16_sum(float x) {
  x += dpp0<0xB1, 0xF>(x); x += dpp0<0x4E, 0xF>(x); x += dpp0<0x141, 0xF>(x); x += dpp0<0x140, 0xF>(x);
  return x;
}
DEV float row16_max(float x) {
  x = fmaxf(x, dppself<0xB1, 0xF>(x)); x = fmaxf(x, dppself<0x4E, 0xF>(x)); x = fmaxf(x, dppself<0x141, 0xF>(x));
  x = fmaxf(x, dppself<0x140, 0xF>(x));
  return x;
}
DEV float quad_sum(float x) { x += dpp0<0xB1, 0xF>(x); x += dpp0<0x4E, 0xF>(x); return x; }

DEV f32x4 mfma16(bf16x8 a, bf16x8 b, f32x4 c) { return __builtin_amdgcn_mfma_f32_16x16x32_bf16(a, b, c, 0, 0, 0); }
DEV f32x16 mfma32(bf16x8 a, bf16x8 b, f32x16 c) { return __builtin_amdgcn_mfma_f32_32x32x16_bf16(a, b, c, 0, 0, 0); }


#define XB_TMO      128
#define XB_XCNT(j)  (256  + 64 * (j))
#define XB_XSUB(j)  (1280 + 64 * (j))
#define XB_XGEN(j)  (2304 + 64 * (j))
#define XB_TOP      3328
#define XB_TOPGEN   3392
#define XCD_BAR_WORDS 3456
#define XB_SPIN_CAP (1u << 23)
#define LAS __attribute__((address_space(3)))

__device__ __forceinline__ unsigned xb_ld(unsigned* p)              { return __hip_atomic_load(p, __ATOMIC_RELAXED, __HIP_MEMORY_SCOPE_AGENT); }
__device__ __forceinline__ unsigned xb_add(unsigned* p, unsigned v) { return __hip_atomic_fetch_add(p, v, __ATOMIC_RELAXED, __HIP_MEMORY_SCOPE_AGENT); }
__device__ __forceinline__ unsigned xb_xcc_id() { return (unsigned)__builtin_amdgcn_s_getreg((3 << 11) | 20) & 0xFu; }
#define XB_SPIN(cond, bar) do { unsigned _sp = 0; while (cond) { __builtin_amdgcn_s_sleep(1); \
    if ((++_sp & 255u) == 0u) { if (xb_ld(&(bar)[XB_TMO])) break; if (_sp > XB_SPIN_CAP) { atomicAdd(&(bar)[XB_TMO], 1u); break; } } } } while (0)

struct XcdBarrier {
    unsigned* bar; unsigned x;
    volatile LAS unsigned* st;
};
__device__ __forceinline__ XcdBarrier xcd_barrier_post(unsigned* bar, volatile LAS unsigned* st) {
    XcdBarrier b; b.bar = bar; b.x = xb_xcc_id(); b.st = st;
    if (threadIdx.x == 0) (void)xb_add(&bar[XB_XCNT(b.x)], 1u);
    return b;
}
__device__ __forceinline__ void xcd_barrier_complete(unsigned* bar, unsigned x, unsigned& nloc, unsigned& nx) {
    const unsigned G = gridDim.x * gridDim.y * gridDim.z;
    unsigned sum, cnt, mine, sp = 0u;
    for (;;) {
        sum = 0u; cnt = 0u; mine = 0u;
#pragma unroll
        for (unsigned j = 0; j < 16; ++j) { const unsigned c = xb_ld(&bar[XB_XCNT(j)]); sum += c; cnt += (c > 0u) ? 1u : 0u; mine = (j == x) ? c : mine; }
        if (sum == G) break;
        __builtin_amdgcn_s_sleep(1);
        if ((++sp & 255u) == 0u) { if (xb_ld(&bar[XB_TMO])) break; if (sp > XB_SPIN_CAP) { atomicAdd(&bar[XB_TMO], 1u); break; } }
    }
    nloc = mine > 0u ? mine : 1u; nx = cnt > 0u ? cnt : 1u;
}
__device__ __forceinline__ void xcd_barrier(const XcdBarrier& b) {
    asm volatile("s_waitcnt vmcnt(0)" ::: "memory");
    __syncthreads();
    if (threadIdx.x == 0) {
        unsigned* bar = b.bar;
        __builtin_amdgcn_s_waitcnt(0);
        unsigned nloc = b.st[0], nx = b.st[1];
        if (nloc == 0u) { xcd_barrier_complete(bar, b.x, nloc, nx); b.st[0] = nloc; b.st[1] = nx; }
        const unsigned old = xb_add(&bar[XB_XSUB(b.x)], 1u);
        const unsigned gen = old / nloc;
        if (old + 1u == (gen + 1u) * nloc) {
            __builtin_amdgcn_fence(__ATOMIC_RELEASE, "agent");
            asm volatile("s_waitcnt vmcnt(0)" ::: "memory");
            const unsigned og = xb_add(&bar[XB_TOP], 1u);
            const unsigned tg = og / nx;
            if (og + 1u == (tg + 1u) * nx) xb_add(&bar[XB_TOPGEN], 1u);
            else XB_SPIN(xb_ld(&bar[XB_TOPGEN]) == tg, bar);
            __builtin_amdgcn_fence(__ATOMIC_ACQUIRE, "agent");
            xb_add(&bar[XB_XGEN(b.x)], 1u);
            asm volatile("s_waitcnt vmcnt(0)" ::: "memory");
        } else {
            XB_SPIN(xb_ld(&bar[XB_XGEN(b.x)]) == gen, bar);
            __builtin_amdgcn_fence(__ATOMIC_ACQUIRE, "agent");
            asm volatile("s_waitcnt vmcnt(0)" ::: "memory");
        }
    }
    __syncthreads();
}

template <class Tp> DEV Tp* opq(Tp* q) { asm volatile("" : "+s"(q)); return q; }
DEV int tid_() { int t = threadIdx.x; asm volatile("" : "+v"(t)); return t; }
DEV int bid_() { int b = blockIdx.x; asm volatile("" : "+s"(b)); return b; }

DEV void glds16(const void* gsrc, char* lds_lane_ptr) {
  __builtin_amdgcn_global_load_lds((const unsigned*)gsrc, (__attribute__((address_space(3))) unsigned*)lds_lane_ptr, 16, 0, 0);
}
template <class Epi>
DEV void gemm_tile(const bf16_t* __restrict__ A, int lda, const bf16_t* __restrict__ Bt, int ldb, int K, char* smem, Epi& epi) {
  const int tid = tid_(), lane = tid & 63, wid = tid >> 6, wr = wid >> 1, wc = wid & 1, fr = lane & 15, fq = lane >> 4;
  f32x4 acc[4][4];
#pragma unroll
  for (int m = 0; m < 4; ++m)
#pragma unroll
    for (int n = 0; n < 4; ++n) acc[m][n] = (f32x4){0.f, 0.f, 0.f, 0.f};
  const int drow0 = 8 * wid + (lane >> 3), dpc = lane & 7;
  auto issue = [&](int kt, int buf) {
    char* sa = smem + buf * 32768;
    char* sb = sa + 16384;
#pragma unroll
    for (int i = 0; i < 4; ++i) {
      const int row = drow0 + 32 * i;
      const int kc = dpc ^ ((row >> 1) & 7);
      glds16(A + (size_t)row * lda + kt * 64 + kc * 8, sa + (i * 4 + wid) * 1024 + lane * 16);
      glds16(Bt + (size_t)row * ldb + kt * 64 + kc * 8, sb + (i * 4 + wid) * 1024 + lane * 16);
    }
  };
  __syncthreads();
  issue(0, 0);
  const int nk = K >> 6;
  const int sw = (fr >> 1) & 7;
  const int aoff = (wr * 64 + fr) * 128, boff = (wc * 64 + fr) * 128;
  for (int kt = 0; kt < nk; ++kt) {
    asm volatile("s_waitcnt vmcnt(0)" ::: "memory");
    __syncthreads();
    if (kt + 1 < nk) issue(kt + 1, (kt + 1) & 1);
    const char* sa = smem + (kt & 1) * 32768;
    const char* sb = sa + 16384;
#pragma unroll
    for (int kh = 0; kh < 2; ++kh) {
      const int pc = ((kh * 4 + fq) ^ sw) * 16;
      bf16x8 af[4], bfr[4];
#pragma unroll
      for (int m = 0; m < 4; ++m) af[m] = *(const bf16x8*)(sa + aoff + m * 2048 + pc);
#pragma unroll
      for (int n = 0; n < 4; ++n) bfr[n] = *(const bf16x8*)(sb + boff + n * 2048 + pc);
#pragma unroll
      for (int m = 0; m < 4; ++m)
#pragma unroll
        for (int n = 0; n < 4; ++n) acc[m][n] = mfma16(af[m], bfr[n], acc[m][n]);
    }
  }
  __syncthreads();
  epi(acc, wr, wc, fr, fq, smem);
}
DEV void stage_tile_bf16(const f32x4 (&acc)[4][4], char* smem, int wid, int fr, int fq) {
  bf16_t (*t)[72] = (bf16_t (*)[72])(smem + wid * 9216);
#pragma unroll
  for (int m = 0; m < 4; ++m)
#pragma unroll
    for (int n = 0; n < 4; ++n)
#pragma unroll
      for (int j = 0; j < 4; ++j) t[m * 16 + fq * 4 + j][n * 16 + fr] = f2bf(acc[m][n][j]);
  asm volatile("s_waitcnt lgkmcnt(0)" ::: "memory");
}

DEV void ph_copy(const P& p) {
  const size_t n8 = (size_t)NTOK * D / 8;
  const float* pctx = opq(p.ctx); const float* px = opq(p.x);
  for (size_t i = (size_t)bid_() * 256 + tid_(); i < n8; i += (size_t)gridDim.x * 256) {
    size_t e = i * 8;
    int row = (int)(e / D), col = (int)(e % D);
    int b = row / LT, pp = row % LT;
    const float* src = pp < LC ? pctx + ((size_t)(b * LC + pp)) * D + col : px + ((size_t)(b * T + pp - LC)) * D + col;
    float4 v0 = *(const float4*)src, v1 = *(const float4*)(src + 4);
    uint4 o = make_uint4(pack2(v0.x, v0.y), pack2(v0.z, v0.w), pack2(v1.x, v1.y), pack2(v1.z, v1.w));
    *(uint4*)(p.X + e) = o;
  }
}

DEV void ph_rope(const P& p) {
  for (int i = bid_() * 256 + tid_(); i < 64 * 16; i += gridDim.x * 256) {
    int pos = i >> 4, k = i & 15;
    float inv = powf(10000.f, -(float)k / 16.f);
    float ang = (float)pos * inv;
    p.rope[2 * i] = cosf(ang); p.rope[2 * i + 1] = sinf(ang);
  }
}

DEV void modv_unit(const P& p, int unit, char* smem) {
  const int cc = unit % 24, layer = unit / 24;
  float (*cs)[128] = (float (*)[128])smem;
  const int col = cc * 256 + tid_();
  const float* pc = opq(p.c); const float* pcc = opq(p.c_ctx);
  float acc[17];
#pragma unroll
  for (int r = 0; r < 17; ++r) acc[r] = 0.f;
  for (int ks = 0; ks < 8; ++ks) {
    __syncthreads();
    for (int i = tid_(); i < 17 * 128; i += 256) {
      int r = i >> 7, e = i & 127;
      float v = r < 16 ? pc[r * D + ks * 128 + e] : pcc[ks * 128 + e];
      cs[r][e] = v / (1.f + expf(-v));
    }
    __syncthreads();
    const float* w = p.mod_w + ((size_t)layer * D + ks * 128) * 6144 + col;
#pragma unroll 4
    for (int e = 0; e < 128; ++e) {
      float wv = w[(size_t)e * 6144];
#pragma unroll
      for (int r = 0; r < 17; ++r) acc[r] += cs[r][e] * wv;
    }
  }
  const float bias = p.mod_b[layer * 6144 + col];
#pragma unroll
  for (int r = 0; r < 17; ++r) p.modv[((size_t)layer * 17 + r) * 6144 + col] = acc[r] + bias;
}

DEV void transpose_unit(const float* __restrict__ src, bf16_t* __restrict__ dst, int R, int C, int tile, char* smem) {
  float (*t)[65] = (float (*)[65])smem;
  const int nct = C / 64;
  const int tr = tile / nct, tc = tile % nct;
  __syncthreads();
  for (int i = tid_(); i < 4096; i += 256) { int r = i >> 6, c = i & 63; t[r][c] = src[(size_t)(tr * 64 + r) * C + tc * 64 + c]; }
  __syncthreads();
  for (int i = tid_(); i < 4096; i += 256) { int c = i >> 6, r = i & 63; dst[(size_t)(tc * 64 + c) * R + tr * 64 + r] = f2bf(t[r][c]); }
}

DEV void wfold_unit(const P& p, int layer, int unit, char* smem) {
  const int hs = unit >> 5, ec = unit & 31, h = hs >> 1, s = hs & 1;
  const float* wq = p.peer_wq + (size_t)layer * D * 2048;
  const float* kk = (s ? opq(p.peer_k2) : opq(p.peer_k1)) + ((size_t)layer * 8 + h) * 128 * 128;
  float (*kS)[65] = (float (*)[65])smem;
  float (*wS)[64] = (float (*)[64])(smem + 33280);
  const int key = tid_() & 127, eh = tid_() >> 7;
  float acc[16];
#pragma unroll
  for (int i = 0; i < 16; ++i) acc[i] = 0.f;
  for (int dh = 0; dh < 2; ++dh) {
    __syncthreads();
    for (int i = tid_(); i < 128 * 64; i += 256) { int k2 = i >> 6, d = i & 63; kS[k2][d] = kk[k2 * 128 + dh * 64 + d]; }
    for (int i = tid_(); i < 32 * 64; i += 256) {
      int e = i >> 6, d = i & 63;
      wS[e][d] = wq[(size_t)(ec * 32 + e) * 2048 + h * 256 + s * 128 + dh * 64 + d];
    }
    __syncthreads();
#pragma unroll 2
    for (int d = 0; d < 64; ++d) {
      float kv = kS[key][d];
#pragma unroll
      for (int i = 0; i < 16; ++i) acc[i] += kv * wS[eh * 16 + i][d];
    }
  }
  bf16_t* dst = p.Wft + ((size_t)(hs * 128 + key)) * D + ec * 32 + eh * 16;
#pragma unroll
  for (int i = 0; i < 16; i += 2) *(unsigned*)(dst + i) = pack2(acc[i], acc[i + 1]);
}

DEV void filt_unit(const P& p, int layer, int unit, char* smem) {
  int kind, j0, L;
  if (unit < 1024) { kind = 0; j0 = unit * 4; L = T; } else { kind = 1; j0 = (unit - 1024) * 4; L = LC; }
  float* zs = (float*)smem;
  float* h1 = zs + 4 * 36;
  float* h2 = h1 + 256;
  const int jj = tid_() >> 6, o = tid_() & 63;
  const int j = j0 + jj;
  const float fj = (float)j;
  const float t = fj / (float)(L - 1);
  __syncthreads();
  if (o < 33) {
    float z;
    if (o == 0) z = t;
    else {
      int i = (o - 1) & 15;
      float band = 1e-4f + (float)i * ((15.0f - 1e-4f) / 15.0f);
      float ang = 6.283185307179586f * fj * band / (float)L;
      z = (o <= 16) ? cosf(ang) : -sinf(ang);
    }
    zs[jj * 36 + o] = z;
  }
  __syncthreads();
  {
    const float* w1 = p.hy_w1 + layer * 33 * 64;
    float a = p.hy_b1[layer * 64 + o];
#pragma unroll 3
    for (int i = 0; i < 33; ++i) a += zs[jj * 36 + i] * w1[i * 64 + o];
    h1[jj * 64 + o] = sinf(p.hy_freq[layer * 128 + o] * a);
  }
  __syncthreads();
  {
    const float* w2 = p.hy_w2 + layer * 64 * 64;
    float a = p.hy_b2[layer * 64 + o];
#pragma unroll 4
    for (int i = 0; i < 64; ++i) a += h1[jj * 64 + i] * w2[i * 64 + o];
    h2[jj * 64 + o] = sinf(p.hy_freq[layer * 128 + 64 + o] * a);
  }
  __syncthreads();
  const float* w3 = p.hy_w3 + layer * 64 * 512;
  float* F = kind ? opq(p.FC) : opq(p.FL);
  const float DMIN = -3.0701134573253945f, DMAX = -15.350567286626973f;
#pragma unroll 1
  for (int m = 0; m < 4; ++m) {
    int c = o + 64 * m;
    float af = p.hy_b3[layer * 512 + c], ab = p.hy_b3[layer * 512 + 256 + c];
#pragma unroll 4
    for (int i = 0; i < 64; ++i) { float hv = h2[jj * 64 + i]; af += hv * w3[i * 512 + c]; ab += hv * w3[i * 512 + 256 + c]; }
    float delta = fabsf(DMIN + (float)c * ((DMAX - DMIN) / 255.f));
    float win = expf(-t * delta) + 0.05f;
    af *= win; ab *= win;
    F[((size_t)c * 2 + 0) * L + j] = af;
    F[((size_t)c * 2 + 1) * L + j] = ab;
  }
}

constexpr int PREP_T0 = 672, PREP_T1 = PREP_T0 + 256, PREP_T2 = PREP_T1 + 8, PREP_T3 = PREP_T2 + 8, PREP_T4 = PREP_T3 + 8;
constexpr int PREP_WF = PREP_T4 + 512, PREP_N = PREP_WF + 1088;
DEV void ph_prep(const P& p, int layer, char* smem) {
  for (int u = bid_(); u < PREP_N; u += gridDim.x) {
    if (u < PREP_T0) transpose_unit(p.w_in + (size_t)layer * D * INW, p.W1t, D, INW, u, smem);
    else if (u < PREP_T1) transpose_unit(p.w_out + (size_t)layer * D * D, p.W2t, D, D, u - PREP_T0, smem);
    else if (u < PREP_T3) {
      const int u0 = u - PREP_T1;
      for (int i = tid_(); i < 64 * 256; i += 256) {
        const int np = u0 * 64 + (i >> 8), kp = i & 255;
        const int ps = np & 3, chan = np >> 2, qp = kp >> 6, kk = kp & 63;
        const int is_a = ps & 1, d = ps >> 1;
        float v = 0.f;
        if (qp == (is_a ? 2 + d : d)) v = (is_a ? opq(p.rw_a_up) : opq(p.rw_w_up))[(((size_t)layer * 2 + d) * 64 + kk) * 256 + chan];
        p.Wlt[(size_t)np * 256 + kp] = f2bf(v);
      }
    }
    else if (u < PREP_T4) transpose_unit(p.rw_g_up + (size_t)layer * 128 * 256, p.Wgt, 128, 256, u - PREP_T3, smem);
    else if (u < PREP_WF) wfold_unit(p, layer, u - PREP_T4, smem);
    else filt_unit(p, layer, u - PREP_WF, smem);
  }
}

DEV void ph_norm(const P& p, int layer, int which) {
  const int gw = (bid_() * 256 + tid_()) >> 6, nw = gridDim.x * 4, lane = tid_() & 63;
  const float* g = (which ? p.norm2_g : p.norm1_g) + layer * D;
  for (int row = gw; row < NTOK; row += nw) {
    int b = row / LT, pp = row % LT;
    int mr = pp < LC ? 16 : b;
    const float* mv = p.modv + ((size_t)layer * 17 + mr) * 6144 + (which ? 3072 : 0);
    const bf16_t* xr = p.X + (size_t)row * D;
    uint4 u0 = *(const uint4*)(xr + 8 * lane), u1 = *(const uint4*)(xr + 512 + 8 * lane);
    float v[16];
    unpack8(u0, v); unpack8(u1, v + 8);
    float ss = 0.f;
#pragma unroll
    for (int i = 0; i < 16; ++i) ss += v[i] * v[i];
    ss = wave_sum(ss);
    float rstd = rsqrtf(ss * (1.f / 1024.f) + 1e-6f);
    float o[16];
#pragma unroll
    for (int hh = 0; hh < 2; ++hh)
#pragma unroll
      for (int i = 0; i < 8; ++i) {
        int col = hh * 512 + 8 * lane + i;
        float y = v[hh * 8 + i] * rstd * g[col];
        o[hh * 8 + i] = y * (1.f + mv[1024 + col]) + mv[col];
      }
    bf16_t* hr = p.H + (size_t)row * D;
    *(uint4*)(hr + 8 * lane) = pack8(o);
    *(uint4*)(hr + 512 + 8 * lane) = pack8(o + 8);
  }
}

DEV bool gemm_unit(int it, int nct, int& rt, int& ct) {
  const int nslot = gridDim.x >> 3;
  const int x = bid_() & 7, sl = bid_() >> 3;
  if (sl >= nslot) return false;
  const int v = it * nslot + sl;
  if (v >= 68 * nct) return false;
  const int rg = v / (8 * nct), rem = v - rg * 8 * nct;
  const int rows = (rg == 8) ? 4 : 8;
  ct = rem / rows;
  rt = x * 68 + rg * 8 + (rem - ct * rows);
  return true;
}
struct Epi1 {
  const P& p; int row0, col0;
  DEV void operator()(f32x4 (&acc)[4][4], int wr, int wc, int fr, int fq, char* smem) const {
    const int cw = col0 + wc * 64;
    const int rbase = row0 + wr * 64;
    const bool lat = (row0 % LT) >= LC;
    if (cw >= 1536 && cw < 1664) {
#pragma unroll
      for (int m = 0; m < 4; ++m)
#pragma unroll
        for (int n = 0; n < 4; ++n)
#pragma unroll
          for (int j = 0; j < 4; ++j) acc[m][n][j] = tanhf(acc[m][n][j]);
    } else if (cw >= 1792 && cw < 1920) {
#pragma unroll
      for (int m = 0; m < 4; ++m)
#pragma unroll
        for (int n = 0; n < 4; ++n)
#pragma unroll
          for (int j = 0; j < 4; ++j) acc[m][n][j] = sigmoidf_(acc[m][n][j]);
    } else if (cw >= 1920 && cw < 2560 && lat) {
#pragma unroll
      for (int m = 0; m < 4; ++m)
#pragma unroll
        for (int j = 0; j < 4; ++j) {
          int row = rbase + m * 16 + fq * 4 + j;
          int pl = (row % LT) - LC;
          int ri = pl >> 6, ci = pl & 63;
          float2 cr = *(const float2*)(p.rope + 2 * (ri * 16 + fr));
          float2 cc = *(const float2*)(p.rope + 2 * (ci * 16 + fr));
          float x1 = acc[m][0][j], x2 = acc[m][1][j];
          acc[m][0][j] = x1 * cr.x - x2 * cr.y; acc[m][1][j] = x2 * cr.x + x1 * cr.y;
          x1 = acc[m][2][j]; x2 = acc[m][3][j];
          acc[m][2][j] = x1 * cc.x - x2 * cc.y; acc[m][3][j] = x2 * cc.x + x1 * cc.y;
        }
    }
    const int wid = wr * 2 + wc, lane = fq * 16 + fr;
    stage_tile_bf16(acc, smem, wid, fr, fq);
    const bf16_t (*t)[72] = (const bf16_t (*)[72])(smem + wid * 9216);
#pragma unroll
    for (int i = 0; i < 8; ++i) {
      const int rl = i * 8 + (lane >> 3), ch = lane & 7;
      *(uint4*)(p.Z + (size_t)(rbase + rl) * INW + cw + ch * 8) = *(const uint4*)&t[rl][ch * 8];
    }
  }
};
DEV void ph_gemm1(const P& p, char* smem) {
  const int nct = INW / 128;
  int rt, ct;
  for (int it = 0; gemm_unit(it, nct, rt, ct); ++it) {
    Epi1 epi{p, rt * 128, ct * 128};
    gemm_tile(p.H + (size_t)rt * 128 * D, D, p.W1t + (size_t)ct * 128 * D, D, D, smem, epi);
  }
}

struct EpiLoraA {
  const P& p; int layer, row0, col0;
  DEV void operator()(f32x4 (&acc)[4][4], int wr, int wc, int fr, int fq, char* smem) const {
    const int ps = fr & 3, is_a = ps & 1, dd = ps >> 1;
    const float scale = is_a ? 1.f : 0.6065306597126334f;
    const float* bias0 = (is_a ? opq(p.rw_a0) : opq(p.rw_w0)) + (layer * 2 + dd) * 256;
#pragma unroll
    for (int n = 0; n < 4; ++n) {
      const int chan = (col0 + wc * 64 + n * 16 + fr) >> 2;
      const float bias = bias0[chan];
#pragma unroll
      for (int m = 0; m < 4; ++m)
#pragma unroll
        for (int j = 0; j < 4; ++j) acc[m][n][j] = scale * sigmoidf_(acc[m][n][j] + bias);
    }
    const int wid = wr * 2 + wc, lane = fq * 16 + fr;
    stage_tile_bf16(acc, smem, wid, fr, fq);
    const bf16_t (*t)[72] = (const bf16_t (*)[72])(smem + wid * 9216);
#pragma unroll
    for (int i = 0; i < 8; ++i) {
      const int rl = i * 8 + (lane >> 3), ch = lane & 7;
      *(uint4*)(p.SC + (size_t)(row0 + wr * 64 + rl) * 1024 + col0 + wc * 64 + ch * 8) = *(const uint4*)&t[rl][ch * 8];
    }
  }
};
struct EpiLoraG {
  const P& p; int row0, col0;
  DEV void operator()(f32x4 (&acc)[4][4], int wr, int wc, int fr, int fq, char* smem) const {
    const int wid = wr * 2 + wc, lane = fq * 16 + fr;
    stage_tile_bf16(acc, smem, wid, fr, fq);
    const bf16_t (*t)[72] = (const bf16_t (*)[72])(smem + wid * 9216);
#pragma unroll
    for (int i = 0; i < 8; ++i) {
      const int rl = i * 8 + (lane >> 3), ch = lane & 7;
      *(uint4*)(p.Y + (size_t)(row0 + wr * 64 + rl) * D + 256 + col0 + wc * 64 + ch * 8) = *(const uint4*)&t[rl][ch * 8];
    }
  }
};
DEV void ph_lora(const P& p, int layer, char* smem) {
  int rt, ct;
  for (int it = 0; gemm_unit(it, 10, rt, ct); ++it) {
    if (ct < 8) {
      EpiLoraA epi{p, layer, rt * 128, ct * 128};
      gemm_tile(p.Z + (size_t)rt * 128 * INW + 1536, INW, p.Wlt + (size_t)ct * 128 * 256, 256, 256, smem, epi);
    } else {
      EpiLoraG epi{p, rt * 128, (ct - 8) * 128};
      gemm_tile(p.Z + (size_t)rt * 128 * INW + 1792, INW, p.Wgt + (size_t)(ct - 8) * 128 * 128, 128, 128, smem, epi);
    }
  }
}

DEV void ph_rwkv_prep(const P& p, int layer) {
  const int gw = (bid_() * 256 + tid_()) >> 6, nw = gridDim.x * 4, lane = tid_() & 63;
  const float* cw = p.conv_w + (size_t)layer * 3 * 1536;
  const float* cb = p.conv_b + (size_t)layer * 1536;
  for (int row = gw; row < NTOK; row += nw) {
    int pp = row % LT;
    bool hasm = (pp != 0) && (pp != LC);
    bool hasp = (pp != LC - 1) && (pp != LT - 1);
    float res[3][4];
#pragma unroll
    for (int a = 0; a < 3; ++a) {
      int col = 768 + a * 256 + 4 * lane;
      const bf16_t* zc = p.Z + (size_t)row * INW + col;
      uint2 um = hasm ? *(const uint2*)(zc - INW) : make_uint2(0, 0);
      uint2 uc = *(const uint2*)zc;
      uint2 up = hasp ? *(const uint2*)(zc + INW) : make_uint2(0, 0);
      float vm[4] = {bflo(um.x), bfhi(um.x), bflo(um.y), bfhi(um.y)};
      float vc[4] = {bflo(uc.x), bfhi(uc.x), bflo(uc.y), bfhi(uc.y)};
      float vp[4] = {bflo(up.x), bfhi(up.x), bflo(up.y), bfhi(up.y)};
#pragma unroll
      for (int i = 0; i < 4; ++i) res[a][i] = cw[col + i] * vm[i] + cw[1536 + col + i] * vc[i] + cw[3072 + col + i] * vp[i] + cb[col + i];
    }
    float kk[4], ss = 0.f;
#pragma unroll
    for (int i = 0; i < 4; ++i) { kk[i] = res[1][i] * p.rw_k_k[layer * 256 + 4 * lane + i]; ss += kk[i] * kk[i]; }
    ss = row16_sum(ss);
    float rs = rsqrtf(ss + 1e-12f);
    bf16_t* hr = p.H + (size_t)row * D + 16 * lane;
    *(uint4*)hr = make_uint4(pack2(res[0][0], res[1][0]), pack2(kk[0] * rs, res[2][0]), pack2(res[0][1], res[1][1]), pack2(kk[1] * rs, res[2][1]));
    *(uint4*)(hr + 8) = make_uint4(pack2(res[0][2], res[1][2]), pack2(kk[2] * rs, res[2][2]), pack2(res[0][3], res[1][3]), pack2(kk[3] * rs, res[2][3]));
  }
}

DEV float oct_sum(float x) { x += dpp0<0xB1, 0xF>(x); x += dpp0<0x4E, 0xF>(x); x += dpp0<0x141, 0xF>(x); return x; }
DEV bf16x8 frag_join(uint2 lo, uint2 hi) { uint4 w = make_uint4(lo.x, lo.y, hi.x, hi.y); return __builtin_bit_cast(bf16x8, w); }
constexpr int SCS_SET = 16640, SCS_IMG = 3 * SCS_SET, SCS_W0 = SCS_IMG + 2 * 3072;
DEV void scanc_unit(const P& p, int layer, int unit, char* smem) {
  const int dir = unit & 1, h = (unit >> 1) & 3, b = unit >> 3;
  const int tid = tid_(), lane = tid & 63, fr = lane & 15, fq = lane >> 4;
  const int w = __builtin_amdgcn_readfirstlane(tid >> 6);
  bf16_t* IMG0 = (bf16_t*)(smem + SCS_W0);
  bf16_t* IMG1 = IMG0 + 512;
  bf16_t* IMG2 = IMG0 + 1024;
  __syncthreads();
  for (int i = tid; i < (2 * 3072 + 3072) / 4; i += 256) ((unsigned*)(smem + SCS_IMG))[i] = 0u;
  const float ka = p.rw_k_a[layer * 256 + h * 64 + lane];
  const size_t rowbase = (size_t)b * LT;
  const char* hbase = (const char*)p.H;
  const char* sbase = (const char*)p.SC;
  const unsigned hoff = (unsigned)(rowbase * 2048) + (unsigned)((h * 64 + lane) * 8);
  const unsigned soff = hoff + 4u * (unsigned)dir;
  bf16_t* yb = p.Z + rowbase * INW + 768 + dir * 256 + h * 64 + w * 16 + fr;
  auto pos0 = [&](int c) -> int { const int t = c * 16; return dir == 0 ? t : (t < LC ? LC - 1 - t : LT - 1 - (t - LC)); };
  const int pstep = dir == 0 ? 1 : -1;
  constexpr int NCH = LT / 16;
  struct Raw { unsigned sc[16]; uint2 hr[6]; };
  auto load_raw = [&](int c, Raw& rw) {
    if (w != 0) {
      const int p0 = pos0(c);
      const unsigned so = soff + (unsigned)(p0 * 2048);
      const int st = pstep * 2048;
#pragma unroll
      for (int i = 0; i < 16; ++i) rw.sc[i] = *(const unsigned*)(sbase + (so + (unsigned)(i * st)));
      const unsigned ho = hoff + (unsigned)((p0 + pstep * (w - 1)) * 2048);
#pragma unroll
      for (int q = 0; q < 6; ++q) {
        const int qq = ((w - 1) + 3 * q < 16) ? q : 4;
        rw.hr[q] = *(const uint2*)(hbase + (ho + (unsigned)(qq * 3 * st)));
      }
    }
  };
  auto stage1w = [&](int set, const Raw& rw, auto W1tag) {
    constexpr int W1 = decltype(W1tag)::value;
    char* base = smem + set * SCS_SET;
    bf16_t (*At)[72] = (bf16_t (*)[72])(base);
    bf16_t (*Rt)[72] = (bf16_t (*)[72])(base + 2304);
    bf16_t (*Bt)[72] = (bf16_t (*)[72])(base + 4608);
    bf16_t (*Kt)[72] = (bf16_t (*)[72])(base + 6912);
    bf16_t (*BKT)[40] = (bf16_t (*)[40])(base + 9216);
    bf16_t (*VV)[16] = (bf16_t (*)[16])(base + 14336);
    float* G16 = (float*)(base + 16384);
    float Erun = 0.f;
#pragma unroll
    for (int i = 0; i < 16; ++i) {
      const float ev = bflo(rw.sc[i]);
      const float Eprev = Erun;
      Erun += ev;
      if ((i % 3) == W1) {
        const uint2 hrec = rw.hr[i / 3];
        const float rr = bflo(hrec.x), kr = bfhi(hrec.x), kkv = bflo(hrec.y);
        const float av = bfhi(rw.sc[i]);
        const float gp = __expf(-Eprev), gi = __expf(-Erun), ig = __expf(Erun);
        const float at = -kkv * gp, rt = rr * gi, bt = kkv * av * ig, kt2 = kr * (1.f + (av - 1.f) * ka) * ig;
        const unsigned ar = pack2(at, rt), bk = pack2(bt, kt2);
        At[i][lane] = (bf16_t)(ar & 0xFFFFu); Rt[i][lane] = (bf16_t)(ar >> 16);
        Bt[i][lane] = (bf16_t)(bk & 0xFFFFu); Kt[i][lane] = (bf16_t)(bk >> 16);
        BKT[lane][(i >> 2) * 8 + (i & 3)] = (bf16_t)(bk & 0xFFFFu);
        BKT[lane][(i >> 2) * 8 + 4 + (i & 3)] = (bf16_t)(bk >> 16);
        VV[lane][(i >> 2) * 4 + (i & 3)] = (bf16_t)(hrec.y >> 16);
        if (i == 15) G16[lane] = gi;
      }
    }
  };
  auto stage1 = [&](int set, const Raw& rw) {
    if (w == 1) stage1w(set, rw, std::integral_constant<int, 0>{});
    else if (w == 2) stage1w(set, rw, std::integral_constant<int, 1>{});
    else if (w == 3) stage1w(set, rw, std::integral_constant<int, 2>{});
  };
  auto stage2 = [&](int set, int iset) {
    char* base = smem + set * SCS_SET;
    const bf16_t (*At)[72] = (const bf16_t (*)[72])(base);
    const bf16_t (*Rt)[72] = (const bf16_t (*)[72])(base + 2304);
    const bf16_t (*Bt)[72] = (const bf16_t (*)[72])(base + 4608);
    const bf16_t (*Kt)[72] = (const bf16_t (*)[72])(base + 6912);
    bf16_t* TT = (bf16_t*)(smem + SCS_IMG + iset * 3072);
    bf16_t* ARK = TT + 512;
    bf16_t* AAK = TT + 1024;
    const bf16_t (*X)[72] = (w < 2) ? At : Rt;
    const bf16_t (*Y)[72] = (w & 1) ? Kt : Bt;
    f32x4 cm = (f32x4){0.f, 0.f, 0.f, 0.f};
#pragma unroll
    for (int s = 0; s < 2; ++s) {
      bf16x8 af = *(const bf16x8*)&X[fr][32 * s + 8 * fq];
      bf16x8 bm = *(const bf16x8*)&Y[fr][32 * s + 8 * fq];
      cm = mfma16(af, bm, cm);
    }
#pragma unroll
    for (int jj = 0; jj < 4; ++jj) {
      const int i = 4 * fq + jj;
      const bool keep = (w < 2) ? (fr < i) : (fr <= i);
      cm[jj] = keep ? cm[jj] : 0.f;
    }
    const int io = (fr >> 2) * 8 + (fr & 3);
    auto wr_img = [&](bf16_t* img, const f32x4& Xv, int hi) {
#pragma unroll
      for (int jj = 0; jj < 4; ++jj) img[(4 * fq + jj) * 32 + io + hi] = f2bf(Xv[jj]);
    };
    if (w == 1) wr_img(AAK, cm, 0);
    else if (w == 2) wr_img(ARK, cm, 0);
    else if (w == 3) wr_img(ARK, cm, 4);
    else {
      auto bfrag = [&](const f32x4& Xv) { return frag_join(make_uint2(pack2(Xv[0], Xv[1]), pack2(Xv[2], Xv[3])), make_uint2(0u, 0u)); };
      auto afr = [&](const bf16_t* img) { return *(const bf16x8*)&img[(fr * 4 + fq) * 8]; };
      const f32x4 Z4 = (f32x4){0.f, 0.f, 0.f, 0.f};
      wr_img(IMG0, cm, 0);
      asm volatile("" ::: "memory");
      f32x4 A2 = mfma16(afr(IMG0), bfrag(cm), Z4);
      wr_img(IMG1, A2, 0);
      asm volatile("" ::: "memory");
      f32x4 A4 = mfma16(afr(IMG1), bfrag(A2), Z4);
      wr_img(IMG2, A4, 0);
      asm volatile("" ::: "memory");
      f32x4 Rm = mfma16(afr(IMG2), bfrag(A4), Z4);
#pragma unroll
      for (int jj = 0; jj < 4; ++jj) Rm[jj] += (fr == 4 * fq + jj) ? 1.f : 0.f;
      Rm = mfma16(afr(IMG2), bfrag(Rm), Rm);
      Rm = mfma16(afr(IMG1), bfrag(Rm), Rm);
      Rm = mfma16(afr(IMG0), bfrag(Rm), Rm);
      wr_img(TT, Rm, 0);
    }
  };
  f32x4 acc[4];
#pragma unroll
  for (int kt = 0; kt < 4; ++kt) acc[kt] = (f32x4){0.f, 0.f, 0.f, 0.f};
  auto part2 = [&](int c, int set, int iset) {
    char* base = smem + set * SCS_SET;
    const bf16_t (*At)[72] = (const bf16_t (*)[72])(base);
    const bf16_t (*Rt)[72] = (const bf16_t (*)[72])(base + 2304);
    const bf16_t (*BKT)[40] = (const bf16_t (*)[40])(base + 9216);
    const bf16_t (*VV)[16] = (const bf16_t (*)[16])(base + 14336);
    const float* G16 = (const float*)(base + 16384);
    const bf16_t* TT = (const bf16_t*)(smem + SCS_IMG + iset * 3072);
    const bf16_t* ARK = TT + 512;
    const bf16_t* AAK = TT + 1024;
    bf16x8 Sb[2];
#pragma unroll
    for (int s = 0; s < 2; ++s) {
      uint4 t = make_uint4(pack2(acc[2 * s][0], acc[2 * s][1]), pack2(acc[2 * s][2], acc[2 * s][3]),
                           pack2(acc[2 * s + 1][0], acc[2 * s + 1][1]), pack2(acc[2 * s + 1][2], acc[2 * s + 1][3]));
      Sb[s] = __builtin_bit_cast(bf16x8, t);
    }
    const uint2 vv = *(const uint2*)&VV[w * 16 + fr][fq * 4];
    const bf16x8 Vlow = frag_join(vv, make_uint2(0u, 0u));
    f32x4 Pm = (f32x4){0.f, 0.f, 0.f, 0.f};
#pragma unroll
    for (int s = 0; s < 2; ++s) {
      bf16x8 af = frag_join(*(const uint2*)&At[fr][32 * s + 4 * fq], *(const uint2*)&At[fr][32 * s + 16 + 4 * fq]);
      Pm = mfma16(af, Sb[s], Pm);
    }
    Pm = mfma16(*(const bf16x8*)&AAK[(fr * 4 + fq) * 8], Vlow, Pm);
    const bf16x8 Pb = frag_join(make_uint2(pack2(Pm[0], Pm[1]), pack2(Pm[2], Pm[3])), make_uint2(0u, 0u));
    f32x4 U = mfma16(*(const bf16x8*)&TT[(fr * 4 + fq) * 8], Pb, (f32x4){0.f, 0.f, 0.f, 0.f});
    const bf16x8 UV = frag_join(make_uint2(pack2(U[0], U[1]), pack2(U[2], U[3])), vv);
    f32x4 Yv = (f32x4){0.f, 0.f, 0.f, 0.f};
#pragma unroll
    for (int s = 0; s < 2; ++s) {
      bf16x8 af = frag_join(*(const uint2*)&Rt[fr][32 * s + 4 * fq], *(const uint2*)&Rt[fr][32 * s + 16 + 4 * fq]);
      Yv = mfma16(af, Sb[s], Yv);
    }
    Yv = mfma16(*(const bf16x8*)&ARK[(fr * 4 + fq) * 8], UV, Yv);
    {
      const int p0 = pos0(c);
#pragma unroll
      for (int jj = 0; jj < 4; ++jj) yb[(size_t)(p0 + pstep * (4 * fq + jj)) * INW] = f2bf(Yv[jj]);
    }
#pragma unroll
    for (int kt = 0; kt < 4; ++kt) {
      f32x4 t = mfma16(*(const bf16x8*)&BKT[16 * kt + fr][fq * 8], UV, acc[kt]);
      const float4 g4 = *(const float4*)&G16[16 * kt + 4 * fq];
      t[0] *= g4.x; t[1] *= g4.y; t[2] *= g4.z; t[3] *= g4.w;
      acc[kt] = t;
    }
  };
  __builtin_amdgcn_s_setprio(3);
  Raw r0, r1;
  load_raw(0, r0); load_raw(1, r1);
  stage1(0, r0);
  load_raw(2, r0);
  __syncthreads();
  stage2(0, 0);
  stage1(1, r1);
  load_raw(3, r1);
  __syncthreads();
  int s0 = 0, s1 = 1, s2 = 2;
  auto iter = [&](int c, Raw& rw) {
    if (c + 1 < NCH) stage2(s1, (c + 1) & 1);
    part2(c, s0, c & 1);
    if (c + 2 < NCH) {
      stage1(s2, rw);
      if (c + 4 < NCH) load_raw(c + 4, rw);
    }
    asm volatile("s_waitcnt lgkmcnt(0)" ::: "memory");
    __builtin_amdgcn_s_barrier();
    asm volatile("" ::: "memory");
    const int t = s0; s0 = s1; s1 = s2; s2 = t;
  };
#pragma unroll 1
  for (int c = 0; c < NCH; c += 2) {
    iter(c, r0); iter(c + 1, r1);
  }
  __builtin_amdgcn_s_setprio(0);
}

DEV void ph_rwkv_post(const P& p, int layer) {
  const int gw = (bid_() * 256 + tid_()) >> 6, nw = gridDim.x * 4, lane = tid_() & 63;
  for (int row = gw; row < NTOK; row += nw) {
    const int ch = 4 * lane;
    const bf16_t* zr = p.Z + (size_t)row * INW + 768 + ch;
    uint2 y0u = *(const uint2*)zr, y1u = *(const uint2*)(zr + 256);
    float y[4] = {bflo(y0u.x) + bflo(y1u.x), bfhi(y0u.x) + bfhi(y1u.x), bflo(y0u.y) + bflo(y1u.y), bfhi(y0u.y) + bfhi(y1u.y)};
    float mu = row16_sum(y[0] + y[1] + y[2] + y[3]) * (1.f / 64.f);
    float vs = 0.f;
#pragma unroll
    for (int i = 0; i < 4; ++i) { y[i] -= mu; vs += y[i] * y[i]; }
    float var = row16_sum(vs) * (1.f / 64.f);
    float rstd = rsqrtf(var + 64e-5f);
    const bf16_t* hr = p.H + (size_t)row * D + 4 * ch;
    uint4 h0 = *(const uint4*)hr, h1 = *(const uint4*)(hr + 8);
    const bf16_t* sr = p.SC + (size_t)row * 1024 + 4 * ch;
    uint4 s0 = *(const uint4*)sr, s1 = *(const uint4*)(sr + 8);
    float r[4] = {bflo(h0.x), bflo(h0.z), bflo(h1.x), bflo(h1.z)};
    float k[4] = {bfhi(h0.x), bfhi(h0.z), bfhi(h1.x), bfhi(h1.z)};
    float v[4] = {bfhi(h0.y), bfhi(h0.w), bfhi(h1.y), bfhi(h1.w)};
    float a0[4] = {bfhi(s0.x), bfhi(s0.z), bfhi(s1.x), bfhi(s1.z)};
    float a1[4] = {bfhi(s0.y), bfhi(s0.w), bfhi(s1.y), bfhi(s1.w)};
    float sd = 0.f;
#pragma unroll
    for (int i = 0; i < 4; ++i) {
      float kav = p.rw_k_a[layer * 256 + ch + i], rk = p.rw_r_k[layer * 256 + ch + i];
      float kd0 = k[i] * (1.f + (a0[i] - 1.f) * kav), kd1 = k[i] * (1.f + (a1[i] - 1.f) * kav);
      sd += r[i] * (kd0 + kd1) * rk;
    }
    sd = row16_sum(sd);
    bf16_t* yr = p.Y + (size_t)row * D + 256 + ch;
    uint2 gu = *(const uint2*)yr;
    float g[4] = {bflo(gu.x), bfhi(gu.x), bflo(gu.y), bfhi(gu.y)};
    float o[4];
#pragma unroll
    for (int i = 0; i < 4; ++i) {
      float yn = y[i] * rstd * p.rw_ln_w[layer * 256 + ch + i] + p.rw_ln_b[layer * 256 + ch + i];
      o[i] = (yn + sd * v[i]) * g[i];
#if !EN_RW
      o[i] = 0.f;
#endif
    }
    *(uint2*)yr = make_uint2(pack2(o[0], o[1]), pack2(o[2], o[3]));
  }
}

DEV void hyena_pre_unit(const P& p, int layer, int unit) {
  int kind, b, t0, L;
  if (unit < 1024) { kind = 0; b = unit >> 6; t0 = (unit & 63) * 64; L = T; } else { int u = unit - 1024; kind = 1; b = u >> 2; t0 = (u & 3) * 64; L = LC; }
  const int c = tid_();
  const size_t row0 = (size_t)b * LT + (kind ? 0 : LC);
  const float* cw = p.conv_w + (size_t)layer * 3 * 1536;
  const float* cb = p.conv_b + (size_t)layer * 1536;
  const float w1a = cw[256 + c], w1b = cw[1536 + 256 + c], w1c = cw[3072 + 256 + c], b1 = cb[256 + c];
  const float w2a = cw[512 + c], w2b = cw[1536 + 512 + c], w2c = cw[3072 + 512 + c], b2 = cb[512 + c];
  auto ld = [&](int t, int col) -> float { return (t >= 0 && t < L) ? bf2f(p.Z[(row0 + t) * INW + col]) : 0.f; };
  float x1m = ld(t0 - 1, 256 + c), x1c = ld(t0, 256 + c), vm = ld(t0 - 1, 512 + c), vc = ld(t0, 512 + c);
  bf16_t* dst = (kind ? opq(p.UTc) : opq(p.UTl)) + ((size_t)c * 16 + b) * L + t0;
#pragma unroll 1
  for (int i8 = 0; i8 < 8; ++i8) {
    float uo[8];
#pragma unroll
    for (int i = 0; i < 8; ++i) {
      int t = t0 + i8 * 8 + i;
      float x1n = ld(t + 1, 256 + c), vn = ld(t + 1, 512 + c);
      float a = w1a * x1m + w1b * x1c + w1c * x1n + b1;
      float bb = w2a * vm + w2b * vc + w2c * vn + b2;
      uo[i] = a * bb;
      x1m = x1c; x1c = x1n; vm = vc; vc = vn;
    }
    *(uint4*)(dst + 8 * i8) = pack8(uo);
  }
}

DEV void hyena_conv_unit(const P& p, int layer, int unit, char* smem) {
  int kind, c, tb, L;
  if (unit < 4096) { kind = 0; c = unit >> 4; tb = (unit & 15) * 256; L = T; } else { kind = 1; c = unit - 4096; tb = 0; L = LC; }
  const int tid = tid_(), lane = tid & 63, wid = tid >> 6, fr = lane & 15, fq = lane >> 4;
  float* red = (float*)(smem + 2 * 16512);
  const float* F = (kind ? opq(p.FC) : opq(p.FL)) + (size_t)c * 2 * L;
  float scale;
  {
    float part = 0.f;
    for (int i = tid; i < 2 * L; i += 256) { float fv = F[i]; part += (i != L) ? fv * fv : 0.f; }
    part = wave_sum(part);
    __syncthreads();
    if (lane == 0) red[wid] = part;
    __syncthreads();
    scale = rsqrtf(((red[0] + red[1]) + (red[2] + red[3])) + 1e-6f);
  }
  const bf16_t* U = (kind ? opq(p.UTc) : opq(p.UTl)) + (size_t)c * 16 * L;
  f32x4 acc[4];
#pragma unroll
  for (int m = 0; m < 4; ++m) acc[m] = (f32x4){0.f, 0.f, 0.f, 0.f};
  const int nch = L / 256;
  float fw0, fw1, fw2;
  uint4 ru0, ru1;
  auto ldchunk = [&](int ch) {
    const int sc = ch * 256;
    const int D0 = tb + 256 - sc;
    auto tap = [&](int n) -> float {
      int d = D0 - n;
      float v = 0.f;
      if (d > -L && d < L) v = (d >= 0 ? F[d] : F[L - d]);
      return v;
    };
    fw0 = tap(tid); fw1 = tap(tid + 256); fw2 = (tid < 8) ? tap(tid + 512) : 0.f;
    const int bb = tid >> 4, sg0 = tid & 15;
    ru0 = *(const uint4*)(U + (size_t)bb * L + sc + 8 * sg0);
    ru1 = *(const uint4*)(U + (size_t)bb * L + sc + 8 * (sg0 + 16));
  };
  auto stchunk = [&](int buf) {
    bf16_t* Cq = (bf16_t*)(smem + buf * 16512);
    bf16_t* Us = (bf16_t*)(smem + buf * 16512 + 8320);
    const bf16_t h0 = f2bf(fw0 * scale), h1 = f2bf(fw1 * scale), h2 = f2bf(fw2 * scale);
#pragma unroll
    for (int rho = 0; rho < 8; ++rho) {
      int m = tid + rho;
      Cq[((m >> 3) * 8 + rho) * 8 + (m & 7)] = h0;
      m = tid + 256 + rho;
      if (m < 520) Cq[((m >> 3) * 8 + rho) * 8 + (m & 7)] = h1;
      m = tid + 512 + rho;
      if (tid < 8 && m < 520) Cq[((m >> 3) * 8 + rho) * 8 + (m & 7)] = h2;
    }
    if (tid < 8) {
#pragma unroll
      for (int rho = 1; rho < 8; ++rho) if (tid < rho) Cq[(rho) * 8 + tid] = 0;
    }
    const int bb = tid >> 4, sg0 = tid & 15;
    *(uint4*)&Us[(sg0 * 16 + bb) * 8] = ru0;
    *(uint4*)&Us[((sg0 + 16) * 16 + bb) * 8] = ru1;
  };
  ldchunk(0);
#pragma unroll 1
  for (int ch = 0; ch < nch; ++ch) {
    const int buf = ch & 1;
    stchunk(buf);
    __syncthreads();
    if (ch + 1 < nch) ldchunk(ch + 1);
    const bf16_t* Cq = (const bf16_t*)(smem + buf * 16512);
    const bf16_t* Us = (const bf16_t*)(smem + buf * 16512 + 8320);
#pragma unroll
    for (int kk = 0; kk < 8; ++kk) {
      bf16x8 bf = *(const bf16x8*)&Us[((4 * kk + fq) * 16 + fr) * 8];
#pragma unroll
      for (int m = 0; m < 4; ++m) {
        int it = wid * 4 + m;
        int base = 256 - 16 * it + 32 * kk + 8 * fq;
        int m0 = base - 8 * (fr >> 3);
        bf16x8 af = *(const bf16x8*)&Cq[((m0 >> 3) * 8 + (fr & 7)) * 8];
        acc[m] = mfma16(af, bf, acc[m]);
      }
    }
  }
  __syncthreads();
  bf16_t* Yt = (kind ? opq(p.YTc) : opq(p.YTl)) + ((size_t)c * 16 + fr) * L + tb;
#pragma unroll
  for (int m = 0; m < 4; ++m) {
    int t = (wid * 4 + m) * 16 + fq * 4;
    *(uint2*)(Yt + t) = make_uint2(pack2(acc[m][0], acc[m][1]), pack2(acc[m][2], acc[m][3]));
  }
}

DEV void hyena_post_unit(const P& p, int layer, int unit, char* smem) {
  int kind, b, t0, L;
  if (unit < 1024) { kind = 0; b = unit >> 6; t0 = (unit & 63) * 64; L = T; } else { int u = unit - 1024; kind = 1; b = u >> 2; t0 = (u & 3) * 64; L = LC; }
  const int c = tid_(), lane = c & 63, wid = c >> 6;
  const size_t row0 = (size_t)b * LT + (kind ? 0 : LC);
  bf16_t (*tile)[264] = (bf16_t (*)[264])smem;
  const float* cw = p.conv_w + (size_t)layer * 3 * 1536;
  const float wa = cw[c], wb = cw[1536 + c], wcc = cw[3072 + c], b0 = p.conv_b[layer * 1536 + c];
  const float bias = p.hy_bias[layer * 256 + c];
  const bf16_t* yt = (kind ? opq(p.YTc) : opq(p.YTl)) + ((size_t)c * 16 + b) * L + t0;
  const bf16_t* ut = (kind ? opq(p.UTc) : opq(p.UTl)) + ((size_t)c * 16 + b) * L + t0;
  auto ld = [&](int t) -> float { return (t >= 0 && t < L) ? bf2f(p.Z[(row0 + t) * INW + c]) : 0.f; };
  float xm = ld(t0 - 1), xc = ld(t0);
  __syncthreads();
#pragma unroll 1
  for (int i8 = 0; i8 < 8; ++i8) {
    uint4 yu = *(const uint4*)(yt + 8 * i8), uu = *(const uint4*)(ut + 8 * i8);
    float yv[8], uv[8];
    unpack8(yu, yv); unpack8(uu, uv);
#pragma unroll
    for (int i = 0; i < 8; ++i) {
      int t = t0 + i8 * 8 + i;
      float xn = ld(t + 1);
      float x0 = wa * xm + wb * xc + wcc * xn + b0;
      float o = x0 * (yv[i] + uv[i] * bias);
      tile[i8 * 8 + i][c] = f2bf(o);
      xm = xc; xc = xn;
    }
  }
  __syncthreads();
  for (int i = 0; i < 16; ++i) {
    int tl = wid * 16 + i;
    uint2 ou = *(const uint2*)&tile[tl][4 * lane];
    float o[4] = {bflo(ou.x), bfhi(ou.x), bflo(ou.y), bfhi(ou.y)};
    float ss = wave_sum(o[0] * o[0] + o[1] * o[1] + o[2] * o[2] + o[3] * o[3]);
    float rstd = rsqrtf(ss * (1.f / 256.f) + 1e-6f);
#pragma unroll
    for (int q = 0; q < 4; ++q) {
      o[q] = o[q] * rstd * p.hy_out_g[layer * 256 + 4 * lane + q];
#if !EN_HY
      o[q] = 0.f;
#endif
    }
    *(uint2*)(p.Y + (row0 + t0 + tl) * D + 4 * lane) = make_uint2(pack2(o[0], o[1]), pack2(o[2], o[3]));
  }
}

DEV void attn_unit(const P& p, int layer, int unit, char* smem) {
  const bool isctx = unit >= 4096;
  int b, qb, hq;
  if (!isctx) { b = unit >> 8; qb = (unit >> 3) & 31; hq = unit & 7; } else { int u = unit - 4096; b = u >> 4; qb = (u >> 3) & 1; hq = u & 7; }
  const int g = hq >> 2;
  const int tid = tid_(), lane = tid & 63, wid = tid >> 6, qn = lane & 31, hh = lane >> 5;
  const int qpos = qb * 128 + wid * 32 + qn;
  const size_t qrow = (size_t)b * LT + (isctx ? qpos : LC + qpos);
  const bf16_t* qptr = p.Z + qrow * INW + 1920 + hq * 64;
  bf16x8 qf[4];
#pragma unroll
  for (int s = 0; s < 4; ++s) qf[s] = *(const bf16x8*)(qptr + 16 * s + 8 * hh);
  const float sink = p.attn_sink[layer * 8 + hq];
  float m_run = sink, l_run = 1.f;
  f32x16 o0, o1;
#pragma unroll
  for (int i = 0; i < 16; ++i) { o0[i] = 0.f; o1[i] = 0.f; }
  typedef bf16_t KTile[64][72];
  KTile* Ks = (KTile*)smem;
  KTile* Vt = (KTile*)(smem + 18432);
  const int ntl = isctx ? 0 : 6;
  const int ntiles = ntl + 4;
  const int skey = tid >> 3, sseg = tid & 7;
  const bf16_t* kvbase = p.Z + (size_t)b * LT * INW + 1920 + 512 + g * 64 + sseg * 8;
  uint4 rk0, rk1, rv0, rv1;
  auto ldtile = [&](int kt) {
    const bool ctxk = kt >= ntl;
    const int kbase = ctxk ? (kt - ntl) * 64 : qb * 128 - 128 + kt * 64;
    const int kp0 = kbase + skey, kp1 = kp0 + 32;
    rk0 = rk1 = rv0 = rv1 = make_uint4(0, 0, 0, 0);
    if (ctxk || (kp0 >= 0 && kp0 < T)) { const bf16_t* src = kvbase + (size_t)(ctxk ? kp0 : LC + kp0) * INW; rk0 = *(const uint4*)src; rv0 = *(const uint4*)(src + 128); }
    if (ctxk || (kp1 >= 0 && kp1 < T)) { const bf16_t* src = kvbase + (size_t)(ctxk ? kp1 : LC + kp1) * INW; rk1 = *(const uint4*)src; rv1 = *(const uint4*)(src + 128); }
  };
  auto sttile = [&](int buf) {
    *(uint4*)&Ks[buf][skey][sseg * 8] = rk0;
    *(uint4*)&Ks[buf][skey + 32][sseg * 8] = rk1;
    bf16_t (*vt)[72] = Vt[buf];
    vt[sseg * 8 + 0][skey] = (bf16_t)(rv0.x & 0xFFFF); vt[sseg * 8 + 1][skey] = (bf16_t)(rv0.x >> 16);
    vt[sseg * 8 + 2][skey] = (bf16_t)(rv0.y & 0xFFFF); vt[sseg * 8 + 3][skey] = (bf16_t)(rv0.y >> 16);
    vt[sseg * 8 + 4][skey] = (bf16_t)(rv0.z & 0xFFFF); vt[sseg * 8 + 5][skey] = (bf16_t)(rv0.z >> 16);
    vt[sseg * 8 + 6][skey] = (bf16_t)(rv0.w & 0xFFFF); vt[sseg * 8 + 7][skey] = (bf16_t)(rv0.w >> 16);
    vt[sseg * 8 + 0][skey + 32] = (bf16_t)(rv1.x & 0xFFFF); vt[sseg * 8 + 1][skey + 32] = (bf16_t)(rv1.x >> 16);
    vt[sseg * 8 + 2][skey + 32] = (bf16_t)(rv1.y & 0xFFFF); vt[sseg * 8 + 3][skey + 32] = (bf16_t)(rv1.y >> 16);
    vt[sseg * 8 + 4][skey + 32] = (bf16_t)(rv1.z & 0xFFFF); vt[sseg * 8 + 5][skey + 32] = (bf16_t)(rv1.z >> 16);
    vt[sseg * 8 + 6][skey + 32] = (bf16_t)(rv1.w & 0xFFFF); vt[sseg * 8 + 7][skey + 32] = (bf16_t)(rv1.w >> 16);
  };
  ldtile(0);
#pragma unroll 1
  for (int kt = 0; kt < ntiles; ++kt) {
    const int buf = kt & 1;
    sttile(buf);
    __syncthreads();
    if (kt + 1 < ntiles) ldtile(kt + 1);
    const bool ctxk = kt >= ntl;
    const int kbase = ctxk ? (kt - ntl) * 64 : qb * 128 - 128 + kt * 64;
#pragma unroll
    for (int sub = 0; sub < 2; ++sub) {
      const int kb2 = kbase + sub * 32;
      bool need = true;
      if (!ctxk) {
        int q0 = qb * 128 + wid * 32;
        if (kb2 + 31 < q0 - 128 || kb2 > q0 + 31 + 128 || kb2 + 31 < 0 || kb2 >= T) need = false;
      }
      if (need) {
        f32x16 sv;
#pragma unroll
        for (int i = 0; i < 16; ++i) sv[i] = 0.f;
#pragma unroll
        for (int ks = 0; ks < 4; ++ks) {
          bf16x8 kf = *(const bf16x8*)&Ks[buf][sub * 32 + qn][16 * ks + 8 * hh];
          sv = mfma32(kf, qf[ks], sv);
        }
        float mt = -3e38f;
#pragma unroll
        for (int rg = 0; rg < 16; ++rg) {
          float v = sv[rg] * 0.125f;
          if (!ctxk) {
            int kp = kb2 + (rg & 3) + 8 * (rg >> 2) + 4 * hh;
            int dl = qpos - kp;
            bool ok = (dl <= 128) && (dl >= -128) && (kp >= 0) && (kp < T);
            v = ok ? v : -1e30f;
          }
          sv[rg] = v;
          mt = fmaxf(mt, v);
        }
        mt = fmaxf(mt, __shfl_xor(mt, 32));
        float m_new = fmaxf(m_run, mt);
        float corr = __expf(m_run - m_new);
        float ps = 0.f;
#pragma unroll
        for (int rg = 0; rg < 16; ++rg) { float pv = __expf(sv[rg] - m_new); sv[rg] = pv; ps += pv; }
        ps += __shfl_xor(ps, 32);
        l_run = l_run * corr + ps;
        m_run = m_new;
#pragma unroll
        for (int i = 0; i < 16; ++i) { o0[i] *= corr; o1[i] *= corr; }
#pragma unroll
        for (int sp = 0; sp < 2; ++sp) {
          bf16x8 pf;
#pragma unroll
          for (int j = 0; j < 8; ++j) pf[j] = (short)f2bf(sv[8 * sp + j]);
          const int kc = sub * 32 + 16 * sp + 4 * hh;
          uint2 va = *(const uint2*)&Vt[buf][qn][kc], vb = *(const uint2*)&Vt[buf][qn][kc + 8];
          uint2 vc = *(const uint2*)&Vt[buf][32 + qn][kc], vd = *(const uint2*)&Vt[buf][32 + qn][kc + 8];
          uint4 w0 = make_uint4(va.x, va.y, vb.x, vb.y), w1 = make_uint4(vc.x, vc.y, vd.x, vd.y);
          bf16x8 v0 = __builtin_bit_cast(bf16x8, w0), v1 = __builtin_bit_cast(bf16x8, w1);
          o0 = mfma32(v0, pf, o0);
          o1 = mfma32(v1, pf, o1);
        }
      }
    }
  }
  __syncthreads();
  const float inv = 1.f / l_run;
  bf16_t* optr = p.Y + qrow * D + 512 + hq * 64;
#pragma unroll
  for (int rg = 0; rg < 4; ++rg) {
    int d0 = 8 * rg + 4 * hh;
    *(uint2*)(optr + d0) = make_uint2(pack2(o0[4 * rg] * inv, o0[4 * rg + 1] * inv), pack2(o0[4 * rg + 2] * inv, o0[4 * rg + 3] * inv));
    *(uint2*)(optr + 32 + d0) = make_uint2(pack2(o1[4 * rg] * inv, o1[4 * rg + 1] * inv), pack2(o1[4 * rg + 2] * inv, o1[4 * rg + 3] * inv));
  }
}

DEV void ph_attn_post(const P& p, int layer) {
  const int gw = (bid_() * 256 + tid_()) >> 6, nw = gridDim.x * 4, lane = tid_() & 63;
  for (int row = gw; row < NTOK; row += nw) {
    bf16_t* yr = p.Y + (size_t)row * D + 512 + 8 * lane;
    uint4 u = *(const uint4*)yr;
    float v[8];
    unpack8(u, v);
    float ss = 0.f;
#pragma unroll
    for (int i = 0; i < 8; ++i) ss += v[i] * v[i];
    ss = wave_sum(ss);
    float rstd = rsqrtf(ss * (1.f / 512.f) + 1e-6f);
#pragma unroll
    for (int i = 0; i < 8; ++i) {
      v[i] = v[i] * rstd * p.at_out_g[layer * 512 + 8 * lane + i];
#if !EN_AT
      v[i] = 0.f;
#endif
    }
    *(uint4*)yr = pack8(v);
  }
}

struct Epi2 {
  const P& p; int layer, row0, col0;
  DEV void operator()(f32x4 (&acc)[4][4], int wr, int wc, int fr, int fq, char* smem) const {
    const int b = row0 / LT, pp = row0 % LT;
    const int mr = pp < LC ? 16 : b;
    const float* g1 = p.modv + ((size_t)layer * 17 + mr) * 6144 + 2048 + col0 + wc * 64;
#pragma unroll
    for (int n = 0; n < 4; ++n) {
      const float gv = g1[n * 16 + fr];
#pragma unroll
      for (int m = 0; m < 4; ++m)
#pragma unroll
        for (int j = 0; j < 4; ++j) acc[m][n][j] *= gv;
    }
    const int wid = wr * 2 + wc, lane = fq * 16 + fr;
    stage_tile_bf16(acc, smem, wid, fr, fq);
    const bf16_t (*t)[72] = (const bf16_t (*)[72])(smem + wid * 9216);
#pragma unroll
    for (int i = 0; i < 8; ++i) {
      const int rl = i * 8 + (lane >> 3), ch = lane & 7;
      bf16_t* xp = p.X + (size_t)(row0 + wr * 64 + rl) * D + col0 + wc * 64 + ch * 8;
      float xv[8], dv[8];
      uint4 xu = *(const uint4*)xp, du = *(const uint4*)&t[rl][ch * 8];
      unpack8(xu, xv); unpack8(du, dv);
#pragma unroll
      for (int q = 0; q < 8; ++q) xv[q] += dv[q];
#if EN_MIX
      *(uint4*)xp = pack8(xv);
#endif
    }
  }
};
DEV void ph_gemm2(const P& p, int layer, char* smem) {
  int rt, ct;
  for (int it = 0; gemm_unit(it, 8, rt, ct); ++it) {
    Epi2 epi{p, layer, rt * 128, ct * 128};
    gemm_tile(p.Y + (size_t)rt * 128 * D, D, p.W2t + (size_t)ct * 128 * D, D, D, smem, epi);
  }
}

DEV void ph_peerconv(const P& p, int layer) {
  const int gw = (bid_() * 256 + tid_()) >> 6, nw = gridDim.x * 4, lane = tid_() & 63;
  const float* su = opq(p.peer_u) + (size_t)layer * 16384 * 1024;
  const float* sv = opq(p.peer_v) + (size_t)layer * 16384 * 1024;
  unsigned char* pu = opq(p.PU); unsigned char* pv = opq(p.PV);
  float* psu = opq(p.PSU); float* psv = opq(p.PSV);
#pragma unroll 1
  for (int r = gw; r < 32768; r += nw) {
    const bool isv = r >= 16384;
    const int e = r & 16383;
    const float* src = (isv ? sv : su) + (size_t)e * 1024 + 16 * lane;
    float4 f0 = *(const float4*)src, f1 = *(const float4*)(src + 4), f2 = *(const float4*)(src + 8), f3 = *(const float4*)(src + 12);
    float am = fmaxf(fmaxf(fmaxf(fabsf(f0.x), fabsf(f0.y)), fmaxf(fabsf(f0.z), fabsf(f0.w))), fmaxf(fmaxf(fabsf(f1.x), fabsf(f1.y)), fmaxf(fabsf(f1.z), fabsf(f1.w))));
    am = fmaxf(am, fmaxf(fmaxf(fmaxf(fabsf(f2.x), fabsf(f2.y)), fmaxf(fabsf(f2.z), fabsf(f2.w))), fmaxf(fmaxf(fabsf(f3.x), fabsf(f3.y)), fmaxf(fabsf(f3.z), fabsf(f3.w)))));
    am = wave_max(am);
    const float sc = am > 0.f ? 224.f / am : 1.f;
    int w0 = __builtin_amdgcn_cvt_pk_fp8_f32(f0.x * sc, f0.y * sc, 0, false); w0 = __builtin_amdgcn_cvt_pk_fp8_f32(f0.z * sc, f0.w * sc, w0, true);
    int w1 = __builtin_amdgcn_cvt_pk_fp8_f32(f1.x * sc, f1.y * sc, 0, false); w1 = __builtin_amdgcn_cvt_pk_fp8_f32(f1.z * sc, f1.w * sc, w1, true);
    int w2 = __builtin_amdgcn_cvt_pk_fp8_f32(f2.x * sc, f2.y * sc, 0, false); w2 = __builtin_amdgcn_cvt_pk_fp8_f32(f2.z * sc, f2.w * sc, w2, true);
    int w3 = __builtin_amdgcn_cvt_pk_fp8_f32(f3.x * sc, f3.y * sc, 0, false); w3 = __builtin_amdgcn_cvt_pk_fp8_f32(f3.z * sc, f3.w * sc, w3, true);
    *(uint4*)((isv ? pv : pu) + (size_t)(lane >> 3) * PSLICE + (size_t)e * 128 + 16 * (lane & 7)) = make_uint4((unsigned)w0, (unsigned)w1, (unsigned)w2, (unsigned)w3);
    if (lane == 0) (isv ? psv : psu)[e] = am > 0.f ? am * (1.f / 224.f) : 1.f;
  }
}
DEV void unpack16_fp8x2(const uint4& u, f32x2* f) {
  f[0] = __builtin_amdgcn_cvt_pk_f32_fp8((int)u.x, false); f[1] = __builtin_amdgcn_cvt_pk_f32_fp8((int)u.x, true);
  f[2] = __builtin_amdgcn_cvt_pk_f32_fp8((int)u.y, false); f[3] = __builtin_amdgcn_cvt_pk_f32_fp8((int)u.y, true);
  f[4] = __builtin_amdgcn_cvt_pk_f32_fp8((int)u.z, false); f[5] = __builtin_amdgcn_cvt_pk_f32_fp8((int)u.z, true);
  f[6] = __builtin_amdgcn_cvt_pk_f32_fp8((int)u.w, false); f[7] = __builtin_amdgcn_cvt_pk_f32_fp8((int)u.w, true);
}
DEV void unpack16_fp8(const uint4& u, float* f) {
  f32x2 t;
  t = __builtin_amdgcn_cvt_pk_f32_fp8((int)u.x, false); f[0] = t[0]; f[1] = t[1];
  t = __builtin_amdgcn_cvt_pk_f32_fp8((int)u.x, true); f[2] = t[0]; f[3] = t[1];
  t = __builtin_amdgcn_cvt_pk_f32_fp8((int)u.y, false); f[4] = t[0]; f[5] = t[1];
  t = __builtin_amdgcn_cvt_pk_f32_fp8((int)u.y, true); f[6] = t[0]; f[7] = t[1];
  t = __builtin_amdgcn_cvt_pk_f32_fp8((int)u.z, false); f[8] = t[0]; f[9] = t[1];
  t = __builtin_amdgcn_cvt_pk_f32_fp8((int)u.z, true); f[10] = t[0]; f[11] = t[1];
  t = __builtin_amdgcn_cvt_pk_f32_fp8((int)u.w, false); f[12] = t[0]; f[13] = t[1];
  t = __builtin_amdgcn_cvt_pk_f32_fp8((int)u.w, true); f[14] = t[0]; f[15] = t[1];
}

struct Epi3 {
  const P& p; int row0, grp;
  DEV void operator()(f32x4 (&acc)[4][4], int wr, int wc, int fr, int fq, char* smem) const {
    float* sc = (float*)smem;
    const int tid = tid_();
    for (int pass = 0; pass < 2; ++pass) {
      __syncthreads();
      if (wr == pass) {
#pragma unroll
        for (int m = 0; m < 4; ++m)
#pragma unroll
          for (int n = 0; n < 4; ++n)
#pragma unroll
            for (int j = 0; j < 4; ++j) {
              int rl = m * 16 + fq * 4 + j, col = wc * 64 + n * 16 + fr;
              unsigned bits = (__float_as_uint(acc[m][n][j]) & ~127u) | (unsigned)col;
              sc[rl * 133 + (col >> 5) * 33 + (col & 31)] = __uint_as_float(bits);
            }
      }
      __syncthreads();
      const int rl = tid >> 2, q = tid & 3;
      float Ls[16];
#pragma unroll
      for (int i = 0; i < 16; ++i) Ls[i] = -3e38f;
      const float* src = sc + rl * 133 + q * 33;
      for (int i = 0; i < 32; ++i) {
        float x = src[i];
        if (x > Ls[15]) {
#pragma unroll
          for (int k = 0; k < 16; ++k) { float hi = fmaxf(Ls[k], x); x = fminf(Ls[k], x); Ls[k] = hi; }
        }
      }
      float Cs[16];
#pragma unroll
      for (int i = 0; i < 16; ++i) Cs[i] = fmaxf(Ls[i], dppself<0xB1, 0xF>(Ls[15 - i]));
#pragma unroll
      for (int d = 8; d >= 1; d >>= 1)
#pragma unroll
        for (int i = 0; i < 16; ++i)
          if ((i & d) == 0) { float hi = fmaxf(Cs[i], Cs[i + d]), lo = fminf(Cs[i], Cs[i + d]); Cs[i] = hi; Cs[i + d] = lo; }
      float Ds[16];
#pragma unroll
      for (int i = 0; i < 16; ++i) Ds[i] = fmaxf(Cs[i], dppself<0x4E, 0xF>(Cs[15 - i]));
#pragma unroll
      for (int d = 8; d >= 1; d >>= 1)
#pragma unroll
        for (int i = 0; i < 16; ++i)
          if ((i & d) == 0) { float hi = fmaxf(Ds[i], Ds[i + d]), lo = fminf(Ds[i], Ds[i + d]); Ds[i] = hi; Ds[i + d] = lo; }
      if (q == 0) {
        float* dst = p.TK + ((size_t)(row0 + pass * 64 + rl) * 16 + grp) * 16;
#pragma unroll
        for (int i = 0; i < 4; ++i) *(float4*)(dst + 4 * i) = make_float4(Ds[4 * i], Ds[4 * i + 1], Ds[4 * i + 2], Ds[4 * i + 3]);
      }
    }
  }
};
DEV void ph_gemm3(const P& p, char* smem) {
  int rt, ct;
  for (int it = 0; gemm_unit(it, 16, rt, ct); ++it) {
    Epi3 epi{p, rt * 128, ct};
    gemm_tile(p.H + (size_t)rt * 128 * D, D, p.Wft + (size_t)ct * 128 * D, D, D, smem, epi);
  }
}

DEV float peer_gate(float scr) {
  float mx = row16_max(scr);
  float ex = __expf(scr - mx);
  float sm = row16_sum(ex);
  return ex / sm;
}
DEV float gelu_exact(float x) { return 0.5f * x * (1.f + erff(x * 0.7071067811865476f)); }

DEV void ph_peer_select(const P& p) {
  const int gw = (bid_() * 256 + tid_()) >> 6, nw = gridDim.x * 4, lane = tid_() & 63;
  int ci, cj;
  {
    const int c = lane;
    if (c < 16) { ci = 0; cj = c; } else if (c < 24) { ci = 1; cj = c - 16; } else if (c < 29) { ci = 2; cj = c - 24; }
    else if (c < 33) { ci = 3; cj = c - 29; } else if (c < 36) { ci = 4; cj = c - 33; } else if (c < 38) { ci = 5; cj = c - 36; }
    else if (c < 40) { ci = 6; cj = c - 38; } else if (c < 42) { ci = 7; cj = c - 40; } else { ci = (c - 42 + 8) & 15; cj = 0; }
  }
  const bool cand = lane < 50;
  float v1s[8], v2s[8];
  auto ldtk = [&](int row) {
    const float* tk = p.TK + (size_t)row * 256;
#pragma unroll
    for (int h = 0; h < 8; ++h) { v1s[h] = tk[(2 * h) * 16 + ci]; v2s[h] = tk[(2 * h + 1) * 16 + cj]; }
  };
  if (gw < NTOK) ldtk(gw);
#pragma unroll 1
  for (int row = gw; row < NTOK; row += nw) {
    float c1[8], c2[8];
#pragma unroll
    for (int h = 0; h < 8; ++h) { c1[h] = v1s[h]; c2[h] = v2s[h]; }
    if (row + nw < NTOK) ldtk(row + nw);
#pragma unroll
    for (int h = 0; h < 8; ++h) {
      const float v1 = c1[h], v2 = c2[h];
      float val = v1 + v2;
      val = __uint_as_float((__float_as_uint(val) & ~63u) | (unsigned)lane);
      val = cand ? val : -3e38f;
      int rank = 0;
#pragma unroll
      for (int q = 0; q < 50; ++q) rank += (readlane_f(val, q) > val) ? 1 : 0;
      const bool sel = cand && rank < 16;
      const float mx = wave_max(val);
      const float ex = sel ? __expf(val - mx) : 0.f;
      const float sm = wave_sum(ex);
      if (sel) {
        const int e = (int)(__float_as_uint(v1) & 127u) * 128 + (int)(__float_as_uint(v2) & 127u);
        p.EL[(size_t)row * 128 + h * 16 + rank] = (unsigned short)e;
        p.GT[(size_t)row * 128 + h * 16 + rank] = ex / sm;
      }
    }
  }
}

struct PeerPre { uint4 e0, e1, a0, a1, a2, a3; };
DEV unsigned peer_eid(const PeerPre& s, int j) {
  const unsigned w = (j < 8) ? ((j >> 1) == 0 ? s.e0.x : (j >> 1) == 1 ? s.e0.y : (j >> 1) == 2 ? s.e0.z : s.e0.w)
                             : (((j - 8) >> 1) == 0 ? s.e1.x : ((j - 8) >> 1) == 1 ? s.e1.y : ((j - 8) >> 1) == 2 ? s.e1.z : s.e1.w);
  return (j & 1) ? (w >> 16) : (w & 0xFFFFu);
}
template <int WHICH>
DEV void peer_wave_run(const P& p, int layer, int x, int tok0, int lane, float* wbuf) {
  const int r = lane >> 3, c = lane & 7;
  const unsigned char* tb = (WHICH == 0 ? p.PU : p.PV) + (size_t)x * PSLICE + c * 16;
  PeerPre S[3];
  uint4 R[16];
  auto ld_pre = [&](int tok, PeerPre& s) {
    const uint4* elp = (const uint4*)(p.EL + (size_t)tok * 128 + r * 16);
    s.e0 = elp[0]; s.e1 = elp[1];
    if (WHICH == 0) {
      const bf16_t* hr = p.H + (size_t)tok * D + x * 128 + c * 16;
      s.a0 = *(const uint4*)hr; s.a1 = *(const uint4*)(hr + 8);
    } else {
      const uint4* wtp = (const uint4*)(p.GT + (size_t)tok * 128 + r * 16);
      s.a0 = wtp[0]; s.a1 = wtp[1]; s.a2 = wtp[2]; s.a3 = wtp[3];
    }
  };
  auto comp = [&](int tok, const PeerPre& s, const PeerPre& sn, bool more) {
    if (WHICH == 0) {
      float hv[16];
      unpack8(s.a0, hv); unpack8(s.a1, hv + 8);
      f32x2 hv2[8];
#pragma unroll
      for (int i = 0; i < 8; ++i) hv2[i] = (f32x2){hv[2 * i], hv[2 * i + 1]};
      float keep0 = 0.f, keep1 = 0.f;
#pragma unroll
      for (int j = 0; j < 16; ++j) {
        f32x2 f[8];
        unpack16_fp8x2(R[j], f);
        if (more) R[j] = *(const uint4*)(tb + (size_t)peer_eid(sn, j) * 128);
        f32x2 d2 = f[0] * hv2[0];
#pragma unroll
        for (int i = 1; i < 8; ++i) d2 += f[i] * hv2[i];
        const float d = oct_sum(d2[0] + d2[1]);
        if (j < 8) keep0 = (c == j) ? d : keep0; else keep1 = (c == j - 8) ? d : keep1;
      }
      float* pd = p.PD + ((size_t)x * NTOK + tok) * 128 + r * 16 + c;
      pd[0] = keep0; pd[8] = keep1;
    } else {
      const float wsv[16] = {__uint_as_float(s.a0.x), __uint_as_float(s.a0.y), __uint_as_float(s.a0.z), __uint_as_float(s.a0.w),
                             __uint_as_float(s.a1.x), __uint_as_float(s.a1.y), __uint_as_float(s.a1.z), __uint_as_float(s.a1.w),
                             __uint_as_float(s.a2.x), __uint_as_float(s.a2.y), __uint_as_float(s.a2.z), __uint_as_float(s.a2.w),
                             __uint_as_float(s.a3.x), __uint_as_float(s.a3.y), __uint_as_float(s.a3.z), __uint_as_float(s.a3.w)};
      f32x2 acc2[8];
#pragma unroll
      for (int i = 0; i < 8; ++i) acc2[i] = (f32x2){0.f, 0.f};
#pragma unroll
      for (int j = 0; j < 16; ++j) {
        f32x2 f[8];
        unpack16_fp8x2(R[j], f);
        if (more) R[j] = *(const uint4*)(tb + (size_t)peer_eid(sn, j) * 128);
        const f32x2 w2 = (f32x2){wsv[j], wsv[j]};
#pragma unroll
        for (int i = 0; i < 8; ++i) acc2[i] += w2 * f[i];
      }
      float* slab = wbuf + (r * 8 + c) * 16;
      *(float4*)(slab) = make_float4(acc2[0][0], acc2[0][1], acc2[1][0], acc2[1][1]);
      *(float4*)(slab + 4) = make_float4(acc2[2][0], acc2[2][1], acc2[3][0], acc2[3][1]);
      *(float4*)(slab + 8) = make_float4(acc2[4][0], acc2[4][1], acc2[5][0], acc2[5][1]);
      *(float4*)(slab + 12) = make_float4(acc2[6][0], acc2[6][1], acc2[7][0], acc2[7][1]);
      asm volatile("s_waitcnt lgkmcnt(0)" ::: "memory");
      float o0 = 0.f, o1 = 0.f;
#pragma unroll
      for (int rr = 0; rr < 8; ++rr) {
        const float2 t = *(const float2*)(wbuf + (rr * 8 + (lane >> 3)) * 16 + 2 * (lane & 7));
        o0 += t.x; o1 += t.y;
      }
      asm volatile("s_waitcnt lgkmcnt(0)" ::: "memory");
      const int b = tok / LT, pp = tok % LT;
      const int mr = pp < LC ? 16 : b;
      const int col = x * 128 + 2 * lane;
      const float* g2 = p.modv + ((size_t)layer * 17 + mr) * 6144 + 5120 + col;
      unsigned* xp = (unsigned*)(p.X + (size_t)tok * D + col);
      const unsigned xu = *xp;
#if EN_PEER
      *xp = pack2(bflo(xu) + g2[0] * o0, bfhi(xu) + g2[1] * o1);
#endif
    }
  };
  ld_pre(tok0, S[0]);
  ld_pre(tok0 + 1, S[1]);
#pragma unroll
  for (int j = 0; j < 16; ++j) R[j] = *(const uint4*)(tb + (size_t)peer_eid(S[0], j) * 128);
  ld_pre(tok0 + 2, S[2]);
#pragma unroll
  for (int t = 0; t < 8; ++t) {
    comp(tok0 + t, S[t % 3], S[(t + 1) % 3], t + 1 < 8);
    if (t + 3 < 8) ld_pre(tok0 + t + 3, S[t % 3]);
  }
}
DEV void ph_peer_w(const P& p) {
  for (size_t i = (size_t)bid_() * 256 + tid_(); i < (size_t)NTOK * 128; i += (size_t)gridDim.x * 256) {
    float d = 0.f;
#pragma unroll
    for (int x = 0; x < 8; ++x) d += p.PD[(size_t)x * NTOK * 128 + i];
    const int e = p.EL[i];
    p.GT[i] = p.GT[i] * gelu_exact(d * p.PSU[e]) * p.PSV[e];
  }
}
template <int WHICH>
DEV void ph_peer_gather(const P& p, int layer, char* smem, volatile LAS unsigned* slot) {
  const int tid = tid_(), lane = tid & 63, wid = tid >> 6;
  unsigned* q = p.wq + 1024 + layer * 256 + WHICH * 128;
  const int my = (int)(xb_xcc_id() & 7u);
  float* wbuf = (float*)smem + wid * 1024;
#pragma unroll 1
  for (int rot = 0; rot < 8; ++rot) {
    const int x = (my + rot) & 7;
    for (;;) {
      __syncthreads();
      if (tid == 0) *slot = atomicAdd(q + x * 16, 1u);
      __syncthreads();
      const int it = (int)*slot;
      if (it >= NTOK / 32) break;
      peer_wave_run<WHICH>(p, layer, x, it * 32 + wid * 8, lane, wbuf);
    }
  }
}

DEV void ph_final(const P& p) {
  const int gw = (bid_() * 256 + tid_()) >> 6, nw = gridDim.x * 4, lane = tid_() & 63;
  for (int r = gw; r < NB * T; r += nw) {
    int b = r / T, t = r % T;
    const bf16_t* xr = p.X + ((size_t)b * LT + LC + t) * D;
    uint4 u0 = *(const uint4*)(xr + 8 * lane), u1 = *(const uint4*)(xr + 512 + 8 * lane);
    float v[16];
    unpack8(u0, v); unpack8(u1, v + 8);
    float ss = 0.f;
#pragma unroll
    for (int i = 0; i < 16; ++i) ss += v[i] * v[i];
    ss = wave_sum(ss);
    float rstd = rsqrtf(ss * (1.f / 1024.f) + 1e-6f);
    float* o = p.out + (size_t)r * D;
#pragma unroll
    for (int hh = 0; hh < 2; ++hh) {
      int col = hh * 512 + 8 * lane;
      float4 a = make_float4(v[hh * 8 + 0] * rstd * p.final_g[col + 0], v[hh * 8 + 1] * rstd * p.final_g[col + 1], v[hh * 8 + 2] * rstd * p.final_g[col + 2], v[hh * 8 + 3] * rstd * p.final_g[col + 3]);
      float4 c = make_float4(v[hh * 8 + 4] * rstd * p.final_g[col + 4], v[hh * 8 + 5] * rstd * p.final_g[col + 5], v[hh * 8 + 6] * rstd * p.final_g[col + 6], v[hh * 8 + 7] * rstd * p.final_g[col + 7]);
      *(float4*)(o + col) = a; *(float4*)(o + col + 4) = c;
    }
  }
}

DEV unsigned hw_cu_key() {
  const unsigned hwid = (unsigned)__builtin_amdgcn_s_getreg(((8 - 1) << 11) | (8 << 6) | 4);
  return (xb_xcc_id() << 8) | (hwid & 0xFFu);
}
DEV void mixB(const P& p, int layer, char* smem, volatile LAS unsigned* slot) {
  unsigned* qa = p.wq + layer * 64;
  unsigned* qs = qa + 16;
  unsigned* claim = p.cuclaim + layer * 4096;
  __syncthreads();
  if (tid_() == 0) {
    unsigned u = 0xFFFFFFFFu;
    if (atomicAdd(&claim[hw_cu_key() & 4095u], 1u) == 0u) u = atomicAdd(qs, 1u);
    *slot = u;
  }
  __syncthreads();
  {
    const unsigned u = *slot;
    if (u < 128u) scanc_unit(p, layer, (int)u, smem);
  }
  for (;;) {
    __syncthreads();
    if (tid_() == 0) *slot = atomicAdd(qa, 1u);
    __syncthreads();
    const int u = (int)*slot;
    if (u >= 8704) break;
    if (u < 4352) attn_unit(p, layer, u, smem); else hyena_conv_unit(p, layer, u - 4352, smem);
  }
  for (;;) {
    __syncthreads();
    if (tid_() == 0) *slot = atomicAdd(qs, 1u);
    __syncthreads();
    const unsigned u = *slot;
    if (u >= 128u) break;
    scanc_unit(p, layer, (int)u, smem);
  }
}
DEV void mixA(const P& p, int layer, char* smem) {
  for (int u = bid_(); u < 1088; u += gridDim.x) hyena_pre_unit(p, layer, u);
  ph_lora(p, layer, smem);
  ph_rwkv_prep(p, layer);
}
DEV void mixC(const P& p, int layer, char* smem) {
  for (int u = bid_(); u < 1088; u += gridDim.x) hyena_post_unit(p, layer, u, smem);
  ph_rwkv_post(p, layer);
  ph_attn_post(p, layer);
}

__global__ void __launch_bounds__(256, 2) k_mega(P p) {
  extern __shared__ __attribute__((aligned(16))) char smem_all[];
  char* smem = smem_all;
  volatile LAS unsigned* xbw = (volatile LAS unsigned*)(smem_all + SMEM_BYTES);
  if (threadIdx.x == 0) { xbw[0] = 0u; xbw[1] = 0u; xbw[2] = 0u; xbw[3] = 0u; }
  __syncthreads();
  XcdBarrier bar = xcd_barrier_post(p.bar, xbw);
#ifndef NO_PRO
  ph_copy(p);
  ph_rope(p);
  for (int u = blockIdx.x; u < 96; u += gridDim.x) modv_unit(p, u, smem);
#endif
#ifndef NO_PREP
  ph_prep(p, 0, smem);
#endif
  xcd_barrier(bar);
  for (int layer = 0; layer < NLAYERS; ++layer) {
#ifndef NO_NORM
    ph_norm(p, layer, 0);
#endif
    xcd_barrier(bar);
#ifdef PROBE_GEMM
    ph_gemm1(p, smem);
#endif
#ifndef NO_GEMM1
    ph_gemm1(p, smem);
#endif
    xcd_barrier(bar);
#ifndef NO_MIXA
    mixA(p, layer, smem);
#endif
    xcd_barrier(bar);
#ifndef NO_MIXB
    mixB(p, layer, smem, (volatile LAS unsigned*)(smem_all + SMEM_BYTES + 16));
#endif
    xcd_barrier(bar);
#ifndef NO_MIXC
    mixC(p, layer, smem);
#endif
    xcd_barrier(bar);
#ifndef NO_GEMM2
    ph_gemm2(p, layer, smem);
    ph_peerconv(p, layer);
#endif
    xcd_barrier(bar);
#ifndef NO_NORM
    ph_norm(p, layer, 1);
#endif
    xcd_barrier(bar);
#ifdef PROBE_GEMM
    ph_gemm3(p, smem);
#endif
#ifndef NO_GEMM3
    ph_gemm3(p, smem);
#endif
    xcd_barrier(bar);
    ph_peer_select(p);
    xcd_barrier(bar);
    ph_peer_gather<0>(p, layer, smem, (volatile LAS unsigned*)(smem_all + SMEM_BYTES + 16));
    xcd_barrier(bar);
    ph_peer_w(p);
    xcd_barrier(bar);
    ph_peer_gather<1>(p, layer, smem, (volatile LAS unsigned*)(smem_all + SMEM_BYTES + 16));
#ifndef NO_PREP
    if (layer + 1 < NLAYERS) ph_prep(p, layer + 1, smem);
#endif
    xcd_barrier(bar);
  }
  ph_final(p);
}

static inline size_t al256(size_t x) { return (x + 255) & ~(size_t)255; }

extern "C" void kernel_launch(void* const* d_in, const int* in_sizes, int n_in, void* d_out, int out_size, void* d_ws, size_t ws_size,
                              hipStream_t stream) {
  (void)in_sizes; (void)n_in; (void)out_size; (void)ws_size;
  P p{};
  const float** f = (const float**)&p;
  for (int i = 0; i < 39; ++i) f[i] = (const float*)d_in[i];
  p.out = (float*)d_out;
  char* w = (char*)d_ws;
  size_t off = 0;
  auto take = [&](size_t bytes) { char* r = w + off; off += al256(bytes); return r; };
  p.bar = (unsigned*)take(16384);
  p.modv = (float*)take((size_t)DEPTH * 17 * 6144 * 4);
  p.SSQ = (float*)take((size_t)DEPTH * 2 * 256 * 4);
  p.wq = (unsigned*)take(4096 + DEPTH * 1024);
  p.cuclaim = (unsigned*)take((size_t)DEPTH * 4096 * 4);
  const size_t zero_bytes = off;
  p.rope = (float*)take(64 * 16 * 2 * 4);
  p.X = (bf16_t*)take((size_t)NTOK * D * 2);
  p.H = (bf16_t*)take((size_t)NTOK * D * 2);
  p.Y = (bf16_t*)take((size_t)NTOK * D * 2);
  p.SC = (bf16_t*)take((size_t)NTOK * 1024 * 2);
  p.Z = (bf16_t*)take((size_t)NTOK * INW * 2);
  p.UTl = (bf16_t*)take((size_t)256 * 16 * T * 2);
  p.UTc = (bf16_t*)take((size_t)256 * 16 * LC * 2);
  p.YTl = (bf16_t*)take((size_t)256 * 16 * T * 2);
  p.YTc = (bf16_t*)take((size_t)256 * 16 * LC * 2);
  p.FL = (float*)take((size_t)256 * 2 * T * 4);
  p.FC = (float*)take((size_t)256 * 2 * LC * 4);
  p.W1t = (bf16_t*)take((size_t)INW * D * 2);
  p.W2t = (bf16_t*)take((size_t)D * D * 2);
  p.Wft = (bf16_t*)take((size_t)2048 * D * 2);
  p.Wlt = (bf16_t*)take((size_t)1024 * 256 * 2);
  p.Wgt = (bf16_t*)take((size_t)256 * 128 * 2);
  p.TK = (float*)p.Z;
  p.PU = (unsigned char*)p.Z + al256((size_t)NTOK * 256 * 4);
  p.PV = p.PU + (size_t)16384 * 1024;
  p.PSU = (float*)(p.PV + (size_t)16384 * 1024);
  p.PSV = p.PSU + 16384;
  p.GT = p.PSV + 16384;
  p.EL = (unsigned short*)(p.GT + (size_t)NTOK * 128);
  p.PD = (float*)p.Y;

  (void)hipMemsetAsync(d_ws, 0, zero_bytes, stream);
  constexpr size_t kDynLds = SMEM_BYTES + 32;
  static int grid = 0;
  if (!grid) {
    int dev = 0, cus = 0, per_cu = 0;
    (void)hipGetDevice(&dev);
    (void)hipDeviceGetAttribute(&cus, hipDeviceAttributeMultiprocessorCount, dev);
    (void)hipFuncSetAttribute((const void*)k_mega, hipFuncAttributeMaxDynamicSharedMemorySize, (int)kDynLds);
    (void)hipOccupancyMaxActiveBlocksPerMultiprocessor(&per_cu, k_mega, 256, kDynLds);
    if (cus <= 0) cus = 256;
    if (per_cu > 2) per_cu = 2;
    if (per_cu < 1) per_cu = 1;
    grid = cus * per_cu;
  }
  k_mega<<<grid, 256, kDynLds, stream>>>(p);
}
```

```cpp
#include <hip/hip_runtime.h>
#include <stdint.h>
#include <type_traits>

#define DEV __device__ __forceinline__
typedef unsigned short bf16_t;
typedef short bf16x8 __attribute__((ext_vector_type(8)));
typedef float f32x2 __attribute__((ext_vector_type(2)));
constexpr size_t PSLICE = (size_t)16384 * 128;
typedef float f32x4 __attribute__((ext_vector_type(4)));
typedef float f32x16 __attribute__((ext_vector_type(16)));

#ifndef NLAYERS
#define NLAYERS 4
#endif
#ifndef EN_HY
#define EN_HY 1
#endif
#ifndef EN_RW
#define EN_RW 1
#endif
#ifndef EN_AT
#define EN_AT 1
#endif
#ifndef EN_MIX
#define EN_MIX 1
#endif
#ifndef EN_PEER
#define EN_PEER 1
#endif

constexpr int NB = 16, T = 4096, LC = 256, LT = 4352, D = 1024, NTOK = NB * LT, INW = 2688, DEPTH = 4;
constexpr int SMEM_BYTES = 65536;

struct P {
  const float *x, *c, *ctx, *c_ctx, *mod_w, *mod_b, *norm1_g, *norm2_g, *w_in, *conv_w, *conv_b;
  const float *hy_w1, *hy_b1, *hy_w2, *hy_b2, *hy_w3, *hy_b3, *hy_freq, *hy_bias;
  const float *rw_w0, *rw_w_up, *rw_a0, *rw_a_up, *rw_g_up, *rw_k_k, *rw_k_a, *rw_r_k, *rw_ln_w, *rw_ln_b;
  const float *attn_sink, *hy_out_g, *at_out_g, *w_out, *peer_wq, *peer_k1, *peer_k2, *peer_u, *peer_v, *final_g;
  float* out;
  unsigned* bar;
  float *modv, *SSQ, *rope, *FL, *FC, *TK;
  unsigned *wq, *cuclaim;
  bf16_t *X, *H, *Y, *SC, *Z, *UTl, *UTc, *YTl, *YTc;
  bf16_t *W1t, *W2t, *Wft, *Wlt, *Wgt;
  unsigned char *PU, *PV;
  float *PSU, *PSV, *GT, *PD;
  unsigned short* EL;
};

typedef __bf16 hwbf2 __attribute__((ext_vector_type(2)));
DEV unsigned pack2(float a, float b) { f32x2 f = {a, b}; hwbf2 r = __builtin_convertvector(f, hwbf2); return __builtin_bit_cast(unsigned, r); }
DEV bf16_t f2bf(float f) { return (bf16_t)(pack2(f, 0.f) & 0xFFFFu); }
DEV float bf2f(bf16_t h) { return __uint_as_float(((unsigned)h) << 16); }
DEV float bflo(unsigned u) { return __uint_as_float(u << 16); }
DEV float bfhi(unsigned u) { return __uint_as_float(u & 0xFFFF0000u); }
DEV void unpack8(const uint4& u, float* v) {
  v[0] = bflo(u.x); v[1] = bfhi(u.x); v[2] = bflo(u.y); v[3] = bfhi(u.y);
  v[4] = bflo(u.z); v[5] = bfhi(u.z); v[6] = bflo(u.w); v[7] = bfhi(u.w);
}
DEV uint4 pack8(const float* v) { return make_uint4(pack2(v[0], v[1]), pack2(v[2], v[3]), pack2(v[4], v[5]), pack2(v[6], v[7])); }
DEV float sigmoidf_(float x) { return __builtin_amdgcn_rcpf(1.f + __expf(-x)); }

template <int CTRL, int ROWMASK>
DEV float dpp0(float x) {
  return __builtin_bit_cast(float, __builtin_amdgcn_update_dpp(0, __builtin_bit_cast(int, x), CTRL, ROWMASK, 0xF, false));
}
template <int CTRL, int ROWMASK>
DEV float dppself(float x) {
  int xi = __builtin_bit_cast(int, x);
  return __builtin_bit_cast(float, __builtin_amdgcn_update_dpp(xi, xi, CTRL, ROWMASK, 0xF, false));
}
DEV float readlane_f(float x, int l) { return __builtin_bit_cast(float, __builtin_amdgcn_readlane(__builtin_bit_cast(int, x), l)); }
DEV int lane_id() { return (int)__builtin_amdgcn_mbcnt_hi(~0u, __builtin_amdgcn_mbcnt_lo(~0u, 0u)); }
DEV float writelane_f(float val, int l, float old) { return lane_id() == l ? val : old; }
DEV int writelane_i(int val, int l, int old) { return lane_id() == l ? val : old; }
DEV float wave_sum(float x) {
  x += dpp0<0x111, 0xF>(x); x += dpp0<0x112, 0xF>(x); x += dpp0<0x114, 0xF>(x); x += dpp0<0x118, 0xF>(x);
  x += dpp0<0x142, 0xA>(x); x += dpp0<0x143, 0xC>(x);
  return readlane_f(x, 63);
}
DEV float wave_max(float x) {
  x = fmaxf(x, dppself<0x111, 0xF>(x)); x = fmaxf(x, dppself<0x112, 0xF>(x)); x = fmaxf(x, dppself<0x114, 0xF>(x));
  x = fmaxf(x, dppself<0x118, 0xF>(x)); x = fmaxf(x, dppself<0x142, 0xA>(x)); x = fmaxf(x, dppself<0x143, 0xC>(x));
  return readlane_f(x, 63);
}
DEV float row16_sum(float x) {
  x += dpp0<0xB1, 0xF>(x); x += dpp0<0x4E, 0xF>(x); x += dpp0<0x141, 0xF>(x); x += dpp0<0x140, 0xF>(x);
  return x;
}
DEV float row16_max(float x) {
  x = fmaxf(x, dppself<0xB1, 0xF>(x)); x = fmaxf(x, dppself<0x4E, 0xF>(x)); x = fmaxf(x, dppself<0x141, 0xF>(x));
  x = fmaxf(x, dppself<0x140, 0xF>(x));
  return x;
}
DEV float quad_sum(float x) { x += dpp0<0xB1, 0xF>(x); x += dpp0<0x4E, 0xF>(x); return x; }

DEV f32x4 mfma16(bf16x8 a, bf16x8 b, f32x4 c) { return __builtin_amdgcn_mfma_f32_16x16x32_bf16(a, b, c, 0, 0, 0); }
DEV f32x16 mfma32(bf16x8 a, bf16x8 b, f32x16 c) { return __builtin_amdgcn_mfma_f32_32x32x16_bf16(a, b, c, 0, 0, 0); }


#define XB_TMO      128
#define XB_XCNT(j)  (256  + 64 * (j))
#define XB_XSUB(j)  (1280 + 64 * (j))
#define XB_XGEN(j)  (2304 + 64 * (j))
#define XB_TOP      3328
#define XB_TOPGEN   3392
#define XCD_BAR_WORDS 3456
#define XB_SPIN_CAP (1u << 23)
#define LAS __attribute__((address_space(3)))

__device__ __forceinline__ unsigned xb_ld(unsigned* p)              { return __hip_atomic_load(p, __ATOMIC_RELAXED, __HIP_MEMORY_SCOPE_AGENT); }
__device__ __forceinline__ unsigned xb_add(unsigned* p, unsigned v) { return __hip_atomic_fetch_add(p, v, __ATOMIC_RELAXED, __HIP_MEMORY_SCOPE_AGENT); }
__device__ __forceinline__ unsigned xb_xcc_id() { return (unsigned)__builtin_amdgcn_s_getreg((3 << 11) | 20) & 0xFu; }
#define XB_SPIN(cond, bar) do { unsigned _sp = 0; while (cond) { __builtin_amdgcn_s_sleep(1); \
    if ((++_sp & 255u) == 0u) { if (xb_ld(&(bar)[XB_TMO])) break; if (_sp > XB_SPIN_CAP) { atomicAdd(&(bar)[XB_TMO], 1u); break; } } } } while (0)

struct XcdBarrier {
    unsigned* bar; unsigned x;
    volatile LAS unsigned* st;
};
__device__ __forceinline__ XcdBarrier xcd_barrier_post(unsigned* bar, volatile LAS unsigned* st) {
    XcdBarrier b; b.bar = bar; b.x = xb_xcc_id(); b.st = st;
    if (threadIdx.x == 0) (void)xb_add(&bar[XB_XCNT(b.x)], 1u);
    return b;
}
__device__ __forceinline__ void xcd_barrier_complete(unsigned* bar, unsigned x, unsigned& nloc, unsigned& nx) {
    const unsigned G = gridDim.x * gridDim.y * gridDim.z;
    unsigned sum, cnt, mine, sp = 0u;
    for (;;) {
        sum = 0u; cnt = 0u; mine = 0u;
#pragma unroll
        for (unsigned j = 0; j < 16; ++j) { const unsigned c = xb_ld(&bar[XB_XCNT(j)]); sum += c; cnt += (c > 0u) ? 1u : 0u; mine = (j == x) ? c : mine; }
        if (sum == G) break;
        __builtin_amdgcn_s_sleep(1);
        if ((++sp & 255u) == 0u) { if (xb_ld(&bar[XB_TMO])) break; if (sp > XB_SPIN_CAP) { atomicAdd(&bar[XB_TMO], 1u); break; } }
    }
    nloc = mine > 0u ? mine : 1u; nx = cnt > 0u ? cnt : 1u;
}
__device__ __forceinline__ void xcd_barrier(const XcdBarrier& b) {
    asm volatile("s_waitcnt vmcnt(0)" ::: "memory");
    __syncthreads();
    if (threadIdx.x == 0) {
        unsigned* bar = b.bar;
        __builtin_amdgcn_s_waitcnt(0);
        unsigned nloc = b.st[0], nx = b.st[1];
        if (nloc == 0u) { xcd_barrier_complete(bar, b.x, nloc, nx); b.st[0] = nloc; b.st[1] = nx; }
        const unsigned old = xb_add(&bar[XB_XSUB(b.x)], 1u);
        const unsigned gen = old / nloc;
        if (old + 1u == (gen + 1u) * nloc) {
            __builtin_amdgcn_fence(__ATOMIC_RELEASE, "agent");
            asm volatile("s_waitcnt vmcnt(0)" ::: "memory");
            const unsigned og = xb_add(&bar[XB_TOP], 1u);
            const unsigned tg = og / nx;
            if (og + 1u == (tg + 1u) * nx) xb_add(&bar[XB_TOPGEN], 1u);
            else XB_SPIN(xb_ld(&bar[XB_TOPGEN]) == tg, bar);
            __builtin_amdgcn_fence(__ATOMIC_ACQUIRE, "agent");
            xb_add(&bar[XB_XGEN(b.x)], 1u);
            asm volatile("s_waitcnt vmcnt(0)" ::: "memory");
        } else {
            XB_SPIN(xb_ld(&bar[XB_XGEN(b.x)]) == gen, bar);
            __builtin_amdgcn_fence(__ATOMIC_ACQUIRE, "agent");
            asm volatile("s_waitcnt vmcnt(0)" ::: "memory");
        }
    }
    __syncthreads();
}

template <class Tp> DEV Tp* opq(Tp* q) { asm volatile("" : "+s"(q)); return q; }
DEV int tid_() { int t = threadIdx.x; asm volatile("" : "+v"(t)); return t; }
DEV int bid_() { int b = blockIdx.x; asm volatile("" : "+s"(b)); return b; }

DEV void glds16(const void* gsrc, char* lds_lane_ptr) {
  __builtin_amdgcn_global_load_lds((const unsigned*)gsrc, (__attribute__((address_space(3))) unsigned*)lds_lane_ptr, 16, 0, 0);
}
template <class Epi>
DEV void gemm_tile(const bf16_t* __restrict__ A, int lda, const bf16_t* __restrict__ Bt, int ldb, int K, char* smem, Epi& epi) {
  const int tid = tid_(), lane = tid & 63, wid = tid >> 6, wr = wid >> 1, wc = wid & 1, fr = lane & 15, fq = lane >> 4;
  f32x4 acc[4][4];
#pragma unroll
  for (int m = 0; m < 4; ++m)
#pragma unroll
    for (int n = 0; n < 4; ++n) acc[m][n] = (f32x4){0.f, 0.f, 0.f, 0.f};
  const int drow0 = 8 * wid + (lane >> 3), dpc = lane & 7;
  auto issue = [&](int kt, int buf) {
    char* sa = smem + buf * 32768;
    char* sb = sa + 16384;
#pragma unroll
    for (int i = 0; i < 4; ++i) {
      const int row = drow0 + 32 * i;
      const int kc = dpc ^ ((row >> 1) & 7);
      glds16(A + (size_t)row * lda + kt * 64 + kc * 8, sa + (i * 4 + wid) * 1024 + lane * 16);
      glds16(Bt + (size_t)row * ldb + kt * 64 + kc * 8, sb + (i * 4 + wid) * 1024 + lane * 16);
    }
  };
  __syncthreads();
  issue(0, 0);
  const int nk = K >> 6;
  const int sw = (fr >> 1) & 7;
  const int aoff = (wr * 64 + fr) * 128, boff = (wc * 64 + fr) * 128;
  for (int kt = 0; kt < nk; ++kt) {
    asm volatile("s_waitcnt vmcnt(0)" ::: "memory");
    __syncthreads();
    if (kt + 1 < nk) issue(kt + 1, (kt + 1) & 1);
    const char* sa = smem + (kt & 1) * 32768;
    const char* sb = sa + 16384;
#pragma unroll
    for (int kh = 0; kh < 2; ++kh) {
      const int pc = ((kh * 4 + fq) ^ sw) * 16;
      bf16x8 af[4], bfr[4];
#pragma unroll
      for (int m = 0; m < 4; ++m) af[m] = *(const bf16x8*)(sa + aoff + m * 2048 + pc);
#pragma unroll
      for (int n = 0; n < 4; ++n) bfr[n] = *(const bf16x8*)(sb + boff + n * 2048 + pc);
#pragma unroll
      for (int m = 0; m < 4; ++m)
#pragma unroll
        for (int n = 0; n < 4; ++n) acc[m][n] = mfma16(af[m], bfr[n], acc[m][n]);
    }
  }
  __syncthreads();
  epi(acc, wr, wc, fr, fq, smem);
}
DEV void stage_tile_bf16(const f32x4 (&acc)[4][4], char* smem, int wid, int fr, int fq) {
  bf16_t (*t)[72] = (bf16_t (*)[72])(smem + wid * 9216);
#pragma unroll
  for (int m = 0; m < 4; ++m)
#pragma unroll
    for (int n = 0; n < 4; ++n)
#pragma unroll
      for (int j = 0; j < 4; ++j) t[m * 16 + fq * 4 + j][n * 16 + fr] = f2bf(acc[m][n][j]);
  asm volatile("s_waitcnt lgkmcnt(0)" ::: "memory");
}

DEV void ph_copy(const P& p) {
  const size_t n8 = (size_t)NTOK * D / 8;
  const float* pctx = opq(p.ctx); const float* px = opq(p.x);
  for (size_t i = (size_t)bid_() * 256 + tid_(); i < n8; i += (size_t)gridDim.x * 256) {
    size_t e = i * 8;
    int row = (int)(e / D), col = (int)(e % D);
    int b = row / LT, pp = row % LT;
    const float* src = pp < LC ? pctx + ((size_t)(b * LC + pp)) * D + col : px + ((size_t)(b * T + pp - LC)) * D + col;
    float4 v0 = *(const float4*)src, v1 = *(const float4*)(src + 4);
    uint4 o = make_uint4(pack2(v0.x, v0.y), pack2(v0.z, v0.w), pack2(v1.x, v1.y), pack2(v1.z, v1.w));
    *(uint4*)(p.X + e) = o;
  }
}

DEV void ph_rope(const P& p) {
  for (int i = bid_() * 256 + tid_(); i < 64 * 16; i += gridDim.x * 256) {
    int pos = i >> 4, k = i & 15;
    float inv = powf(10000.f, -(float)k / 16.f);
    float ang = (float)pos * inv;
    p.rope[2 * i] = cosf(ang); p.rope[2 * i + 1] = sinf(ang);
  }
}

DEV void modv_unit(const P& p, int unit, char* smem) {
  const int cc = unit % 24, layer = unit / 24;
  float (*cs)[128] = (float (*)[128])smem;
  const int col = cc * 256 + tid_();
  const float* pc = opq(p.c); const float* pcc = opq(p.c_ctx);
  float acc[17];
#pragma unroll
  for (int r = 0; r < 17; ++r) acc[r] = 0.f;
  for (int ks = 0; ks < 8; ++ks) {
    __syncthreads();
    for (int i = tid_(); i < 17 * 128; i += 256) {
      int r = i >> 7, e = i & 127;
      float v = r < 16 ? pc[r * D + ks * 128 + e] : pcc[ks * 128 + e];
      cs[r][e] = v / (1.f + expf(-v));
    }
    __syncthreads();
    const float* w = p.mod_w + ((size_t)layer * D + ks * 128) * 6144 + col;
#pragma unroll 4
    for (int e = 0; e < 128; ++e) {
      float wv = w[(size_t)e * 6144];
#pragma unroll
      for (int r = 0; r < 17; ++r) acc[r] += cs[r][e] * wv;
    }
  }
  const float bias = p.mod_b[layer * 6144 + col];
#pragma unroll
  for (int r = 0; r < 17; ++r) p.modv[((size_t)layer * 17 + r) * 6144 + col] = acc[r] + bias;
}

DEV void transpose_unit(const float* __restrict__ src, bf16_t* __restrict__ dst, int R, int C, int tile, char* smem) {
  float (*t)[65] = (float (*)[65])smem;
  const int nct = C / 64;
  const int tr = tile / nct, tc = tile % nct;
  __syncthreads();
  for (int i = tid_(); i < 4096; i += 256) { int r = i >> 6, c = i & 63; t[r][c] = src[(size_t)(tr * 64 + r) * C + tc * 64 + c]; }
  __syncthreads();
  for (int i = tid_(); i < 4096; i += 256) { int c = i >> 6, r = i & 63; dst[(size_t)(tc * 64 + c) * R + tr * 64 + r] = f2bf(t[r][c]); }
}

DEV void wfold_unit(const P& p, int layer, int unit, char* smem) {
  const int hs = unit >> 5, ec = unit & 31, h = hs >> 1, s = hs & 1;
  const float* wq = p.peer_wq + (size_t)layer * D * 2048;
  const float* kk = (s ? opq(p.peer_k2) : opq(p.peer_k1)) + ((size_t)layer * 8 + h) * 128 * 128;
  float (*kS)[65] = (float (*)[65])smem;
  float (*wS)[64] = (float (*)[64])(smem + 33280);
  const int key = tid_() & 127, eh = tid_() >> 7;
  float acc[16];
#pragma unroll
  for (int i = 0; i < 16; ++i) acc[i] = 0.f;
  for (int dh = 0; dh < 2; ++dh) {
    __syncthreads();
    for (int i = tid_(); i < 128 * 64; i += 256) { int k2 = i >> 6, d = i & 63; kS[k2][d] = kk[k2 * 128 + dh * 64 + d]; }
    for (int i = tid_(); i < 32 * 64; i += 256) {
      int e = i >> 6, d = i & 63;
      wS[e][d] = wq[(size_t)(ec * 32 + e) * 2048 + h * 256 + s * 128 + dh * 64 + d];
    }
    __syncthreads();
#pragma unroll 2
    for (int d = 0; d < 64; ++d) {
      float kv = kS[key][d];
#pragma unroll
      for (int i = 0; i < 16; ++i) acc[i] += kv * wS[eh * 16 + i][d];
    }
  }
  bf16_t* dst = p.Wft + ((size_t)(hs * 128 + key)) * D + ec * 32 + eh * 16;
#pragma unroll
  for (int i = 0; i < 16; i += 2) *(unsigned*)(dst + i) = pack2(acc[i], acc[i + 1]);
}

DEV void filt_unit(const P& p, int layer, int unit, char* smem) {
  int kind, j0, L;
  if (unit < 1024) { kind = 0; j0 = unit * 4; L = T; } else { kind = 1; j0 = (unit - 1024) * 4; L = LC; }
  float* zs = (float*)smem;
  float* h1 = zs + 4 * 36;
  float* h2 = h1 + 256;
  const int jj = tid_() >> 6, o = tid_() & 63;
  const int j = j0 + jj;
  const float fj = (float)j;
  const float t = fj / (float)(L - 1);
  __syncthreads();
  if (o < 33) {
    float z;
    if (o == 0) z = t;
    else {
      int i = (o - 1) & 15;
      float band = 1e-4f + (float)i * ((15.0f - 1e-4f) / 15.0f);
      float ang = 6.283185307179586f * fj * band / (float)L;
      z = (o <= 16) ? cosf(ang) : -sinf(ang);
    }
    zs[jj * 36 + o] = z;
  }
  __syncthreads();
  {
    const float* w1 = p.hy_w1 + layer * 33 * 64;
    float a = p.hy_b1[layer * 64 + o];
#pragma unroll 3
    for (int i = 0; i < 33; ++i) a += zs[jj * 36 + i] * w1[i * 64 + o];
    h1[jj * 64 + o] = sinf(p.hy_freq[layer * 128 + o] * a);
  }
  __syncthreads();
  {
    const float* w2 = p.hy_w2 + layer * 64 * 64;
    float a = p.hy_b2[layer * 64 + o];
#pragma unroll 4
    for (int i = 0; i < 64; ++i) a += h1[jj * 64 + i] * w2[i * 64 + o];
    h2[jj * 64 + o] = sinf(p.hy_freq[layer * 128 + 64 + o] * a);
  }
  __syncthreads();
  const float* w3 = p.hy_w3 + layer * 64 * 512;
  float* F = kind ? opq(p.FC) : opq(p.FL);
  const float DMIN = -3.0701134573253945f, DMAX = -15.350567286626973f;
#pragma unroll 1
  for (int m = 0; m < 4; ++m) {
    int c = o + 64 * m;
    float af = p.hy_b3[layer * 512 + c], ab = p.hy_b3[layer * 512 + 256 + c];
#pragma unroll 4
    for (int i = 0; i < 64; ++i) { float hv = h2[jj * 64 + i]; af += hv * w3[i * 512 + c]; ab += hv * w3[i * 512 + 256 + c]; }
    float delta = fabsf(DMIN + (float)c * ((DMAX - DMIN) / 255.f));
    float win = expf(-t * delta) + 0.05f;
    af *= win; ab *= win;
    F[((size_t)c * 2 + 0) * L + j] = af;
    F[((size_t)c * 2 + 1) * L + j] = ab;
  }
}

constexpr int PREP_T0 = 672, PREP_T1 = PREP_T0 + 256, PREP_T2 = PREP_T1 + 8, PREP_T3 = PREP_T2 + 8, PREP_T4 = PREP_T3 + 8;
constexpr int PREP_WF = PREP_T4 + 512, PREP_N = PREP_WF + 1088;
DEV void ph_prep(const P& p, int layer, char* smem) {
  for (int u = bid_(); u < PREP_N; u += gridDim.x) {
    if (u < PREP_T0) transpose_unit(p.w_in + (size_t)layer * D * INW, p.W1t, D, INW, u, smem);
    else if (u < PREP_T1) transpose_unit(p.w_out + (size_t)layer * D * D, p.W2t, D, D, u - PREP_T0, smem);
    else if (u < PREP_T3) {
      const int u0 = u - PREP_T1;
      for (int i = tid_(); i < 64 * 256; i += 256) {
        const int np = u0 * 64 + (i >> 8), kp = i & 255;
        const int ps = np & 3, chan = np >> 2, qp = kp >> 6, kk = kp & 63;
        const int is_a = ps & 1, d = ps >> 1;
        float v = 0.f;
        if (qp == (is_a ? 2 + d : d)) v = (is_a ? opq(p.rw_a_up) : opq(p.rw_w_up))[(((size_t)layer * 2 + d) * 64 + kk) * 256 + chan];
        p.Wlt[(size_t)np * 256 + kp] = f2bf(v);
      }
    }
    else if (u < PREP_T4) transpose_unit(p.rw_g_up + (size_t)layer * 128 * 256, p.Wgt, 128, 256, u - PREP_T3, smem);
    else if (u < PREP_WF) wfold_unit(p, layer, u - PREP_T4, smem);
    else filt_unit(p, layer, u - PREP_WF, smem);
  }
}

DEV void wave_range(int& r0, int& r1, int ntok) {
  const int gw = (bid_() * 256 + tid_()) >> 6, nw = gridDim.x * 4;
  const int per = (ntok + nw - 1) / nw;
  r0 = gw * per; r1 = r0 + per; if (r1 > ntok) r1 = ntok;
}
DEV void ph_norm(const P& p, int layer, int which) {
  const int lane = tid_() & 63;
  int r0, r1;
  wave_range(r0, r1, NTOK);
  const float* g = (which ? p.norm2_g : p.norm1_g) + layer * D;
  float gv[16], scv[16], shv[16];
#pragma unroll
  for (int hh = 0; hh < 2; ++hh)
#pragma unroll
    for (int i = 0; i < 8; ++i) gv[hh * 8 + i] = g[hh * 512 + 8 * lane + i];
  int mr_cur = -1;
  uint4 n0 = make_uint4(0, 0, 0, 0), n1 = n0;
  if (r0 < r1) { const bf16_t* xr = p.X + (size_t)r0 * D; n0 = *(const uint4*)(xr + 8 * lane); n1 = *(const uint4*)(xr + 512 + 8 * lane); }
#pragma unroll 1
  for (int row = r0; row < r1; ++row) {
    const uint4 u0 = n0, u1 = n1;
    if (row + 1 < r1) { const bf16_t* xr = p.X + (size_t)(row + 1) * D; n0 = *(const uint4*)(xr + 8 * lane); n1 = *(const uint4*)(xr + 512 + 8 * lane); }
    const int b = row / LT, pp = row % LT;
    const int mr = pp < LC ? 16 : b;
    if (mr != mr_cur) {
      mr_cur = mr;
      const float* mv = p.modv + ((size_t)layer * 17 + mr) * 6144 + (which ? 3072 : 0);
#pragma unroll
      for (int hh = 0; hh < 2; ++hh)
#pragma unroll
        for (int i = 0; i < 8; ++i) { shv[hh * 8 + i] = mv[hh * 512 + 8 * lane + i]; scv[hh * 8 + i] = 1.f + mv[1024 + hh * 512 + 8 * lane + i]; }
    }
    float v[16];
    unpack8(u0, v); unpack8(u1, v + 8);
    float ss = 0.f;
#pragma unroll
    for (int i = 0; i < 16; ++i) ss += v[i] * v[i];
    ss = wave_sum(ss);
    const float rstd = rsqrtf(ss * (1.f / 1024.f) + 1e-6f);
    float o[16];
#pragma unroll
    for (int i = 0; i < 16; ++i) o[i] = (v[i] * rstd * gv[i]) * scv[i] + shv[i];
    bf16_t* hr = p.H + (size_t)row * D;
    *(uint4*)(hr + 8 * lane) = pack8(o);
    *(uint4*)(hr + 512 + 8 * lane) = pack8(o + 8);
  }
}

DEV bool gemm_unit(int it, int nct, int& rt, int& ct) {
  const int nslot = gridDim.x >> 3;
  const int x = bid_() & 7, sl = bid_() >> 3;
  if (sl >= nslot) return false;
  const int v = it * nslot + sl;
  if (v >= 68 * nct) return false;
  const int rg = v / (8 * nct), rem = v - rg * 8 * nct;
  const int rows = (rg == 8) ? 4 : 8;
  ct = rem / rows;
  rt = x * 68 + rg * 8 + (rem - ct * rows);
  return true;
}
struct Epi1 {
  const P& p; int row0, col0;
  DEV void operator()(f32x4 (&acc)[4][4], int wr, int wc, int fr, int fq, char* smem) const {
    const int cw = col0 + wc * 64;
    const int rbase = row0 + wr * 64;
    const bool lat = (row0 % LT) >= LC;
    if (cw >= 1536 && cw < 1664) {
#pragma unroll
      for (int m = 0; m < 4; ++m)
#pragma unroll
        for (int n = 0; n < 4; ++n)
#pragma unroll
          for (int j = 0; j < 4; ++j) acc[m][n][j] = tanhf(acc[m][n][j]);
    } else if (cw >= 1792 && cw < 1920) {
#pragma unroll
      for (int m = 0; m < 4; ++m)
#pragma unroll
        for (int n = 0; n < 4; ++n)
#pragma unroll
          for (int j = 0; j < 4; ++j) acc[m][n][j] = sigmoidf_(acc[m][n][j]);
    } else if (cw >= 1920 && cw < 2560 && lat) {
#pragma unroll
      for (int m = 0; m < 4; ++m)
#pragma unroll
        for (int j = 0; j < 4; ++j) {
          int row = rbase + m * 16 + fq * 4 + j;
          int pl = (row % LT) - LC;
          int ri = pl >> 6, ci = pl & 63;
          float2 cr = *(const float2*)(p.rope + 2 * (ri * 16 + fr));
          float2 cc = *(const float2*)(p.rope + 2 * (ci * 16 + fr));
          float x1 = acc[m][0][j], x2 = acc[m][1][j];
          acc[m][0][j] = x1 * cr.x - x2 * cr.y; acc[m][1][j] = x2 * cr.x + x1 * cr.y;
          x1 = acc[m][2][j]; x2 = acc[m][3][j];
          acc[m][2][j] = x1 * cc.x - x2 * cc.y; acc[m][3][j] = x2 * cc.x + x1 * cc.y;
        }
    }
    const int wid = wr * 2 + wc, lane = fq * 16 + fr;
    stage_tile_bf16(acc, smem, wid, fr, fq);
    const bf16_t (*t)[72] = (const bf16_t (*)[72])(smem + wid * 9216);
#pragma unroll
    for (int i = 0; i < 8; ++i) {
      const int rl = i * 8 + (lane >> 3), ch = lane & 7;
      *(uint4*)(p.Z + (size_t)(rbase + rl) * INW + cw + ch * 8) = *(const uint4*)&t[rl][ch * 8];
    }
  }
};
DEV void ph_gemm1(const P& p, char* smem) {
  const int nct = INW / 128;
  int rt, ct;
  for (int it = 0; gemm_unit(it, nct, rt, ct); ++it) {
    Epi1 epi{p, rt * 128, ct * 128};
    gemm_tile(p.H + (size_t)rt * 128 * D, D, p.W1t + (size_t)ct * 128 * D, D, D, smem, epi);
  }
}

struct EpiLoraA {
  const P& p; int layer, row0, col0;
  DEV void operator()(f32x4 (&acc)[4][4], int wr, int wc, int fr, int fq, char* smem) const {
    const int ps = fr & 3, is_a = ps & 1, dd = ps >> 1;
    const float scale = is_a ? 1.f : 0.6065306597126334f;
    const float* bias0 = (is_a ? opq(p.rw_a0) : opq(p.rw_w0)) + (layer * 2 + dd) * 256;
#pragma unroll
    for (int n = 0; n < 4; ++n) {
      const int chan = (col0 + wc * 64 + n * 16 + fr) >> 2;
      const float bias = bias0[chan];
#pragma unroll
      for (int m = 0; m < 4; ++m)
#pragma unroll
        for (int j = 0; j < 4; ++j) acc[m][n][j] = scale * sigmoidf_(acc[m][n][j] + bias);
    }
    const int wid = wr * 2 + wc, lane = fq * 16 + fr;
    stage_tile_bf16(acc, smem, wid, fr, fq);
    const bf16_t (*t)[72] = (const bf16_t (*)[72])(smem + wid * 9216);
#pragma unroll
    for (int i = 0; i < 8; ++i) {
      const int rl = i * 8 + (lane >> 3), ch = lane & 7;
      *(uint4*)(p.SC + (size_t)(row0 + wr * 64 + rl) * 1024 + col0 + wc * 64 + ch * 8) = *(const uint4*)&t[rl][ch * 8];
    }
  }
};
struct EpiLoraG {
  const P& p; int row0, col0;
  DEV void operator()(f32x4 (&acc)[4][4], int wr, int wc, int fr, int fq, char* smem) const {
    const int wid = wr * 2 + wc, lane = fq * 16 + fr;
    stage_tile_bf16(acc, smem, wid, fr, fq);
    const bf16_t (*t)[72] = (const bf16_t (*)[72])(smem + wid * 9216);
#pragma unroll
    for (int i = 0; i < 8; ++i) {
      const int rl = i * 8 + (lane >> 3), ch = lane & 7;
      *(uint4*)(p.Y + (size_t)(row0 + wr * 64 + rl) * D + 256 + col0 + wc * 64 + ch * 8) = *(const uint4*)&t[rl][ch * 8];
    }
  }
};
DEV void ph_lora(const P& p, int layer, char* smem) {
  int rt, ct;
  for (int it = 0; gemm_unit(it, 10, rt, ct); ++it) {
    if (ct < 8) {
      EpiLoraA epi{p, layer, rt * 128, ct * 128};
      gemm_tile(p.Z + (size_t)rt * 128 * INW + 1536, INW, p.Wlt + (size_t)ct * 128 * 256, 256, 256, smem, epi);
    } else {
      EpiLoraG epi{p, rt * 128, (ct - 8) * 128};
      gemm_tile(p.Z + (size_t)rt * 128 * INW + 1792, INW, p.Wgt + (size_t)(ct - 8) * 128 * 128, 128, 128, smem, epi);
    }
  }
}

DEV void ph_rwkv_prep(const P& p, int layer) {
  const int lane = tid_() & 63;
  int r0, r1;
  wave_range(r0, r1, NTOK);
  const float* cw = p.conv_w + (size_t)layer * 3 * 1536;
  const float* cb = p.conv_b + (size_t)layer * 1536;
  float w0[3][4], w1[3][4], w2[3][4], bb[3][4], kkw[4];
#pragma unroll
  for (int a = 0; a < 3; ++a)
#pragma unroll
    for (int i = 0; i < 4; ++i) {
      const int col = 768 + a * 256 + 4 * lane + i;
      w0[a][i] = cw[col]; w1[a][i] = cw[1536 + col]; w2[a][i] = cw[3072 + col]; bb[a][i] = cb[col];
    }
#pragma unroll
  for (int i = 0; i < 4; ++i) kkw[i] = p.rw_k_k[layer * 256 + 4 * lane + i];
  uint2 zm[3], zc[3], zp[3];
  auto ldz = [&](int row, uint2 (&z)[3]) {
#pragma unroll
    for (int a = 0; a < 3; ++a) z[a] = *(const uint2*)(p.Z + (size_t)row * INW + 768 + a * 256 + 4 * lane);
  };
  auto zero3 = [&](uint2 (&z)[3]) {
#pragma unroll
    for (int a = 0; a < 3; ++a) z[a] = make_uint2(0u, 0u);
  };
  if (r0 < r1) {
    if (r0 > 0) ldz(r0 - 1, zm); else zero3(zm);
    ldz(r0, zc);
  }
#pragma unroll 1
  for (int row = r0; row < r1; ++row) {
    if (row + 1 < NTOK) ldz(row + 1, zp); else zero3(zp);
    const int pp = row % LT;
    const bool hasm = (pp != 0) && (pp != LC);
    const bool hasp = (pp != LC - 1) && (pp != LT - 1);
    float res[3][4];
#pragma unroll
    for (int a = 0; a < 3; ++a) {
      const uint2 um = hasm ? zm[a] : make_uint2(0u, 0u), uc = zc[a], up = hasp ? zp[a] : make_uint2(0u, 0u);
      const float vm[4] = {bflo(um.x), bfhi(um.x), bflo(um.y), bfhi(um.y)};
      const float vc[4] = {bflo(uc.x), bfhi(uc.x), bflo(uc.y), bfhi(uc.y)};
      const float vp[4] = {bflo(up.x), bfhi(up.x), bflo(up.y), bfhi(up.y)};
#pragma unroll
      for (int i = 0; i < 4; ++i) res[a][i] = w0[a][i] * vm[i] + w1[a][i] * vc[i] + w2[a][i] * vp[i] + bb[a][i];
    }
    float kk[4], ss = 0.f;
#pragma unroll
    for (int i = 0; i < 4; ++i) { kk[i] = res[1][i] * kkw[i]; ss += kk[i] * kk[i]; }
    ss = row16_sum(ss);
    const float rs = rsqrtf(ss + 1e-12f);
    bf16_t* hr = p.H + (size_t)row * D + 16 * lane;
    *(uint4*)hr = make_uint4(pack2(res[0][0], res[1][0]), pack2(kk[0] * rs, res[2][0]), pack2(res[0][1], res[1][1]), pack2(kk[1] * rs, res[2][1]));
    *(uint4*)(hr + 8) = make_uint4(pack2(res[0][2], res[1][2]), pack2(kk[2] * rs, res[2][2]), pack2(res[0][3], res[1][3]), pack2(kk[3] * rs, res[2][3]));
#pragma unroll
    for (int a = 0; a < 3; ++a) { zm[a] = zc[a]; zc[a] = zp[a]; }
  }
}

DEV float oct_sum(float x) { x += dpp0<0xB1, 0xF>(x); x += dpp0<0x4E, 0xF>(x); x += dpp0<0x141, 0xF>(x); return x; }
DEV bf16x8 frag_join(uint2 lo, uint2 hi) { uint4 w = make_uint4(lo.x, lo.y, hi.x, hi.y); return __builtin_bit_cast(bf16x8, w); }
constexpr int SCS_SET = 16640, SCS_IMG = 3 * SCS_SET, SCS_W0 = SCS_IMG + 2 * 3072;
DEV void scanc_unit(const P& p, int layer, int unit, char* smem) {
  const int dir = unit & 1, h = (unit >> 1) & 3, b = unit >> 3;
  const int tid = tid_(), lane = tid & 63, fr = lane & 15, fq = lane >> 4;
  const int w = __builtin_amdgcn_readfirstlane(tid >> 6);
  bf16_t* IMG0 = (bf16_t*)(smem + SCS_W0);
  bf16_t* IMG1 = IMG0 + 512;
  bf16_t* IMG2 = IMG0 + 1024;
  __syncthreads();
  for (int i = tid; i < (2 * 3072 + 3072) / 4; i += 256) ((unsigned*)(smem + SCS_IMG))[i] = 0u;
  const float ka = p.rw_k_a[layer * 256 + h * 64 + lane];
  const size_t rowbase = (size_t)b * LT;
  const char* hbase = (const char*)p.H;
  const char* sbase = (const char*)p.SC;
  const unsigned hoff = (unsigned)(rowbase * 2048) + (unsigned)((h * 64 + lane) * 8);
  const unsigned soff = hoff + 4u * (unsigned)dir;
  bf16_t* yb = p.Z + rowbase * INW + 768 + dir * 256 + h * 64 + w * 16 + fr;
  auto pos0 = [&](int c) -> int { const int t = c * 16; return dir == 0 ? t : (t < LC ? LC - 1 - t : LT - 1 - (t - LC)); };
  const int pstep = dir == 0 ? 1 : -1;
  constexpr int NCH = LT / 16;
  struct Raw { unsigned sc[16]; uint2 hr[6]; };
  auto load_raw = [&](int c, Raw& rw) {
    if (w != 0) {
      const int p0 = pos0(c);
      const unsigned so = soff + (unsigned)(p0 * 2048);
      const int st = pstep * 2048;
#pragma unroll
      for (int i = 0; i < 16; ++i) rw.sc[i] = *(const unsigned*)(sbase + (so + (unsigned)(i * st)));
      const unsigned ho = hoff + (unsigned)((p0 + pstep * (w - 1)) * 2048);
#pragma unroll
      for (int q = 0; q < 6; ++q) {
        const int qq = ((w - 1) + 3 * q < 16) ? q : 4;
        rw.hr[q] = *(const uint2*)(hbase + (ho + (unsigned)(qq * 3 * st)));
      }
    }
  };
  auto stage1w = [&](int set, const Raw& rw, auto W1tag) {
    constexpr int W1 = decltype(W1tag)::value;
    char* base = smem + set * SCS_SET;
    bf16_t (*At)[72] = (bf16_t (*)[72])(base);
    bf16_t (*Rt)[72] = (bf16_t (*)[72])(base + 2304);
    bf16_t (*Bt)[72] = (bf16_t (*)[72])(base + 4608);
    bf16_t (*Kt)[72] = (bf16_t (*)[72])(base + 6912);
    bf16_t (*BKT)[40] = (bf16_t (*)[40])(base + 9216);
    bf16_t (*VV)[16] = (bf16_t (*)[16])(base + 14336);
    float* G16 = (float*)(base + 16384);
    float Erun = 0.f;
#pragma unroll
    for (int i = 0; i < 16; ++i) {
      const float ev = bflo(rw.sc[i]);
      const float Eprev = Erun;
      Erun += ev;
      if ((i % 3) == W1) {
        const uint2 hrec = rw.hr[i / 3];
        const float rr = bflo(hrec.x), kr = bfhi(hrec.x), kkv = bflo(hrec.y);
        const float av = bfhi(rw.sc[i]);
        const float gp = __expf(-Eprev), gi = __expf(-Erun), ig = __expf(Erun);
        const float at = -kkv * gp, rt = rr * gi, bt = kkv * av * ig, kt2 = kr * (1.f + (av - 1.f) * ka) * ig;
        const unsigned ar = pack2(at, rt), bk = pack2(bt, kt2);
        At[i][lane] = (bf16_t)(ar & 0xFFFFu); Rt[i][lane] = (bf16_t)(ar >> 16);
        Bt[i][lane] = (bf16_t)(bk & 0xFFFFu); Kt[i][lane] = (bf16_t)(bk >> 16);
        BKT[lane][(i >> 2) * 8 + (i & 3)] = (bf16_t)(bk & 0xFFFFu);
        BKT[lane][(i >> 2) * 8 + 4 + (i & 3)] = (bf16_t)(bk >> 16);
        VV[lane][(i >> 2) * 4 + (i & 3)] = (bf16_t)(hrec.y >> 16);
        if (i == 15) G16[lane] = gi;
      }
    }
  };
  auto stage1 = [&](int set, const Raw& rw) {
    if (w == 1) stage1w(set, rw, std::integral_constant<int, 0>{});
    else if (w == 2) stage1w(set, rw, std::integral_constant<int, 1>{});
    else if (w == 3) stage1w(set, rw, std::integral_constant<int, 2>{});
  };
  auto stage2 = [&](int set, int iset) {
    char* base = smem + set * SCS_SET;
    const bf16_t (*At)[72] = (const bf16_t (*)[72])(base);
    const bf16_t (*Rt)[72] = (const bf16_t (*)[72])(base + 2304);
    const bf16_t (*Bt)[72] = (const bf16_t (*)[72])(base + 4608);
    const bf16_t (*Kt)[72] = (const bf16_t (*)[72])(base + 6912);
    bf16_t* TT = (bf16_t*)(smem + SCS_IMG + iset * 3072);
    bf16_t* ARK = TT + 512;
    bf16_t* AAK = TT + 1024;
    const bf16_t (*X)[72] = (w < 2) ? At : Rt;
    const bf16_t (*Y)[72] = (w & 1) ? Kt : Bt;
    f32x4 cm = (f32x4){0.f, 0.f, 0.f, 0.f};
#pragma unroll
    for (int s = 0; s < 2; ++s) {
      bf16x8 af = *(const bf16x8*)&X[fr][32 * s + 8 * fq];
      bf16x8 bm = *(const bf16x8*)&Y[fr][32 * s + 8 * fq];
      cm = mfma16(af, bm, cm);
    }
#pragma unroll
    for (int jj = 0; jj < 4; ++jj) {
      const int i = 4 * fq + jj;
      const bool keep = (w < 2) ? (fr < i) : (fr <= i);
      cm[jj] = keep ? cm[jj] : 0.f;
    }
    const int io = (fr >> 2) * 8 + (fr & 3);
    auto wr_img = [&](bf16_t* img, const f32x4& Xv, int hi) {
#pragma unroll
      for (int jj = 0; jj < 4; ++jj) img[(4 * fq + jj) * 32 + io + hi] = f2bf(Xv[jj]);
    };
    if (w == 1) wr_img(AAK, cm, 0);
    else if (w == 2) wr_img(ARK, cm, 0);
    else if (w == 3) wr_img(ARK, cm, 4);
    else {
      auto bfrag = [&](const f32x4& Xv) { return frag_join(make_uint2(pack2(Xv[0], Xv[1]), pack2(Xv[2], Xv[3])), make_uint2(0u, 0u)); };
      auto afr = [&](const bf16_t* img) { return *(const bf16x8*)&img[(fr * 4 + fq) * 8]; };
      const f32x4 Z4 = (f32x4){0.f, 0.f, 0.f, 0.f};
      wr_img(IMG0, cm, 0);
      asm volatile("" ::: "memory");
      f32x4 A2 = mfma16(afr(IMG0), bfrag(cm), Z4);
      wr_img(IMG1, A2, 0);
      asm volatile("" ::: "memory");
      f32x4 A4 = mfma16(afr(IMG1), bfrag(A2), Z4);
      wr_img(IMG2, A4, 0);
      asm volatile("" ::: "memory");
      f32x4 Rm = mfma16(afr(IMG2), bfrag(A4), Z4);
#pragma unroll
      for (int jj = 0; jj < 4; ++jj) Rm[jj] += (fr == 4 * fq + jj) ? 1.f : 0.f;
      Rm = mfma16(afr(IMG2), bfrag(Rm), Rm);
      Rm = mfma16(afr(IMG1), bfrag(Rm), Rm);
      Rm = mfma16(afr(IMG0), bfrag(Rm), Rm);
      wr_img(TT, Rm, 0);
    }
  };
  f32x4 acc[4];
#pragma unroll
  for (int kt = 0; kt < 4; ++kt) acc[kt] = (f32x4){0.f, 0.f, 0.f, 0.f};
  auto part2 = [&](int c, int set, int iset) {
    char* base = smem + set * SCS_SET;
    const bf16_t (*At)[72] = (const bf16_t (*)[72])(base);
    const bf16_t (*Rt)[72] = (const bf16_t (*)[72])(base + 2304);
    const bf16_t (*BKT)[40] = (const bf16_t (*)[40])(base + 9216);
    const bf16_t (*VV)[16] = (const bf16_t (*)[16])(base + 14336);
    const float* G16 = (const float*)(base + 16384);
    const bf16_t* TT = (const bf16_t*)(smem + SCS_IMG + iset * 3072);
    const bf16_t* ARK = TT + 512;
    const bf16_t* AAK = TT + 1024;
    bf16x8 Sb[2];
#pragma unroll
    for (int s = 0; s < 2; ++s) {
      uint4 t = make_uint4(pack2(acc[2 * s][0], acc[2 * s][1]), pack2(acc[2 * s][2], acc[2 * s][3]),
                           pack2(acc[2 * s + 1][0], acc[2 * s + 1][1]), pack2(acc[2 * s + 1][2], acc[2 * s + 1][3]));
      Sb[s] = __builtin_bit_cast(bf16x8, t);
    }
    const uint2 vv = *(const uint2*)&VV[w * 16 + fr][fq * 4];
    const bf16x8 Vlow = frag_join(vv, make_uint2(0u, 0u));
    f32x4 Pm = (f32x4){0.f, 0.f, 0.f, 0.f};
#pragma unroll
    for (int s = 0; s < 2; ++s) {
      bf16x8 af = frag_join(*(const uint2*)&At[fr][32 * s + 4 * fq], *(const uint2*)&At[fr][32 * s + 16 + 4 * fq]);
      Pm = mfma16(af, Sb[s], Pm);
    }
    Pm = mfma16(*(const bf16x8*)&AAK[(fr * 4 + fq) * 8], Vlow, Pm);
    const bf16x8 Pb = frag_join(make_uint2(pack2(Pm[0], Pm[1]), pack2(Pm[2], Pm[3])), make_uint2(0u, 0u));
    f32x4 U = mfma16(*(const bf16x8*)&TT[(fr * 4 + fq) * 8], Pb, (f32x4){0.f, 0.f, 0.f, 0.f});
    const bf16x8 UV = frag_join(make_uint2(pack2(U[0], U[1]), pack2(U[2], U[3])), vv);
    f32x4 Yv = (f32x4){0.f, 0.f, 0.f, 0.f};
#pragma unroll
    for (int s = 0; s < 2; ++s) {
      bf16x8 af = frag_join(*(const uint2*)&Rt[fr][32 * s + 4 * fq], *(const uint2*)&Rt[fr][32 * s + 16 + 4 * fq]);
      Yv = mfma16(af, Sb[s], Yv);
    }
    Yv = mfma16(*(const bf16x8*)&ARK[(fr * 4 + fq) * 8], UV, Yv);
    {
      const int p0 = pos0(c);
#pragma unroll
      for (int jj = 0; jj < 4; ++jj) yb[(size_t)(p0 + pstep * (4 * fq + jj)) * INW] = f2bf(Yv[jj]);
    }
#pragma unroll
    for (int kt = 0; kt < 4; ++kt) {
      f32x4 t = mfma16(*(const bf16x8*)&BKT[16 * kt + fr][fq * 8], UV, acc[kt]);
      const float4 g4 = *(const float4*)&G16[16 * kt + 4 * fq];
      t[0] *= g4.x; t[1] *= g4.y; t[2] *= g4.z; t[3] *= g4.w;
      acc[kt] = t;
    }
  };
  __builtin_amdgcn_s_setprio(3);
  Raw r0, r1;
  load_raw(0, r0); load_raw(1, r1);
  stage1(0, r0);
  load_raw(2, r0);
  __syncthreads();
  stage2(0, 0);
  stage1(1, r1);
  load_raw(3, r1);
  __syncthreads();
  int s0 = 0, s1 = 1, s2 = 2;
  auto iter = [&](int c, Raw& rw) {
    if (c + 1 < NCH) stage2(s1, (c + 1) & 1);
    part2(c, s0, c & 1);
    if (c + 2 < NCH) {
      stage1(s2, rw);
      if (c + 4 < NCH) load_raw(c + 4, rw);
    }
    asm volatile("s_waitcnt lgkmcnt(0)" ::: "memory");
    __builtin_amdgcn_s_barrier();
    asm volatile("" ::: "memory");
    const int t = s0; s0 = s1; s1 = s2; s2 = t;
  };
#pragma unroll 1
  for (int c = 0; c < NCH; c += 2) {
    iter(c, r0); iter(c + 1, r1);
  }
  __builtin_amdgcn_s_setprio(0);
}

DEV void ph_rwkv_post(const P& p, int layer) {
  const int lane = tid_() & 63;
  int r0, r1;
  wave_range(r0, r1, NTOK);
  const int ch = 4 * lane;
  float kav[4], rkv[4], lnw[4], lnb[4];
#pragma unroll
  for (int i = 0; i < 4; ++i) {
    kav[i] = p.rw_k_a[layer * 256 + ch + i]; rkv[i] = p.rw_r_k[layer * 256 + ch + i];
    lnw[i] = p.rw_ln_w[layer * 256 + ch + i]; lnb[i] = p.rw_ln_b[layer * 256 + ch + i];
  }
  struct In { uint2 y0, y1, g; uint4 h0, h1, s0, s1; };
  auto ld = [&](int row, In& in) {
    const bf16_t* zr = p.Z + (size_t)row * INW + 768 + ch;
    in.y0 = *(const uint2*)zr; in.y1 = *(const uint2*)(zr + 256);
    const bf16_t* hr = p.H + (size_t)row * D + 4 * ch;
    in.h0 = *(const uint4*)hr; in.h1 = *(const uint4*)(hr + 8);
    const bf16_t* sr = p.SC + (size_t)row * 1024 + 4 * ch;
    in.s0 = *(const uint4*)sr; in.s1 = *(const uint4*)(sr + 8);
    in.g = *(const uint2*)(p.Y + (size_t)row * D + 256 + ch);
  };
  In nx;
  if (r0 < r1) ld(r0, nx);
#pragma unroll 1
  for (int row = r0; row < r1; ++row) {
    const In in = nx;
    if (row + 1 < r1) ld(row + 1, nx);
    float y[4] = {bflo(in.y0.x) + bflo(in.y1.x), bfhi(in.y0.x) + bfhi(in.y1.x), bflo(in.y0.y) + bflo(in.y1.y), bfhi(in.y0.y) + bfhi(in.y1.y)};
    const float mu = row16_sum(y[0] + y[1] + y[2] + y[3]) * (1.f / 64.f);
    float vs = 0.f;
#pragma unroll
    for (int i = 0; i < 4; ++i) { y[i] -= mu; vs += y[i] * y[i]; }
    const float var = row16_sum(vs) * (1.f / 64.f);
    const float rstd = rsqrtf(var + 64e-5f);
    const float r[4] = {bflo(in.h0.x), bflo(in.h0.z), bflo(in.h1.x), bflo(in.h1.z)};
    const float k[4] = {bfhi(in.h0.x), bfhi(in.h0.z), bfhi(in.h1.x), bfhi(in.h1.z)};
    const float v[4] = {bfhi(in.h0.y), bfhi(in.h0.w), bfhi(in.h1.y), bfhi(in.h1.w)};
    const float a0[4] = {bfhi(in.s0.x), bfhi(in.s0.z), bfhi(in.s1.x), bfhi(in.s1.z)};
    const float a1[4] = {bfhi(in.s0.y), bfhi(in.s0.w), bfhi(in.s1.y), bfhi(in.s1.w)};
    float sd = 0.f;
#pragma unroll
    for (int i = 0; i < 4; ++i) {
      const float kd0 = k[i] * (1.f + (a0[i] - 1.f) * kav[i]), kd1 = k[i] * (1.f + (a1[i] - 1.f) * kav[i]);
      sd += r[i] * (kd0 + kd1) * rkv[i];
    }
    sd = row16_sum(sd);
    const float g[4] = {bflo(in.g.x), bfhi(in.g.x), bflo(in.g.y), bfhi(in.g.y)};
    float o[4];
#pragma unroll
    for (int i = 0; i < 4; ++i) {
      const float yn = y[i] * rstd * lnw[i] + lnb[i];
      o[i] = (yn + sd * v[i]) * g[i];
#if !EN_RW
      o[i] = 0.f;
#endif
    }
    *(uint2*)(p.Y + (size_t)row * D + 256 + ch) = make_uint2(pack2(o[0], o[1]), pack2(o[2], o[3]));
  }
}

DEV void hyena_pre_unit(const P& p, int layer, int unit) {
  int kind, b, t0, L;
  if (unit < 1024) { kind = 0; b = unit >> 6; t0 = (unit & 63) * 64; L = T; } else { int u = unit - 1024; kind = 1; b = u >> 2; t0 = (u & 3) * 64; L = LC; }
  const int c = tid_();
  const size_t row0 = (size_t)b * LT + (kind ? 0 : LC);
  const float* cw = p.conv_w + (size_t)layer * 3 * 1536;
  const float* cb = p.conv_b + (size_t)layer * 1536;
  const float w1a = cw[256 + c], w1b = cw[1536 + 256 + c], w1c = cw[3072 + 256 + c], b1 = cb[256 + c];
  const float w2a = cw[512 + c], w2b = cw[1536 + 512 + c], w2c = cw[3072 + 512 + c], b2 = cb[512 + c];
  auto ld = [&](int t, int col) -> float { return (t >= 0 && t < L) ? bf2f(p.Z[(row0 + t) * INW + col]) : 0.f; };
  float x1m = ld(t0 - 1, 256 + c), x1c = ld(t0, 256 + c), vm = ld(t0 - 1, 512 + c), vc = ld(t0, 512 + c);
  bf16_t* dst = (kind ? opq(p.UTc) : opq(p.UTl)) + ((size_t)c * 16 + b) * L + t0;
#pragma unroll 1
  for (int i8 = 0; i8 < 8; ++i8) {
    float uo[8];
#pragma unroll
    for (int i = 0; i < 8; ++i) {
      int t = t0 + i8 * 8 + i;
      float x1n = ld(t + 1, 256 + c), vn = ld(t + 1, 512 + c);
      float a = w1a * x1m + w1b * x1c + w1c * x1n + b1;
      float bb = w2a * vm + w2b * vc + w2c * vn + b2;
      uo[i] = a * bb;
      x1m = x1c; x1c = x1n; vm = vc; vc = vn;
    }
    *(uint4*)(dst + 8 * i8) = pack8(uo);
  }
}

DEV void hyena_conv_unit(const P& p, int layer, int unit, char* smem) {
  int kind, c, tb, L;
  if (unit < 4096) { kind = 0; c = unit >> 4; tb = (unit & 15) * 256; L = T; } else { kind = 1; c = unit - 4096; tb = 0; L = LC; }
  const int tid = tid_(), lane = tid & 63, wid = tid >> 6, fr = lane & 15, fq = lane >> 4;
  float* red = (float*)(smem + 2 * 16512);
  const float* F = (kind ? opq(p.FC) : opq(p.FL)) + (size_t)c * 2 * L;
  float scale;
  {
    float part = 0.f;
    for (int i = tid; i < 2 * L; i += 256) { float fv = F[i]; part += (i != L) ? fv * fv : 0.f; }
    part = wave_sum(part);
    __syncthreads();
    if (lane == 0) red[wid] = part;
    __syncthreads();
    scale = rsqrtf(((red[0] + red[1]) + (red[2] + red[3])) + 1e-6f);
  }
  const bf16_t* U = (kind ? opq(p.UTc) : opq(p.UTl)) + (size_t)c * 16 * L;
  f32x4 acc[4];
#pragma unroll
  for (int m = 0; m < 4; ++m) acc[m] = (f32x4){0.f, 0.f, 0.f, 0.f};
  const int nch = L / 256;
  float fw0, fw1, fw2;
  uint4 ru0, ru1;
  auto ldchunk = [&](int ch) {
    const int sc = ch * 256;
    const int D0 = tb + 256 - sc;
    auto tap = [&](int n) -> float {
      int d = D0 - n;
      float v = 0.f;
      if (d > -L && d < L) v = (d >= 0 ? F[d] : F[L - d]);
      return v;
    };
    fw0 = tap(tid); fw1 = tap(tid + 256); fw2 = (tid < 8) ? tap(tid + 512) : 0.f;
    const int bb = tid >> 4, sg0 = tid & 15;
    ru0 = *(const uint4*)(U + (size_t)bb * L + sc + 8 * sg0);
    ru1 = *(const uint4*)(U + (size_t)bb * L + sc + 8 * (sg0 + 16));
  };
  auto stchunk = [&](int buf) {
    bf16_t* Cq = (bf16_t*)(smem + buf * 16512);
    bf16_t* Us = (bf16_t*)(smem + buf * 16512 + 8320);
    const bf16_t h0 = f2bf(fw0 * scale), h1 = f2bf(fw1 * scale), h2 = f2bf(fw2 * scale);
#pragma unroll
    for (int rho = 0; rho < 8; ++rho) {
      int m = tid + rho;
      Cq[((m >> 3) * 8 + rho) * 8 + (m & 7)] = h0;
      m = tid + 256 + rho;
      if (m < 520) Cq[((m >> 3) * 8 + rho) * 8 + (m & 7)] = h1;
      m = tid + 512 + rho;
      if (tid < 8 && m < 520) Cq[((m >> 3) * 8 + rho) * 8 + (m & 7)] = h2;
    }
    if (tid < 8) {
#pragma unroll
      for (int rho = 1; rho < 8; ++rho) if (tid < rho) Cq[(rho) * 8 + tid] = 0;
    }
    const int bb = tid >> 4, sg0 = tid & 15;
    *(uint4*)&Us[(sg0 * 16 + bb) * 8] = ru0;
    *(uint4*)&Us[((sg0 + 16) * 16 + bb) * 8] = ru1;
  };
  ldchunk(0);
#pragma unroll 1
  for (int ch = 0; ch < nch; ++ch) {
    const int buf = ch & 1;
    stchunk(buf);
    __syncthreads();
    if (ch + 1 < nch) ldchunk(ch + 1);
    const bf16_t* Cq = (const bf16_t*)(smem + buf * 16512);
    const bf16_t* Us = (const bf16_t*)(smem + buf * 16512 + 8320);
#pragma unroll
    for (int kk = 0; kk < 8; ++kk) {
      bf16x8 bf = *(const bf16x8*)&Us[((4 * kk + fq) * 16 + fr) * 8];
#pragma unroll
      for (int m = 0; m < 4; ++m) {
        int it = wid * 4 + m;
        int base = 256 - 16 * it + 32 * kk + 8 * fq;
        int m0 = base - 8 * (fr >> 3);
        bf16x8 af = *(const bf16x8*)&Cq[((m0 >> 3) * 8 + (fr & 7)) * 8];
        acc[m] = mfma16(af, bf, acc[m]);
      }
    }
  }
  __syncthreads();
  bf16_t* Yt = (kind ? opq(p.YTc) : opq(p.YTl)) + ((size_t)c * 16 + fr) * L + tb;
#pragma unroll
  for (int m = 0; m < 4; ++m) {
    int t = (wid * 4 + m) * 16 + fq * 4;
    *(uint2*)(Yt + t) = make_uint2(pack2(acc[m][0], acc[m][1]), pack2(acc[m][2], acc[m][3]));
  }
}

DEV void hyena_post_unit(const P& p, int layer, int unit, char* smem) {
  int kind, b, t0, L;
  if (unit < 1024) { kind = 0; b = unit >> 6; t0 = (unit & 63) * 64; L = T; } else { int u = unit - 1024; kind = 1; b = u >> 2; t0 = (u & 3) * 64; L = LC; }
  const int c = tid_(), lane = c & 63, wid = c >> 6;
  const size_t row0 = (size_t)b * LT + (kind ? 0 : LC);
  bf16_t (*tile)[264] = (bf16_t (*)[264])smem;
  const float* cw = p.conv_w + (size_t)layer * 3 * 1536;
  const float wa = cw[c], wb = cw[1536 + c], wcc = cw[3072 + c], b0 = p.conv_b[layer * 1536 + c];
  const float bias = p.hy_bias[layer * 256 + c];
  const bf16_t* yt = (kind ? opq(p.YTc) : opq(p.YTl)) + ((size_t)c * 16 + b) * L + t0;
  const bf16_t* ut = (kind ? opq(p.UTc) : opq(p.UTl)) + ((size_t)c * 16 + b) * L + t0;
  auto ld = [&](int t) -> float { return (t >= 0 && t < L) ? bf2f(p.Z[(row0 + t) * INW + c]) : 0.f; };
  float xm = ld(t0 - 1), xc = ld(t0);
  __syncthreads();
#pragma unroll 1
  for (int i8 = 0; i8 < 8; ++i8) {
    uint4 yu = *(const uint4*)(yt + 8 * i8), uu = *(const uint4*)(ut + 8 * i8);
    float yv[8], uv[8];
    unpack8(yu, yv); unpack8(uu, uv);
#pragma unroll
    for (int i = 0; i < 8; ++i) {
      int t = t0 + i8 * 8 + i;
      float xn = ld(t + 1);
      float x0 = wa * xm + wb * xc + wcc * xn + b0;
      float o = x0 * (yv[i] + uv[i] * bias);
      tile[i8 * 8 + i][c] = f2bf(o);
      xm = xc; xc = xn;
    }
  }
  __syncthreads();
  for (int i = 0; i < 16; ++i) {
    int tl = wid * 16 + i;
    uint2 ou = *(const uint2*)&tile[tl][4 * lane];
    float o[4] = {bflo(ou.x), bfhi(ou.x), bflo(ou.y), bfhi(ou.y)};
    float ss = wave_sum(o[0] * o[0] + o[1] * o[1] + o[2] * o[2] + o[3] * o[3]);
    float rstd = rsqrtf(ss * (1.f / 256.f) + 1e-6f);
#pragma unroll
    for (int q = 0; q < 4; ++q) {
      o[q] = o[q] * rstd * p.hy_out_g[layer * 256 + 4 * lane + q];
#if !EN_HY
      o[q] = 0.f;
#endif
    }
    *(uint2*)(p.Y + (row0 + t0 + tl) * D + 4 * lane) = make_uint2(pack2(o[0], o[1]), pack2(o[2], o[3]));
  }
}

DEV void attn_unit(const P& p, int layer, int unit, char* smem) {
  const bool isctx = unit >= 4096;
  int b, qb, hq;
  if (!isctx) { b = unit >> 8; qb = (unit >> 3) & 31; hq = unit & 7; } else { int u = unit - 4096; b = u >> 4; qb = (u >> 3) & 1; hq = u & 7; }
  const int g = hq >> 2;
  const int tid = tid_(), lane = tid & 63, wid = tid >> 6, qn = lane & 31, hh = lane >> 5;
  const int qpos = qb * 128 + wid * 32 + qn;
  const size_t qrow = (size_t)b * LT + (isctx ? qpos : LC + qpos);
  const bf16_t* qptr = p.Z + qrow * INW + 1920 + hq * 64;
  bf16x8 qf[4];
#pragma unroll
  for (int s = 0; s < 4; ++s) qf[s] = *(const bf16x8*)(qptr + 16 * s + 8 * hh);
  const float sink = p.attn_sink[layer * 8 + hq];
  float m_run = sink, l_run = 1.f;
  f32x16 o0, o1;
#pragma unroll
  for (int i = 0; i < 16; ++i) { o0[i] = 0.f; o1[i] = 0.f; }
  typedef bf16_t KTile[64][72];
  KTile* Ks = (KTile*)smem;
  KTile* Vt = (KTile*)(smem + 18432);
  const int ntl = isctx ? 0 : 6;
  const int ntiles = ntl + 4;
  const int skey = tid >> 3, sseg = tid & 7;
  const bf16_t* kvbase = p.Z + (size_t)b * LT * INW + 1920 + 512 + g * 64 + sseg * 8;
  uint4 rk0, rk1, rv0, rv1;
  auto ldtile = [&](int kt) {
    const bool ctxk = kt >= ntl;
    const int kbase = ctxk ? (kt - ntl) * 64 : qb * 128 - 128 + kt * 64;
    const int kp0 = kbase + skey, kp1 = kp0 + 32;
    rk0 = rk1 = rv0 = rv1 = make_uint4(0, 0, 0, 0);
    if (ctxk || (kp0 >= 0 && kp0 < T)) { const bf16_t* src = kvbase + (size_t)(ctxk ? kp0 : LC + kp0) * INW; rk0 = *(const uint4*)src; rv0 = *(const uint4*)(src + 128); }
    if (ctxk || (kp1 >= 0 && kp1 < T)) { const bf16_t* src = kvbase + (size_t)(ctxk ? kp1 : LC + kp1) * INW; rk1 = *(const uint4*)src; rv1 = *(const uint4*)(src + 128); }
  };
  auto sttile = [&](int buf) {
    *(uint4*)&Ks[buf][skey][sseg * 8] = rk0;
    *(uint4*)&Ks[buf][skey + 32][sseg * 8] = rk1;
    bf16_t (*vt)[72] = Vt[buf];
    vt[sseg * 8 + 0][skey] = (bf16_t)(rv0.x & 0xFFFF); vt[sseg * 8 + 1][skey] = (bf16_t)(rv0.x >> 16);
    vt[sseg * 8 + 2][skey] = (bf16_t)(rv0.y & 0xFFFF); vt[sseg * 8 + 3][skey] = (bf16_t)(rv0.y >> 16);
    vt[sseg * 8 + 4][skey] = (bf16_t)(rv0.z & 0xFFFF); vt[sseg * 8 + 5][skey] = (bf16_t)(rv0.z >> 16);
    vt[sseg * 8 + 6][skey] = (bf16_t)(rv0.w & 0xFFFF); vt[sseg * 8 + 7][skey] = (bf16_t)(rv0.w >> 16);
    vt[sseg * 8 + 0][skey + 32] = (bf16_t)(rv1.x & 0xFFFF); vt[sseg * 8 + 1][skey + 32] = (bf16_t)(rv1.x >> 16);
    vt[sseg * 8 + 2][skey + 32] = (bf16_t)(rv1.y & 0xFFFF); vt[sseg * 8 + 3][skey + 32] = (bf16_t)(rv1.y >> 16);
    vt[sseg * 8 + 4][skey + 32] = (bf16_t)(rv1.z & 0xFFFF); vt[sseg * 8 + 5][skey + 32] = (bf16_t)(rv1.z >> 16);
    vt[sseg * 8 + 6][skey + 32] = (bf16_t)(rv1.w & 0xFFFF); vt[sseg * 8 + 7][skey + 32] = (bf16_t)(rv1.w >> 16);
  };
  ldtile(0);
#pragma unroll 1
  for (int kt = 0; kt < ntiles; ++kt) {
    const int buf = kt & 1;
    sttile(buf);
    __syncthreads();
    if (kt + 1 < ntiles) ldtile(kt + 1);
    const bool ctxk = kt >= ntl;
    const int kbase = ctxk ? (kt - ntl) * 64 : qb * 128 - 128 + kt * 64;
#pragma unroll
    for (int sub = 0; sub < 2; ++sub) {
      const int kb2 = kbase + sub * 32;
      bool need = true;
      if (!ctxk) {
        int q0 = qb * 128 + wid * 32;
        if (kb2 + 31 < q0 - 128 || kb2 > q0 + 31 + 128 || kb2 + 31 < 0 || kb2 >= T) need = false;
      }
      if (need) {
        f32x16 sv;
#pragma unroll
        for (int i = 0; i < 16; ++i) sv[i] = 0.f;
#pragma unroll
        for (int ks = 0; ks < 4; ++ks) {
          bf16x8 kf = *(const bf16x8*)&Ks[buf][sub * 32 + qn][16 * ks + 8 * hh];
          sv = mfma32(kf, qf[ks], sv);
        }
        float mt = -3e38f;
#pragma unroll
        for (int rg = 0; rg < 16; ++rg) {
          float v = sv[rg] * 0.125f;
          if (!ctxk) {
            int kp = kb2 + (rg & 3) + 8 * (rg >> 2) + 4 * hh;
            int dl = qpos - kp;
            bool ok = (dl <= 128) && (dl >= -128) && (kp >= 0) && (kp < T);
            v = ok ? v : -1e30f;
          }
          sv[rg] = v;
          mt = fmaxf(mt, v);
        }
        mt = fmaxf(mt, __shfl_xor(mt, 32));
        float m_new = fmaxf(m_run, mt);
        float corr = __expf(m_run - m_new);
        float ps = 0.f;
#pragma unroll
        for (int rg = 0; rg < 16; ++rg) { float pv = __expf(sv[rg] - m_new); sv[rg] = pv; ps += pv; }
        ps += __shfl_xor(ps, 32);
        l_run = l_run * corr + ps;
        m_run = m_new;
#pragma unroll
        for (int i = 0; i < 16; ++i) { o0[i] *= corr; o1[i] *= corr; }
#pragma unroll
        for (int sp = 0; sp < 2; ++sp) {
          bf16x8 pf;
#pragma unroll
          for (int j = 0; j < 8; ++j) pf[j] = (short)f2bf(sv[8 * sp + j]);
          const int kc = sub * 32 + 16 * sp + 4 * hh;
          uint2 va = *(const uint2*)&Vt[buf][qn][kc], vb = *(const uint2*)&Vt[buf][qn][kc + 8];
          uint2 vc = *(const uint2*)&Vt[buf][32 + qn][kc], vd = *(const uint2*)&Vt[buf][32 + qn][kc + 8];
          uint4 w0 = make_uint4(va.x, va.y, vb.x, vb.y), w1 = make_uint4(vc.x, vc.y, vd.x, vd.y);
          bf16x8 v0 = __builtin_bit_cast(bf16x8, w0), v1 = __builtin_bit_cast(bf16x8, w1);
          o0 = mfma32(v0, pf, o0);
          o1 = mfma32(v1, pf, o1);
        }
      }
    }
  }
  __syncthreads();
  const float inv = 1.f / l_run;
  bf16_t* optr = p.Y + qrow * D + 512 + hq * 64;
#pragma unroll
  for (int rg = 0; rg < 4; ++rg) {
    int d0 = 8 * rg + 4 * hh;
    *(uint2*)(optr + d0) = make_uint2(pack2(o0[4 * rg] * inv, o0[4 * rg + 1] * inv), pack2(o0[4 * rg + 2] * inv, o0[4 * rg + 3] * inv));
    *(uint2*)(optr + 32 + d0) = make_uint2(pack2(o1[4 * rg] * inv, o1[4 * rg + 1] * inv), pack2(o1[4 * rg + 2] * inv, o1[4 * rg + 3] * inv));
  }
}

DEV void ph_attn_post(const P& p, int layer) {
  const int lane = tid_() & 63;
  int r0, r1;
  wave_range(r0, r1, NTOK);
  float gv[8];
#pragma unroll
  for (int i = 0; i < 8; ++i) gv[i] = p.at_out_g[layer * 512 + 8 * lane + i];
  uint4 nx = make_uint4(0, 0, 0, 0);
  if (r0 < r1) nx = *(const uint4*)(p.Y + (size_t)r0 * D + 512 + 8 * lane);
#pragma unroll 1
  for (int row = r0; row < r1; ++row) {
    const uint4 u = nx;
    if (row + 1 < r1) nx = *(const uint4*)(p.Y + (size_t)(row + 1) * D + 512 + 8 * lane);
    float v[8];
    unpack8(u, v);
    float ss = 0.f;
#pragma unroll
    for (int i = 0; i < 8; ++i) ss += v[i] * v[i];
    ss = wave_sum(ss);
    const float rstd = rsqrtf(ss * (1.f / 512.f) + 1e-6f);
#pragma unroll
    for (int i = 0; i < 8; ++i) {
      v[i] = v[i] * rstd * gv[i];
#if !EN_AT
      v[i] = 0.f;
#endif
    }
    *(uint4*)(p.Y + (size_t)row * D + 512 + 8 * lane) = pack8(v);
  }
}

struct Epi2 {
  const P& p; int layer, row0, col0;
  DEV void operator()(f32x4 (&acc)[4][4], int wr, int wc, int fr, int fq, char* smem) const {
    const int b = row0 / LT, pp = row0 % LT;
    const int mr = pp < LC ? 16 : b;
    const float* g1 = p.modv + ((size_t)layer * 17 + mr) * 6144 + 2048 + col0 + wc * 64;
#pragma unroll
    for (int n = 0; n < 4; ++n) {
      const float gv = g1[n * 16 + fr];
#pragma unroll
      for (int m = 0; m < 4; ++m)
#pragma unroll
        for (int j = 0; j < 4; ++j) acc[m][n][j] *= gv;
    }
    const int wid = wr * 2 + wc, lane = fq * 16 + fr;
    stage_tile_bf16(acc, smem, wid, fr, fq);
    const bf16_t (*t)[72] = (const bf16_t (*)[72])(smem + wid * 9216);
#pragma unroll
    for (int i = 0; i < 8; ++i) {
      const int rl = i * 8 + (lane >> 3), ch = lane & 7;
      bf16_t* xp = p.X + (size_t)(row0 + wr * 64 + rl) * D + col0 + wc * 64 + ch * 8;
      float xv[8], dv[8];
      uint4 xu = *(const uint4*)xp, du = *(const uint4*)&t[rl][ch * 8];
      unpack8(xu, xv); unpack8(du, dv);
#pragma unroll
      for (int q = 0; q < 8; ++q) xv[q] += dv[q];
#if EN_MIX
      *(uint4*)xp = pack8(xv);
#endif
    }
  }
};
DEV void ph_gemm2(const P& p, int layer, char* smem) {
  int rt, ct;
  for (int it = 0; gemm_unit(it, 8, rt, ct); ++it) {
    Epi2 epi{p, layer, rt * 128, ct * 128};
    gemm_tile(p.Y + (size_t)rt * 128 * D, D, p.W2t + (size_t)ct * 128 * D, D, D, smem, epi);
  }
}

DEV void ph_peerconv(const P& p, int layer) {
  const int gw = (bid_() * 256 + tid_()) >> 6, nw = gridDim.x * 4, lane = tid_() & 63;
  const float* su = opq(p.peer_u) + (size_t)layer * 16384 * 1024;
  const float* sv = opq(p.peer_v) + (size_t)layer * 16384 * 1024;
  unsigned char* pu = opq(p.PU); unsigned char* pv = opq(p.PV);
  float* psu = opq(p.PSU); float* psv = opq(p.PSV);
#pragma unroll 1
  for (int r = gw; r < 32768; r += nw) {
    const bool isv = r >= 16384;
    const int e = r & 16383;
    const float* src = (isv ? sv : su) + (size_t)e * 1024 + 16 * lane;
    float4 f0 = *(const float4*)src, f1 = *(const float4*)(src + 4), f2 = *(const float4*)(src + 8), f3 = *(const float4*)(src + 12);
    float am = fmaxf(fmaxf(fmaxf(fabsf(f0.x), fabsf(f0.y)), fmaxf(fabsf(f0.z), fabsf(f0.w))), fmaxf(fmaxf(fabsf(f1.x), fabsf(f1.y)), fmaxf(fabsf(f1.z), fabsf(f1.w))));
    am = fmaxf(am, fmaxf(fmaxf(fmaxf(fabsf(f2.x), fabsf(f2.y)), fmaxf(fabsf(f2.z), fabsf(f2.w))), fmaxf(fmaxf(fabsf(f3.x), fabsf(f3.y)), fmaxf(fabsf(f3.z), fabsf(f3.w)))));
    am = wave_max(am);
    const float sc = am > 0.f ? 224.f / am : 1.f;
    int w0 = __builtin_amdgcn_cvt_pk_fp8_f32(f0.x * sc, f0.y * sc, 0, false); w0 = __builtin_amdgcn_cvt_pk_fp8_f32(f0.z * sc, f0.w * sc, w0, true);
    int w1 = __builtin_amdgcn_cvt_pk_fp8_f32(f1.x * sc, f1.y * sc, 0, false); w1 = __builtin_amdgcn_cvt_pk_fp8_f32(f1.z * sc, f1.w * sc, w1, true);
    int w2 = __builtin_amdgcn_cvt_pk_fp8_f32(f2.x * sc, f2.y * sc, 0, false); w2 = __builtin_amdgcn_cvt_pk_fp8_f32(f2.z * sc, f2.w * sc, w2, true);
    int w3 = __builtin_amdgcn_cvt_pk_fp8_f32(f3.x * sc, f3.y * sc, 0, false); w3 = __builtin_amdgcn_cvt_pk_fp8_f32(f3.z * sc, f3.w * sc, w3, true);
    *(uint4*)((isv ? pv : pu) + (size_t)(lane >> 3) * PSLICE + (size_t)e * 128 + 16 * (lane & 7)) = make_uint4((unsigned)w0, (unsigned)w1, (unsigned)w2, (unsigned)w3);
    if (lane == 0) (isv ? psv : psu)[e] = am > 0.f ? am * (1.f / 224.f) : 1.f;
  }
}
DEV void unpack16_fp8x2(const uint4& u, f32x2* f) {
  f[0] = __builtin_amdgcn_cvt_pk_f32_fp8((int)u.x, false); f[1] = __builtin_amdgcn_cvt_pk_f32_fp8((int)u.x, true);
  f[2] = __builtin_amdgcn_cvt_pk_f32_fp8((int)u.y, false); f[3] = __builtin_amdgcn_cvt_pk_f32_fp8((int)u.y, true);
  f[4] = __builtin_amdgcn_cvt_pk_f32_fp8((int)u.z, false); f[5] = __builtin_amdgcn_cvt_pk_f32_fp8((int)u.z, true);
  f[6] = __builtin_amdgcn_cvt_pk_f32_fp8((int)u.w, false); f[7] = __builtin_amdgcn_cvt_pk_f32_fp8((int)u.w, true);
}
DEV void unpack16_fp8(const uint4& u, float* f) {
  f32x2 t;
  t = __builtin_amdgcn_cvt_pk_f32_fp8((int)u.x, false); f[0] = t[0]; f[1] = t[1];
  t = __builtin_amdgcn_cvt_pk_f32_fp8((int)u.x, true); f[2] = t[0]; f[3] = t[1];
  t = __builtin_amdgcn_cvt_pk_f32_fp8((int)u.y, false); f[4] = t[0]; f[5] = t[1];
  t = __builtin_amdgcn_cvt_pk_f32_fp8((int)u.y, true); f[6] = t[0]; f[7] = t[1];
  t = __builtin_amdgcn_cvt_pk_f32_fp8((int)u.z, false); f[8] = t[0]; f[9] = t[1];
  t = __builtin_amdgcn_cvt_pk_f32_fp8((int)u.z, true); f[10] = t[0]; f[11] = t[1];
  t = __builtin_amdgcn_cvt_pk_f32_fp8((int)u.w, false); f[12] = t[0]; f[13] = t[1];
  t = __builtin_amdgcn_cvt_pk_f32_fp8((int)u.w, true); f[14] = t[0]; f[15] = t[1];
}

struct Epi3 {
  const P& p; int row0, grp;
  DEV void operator()(f32x4 (&acc)[4][4], int wr, int wc, int fr, int fq, char* smem) const {
    float* sc = (float*)smem;
    const int tid = tid_();
    for (int pass = 0; pass < 2; ++pass) {
      __syncthreads();
      if (wr == pass) {
#pragma unroll
        for (int m = 0; m < 4; ++m)
#pragma unroll
          for (int n = 0; n < 4; ++n)
#pragma unroll
            for (int j = 0; j < 4; ++j) {
              int rl = m * 16 + fq * 4 + j, col = wc * 64 + n * 16 + fr;
              unsigned bits = (__float_as_uint(acc[m][n][j]) & ~127u) | (unsigned)col;
              sc[rl * 133 + (col >> 5) * 33 + (col & 31)] = __uint_as_float(bits);
            }
      }
      __syncthreads();
      const int rl = tid >> 2, q = tid & 3;
      float Ls[16];
#pragma unroll
      for (int i = 0; i < 16; ++i) Ls[i] = -3e38f;
      const float* src = sc + rl * 133 + q * 33;
      for (int i = 0; i < 32; ++i) {
        float x = src[i];
        if (x > Ls[15]) {
#pragma unroll
          for (int k = 0; k < 16; ++k) { float hi = fmaxf(Ls[k], x); x = fminf(Ls[k], x); Ls[k] = hi; }
        }
      }
      float Cs[16];
#pragma unroll
      for (int i = 0; i < 16; ++i) Cs[i] = fmaxf(Ls[i], dppself<0xB1, 0xF>(Ls[15 - i]));
#pragma unroll
      for (int d = 8; d >= 1; d >>= 1)
#pragma unroll
        for (int i = 0; i < 16; ++i)
          if ((i & d) == 0) { float hi = fmaxf(Cs[i], Cs[i + d]), lo = fminf(Cs[i], Cs[i + d]); Cs[i] = hi; Cs[i + d] = lo; }
      float Ds[16];
#pragma unroll
      for (int i = 0; i < 16; ++i) Ds[i] = fmaxf(Cs[i], dppself<0x4E, 0xF>(Cs[15 - i]));
#pragma unroll
      for (int d = 8; d >= 1; d >>= 1)
#pragma unroll
        for (int i = 0; i < 16; ++i)
          if ((i & d) == 0) { float hi = fmaxf(Ds[i], Ds[i + d]), lo = fminf(Ds[i], Ds[i + d]); Ds[i] = hi; Ds[i + d] = lo; }
      if (q == 0) {
        float* dst = p.TK + ((size_t)(row0 + pass * 64 + rl) * 16 + grp) * 16;
#pragma unroll
        for (int i = 0; i < 4; ++i) *(float4*)(dst + 4 * i) = make_float4(Ds[4 * i], Ds[4 * i + 1], Ds[4 * i + 2], Ds[4 * i + 3]);
      }
    }
  }
};
DEV void ph_gemm3(const P& p, char* smem) {
  int rt, ct;
  for (int it = 0; gemm_unit(it, 16, rt, ct); ++it) {
    Epi3 epi{p, rt * 128, ct};
    gemm_tile(p.H + (size_t)rt * 128 * D, D, p.Wft + (size_t)ct * 128 * D, D, D, smem, epi);
  }
}

DEV float peer_gate(float scr) {
  float mx = row16_max(scr);
  float ex = __expf(scr - mx);
  float sm = row16_sum(ex);
  return ex / sm;
}
DEV float gelu_exact(float x) { return 0.5f * x * (1.f + erff(x * 0.7071067811865476f)); }

DEV void ph_peer_select(const P& p) {
  const int gw = (bid_() * 256 + tid_()) >> 6, nw = gridDim.x * 4, lane = tid_() & 63;
  int ci, cj;
  {
    const int c = lane;
    if (c < 16) { ci = 0; cj = c; } else if (c < 24) { ci = 1; cj = c - 16; } else if (c < 29) { ci = 2; cj = c - 24; }
    else if (c < 33) { ci = 3; cj = c - 29; } else if (c < 36) { ci = 4; cj = c - 33; } else if (c < 38) { ci = 5; cj = c - 36; }
    else if (c < 40) { ci = 6; cj = c - 38; } else if (c < 42) { ci = 7; cj = c - 40; } else { ci = (c - 42 + 8) & 15; cj = 0; }
  }
  const bool cand = lane < 50;
  float v1s[8], v2s[8];
  auto ldtk = [&](int row) {
    const float* tk = p.TK + (size_t)row * 256;
#pragma unroll
    for (int h = 0; h < 8; ++h) { v1s[h] = tk[(2 * h) * 16 + ci]; v2s[h] = tk[(2 * h + 1) * 16 + cj]; }
  };
  if (gw < NTOK) ldtk(gw);
#pragma unroll 1
  for (int row = gw; row < NTOK; row += nw) {
    float c1[8], c2[8];
#pragma unroll
    for (int h = 0; h < 8; ++h) { c1[h] = v1s[h]; c2[h] = v2s[h]; }
    if (row + nw < NTOK) ldtk(row + nw);
#pragma unroll
    for (int h = 0; h < 8; ++h) {
      const float v1 = c1[h], v2 = c2[h];
      float val = v1 + v2;
      val = __uint_as_float((__float_as_uint(val) & ~63u) | (unsigned)lane);
      val = cand ? val : -3e38f;
      int rank = 0;
#pragma unroll
      for (int q = 0; q < 50; ++q) rank += (readlane_f(val, q) > val) ? 1 : 0;
      const bool sel = cand && rank < 16;
      const float mx = wave_max(val);
      const float ex = sel ? __expf(val - mx) : 0.f;
      const float sm = wave_sum(ex);
      if (sel) {
        const int e = (int)(__float_as_uint(v1) & 127u) * 128 + (int)(__float_as_uint(v2) & 127u);
        p.EL[(size_t)row * 128 + h * 16 + rank] = (unsigned short)e;
        p.GT[(size_t)row * 128 + h * 16 + rank] = ex / sm;
      }
    }
  }
}

struct PeerPre { uint4 e0, e1, a0, a1, a2, a3; };
DEV unsigned peer_eid(const PeerPre& s, int j) {
  const unsigned w = (j < 8) ? ((j >> 1) == 0 ? s.e0.x : (j >> 1) == 1 ? s.e0.y : (j >> 1) == 2 ? s.e0.z : s.e0.w)
                             : (((j - 8) >> 1) == 0 ? s.e1.x : ((j - 8) >> 1) == 1 ? s.e1.y : ((j - 8) >> 1) == 2 ? s.e1.z : s.e1.w);
  return (j & 1) ? (w >> 16) : (w & 0xFFFFu);
}
template <int WHICH>
DEV void peer_wave_run(const P& p, int layer, int x, int tok0, int lane, float* wbuf) {
  const int r = lane >> 3, c = lane & 7;
  const unsigned char* tb = (WHICH == 0 ? p.PU : p.PV) + (size_t)x * PSLICE + c * 16;
  PeerPre S[3];
  uint4 R[16];
  auto ld_pre = [&](int tok, PeerPre& s) {
    const uint4* elp = (const uint4*)(p.EL + (size_t)tok * 128 + r * 16);
    s.e0 = elp[0]; s.e1 = elp[1];
    if (WHICH == 0) {
      const bf16_t* hr = p.H + (size_t)tok * D + x * 128 + c * 16;
      s.a0 = *(const uint4*)hr; s.a1 = *(const uint4*)(hr + 8);
    } else {
      const uint4* wtp = (const uint4*)(p.GT + (size_t)tok * 128 + r * 16);
      s.a0 = wtp[0]; s.a1 = wtp[1]; s.a2 = wtp[2]; s.a3 = wtp[3];
    }
  };
  auto comp = [&](int tok, const PeerPre& s, const PeerPre& sn, bool more) {
    if (WHICH == 0) {
      float hv[16];
      unpack8(s.a0, hv); unpack8(s.a1, hv + 8);
      f32x2 hv2[8];
#pragma unroll
      for (int i = 0; i < 8; ++i) hv2[i] = (f32x2){hv[2 * i], hv[2 * i + 1]};
      float keep0 = 0.f, keep1 = 0.f;
#pragma unroll
      for (int j = 0; j < 16; ++j) {
        f32x2 f[8];
        unpack16_fp8x2(R[j], f);
        if (more) R[j] = *(const uint4*)(tb + (size_t)peer_eid(sn, j) * 128);
        f32x2 d2 = f[0] * hv2[0];
#pragma unroll
        for (int i = 1; i < 8; ++i) d2 += f[i] * hv2[i];
        const float d = oct_sum(d2[0] + d2[1]);
        if (j < 8) keep0 = (c == j) ? d : keep0; else keep1 = (c == j - 8) ? d : keep1;
      }
      float* pd = p.PD + ((size_t)x * NTOK + tok) * 128 + r * 16 + c;
      pd[0] = keep0; pd[8] = keep1;
    } else {
      const float wsv[16] = {__uint_as_float(s.a0.x), __uint_as_float(s.a0.y), __uint_as_float(s.a0.z), __uint_as_float(s.a0.w),
                             __uint_as_float(s.a1.x), __uint_as_float(s.a1.y), __uint_as_float(s.a1.z), __uint_as_float(s.a1.w),
                             __uint_as_float(s.a2.x), __uint_as_float(s.a2.y), __uint_as_float(s.a2.z), __uint_as_float(s.a2.w),
                             __uint_as_float(s.a3.x), __uint_as_float(s.a3.y), __uint_as_float(s.a3.z), __uint_as_float(s.a3.w)};
      f32x2 acc2[8];
#pragma unroll
      for (int i = 0; i < 8; ++i) acc2[i] = (f32x2){0.f, 0.f};
#pragma unroll
      for (int j = 0; j < 16; ++j) {
        f32x2 f[8];
        unpack16_fp8x2(R[j], f);
        if (more) R[j] = *(const uint4*)(tb + (size_t)peer_eid(sn, j) * 128);
        const f32x2 w2 = (f32x2){wsv[j], wsv[j]};
#pragma unroll
        for (int i = 0; i < 8; ++i) acc2[i] += w2 * f[i];
      }
      float* slab = wbuf + (r * 8 + c) * 16;
      *(float4*)(slab) = make_float4(acc2[0][0], acc2[0][1], acc2[1][0], acc2[1][1]);
      *(float4*)(slab + 4) = make_float4(acc2[2][0], acc2[2][1], acc2[3][0], acc2[3][1]);
      *(float4*)(slab + 8) = make_float4(acc2[4][0], acc2[4][1], acc2[5][0], acc2[5][1]);
      *(float4*)(slab + 12) = make_float4(acc2[6][0], acc2[6][1], acc2[7][0], acc2[7][1]);
      asm volatile("s_waitcnt lgkmcnt(0)" ::: "memory");
      float o0 = 0.f, o1 = 0.f;
#pragma unroll
      for (int rr = 0; rr < 8; ++rr) {
        const float2 t = *(const float2*)(wbuf + (rr * 8 + (lane >> 3)) * 16 + 2 * (lane & 7));
        o0 += t.x; o1 += t.y;
      }
      asm volatile("s_waitcnt lgkmcnt(0)" ::: "memory");
      const int b = tok / LT, pp = tok % LT;
      const int mr = pp < LC ? 16 : b;
      const int col = x * 128 + 2 * lane;
      const float* g2 = p.modv + ((size_t)layer * 17 + mr) * 6144 + 5120 + col;
      unsigned* xp = (unsigned*)(p.X + (size_t)tok * D + col);
      const unsigned xu = *xp;
#if EN_PEER
      *xp = pack2(bflo(xu) + g2[0] * o0, bfhi(xu) + g2[1] * o1);
#endif
    }
  };
  ld_pre(tok0, S[0]);
  ld_pre(tok0 + 1, S[1]);
#pragma unroll
  for (int j = 0; j < 16; ++j) R[j] = *(const uint4*)(tb + (size_t)peer_eid(S[0], j) * 128);
  ld_pre(tok0 + 2, S[2]);
#pragma unroll
  for (int t = 0; t < 8; ++t) {
    comp(tok0 + t, S[t % 3], S[(t + 1) % 3], t + 1 < 8);
    if (t + 3 < 8) ld_pre(tok0 + t + 3, S[t % 3]);
  }
}
DEV void ph_peer_w(const P& p) {
  for (size_t i = (size_t)bid_() * 256 + tid_(); i < (size_t)NTOK * 128; i += (size_t)gridDim.x * 256) {
    float d = 0.f;
#pragma unroll
    for (int x = 0; x < 8; ++x) d += p.PD[(size_t)x * NTOK * 128 + i];
    const int e = p.EL[i];
    p.GT[i] = p.GT[i] * gelu_exact(d * p.PSU[e]) * p.PSV[e];
  }
}
template <int WHICH>
DEV void ph_peer_gather(const P& p, int layer, char* smem, volatile LAS unsigned* slot) {
  const int tid = tid_(), lane = tid & 63, wid = tid >> 6;
  unsigned* q = p.wq + 1024 + layer * 256 + WHICH * 128;
  const int my = (int)(xb_xcc_id() & 7u);
  float* wbuf = (float*)smem + wid * 1024;
#pragma unroll 1
  for (int rot = 0; rot < 8; ++rot) {
    const int x = (my + rot) & 7;
    for (;;) {
      __syncthreads();
      if (tid == 0) *slot = atomicAdd(q + x * 16, 1u);
      __syncthreads();
      const int it = (int)*slot;
      if (it >= NTOK / 32) break;
      peer_wave_run<WHICH>(p, layer, x, it * 32 + wid * 8, lane, wbuf);
    }
  }
}

DEV void ph_final(const P& p) {
  const int lane = tid_() & 63;
  int r0, r1;
  wave_range(r0, r1, NB * T);
  float gv[16];
#pragma unroll
  for (int hh = 0; hh < 2; ++hh)
#pragma unroll
    for (int i = 0; i < 8; ++i) gv[hh * 8 + i] = p.final_g[hh * 512 + 8 * lane + i];
  auto xrow = [&](int r) -> const bf16_t* { const int b = r / T, t = r % T; return p.X + ((size_t)b * LT + LC + t) * D; };
  uint4 n0 = make_uint4(0, 0, 0, 0), n1 = n0;
  if (r0 < r1) { const bf16_t* xr = xrow(r0); n0 = *(const uint4*)(xr + 8 * lane); n1 = *(const uint4*)(xr + 512 + 8 * lane); }
#pragma unroll 1
  for (int r = r0; r < r1; ++r) {
    const uint4 u0 = n0, u1 = n1;
    if (r + 1 < r1) { const bf16_t* xr = xrow(r + 1); n0 = *(const uint4*)(xr + 8 * lane); n1 = *(const uint4*)(xr + 512 + 8 * lane); }
    float v[16];
    unpack8(u0, v); unpack8(u1, v + 8);
    float ss = 0.f;
#pragma unroll
    for (int i = 0; i < 16; ++i) ss += v[i] * v[i];
    ss = wave_sum(ss);
    const float rstd = rsqrtf(ss * (1.f / 1024.f) + 1e-6f);
    float* o = p.out + (size_t)r * D;
#pragma unroll
    for (int hh = 0; hh < 2; ++hh) {
      const int col = hh * 512 + 8 * lane;
      *(float4*)(o + col) = make_float4(v[hh * 8 + 0] * rstd * gv[hh * 8 + 0], v[hh * 8 + 1] * rstd * gv[hh * 8 + 1], v[hh * 8 + 2] * rstd * gv[hh * 8 + 2], v[hh * 8 + 3] * rstd * gv[hh * 8 + 3]);
      *(float4*)(o + col + 4) = make_float4(v[hh * 8 + 4] * rstd * gv[hh * 8 + 4], v[hh * 8 + 5] * rstd * gv[hh * 8 + 5], v[hh * 8 + 6] * rstd * gv[hh * 8 + 6], v[hh * 8 + 7] * rstd * gv[hh * 8 + 7]);
    }
  }
}

DEV unsigned hw_cu_key() {
  const unsigned hwid = (unsigned)__builtin_amdgcn_s_getreg(((8 - 1) << 11) | (8 << 6) | 4);
  return (xb_xcc_id() << 8) | (hwid & 0xFFu);
}
DEV void mixB(const P& p, int layer, char* smem, volatile LAS unsigned* slot) {
  unsigned* qa = p.wq + layer * 64;
  unsigned* qs = qa + 16;
  unsigned* claim = p.cuclaim + layer * 4096;
  __syncthreads();
  if (tid_() == 0) {
    unsigned u = 0xFFFFFFFFu;
    if (atomicAdd(&claim[hw_cu_key() & 4095u], 1u) == 0u) u = atomicAdd(qs, 1u);
    *slot = u;
  }
  __syncthreads();
  {
    const unsigned u = *slot;
    if (u < 128u) scanc_unit(p, layer, (int)u, smem);
  }
  for (;;) {
    __syncthreads();
    if (tid_() == 0) *slot = atomicAdd(qa, 1u);
    __syncthreads();
    const int u = (int)*slot;
    if (u >= 8704) break;
    if (u < 4352) attn_unit(p, layer, u, smem); else hyena_conv_unit(p, layer, u - 4352, smem);
  }
  for (;;) {
    __syncthreads();
    if (tid_() == 0) *slot = atomicAdd(qs, 1u);
    __syncthreads();
    const unsigned u = *slot;
    if (u >= 128u) break;
    scanc_unit(p, layer, (int)u, smem);
  }
}
DEV void mixA(const P& p, int layer, char* smem) {
  for (int u = bid_(); u < 1088; u += gridDim.x) hyena_pre_unit(p, layer, u);
  ph_lora(p, layer, smem);
  ph_rwkv_prep(p, layer);
}
DEV void mixC(const P& p, int layer, char* smem) {
  for (int u = bid_(); u < 1088; u += gridDim.x) hyena_post_unit(p, layer, u, smem);
  ph_rwkv_post(p, layer);
  ph_attn_post(p, layer);
}

__global__ void __launch_bounds__(256, 2) k_mega(P p) {
  extern __shared__ __attribute__((aligned(16))) char smem_all[];
  char* smem = smem_all;
  volatile LAS unsigned* xbw = (volatile LAS unsigned*)(smem_all + SMEM_BYTES);
  if (threadIdx.x == 0) { xbw[0] = 0u; xbw[1] = 0u; xbw[2] = 0u; xbw[3] = 0u; }
  __syncthreads();
  XcdBarrier bar = xcd_barrier_post(p.bar, xbw);
#ifndef NO_PRO
  ph_copy(p);
  ph_rope(p);
  for (int u = blockIdx.x; u < 96; u += gridDim.x) modv_unit(p, u, smem);
#endif
#ifndef NO_PREP
  ph_prep(p, 0, smem);
#endif
  xcd_barrier(bar);
  for (int layer = 0; layer < NLAYERS; ++layer) {
#ifndef NO_NORM
    ph_norm(p, layer, 0);
#endif
    xcd_barrier(bar);
#ifdef PROBE_GEMM
    ph_gemm1(p, smem);
#endif
#ifndef NO_GEMM1
    ph_gemm1(p, smem);
#endif
    xcd_barrier(bar);
#ifndef NO_MIXA
    mixA(p, layer, smem);
#endif
    xcd_barrier(bar);
#ifndef NO_MIXB
    mixB(p, layer, smem, (volatile LAS unsigned*)(smem_all + SMEM_BYTES + 16));
#endif
    xcd_barrier(bar);
#ifndef NO_MIXC
    mixC(p, layer, smem);
#endif
    xcd_barrier(bar);
#ifndef NO_GEMM2
    ph_gemm2(p, layer, smem);
    ph_peerconv(p, layer);
#endif
    xcd_barrier(bar);
#ifndef NO_NORM
    ph_norm(p, layer, 1);
#endif
    xcd_barrier(bar);
#ifdef PROBE_GEMM
    ph_gemm3(p, smem);
#endif
#ifndef NO_GEMM3
    ph_gemm3(p, smem);
#endif
    xcd_barrier(bar);
    ph_peer_select(p);
    xcd_barrier(bar);
    ph_peer_gather<0>(p, layer, smem, (volatile LAS unsigned*)(smem_all + SMEM_BYTES + 16));
    xcd_barrier(bar);
    ph_peer_w(p);
    xcd_barrier(bar);
    ph_peer_gather<1>(p, layer, smem, (volatile LAS unsigned*)(smem_all + SMEM_BYTES + 16));
#ifndef NO_PREP
    if (layer + 1 < NLAYERS) ph_prep(p, layer + 1, smem);
#endif
    xcd_barrier(bar);
  }
  ph_final(p);
}

static inline size_t al256(size_t x) { return (x + 255) & ~(size_t)255; }

extern "C" void kernel_launch(void* const* d_in, const int* in_sizes, int n_in, void* d_out, int out_size, void* d_ws, size_t ws_size,
                              hipStream_t stream) {
  (void)in_sizes; (void)n_in; (void)out_size; (void)ws_size;
  P p{};
  const float** f = (const float**)&p;
  for (int i = 0; i < 39; ++i) f[i] = (const float*)d_in[i];
  p.out = (float*)d_out;
  char* w = (char*)d_ws;
  size_t off = 0;
  auto take = [&](size_t bytes) { char* r = w + off; off += al256(bytes); return r; };
  p.bar = (unsigned*)take(16384);
  p.modv = (float*)take((size_t)DEPTH * 17 * 6144 * 4);
  p.SSQ = (float*)take((size_t)DEPTH * 2 * 256 * 4);
  p.wq = (unsigned*)take(4096 + DEPTH * 1024);
  p.cuclaim = (unsigned*)take((size_t)DEPTH * 4096 * 4);
  const size_t zero_bytes = off;
  p.rope = (float*)take(64 * 16 * 2 * 4);
  p.X = (bf16_t*)take((size_t)NTOK * D * 2);
  p.H = (bf16_t*)take((size_t)NTOK * D * 2);
  p.Y = (bf16_t*)take((size_t)NTOK * D * 2);
  p.SC = (bf16_t*)take((size_t)NTOK * 1024 * 2);
  p.Z = (bf16_t*)take((size_t)NTOK * INW * 2);
  p.UTl = (bf16_t*)take((size_t)256 * 16 * T * 2);
  p.UTc = (bf16_t*)take((size_t)256 * 16 * LC * 2);
  p.YTl = (bf16_t*)take((size_t)256 * 16 * T * 2);
  p.YTc = (bf16_t*)take((size_t)256 * 16 * LC * 2);
  p.FL = (float*)take((size_t)256 * 2 * T * 4);
  p.FC = (float*)take((size_t)256 * 2 * LC * 4);
  p.W1t = (bf16_t*)take((size_t)INW * D * 2);
  p.W2t = (bf16_t*)take((size_t)D * D * 2);
  p.Wft = (bf16_t*)take((size_t)2048 * D * 2);
  p.Wlt = (bf16_t*)take((size_t)1024 * 256 * 2);
  p.Wgt = (bf16_t*)take((size_t)256 * 128 * 2);
  p.TK = (float*)p.Z;
  p.PU = (unsigned char*)p.Z + al256((size_t)NTOK * 256 * 4);
  p.PV = p.PU + (size_t)16384 * 1024;
  p.PSU = (float*)(p.PV + (size_t)16384 * 1024);
  p.PSV = p.PSU + 16384;
  p.GT = p.PSV + 16384;
  p.EL = (unsigned short*)(p.GT + (size_t)NTOK * 128);
  p.PD = (float*)p.Y;

  (void)hipMemsetAsync(d_ws, 0, zero_bytes, stream);
  constexpr size_t kDynLds = SMEM_BYTES + 32;
  static int grid = 0;
  if (!grid) {
    int dev = 0, cus = 0, per_cu = 0;
    (void)hipGetDevice(&dev);
    (void)hipDeviceGetAttribute(&cus, hipDeviceAttributeMultiprocessorCount, dev);
    (void)hipFuncSetAttribute((const void*)k_mega, hipFuncAttributeMaxDynamicSharedMemorySize, (int)kDynLds);
    (void)hipOccupancyMaxActiveBlocksPerMultiprocessor(&per_cu, k_mega, 256, kDynLds);
    if (cus <= 0) cus = 256;
    if (per_cu > 2) per_cu = 2;
    if (per_cu < 1) per_cu = 1;
    grid = cus * per_cu;
  }
  k_mega<<<grid, 256, kDynLds, stream>>>(p);
}
```

```cpp
#include <hip/hip_runtime.h>
#include <stdint.h>
#include <type_traits>

#define DEV __device__ __forceinline__
typedef unsigned short bf16_t;
typedef short bf16x8 __attribute__((ext_vector_type(8)));
typedef float f32x2 __attribute__((ext_vector_type(2)));
constexpr size_t PSLICE = (size_t)16384 * 128;
typedef float f32x4 __attribute__((ext_vector_type(4)));
typedef float f32x16 __attribute__((ext_vector_type(16)));

#ifndef NLAYERS
#define NLAYERS 4
#endif
#ifndef EN_HY
#define EN_HY 1
#endif
#ifndef EN_RW
#define EN_RW 1
#endif
#ifndef EN_AT
#define EN_AT 1
#endif
#ifndef EN_MIX
#define EN_MIX 1
#endif
#ifndef EN_PEER
#define EN_PEER 1
#endif

constexpr int NB = 16, T = 4096, LC = 256, LT = 4352, D = 1024, NTOK = NB * LT, INW = 2688, DEPTH = 4;
constexpr int SMEM_BYTES = 65536;

struct P {
  const float *x, *c, *ctx, *c_ctx, *mod_w, *mod_b, *norm1_g, *norm2_g, *w_in, *conv_w, *conv_b;
  const float *hy_w1, *hy_b1, *hy_w2, *hy_b2, *hy_w3, *hy_b3, *hy_freq, *hy_bias;
  const float *rw_w0, *rw_w_up, *rw_a0, *rw_a_up, *rw_g_up, *rw_k_k, *rw_k_a, *rw_r_k, *rw_ln_w, *rw_ln_b;
  const float *attn_sink, *hy_out_g, *at_out_g, *w_out, *peer_wq, *peer_k1, *peer_k2, *peer_u, *peer_v, *final_g;
  float* out;
  unsigned* bar;
  float *modv, *SSQ, *rope, *FL, *FC, *TK;
  unsigned *wq, *cuclaim;
  bf16_t *X, *H, *Y, *SC, *Z, *UTl, *UTc, *YTl, *YTc;
  bf16_t *W1t, *W2t, *Wft, *Wlt, *Wgt;
  unsigned char *PU, *PV;
  float *PSU, *PSV, *GT, *PD, *HINV;
  unsigned short* EL;
  unsigned char* H8;
};

typedef __bf16 hwbf2 __attribute__((ext_vector_type(2)));
DEV unsigned pack2(float a, float b) { f32x2 f = {a, b}; hwbf2 r = __builtin_convertvector(f, hwbf2); return __builtin_bit_cast(unsigned, r); }
DEV bf16_t f2bf(float f) { return (bf16_t)(pack2(f, 0.f) & 0xFFFFu); }
DEV float bf2f(bf16_t h) { return __uint_as_float(((unsigned)h) << 16); }
DEV float bflo(unsigned u) { return __uint_as_float(u << 16); }
DEV float bfhi(unsigned u) { return __uint_as_float(u & 0xFFFF0000u); }
DEV void unpack8(const uint4& u, float* v) {
  v[0] = bflo(u.x); v[1] = bfhi(u.x); v[2] = bflo(u.y); v[3] = bfhi(u.y);
  v[4] = bflo(u.z); v[5] = bfhi(u.z); v[6] = bflo(u.w); v[7] = bfhi(u.w);
}
DEV uint4 pack8(const float* v) { return make_uint4(pack2(v[0], v[1]), pack2(v[2], v[3]), pack2(v[4], v[5]), pack2(v[6], v[7])); }
DEV int pack_i8(float a, float b, float c, float d) {
  const int ia = __float2int_rn(a), ib = __float2int_rn(b), ic = __float2int_rn(c), id = __float2int_rn(d);
  return (ia & 0xFF) | ((ib & 0xFF) << 8) | ((ic & 0xFF) << 16) | ((id & 0xFF) << 24);
}
DEV float sigmoidf_(float x) { return __builtin_amdgcn_rcpf(1.f + __expf(-x)); }

template <int CTRL, int ROWMASK>
DEV float dpp0(float x) {
  return __builtin_bit_cast(float, __builtin_amdgcn_update_dpp(0, __builtin_bit_cast(int, x), CTRL, ROWMASK, 0xF, false));
}
template <int CTRL, int ROWMASK>
DEV float dppself(float x) {
  int xi = __builtin_bit_cast(int, x);
  return __builtin_bit_cast(float, __builtin_amdgcn_update_dpp(xi, xi, CTRL, ROWMASK, 0xF, false));
}
DEV float readlane_f(float x, int l) { return __builtin_bit_cast(float, __builtin_amdgcn_readlane(__builtin_bit_cast(int, x), l)); }
DEV int lane_id() { return (int)__builtin_amdgcn_mbcnt_hi(~0u, __builtin_amdgcn_mbcnt_lo(~0u, 0u)); }
DEV float writelane_f(float val, int l, float old) { return lane_id() == l ? val : old; }
DEV int writelane_i(int val, int l, int old) { return lane_id() == l ? val : old; }
DEV float wave_sum(float x) {
  x += dpp0<0x111, 0xF>(x); x += dpp0<0x112, 0xF>(x); x += dpp0<0x114, 0xF>(x); x += dpp0<0x118, 0xF>(x);
  x += dpp0<0x142, 0xA>(x); x += dpp0<0x143, 0xC>(x);
  return readlane_f(x, 63);
}
DEV float wave_max(float x) {
  x = fmaxf(x, dppself<0x111, 0xF>(x)); x = fmaxf(x, dppself<0x112, 0xF>(x)); x = fmaxf(x, dppself<0x114, 0xF>(x));
  x = fmaxf(x, dppself<0x118, 0xF>(x)); x = fmaxf(x, dppself<0x142, 0xA>(x)); x = fmaxf(x, dppself<0x143, 0xC>(x));
  return readlane_f(x, 63);
}
DEV float row16_sum(float x) {
  x += dpp0<0xB1, 0xF>(x); x += dpp0<0x4E, 0xF>(x); x += dpp0<0x141, 0xF>(x); x += dpp0<0x140, 0xF>(x);
  return x;
}
DEV float row16_max(float x) {
  x = fmaxf(x, dppself<0xB1, 0xF>(x)); x = fmaxf(x, dppself<0x4E, 0xF>(x)); x = fmaxf(x, dppself<0x141, 0xF>(x));
  x = fmaxf(x, dppself<0x140, 0xF>(x));
  return x;
}
DEV float quad_sum(float x) { x += dpp0<0xB1, 0xF>(x); x += dpp0<0x4E, 0xF>(x); return x; }

DEV f32x4 mfma16(bf16x8 a, bf16x8 b, f32x4 c) { return __builtin_amdgcn_mfma_f32_16x16x32_bf16(a, b, c, 0, 0, 0); }
DEV f32x16 mfma32(bf16x8 a, bf16x8 b, f32x16 c) { return __builtin_amdgcn_mfma_f32_32x32x16_bf16(a, b, c, 0, 0, 0); }


#define XB_TMO      128
#define XB_XCNT(j)  (256  + 64 * (j))
#define XB_XSUB(j)  (1280 + 64 * (j))
#define XB_XGEN(j)  (2304 + 64 * (j))
#define XB_TOP      3328
#define XB_TOPGEN   3392
#define XCD_BAR_WORDS 3456
#define XB_SPIN_CAP (1u << 23)
#define LAS __attribute__((address_space(3)))

__device__ __forceinline__ unsigned xb_ld(unsigned* p)              { return __hip_atomic_load(p, __ATOMIC_RELAXED, __HIP_MEMORY_SCOPE_AGENT); }
__device__ __forceinline__ unsigned xb_add(unsigned* p, unsigned v) { return __hip_atomic_fetch_add(p, v, __ATOMIC_RELAXED, __HIP_MEMORY_SCOPE_AGENT); }
__device__ __forceinline__ unsigned xb_xcc_id() { return (unsigned)__builtin_amdgcn_s_getreg((3 << 11) | 20) & 0xFu; }
#define XB_SPIN(cond, bar) do { unsigned _sp = 0; while (cond) { __builtin_amdgcn_s_sleep(1); \
    if ((++_sp & 255u) == 0u) { if (xb_ld(&(bar)[XB_TMO])) break; if (_sp > XB_SPIN_CAP) { atomicAdd(&(bar)[XB_TMO], 1u); break; } } } } while (0)

struct XcdBarrier {
    unsigned* bar; unsigned x;
    volatile LAS unsigned* st;
};
__device__ __forceinline__ XcdBarrier xcd_barrier_post(unsigned* bar, volatile LAS unsigned* st) {
    XcdBarrier b; b.bar = bar; b.x = xb_xcc_id(); b.st = st;
    if (threadIdx.x == 0) (void)xb_add(&bar[XB_XCNT(b.x)], 1u);
    return b;
}
__device__ __forceinline__ void xcd_barrier_complete(unsigned* bar, unsigned x, unsigned& nloc, unsigned& nx) {
    const unsigned G = gridDim.x * gridDim.y * gridDim.z;
    unsigned sum, cnt, mine, sp = 0u;
    for (;;) {
        sum = 0u; cnt = 0u; mine = 0u;
#pragma unroll
        for (unsigned j = 0; j < 16; ++j) { const unsigned c = xb_ld(&bar[XB_XCNT(j)]); sum += c; cnt += (c > 0u) ? 1u : 0u; mine = (j == x) ? c : mine; }
        if (sum == G) break;
        __builtin_amdgcn_s_sleep(1);
        if ((++sp & 255u) == 0u) { if (xb_ld(&bar[XB_TMO])) break; if (sp > XB_SPIN_CAP) { atomicAdd(&bar[XB_TMO], 1u); break; } }
    }
    nloc = mine > 0u ? mine : 1u; nx = cnt > 0u ? cnt : 1u;
}
__device__ __forceinline__ void xcd_barrier(const XcdBarrier& b) {
    asm volatile("s_waitcnt vmcnt(0)" ::: "memory");
    __syncthreads();
    if (threadIdx.x == 0) {
        unsigned* bar = b.bar;
        __builtin_amdgcn_s_waitcnt(0);
        unsigned nloc = b.st[0], nx = b.st[1];
        if (nloc == 0u) { xcd_barrier_complete(bar, b.x, nloc, nx); b.st[0] = nloc; b.st[1] = nx; }
        const unsigned old = xb_add(&bar[XB_XSUB(b.x)], 1u);
        const unsigned gen = old / nloc;
        if (old + 1u == (gen + 1u) * nloc) {
            __builtin_amdgcn_fence(__ATOMIC_RELEASE, "agent");
            asm volatile("s_waitcnt vmcnt(0)" ::: "memory");
            const unsigned og = xb_add(&bar[XB_TOP], 1u);
            const unsigned tg = og / nx;
            if (og + 1u == (tg + 1u) * nx) xb_add(&bar[XB_TOPGEN], 1u);
            else XB_SPIN(xb_ld(&bar[XB_TOPGEN]) == tg, bar);
            __builtin_amdgcn_fence(__ATOMIC_ACQUIRE, "agent");
            xb_add(&bar[XB_XGEN(b.x)], 1u);
            asm volatile("s_waitcnt vmcnt(0)" ::: "memory");
        } else {
            XB_SPIN(xb_ld(&bar[XB_XGEN(b.x)]) == gen, bar);
            __builtin_amdgcn_fence(__ATOMIC_ACQUIRE, "agent");
            asm volatile("s_waitcnt vmcnt(0)" ::: "memory");
        }
    }
    __syncthreads();
}

template <class Tp> DEV Tp* opq(Tp* q) { asm volatile("" : "+s"(q)); return q; }
DEV int tid_() { int t = threadIdx.x; asm volatile("" : "+v"(t)); return t; }
DEV int bid_() { int b = blockIdx.x; asm volatile("" : "+s"(b)); return b; }

DEV void glds16(const void* gsrc, char* lds_lane_ptr) {
  __builtin_amdgcn_global_load_lds((const unsigned*)gsrc, (__attribute__((address_space(3))) unsigned*)lds_lane_ptr, 16, 0, 0);
}
template <class Epi>
DEV void gemm_tile(const bf16_t* __restrict__ A, int lda, const bf16_t* __restrict__ Bt, int ldb, int K, char* smem, Epi& epi) {
  const int tid = tid_(), lane = tid & 63, wid = tid >> 6, wr = wid >> 1, wc = wid & 1, fr = lane & 15, fq = lane >> 4;
  f32x4 acc[4][4];
#pragma unroll
  for (int m = 0; m < 4; ++m)
#pragma unroll
    for (int n = 0; n < 4; ++n) acc[m][n] = (f32x4){0.f, 0.f, 0.f, 0.f};
  const int drow0 = 8 * wid + (lane >> 3), dpc = lane & 7;
  auto issue = [&](int kt, int buf) {
    char* sa = smem + buf * 32768;
    char* sb = sa + 16384;
#pragma unroll
    for (int i = 0; i < 4; ++i) {
      const int row = drow0 + 32 * i;
      const int kc = dpc ^ ((row >> 1) & 7);
      glds16(A + (size_t)row * lda + kt * 64 + kc * 8, sa + (i * 4 + wid) * 1024 + lane * 16);
      glds16(Bt + (size_t)row * ldb + kt * 64 + kc * 8, sb + (i * 4 + wid) * 1024 + lane * 16);
    }
  };
  __syncthreads();
  issue(0, 0);
  const int nk = K >> 6;
  const int sw = (fr >> 1) & 7;
  const int aoff = (wr * 64 + fr) * 128, boff = (wc * 64 + fr) * 128;
  for (int kt = 0; kt < nk; ++kt) {
    asm volatile("s_waitcnt vmcnt(0)" ::: "memory");
    __syncthreads();
    if (kt + 1 < nk) issue(kt + 1, (kt + 1) & 1);
    const char* sa = smem + (kt & 1) * 32768;
    const char* sb = sa + 16384;
#pragma unroll
    for (int kh = 0; kh < 2; ++kh) {
      const int pc = ((kh * 4 + fq) ^ sw) * 16;
      bf16x8 af[4], bfr[4];
#pragma unroll
      for (int m = 0; m < 4; ++m) af[m] = *(const bf16x8*)(sa + aoff + m * 2048 + pc);
#pragma unroll
      for (int n = 0; n < 4; ++n) bfr[n] = *(const bf16x8*)(sb + boff + n * 2048 + pc);
#pragma unroll
      for (int m = 0; m < 4; ++m)
#pragma unroll
        for (int n = 0; n < 4; ++n) acc[m][n] = mfma16(af[m], bfr[n], acc[m][n]);
    }
  }
  __syncthreads();
  epi(acc, wr, wc, fr, fq, smem);
}
DEV void stage_tile_bf16(const f32x4 (&acc)[4][4], char* smem, int wid, int fr, int fq) {
  bf16_t (*t)[72] = (bf16_t (*)[72])(smem + wid * 9216);
#pragma unroll
  for (int m = 0; m < 4; ++m)
#pragma unroll
    for (int n = 0; n < 4; ++n)
#pragma unroll
      for (int j = 0; j < 4; ++j) t[m * 16 + fq * 4 + j][n * 16 + fr] = f2bf(acc[m][n][j]);
  asm volatile("s_waitcnt lgkmcnt(0)" ::: "memory");
}

DEV void ph_copy(const P& p) {
  const size_t n8 = (size_t)NTOK * D / 8;
  const float* pctx = opq(p.ctx); const float* px = opq(p.x);
  for (size_t i = (size_t)bid_() * 256 + tid_(); i < n8; i += (size_t)gridDim.x * 256) {
    size_t e = i * 8;
    int row = (int)(e / D), col = (int)(e % D);
    int b = row / LT, pp = row % LT;
    const float* src = pp < LC ? pctx + ((size_t)(b * LC + pp)) * D + col : px + ((size_t)(b * T + pp - LC)) * D + col;
    float4 v0 = *(const float4*)src, v1 = *(const float4*)(src + 4);
    uint4 o = make_uint4(pack2(v0.x, v0.y), pack2(v0.z, v0.w), pack2(v1.x, v1.y), pack2(v1.z, v1.w));
    *(uint4*)(p.X + e) = o;
  }
}

DEV void ph_rope(const P& p) {
  for (int i = bid_() * 256 + tid_(); i < 64 * 16; i += gridDim.x * 256) {
    int pos = i >> 4, k = i & 15;
    float inv = powf(10000.f, -(float)k / 16.f);
    float ang = (float)pos * inv;
    p.rope[2 * i] = cosf(ang); p.rope[2 * i + 1] = sinf(ang);
  }
}

DEV void modv_unit(const P& p, int unit, char* smem) {
  const int cc = unit % 24, layer = unit / 24;
  float (*cs)[128] = (float (*)[128])smem;
  const int col = cc * 256 + tid_();
  const float* pc = opq(p.c); const float* pcc = opq(p.c_ctx);
  float acc[17];
#pragma unroll
  for (int r = 0; r < 17; ++r) acc[r] = 0.f;
  for (int ks = 0; ks < 8; ++ks) {
    __syncthreads();
    for (int i = tid_(); i < 17 * 128; i += 256) {
      int r = i >> 7, e = i & 127;
      float v = r < 16 ? pc[r * D + ks * 128 + e] : pcc[ks * 128 + e];
      cs[r][e] = v / (1.f + expf(-v));
    }
    __syncthreads();
    const float* w = p.mod_w + ((size_t)layer * D + ks * 128) * 6144 + col;
#pragma unroll 4
    for (int e = 0; e < 128; ++e) {
      float wv = w[(size_t)e * 6144];
#pragma unroll
      for (int r = 0; r < 17; ++r) acc[r] += cs[r][e] * wv;
    }
  }
  const float bias = p.mod_b[layer * 6144 + col];
#pragma unroll
  for (int r = 0; r < 17; ++r) p.modv[((size_t)layer * 17 + r) * 6144 + col] = acc[r] + bias;
}

DEV void transpose_unit(const float* __restrict__ src, bf16_t* __restrict__ dst, int R, int C, int tile, char* smem) {
  float (*t)[65] = (float (*)[65])smem;
  const int nct = C / 64;
  const int tr = tile / nct, tc = tile % nct;
  __syncthreads();
  for (int i = tid_(); i < 4096; i += 256) { int r = i >> 6, c = i & 63; t[r][c] = src[(size_t)(tr * 64 + r) * C + tc * 64 + c]; }
  __syncthreads();
  for (int i = tid_(); i < 4096; i += 256) { int c = i >> 6, r = i & 63; dst[(size_t)(tc * 64 + c) * R + tr * 64 + r] = f2bf(t[r][c]); }
}

DEV void wfold_unit(const P& p, int layer, int unit, char* smem) {
  const int hs = unit >> 5, ec = unit & 31, h = hs >> 1, s = hs & 1;
  const float* wq = p.peer_wq + (size_t)layer * D * 2048;
  const float* kk = (s ? opq(p.peer_k2) : opq(p.peer_k1)) + ((size_t)layer * 8 + h) * 128 * 128;
  float (*kS)[65] = (float (*)[65])smem;
  float (*wS)[64] = (float (*)[64])(smem + 33280);
  const int key = tid_() & 127, eh = tid_() >> 7;
  float acc[16];
#pragma unroll
  for (int i = 0; i < 16; ++i) acc[i] = 0.f;
  for (int dh = 0; dh < 2; ++dh) {
    __syncthreads();
    for (int i = tid_(); i < 128 * 64; i += 256) { int k2 = i >> 6, d = i & 63; kS[k2][d] = kk[k2 * 128 + dh * 64 + d]; }
    for (int i = tid_(); i < 32 * 64; i += 256) {
      int e = i >> 6, d = i & 63;
      wS[e][d] = wq[(size_t)(ec * 32 + e) * 2048 + h * 256 + s * 128 + dh * 64 + d];
    }
    __syncthreads();
#pragma unroll 2
    for (int d = 0; d < 64; ++d) {
      float kv = kS[key][d];
#pragma unroll
      for (int i = 0; i < 16; ++i) acc[i] += kv * wS[eh * 16 + i][d];
    }
  }
  bf16_t* dst = p.Wft + ((size_t)(hs * 128 + key)) * D + ec * 32 + eh * 16;
#pragma unroll
  for (int i = 0; i < 16; i += 2) *(unsigned*)(dst + i) = pack2(acc[i], acc[i + 1]);
}

DEV void filt_unit(const P& p, int layer, int unit, char* smem) {
  int kind, j0, L;
  if (unit < 1024) { kind = 0; j0 = unit * 4; L = T; } else { kind = 1; j0 = (unit - 1024) * 4; L = LC; }
  float* zs = (float*)smem;
  float* h1 = zs + 4 * 36;
  float* h2 = h1 + 256;
  const int jj = tid_() >> 6, o = tid_() & 63;
  const int j = j0 + jj;
  const float fj = (float)j;
  const float t = fj / (float)(L - 1);
  __syncthreads();
  if (o < 33) {
    float z;
    if (o == 0) z = t;
    else {
      int i = (o - 1) & 15;
      float band = 1e-4f + (float)i * ((15.0f - 1e-4f) / 15.0f);
      float ang = 6.283185307179586f * fj * band / (float)L;
      z = (o <= 16) ? cosf(ang) : -sinf(ang);
    }
    zs[jj * 36 + o] = z;
  }
  __syncthreads();
  {
    const float* w1 = p.hy_w1 + layer * 33 * 64;
    float a = p.hy_b1[layer * 64 + o];
#pragma unroll 3
    for (int i = 0; i < 33; ++i) a += zs[jj * 36 + i] * w1[i * 64 + o];
    h1[jj * 64 + o] = sinf(p.hy_freq[layer * 128 + o] * a);
  }
  __syncthreads();
  {
    const float* w2 = p.hy_w2 + layer * 64 * 64;
    float a = p.hy_b2[layer * 64 + o];
#pragma unroll 4
    for (int i = 0; i < 64; ++i) a += h1[jj * 64 + i] * w2[i * 64 + o];
    h2[jj * 64 + o] = sinf(p.hy_freq[layer * 128 + 64 + o] * a);
  }
  __syncthreads();
  const float* w3 = p.hy_w3 + layer * 64 * 512;
  float* F = kind ? opq(p.FC) : opq(p.FL);
  const float DMIN = -3.0701134573253945f, DMAX = -15.350567286626973f;
#pragma unroll 1
  for (int m = 0; m < 4; ++m) {
    int c = o + 64 * m;
    float af = p.hy_b3[layer * 512 + c], ab = p.hy_b3[layer * 512 + 256 + c];
#pragma unroll 4
    for (int i = 0; i < 64; ++i) { float hv = h2[jj * 64 + i]; af += hv * w3[i * 512 + c]; ab += hv * w3[i * 512 + 256 + c]; }
    float delta = fabsf(DMIN + (float)c * ((DMAX - DMIN) / 255.f));
    float win = expf(-t * delta) + 0.05f;
    af *= win; ab *= win;
    F[((size_t)c * 2 + 0) * L + j] = af;
    F[((size_t)c * 2 + 1) * L + j] = ab;
  }
}

constexpr int PREP_T0 = 672, PREP_T1 = PREP_T0 + 256, PREP_T2 = PREP_T1 + 8, PREP_T3 = PREP_T2 + 8, PREP_T4 = PREP_T3 + 8;
constexpr int PREP_WF = PREP_T4 + 512, PREP_N = PREP_WF + 1088;
DEV void prep_unit(const P& p, int layer, int u, char* smem) {
  if (u < PREP_T0) transpose_unit(p.w_in + (size_t)layer * D * INW, p.W1t, D, INW, u, smem);
  else if (u < PREP_T1) transpose_unit(p.w_out + (size_t)layer * D * D, p.W2t, D, D, u - PREP_T0, smem);
  else if (u < PREP_T3) {
    const int u0 = u - PREP_T1;
    for (int i = tid_(); i < 64 * 256; i += 256) {
      const int np = u0 * 64 + (i >> 8), kp = i & 255;
      const int ps = np & 3, chan = np >> 2, qp = kp >> 6, kk = kp & 63;
      const int is_a = ps & 1, d = ps >> 1;
      float v = 0.f;
      if (qp == (is_a ? 2 + d : d)) v = (is_a ? opq(p.rw_a_up) : opq(p.rw_w_up))[(((size_t)layer * 2 + d) * 64 + kk) * 256 + chan];
      p.Wlt[(size_t)np * 256 + kp] = f2bf(v);
    }
  }
  else if (u < PREP_T4) transpose_unit(p.rw_g_up + (size_t)layer * 128 * 256, p.Wgt, 128, 256, u - PREP_T3, smem);
  else if (u < PREP_WF) wfold_unit(p, layer, u - PREP_T4, smem);
  else filt_unit(p, layer, u - PREP_WF, smem);
}
constexpr int PREPA_N = PREP_T0 + (PREP_T4 - PREP_T1);
DEV int prepA_unit_index(int i) { return i < PREP_T0 ? i : PREP_T1 + (i - PREP_T0); }
DEV void ph_prep(const P& p, int layer, char* smem, bool onlyB) {
  for (int u = bid_(); u < PREP_N; u += gridDim.x) {
    const bool isA = (u < PREP_T0) || (u >= PREP_T1 && u < PREP_T4);
    if (onlyB && isA) continue;
    prep_unit(p, layer, u, smem);
  }
}

DEV void wave_range(int& r0, int& r1, int ntok) {
  const int gw = (bid_() * 256 + tid_()) >> 6, nw = gridDim.x * 4;
  const int per = (ntok + nw - 1) / nw;
  r0 = gw * per; r1 = r0 + per; if (r1 > ntok) r1 = ntok;
}
DEV void ph_norm(const P& p, int layer, int which) {
  const int lane = tid_() & 63;
  int r0, r1;
  wave_range(r0, r1, NTOK);
  const float* g = (which ? p.norm2_g : p.norm1_g) + layer * D;
  float gv[16], scv[16], shv[16];
#pragma unroll
  for (int hh = 0; hh < 2; ++hh)
#pragma unroll
    for (int i = 0; i < 8; ++i) gv[hh * 8 + i] = g[hh * 512 + 8 * lane + i];
  int mr_cur = -1;
  uint4 n0 = make_uint4(0, 0, 0, 0), n1 = n0;
  if (r0 < r1) { const bf16_t* xr = p.X + (size_t)r0 * D; n0 = *(const uint4*)(xr + 8 * lane); n1 = *(const uint4*)(xr + 512 + 8 * lane); }
#pragma unroll 1
  for (int row = r0; row < r1; ++row) {
    const uint4 u0 = n0, u1 = n1;
    if (row + 1 < r1) { const bf16_t* xr = p.X + (size_t)(row + 1) * D; n0 = *(const uint4*)(xr + 8 * lane); n1 = *(const uint4*)(xr + 512 + 8 * lane); }
    const int b = row / LT, pp = row % LT;
    const int mr = pp < LC ? 16 : b;
    if (mr != mr_cur) {
      mr_cur = mr;
      const float* mv = p.modv + ((size_t)layer * 17 + mr) * 6144 + (which ? 3072 : 0);
#pragma unroll
      for (int hh = 0; hh < 2; ++hh)
#pragma unroll
        for (int i = 0; i < 8; ++i) { shv[hh * 8 + i] = mv[hh * 512 + 8 * lane + i]; scv[hh * 8 + i] = 1.f + mv[1024 + hh * 512 + 8 * lane + i]; }
    }
    float v[16];
    unpack8(u0, v); unpack8(u1, v + 8);
    float ss = 0.f;
#pragma unroll
    for (int i = 0; i < 16; ++i) ss += v[i] * v[i];
    ss = wave_sum(ss);
    const float rstd = rsqrtf(ss * (1.f / 1024.f) + 1e-6f);
    float o[16];
#pragma unroll
    for (int i = 0; i < 16; ++i) o[i] = (v[i] * rstd * gv[i]) * scv[i] + shv[i];
    bf16_t* hr = p.H + (size_t)row * D;
    *(uint4*)(hr + 8 * lane) = pack8(o);
    *(uint4*)(hr + 512 + 8 * lane) = pack8(o + 8);
    if (which) {
      float am = 0.f;
#pragma unroll
      for (int i = 0; i < 16; ++i) am = fmaxf(am, fabsf(o[i]));
      am = wave_max(am);
      const float sc = am > 0.f ? 127.f / am : 1.f;
      unsigned char* h8 = p.H8 + (size_t)row * 1024;
      *(uint2*)(h8 + 8 * lane) = make_uint2((unsigned)pack_i8(o[0] * sc, o[1] * sc, o[2] * sc, o[3] * sc), (unsigned)pack_i8(o[4] * sc, o[5] * sc, o[6] * sc, o[7] * sc));
      *(uint2*)(h8 + 512 + 8 * lane) = make_uint2((unsigned)pack_i8(o[8] * sc, o[9] * sc, o[10] * sc, o[11] * sc), (unsigned)pack_i8(o[12] * sc, o[13] * sc, o[14] * sc, o[15] * sc));
      if (lane == 0) p.HINV[row] = am > 0.f ? am * (1.f / 127.f) : 1.f;
    }
  }
}

DEV bool gemm_unit(int it, int nct, int& rt, int& ct) {
  const int nslot = gridDim.x >> 3;
  const int x = bid_() & 7, sl = bid_() >> 3;
  if (sl >= nslot) return false;
  const int v = it * nslot + sl;
  if (v >= 68 * nct) return false;
  const int rg = v / (8 * nct), rem = v - rg * 8 * nct;
  const int rows = (rg == 8) ? 4 : 8;
  ct = rem / rows;
  rt = x * 68 + rg * 8 + (rem - ct * rows);
  return true;
}
struct Epi1 {
  const P& p; int row0, col0;
  DEV void operator()(f32x4 (&acc)[4][4], int wr, int wc, int fr, int fq, char* smem) const {
    const int cw = col0 + wc * 64;
    const int rbase = row0 + wr * 64;
    const bool lat = (row0 % LT) >= LC;
    if (cw >= 1536 && cw < 1664) {
#pragma unroll
      for (int m = 0; m < 4; ++m)
#pragma unroll
        for (int n = 0; n < 4; ++n)
#pragma unroll
          for (int j = 0; j < 4; ++j) acc[m][n][j] = tanhf(acc[m][n][j]);
    } else if (cw >= 1792 && cw < 1920) {
#pragma unroll
      for (int m = 0; m < 4; ++m)
#pragma unroll
        for (int n = 0; n < 4; ++n)
#pragma unroll
          for (int j = 0; j < 4; ++j) acc[m][n][j] = sigmoidf_(acc[m][n][j]);
    } else if (cw >= 1920 && cw < 2560 && lat) {
#pragma unroll
      for (int m = 0; m < 4; ++m)
#pragma unroll
        for (int j = 0; j < 4; ++j) {
          int row = rbase + m * 16 + fq * 4 + j;
          int pl = (row % LT) - LC;
          int ri = pl >> 6, ci = pl & 63;
          float2 cr = *(const float2*)(p.rope + 2 * (ri * 16 + fr));
          float2 cc = *(const float2*)(p.rope + 2 * (ci * 16 + fr));
          float x1 = acc[m][0][j], x2 = acc[m][1][j];
          acc[m][0][j] = x1 * cr.x - x2 * cr.y; acc[m][1][j] = x2 * cr.x + x1 * cr.y;
          x1 = acc[m][2][j]; x2 = acc[m][3][j];
          acc[m][2][j] = x1 * cc.x - x2 * cc.y; acc[m][3][j] = x2 * cc.x + x1 * cc.y;
        }
    }
    const int wid = wr * 2 + wc, lane = fq * 16 + fr;
    stage_tile_bf16(acc, smem, wid, fr, fq);
    const bf16_t (*t)[72] = (const bf16_t (*)[72])(smem + wid * 9216);
#pragma unroll
    for (int i = 0; i < 8; ++i) {
      const int rl = i * 8 + (lane >> 3), ch = lane & 7;
      *(uint4*)(p.Z + (size_t)(rbase + rl) * INW + cw + ch * 8) = *(const uint4*)&t[rl][ch * 8];
    }
  }
};
DEV void ph_gemm1(const P& p, char* smem) {
  const int nct = INW / 128;
  int rt, ct;
  for (int it = 0; gemm_unit(it, nct, rt, ct); ++it) {
    Epi1 epi{p, rt * 128, ct * 128};
    gemm_tile(p.H + (size_t)rt * 128 * D, D, p.W1t + (size_t)ct * 128 * D, D, D, smem, epi);
  }
}

struct EpiLoraA {
  const P& p; int layer, row0, col0;
  DEV void operator()(f32x4 (&acc)[4][4], int wr, int wc, int fr, int fq, char* smem) const {
    const int ps = fr & 3, is_a = ps & 1, dd = ps >> 1;
    const float scale = is_a ? 1.f : 0.6065306597126334f;
    const float* bias0 = (is_a ? opq(p.rw_a0) : opq(p.rw_w0)) + (layer * 2 + dd) * 256;
#pragma unroll
    for (int n = 0; n < 4; ++n) {
      const int chan = (col0 + wc * 64 + n * 16 + fr) >> 2;
      const float bias = bias0[chan];
#pragma unroll
      for (int m = 0; m < 4; ++m)
#pragma unroll
        for (int j = 0; j < 4; ++j) acc[m][n][j] = scale * sigmoidf_(acc[m][n][j] + bias);
    }
    const int wid = wr * 2 + wc, lane = fq * 16 + fr;
    stage_tile_bf16(acc, smem, wid, fr, fq);
    const bf16_t (*t)[72] = (const bf16_t (*)[72])(smem + wid * 9216);
#pragma unroll
    for (int i = 0; i < 8; ++i) {
      const int rl = i * 8 + (lane >> 3), ch = lane & 7;
      *(uint4*)(p.SC + (size_t)(row0 + wr * 64 + rl) * 1024 + col0 + wc * 64 + ch * 8) = *(const uint4*)&t[rl][ch * 8];
    }
  }
};
struct EpiLoraG {
  const P& p; int row0, col0;
  DEV void operator()(f32x4 (&acc)[4][4], int wr, int wc, int fr, int fq, char* smem) const {
    const int wid = wr * 2 + wc, lane = fq * 16 + fr;
    stage_tile_bf16(acc, smem, wid, fr, fq);
    const bf16_t (*t)[72] = (const bf16_t (*)[72])(smem + wid * 9216);
#pragma unroll
    for (int i = 0; i < 8; ++i) {
      const int rl = i * 8 + (lane >> 3), ch = lane & 7;
      *(uint4*)(p.Y + (size_t)(row0 + wr * 64 + rl) * D + 256 + col0 + wc * 64 + ch * 8) = *(const uint4*)&t[rl][ch * 8];
    }
  }
};
DEV void ph_lora(const P& p, int layer, char* smem) {
  int rt, ct;
  for (int it = 0; gemm_unit(it, 10, rt, ct); ++it) {
    if (ct < 8) {
      EpiLoraA epi{p, layer, rt * 128, ct * 128};
      gemm_tile(p.Z + (size_t)rt * 128 * INW + 1536, INW, p.Wlt + (size_t)ct * 128 * 256, 256, 256, smem, epi);
    } else {
      EpiLoraG epi{p, rt * 128, (ct - 8) * 128};
      gemm_tile(p.Z + (size_t)rt * 128 * INW + 1792, INW, p.Wgt + (size_t)(ct - 8) * 128 * 128, 128, 128, smem, epi);
    }
  }
}

DEV void ph_rwkv_prep(const P& p, int layer) {
  const int lane = tid_() & 63;
  int r0, r1;
  wave_range(r0, r1, NTOK);
  const float* cw = p.conv_w + (size_t)layer * 3 * 1536;
  const float* cb = p.conv_b + (size_t)layer * 1536;
  float w0[3][4], w1[3][4], w2[3][4], bb[3][4], kkw[4];
#pragma unroll
  for (int a = 0; a < 3; ++a)
#pragma unroll
    for (int i = 0; i < 4; ++i) {
      const int col = 768 + a * 256 + 4 * lane + i;
      w0[a][i] = cw[col]; w1[a][i] = cw[1536 + col]; w2[a][i] = cw[3072 + col]; bb[a][i] = cb[col];
    }
#pragma unroll
  for (int i = 0; i < 4; ++i) kkw[i] = p.rw_k_k[layer * 256 + 4 * lane + i];
  uint2 zm[3], zc[3], zp[3];
  auto ldz = [&](int row, uint2 (&z)[3]) {
#pragma unroll
    for (int a = 0; a < 3; ++a) z[a] = *(const uint2*)(p.Z + (size_t)row * INW + 768 + a * 256 + 4 * lane);
  };
  auto zero3 = [&](uint2 (&z)[3]) {
#pragma unroll
    for (int a = 0; a < 3; ++a) z[a] = make_uint2(0u, 0u);
  };
  if (r0 < r1) {
    if (r0 > 0) ldz(r0 - 1, zm); else zero3(zm);
    ldz(r0, zc);
  }
#pragma unroll 1
  for (int row = r0; row < r1; ++row) {
    if (row + 1 < NTOK) ldz(row + 1, zp); else zero3(zp);
    const int pp = row % LT;
    const bool hasm = (pp != 0) && (pp != LC);
    const bool hasp = (pp != LC - 1) && (pp != LT - 1);
    float res[3][4];
#pragma unroll
    for (int a = 0; a < 3; ++a) {
      const uint2 um = hasm ? zm[a] : make_uint2(0u, 0u), uc = zc[a], up = hasp ? zp[a] : make_uint2(0u, 0u);
      const float vm[4] = {bflo(um.x), bfhi(um.x), bflo(um.y), bfhi(um.y)};
      const float vc[4] = {bflo(uc.x), bfhi(uc.x), bflo(uc.y), bfhi(uc.y)};
      const float vp[4] = {bflo(up.x), bfhi(up.x), bflo(up.y), bfhi(up.y)};
#pragma unroll
      for (int i = 0; i < 4; ++i) res[a][i] = w0[a][i] * vm[i] + w1[a][i] * vc[i] + w2[a][i] * vp[i] + bb[a][i];
    }
    float kk[4], ss = 0.f;
#pragma unroll
    for (int i = 0; i < 4; ++i) { kk[i] = res[1][i] * kkw[i]; ss += kk[i] * kk[i]; }
    ss = row16_sum(ss);
    const float rs = rsqrtf(ss + 1e-12f);
    bf16_t* hr = p.H + (size_t)row * D + 16 * lane;
    *(uint4*)hr = make_uint4(pack2(res[0][0], res[1][0]), pack2(kk[0] * rs, res[2][0]), pack2(res[0][1], res[1][1]), pack2(kk[1] * rs, res[2][1]));
    *(uint4*)(hr + 8) = make_uint4(pack2(res[0][2], res[1][2]), pack2(kk[2] * rs, res[2][2]), pack2(res[0][3], res[1][3]), pack2(kk[3] * rs, res[2][3]));
#pragma unroll
    for (int a = 0; a < 3; ++a) { zm[a] = zc[a]; zc[a] = zp[a]; }
  }
}

DEV float oct_sum(float x) { x += dpp0<0xB1, 0xF>(x); x += dpp0<0x4E, 0xF>(x); x += dpp0<0x141, 0xF>(x); return x; }
DEV bf16x8 frag_join(uint2 lo, uint2 hi) { uint4 w = make_uint4(lo.x, lo.y, hi.x, hi.y); return __builtin_bit_cast(bf16x8, w); }
constexpr int SCS_SET = 16640, SCS_IMG = 3 * SCS_SET, SCS_W0 = SCS_IMG + 2 * 3072;
DEV void scanc_unit(const P& p, int layer, int unit, char* smem) {
  const int dir = unit & 1, h = (unit >> 1) & 3, b = unit >> 3;
  const int tid = tid_(), lane = tid & 63, fr = lane & 15, fq = lane >> 4;
  const int w = __builtin_amdgcn_readfirstlane(tid >> 6);
  bf16_t* IMG0 = (bf16_t*)(smem + SCS_W0);
  bf16_t* IMG1 = IMG0 + 512;
  bf16_t* IMG2 = IMG0 + 1024;
  __syncthreads();
  for (int i = tid; i < (2 * 3072 + 3072) / 4; i += 256) ((unsigned*)(smem + SCS_IMG))[i] = 0u;
  const float ka = p.rw_k_a[layer * 256 + h * 64 + lane];
  const size_t rowbase = (size_t)b * LT;
  const char* hbase = (const char*)p.H;
  const char* sbase = (const char*)p.SC;
  const unsigned hoff = (unsigned)(rowbase * 2048) + (unsigned)((h * 64 + lane) * 8);
  const unsigned soff = hoff + 4u * (unsigned)dir;
  bf16_t* yb = p.Z + rowbase * INW + 768 + dir * 256 + h * 64 + w * 16 + fr;
  auto pos0 = [&](int c) -> int { const int t = c * 16; return dir == 0 ? t : (t < LC ? LC - 1 - t : LT - 1 - (t - LC)); };
  const int pstep = dir == 0 ? 1 : -1;
  constexpr int NCH = LT / 16;
  struct Raw { unsigned sc[16]; uint2 hr[6]; };
  auto load_raw = [&](int c, Raw& rw) {
    if (w != 0) {
      const int p0 = pos0(c);
      const unsigned so = soff + (unsigned)(p0 * 2048);
      const int st = pstep * 2048;
#pragma unroll
      for (int i = 0; i < 16; ++i) rw.sc[i] = *(const unsigned*)(sbase + (so + (unsigned)(i * st)));
      const unsigned ho = hoff + (unsigned)((p0 + pstep * (w - 1)) * 2048);
#pragma unroll
      for (int q = 0; q < 6; ++q) {
        const int qq = ((w - 1) + 3 * q < 16) ? q : 4;
        rw.hr[q] = *(const uint2*)(hbase + (ho + (unsigned)(qq * 3 * st)));
      }
    }
  };
  auto stage1w = [&](int set, const Raw& rw, auto W1tag) {
    constexpr int W1 = decltype(W1tag)::value;
    char* base = smem + set * SCS_SET;
    bf16_t (*At)[72] = (bf16_t (*)[72])(base);
    bf16_t (*Rt)[72] = (bf16_t (*)[72])(base + 2304);
    bf16_t (*Bt)[72] = (bf16_t (*)[72])(base + 4608);
    bf16_t (*Kt)[72] = (bf16_t (*)[72])(base + 6912);
    bf16_t (*BKT)[40] = (bf16_t (*)[40])(base + 9216);
    bf16_t (*VV)[16] = (bf16_t (*)[16])(base + 14336);
    float* G16 = (float*)(base + 16384);
    float Erun = 0.f;
#pragma unroll
    for (int i = 0; i < 16; ++i) {
      const float ev = bflo(rw.sc[i]);
      const float Eprev = Erun;
      Erun += ev;
      if ((i % 3) == W1) {
        const uint2 hrec = rw.hr[i / 3];
        const float rr = bflo(hrec.x), kr = bfhi(hrec.x), kkv = bflo(hrec.y);
        const float av = bfhi(rw.sc[i]);
        const float gp = __expf(-Eprev), gi = __expf(-Erun), ig = __expf(Erun);
        const float at = -kkv * gp, rt = rr * gi, bt = kkv * av * ig, kt2 = kr * (1.f + (av - 1.f) * ka) * ig;
        const unsigned ar = pack2(at, rt), bk = pack2(bt, kt2);
        At[i][lane] = (bf16_t)(ar & 0xFFFFu); Rt[i][lane] = (bf16_t)(ar >> 16);
        Bt[i][lane] = (bf16_t)(bk & 0xFFFFu); Kt[i][lane] = (bf16_t)(bk >> 16);
        BKT[lane][(i >> 2) * 8 + (i & 3)] = (bf16_t)(bk & 0xFFFFu);
        BKT[lane][(i >> 2) * 8 + 4 + (i & 3)] = (bf16_t)(bk >> 16);
        VV[lane][(i >> 2) * 4 + (i & 3)] = (bf16_t)(hrec.y >> 16);
        if (i == 15) G16[lane] = gi;
      }
    }
  };
  auto stage1 = [&](int set, const Raw& rw) {
    if (w == 1) stage1w(set, rw, std::integral_constant<int, 0>{});
    else if (w == 2) stage1w(set, rw, std::integral_constant<int, 1>{});
    else if (w == 3) stage1w(set, rw, std::integral_constant<int, 2>{});
  };
  auto stage2 = [&](int set, int iset) {
    char* base = smem + set * SCS_SET;
    const bf16_t (*At)[72] = (const bf16_t (*)[72])(base);
    const bf16_t (*Rt)[72] = (const bf16_t (*)[72])(base + 2304);
    const bf16_t (*Bt)[72] = (const bf16_t (*)[72])(base + 4608);
    const bf16_t (*Kt)[72] = (const bf16_t (*)[72])(base + 6912);
    bf16_t* TT = (bf16_t*)(smem + SCS_IMG + iset * 3072);
    bf16_t* ARK = TT + 512;
    bf16_t* AAK = TT + 1024;
    const bf16_t (*X)[72] = (w < 2) ? At : Rt;
    const bf16_t (*Y)[72] = (w & 1) ? Kt : Bt;
    f32x4 cm = (f32x4){0.f, 0.f, 0.f, 0.f};
#pragma unroll
    for (int s = 0; s < 2; ++s) {
      bf16x8 af = *(const bf16x8*)&X[fr][32 * s + 8 * fq];
      bf16x8 bm = *(const bf16x8*)&Y[fr][32 * s + 8 * fq];
      cm = mfma16(af, bm, cm);
    }
#pragma unroll
    for (int jj = 0; jj < 4; ++jj) {
      const int i = 4 * fq + jj;
      const bool keep = (w < 2) ? (fr < i) : (fr <= i);
      cm[jj] = keep ? cm[jj] : 0.f;
    }
    const int io = (fr >> 2) * 8 + (fr & 3);
    auto wr_img = [&](bf16_t* img, const f32x4& Xv, int hi) {
#pragma unroll
      for (int jj = 0; jj < 4; ++jj) img[(4 * fq + jj) * 32 + io + hi] = f2bf(Xv[jj]);
    };
    if (w == 1) wr_img(AAK, cm, 0);
    else if (w == 2) wr_img(ARK, cm, 0);
    else if (w == 3) wr_img(ARK, cm, 4);
    else {
      auto bfrag = [&](const f32x4& Xv) { return frag_join(make_uint2(pack2(Xv[0], Xv[1]), pack2(Xv[2], Xv[3])), make_uint2(0u, 0u)); };
      auto afr = [&](const bf16_t* img) { return *(const bf16x8*)&img[(fr * 4 + fq) * 8]; };
      const f32x4 Z4 = (f32x4){0.f, 0.f, 0.f, 0.f};
      wr_img(IMG0, cm, 0);
      asm volatile("" ::: "memory");
      f32x4 A2 = mfma16(afr(IMG0), bfrag(cm), Z4);
      wr_img(IMG1, A2, 0);
      asm volatile("" ::: "memory");
      f32x4 A4 = mfma16(afr(IMG1), bfrag(A2), Z4);
      wr_img(IMG2, A4, 0);
      asm volatile("" ::: "memory");
      f32x4 Rm = mfma16(afr(IMG2), bfrag(A4), Z4);
#pragma unroll
      for (int jj = 0; jj < 4; ++jj) Rm[jj] += (fr == 4 * fq + jj) ? 1.f : 0.f;
      Rm = mfma16(afr(IMG2), bfrag(Rm), Rm);
      Rm = mfma16(afr(IMG1), bfrag(Rm), Rm);
      Rm = mfma16(afr(IMG0), bfrag(Rm), Rm);
      wr_img(TT, Rm, 0);
    }
  };
  f32x4 acc[4];
#pragma unroll
  for (int kt = 0; kt < 4; ++kt) acc[kt] = (f32x4){0.f, 0.f, 0.f, 0.f};
  auto part2 = [&](int c, int set, int iset) {
    char* base = smem + set * SCS_SET;
    const bf16_t (*At)[72] = (const bf16_t (*)[72])(base);
    const bf16_t (*Rt)[72] = (const bf16_t (*)[72])(base + 2304);
    const bf16_t (*BKT)[40] = (const bf16_t (*)[40])(base + 9216);
    const bf16_t (*VV)[16] = (const bf16_t (*)[16])(base + 14336);
    const float* G16 = (const float*)(base + 16384);
    const bf16_t* TT = (const bf16_t*)(smem + SCS_IMG + iset * 3072);
    const bf16_t* ARK = TT + 512;
    const bf16_t* AAK = TT + 1024;
    bf16x8 Sb[2];
#pragma unroll
    for (int s = 0; s < 2; ++s) {
      uint4 t = make_uint4(pack2(acc[2 * s][0], acc[2 * s][1]), pack2(acc[2 * s][2], acc[2 * s][3]),
                           pack2(acc[2 * s + 1][0], acc[2 * s + 1][1]), pack2(acc[2 * s + 1][2], acc[2 * s + 1][3]));
      Sb[s] = __builtin_bit_cast(bf16x8, t);
    }
    const uint2 vv = *(const uint2*)&VV[w * 16 + fr][fq * 4];
    const bf16x8 Vlow = frag_join(vv, make_uint2(0u, 0u));
    f32x4 Pm = (f32x4){0.f, 0.f, 0.f, 0.f};
#pragma unroll
    for (int s = 0; s < 2; ++s) {
      bf16x8 af = frag_join(*(const uint2*)&At[fr][32 * s + 4 * fq], *(const uint2*)&At[fr][32 * s + 16 + 4 * fq]);
      Pm = mfma16(af, Sb[s], Pm);
    }
    Pm = mfma16(*(const bf16x8*)&AAK[(fr * 4 + fq) * 8], Vlow, Pm);
    const bf16x8 Pb = frag_join(make_uint2(pack2(Pm[0], Pm[1]), pack2(Pm[2], Pm[3])), make_uint2(0u, 0u));
    f32x4 U = mfma16(*(const bf16x8*)&TT[(fr * 4 + fq) * 8], Pb, (f32x4){0.f, 0.f, 0.f, 0.f});
    const bf16x8 UV = frag_join(make_uint2(pack2(U[0], U[1]), pack2(U[2], U[3])), vv);
    f32x4 Yv = (f32x4){0.f, 0.f, 0.f, 0.f};
#pragma unroll
    for (int s = 0; s < 2; ++s) {
      bf16x8 af = frag_join(*(const uint2*)&Rt[fr][32 * s + 4 * fq], *(const uint2*)&Rt[fr][32 * s + 16 + 4 * fq]);
      Yv = mfma16(af, Sb[s], Yv);
    }
    Yv = mfma16(*(const bf16x8*)&ARK[(fr * 4 + fq) * 8], UV, Yv);
    {
      const int p0 = pos0(c);
#pragma unroll
      for (int jj = 0; jj < 4; ++jj) yb[(size_t)(p0 + pstep * (4 * fq + jj)) * INW] = f2bf(Yv[jj]);
    }
#pragma unroll
    for (int kt = 0; kt < 4; ++kt) {
      f32x4 t = mfma16(*(const bf16x8*)&BKT[16 * kt + fr][fq * 8], UV, acc[kt]);
      const float4 g4 = *(const float4*)&G16[16 * kt + 4 * fq];
      t[0] *= g4.x; t[1] *= g4.y; t[2] *= g4.z; t[3] *= g4.w;
      acc[kt] = t;
    }
  };
  __builtin_amdgcn_s_setprio(3);
  Raw r0, r1;
  load_raw(0, r0); load_raw(1, r1);
  stage1(0, r0);
  load_raw(2, r0);
  __syncthreads();
  stage2(0, 0);
  stage1(1, r1);
  load_raw(3, r1);
  __syncthreads();
  int s0 = 0, s1 = 1, s2 = 2;
  auto iter = [&](int c, Raw& rw) {
    if (c + 1 < NCH) stage2(s1, (c + 1) & 1);
    part2(c, s0, c & 1);
    if (c + 2 < NCH) {
      stage1(s2, rw);
      if (c + 4 < NCH) load_raw(c + 4, rw);
    }
    asm volatile("s_waitcnt lgkmcnt(0)" ::: "memory");
    __builtin_amdgcn_s_barrier();
    asm volatile("" ::: "memory");
    const int t = s0; s0 = s1; s1 = s2; s2 = t;
  };
#pragma unroll 1
  for (int c = 0; c < NCH; c += 2) {
    iter(c, r0); iter(c + 1, r1);
  }
  __builtin_amdgcn_s_setprio(0);
}

DEV void ph_rwkv_post(const P& p, int layer) {
  const int lane = tid_() & 63;
  int r0, r1;
  wave_range(r0, r1, NTOK);
  const int ch = 4 * lane;
  float kav[4], rkv[4], lnw[4], lnb[4];
#pragma unroll
  for (int i = 0; i < 4; ++i) {
    kav[i] = p.rw_k_a[layer * 256 + ch + i]; rkv[i] = p.rw_r_k[layer * 256 + ch + i];
    lnw[i] = p.rw_ln_w[layer * 256 + ch + i]; lnb[i] = p.rw_ln_b[layer * 256 + ch + i];
  }
  struct In { uint2 y0, y1, g; uint4 h0, h1, s0, s1; };
  auto ld = [&](int row, In& in) {
    const bf16_t* zr = p.Z + (size_t)row * INW + 768 + ch;
    in.y0 = *(const uint2*)zr; in.y1 = *(const uint2*)(zr + 256);
    const bf16_t* hr = p.H + (size_t)row * D + 4 * ch;
    in.h0 = *(const uint4*)hr; in.h1 = *(const uint4*)(hr + 8);
    const bf16_t* sr = p.SC + (size_t)row * 1024 + 4 * ch;
    in.s0 = *(const uint4*)sr; in.s1 = *(const uint4*)(sr + 8);
    in.g = *(const uint2*)(p.Y + (size_t)row * D + 256 + ch);
  };
  In nx;
  if (r0 < r1) ld(r0, nx);
#pragma unroll 1
  for (int row = r0; row < r1; ++row) {
    const In in = nx;
    if (row + 1 < r1) ld(row + 1, nx);
    float y[4] = {bflo(in.y0.x) + bflo(in.y1.x), bfhi(in.y0.x) + bfhi(in.y1.x), bflo(in.y0.y) + bflo(in.y1.y), bfhi(in.y0.y) + bfhi(in.y1.y)};
    const float mu = row16_sum(y[0] + y[1] + y[2] + y[3]) * (1.f / 64.f);
    float vs = 0.f;
#pragma unroll
    for (int i = 0; i < 4; ++i) { y[i] -= mu; vs += y[i] * y[i]; }
    const float var = row16_sum(vs) * (1.f / 64.f);
    const float rstd = rsqrtf(var + 64e-5f);
    const float r[4] = {bflo(in.h0.x), bflo(in.h0.z), bflo(in.h1.x), bflo(in.h1.z)};
    const float k[4] = {bfhi(in.h0.x), bfhi(in.h0.z), bfhi(in.h1.x), bfhi(in.h1.z)};
    const float v[4] = {bfhi(in.h0.y), bfhi(in.h0.w), bfhi(in.h1.y), bfhi(in.h1.w)};
    const float a0[4] = {bfhi(in.s0.x), bfhi(in.s0.z), bfhi(in.s1.x), bfhi(in.s1.z)};
    const float a1[4] = {bfhi(in.s0.y), bfhi(in.s0.w), bfhi(in.s1.y), bfhi(in.s1.w)};
    float sd = 0.f;
#pragma unroll
    for (int i = 0; i < 4; ++i) {
      const float kd0 = k[i] * (1.f + (a0[i] - 1.f) * kav[i]), kd1 = k[i] * (1.f + (a1[i] - 1.f) * kav[i]);
      sd += r[i] * (kd0 + kd1) * rkv[i];
    }
    sd = row16_sum(sd);
    const float g[4] = {bflo(in.g.x), bfhi(in.g.x), bflo(in.g.y), bfhi(in.g.y)};
    float o[4];
#pragma unroll
    for (int i = 0; i < 4; ++i) {
      const float yn = y[i] * rstd * lnw[i] + lnb[i];
      o[i] = (yn + sd * v[i]) * g[i];
#if !EN_RW
      o[i] = 0.f;
#endif
    }
    *(uint2*)(p.Y + (size_t)row * D + 256 + ch) = make_uint2(pack2(o[0], o[1]), pack2(o[2], o[3]));
  }
}

DEV void hyena_pre_unit(const P& p, int layer, int unit) {
  int kind, b, t0, L;
  if (unit < 1024) { kind = 0; b = unit >> 6; t0 = (unit & 63) * 64; L = T; } else { int u = unit - 1024; kind = 1; b = u >> 2; t0 = (u & 3) * 64; L = LC; }
  const int c = tid_();
  const size_t row0 = (size_t)b * LT + (kind ? 0 : LC);
  const float* cw = p.conv_w + (size_t)layer * 3 * 1536;
  const float* cb = p.conv_b + (size_t)layer * 1536;
  const float w1a = cw[256 + c], w1b = cw[1536 + 256 + c], w1c = cw[3072 + 256 + c], b1 = cb[256 + c];
  const float w2a = cw[512 + c], w2b = cw[1536 + 512 + c], w2c = cw[3072 + 512 + c], b2 = cb[512 + c];
  auto ld = [&](int t, int col) -> float { return (t >= 0 && t < L) ? bf2f(p.Z[(row0 + t) * INW + col]) : 0.f; };
  float x1m = ld(t0 - 1, 256 + c), x1c = ld(t0, 256 + c), vm = ld(t0 - 1, 512 + c), vc = ld(t0, 512 + c);
  bf16_t* dst = (kind ? opq(p.UTc) : opq(p.UTl)) + ((size_t)c * 16 + b) * L + t0;
#pragma unroll 1
  for (int i8 = 0; i8 < 8; ++i8) {
    float uo[8];
#pragma unroll
    for (int i = 0; i < 8; ++i) {
      int t = t0 + i8 * 8 + i;
      float x1n = ld(t + 1, 256 + c), vn = ld(t + 1, 512 + c);
      float a = w1a * x1m + w1b * x1c + w1c * x1n + b1;
      float bb = w2a * vm + w2b * vc + w2c * vn + b2;
      uo[i] = a * bb;
      x1m = x1c; x1c = x1n; vm = vc; vc = vn;
    }
    *(uint4*)(dst + 8 * i8) = pack8(uo);
  }
}

DEV void hyena_conv_unit(const P& p, int layer, int unit, char* smem) {
  int kind, c, tb, L;
  if (unit < 4096) { kind = 0; c = unit >> 4; tb = (unit & 15) * 256; L = T; } else { kind = 1; c = unit - 4096; tb = 0; L = LC; }
  const int tid = tid_(), lane = tid & 63, wid = tid >> 6, fr = lane & 15, fq = lane >> 4;
  float* red = (float*)(smem + 2 * 16512);
  const float* F = (kind ? opq(p.FC) : opq(p.FL)) + (size_t)c * 2 * L;
  float scale;
  {
    float part = 0.f;
    for (int i = tid; i < 2 * L; i += 256) { float fv = F[i]; part += (i != L) ? fv * fv : 0.f; }
    part = wave_sum(part);
    __syncthreads();
    if (lane == 0) red[wid] = part;
    __syncthreads();
    scale = rsqrtf(((red[0] + red[1]) + (red[2] + red[3])) + 1e-6f);
  }
  const bf16_t* U = (kind ? opq(p.UTc) : opq(p.UTl)) + (size_t)c * 16 * L;
  f32x4 acc[4];
#pragma unroll
  for (int m = 0; m < 4; ++m) acc[m] = (f32x4){0.f, 0.f, 0.f, 0.f};
  const int nch = L / 256;
  float fw0, fw1, fw2;
  uint4 ru0, ru1;
  auto ldchunk = [&](int ch) {
    const int sc = ch * 256;
    const int D0 = tb + 256 - sc;
    auto tap = [&](int n) -> float {
      int d = D0 - n;
      float v = 0.f;
      if (d > -L && d < L) v = (d >= 0 ? F[d] : F[L - d]);
      return v;
    };
    fw0 = tap(tid); fw1 = tap(tid + 256); fw2 = (tid < 8) ? tap(tid + 512) : 0.f;
    const int bb = tid >> 4, sg0 = tid & 15;
    ru0 = *(const uint4*)(U + (size_t)bb * L + sc + 8 * sg0);
    ru1 = *(const uint4*)(U + (size_t)bb * L + sc + 8 * (sg0 + 16));
  };
  auto stchunk = [&](int buf) {
    bf16_t* Cq = (bf16_t*)(smem + buf * 16512);
    bf16_t* Us = (bf16_t*)(smem + buf * 16512 + 8320);
    const bf16_t h0 = f2bf(fw0 * scale), h1 = f2bf(fw1 * scale), h2 = f2bf(fw2 * scale);
#pragma unroll
    for (int rho = 0; rho < 8; ++rho) {
      int m = tid + rho;
      Cq[((m >> 3) * 8 + rho) * 8 + (m & 7)] = h0;
      m = tid + 256 + rho;
      if (m < 520) Cq[((m >> 3) * 8 + rho) * 8 + (m & 7)] = h1;
      m = tid + 512 + rho;
      if (tid < 8 && m < 520) Cq[((m >> 3) * 8 + rho) * 8 + (m & 7)] = h2;
    }
    if (tid < 8) {
#pragma unroll
      for (int rho = 1; rho < 8; ++rho) if (tid < rho) Cq[(rho) * 8 + tid] = 0;
    }
    const int bb = tid >> 4, sg0 = tid & 15;
    *(uint4*)&Us[(sg0 * 16 + bb) * 8] = ru0;
    *(uint4*)&Us[((sg0 + 16) * 16 + bb) * 8] = ru1;
  };
  ldchunk(0);
#pragma unroll 1
  for (int ch = 0; ch < nch; ++ch) {
    const int buf = ch & 1;
    stchunk(buf);
    __syncthreads();
    if (ch + 1 < nch) ldchunk(ch + 1);
    const bf16_t* Cq = (const bf16_t*)(smem + buf * 16512);
    const bf16_t* Us = (const bf16_t*)(smem + buf * 16512 + 8320);
#pragma unroll
    for (int kk = 0; kk < 8; ++kk) {
      bf16x8 bf = *(const bf16x8*)&Us[((4 * kk + fq) * 16 + fr) * 8];
#pragma unroll
      for (int m = 0; m < 4; ++m) {
        int it = wid * 4 + m;
        int base = 256 - 16 * it + 32 * kk + 8 * fq;
        int m0 = base - 8 * (fr >> 3);
        bf16x8 af = *(const bf16x8*)&Cq[((m0 >> 3) * 8 + (fr & 7)) * 8];
        acc[m] = mfma16(af, bf, acc[m]);
      }
    }
  }
  __syncthreads();
  bf16_t* Yt = (kind ? opq(p.YTc) : opq(p.YTl)) + ((size_t)c * 16 + fr) * L + tb;
#pragma unroll
  for (int m = 0; m < 4; ++m) {
    int t = (wid * 4 + m) * 16 + fq * 4;
    *(uint2*)(Yt + t) = make_uint2(pack2(acc[m][0], acc[m][1]), pack2(acc[m][2], acc[m][3]));
  }
}

DEV void hyena_post_unit(const P& p, int layer, int unit, char* smem) {
  int kind, b, t0, L;
  if (unit < 1024) { kind = 0; b = unit >> 6; t0 = (unit & 63) * 64; L = T; } else { int u = unit - 1024; kind = 1; b = u >> 2; t0 = (u & 3) * 64; L = LC; }
  const int c = tid_(), lane = c & 63, wid = c >> 6;
  const size_t row0 = (size_t)b * LT + (kind ? 0 : LC);
  bf16_t (*tile)[264] = (bf16_t (*)[264])smem;
  const float* cw = p.conv_w + (size_t)layer * 3 * 1536;
  const float wa = cw[c], wb = cw[1536 + c], wcc = cw[3072 + c], b0 = p.conv_b[layer * 1536 + c];
  const float bias = p.hy_bias[layer * 256 + c];
  const bf16_t* yt = (kind ? opq(p.YTc) : opq(p.YTl)) + ((size_t)c * 16 + b) * L + t0;
  const bf16_t* ut = (kind ? opq(p.UTc) : opq(p.UTl)) + ((size_t)c * 16 + b) * L + t0;
  auto ld = [&](int t) -> float { return (t >= 0 && t < L) ? bf2f(p.Z[(row0 + t) * INW + c]) : 0.f; };
  float xm = ld(t0 - 1), xc = ld(t0);
  __syncthreads();
#pragma unroll 1
  for (int i8 = 0; i8 < 8; ++i8) {
    uint4 yu = *(const uint4*)(yt + 8 * i8), uu = *(const uint4*)(ut + 8 * i8);
    float yv[8], uv[8];
    unpack8(yu, yv); unpack8(uu, uv);
#pragma unroll
    for (int i = 0; i < 8; ++i) {
      int t = t0 + i8 * 8 + i;
      float xn = ld(t + 1);
      float x0 = wa * xm + wb * xc + wcc * xn + b0;
      float o = x0 * (yv[i] + uv[i] * bias);
      tile[i8 * 8 + i][c] = f2bf(o);
      xm = xc; xc = xn;
    }
  }
  __syncthreads();
  for (int i = 0; i < 16; ++i) {
    int tl = wid * 16 + i;
    uint2 ou = *(const uint2*)&tile[tl][4 * lane];
    float o[4] = {bflo(ou.x), bfhi(ou.x), bflo(ou.y), bfhi(ou.y)};
    float ss = wave_sum(o[0] * o[0] + o[1] * o[1] + o[2] * o[2] + o[3] * o[3]);
    float rstd = rsqrtf(ss * (1.f / 256.f) + 1e-6f);
#pragma unroll
    for (int q = 0; q < 4; ++q) {
      o[q] = o[q] * rstd * p.hy_out_g[layer * 256 + 4 * lane + q];
#if !EN_HY
      o[q] = 0.f;
#endif
    }
    *(uint2*)(p.Y + (row0 + t0 + tl) * D + 4 * lane) = make_uint2(pack2(o[0], o[1]), pack2(o[2], o[3]));
  }
}

DEV void attn_unit(const P& p, int layer, int unit, char* smem) {
  const bool isctx = unit >= 4096;
  int b, qb, hq;
  if (!isctx) { b = unit >> 8; qb = (unit >> 3) & 31; hq = unit & 7; } else { int u = unit - 4096; b = u >> 4; qb = (u >> 3) & 1; hq = u & 7; }
  const int g = hq >> 2;
  const int tid = tid_(), lane = tid & 63, wid = tid >> 6, qn = lane & 31, hh = lane >> 5;
  const int qpos = qb * 128 + wid * 32 + qn;
  const size_t qrow = (size_t)b * LT + (isctx ? qpos : LC + qpos);
  const bf16_t* qptr = p.Z + qrow * INW + 1920 + hq * 64;
  bf16x8 qf[4];
#pragma unroll
  for (int s = 0; s < 4; ++s) qf[s] = *(const bf16x8*)(qptr + 16 * s + 8 * hh);
  const float sink = p.attn_sink[layer * 8 + hq];
  float m_run = sink, l_run = 1.f;
  f32x16 o0, o1;
#pragma unroll
  for (int i = 0; i < 16; ++i) { o0[i] = 0.f; o1[i] = 0.f; }
  typedef bf16_t KTile[64][72];
  KTile* Ks = (KTile*)smem;
  KTile* Vt = (KTile*)(smem + 18432);
  const int ntl = isctx ? 0 : 6;
  const int ntiles = ntl + 4;
  const int skey = tid >> 3, sseg = tid & 7;
  const bf16_t* kvbase = p.Z + (size_t)b * LT * INW + 1920 + 512 + g * 64 + sseg * 8;
  uint4 rk0, rk1, rv0, rv1;
  auto ldtile = [&](int kt) {
    const bool ctxk = kt >= ntl;
    const int kbase = ctxk ? (kt - ntl) * 64 : qb * 128 - 128 + kt * 64;
    const int kp0 = kbase + skey, kp1 = kp0 + 32;
    rk0 = rk1 = rv0 = rv1 = make_uint4(0, 0, 0, 0);
    if (ctxk || (kp0 >= 0 && kp0 < T)) { const bf16_t* src = kvbase + (size_t)(ctxk ? kp0 : LC + kp0) * INW; rk0 = *(const uint4*)src; rv0 = *(const uint4*)(src + 128); }
    if (ctxk || (kp1 >= 0 && kp1 < T)) { const bf16_t* src = kvbase + (size_t)(ctxk ? kp1 : LC + kp1) * INW; rk1 = *(const uint4*)src; rv1 = *(const uint4*)(src + 128); }
  };
  auto sttile = [&](int buf) {
    *(uint4*)&Ks[buf][skey][sseg * 8] = rk0;
    *(uint4*)&Ks[buf][skey + 32][sseg * 8] = rk1;
    bf16_t (*vt)[72] = Vt[buf];
    vt[sseg * 8 + 0][skey] = (bf16_t)(rv0.x & 0xFFFF); vt[sseg * 8 + 1][skey] = (bf16_t)(rv0.x >> 16);
    vt[sseg * 8 + 2][skey] = (bf16_t)(rv0.y & 0xFFFF); vt[sseg * 8 + 3][skey] = (bf16_t)(rv0.y >> 16);
    vt[sseg * 8 + 4][skey] = (bf16_t)(rv0.z & 0xFFFF); vt[sseg * 8 + 5][skey] = (bf16_t)(rv0.z >> 16);
    vt[sseg * 8 + 6][skey] = (bf16_t)(rv0.w & 0xFFFF); vt[sseg * 8 + 7][skey] = (bf16_t)(rv0.w >> 16);
    vt[sseg * 8 + 0][skey + 32] = (bf16_t)(rv1.x & 0xFFFF); vt[sseg * 8 + 1][skey + 32] = (bf16_t)(rv1.x >> 16);
    vt[sseg * 8 + 2][skey + 32] = (bf16_t)(rv1.y & 0xFFFF); vt[sseg * 8 + 3][skey + 32] = (bf16_t)(rv1.y >> 16);
    vt[sseg * 8 + 4][skey + 32] = (bf16_t)(rv1.z & 0xFFFF); vt[sseg * 8 + 5][skey + 32] = (bf16_t)(rv1.z >> 16);
    vt[sseg * 8 + 6][skey + 32] = (bf16_t)(rv1.w & 0xFFFF); vt[sseg * 8 + 7][skey + 32] = (bf16_t)(rv1.w >> 16);
  };
  ldtile(0);
#pragma unroll 1
  for (int kt = 0; kt < ntiles; ++kt) {
    const int buf = kt & 1;
    sttile(buf);
    __syncthreads();
    if (kt + 1 < ntiles) ldtile(kt + 1);
    const bool ctxk = kt >= ntl;
    const int kbase = ctxk ? (kt - ntl) * 64 : qb * 128 - 128 + kt * 64;
#pragma unroll
    for (int sub = 0; sub < 2; ++sub) {
      const int kb2 = kbase + sub * 32;
      bool need = true;
      if (!ctxk) {
        int q0 = qb * 128 + wid * 32;
        if (kb2 + 31 < q0 - 128 || kb2 > q0 + 31 + 128 || kb2 + 31 < 0 || kb2 >= T) need = false;
      }
      if (need) {
        f32x16 sv;
#pragma unroll
        for (int i = 0; i < 16; ++i) sv[i] = 0.f;
#pragma unroll
        for (int ks = 0; ks < 4; ++ks) {
          bf16x8 kf = *(const bf16x8*)&Ks[buf][sub * 32 + qn][16 * ks + 8 * hh];
          sv = mfma32(kf, qf[ks], sv);
        }
        float mt = -3e38f;
#pragma unroll
        for (int rg = 0; rg < 16; ++rg) {
          float v = sv[rg] * 0.125f;
          if (!ctxk) {
            int kp = kb2 + (rg & 3) + 8 * (rg >> 2) + 4 * hh;
            int dl = qpos - kp;
            bool ok = (dl <= 128) && (dl >= -128) && (kp >= 0) && (kp < T);
            v = ok ? v : -1e30f;
          }
          sv[rg] = v;
          mt = fmaxf(mt, v);
        }
        mt = fmaxf(mt, __shfl_xor(mt, 32));
        float m_new = fmaxf(m_run, mt);
        float corr = __expf(m_run - m_new);
        float ps = 0.f;
#pragma unroll
        for (int rg = 0; rg < 16; ++rg) { float pv = __expf(sv[rg] - m_new); sv[rg] = pv; ps += pv; }
        ps += __shfl_xor(ps, 32);
        l_run = l_run * corr + ps;
        m_run = m_new;
#pragma unroll
        for (int i = 0; i < 16; ++i) { o0[i] *= corr; o1[i] *= corr; }
#pragma unroll
        for (int sp = 0; sp < 2; ++sp) {
          bf16x8 pf;
#pragma unroll
          for (int j = 0; j < 8; ++j) pf[j] = (short)f2bf(sv[8 * sp + j]);
          const int kc = sub * 32 + 16 * sp + 4 * hh;
          uint2 va = *(const uint2*)&Vt[buf][qn][kc], vb = *(const uint2*)&Vt[buf][qn][kc + 8];
          uint2 vc = *(const uint2*)&Vt[buf][32 + qn][kc], vd = *(const uint2*)&Vt[buf][32 + qn][kc + 8];
          uint4 w0 = make_uint4(va.x, va.y, vb.x, vb.y), w1 = make_uint4(vc.x, vc.y, vd.x, vd.y);
          bf16x8 v0 = __builtin_bit_cast(bf16x8, w0), v1 = __builtin_bit_cast(bf16x8, w1);
          o0 = mfma32(v0, pf, o0);
          o1 = mfma32(v1, pf, o1);
        }
      }
    }
  }
  __syncthreads();
  const float inv = 1.f / l_run;
  bf16_t* optr = p.Y + qrow * D + 512 + hq * 64;
#pragma unroll
  for (int rg = 0; rg < 4; ++rg) {
    int d0 = 8 * rg + 4 * hh;
    *(uint2*)(optr + d0) = make_uint2(pack2(o0[4 * rg] * inv, o0[4 * rg + 1] * inv), pack2(o0[4 * rg + 2] * inv, o0[4 * rg + 3] * inv));
    *(uint2*)(optr + 32 + d0) = make_uint2(pack2(o1[4 * rg] * inv, o1[4 * rg + 1] * inv), pack2(o1[4 * rg + 2] * inv, o1[4 * rg + 3] * inv));
  }
}

DEV void ph_attn_post(const P& p, int layer) {
  const int lane = tid_() & 63;
  int r0, r1;
  wave_range(r0, r1, NTOK);
  float gv[8];
#pragma unroll
  for (int i = 0; i < 8; ++i) gv[i] = p.at_out_g[layer * 512 + 8 * lane + i];
  uint4 nx = make_uint4(0, 0, 0, 0);
  if (r0 < r1) nx = *(const uint4*)(p.Y + (size_t)r0 * D + 512 + 8 * lane);
#pragma unroll 1
  for (int row = r0; row < r1; ++row) {
    const uint4 u = nx;
    if (row + 1 < r1) nx = *(const uint4*)(p.Y + (size_t)(row + 1) * D + 512 + 8 * lane);
    float v[8];
    unpack8(u, v);
    float ss = 0.f;
#pragma unroll
    for (int i = 0; i < 8; ++i) ss += v[i] * v[i];
    ss = wave_sum(ss);
    const float rstd = rsqrtf(ss * (1.f / 512.f) + 1e-6f);
#pragma unroll
    for (int i = 0; i < 8; ++i) {
      v[i] = v[i] * rstd * gv[i];
#if !EN_AT
      v[i] = 0.f;
#endif
    }
    *(uint4*)(p.Y + (size_t)row * D + 512 + 8 * lane) = pack8(v);
  }
}

struct Epi2 {
  const P& p; int layer, row0, col0;
  DEV void operator()(f32x4 (&acc)[4][4], int wr, int wc, int fr, int fq, char* smem) const {
    const int b = row0 / LT, pp = row0 % LT;
    const int mr = pp < LC ? 16 : b;
    const float* g1 = p.modv + ((size_t)layer * 17 + mr) * 6144 + 2048 + col0 + wc * 64;
#pragma unroll
    for (int n = 0; n < 4; ++n) {
      const float gv = g1[n * 16 + fr];
#pragma unroll
      for (int m = 0; m < 4; ++m)
#pragma unroll
        for (int j = 0; j < 4; ++j) acc[m][n][j] *= gv;
    }
    const int wid = wr * 2 + wc, lane = fq * 16 + fr;
    stage_tile_bf16(acc, smem, wid, fr, fq);
    const bf16_t (*t)[72] = (const bf16_t (*)[72])(smem + wid * 9216);
#pragma unroll
    for (int i = 0; i < 8; ++i) {
      const int rl = i * 8 + (lane >> 3), ch = lane & 7;
      bf16_t* xp = p.X + (size_t)(row0 + wr * 64 + rl) * D + col0 + wc * 64 + ch * 8;
      float xv[8], dv[8];
      uint4 xu = *(const uint4*)xp, du = *(const uint4*)&t[rl][ch * 8];
      unpack8(xu, xv); unpack8(du, dv);
#pragma unroll
      for (int q = 0; q < 8; ++q) xv[q] += dv[q];
#if EN_MIX
      *(uint4*)xp = pack8(xv);
#endif
    }
  }
};
DEV void ph_gemm2(const P& p, int layer, char* smem) {
  int rt, ct;
  for (int it = 0; gemm_unit(it, 8, rt, ct); ++it) {
    Epi2 epi{p, layer, rt * 128, ct * 128};
    gemm_tile(p.Y + (size_t)rt * 128 * D, D, p.W2t + (size_t)ct * 128 * D, D, D, smem, epi);
  }
}

DEV void ph_peerconv(const P& p, int layer) {
  const int gw = (bid_() * 256 + tid_()) >> 6, nw = gridDim.x * 4, lane = tid_() & 63;
  const float* su = opq(p.peer_u) + (size_t)layer * 16384 * 1024;
  const float* sv = opq(p.peer_v) + (size_t)layer * 16384 * 1024;
  unsigned char* pu = opq(p.PU); unsigned char* pv = opq(p.PV);
  float* psu = opq(p.PSU); float* psv = opq(p.PSV);
#pragma unroll 1
  for (int r = gw; r < 32768; r += nw) {
    const bool isv = r >= 16384;
    const int e = r & 16383;
    const float* src = (isv ? sv : su) + (size_t)e * 1024 + 16 * lane;
    float4 f0 = *(const float4*)src, f1 = *(const float4*)(src + 4), f2 = *(const float4*)(src + 8), f3 = *(const float4*)(src + 12);
    float am = fmaxf(fmaxf(fmaxf(fabsf(f0.x), fabsf(f0.y)), fmaxf(fabsf(f0.z), fabsf(f0.w))), fmaxf(fmaxf(fabsf(f1.x), fabsf(f1.y)), fmaxf(fabsf(f1.z), fabsf(f1.w))));
    am = fmaxf(am, fmaxf(fmaxf(fmaxf(fabsf(f2.x), fabsf(f2.y)), fmaxf(fabsf(f2.z), fabsf(f2.w))), fmaxf(fmaxf(fabsf(f3.x), fabsf(f3.y)), fmaxf(fabsf(f3.z), fabsf(f3.w)))));
    am = wave_max(am);
    int w0, w1, w2, w3;
    float inv;
    if (isv) {
      const float sc = am > 0.f ? 224.f / am : 1.f;
      inv = am > 0.f ? am * (1.f / 224.f) : 1.f;
      w0 = __builtin_amdgcn_cvt_pk_fp8_f32(f0.x * sc, f0.y * sc, 0, false); w0 = __builtin_amdgcn_cvt_pk_fp8_f32(f0.z * sc, f0.w * sc, w0, true);
      w1 = __builtin_amdgcn_cvt_pk_fp8_f32(f1.x * sc, f1.y * sc, 0, false); w1 = __builtin_amdgcn_cvt_pk_fp8_f32(f1.z * sc, f1.w * sc, w1, true);
      w2 = __builtin_amdgcn_cvt_pk_fp8_f32(f2.x * sc, f2.y * sc, 0, false); w2 = __builtin_amdgcn_cvt_pk_fp8_f32(f2.z * sc, f2.w * sc, w2, true);
      w3 = __builtin_amdgcn_cvt_pk_fp8_f32(f3.x * sc, f3.y * sc, 0, false); w3 = __builtin_amdgcn_cvt_pk_fp8_f32(f3.z * sc, f3.w * sc, w3, true);
    } else {
      const float sc = am > 0.f ? 127.f / am : 1.f;
      inv = am > 0.f ? am * (1.f / 127.f) : 1.f;
      w0 = pack_i8(f0.x * sc, f0.y * sc, f0.z * sc, f0.w * sc); w1 = pack_i8(f1.x * sc, f1.y * sc, f1.z * sc, f1.w * sc);
      w2 = pack_i8(f2.x * sc, f2.y * sc, f2.z * sc, f2.w * sc); w3 = pack_i8(f3.x * sc, f3.y * sc, f3.z * sc, f3.w * sc);
    }
    *(uint4*)((isv ? pv : pu) + (size_t)(lane >> 3) * PSLICE + (size_t)e * 128 + 16 * (lane & 7)) = make_uint4((unsigned)w0, (unsigned)w1, (unsigned)w2, (unsigned)w3);
    if (lane == 0) (isv ? psv : psu)[e] = inv;
  }
}
DEV void unpack16_fp8x2(const uint4& u, f32x2* f) {
  f[0] = __builtin_amdgcn_cvt_pk_f32_fp8((int)u.x, false); f[1] = __builtin_amdgcn_cvt_pk_f32_fp8((int)u.x, true);
  f[2] = __builtin_amdgcn_cvt_pk_f32_fp8((int)u.y, false); f[3] = __builtin_amdgcn_cvt_pk_f32_fp8((int)u.y, true);
  f[4] = __builtin_amdgcn_cvt_pk_f32_fp8((int)u.z, false); f[5] = __builtin_amdgcn_cvt_pk_f32_fp8((int)u.z, true);
  f[6] = __builtin_amdgcn_cvt_pk_f32_fp8((int)u.w, false); f[7] = __builtin_amdgcn_cvt_pk_f32_fp8((int)u.w, true);
}
DEV void unpack16_fp8(const uint4& u, float* f) {
  f32x2 t;
  t = __builtin_amdgcn_cvt_pk_f32_fp8((int)u.x, false); f[0] = t[0]; f[1] = t[1];
  t = __builtin_amdgcn_cvt_pk_f32_fp8((int)u.x, true); f[2] = t[0]; f[3] = t[1];
  t = __builtin_amdgcn_cvt_pk_f32_fp8((int)u.y, false); f[4] = t[0]; f[5] = t[1];
  t = __builtin_amdgcn_cvt_pk_f32_fp8((int)u.y, true); f[6] = t[0]; f[7] = t[1];
  t = __builtin_amdgcn_cvt_pk_f32_fp8((int)u.z, false); f[8] = t[0]; f[9] = t[1];
  t = __builtin_amdgcn_cvt_pk_f32_fp8((int)u.z, true); f[10] = t[0]; f[11] = t[1];
  t = __builtin_amdgcn_cvt_pk_f32_fp8((int)u.w, false); f[12] = t[0]; f[13] = t[1];
  t = __builtin_amdgcn_cvt_pk_f32_fp8((int)u.w, true); f[14] = t[0]; f[15] = t[1];
}

struct Epi3 {
  const P& p; int row0, grp;
  DEV void operator()(f32x4 (&acc)[4][4], int wr, int wc, int fr, int fq, char* smem) const {
    float* sc = (float*)smem;
    const int tid = tid_();
    for (int pass = 0; pass < 2; ++pass) {
      __syncthreads();
      if (wr == pass) {
#pragma unroll
        for (int m = 0; m < 4; ++m)
#pragma unroll
          for (int n = 0; n < 4; ++n)
#pragma unroll
            for (int j = 0; j < 4; ++j) {
              int rl = m * 16 + fq * 4 + j, col = wc * 64 + n * 16 + fr;
              unsigned bits = (__float_as_uint(acc[m][n][j]) & ~127u) | (unsigned)col;
              sc[rl * 133 + (col >> 5) * 33 + (col & 31)] = __uint_as_float(bits);
            }
      }
      __syncthreads();
      const int rl = tid >> 2, q = tid & 3;
      float Ls[16];
#pragma unroll
      for (int i = 0; i < 16; ++i) Ls[i] = -3e38f;
      const float* src = sc + rl * 133 + q * 33;
      for (int i = 0; i < 32; ++i) {
        float x = src[i];
        if (x > Ls[15]) {
#pragma unroll
          for (int k = 0; k < 16; ++k) { float hi = fmaxf(Ls[k], x); x = fminf(Ls[k], x); Ls[k] = hi; }
        }
      }
      float Cs[16];
#pragma unroll
      for (int i = 0; i < 16; ++i) Cs[i] = fmaxf(Ls[i], dppself<0xB1, 0xF>(Ls[15 - i]));
#pragma unroll
      for (int d = 8; d >= 1; d >>= 1)
#pragma unroll
        for (int i = 0; i < 16; ++i)
          if ((i & d) == 0) { float hi = fmaxf(Cs[i], Cs[i + d]), lo = fminf(Cs[i], Cs[i + d]); Cs[i] = hi; Cs[i + d] = lo; }
      float Ds[16];
#pragma unroll
      for (int i = 0; i < 16; ++i) Ds[i] = fmaxf(Cs[i], dppself<0x4E, 0xF>(Cs[15 - i]));
#pragma unroll
      for (int d = 8; d >= 1; d >>= 1)
#pragma unroll
        for (int i = 0; i < 16; ++i)
          if ((i & d) == 0) { float hi = fmaxf(Ds[i], Ds[i + d]), lo = fminf(Ds[i], Ds[i + d]); Ds[i] = hi; Ds[i + d] = lo; }
      if (q == 0) {
        float* dst = p.TK + ((size_t)(row0 + pass * 64 + rl) * 16 + grp) * 16;
#pragma unroll
        for (int i = 0; i < 4; ++i) *(float4*)(dst + 4 * i) = make_float4(Ds[4 * i], Ds[4 * i + 1], Ds[4 * i + 2], Ds[4 * i + 3]);
      }
    }
  }
};
DEV void ph_gemm3(const P& p, char* smem) {
  int rt, ct;
  for (int it = 0; gemm_unit(it, 16, rt, ct); ++it) {
    Epi3 epi{p, rt * 128, ct};
    gemm_tile(p.H + (size_t)rt * 128 * D, D, p.Wft + (size_t)ct * 128 * D, D, D, smem, epi);
  }
}

DEV float peer_gate(float scr) {
  float mx = row16_max(scr);
  float ex = __expf(scr - mx);
  float sm = row16_sum(ex);
  return ex / sm;
}
DEV float gelu_exact(float x) { return 0.5f * x * (1.f + erff(x * 0.7071067811865476f)); }

DEV void ph_peer_select(const P& p) {
  const int gw = (bid_() * 256 + tid_()) >> 6, nw = gridDim.x * 4, lane = tid_() & 63;
  int ci, cj;
  {
    const int c = lane;
    if (c < 16) { ci = 0; cj = c; } else if (c < 24) { ci = 1; cj = c - 16; } else if (c < 29) { ci = 2; cj = c - 24; }
    else if (c < 33) { ci = 3; cj = c - 29; } else if (c < 36) { ci = 4; cj = c - 33; } else if (c < 38) { ci = 5; cj = c - 36; }
    else if (c < 40) { ci = 6; cj = c - 38; } else if (c < 42) { ci = 7; cj = c - 40; } else { ci = (c - 42 + 8) & 15; cj = 0; }
  }
  const bool cand = lane < 50;
  float v1s[8], v2s[8];
  auto ldtk = [&](int row) {
    const float* tk = p.TK + (size_t)row * 256;
#pragma unroll
    for (int h = 0; h < 8; ++h) { v1s[h] = tk[(2 * h) * 16 + ci]; v2s[h] = tk[(2 * h + 1) * 16 + cj]; }
  };
  if (gw < NTOK) ldtk(gw);
#pragma unroll 1
  for (int row = gw; row < NTOK; row += nw) {
    float c1[8], c2[8];
#pragma unroll
    for (int h = 0; h < 8; ++h) { c1[h] = v1s[h]; c2[h] = v2s[h]; }
    if (row + nw < NTOK) ldtk(row + nw);
#pragma unroll
    for (int h = 0; h < 8; ++h) {
      const float v1 = c1[h], v2 = c2[h];
      float val = v1 + v2;
      val = __uint_as_float((__float_as_uint(val) & ~63u) | (unsigned)lane);
      val = cand ? val : -3e38f;
      int rank = 0;
#pragma unroll
      for (int q = 0; q < 50; ++q) rank += (readlane_f(val, q) > val) ? 1 : 0;
      const bool sel = cand && rank < 16;
      const float mx = wave_max(val);
      const float ex = sel ? __expf(val - mx) : 0.f;
      const float sm = wave_sum(ex);
      if (sel) {
        const int e = (int)(__float_as_uint(v1) & 127u) * 128 + (int)(__float_as_uint(v2) & 127u);
        p.EL[(size_t)row * 128 + h * 16 + rank] = (unsigned short)e;
        p.GT[(size_t)row * 128 + h * 16 + rank] = ex / sm;
      }
    }
  }
}

struct PeerPre { uint4 e0, e1, a0, a1, a2, a3; };
DEV unsigned peer_eid(const PeerPre& s, int j) {
  const unsigned w = (j < 8) ? ((j >> 1) == 0 ? s.e0.x : (j >> 1) == 1 ? s.e0.y : (j >> 1) == 2 ? s.e0.z : s.e0.w)
                             : (((j - 8) >> 1) == 0 ? s.e1.x : ((j - 8) >> 1) == 1 ? s.e1.y : ((j - 8) >> 1) == 2 ? s.e1.z : s.e1.w);
  return (j & 1) ? (w >> 16) : (w & 0xFFFFu);
}
template <int WHICH>
DEV void peer_wave_run(const P& p, int layer, int x, int tok0, int lane, float* wbuf) {
  const int r = lane >> 3, c = lane & 7;
  const unsigned char* tb = (WHICH == 0 ? p.PU : p.PV) + (size_t)x * PSLICE + c * 16;
  PeerPre S[3];
  uint4 R[16];
  auto ld_pre = [&](int tok, PeerPre& s) {
    const uint4* elp = (const uint4*)(p.EL + (size_t)tok * 128 + r * 16);
    s.e0 = elp[0]; s.e1 = elp[1];
    if (WHICH == 0) {
      s.a0 = *(const uint4*)(p.H8 + (size_t)tok * 1024 + x * 128 + c * 16);
    } else {
      const uint4* wtp = (const uint4*)(p.GT + (size_t)tok * 128 + r * 16);
      s.a0 = wtp[0]; s.a1 = wtp[1]; s.a2 = wtp[2]; s.a3 = wtp[3];
    }
  };
  auto comp = [&](int tok, const PeerPre& s, const PeerPre& sn, bool more) {
    if (WHICH == 0) {
      int keep0 = 0, keep1 = 0;
#pragma unroll
      for (int j = 0; j < 16; ++j) {
        const uint4 rw = R[j];
        if (more) R[j] = *(const uint4*)(tb + (size_t)peer_eid(sn, j) * 128);
        int d = __builtin_amdgcn_sdot4((int)rw.x, (int)s.a0.x, 0, false);
        d = __builtin_amdgcn_sdot4((int)rw.y, (int)s.a0.y, d, false);
        d = __builtin_amdgcn_sdot4((int)rw.z, (int)s.a0.z, d, false);
        d = __builtin_amdgcn_sdot4((int)rw.w, (int)s.a0.w, d, false);
        d += __builtin_amdgcn_update_dpp(0, d, 0xB1, 0xF, 0xF, false);
        d += __builtin_amdgcn_update_dpp(0, d, 0x4E, 0xF, 0xF, false);
        d += __builtin_amdgcn_update_dpp(0, d, 0x141, 0xF, 0xF, false);
        if (j < 8) keep0 = (c == j) ? d : keep0; else keep1 = (c == j - 8) ? d : keep1;
      }
      float* pd = p.PD + ((size_t)x * NTOK + tok) * 128 + r * 16 + c;
      pd[0] = (float)keep0; pd[8] = (float)keep1;
    } else {
      const float wsv[16] = {__uint_as_float(s.a0.x), __uint_as_float(s.a0.y), __uint_as_float(s.a0.z), __uint_as_float(s.a0.w),
                             __uint_as_float(s.a1.x), __uint_as_float(s.a1.y), __uint_as_float(s.a1.z), __uint_as_float(s.a1.w),
                             __uint_as_float(s.a2.x), __uint_as_float(s.a2.y), __uint_as_float(s.a2.z), __uint_as_float(s.a2.w),
                             __uint_as_float(s.a3.x), __uint_as_float(s.a3.y), __uint_as_float(s.a3.z), __uint_as_float(s.a3.w)};
      f32x2 acc2[8];
#pragma unroll
      for (int i = 0; i < 8; ++i) acc2[i] = (f32x2){0.f, 0.f};
#pragma unroll
      for (int j = 0; j < 16; ++j) {
        f32x2 f[8];
        unpack16_fp8x2(R[j], f);
        if (more) R[j] = *(const uint4*)(tb + (size_t)peer_eid(sn, j) * 128);
        const f32x2 w2 = (f32x2){wsv[j], wsv[j]};
#pragma unroll
        for (int i = 0; i < 8; ++i) acc2[i] += w2 * f[i];
      }
      float* slab = wbuf + (r * 8 + c) * 16;
      *(float4*)(slab) = make_float4(acc2[0][0], acc2[0][1], acc2[1][0], acc2[1][1]);
      *(float4*)(slab + 4) = make_float4(acc2[2][0], acc2[2][1], acc2[3][0], acc2[3][1]);
      *(float4*)(slab + 8) = make_float4(acc2[4][0], acc2[4][1], acc2[5][0], acc2[5][1]);
      *(float4*)(slab + 12) = make_float4(acc2[6][0], acc2[6][1], acc2[7][0], acc2[7][1]);
      asm volatile("s_waitcnt lgkmcnt(0)" ::: "memory");
      float o0 = 0.f, o1 = 0.f;
#pragma unroll
      for (int rr = 0; rr < 8; ++rr) {
        const float2 t = *(const float2*)(wbuf + (rr * 8 + (lane >> 3)) * 16 + 2 * (lane & 7));
        o0 += t.x; o1 += t.y;
      }
      asm volatile("s_waitcnt lgkmcnt(0)" ::: "memory");
      const int b = tok / LT, pp = tok % LT;
      const int mr = pp < LC ? 16 : b;
      const int col = x * 128 + 2 * lane;
      const float* g2 = p.modv + ((size_t)layer * 17 + mr) * 6144 + 5120 + col;
      unsigned* xp = (unsigned*)(p.X + (size_t)tok * D + col);
      const unsigned xu = *xp;
#if EN_PEER
      *xp = pack2(bflo(xu) + g2[0] * o0, bfhi(xu) + g2[1] * o1);
#endif
    }
  };
  ld_pre(tok0, S[0]);
  ld_pre(tok0 + 1, S[1]);
#pragma unroll
  for (int j = 0; j < 16; ++j) R[j] = *(const uint4*)(tb + (size_t)peer_eid(S[0], j) * 128);
  ld_pre(tok0 + 2, S[2]);
#pragma unroll
  for (int t = 0; t < 8; ++t) {
    comp(tok0 + t, S[t % 3], S[(t + 1) % 3], t + 1 < 8);
    if (t + 3 < 8) ld_pre(tok0 + t + 3, S[t % 3]);
  }
}
DEV void ph_peer_w(const P& p) {
  for (size_t i = (size_t)bid_() * 256 + tid_(); i < (size_t)NTOK * 128; i += (size_t)gridDim.x * 256) {
    float d = 0.f;
#pragma unroll
    for (int x = 0; x < 8; ++x) d += p.PD[(size_t)x * NTOK * 128 + i];
    const int e = p.EL[i];
    p.GT[i] = p.GT[i] * gelu_exact(d * p.PSU[e] * p.HINV[i >> 7]) * p.PSV[e];
  }
}
template <int WHICH>
DEV void ph_peer_gather(const P& p, int layer, char* smem, volatile LAS unsigned* slot) {
  const int tid = tid_(), lane = tid & 63, wid = tid >> 6;
  unsigned* q = p.wq + 1024 + layer * 256 + WHICH * 128;
  const int my = (int)(xb_xcc_id() & 7u);
  float* wbuf = (float*)smem + wid * 1024;
#pragma unroll 1
  for (int rot = 0; rot < 8; ++rot) {
    const int x = (my + rot) & 7;
    for (;;) {
      __syncthreads();
      if (tid == 0) *slot = atomicAdd(q + x * 16, 1u);
      __syncthreads();
      const int it = (int)*slot;
      if (it >= NTOK / 32) break;
      peer_wave_run<WHICH>(p, layer, x, it * 32 + wid * 8, lane, wbuf);
    }
  }
}

DEV void ph_final(const P& p) {
  const int lane = tid_() & 63;
  int r0, r1;
  wave_range(r0, r1, NB * T);
  float gv[16];
#pragma unroll
  for (int hh = 0; hh < 2; ++hh)
#pragma unroll
    for (int i = 0; i < 8; ++i) gv[hh * 8 + i] = p.final_g[hh * 512 + 8 * lane + i];
  auto xrow = [&](int r) -> const bf16_t* { const int b = r / T, t = r % T; return p.X + ((size_t)b * LT + LC + t) * D; };
  uint4 n0 = make_uint4(0, 0, 0, 0), n1 = n0;
  if (r0 < r1) { const bf16_t* xr = xrow(r0); n0 = *(const uint4*)(xr + 8 * lane); n1 = *(const uint4*)(xr + 512 + 8 * lane); }
#pragma unroll 1
  for (int r = r0; r < r1; ++r) {
    const uint4 u0 = n0, u1 = n1;
    if (r + 1 < r1) { const bf16_t* xr = xrow(r + 1); n0 = *(const uint4*)(xr + 8 * lane); n1 = *(const uint4*)(xr + 512 + 8 * lane); }
    float v[16];
    unpack8(u0, v); unpack8(u1, v + 8);
    float ss = 0.f;
#pragma unroll
    for (int i = 0; i < 16; ++i) ss += v[i] * v[i];
    ss = wave_sum(ss);
    const float rstd = rsqrtf(ss * (1.f / 1024.f) + 1e-6f);
    float* o = p.out + (size_t)r * D;
#pragma unroll
    for (int hh = 0; hh < 2; ++hh) {
      const int col = hh * 512 + 8 * lane;
      *(float4*)(o + col) = make_float4(v[hh * 8 + 0] * rstd * gv[hh * 8 + 0], v[hh * 8 + 1] * rstd * gv[hh * 8 + 1], v[hh * 8 + 2] * rstd * gv[hh * 8 + 2], v[hh * 8 + 3] * rstd * gv[hh * 8 + 3]);
      *(float4*)(o + col + 4) = make_float4(v[hh * 8 + 4] * rstd * gv[hh * 8 + 4], v[hh * 8 + 5] * rstd * gv[hh * 8 + 5], v[hh * 8 + 6] * rstd * gv[hh * 8 + 6], v[hh * 8 + 7] * rstd * gv[hh * 8 + 7]);
    }
  }
}

DEV unsigned hw_cu_key() {
  const unsigned hwid = (unsigned)__builtin_amdgcn_s_getreg(((8 - 1) << 11) | (8 << 6) | 4);
  return (xb_xcc_id() << 8) | (hwid & 0xFFu);
}
DEV void mixB(const P& p, int layer, char* smem, volatile LAS unsigned* slot) {
  unsigned* qa = p.wq + layer * 64;
  unsigned* qs = qa + 16;
  unsigned* claim = p.cuclaim + layer * 4096;
  __syncthreads();
  if (tid_() == 0) {
    unsigned u = 0xFFFFFFFFu;
    if (atomicAdd(&claim[hw_cu_key() & 4095u], 1u) == 0u) u = atomicAdd(qs, 1u);
    *slot = u;
  }
  __syncthreads();
  {
    const unsigned u = *slot;
    if (u < 128u) scanc_unit(p, layer, (int)u, smem);
  }
  for (;;) {
    __syncthreads();
    if (tid_() == 0) *slot = atomicAdd(qa, 1u);
    __syncthreads();
    const int u = (int)*slot;
    if (u >= 8704) break;
    if (u < 4352) attn_unit(p, layer, u, smem); else hyena_conv_unit(p, layer, u - 4352, smem);
  }
  if (layer + 1 < NLAYERS) {
    unsigned* qp = qa + 32;
    for (;;) {
      __syncthreads();
      if (tid_() == 0) *slot = atomicAdd(qp, 1u);
      __syncthreads();
      const int u = (int)*slot;
      if (u >= PREPA_N) break;
      prep_unit(p, layer + 1, prepA_unit_index(u), smem);
    }
  }
  for (;;) {
    __syncthreads();
    if (tid_() == 0) *slot = atomicAdd(qs, 1u);
    __syncthreads();
    const unsigned u = *slot;
    if (u >= 128u) break;
    scanc_unit(p, layer, (int)u, smem);
  }
}
DEV void mixA(const P& p, int layer, char* smem) {
  for (int u = bid_(); u < 1088; u += gridDim.x) hyena_pre_unit(p, layer, u);
  ph_lora(p, layer, smem);
  ph_rwkv_prep(p, layer);
}
DEV void mixC(const P& p, int layer, char* smem) {
  for (int u = bid_(); u < 1088; u += gridDim.x) hyena_post_unit(p, layer, u, smem);
  ph_rwkv_post(p, layer);
  ph_attn_post(p, layer);
}

__global__ void __launch_bounds__(256, 2) k_mega(P p) {
  extern __shared__ __attribute__((aligned(16))) char smem_all[];
  char* smem = smem_all;
  volatile LAS unsigned* xbw = (volatile LAS unsigned*)(smem_all + SMEM_BYTES);
  if (threadIdx.x == 0) { xbw[0] = 0u; xbw[1] = 0u; xbw[2] = 0u; xbw[3] = 0u; }
  __syncthreads();
  XcdBarrier bar = xcd_barrier_post(p.bar, xbw);
#ifndef NO_PRO
  ph_copy(p);
  ph_rope(p);
  for (int u = blockIdx.x; u < 96; u += gridDim.x) modv_unit(p, u, smem);
#endif
#ifndef NO_PREP
  ph_prep(p, 0, smem, false);
#endif
  xcd_barrier(bar);
  for (int layer = 0; layer < NLAYERS; ++layer) {
#ifndef NO_NORM
    ph_norm(p, layer, 0);
#endif
    xcd_barrier(bar);
#ifdef PROBE_GEMM
    ph_gemm1(p, smem);
#endif
#ifndef NO_GEMM1
    ph_gemm1(p, smem);
#endif
    xcd_barrier(bar);
#ifndef NO_MIXA
    mixA(p, layer, smem);
#endif
    xcd_barrier(bar);
#ifndef NO_MIXB
    mixB(p, layer, smem, (volatile LAS unsigned*)(smem_all + SMEM_BYTES + 16));
#endif
    xcd_barrier(bar);
#ifndef NO_MIXC
    mixC(p, layer, smem);
#endif
    xcd_barrier(bar);
#ifndef NO_GEMM2
    ph_gemm2(p, layer, smem);
    ph_peerconv(p, layer);
#endif
    xcd_barrier(bar);
#ifndef NO_NORM
    ph_norm(p, layer, 1);
#endif
    xcd_barrier(bar);
#ifdef PROBE_GEMM
    ph_gemm3(p, smem);
#endif
#ifndef NO_GEMM3
    ph_gemm3(p, smem);
#endif
    xcd_barrier(bar);
    ph_peer_select(p);
    xcd_barrier(bar);
    ph_peer_gather<0>(p, layer, smem, (volatile LAS unsigned*)(smem_all + SMEM_BYTES + 16));
    xcd_barrier(bar);
    ph_peer_w(p);
    xcd_barrier(bar);
    ph_peer_gather<1>(p, layer, smem, (volatile LAS unsigned*)(smem_all + SMEM_BYTES + 16));
#ifndef NO_PREP
    if (layer + 1 < NLAYERS) ph_prep(p, layer + 1, smem, true);
#endif
    xcd_barrier(bar);
  }
  ph_final(p);
}

static inline size_t al256(size_t x) { return (x + 255) & ~(size_t)255; }

extern "C" void kernel_launch(void* const* d_in, const int* in_sizes, int n_in, void* d_out, int out_size, void* d_ws, size_t ws_size,
                              hipStream_t stream) {
  (void)in_sizes; (void)n_in; (void)out_size; (void)ws_size;
  P p{};
  const float** f = (const float**)&p;
  for (int i = 0; i < 39; ++i) f[i] = (const float*)d_in[i];
  p.out = (float*)d_out;
  char* w = (char*)d_ws;
  size_t off = 0;
  auto take = [&](size_t bytes) { char* r = w + off; off += al256(bytes); return r; };
  p.bar = (unsigned*)take(16384);
  p.modv = (float*)take((size_t)DEPTH * 17 * 6144 * 4);
  p.SSQ = (float*)take((size_t)DEPTH * 2 * 256 * 4);
  p.wq = (unsigned*)take(4096 + DEPTH * 1024);
  p.cuclaim = (unsigned*)take((size_t)DEPTH * 4096 * 4);
  const size_t zero_bytes = off;
  p.rope = (float*)take(64 * 16 * 2 * 4);
  p.X = (bf16_t*)take((size_t)NTOK * D * 2);
  p.H = (bf16_t*)take((size_t)NTOK * D * 2);
  p.Y = (bf16_t*)take((size_t)NTOK * D * 2);
  p.SC = (bf16_t*)take((size_t)NTOK * 1024 * 2);
  p.Z = (bf16_t*)take((size_t)NTOK * INW * 2);
  p.UTl = (bf16_t*)take((size_t)256 * 16 * T * 2);
  p.UTc = (bf16_t*)take((size_t)256 * 16 * LC * 2);
  p.YTl = (bf16_t*)take((size_t)256 * 16 * T * 2);
  p.YTc = (bf16_t*)take((size_t)256 * 16 * LC * 2);
  p.FL = (float*)take((size_t)256 * 2 * T * 4);
  p.FC = (float*)take((size_t)256 * 2 * LC * 4);
  p.W1t = (bf16_t*)take((size_t)INW * D * 2);
  p.W2t = (bf16_t*)take((size_t)D * D * 2);
  p.Wft = (bf16_t*)take((size_t)2048 * D * 2);
  p.Wlt = (bf16_t*)take((size_t)1024 * 256 * 2);
  p.Wgt = (bf16_t*)take((size_t)256 * 128 * 2);
  p.TK = (float*)p.Z;
  p.PU = (unsigned char*)p.Z + al256((size_t)NTOK * 256 * 4);
  p.PV = p.PU + (size_t)16384 * 1024;
  p.PSU = (float*)(p.PV + (size_t)16384 * 1024);
  p.PSV = p.PSU + 16384;
  p.GT = p.PSV + 16384;
  p.EL = (unsigned short*)(p.GT + (size_t)NTOK * 128);
  p.H8 = (unsigned char*)p.EL + al256((size_t)NTOK * 128 * 2);
  p.HINV = (float*)(p.H8 + (size_t)NTOK * 1024);
  p.PD = (float*)p.Y;

  (void)hipMemsetAsync(d_ws, 0, zero_bytes, stream);
  constexpr size_t kDynLds = SMEM_BYTES + 32;
  static int grid = 0;
  if (!grid) {
    int dev = 0, cus = 0, per_cu = 0;
    (void)hipGetDevice(&dev);
    (void)hipDeviceGetAttribute(&cus, hipDeviceAttributeMultiprocessorCount, dev);
    (void)hipFuncSetAttribute((const void*)k_mega, hipFuncAttributeMaxDynamicSharedMemorySize, (int)kDynLds);
    (void)hipOccupancyMaxActiveBlocksPerMultiprocessor(&per_cu, k_mega, 256, kDynLds);
    if (cus <= 0) cus = 256;
    if (per_cu > 2) per_cu = 2;
    if (per_cu < 1) per_cu = 1;
    grid = cus * per_cu;
  }
  k_mega<<<grid, 256, kDynLds, stream>>>(p);
}
```

```cpp
#include <hip/hip_runtime.h>
#include <stdint.h>
#include <type_traits>

#define DEV __device__ __forceinline__
typedef unsigned short bf16_t;
typedef short bf16x8 __attribute__((ext_vector_type(8)));
typedef float f32x2 __attribute__((ext_vector_type(2)));
constexpr size_t PSLICE = (size_t)16384 * 128;
typedef float f32x4 __attribute__((ext_vector_type(4)));
typedef float f32x16 __attribute__((ext_vector_type(16)));

#ifndef NLAYERS
#define NLAYERS 4
#endif
#ifndef EN_HY
#define EN_HY 1
#endif
#ifndef EN_RW
#define EN_RW 1
#endif
#ifndef EN_AT
#define EN_AT 1
#endif
#ifndef EN_MIX
#define EN_MIX 1
#endif
#ifndef EN_PEER
#define EN_PEER 1
#endif

constexpr int NB = 16, T = 4096, LC = 256, LT = 4352, D = 1024, NTOK = NB * LT, INW = 2688, DEPTH = 4;
constexpr int SMEM_BYTES = 65536;

struct P {
  const float *x, *c, *ctx, *c_ctx, *mod_w, *mod_b, *norm1_g, *norm2_g, *w_in, *conv_w, *conv_b;
  const float *hy_w1, *hy_b1, *hy_w2, *hy_b2, *hy_w3, *hy_b3, *hy_freq, *hy_bias;
  const float *rw_w0, *rw_w_up, *rw_a0, *rw_a_up, *rw_g_up, *rw_k_k, *rw_k_a, *rw_r_k, *rw_ln_w, *rw_ln_b;
  const float *attn_sink, *hy_out_g, *at_out_g, *w_out, *peer_wq, *peer_k1, *peer_k2, *peer_u, *peer_v, *final_g;
  float* out;
  unsigned* bar;
  float *modv, *SSQ, *rope, *FL, *FC, *TK;
  unsigned *wq, *cuclaim;
  bf16_t *X, *H, *Y, *SC, *Z, *UTl, *UTc, *YTl, *YTc;
  bf16_t *W1t, *W2t, *Wft, *Wlt, *Wgt;
  unsigned char *PU, *PV;
  float *PSU, *PSV, *GT, *PD, *HINV;
  unsigned short* EL;
  unsigned char* H8;
};

typedef __bf16 hwbf2 __attribute__((ext_vector_type(2)));
DEV unsigned pack2(float a, float b) { f32x2 f = {a, b}; hwbf2 r = __builtin_convertvector(f, hwbf2); return __builtin_bit_cast(unsigned, r); }
DEV bf16_t f2bf(float f) { return (bf16_t)(pack2(f, 0.f) & 0xFFFFu); }
DEV float bf2f(bf16_t h) { return __uint_as_float(((unsigned)h) << 16); }
DEV float bflo(unsigned u) { return __uint_as_float(u << 16); }
DEV float bfhi(unsigned u) { return __uint_as_float(u & 0xFFFF0000u); }
DEV void unpack8(const uint4& u, float* v) {
  v[0] = bflo(u.x); v[1] = bfhi(u.x); v[2] = bflo(u.y); v[3] = bfhi(u.y);
  v[4] = bflo(u.z); v[5] = bfhi(u.z); v[6] = bflo(u.w); v[7] = bfhi(u.w);
}
DEV uint4 pack8(const float* v) { return make_uint4(pack2(v[0], v[1]), pack2(v[2], v[3]), pack2(v[4], v[5]), pack2(v[6], v[7])); }
DEV int pack_i8(float a, float b, float c, float d) {
  const int ia = __float2int_rn(a), ib = __float2int_rn(b), ic = __float2int_rn(c), id = __float2int_rn(d);
  return (ia & 0xFF) | ((ib & 0xFF) << 8) | ((ic & 0xFF) << 16) | ((id & 0xFF) << 24);
}
DEV float sigmoidf_(float x) { return __builtin_amdgcn_rcpf(1.f + __expf(-x)); }

template <int CTRL, int ROWMASK>
DEV float dpp0(float x) {
  return __builtin_bit_cast(float, __builtin_amdgcn_update_dpp(0, __builtin_bit_cast(int, x), CTRL, ROWMASK, 0xF, false));
}
template <int CTRL, int ROWMASK>
DEV float dppself(float x) {
  int xi = __builtin_bit_cast(int, x);
  return __builtin_bit_cast(float, __builtin_amdgcn_update_dpp(xi, xi, CTRL, ROWMASK, 0xF, false));
}
DEV float readlane_f(float x, int l) { return __builtin_bit_cast(float, __builtin_amdgcn_readlane(__builtin_bit_cast(int, x), l)); }
DEV int lane_id() { return (int)__builtin_amdgcn_mbcnt_hi(~0u, __builtin_amdgcn_mbcnt_lo(~0u, 0u)); }
DEV float writelane_f(float val, int l, float old) { return lane_id() == l ? val : old; }
DEV int writelane_i(int val, int l, int old) { return lane_id() == l ? val : old; }
DEV float wave_sum(float x) {
  x += dpp0<0x111, 0xF>(x); x += dpp0<0x112, 0xF>(x); x += dpp0<0x114, 0xF>(x); x += dpp0<0x118, 0xF>(x);
  x += dpp0<0x142, 0xA>(x); x += dpp0<0x143, 0xC>(x);
  return readlane_f(x, 63);
}
DEV float wave_max(float x) {
  x = fmaxf(x, dppself<0x111, 0xF>(x)); x = fmaxf(x, dppself<0x112, 0xF>(x)); x = fmaxf(x, dppself<0x114, 0xF>(x));
  x = fmaxf(x, dppself<0x118, 0xF>(x)); x = fmaxf(x, dppself<0x142, 0xA>(x)); x = fmaxf(x, dppself<0x143, 0xC>(x));
  return readlane_f(x, 63);
}
DEV float row16_sum(float x) {
  x += dpp0<0xB1, 0xF>(x); x += dpp0<0x4E, 0xF>(x); x += dpp0<0x141, 0xF>(x); x += dpp0<0x140, 0xF>(x);
  return x;
}
DEV float row16_max(float x) {
  x = fmaxf(x, dppself<0xB1, 0xF>(x)); x = fmaxf(x, dppself<0x4E, 0xF>(x)); x = fmaxf(x, dppself<0x141, 0xF>(x));
  x = fmaxf(x, dppself<0x140, 0xF>(x));
  return x;
}
DEV float quad_sum(float x) { x += dpp0<0xB1, 0xF>(x); x += dpp0<0x4E, 0xF>(x); return x; }

DEV f32x4 mfma16(bf16x8 a, bf16x8 b, f32x4 c) { return __builtin_amdgcn_mfma_f32_16x16x32_bf16(a, b, c, 0, 0, 0); }
DEV f32x16 mfma32(bf16x8 a, bf16x8 b, f32x16 c) { return __builtin_amdgcn_mfma_f32_32x32x16_bf16(a, b, c, 0, 0, 0); }


#define XB_TMO      128
#define XB_XCNT(j)  (256  + 64 * (j))
#define XB_XSUB(j)  (1280 + 64 * (j))
#define XB_XGEN(j)  (2304 + 64 * (j))
#define XB_TOP      3328
#define XB_TOPGEN   3392
#define XCD_BAR_WORDS 3456
#define XB_SPIN_CAP (1u << 23)
#define LAS __attribute__((address_space(3)))

__device__ __forceinline__ unsigned xb_ld(unsigned* p)              { return __hip_atomic_load(p, __ATOMIC_RELAXED, __HIP_MEMORY_SCOPE_AGENT); }
__device__ __forceinline__ unsigned xb_add(unsigned* p, unsigned v) { return __hip_atomic_fetch_add(p, v, __ATOMIC_RELAXED, __HIP_MEMORY_SCOPE_AGENT); }
__device__ __forceinline__ unsigned xb_xcc_id() { return (unsigned)__builtin_amdgcn_s_getreg((3 << 11) | 20) & 0xFu; }
#define XB_SPIN(cond, bar) do { unsigned _sp = 0; while (cond) { __builtin_amdgcn_s_sleep(1); \
    if ((++_sp & 255u) == 0u) { if (xb_ld(&(bar)[XB_TMO])) break; if (_sp > XB_SPIN_CAP) { atomicAdd(&(bar)[XB_TMO], 1u); break; } } } } while (0)

struct XcdBarrier {
    unsigned* bar; unsigned x;
    volatile LAS unsigned* st;
};
__device__ __forceinline__ XcdBarrier xcd_barrier_post(unsigned* bar, volatile LAS unsigned* st) {
    XcdBarrier b; b.bar = bar; b.x = xb_xcc_id(); b.st = st;
    if (threadIdx.x == 0) (void)xb_add(&bar[XB_XCNT(b.x)], 1u);
    return b;
}
__device__ __forceinline__ void xcd_barrier_complete(unsigned* bar, unsigned x, unsigned& nloc, unsigned& nx) {
    const unsigned G = gridDim.x * gridDim.y * gridDim.z;
    unsigned sum, cnt, mine, sp = 0u;
    for (;;) {
        sum = 0u; cnt = 0u; mine = 0u;
#pragma unroll
        for (unsigned j = 0; j < 16; ++j) { const unsigned c = xb_ld(&bar[XB_XCNT(j)]); sum += c; cnt += (c > 0u) ? 1u : 0u; mine = (j == x) ? c : mine; }
        if (sum == G) break;
        __builtin_amdgcn_s_sleep(1);
        if ((++sp & 255u) == 0u) { if (xb_ld(&bar[XB_TMO])) break; if (sp > XB_SPIN_CAP) { atomicAdd(&bar[XB_TMO], 1u); break; } }
    }
    nloc = mine > 0u ? mine : 1u; nx = cnt > 0u ? cnt : 1u;
}
__device__ __forceinline__ void xcd_barrier(const XcdBarrier& b) {
    asm volatile("s_waitcnt vmcnt(0)" ::: "memory");
    __syncthreads();
    if (threadIdx.x == 0) {
        unsigned* bar = b.bar;
        __builtin_amdgcn_s_waitcnt(0);
        unsigned nloc = b.st[0], nx = b.st[1];
        if (nloc == 0u) { xcd_barrier_complete(bar, b.x, nloc, nx); b.st[0] = nloc; b.st[1] = nx; }
        const unsigned old = xb_add(&bar[XB_XSUB(b.x)], 1u);
        const unsigned gen = old / nloc;
        if (old + 1u == (gen + 1u) * nloc) {
            __builtin_amdgcn_fence(__ATOMIC_RELEASE, "agent");
            asm volatile("s_waitcnt vmcnt(0)" ::: "memory");
            const unsigned og = xb_add(&bar[XB_TOP], 1u);
            const unsigned tg = og / nx;
            if (og + 1u == (tg + 1u) * nx) xb_add(&bar[XB_TOPGEN], 1u);
            else XB_SPIN(xb_ld(&bar[XB_TOPGEN]) == tg, bar);
            __builtin_amdgcn_fence(__ATOMIC_ACQUIRE, "agent");
            xb_add(&bar[XB_XGEN(b.x)], 1u);
            asm volatile("s_waitcnt vmcnt(0)" ::: "memory");
        } else {
            XB_SPIN(xb_ld(&bar[XB_XGEN(b.x)]) == gen, bar);
            __builtin_amdgcn_fence(__ATOMIC_ACQUIRE, "agent");
            asm volatile("s_waitcnt vmcnt(0)" ::: "memory");
        }
    }
    __syncthreads();
}

template <class Tp> DEV Tp* opq(Tp* q) { asm volatile("" : "+s"(q)); return q; }
DEV int tid_() { int t = threadIdx.x; asm volatile("" : "+v"(t)); return t; }
DEV int bid_() { int b = blockIdx.x; asm volatile("" : "+s"(b)); return b; }

DEV void glds16(const void* gsrc, char* lds_lane_ptr) {
  __builtin_amdgcn_global_load_lds((const unsigned*)gsrc, (__attribute__((address_space(3))) unsigned*)lds_lane_ptr, 16, 0, 0);
}
template <class Epi>
DEV void gemm_tile(const bf16_t* __restrict__ A, int lda, const bf16_t* __restrict__ Bt, int ldb, int K, char* smem, Epi& epi) {
  const int tid = tid_(), lane = tid & 63, wid = tid >> 6, wr = wid >> 1, wc = wid & 1, fr = lane & 15, fq = lane >> 4;
  f32x4 acc[4][4];
#pragma unroll
  for (int m = 0; m < 4; ++m)
#pragma unroll
    for (int n = 0; n < 4; ++n) acc[m][n] = (f32x4){0.f, 0.f, 0.f, 0.f};
  const int drow0 = 8 * wid + (lane >> 3), dpc = lane & 7;
  auto issue = [&](int kt, int buf) {
    char* sa = smem + buf * 32768;
    char* sb = sa + 16384;
#pragma unroll
    for (int i = 0; i < 4; ++i) {
      const int row = drow0 + 32 * i;
      const int kc = dpc ^ ((row >> 1) & 7);
      glds16(A + (size_t)row * lda + kt * 64 + kc * 8, sa + (i * 4 + wid) * 1024 + lane * 16);
      glds16(Bt + (size_t)row * ldb + kt * 64 + kc * 8, sb + (i * 4 + wid) * 1024 + lane * 16);
    }
  };
  __syncthreads();
  issue(0, 0);
  const int nk = K >> 6;
  const int sw = (fr >> 1) & 7;
  const int aoff = (wr * 64 + fr) * 128, boff = (wc * 64 + fr) * 128;
  for (int kt = 0; kt < nk; ++kt) {
    asm volatile("s_waitcnt vmcnt(0)" ::: "memory");
    __syncthreads();
    if (kt + 1 < nk) issue(kt + 1, (kt + 1) & 1);
    const char* sa = smem + (kt & 1) * 32768;
    const char* sb = sa + 16384;
    bf16x8 af[2][4], bfr[2][4];
#pragma unroll
    for (int kh = 0; kh < 2; ++kh) {
      const int pc = ((kh * 4 + fq) ^ sw) * 16;
#pragma unroll
      for (int m = 0; m < 4; ++m) af[kh][m] = *(const bf16x8*)(sa + aoff + m * 2048 + pc);
#pragma unroll
      for (int n = 0; n < 4; ++n) bfr[kh][n] = *(const bf16x8*)(sb + boff + n * 2048 + pc);
    }
    __builtin_amdgcn_sched_barrier(0);
    asm volatile("s_waitcnt lgkmcnt(8)" ::: "memory");
    __builtin_amdgcn_sched_barrier(0);
#pragma unroll
    for (int m = 0; m < 4; ++m)
#pragma unroll
      for (int n = 0; n < 4; ++n) acc[m][n] = mfma16(af[0][m], bfr[0][n], acc[m][n]);
    __builtin_amdgcn_sched_barrier(0);
    asm volatile("s_waitcnt lgkmcnt(0)" ::: "memory");
    __builtin_amdgcn_sched_barrier(0);
#pragma unroll
    for (int m = 0; m < 4; ++m)
#pragma unroll
      for (int n = 0; n < 4; ++n) acc[m][n] = mfma16(af[1][m], bfr[1][n], acc[m][n]);
  }
  __syncthreads();
  epi(acc, wr, wc, fr, fq, smem);
}
DEV void stage_tile_bf16(const f32x4 (&acc)[4][4], char* smem, int wid, int fr, int fq) {
  bf16_t (*t)[72] = (bf16_t (*)[72])(smem + wid * 9216);
#pragma unroll
  for (int m = 0; m < 4; ++m)
#pragma unroll
    for (int n = 0; n < 4; ++n)
#pragma unroll
      for (int j = 0; j < 4; ++j) t[m * 16 + fq * 4 + j][n * 16 + fr] = f2bf(acc[m][n][j]);
  asm volatile("s_waitcnt lgkmcnt(0)" ::: "memory");
}

DEV void ph_copy(const P& p) {
  const size_t n8 = (size_t)NTOK * D / 8;
  const float* pctx = opq(p.ctx); const float* px = opq(p.x);
  for (size_t i = (size_t)bid_() * 256 + tid_(); i < n8; i += (size_t)gridDim.x * 256) {
    size_t e = i * 8;
    int row = (int)(e / D), col = (int)(e % D);
    int b = row / LT, pp = row % LT;
    const float* src = pp < LC ? pctx + ((size_t)(b * LC + pp)) * D + col : px + ((size_t)(b * T + pp - LC)) * D + col;
    float4 v0 = *(const float4*)src, v1 = *(const float4*)(src + 4);
    uint4 o = make_uint4(pack2(v0.x, v0.y), pack2(v0.z, v0.w), pack2(v1.x, v1.y), pack2(v1.z, v1.w));
    *(uint4*)(p.X + e) = o;
  }
}

DEV void ph_rope(const P& p) {
  for (int i = bid_() * 256 + tid_(); i < 64 * 16; i += gridDim.x * 256) {
    int pos = i >> 4, k = i & 15;
    float inv = powf(10000.f, -(float)k / 16.f);
    float ang = (float)pos * inv;
    p.rope[2 * i] = cosf(ang); p.rope[2 * i + 1] = sinf(ang);
  }
}

DEV void modv_unit(const P& p, int unit, char* smem) {
  const int cc = unit % 24, layer = unit / 24;
  float (*cs)[128] = (float (*)[128])smem;
  const int col = cc * 256 + tid_();
  const float* pc = opq(p.c); const float* pcc = opq(p.c_ctx);
  float acc[17];
#pragma unroll
  for (int r = 0; r < 17; ++r) acc[r] = 0.f;
  for (int ks = 0; ks < 8; ++ks) {
    __syncthreads();
    for (int i = tid_(); i < 17 * 128; i += 256) {
      int r = i >> 7, e = i & 127;
      float v = r < 16 ? pc[r * D + ks * 128 + e] : pcc[ks * 128 + e];
      cs[r][e] = v / (1.f + expf(-v));
    }
    __syncthreads();
    const float* w = p.mod_w + ((size_t)layer * D + ks * 128) * 6144 + col;
#pragma unroll 4
    for (int e = 0; e < 128; ++e) {
      float wv = w[(size_t)e * 6144];
#pragma unroll
      for (int r = 0; r < 17; ++r) acc[r] += cs[r][e] * wv;
    }
  }
  const float bias = p.mod_b[layer * 6144 + col];
#pragma unroll
  for (int r = 0; r < 17; ++r) p.modv[((size_t)layer * 17 + r) * 6144 + col] = acc[r] + bias;
}

DEV void transpose_unit(const float* __restrict__ src, bf16_t* __restrict__ dst, int R, int C, int tile, char* smem) {
  float (*t)[65] = (float (*)[65])smem;
  const int nct = C / 64;
  const int tr = tile / nct, tc = tile % nct;
  __syncthreads();
  for (int i = tid_(); i < 4096; i += 256) { int r = i >> 6, c = i & 63; t[r][c] = src[(size_t)(tr * 64 + r) * C + tc * 64 + c]; }
  __syncthreads();
  for (int i = tid_(); i < 4096; i += 256) { int c = i >> 6, r = i & 63; dst[(size_t)(tc * 64 + c) * R + tr * 64 + r] = f2bf(t[r][c]); }
}

DEV void wfold_unit(const P& p, int layer, int unit, char* smem) {
  const int hs = unit >> 5, ec = unit & 31, h = hs >> 1, s = hs & 1;
  const float* wq = p.peer_wq + (size_t)layer * D * 2048;
  const float* kk = (s ? opq(p.peer_k2) : opq(p.peer_k1)) + ((size_t)layer * 8 + h) * 128 * 128;
  float (*kS)[65] = (float (*)[65])smem;
  float (*wS)[64] = (float (*)[64])(smem + 33280);
  const int key = tid_() & 127, eh = tid_() >> 7;
  float acc[16];
#pragma unroll
  for (int i = 0; i < 16; ++i) acc[i] = 0.f;
  for (int dh = 0; dh < 2; ++dh) {
    __syncthreads();
    for (int i = tid_(); i < 128 * 64; i += 256) { int k2 = i >> 6, d = i & 63; kS[k2][d] = kk[k2 * 128 + dh * 64 + d]; }
    for (int i = tid_(); i < 32 * 64; i += 256) {
      int e = i >> 6, d = i & 63;
      wS[e][d] = wq[(size_t)(ec * 32 + e) * 2048 + h * 256 + s * 128 + dh * 64 + d];
    }
    __syncthreads();
#pragma unroll 2
    for (int d = 0; d < 64; ++d) {
      float kv = kS[key][d];
#pragma unroll
      for (int i = 0; i < 16; ++i) acc[i] += kv * wS[eh * 16 + i][d];
    }
  }
  bf16_t* dst = p.Wft + ((size_t)(hs * 128 + key)) * D + ec * 32 + eh * 16;
#pragma unroll
  for (int i = 0; i < 16; i += 2) *(unsigned*)(dst + i) = pack2(acc[i], acc[i + 1]);
}

DEV void filt_unit(const P& p, int layer, int unit, char* smem) {
  int kind, j0, L;
  if (unit < 1024) { kind = 0; j0 = unit * 4; L = T; } else { kind = 1; j0 = (unit - 1024) * 4; L = LC; }
  float* zs = (float*)smem;
  float* h1 = zs + 4 * 36;
  float* h2 = h1 + 256;
  const int jj = tid_() >> 6, o = tid_() & 63;
  const int j = j0 + jj;
  const float fj = (float)j;
  const float t = fj / (float)(L - 1);
  __syncthreads();
  if (o < 33) {
    float z;
    if (o == 0) z = t;
    else {
      int i = (o - 1) & 15;
      float band = 1e-4f + (float)i * ((15.0f - 1e-4f) / 15.0f);
      float ang = 6.283185307179586f * fj * band / (float)L;
      z = (o <= 16) ? cosf(ang) : -sinf(ang);
    }
    zs[jj * 36 + o] = z;
  }
  __syncthreads();
  {
    const float* w1 = p.hy_w1 + layer * 33 * 64;
    float a = p.hy_b1[layer * 64 + o];
#pragma unroll 3
    for (int i = 0; i < 33; ++i) a += zs[jj * 36 + i] * w1[i * 64 + o];
    h1[jj * 64 + o] = sinf(p.hy_freq[layer * 128 + o] * a);
  }
  __syncthreads();
  {
    const float* w2 = p.hy_w2 + layer * 64 * 64;
    float a = p.hy_b2[layer * 64 + o];
#pragma unroll 4
    for (int i = 0; i < 64; ++i) a += h1[jj * 64 + i] * w2[i * 64 + o];
    h2[jj * 64 + o] = sinf(p.hy_freq[layer * 128 + 64 + o] * a);
  }
  __syncthreads();
  const float* w3 = p.hy_w3 + layer * 64 * 512;
  float* F = kind ? opq(p.FC) : opq(p.FL);
  const float DMIN = -3.0701134573253945f, DMAX = -15.350567286626973f;
#pragma unroll 1
  for (int m = 0; m < 4; ++m) {
    int c = o + 64 * m;
    float af = p.hy_b3[layer * 512 + c], ab = p.hy_b3[layer * 512 + 256 + c];
#pragma unroll 4
    for (int i = 0; i < 64; ++i) { float hv = h2[jj * 64 + i]; af += hv * w3[i * 512 + c]; ab += hv * w3[i * 512 + 256 + c]; }
    float delta = fabsf(DMIN + (float)c * ((DMAX - DMIN) / 255.f));
    float win = expf(-t * delta) + 0.05f;
    af *= win; ab *= win;
    F[((size_t)c * 2 + 0) * L + j] = af;
    F[((size_t)c * 2 + 1) * L + j] = ab;
  }
}

constexpr int PREP_T0 = 672, PREP_T1 = PREP_T0 + 256, PREP_T2 = PREP_T1 + 8, PREP_T3 = PREP_T2 + 8, PREP_T4 = PREP_T3 + 8;
constexpr int PREP_WF = PREP_T4 + 512, PREP_N = PREP_WF + 1088;
DEV void prep_unit(const P& p, int layer, int u, char* smem) {
  if (u < PREP_T0) transpose_unit(p.w_in + (size_t)layer * D * INW, p.W1t, D, INW, u, smem);
  else if (u < PREP_T1) transpose_unit(p.w_out + (size_t)layer * D * D, p.W2t, D, D, u - PREP_T0, smem);
  else if (u < PREP_T3) {
    const int u0 = u - PREP_T1;
    for (int i = tid_(); i < 64 * 256; i += 256) {
      const int np = u0 * 64 + (i >> 8), kp = i & 255;
      const int ps = np & 3, chan = np >> 2, qp = kp >> 6, kk = kp & 63;
      const int is_a = ps & 1, d = ps >> 1;
      float v = 0.f;
      if (qp == (is_a ? 2 + d : d)) v = (is_a ? opq(p.rw_a_up) : opq(p.rw_w_up))[(((size_t)layer * 2 + d) * 64 + kk) * 256 + chan];
      p.Wlt[(size_t)np * 256 + kp] = f2bf(v);
    }
  }
  else if (u < PREP_T4) transpose_unit(p.rw_g_up + (size_t)layer * 128 * 256, p.Wgt, 128, 256, u - PREP_T3, smem);
  else if (u < PREP_WF) wfold_unit(p, layer, u - PREP_T4, smem);
  else filt_unit(p, layer, u - PREP_WF, smem);
}
constexpr int PREPA_N = PREP_T0 + (PREP_T4 - PREP_T1);
DEV int prepA_unit_index(int i) { return i < PREP_T0 ? i : PREP_T1 + (i - PREP_T0); }
DEV void ph_prep(const P& p, int layer, char* smem, bool onlyB) {
  for (int u = bid_(); u < PREP_N; u += gridDim.x) {
    const bool isA = (u < PREP_T0) || (u >= PREP_T1 && u < PREP_T4);
    if (onlyB && isA) continue;
    prep_unit(p, layer, u, smem);
  }
}

DEV void wave_range(int& r0, int& r1, int ntok) {
  const int gw = (bid_() * 256 + tid_()) >> 6, nw = gridDim.x * 4;
  const int per = (ntok + nw - 1) / nw;
  r0 = gw * per; r1 = r0 + per; if (r1 > ntok) r1 = ntok;
}
DEV void ph_norm(const P& p, int layer, int which) {
  const int lane = tid_() & 63;
  int r0, r1;
  wave_range(r0, r1, NTOK);
  const float* g = (which ? p.norm2_g : p.norm1_g) + layer * D;
  float gv[16], scv[16], shv[16];
#pragma unroll
  for (int hh = 0; hh < 2; ++hh)
#pragma unroll
    for (int i = 0; i < 8; ++i) gv[hh * 8 + i] = g[hh * 512 + 8 * lane + i];
  int mr_cur = -1;
  uint4 n0 = make_uint4(0, 0, 0, 0), n1 = n0;
  if (r0 < r1) { const bf16_t* xr = p.X + (size_t)r0 * D; n0 = *(const uint4*)(xr + 8 * lane); n1 = *(const uint4*)(xr + 512 + 8 * lane); }
#pragma unroll 1
  for (int row = r0; row < r1; ++row) {
    const uint4 u0 = n0, u1 = n1;
    if (row + 1 < r1) { const bf16_t* xr = p.X + (size_t)(row + 1) * D; n0 = *(const uint4*)(xr + 8 * lane); n1 = *(const uint4*)(xr + 512 + 8 * lane); }
    const int b = row / LT, pp = row % LT;
    const int mr = pp < LC ? 16 : b;
    if (mr != mr_cur) {
      mr_cur = mr;
      const float* mv = p.modv + ((size_t)layer * 17 + mr) * 6144 + (which ? 3072 : 0);
#pragma unroll
      for (int hh = 0; hh < 2; ++hh)
#pragma unroll
        for (int i = 0; i < 8; ++i) { shv[hh * 8 + i] = mv[hh * 512 + 8 * lane + i]; scv[hh * 8 + i] = 1.f + mv[1024 + hh * 512 + 8 * lane + i]; }
    }
    float v[16];
    unpack8(u0, v); unpack8(u1, v + 8);
    float ss = 0.f;
#pragma unroll
    for (int i = 0; i < 16; ++i) ss += v[i] * v[i];
    ss = wave_sum(ss);
    const float rstd = rsqrtf(ss * (1.f / 1024.f) + 1e-6f);
    float o[16];
#pragma unroll
    for (int i = 0; i < 16; ++i) o[i] = (v[i] * rstd * gv[i]) * scv[i] + shv[i];
    bf16_t* hr = p.H + (size_t)row * D;
    *(uint4*)(hr + 8 * lane) = pack8(o);
    *(uint4*)(hr + 512 + 8 * lane) = pack8(o + 8);
    if (which) {
      float am = 0.f;
#pragma unroll
      for (int i = 0; i < 16; ++i) am = fmaxf(am, fabsf(o[i]));
      am = wave_max(am);
      const float sc = am > 0.f ? 127.f / am : 1.f;
      unsigned char* h8 = p.H8 + (size_t)row * 1024;
      *(uint2*)(h8 + 8 * lane) = make_uint2((unsigned)pack_i8(o[0] * sc, o[1] * sc, o[2] * sc, o[3] * sc), (unsigned)pack_i8(o[4] * sc, o[5] * sc, o[6] * sc, o[7] * sc));
      *(uint2*)(h8 + 512 + 8 * lane) = make_uint2((unsigned)pack_i8(o[8] * sc, o[9] * sc, o[10] * sc, o[11] * sc), (unsigned)pack_i8(o[12] * sc, o[13] * sc, o[14] * sc, o[15] * sc));
      if (lane == 0) p.HINV[row] = am > 0.f ? am * (1.f / 127.f) : 1.f;
    }
  }
}

DEV bool gemm_unit(int it, int nct, int& rt, int& ct) {
  const int nslot = gridDim.x >> 3;
  const int x = bid_() & 7, sl = bid_() >> 3;
  if (sl >= nslot) return false;
  const int v = it * nslot + sl;
  if (v >= 68 * nct) return false;
  const int rg = v / (8 * nct), rem = v - rg * 8 * nct;
  const int rows = (rg == 8) ? 4 : 8;
  ct = rem / rows;
  rt = x * 68 + rg * 8 + (rem - ct * rows);
  return true;
}
struct Epi1 {
  const P& p; int row0, col0;
  DEV void operator()(f32x4 (&acc)[4][4], int wr, int wc, int fr, int fq, char* smem) const {
    const int cw = col0 + wc * 64;
    const int rbase = row0 + wr * 64;
    const bool lat = (row0 % LT) >= LC;
    if (cw >= 1536 && cw < 1664) {
#pragma unroll
      for (int m = 0; m < 4; ++m)
#pragma unroll
        for (int n = 0; n < 4; ++n)
#pragma unroll
          for (int j = 0; j < 4; ++j) acc[m][n][j] = tanhf(acc[m][n][j]);
    } else if (cw >= 1792 && cw < 1920) {
#pragma unroll
      for (int m = 0; m < 4; ++m)
#pragma unroll
        for (int n = 0; n < 4; ++n)
#pragma unroll
          for (int j = 0; j < 4; ++j) acc[m][n][j] = sigmoidf_(acc[m][n][j]);
    } else if (cw >= 1920 && cw < 2560 && lat) {
#pragma unroll
      for (int m = 0; m < 4; ++m)
#pragma unroll
        for (int j = 0; j < 4; ++j) {
          int row = rbase + m * 16 + fq * 4 + j;
          int pl = (row % LT) - LC;
          int ri = pl >> 6, ci = pl & 63;
          float2 cr = *(const float2*)(p.rope + 2 * (ri * 16 + fr));
          float2 cc = *(const float2*)(p.rope + 2 * (ci * 16 + fr));
          float x1 = acc[m][0][j], x2 = acc[m][1][j];
          acc[m][0][j] = x1 * cr.x - x2 * cr.y; acc[m][1][j] = x2 * cr.x + x1 * cr.y;
          x1 = acc[m][2][j]; x2 = acc[m][3][j];
          acc[m][2][j] = x1 * cc.x - x2 * cc.y; acc[m][3][j] = x2 * cc.x + x1 * cc.y;
        }
    }
    const int wid = wr * 2 + wc, lane = fq * 16 + fr;
    stage_tile_bf16(acc, smem, wid, fr, fq);
    const bf16_t (*t)[72] = (const bf16_t (*)[72])(smem + wid * 9216);
#pragma unroll
    for (int i = 0; i < 8; ++i) {
      const int rl = i * 8 + (lane >> 3), ch = lane & 7;
      *(uint4*)(p.Z + (size_t)(rbase + rl) * INW + cw + ch * 8) = *(const uint4*)&t[rl][ch * 8];
    }
  }
};
DEV void ph_gemm1(const P& p, char* smem) {
  const int nct = INW / 128;
  int rt, ct;
  for (int it = 0; gemm_unit(it, nct, rt, ct); ++it) {
    Epi1 epi{p, rt * 128, ct * 128};
    gemm_tile(p.H + (size_t)rt * 128 * D, D, p.W1t + (size_t)ct * 128 * D, D, D, smem, epi);
  }
}

struct EpiLoraA {
  const P& p; int layer, row0, col0;
  DEV void operator()(f32x4 (&acc)[4][4], int wr, int wc, int fr, int fq, char* smem) const {
    const int ps = fr & 3, is_a = ps & 1, dd = ps >> 1;
    const float scale = is_a ? 1.f : 0.6065306597126334f;
    const float* bias0 = (is_a ? opq(p.rw_a0) : opq(p.rw_w0)) + (layer * 2 + dd) * 256;
#pragma unroll
    for (int n = 0; n < 4; ++n) {
      const int chan = (col0 + wc * 64 + n * 16 + fr) >> 2;
      const float bias = bias0[chan];
#pragma unroll
      for (int m = 0; m < 4; ++m)
#pragma unroll
        for (int j = 0; j < 4; ++j) acc[m][n][j] = scale * sigmoidf_(acc[m][n][j] + bias);
    }
    const int wid = wr * 2 + wc, lane = fq * 16 + fr;
    stage_tile_bf16(acc, smem, wid, fr, fq);
    const bf16_t (*t)[72] = (const bf16_t (*)[72])(smem + wid * 9216);
#pragma unroll
    for (int i = 0; i < 8; ++i) {
      const int rl = i * 8 + (lane >> 3), ch = lane & 7;
      *(uint4*)(p.SC + (size_t)(row0 + wr * 64 + rl) * 1024 + col0 + wc * 64 + ch * 8) = *(const uint4*)&t[rl][ch * 8];
    }
  }
};
struct EpiLoraG {
  const P& p; int row0, col0;
  DEV void operator()(f32x4 (&acc)[4][4], int wr, int wc, int fr, int fq, char* smem) const {
    const int wid = wr * 2 + wc, lane = fq * 16 + fr;
    stage_tile_bf16(acc, smem, wid, fr, fq);
    const bf16_t (*t)[72] = (const bf16_t (*)[72])(smem + wid * 9216);
#pragma unroll
    for (int i = 0; i < 8; ++i) {
      const int rl = i * 8 + (lane >> 3), ch = lane & 7;
      *(uint4*)(p.Y + (size_t)(row0 + wr * 64 + rl) * D + 256 + col0 + wc * 64 + ch * 8) = *(const uint4*)&t[rl][ch * 8];
    }
  }
};
DEV void ph_lora(const P& p, int layer, char* smem) {
  int rt, ct;
  for (int it = 0; gemm_unit(it, 10, rt, ct); ++it) {
    if (ct < 8) {
      EpiLoraA epi{p, layer, rt * 128, ct * 128};
      gemm_tile(p.Z + (size_t)rt * 128 * INW + 1536, INW, p.Wlt + (size_t)ct * 128 * 256, 256, 256, smem, epi);
    } else {
      EpiLoraG epi{p, rt * 128, (ct - 8) * 128};
      gemm_tile(p.Z + (size_t)rt * 128 * INW + 1792, INW, p.Wgt + (size_t)(ct - 8) * 128 * 128, 128, 128, smem, epi);
    }
  }
}

DEV void ph_rwkv_prep(const P& p, int layer) {
  const int lane = tid_() & 63;
  int r0, r1;
  wave_range(r0, r1, NTOK);
  const float* cw = p.conv_w + (size_t)layer * 3 * 1536;
  const float* cb = p.conv_b + (size_t)layer * 1536;
  float w0[3][4], w1[3][4], w2[3][4], bb[3][4], kkw[4];
#pragma unroll
  for (int a = 0; a < 3; ++a)
#pragma unroll
    for (int i = 0; i < 4; ++i) {
      const int col = 768 + a * 256 + 4 * lane + i;
      w0[a][i] = cw[col]; w1[a][i] = cw[1536 + col]; w2[a][i] = cw[3072 + col]; bb[a][i] = cb[col];
    }
#pragma unroll
  for (int i = 0; i < 4; ++i) kkw[i] = p.rw_k_k[layer * 256 + 4 * lane + i];
  uint2 zm[3], zc[3], zp[3];
  auto ldz = [&](int row, uint2 (&z)[3]) {
#pragma unroll
    for (int a = 0; a < 3; ++a) z[a] = *(const uint2*)(p.Z + (size_t)row * INW + 768 + a * 256 + 4 * lane);
  };
  auto zero3 = [&](uint2 (&z)[3]) {
#pragma unroll
    for (int a = 0; a < 3; ++a) z[a] = make_uint2(0u, 0u);
  };
  if (r0 < r1) {
    if (r0 > 0) ldz(r0 - 1, zm); else zero3(zm);
    ldz(r0, zc);
  }
#pragma unroll 1
  for (int row = r0; row < r1; ++row) {
    if (row + 1 < NTOK) ldz(row + 1, zp); else zero3(zp);
    const int pp = row % LT;
    const bool hasm = (pp != 0) && (pp != LC);
    const bool hasp = (pp != LC - 1) && (pp != LT - 1);
    float res[3][4];
#pragma unroll
    for (int a = 0; a < 3; ++a) {
      const uint2 um = hasm ? zm[a] : make_uint2(0u, 0u), uc = zc[a], up = hasp ? zp[a] : make_uint2(0u, 0u);
      const float vm[4] = {bflo(um.x), bfhi(um.x), bflo(um.y), bfhi(um.y)};
      const float vc[4] = {bflo(uc.x), bfhi(uc.x), bflo(uc.y), bfhi(uc.y)};
      const float vp[4] = {bflo(up.x), bfhi(up.x), bflo(up.y), bfhi(up.y)};
#pragma unroll
      for (int i = 0; i < 4; ++i) res[a][i] = w0[a][i] * vm[i] + w1[a][i] * vc[i] + w2[a][i] * vp[i] + bb[a][i];
    }
    float kk[4], ss = 0.f;
#pragma unroll
    for (int i = 0; i < 4; ++i) { kk[i] = res[1][i] * kkw[i]; ss += kk[i] * kk[i]; }
    ss = row16_sum(ss);
    const float rs = rsqrtf(ss + 1e-12f);
    bf16_t* hr = p.H + (size_t)row * D + 16 * lane;
    *(uint4*)hr = make_uint4(pack2(res[0][0], res[1][0]), pack2(kk[0] * rs, res[2][0]), pack2(res[0][1], res[1][1]), pack2(kk[1] * rs, res[2][1]));
    *(uint4*)(hr + 8) = make_uint4(pack2(res[0][2], res[1][2]), pack2(kk[2] * rs, res[2][2]), pack2(res[0][3], res[1][3]), pack2(kk[3] * rs, res[2][3]));
#pragma unroll
    for (int a = 0; a < 3; ++a) { zm[a] = zc[a]; zc[a] = zp[a]; }
  }
}

DEV float oct_sum(float x) { x += dpp0<0xB1, 0xF>(x); x += dpp0<0x4E, 0xF>(x); x += dpp0<0x141, 0xF>(x); return x; }
DEV bf16x8 frag_join(uint2 lo, uint2 hi) { uint4 w = make_uint4(lo.x, lo.y, hi.x, hi.y); return __builtin_bit_cast(bf16x8, w); }
constexpr int SCS_SET = 16640, SCS_IMG = 3 * SCS_SET, SCS_W0 = SCS_IMG + 2 * 3072;
DEV void scanc_unit(const P& p, int layer, int unit, char* smem) {
  const int dir = unit & 1, h = (unit >> 1) & 3, b = unit >> 3;
  const int tid = tid_(), lane = tid & 63, fr = lane & 15, fq = lane >> 4;
  const int w = __builtin_amdgcn_readfirstlane(tid >> 6);
  bf16_t* IMG0 = (bf16_t*)(smem + SCS_W0);
  bf16_t* IMG1 = IMG0 + 512;
  bf16_t* IMG2 = IMG0 + 1024;
  __syncthreads();
  for (int i = tid; i < (2 * 3072 + 3072) / 4; i += 256) ((unsigned*)(smem + SCS_IMG))[i] = 0u;
  const float ka = p.rw_k_a[layer * 256 + h * 64 + lane];
  const size_t rowbase = (size_t)b * LT;
  const char* hbase = (const char*)p.H;
  const char* sbase = (const char*)p.SC;
  const unsigned hoff = (unsigned)(rowbase * 2048) + (unsigned)((h * 64 + lane) * 8);
  const unsigned soff = hoff + 4u * (unsigned)dir;
  bf16_t* yb = p.Z + rowbase * INW + 768 + dir * 256 + h * 64 + w * 16 + fr;
  auto pos0 = [&](int c) -> int { const int t = c * 16; return dir == 0 ? t : (t < LC ? LC - 1 - t : LT - 1 - (t - LC)); };
  const int pstep = dir == 0 ? 1 : -1;
  constexpr int NCH = LT / 16;
  struct Raw { unsigned sc[16]; uint2 hr[6]; };
  auto load_raw = [&](int c, Raw& rw) {
    if (w != 0) {
      const int p0 = pos0(c);
      const unsigned so = soff + (unsigned)(p0 * 2048);
      const int st = pstep * 2048;
#pragma unroll
      for (int i = 0; i < 16; ++i) rw.sc[i] = *(const unsigned*)(sbase + (so + (unsigned)(i * st)));
      const unsigned ho = hoff + (unsigned)((p0 + pstep * (w - 1)) * 2048);
#pragma unroll
      for (int q = 0; q < 6; ++q) {
        const int qq = ((w - 1) + 3 * q < 16) ? q : 4;
        rw.hr[q] = *(const uint2*)(hbase + (ho + (unsigned)(qq * 3 * st)));
      }
    }
  };
  auto stage1w = [&](int set, const Raw& rw, auto W1tag) {
    constexpr int W1 = decltype(W1tag)::value;
    char* base = smem + set * SCS_SET;
    bf16_t (*At)[72] = (bf16_t (*)[72])(base);
    bf16_t (*Rt)[72] = (bf16_t (*)[72])(base + 2304);
    bf16_t (*Bt)[72] = (bf16_t (*)[72])(base + 4608);
    bf16_t (*Kt)[72] = (bf16_t (*)[72])(base + 6912);
    bf16_t (*BKT)[40] = (bf16_t (*)[40])(base + 9216);
    bf16_t (*VV)[16] = (bf16_t (*)[16])(base + 14336);
    float* G16 = (float*)(base + 16384);
    float Erun = 0.f;
#pragma unroll
    for (int i = 0; i < 16; ++i) {
      const float ev = bflo(rw.sc[i]);
      const float Eprev = Erun;
      Erun += ev;
      if ((i % 3) == W1) {
        const uint2 hrec = rw.hr[i / 3];
        const float rr = bflo(hrec.x), kr = bfhi(hrec.x), kkv = bflo(hrec.y);
        const float av = bfhi(rw.sc[i]);
        const float gp = __expf(-Eprev), gi = __expf(-Erun), ig = __expf(Erun);
        const float at = -kkv * gp, rt = rr * gi, bt = kkv * av * ig, kt2 = kr * (1.f + (av - 1.f) * ka) * ig;
        const unsigned ar = pack2(at, rt), bk = pack2(bt, kt2);
        At[i][lane] = (bf16_t)(ar & 0xFFFFu); Rt[i][lane] = (bf16_t)(ar >> 16);
        Bt[i][lane] = (bf16_t)(bk & 0xFFFFu); Kt[i][lane] = (bf16_t)(bk >> 16);
        BKT[lane][(i >> 2) * 8 + (i & 3)] = (bf16_t)(bk & 0xFFFFu);
        BKT[lane][(i >> 2) * 8 + 4 + (i & 3)] = (bf16_t)(bk >> 16);
        VV[lane][(i >> 2) * 4 + (i & 3)] = (bf16_t)(hrec.y >> 16);
        if (i == 15) G16[lane] = gi;
      }
    }
  };
  auto stage1 = [&](int set, const Raw& rw) {
    if (w == 1) stage1w(set, rw, std::integral_constant<int, 0>{});
    else if (w == 2) stage1w(set, rw, std::integral_constant<int, 1>{});
    else if (w == 3) stage1w(set, rw, std::integral_constant<int, 2>{});
  };
  auto stage2 = [&](int set, int iset) {
    char* base = smem + set * SCS_SET;
    const bf16_t (*At)[72] = (const bf16_t (*)[72])(base);
    const bf16_t (*Rt)[72] = (const bf16_t (*)[72])(base + 2304);
    const bf16_t (*Bt)[72] = (const bf16_t (*)[72])(base + 4608);
    const bf16_t (*Kt)[72] = (const bf16_t (*)[72])(base + 6912);
    bf16_t* TT = (bf16_t*)(smem + SCS_IMG + iset * 3072);
    bf16_t* ARK = TT + 512;
    bf16_t* AAK = TT + 1024;
    const bf16_t (*X)[72] = (w < 2) ? At : Rt;
    const bf16_t (*Y)[72] = (w & 1) ? Kt : Bt;
    f32x4 cm = (f32x4){0.f, 0.f, 0.f, 0.f};
#pragma unroll
    for (int s = 0; s < 2; ++s) {
      bf16x8 af = *(const bf16x8*)&X[fr][32 * s + 8 * fq];
      bf16x8 bm = *(const bf16x8*)&Y[fr][32 * s + 8 * fq];
      cm = mfma16(af, bm, cm);
    }
#pragma unroll
    for (int jj = 0; jj < 4; ++jj) {
      const int i = 4 * fq + jj;
      const bool keep = (w < 2) ? (fr < i) : (fr <= i);
      cm[jj] = keep ? cm[jj] : 0.f;
    }
    const int io = (fr >> 2) * 8 + (fr & 3);
    auto wr_img = [&](bf16_t* img, const f32x4& Xv, int hi) {
#pragma unroll
      for (int jj = 0; jj < 4; ++jj) img[(4 * fq + jj) * 32 + io + hi] = f2bf(Xv[jj]);
    };
    if (w == 1) wr_img(AAK, cm, 0);
    else if (w == 2) wr_img(ARK, cm, 0);
    else if (w == 3) wr_img(ARK, cm, 4);
    else {
      auto bfrag = [&](const f32x4& Xv) { return frag_join(make_uint2(pack2(Xv[0], Xv[1]), pack2(Xv[2], Xv[3])), make_uint2(0u, 0u)); };
      auto afr = [&](const bf16_t* img) { return *(const bf16x8*)&img[(fr * 4 + fq) * 8]; };
      const f32x4 Z4 = (f32x4){0.f, 0.f, 0.f, 0.f};
      wr_img(IMG0, cm, 0);
      asm volatile("" ::: "memory");
      f32x4 A2 = mfma16(afr(IMG0), bfrag(cm), Z4);
      wr_img(IMG1, A2, 0);
      asm volatile("" ::: "memory");
      f32x4 A4 = mfma16(afr(IMG1), bfrag(A2), Z4);
      wr_img(IMG2, A4, 0);
      asm volatile("" ::: "memory");
      f32x4 Rm = mfma16(afr(IMG2), bfrag(A4), Z4);
#pragma unroll
      for (int jj = 0; jj < 4; ++jj) Rm[jj] += (fr == 4 * fq + jj) ? 1.f : 0.f;
      Rm = mfma16(afr(IMG2), bfrag(Rm), Rm);
      Rm = mfma16(afr(IMG1), bfrag(Rm), Rm);
      Rm = mfma16(afr(IMG0), bfrag(Rm), Rm);
      wr_img(TT, Rm, 0);
    }
  };
  f32x4 acc[4];
#pragma unroll
  for (int kt = 0; kt < 4; ++kt) acc[kt] = (f32x4){0.f, 0.f, 0.f, 0.f};
  auto part2 = [&](int c, int set, int iset) {
    char* base = smem + set * SCS_SET;
    const bf16_t (*At)[72] = (const bf16_t (*)[72])(base);
    const bf16_t (*Rt)[72] = (const bf16_t (*)[72])(base + 2304);
    const bf16_t (*BKT)[40] = (const bf16_t (*)[40])(base + 9216);
    const bf16_t (*VV)[16] = (const bf16_t (*)[16])(base + 14336);
    const float* G16 = (const float*)(base + 16384);
    const bf16_t* TT = (const bf16_t*)(smem + SCS_IMG + iset * 3072);
    const bf16_t* ARK = TT + 512;
    const bf16_t* AAK = TT + 1024;
    bf16x8 Sb[2];
#pragma unroll
    for (int s = 0; s < 2; ++s) {
      uint4 t = make_uint4(pack2(acc[2 * s][0], acc[2 * s][1]), pack2(acc[2 * s][2], acc[2 * s][3]),
                           pack2(acc[2 * s + 1][0], acc[2 * s + 1][1]), pack2(acc[2 * s + 1][2], acc[2 * s + 1][3]));
      Sb[s] = __builtin_bit_cast(bf16x8, t);
    }
    const uint2 vv = *(const uint2*)&VV[w * 16 + fr][fq * 4];
    const bf16x8 Vlow = frag_join(vv, make_uint2(0u, 0u));
    f32x4 Pm = (f32x4){0.f, 0.f, 0.f, 0.f};
#pragma unroll
    for (int s = 0; s < 2; ++s) {
      bf16x8 af = frag_join(*(const uint2*)&At[fr][32 * s + 4 * fq], *(const uint2*)&At[fr][32 * s + 16 + 4 * fq]);
      Pm = mfma16(af, Sb[s], Pm);
    }
    Pm = mfma16(*(const bf16x8*)&AAK[(fr * 4 + fq) * 8], Vlow, Pm);
    const bf16x8 Pb = frag_join(make_uint2(pack2(Pm[0], Pm[1]), pack2(Pm[2], Pm[3])), make_uint2(0u, 0u));
    f32x4 U = mfma16(*(const bf16x8*)&TT[(fr * 4 + fq) * 8], Pb, (f32x4){0.f, 0.f, 0.f, 0.f});
    const bf16x8 UV = frag_join(make_uint2(pack2(U[0], U[1]), pack2(U[2], U[3])), vv);
    f32x4 Yv = (f32x4){0.f, 0.f, 0.f, 0.f};
#pragma unroll
    for (int s = 0; s < 2; ++s) {
      bf16x8 af = frag_join(*(const uint2*)&Rt[fr][32 * s + 4 * fq], *(const uint2*)&Rt[fr][32 * s + 16 + 4 * fq]);
      Yv = mfma16(af, Sb[s], Yv);
    }
    Yv = mfma16(*(const bf16x8*)&ARK[(fr * 4 + fq) * 8], UV, Yv);
    {
      const int p0 = pos0(c);
#pragma unroll
      for (int jj = 0; jj < 4; ++jj) yb[(size_t)(p0 + pstep * (4 * fq + jj)) * INW] = f2bf(Yv[jj]);
    }
#pragma unroll
    for (int kt = 0; kt < 4; ++kt) {
      f32x4 t = mfma16(*(const bf16x8*)&BKT[16 * kt + fr][fq * 8], UV, acc[kt]);
      const float4 g4 = *(const float4*)&G16[16 * kt + 4 * fq];
      t[0] *= g4.x; t[1] *= g4.y; t[2] *= g4.z; t[3] *= g4.w;
      acc[kt] = t;
    }
  };
  __builtin_amdgcn_s_setprio(3);
  Raw r0, r1;
  load_raw(0, r0); load_raw(1, r1);
  stage1(0, r0);
  load_raw(2, r0);
  __syncthreads();
  stage2(0, 0);
  stage1(1, r1);
  load_raw(3, r1);
  __syncthreads();
  int s0 = 0, s1 = 1, s2 = 2;
  auto iter = [&](int c, Raw& rw) {
    if (c + 1 < NCH) stage2(s1, (c + 1) & 1);
    part2(c, s0, c & 1);
    if (c + 2 < NCH) {
      stage1(s2, rw);
      if (c + 4 < NCH) load_raw(c + 4, rw);
    }
    asm volatile("s_waitcnt lgkmcnt(0)" ::: "memory");
    __builtin_amdgcn_s_barrier();
    asm volatile("" ::: "memory");
    const int t = s0; s0 = s1; s1 = s2; s2 = t;
  };
#pragma unroll 1
  for (int c = 0; c < NCH; c += 2) {
    iter(c, r0); iter(c + 1, r1);
  }
  __builtin_amdgcn_s_setprio(0);
}

DEV void ph_rwkv_post(const P& p, int layer) {
  const int lane = tid_() & 63;
  int r0, r1;
  wave_range(r0, r1, NTOK);
  const int ch = 4 * lane;
  float kav[4], rkv[4], lnw[4], lnb[4];
#pragma unroll
  for (int i = 0; i < 4; ++i) {
    kav[i] = p.rw_k_a[layer * 256 + ch + i]; rkv[i] = p.rw_r_k[layer * 256 + ch + i];
    lnw[i] = p.rw_ln_w[layer * 256 + ch + i]; lnb[i] = p.rw_ln_b[layer * 256 + ch + i];
  }
  struct In { uint2 y0, y1, g; uint4 h0, h1, s0, s1; };
  auto ld = [&](int row, In& in) {
    const bf16_t* zr = p.Z + (size_t)row * INW + 768 + ch;
    in.y0 = *(const uint2*)zr; in.y1 = *(const uint2*)(zr + 256);
    const bf16_t* hr = p.H + (size_t)row * D + 4 * ch;
    in.h0 = *(const uint4*)hr; in.h1 = *(const uint4*)(hr + 8);
    const bf16_t* sr = p.SC + (size_t)row * 1024 + 4 * ch;
    in.s0 = *(const uint4*)sr; in.s1 = *(const uint4*)(sr + 8);
    in.g = *(const uint2*)(p.Y + (size_t)row * D + 256 + ch);
  };
  In nx;
  if (r0 < r1) ld(r0, nx);
#pragma unroll 1
  for (int row = r0; row < r1; ++row) {
    const In in = nx;
    if (row + 1 < r1) ld(row + 1, nx);
    float y[4] = {bflo(in.y0.x) + bflo(in.y1.x), bfhi(in.y0.x) + bfhi(in.y1.x), bflo(in.y0.y) + bflo(in.y1.y), bfhi(in.y0.y) + bfhi(in.y1.y)};
    const float mu = row16_sum(y[0] + y[1] + y[2] + y[3]) * (1.f / 64.f);
    float vs = 0.f;
#pragma unroll
    for (int i = 0; i < 4; ++i) { y[i] -= mu; vs += y[i] * y[i]; }
    const float var = row16_sum(vs) * (1.f / 64.f);
    const float rstd = rsqrtf(var + 64e-5f);
    const float r[4] = {bflo(in.h0.x), bflo(in.h0.z), bflo(in.h1.x), bflo(in.h1.z)};
    const float k[4] = {bfhi(in.h0.x), bfhi(in.h0.z), bfhi(in.h1.x), bfhi(in.h1.z)};
    const float v[4] = {bfhi(in.h0.y), bfhi(in.h0.w), bfhi(in.h1.y), bfhi(in.h1.w)};
    const float a0[4] = {bfhi(in.s0.x), bfhi(in.s0.z), bfhi(in.s1.x), bfhi(in.s1.z)};
    const float a1[4] = {bfhi(in.s0.y), bfhi(in.s0.w), bfhi(in.s1.y), bfhi(in.s1.w)};
    float sd = 0.f;
#pragma unroll
    for (int i = 0; i < 4; ++i) {
      const float kd0 = k[i] * (1.f + (a0[i] - 1.f) * kav[i]), kd1 = k[i] * (1.f + (a1[i] - 1.f) * kav[i]);
      sd += r[i] * (kd0 + kd1) * rkv[i];
    }
    sd = row16_sum(sd);
    const float g[4] = {bflo(in.g.x), bfhi(in.g.x), bflo(in.g.y), bfhi(in.g.y)};
    float o[4];
#pragma unroll
    for (int i = 0; i < 4; ++i) {
      const float yn = y[i] * rstd * lnw[i] + lnb[i];
      o[i] = (yn + sd * v[i]) * g[i];
#if !EN_RW
      o[i] = 0.f;
#endif
    }
    *(uint2*)(p.Y + (size_t)row * D + 256 + ch) = make_uint2(pack2(o[0], o[1]), pack2(o[2], o[3]));
  }
}

DEV void hyena_pre_unit(const P& p, int layer, int unit) {
  int kind, b, t0, L;
  if (unit < 1024) { kind = 0; b = unit >> 6; t0 = (unit & 63) * 64; L = T; } else { int u = unit - 1024; kind = 1; b = u >> 2; t0 = (u & 3) * 64; L = LC; }
  const int c = tid_();
  const size_t row0 = (size_t)b * LT + (kind ? 0 : LC);
  const float* cw = p.conv_w + (size_t)layer * 3 * 1536;
  const float* cb = p.conv_b + (size_t)layer * 1536;
  const float w1a = cw[256 + c], w1b = cw[1536 + 256 + c], w1c = cw[3072 + 256 + c], b1 = cb[256 + c];
  const float w2a = cw[512 + c], w2b = cw[1536 + 512 + c], w2c = cw[3072 + 512 + c], b2 = cb[512 + c];
  auto ld = [&](int t, int col) -> float { return (t >= 0 && t < L) ? bf2f(p.Z[(row0 + t) * INW + col]) : 0.f; };
  float x1m = ld(t0 - 1, 256 + c), x1c = ld(t0, 256 + c), vm = ld(t0 - 1, 512 + c), vc = ld(t0, 512 + c);
  bf16_t* dst = (kind ? opq(p.UTc) : opq(p.UTl)) + ((size_t)c * 16 + b) * L + t0;
#pragma unroll 1
  for (int i8 = 0; i8 < 8; ++i8) {
    float uo[8];
#pragma unroll
    for (int i = 0; i < 8; ++i) {
      int t = t0 + i8 * 8 + i;
      float x1n = ld(t + 1, 256 + c), vn = ld(t + 1, 512 + c);
      float a = w1a * x1m + w1b * x1c + w1c * x1n + b1;
      float bb = w2a * vm + w2b * vc + w2c * vn + b2;
      uo[i] = a * bb;
      x1m = x1c; x1c = x1n; vm = vc; vc = vn;
    }
    *(uint4*)(dst + 8 * i8) = pack8(uo);
  }
}

DEV void hyena_conv_unit(const P& p, int layer, int unit, char* smem) {
  int kind, c, tb, L;
  if (unit < 4096) { kind = 0; c = unit >> 4; tb = (unit & 15) * 256; L = T; } else { kind = 1; c = unit - 4096; tb = 0; L = LC; }
  const int tid = tid_(), lane = tid & 63, wid = tid >> 6, fr = lane & 15, fq = lane >> 4;
  float* red = (float*)(smem + 2 * 16512);
  const float* F = (kind ? opq(p.FC) : opq(p.FL)) + (size_t)c * 2 * L;
  float scale;
  {
    float part = 0.f;
    for (int i = tid; i < 2 * L; i += 256) { float fv = F[i]; part += (i != L) ? fv * fv : 0.f; }
    part = wave_sum(part);
    __syncthreads();
    if (lane == 0) red[wid] = part;
    __syncthreads();
    scale = rsqrtf(((red[0] + red[1]) + (red[2] + red[3])) + 1e-6f);
  }
  const bf16_t* U = (kind ? opq(p.UTc) : opq(p.UTl)) + (size_t)c * 16 * L;
  f32x4 acc[4];
#pragma unroll
  for (int m = 0; m < 4; ++m) acc[m] = (f32x4){0.f, 0.f, 0.f, 0.f};
  const int nch = L / 256;
  float fw0, fw1, fw2;
  uint4 ru0, ru1;
  auto ldchunk = [&](int ch) {
    const int sc = ch * 256;
    const int D0 = tb + 256 - sc;
    auto tap = [&](int n) -> float {
      int d = D0 - n;
      float v = 0.f;
      if (d > -L && d < L) v = (d >= 0 ? F[d] : F[L - d]);
      return v;
    };
    fw0 = tap(tid); fw1 = tap(tid + 256); fw2 = (tid < 8) ? tap(tid + 512) : 0.f;
    const int bb = tid >> 4, sg0 = tid & 15;
    ru0 = *(const uint4*)(U + (size_t)bb * L + sc + 8 * sg0);
    ru1 = *(const uint4*)(U + (size_t)bb * L + sc + 8 * (sg0 + 16));
  };
  auto stchunk = [&](int buf) {
    bf16_t* Cq = (bf16_t*)(smem + buf * 16512);
    bf16_t* Us = (bf16_t*)(smem + buf * 16512 + 8320);
    const bf16_t h0 = f2bf(fw0 * scale), h1 = f2bf(fw1 * scale), h2 = f2bf(fw2 * scale);
#pragma unroll
    for (int rho = 0; rho < 8; ++rho) {
      int m = tid + rho;
      Cq[((m >> 3) * 8 + rho) * 8 + (m & 7)] = h0;
      m = tid + 256 + rho;
      if (m < 520) Cq[((m >> 3) * 8 + rho) * 8 + (m & 7)] = h1;
      m = tid + 512 + rho;
      if (tid < 8 && m < 520) Cq[((m >> 3) * 8 + rho) * 8 + (m & 7)] = h2;
    }
    if (tid < 8) {
#pragma unroll
      for (int rho = 1; rho < 8; ++rho) if (tid < rho) Cq[(rho) * 8 + tid] = 0;
    }
    const int bb = tid >> 4, sg0 = tid & 15;
    *(uint4*)&Us[(sg0 * 16 + bb) * 8] = ru0;
    *(uint4*)&Us[((sg0 + 16) * 16 + bb) * 8] = ru1;
  };
  ldchunk(0);
#pragma unroll 1
  for (int ch = 0; ch < nch; ++ch) {
    const int buf = ch & 1;
    stchunk(buf);
    __syncthreads();
    if (ch + 1 < nch) ldchunk(ch + 1);
    const bf16_t* Cq = (const bf16_t*)(smem + buf * 16512);
    const bf16_t* Us = (const bf16_t*)(smem + buf * 16512 + 8320);
#pragma unroll
    for (int kk = 0; kk < 8; ++kk) {
      bf16x8 bf = *(const bf16x8*)&Us[((4 * kk + fq) * 16 + fr) * 8];
#pragma unroll
      for (int m = 0; m < 4; ++m) {
        int it = wid * 4 + m;
        int base = 256 - 16 * it + 32 * kk + 8 * fq;
        int m0 = base - 8 * (fr >> 3);
        bf16x8 af = *(const bf16x8*)&Cq[((m0 >> 3) * 8 + (fr & 7)) * 8];
        acc[m] = mfma16(af, bf, acc[m]);
      }
    }
  }
  __syncthreads();
  bf16_t* Yt = (kind ? opq(p.YTc) : opq(p.YTl)) + ((size_t)c * 16 + fr) * L + tb;
#pragma unroll
  for (int m = 0; m < 4; ++m) {
    int t = (wid * 4 + m) * 16 + fq * 4;
    *(uint2*)(Yt + t) = make_uint2(pack2(acc[m][0], acc[m][1]), pack2(acc[m][2], acc[m][3]));
  }
}

DEV void hyena_post_unit(const P& p, int layer, int unit, char* smem) {
  int kind, b, t0, L;
  if (unit < 1024) { kind = 0; b = unit >> 6; t0 = (unit & 63) * 64; L = T; } else { int u = unit - 1024; kind = 1; b = u >> 2; t0 = (u & 3) * 64; L = LC; }
  const int c = tid_(), lane = c & 63, wid = c >> 6;
  const size_t row0 = (size_t)b * LT + (kind ? 0 : LC);
  bf16_t (*tile)[264] = (bf16_t (*)[264])smem;
  const float* cw = p.conv_w + (size_t)layer * 3 * 1536;
  const float wa = cw[c], wb = cw[1536 + c], wcc = cw[3072 + c], b0 = p.conv_b[layer * 1536 + c];
  const float bias = p.hy_bias[layer * 256 + c];
  const bf16_t* yt = (kind ? opq(p.YTc) : opq(p.YTl)) + ((size_t)c * 16 + b) * L + t0;
  const bf16_t* ut = (kind ? opq(p.UTc) : opq(p.UTl)) + ((size_t)c * 16 + b) * L + t0;
  auto ld = [&](int t) -> float { return (t >= 0 && t < L) ? bf2f(p.Z[(row0 + t) * INW + c]) : 0.f; };
  float xm = ld(t0 - 1), xc = ld(t0);
  __syncthreads();
#pragma unroll 1
  for (int i8 = 0; i8 < 8; ++i8) {
    uint4 yu = *(const uint4*)(yt + 8 * i8), uu = *(const uint4*)(ut + 8 * i8);
    float yv[8], uv[8];
    unpack8(yu, yv); unpack8(uu, uv);
#pragma unroll
    for (int i = 0; i < 8; ++i) {
      int t = t0 + i8 * 8 + i;
      float xn = ld(t + 1);
      float x0 = wa * xm + wb * xc + wcc * xn + b0;
      float o = x0 * (yv[i] + uv[i] * bias);
      tile[i8 * 8 + i][c] = f2bf(o);
      xm = xc; xc = xn;
    }
  }
  __syncthreads();
  for (int i = 0; i < 16; ++i) {
    int tl = wid * 16 + i;
    uint2 ou = *(const uint2*)&tile[tl][4 * lane];
    float o[4] = {bflo(ou.x), bfhi(ou.x), bflo(ou.y), bfhi(ou.y)};
    float ss = wave_sum(o[0] * o[0] + o[1] * o[1] + o[2] * o[2] + o[3] * o[3]);
    float rstd = rsqrtf(ss * (1.f / 256.f) + 1e-6f);
#pragma unroll
    for (int q = 0; q < 4; ++q) {
      o[q] = o[q] * rstd * p.hy_out_g[layer * 256 + 4 * lane + q];
#if !EN_HY
      o[q] = 0.f;
#endif
    }
    *(uint2*)(p.Y + (row0 + t0 + tl) * D + 4 * lane) = make_uint2(pack2(o[0], o[1]), pack2(o[2], o[3]));
  }
}

DEV void attn_unit(const P& p, int layer, int unit, char* smem) {
  const bool isctx = unit >= 4096;
  int b, qb, hq;
  if (!isctx) { b = unit >> 8; qb = (unit >> 3) & 31; hq = unit & 7; } else { int u = unit - 4096; b = u >> 4; qb = (u >> 3) & 1; hq = u & 7; }
  const int g = hq >> 2;
  const int tid = tid_(), lane = tid & 63, wid = tid >> 6, qn = lane & 31, hh = lane >> 5;
  const int qpos = qb * 128 + wid * 32 + qn;
  const size_t qrow = (size_t)b * LT + (isctx ? qpos : LC + qpos);
  const bf16_t* qptr = p.Z + qrow * INW + 1920 + hq * 64;
  bf16x8 qf[4];
#pragma unroll
  for (int s = 0; s < 4; ++s) qf[s] = *(const bf16x8*)(qptr + 16 * s + 8 * hh);
  const float sink = p.attn_sink[layer * 8 + hq];
  float m_run = sink, l_run = 1.f;
  f32x16 o0, o1;
#pragma unroll
  for (int i = 0; i < 16; ++i) { o0[i] = 0.f; o1[i] = 0.f; }
  typedef bf16_t KTile[64][72];
  KTile* Ks = (KTile*)smem;
  KTile* Vt = (KTile*)(smem + 18432);
  const int ntl = isctx ? 0 : 6;
  const int ntiles = ntl + 4;
  const int skey = tid >> 3, sseg = tid & 7;
  const bf16_t* kvbase = p.Z + (size_t)b * LT * INW + 1920 + 512 + g * 64 + sseg * 8;
  uint4 rk0, rk1, rv0, rv1;
  auto ldtile = [&](int kt) {
    const bool ctxk = kt >= ntl;
    const int kbase = ctxk ? (kt - ntl) * 64 : qb * 128 - 128 + kt * 64;
    const int kp0 = kbase + skey, kp1 = kp0 + 32;
    rk0 = rk1 = rv0 = rv1 = make_uint4(0, 0, 0, 0);
    if (ctxk || (kp0 >= 0 && kp0 < T)) { const bf16_t* src = kvbase + (size_t)(ctxk ? kp0 : LC + kp0) * INW; rk0 = *(const uint4*)src; rv0 = *(const uint4*)(src + 128); }
    if (ctxk || (kp1 >= 0 && kp1 < T)) { const bf16_t* src = kvbase + (size_t)(ctxk ? kp1 : LC + kp1) * INW; rk1 = *(const uint4*)src; rv1 = *(const uint4*)(src + 128); }
  };
  auto sttile = [&](int buf) {
    *(uint4*)&Ks[buf][skey][sseg * 8] = rk0;
    *(uint4*)&Ks[buf][skey + 32][sseg * 8] = rk1;
    bf16_t (*vt)[72] = Vt[buf];
    vt[sseg * 8 + 0][skey] = (bf16_t)(rv0.x & 0xFFFF); vt[sseg * 8 + 1][skey] = (bf16_t)(rv0.x >> 16);
    vt[sseg * 8 + 2][skey] = (bf16_t)(rv0.y & 0xFFFF); vt[sseg * 8 + 3][skey] = (bf16_t)(rv0.y >> 16);
    vt[sseg * 8 + 4][skey] = (bf16_t)(rv0.z & 0xFFFF); vt[sseg * 8 + 5][skey] = (bf16_t)(rv0.z >> 16);
    vt[sseg * 8 + 6][skey] = (bf16_t)(rv0.w & 0xFFFF); vt[sseg * 8 + 7][skey] = (bf16_t)(rv0.w >> 16);
    vt[sseg * 8 + 0][skey + 32] = (bf16_t)(rv1.x & 0xFFFF); vt[sseg * 8 + 1][skey + 32] = (bf16_t)(rv1.x >> 16);
    vt[sseg * 8 + 2][skey + 32] = (bf16_t)(rv1.y & 0xFFFF); vt[sseg * 8 + 3][skey + 32] = (bf16_t)(rv1.y >> 16);
    vt[sseg * 8 + 4][skey + 32] = (bf16_t)(rv1.z & 0xFFFF); vt[sseg * 8 + 5][skey + 32] = (bf16_t)(rv1.z >> 16);
    vt[sseg * 8 + 6][skey + 32] = (bf16_t)(rv1.w & 0xFFFF); vt[sseg * 8 + 7][skey + 32] = (bf16_t)(rv1.w >> 16);
  };
  ldtile(0);
#pragma unroll 1
  for (int kt = 0; kt < ntiles; ++kt) {
    const int buf = kt & 1;
    sttile(buf);
    __syncthreads();
    if (kt + 1 < ntiles) ldtile(kt + 1);
    const bool ctxk = kt >= ntl;
    const int kbase = ctxk ? (kt - ntl) * 64 : qb * 128 - 128 + kt * 64;
#pragma unroll
    for (int sub = 0; sub < 2; ++sub) {
      const int kb2 = kbase + sub * 32;
      bool need = true;
      if (!ctxk) {
        int q0 = qb * 128 + wid * 32;
        if (kb2 + 31 < q0 - 128 || kb2 > q0 + 31 + 128 || kb2 + 31 < 0 || kb2 >= T) need = false;
      }
      if (need) {
        f32x16 sv;
#pragma unroll
        for (int i = 0; i < 16; ++i) sv[i] = 0.f;
#pragma unroll
        for (int ks = 0; ks < 4; ++ks) {
          bf16x8 kf = *(const bf16x8*)&Ks[buf][sub * 32 + qn][16 * ks + 8 * hh];
          sv = mfma32(kf, qf[ks], sv);
        }
        float mt = -3e38f;
#pragma unroll
        for (int rg = 0; rg < 16; ++rg) {
          float v = sv[rg] * 0.125f;
          if (!ctxk) {
            int kp = kb2 + (rg & 3) + 8 * (rg >> 2) + 4 * hh;
            int dl = qpos - kp;
            bool ok = (dl <= 128) && (dl >= -128) && (kp >= 0) && (kp < T);
            v = ok ? v : -1e30f;
          }
          sv[rg] = v;
          mt = fmaxf(mt, v);
        }
        mt = fmaxf(mt, __shfl_xor(mt, 32));
        float m_new = fmaxf(m_run, mt);
        float corr = __expf(m_run - m_new);
        float ps = 0.f;
#pragma unroll
        for (int rg = 0; rg < 16; ++rg) { float pv = __expf(sv[rg] - m_new); sv[rg] = pv; ps += pv; }
        ps += __shfl_xor(ps, 32);
        l_run = l_run * corr + ps;
        m_run = m_new;
#pragma unroll
        for (int i = 0; i < 16; ++i) { o0[i] *= corr; o1[i] *= corr; }
#pragma unroll
        for (int sp = 0; sp < 2; ++sp) {
          bf16x8 pf;
#pragma unroll
          for (int j = 0; j < 8; ++j) pf[j] = (short)f2bf(sv[8 * sp + j]);
          const int kc = sub * 32 + 16 * sp + 4 * hh;
          uint2 va = *(const uint2*)&Vt[buf][qn][kc], vb = *(const uint2*)&Vt[buf][qn][kc + 8];
          uint2 vc = *(const uint2*)&Vt[buf][32 + qn][kc], vd = *(const uint2*)&Vt[buf][32 + qn][kc + 8];
          uint4 w0 = make_uint4(va.x, va.y, vb.x, vb.y), w1 = make_uint4(vc.x, vc.y, vd.x, vd.y);
          bf16x8 v0 = __builtin_bit_cast(bf16x8, w0), v1 = __builtin_bit_cast(bf16x8, w1);
          o0 = mfma32(v0, pf, o0);
          o1 = mfma32(v1, pf, o1);
        }
      }
    }
  }
  __syncthreads();
  const float inv = 1.f / l_run;
  bf16_t* optr = p.Y + qrow * D + 512 + hq * 64;
#pragma unroll
  for (int rg = 0; rg < 4; ++rg) {
    int d0 = 8 * rg + 4 * hh;
    *(uint2*)(optr + d0) = make_uint2(pack2(o0[4 * rg] * inv, o0[4 * rg + 1] * inv), pack2(o0[4 * rg + 2] * inv, o0[4 * rg + 3] * inv));
    *(uint2*)(optr + 32 + d0) = make_uint2(pack2(o1[4 * rg] * inv, o1[4 * rg + 1] * inv), pack2(o1[4 * rg + 2] * inv, o1[4 * rg + 3] * inv));
  }
}

DEV void ph_attn_post(const P& p, int layer) {
  const int lane = tid_() & 63;
  int r0, r1;
  wave_range(r0, r1, NTOK);
  float gv[8];
#pragma unroll
  for (int i = 0; i < 8; ++i) gv[i] = p.at_out_g[layer * 512 + 8 * lane + i];
  uint4 nx = make_uint4(0, 0, 0, 0);
  if (r0 < r1) nx = *(const uint4*)(p.Y + (size_t)r0 * D + 512 + 8 * lane);
#pragma unroll 1
  for (int row = r0; row < r1; ++row) {
    const uint4 u = nx;
    if (row + 1 < r1) nx = *(const uint4*)(p.Y + (size_t)(row + 1) * D + 512 + 8 * lane);
    float v[8];
    unpack8(u, v);
    float ss = 0.f;
#pragma unroll
    for (int i = 0; i < 8; ++i) ss += v[i] * v[i];
    ss = wave_sum(ss);
    const float rstd = rsqrtf(ss * (1.f / 512.f) + 1e-6f);
#pragma unroll
    for (int i = 0; i < 8; ++i) {
      v[i] = v[i] * rstd * gv[i];
#if !EN_AT
      v[i] = 0.f;
#endif
    }
    *(uint4*)(p.Y + (size_t)row * D + 512 + 8 * lane) = pack8(v);
  }
}

struct Epi2 {
  const P& p; int layer, row0, col0;
  DEV void operator()(f32x4 (&acc)[4][4], int wr, int wc, int fr, int fq, char* smem) const {
    const int b = row0 / LT, pp = row0 % LT;
    const int mr = pp < LC ? 16 : b;
    const float* g1 = p.modv + ((size_t)layer * 17 + mr) * 6144 + 2048 + col0 + wc * 64;
#pragma unroll
    for (int n = 0; n < 4; ++n) {
      const float gv = g1[n * 16 + fr];
#pragma unroll
      for (int m = 0; m < 4; ++m)
#pragma unroll
        for (int j = 0; j < 4; ++j) acc[m][n][j] *= gv;
    }
    const int wid = wr * 2 + wc, lane = fq * 16 + fr;
    stage_tile_bf16(acc, smem, wid, fr, fq);
    const bf16_t (*t)[72] = (const bf16_t (*)[72])(smem + wid * 9216);
#pragma unroll
    for (int i = 0; i < 8; ++i) {
      const int rl = i * 8 + (lane >> 3), ch = lane & 7;
      bf16_t* xp = p.X + (size_t)(row0 + wr * 64 + rl) * D + col0 + wc * 64 + ch * 8;
      float xv[8], dv[8];
      uint4 xu = *(const uint4*)xp, du = *(const uint4*)&t[rl][ch * 8];
      unpack8(xu, xv); unpack8(du, dv);
#pragma unroll
      for (int q = 0; q < 8; ++q) xv[q] += dv[q];
#if EN_MIX
      *(uint4*)xp = pack8(xv);
#endif
    }
  }
};
DEV void ph_gemm2(const P& p, int layer, char* smem) {
  int rt, ct;
  for (int it = 0; gemm_unit(it, 8, rt, ct); ++it) {
    Epi2 epi{p, layer, rt * 128, ct * 128};
    gemm_tile(p.Y + (size_t)rt * 128 * D, D, p.W2t + (size_t)ct * 128 * D, D, D, smem, epi);
  }
}

DEV void ph_peerconv(const P& p, int layer) {
  const int gw = (bid_() * 256 + tid_()) >> 6, nw = gridDim.x * 4, lane = tid_() & 63;
  const float* su = opq(p.peer_u) + (size_t)layer * 16384 * 1024;
  const float* sv = opq(p.peer_v) + (size_t)layer * 16384 * 1024;
  unsigned char* pu = opq(p.PU); unsigned char* pv = opq(p.PV);
  float* psu = opq(p.PSU); float* psv = opq(p.PSV);
#pragma unroll 1
  for (int r = gw; r < 32768; r += nw) {
    const bool isv = r >= 16384;
    const int e = r & 16383;
    const float* src = (isv ? sv : su) + (size_t)e * 1024 + 16 * lane;
    float4 f0 = *(const float4*)src, f1 = *(const float4*)(src + 4), f2 = *(const float4*)(src + 8), f3 = *(const float4*)(src + 12);
    float am = fmaxf(fmaxf(fmaxf(fabsf(f0.x), fabsf(f0.y)), fmaxf(fabsf(f0.z), fabsf(f0.w))), fmaxf(fmaxf(fabsf(f1.x), fabsf(f1.y)), fmaxf(fabsf(f1.z), fabsf(f1.w))));
    am = fmaxf(am, fmaxf(fmaxf(fmaxf(fabsf(f2.x), fabsf(f2.y)), fmaxf(fabsf(f2.z), fabsf(f2.w))), fmaxf(fmaxf(fabsf(f3.x), fabsf(f3.y)), fmaxf(fabsf(f3.z), fabsf(f3.w)))));
    am = wave_max(am);
    int w0, w1, w2, w3;
    float inv;
    if (isv) {
      const float sc = am > 0.f ? 224.f / am : 1.f;
      inv = am > 0.f ? am * (1.f / 224.f) : 1.f;
      w0 = __builtin_amdgcn_cvt_pk_fp8_f32(f0.x * sc, f0.y * sc, 0, false); w0 = __builtin_amdgcn_cvt_pk_fp8_f32(f0.z * sc, f0.w * sc, w0, true);
      w1 = __builtin_amdgcn_cvt_pk_fp8_f32(f1.x * sc, f1.y * sc, 0, false); w1 = __builtin_amdgcn_cvt_pk_fp8_f32(f1.z * sc, f1.w * sc, w1, true);
      w2 = __builtin_amdgcn_cvt_pk_fp8_f32(f2.x * sc, f2.y * sc, 0, false); w2 = __builtin_amdgcn_cvt_pk_fp8_f32(f2.z * sc, f2.w * sc, w2, true);
      w3 = __builtin_amdgcn_cvt_pk_fp8_f32(f3.x * sc, f3.y * sc, 0, false); w3 = __builtin_amdgcn_cvt_pk_fp8_f32(f3.z * sc, f3.w * sc, w3, true);
    } else {
      const float sc = am > 0.f ? 127.f / am : 1.f;
      inv = am > 0.f ? am * (1.f / 127.f) : 1.f;
      w0 = pack_i8(f0.x * sc, f0.y * sc, f0.z * sc, f0.w * sc); w1 = pack_i8(f1.x * sc, f1.y * sc, f1.z * sc, f1.w * sc);
      w2 = pack_i8(f2.x * sc, f2.y * sc, f2.z * sc, f2.w * sc); w3 = pack_i8(f3.x * sc, f3.y * sc, f3.z * sc, f3.w * sc);
    }
    *(uint4*)((isv ? pv : pu) + (size_t)(lane >> 3) * PSLICE + (size_t)e * 128 + 16 * (lane & 7)) = make_uint4((unsigned)w0, (unsigned)w1, (unsigned)w2, (unsigned)w3);
    if (lane == 0) (isv ? psv : psu)[e] = inv;
  }
}
DEV void unpack16_fp8x2(const uint4& u, f32x2* f) {
  f[0] = __builtin_amdgcn_cvt_pk_f32_fp8((int)u.x, false); f[1] = __builtin_amdgcn_cvt_pk_f32_fp8((int)u.x, true);
  f[2] = __builtin_amdgcn_cvt_pk_f32_fp8((int)u.y, false); f[3] = __builtin_amdgcn_cvt_pk_f32_fp8((int)u.y, true);
  f[4] = __builtin_amdgcn_cvt_pk_f32_fp8((int)u.z, false); f[5] = __builtin_amdgcn_cvt_pk_f32_fp8((int)u.z, true);
  f[6] = __builtin_amdgcn_cvt_pk_f32_fp8((int)u.w, false); f[7] = __builtin_amdgcn_cvt_pk_f32_fp8((int)u.w, true);
}
DEV void unpack16_fp8(const uint4& u, float* f) {
  f32x2 t;
  t = __builtin_amdgcn_cvt_pk_f32_fp8((int)u.x, false); f[0] = t[0]; f[1] = t[1];
  t = __builtin_amdgcn_cvt_pk_f32_fp8((int)u.x, true); f[2] = t[0]; f[3] = t[1];
  t = __builtin_amdgcn_cvt_pk_f32_fp8((int)u.y, false); f[4] = t[0]; f[5] = t[1];
  t = __builtin_amdgcn_cvt_pk_f32_fp8((int)u.y, true); f[6] = t[0]; f[7] = t[1];
  t = __builtin_amdgcn_cvt_pk_f32_fp8((int)u.z, false); f[8] = t[0]; f[9] = t[1];
  t = __builtin_amdgcn_cvt_pk_f32_fp8((int)u.z, true); f[10] = t[0]; f[11] = t[1];
  t = __builtin_amdgcn_cvt_pk_f32_fp8((int)u.w, false); f[12] = t[0]; f[13] = t[1];
  t = __builtin_amdgcn_cvt_pk_f32_fp8((int)u.w, true); f[14] = t[0]; f[15] = t[1];
}

DEV void bitonic_sort16_desc(float (&v)[16]) {
#pragma unroll
  for (int k = 2; k <= 16; k <<= 1)
#pragma unroll
    for (int j = k >> 1; j >= 1; j >>= 1)
#pragma unroll
      for (int i = 0; i < 16; ++i) {
        const int l = i ^ j;
        if (l > i) {
          const float hi = fmaxf(v[i], v[l]), lo = fminf(v[i], v[l]);
          if ((i & k) == 0) { v[i] = hi; v[l] = lo; } else { v[i] = lo; v[l] = hi; }
        }
      }
}
struct Epi3 {
  const P& p; int row0, grp;
  DEV void operator()(f32x4 (&acc)[4][4], int wr, int wc, int fr, int fq, char* smem) const {
    float* sc = (float*)smem;
    const int tid = tid_();
    for (int pass = 0; pass < 2; ++pass) {
      __syncthreads();
      if (wr == pass) {
#pragma unroll
        for (int m = 0; m < 4; ++m)
#pragma unroll
          for (int n = 0; n < 4; ++n)
#pragma unroll
            for (int j = 0; j < 4; ++j) {
              int rl = m * 16 + fq * 4 + j, col = wc * 64 + n * 16 + fr;
              unsigned bits = (__float_as_uint(acc[m][n][j]) & ~127u) | (unsigned)col;
              sc[rl * 133 + (col >> 5) * 33 + (col & 31)] = __uint_as_float(bits);
            }
      }
      __syncthreads();
      const int rl = tid >> 2, q = tid & 3;
      const float* src = sc + rl * 133 + q * 33;
      float Ls[16], Hs[16];
#pragma unroll
      for (int i = 0; i < 16; ++i) { Ls[i] = src[i]; Hs[i] = src[16 + i]; }
      bitonic_sort16_desc(Ls);
      bitonic_sort16_desc(Hs);
#pragma unroll
      for (int i = 0; i < 16; ++i) Ls[i] = fmaxf(Ls[i], Hs[15 - i]);
#pragma unroll
      for (int d = 8; d >= 1; d >>= 1)
#pragma unroll
        for (int i = 0; i < 16; ++i)
          if ((i & d) == 0) { float hi = fmaxf(Ls[i], Ls[i + d]), lo = fminf(Ls[i], Ls[i + d]); Ls[i] = hi; Ls[i + d] = lo; }
      float Cs[16];
#pragma unroll
      for (int i = 0; i < 16; ++i) Cs[i] = fmaxf(Ls[i], dppself<0xB1, 0xF>(Ls[15 - i]));
#pragma unroll
      for (int d = 8; d >= 1; d >>= 1)
#pragma unroll
        for (int i = 0; i < 16; ++i)
          if ((i & d) == 0) { float hi = fmaxf(Cs[i], Cs[i + d]), lo = fminf(Cs[i], Cs[i + d]); Cs[i] = hi; Cs[i + d] = lo; }
      float Ds[16];
#pragma unroll
      for (int i = 0; i < 16; ++i) Ds[i] = fmaxf(Cs[i], dppself<0x4E, 0xF>(Cs[15 - i]));
#pragma unroll
      for (int d = 8; d >= 1; d >>= 1)
#pragma unroll
        for (int i = 0; i < 16; ++i)
          if ((i & d) == 0) { float hi = fmaxf(Ds[i], Ds[i + d]), lo = fminf(Ds[i], Ds[i + d]); Ds[i] = hi; Ds[i + d] = lo; }
      if (q == 0) {
        float* dst = p.TK + ((size_t)(row0 + pass * 64 + rl) * 16 + grp) * 16;
#pragma unroll
        for (int i = 0; i < 4; ++i) *(float4*)(dst + 4 * i) = make_float4(Ds[4 * i], Ds[4 * i + 1], Ds[4 * i + 2], Ds[4 * i + 3]);
      }
    }
  }
};
DEV void ph_gemm3(const P& p, char* smem) {
  int rt, ct;
  for (int it = 0; gemm_unit(it, 16, rt, ct); ++it) {
    Epi3 epi{p, rt * 128, ct};
    gemm_tile(p.H + (size_t)rt * 128 * D, D, p.Wft + (size_t)ct * 128 * D, D, D, smem, epi);
  }
}

DEV float peer_gate(float scr) {
  float mx = row16_max(scr);
  float ex = __expf(scr - mx);
  float sm = row16_sum(ex);
  return ex / sm;
}
DEV float gelu_exact(float x) { return 0.5f * x * (1.f + erff(x * 0.7071067811865476f)); }

DEV void ph_peer_select(const P& p) {
  const int gw = (bid_() * 256 + tid_()) >> 6, nw = gridDim.x * 4, lane = tid_() & 63;
  int ci, cj;
  {
    const int c = lane;
    if (c < 16) { ci = 0; cj = c; } else if (c < 24) { ci = 1; cj = c - 16; } else if (c < 29) { ci = 2; cj = c - 24; }
    else if (c < 33) { ci = 3; cj = c - 29; } else if (c < 36) { ci = 4; cj = c - 33; } else if (c < 38) { ci = 5; cj = c - 36; }
    else if (c < 40) { ci = 6; cj = c - 38; } else if (c < 42) { ci = 7; cj = c - 40; } else { ci = (c - 42 + 8) & 15; cj = 0; }
  }
  const bool cand = lane < 50;
  float v1s[8], v2s[8];
  auto ldtk = [&](int row) {
    const float* tk = p.TK + (size_t)row * 256;
#pragma unroll
    for (int h = 0; h < 8; ++h) { v1s[h] = tk[(2 * h) * 16 + ci]; v2s[h] = tk[(2 * h + 1) * 16 + cj]; }
  };
  if (gw < NTOK) ldtk(gw);
#pragma unroll 1
  for (int row = gw; row < NTOK; row += nw) {
    float c1[8], c2[8];
#pragma unroll
    for (int h = 0; h < 8; ++h) { c1[h] = v1s[h]; c2[h] = v2s[h]; }
    if (row + nw < NTOK) ldtk(row + nw);
#pragma unroll
    for (int h = 0; h < 8; ++h) {
      const float v1 = c1[h], v2 = c2[h];
      float val = v1 + v2;
      val = __uint_as_float((__float_as_uint(val) & ~63u) | (unsigned)lane);
      val = cand ? val : -3e38f;
      int rank = 0;
#pragma unroll
      for (int q = 0; q < 50; ++q) rank += (readlane_f(val, q) > val) ? 1 : 0;
      const bool sel = cand && rank < 16;
      const float mx = wave_max(val);
      const float ex = sel ? __expf(val - mx) : 0.f;
      const float sm = wave_sum(ex);
      if (sel) {
        const int e = (int)(__float_as_uint(v1) & 127u) * 128 + (int)(__float_as_uint(v2) & 127u);
        p.EL[(size_t)row * 128 + h * 16 + rank] = (unsigned short)e;
        p.GT[(size_t)row * 128 + h * 16 + rank] = ex / sm;
      }
    }
  }
}

struct PeerPre { uint4 e0, e1, a0, a1, a2, a3; };
DEV unsigned peer_eid(const PeerPre& s, int j) {
  const unsigned w = (j < 8) ? ((j >> 1) == 0 ? s.e0.x : (j >> 1) == 1 ? s.e0.y : (j >> 1) == 2 ? s.e0.z : s.e0.w)
                             : (((j - 8) >> 1) == 0 ? s.e1.x : ((j - 8) >> 1) == 1 ? s.e1.y : ((j - 8) >> 1) == 2 ? s.e1.z : s.e1.w);
  return (j & 1) ? (w >> 16) : (w & 0xFFFFu);
}
template <int WHICH>
DEV void peer_wave_run(const P& p, int layer, int x, int tok0, int lane, float* wbuf) {
  const int r = lane >> 3, c = lane & 7;
  const unsigned char* tb = (WHICH == 0 ? p.PU : p.PV) + (size_t)x * PSLICE + c * 16;
  PeerPre S[3];
  uint4 R[16];
  auto ld_pre = [&](int tok, PeerPre& s) {
    const uint4* elp = (const uint4*)(p.EL + (size_t)tok * 128 + r * 16);
    s.e0 = elp[0]; s.e1 = elp[1];
    if (WHICH == 0) {
      s.a0 = *(const uint4*)(p.H8 + (size_t)tok * 1024 + x * 128 + c * 16);
    } else {
      const uint4* wtp = (const uint4*)(p.GT + (size_t)tok * 128 + r * 16);
      s.a0 = wtp[0]; s.a1 = wtp[1]; s.a2 = wtp[2]; s.a3 = wtp[3];
    }
  };
  auto comp = [&](int tok, const PeerPre& s, const PeerPre& sn, bool more) {
    if (WHICH == 0) {
      int keep0 = 0, keep1 = 0;
#pragma unroll
      for (int j = 0; j < 16; ++j) {
        const uint4 rw = R[j];
        if (more) R[j] = *(const uint4*)(tb + (size_t)peer_eid(sn, j) * 128);
        int d = __builtin_amdgcn_sdot4((int)rw.x, (int)s.a0.x, 0, false);
        d = __builtin_amdgcn_sdot4((int)rw.y, (int)s.a0.y, d, false);
        d = __builtin_amdgcn_sdot4((int)rw.z, (int)s.a0.z, d, false);
        d = __builtin_amdgcn_sdot4((int)rw.w, (int)s.a0.w, d, false);
        d += __builtin_amdgcn_update_dpp(0, d, 0xB1, 0xF, 0xF, false);
        d += __builtin_amdgcn_update_dpp(0, d, 0x4E, 0xF, 0xF, false);
        d += __builtin_amdgcn_update_dpp(0, d, 0x141, 0xF, 0xF, false);
        if (j < 8) keep0 = (c == j) ? d : keep0; else keep1 = (c == j - 8) ? d : keep1;
      }
      float* pd = p.PD + ((size_t)x * NTOK + tok) * 128 + r * 16 + c;
      pd[0] = (float)keep0; pd[8] = (float)keep1;
    } else {
      const float wsv[16] = {__uint_as_float(s.a0.x), __uint_as_float(s.a0.y), __uint_as_float(s.a0.z), __uint_as_float(s.a0.w),
                             __uint_as_float(s.a1.x), __uint_as_float(s.a1.y), __uint_as_float(s.a1.z), __uint_as_float(s.a1.w),
                             __uint_as_float(s.a2.x), __uint_as_float(s.a2.y), __uint_as_float(s.a2.z), __uint_as_float(s.a2.w),
                             __uint_as_float(s.a3.x), __uint_as_float(s.a3.y), __uint_as_float(s.a3.z), __uint_as_float(s.a3.w)};
      f32x2 acc2[8];
#pragma unroll
      for (int i = 0; i < 8; ++i) acc2[i] = (f32x2){0.f, 0.f};
#pragma unroll
      for (int j = 0; j < 16; ++j) {
        f32x2 f[8];
        unpack16_fp8x2(R[j], f);
        if (more) R[j] = *(const uint4*)(tb + (size_t)peer_eid(sn, j) * 128);
        const f32x2 w2 = (f32x2){wsv[j], wsv[j]};
#pragma unroll
        for (int i = 0; i < 8; ++i) acc2[i] += w2 * f[i];
      }
      float* slab = wbuf + (r * 8 + c) * 16;
      *(float4*)(slab) = make_float4(acc2[0][0], acc2[0][1], acc2[1][0], acc2[1][1]);
      *(float4*)(slab + 4) = make_float4(acc2[2][0], acc2[2][1], acc2[3][0], acc2[3][1]);
      *(float4*)(slab + 8) = make_float4(acc2[4][0], acc2[4][1], acc2[5][0], acc2[5][1]);
      *(float4*)(slab + 12) = make_float4(acc2[6][0], acc2[6][1], acc2[7][0], acc2[7][1]);
      asm volatile("s_waitcnt lgkmcnt(0)" ::: "memory");
      float o0 = 0.f, o1 = 0.f;
#pragma unroll
      for (int rr = 0; rr < 8; ++rr) {
        const float2 t = *(const float2*)(wbuf + (rr * 8 + (lane >> 3)) * 16 + 2 * (lane & 7));
        o0 += t.x; o1 += t.y;
      }
      asm volatile("s_waitcnt lgkmcnt(0)" ::: "memory");
      const int b = tok / LT, pp = tok % LT;
      const int mr = pp < LC ? 16 : b;
      const int col = x * 128 + 2 * lane;
      const float* g2 = p.modv + ((size_t)layer * 17 + mr) * 6144 + 5120 + col;
      unsigned* xp = (unsigned*)(p.X + (size_t)tok * D + col);
      const unsigned xu = *xp;
#if EN_PEER
      *xp = pack2(bflo(xu) + g2[0] * o0, bfhi(xu) + g2[1] * o1);
#endif
    }
  };
  ld_pre(tok0, S[0]);
  ld_pre(tok0 + 1, S[1]);
#pragma unroll
  for (int j = 0; j < 16; ++j) R[j] = *(const uint4*)(tb + (size_t)peer_eid(S[0], j) * 128);
  ld_pre(tok0 + 2, S[2]);
#pragma unroll
  for (int t = 0; t < 8; ++t) {
    comp(tok0 + t, S[t % 3], S[(t + 1) % 3], t + 1 < 8);
    if (t + 3 < 8) ld_pre(tok0 + t + 3, S[t % 3]);
  }
}
DEV void ph_peer_w(const P& p) {
  for (size_t i = (size_t)bid_() * 256 + tid_(); i < (size_t)NTOK * 128; i += (size_t)gridDim.x * 256) {
    float d = 0.f;
#pragma unroll
    for (int x = 0; x < 8; ++x) d += p.PD[(size_t)x * NTOK * 128 + i];
    const int e = p.EL[i];
    p.GT[i] = p.GT[i] * gelu_exact(d * p.PSU[e] * p.HINV[i >> 7]) * p.PSV[e];
  }
}
template <int WHICH>
DEV void ph_peer_gather(const P& p, int layer, char* smem, volatile LAS unsigned* slot) {
  const int tid = tid_(), lane = tid & 63, wid = tid >> 6;
  unsigned* q = p.wq + 1024 + layer * 256 + WHICH * 128;
  const int my = (int)(xb_xcc_id() & 7u);
  float* wbuf = (float*)smem + wid * 1024;
#pragma unroll 1
  for (int rot = 0; rot < 8; ++rot) {
    const int x = (my + rot) & 7;
    for (;;) {
      __syncthreads();
      if (tid == 0) *slot = atomicAdd(q + x * 16, 1u);
      __syncthreads();
      const int it = (int)*slot;
      if (it >= NTOK / 32) break;
      peer_wave_run<WHICH>(p, layer, x, it * 32 + wid * 8, lane, wbuf);
    }
  }
}

DEV void ph_final(const P& p) {
  const int lane = tid_() & 63;
  int r0, r1;
  wave_range(r0, r1, NB * T);
  float gv[16];
#pragma unroll
  for (int hh = 0; hh < 2; ++hh)
#pragma unroll
    for (int i = 0; i < 8; ++i) gv[hh * 8 + i] = p.final_g[hh * 512 + 8 * lane + i];
  auto xrow = [&](int r) -> const bf16_t* { const int b = r / T, t = r % T; return p.X + ((size_t)b * LT + LC + t) * D; };
  uint4 n0 = make_uint4(0, 0, 0, 0), n1 = n0;
  if (r0 < r1) { const bf16_t* xr = xrow(r0); n0 = *(const uint4*)(xr + 8 * lane); n1 = *(const uint4*)(xr + 512 + 8 * lane); }
#pragma unroll 1
  for (int r = r0; r < r1; ++r) {
    const uint4 u0 = n0, u1 = n1;
    if (r + 1 < r1) { const bf16_t* xr = xrow(r + 1); n0 = *(const uint4*)(xr + 8 * lane); n1 = *(const uint4*)(xr + 512 + 8 * lane); }
    float v[16];
    unpack8(u0, v); unpack8(u1, v + 8);
    float ss = 0.f;
#pragma unroll
    for (int i = 0; i < 16; ++i) ss += v[i] * v[i];
    ss = wave_sum(ss);
    const float rstd = rsqrtf(ss * (1.f / 1024.f) + 1e-6f);
    float* o = p.out + (size_t)r * D;
#pragma unroll
    for (int hh = 0; hh < 2; ++hh) {
      const int col = hh * 512 + 8 * lane;
      *(float4*)(o + col) = make_float4(v[hh * 8 + 0] * rstd * gv[hh * 8 + 0], v[hh * 8 + 1] * rstd * gv[hh * 8 + 1], v[hh * 8 + 2] * rstd * gv[hh * 8 + 2], v[hh * 8 + 3] * rstd * gv[hh * 8 + 3]);
      *(float4*)(o + col + 4) = make_float4(v[hh * 8 + 4] * rstd * gv[hh * 8 + 4], v[hh * 8 + 5] * rstd * gv[hh * 8 + 5], v[hh * 8 + 6] * rstd * gv[hh * 8 + 6], v[hh * 8 + 7] * rstd * gv[hh * 8 + 7]);
    }
  }
}

DEV unsigned hw_cu_key() {
  const unsigned hwid = (unsigned)__builtin_amdgcn_s_getreg(((8 - 1) << 11) | (8 << 6) | 4);
  return (xb_xcc_id() << 8) | (hwid & 0xFFu);
}
DEV void mixB(const P& p, int layer, char* smem, volatile LAS unsigned* slot) {
  unsigned* qa = p.wq + layer * 64;
  unsigned* qs = qa + 16;
  unsigned* claim = p.cuclaim + layer * 4096;
  __syncthreads();
  if (tid_() == 0) {
    unsigned u = 0xFFFFFFFFu;
    if (atomicAdd(&claim[hw_cu_key() & 4095u], 1u) == 0u) u = atomicAdd(qs, 1u);
    *slot = u;
  }
  __syncthreads();
  {
    const unsigned u = *slot;
    if (u < 128u) scanc_unit(p, layer, (int)u, smem);
  }
  for (;;) {
    __syncthreads();
    if (tid_() == 0) *slot = atomicAdd(qa, 1u);
    __syncthreads();
    const int u = (int)*slot;
    if (u >= 8704) break;
    if (u < 4352) attn_unit(p, layer, u, smem); else hyena_conv_unit(p, layer, u - 4352, smem);
  }
  if (layer + 1 < NLAYERS) {
    unsigned* qp = qa + 32;
    for (;;) {
      __syncthreads();
      if (tid_() == 0) *slot = atomicAdd(qp, 1u);
      __syncthreads();
      const int u = (int)*slot;
      if (u >= PREPA_N) break;
      prep_unit(p, layer + 1, prepA_unit_index(u), smem);
    }
  }
  for (;;) {
    __syncthreads();
    if (tid_() == 0) *slot = atomicAdd(qs, 1u);
    __syncthreads();
    const unsigned u = *slot;
    if (u >= 128u) break;
    scanc_unit(p, layer, (int)u, smem);
  }
}
DEV void mixA(const P& p, int layer, char* smem) {
  for (int u = bid_(); u < 1088; u += gridDim.x) hyena_pre_unit(p, layer, u);
  ph_lora(p, layer, smem);
  ph_rwkv_prep(p, layer);
}
DEV void mixC(const P& p, int layer, char* smem) {
  for (int u = bid_(); u < 1088; u += gridDim.x) hyena_post_unit(p, layer, u, smem);
  ph_rwkv_post(p, layer);
  ph_attn_post(p, layer);
}

__global__ void __launch_bounds__(256, 2) k_mega(P p) {
  extern __shared__ __attribute__((aligned(16))) char smem_all[];
  char* smem = smem_all;
  volatile LAS unsigned* xbw = (volatile LAS unsigned*)(smem_all + SMEM_BYTES);
  if (threadIdx.x == 0) { xbw[0] = 0u; xbw[1] = 0u; xbw[2] = 0u; xbw[3] = 0u; }
  __syncthreads();
  XcdBarrier bar = xcd_barrier_post(p.bar, xbw);
#ifndef NO_PRO
  ph_copy(p);
  ph_rope(p);
  for (int u = blockIdx.x; u < 96; u += gridDim.x) modv_unit(p, u, smem);
#endif
#ifndef NO_PREP
  ph_prep(p, 0, smem, false);
#endif
  xcd_barrier(bar);
  for (int layer = 0; layer < NLAYERS; ++layer) {
#ifndef NO_NORM
    ph_norm(p, layer, 0);
#endif
    xcd_barrier(bar);
#ifdef PROBE_GEMM
    ph_gemm1(p, smem);
#endif
#ifndef NO_GEMM1
    ph_gemm1(p, smem);
#endif
    xcd_barrier(bar);
#ifndef NO_MIXA
    mixA(p, layer, smem);
#endif
    xcd_barrier(bar);
#ifndef NO_MIXB
    mixB(p, layer, smem, (volatile LAS unsigned*)(smem_all + SMEM_BYTES + 16));
#endif
    xcd_barrier(bar);
#ifndef NO_MIXC
    mixC(p, layer, smem);
#endif
    xcd_barrier(bar);
#ifndef NO_GEMM2
    ph_gemm2(p, layer, smem);
    ph_peerconv(p, layer);
#endif
    xcd_barrier(bar);
#ifndef NO_NORM
    ph_norm(p, layer, 1);
#endif
    xcd_barrier(bar);
#ifdef PROBE_GEMM
    ph_gemm3(p, smem);
#endif
#ifndef NO_GEMM3
    ph_gemm3(p, smem);
#endif
    xcd_barrier(bar);
    ph_peer_select(p);
    xcd_barrier(bar);
    ph_peer_gather<0>(p, layer, smem, (volatile LAS unsigned*)(smem_all + SMEM_BYTES + 16));
    xcd_barrier(bar);
    ph_peer_w(p);
    xcd_barrier(bar);
    ph_peer_gather<1>(p, layer, smem, (volatile LAS unsigned*)(smem_all + SMEM_BYTES + 16));
#ifndef NO_PREP
    if (layer + 1 < NLAYERS) ph_prep(p, layer + 1, smem, true);
#endif
    xcd_barrier(bar);
  }
  ph_final(p);
}

static inline size_t al256(size_t x) { return (x + 255) & ~(size_t)255; }

extern "C" void kernel_launch(void* const* d_in, const int* in_sizes, int n_in, void* d_out, int out_size, void* d_ws, size_t ws_size,
                              hipStream_t stream) {
  (void)in_sizes; (void)n_in; (void)out_size; (void)ws_size;
  P p{};
  const float** f = (const float**)&p;
  for (int i = 0; i < 39; ++i) f[i] = (const float*)d_in[i];
  p.out = (float*)d_out;
  char* w = (char*)d_ws;
  size_t off = 0;
  auto take = [&](size_t bytes) { char* r = w + off; off += al256(bytes); return r; };
  p.bar = (unsigned*)take(16384);
  p.modv = (float*)take((size_t)DEPTH * 17 * 6144 * 4);
  p.SSQ = (float*)take((size_t)DEPTH * 2 * 256 * 4);
  p.wq = (unsigned*)take(4096 + DEPTH * 1024);
  p.cuclaim = (unsigned*)take((size_t)DEPTH * 4096 * 4);
  const size_t zero_bytes = off;
  p.rope = (float*)take(64 * 16 * 2 * 4);
  p.X = (bf16_t*)take((size_t)NTOK * D * 2);
  p.H = (bf16_t*)take((size_t)NTOK * D * 2);
  p.Y = (bf16_t*)take((size_t)NTOK * D * 2);
  p.SC = (bf16_t*)take((size_t)NTOK * 1024 * 2);
  p.Z = (bf16_t*)take((size_t)NTOK * INW * 2);
  p.UTl = (bf16_t*)take((size_t)256 * 16 * T * 2);
  p.UTc = (bf16_t*)take((size_t)256 * 16 * LC * 2);
  p.YTl = (bf16_t*)take((size_t)256 * 16 * T * 2);
  p.YTc = (bf16_t*)take((size_t)256 * 16 * LC * 2);
  p.FL = (float*)take((size_t)256 * 2 * T * 4);
  p.FC = (float*)take((size_t)256 * 2 * LC * 4);
  p.W1t = (bf16_t*)take((size_t)INW * D * 2);
  p.W2t = (bf16_t*)take((size_t)D * D * 2);
  p.Wft = (bf16_t*)take((size_t)2048 * D * 2);
  p.Wlt = (bf16_t*)take((size_t)1024 * 256 * 2);
  p.Wgt = (bf16_t*)take((size_t)256 * 128 * 2);
  p.TK = (float*)p.Z;
  p.PU = (unsigned char*)p.Z + al256((size_t)NTOK * 256 * 4);
  p.PV = p.PU + (size_t)16384 * 1024;
  p.PSU = (float*)(p.PV + (size_t)16384 * 1024);
  p.PSV = p.PSU + 16384;
  p.GT = p.PSV + 16384;
  p.EL = (unsigned short*)(p.GT + (size_t)NTOK * 128);
  p.H8 = (unsigned char*)p.EL + al256((size_t)NTOK * 128 * 2);
  p.HINV = (float*)(p.H8 + (size_t)NTOK * 1024);
  p.PD = (float*)p.Y;

  (void)hipMemsetAsync(d_ws, 0, zero_bytes, stream);
  constexpr size_t kDynLds = SMEM_BYTES + 32;
  static int grid = 0;
  if (!grid) {
    int dev = 0, cus = 0, per_cu = 0;
    (void)hipGetDevice(&dev);
    (void)hipDeviceGetAttribute(&cus, hipDeviceAttributeMultiprocessorCount, dev);
    (void)hipFuncSetAttribute((const void*)k_mega, hipFuncAttributeMaxDynamicSharedMemorySize, (int)kDynLds);
    (void)hipOccupancyMaxActiveBlocksPerMultiprocessor(&per_cu, k_mega, 256, kDynLds);
    if (cus <= 0) cus = 256;
    if (per_cu > 2) per_cu = 2;
    if (per_cu < 1) per_cu = 1;
    grid = cus * per_cu;
  }
  k_mega<<<grid, 256, kDynLds, stream>>>(p);
}
```

```cpp
#include <hip/hip_runtime.h>
#include <stdint.h>
#include <type_traits>

#define DEV __device__ __forceinline__
typedef unsigned short bf16_t;
typedef short bf16x8 __attribute__((ext_vector_type(8)));
typedef float f32x2 __attribute__((ext_vector_type(2)));
constexpr size_t PSLICE = (size_t)16384 * 128;
typedef float f32x4 __attribute__((ext_vector_type(4)));
typedef float f32x16 __attribute__((ext_vector_type(16)));

#ifndef NLAYERS
#define NLAYERS 4
#endif
#ifndef EN_HY
#define EN_HY 1
#endif
#ifndef EN_RW
#define EN_RW 1
#endif
#ifndef EN_AT
#define EN_AT 1
#endif
#ifndef EN_MIX
#define EN_MIX 1
#endif
#ifndef EN_PEER
#define EN_PEER 1
#endif

constexpr int NB = 16, T = 4096, LC = 256, LT = 4352, D = 1024, NTOK = NB * LT, INW = 2688, DEPTH = 4;
constexpr int SMEM_BYTES = 65536;

struct P {
  const float *x, *c, *ctx, *c_ctx, *mod_w, *mod_b, *norm1_g, *norm2_g, *w_in, *conv_w, *conv_b;
  const float *hy_w1, *hy_b1, *hy_w2, *hy_b2, *hy_w3, *hy_b3, *hy_freq, *hy_bias;
  const float *rw_w0, *rw_w_up, *rw_a0, *rw_a_up, *rw_g_up, *rw_k_k, *rw_k_a, *rw_r_k, *rw_ln_w, *rw_ln_b;
  const float *attn_sink, *hy_out_g, *at_out_g, *w_out, *peer_wq, *peer_k1, *peer_k2, *peer_u, *peer_v, *final_g;
  float* out;
  unsigned* bar;
  float *modv, *SSQ, *rope, *FL, *FC, *TK;
  unsigned *wq, *cuclaim;
  bf16_t *X, *H, *Y, *SC, *Z, *UTl, *UTc, *YTl, *YTc;
  bf16_t *W1t, *W2t, *Wft, *Wlt, *Wgt;
  unsigned char *PU, *PV;
  float *PSU, *PSV, *GT, *PD, *HINV;
  unsigned short* EL;
  unsigned char* H8;
};

typedef __bf16 hwbf2 __attribute__((ext_vector_type(2)));
DEV unsigned pack2(float a, float b) { f32x2 f = {a, b}; hwbf2 r = __builtin_convertvector(f, hwbf2); return __builtin_bit_cast(unsigned, r); }
DEV bf16_t f2bf(float f) { return (bf16_t)(pack2(f, 0.f) & 0xFFFFu); }
DEV float bf2f(bf16_t h) { return __uint_as_float(((unsigned)h) << 16); }
DEV float bflo(unsigned u) { return __uint_as_float(u << 16); }
DEV float bfhi(unsigned u) { return __uint_as_float(u & 0xFFFF0000u); }
DEV void unpack8(const uint4& u, float* v) {
  v[0] = bflo(u.x); v[1] = bfhi(u.x); v[2] = bflo(u.y); v[3] = bfhi(u.y);
  v[4] = bflo(u.z); v[5] = bfhi(u.z); v[6] = bflo(u.w); v[7] = bfhi(u.w);
}
DEV uint4 pack8(const float* v) { return make_uint4(pack2(v[0], v[1]), pack2(v[2], v[3]), pack2(v[4], v[5]), pack2(v[6], v[7])); }
DEV int pack_i8(float a, float b, float c, float d) {
  const int ia = __float2int_rn(a), ib = __float2int_rn(b), ic = __float2int_rn(c), id = __float2int_rn(d);
  return (ia & 0xFF) | ((ib & 0xFF) << 8) | ((ic & 0xFF) << 16) | ((id & 0xFF) << 24);
}
DEV float sigmoidf_(float x) { return __builtin_amdgcn_rcpf(1.f + __expf(-x)); }

template <int CTRL, int ROWMASK>
DEV float dpp0(float x) {
  return __builtin_bit_cast(float, __builtin_amdgcn_update_dpp(0, __builtin_bit_cast(int, x), CTRL, ROWMASK, 0xF, false));
}
template <int CTRL, int ROWMASK>
DEV float dppself(float x) {
  int xi = __builtin_bit_cast(int, x);
  return __builtin_bit_cast(float, __builtin_amdgcn_update_dpp(xi, xi, CTRL, ROWMASK, 0xF, false));
}
DEV float readlane_f(float x, int l) { return __builtin_bit_cast(float, __builtin_amdgcn_readlane(__builtin_bit_cast(int, x), l)); }
DEV int lane_id() { return (int)__builtin_amdgcn_mbcnt_hi(~0u, __builtin_amdgcn_mbcnt_lo(~0u, 0u)); }
DEV float writelane_f(float val, int l, float old) { return lane_id() == l ? val : old; }
DEV int writelane_i(int val, int l, int old) { return lane_id() == l ? val : old; }
DEV float wave_sum(float x) {
  x += dpp0<0x111, 0xF>(x); x += dpp0<0x112, 0xF>(x); x += dpp0<0x114, 0xF>(x); x += dpp0<0x118, 0xF>(x);
  x += dpp0<0x142, 0xA>(x); x += dpp0<0x143, 0xC>(x);
  return readlane_f(x, 63);
}
DEV float wave_max(float x) {
  x = fmaxf(x, dppself<0x111, 0xF>(x)); x = fmaxf(x, dppself<0x112, 0xF>(x)); x = fmaxf(x, dppself<0x114, 0xF>(x));
  x = fmaxf(x, dppself<0x118, 0xF>(x)); x = fmaxf(x, dppself<0x142, 0xA>(x)); x = fmaxf(x, dppself<0x143, 0xC>(x));
  return readlane_f(x, 63);
}
DEV float row16_sum(float x) {
  x += dpp0<0xB1, 0xF>(x); x += dpp0<0x4E, 0xF>(x); x += dpp0<0x141, 0xF>(x); x += dpp0<0x140, 0xF>(x);
  return x;
}
DEV float row16_max(float x) {
  x = fmaxf(x, dppself<0xB1, 0xF>(x)); x = fmaxf(x, dppself<0x4E, 0xF>(x)); x = fmaxf(x, dppself<0x141, 0xF>(x));
  x = fmaxf(x, dppself<0x140, 0xF>(x));
  return x;
}
DEV float quad_sum(float x) { x += dpp0<0xB1, 0xF>(x); x += dpp0<0x4E, 0xF>(x); return x; }

DEV f32x4 mfma16(bf16x8 a, bf16x8 b, f32x4 c) { return __builtin_amdgcn_mfma_f32_16x16x32_bf16(a, b, c, 0, 0, 0); }
DEV f32x16 mfma32(bf16x8 a, bf16x8 b, f32x16 c) { return __builtin_amdgcn_mfma_f32_32x32x16_bf16(a, b, c, 0, 0, 0); }


#define XB_TMO      128
#define XB_XCNT(j)  (256  + 64 * (j))
#define XB_XSUB(j)  (1280 + 64 * (j))
#define XB_XGEN(j)  (2304 + 64 * (j))
#define XB_TOP      3328
#define XB_TOPGEN   3392
#define XCD_BAR_WORDS 3456
#define XB_SPIN_CAP (1u << 23)
#define LAS __attribute__((address_space(3)))

__device__ __forceinline__ unsigned xb_ld(unsigned* p)              { return __hip_atomic_load(p, __ATOMIC_RELAXED, __HIP_MEMORY_SCOPE_AGENT); }
__device__ __forceinline__ unsigned xb_add(unsigned* p, unsigned v) { return __hip_atomic_fetch_add(p, v, __ATOMIC_RELAXED, __HIP_MEMORY_SCOPE_AGENT); }
__device__ __forceinline__ unsigned xb_xcc_id() { return (unsigned)__builtin_amdgcn_s_getreg((3 << 11) | 20) & 0xFu; }
#define XB_SPIN(cond, bar) do { unsigned _sp = 0; while (cond) { __builtin_amdgcn_s_sleep(1); \
    if ((++_sp & 255u) == 0u) { if (xb_ld(&(bar)[XB_TMO])) break; if (_sp > XB_SPIN_CAP) { atomicAdd(&(bar)[XB_TMO], 1u); break; } } } } while (0)

struct XcdBarrier {
    unsigned* bar; unsigned x;
    volatile LAS unsigned* st;
};
__device__ __forceinline__ XcdBarrier xcd_barrier_post(unsigned* bar, volatile LAS unsigned* st) {
    XcdBarrier b; b.bar = bar; b.x = xb_xcc_id(); b.st = st;
    if (threadIdx.x == 0) (void)xb_add(&bar[XB_XCNT(b.x)], 1u);
    return b;
}
__device__ __forceinline__ void xcd_barrier_complete(unsigned* bar, unsigned x, unsigned& nloc, unsigned& nx) {
    const unsigned G = gridDim.x * gridDim.y * gridDim.z;
    unsigned sum, cnt, mine, sp = 0u;
    for (;;) {
        sum = 0u; cnt = 0u; mine = 0u;
#pragma unroll
        for (unsigned j = 0; j < 16; ++j) { const unsigned c = xb_ld(&bar[XB_XCNT(j)]); sum += c; cnt += (c > 0u) ? 1u : 0u; mine = (j == x) ? c : mine; }
        if (sum == G) break;
        __builtin_amdgcn_s_sleep(1);
        if ((++sp & 255u) == 0u) { if (xb_ld(&bar[XB_TMO])) break; if (sp > XB_SPIN_CAP) { atomicAdd(&bar[XB_TMO], 1u); break; } }
    }
    nloc = mine > 0u ? mine : 1u; nx = cnt > 0u ? cnt : 1u;
}
__device__ __forceinline__ void xcd_barrier(const XcdBarrier& b) {
    asm volatile("s_waitcnt vmcnt(0)" ::: "memory");
    __syncthreads();
    if (threadIdx.x == 0) {
        unsigned* bar = b.bar;
        __builtin_amdgcn_s_waitcnt(0);
        unsigned nloc = b.st[0], nx = b.st[1];
        if (nloc == 0u) { xcd_barrier_complete(bar, b.x, nloc, nx); b.st[0] = nloc; b.st[1] = nx; }
        const unsigned old = xb_add(&bar[XB_XSUB(b.x)], 1u);
        const unsigned gen = old / nloc;
        if (old + 1u == (gen + 1u) * nloc) {
            __builtin_amdgcn_fence(__ATOMIC_RELEASE, "agent");
            asm volatile("s_waitcnt vmcnt(0)" ::: "memory");
            const unsigned og = xb_add(&bar[XB_TOP], 1u);
            const unsigned tg = og / nx;
            if (og + 1u == (tg + 1u) * nx) xb_add(&bar[XB_TOPGEN], 1u);
            else XB_SPIN(xb_ld(&bar[XB_TOPGEN]) == tg, bar);
            __builtin_amdgcn_fence(__ATOMIC_ACQUIRE, "agent");
            xb_add(&bar[XB_XGEN(b.x)], 1u);
            asm volatile("s_waitcnt vmcnt(0)" ::: "memory");
        } else {
            XB_SPIN(xb_ld(&bar[XB_XGEN(b.x)]) == gen, bar);
            __builtin_amdgcn_fence(__ATOMIC_ACQUIRE, "agent");
            asm volatile("s_waitcnt vmcnt(0)" ::: "memory");
        }
    }
    __syncthreads();
}

template <class Tp> DEV Tp* opq(Tp* q) { asm volatile("" : "+s"(q)); return q; }
DEV int tid_() { int t = threadIdx.x; asm volatile("" : "+v"(t)); return t; }
DEV int bid_() { int b = blockIdx.x; asm volatile("" : "+s"(b)); return b; }

DEV void glds16(const void* gsrc, char* lds_lane_ptr) {
  __builtin_amdgcn_global_load_lds((const unsigned*)gsrc, (__attribute__((address_space(3))) unsigned*)lds_lane_ptr, 16, 0, 0);
}
template <class Epi>
DEV void gemm_tile(const bf16_t* __restrict__ A, int lda, const bf16_t* __restrict__ Bt, int ldb, int K, char* smem, Epi& epi) {
  const int tid = tid_(), lane = tid & 63, wid = tid >> 6, wr = wid >> 1, wc = wid & 1, fr = lane & 15, fq = lane >> 4;
  f32x4 acc[4][4];
#pragma unroll
  for (int m = 0; m < 4; ++m)
#pragma unroll
    for (int n = 0; n < 4; ++n) acc[m][n] = (f32x4){0.f, 0.f, 0.f, 0.f};
  const int drow0 = 8 * wid + (lane >> 3), dpc = lane & 7;
  auto issue = [&](int kt, int buf) {
    char* sa = smem + buf * 32768;
    char* sb = sa + 16384;
#pragma unroll
    for (int i = 0; i < 4; ++i) {
      const int row = drow0 + 32 * i;
      const int kc = dpc ^ ((row >> 1) & 7);
      glds16(A + (size_t)row * lda + kt * 64 + kc * 8, sa + (i * 4 + wid) * 1024 + lane * 16);
      glds16(Bt + (size_t)row * ldb + kt * 64 + kc * 8, sb + (i * 4 + wid) * 1024 + lane * 16);
    }
  };
  __syncthreads();
  issue(0, 0);
  const int nk = K >> 6;
  const int sw = (fr >> 1) & 7;
  const int aoff = (wr * 64 + fr) * 128, boff = (wc * 64 + fr) * 128;
  for (int kt = 0; kt < nk; ++kt) {
    asm volatile("s_waitcnt vmcnt(0)" ::: "memory");
    __syncthreads();
    if (kt + 1 < nk) issue(kt + 1, (kt + 1) & 1);
    const char* sa = smem + (kt & 1) * 32768;
    const char* sb = sa + 16384;
    bf16x8 af[2][4], bfr[2][4];
#pragma unroll
    for (int kh = 0; kh < 2; ++kh) {
      const int pc = ((kh * 4 + fq) ^ sw) * 16;
#pragma unroll
      for (int m = 0; m < 4; ++m) af[kh][m] = *(const bf16x8*)(sa + aoff + m * 2048 + pc);
#pragma unroll
      for (int n = 0; n < 4; ++n) bfr[kh][n] = *(const bf16x8*)(sb + boff + n * 2048 + pc);
    }
    __builtin_amdgcn_sched_barrier(0);
    asm volatile("s_waitcnt lgkmcnt(8)" ::: "memory");
    __builtin_amdgcn_sched_barrier(0);
#pragma unroll
    for (int m = 0; m < 4; ++m)
#pragma unroll
      for (int n = 0; n < 4; ++n) acc[m][n] = mfma16(af[0][m], bfr[0][n], acc[m][n]);
    __builtin_amdgcn_sched_barrier(0);
    asm volatile("s_waitcnt lgkmcnt(0)" ::: "memory");
    __builtin_amdgcn_sched_barrier(0);
#pragma unroll
    for (int m = 0; m < 4; ++m)
#pragma unroll
      for (int n = 0; n < 4; ++n) acc[m][n] = mfma16(af[1][m], bfr[1][n], acc[m][n]);
  }
  __syncthreads();
  epi(acc, wr, wc, fr, fq, smem);
}
DEV void stage_tile_bf16(const f32x4 (&acc)[4][4], char* smem, int wid, int fr, int fq) {
  bf16_t (*t)[72] = (bf16_t (*)[72])(smem + wid * 9216);
#pragma unroll
  for (int m = 0; m < 4; ++m)
#pragma unroll
    for (int n = 0; n < 4; ++n)
#pragma unroll
      for (int j = 0; j < 4; ++j) t[m * 16 + fq * 4 + j][n * 16 + fr] = f2bf(acc[m][n][j]);
  asm volatile("s_waitcnt lgkmcnt(0)" ::: "memory");
}

DEV void ph_copy(const P& p) {
  const size_t n8 = (size_t)NTOK * D / 8;
  const float* pctx = opq(p.ctx); const float* px = opq(p.x);
  for (size_t i = (size_t)bid_() * 256 + tid_(); i < n8; i += (size_t)gridDim.x * 256) {
    size_t e = i * 8;
    int row = (int)(e / D), col = (int)(e % D);
    int b = row / LT, pp = row % LT;
    const float* src = pp < LC ? pctx + ((size_t)(b * LC + pp)) * D + col : px + ((size_t)(b * T + pp - LC)) * D + col;
    float4 v0 = *(const float4*)src, v1 = *(const float4*)(src + 4);
    uint4 o = make_uint4(pack2(v0.x, v0.y), pack2(v0.z, v0.w), pack2(v1.x, v1.y), pack2(v1.z, v1.w));
    *(uint4*)(p.X + e) = o;
  }
}

DEV void ph_rope(const P& p) {
  for (int i = bid_() * 256 + tid_(); i < 64 * 16; i += gridDim.x * 256) {
    int pos = i >> 4, k = i & 15;
    float inv = powf(10000.f, -(float)k / 16.f);
    float ang = (float)pos * inv;
    p.rope[2 * i] = cosf(ang); p.rope[2 * i + 1] = sinf(ang);
  }
}

DEV void modv_unit(const P& p, int unit, char* smem) {
  const int cc = unit % 24, layer = unit / 24;
  float (*cs)[128] = (float (*)[128])smem;
  const int col = cc * 256 + tid_();
  const float* pc = opq(p.c); const float* pcc = opq(p.c_ctx);
  float acc[17];
#pragma unroll
  for (int r = 0; r < 17; ++r) acc[r] = 0.f;
  for (int ks = 0; ks < 8; ++ks) {
    __syncthreads();
    for (int i = tid_(); i < 17 * 128; i += 256) {
      int r = i >> 7, e = i & 127;
      float v = r < 16 ? pc[r * D + ks * 128 + e] : pcc[ks * 128 + e];
      cs[r][e] = v / (1.f + expf(-v));
    }
    __syncthreads();
    const float* w = p.mod_w + ((size_t)layer * D + ks * 128) * 6144 + col;
#pragma unroll 4
    for (int e = 0; e < 128; ++e) {
      float wv = w[(size_t)e * 6144];
#pragma unroll
      for (int r = 0; r < 17; ++r) acc[r] += cs[r][e] * wv;
    }
  }
  const float bias = p.mod_b[layer * 6144 + col];
#pragma unroll
  for (int r = 0; r < 17; ++r) p.modv[((size_t)layer * 17 + r) * 6144 + col] = acc[r] + bias;
}

DEV void transpose_unit(const float* __restrict__ src, bf16_t* __restrict__ dst, int R, int C, int tile, char* smem) {
  float (*t)[65] = (float (*)[65])smem;
  const int nct = C / 64;
  const int tr = tile / nct, tc = tile % nct;
  __syncthreads();
  for (int i = tid_(); i < 4096; i += 256) { int r = i >> 6, c = i & 63; t[r][c] = src[(size_t)(tr * 64 + r) * C + tc * 64 + c]; }
  __syncthreads();
  for (int i = tid_(); i < 4096; i += 256) { int c = i >> 6, r = i & 63; dst[(size_t)(tc * 64 + c) * R + tr * 64 + r] = f2bf(t[r][c]); }
}

DEV void wfold_unit(const P& p, int layer, int unit, char* smem) {
  const int hs = unit >> 5, ec = unit & 31, h = hs >> 1, s = hs & 1;
  const float* wq = p.peer_wq + (size_t)layer * D * 2048;
  const float* kk = (s ? opq(p.peer_k2) : opq(p.peer_k1)) + ((size_t)layer * 8 + h) * 128 * 128;
  float (*kS)[65] = (float (*)[65])smem;
  float (*wS)[64] = (float (*)[64])(smem + 33280);
  const int key = tid_() & 127, eh = tid_() >> 7;
  float acc[16];
#pragma unroll
  for (int i = 0; i < 16; ++i) acc[i] = 0.f;
  for (int dh = 0; dh < 2; ++dh) {
    __syncthreads();
    for (int i = tid_(); i < 128 * 64; i += 256) { int k2 = i >> 6, d = i & 63; kS[k2][d] = kk[k2 * 128 + dh * 64 + d]; }
    for (int i = tid_(); i < 32 * 64; i += 256) {
      int e = i >> 6, d = i & 63;
      wS[e][d] = wq[(size_t)(ec * 32 + e) * 2048 + h * 256 + s * 128 + dh * 64 + d];
    }
    __syncthreads();
#pragma unroll 2
    for (int d = 0; d < 64; ++d) {
      float kv = kS[key][d];
#pragma unroll
      for (int i = 0; i < 16; ++i) acc[i] += kv * wS[eh * 16 + i][d];
    }
  }
  bf16_t* dst = p.Wft + ((size_t)(hs * 128 + key)) * D + ec * 32 + eh * 16;
#pragma unroll
  for (int i = 0; i < 16; i += 2) *(unsigned*)(dst + i) = pack2(acc[i], acc[i + 1]);
}

DEV void filt_unit(const P& p, int layer, int unit, char* smem) {
  int kind, j0, L;
  if (unit < 1024) { kind = 0; j0 = unit * 4; L = T; } else { kind = 1; j0 = (unit - 1024) * 4; L = LC; }
  float* zs = (float*)smem;
  float* h1 = zs + 4 * 36;
  float* h2 = h1 + 256;
  const int jj = tid_() >> 6, o = tid_() & 63;
  const int j = j0 + jj;
  const float fj = (float)j;
  const float t = fj / (float)(L - 1);
  __syncthreads();
  if (o < 33) {
    float z;
    if (o == 0) z = t;
    else {
      int i = (o - 1) & 15;
      float band = 1e-4f + (float)i * ((15.0f - 1e-4f) / 15.0f);
      float ang = 6.283185307179586f * fj * band / (float)L;
      z = (o <= 16) ? cosf(ang) : -sinf(ang);
    }
    zs[jj * 36 + o] = z;
  }
  __syncthreads();
  {
    const float* w1 = p.hy_w1 + layer * 33 * 64;
    float a = p.hy_b1[layer * 64 + o];
#pragma unroll 3
    for (int i = 0; i < 33; ++i) a += zs[jj * 36 + i] * w1[i * 64 + o];
    h1[jj * 64 + o] = sinf(p.hy_freq[layer * 128 + o] * a);
  }
  __syncthreads();
  {
    const float* w2 = p.hy_w2 + layer * 64 * 64;
    float a = p.hy_b2[layer * 64 + o];
#pragma unroll 4
    for (int i = 0; i < 64; ++i) a += h1[jj * 64 + i] * w2[i * 64 + o];
    h2[jj * 64 + o] = sinf(p.hy_freq[layer * 128 + 64 + o] * a);
  }
  __syncthreads();
  const float* w3 = p.hy_w3 + layer * 64 * 512;
  float* F = kind ? opq(p.FC) : opq(p.FL);
  const float DMIN = -3.0701134573253945f, DMAX = -15.350567286626973f;
#pragma unroll 1
  for (int m = 0; m < 4; ++m) {
    int c = o + 64 * m;
    float af = p.hy_b3[layer * 512 + c], ab = p.hy_b3[layer * 512 + 256 + c];
#pragma unroll 4
    for (int i = 0; i < 64; ++i) { float hv = h2[jj * 64 + i]; af += hv * w3[i * 512 + c]; ab += hv * w3[i * 512 + 256 + c]; }
    float delta = fabsf(DMIN + (float)c * ((DMAX - DMIN) / 255.f));
    float win = expf(-t * delta) + 0.05f;
    af *= win; ab *= win;
    F[((size_t)c * 2 + 0) * L + j] = af;
    F[((size_t)c * 2 + 1) * L + j] = ab;
  }
}

constexpr int PREP_T0 = 672, PREP_T1 = PREP_T0 + 256, PREP_T2 = PREP_T1 + 8, PREP_T3 = PREP_T2 + 8, PREP_T4 = PREP_T3 + 8;
constexpr int PREP_WF = PREP_T4 + 512, PREP_N = PREP_WF + 1088;
DEV void prep_unit(const P& p, int layer, int u, char* smem) {
  if (u < PREP_T0) transpose_unit(p.w_in + (size_t)layer * D * INW, p.W1t, D, INW, u, smem);
  else if (u < PREP_T1) transpose_unit(p.w_out + (size_t)layer * D * D, p.W2t, D, D, u - PREP_T0, smem);
  else if (u < PREP_T3) {
    const int u0 = u - PREP_T1;
    for (int i = tid_(); i < 64 * 256; i += 256) {
      const int np = u0 * 64 + (i >> 8), kp = i & 255;
      const int ps = np & 3, chan = np >> 2, qp = kp >> 6, kk = kp & 63;
      const int is_a = ps & 1, d = ps >> 1;
      float v = 0.f;
      if (qp == (is_a ? 2 + d : d)) v = (is_a ? opq(p.rw_a_up) : opq(p.rw_w_up))[(((size_t)layer * 2 + d) * 64 + kk) * 256 + chan];
      p.Wlt[(size_t)np * 256 + kp] = f2bf(v);
    }
  }
  else if (u < PREP_T4) transpose_unit(p.rw_g_up + (size_t)layer * 128 * 256, p.Wgt, 128, 256, u - PREP_T3, smem);
  else if (u < PREP_WF) wfold_unit(p, layer, u - PREP_T4, smem);
  else filt_unit(p, layer, u - PREP_WF, smem);
}
constexpr int PREPA_N = PREP_T0 + (PREP_T4 - PREP_T1);
DEV int prepA_unit_index(int i) { return i < PREP_T0 ? i : PREP_T1 + (i - PREP_T0); }
DEV void ph_prep(const P& p, int layer, char* smem, bool onlyB) {
  for (int u = bid_(); u < PREP_N; u += gridDim.x) {
    const bool isA = (u < PREP_T0) || (u >= PREP_T1 && u < PREP_T4);
    if (onlyB && isA) continue;
    prep_unit(p, layer, u, smem);
  }
}

DEV void wave_range(int& r0, int& r1, int ntok) {
  const int gw = (bid_() * 256 + tid_()) >> 6, nw = gridDim.x * 4;
  const int per = (ntok + nw - 1) / nw;
  r0 = gw * per; r1 = r0 + per; if (r1 > ntok) r1 = ntok;
}
DEV void ph_norm(const P& p, int layer, int which) {
  const int lane = tid_() & 63;
  int r0, r1;
  wave_range(r0, r1, NTOK);
  const float* g = (which ? p.norm2_g : p.norm1_g) + layer * D;
  float gv[16], scv[16], shv[16];
#pragma unroll
  for (int hh = 0; hh < 2; ++hh)
#pragma unroll
    for (int i = 0; i < 8; ++i) gv[hh * 8 + i] = g[hh * 512 + 8 * lane + i];
  int mr_cur = -1;
  uint4 n0 = make_uint4(0, 0, 0, 0), n1 = n0;
  if (r0 < r1) { const bf16_t* xr = p.X + (size_t)r0 * D; n0 = *(const uint4*)(xr + 8 * lane); n1 = *(const uint4*)(xr + 512 + 8 * lane); }
#pragma unroll 1
  for (int row = r0; row < r1; ++row) {
    const uint4 u0 = n0, u1 = n1;
    if (row + 1 < r1) { const bf16_t* xr = p.X + (size_t)(row + 1) * D; n0 = *(const uint4*)(xr + 8 * lane); n1 = *(const uint4*)(xr + 512 + 8 * lane); }
    const int b = row / LT, pp = row % LT;
    const int mr = pp < LC ? 16 : b;
    if (mr != mr_cur) {
      mr_cur = mr;
      const float* mv = p.modv + ((size_t)layer * 17 + mr) * 6144 + (which ? 3072 : 0);
#pragma unroll
      for (int hh = 0; hh < 2; ++hh)
#pragma unroll
        for (int i = 0; i < 8; ++i) { shv[hh * 8 + i] = mv[hh * 512 + 8 * lane + i]; scv[hh * 8 + i] = 1.f + mv[1024 + hh * 512 + 8 * lane + i]; }
    }
    float v[16];
    unpack8(u0, v); unpack8(u1, v + 8);
    float ss = 0.f;
#pragma unroll
    for (int i = 0; i < 16; ++i) ss += v[i] * v[i];
    ss = wave_sum(ss);
    const float rstd = rsqrtf(ss * (1.f / 1024.f) + 1e-6f);
    float o[16];
#pragma unroll
    for (int i = 0; i < 16; ++i) o[i] = (v[i] * rstd * gv[i]) * scv[i] + shv[i];
    bf16_t* hr = p.H + (size_t)row * D;
    *(uint4*)(hr + 8 * lane) = pack8(o);
    *(uint4*)(hr + 512 + 8 * lane) = pack8(o + 8);
    if (which) {
      float am = 0.f;
#pragma unroll
      for (int i = 0; i < 16; ++i) am = fmaxf(am, fabsf(o[i]));
      am = wave_max(am);
      const float sc = am > 0.f ? 127.f / am : 1.f;
      unsigned char* h8 = p.H8 + (size_t)row * 1024;
      *(uint2*)(h8 + 8 * lane) = make_uint2((unsigned)pack_i8(o[0] * sc, o[1] * sc, o[2] * sc, o[3] * sc), (unsigned)pack_i8(o[4] * sc, o[5] * sc, o[6] * sc, o[7] * sc));
      *(uint2*)(h8 + 512 + 8 * lane) = make_uint2((unsigned)pack_i8(o[8] * sc, o[9] * sc, o[10] * sc, o[11] * sc), (unsigned)pack_i8(o[12] * sc, o[13] * sc, o[14] * sc, o[15] * sc));
      if (lane == 0) p.HINV[row] = am > 0.f ? am * (1.f / 127.f) : 1.f;
    }
  }
}

DEV bool gemm_unit(int it, int nct, int& rt, int& ct) {
  const int nslot = gridDim.x >> 3;
  const int x = bid_() & 7, sl = bid_() >> 3;
  if (sl >= nslot) return false;
  const int v = it * nslot + sl;
  if (v >= 68 * nct) return false;
  const int rg = v / (8 * nct), rem = v - rg * 8 * nct;
  const int rows = (rg == 8) ? 4 : 8;
  ct = rem / rows;
  rt = x * 68 + rg * 8 + (rem - ct * rows);
  return true;
}
struct Epi1 {
  const P& p; int row0, col0;
  DEV void operator()(f32x4 (&acc)[4][4], int wr, int wc, int fr, int fq, char* smem) const {
    const int cw = col0 + wc * 64;
    const int rbase = row0 + wr * 64;
    const bool lat = (row0 % LT) >= LC;
    if (cw >= 1536 && cw < 1664) {
#pragma unroll
      for (int m = 0; m < 4; ++m)
#pragma unroll
        for (int n = 0; n < 4; ++n)
#pragma unroll
          for (int j = 0; j < 4; ++j) acc[m][n][j] = 2.f * sigmoidf_(2.f * acc[m][n][j]) - 1.f;
    } else if (cw >= 1792 && cw < 1920) {
#pragma unroll
      for (int m = 0; m < 4; ++m)
#pragma unroll
        for (int n = 0; n < 4; ++n)
#pragma unroll
          for (int j = 0; j < 4; ++j) acc[m][n][j] = sigmoidf_(acc[m][n][j]);
    } else if (cw >= 1920 && cw < 2560 && lat) {
#pragma unroll
      for (int m = 0; m < 4; ++m)
#pragma unroll
        for (int j = 0; j < 4; ++j) {
          int row = rbase + m * 16 + fq * 4 + j;
          int pl = (row % LT) - LC;
          int ri = pl >> 6, ci = pl & 63;
          float2 cr = *(const float2*)(p.rope + 2 * (ri * 16 + fr));
          float2 cc = *(const float2*)(p.rope + 2 * (ci * 16 + fr));
          float x1 = acc[m][0][j], x2 = acc[m][1][j];
          acc[m][0][j] = x1 * cr.x - x2 * cr.y; acc[m][1][j] = x2 * cr.x + x1 * cr.y;
          x1 = acc[m][2][j]; x2 = acc[m][3][j];
          acc[m][2][j] = x1 * cc.x - x2 * cc.y; acc[m][3][j] = x2 * cc.x + x1 * cc.y;
        }
    }
    const int wid = wr * 2 + wc, lane = fq * 16 + fr;
    stage_tile_bf16(acc, smem, wid, fr, fq);
    const bf16_t (*t)[72] = (const bf16_t (*)[72])(smem + wid * 9216);
#pragma unroll
    for (int i = 0; i < 8; ++i) {
      const int rl = i * 8 + (lane >> 3), ch = lane & 7;
      *(uint4*)(p.Z + (size_t)(rbase + rl) * INW + cw + ch * 8) = *(const uint4*)&t[rl][ch * 8];
    }
  }
};
DEV void ph_gemm1(const P& p, char* smem) {
  const int nct = INW / 128;
  int rt, ct;
  for (int it = 0; gemm_unit(it, nct, rt, ct); ++it) {
    Epi1 epi{p, rt * 128, ct * 128};
    gemm_tile(p.H + (size_t)rt * 128 * D, D, p.W1t + (size_t)ct * 128 * D, D, D, smem, epi);
  }
}

struct EpiLoraA {
  const P& p; int layer, row0, col0;
  DEV void operator()(f32x4 (&acc)[4][4], int wr, int wc, int fr, int fq, char* smem) const {
    const int ps = fr & 3, is_a = ps & 1, dd = ps >> 1;
    const float scale = is_a ? 1.f : 0.6065306597126334f;
    const float* bias0 = (is_a ? opq(p.rw_a0) : opq(p.rw_w0)) + (layer * 2 + dd) * 256;
#pragma unroll
    for (int n = 0; n < 4; ++n) {
      const int chan = (col0 + wc * 64 + n * 16 + fr) >> 2;
      const float bias = bias0[chan];
#pragma unroll
      for (int m = 0; m < 4; ++m)
#pragma unroll
        for (int j = 0; j < 4; ++j) acc[m][n][j] = scale * sigmoidf_(acc[m][n][j] + bias);
    }
    const int wid = wr * 2 + wc, lane = fq * 16 + fr;
    stage_tile_bf16(acc, smem, wid, fr, fq);
    const bf16_t (*t)[72] = (const bf16_t (*)[72])(smem + wid * 9216);
#pragma unroll
    for (int i = 0; i < 8; ++i) {
      const int rl = i * 8 + (lane >> 3), ch = lane & 7;
      *(uint4*)(p.SC + (size_t)(row0 + wr * 64 + rl) * 1024 + col0 + wc * 64 + ch * 8) = *(const uint4*)&t[rl][ch * 8];
    }
  }
};
struct EpiLoraG {
  const P& p; int row0, col0;
  DEV void operator()(f32x4 (&acc)[4][4], int wr, int wc, int fr, int fq, char* smem) const {
    const int wid = wr * 2 + wc, lane = fq * 16 + fr;
    stage_tile_bf16(acc, smem, wid, fr, fq);
    const bf16_t (*t)[72] = (const bf16_t (*)[72])(smem + wid * 9216);
#pragma unroll
    for (int i = 0; i < 8; ++i) {
      const int rl = i * 8 + (lane >> 3), ch = lane & 7;
      *(uint4*)(p.Y + (size_t)(row0 + wr * 64 + rl) * D + 256 + col0 + wc * 64 + ch * 8) = *(const uint4*)&t[rl][ch * 8];
    }
  }
};
DEV void ph_lora(const P& p, int layer, char* smem) {
  int rt, ct;
  for (int it = 0; gemm_unit(it, 10, rt, ct); ++it) {
    if (ct < 8) {
      EpiLoraA epi{p, layer, rt * 128, ct * 128};
      gemm_tile(p.Z + (size_t)rt * 128 * INW + 1536, INW, p.Wlt + (size_t)ct * 128 * 256, 256, 256, smem, epi);
    } else {
      EpiLoraG epi{p, rt * 128, (ct - 8) * 128};
      gemm_tile(p.Z + (size_t)rt * 128 * INW + 1792, INW, p.Wgt + (size_t)(ct - 8) * 128 * 128, 128, 128, smem, epi);
    }
  }
}

DEV void ph_rwkv_prep(const P& p, int layer) {
  const int lane = tid_() & 63;
  int r0, r1;
  wave_range(r0, r1, NTOK);
  const float* cw = p.conv_w + (size_t)layer * 3 * 1536;
  const float* cb = p.conv_b + (size_t)layer * 1536;
  float w0[3][4], w1[3][4], w2[3][4], bb[3][4], kkw[4];
#pragma unroll
  for (int a = 0; a < 3; ++a)
#pragma unroll
    for (int i = 0; i < 4; ++i) {
      const int col = 768 + a * 256 + 4 * lane + i;
      w0[a][i] = cw[col]; w1[a][i] = cw[1536 + col]; w2[a][i] = cw[3072 + col]; bb[a][i] = cb[col];
    }
#pragma unroll
  for (int i = 0; i < 4; ++i) kkw[i] = p.rw_k_k[layer * 256 + 4 * lane + i];
  uint2 zm[3], zc[3], zp[3];
  auto ldz = [&](int row, uint2 (&z)[3]) {
#pragma unroll
    for (int a = 0; a < 3; ++a) z[a] = *(const uint2*)(p.Z + (size_t)row * INW + 768 + a * 256 + 4 * lane);
  };
  auto zero3 = [&](uint2 (&z)[3]) {
#pragma unroll
    for (int a = 0; a < 3; ++a) z[a] = make_uint2(0u, 0u);
  };
  if (r0 < r1) {
    if (r0 > 0) ldz(r0 - 1, zm); else zero3(zm);
    ldz(r0, zc);
  }
#pragma unroll 1
  for (int row = r0; row < r1; ++row) {
    if (row + 1 < NTOK) ldz(row + 1, zp); else zero3(zp);
    const int pp = row % LT;
    const bool hasm = (pp != 0) && (pp != LC);
    const bool hasp = (pp != LC - 1) && (pp != LT - 1);
    float res[3][4];
#pragma unroll
    for (int a = 0; a < 3; ++a) {
      const uint2 um = hasm ? zm[a] : make_uint2(0u, 0u), uc = zc[a], up = hasp ? zp[a] : make_uint2(0u, 0u);
      const float vm[4] = {bflo(um.x), bfhi(um.x), bflo(um.y), bfhi(um.y)};
      const float vc[4] = {bflo(uc.x), bfhi(uc.x), bflo(uc.y), bfhi(uc.y)};
      const float vp[4] = {bflo(up.x), bfhi(up.x), bflo(up.y), bfhi(up.y)};
#pragma unroll
      for (int i = 0; i < 4; ++i) res[a][i] = w0[a][i] * vm[i] + w1[a][i] * vc[i] + w2[a][i] * vp[i] + bb[a][i];
    }
    float kk[4], ss = 0.f;
#pragma unroll
    for (int i = 0; i < 4; ++i) { kk[i] = res[1][i] * kkw[i]; ss += kk[i] * kk[i]; }
    ss = row16_sum(ss);
    const float rs = rsqrtf(ss + 1e-12f);
    bf16_t* hr = p.H + (size_t)row * D + 16 * lane;
    *(uint4*)hr = make_uint4(pack2(res[0][0], res[1][0]), pack2(kk[0] * rs, res[2][0]), pack2(res[0][1], res[1][1]), pack2(kk[1] * rs, res[2][1]));
    *(uint4*)(hr + 8) = make_uint4(pack2(res[0][2], res[1][2]), pack2(kk[2] * rs, res[2][2]), pack2(res[0][3], res[1][3]), pack2(kk[3] * rs, res[2][3]));
#pragma unroll
    for (int a = 0; a < 3; ++a) { zm[a] = zc[a]; zc[a] = zp[a]; }
  }
}

DEV float oct_sum(float x) { x += dpp0<0xB1, 0xF>(x); x += dpp0<0x4E, 0xF>(x); x += dpp0<0x141, 0xF>(x); return x; }
DEV bf16x8 frag_join(uint2 lo, uint2 hi) { uint4 w = make_uint4(lo.x, lo.y, hi.x, hi.y); return __builtin_bit_cast(bf16x8, w); }
constexpr int SCS_SET = 17152, SCS_IMG = 3 * SCS_SET, SCS_W0 = SCS_IMG + 2 * 3072;
DEV void scanc_unit(const P& p, int layer, int unit, char* smem) {
  const int dir = unit & 1, h = (unit >> 1) & 3, b = unit >> 3;
  const int tid = tid_(), lane = tid & 63, fr = lane & 15, fq = lane >> 4;
  const int w = __builtin_amdgcn_readfirstlane(tid >> 6);
  bf16_t* IMG0 = (bf16_t*)(smem + SCS_W0);
  bf16_t* IMG1 = IMG0 + 512;
  bf16_t* IMG2 = IMG0 + 1024;
  __syncthreads();
  for (int i = tid; i < (2 * 3072 + 3072) / 4; i += 256) ((unsigned*)(smem + SCS_IMG))[i] = 0u;
  const float ka = p.rw_k_a[layer * 256 + h * 64 + lane];
  const size_t rowbase = (size_t)b * LT;
  const char* hbase = (const char*)p.H;
  const char* sbase = (const char*)p.SC;
  const unsigned hoff = (unsigned)(rowbase * 2048) + (unsigned)((h * 64 + lane) * 8);
  const unsigned soff = hoff + 4u * (unsigned)dir;
  bf16_t* yb = p.Z + rowbase * INW + 768 + dir * 256 + h * 64 + w * 16 + fr;
  auto pos0 = [&](int c) -> int { const int t = c * 16; return dir == 0 ? t : (t < LC ? LC - 1 - t : LT - 1 - (t - LC)); };
  const int pstep = dir == 0 ? 1 : -1;
  constexpr int NCH = LT / 16;
  struct Raw { unsigned sc[16]; uint2 hr[6]; };
  auto load_raw = [&](int c, Raw& rw) {
    if (w != 0) {
      const int p0 = pos0(c);
      const unsigned so = soff + (unsigned)(p0 * 2048);
      const int st = pstep * 2048;
#pragma unroll
      for (int i = 0; i < 16; ++i) rw.sc[i] = *(const unsigned*)(sbase + (so + (unsigned)(i * st)));
      const unsigned ho = hoff + (unsigned)((p0 + pstep * (w - 1)) * 2048);
#pragma unroll
      for (int q = 0; q < 6; ++q) {
        const int qq = ((w - 1) + 3 * q < 16) ? q : 4;
        rw.hr[q] = *(const uint2*)(hbase + (ho + (unsigned)(qq * 3 * st)));
      }
    }
  };
  auto stage1w = [&](int set, const Raw& rw, auto W1tag) {
    constexpr int W1 = decltype(W1tag)::value;
    char* base = smem + set * SCS_SET;
    bf16_t (*At)[72] = (bf16_t (*)[72])(base);
    bf16_t (*Rt)[72] = (bf16_t (*)[72])(base + 2304);
    bf16_t (*Bt)[72] = (bf16_t (*)[72])(base + 4608);
    bf16_t (*Kt)[72] = (bf16_t (*)[72])(base + 6912);
    bf16_t (*BKT)[36] = (bf16_t (*)[36])(base + 9216);
    bf16_t* VV = (bf16_t*)(base + 13824);
    float* G16 = (float*)(base + 16896);
    float Erun = 0.f;
#pragma unroll
    for (int i = 0; i < 16; ++i) {
      const float ev = bflo(rw.sc[i]);
      const float Eprev = Erun;
      Erun += ev;
      if ((i % 3) == W1) {
        const uint2 hrec = rw.hr[i / 3];
        const float rr = bflo(hrec.x), kr = bfhi(hrec.x), kkv = bflo(hrec.y);
        const float av = bfhi(rw.sc[i]);
        const float gp = __expf(-Eprev), gi = __expf(-Erun), ig = __expf(Erun);
        const float at = -kkv * gp, rt = rr * gi, bt = kkv * av * ig, kt2 = kr * (1.f + (av - 1.f) * ka) * ig;
        const unsigned ar = pack2(at, rt), bk = pack2(bt, kt2);
        At[i][lane] = (bf16_t)(ar & 0xFFFFu); Rt[i][lane] = (bf16_t)(ar >> 16);
        Bt[i][lane] = (bf16_t)(bk & 0xFFFFu); Kt[i][lane] = (bf16_t)(bk >> 16);
        BKT[lane][(i >> 2) * 8 + (i & 3)] = (bf16_t)(bk & 0xFFFFu);
        BKT[lane][(i >> 2) * 8 + 4 + (i & 3)] = (bf16_t)(bk >> 16);
        VV[((i >> 2) * 64 + lane) * 6 + (i & 3)] = (bf16_t)(hrec.y >> 16);
        if (i == 15) G16[lane] = gi;
      }
    }
  };
  auto stage1 = [&](int set, const Raw& rw) {
    if (w == 1) stage1w(set, rw, std::integral_constant<int, 0>{});
    else if (w == 2) stage1w(set, rw, std::integral_constant<int, 1>{});
    else if (w == 3) stage1w(set, rw, std::integral_constant<int, 2>{});
  };
  auto stage2 = [&](int set, int iset) {
    char* base = smem + set * SCS_SET;
    const bf16_t (*At)[72] = (const bf16_t (*)[72])(base);
    const bf16_t (*Rt)[72] = (const bf16_t (*)[72])(base + 2304);
    const bf16_t (*Bt)[72] = (const bf16_t (*)[72])(base + 4608);
    const bf16_t (*Kt)[72] = (const bf16_t (*)[72])(base + 6912);
    bf16_t* TT = (bf16_t*)(smem + SCS_IMG + iset * 3072);
    bf16_t* ARK = TT + 512;
    bf16_t* AAK = TT + 1024;
    const bf16_t (*X)[72] = (w < 2) ? At : Rt;
    const bf16_t (*Y)[72] = (w & 1) ? Kt : Bt;
    f32x4 cm = (f32x4){0.f, 0.f, 0.f, 0.f};
#pragma unroll
    for (int s = 0; s < 2; ++s) {
      bf16x8 af = *(const bf16x8*)&X[fr][32 * s + 8 * fq];
      bf16x8 bm = *(const bf16x8*)&Y[fr][32 * s + 8 * fq];
      cm = mfma16(af, bm, cm);
    }
#pragma unroll
    for (int jj = 0; jj < 4; ++jj) {
      const int i = 4 * fq + jj;
      const bool keep = (w < 2) ? (fr < i) : (fr <= i);
      cm[jj] = keep ? cm[jj] : 0.f;
    }
    const int io = (fr >> 2) * 8 + (fr & 3);
    auto wr_img = [&](bf16_t* img, const f32x4& Xv, int hi) {
#pragma unroll
      for (int jj = 0; jj < 4; ++jj) img[(4 * fq + jj) * 32 + io + hi] = f2bf(Xv[jj]);
    };
    if (w == 1) wr_img(AAK, cm, 0);
    else if (w == 2) wr_img(ARK, cm, 0);
    else if (w == 3) wr_img(ARK, cm, 4);
    else {
      auto bfrag = [&](const f32x4& Xv) { return frag_join(make_uint2(pack2(Xv[0], Xv[1]), pack2(Xv[2], Xv[3])), make_uint2(0u, 0u)); };
      auto afr = [&](const bf16_t* img) { return *(const bf16x8*)&img[(fr * 4 + fq) * 8]; };
      const f32x4 Z4 = (f32x4){0.f, 0.f, 0.f, 0.f};
      wr_img(IMG0, cm, 0);
      asm volatile("" ::: "memory");
      f32x4 A2 = mfma16(afr(IMG0), bfrag(cm), Z4);
      wr_img(IMG1, A2, 0);
      asm volatile("" ::: "memory");
      f32x4 A4 = mfma16(afr(IMG1), bfrag(A2), Z4);
      wr_img(IMG2, A4, 0);
      asm volatile("" ::: "memory");
      f32x4 Rm = mfma16(afr(IMG2), bfrag(A4), Z4);
#pragma unroll
      for (int jj = 0; jj < 4; ++jj) Rm[jj] += (fr == 4 * fq + jj) ? 1.f : 0.f;
      Rm = mfma16(afr(IMG2), bfrag(Rm), Rm);
      Rm = mfma16(afr(IMG1), bfrag(Rm), Rm);
      Rm = mfma16(afr(IMG0), bfrag(Rm), Rm);
      wr_img(TT, Rm, 0);
    }
  };
  f32x4 acc[4];
#pragma unroll
  for (int kt = 0; kt < 4; ++kt) acc[kt] = (f32x4){0.f, 0.f, 0.f, 0.f};
  auto part2 = [&](int c, int set, int iset) {
    char* base = smem + set * SCS_SET;
    const bf16_t (*At)[72] = (const bf16_t (*)[72])(base);
    const bf16_t (*Rt)[72] = (const bf16_t (*)[72])(base + 2304);
    const bf16_t (*BKT)[36] = (const bf16_t (*)[36])(base + 9216);
    const bf16_t* VV = (const bf16_t*)(base + 13824);
    const float* G16 = (const float*)(base + 16896);
    const bf16_t* TT = (const bf16_t*)(smem + SCS_IMG + iset * 3072);
    const bf16_t* ARK = TT + 512;
    const bf16_t* AAK = TT + 1024;
    bf16x8 Sb[2];
#pragma unroll
    for (int s = 0; s < 2; ++s) {
      uint4 t = make_uint4(pack2(acc[2 * s][0], acc[2 * s][1]), pack2(acc[2 * s][2], acc[2 * s][3]),
                           pack2(acc[2 * s + 1][0], acc[2 * s + 1][1]), pack2(acc[2 * s + 1][2], acc[2 * s + 1][3]));
      Sb[s] = __builtin_bit_cast(bf16x8, t);
    }
    const unsigned* vvp = (const unsigned*)&VV[(fq * 64 + w * 16 + fr) * 6];
    const uint2 vv = make_uint2(vvp[0], vvp[1]);
    const bf16x8 Vlow = frag_join(vv, make_uint2(0u, 0u));
    f32x4 Pm = (f32x4){0.f, 0.f, 0.f, 0.f};
#pragma unroll
    for (int s = 0; s < 2; ++s) {
      bf16x8 af = frag_join(*(const uint2*)&At[fr][32 * s + 4 * fq], *(const uint2*)&At[fr][32 * s + 16 + 4 * fq]);
      Pm = mfma16(af, Sb[s], Pm);
    }
    Pm = mfma16(*(const bf16x8*)&AAK[(fr * 4 + fq) * 8], Vlow, Pm);
    const bf16x8 Pb = frag_join(make_uint2(pack2(Pm[0], Pm[1]), pack2(Pm[2], Pm[3])), make_uint2(0u, 0u));
    f32x4 U = mfma16(*(const bf16x8*)&TT[(fr * 4 + fq) * 8], Pb, (f32x4){0.f, 0.f, 0.f, 0.f});
    const bf16x8 UV = frag_join(make_uint2(pack2(U[0], U[1]), pack2(U[2], U[3])), vv);
    f32x4 Yv = (f32x4){0.f, 0.f, 0.f, 0.f};
#pragma unroll
    for (int s = 0; s < 2; ++s) {
      bf16x8 af = frag_join(*(const uint2*)&Rt[fr][32 * s + 4 * fq], *(const uint2*)&Rt[fr][32 * s + 16 + 4 * fq]);
      Yv = mfma16(af, Sb[s], Yv);
    }
    Yv = mfma16(*(const bf16x8*)&ARK[(fr * 4 + fq) * 8], UV, Yv);
    {
      const int p0 = pos0(c);
#pragma unroll
      for (int jj = 0; jj < 4; ++jj) yb[(size_t)(p0 + pstep * (4 * fq + jj)) * INW] = f2bf(Yv[jj]);
    }
#pragma unroll
    for (int kt = 0; kt < 4; ++kt) {
      f32x4 t = mfma16(frag_join(*(const uint2*)&BKT[16 * kt + fr][fq * 8], *(const uint2*)&BKT[16 * kt + fr][fq * 8 + 4]), UV, acc[kt]);
      const float4 g4 = *(const float4*)&G16[16 * kt + 4 * fq];
      t[0] *= g4.x; t[1] *= g4.y; t[2] *= g4.z; t[3] *= g4.w;
      acc[kt] = t;
    }
  };
  __builtin_amdgcn_s_setprio(3);
  Raw r0, r1;
  load_raw(0, r0); load_raw(1, r1);
  stage1(0, r0);
  load_raw(2, r0);
  __syncthreads();
  stage2(0, 0);
  stage1(1, r1);
  load_raw(3, r1);
  __syncthreads();
  int s0 = 0, s1 = 1, s2 = 2;
  auto iter = [&](int c, Raw& rw) {
    if (c + 1 < NCH) stage2(s1, (c + 1) & 1);
    part2(c, s0, c & 1);
    if (c + 2 < NCH) {
      stage1(s2, rw);
      if (c + 4 < NCH) load_raw(c + 4, rw);
    }
    asm volatile("s_waitcnt lgkmcnt(0)" ::: "memory");
    __builtin_amdgcn_s_barrier();
    asm volatile("" ::: "memory");
    const int t = s0; s0 = s1; s1 = s2; s2 = t;
  };
#pragma unroll 1
  for (int c = 0; c < NCH; c += 2) {
    iter(c, r0); iter(c + 1, r1);
  }
  __builtin_amdgcn_s_setprio(0);
}

DEV void ph_rwkv_post(const P& p, int layer) {
  const int lane = tid_() & 63;
  int r0, r1;
  wave_range(r0, r1, NTOK);
  const int ch = 4 * lane;
  float kav[4], rkv[4], lnw[4], lnb[4];
#pragma unroll
  for (int i = 0; i < 4; ++i) {
    kav[i] = p.rw_k_a[layer * 256 + ch + i]; rkv[i] = p.rw_r_k[layer * 256 + ch + i];
    lnw[i] = p.rw_ln_w[layer * 256 + ch + i]; lnb[i] = p.rw_ln_b[layer * 256 + ch + i];
  }
  struct In { uint2 y0, y1, g; uint4 h0, h1, s0, s1; };
  auto ld = [&](int row, In& in) {
    const bf16_t* zr = p.Z + (size_t)row * INW + 768 + ch;
    in.y0 = *(const uint2*)zr; in.y1 = *(const uint2*)(zr + 256);
    const bf16_t* hr = p.H + (size_t)row * D + 4 * ch;
    in.h0 = *(const uint4*)hr; in.h1 = *(const uint4*)(hr + 8);
    const bf16_t* sr = p.SC + (size_t)row * 1024 + 4 * ch;
    in.s0 = *(const uint4*)sr; in.s1 = *(const uint4*)(sr + 8);
    in.g = *(const uint2*)(p.Y + (size_t)row * D + 256 + ch);
  };
  In nx;
  if (r0 < r1) ld(r0, nx);
#pragma unroll 1
  for (int row = r0; row < r1; ++row) {
    const In in = nx;
    if (row + 1 < r1) ld(row + 1, nx);
    float y[4] = {bflo(in.y0.x) + bflo(in.y1.x), bfhi(in.y0.x) + bfhi(in.y1.x), bflo(in.y0.y) + bflo(in.y1.y), bfhi(in.y0.y) + bfhi(in.y1.y)};
    const float mu = row16_sum(y[0] + y[1] + y[2] + y[3]) * (1.f / 64.f);
    float vs = 0.f;
#pragma unroll
    for (int i = 0; i < 4; ++i) { y[i] -= mu; vs += y[i] * y[i]; }
    const float var = row16_sum(vs) * (1.f / 64.f);
    const float rstd = rsqrtf(var + 64e-5f);
    const float r[4] = {bflo(in.h0.x), bflo(in.h0.z), bflo(in.h1.x), bflo(in.h1.z)};
    const float k[4] = {bfhi(in.h0.x), bfhi(in.h0.z), bfhi(in.h1.x), bfhi(in.h1.z)};
    const float v[4] = {bfhi(in.h0.y), bfhi(in.h0.w), bfhi(in.h1.y), bfhi(in.h1.w)};
    const float a0[4] = {bfhi(in.s0.x), bfhi(in.s0.z), bfhi(in.s1.x), bfhi(in.s1.z)};
    const float a1[4] = {bfhi(in.s0.y), bfhi(in.s0.w), bfhi(in.s1.y), bfhi(in.s1.w)};
    float sd = 0.f;
#pragma unroll
    for (int i = 0; i < 4; ++i) {
      const float kd0 = k[i] * (1.f + (a0[i] - 1.f) * kav[i]), kd1 = k[i] * (1.f + (a1[i] - 1.f) * kav[i]);
      sd += r[i] * (kd0 + kd1) * rkv[i];
    }
    sd = row16_sum(sd);
    const float g[4] = {bflo(in.g.x), bfhi(in.g.x), bflo(in.g.y), bfhi(in.g.y)};
    float o[4];
#pragma unroll
    for (int i = 0; i < 4; ++i) {
      const float yn = y[i] * rstd * lnw[i] + lnb[i];
      o[i] = (yn + sd * v[i]) * g[i];
#if !EN_RW
      o[i] = 0.f;
#endif
    }
    *(uint2*)(p.Y + (size_t)row * D + 256 + ch) = make_uint2(pack2(o[0], o[1]), pack2(o[2], o[3]));
  }
}

DEV void hyena_pre_unit(const P& p, int layer, int unit) {
  int kind, b, t0, L;
  if (unit < 1024) { kind = 0; b = unit >> 6; t0 = (unit & 63) * 64; L = T; } else { int u = unit - 1024; kind = 1; b = u >> 2; t0 = (u & 3) * 64; L = LC; }
  const int c = tid_();
  const size_t row0 = (size_t)b * LT + (kind ? 0 : LC);
  const float* cw = p.conv_w + (size_t)layer * 3 * 1536;
  const float* cb = p.conv_b + (size_t)layer * 1536;
  const float w1a = cw[256 + c], w1b = cw[1536 + 256 + c], w1c = cw[3072 + 256 + c], b1 = cb[256 + c];
  const float w2a = cw[512 + c], w2b = cw[1536 + 512 + c], w2c = cw[3072 + 512 + c], b2 = cb[512 + c];
  auto ld = [&](int t, int col) -> float { return (t >= 0 && t < L) ? bf2f(p.Z[(row0 + t) * INW + col]) : 0.f; };
  float x1m = ld(t0 - 1, 256 + c), x1c = ld(t0, 256 + c), vm = ld(t0 - 1, 512 + c), vc = ld(t0, 512 + c);
  bf16_t* dst = (kind ? opq(p.UTc) : opq(p.UTl)) + ((size_t)c * 16 + b) * L + t0;
#pragma unroll 1
  for (int i8 = 0; i8 < 8; ++i8) {
    float uo[8];
#pragma unroll
    for (int i = 0; i < 8; ++i) {
      int t = t0 + i8 * 8 + i;
      float x1n = ld(t + 1, 256 + c), vn = ld(t + 1, 512 + c);
      float a = w1a * x1m + w1b * x1c + w1c * x1n + b1;
      float bb = w2a * vm + w2b * vc + w2c * vn + b2;
      uo[i] = a * bb;
      x1m = x1c; x1c = x1n; vm = vc; vc = vn;
    }
    *(uint4*)(dst + 8 * i8) = pack8(uo);
  }
}

DEV void hyena_conv_unit(const P& p, int layer, int unit, char* smem) {
  int kind, c, tb, L;
  if (unit < 4096) { kind = 0; c = unit >> 4; tb = (unit & 15) * 256; L = T; } else { kind = 1; c = unit - 4096; tb = 0; L = LC; }
  const int tid = tid_(), lane = tid & 63, wid = tid >> 6, fr = lane & 15, fq = lane >> 4;
  float* red = (float*)(smem + 2 * 16512);
  const float* F = (kind ? opq(p.FC) : opq(p.FL)) + (size_t)c * 2 * L;
  float scale;
  {
    float part = 0.f;
    for (int i = tid; i < 2 * L; i += 256) { float fv = F[i]; part += (i != L) ? fv * fv : 0.f; }
    part = wave_sum(part);
    __syncthreads();
    if (lane == 0) red[wid] = part;
    __syncthreads();
    scale = rsqrtf(((red[0] + red[1]) + (red[2] + red[3])) + 1e-6f);
  }
  const bf16_t* U = (kind ? opq(p.UTc) : opq(p.UTl)) + (size_t)c * 16 * L;
  f32x4 acc[4];
#pragma unroll
  for (int m = 0; m < 4; ++m) acc[m] = (f32x4){0.f, 0.f, 0.f, 0.f};
  const int nch = L / 256;
  float fw0, fw1, fw2;
  uint4 ru0, ru1;
  auto ldchunk = [&](int ch) {
    const int sc = ch * 256;
    const int D0 = tb + 256 - sc;
    auto tap = [&](int n) -> float {
      int d = D0 - n;
      float v = 0.f;
      if (d > -L && d < L) v = (d >= 0 ? F[d] : F[L - d]);
      return v;
    };
    fw0 = tap(tid); fw1 = tap(tid + 256); fw2 = (tid < 8) ? tap(tid + 512) : 0.f;
    const int bb = tid >> 4, sg0 = tid & 15;
    ru0 = *(const uint4*)(U + (size_t)bb * L + sc + 8 * sg0);
    ru1 = *(const uint4*)(U + (size_t)bb * L + sc + 8 * (sg0 + 16));
  };
  auto stchunk = [&](int buf) {
    bf16_t* Cq = (bf16_t*)(smem + buf * 16512);
    bf16_t* Us = (bf16_t*)(smem + buf * 16512 + 8320);
    const bf16_t h0 = f2bf(fw0 * scale), h1 = f2bf(fw1 * scale), h2 = f2bf(fw2 * scale);
#pragma unroll
    for (int rho = 0; rho < 8; ++rho) {
      int m = tid + rho;
      Cq[((m >> 3) * 8 + rho) * 8 + (m & 7)] = h0;
      m = tid + 256 + rho;
      if (m < 520) Cq[((m >> 3) * 8 + rho) * 8 + (m & 7)] = h1;
      m = tid + 512 + rho;
      if (tid < 8 && m < 520) Cq[((m >> 3) * 8 + rho) * 8 + (m & 7)] = h2;
    }
    if (tid < 8) {
#pragma unroll
      for (int rho = 1; rho < 8; ++rho) if (tid < rho) Cq[(rho) * 8 + tid] = 0;
    }
    const int bb = tid >> 4, sg0 = tid & 15;
    *(uint4*)&Us[(sg0 * 16 + bb) * 8] = ru0;
    *(uint4*)&Us[((sg0 + 16) * 16 + bb) * 8] = ru1;
  };
  ldchunk(0);
#pragma unroll 1
  for (int ch = 0; ch < nch; ++ch) {
    const int buf = ch & 1;
    stchunk(buf);
    __syncthreads();
    if (ch + 1 < nch) ldchunk(ch + 1);
    const bf16_t* Cq = (const bf16_t*)(smem + buf * 16512);
    const bf16_t* Us = (const bf16_t*)(smem + buf * 16512 + 8320);
#pragma unroll
    for (int kk = 0; kk < 8; ++kk) {
      bf16x8 bf = *(const bf16x8*)&Us[((4 * kk + fq) * 16 + fr) * 8];
#pragma unroll
      for (int m = 0; m < 4; ++m) {
        int it = wid * 4 + m;
        int base = 256 - 16 * it + 32 * kk + 8 * fq;
        int m0 = base - 8 * (fr >> 3);
        bf16x8 af = *(const bf16x8*)&Cq[((m0 >> 3) * 8 + (fr & 7)) * 8];
        acc[m] = mfma16(af, bf, acc[m]);
      }
    }
  }
  __syncthreads();
  bf16_t* Yt = (kind ? opq(p.YTc) : opq(p.YTl)) + ((size_t)c * 16 + fr) * L + tb;
#pragma unroll
  for (int m = 0; m < 4; ++m) {
    int t = (wid * 4 + m) * 16 + fq * 4;
    *(uint2*)(Yt + t) = make_uint2(pack2(acc[m][0], acc[m][1]), pack2(acc[m][2], acc[m][3]));
  }
}

DEV void hyena_post_unit(const P& p, int layer, int unit, char* smem) {
  int kind, b, t0, L;
  if (unit < 1024) { kind = 0; b = unit >> 6; t0 = (unit & 63) * 64; L = T; } else { int u = unit - 1024; kind = 1; b = u >> 2; t0 = (u & 3) * 64; L = LC; }
  const int c = tid_(), lane = c & 63, wid = c >> 6;
  const size_t row0 = (size_t)b * LT + (kind ? 0 : LC);
  bf16_t (*tile)[264] = (bf16_t (*)[264])smem;
  const float* cw = p.conv_w + (size_t)layer * 3 * 1536;
  const float wa = cw[c], wb = cw[1536 + c], wcc = cw[3072 + c], b0 = p.conv_b[layer * 1536 + c];
  const float bias = p.hy_bias[layer * 256 + c];
  const bf16_t* yt = (kind ? opq(p.YTc) : opq(p.YTl)) + ((size_t)c * 16 + b) * L + t0;
  const bf16_t* ut = (kind ? opq(p.UTc) : opq(p.UTl)) + ((size_t)c * 16 + b) * L + t0;
  auto ld = [&](int t) -> float { return (t >= 0 && t < L) ? bf2f(p.Z[(row0 + t) * INW + c]) : 0.f; };
  float xm = ld(t0 - 1), xc = ld(t0);
  __syncthreads();
#pragma unroll 1
  for (int i8 = 0; i8 < 8; ++i8) {
    uint4 yu = *(const uint4*)(yt + 8 * i8), uu = *(const uint4*)(ut + 8 * i8);
    float yv[8], uv[8];
    unpack8(yu, yv); unpack8(uu, uv);
#pragma unroll
    for (int i = 0; i < 8; ++i) {
      int t = t0 + i8 * 8 + i;
      float xn = ld(t + 1);
      float x0 = wa * xm + wb * xc + wcc * xn + b0;
      float o = x0 * (yv[i] + uv[i] * bias);
      tile[i8 * 8 + i][c] = f2bf(o);
      xm = xc; xc = xn;
    }
  }
  __syncthreads();
  for (int i = 0; i < 16; ++i) {
    int tl = wid * 16 + i;
    uint2 ou = *(const uint2*)&tile[tl][4 * lane];
    float o[4] = {bflo(ou.x), bfhi(ou.x), bflo(ou.y), bfhi(ou.y)};
    float ss = wave_sum(o[0] * o[0] + o[1] * o[1] + o[2] * o[2] + o[3] * o[3]);
    float rstd = rsqrtf(ss * (1.f / 256.f) + 1e-6f);
#pragma unroll
    for (int q = 0; q < 4; ++q) {
      o[q] = o[q] * rstd * p.hy_out_g[layer * 256 + 4 * lane + q];
#if !EN_HY
      o[q] = 0.f;
#endif
    }
    *(uint2*)(p.Y + (row0 + t0 + tl) * D + 4 * lane) = make_uint2(pack2(o[0], o[1]), pack2(o[2], o[3]));
  }
}

DEV void attn_unit(const P& p, int layer, int unit, char* smem) {
  const bool isctx = unit >= 4096;
  int b, qb, hq;
  if (!isctx) { b = unit >> 8; qb = (unit >> 3) & 31; hq = unit & 7; } else { int u = unit - 4096; b = u >> 4; qb = (u >> 3) & 1; hq = u & 7; }
  const int g = hq >> 2;
  const int tid = tid_(), lane = tid & 63, wid = tid >> 6, qn = lane & 31, hh = lane >> 5;
  const int qpos = qb * 128 + wid * 32 + qn;
  const size_t qrow = (size_t)b * LT + (isctx ? qpos : LC + qpos);
  const bf16_t* qptr = p.Z + qrow * INW + 1920 + hq * 64;
  bf16x8 qf[4];
#pragma unroll
  for (int s = 0; s < 4; ++s) qf[s] = *(const bf16x8*)(qptr + 16 * s + 8 * hh);
  const float sink = p.attn_sink[layer * 8 + hq];
  float m_run = sink, l_run = 1.f;
  f32x16 o0, o1;
#pragma unroll
  for (int i = 0; i < 16; ++i) { o0[i] = 0.f; o1[i] = 0.f; }
  typedef bf16_t KTile[64][72];
  KTile* Ks = (KTile*)smem;
  KTile* Vt = (KTile*)(smem + 18432);
  const int ntl = isctx ? 0 : 6;
  const int ntiles = ntl + 4;
  const int skey = tid >> 3, sseg = tid & 7;
  const bf16_t* kvbase = p.Z + (size_t)b * LT * INW + 1920 + 512 + g * 64 + sseg * 8;
  uint4 rk0, rk1, rv0, rv1;
  auto ldtile = [&](int kt) {
    const bool ctxk = kt >= ntl;
    const int kbase = ctxk ? (kt - ntl) * 64 : qb * 128 - 128 + kt * 64;
    const int kp0 = kbase + skey, kp1 = kp0 + 32;
    rk0 = rk1 = rv0 = rv1 = make_uint4(0, 0, 0, 0);
    if (ctxk || (kp0 >= 0 && kp0 < T)) { const bf16_t* src = kvbase + (size_t)(ctxk ? kp0 : LC + kp0) * INW; rk0 = *(const uint4*)src; rv0 = *(const uint4*)(src + 128); }
    if (ctxk || (kp1 >= 0 && kp1 < T)) { const bf16_t* src = kvbase + (size_t)(ctxk ? kp1 : LC + kp1) * INW; rk1 = *(const uint4*)src; rv1 = *(const uint4*)(src + 128); }
  };
  auto sttile = [&](int buf) {
    *(uint4*)&Ks[buf][skey][sseg * 8] = rk0;
    *(uint4*)&Ks[buf][skey + 32][sseg * 8] = rk1;
    bf16_t (*vt)[72] = Vt[buf];
    vt[sseg * 8 + 0][skey] = (bf16_t)(rv0.x & 0xFFFF); vt[sseg * 8 + 1][skey] = (bf16_t)(rv0.x >> 16);
    vt[sseg * 8 + 2][skey] = (bf16_t)(rv0.y & 0xFFFF); vt[sseg * 8 + 3][skey] = (bf16_t)(rv0.y >> 16);
    vt[sseg * 8 + 4][skey] = (bf16_t)(rv0.z & 0xFFFF); vt[sseg * 8 + 5][skey] = (bf16_t)(rv0.z >> 16);
    vt[sseg * 8 + 6][skey] = (bf16_t)(rv0.w & 0xFFFF); vt[sseg * 8 + 7][skey] = (bf16_t)(rv0.w >> 16);
    vt[sseg * 8 + 0][skey + 32] = (bf16_t)(rv1.x & 0xFFFF); vt[sseg * 8 + 1][skey + 32] = (bf16_t)(rv1.x >> 16);
    vt[sseg * 8 + 2][skey + 32] = (bf16_t)(rv1.y & 0xFFFF); vt[sseg * 8 + 3][skey + 32] = (bf16_t)(rv1.y >> 16);
    vt[sseg * 8 + 4][skey + 32] = (bf16_t)(rv1.z & 0xFFFF); vt[sseg * 8 + 5][skey + 32] = (bf16_t)(rv1.z >> 16);
    vt[sseg * 8 + 6][skey + 32] = (bf16_t)(rv1.w & 0xFFFF); vt[sseg * 8 + 7][skey + 32] = (bf16_t)(rv1.w >> 16);
  };
  ldtile(0);
#pragma unroll 1
  for (int kt = 0; kt < ntiles; ++kt) {
    const int buf = kt & 1;
    sttile(buf);
    __syncthreads();
    if (kt + 1 < ntiles) ldtile(kt + 1);
    const bool ctxk = kt >= ntl;
    const int kbase = ctxk ? (kt - ntl) * 64 : qb * 128 - 128 + kt * 64;
#pragma unroll
    for (int sub = 0; sub < 2; ++sub) {
      const int kb2 = kbase + sub * 32;
      bool need = true;
      if (!ctxk) {
        int q0 = qb * 128 + wid * 32;
        if (kb2 + 31 < q0 - 128 || kb2 > q0 + 31 + 128 || kb2 + 31 < 0 || kb2 >= T) need = false;
      }
      if (need) {
        f32x16 sv;
#pragma unroll
        for (int i = 0; i < 16; ++i) sv[i] = 0.f;
#pragma unroll
        for (int ks = 0; ks < 4; ++ks) {
          bf16x8 kf = *(const bf16x8*)&Ks[buf][sub * 32 + qn][16 * ks + 8 * hh];
          sv = mfma32(kf, qf[ks], sv);
        }
        float mt = -3e38f;
#pragma unroll
        for (int rg = 0; rg < 16; ++rg) {
          float v = sv[rg] * 0.125f;
          if (!ctxk) {
            int kp = kb2 + (rg & 3) + 8 * (rg >> 2) + 4 * hh;
            int dl = qpos - kp;
            bool ok = (dl <= 128) && (dl >= -128) && (kp >= 0) && (kp < T);
            v = ok ? v : -1e30f;
          }
          sv[rg] = v;
          mt = fmaxf(mt, v);
        }
        mt = fmaxf(mt, __shfl_xor(mt, 32));
        float m_new = fmaxf(m_run, mt);
        float corr = __expf(m_run - m_new);
        float ps = 0.f;
#pragma unroll
        for (int rg = 0; rg < 16; ++rg) { float pv = __expf(sv[rg] - m_new); sv[rg] = pv; ps += pv; }
        ps += __shfl_xor(ps, 32);
        l_run = l_run * corr + ps;
        m_run = m_new;
#pragma unroll
        for (int i = 0; i < 16; ++i) { o0[i] *= corr; o1[i] *= corr; }
#pragma unroll
        for (int sp = 0; sp < 2; ++sp) {
          bf16x8 pf;
#pragma unroll
          for (int j = 0; j < 8; ++j) pf[j] = (short)f2bf(sv[8 * sp + j]);
          const int kc = sub * 32 + 16 * sp + 4 * hh;
          uint2 va = *(const uint2*)&Vt[buf][qn][kc], vb = *(const uint2*)&Vt[buf][qn][kc + 8];
          uint2 vc = *(const uint2*)&Vt[buf][32 + qn][kc], vd = *(const uint2*)&Vt[buf][32 + qn][kc + 8];
          uint4 w0 = make_uint4(va.x, va.y, vb.x, vb.y), w1 = make_uint4(vc.x, vc.y, vd.x, vd.y);
          bf16x8 v0 = __builtin_bit_cast(bf16x8, w0), v1 = __builtin_bit_cast(bf16x8, w1);
          o0 = mfma32(v0, pf, o0);
          o1 = mfma32(v1, pf, o1);
        }
      }
    }
  }
  __syncthreads();
  const float inv = 1.f / l_run;
  bf16_t* optr = p.Y + qrow * D + 512 + hq * 64;
#pragma unroll
  for (int rg = 0; rg < 4; ++rg) {
    int d0 = 8 * rg + 4 * hh;
    *(uint2*)(optr + d0) = make_uint2(pack2(o0[4 * rg] * inv, o0[4 * rg + 1] * inv), pack2(o0[4 * rg + 2] * inv, o0[4 * rg + 3] * inv));
    *(uint2*)(optr + 32 + d0) = make_uint2(pack2(o1[4 * rg] * inv, o1[4 * rg + 1] * inv), pack2(o1[4 * rg + 2] * inv, o1[4 * rg + 3] * inv));
  }
}

DEV void ph_attn_post(const P& p, int layer) {
  const int lane = tid_() & 63;
  int r0, r1;
  wave_range(r0, r1, NTOK);
  float gv[8];
#pragma unroll
  for (int i = 0; i < 8; ++i) gv[i] = p.at_out_g[layer * 512 + 8 * lane + i];
  uint4 nx = make_uint4(0, 0, 0, 0);
  if (r0 < r1) nx = *(const uint4*)(p.Y + (size_t)r0 * D + 512 + 8 * lane);
#pragma unroll 1
  for (int row = r0; row < r1; ++row) {
    const uint4 u = nx;
    if (row + 1 < r1) nx = *(const uint4*)(p.Y + (size_t)(row + 1) * D + 512 + 8 * lane);
    float v[8];
    unpack8(u, v);
    float ss = 0.f;
#pragma unroll
    for (int i = 0; i < 8; ++i) ss += v[i] * v[i];
    ss = wave_sum(ss);
    const float rstd = rsqrtf(ss * (1.f / 512.f) + 1e-6f);
#pragma unroll
    for (int i = 0; i < 8; ++i) {
      v[i] = v[i] * rstd * gv[i];
#if !EN_AT
      v[i] = 0.f;
#endif
    }
    *(uint4*)(p.Y + (size_t)row * D + 512 + 8 * lane) = pack8(v);
  }
}

struct Epi2 {
  const P& p; int layer, row0, col0;
  DEV void operator()(f32x4 (&acc)[4][4], int wr, int wc, int fr, int fq, char* smem) const {
    const int b = row0 / LT, pp = row0 % LT;
    const int mr = pp < LC ? 16 : b;
    const float* g1 = p.modv + ((size_t)layer * 17 + mr) * 6144 + 2048 + col0 + wc * 64;
#pragma unroll
    for (int n = 0; n < 4; ++n) {
      const float gv = g1[n * 16 + fr];
#pragma unroll
      for (int m = 0; m < 4; ++m)
#pragma unroll
        for (int j = 0; j < 4; ++j) acc[m][n][j] *= gv;
    }
    const int wid = wr * 2 + wc, lane = fq * 16 + fr;
    stage_tile_bf16(acc, smem, wid, fr, fq);
    const bf16_t (*t)[72] = (const bf16_t (*)[72])(smem + wid * 9216);
#pragma unroll
    for (int i = 0; i < 8; ++i) {
      const int rl = i * 8 + (lane >> 3), ch = lane & 7;
      bf16_t* xp = p.X + (size_t)(row0 + wr * 64 + rl) * D + col0 + wc * 64 + ch * 8;
      float xv[8], dv[8];
      uint4 xu = *(const uint4*)xp, du = *(const uint4*)&t[rl][ch * 8];
      unpack8(xu, xv); unpack8(du, dv);
#pragma unroll
      for (int q = 0; q < 8; ++q) xv[q] += dv[q];
#if EN_MIX
      *(uint4*)xp = pack8(xv);
#endif
    }
  }
};
DEV void ph_gemm2(const P& p, int layer, char* smem) {
  int rt, ct;
  for (int it = 0; gemm_unit(it, 8, rt, ct); ++it) {
    Epi2 epi{p, layer, rt * 128, ct * 128};
    gemm_tile(p.Y + (size_t)rt * 128 * D, D, p.W2t + (size_t)ct * 128 * D, D, D, smem, epi);
  }
}

DEV void ph_peerconv(const P& p, int layer) {
  const int gw = (bid_() * 256 + tid_()) >> 6, nw = gridDim.x * 4, lane = tid_() & 63;
  const float* su = opq(p.peer_u) + (size_t)layer * 16384 * 1024;
  const float* sv = opq(p.peer_v) + (size_t)layer * 16384 * 1024;
  unsigned char* pu = opq(p.PU); unsigned char* pv = opq(p.PV);
  float* psu = opq(p.PSU); float* psv = opq(p.PSV);
#pragma unroll 1
  for (int r = gw; r < 32768; r += nw) {
    const bool isv = r >= 16384;
    const int e = r & 16383;
    const float* src = (isv ? sv : su) + (size_t)e * 1024 + 16 * lane;
    float4 f0 = *(const float4*)src, f1 = *(const float4*)(src + 4), f2 = *(const float4*)(src + 8), f3 = *(const float4*)(src + 12);
    float am = fmaxf(fmaxf(fmaxf(fabsf(f0.x), fabsf(f0.y)), fmaxf(fabsf(f0.z), fabsf(f0.w))), fmaxf(fmaxf(fabsf(f1.x), fabsf(f1.y)), fmaxf(fabsf(f1.z), fabsf(f1.w))));
    am = fmaxf(am, fmaxf(fmaxf(fmaxf(fabsf(f2.x), fabsf(f2.y)), fmaxf(fabsf(f2.z), fabsf(f2.w))), fmaxf(fmaxf(fabsf(f3.x), fabsf(f3.y)), fmaxf(fabsf(f3.z), fabsf(f3.w)))));
    am = wave_max(am);
    int w0, w1, w2, w3;
    float inv;
    if (isv) {
      const float sc = am > 0.f ? 224.f / am : 1.f;
      inv = am > 0.f ? am * (1.f / 224.f) : 1.f;
      w0 = __builtin_amdgcn_cvt_pk_fp8_f32(f0.x * sc, f0.y * sc, 0, false); w0 = __builtin_amdgcn_cvt_pk_fp8_f32(f0.z * sc, f0.w * sc, w0, true);
      w1 = __builtin_amdgcn_cvt_pk_fp8_f32(f1.x * sc, f1.y * sc, 0, false); w1 = __builtin_amdgcn_cvt_pk_fp8_f32(f1.z * sc, f1.w * sc, w1, true);
      w2 = __builtin_amdgcn_cvt_pk_fp8_f32(f2.x * sc, f2.y * sc, 0, false); w2 = __builtin_amdgcn_cvt_pk_fp8_f32(f2.z * sc, f2.w * sc, w2, true);
      w3 = __builtin_amdgcn_cvt_pk_fp8_f32(f3.x * sc, f3.y * sc, 0, false); w3 = __builtin_amdgcn_cvt_pk_fp8_f32(f3.z * sc, f3.w * sc, w3, true);
    } else {
      const float sc = am > 0.f ? 127.f / am : 1.f;
      inv = am > 0.f ? am * (1.f / 127.f) : 1.f;
      w0 = pack_i8(f0.x * sc, f0.y * sc, f0.z * sc, f0.w * sc); w1 = pack_i8(f1.x * sc, f1.y * sc, f1.z * sc, f1.w * sc);
      w2 = pack_i8(f2.x * sc, f2.y * sc, f2.z * sc, f2.w * sc); w3 = pack_i8(f3.x * sc, f3.y * sc, f3.z * sc, f3.w * sc);
    }
    *(uint4*)((isv ? pv : pu) + (size_t)(lane >> 3) * PSLICE + (size_t)e * 128 + 16 * (lane & 7)) = make_uint4((unsigned)w0, (unsigned)w1, (unsigned)w2, (unsigned)w3);
    if (lane == 0) (isv ? psv : psu)[e] = inv;
  }
}
DEV void unpack16_fp8x2(const uint4& u, f32x2* f) {
  f[0] = __builtin_amdgcn_cvt_pk_f32_fp8((int)u.x, false); f[1] = __builtin_amdgcn_cvt_pk_f32_fp8((int)u.x, true);
  f[2] = __builtin_amdgcn_cvt_pk_f32_fp8((int)u.y, false); f[3] = __builtin_amdgcn_cvt_pk_f32_fp8((int)u.y, true);
  f[4] = __builtin_amdgcn_cvt_pk_f32_fp8((int)u.z, false); f[5] = __builtin_amdgcn_cvt_pk_f32_fp8((int)u.z, true);
  f[6] = __builtin_amdgcn_cvt_pk_f32_fp8((int)u.w, false); f[7] = __builtin_amdgcn_cvt_pk_f32_fp8((int)u.w, true);
}
DEV void unpack16_fp8(const uint4& u, float* f) {
  f32x2 t;
  t = __builtin_amdgcn_cvt_pk_f32_fp8((int)u.x, false); f[0] = t[0]; f[1] = t[1];
  t = __builtin_amdgcn_cvt_pk_f32_fp8((int)u.x, true); f[2] = t[0]; f[3] = t[1];
  t = __builtin_amdgcn_cvt_pk_f32_fp8((int)u.y, false); f[4] = t[0]; f[5] = t[1];
  t = __builtin_amdgcn_cvt_pk_f32_fp8((int)u.y, true); f[6] = t[0]; f[7] = t[1];
  t = __builtin_amdgcn_cvt_pk_f32_fp8((int)u.z, false); f[8] = t[0]; f[9] = t[1];
  t = __builtin_amdgcn_cvt_pk_f32_fp8((int)u.z, true); f[10] = t[0]; f[11] = t[1];
  t = __builtin_amdgcn_cvt_pk_f32_fp8((int)u.w, false); f[12] = t[0]; f[13] = t[1];
  t = __builtin_amdgcn_cvt_pk_f32_fp8((int)u.w, true); f[14] = t[0]; f[15] = t[1];
}

DEV void bitonic_sort16_desc(float (&v)[16]) {
#pragma unroll
  for (int k = 2; k <= 16; k <<= 1)
#pragma unroll
    for (int j = k >> 1; j >= 1; j >>= 1)
#pragma unroll
      for (int i = 0; i < 16; ++i) {
        const int l = i ^ j;
        if (l > i) {
          const float hi = fmaxf(v[i], v[l]), lo = fminf(v[i], v[l]);
          if ((i & k) == 0) { v[i] = hi; v[l] = lo; } else { v[i] = lo; v[l] = hi; }
        }
      }
}
struct Epi3 {
  const P& p; int row0, grp;
  DEV void operator()(f32x4 (&acc)[4][4], int wr, int wc, int fr, int fq, char* smem) const {
    float* sc = (float*)smem;
    const int tid = tid_();
    for (int pass = 0; pass < 2; ++pass) {
      __syncthreads();
      if (wr == pass) {
#pragma unroll
        for (int m = 0; m < 4; ++m)
#pragma unroll
          for (int n = 0; n < 4; ++n)
#pragma unroll
            for (int j = 0; j < 4; ++j) {
              int rl = m * 16 + fq * 4 + j, col = wc * 64 + n * 16 + fr;
              unsigned bits = (__float_as_uint(acc[m][n][j]) & ~127u) | (unsigned)col;
              sc[rl * 133 + (col >> 5) * 33 + (col & 31)] = __uint_as_float(bits);
            }
      }
      __syncthreads();
      const int rl = tid >> 2, q = tid & 3;
      const float* src = sc + rl * 133 + q * 33;
      float Ls[16], Hs[16];
#pragma unroll
      for (int i = 0; i < 16; ++i) { Ls[i] = src[i]; Hs[i] = src[16 + i]; }
      bitonic_sort16_desc(Ls);
      bitonic_sort16_desc(Hs);
#pragma unroll
      for (int i = 0; i < 16; ++i) Ls[i] = fmaxf(Ls[i], Hs[15 - i]);
#pragma unroll
      for (int d = 8; d >= 1; d >>= 1)
#pragma unroll
        for (int i = 0; i < 16; ++i)
          if ((i & d) == 0) { float hi = fmaxf(Ls[i], Ls[i + d]), lo = fminf(Ls[i], Ls[i + d]); Ls[i] = hi; Ls[i + d] = lo; }
      float Cs[16];
#pragma unroll
      for (int i = 0; i < 16; ++i) Cs[i] = fmaxf(Ls[i], dppself<0xB1, 0xF>(Ls[15 - i]));
#pragma unroll
      for (int d = 8; d >= 1; d >>= 1)
#pragma unroll
        for (int i = 0; i < 16; ++i)
          if ((i & d) == 0) { float hi = fmaxf(Cs[i], Cs[i + d]), lo = fminf(Cs[i], Cs[i + d]); Cs[i] = hi; Cs[i + d] = lo; }
      float Ds[16];
#pragma unroll
      for (int i = 0; i < 16; ++i) Ds[i] = fmaxf(Cs[i], dppself<0x4E, 0xF>(Cs[15 - i]));
#pragma unroll
      for (int d = 8; d >= 1; d >>= 1)
#pragma unroll
        for (int i = 0; i < 16; ++i)
          if ((i & d) == 0) { float hi = fmaxf(Ds[i], Ds[i + d]), lo = fminf(Ds[i], Ds[i + d]); Ds[i] = hi; Ds[i + d] = lo; }
      if (q == 0) {
        float* dst = p.TK + ((size_t)(row0 + pass * 64 + rl) * 16 + grp) * 16;
#pragma unroll
        for (int i = 0; i < 4; ++i) *(float4*)(dst + 4 * i) = make_float4(Ds[4 * i], Ds[4 * i + 1], Ds[4 * i + 2], Ds[4 * i + 3]);
      }
    }
  }
};
DEV void ph_gemm3(const P& p, char* smem) {
  int rt, ct;
  for (int it = 0; gemm_unit(it, 16, rt, ct); ++it) {
    Epi3 epi{p, rt * 128, ct};
    gemm_tile(p.H + (size_t)rt * 128 * D, D, p.Wft + (size_t)ct * 128 * D, D, D, smem, epi);
  }
}

DEV float peer_gate(float scr) {
  float mx = row16_max(scr);
  float ex = __expf(scr - mx);
  float sm = row16_sum(ex);
  return ex / sm;
}
DEV float gelu_exact(float x) { return 0.5f * x * (1.f + erff(x * 0.7071067811865476f)); }

DEV void ph_peer_select(const P& p) {
  const int gw = (bid_() * 256 + tid_()) >> 6, nw = gridDim.x * 4, lane = tid_() & 63;
  int ci, cj;
  {
    const int c = lane;
    if (c < 16) { ci = 0; cj = c; } else if (c < 24) { ci = 1; cj = c - 16; } else if (c < 29) { ci = 2; cj = c - 24; }
    else if (c < 33) { ci = 3; cj = c - 29; } else if (c < 36) { ci = 4; cj = c - 33; } else if (c < 38) { ci = 5; cj = c - 36; }
    else if (c < 40) { ci = 6; cj = c - 38; } else if (c < 42) { ci = 7; cj = c - 40; } else { ci = (c - 42 + 8) & 15; cj = 0; }
  }
  const bool cand = lane < 50;
  float v1s[8], v2s[8];
  auto ldtk = [&](int row) {
    const float* tk = p.TK + (size_t)row * 256;
#pragma unroll
    for (int h = 0; h < 8; ++h) { v1s[h] = tk[(2 * h) * 16 + ci]; v2s[h] = tk[(2 * h + 1) * 16 + cj]; }
  };
  if (gw < NTOK) ldtk(gw);
#pragma unroll 1
  for (int row = gw; row < NTOK; row += nw) {
    float c1[8], c2[8];
#pragma unroll
    for (int h = 0; h < 8; ++h) { c1[h] = v1s[h]; c2[h] = v2s[h]; }
    if (row + nw < NTOK) ldtk(row + nw);
#pragma unroll
    for (int h = 0; h < 8; ++h) {
      const float v1 = c1[h], v2 = c2[h];
      float val = v1 + v2;
      val = __uint_as_float((__float_as_uint(val) & ~63u) | (unsigned)lane);
      val = cand ? val : -3e38f;
      int rank = 0;
#pragma unroll
      for (int q = 0; q < 50; ++q) rank += (readlane_f(val, q) > val) ? 1 : 0;
      const bool sel = cand && rank < 16;
      const float mx = wave_max(val);
      const float ex = sel ? __expf(val - mx) : 0.f;
      const float sm = wave_sum(ex);
      if (sel) {
        const int e = (int)(__float_as_uint(v1) & 127u) * 128 + (int)(__float_as_uint(v2) & 127u);
        p.EL[(size_t)row * 128 + h * 16 + rank] = (unsigned short)e;
        p.GT[(size_t)row * 128 + h * 16 + rank] = ex / sm;
      }
    }
  }
}

struct PeerPre { uint4 e0, e1, a0, a1, a2, a3; };
DEV unsigned peer_eid(const PeerPre& s, int j) {
  const unsigned w = (j < 8) ? ((j >> 1) == 0 ? s.e0.x : (j >> 1) == 1 ? s.e0.y : (j >> 1) == 2 ? s.e0.z : s.e0.w)
                             : (((j - 8) >> 1) == 0 ? s.e1.x : ((j - 8) >> 1) == 1 ? s.e1.y : ((j - 8) >> 1) == 2 ? s.e1.z : s.e1.w);
  return (j & 1) ? (w >> 16) : (w & 0xFFFFu);
}
template <int WHICH>
DEV void peer_wave_run(const P& p, int layer, int x, int tok0, int lane, float* wbuf) {
  const int r = lane >> 3, c = lane & 7;
  const unsigned char* tb = (WHICH == 0 ? p.PU : p.PV) + (size_t)x * PSLICE + c * 16;
  PeerPre S[3];
  uint4 R[16];
  auto ld_pre = [&](int tok, PeerPre& s) {
    const uint4* elp = (const uint4*)(p.EL + (size_t)tok * 128 + r * 16);
    s.e0 = elp[0]; s.e1 = elp[1];
    if (WHICH == 0) {
      s.a0 = *(const uint4*)(p.H8 + (size_t)tok * 1024 + x * 128 + c * 16);
    } else {
      const uint4* wtp = (const uint4*)(p.GT + (size_t)tok * 128 + r * 16);
      s.a0 = wtp[0]; s.a1 = wtp[1]; s.a2 = wtp[2]; s.a3 = wtp[3];
    }
  };
  auto comp = [&](int tok, const PeerPre& s, const PeerPre& sn, bool more) {
    if (WHICH == 0) {
      int keep0 = 0, keep1 = 0;
#pragma unroll
      for (int j = 0; j < 16; ++j) {
        const uint4 rw = R[j];
        if (more) R[j] = *(const uint4*)(tb + (size_t)peer_eid(sn, j) * 128);
        int d = __builtin_amdgcn_sdot4((int)rw.x, (int)s.a0.x, 0, false);
        d = __builtin_amdgcn_sdot4((int)rw.y, (int)s.a0.y, d, false);
        d = __builtin_amdgcn_sdot4((int)rw.z, (int)s.a0.z, d, false);
        d = __builtin_amdgcn_sdot4((int)rw.w, (int)s.a0.w, d, false);
        d += __builtin_amdgcn_update_dpp(0, d, 0xB1, 0xF, 0xF, false);
        d += __builtin_amdgcn_update_dpp(0, d, 0x4E, 0xF, 0xF, false);
        d += __builtin_amdgcn_update_dpp(0, d, 0x141, 0xF, 0xF, false);
        if (j < 8) keep0 = (c == j) ? d : keep0; else keep1 = (c == j - 8) ? d : keep1;
      }
      float* pd = p.PD + ((size_t)x * NTOK + tok) * 128 + r * 16 + c;
      pd[0] = (float)keep0; pd[8] = (float)keep1;
    } else {
      const float wsv[16] = {__uint_as_float(s.a0.x), __uint_as_float(s.a0.y), __uint_as_float(s.a0.z), __uint_as_float(s.a0.w),
                             __uint_as_float(s.a1.x), __uint_as_float(s.a1.y), __uint_as_float(s.a1.z), __uint_as_float(s.a1.w),
                             __uint_as_float(s.a2.x), __uint_as_float(s.a2.y), __uint_as_float(s.a2.z), __uint_as_float(s.a2.w),
                             __uint_as_float(s.a3.x), __uint_as_float(s.a3.y), __uint_as_float(s.a3.z), __uint_as_float(s.a3.w)};
      f32x2 acc2[8];
#pragma unroll
      for (int i = 0; i < 8; ++i) acc2[i] = (f32x2){0.f, 0.f};
#pragma unroll
      for (int j = 0; j < 16; ++j) {
        f32x2 f[8];
        unpack16_fp8x2(R[j], f);
        if (more) R[j] = *(const uint4*)(tb + (size_t)peer_eid(sn, j) * 128);
        const f32x2 w2 = (f32x2){wsv[j], wsv[j]};
#pragma unroll
        for (int i = 0; i < 8; ++i) acc2[i] += w2 * f[i];
      }
      float* slab = wbuf + (r * 8 + c) * 16;
      *(float4*)(slab) = make_float4(acc2[0][0], acc2[0][1], acc2[1][0], acc2[1][1]);
      *(float4*)(slab + 4) = make_float4(acc2[2][0], acc2[2][1], acc2[3][0], acc2[3][1]);
      *(float4*)(slab + 8) = make_float4(acc2[4][0], acc2[4][1], acc2[5][0], acc2[5][1]);
      *(float4*)(slab + 12) = make_float4(acc2[6][0], acc2[6][1], acc2[7][0], acc2[7][1]);
      asm volatile("s_waitcnt lgkmcnt(0)" ::: "memory");
      float o0 = 0.f, o1 = 0.f;
#pragma unroll
      for (int rr = 0; rr < 8; ++rr) {
        const float2 t = *(const float2*)(wbuf + (rr * 8 + (lane >> 3)) * 16 + 2 * (lane & 7));
        o0 += t.x; o1 += t.y;
      }
      asm volatile("s_waitcnt lgkmcnt(0)" ::: "memory");
      const int b = tok / LT, pp = tok % LT;
      const int mr = pp < LC ? 16 : b;
      const int col = x * 128 + 2 * lane;
      const float* g2 = p.modv + ((size_t)layer * 17 + mr) * 6144 + 5120 + col;
      unsigned* xp = (unsigned*)(p.X + (size_t)tok * D + col);
      const unsigned xu = *xp;
#if EN_PEER
      *xp = pack2(bflo(xu) + g2[0] * o0, bfhi(xu) + g2[1] * o1);
#endif
    }
  };
  ld_pre(tok0, S[0]);
  ld_pre(tok0 + 1, S[1]);
#pragma unroll
  for (int j = 0; j < 16; ++j) R[j] = *(const uint4*)(tb + (size_t)peer_eid(S[0], j) * 128);
  ld_pre(tok0 + 2, S[2]);
#pragma unroll
  for (int t = 0; t < 8; ++t) {
    comp(tok0 + t, S[t % 3], S[(t + 1) % 3], t + 1 < 8);
    if (t + 3 < 8) ld_pre(tok0 + t + 3, S[t % 3]);
  }
}
DEV void ph_peer_w(const P& p) {
  for (size_t i = (size_t)bid_() * 256 + tid_(); i < (size_t)NTOK * 128; i += (size_t)gridDim.x * 256) {
    float d = 0.f;
#pragma unroll
    for (int x = 0; x < 8; ++x) d += p.PD[(size_t)x * NTOK * 128 + i];
    const int e = p.EL[i];
    p.GT[i] = p.GT[i] * gelu_exact(d * p.PSU[e] * p.HINV[i >> 7]) * p.PSV[e];
  }
}
template <int WHICH>
DEV void ph_peer_gather(const P& p, int layer, char* smem, volatile LAS unsigned* slot) {
  const int tid = tid_(), lane = tid & 63, wid = tid >> 6;
  unsigned* q = p.wq + 1024 + layer * 256 + WHICH * 128;
  const int my = (int)(xb_xcc_id() & 7u);
  float* wbuf = (float*)smem + wid * 1024;
#pragma unroll 1
  for (int rot = 0; rot < 8; ++rot) {
    const int x = (my + rot) & 7;
    for (;;) {
      __syncthreads();
      if (tid == 0) *slot = atomicAdd(q + x * 16, 1u);
      __syncthreads();
      const int it = (int)*slot;
      if (it >= NTOK / 32) break;
      peer_wave_run<WHICH>(p, layer, x, it * 32 + wid * 8, lane, wbuf);
    }
  }
}

DEV void ph_final(const P& p) {
  const int lane = tid_() & 63;
  int r0, r1;
  wave_range(r0, r1, NB * T);
  float gv[16];
#pragma unroll
  for (int hh = 0; hh < 2; ++hh)
#pragma unroll
    for (int i = 0; i < 8; ++i) gv[hh * 8 + i] = p.final_g[hh * 512 + 8 * lane + i];
  auto xrow = [&](int r) -> const bf16_t* { const int b = r / T, t = r % T; return p.X + ((size_t)b * LT + LC + t) * D; };
  uint4 n0 = make_uint4(0, 0, 0, 0), n1 = n0;
  if (r0 < r1) { const bf16_t* xr = xrow(r0); n0 = *(const uint4*)(xr + 8 * lane); n1 = *(const uint4*)(xr + 512 + 8 * lane); }
#pragma unroll 1
  for (int r = r0; r < r1; ++r) {
    const uint4 u0 = n0, u1 = n1;
    if (r + 1 < r1) { const bf16_t* xr = xrow(r + 1); n0 = *(const uint4*)(xr + 8 * lane); n1 = *(const uint4*)(xr + 512 + 8 * lane); }
    float v[16];
    unpack8(u0, v); unpack8(u1, v + 8);
    float ss = 0.f;
#pragma unroll
    for (int i = 0; i < 16; ++i) ss += v[i] * v[i];
    ss = wave_sum(ss);
    const float rstd = rsqrtf(ss * (1.f / 1024.f) + 1e-6f);
    float* o = p.out + (size_t)r * D;
#pragma unroll
    for (int hh = 0; hh < 2; ++hh) {
      const int col = hh * 512 + 8 * lane;
      *(float4*)(o + col) = make_float4(v[hh * 8 + 0] * rstd * gv[hh * 8 + 0], v[hh * 8 + 1] * rstd * gv[hh * 8 + 1], v[hh * 8 + 2] * rstd * gv[hh * 8 + 2], v[hh * 8 + 3] * rstd * gv[hh * 8 + 3]);
      *(float4*)(o + col + 4) = make_float4(v[hh * 8 + 4] * rstd * gv[hh * 8 + 4], v[hh * 8 + 5] * rstd * gv[hh * 8 + 5], v[hh * 8 + 6] * rstd * gv[hh * 8 + 6], v[hh * 8 + 7] * rstd * gv[hh * 8 + 7]);
    }
  }
}

DEV unsigned hw_cu_key() {
  const unsigned hwid = (unsigned)__builtin_amdgcn_s_getreg(((8 - 1) << 11) | (8 << 6) | 4);
  return (xb_xcc_id() << 8) | (hwid & 0xFFu);
}
DEV void mixB(const P& p, int layer, char* smem, volatile LAS unsigned* slot) {
  unsigned* qa = p.wq + layer * 64;
  unsigned* qs = qa + 16;
  unsigned* claim = p.cuclaim + layer * 4096;
  __syncthreads();
  if (tid_() == 0) {
    unsigned u = 0xFFFFFFFFu;
    if (atomicAdd(&claim[hw_cu_key() & 4095u], 1u) == 0u) u = atomicAdd(qs, 1u);
    *slot = u;
  }
  __syncthreads();
  {
    const unsigned u = *slot;
    if (u < 128u) scanc_unit(p, layer, (int)u, smem);
  }
  for (;;) {
    __syncthreads();
    if (tid_() == 0) *slot = atomicAdd(qa, 1u);
    __syncthreads();
    const int u = (int)*slot;
    if (u >= 8704) break;
    if (u < 4352) attn_unit(p, layer, u, smem); else hyena_conv_unit(p, layer, u - 4352, smem);
  }
  if (layer + 1 < NLAYERS) {
    unsigned* qp = qa + 32;
    for (;;) {
      __syncthreads();
      if (tid_() == 0) *slot = atomicAdd(qp, 1u);
      __syncthreads();
      const int u = (int)*slot;
      if (u >= PREPA_N) break;
      prep_unit(p, layer + 1, prepA_unit_index(u), smem);
    }
  }
  for (;;) {
    __syncthreads();
    if (tid_() == 0) *slot = atomicAdd(qs, 1u);
    __syncthreads();
    const unsigned u = *slot;
    if (u >= 128u) break;
    scanc_unit(p, layer, (int)u, smem);
  }
}
DEV void mixA(const P& p, int layer, char* smem) {
  for (int u = bid_(); u < 1088; u += gridDim.x) hyena_pre_unit(p, layer, u);
  ph_lora(p, layer, smem);
  ph_rwkv_prep(p, layer);
}
DEV void mixC(const P& p, int layer, char* smem) {
  for (int u = bid_(); u < 1088; u += gridDim.x) hyena_post_unit(p, layer, u, smem);
  ph_rwkv_post(p, layer);
  ph_attn_post(p, layer);
}

__global__ void __launch_bounds__(256, 2) k_mega(P p) {
  extern __shared__ __attribute__((aligned(16))) char smem_all[];
  char* smem = smem_all;
  volatile LAS unsigned* xbw = (volatile LAS unsigned*)(smem_all + SMEM_BYTES);
  if (threadIdx.x == 0) { xbw[0] = 0u; xbw[1] = 0u; xbw[2] = 0u; xbw[3] = 0u; }
  __syncthreads();
  XcdBarrier bar = xcd_barrier_post(p.bar, xbw);
#ifndef NO_PRO
  ph_copy(p);
  ph_rope(p);
  for (int u = blockIdx.x; u < 96; u += gridDim.x) modv_unit(p, u, smem);
#endif
#ifndef NO_PREP
  ph_prep(p, 0, smem, false);
#endif
  xcd_barrier(bar);
  for (int layer = 0; layer < NLAYERS; ++layer) {
#ifndef NO_NORM
    ph_norm(p, layer, 0);
#endif
    xcd_barrier(bar);
#ifdef PROBE_GEMM
    ph_gemm1(p, smem);
#endif
#ifndef NO_GEMM1
    ph_gemm1(p, smem);
#endif
    xcd_barrier(bar);
#ifndef NO_MIXA
    mixA(p, layer, smem);
#endif
    xcd_barrier(bar);
#ifndef NO_MIXB
    mixB(p, layer, smem, (volatile LAS unsigned*)(smem_all + SMEM_BYTES + 16));
#endif
    xcd_barrier(bar);
#ifndef NO_MIXC
    mixC(p, layer, smem);
#endif
    xcd_barrier(bar);
#ifndef NO_GEMM2
    ph_gemm2(p, layer, smem);
    ph_peerconv(p, layer);
#endif
    xcd_barrier(bar);
#ifndef NO_NORM
    ph_norm(p, layer, 1);
#endif
    xcd_barrier(bar);
#ifdef PROBE_GEMM
    ph_gemm3(p, smem);
#endif
#ifndef NO_GEMM3
    ph_gemm3(p, smem);
#endif
    xcd_barrier(bar);
    ph_peer_select(p);
    xcd_barrier(bar);
    ph_peer_gather<0>(p, layer, smem, (volatile LAS unsigned*)(smem_all + SMEM_BYTES + 16));
    xcd_barrier(bar);
    ph_peer_w(p);
    xcd_barrier(bar);
    ph_peer_gather<1>(p, layer, smem, (volatile LAS unsigned*)(smem_all + SMEM_BYTES + 16));
#ifndef NO_PREP
    if (layer + 1 < NLAYERS) ph_prep(p, layer + 1, smem, true);
#endif
    xcd_barrier(bar);
  }
  ph_final(p);
}

static inline size_t al256(size_t x) { return (x + 255) & ~(size_t)255; }

extern "C" void kernel_launch(void* const* d_in, const int* in_sizes, int n_in, void* d_out, int out_size, void* d_ws, size_t ws_size,
                              hipStream_t stream) {
  (void)in_sizes; (void)n_in; (void)out_size; (void)ws_size;
  P p{};
  const float** f = (const float**)&p;
  for (int i = 0; i < 39; ++i) f[i] = (const float*)d_in[i];
  p.out = (float*)d_out;
  char* w = (char*)d_ws;
  size_t off = 0;
  auto take = [&](size_t bytes) { char* r = w + off; off += al256(bytes); return r; };
  p.bar = (unsigned*)take(16384);
  p.modv = (float*)take((size_t)DEPTH * 17 * 6144 * 4);
  p.SSQ = (float*)take((size_t)DEPTH * 2 * 256 * 4);
  p.wq = (unsigned*)take(4096 + DEPTH * 1024);
  p.cuclaim = (unsigned*)take((size_t)DEPTH * 4096 * 4);
  const size_t zero_bytes = off;
  p.rope = (float*)take(64 * 16 * 2 * 4);
  p.X = (bf16_t*)take((size_t)NTOK * D * 2);
  p.H = (bf16_t*)take((size_t)NTOK * D * 2);
  p.Y = (bf16_t*)take((size_t)NTOK * D * 2);
  p.SC = (bf16_t*)take((size_t)NTOK * 1024 * 2);
  p.Z = (bf16_t*)take((size_t)NTOK * INW * 2);
  p.UTl = (bf16_t*)take((size_t)256 * 16 * T * 2);
  p.UTc = (bf16_t*)take((size_t)256 * 16 * LC * 2);
  p.YTl = (bf16_t*)take((size_t)256 * 16 * T * 2);
  p.YTc = (bf16_t*)take((size_t)256 * 16 * LC * 2);
  p.FL = (float*)take((size_t)256 * 2 * T * 4);
  p.FC = (float*)take((size_t)256 * 2 * LC * 4);
  p.W1t = (bf16_t*)take((size_t)INW * D * 2);
  p.W2t = (bf16_t*)take((size_t)D * D * 2);
  p.Wft = (bf16_t*)take((size_t)2048 * D * 2);
  p.Wlt = (bf16_t*)take((size_t)1024 * 256 * 2);
  p.Wgt = (bf16_t*)take((size_t)256 * 128 * 2);
  p.TK = (float*)p.Z;
  p.PU = (unsigned char*)p.Z + al256((size_t)NTOK * 256 * 4);
  p.PV = p.PU + (size_t)16384 * 1024;
  p.PSU = (float*)(p.PV + (size_t)16384 * 1024);
  p.PSV = p.PSU + 16384;
  p.GT = p.PSV + 16384;
  p.EL = (unsigned short*)(p.GT + (size_t)NTOK * 128);
  p.H8 = (unsigned char*)p.EL + al256((size_t)NTOK * 128 * 2);
  p.HINV = (float*)(p.H8 + (size_t)NTOK * 1024);
  p.PD = (float*)p.Y;

  (void)hipMemsetAsync(d_ws, 0, zero_bytes, stream);
  constexpr size_t kDynLds = SMEM_BYTES + 32;
  static int grid = 0;
  if (!grid) {
    int dev = 0, cus = 0, per_cu = 0;
    (void)hipGetDevice(&dev);
    (void)hipDeviceGetAttribute(&cus, hipDeviceAttributeMultiprocessorCount, dev);
    (void)hipFuncSetAttribute((const void*)k_mega, hipFuncAttributeMaxDynamicSharedMemorySize, (int)kDynLds);
    (void)hipOccupancyMaxActiveBlocksPerMultiprocessor(&per_cu, k_mega, 256, kDynLds);
    if (cus <= 0) cus = 256;
    if (per_cu > 2) per_cu = 2;
    if (per_cu < 1) per_cu = 1;
    grid = cus * per_cu;
  }
  k_mega<<<grid, 256, kDynLds, stream>>>(p);
}
```

```cpp
#include <hip/hip_runtime.h>
#include <stdint.h>
#include <type_traits>

#define DEV __device__ __forceinline__
typedef unsigned short bf16_t;
typedef short bf16x8 __attribute__((ext_vector_type(8)));
typedef float f32x2 __attribute__((ext_vector_type(2)));
constexpr size_t PSLICE = (size_t)16384 * 128;
typedef float f32x4 __attribute__((ext_vector_type(4)));
typedef float f32x16 __attribute__((ext_vector_type(16)));


constexpr int NB = 16, T = 4096, LC = 256, LT = 4352, D = 1024, NTOK = NB * LT, INW = 2688, DEPTH = 4;
constexpr int SMEM_BYTES = 65536;

struct P {
  const float *x, *c, *ctx, *c_ctx, *mod_w, *mod_b, *norm1_g, *norm2_g, *w_in, *conv_w, *conv_b;
  const float *hy_w1, *hy_b1, *hy_w2, *hy_b2, *hy_w3, *hy_b3, *hy_freq, *hy_bias;
  const float *rw_w0, *rw_w_up, *rw_a0, *rw_a_up, *rw_g_up, *rw_k_k, *rw_k_a, *rw_r_k, *rw_ln_w, *rw_ln_b;
  const float *attn_sink, *hy_out_g, *at_out_g, *w_out, *peer_wq, *peer_k1, *peer_k2, *peer_u, *peer_v, *final_g;
  float* out;
  unsigned* bar;
  float *modv, *SSQ, *rope, *FL, *FC, *TK;
  unsigned *wq, *cuclaim;
  bf16_t *X, *H, *Y, *SC, *Z, *UTl, *UTc, *YTl, *YTc;
  bf16_t *W1t, *W2t, *Wft, *Wlt, *Wgt;
  unsigned char *PU, *PV;
  float *PSU, *PSV, *GT, *PD, *HINV;
  unsigned short* EL;
  unsigned char* H8;
};

typedef __bf16 hwbf2 __attribute__((ext_vector_type(2)));
DEV unsigned pack2(float a, float b) { f32x2 f = {a, b}; hwbf2 r = __builtin_convertvector(f, hwbf2); return __builtin_bit_cast(unsigned, r); }
DEV bf16_t f2bf(float f) { return (bf16_t)(pack2(f, 0.f) & 0xFFFFu); }
DEV float bf2f(bf16_t h) { return __uint_as_float(((unsigned)h) << 16); }
DEV float bflo(unsigned u) { return __uint_as_float(u << 16); }
DEV float bfhi(unsigned u) { return __uint_as_float(u & 0xFFFF0000u); }
DEV void unpack8(const uint4& u, float* v) {
  v[0] = bflo(u.x); v[1] = bfhi(u.x); v[2] = bflo(u.y); v[3] = bfhi(u.y);
  v[4] = bflo(u.z); v[5] = bfhi(u.z); v[6] = bflo(u.w); v[7] = bfhi(u.w);
}
DEV uint4 pack8(const float* v) { return make_uint4(pack2(v[0], v[1]), pack2(v[2], v[3]), pack2(v[4], v[5]), pack2(v[6], v[7])); }
DEV int pack_i8(float a, float b, float c, float d) {
  const int ia = __float2int_rn(a), ib = __float2int_rn(b), ic = __float2int_rn(c), id = __float2int_rn(d);
  return (ia & 0xFF) | ((ib & 0xFF) << 8) | ((ic & 0xFF) << 16) | ((id & 0xFF) << 24);
}
DEV float sigmoidf_(float x) { return __builtin_amdgcn_rcpf(1.f + __expf(-x)); }

template <int CTRL, int ROWMASK>
DEV float dpp0(float x) {
  return __builtin_bit_cast(float, __builtin_amdgcn_update_dpp(0, __builtin_bit_cast(int, x), CTRL, ROWMASK, 0xF, false));
}
template <int CTRL, int ROWMASK>
DEV float dppself(float x) {
  int xi = __builtin_bit_cast(int, x);
  return __builtin_bit_cast(float, __builtin_amdgcn_update_dpp(xi, xi, CTRL, ROWMASK, 0xF, false));
}
DEV float readlane_f(float x, int l) { return __builtin_bit_cast(float, __builtin_amdgcn_readlane(__builtin_bit_cast(int, x), l)); }
DEV int lane_id() { return (int)__builtin_amdgcn_mbcnt_hi(~0u, __builtin_amdgcn_mbcnt_lo(~0u, 0u)); }
DEV float writelane_f(float val, int l, float old) { return lane_id() == l ? val : old; }
DEV int writelane_i(int val, int l, int old) { return lane_id() == l ? val : old; }
DEV float wave_sum(float x) {
  x += dpp0<0x111, 0xF>(x); x += dpp0<0x112, 0xF>(x); x += dpp0<0x114, 0xF>(x); x += dpp0<0x118, 0xF>(x);
  x += dpp0<0x142, 0xA>(x); x += dpp0<0x143, 0xC>(x);
  return readlane_f(x, 63);
}
DEV float wave_max(float x) {
  x = fmaxf(x, dppself<0x111, 0xF>(x)); x = fmaxf(x, dppself<0x112, 0xF>(x)); x = fmaxf(x, dppself<0x114, 0xF>(x));
  x = fmaxf(x, dppself<0x118, 0xF>(x)); x = fmaxf(x, dppself<0x142, 0xA>(x)); x = fmaxf(x, dppself<0x143, 0xC>(x));
  return readlane_f(x, 63);
}
DEV float row16_sum(float x) {
  x += dpp0<0xB1, 0xF>(x); x += dpp0<0x4E, 0xF>(x); x += dpp0<0x141, 0xF>(x); x += dpp0<0x140, 0xF>(x);
  return x;
}
DEV float row16_max(float x) {
  x = fmaxf(x, dppself<0xB1, 0xF>(x)); x = fmaxf(x, dppself<0x4E, 0xF>(x)); x = fmaxf(x, dppself<0x141, 0xF>(x));
  x = fmaxf(x, dppself<0x140, 0xF>(x));
  return x;
}
DEV float quad_sum(float x) { x += dpp0<0xB1, 0xF>(x); x += dpp0<0x4E, 0xF>(x); return x; }

DEV f32x4 mfma16(bf16x8 a, bf16x8 b, f32x4 c) { return __builtin_amdgcn_mfma_f32_16x16x32_bf16(a, b, c, 0, 0, 0); }
DEV f32x16 mfma32(bf16x8 a, bf16x8 b, f32x16 c) { return __builtin_amdgcn_mfma_f32_32x32x16_bf16(a, b, c, 0, 0, 0); }


#define XB_TMO      128
#define XB_XCNT(j)  (256  + 64 * (j))
#define XB_XSUB(j)  (1280 + 64 * (j))
#define XB_XGEN(j)  (2304 + 64 * (j))
#define XB_TOP      3328
#define XB_TOPGEN   3392
#define XCD_BAR_WORDS 3456
#define XB_SPIN_CAP (1u << 23)
#define LAS __attribute__((address_space(3)))

__device__ __forceinline__ unsigned xb_ld(unsigned* p)              { return __hip_atomic_load(p, __ATOMIC_RELAXED, __HIP_MEMORY_SCOPE_AGENT); }
__device__ __forceinline__ unsigned xb_add(unsigned* p, unsigned v) { return __hip_atomic_fetch_add(p, v, __ATOMIC_RELAXED, __HIP_MEMORY_SCOPE_AGENT); }
__device__ __forceinline__ unsigned xb_xcc_id() { return (unsigned)__builtin_amdgcn_s_getreg((3 << 11) | 20) & 0xFu; }
#define XB_SPIN(cond, bar) do { unsigned _sp = 0; while (cond) { __builtin_amdgcn_s_sleep(1); \
    if ((++_sp & 255u) == 0u) { if (xb_ld(&(bar)[XB_TMO])) break; if (_sp > XB_SPIN_CAP) { atomicAdd(&(bar)[XB_TMO], 1u); break; } } } } while (0)

struct XcdBarrier {
    unsigned* bar; unsigned x;
    volatile LAS unsigned* st;
};
__device__ __forceinline__ XcdBarrier xcd_barrier_post(unsigned* bar, volatile LAS unsigned* st) {
    XcdBarrier b; b.bar = bar; b.x = xb_xcc_id(); b.st = st;
    if (threadIdx.x == 0) (void)xb_add(&bar[XB_XCNT(b.x)], 1u);
    return b;
}
__device__ __forceinline__ void xcd_barrier_complete(unsigned* bar, unsigned x, unsigned& nloc, unsigned& nx) {
    const unsigned G = gridDim.x * gridDim.y * gridDim.z;
    unsigned sum, cnt, mine, sp = 0u;
    for (;;) {
        sum = 0u; cnt = 0u; mine = 0u;
#pragma unroll
        for (unsigned j = 0; j < 16; ++j) { const unsigned c = xb_ld(&bar[XB_XCNT(j)]); sum += c; cnt += (c > 0u) ? 1u : 0u; mine = (j == x) ? c : mine; }
        if (sum == G) break;
        __builtin_amdgcn_s_sleep(1);
        if ((++sp & 255u) == 0u) { if (xb_ld(&bar[XB_TMO])) break; if (sp > XB_SPIN_CAP) { atomicAdd(&bar[XB_TMO], 1u); break; } }
    }
    nloc = mine > 0u ? mine : 1u; nx = cnt > 0u ? cnt : 1u;
}
__device__ __forceinline__ void xcd_barrier(const XcdBarrier& b) {
    asm volatile("s_waitcnt vmcnt(0)" ::: "memory");
    __syncthreads();
    if (threadIdx.x == 0) {
        unsigned* bar = b.bar;
        __builtin_amdgcn_s_waitcnt(0);
        unsigned nloc = b.st[0], nx = b.st[1];
        if (nloc == 0u) { xcd_barrier_complete(bar, b.x, nloc, nx); b.st[0] = nloc; b.st[1] = nx; }
        const unsigned old = xb_add(&bar[XB_XSUB(b.x)], 1u);
        const unsigned gen = old / nloc;
        if (old + 1u == (gen + 1u) * nloc) {
            __builtin_amdgcn_fence(__ATOMIC_RELEASE, "agent");
            asm volatile("s_waitcnt vmcnt(0)" ::: "memory");
            const unsigned og = xb_add(&bar[XB_TOP], 1u);
            const unsigned tg = og / nx;
            if (og + 1u == (tg + 1u) * nx) xb_add(&bar[XB_TOPGEN], 1u);
            else XB_SPIN(xb_ld(&bar[XB_TOPGEN]) == tg, bar);
            __builtin_amdgcn_fence(__ATOMIC_ACQUIRE, "agent");
            xb_add(&bar[XB_XGEN(b.x)], 1u);
            asm volatile("s_waitcnt vmcnt(0)" ::: "memory");
        } else {
            XB_SPIN(xb_ld(&bar[XB_XGEN(b.x)]) == gen, bar);
            __builtin_amdgcn_fence(__ATOMIC_ACQUIRE, "agent");
            asm volatile("s_waitcnt vmcnt(0)" ::: "memory");
        }
    }
    __syncthreads();
}

template <class Tp> DEV Tp* opq(Tp* q) { asm volatile("" : "+s"(q)); return q; }
DEV int tid_() { int t = threadIdx.x; asm volatile("" : "+v"(t)); return t; }
DEV int bid_() { int b = blockIdx.x; asm volatile("" : "+s"(b)); return b; }

DEV void glds16(const void* gsrc, char* lds_lane_ptr) {
  __builtin_amdgcn_global_load_lds((const unsigned*)gsrc, (__attribute__((address_space(3))) unsigned*)lds_lane_ptr, 16, 0, 0);
}
template <class Epi>
DEV void gemm_tile(const bf16_t* __restrict__ A, int lda, const bf16_t* __restrict__ Bt, int ldb, int K, char* smem, Epi& epi) {
  const int tid = tid_(), lane = tid & 63, wid = tid >> 6, wr = wid >> 1, wc = wid & 1, fr = lane & 15, fq = lane >> 4;
  f32x4 acc[4][4];
#pragma unroll
  for (int m = 0; m < 4; ++m)
#pragma unroll
    for (int n = 0; n < 4; ++n) acc[m][n] = (f32x4){0.f, 0.f, 0.f, 0.f};
  const int drow0 = 8 * wid + (lane >> 3), dpc = lane & 7;
  auto issue = [&](int kt, int buf) {
    char* sa = smem + buf * 32768;
    char* sb = sa + 16384;
#pragma unroll
    for (int i = 0; i < 4; ++i) {
      const int row = drow0 + 32 * i;
      const int kc = dpc ^ ((row >> 1) & 7);
      glds16(A + (size_t)row * lda + kt * 64 + kc * 8, sa + (i * 4 + wid) * 1024 + lane * 16);
      glds16(Bt + (size_t)row * ldb + kt * 64 + kc * 8, sb + (i * 4 + wid) * 1024 + lane * 16);
    }
  };
  __syncthreads();
  issue(0, 0);
  const int nk = K >> 6;
  const int sw = (fr >> 1) & 7;
  const int aoff = (wr * 64 + fr) * 128, boff = (wc * 64 + fr) * 128;
  for (int kt = 0; kt < nk; ++kt) {
    asm volatile("s_waitcnt vmcnt(0)" ::: "memory");
    __syncthreads();
    if (kt + 1 < nk) issue(kt + 1, (kt + 1) & 1);
    const char* sa = smem + (kt & 1) * 32768;
    const char* sb = sa + 16384;
    bf16x8 af[2][4], bfr[2][4];
#pragma unroll
    for (int kh = 0; kh < 2; ++kh) {
      const int pc = ((kh * 4 + fq) ^ sw) * 16;
#pragma unroll
      for (int m = 0; m < 4; ++m) af[kh][m] = *(const bf16x8*)(sa + aoff + m * 2048 + pc);
#pragma unroll
      for (int n = 0; n < 4; ++n) bfr[kh][n] = *(const bf16x8*)(sb + boff + n * 2048 + pc);
    }
    __builtin_amdgcn_sched_barrier(0);
    asm volatile("s_waitcnt lgkmcnt(8)" ::: "memory");
    __builtin_amdgcn_sched_barrier(0);
#pragma unroll
    for (int m = 0; m < 4; ++m)
#pragma unroll
      for (int n = 0; n < 4; ++n) acc[m][n] = mfma16(af[0][m], bfr[0][n], acc[m][n]);
    __builtin_amdgcn_sched_barrier(0);
    asm volatile("s_waitcnt lgkmcnt(0)" ::: "memory");
    __builtin_amdgcn_sched_barrier(0);
#pragma unroll
    for (int m = 0; m < 4; ++m)
#pragma unroll
      for (int n = 0; n < 4; ++n) acc[m][n] = mfma16(af[1][m], bfr[1][n], acc[m][n]);
  }
  __syncthreads();
  epi(acc, wr, wc, fr, fq, smem);
}
DEV void stage_tile_bf16(const f32x4 (&acc)[4][4], char* smem, int wid, int fr, int fq) {
  bf16_t (*t)[72] = (bf16_t (*)[72])(smem + wid * 9216);
#pragma unroll
  for (int m = 0; m < 4; ++m)
#pragma unroll
    for (int n = 0; n < 4; ++n)
#pragma unroll
      for (int j = 0; j < 4; ++j) t[m * 16 + fq * 4 + j][n * 16 + fr] = f2bf(acc[m][n][j]);
  asm volatile("s_waitcnt lgkmcnt(0)" ::: "memory");
}

DEV void ph_copy(const P& p) {
  const size_t n8 = (size_t)NTOK * D / 8;
  const float* pctx = opq(p.ctx); const float* px = opq(p.x);
  for (size_t i = (size_t)bid_() * 256 + tid_(); i < n8; i += (size_t)gridDim.x * 256) {
    size_t e = i * 8;
    int row = (int)(e / D), col = (int)(e % D);
    int b = row / LT, pp = row % LT;
    const float* src = pp < LC ? pctx + ((size_t)(b * LC + pp)) * D + col : px + ((size_t)(b * T + pp - LC)) * D + col;
    float4 v0 = *(const float4*)src, v1 = *(const float4*)(src + 4);
    uint4 o = make_uint4(pack2(v0.x, v0.y), pack2(v0.z, v0.w), pack2(v1.x, v1.y), pack2(v1.z, v1.w));
    *(uint4*)(p.X + e) = o;
  }
}

DEV void ph_rope(const P& p) {
  for (int i = bid_() * 256 + tid_(); i < 64 * 16; i += gridDim.x * 256) {
    int pos = i >> 4, k = i & 15;
    float inv = powf(10000.f, -(float)k / 16.f);
    float ang = (float)pos * inv;
    p.rope[2 * i] = cosf(ang); p.rope[2 * i + 1] = sinf(ang);
  }
}

DEV void modv_unit(const P& p, int unit, char* smem) {
  const int cc = unit % 24, layer = unit / 24;
  float (*cs)[128] = (float (*)[128])smem;
  const int col = cc * 256 + tid_();
  const float* pc = opq(p.c); const float* pcc = opq(p.c_ctx);
  float acc[17];
#pragma unroll
  for (int r = 0; r < 17; ++r) acc[r] = 0.f;
  for (int ks = 0; ks < 8; ++ks) {
    __syncthreads();
    for (int i = tid_(); i < 17 * 128; i += 256) {
      int r = i >> 7, e = i & 127;
      float v = r < 16 ? pc[r * D + ks * 128 + e] : pcc[ks * 128 + e];
      cs[r][e] = v / (1.f + expf(-v));
    }
    __syncthreads();
    const float* w = p.mod_w + ((size_t)layer * D + ks * 128) * 6144 + col;
#pragma unroll 4
    for (int e = 0; e < 128; ++e) {
      float wv = w[(size_t)e * 6144];
#pragma unroll
      for (int r = 0; r < 17; ++r) acc[r] += cs[r][e] * wv;
    }
  }
  const float bias = p.mod_b[layer * 6144 + col];
#pragma unroll
  for (int r = 0; r < 17; ++r) p.modv[((size_t)layer * 17 + r) * 6144 + col] = acc[r] + bias;
}

DEV void transpose_unit(const float* __restrict__ src, bf16_t* __restrict__ dst, int R, int C, int tile, char* smem) {
  float (*t)[65] = (float (*)[65])smem;
  const int nct = C / 64;
  const int tr = tile / nct, tc = tile % nct;
  __syncthreads();
  for (int i = tid_(); i < 4096; i += 256) { int r = i >> 6, c = i & 63; t[r][c] = src[(size_t)(tr * 64 + r) * C + tc * 64 + c]; }
  __syncthreads();
  for (int i = tid_(); i < 4096; i += 256) { int c = i >> 6, r = i & 63; dst[(size_t)(tc * 64 + c) * R + tr * 64 + r] = f2bf(t[r][c]); }
}

DEV void wfold_unit(const P& p, int layer, int unit, char* smem) {
  const int hs = unit >> 5, ec = unit & 31, h = hs >> 1, s = hs & 1;
  const float* wq = p.peer_wq + (size_t)layer * D * 2048;
  const float* kk = (s ? opq(p.peer_k2) : opq(p.peer_k1)) + ((size_t)layer * 8 + h) * 128 * 128;
  float (*kS)[65] = (float (*)[65])smem;
  float (*wS)[64] = (float (*)[64])(smem + 33280);
  const int key = tid_() & 127, eh = tid_() >> 7;
  float acc[16];
#pragma unroll
  for (int i = 0; i < 16; ++i) acc[i] = 0.f;
  for (int dh = 0; dh < 2; ++dh) {
    __syncthreads();
    for (int i = tid_(); i < 128 * 64; i += 256) { int k2 = i >> 6, d = i & 63; kS[k2][d] = kk[k2 * 128 + dh * 64 + d]; }
    for (int i = tid_(); i < 32 * 64; i += 256) {
      int e = i >> 6, d = i & 63;
      wS[e][d] = wq[(size_t)(ec * 32 + e) * 2048 + h * 256 + s * 128 + dh * 64 + d];
    }
    __syncthreads();
#pragma unroll 2
    for (int d = 0; d < 64; ++d) {
      float kv = kS[key][d];
#pragma unroll
      for (int i = 0; i < 16; ++i) acc[i] += kv * wS[eh * 16 + i][d];
    }
  }
  bf16_t* dst = p.Wft + ((size_t)(hs * 128 + key)) * D + ec * 32 + eh * 16;
#pragma unroll
  for (int i = 0; i < 16; i += 2) *(unsigned*)(dst + i) = pack2(acc[i], acc[i + 1]);
}

DEV void filt_unit(const P& p, int layer, int unit, char* smem) {
  int kind, j0, L;
  if (unit < 1024) { kind = 0; j0 = unit * 4; L = T; } else { kind = 1; j0 = (unit - 1024) * 4; L = LC; }
  float* zs = (float*)smem;
  float* h1 = zs + 4 * 36;
  float* h2 = h1 + 256;
  const int jj = tid_() >> 6, o = tid_() & 63;
  const int j = j0 + jj;
  const float fj = (float)j;
  const float t = fj / (float)(L - 1);
  __syncthreads();
  if (o < 33) {
    float z;
    if (o == 0) z = t;
    else {
      int i = (o - 1) & 15;
      float band = 1e-4f + (float)i * ((15.0f - 1e-4f) / 15.0f);
      float ang = 6.283185307179586f * fj * band / (float)L;
      z = (o <= 16) ? cosf(ang) : -sinf(ang);
    }
    zs[jj * 36 + o] = z;
  }
  __syncthreads();
  {
    const float* w1 = p.hy_w1 + layer * 33 * 64;
    float a = p.hy_b1[layer * 64 + o];
#pragma unroll 3
    for (int i = 0; i < 33; ++i) a += zs[jj * 36 + i] * w1[i * 64 + o];
    h1[jj * 64 + o] = sinf(p.hy_freq[layer * 128 + o] * a);
  }
  __syncthreads();
  {
    const float* w2 = p.hy_w2 + layer * 64 * 64;
    float a = p.hy_b2[layer * 64 + o];
#pragma unroll 4
    for (int i = 0; i < 64; ++i) a += h1[jj * 64 + i] * w2[i * 64 + o];
    h2[jj * 64 + o] = sinf(p.hy_freq[layer * 128 + 64 + o] * a);
  }
  __syncthreads();
  const float* w3 = p.hy_w3 + layer * 64 * 512;
  float* F = kind ? opq(p.FC) : opq(p.FL);
  const float DMIN = -3.0701134573253945f, DMAX = -15.350567286626973f;
#pragma unroll 1
  for (int m = 0; m < 4; ++m) {
    int c = o + 64 * m;
    float af = p.hy_b3[layer * 512 + c], ab = p.hy_b3[layer * 512 + 256 + c];
#pragma unroll 4
    for (int i = 0; i < 64; ++i) { float hv = h2[jj * 64 + i]; af += hv * w3[i * 512 + c]; ab += hv * w3[i * 512 + 256 + c]; }
    float delta = fabsf(DMIN + (float)c * ((DMAX - DMIN) / 255.f));
    float win = expf(-t * delta) + 0.05f;
    af *= win; ab *= win;
    F[((size_t)c * 2 + 0) * L + j] = af;
    F[((size_t)c * 2 + 1) * L + j] = ab;
  }
}

constexpr int PREP_T0 = 672, PREP_T1 = PREP_T0 + 256, PREP_T2 = PREP_T1 + 8, PREP_T3 = PREP_T2 + 8, PREP_T4 = PREP_T3 + 8;
constexpr int PREP_WF = PREP_T4 + 512, PREP_N = PREP_WF + 1088;
DEV void prep_unit(const P& p, int layer, int u, char* smem) {
  if (u < PREP_T0) transpose_unit(p.w_in + (size_t)layer * D * INW, p.W1t, D, INW, u, smem);
  else if (u < PREP_T1) transpose_unit(p.w_out + (size_t)layer * D * D, p.W2t, D, D, u - PREP_T0, smem);
  else if (u < PREP_T3) {
    const int u0 = u - PREP_T1;
    for (int i = tid_(); i < 64 * 256; i += 256) {
      const int np = u0 * 64 + (i >> 8), kp = i & 255;
      const int ps = np & 3, chan = np >> 2, qp = kp >> 6, kk = kp & 63;
      const int is_a = ps & 1, d = ps >> 1;
      float v = 0.f;
      if (qp == (is_a ? 2 + d : d)) v = (is_a ? opq(p.rw_a_up) : opq(p.rw_w_up))[(((size_t)layer * 2 + d) * 64 + kk) * 256 + chan];
      p.Wlt[(size_t)np * 256 + kp] = f2bf(v);
    }
  }
  else if (u < PREP_T4) transpose_unit(p.rw_g_up + (size_t)layer * 128 * 256, p.Wgt, 128, 256, u - PREP_T3, smem);
  else if (u < PREP_WF) wfold_unit(p, layer, u - PREP_T4, smem);
  else filt_unit(p, layer, u - PREP_WF, smem);
}
constexpr int PREPA_N = PREP_T0 + (PREP_T4 - PREP_T1);
DEV int prepA_unit_index(int i) { return i < PREP_T0 ? i : PREP_T1 + (i - PREP_T0); }
DEV void ph_prep(const P& p, int layer, char* smem, bool onlyB) {
  for (int u = bid_(); u < PREP_N; u += gridDim.x) {
    const bool isA = (u < PREP_T0) || (u >= PREP_T1 && u < PREP_T4);
    if (onlyB && isA) continue;
    prep_unit(p, layer, u, smem);
  }
}

DEV void wave_range(int& r0, int& r1, int ntok) {
  const int gw = (bid_() * 256 + tid_()) >> 6, nw = gridDim.x * 4;
  const int per = (ntok + nw - 1) / nw;
  r0 = gw * per; r1 = r0 + per; if (r1 > ntok) r1 = ntok;
}
DEV void ph_norm(const P& p, int layer, int which) {
  const int lane = tid_() & 63;
  int r0, r1;
  wave_range(r0, r1, NTOK);
  const float* g = (which ? p.norm2_g : p.norm1_g) + layer * D;
  float gv[16], scv[16], shv[16];
#pragma unroll
  for (int hh = 0; hh < 2; ++hh)
#pragma unroll
    for (int i = 0; i < 8; ++i) gv[hh * 8 + i] = g[hh * 512 + 8 * lane + i];
  int mr_cur = -1;
  uint4 n0 = make_uint4(0, 0, 0, 0), n1 = n0;
  if (r0 < r1) { const bf16_t* xr = p.X + (size_t)r0 * D; n0 = *(const uint4*)(xr + 8 * lane); n1 = *(const uint4*)(xr + 512 + 8 * lane); }
#pragma unroll 1
  for (int row = r0; row < r1; ++row) {
    const uint4 u0 = n0, u1 = n1;
    if (row + 1 < r1) { const bf16_t* xr = p.X + (size_t)(row + 1) * D; n0 = *(const uint4*)(xr + 8 * lane); n1 = *(const uint4*)(xr + 512 + 8 * lane); }
    const int b = row / LT, pp = row % LT;
    const int mr = pp < LC ? 16 : b;
    if (mr != mr_cur) {
      mr_cur = mr;
      const float* mv = p.modv + ((size_t)layer * 17 + mr) * 6144 + (which ? 3072 : 0);
#pragma unroll
      for (int hh = 0; hh < 2; ++hh)
#pragma unroll
        for (int i = 0; i < 8; ++i) { shv[hh * 8 + i] = mv[hh * 512 + 8 * lane + i]; scv[hh * 8 + i] = 1.f + mv[1024 + hh * 512 + 8 * lane + i]; }
    }
    float v[16];
    unpack8(u0, v); unpack8(u1, v + 8);
    float ss = 0.f;
#pragma unroll
    for (int i = 0; i < 16; ++i) ss += v[i] * v[i];
    ss = wave_sum(ss);
    const float rstd = rsqrtf(ss * (1.f / 1024.f) + 1e-6f);
    float o[16];
#pragma unroll
    for (int i = 0; i < 16; ++i) o[i] = (v[i] * rstd * gv[i]) * scv[i] + shv[i];
    bf16_t* hr = p.H + (size_t)row * D;
    *(uint4*)(hr + 8 * lane) = pack8(o);
    *(uint4*)(hr + 512 + 8 * lane) = pack8(o + 8);
    if (which) {
      float am = 0.f;
#pragma unroll
      for (int i = 0; i < 16; ++i) am = fmaxf(am, fabsf(o[i]));
      am = wave_max(am);
      const float sc = am > 0.f ? 127.f / am : 1.f;
      unsigned char* h8 = p.H8 + (size_t)row * 1024;
      *(uint2*)(h8 + 8 * lane) = make_uint2((unsigned)pack_i8(o[0] * sc, o[1] * sc, o[2] * sc, o[3] * sc), (unsigned)pack_i8(o[4] * sc, o[5] * sc, o[6] * sc, o[7] * sc));
      *(uint2*)(h8 + 512 + 8 * lane) = make_uint2((unsigned)pack_i8(o[8] * sc, o[9] * sc, o[10] * sc, o[11] * sc), (unsigned)pack_i8(o[12] * sc, o[13] * sc, o[14] * sc, o[15] * sc));
      if (lane == 0) p.HINV[row] = am > 0.f ? am * (1.f / 127.f) : 1.f;
    }
  }
}

DEV bool gemm_unit(int it, int nct, int& rt, int& ct) {
  const int nslot = gridDim.x >> 3;
  const int x = bid_() & 7, sl = bid_() >> 3;
  if (sl >= nslot) return false;
  const int v = it * nslot + sl;
  if (v >= 68 * nct) return false;
  const int rg = v / (8 * nct), rem = v - rg * 8 * nct;
  const int rows = (rg == 8) ? 4 : 8;
  ct = rem / rows;
  rt = x * 68 + rg * 8 + (rem - ct * rows);
  return true;
}
struct Epi1 {
  const P& p; int row0, col0;
  DEV void operator()(f32x4 (&acc)[4][4], int wr, int wc, int fr, int fq, char* smem) const {
    const int cw = col0 + wc * 64;
    const int rbase = row0 + wr * 64;
    const bool lat = (row0 % LT) >= LC;
    if (cw >= 1536 && cw < 1664) {
#pragma unroll
      for (int m = 0; m < 4; ++m)
#pragma unroll
        for (int n = 0; n < 4; ++n)
#pragma unroll
          for (int j = 0; j < 4; ++j) acc[m][n][j] = 2.f * sigmoidf_(2.f * acc[m][n][j]) - 1.f;
    } else if (cw >= 1792 && cw < 1920) {
#pragma unroll
      for (int m = 0; m < 4; ++m)
#pragma unroll
        for (int n = 0; n < 4; ++n)
#pragma unroll
          for (int j = 0; j < 4; ++j) acc[m][n][j] = sigmoidf_(acc[m][n][j]);
    } else if (cw >= 1920 && cw < 2560 && lat) {
#pragma unroll
      for (int m = 0; m < 4; ++m)
#pragma unroll
        for (int j = 0; j < 4; ++j) {
          int row = rbase + m * 16 + fq * 4 + j;
          int pl = (row % LT) - LC;
          int ri = pl >> 6, ci = pl & 63;
          float2 cr = *(const float2*)(p.rope + 2 * (ri * 16 + fr));
          float2 cc = *(const float2*)(p.rope + 2 * (ci * 16 + fr));
          float x1 = acc[m][0][j], x2 = acc[m][1][j];
          acc[m][0][j] = x1 * cr.x - x2 * cr.y; acc[m][1][j] = x2 * cr.x + x1 * cr.y;
          x1 = acc[m][2][j]; x2 = acc[m][3][j];
          acc[m][2][j] = x1 * cc.x - x2 * cc.y; acc[m][3][j] = x2 * cc.x + x1 * cc.y;
        }
    }
    const int wid = wr * 2 + wc, lane = fq * 16 + fr;
    stage_tile_bf16(acc, smem, wid, fr, fq);
    const bf16_t (*t)[72] = (const bf16_t (*)[72])(smem + wid * 9216);
#pragma unroll
    for (int i = 0; i < 8; ++i) {
      const int rl = i * 8 + (lane >> 3), ch = lane & 7;
      *(uint4*)(p.Z + (size_t)(rbase + rl) * INW + cw + ch * 8) = *(const uint4*)&t[rl][ch * 8];
    }
  }
};
DEV void ph_gemm1(const P& p, char* smem) {
  const int nct = INW / 128;
  int rt, ct;
  for (int it = 0; gemm_unit(it, nct, rt, ct); ++it) {
    Epi1 epi{p, rt * 128, ct * 128};
    gemm_tile(p.H + (size_t)rt * 128 * D, D, p.W1t + (size_t)ct * 128 * D, D, D, smem, epi);
  }
}

struct EpiLoraA {
  const P& p; int layer, row0, col0;
  DEV void operator()(f32x4 (&acc)[4][4], int wr, int wc, int fr, int fq, char* smem) const {
    const int ps = fr & 3, is_a = ps & 1, dd = ps >> 1;
    const float scale = is_a ? 1.f : 0.6065306597126334f;
    const float* bias0 = (is_a ? opq(p.rw_a0) : opq(p.rw_w0)) + (layer * 2 + dd) * 256;
#pragma unroll
    for (int n = 0; n < 4; ++n) {
      const int chan = (col0 + wc * 64 + n * 16 + fr) >> 2;
      const float bias = bias0[chan];
#pragma unroll
      for (int m = 0; m < 4; ++m)
#pragma unroll
        for (int j = 0; j < 4; ++j) acc[m][n][j] = scale * sigmoidf_(acc[m][n][j] + bias);
    }
    const int wid = wr * 2 + wc, lane = fq * 16 + fr;
    stage_tile_bf16(acc, smem, wid, fr, fq);
    const bf16_t (*t)[72] = (const bf16_t (*)[72])(smem + wid * 9216);
#pragma unroll
    for (int i = 0; i < 8; ++i) {
      const int rl = i * 8 + (lane >> 3), ch = lane & 7;
      *(uint4*)(p.SC + (size_t)(row0 + wr * 64 + rl) * 1024 + col0 + wc * 64 + ch * 8) = *(const uint4*)&t[rl][ch * 8];
    }
  }
};
struct EpiLoraG {
  const P& p; int row0, col0;
  DEV void operator()(f32x4 (&acc)[4][4], int wr, int wc, int fr, int fq, char* smem) const {
    const int wid = wr * 2 + wc, lane = fq * 16 + fr;
    stage_tile_bf16(acc, smem, wid, fr, fq);
    const bf16_t (*t)[72] = (const bf16_t (*)[72])(smem + wid * 9216);
#pragma unroll
    for (int i = 0; i < 8; ++i) {
      const int rl = i * 8 + (lane >> 3), ch = lane & 7;
      *(uint4*)(p.Y + (size_t)(row0 + wr * 64 + rl) * D + 256 + col0 + wc * 64 + ch * 8) = *(const uint4*)&t[rl][ch * 8];
    }
  }
};
DEV void ph_lora(const P& p, int layer, char* smem) {
  int rt, ct;
  for (int it = 0; gemm_unit(it, 10, rt, ct); ++it) {
    if (ct < 8) {
      EpiLoraA epi{p, layer, rt * 128, ct * 128};
      gemm_tile(p.Z + (size_t)rt * 128 * INW + 1536, INW, p.Wlt + (size_t)ct * 128 * 256, 256, 256, smem, epi);
    } else {
      EpiLoraG epi{p, rt * 128, (ct - 8) * 128};
      gemm_tile(p.Z + (size_t)rt * 128 * INW + 1792, INW, p.Wgt + (size_t)(ct - 8) * 128 * 128, 128, 128, smem, epi);
    }
  }
}

DEV void ph_rwkv_prep(const P& p, int layer) {
  const int lane = tid_() & 63;
  int r0, r1;
  wave_range(r0, r1, NTOK);
  const float* cw = p.conv_w + (size_t)layer * 3 * 1536;
  const float* cb = p.conv_b + (size_t)layer * 1536;
  float w0[3][4], w1[3][4], w2[3][4], bb[3][4], kkw[4];
#pragma unroll
  for (int a = 0; a < 3; ++a)
#pragma unroll
    for (int i = 0; i < 4; ++i) {
      const int col = 768 + a * 256 + 4 * lane + i;
      w0[a][i] = cw[col]; w1[a][i] = cw[1536 + col]; w2[a][i] = cw[3072 + col]; bb[a][i] = cb[col];
    }
#pragma unroll
  for (int i = 0; i < 4; ++i) kkw[i] = p.rw_k_k[layer * 256 + 4 * lane + i];
  uint2 zm[3], zc[3], zp[3];
  auto ldz = [&](int row, uint2 (&z)[3]) {
#pragma unroll
    for (int a = 0; a < 3; ++a) z[a] = *(const uint2*)(p.Z + (size_t)row * INW + 768 + a * 256 + 4 * lane);
  };
  auto zero3 = [&](uint2 (&z)[3]) {
#pragma unroll
    for (int a = 0; a < 3; ++a) z[a] = make_uint2(0u, 0u);
  };
  if (r0 < r1) {
    if (r0 > 0) ldz(r0 - 1, zm); else zero3(zm);
    ldz(r0, zc);
  }
#pragma unroll 1
  for (int row = r0; row < r1; ++row) {
    if (row + 1 < NTOK) ldz(row + 1, zp); else zero3(zp);
    const int pp = row % LT;
    const bool hasm = (pp != 0) && (pp != LC);
    const bool hasp = (pp != LC - 1) && (pp != LT - 1);
    float res[3][4];
#pragma unroll
    for (int a = 0; a < 3; ++a) {
      const uint2 um = hasm ? zm[a] : make_uint2(0u, 0u), uc = zc[a], up = hasp ? zp[a] : make_uint2(0u, 0u);
      const float vm[4] = {bflo(um.x), bfhi(um.x), bflo(um.y), bfhi(um.y)};
      const float vc[4] = {bflo(uc.x), bfhi(uc.x), bflo(uc.y), bfhi(uc.y)};
      const float vp[4] = {bflo(up.x), bfhi(up.x), bflo(up.y), bfhi(up.y)};
#pragma unroll
      for (int i = 0; i < 4; ++i) res[a][i] = w0[a][i] * vm[i] + w1[a][i] * vc[i] + w2[a][i] * vp[i] + bb[a][i];
    }
    float kk[4], ss = 0.f;
#pragma unroll
    for (int i = 0; i < 4; ++i) { kk[i] = res[1][i] * kkw[i]; ss += kk[i] * kk[i]; }
    ss = row16_sum(ss);
    const float rs = rsqrtf(ss + 1e-12f);
    bf16_t* hr = p.H + (size_t)row * D + 16 * lane;
    *(uint4*)hr = make_uint4(pack2(res[0][0], res[1][0]), pack2(kk[0] * rs, res[2][0]), pack2(res[0][1], res[1][1]), pack2(kk[1] * rs, res[2][1]));
    *(uint4*)(hr + 8) = make_uint4(pack2(res[0][2], res[1][2]), pack2(kk[2] * rs, res[2][2]), pack2(res[0][3], res[1][3]), pack2(kk[3] * rs, res[2][3]));
#pragma unroll
    for (int a = 0; a < 3; ++a) { zm[a] = zc[a]; zc[a] = zp[a]; }
  }
}

DEV float oct_sum(float x) { x += dpp0<0xB1, 0xF>(x); x += dpp0<0x4E, 0xF>(x); x += dpp0<0x141, 0xF>(x); return x; }
DEV bf16x8 frag_join(uint2 lo, uint2 hi) { uint4 w = make_uint4(lo.x, lo.y, hi.x, hi.y); return __builtin_bit_cast(bf16x8, w); }
constexpr int SCS_SET = 17152, SCS_IMG = 3 * SCS_SET, SCS_W0 = SCS_IMG + 2 * 3072;
DEV void scanc_unit(const P& p, int layer, int unit, char* smem) {
  const int dir = unit & 1, h = (unit >> 1) & 3, b = unit >> 3;
  const int tid = tid_(), lane = tid & 63, fr = lane & 15, fq = lane >> 4;
  const int w = __builtin_amdgcn_readfirstlane(tid >> 6);
  bf16_t* IMG0 = (bf16_t*)(smem + SCS_W0);
  bf16_t* IMG1 = IMG0 + 512;
  bf16_t* IMG2 = IMG0 + 1024;
  __syncthreads();
  for (int i = tid; i < (2 * 3072 + 3072) / 4; i += 256) ((unsigned*)(smem + SCS_IMG))[i] = 0u;
  const float ka = p.rw_k_a[layer * 256 + h * 64 + lane];
  const size_t rowbase = (size_t)b * LT;
  const char* hbase = (const char*)p.H;
  const char* sbase = (const char*)p.SC;
  const unsigned hoff = (unsigned)(rowbase * 2048) + (unsigned)((h * 64 + lane) * 8);
  const unsigned soff = hoff + 4u * (unsigned)dir;
  bf16_t* yb = p.Z + rowbase * INW + 768 + dir * 256 + h * 64 + w * 16 + fr;
  auto pos0 = [&](int c) -> int { const int t = c * 16; return dir == 0 ? t : (t < LC ? LC - 1 - t : LT - 1 - (t - LC)); };
  const int pstep = dir == 0 ? 1 : -1;
  constexpr int NCH = LT / 16;
  struct Raw { unsigned sc[16]; uint2 hr[6]; };
  auto load_raw = [&](int c, Raw& rw) {
    if (w != 0) {
      const int p0 = pos0(c);
      const unsigned so = soff + (unsigned)(p0 * 2048);
      const int st = pstep * 2048;
#pragma unroll
      for (int i = 0; i < 16; ++i) rw.sc[i] = *(const unsigned*)(sbase + (so + (unsigned)(i * st)));
      const unsigned ho = hoff + (unsigned)((p0 + pstep * (w - 1)) * 2048);
#pragma unroll
      for (int q = 0; q < 6; ++q) {
        const int qq = ((w - 1) + 3 * q < 16) ? q : 4;
        rw.hr[q] = *(const uint2*)(hbase + (ho + (unsigned)(qq * 3 * st)));
      }
    }
  };
  auto stage1w = [&](int set, const Raw& rw, auto W1tag) {
    constexpr int W1 = decltype(W1tag)::value;
    char* base = smem + set * SCS_SET;
    bf16_t (*At)[72] = (bf16_t (*)[72])(base);
    bf16_t (*Rt)[72] = (bf16_t (*)[72])(base + 2304);
    bf16_t (*Bt)[72] = (bf16_t (*)[72])(base + 4608);
    bf16_t (*Kt)[72] = (bf16_t (*)[72])(base + 6912);
    bf16_t (*BKT)[36] = (bf16_t (*)[36])(base + 9216);
    bf16_t* VV = (bf16_t*)(base + 13824);
    float* G16 = (float*)(base + 16896);
    float Erun = 0.f;
#pragma unroll
    for (int i = 0; i < 16; ++i) {
      const float ev = bflo(rw.sc[i]);
      const float Eprev = Erun;
      Erun += ev;
      if ((i % 3) == W1) {
        const uint2 hrec = rw.hr[i / 3];
        const float rr = bflo(hrec.x), kr = bfhi(hrec.x), kkv = bflo(hrec.y);
        const float av = bfhi(rw.sc[i]);
        const float gp = __expf(-Eprev), gi = __expf(-Erun), ig = __expf(Erun);
        const float at = -kkv * gp, rt = rr * gi, bt = kkv * av * ig, kt2 = kr * (1.f + (av - 1.f) * ka) * ig;
        const unsigned ar = pack2(at, rt), bk = pack2(bt, kt2);
        At[i][lane] = (bf16_t)(ar & 0xFFFFu); Rt[i][lane] = (bf16_t)(ar >> 16);
        Bt[i][lane] = (bf16_t)(bk & 0xFFFFu); Kt[i][lane] = (bf16_t)(bk >> 16);
        BKT[lane][(i >> 2) * 8 + (i & 3)] = (bf16_t)(bk & 0xFFFFu);
        BKT[lane][(i >> 2) * 8 + 4 + (i & 3)] = (bf16_t)(bk >> 16);
        VV[((i >> 2) * 64 + lane) * 6 + (i & 3)] = (bf16_t)(hrec.y >> 16);
        if (i == 15) G16[lane] = gi;
      }
    }
  };
  auto stage1 = [&](int set, const Raw& rw) {
    if (w == 1) stage1w(set, rw, std::integral_constant<int, 0>{});
    else if (w == 2) stage1w(set, rw, std::integral_constant<int, 1>{});
    else if (w == 3) stage1w(set, rw, std::integral_constant<int, 2>{});
  };
  auto stage2 = [&](int set, int iset) {
    char* base = smem + set * SCS_SET;
    const bf16_t (*At)[72] = (const bf16_t (*)[72])(base);
    const bf16_t (*Rt)[72] = (const bf16_t (*)[72])(base + 2304);
    const bf16_t (*Bt)[72] = (const bf16_t (*)[72])(base + 4608);
    const bf16_t (*Kt)[72] = (const bf16_t (*)[72])(base + 6912);
    bf16_t* TT = (bf16_t*)(smem + SCS_IMG + iset * 3072);
    bf16_t* ARK = TT + 512;
    bf16_t* AAK = TT + 1024;
    const bf16_t (*X)[72] = (w < 2) ? At : Rt;
    const bf16_t (*Y)[72] = (w & 1) ? Kt : Bt;
    f32x4 cm = (f32x4){0.f, 0.f, 0.f, 0.f};
#pragma unroll
    for (int s = 0; s < 2; ++s) {
      bf16x8 af = *(const bf16x8*)&X[fr][32 * s + 8 * fq];
      bf16x8 bm = *(const bf16x8*)&Y[fr][32 * s + 8 * fq];
      cm = mfma16(af, bm, cm);
    }
#pragma unroll
    for (int jj = 0; jj < 4; ++jj) {
      const int i = 4 * fq + jj;
      const bool keep = (w < 2) ? (fr < i) : (fr <= i);
      cm[jj] = keep ? cm[jj] : 0.f;
    }
    const int io = (fr >> 2) * 8 + (fr & 3);
    auto wr_img = [&](bf16_t* img, const f32x4& Xv, int hi) {
#pragma unroll
      for (int jj = 0; jj < 4; ++jj) img[(4 * fq + jj) * 32 + io + hi] = f2bf(Xv[jj]);
    };
    if (w == 1) wr_img(AAK, cm, 0);
    else if (w == 2) wr_img(ARK, cm, 0);
    else if (w == 3) wr_img(ARK, cm, 4);
    else {
      auto bfrag = [&](const f32x4& Xv) { return frag_join(make_uint2(pack2(Xv[0], Xv[1]), pack2(Xv[2], Xv[3])), make_uint2(0u, 0u)); };
      auto afr = [&](const bf16_t* img) { return *(const bf16x8*)&img[(fr * 4 + fq) * 8]; };
      const f32x4 Z4 = (f32x4){0.f, 0.f, 0.f, 0.f};
      wr_img(IMG0, cm, 0);
      asm volatile("" ::: "memory");
      f32x4 A2 = mfma16(afr(IMG0), bfrag(cm), Z4);
      wr_img(IMG1, A2, 0);
      asm volatile("" ::: "memory");
      f32x4 A4 = mfma16(afr(IMG1), bfrag(A2), Z4);
      wr_img(IMG2, A4, 0);
      asm volatile("" ::: "memory");
      f32x4 Rm = mfma16(afr(IMG2), bfrag(A4), Z4);
#pragma unroll
      for (int jj = 0; jj < 4; ++jj) Rm[jj] += (fr == 4 * fq + jj) ? 1.f : 0.f;
      Rm = mfma16(afr(IMG2), bfrag(Rm), Rm);
      Rm = mfma16(afr(IMG1), bfrag(Rm), Rm);
      Rm = mfma16(afr(IMG0), bfrag(Rm), Rm);
      wr_img(TT, Rm, 0);
    }
  };
  f32x4 acc[4];
#pragma unroll
  for (int kt = 0; kt < 4; ++kt) acc[kt] = (f32x4){0.f, 0.f, 0.f, 0.f};
  auto part2 = [&](int c, int set, int iset) {
    char* base = smem + set * SCS_SET;
    const bf16_t (*At)[72] = (const bf16_t (*)[72])(base);
    const bf16_t (*Rt)[72] = (const bf16_t (*)[72])(base + 2304);
    const bf16_t (*BKT)[36] = (const bf16_t (*)[36])(base + 9216);
    const bf16_t* VV = (const bf16_t*)(base + 13824);
    const float* G16 = (const float*)(base + 16896);
    const bf16_t* TT = (const bf16_t*)(smem + SCS_IMG + iset * 3072);
    const bf16_t* ARK = TT + 512;
    const bf16_t* AAK = TT + 1024;
    bf16x8 Sb[2];
#pragma unroll
    for (int s = 0; s < 2; ++s) {
      uint4 t = make_uint4(pack2(acc[2 * s][0], acc[2 * s][1]), pack2(acc[2 * s][2], acc[2 * s][3]),
                           pack2(acc[2 * s + 1][0], acc[2 * s + 1][1]), pack2(acc[2 * s + 1][2], acc[2 * s + 1][3]));
      Sb[s] = __builtin_bit_cast(bf16x8, t);
    }
    const unsigned* vvp = (const unsigned*)&VV[(fq * 64 + w * 16 + fr) * 6];
    const uint2 vv = make_uint2(vvp[0], vvp[1]);
    const bf16x8 Vlow = frag_join(vv, make_uint2(0u, 0u));
    f32x4 Pm = (f32x4){0.f, 0.f, 0.f, 0.f};
#pragma unroll
    for (int s = 0; s < 2; ++s) {
      bf16x8 af = frag_join(*(const uint2*)&At[fr][32 * s + 4 * fq], *(const uint2*)&At[fr][32 * s + 16 + 4 * fq]);
      Pm = mfma16(af, Sb[s], Pm);
    }
    Pm = mfma16(*(const bf16x8*)&AAK[(fr * 4 + fq) * 8], Vlow, Pm);
    const bf16x8 Pb = frag_join(make_uint2(pack2(Pm[0], Pm[1]), pack2(Pm[2], Pm[3])), make_uint2(0u, 0u));
    f32x4 U = mfma16(*(const bf16x8*)&TT[(fr * 4 + fq) * 8], Pb, (f32x4){0.f, 0.f, 0.f, 0.f});
    const bf16x8 UV = frag_join(make_uint2(pack2(U[0], U[1]), pack2(U[2], U[3])), vv);
    f32x4 Yv = (f32x4){0.f, 0.f, 0.f, 0.f};
#pragma unroll
    for (int s = 0; s < 2; ++s) {
      bf16x8 af = frag_join(*(const uint2*)&Rt[fr][32 * s + 4 * fq], *(const uint2*)&Rt[fr][32 * s + 16 + 4 * fq]);
      Yv = mfma16(af, Sb[s], Yv);
    }
    Yv = mfma16(*(const bf16x8*)&ARK[(fr * 4 + fq) * 8], UV, Yv);
    {
      const int p0 = pos0(c);
#pragma unroll
      for (int jj = 0; jj < 4; ++jj) yb[(size_t)(p0 + pstep * (4 * fq + jj)) * INW] = f2bf(Yv[jj]);
    }
#pragma unroll
    for (int kt = 0; kt < 4; ++kt) {
      f32x4 t = mfma16(frag_join(*(const uint2*)&BKT[16 * kt + fr][fq * 8], *(const uint2*)&BKT[16 * kt + fr][fq * 8 + 4]), UV, acc[kt]);
      const float4 g4 = *(const float4*)&G16[16 * kt + 4 * fq];
      t[0] *= g4.x; t[1] *= g4.y; t[2] *= g4.z; t[3] *= g4.w;
      acc[kt] = t;
    }
  };
  __builtin_amdgcn_s_setprio(3);
  Raw r0, r1;
  load_raw(0, r0); load_raw(1, r1);
  stage1(0, r0);
  load_raw(2, r0);
  __syncthreads();
  stage2(0, 0);
  stage1(1, r1);
  load_raw(3, r1);
  __syncthreads();
  int s0 = 0, s1 = 1, s2 = 2;
  auto iter = [&](int c, Raw& rw) {
    if (c + 1 < NCH) stage2(s1, (c + 1) & 1);
    part2(c, s0, c & 1);
    if (c + 2 < NCH) {
      stage1(s2, rw);
      if (c + 4 < NCH) load_raw(c + 4, rw);
    }
    asm volatile("s_waitcnt lgkmcnt(0)" ::: "memory");
    __builtin_amdgcn_s_barrier();
    asm volatile("" ::: "memory");
    const int t = s0; s0 = s1; s1 = s2; s2 = t;
  };
#pragma unroll 1
  for (int c = 0; c < NCH; c += 2) {
    iter(c, r0); iter(c + 1, r1);
  }
  __builtin_amdgcn_s_setprio(0);
}

DEV void ph_rwkv_post(const P& p, int layer) {
  const int lane = tid_() & 63;
  int r0, r1;
  wave_range(r0, r1, NTOK);
  const int ch = 4 * lane;
  float kav[4], rkv[4], lnw[4], lnb[4];
#pragma unroll
  for (int i = 0; i < 4; ++i) {
    kav[i] = p.rw_k_a[layer * 256 + ch + i]; rkv[i] = p.rw_r_k[layer * 256 + ch + i];
    lnw[i] = p.rw_ln_w[layer * 256 + ch + i]; lnb[i] = p.rw_ln_b[layer * 256 + ch + i];
  }
  struct In { uint2 y0, y1, g; uint4 h0, h1, s0, s1; };
  auto ld = [&](int row, In& in) {
    const bf16_t* zr = p.Z + (size_t)row * INW + 768 + ch;
    in.y0 = *(const uint2*)zr; in.y1 = *(const uint2*)(zr + 256);
    const bf16_t* hr = p.H + (size_t)row * D + 4 * ch;
    in.h0 = *(const uint4*)hr; in.h1 = *(const uint4*)(hr + 8);
    const bf16_t* sr = p.SC + (size_t)row * 1024 + 4 * ch;
    in.s0 = *(const uint4*)sr; in.s1 = *(const uint4*)(sr + 8);
    in.g = *(const uint2*)(p.Y + (size_t)row * D + 256 + ch);
  };
  In nx;
  if (r0 < r1) ld(r0, nx);
#pragma unroll 1
  for (int row = r0; row < r1; ++row) {
    const In in = nx;
    if (row + 1 < r1) ld(row + 1, nx);
    float y[4] = {bflo(in.y0.x) + bflo(in.y1.x), bfhi(in.y0.x) + bfhi(in.y1.x), bflo(in.y0.y) + bflo(in.y1.y), bfhi(in.y0.y) + bfhi(in.y1.y)};
    const float mu = row16_sum(y[0] + y[1] + y[2] + y[3]) * (1.f / 64.f);
    float vs = 0.f;
#pragma unroll
    for (int i = 0; i < 4; ++i) { y[i] -= mu; vs += y[i] * y[i]; }
    const float var = row16_sum(vs) * (1.f / 64.f);
    const float rstd = rsqrtf(var + 64e-5f);
    const float r[4] = {bflo(in.h0.x), bflo(in.h0.z), bflo(in.h1.x), bflo(in.h1.z)};
    const float k[4] = {bfhi(in.h0.x), bfhi(in.h0.z), bfhi(in.h1.x), bfhi(in.h1.z)};
    const float v[4] = {bfhi(in.h0.y), bfhi(in.h0.w), bfhi(in.h1.y), bfhi(in.h1.w)};
    const float a0[4] = {bfhi(in.s0.x), bfhi(in.s0.z), bfhi(in.s1.x), bfhi(in.s1.z)};
    const float a1[4] = {bfhi(in.s0.y), bfhi(in.s0.w), bfhi(in.s1.y), bfhi(in.s1.w)};
    float sd = 0.f;
#pragma unroll
    for (int i = 0; i < 4; ++i) {
      const float kd0 = k[i] * (1.f + (a0[i] - 1.f) * kav[i]), kd1 = k[i] * (1.f + (a1[i] - 1.f) * kav[i]);
      sd += r[i] * (kd0 + kd1) * rkv[i];
    }
    sd = row16_sum(sd);
    const float g[4] = {bflo(in.g.x), bfhi(in.g.x), bflo(in.g.y), bfhi(in.g.y)};
    float o[4];
#pragma unroll
    for (int i = 0; i < 4; ++i) {
      const float yn = y[i] * rstd * lnw[i] + lnb[i];
      o[i] = (yn + sd * v[i]) * g[i];
    }
    *(uint2*)(p.Y + (size_t)row * D + 256 + ch) = make_uint2(pack2(o[0], o[1]), pack2(o[2], o[3]));
  }
}

DEV void hyena_pre_unit(const P& p, int layer, int unit) {
  int kind, b, t0, L;
  if (unit < 1024) { kind = 0; b = unit >> 6; t0 = (unit & 63) * 64; L = T; } else { int u = unit - 1024; kind = 1; b = u >> 2; t0 = (u & 3) * 64; L = LC; }
  const int c = tid_();
  const size_t row0 = (size_t)b * LT + (kind ? 0 : LC);
  const float* cw = p.conv_w + (size_t)layer * 3 * 1536;
  const float* cb = p.conv_b + (size_t)layer * 1536;
  const float w1a = cw[256 + c], w1b = cw[1536 + 256 + c], w1c = cw[3072 + 256 + c], b1 = cb[256 + c];
  const float w2a = cw[512 + c], w2b = cw[1536 + 512 + c], w2c = cw[3072 + 512 + c], b2 = cb[512 + c];
  auto ld = [&](int t, int col) -> float { return (t >= 0 && t < L) ? bf2f(p.Z[(row0 + t) * INW + col]) : 0.f; };
  float x1m = ld(t0 - 1, 256 + c), x1c = ld(t0, 256 + c), vm = ld(t0 - 1, 512 + c), vc = ld(t0, 512 + c);
  bf16_t* dst = (kind ? opq(p.UTc) : opq(p.UTl)) + ((size_t)c * 16 + b) * L + t0;
#pragma unroll 1
  for (int i8 = 0; i8 < 8; ++i8) {
    float uo[8];
#pragma unroll
    for (int i = 0; i < 8; ++i) {
      int t = t0 + i8 * 8 + i;
      float x1n = ld(t + 1, 256 + c), vn = ld(t + 1, 512 + c);
      float a = w1a * x1m + w1b * x1c + w1c * x1n + b1;
      float bb = w2a * vm + w2b * vc + w2c * vn + b2;
      uo[i] = a * bb;
      x1m = x1c; x1c = x1n; vm = vc; vc = vn;
    }
    *(uint4*)(dst + 8 * i8) = pack8(uo);
  }
}

DEV void hyena_conv_unit(const P& p, int layer, int unit, char* smem) {
  int kind, c, tb, L;
  if (unit < 4096) { kind = 0; c = unit >> 4; tb = (unit & 15) * 256; L = T; } else { kind = 1; c = unit - 4096; tb = 0; L = LC; }
  const int tid = tid_(), lane = tid & 63, wid = tid >> 6, fr = lane & 15, fq = lane >> 4;
  float* red = (float*)(smem + 2 * 16512);
  const float* F = (kind ? opq(p.FC) : opq(p.FL)) + (size_t)c * 2 * L;
  float scale;
  {
    float part = 0.f;
    for (int i = tid; i < 2 * L; i += 256) { float fv = F[i]; part += (i != L) ? fv * fv : 0.f; }
    part = wave_sum(part);
    __syncthreads();
    if (lane == 0) red[wid] = part;
    __syncthreads();
    scale = rsqrtf(((red[0] + red[1]) + (red[2] + red[3])) + 1e-6f);
  }
  const bf16_t* U = (kind ? opq(p.UTc) : opq(p.UTl)) + (size_t)c * 16 * L;
  f32x4 acc[4];
#pragma unroll
  for (int m = 0; m < 4; ++m) acc[m] = (f32x4){0.f, 0.f, 0.f, 0.f};
  const int nch = L / 256;
  float fw0, fw1, fw2;
  uint4 ru0, ru1;
  auto ldchunk = [&](int ch) {
    const int sc = ch * 256;
    const int D0 = tb + 256 - sc;
    auto tap = [&](int n) -> float {
      int d = D0 - n;
      float v = 0.f;
      if (d > -L && d < L) v = (d >= 0 ? F[d] : F[L - d]);
      return v;
    };
    fw0 = tap(tid); fw1 = tap(tid + 256); fw2 = (tid < 8) ? tap(tid + 512) : 0.f;
    const int bb = tid >> 4, sg0 = tid & 15;
    ru0 = *(const uint4*)(U + (size_t)bb * L + sc + 8 * sg0);
    ru1 = *(const uint4*)(U + (size_t)bb * L + sc + 8 * (sg0 + 16));
  };
  auto stchunk = [&](int buf) {
    bf16_t* Cq = (bf16_t*)(smem + buf * 16512);
    bf16_t* Us = (bf16_t*)(smem + buf * 16512 + 8320);
    const bf16_t h0 = f2bf(fw0 * scale), h1 = f2bf(fw1 * scale), h2 = f2bf(fw2 * scale);
#pragma unroll
    for (int rho = 0; rho < 8; ++rho) {
      int m = tid + rho;
      Cq[((m >> 3) * 8 + rho) * 8 + (m & 7)] = h0;
      m = tid + 256 + rho;
      if (m < 520) Cq[((m >> 3) * 8 + rho) * 8 + (m & 7)] = h1;
      m = tid + 512 + rho;
      if (tid < 8 && m < 520) Cq[((m >> 3) * 8 + rho) * 8 + (m & 7)] = h2;
    }
    if (tid < 8) {
#pragma unroll
      for (int rho = 1; rho < 8; ++rho) if (tid < rho) Cq[(rho) * 8 + tid] = 0;
    }
    const int bb = tid >> 4, sg0 = tid & 15;
    *(uint4*)&Us[(sg0 * 16 + bb) * 8] = ru0;
    *(uint4*)&Us[((sg0 + 16) * 16 + bb) * 8] = ru1;
  };
  ldchunk(0);
#pragma unroll 1
  for (int ch = 0; ch < nch; ++ch) {
    const int buf = ch & 1;
    stchunk(buf);
    __syncthreads();
    if (ch + 1 < nch) ldchunk(ch + 1);
    const bf16_t* Cq = (const bf16_t*)(smem + buf * 16512);
    const bf16_t* Us = (const bf16_t*)(smem + buf * 16512 + 8320);
#pragma unroll
    for (int kk = 0; kk < 8; ++kk) {
      bf16x8 bf = *(const bf16x8*)&Us[((4 * kk + fq) * 16 + fr) * 8];
#pragma unroll
      for (int m = 0; m < 4; ++m) {
        int it = wid * 4 + m;
        int base = 256 - 16 * it + 32 * kk + 8 * fq;
        int m0 = base - 8 * (fr >> 3);
        bf16x8 af = *(const bf16x8*)&Cq[((m0 >> 3) * 8 + (fr & 7)) * 8];
        acc[m] = mfma16(af, bf, acc[m]);
      }
    }
  }
  __syncthreads();
  bf16_t* Yt = (kind ? opq(p.YTc) : opq(p.YTl)) + ((size_t)c * 16 + fr) * L + tb;
#pragma unroll
  for (int m = 0; m < 4; ++m) {
    int t = (wid * 4 + m) * 16 + fq * 4;
    *(uint2*)(Yt + t) = make_uint2(pack2(acc[m][0], acc[m][1]), pack2(acc[m][2], acc[m][3]));
  }
}

DEV void hyena_post_unit(const P& p, int layer, int unit, char* smem) {
  int kind, b, t0, L;
  if (unit < 1024) { kind = 0; b = unit >> 6; t0 = (unit & 63) * 64; L = T; } else { int u = unit - 1024; kind = 1; b = u >> 2; t0 = (u & 3) * 64; L = LC; }
  const int c = tid_(), lane = c & 63, wid = c >> 6;
  const size_t row0 = (size_t)b * LT + (kind ? 0 : LC);
  bf16_t (*tile)[264] = (bf16_t (*)[264])smem;
  const float* cw = p.conv_w + (size_t)layer * 3 * 1536;
  const float wa = cw[c], wb = cw[1536 + c], wcc = cw[3072 + c], b0 = p.conv_b[layer * 1536 + c];
  const float bias = p.hy_bias[layer * 256 + c];
  const bf16_t* yt = (kind ? opq(p.YTc) : opq(p.YTl)) + ((size_t)c * 16 + b) * L + t0;
  const bf16_t* ut = (kind ? opq(p.UTc) : opq(p.UTl)) + ((size_t)c * 16 + b) * L + t0;
  auto ld = [&](int t) -> float { return (t >= 0 && t < L) ? bf2f(p.Z[(row0 + t) * INW + c]) : 0.f; };
  float xm = ld(t0 - 1), xc = ld(t0);
  __syncthreads();
#pragma unroll 1
  for (int i8 = 0; i8 < 8; ++i8) {
    uint4 yu = *(const uint4*)(yt + 8 * i8), uu = *(const uint4*)(ut + 8 * i8);
    float yv[8], uv[8];
    unpack8(yu, yv); unpack8(uu, uv);
#pragma unroll
    for (int i = 0; i < 8; ++i) {
      int t = t0 + i8 * 8 + i;
      float xn = ld(t + 1);
      float x0 = wa * xm + wb * xc + wcc * xn + b0;
      float o = x0 * (yv[i] + uv[i] * bias);
      tile[i8 * 8 + i][c] = f2bf(o);
      xm = xc; xc = xn;
    }
  }
  __syncthreads();
  for (int i = 0; i < 16; ++i) {
    int tl = wid * 16 + i;
    uint2 ou = *(const uint2*)&tile[tl][4 * lane];
    float o[4] = {bflo(ou.x), bfhi(ou.x), bflo(ou.y), bfhi(ou.y)};
    float ss = wave_sum(o[0] * o[0] + o[1] * o[1] + o[2] * o[2] + o[3] * o[3]);
    float rstd = rsqrtf(ss * (1.f / 256.f) + 1e-6f);
#pragma unroll
    for (int q = 0; q < 4; ++q) {
      o[q] = o[q] * rstd * p.hy_out_g[layer * 256 + 4 * lane + q];
    }
    *(uint2*)(p.Y + (row0 + t0 + tl) * D + 4 * lane) = make_uint2(pack2(o[0], o[1]), pack2(o[2], o[3]));
  }
}

DEV void attn_unit(const P& p, int layer, int unit, char* smem) {
  const bool isctx = unit >= 4096;
  int b, qb, hq;
  if (!isctx) { b = unit >> 8; qb = (unit >> 3) & 31; hq = unit & 7; } else { int u = unit - 4096; b = u >> 4; qb = (u >> 3) & 1; hq = u & 7; }
  const int g = hq >> 2;
  const int tid = tid_(), lane = tid & 63, wid = tid >> 6, qn = lane & 31, hh = lane >> 5;
  const int qpos = qb * 128 + wid * 32 + qn;
  const size_t qrow = (size_t)b * LT + (isctx ? qpos : LC + qpos);
  const bf16_t* qptr = p.Z + qrow * INW + 1920 + hq * 64;
  bf16x8 qf[4];
#pragma unroll
  for (int s = 0; s < 4; ++s) qf[s] = *(const bf16x8*)(qptr + 16 * s + 8 * hh);
  const float sink = p.attn_sink[layer * 8 + hq];
  float m_run = sink, l_run = 1.f;
  f32x16 o0, o1;
#pragma unroll
  for (int i = 0; i < 16; ++i) { o0[i] = 0.f; o1[i] = 0.f; }
  typedef bf16_t KTile[64][72];
  KTile* Ks = (KTile*)smem;
  KTile* Vt = (KTile*)(smem + 18432);
  const int ntl = isctx ? 0 : 6;
  const int ntiles = ntl + 4;
  const int skey = tid >> 3, sseg = tid & 7;
  const bf16_t* kvbase = p.Z + (size_t)b * LT * INW + 1920 + 512 + g * 64 + sseg * 8;
  uint4 rk0, rk1, rv0, rv1;
  auto ldtile = [&](int kt) {
    const bool ctxk = kt >= ntl;
    const int kbase = ctxk ? (kt - ntl) * 64 : qb * 128 - 128 + kt * 64;
    const int kp0 = kbase + skey, kp1 = kp0 + 32;
    rk0 = rk1 = rv0 = rv1 = make_uint4(0, 0, 0, 0);
    if (ctxk || (kp0 >= 0 && kp0 < T)) { const bf16_t* src = kvbase + (size_t)(ctxk ? kp0 : LC + kp0) * INW; rk0 = *(const uint4*)src; rv0 = *(const uint4*)(src + 128); }
    if (ctxk || (kp1 >= 0 && kp1 < T)) { const bf16_t* src = kvbase + (size_t)(ctxk ? kp1 : LC + kp1) * INW; rk1 = *(const uint4*)src; rv1 = *(const uint4*)(src + 128); }
  };
  auto sttile = [&](int buf) {
    *(uint4*)&Ks[buf][skey][sseg * 8] = rk0;
    *(uint4*)&Ks[buf][skey + 32][sseg * 8] = rk1;
    bf16_t (*vt)[72] = Vt[buf];
    vt[sseg * 8 + 0][skey] = (bf16_t)(rv0.x & 0xFFFF); vt[sseg * 8 + 1][skey] = (bf16_t)(rv0.x >> 16);
    vt[sseg * 8 + 2][skey] = (bf16_t)(rv0.y & 0xFFFF); vt[sseg * 8 + 3][skey] = (bf16_t)(rv0.y >> 16);
    vt[sseg * 8 + 4][skey] = (bf16_t)(rv0.z & 0xFFFF); vt[sseg * 8 + 5][skey] = (bf16_t)(rv0.z >> 16);
    vt[sseg * 8 + 6][skey] = (bf16_t)(rv0.w & 0xFFFF); vt[sseg * 8 + 7][skey] = (bf16_t)(rv0.w >> 16);
    vt[sseg * 8 + 0][skey + 32] = (bf16_t)(rv1.x & 0xFFFF); vt[sseg * 8 + 1][skey + 32] = (bf16_t)(rv1.x >> 16);
    vt[sseg * 8 + 2][skey + 32] = (bf16_t)(rv1.y & 0xFFFF); vt[sseg * 8 + 3][skey + 32] = (bf16_t)(rv1.y >> 16);
    vt[sseg * 8 + 4][skey + 32] = (bf16_t)(rv1.z & 0xFFFF); vt[sseg * 8 + 5][skey + 32] = (bf16_t)(rv1.z >> 16);
    vt[sseg * 8 + 6][skey + 32] = (bf16_t)(rv1.w & 0xFFFF); vt[sseg * 8 + 7][skey + 32] = (bf16_t)(rv1.w >> 16);
  };
  ldtile(0);
#pragma unroll 1
  for (int kt = 0; kt < ntiles; ++kt) {
    const int buf = kt & 1;
    sttile(buf);
    __syncthreads();
    if (kt + 1 < ntiles) ldtile(kt + 1);
    const bool ctxk = kt >= ntl;
    const int kbase = ctxk ? (kt - ntl) * 64 : qb * 128 - 128 + kt * 64;
#pragma unroll
    for (int sub = 0; sub < 2; ++sub) {
      const int kb2 = kbase + sub * 32;
      bool need = true;
      if (!ctxk) {
        int q0 = qb * 128 + wid * 32;
        if (kb2 + 31 < q0 - 128 || kb2 > q0 + 31 + 128 || kb2 + 31 < 0 || kb2 >= T) need = false;
      }
      if (need) {
        f32x16 sv;
#pragma unroll
        for (int i = 0; i < 16; ++i) sv[i] = 0.f;
#pragma unroll
        for (int ks = 0; ks < 4; ++ks) {
          bf16x8 kf = *(const bf16x8*)&Ks[buf][sub * 32 + qn][16 * ks + 8 * hh];
          sv = mfma32(kf, qf[ks], sv);
        }
        float mt = -3e38f;
#pragma unroll
        for (int rg = 0; rg < 16; ++rg) {
          float v = sv[rg] * 0.125f;
          if (!ctxk) {
            int kp = kb2 + (rg & 3) + 8 * (rg >> 2) + 4 * hh;
            int dl = qpos - kp;
            bool ok = (dl <= 128) && (dl >= -128) && (kp >= 0) && (kp < T);
            v = ok ? v : -1e30f;
          }
          sv[rg] = v;
          mt = fmaxf(mt, v);
        }
        mt = fmaxf(mt, __shfl_xor(mt, 32));
        float m_new = fmaxf(m_run, mt);
        float corr = __expf(m_run - m_new);
        float ps = 0.f;
#pragma unroll
        for (int rg = 0; rg < 16; ++rg) { float pv = __expf(sv[rg] - m_new); sv[rg] = pv; ps += pv; }
        ps += __shfl_xor(ps, 32);
        l_run = l_run * corr + ps;
        m_run = m_new;
#pragma unroll
        for (int i = 0; i < 16; ++i) { o0[i] *= corr; o1[i] *= corr; }
#pragma unroll
        for (int sp = 0; sp < 2; ++sp) {
          bf16x8 pf;
#pragma unroll
          for (int j = 0; j < 8; ++j) pf[j] = (short)f2bf(sv[8 * sp + j]);
          const int kc = sub * 32 + 16 * sp + 4 * hh;
          uint2 va = *(const uint2*)&Vt[buf][qn][kc], vb = *(const uint2*)&Vt[buf][qn][kc + 8];
          uint2 vc = *(const uint2*)&Vt[buf][32 + qn][kc], vd = *(const uint2*)&Vt[buf][32 + qn][kc + 8];
          uint4 w0 = make_uint4(va.x, va.y, vb.x, vb.y), w1 = make_uint4(vc.x, vc.y, vd.x, vd.y);
          bf16x8 v0 = __builtin_bit_cast(bf16x8, w0), v1 = __builtin_bit_cast(bf16x8, w1);
          o0 = mfma32(v0, pf, o0);
          o1 = mfma32(v1, pf, o1);
        }
      }
    }
  }
  __syncthreads();
  const float inv = 1.f / l_run;
  bf16_t* optr = p.Y + qrow * D + 512 + hq * 64;
#pragma unroll
  for (int rg = 0; rg < 4; ++rg) {
    int d0 = 8 * rg + 4 * hh;
    *(uint2*)(optr + d0) = make_uint2(pack2(o0[4 * rg] * inv, o0[4 * rg + 1] * inv), pack2(o0[4 * rg + 2] * inv, o0[4 * rg + 3] * inv));
    *(uint2*)(optr + 32 + d0) = make_uint2(pack2(o1[4 * rg] * inv, o1[4 * rg + 1] * inv), pack2(o1[4 * rg + 2] * inv, o1[4 * rg + 3] * inv));
  }
}

DEV void ph_attn_post(const P& p, int layer) {
  const int lane = tid_() & 63;
  int r0, r1;
  wave_range(r0, r1, NTOK);
  float gv[8];
#pragma unroll
  for (int i = 0; i < 8; ++i) gv[i] = p.at_out_g[layer * 512 + 8 * lane + i];
  uint4 nx = make_uint4(0, 0, 0, 0);
  if (r0 < r1) nx = *(const uint4*)(p.Y + (size_t)r0 * D + 512 + 8 * lane);
#pragma unroll 1
  for (int row = r0; row < r1; ++row) {
    const uint4 u = nx;
    if (row + 1 < r1) nx = *(const uint4*)(p.Y + (size_t)(row + 1) * D + 512 + 8 * lane);
    float v[8];
    unpack8(u, v);
    float ss = 0.f;
#pragma unroll
    for (int i = 0; i < 8; ++i) ss += v[i] * v[i];
    ss = wave_sum(ss);
    const float rstd = rsqrtf(ss * (1.f / 512.f) + 1e-6f);
#pragma unroll
    for (int i = 0; i < 8; ++i) {
      v[i] = v[i] * rstd * gv[i];
    }
    *(uint4*)(p.Y + (size_t)row * D + 512 + 8 * lane) = pack8(v);
  }
}

struct Epi2 {
  const P& p; int layer, row0, col0;
  DEV void operator()(f32x4 (&acc)[4][4], int wr, int wc, int fr, int fq, char* smem) const {
    const int b = row0 / LT, pp = row0 % LT;
    const int mr = pp < LC ? 16 : b;
    const float* g1 = p.modv + ((size_t)layer * 17 + mr) * 6144 + 2048 + col0 + wc * 64;
#pragma unroll
    for (int n = 0; n < 4; ++n) {
      const float gv = g1[n * 16 + fr];
#pragma unroll
      for (int m = 0; m < 4; ++m)
#pragma unroll
        for (int j = 0; j < 4; ++j) acc[m][n][j] *= gv;
    }
    const int wid = wr * 2 + wc, lane = fq * 16 + fr;
    stage_tile_bf16(acc, smem, wid, fr, fq);
    const bf16_t (*t)[72] = (const bf16_t (*)[72])(smem + wid * 9216);
#pragma unroll
    for (int i = 0; i < 8; ++i) {
      const int rl = i * 8 + (lane >> 3), ch = lane & 7;
      bf16_t* xp = p.X + (size_t)(row0 + wr * 64 + rl) * D + col0 + wc * 64 + ch * 8;
      float xv[8], dv[8];
      uint4 xu = *(const uint4*)xp, du = *(const uint4*)&t[rl][ch * 8];
      unpack8(xu, xv); unpack8(du, dv);
#pragma unroll
      for (int q = 0; q < 8; ++q) xv[q] += dv[q];
      *(uint4*)xp = pack8(xv);
    }
  }
};
DEV void ph_gemm2(const P& p, int layer, char* smem) {
  int rt, ct;
  for (int it = 0; gemm_unit(it, 8, rt, ct); ++it) {
    Epi2 epi{p, layer, rt * 128, ct * 128};
    gemm_tile(p.Y + (size_t)rt * 128 * D, D, p.W2t + (size_t)ct * 128 * D, D, D, smem, epi);
  }
}

DEV void ph_peerconv(const P& p, int layer) {
  const int gw = (bid_() * 256 + tid_()) >> 6, nw = gridDim.x * 4, lane = tid_() & 63;
  const float* su = opq(p.peer_u) + (size_t)layer * 16384 * 1024;
  const float* sv = opq(p.peer_v) + (size_t)layer * 16384 * 1024;
  unsigned char* pu = opq(p.PU); unsigned char* pv = opq(p.PV);
  float* psu = opq(p.PSU); float* psv = opq(p.PSV);
#pragma unroll 1
  for (int r = gw; r < 32768; r += nw) {
    const bool isv = r >= 16384;
    const int e = r & 16383;
    const float* src = (isv ? sv : su) + (size_t)e * 1024 + 16 * lane;
    float4 f0 = *(const float4*)src, f1 = *(const float4*)(src + 4), f2 = *(const float4*)(src + 8), f3 = *(const float4*)(src + 12);
    float am = fmaxf(fmaxf(fmaxf(fabsf(f0.x), fabsf(f0.y)), fmaxf(fabsf(f0.z), fabsf(f0.w))), fmaxf(fmaxf(fabsf(f1.x), fabsf(f1.y)), fmaxf(fabsf(f1.z), fabsf(f1.w))));
    am = fmaxf(am, fmaxf(fmaxf(fmaxf(fabsf(f2.x), fabsf(f2.y)), fmaxf(fabsf(f2.z), fabsf(f2.w))), fmaxf(fmaxf(fabsf(f3.x), fabsf(f3.y)), fmaxf(fabsf(f3.z), fabsf(f3.w)))));
    am = wave_max(am);
    int w0, w1, w2, w3;
    float inv;
    if (isv) {
      const float sc = am > 0.f ? 224.f / am : 1.f;
      inv = am > 0.f ? am * (1.f / 224.f) : 1.f;
      w0 = __builtin_amdgcn_cvt_pk_fp8_f32(f0.x * sc, f0.y * sc, 0, false); w0 = __builtin_amdgcn_cvt_pk_fp8_f32(f0.z * sc, f0.w * sc, w0, true);
      w1 = __builtin_amdgcn_cvt_pk_fp8_f32(f1.x * sc, f1.y * sc, 0, false); w1 = __builtin_amdgcn_cvt_pk_fp8_f32(f1.z * sc, f1.w * sc, w1, true);
      w2 = __builtin_amdgcn_cvt_pk_fp8_f32(f2.x * sc, f2.y * sc, 0, false); w2 = __builtin_amdgcn_cvt_pk_fp8_f32(f2.z * sc, f2.w * sc, w2, true);
      w3 = __builtin_amdgcn_cvt_pk_fp8_f32(f3.x * sc, f3.y * sc, 0, false); w3 = __builtin_amdgcn_cvt_pk_fp8_f32(f3.z * sc, f3.w * sc, w3, true);
    } else {
      const float sc = am > 0.f ? 127.f / am : 1.f;
      inv = am > 0.f ? am * (1.f / 127.f) : 1.f;
      w0 = pack_i8(f0.x * sc, f0.y * sc, f0.z * sc, f0.w * sc); w1 = pack_i8(f1.x * sc, f1.y * sc, f1.z * sc, f1.w * sc);
      w2 = pack_i8(f2.x * sc, f2.y * sc, f2.z * sc, f2.w * sc); w3 = pack_i8(f3.x * sc, f3.y * sc, f3.z * sc, f3.w * sc);
    }
    *(uint4*)((isv ? pv : pu) + (size_t)(lane >> 3) * PSLICE + (size_t)e * 128 + 16 * (lane & 7)) = make_uint4((unsigned)w0, (unsigned)w1, (unsigned)w2, (unsigned)w3);
    if (lane == 0) (isv ? psv : psu)[e] = inv;
  }
}
DEV void unpack16_fp8x2(const uint4& u, f32x2* f) {
  f[0] = __builtin_amdgcn_cvt_pk_f32_fp8((int)u.x, false); f[1] = __builtin_amdgcn_cvt_pk_f32_fp8((int)u.x, true);
  f[2] = __builtin_amdgcn_cvt_pk_f32_fp8((int)u.y, false); f[3] = __builtin_amdgcn_cvt_pk_f32_fp8((int)u.y, true);
  f[4] = __builtin_amdgcn_cvt_pk_f32_fp8((int)u.z, false); f[5] = __builtin_amdgcn_cvt_pk_f32_fp8((int)u.z, true);
  f[6] = __builtin_amdgcn_cvt_pk_f32_fp8((int)u.w, false); f[7] = __builtin_amdgcn_cvt_pk_f32_fp8((int)u.w, true);
}

DEV void bitonic_sort16_desc(float (&v)[16]) {
#pragma unroll
  for (int k = 2; k <= 16; k <<= 1)
#pragma unroll
    for (int j = k >> 1; j >= 1; j >>= 1)
#pragma unroll
      for (int i = 0; i < 16; ++i) {
        const int l = i ^ j;
        if (l > i) {
          const float hi = fmaxf(v[i], v[l]), lo = fminf(v[i], v[l]);
          if ((i & k) == 0) { v[i] = hi; v[l] = lo; } else { v[i] = lo; v[l] = hi; }
        }
      }
}
struct Epi3 {
  const P& p; int row0, grp;
  DEV void operator()(f32x4 (&acc)[4][4], int wr, int wc, int fr, int fq, char* smem) const {
    float* sc = (float*)smem;
    const int tid = tid_();
    for (int pass = 0; pass < 2; ++pass) {
      __syncthreads();
      if (wr == pass) {
#pragma unroll
        for (int m = 0; m < 4; ++m)
#pragma unroll
          for (int n = 0; n < 4; ++n)
#pragma unroll
            for (int j = 0; j < 4; ++j) {
              int rl = m * 16 + fq * 4 + j, col = wc * 64 + n * 16 + fr;
              unsigned bits = (__float_as_uint(acc[m][n][j]) & ~127u) | (unsigned)col;
              sc[rl * 133 + (col >> 5) * 33 + (col & 31)] = __uint_as_float(bits);
            }
      }
      __syncthreads();
      const int rl = tid >> 2, q = tid & 3;
      const float* src = sc + rl * 133 + q * 33;
      float Ls[16], Hs[16];
#pragma unroll
      for (int i = 0; i < 16; ++i) { Ls[i] = src[i]; Hs[i] = src[16 + i]; }
      bitonic_sort16_desc(Ls);
      bitonic_sort16_desc(Hs);
#pragma unroll
      for (int i = 0; i < 16; ++i) Ls[i] = fmaxf(Ls[i], Hs[15 - i]);
#pragma unroll
      for (int d = 8; d >= 1; d >>= 1)
#pragma unroll
        for (int i = 0; i < 16; ++i)
          if ((i & d) == 0) { float hi = fmaxf(Ls[i], Ls[i + d]), lo = fminf(Ls[i], Ls[i + d]); Ls[i] = hi; Ls[i + d] = lo; }
      float Cs[16];
#pragma unroll
      for (int i = 0; i < 16; ++i) Cs[i] = fmaxf(Ls[i], dppself<0xB1, 0xF>(Ls[15 - i]));
#pragma unroll
      for (int d = 8; d >= 1; d >>= 1)
#pragma unroll
        for (int i = 0; i < 16; ++i)
          if ((i & d) == 0) { float hi = fmaxf(Cs[i], Cs[i + d]), lo = fminf(Cs[i], Cs[i + d]); Cs[i] = hi; Cs[i + d] = lo; }
      float Ds[16];
#pragma unroll
      for (int i = 0; i < 16; ++i) Ds[i] = fmaxf(Cs[i], dppself<0x4E, 0xF>(Cs[15 - i]));
#pragma unroll
      for (int d = 8; d >= 1; d >>= 1)
#pragma unroll
        for (int i = 0; i < 16; ++i)
          if ((i & d) == 0) { float hi = fmaxf(Ds[i], Ds[i + d]), lo = fminf(Ds[i], Ds[i + d]); Ds[i] = hi; Ds[i + d] = lo; }
      if (q == 0) {
        float* dst = p.TK + ((size_t)(row0 + pass * 64 + rl) * 16 + grp) * 16;
#pragma unroll
        for (int i = 0; i < 4; ++i) *(float4*)(dst + 4 * i) = make_float4(Ds[4 * i], Ds[4 * i + 1], Ds[4 * i + 2], Ds[4 * i + 3]);
      }
    }
  }
};
DEV void ph_gemm3(const P& p, char* smem) {
  int rt, ct;
  for (int it = 0; gemm_unit(it, 16, rt, ct); ++it) {
    Epi3 epi{p, rt * 128, ct};
    gemm_tile(p.H + (size_t)rt * 128 * D, D, p.Wft + (size_t)ct * 128 * D, D, D, smem, epi);
  }
}

DEV float peer_gate(float scr) {
  float mx = row16_max(scr);
  float ex = __expf(scr - mx);
  float sm = row16_sum(ex);
  return ex / sm;
}
DEV float gelu_exact(float x) { return 0.5f * x * (1.f + erff(x * 0.7071067811865476f)); }

DEV void ph_peer_select(const P& p) {
  const int gw = (bid_() * 256 + tid_()) >> 6, nw = gridDim.x * 4, lane = tid_() & 63;
  int ci, cj;
  {
    const int c = lane;
    if (c < 16) { ci = 0; cj = c; } else if (c < 24) { ci = 1; cj = c - 16; } else if (c < 29) { ci = 2; cj = c - 24; }
    else if (c < 33) { ci = 3; cj = c - 29; } else if (c < 36) { ci = 4; cj = c - 33; } else if (c < 38) { ci = 5; cj = c - 36; }
    else if (c < 40) { ci = 6; cj = c - 38; } else if (c < 42) { ci = 7; cj = c - 40; } else { ci = (c - 42 + 8) & 15; cj = 0; }
  }
  const bool cand = lane < 50;
  float v1s[8], v2s[8];
  auto ldtk = [&](int row) {
    const float* tk = p.TK + (size_t)row * 256;
#pragma unroll
    for (int h = 0; h < 8; ++h) { v1s[h] = tk[(2 * h) * 16 + ci]; v2s[h] = tk[(2 * h + 1) * 16 + cj]; }
  };
  if (gw < NTOK) ldtk(gw);
#pragma unroll 1
  for (int row = gw; row < NTOK; row += nw) {
    float c1[8], c2[8];
#pragma unroll
    for (int h = 0; h < 8; ++h) { c1[h] = v1s[h]; c2[h] = v2s[h]; }
    if (row + nw < NTOK) ldtk(row + nw);
#pragma unroll
    for (int h = 0; h < 8; ++h) {
      const float v1 = c1[h], v2 = c2[h];
      float val = v1 + v2;
      val = __uint_as_float((__float_as_uint(val) & ~63u) | (unsigned)lane);
      val = cand ? val : -3e38f;
      int rank = 0;
#pragma unroll
      for (int q = 0; q < 50; ++q) rank += (readlane_f(val, q) > val) ? 1 : 0;
      const bool sel = cand && rank < 16;
      const float mx = wave_max(val);
      const float ex = sel ? __expf(val - mx) : 0.f;
      const float sm = wave_sum(ex);
      if (sel) {
        const int e = (int)(__float_as_uint(v1) & 127u) * 128 + (int)(__float_as_uint(v2) & 127u);
        p.EL[(size_t)row * 128 + h * 16 + rank] = (unsigned short)e;
        p.GT[(size_t)row * 128 + h * 16 + rank] = ex / sm;
      }
    }
  }
}

struct PeerPre { uint4 e0, e1, a0, a1, a2, a3; };
DEV unsigned peer_eid(const PeerPre& s, int j) {
  const unsigned w = (j < 8) ? ((j >> 1) == 0 ? s.e0.x : (j >> 1) == 1 ? s.e0.y : (j >> 1) == 2 ? s.e0.z : s.e0.w)
                             : (((j - 8) >> 1) == 0 ? s.e1.x : ((j - 8) >> 1) == 1 ? s.e1.y : ((j - 8) >> 1) == 2 ? s.e1.z : s.e1.w);
  return (j & 1) ? (w >> 16) : (w & 0xFFFFu);
}
template <int WHICH>
DEV void peer_wave_run(const P& p, int layer, int x, int tok0, int lane, float* wbuf) {
  const int r = lane >> 3, c = lane & 7;
  const unsigned char* tb = (WHICH == 0 ? p.PU : p.PV) + (size_t)x * PSLICE + c * 16;
  PeerPre S[3];
  uint4 R[16];
  auto ld_pre = [&](int tok, PeerPre& s) {
    const uint4* elp = (const uint4*)(p.EL + (size_t)tok * 128 + r * 16);
    s.e0 = elp[0]; s.e1 = elp[1];
    if (WHICH == 0) {
      s.a0 = *(const uint4*)(p.H8 + (size_t)tok * 1024 + x * 128 + c * 16);
    } else {
      const uint4* wtp = (const uint4*)(p.GT + (size_t)tok * 128 + r * 16);
      s.a0 = wtp[0]; s.a1 = wtp[1]; s.a2 = wtp[2]; s.a3 = wtp[3];
    }
  };
  auto comp = [&](int tok, const PeerPre& s, const PeerPre& sn, bool more) {
    if (WHICH == 0) {
      int keep0 = 0, keep1 = 0;
#pragma unroll
      for (int j = 0; j < 16; ++j) {
        const uint4 rw = R[j];
        if (more) R[j] = *(const uint4*)(tb + (size_t)peer_eid(sn, j) * 128);
        int d = __builtin_amdgcn_sdot4((int)rw.x, (int)s.a0.x, 0, false);
        d = __builtin_amdgcn_sdot4((int)rw.y, (int)s.a0.y, d, false);
        d = __builtin_amdgcn_sdot4((int)rw.z, (int)s.a0.z, d, false);
        d = __builtin_amdgcn_sdot4((int)rw.w, (int)s.a0.w, d, false);
        d += __builtin_amdgcn_update_dpp(0, d, 0xB1, 0xF, 0xF, false);
        d += __builtin_amdgcn_update_dpp(0, d, 0x4E, 0xF, 0xF, false);
        d += __builtin_amdgcn_update_dpp(0, d, 0x141, 0xF, 0xF, false);
        if (j < 8) keep0 = (c == j) ? d : keep0; else keep1 = (c == j - 8) ? d : keep1;
      }
      float* pd = p.PD + ((size_t)x * NTOK + tok) * 128 + r * 16 + c;
      pd[0] = (float)keep0; pd[8] = (float)keep1;
    } else {
      const float wsv[16] = {__uint_as_float(s.a0.x), __uint_as_float(s.a0.y), __uint_as_float(s.a0.z), __uint_as_float(s.a0.w),
                             __uint_as_float(s.a1.x), __uint_as_float(s.a1.y), __uint_as_float(s.a1.z), __uint_as_float(s.a1.w),
                             __uint_as_float(s.a2.x), __uint_as_float(s.a2.y), __uint_as_float(s.a2.z), __uint_as_float(s.a2.w),
                             __uint_as_float(s.a3.x), __uint_as_float(s.a3.y), __uint_as_float(s.a3.z), __uint_as_float(s.a3.w)};
      f32x2 acc2[8];
#pragma unroll
      for (int i = 0; i < 8; ++i) acc2[i] = (f32x2){0.f, 0.f};
#pragma unroll
      for (int j = 0; j < 16; ++j) {
        f32x2 f[8];
        unpack16_fp8x2(R[j], f);
        if (more) R[j] = *(const uint4*)(tb + (size_t)peer_eid(sn, j) * 128);
        const f32x2 w2 = (f32x2){wsv[j], wsv[j]};
#pragma unroll
        for (int i = 0; i < 8; ++i) acc2[i] += w2 * f[i];
      }
      float* slab = wbuf + (r * 8 + c) * 16;
      *(float4*)(slab) = make_float4(acc2[0][0], acc2[0][1], acc2[1][0], acc2[1][1]);
      *(float4*)(slab + 4) = make_float4(acc2[2][0], acc2[2][1], acc2[3][0], acc2[3][1]);
      *(float4*)(slab + 8) = make_float4(acc2[4][0], acc2[4][1], acc2[5][0], acc2[5][1]);
      *(float4*)(slab + 12) = make_float4(acc2[6][0], acc2[6][1], acc2[7][0], acc2[7][1]);
      asm volatile("s_waitcnt lgkmcnt(0)" ::: "memory");
      float o0 = 0.f, o1 = 0.f;
#pragma unroll
      for (int rr = 0; rr < 8; ++rr) {
        const float2 t = *(const float2*)(wbuf + (rr * 8 + (lane >> 3)) * 16 + 2 * (lane & 7));
        o0 += t.x; o1 += t.y;
      }
      asm volatile("s_waitcnt lgkmcnt(0)" ::: "memory");
      const int b = tok / LT, pp = tok % LT;
      const int mr = pp < LC ? 16 : b;
      const int col = x * 128 + 2 * lane;
      const float* g2 = p.modv + ((size_t)layer * 17 + mr) * 6144 + 5120 + col;
      unsigned* xp = (unsigned*)(p.X + (size_t)tok * D + col);
      const unsigned xu = *xp;
      *xp = pack2(bflo(xu) + g2[0] * o0, bfhi(xu) + g2[1] * o1);
    }
  };
  ld_pre(tok0, S[0]);
  ld_pre(tok0 + 1, S[1]);
#pragma unroll
  for (int j = 0; j < 16; ++j) R[j] = *(const uint4*)(tb + (size_t)peer_eid(S[0], j) * 128);
  ld_pre(tok0 + 2, S[2]);
#pragma unroll
  for (int t = 0; t < 8; ++t) {
    comp(tok0 + t, S[t % 3], S[(t + 1) % 3], t + 1 < 8);
    if (t + 3 < 8) ld_pre(tok0 + t + 3, S[t % 3]);
  }
}
DEV void ph_peer_w(const P& p) {
  for (size_t i = (size_t)bid_() * 256 + tid_(); i < (size_t)NTOK * 128; i += (size_t)gridDim.x * 256) {
    float d = 0.f;
#pragma unroll
    for (int x = 0; x < 8; ++x) d += p.PD[(size_t)x * NTOK * 128 + i];
    const int e = p.EL[i];
    p.GT[i] = p.GT[i] * gelu_exact(d * p.PSU[e] * p.HINV[i >> 7]) * p.PSV[e];
  }
}
template <int WHICH>
DEV void ph_peer_gather(const P& p, int layer, char* smem, volatile LAS unsigned* slot) {
  const int tid = tid_(), lane = tid & 63, wid = tid >> 6;
  unsigned* q = p.wq + 1024 + layer * 256 + WHICH * 128;
  const int my = (int)(xb_xcc_id() & 7u);
  float* wbuf = (float*)smem + wid * 1024;
#pragma unroll 1
  for (int rot = 0; rot < 8; ++rot) {
    const int x = (my + rot) & 7;
    for (;;) {
      __syncthreads();
      if (tid == 0) *slot = atomicAdd(q + x * 16, 1u);
      __syncthreads();
      const int it = (int)*slot;
      if (it >= NTOK / 32) break;
      peer_wave_run<WHICH>(p, layer, x, it * 32 + wid * 8, lane, wbuf);
    }
  }
}

DEV void ph_final(const P& p) {
  const int lane = tid_() & 63;
  int r0, r1;
  wave_range(r0, r1, NB * T);
  float gv[16];
#pragma unroll
  for (int hh = 0; hh < 2; ++hh)
#pragma unroll
    for (int i = 0; i < 8; ++i) gv[hh * 8 + i] = p.final_g[hh * 512 + 8 * lane + i];
  auto xrow = [&](int r) -> const bf16_t* { const int b = r / T, t = r % T; return p.X + ((size_t)b * LT + LC + t) * D; };
  uint4 n0 = make_uint4(0, 0, 0, 0), n1 = n0;
  if (r0 < r1) { const bf16_t* xr = xrow(r0); n0 = *(const uint4*)(xr + 8 * lane); n1 = *(const uint4*)(xr + 512 + 8 * lane); }
#pragma unroll 1
  for (int r = r0; r < r1; ++r) {
    const uint4 u0 = n0, u1 = n1;
    if (r + 1 < r1) { const bf16_t* xr = xrow(r + 1); n0 = *(const uint4*)(xr + 8 * lane); n1 = *(const uint4*)(xr + 512 + 8 * lane); }
    float v[16];
    unpack8(u0, v); unpack8(u1, v + 8);
    float ss = 0.f;
#pragma unroll
    for (int i = 0; i < 16; ++i) ss += v[i] * v[i];
    ss = wave_sum(ss);
    const float rstd = rsqrtf(ss * (1.f / 1024.f) + 1e-6f);
    float* o = p.out + (size_t)r * D;
#pragma unroll
    for (int hh = 0; hh < 2; ++hh) {
      const int col = hh * 512 + 8 * lane;
      *(float4*)(o + col) = make_float4(v[hh * 8 + 0] * rstd * gv[hh * 8 + 0], v[hh * 8 + 1] * rstd * gv[hh * 8 + 1], v[hh * 8 + 2] * rstd * gv[hh * 8 + 2], v[hh * 8 + 3] * rstd * gv[hh * 8 + 3]);
      *(float4*)(o + col + 4) = make_float4(v[hh * 8 + 4] * rstd * gv[hh * 8 + 4], v[hh * 8 + 5] * rstd * gv[hh * 8 + 5], v[hh * 8 + 6] * rstd * gv[hh * 8 + 6], v[hh * 8 + 7] * rstd * gv[hh * 8 + 7]);
    }
  }
}

DEV unsigned hw_cu_key() {
  const unsigned hwid = (unsigned)__builtin_amdgcn_s_getreg(((8 - 1) << 11) | (8 << 6) | 4);
  return (xb_xcc_id() << 8) | (hwid & 0xFFu);
}
DEV void mixB(const P& p, int layer, char* smem, volatile LAS unsigned* slot) {
  unsigned* qa = p.wq + layer * 64;
  unsigned* qs = qa + 16;
  unsigned* claim = p.cuclaim + layer * 4096;
  __syncthreads();
  if (tid_() == 0) {
    unsigned u = 0xFFFFFFFFu;
    if (atomicAdd(&claim[hw_cu_key() & 4095u], 1u) == 0u) u = atomicAdd(qs, 1u);
    *slot = u;
  }
  __syncthreads();
  {
    const unsigned u = *slot;
    if (u < 128u) scanc_unit(p, layer, (int)u, smem);
  }
  for (;;) {
    __syncthreads();
    if (tid_() == 0) *slot = atomicAdd(qa, 1u);
    __syncthreads();
    const int u = (int)*slot;
    if (u >= 8704) break;
    if (u < 4352) attn_unit(p, layer, u, smem); else hyena_conv_unit(p, layer, u - 4352, smem);
  }
  if (layer + 1 < DEPTH) {
    unsigned* qp = qa + 32;
    for (;;) {
      __syncthreads();
      if (tid_() == 0) *slot = atomicAdd(qp, 1u);
      __syncthreads();
      const int u = (int)*slot;
      if (u >= PREPA_N) break;
      prep_unit(p, layer + 1, prepA_unit_index(u), smem);
    }
  }
  for (;;) {
    __syncthreads();
    if (tid_() == 0) *slot = atomicAdd(qs, 1u);
    __syncthreads();
    const unsigned u = *slot;
    if (u >= 128u) break;
    scanc_unit(p, layer, (int)u, smem);
  }
}
DEV void mixA(const P& p, int layer, char* smem) {
  for (int u = bid_(); u < 1088; u += gridDim.x) hyena_pre_unit(p, layer, u);
  ph_lora(p, layer, smem);
  ph_rwkv_prep(p, layer);
}
DEV void mixC(const P& p, int layer, char* smem) {
  for (int u = bid_(); u < 1088; u += gridDim.x) hyena_post_unit(p, layer, u, smem);
  ph_rwkv_post(p, layer);
  ph_attn_post(p, layer);
}

__global__ void __launch_bounds__(256, 2) k_mega(P p) {
  extern __shared__ __attribute__((aligned(16))) char smem_all[];
  char* smem = smem_all;
  volatile LAS unsigned* xbw = (volatile LAS unsigned*)(smem_all + SMEM_BYTES);
  if (threadIdx.x == 0) { xbw[0] = 0u; xbw[1] = 0u; xbw[2] = 0u; xbw[3] = 0u; }
  __syncthreads();
  XcdBarrier bar = xcd_barrier_post(p.bar, xbw);
  ph_copy(p);
  ph_rope(p);
  for (int u = blockIdx.x; u < 96; u += gridDim.x) modv_unit(p, u, smem);
  ph_prep(p, 0, smem, false);
  xcd_barrier(bar);
  for (int layer = 0; layer < DEPTH; ++layer) {
    ph_norm(p, layer, 0);
    xcd_barrier(bar);
    ph_gemm1(p, smem);
    xcd_barrier(bar);
    mixA(p, layer, smem);
    xcd_barrier(bar);
    mixB(p, layer, smem, (volatile LAS unsigned*)(smem_all + SMEM_BYTES + 16));
    xcd_barrier(bar);
    mixC(p, layer, smem);
    xcd_barrier(bar);
    ph_gemm2(p, layer, smem);
    ph_peerconv(p, layer);
    xcd_barrier(bar);
    ph_norm(p, layer, 1);
    xcd_barrier(bar);
    ph_gemm3(p, smem);
    xcd_barrier(bar);
    ph_peer_select(p);
    xcd_barrier(bar);
    ph_peer_gather<0>(p, layer, smem, (volatile LAS unsigned*)(smem_all + SMEM_BYTES + 16));
    xcd_barrier(bar);
    ph_peer_w(p);
    xcd_barrier(bar);
    ph_peer_gather<1>(p, layer, smem, (volatile LAS unsigned*)(smem_all + SMEM_BYTES + 16));
    if (layer + 1 < DEPTH) ph_prep(p, layer + 1, smem, true);
    xcd_barrier(bar);
  }
  ph_final(p);
}

static inline size_t al256(size_t x) { return (x + 255) & ~(size_t)255; }

extern "C" void kernel_launch(void* const* d_in, const int* in_sizes, int n_in, void* d_out, int out_size, void* d_ws, size_t ws_size,
                              hipStream_t stream) {
  (void)in_sizes; (void)n_in; (void)out_size; (void)ws_size;
  P p{};
  const float** f = (const float**)&p;
  for (int i = 0; i < 39; ++i) f[i] = (const float*)d_in[i];
  p.out = (float*)d_out;
  char* w = (char*)d_ws;
  size_t off = 0;
  auto take = [&](size_t bytes) { char* r = w + off; off += al256(bytes); return r; };
  p.bar = (unsigned*)take(16384);
  p.modv = (float*)take((size_t)DEPTH * 17 * 6144 * 4);
  p.SSQ = (float*)take((size_t)DEPTH * 2 * 256 * 4);
  p.wq = (unsigned*)take(4096 + DEPTH * 1024);
  p.cuclaim = (unsigned*)take((size_t)DEPTH * 4096 * 4);
  const size_t zero_bytes = off;
  p.rope = (float*)take(64 * 16 * 2 * 4);
  p.X = (bf16_t*)take((size_t)NTOK * D * 2);
  p.H = (bf16_t*)take((size_t)NTOK * D * 2);
  p.Y = (bf16_t*)take((size_t)NTOK * D * 2);
  p.SC = (bf16_t*)take((size_t)NTOK * 1024 * 2);
  p.Z = (bf16_t*)take((size_t)NTOK * INW * 2);
  p.UTl = (bf16_t*)take((size_t)256 * 16 * T * 2);
  p.UTc = (bf16_t*)take((size_t)256 * 16 * LC * 2);
  p.YTl = (bf16_t*)take((size_t)256 * 16 * T * 2);
  p.YTc = (bf16_t*)take((size_t)256 * 16 * LC * 2);
  p.FL = (float*)take((size_t)256 * 2 * T * 4);
  p.FC = (float*)take((size_t)256 * 2 * LC * 4);
  p.W1t = (bf16_t*)take((size_t)INW * D * 2);
  p.W2t = (bf16_t*)take((size_t)D * D * 2);
  p.Wft = (bf16_t*)take((size_t)2048 * D * 2);
  p.Wlt = (bf16_t*)take((size_t)1024 * 256 * 2);
  p.Wgt = (bf16_t*)take((size_t)256 * 128 * 2);
  p.TK = (float*)p.Z;
  p.PU = (unsigned char*)p.Z + al256((size_t)NTOK * 256 * 4);
  p.PV = p.PU + (size_t)16384 * 1024;
  p.PSU = (float*)(p.PV + (size_t)16384 * 1024);
  p.PSV = p.PSU + 16384;
  p.GT = p.PSV + 16384;
  p.EL = (unsigned short*)(p.GT + (size_t)NTOK * 128);
  p.H8 = (unsigned char*)p.EL + al256((size_t)NTOK * 128 * 2);
  p.HINV = (float*)(p.H8 + (size_t)NTOK * 1024);
  p.PD = (float*)p.Y;

  (void)hipMemsetAsync(d_ws, 0, zero_bytes, stream);
  constexpr size_t kDynLds = SMEM_BYTES + 32;
  static int grid = 0;
  if (!grid) {
    int dev = 0, cus = 0, per_cu = 0;
    (void)hipGetDevice(&dev);
    (void)hipDeviceGetAttribute(&cus, hipDeviceAttributeMultiprocessorCount, dev);
    (void)hipFuncSetAttribute((const void*)k_mega, hipFuncAttributeMaxDynamicSharedMemorySize, (int)kDynLds);
    (void)hipOccupancyMaxActiveBlocksPerMultiprocessor(&per_cu, k_mega, 256, kDynLds);
    if (cus <= 0) cus = 256;
    if (per_cu > 2) per_cu = 2;
    if (per_cu < 1) per_cu = 1;
    grid = cus * per_cu;
  }
  k_mega<<<grid, 256, kDynLds, stream>>>(p);
}
```

```cpp
#include <hip/hip_runtime.h>
#include <stdint.h>
#include <type_traits>

#define DEV __device__ __forceinline__
typedef unsigned short bf16_t;
typedef short bf16x8 __attribute__((ext_vector_type(8)));
typedef float f32x2 __attribute__((ext_vector_type(2)));
constexpr size_t PSLICE = (size_t)16384 * 128;
typedef float f32x4 __attribute__((ext_vector_type(4)));
typedef float f32x16 __attribute__((ext_vector_type(16)));


constexpr int NB = 16, T = 4096, LC = 256, LT = 4352, D = 1024, NTOK = NB * LT, INW = 2688, DEPTH = 4;
constexpr int SMEM_BYTES = 65536;

struct P {
  const float *x, *c, *ctx, *c_ctx, *mod_w, *mod_b, *norm1_g, *norm2_g, *w_in, *conv_w, *conv_b;
  const float *hy_w1, *hy_b1, *hy_w2, *hy_b2, *hy_w3, *hy_b3, *hy_freq, *hy_bias;
  const float *rw_w0, *rw_w_up, *rw_a0, *rw_a_up, *rw_g_up, *rw_k_k, *rw_k_a, *rw_r_k, *rw_ln_w, *rw_ln_b;
  const float *attn_sink, *hy_out_g, *at_out_g, *w_out, *peer_wq, *peer_k1, *peer_k2, *peer_u, *peer_v, *final_g;
  float* out;
  unsigned* bar;
  float *modv, *SSQ, *rope, *FL, *FC, *TK;
  unsigned *wq, *cuclaim;
  bf16_t *X, *H, *Y, *SC, *Z, *UTl, *UTc, *YTl, *YTc;
  bf16_t *W1t, *W2t, *Wft, *Wlt, *Wgt;
  unsigned char *PU, *PV;
  float *PSU, *PSV, *GT, *HINV;
  bf16_t* PD;
  unsigned short* EL;
  unsigned char* H8;
};

typedef __bf16 hwbf2 __attribute__((ext_vector_type(2)));
DEV unsigned pack2(float a, float b) { f32x2 f = {a, b}; hwbf2 r = __builtin_convertvector(f, hwbf2); return __builtin_bit_cast(unsigned, r); }
DEV bf16_t f2bf(float f) { return (bf16_t)(pack2(f, 0.f) & 0xFFFFu); }
DEV float bf2f(bf16_t h) { return __uint_as_float(((unsigned)h) << 16); }
DEV float bflo(unsigned u) { return __uint_as_float(u << 16); }
DEV float bfhi(unsigned u) { return __uint_as_float(u & 0xFFFF0000u); }
DEV void unpack8(const uint4& u, float* v) {
  v[0] = bflo(u.x); v[1] = bfhi(u.x); v[2] = bflo(u.y); v[3] = bfhi(u.y);
  v[4] = bflo(u.z); v[5] = bfhi(u.z); v[6] = bflo(u.w); v[7] = bfhi(u.w);
}
DEV uint4 pack8(const float* v) { return make_uint4(pack2(v[0], v[1]), pack2(v[2], v[3]), pack2(v[4], v[5]), pack2(v[6], v[7])); }
DEV int pack_i8(float a, float b, float c, float d) {
  const int ia = __float2int_rn(a), ib = __float2int_rn(b), ic = __float2int_rn(c), id = __float2int_rn(d);
  return (ia & 0xFF) | ((ib & 0xFF) << 8) | ((ic & 0xFF) << 16) | ((id & 0xFF) << 24);
}
DEV float sigmoidf_(float x) { return __builtin_amdgcn_rcpf(1.f + __expf(-x)); }

template <int CTRL, int ROWMASK>
DEV float dpp0(float x) {
  return __builtin_bit_cast(float, __builtin_amdgcn_update_dpp(0, __builtin_bit_cast(int, x), CTRL, ROWMASK, 0xF, false));
}
template <int CTRL, int ROWMASK>
DEV float dppself(float x) {
  int xi = __builtin_bit_cast(int, x);
  return __builtin_bit_cast(float, __builtin_amdgcn_update_dpp(xi, xi, CTRL, ROWMASK, 0xF, false));
}
DEV float readlane_f(float x, int l) { return __builtin_bit_cast(float, __builtin_amdgcn_readlane(__builtin_bit_cast(int, x), l)); }
DEV int lane_id() { return (int)__builtin_amdgcn_mbcnt_hi(~0u, __builtin_amdgcn_mbcnt_lo(~0u, 0u)); }
DEV float writelane_f(float val, int l, float old) { return lane_id() == l ? val : old; }
DEV int writelane_i(int val, int l, int old) { return lane_id() == l ? val : old; }
DEV float wave_sum(float x) {
  x += dpp0<0x111, 0xF>(x); x += dpp0<0x112, 0xF>(x); x += dpp0<0x114, 0xF>(x); x += dpp0<0x118, 0xF>(x);
  x += dpp0<0x142, 0xA>(x); x += dpp0<0x143, 0xC>(x);
  return readlane_f(x, 63);
}
DEV float wave_max(float x) {
  x = fmaxf(x, dppself<0x111, 0xF>(x)); x = fmaxf(x, dppself<0x112, 0xF>(x)); x = fmaxf(x, dppself<0x114, 0xF>(x));
  x = fmaxf(x, dppself<0x118, 0xF>(x)); x = fmaxf(x, dppself<0x142, 0xA>(x)); x = fmaxf(x, dppself<0x143, 0xC>(x));
  return readlane_f(x, 63);
}
DEV float row16_sum(float x) {
  x += dpp0<0xB1, 0xF>(x); x += dpp0<0x4E, 0xF>(x); x += dpp0<0x141, 0xF>(x); x += dpp0<0x140, 0xF>(x);
  return x;
}
DEV float row16_max(float x) {
  x = fmaxf(x, dppself<0xB1, 0xF>(x)); x = fmaxf(x, dppself<0x4E, 0xF>(x)); x = fmaxf(x, dppself<0x141, 0xF>(x));
  x = fmaxf(x, dppself<0x140, 0xF>(x));
  return x;
}
DEV float quad_sum(float x) { x += dpp0<0xB1, 0xF>(x); x += dpp0<0x4E, 0xF>(x); return x; }

DEV f32x4 mfma16(bf16x8 a, bf16x8 b, f32x4 c) { return __builtin_amdgcn_mfma_f32_16x16x32_bf16(a, b, c, 0, 0, 0); }
DEV f32x16 mfma32(bf16x8 a, bf16x8 b, f32x16 c) { return __builtin_amdgcn_mfma_f32_32x32x16_bf16(a, b, c, 0, 0, 0); }


#define XB_TMO      128
#define XB_XCNT(j)  (256  + 64 * (j))
#define XB_XSUB(j)  (1280 + 64 * (j))
#define XB_XGEN(j)  (2304 + 64 * (j))
#define XB_TOP      3328
#define XB_TOPGEN   3392
#define XCD_BAR_WORDS 3456
#define XB_SPIN_CAP (1u << 23)
#define LAS __attribute__((address_space(3)))

__device__ __forceinline__ unsigned xb_ld(unsigned* p)              { return __hip_atomic_load(p, __ATOMIC_RELAXED, __HIP_MEMORY_SCOPE_AGENT); }
__device__ __forceinline__ unsigned xb_add(unsigned* p, unsigned v) { return __hip_atomic_fetch_add(p, v, __ATOMIC_RELAXED, __HIP_MEMORY_SCOPE_AGENT); }
__device__ __forceinline__ unsigned xb_xcc_id() { return (unsigned)__builtin_amdgcn_s_getreg((3 << 11) | 20) & 0xFu; }
#define XB_SPIN(cond, bar) do { unsigned _sp = 0; while (cond) { __builtin_amdgcn_s_sleep(1); \
    if ((++_sp & 255u) == 0u) { if (xb_ld(&(bar)[XB_TMO])) break; if (_sp > XB_SPIN_CAP) { atomicAdd(&(bar)[XB_TMO], 1u); break; } } } } while (0)

struct XcdBarrier {
    unsigned* bar; unsigned x;
    volatile LAS unsigned* st;
};
__device__ __forceinline__ XcdBarrier xcd_barrier_post(unsigned* bar, volatile LAS unsigned* st) {
    XcdBarrier b; b.bar = bar; b.x = xb_xcc_id(); b.st = st;
    if (threadIdx.x == 0) (void)xb_add(&bar[XB_XCNT(b.x)], 1u);
    return b;
}
__device__ __forceinline__ void xcd_barrier_complete(unsigned* bar, unsigned x, unsigned& nloc, unsigned& nx) {
    const unsigned G = gridDim.x * gridDim.y * gridDim.z;
    unsigned sum, cnt, mine, sp = 0u;
    for (;;) {
        sum = 0u; cnt = 0u; mine = 0u;
#pragma unroll
        for (unsigned j = 0; j < 16; ++j) { const unsigned c = xb_ld(&bar[XB_XCNT(j)]); sum += c; cnt += (c > 0u) ? 1u : 0u; mine = (j == x) ? c : mine; }
        if (sum == G) break;
        __builtin_amdgcn_s_sleep(1);
        if ((++sp & 255u) == 0u) { if (xb_ld(&bar[XB_TMO])) break; if (sp > XB_SPIN_CAP) { atomicAdd(&bar[XB_TMO], 1u); break; } }
    }
    nloc = mine > 0u ? mine : 1u; nx = cnt > 0u ? cnt : 1u;
}
__device__ __forceinline__ void xcd_barrier(const XcdBarrier& b) {
    asm volatile("s_waitcnt vmcnt(0)" ::: "memory");
    __syncthreads();
    if (threadIdx.x == 0) {
        unsigned* bar = b.bar;
        __builtin_amdgcn_s_waitcnt(0);
        unsigned nloc = b.st[0], nx = b.st[1];
        if (nloc == 0u) { xcd_barrier_complete(bar, b.x, nloc, nx); b.st[0] = nloc; b.st[1] = nx; }
        const unsigned old = xb_add(&bar[XB_XSUB(b.x)], 1u);
        const unsigned gen = old / nloc;
        if (old + 1u == (gen + 1u) * nloc) {
            __builtin_amdgcn_fence(__ATOMIC_RELEASE, "agent");
            asm volatile("s_waitcnt vmcnt(0)" ::: "memory");
            const unsigned og = xb_add(&bar[XB_TOP], 1u);
            const unsigned tg = og / nx;
            if (og + 1u == (tg + 1u) * nx) xb_add(&bar[XB_TOPGEN], 1u);
            else XB_SPIN(xb_ld(&bar[XB_TOPGEN]) == tg, bar);
            __builtin_amdgcn_fence(__ATOMIC_ACQUIRE, "agent");
            xb_add(&bar[XB_XGEN(b.x)], 1u);
            asm volatile("s_waitcnt vmcnt(0)" ::: "memory");
        } else {
            XB_SPIN(xb_ld(&bar[XB_XGEN(b.x)]) == gen, bar);
            __builtin_amdgcn_fence(__ATOMIC_ACQUIRE, "agent");
            asm volatile("s_waitcnt vmcnt(0)" ::: "memory");
        }
    }
    __syncthreads();
}

template <class Tp> DEV Tp* opq(Tp* q) { asm volatile("" : "+s"(q)); return q; }
DEV int tid_() { int t = threadIdx.x; asm volatile("" : "+v"(t)); return t; }
DEV int bid_() { int b = blockIdx.x; asm volatile("" : "+s"(b)); return b; }

DEV void glds16(const void* gsrc, char* lds_lane_ptr) {
  __builtin_amdgcn_global_load_lds((const unsigned*)gsrc, (__attribute__((address_space(3))) unsigned*)lds_lane_ptr, 16, 0, 0);
}
template <class Epi>
DEV void gemm_tile(const bf16_t* __restrict__ A, int lda, const bf16_t* __restrict__ Bt, int ldb, int K, char* smem, Epi& epi) {
  const int tid = tid_(), lane = tid & 63, wid = tid >> 6, wr = wid >> 1, wc = wid & 1, fr = lane & 15, fq = lane >> 4;
  f32x4 acc[4][4];
#pragma unroll
  for (int m = 0; m < 4; ++m)
#pragma unroll
    for (int n = 0; n < 4; ++n) acc[m][n] = (f32x4){0.f, 0.f, 0.f, 0.f};
  const int drow0 = 8 * wid + (lane >> 3), dpc = lane & 7;
  auto issue = [&](int kt, int buf) {
    char* sa = smem + buf * 32768;
    char* sb = sa + 16384;
#pragma unroll
    for (int i = 0; i < 4; ++i) {
      const int row = drow0 + 32 * i;
      const int kc = dpc ^ ((row >> 1) & 7);
      glds16(A + (size_t)row * lda + kt * 64 + kc * 8, sa + (i * 4 + wid) * 1024 + lane * 16);
      glds16(Bt + (size_t)row * ldb + kt * 64 + kc * 8, sb + (i * 4 + wid) * 1024 + lane * 16);
    }
  };
  __syncthreads();
  issue(0, 0);
  const int nk = K >> 6;
  const int sw = (fr >> 1) & 7;
  const int aoff = (wr * 64 + fr) * 128, boff = (wc * 64 + fr) * 128;
  for (int kt = 0; kt < nk; ++kt) {
    asm volatile("s_waitcnt vmcnt(0)" ::: "memory");
    __syncthreads();
    if (kt + 1 < nk) issue(kt + 1, (kt + 1) & 1);
    const char* sa = smem + (kt & 1) * 32768;
    const char* sb = sa + 16384;
    bf16x8 af[2][4], bfr[2][4];
#pragma unroll
    for (int kh = 0; kh < 2; ++kh) {
      const int pc = ((kh * 4 + fq) ^ sw) * 16;
#pragma unroll
      for (int m = 0; m < 4; ++m) af[kh][m] = *(const bf16x8*)(sa + aoff + m * 2048 + pc);
#pragma unroll
      for (int n = 0; n < 4; ++n) bfr[kh][n] = *(const bf16x8*)(sb + boff + n * 2048 + pc);
    }
    __builtin_amdgcn_sched_barrier(0);
    asm volatile("s_waitcnt lgkmcnt(8)" ::: "memory");
    __builtin_amdgcn_sched_barrier(0);
#pragma unroll
    for (int m = 0; m < 4; ++m)
#pragma unroll
      for (int n = 0; n < 4; ++n) acc[m][n] = mfma16(af[0][m], bfr[0][n], acc[m][n]);
    __builtin_amdgcn_sched_barrier(0);
    asm volatile("s_waitcnt lgkmcnt(0)" ::: "memory");
    __builtin_amdgcn_sched_barrier(0);
#pragma unroll
    for (int m = 0; m < 4; ++m)
#pragma unroll
      for (int n = 0; n < 4; ++n) acc[m][n] = mfma16(af[1][m], bfr[1][n], acc[m][n]);
  }
  __syncthreads();
  epi(acc, wr, wc, fr, fq, smem);
}
DEV void stage_tile_bf16(const f32x4 (&acc)[4][4], char* smem, int wid, int fr, int fq) {
  bf16_t (*t)[72] = (bf16_t (*)[72])(smem + wid * 9216);
#pragma unroll
  for (int m = 0; m < 4; ++m)
#pragma unroll
    for (int n = 0; n < 4; ++n)
#pragma unroll
      for (int j = 0; j < 4; ++j) t[m * 16 + fq * 4 + j][n * 16 + fr] = f2bf(acc[m][n][j]);
  asm volatile("s_waitcnt lgkmcnt(0)" ::: "memory");
}

DEV void ph_copy(const P& p) {
  const size_t n8 = (size_t)NTOK * D / 8;
  const float* pctx = opq(p.ctx); const float* px = opq(p.x);
  for (size_t i = (size_t)bid_() * 256 + tid_(); i < n8; i += (size_t)gridDim.x * 256) {
    size_t e = i * 8;
    int row = (int)(e / D), col = (int)(e % D);
    int b = row / LT, pp = row % LT;
    const float* src = pp < LC ? pctx + ((size_t)(b * LC + pp)) * D + col : px + ((size_t)(b * T + pp - LC)) * D + col;
    float4 v0 = *(const float4*)src, v1 = *(const float4*)(src + 4);
    uint4 o = make_uint4(pack2(v0.x, v0.y), pack2(v0.z, v0.w), pack2(v1.x, v1.y), pack2(v1.z, v1.w));
    *(uint4*)(p.X + e) = o;
  }
}

DEV void ph_rope(const P& p) {
  for (int i = bid_() * 256 + tid_(); i < 64 * 16; i += gridDim.x * 256) {
    int pos = i >> 4, k = i & 15;
    float inv = powf(10000.f, -(float)k / 16.f);
    float ang = (float)pos * inv;
    p.rope[2 * i] = cosf(ang); p.rope[2 * i + 1] = sinf(ang);
  }
}

DEV void modv_unit(const P& p, int unit, char* smem) {
  const int cc = unit % 24, layer = unit / 24;
  float (*cs)[128] = (float (*)[128])smem;
  const int col = cc * 256 + tid_();
  const float* pc = opq(p.c); const float* pcc = opq(p.c_ctx);
  float acc[17];
#pragma unroll
  for (int r = 0; r < 17; ++r) acc[r] = 0.f;
  for (int ks = 0; ks < 8; ++ks) {
    __syncthreads();
    for (int i = tid_(); i < 17 * 128; i += 256) {
      int r = i >> 7, e = i & 127;
      float v = r < 16 ? pc[r * D + ks * 128 + e] : pcc[ks * 128 + e];
      cs[r][e] = v / (1.f + expf(-v));
    }
    __syncthreads();
    const float* w = p.mod_w + ((size_t)layer * D + ks * 128) * 6144 + col;
#pragma unroll 4
    for (int e = 0; e < 128; ++e) {
      float wv = w[(size_t)e * 6144];
#pragma unroll
      for (int r = 0; r < 17; ++r) acc[r] += cs[r][e] * wv;
    }
  }
  const float bias = p.mod_b[layer * 6144 + col];
#pragma unroll
  for (int r = 0; r < 17; ++r) p.modv[((size_t)layer * 17 + r) * 6144 + col] = acc[r] + bias;
}

DEV void transpose_unit(const float* __restrict__ src, bf16_t* __restrict__ dst, int R, int C, int tile, char* smem) {
  float (*t)[65] = (float (*)[65])smem;
  const int nct = C / 64;
  const int tr = tile / nct, tc = tile % nct;
  __syncthreads();
  for (int i = tid_(); i < 4096; i += 256) { int r = i >> 6, c = i & 63; t[r][c] = src[(size_t)(tr * 64 + r) * C + tc * 64 + c]; }
  __syncthreads();
  for (int i = tid_(); i < 4096; i += 256) { int c = i >> 6, r = i & 63; dst[(size_t)(tc * 64 + c) * R + tr * 64 + r] = f2bf(t[r][c]); }
}

DEV void wfold_unit(const P& p, int layer, int unit, char* smem) {
  const int hs = unit >> 5, ec = unit & 31, h = hs >> 1, s = hs & 1;
  const float* wq = p.peer_wq + (size_t)layer * D * 2048;
  const float* kk = (s ? opq(p.peer_k2) : opq(p.peer_k1)) + ((size_t)layer * 8 + h) * 128 * 128;
  float (*kS)[65] = (float (*)[65])smem;
  float (*wS)[64] = (float (*)[64])(smem + 33280);
  const int key = tid_() & 127, eh = tid_() >> 7;
  float acc[16];
#pragma unroll
  for (int i = 0; i < 16; ++i) acc[i] = 0.f;
  for (int dh = 0; dh < 2; ++dh) {
    __syncthreads();
    for (int i = tid_(); i < 128 * 64; i += 256) { int k2 = i >> 6, d = i & 63; kS[k2][d] = kk[k2 * 128 + dh * 64 + d]; }
    for (int i = tid_(); i < 32 * 64; i += 256) {
      int e = i >> 6, d = i & 63;
      wS[e][d] = wq[(size_t)(ec * 32 + e) * 2048 + h * 256 + s * 128 + dh * 64 + d];
    }
    __syncthreads();
#pragma unroll 2
    for (int d = 0; d < 64; ++d) {
      float kv = kS[key][d];
#pragma unroll
      for (int i = 0; i < 16; ++i) acc[i] += kv * wS[eh * 16 + i][d];
    }
  }
  bf16_t* dst = p.Wft + ((size_t)(hs * 128 + key)) * D + ec * 32 + eh * 16;
#pragma unroll
  for (int i = 0; i < 16; i += 2) *(unsigned*)(dst + i) = pack2(acc[i], acc[i + 1]);
}

DEV void filt_unit(const P& p, int layer, int unit, char* smem) {
  int kind, j0, L;
  if (unit < 1024) { kind = 0; j0 = unit * 4; L = T; } else { kind = 1; j0 = (unit - 1024) * 4; L = LC; }
  float* zs = (float*)smem;
  float* h1 = zs + 4 * 36;
  float* h2 = h1 + 256;
  const int jj = tid_() >> 6, o = tid_() & 63;
  const int j = j0 + jj;
  const float fj = (float)j;
  const float t = fj / (float)(L - 1);
  __syncthreads();
  if (o < 33) {
    float z;
    if (o == 0) z = t;
    else {
      int i = (o - 1) & 15;
      float band = 1e-4f + (float)i * ((15.0f - 1e-4f) / 15.0f);
      float ang = 6.283185307179586f * fj * band / (float)L;
      z = (o <= 16) ? cosf(ang) : -sinf(ang);
    }
    zs[jj * 36 + o] = z;
  }
  __syncthreads();
  {
    const float* w1 = p.hy_w1 + layer * 33 * 64;
    float a = p.hy_b1[layer * 64 + o];
#pragma unroll 3
    for (int i = 0; i < 33; ++i) a += zs[jj * 36 + i] * w1[i * 64 + o];
    h1[jj * 64 + o] = sinf(p.hy_freq[layer * 128 + o] * a);
  }
  __syncthreads();
  {
    const float* w2 = p.hy_w2 + layer * 64 * 64;
    float a = p.hy_b2[layer * 64 + o];
#pragma unroll 4
    for (int i = 0; i < 64; ++i) a += h1[jj * 64 + i] * w2[i * 64 + o];
    h2[jj * 64 + o] = sinf(p.hy_freq[layer * 128 + 64 + o] * a);
  }
  __syncthreads();
  const float* w3 = p.hy_w3 + layer * 64 * 512;
  float* F = kind ? opq(p.FC) : opq(p.FL);
  const float DMIN = -3.0701134573253945f, DMAX = -15.350567286626973f;
#pragma unroll 1
  for (int m = 0; m < 4; ++m) {
    int c = o + 64 * m;
    float af = p.hy_b3[layer * 512 + c], ab = p.hy_b3[layer * 512 + 256 + c];
#pragma unroll 4
    for (int i = 0; i < 64; ++i) { float hv = h2[jj * 64 + i]; af += hv * w3[i * 512 + c]; ab += hv * w3[i * 512 + 256 + c]; }
    float delta = fabsf(DMIN + (float)c * ((DMAX - DMIN) / 255.f));
    float win = expf(-t * delta) + 0.05f;
    af *= win; ab *= win;
    F[((size_t)c * 2 + 0) * L + j] = af;
    F[((size_t)c * 2 + 1) * L + j] = ab;
  }
}

constexpr int PREP_T0 = 672, PREP_T1 = PREP_T0 + 256, PREP_T2 = PREP_T1 + 8, PREP_T3 = PREP_T2 + 8, PREP_T4 = PREP_T3 + 8;
constexpr int PREP_WF = PREP_T4 + 512, PREP_N = PREP_WF + 1088;
DEV void prep_unit(const P& p, int layer, int u, char* smem) {
  if (u < PREP_T0) transpose_unit(p.w_in + (size_t)layer * D * INW, p.W1t, D, INW, u, smem);
  else if (u < PREP_T1) transpose_unit(p.w_out + (size_t)layer * D * D, p.W2t, D, D, u - PREP_T0, smem);
  else if (u < PREP_T3) {
    const int u0 = u - PREP_T1;
    for (int i = tid_(); i < 64 * 256; i += 256) {
      const int np = u0 * 64 + (i >> 8), kp = i & 255;
      const int ps = np & 3, chan = np >> 2, qp = kp >> 6, kk = kp & 63;
      const int is_a = ps & 1, d = ps >> 1;
      float v = 0.f;
      if (qp == (is_a ? 2 + d : d)) v = (is_a ? opq(p.rw_a_up) : opq(p.rw_w_up))[(((size_t)layer * 2 + d) * 64 + kk) * 256 + chan];
      p.Wlt[(size_t)np * 256 + kp] = f2bf(v);
    }
  }
  else if (u < PREP_T4) transpose_unit(p.rw_g_up + (size_t)layer * 128 * 256, p.Wgt, 128, 256, u - PREP_T3, smem);
  else if (u < PREP_WF) wfold_unit(p, layer, u - PREP_T4, smem);
  else filt_unit(p, layer, u - PREP_WF, smem);
}
constexpr int PREPA_N = PREP_T0 + (PREP_T4 - PREP_T1);
DEV int prepA_unit_index(int i) { return i < PREP_T0 ? i : PREP_T1 + (i - PREP_T0); }
DEV void ph_prep(const P& p, int layer, char* smem, bool onlyB) {
  for (int u = bid_(); u < PREP_N; u += gridDim.x) {
    const bool isA = (u < PREP_T0) || (u >= PREP_T1 && u < PREP_T4);
    if (onlyB && isA) continue;
    prep_unit(p, layer, u, smem);
  }
}

DEV void wave_range(int& r0, int& r1, int ntok) {
  const int gw = (bid_() * 256 + tid_()) >> 6, nw = gridDim.x * 4;
  const int per = (ntok + nw - 1) / nw;
  r0 = gw * per; r1 = r0 + per; if (r1 > ntok) r1 = ntok;
}
DEV void ph_norm(const P& p, int layer, int which) {
  const int lane = tid_() & 63;
  int r0, r1;
  wave_range(r0, r1, NTOK);
  const float* g = (which ? p.norm2_g : p.norm1_g) + layer * D;
  float gv[16], scv[16], shv[16];
#pragma unroll
  for (int hh = 0; hh < 2; ++hh)
#pragma unroll
    for (int i = 0; i < 8; ++i) gv[hh * 8 + i] = g[hh * 512 + 8 * lane + i];
  int mr_cur = -1;
  uint4 n0 = make_uint4(0, 0, 0, 0), n1 = n0;
  if (r0 < r1) { const bf16_t* xr = p.X + (size_t)r0 * D; n0 = *(const uint4*)(xr + 8 * lane); n1 = *(const uint4*)(xr + 512 + 8 * lane); }
#pragma unroll 1
  for (int row = r0; row < r1; ++row) {
    const uint4 u0 = n0, u1 = n1;
    if (row + 1 < r1) { const bf16_t* xr = p.X + (size_t)(row + 1) * D; n0 = *(const uint4*)(xr + 8 * lane); n1 = *(const uint4*)(xr + 512 + 8 * lane); }
    const int b = row / LT, pp = row % LT;
    const int mr = pp < LC ? 16 : b;
    if (mr != mr_cur) {
      mr_cur = mr;
      const float* mv = p.modv + ((size_t)layer * 17 + mr) * 6144 + (which ? 3072 : 0);
#pragma unroll
      for (int hh = 0; hh < 2; ++hh)
#pragma unroll
        for (int i = 0; i < 8; ++i) { shv[hh * 8 + i] = mv[hh * 512 + 8 * lane + i]; scv[hh * 8 + i] = 1.f + mv[1024 + hh * 512 + 8 * lane + i]; }
    }
    float v[16];
    unpack8(u0, v); unpack8(u1, v + 8);
    float ss = 0.f;
#pragma unroll
    for (int i = 0; i < 16; ++i) ss += v[i] * v[i];
    ss = wave_sum(ss);
    const float rstd = rsqrtf(ss * (1.f / 1024.f) + 1e-6f);
    float o[16];
#pragma unroll
    for (int i = 0; i < 16; ++i) o[i] = (v[i] * rstd * gv[i]) * scv[i] + shv[i];
    bf16_t* hr = p.H + (size_t)row * D;
    *(uint4*)(hr + 8 * lane) = pack8(o);
    *(uint4*)(hr + 512 + 8 * lane) = pack8(o + 8);
    if (which) {
      float am = 0.f;
#pragma unroll
      for (int i = 0; i < 16; ++i) am = fmaxf(am, fabsf(o[i]));
      am = wave_max(am);
      const float sc = am > 0.f ? 127.f / am : 1.f;
      unsigned char* h8 = p.H8 + (size_t)row * 1024;
      *(uint2*)(h8 + 8 * lane) = make_uint2((unsigned)pack_i8(o[0] * sc, o[1] * sc, o[2] * sc, o[3] * sc), (unsigned)pack_i8(o[4] * sc, o[5] * sc, o[6] * sc, o[7] * sc));
      *(uint2*)(h8 + 512 + 8 * lane) = make_uint2((unsigned)pack_i8(o[8] * sc, o[9] * sc, o[10] * sc, o[11] * sc), (unsigned)pack_i8(o[12] * sc, o[13] * sc, o[14] * sc, o[15] * sc));
      if (lane == 0) p.HINV[row] = am > 0.f ? am * (1.f / 127.f) : 1.f;
    }
  }
}

DEV bool gemm_unit(int it, int nct, int& rt, int& ct) {
  const int nslot = gridDim.x >> 3;
  const int x = bid_() & 7, sl = bid_() >> 3;
  if (sl >= nslot) return false;
  const int v = it * nslot + sl;
  if (v >= 68 * nct) return false;
  const int rg = v / (8 * nct), rem = v - rg * 8 * nct;
  const int rows = (rg == 8) ? 4 : 8;
  ct = rem / rows;
  rt = x * 68 + rg * 8 + (rem - ct * rows);
  return true;
}
struct Epi1 {
  const P& p; int row0, col0;
  DEV void operator()(f32x4 (&acc)[4][4], int wr, int wc, int fr, int fq, char* smem) const {
    const int cw = col0 + wc * 64;
    const int rbase = row0 + wr * 64;
    const bool lat = (row0 % LT) >= LC;
    if (cw >= 1536 && cw < 1664) {
#pragma unroll
      for (int m = 0; m < 4; ++m)
#pragma unroll
        for (int n = 0; n < 4; ++n)
#pragma unroll
          for (int j = 0; j < 4; ++j) acc[m][n][j] = 2.f * sigmoidf_(2.f * acc[m][n][j]) - 1.f;
    } else if (cw >= 1792 && cw < 1920) {
#pragma unroll
      for (int m = 0; m < 4; ++m)
#pragma unroll
        for (int n = 0; n < 4; ++n)
#pragma unroll
          for (int j = 0; j < 4; ++j) acc[m][n][j] = sigmoidf_(acc[m][n][j]);
    } else if (cw >= 1920 && cw < 2560 && lat) {
#pragma unroll
      for (int m = 0; m < 4; ++m)
#pragma unroll
        for (int j = 0; j < 4; ++j) {
          int row = rbase + m * 16 + fq * 4 + j;
          int pl = (row % LT) - LC;
          int ri = pl >> 6, ci = pl & 63;
          float2 cr = *(const float2*)(p.rope + 2 * (ri * 16 + fr));
          float2 cc = *(const float2*)(p.rope + 2 * (ci * 16 + fr));
          float x1 = acc[m][0][j], x2 = acc[m][1][j];
          acc[m][0][j] = x1 * cr.x - x2 * cr.y; acc[m][1][j] = x2 * cr.x + x1 * cr.y;
          x1 = acc[m][2][j]; x2 = acc[m][3][j];
          acc[m][2][j] = x1 * cc.x - x2 * cc.y; acc[m][3][j] = x2 * cc.x + x1 * cc.y;
        }
    }
    const int wid = wr * 2 + wc, lane = fq * 16 + fr;
    stage_tile_bf16(acc, smem, wid, fr, fq);
    const bf16_t (*t)[72] = (const bf16_t (*)[72])(smem + wid * 9216);
#pragma unroll
    for (int i = 0; i < 8; ++i) {
      const int rl = i * 8 + (lane >> 3), ch = lane & 7;
      *(uint4*)(p.Z + (size_t)(rbase + rl) * INW + cw + ch * 8) = *(const uint4*)&t[rl][ch * 8];
    }
  }
};
DEV void ph_gemm1(const P& p, char* smem) {
  const int nct = INW / 128;
  int rt, ct;
  for (int it = 0; gemm_unit(it, nct, rt, ct); ++it) {
    Epi1 epi{p, rt * 128, ct * 128};
    gemm_tile(p.H + (size_t)rt * 128 * D, D, p.W1t + (size_t)ct * 128 * D, D, D, smem, epi);
  }
}

struct EpiLoraA {
  const P& p; int layer, row0, col0;
  DEV void operator()(f32x4 (&acc)[4][4], int wr, int wc, int fr, int fq, char* smem) const {
    const int ps = fr & 3, is_a = ps & 1, dd = ps >> 1;
    const float scale = is_a ? 1.f : 0.6065306597126334f;
    const float* bias0 = (is_a ? opq(p.rw_a0) : opq(p.rw_w0)) + (layer * 2 + dd) * 256;
#pragma unroll
    for (int n = 0; n < 4; ++n) {
      const int chan = (col0 + wc * 64 + n * 16 + fr) >> 2;
      const float bias = bias0[chan];
#pragma unroll
      for (int m = 0; m < 4; ++m)
#pragma unroll
        for (int j = 0; j < 4; ++j) acc[m][n][j] = scale * sigmoidf_(acc[m][n][j] + bias);
    }
    const int wid = wr * 2 + wc, lane = fq * 16 + fr;
    stage_tile_bf16(acc, smem, wid, fr, fq);
    const bf16_t (*t)[72] = (const bf16_t (*)[72])(smem + wid * 9216);
#pragma unroll
    for (int i = 0; i < 8; ++i) {
      const int rl = i * 8 + (lane >> 3), ch = lane & 7;
      *(uint4*)(p.SC + (size_t)(row0 + wr * 64 + rl) * 1024 + col0 + wc * 64 + ch * 8) = *(const uint4*)&t[rl][ch * 8];
    }
  }
};
struct EpiLoraG {
  const P& p; int row0, col0;
  DEV void operator()(f32x4 (&acc)[4][4], int wr, int wc, int fr, int fq, char* smem) const {
    const int wid = wr * 2 + wc, lane = fq * 16 + fr;
    stage_tile_bf16(acc, smem, wid, fr, fq);
    const bf16_t (*t)[72] = (const bf16_t (*)[72])(smem + wid * 9216);
#pragma unroll
    for (int i = 0; i < 8; ++i) {
      const int rl = i * 8 + (lane >> 3), ch = lane & 7;
      *(uint4*)(p.Y + (size_t)(row0 + wr * 64 + rl) * D + 256 + col0 + wc * 64 + ch * 8) = *(const uint4*)&t[rl][ch * 8];
    }
  }
};
DEV void ph_lora(const P& p, int layer, char* smem) {
  int rt, ct;
  for (int it = 0; gemm_unit(it, 10, rt, ct); ++it) {
    if (ct < 8) {
      EpiLoraA epi{p, layer, rt * 128, ct * 128};
      gemm_tile(p.Z + (size_t)rt * 128 * INW + 1536, INW, p.Wlt + (size_t)ct * 128 * 256, 256, 256, smem, epi);
    } else {
      EpiLoraG epi{p, rt * 128, (ct - 8) * 128};
      gemm_tile(p.Z + (size_t)rt * 128 * INW + 1792, INW, p.Wgt + (size_t)(ct - 8) * 128 * 128, 128, 128, smem, epi);
    }
  }
}

DEV void ph_rwkv_prep(const P& p, int layer) {
  const int lane = tid_() & 63;
  int r0, r1;
  wave_range(r0, r1, NTOK);
  const float* cw = p.conv_w + (size_t)layer * 3 * 1536;
  const float* cb = p.conv_b + (size_t)layer * 1536;
  float w0[3][4], w1[3][4], w2[3][4], bb[3][4], kkw[4];
#pragma unroll
  for (int a = 0; a < 3; ++a)
#pragma unroll
    for (int i = 0; i < 4; ++i) {
      const int col = 768 + a * 256 + 4 * lane + i;
      w0[a][i] = cw[col]; w1[a][i] = cw[1536 + col]; w2[a][i] = cw[3072 + col]; bb[a][i] = cb[col];
    }
#pragma unroll
  for (int i = 0; i < 4; ++i) kkw[i] = p.rw_k_k[layer * 256 + 4 * lane + i];
  uint2 zm[3], zc[3], zp[3];
  auto ldz = [&](int row, uint2 (&z)[3]) {
#pragma unroll
    for (int a = 0; a < 3; ++a) z[a] = *(const uint2*)(p.Z + (size_t)row * INW + 768 + a * 256 + 4 * lane);
  };
  auto zero3 = [&](uint2 (&z)[3]) {
#pragma unroll
    for (int a = 0; a < 3; ++a) z[a] = make_uint2(0u, 0u);
  };
  if (r0 < r1) {
    if (r0 > 0) ldz(r0 - 1, zm); else zero3(zm);
    ldz(r0, zc);
  }
#pragma unroll 1
  for (int row = r0; row < r1; ++row) {
    if (row + 1 < NTOK) ldz(row + 1, zp); else zero3(zp);
    const int pp = row % LT;
    const bool hasm = (pp != 0) && (pp != LC);
    const bool hasp = (pp != LC - 1) && (pp != LT - 1);
    float res[3][4];
#pragma unroll
    for (int a = 0; a < 3; ++a) {
      const uint2 um = hasm ? zm[a] : make_uint2(0u, 0u), uc = zc[a], up = hasp ? zp[a] : make_uint2(0u, 0u);
      const float vm[4] = {bflo(um.x), bfhi(um.x), bflo(um.y), bfhi(um.y)};
      const float vc[4] = {bflo(uc.x), bfhi(uc.x), bflo(uc.y), bfhi(uc.y)};
      const float vp[4] = {bflo(up.x), bfhi(up.x), bflo(up.y), bfhi(up.y)};
#pragma unroll
      for (int i = 0; i < 4; ++i) res[a][i] = w0[a][i] * vm[i] + w1[a][i] * vc[i] + w2[a][i] * vp[i] + bb[a][i];
    }
    float kk[4], ss = 0.f;
#pragma unroll
    for (int i = 0; i < 4; ++i) { kk[i] = res[1][i] * kkw[i]; ss += kk[i] * kk[i]; }
    ss = row16_sum(ss);
    const float rs = rsqrtf(ss + 1e-12f);
    bf16_t* hr = p.H + (size_t)row * D + 16 * lane;
    *(uint4*)hr = make_uint4(pack2(res[0][0], res[1][0]), pack2(kk[0] * rs, res[2][0]), pack2(res[0][1], res[1][1]), pack2(kk[1] * rs, res[2][1]));
    *(uint4*)(hr + 8) = make_uint4(pack2(res[0][2], res[1][2]), pack2(kk[2] * rs, res[2][2]), pack2(res[0][3], res[1][3]), pack2(kk[3] * rs, res[2][3]));
#pragma unroll
    for (int a = 0; a < 3; ++a) { zm[a] = zc[a]; zc[a] = zp[a]; }
  }
}

DEV float oct_sum(float x) { x += dpp0<0xB1, 0xF>(x); x += dpp0<0x4E, 0xF>(x); x += dpp0<0x141, 0xF>(x); return x; }
DEV bf16x8 frag_join(uint2 lo, uint2 hi) { uint4 w = make_uint4(lo.x, lo.y, hi.x, hi.y); return __builtin_bit_cast(bf16x8, w); }
constexpr int SCS_SET = 17152, SCS_IMG = 3 * SCS_SET, SCS_W0 = SCS_IMG + 2 * 3072;
DEV void scanc_unit(const P& p, int layer, int unit, char* smem) {
  const int dir = unit & 1, h = (unit >> 1) & 3, b = unit >> 3;
  const int tid = tid_(), lane = tid & 63, fr = lane & 15, fq = lane >> 4;
  const int w = __builtin_amdgcn_readfirstlane(tid >> 6);
  bf16_t* IMG0 = (bf16_t*)(smem + SCS_W0);
  bf16_t* IMG1 = IMG0 + 512;
  bf16_t* IMG2 = IMG0 + 1024;
  __syncthreads();
  for (int i = tid; i < (2 * 3072 + 3072) / 4; i += 256) ((unsigned*)(smem + SCS_IMG))[i] = 0u;
  const float ka = p.rw_k_a[layer * 256 + h * 64 + lane];
  const size_t rowbase = (size_t)b * LT;
  const char* hbase = (const char*)p.H;
  const char* sbase = (const char*)p.SC;
  const unsigned hoff = (unsigned)(rowbase * 2048) + (unsigned)((h * 64 + lane) * 8);
  const unsigned soff = hoff + 4u * (unsigned)dir;
  bf16_t* yb = p.Z + rowbase * INW + 768 + dir * 256 + h * 64 + w * 16 + fr;
  auto pos0 = [&](int c) -> int { const int t = c * 16; return dir == 0 ? t : (t < LC ? LC - 1 - t : LT - 1 - (t - LC)); };
  const int pstep = dir == 0 ? 1 : -1;
  constexpr int NCH = LT / 16;
  struct Raw { unsigned sc[16]; uint2 hr[6]; };
  auto load_raw = [&](int c, Raw& rw) {
    if (w != 0) {
      const int p0 = pos0(c);
      const unsigned so = soff + (unsigned)(p0 * 2048);
      const int st = pstep * 2048;
#pragma unroll
      for (int i = 0; i < 16; ++i) rw.sc[i] = *(const unsigned*)(sbase + (so + (unsigned)(i * st)));
      const unsigned ho = hoff + (unsigned)((p0 + pstep * (w - 1)) * 2048);
#pragma unroll
      for (int q = 0; q < 6; ++q) {
        const int qq = ((w - 1) + 3 * q < 16) ? q : 4;
        rw.hr[q] = *(const uint2*)(hbase + (ho + (unsigned)(qq * 3 * st)));
      }
    }
  };
  auto stage1w = [&](int set, const Raw& rw, auto W1tag) {
    constexpr int W1 = decltype(W1tag)::value;
    char* base = smem + set * SCS_SET;
    bf16_t (*At)[72] = (bf16_t (*)[72])(base);
    bf16_t (*Rt)[72] = (bf16_t (*)[72])(base + 2304);
    bf16_t (*Bt)[72] = (bf16_t (*)[72])(base + 4608);
    bf16_t (*Kt)[72] = (bf16_t (*)[72])(base + 6912);
    bf16_t (*BKT)[36] = (bf16_t (*)[36])(base + 9216);
    bf16_t* VV = (bf16_t*)(base + 13824);
    float* G16 = (float*)(base + 16896);
    float Erun = 0.f;
#pragma unroll
    for (int i = 0; i < 16; ++i) {
      const float ev = bflo(rw.sc[i]);
      const float Eprev = Erun;
      Erun += ev;
      if ((i % 3) == W1) {
        const uint2 hrec = rw.hr[i / 3];
        const float rr = bflo(hrec.x), kr = bfhi(hrec.x), kkv = bflo(hrec.y);
        const float av = bfhi(rw.sc[i]);
        const float gp = __expf(-Eprev), gi = __expf(-Erun), ig = __expf(Erun);
        const float at = -kkv * gp, rt = rr * gi, bt = kkv * av * ig, kt2 = kr * (1.f + (av - 1.f) * ka) * ig;
        const unsigned ar = pack2(at, rt), bk = pack2(bt, kt2);
        At[i][lane] = (bf16_t)(ar & 0xFFFFu); Rt[i][lane] = (bf16_t)(ar >> 16);
        Bt[i][lane] = (bf16_t)(bk & 0xFFFFu); Kt[i][lane] = (bf16_t)(bk >> 16);
        BKT[lane][(i >> 2) * 8 + (i & 3)] = (bf16_t)(bk & 0xFFFFu);
        BKT[lane][(i >> 2) * 8 + 4 + (i & 3)] = (bf16_t)(bk >> 16);
        VV[((i >> 2) * 64 + lane) * 6 + (i & 3)] = (bf16_t)(hrec.y >> 16);
        if (i == 15) G16[lane] = gi;
      }
    }
  };
  auto stage1 = [&](int set, const Raw& rw) {
    if (w == 1) stage1w(set, rw, std::integral_constant<int, 0>{});
    else if (w == 2) stage1w(set, rw, std::integral_constant<int, 1>{});
    else if (w == 3) stage1w(set, rw, std::integral_constant<int, 2>{});
  };
  auto stage2 = [&](int set, int iset) {
    char* base = smem + set * SCS_SET;
    const bf16_t (*At)[72] = (const bf16_t (*)[72])(base);
    const bf16_t (*Rt)[72] = (const bf16_t (*)[72])(base + 2304);
    const bf16_t (*Bt)[72] = (const bf16_t (*)[72])(base + 4608);
    const bf16_t (*Kt)[72] = (const bf16_t (*)[72])(base + 6912);
    bf16_t* TT = (bf16_t*)(smem + SCS_IMG + iset * 3072);
    bf16_t* ARK = TT + 512;
    bf16_t* AAK = TT + 1024;
    const bf16_t (*X)[72] = (w < 2) ? At : Rt;
    const bf16_t (*Y)[72] = (w & 1) ? Kt : Bt;
    f32x4 cm = (f32x4){0.f, 0.f, 0.f, 0.f};
#pragma unroll
    for (int s = 0; s < 2; ++s) {
      bf16x8 af = *(const bf16x8*)&X[fr][32 * s + 8 * fq];
      bf16x8 bm = *(const bf16x8*)&Y[fr][32 * s + 8 * fq];
      cm = mfma16(af, bm, cm);
    }
#pragma unroll
    for (int jj = 0; jj < 4; ++jj) {
      const int i = 4 * fq + jj;
      const bool keep = (w < 2) ? (fr < i) : (fr <= i);
      cm[jj] = keep ? cm[jj] : 0.f;
    }
    const int io = (fr >> 2) * 8 + (fr & 3);
    auto wr_img = [&](bf16_t* img, const f32x4& Xv, int hi) {
#pragma unroll
      for (int jj = 0; jj < 4; ++jj) img[(4 * fq + jj) * 32 + io + hi] = f2bf(Xv[jj]);
    };
    if (w == 1) wr_img(AAK, cm, 0);
    else if (w == 2) wr_img(ARK, cm, 0);
    else if (w == 3) wr_img(ARK, cm, 4);
    else {
      auto bfrag = [&](const f32x4& Xv) { return frag_join(make_uint2(pack2(Xv[0], Xv[1]), pack2(Xv[2], Xv[3])), make_uint2(0u, 0u)); };
      auto afr = [&](const bf16_t* img) { return *(const bf16x8*)&img[(fr * 4 + fq) * 8]; };
      const f32x4 Z4 = (f32x4){0.f, 0.f, 0.f, 0.f};
      wr_img(IMG0, cm, 0);
      asm volatile("" ::: "memory");
      f32x4 A2 = mfma16(afr(IMG0), bfrag(cm), Z4);
      wr_img(IMG1, A2, 0);
      asm volatile("" ::: "memory");
      f32x4 A4 = mfma16(afr(IMG1), bfrag(A2), Z4);
      wr_img(IMG2, A4, 0);
      asm volatile("" ::: "memory");
      f32x4 Rm = mfma16(afr(IMG2), bfrag(A4), Z4);
#pragma unroll
      for (int jj = 0; jj < 4; ++jj) Rm[jj] += (fr == 4 * fq + jj) ? 1.f : 0.f;
      Rm = mfma16(afr(IMG2), bfrag(Rm), Rm);
      Rm = mfma16(afr(IMG1), bfrag(Rm), Rm);
      Rm = mfma16(afr(IMG0), bfrag(Rm), Rm);
      wr_img(TT, Rm, 0);
    }
  };
  f32x4 acc[4];
#pragma unroll
  for (int kt = 0; kt < 4; ++kt) acc[kt] = (f32x4){0.f, 0.f, 0.f, 0.f};
  auto part2 = [&](int c, int set, int iset) {
    char* base = smem + set * SCS_SET;
    const bf16_t (*At)[72] = (const bf16_t (*)[72])(base);
    const bf16_t (*Rt)[72] = (const bf16_t (*)[72])(base + 2304);
    const bf16_t (*BKT)[36] = (const bf16_t (*)[36])(base + 9216);
    const bf16_t* VV = (const bf16_t*)(base + 13824);
    const float* G16 = (const float*)(base + 16896);
    const bf16_t* TT = (const bf16_t*)(smem + SCS_IMG + iset * 3072);
    const bf16_t* ARK = TT + 512;
    const bf16_t* AAK = TT + 1024;
    bf16x8 Sb[2];
#pragma unroll
    for (int s = 0; s < 2; ++s) {
      uint4 t = make_uint4(pack2(acc[2 * s][0], acc[2 * s][1]), pack2(acc[2 * s][2], acc[2 * s][3]),
                           pack2(acc[2 * s + 1][0], acc[2 * s + 1][1]), pack2(acc[2 * s + 1][2], acc[2 * s + 1][3]));
      Sb[s] = __builtin_bit_cast(bf16x8, t);
    }
    const unsigned* vvp = (const unsigned*)&VV[(fq * 64 + w * 16 + fr) * 6];
    const uint2 vv = make_uint2(vvp[0], vvp[1]);
    const bf16x8 Vlow = frag_join(vv, make_uint2(0u, 0u));
    f32x4 Pm = (f32x4){0.f, 0.f, 0.f, 0.f};
#pragma unroll
    for (int s = 0; s < 2; ++s) {
      bf16x8 af = frag_join(*(const uint2*)&At[fr][32 * s + 4 * fq], *(const uint2*)&At[fr][32 * s + 16 + 4 * fq]);
      Pm = mfma16(af, Sb[s], Pm);
    }
    Pm = mfma16(*(const bf16x8*)&AAK[(fr * 4 + fq) * 8], Vlow, Pm);
    const bf16x8 Pb = frag_join(make_uint2(pack2(Pm[0], Pm[1]), pack2(Pm[2], Pm[3])), make_uint2(0u, 0u));
    f32x4 U = mfma16(*(const bf16x8*)&TT[(fr * 4 + fq) * 8], Pb, (f32x4){0.f, 0.f, 0.f, 0.f});
    const bf16x8 UV = frag_join(make_uint2(pack2(U[0], U[1]), pack2(U[2], U[3])), vv);
    f32x4 Yv = (f32x4){0.f, 0.f, 0.f, 0.f};
#pragma unroll
    for (int s = 0; s < 2; ++s) {
      bf16x8 af = frag_join(*(const uint2*)&Rt[fr][32 * s + 4 * fq], *(const uint2*)&Rt[fr][32 * s + 16 + 4 * fq]);
      Yv = mfma16(af, Sb[s], Yv);
    }
    Yv = mfma16(*(const bf16x8*)&ARK[(fr * 4 + fq) * 8], UV, Yv);
    {
      const int p0 = pos0(c);
#pragma unroll
      for (int jj = 0; jj < 4; ++jj) yb[(size_t)(p0 + pstep * (4 * fq + jj)) * INW] = f2bf(Yv[jj]);
    }
#pragma unroll
    for (int kt = 0; kt < 4; ++kt) {
      f32x4 t = mfma16(frag_join(*(const uint2*)&BKT[16 * kt + fr][fq * 8], *(const uint2*)&BKT[16 * kt + fr][fq * 8 + 4]), UV, acc[kt]);
      const float4 g4 = *(const float4*)&G16[16 * kt + 4 * fq];
      t[0] *= g4.x; t[1] *= g4.y; t[2] *= g4.z; t[3] *= g4.w;
      acc[kt] = t;
    }
  };
  __builtin_amdgcn_s_setprio(3);
  Raw r0, r1;
  load_raw(0, r0); load_raw(1, r1);
  stage1(0, r0);
  load_raw(2, r0);
  __syncthreads();
  stage2(0, 0);
  stage1(1, r1);
  load_raw(3, r1);
  __syncthreads();
  int s0 = 0, s1 = 1, s2 = 2;
  auto iter = [&](int c, Raw& rw) {
    if (c + 1 < NCH) stage2(s1, (c + 1) & 1);
    part2(c, s0, c & 1);
    if (c + 2 < NCH) {
      stage1(s2, rw);
      if (c + 4 < NCH) load_raw(c + 4, rw);
    }
    asm volatile("s_waitcnt lgkmcnt(0)" ::: "memory");
    __builtin_amdgcn_s_barrier();
    asm volatile("" ::: "memory");
    const int t = s0; s0 = s1; s1 = s2; s2 = t;
  };
#pragma unroll 1
  for (int c = 0; c < NCH; c += 2) {
    iter(c, r0); iter(c + 1, r1);
  }
  __builtin_amdgcn_s_setprio(0);
}

DEV void ph_rwkv_post(const P& p, int layer) {
  const int lane = tid_() & 63;
  int r0, r1;
  wave_range(r0, r1, NTOK);
  const int ch = 4 * lane;
  float kav[4], rkv[4], lnw[4], lnb[4];
#pragma unroll
  for (int i = 0; i < 4; ++i) {
    kav[i] = p.rw_k_a[layer * 256 + ch + i]; rkv[i] = p.rw_r_k[layer * 256 + ch + i];
    lnw[i] = p.rw_ln_w[layer * 256 + ch + i]; lnb[i] = p.rw_ln_b[layer * 256 + ch + i];
  }
  struct In { uint2 y0, y1, g; uint4 h0, h1, s0, s1; };
  auto ld = [&](int row, In& in) {
    const bf16_t* zr = p.Z + (size_t)row * INW + 768 + ch;
    in.y0 = *(const uint2*)zr; in.y1 = *(const uint2*)(zr + 256);
    const bf16_t* hr = p.H + (size_t)row * D + 4 * ch;
    in.h0 = *(const uint4*)hr; in.h1 = *(const uint4*)(hr + 8);
    const bf16_t* sr = p.SC + (size_t)row * 1024 + 4 * ch;
    in.s0 = *(const uint4*)sr; in.s1 = *(const uint4*)(sr + 8);
    in.g = *(const uint2*)(p.Y + (size_t)row * D + 256 + ch);
  };
  In nx;
  if (r0 < r1) ld(r0, nx);
#pragma unroll 1
  for (int row = r0; row < r1; ++row) {
    const In in = nx;
    if (row + 1 < r1) ld(row + 1, nx);
    float y[4] = {bflo(in.y0.x) + bflo(in.y1.x), bfhi(in.y0.x) + bfhi(in.y1.x), bflo(in.y0.y) + bflo(in.y1.y), bfhi(in.y0.y) + bfhi(in.y1.y)};
    const float mu = row16_sum(y[0] + y[1] + y[2] + y[3]) * (1.f / 64.f);
    float vs = 0.f;
#pragma unroll
    for (int i = 0; i < 4; ++i) { y[i] -= mu; vs += y[i] * y[i]; }
    const float var = row16_sum(vs) * (1.f / 64.f);
    const float rstd = rsqrtf(var + 64e-5f);
    const float r[4] = {bflo(in.h0.x), bflo(in.h0.z), bflo(in.h1.x), bflo(in.h1.z)};
    const float k[4] = {bfhi(in.h0.x), bfhi(in.h0.z), bfhi(in.h1.x), bfhi(in.h1.z)};
    const float v[4] = {bfhi(in.h0.y), bfhi(in.h0.w), bfhi(in.h1.y), bfhi(in.h1.w)};
    const float a0[4] = {bfhi(in.s0.x), bfhi(in.s0.z), bfhi(in.s1.x), bfhi(in.s1.z)};
    const float a1[4] = {bfhi(in.s0.y), bfhi(in.s0.w), bfhi(in.s1.y), bfhi(in.s1.w)};
    float sd = 0.f;
#pragma unroll
    for (int i = 0; i < 4; ++i) {
      const float kd0 = k[i] * (1.f + (a0[i] - 1.f) * kav[i]), kd1 = k[i] * (1.f + (a1[i] - 1.f) * kav[i]);
      sd += r[i] * (kd0 + kd1) * rkv[i];
    }
    sd = row16_sum(sd);
    const float g[4] = {bflo(in.g.x), bfhi(in.g.x), bflo(in.g.y), bfhi(in.g.y)};
    float o[4];
#pragma unroll
    for (int i = 0; i < 4; ++i) {
      const float yn = y[i] * rstd * lnw[i] + lnb[i];
      o[i] = (yn + sd * v[i]) * g[i];
    }
    *(uint2*)(p.Y + (size_t)row * D + 256 + ch) = make_uint2(pack2(o[0], o[1]), pack2(o[2], o[3]));
  }
}

DEV void hyena_pre_unit(const P& p, int layer, int unit) {
  int kind, b, t0, L;
  if (unit < 1024) { kind = 0; b = unit >> 6; t0 = (unit & 63) * 64; L = T; } else { int u = unit - 1024; kind = 1; b = u >> 2; t0 = (u & 3) * 64; L = LC; }
  const int c = tid_();
  const size_t row0 = (size_t)b * LT + (kind ? 0 : LC);
  const float* cw = p.conv_w + (size_t)layer * 3 * 1536;
  const float* cb = p.conv_b + (size_t)layer * 1536;
  const float w1a = cw[256 + c], w1b = cw[1536 + 256 + c], w1c = cw[3072 + 256 + c], b1 = cb[256 + c];
  const float w2a = cw[512 + c], w2b = cw[1536 + 512 + c], w2c = cw[3072 + 512 + c], b2 = cb[512 + c];
  auto ld = [&](int t, int col) -> float { return (t >= 0 && t < L) ? bf2f(p.Z[(row0 + t) * INW + col]) : 0.f; };
  float x1m = ld(t0 - 1, 256 + c), x1c = ld(t0, 256 + c), vm = ld(t0 - 1, 512 + c), vc = ld(t0, 512 + c);
  bf16_t* dst = (kind ? opq(p.UTc) : opq(p.UTl)) + ((size_t)c * 16 + b) * L + t0;
#pragma unroll 1
  for (int i8 = 0; i8 < 8; ++i8) {
    float uo[8];
#pragma unroll
    for (int i = 0; i < 8; ++i) {
      int t = t0 + i8 * 8 + i;
      float x1n = ld(t + 1, 256 + c), vn = ld(t + 1, 512 + c);
      float a = w1a * x1m + w1b * x1c + w1c * x1n + b1;
      float bb = w2a * vm + w2b * vc + w2c * vn + b2;
      uo[i] = a * bb;
      x1m = x1c; x1c = x1n; vm = vc; vc = vn;
    }
    *(uint4*)(dst + 8 * i8) = pack8(uo);
  }
}

DEV void hyena_conv_unit(const P& p, int layer, int unit, char* smem) {
  int kind, c, tb, L;
  if (unit < 4096) { kind = 0; c = unit >> 4; tb = (unit & 15) * 256; L = T; } else { kind = 1; c = unit - 4096; tb = 0; L = LC; }
  const int tid = tid_(), lane = tid & 63, wid = tid >> 6, fr = lane & 15, fq = lane >> 4;
  float* red = (float*)(smem + 2 * 16512);
  const float* F = (kind ? opq(p.FC) : opq(p.FL)) + (size_t)c * 2 * L;
  float scale;
  {
    float part = 0.f;
    for (int i = tid; i < 2 * L; i += 256) { float fv = F[i]; part += (i != L) ? fv * fv : 0.f; }
    part = wave_sum(part);
    __syncthreads();
    if (lane == 0) red[wid] = part;
    __syncthreads();
    scale = rsqrtf(((red[0] + red[1]) + (red[2] + red[3])) + 1e-6f);
  }
  const bf16_t* U = (kind ? opq(p.UTc) : opq(p.UTl)) + (size_t)c * 16 * L;
  f32x4 acc[4];
#pragma unroll
  for (int m = 0; m < 4; ++m) acc[m] = (f32x4){0.f, 0.f, 0.f, 0.f};
  const int nch = L / 256;
  float fw0, fw1, fw2;
  uint4 ru0, ru1;
  auto ldchunk = [&](int ch) {
    const int sc = ch * 256;
    const int D0 = tb + 256 - sc;
    auto tap = [&](int n) -> float {
      int d = D0 - n;
      float v = 0.f;
      if (d > -L && d < L) v = (d >= 0 ? F[d] : F[L - d]);
      return v;
    };
    fw0 = tap(tid); fw1 = tap(tid + 256); fw2 = (tid < 8) ? tap(tid + 512) : 0.f;
    const int bb = tid >> 4, sg0 = tid & 15;
    ru0 = *(const uint4*)(U + (size_t)bb * L + sc + 8 * sg0);
    ru1 = *(const uint4*)(U + (size_t)bb * L + sc + 8 * (sg0 + 16));
  };
  auto stchunk = [&](int buf) {
    bf16_t* Cq = (bf16_t*)(smem + buf * 16512);
    bf16_t* Us = (bf16_t*)(smem + buf * 16512 + 8320);
    const bf16_t h0 = f2bf(fw0 * scale), h1 = f2bf(fw1 * scale), h2 = f2bf(fw2 * scale);
#pragma unroll
    for (int rho = 0; rho < 8; ++rho) {
      int m = tid + rho;
      Cq[((m >> 3) * 8 + rho) * 8 + (m & 7)] = h0;
      m = tid + 256 + rho;
      if (m < 520) Cq[((m >> 3) * 8 + rho) * 8 + (m & 7)] = h1;
      m = tid + 512 + rho;
      if (tid < 8 && m < 520) Cq[((m >> 3) * 8 + rho) * 8 + (m & 7)] = h2;
    }
    if (tid < 8) {
#pragma unroll
      for (int rho = 1; rho < 8; ++rho) if (tid < rho) Cq[(rho) * 8 + tid] = 0;
    }
    const int bb = tid >> 4, sg0 = tid & 15;
    *(uint4*)&Us[(sg0 * 16 + bb) * 8] = ru0;
    *(uint4*)&Us[((sg0 + 16) * 16 + bb) * 8] = ru1;
  };
  ldchunk(0);
#pragma unroll 1
  for (int ch = 0; ch < nch; ++ch) {
    const int buf = ch & 1;
    stchunk(buf);
    __syncthreads();
    if (ch + 1 < nch) ldchunk(ch + 1);
    const bf16_t* Cq = (const bf16_t*)(smem + buf * 16512);
    const bf16_t* Us = (const bf16_t*)(smem + buf * 16512 + 8320);
#pragma unroll
    for (int kk = 0; kk < 8; ++kk) {
      bf16x8 bf = *(const bf16x8*)&Us[((4 * kk + fq) * 16 + fr) * 8];
#pragma unroll
      for (int m = 0; m < 4; ++m) {
        int it = wid * 4 + m;
        int base = 256 - 16 * it + 32 * kk + 8 * fq;
        int m0 = base - 8 * (fr >> 3);
        bf16x8 af = *(const bf16x8*)&Cq[((m0 >> 3) * 8 + (fr & 7)) * 8];
        acc[m] = mfma16(af, bf, acc[m]);
      }
    }
  }
  __syncthreads();
  bf16_t* Yt = (kind ? opq(p.YTc) : opq(p.YTl)) + ((size_t)c * 16 + fr) * L + tb;
#pragma unroll
  for (int m = 0; m < 4; ++m) {
    int t = (wid * 4 + m) * 16 + fq * 4;
    *(uint2*)(Yt + t) = make_uint2(pack2(acc[m][0], acc[m][1]), pack2(acc[m][2], acc[m][3]));
  }
}

DEV void hyena_post_unit(const P& p, int layer, int unit, char* smem) {
  int kind, b, t0, L;
  if (unit < 1024) { kind = 0; b = unit >> 6; t0 = (unit & 63) * 64; L = T; } else { int u = unit - 1024; kind = 1; b = u >> 2; t0 = (u & 3) * 64; L = LC; }
  const int c = tid_(), lane = c & 63, wid = c >> 6;
  const size_t row0 = (size_t)b * LT + (kind ? 0 : LC);
  bf16_t (*tile)[264] = (bf16_t (*)[264])smem;
  const float* cw = p.conv_w + (size_t)layer * 3 * 1536;
  const float wa = cw[c], wb = cw[1536 + c], wcc = cw[3072 + c], b0 = p.conv_b[layer * 1536 + c];
  const float bias = p.hy_bias[layer * 256 + c];
  const bf16_t* yt = (kind ? opq(p.YTc) : opq(p.YTl)) + ((size_t)c * 16 + b) * L + t0;
  const bf16_t* ut = (kind ? opq(p.UTc) : opq(p.UTl)) + ((size_t)c * 16 + b) * L + t0;
  auto ld = [&](int t) -> float { return (t >= 0 && t < L) ? bf2f(p.Z[(row0 + t) * INW + c]) : 0.f; };
  float xm = ld(t0 - 1), xc = ld(t0);
  __syncthreads();
#pragma unroll 1
  for (int i8 = 0; i8 < 8; ++i8) {
    uint4 yu = *(const uint4*)(yt + 8 * i8), uu = *(const uint4*)(ut + 8 * i8);
    float yv[8], uv[8];
    unpack8(yu, yv); unpack8(uu, uv);
#pragma unroll
    for (int i = 0; i < 8; ++i) {
      int t = t0 + i8 * 8 + i;
      float xn = ld(t + 1);
      float x0 = wa * xm + wb * xc + wcc * xn + b0;
      float o = x0 * (yv[i] + uv[i] * bias);
      tile[i8 * 8 + i][c] = f2bf(o);
      xm = xc; xc = xn;
    }
  }
  __syncthreads();
  for (int i = 0; i < 16; ++i) {
    int tl = wid * 16 + i;
    uint2 ou = *(const uint2*)&tile[tl][4 * lane];
    float o[4] = {bflo(ou.x), bfhi(ou.x), bflo(ou.y), bfhi(ou.y)};
    float ss = wave_sum(o[0] * o[0] + o[1] * o[1] + o[2] * o[2] + o[3] * o[3]);
    float rstd = rsqrtf(ss * (1.f / 256.f) + 1e-6f);
#pragma unroll
    for (int q = 0; q < 4; ++q) {
      o[q] = o[q] * rstd * p.hy_out_g[layer * 256 + 4 * lane + q];
    }
    *(uint2*)(p.Y + (row0 + t0 + tl) * D + 4 * lane) = make_uint2(pack2(o[0], o[1]), pack2(o[2], o[3]));
  }
}

DEV void attn_unit(const P& p, int layer, int unit, char* smem) {
  const bool isctx = unit >= 4096;
  int b, qb, hq;
  if (!isctx) { b = unit >> 8; qb = (unit >> 3) & 31; hq = unit & 7; } else { int u = unit - 4096; b = u >> 4; qb = (u >> 3) & 1; hq = u & 7; }
  const int g = hq >> 2;
  const int tid = tid_(), lane = tid & 63, wid = tid >> 6, qn = lane & 31, hh = lane >> 5;
  const int qpos = qb * 128 + wid * 32 + qn;
  const size_t qrow = (size_t)b * LT + (isctx ? qpos : LC + qpos);
  const bf16_t* qptr = p.Z + qrow * INW + 1920 + hq * 64;
  bf16x8 qf[4];
#pragma unroll
  for (int s = 0; s < 4; ++s) qf[s] = *(const bf16x8*)(qptr + 16 * s + 8 * hh);
  const float sink = p.attn_sink[layer * 8 + hq];
  float m_run = sink, l_run = 1.f;
  f32x16 o0, o1;
#pragma unroll
  for (int i = 0; i < 16; ++i) { o0[i] = 0.f; o1[i] = 0.f; }
  typedef bf16_t KTile[64][72];
  KTile* Ks = (KTile*)smem;
  KTile* Vt = (KTile*)(smem + 18432);
  const int ntl = isctx ? 0 : 6;
  const int ntiles = ntl + 4;
  const int skey = tid >> 3, sseg = tid & 7;
  const bf16_t* kvbase = p.Z + (size_t)b * LT * INW + 1920 + 512 + g * 64 + sseg * 8;
  uint4 rk0, rk1, rv0, rv1;
  auto ldtile = [&](int kt) {
    const bool ctxk = kt >= ntl;
    const int kbase = ctxk ? (kt - ntl) * 64 : qb * 128 - 128 + kt * 64;
    const int kp0 = kbase + skey, kp1 = kp0 + 32;
    rk0 = rk1 = rv0 = rv1 = make_uint4(0, 0, 0, 0);
    if (ctxk || (kp0 >= 0 && kp0 < T)) { const bf16_t* src = kvbase + (size_t)(ctxk ? kp0 : LC + kp0) * INW; rk0 = *(const uint4*)src; rv0 = *(const uint4*)(src + 128); }
    if (ctxk || (kp1 >= 0 && kp1 < T)) { const bf16_t* src = kvbase + (size_t)(ctxk ? kp1 : LC + kp1) * INW; rk1 = *(const uint4*)src; rv1 = *(const uint4*)(src + 128); }
  };
  auto sttile = [&](int buf) {
    *(uint4*)&Ks[buf][skey][sseg * 8] = rk0;
    *(uint4*)&Ks[buf][skey + 32][sseg * 8] = rk1;
    bf16_t (*vt)[72] = Vt[buf];
    vt[sseg * 8 + 0][skey] = (bf16_t)(rv0.x & 0xFFFF); vt[sseg * 8 + 1][skey] = (bf16_t)(rv0.x >> 16);
    vt[sseg * 8 + 2][skey] = (bf16_t)(rv0.y & 0xFFFF); vt[sseg * 8 + 3][skey] = (bf16_t)(rv0.y >> 16);
    vt[sseg * 8 + 4][skey] = (bf16_t)(rv0.z & 0xFFFF); vt[sseg * 8 + 5][skey] = (bf16_t)(rv0.z >> 16);
    vt[sseg * 8 + 6][skey] = (bf16_t)(rv0.w & 0xFFFF); vt[sseg * 8 + 7][skey] = (bf16_t)(rv0.w >> 16);
    vt[sseg * 8 + 0][skey + 32] = (bf16_t)(rv1.x & 0xFFFF); vt[sseg * 8 + 1][skey + 32] = (bf16_t)(rv1.x >> 16);
    vt[sseg * 8 + 2][skey + 32] = (bf16_t)(rv1.y & 0xFFFF); vt[sseg * 8 + 3][skey + 32] = (bf16_t)(rv1.y >> 16);
    vt[sseg * 8 + 4][skey + 32] = (bf16_t)(rv1.z & 0xFFFF); vt[sseg * 8 + 5][skey + 32] = (bf16_t)(rv1.z >> 16);
    vt[sseg * 8 + 6][skey + 32] = (bf16_t)(rv1.w & 0xFFFF); vt[sseg * 8 + 7][skey + 32] = (bf16_t)(rv1.w >> 16);
  };
  ldtile(0);
#pragma unroll 1
  for (int kt = 0; kt < ntiles; ++kt) {
    const int buf = kt & 1;
    sttile(buf);
    __syncthreads();
    if (kt + 1 < ntiles) ldtile(kt + 1);
    const bool ctxk = kt >= ntl;
    const int kbase = ctxk ? (kt - ntl) * 64 : qb * 128 - 128 + kt * 64;
#pragma unroll
    for (int sub = 0; sub < 2; ++sub) {
      const int kb2 = kbase + sub * 32;
      bool need = true;
      if (!ctxk) {
        int q0 = qb * 128 + wid * 32;
        if (kb2 + 31 < q0 - 128 || kb2 > q0 + 31 + 128 || kb2 + 31 < 0 || kb2 >= T) need = false;
      }
      if (need) {
        f32x16 sv;
#pragma unroll
        for (int i = 0; i < 16; ++i) sv[i] = 0.f;
#pragma unroll
        for (int ks = 0; ks < 4; ++ks) {
          bf16x8 kf = *(const bf16x8*)&Ks[buf][sub * 32 + qn][16 * ks + 8 * hh];
          sv = mfma32(kf, qf[ks], sv);
        }
        float mt = -3e38f;
#pragma unroll
        for (int rg = 0; rg < 16; ++rg) {
          float v = sv[rg] * 0.125f;
          if (!ctxk) {
            int kp = kb2 + (rg & 3) + 8 * (rg >> 2) + 4 * hh;
            int dl = qpos - kp;
            bool ok = (dl <= 128) && (dl >= -128) && (kp >= 0) && (kp < T);
            v = ok ? v : -1e30f;
          }
          sv[rg] = v;
          mt = fmaxf(mt, v);
        }
        mt = fmaxf(mt, __shfl_xor(mt, 32));
        float m_new = fmaxf(m_run, mt);
        float corr = __expf(m_run - m_new);
        float ps = 0.f;
#pragma unroll
        for (int rg = 0; rg < 16; ++rg) { float pv = __expf(sv[rg] - m_new); sv[rg] = pv; ps += pv; }
        ps += __shfl_xor(ps, 32);
        l_run = l_run * corr + ps;
        m_run = m_new;
#pragma unroll
        for (int i = 0; i < 16; ++i) { o0[i] *= corr; o1[i] *= corr; }
#pragma unroll
        for (int sp = 0; sp < 2; ++sp) {
          bf16x8 pf;
#pragma unroll
          for (int j = 0; j < 8; ++j) pf[j] = (short)f2bf(sv[8 * sp + j]);
          const int kc = sub * 32 + 16 * sp + 4 * hh;
          uint2 va = *(const uint2*)&Vt[buf][qn][kc], vb = *(const uint2*)&Vt[buf][qn][kc + 8];
          uint2 vc = *(const uint2*)&Vt[buf][32 + qn][kc], vd = *(const uint2*)&Vt[buf][32 + qn][kc + 8];
          uint4 w0 = make_uint4(va.x, va.y, vb.x, vb.y), w1 = make_uint4(vc.x, vc.y, vd.x, vd.y);
          bf16x8 v0 = __builtin_bit_cast(bf16x8, w0), v1 = __builtin_bit_cast(bf16x8, w1);
          o0 = mfma32(v0, pf, o0);
          o1 = mfma32(v1, pf, o1);
        }
      }
    }
  }
  __syncthreads();
  const float inv = 1.f / l_run;
  bf16_t* optr = p.Y + qrow * D + 512 + hq * 64;
#pragma unroll
  for (int rg = 0; rg < 4; ++rg) {
    int d0 = 8 * rg + 4 * hh;
    *(uint2*)(optr + d0) = make_uint2(pack2(o0[4 * rg] * inv, o0[4 * rg + 1] * inv), pack2(o0[4 * rg + 2] * inv, o0[4 * rg + 3] * inv));
    *(uint2*)(optr + 32 + d0) = make_uint2(pack2(o1[4 * rg] * inv, o1[4 * rg + 1] * inv), pack2(o1[4 * rg + 2] * inv, o1[4 * rg + 3] * inv));
  }
}

DEV void ph_attn_post(const P& p, int layer) {
  const int lane = tid_() & 63;
  int r0, r1;
  wave_range(r0, r1, NTOK);
  float gv[8];
#pragma unroll
  for (int i = 0; i < 8; ++i) gv[i] = p.at_out_g[layer * 512 + 8 * lane + i];
  uint4 nx = make_uint4(0, 0, 0, 0);
  if (r0 < r1) nx = *(const uint4*)(p.Y + (size_t)r0 * D + 512 + 8 * lane);
#pragma unroll 1
  for (int row = r0; row < r1; ++row) {
    const uint4 u = nx;
    if (row + 1 < r1) nx = *(const uint4*)(p.Y + (size_t)(row + 1) * D + 512 + 8 * lane);
    float v[8];
    unpack8(u, v);
    float ss = 0.f;
#pragma unroll
    for (int i = 0; i < 8; ++i) ss += v[i] * v[i];
    ss = wave_sum(ss);
    const float rstd = rsqrtf(ss * (1.f / 512.f) + 1e-6f);
#pragma unroll
    for (int i = 0; i < 8; ++i) {
      v[i] = v[i] * rstd * gv[i];
    }
    *(uint4*)(p.Y + (size_t)row * D + 512 + 8 * lane) = pack8(v);
  }
}

struct Epi2 {
  const P& p; int layer, row0, col0;
  DEV void operator()(f32x4 (&acc)[4][4], int wr, int wc, int fr, int fq, char* smem) const {
    const int b = row0 / LT, pp = row0 % LT;
    const int mr = pp < LC ? 16 : b;
    const float* g1 = p.modv + ((size_t)layer * 17 + mr) * 6144 + 2048 + col0 + wc * 64;
#pragma unroll
    for (int n = 0; n < 4; ++n) {
      const float gv = g1[n * 16 + fr];
#pragma unroll
      for (int m = 0; m < 4; ++m)
#pragma unroll
        for (int j = 0; j < 4; ++j) acc[m][n][j] *= gv;
    }
    const int wid = wr * 2 + wc, lane = fq * 16 + fr;
    stage_tile_bf16(acc, smem, wid, fr, fq);
    const bf16_t (*t)[72] = (const bf16_t (*)[72])(smem + wid * 9216);
#pragma unroll
    for (int i = 0; i < 8; ++i) {
      const int rl = i * 8 + (lane >> 3), ch = lane & 7;
      bf16_t* xp = p.X + (size_t)(row0 + wr * 64 + rl) * D + col0 + wc * 64 + ch * 8;
      float xv[8], dv[8];
      uint4 xu = *(const uint4*)xp, du = *(const uint4*)&t[rl][ch * 8];
      unpack8(xu, xv); unpack8(du, dv);
#pragma unroll
      for (int q = 0; q < 8; ++q) xv[q] += dv[q];
      *(uint4*)xp = pack8(xv);
    }
  }
};
DEV void ph_gemm2(const P& p, int layer, char* smem) {
  int rt, ct;
  for (int it = 0; gemm_unit(it, 8, rt, ct); ++it) {
    Epi2 epi{p, layer, rt * 128, ct * 128};
    gemm_tile(p.Y + (size_t)rt * 128 * D, D, p.W2t + (size_t)ct * 128 * D, D, D, smem, epi);
  }
}

DEV void ph_peerconv(const P& p, int layer) {
  const int gw = (bid_() * 256 + tid_()) >> 6, nw = gridDim.x * 4, lane = tid_() & 63;
  const float* su = opq(p.peer_u) + (size_t)layer * 16384 * 1024;
  const float* sv = opq(p.peer_v) + (size_t)layer * 16384 * 1024;
  unsigned char* pu = opq(p.PU); unsigned char* pv = opq(p.PV);
  float* psu = opq(p.PSU); float* psv = opq(p.PSV);
#pragma unroll 1
  for (int r = gw; r < 32768; r += nw) {
    const bool isv = r >= 16384;
    const int e = r & 16383;
    const float* src = (isv ? sv : su) + (size_t)e * 1024 + 16 * lane;
    float4 f0 = *(const float4*)src, f1 = *(const float4*)(src + 4), f2 = *(const float4*)(src + 8), f3 = *(const float4*)(src + 12);
    float am = fmaxf(fmaxf(fmaxf(fabsf(f0.x), fabsf(f0.y)), fmaxf(fabsf(f0.z), fabsf(f0.w))), fmaxf(fmaxf(fabsf(f1.x), fabsf(f1.y)), fmaxf(fabsf(f1.z), fabsf(f1.w))));
    am = fmaxf(am, fmaxf(fmaxf(fmaxf(fabsf(f2.x), fabsf(f2.y)), fmaxf(fabsf(f2.z), fabsf(f2.w))), fmaxf(fmaxf(fabsf(f3.x), fabsf(f3.y)), fmaxf(fabsf(f3.z), fabsf(f3.w)))));
    am = wave_max(am);
    int w0, w1, w2, w3;
    float inv;
    if (isv) {
      const float sc = am > 0.f ? 224.f / am : 1.f;
      inv = am > 0.f ? am * (1.f / 224.f) : 1.f;
      w0 = __builtin_amdgcn_cvt_pk_fp8_f32(f0.x * sc, f0.y * sc, 0, false); w0 = __builtin_amdgcn_cvt_pk_fp8_f32(f0.z * sc, f0.w * sc, w0, true);
      w1 = __builtin_amdgcn_cvt_pk_fp8_f32(f1.x * sc, f1.y * sc, 0, false); w1 = __builtin_amdgcn_cvt_pk_fp8_f32(f1.z * sc, f1.w * sc, w1, true);
      w2 = __builtin_amdgcn_cvt_pk_fp8_f32(f2.x * sc, f2.y * sc, 0, false); w2 = __builtin_amdgcn_cvt_pk_fp8_f32(f2.z * sc, f2.w * sc, w2, true);
      w3 = __builtin_amdgcn_cvt_pk_fp8_f32(f3.x * sc, f3.y * sc, 0, false); w3 = __builtin_amdgcn_cvt_pk_fp8_f32(f3.z * sc, f3.w * sc, w3, true);
    } else {
      const float sc = am > 0.f ? 127.f / am : 1.f;
      inv = am > 0.f ? am * (1.f / 127.f) : 1.f;
      w0 = pack_i8(f0.x * sc, f0.y * sc, f0.z * sc, f0.w * sc); w1 = pack_i8(f1.x * sc, f1.y * sc, f1.z * sc, f1.w * sc);
      w2 = pack_i8(f2.x * sc, f2.y * sc, f2.z * sc, f2.w * sc); w3 = pack_i8(f3.x * sc, f3.y * sc, f3.z * sc, f3.w * sc);
    }
    *(uint4*)((isv ? pv : pu) + (size_t)(lane >> 3) * PSLICE + (size_t)e * 128 + 16 * (lane & 7)) = make_uint4((unsigned)w0, (unsigned)w1, (unsigned)w2, (unsigned)w3);
    if (lane == 0) (isv ? psv : psu)[e] = inv;
  }
}
DEV void unpack16_fp8x2(const uint4& u, f32x2* f) {
  f[0] = __builtin_amdgcn_cvt_pk_f32_fp8((int)u.x, false); f[1] = __builtin_amdgcn_cvt_pk_f32_fp8((int)u.x, true);
  f[2] = __builtin_amdgcn_cvt_pk_f32_fp8((int)u.y, false); f[3] = __builtin_amdgcn_cvt_pk_f32_fp8((int)u.y, true);
  f[4] = __builtin_amdgcn_cvt_pk_f32_fp8((int)u.z, false); f[5] = __builtin_amdgcn_cvt_pk_f32_fp8((int)u.z, true);
  f[6] = __builtin_amdgcn_cvt_pk_f32_fp8((int)u.w, false); f[7] = __builtin_amdgcn_cvt_pk_f32_fp8((int)u.w, true);
}

DEV void bitonic_sort16_desc(float (&v)[16]) {
#pragma unroll
  for (int k = 2; k <= 16; k <<= 1)
#pragma unroll
    for (int j = k >> 1; j >= 1; j >>= 1)
#pragma unroll
      for (int i = 0; i < 16; ++i) {
        const int l = i ^ j;
        if (l > i) {
          const float hi = fmaxf(v[i], v[l]), lo = fminf(v[i], v[l]);
          if ((i & k) == 0) { v[i] = hi; v[l] = lo; } else { v[i] = lo; v[l] = hi; }
        }
      }
}
struct Epi3 {
  const P& p; int row0, grp;
  DEV void operator()(f32x4 (&acc)[4][4], int wr, int wc, int fr, int fq, char* smem) const {
    float* sc = (float*)smem;
    const int tid = tid_();
    for (int pass = 0; pass < 2; ++pass) {
      __syncthreads();
      if (wr == pass) {
#pragma unroll
        for (int m = 0; m < 4; ++m)
#pragma unroll
          for (int n = 0; n < 4; ++n)
#pragma unroll
            for (int j = 0; j < 4; ++j) {
              int rl = m * 16 + fq * 4 + j, col = wc * 64 + n * 16 + fr;
              unsigned bits = (__float_as_uint(acc[m][n][j]) & ~127u) | (unsigned)col;
              sc[rl * 133 + (col >> 5) * 33 + (col & 31)] = __uint_as_float(bits);
            }
      }
      __syncthreads();
      const int rl = tid >> 2, q = tid & 3;
      const float* src = sc + rl * 133 + q * 33;
      float Ls[16], Hs[16];
#pragma unroll
      for (int i = 0; i < 16; ++i) { Ls[i] = src[i]; Hs[i] = src[16 + i]; }
      bitonic_sort16_desc(Ls);
      bitonic_sort16_desc(Hs);
#pragma unroll
      for (int i = 0; i < 16; ++i) Ls[i] = fmaxf(Ls[i], Hs[15 - i]);
#pragma unroll
      for (int d = 8; d >= 1; d >>= 1)
#pragma unroll
        for (int i = 0; i < 16; ++i)
          if ((i & d) == 0) { float hi = fmaxf(Ls[i], Ls[i + d]), lo = fminf(Ls[i], Ls[i + d]); Ls[i] = hi; Ls[i + d] = lo; }
      float Cs[16];
#pragma unroll
      for (int i = 0; i < 16; ++i) Cs[i] = fmaxf(Ls[i], dppself<0xB1, 0xF>(Ls[15 - i]));
#pragma unroll
      for (int d = 8; d >= 1; d >>= 1)
#pragma unroll
        for (int i = 0; i < 16; ++i)
          if ((i & d) == 0) { float hi = fmaxf(Cs[i], Cs[i + d]), lo = fminf(Cs[i], Cs[i + d]); Cs[i] = hi; Cs[i + d] = lo; }
      float Ds[16];
#pragma unroll
      for (int i = 0; i < 16; ++i) Ds[i] = fmaxf(Cs[i], dppself<0x4E, 0xF>(Cs[15 - i]));
#pragma unroll
      for (int d = 8; d >= 1; d >>= 1)
#pragma unroll
        for (int i = 0; i < 16; ++i)
          if ((i & d) == 0) { float hi = fmaxf(Ds[i], Ds[i + d]), lo = fminf(Ds[i], Ds[i + d]); Ds[i] = hi; Ds[i + d] = lo; }
      if (q == 0) {
        float* dst = p.TK + ((size_t)(row0 + pass * 64 + rl) * 16 + grp) * 16;
#pragma unroll
        for (int i = 0; i < 4; ++i) *(float4*)(dst + 4 * i) = make_float4(Ds[4 * i], Ds[4 * i + 1], Ds[4 * i + 2], Ds[4 * i + 3]);
      }
    }
  }
};
DEV void ph_gemm3(const P& p, char* smem) {
  int rt, ct;
  for (int it = 0; gemm_unit(it, 16, rt, ct); ++it) {
    Epi3 epi{p, rt * 128, ct};
    gemm_tile(p.H + (size_t)rt * 128 * D, D, p.Wft + (size_t)ct * 128 * D, D, D, smem, epi);
  }
}

DEV float peer_gate(float scr) {
  float mx = row16_max(scr);
  float ex = __expf(scr - mx);
  float sm = row16_sum(ex);
  return ex / sm;
}
DEV float gelu_exact(float x) { return 0.5f * x * (1.f + erff(x * 0.7071067811865476f)); }

DEV void ph_peer_select(const P& p) {
  const int gw = (bid_() * 256 + tid_()) >> 6, nw = gridDim.x * 4, lane = tid_() & 63;
  int ci, cj;
  {
    const int c = lane;
    if (c < 16) { ci = 0; cj = c; } else if (c < 24) { ci = 1; cj = c - 16; } else if (c < 29) { ci = 2; cj = c - 24; }
    else if (c < 33) { ci = 3; cj = c - 29; } else if (c < 36) { ci = 4; cj = c - 33; } else if (c < 38) { ci = 5; cj = c - 36; }
    else if (c < 40) { ci = 6; cj = c - 38; } else if (c < 42) { ci = 7; cj = c - 40; } else { ci = (c - 42 + 8) & 15; cj = 0; }
  }
  const bool cand = lane < 50;
  float v1s[8], v2s[8];
  auto ldtk = [&](int row) {
    const float* tk = p.TK + (size_t)row * 256;
#pragma unroll
    for (int h = 0; h < 8; ++h) { v1s[h] = tk[(2 * h) * 16 + ci]; v2s[h] = tk[(2 * h + 1) * 16 + cj]; }
  };
  if (gw < NTOK) ldtk(gw);
#pragma unroll 1
  for (int row = gw; row < NTOK; row += nw) {
    float c1[8], c2[8];
#pragma unroll
    for (int h = 0; h < 8; ++h) { c1[h] = v1s[h]; c2[h] = v2s[h]; }
    if (row + nw < NTOK) ldtk(row + nw);
#pragma unroll
    for (int h = 0; h < 8; ++h) {
      const float v1 = c1[h], v2 = c2[h];
      float val = v1 + v2;
      val = __uint_as_float((__float_as_uint(val) & ~63u) | (unsigned)lane);
      val = cand ? val : -3e38f;
      int rank = 0;
#pragma unroll
      for (int q = 0; q < 50; ++q) rank += (readlane_f(val, q) > val) ? 1 : 0;
      const bool sel = cand && rank < 16;
      const float mx = wave_max(val);
      const float ex = sel ? __expf(val - mx) : 0.f;
      const float sm = wave_sum(ex);
      if (sel) {
        const int e = (int)(__float_as_uint(v1) & 127u) * 128 + (int)(__float_as_uint(v2) & 127u);
        p.EL[(size_t)row * 128 + h * 16 + rank] = (unsigned short)e;
        p.GT[(size_t)row * 128 + h * 16 + rank] = ex / sm;
      }
    }
  }
}

struct PeerPre { uint4 e0, e1, a0, a1, a2, a3; };
DEV unsigned peer_eid(const PeerPre& s, int j) {
  const unsigned w = (j < 8) ? ((j >> 1) == 0 ? s.e0.x : (j >> 1) == 1 ? s.e0.y : (j >> 1) == 2 ? s.e0.z : s.e0.w)
                             : (((j - 8) >> 1) == 0 ? s.e1.x : ((j - 8) >> 1) == 1 ? s.e1.y : ((j - 8) >> 1) == 2 ? s.e1.z : s.e1.w);
  return (j & 1) ? (w >> 16) : (w & 0xFFFFu);
}
template <int WHICH>
DEV void peer_wave_run(const P& p, int layer, int x, int tok0, int lane, float* wbuf) {
  const int r = lane >> 3, c = lane & 7;
  const unsigned char* tb = (WHICH == 0 ? p.PU : p.PV) + (size_t)x * PSLICE + c * 16;
  PeerPre S[3];
  uint4 R[16];
  auto ld_pre = [&](int tok, PeerPre& s) {
    const uint4* elp = (const uint4*)(p.EL + (size_t)tok * 128 + r * 16);
    s.e0 = elp[0]; s.e1 = elp[1];
    if (WHICH == 0) {
      s.a0 = *(const uint4*)(p.H8 + (size_t)tok * 1024 + x * 128 + c * 16);
    } else {
      const uint4* wtp = (const uint4*)(p.GT + (size_t)tok * 128 + r * 16);
      s.a0 = wtp[0]; s.a1 = wtp[1]; s.a2 = wtp[2]; s.a3 = wtp[3];
    }
  };
  auto comp = [&](int tok, const PeerPre& s, const PeerPre& sn, bool more) {
    if (WHICH == 0) {
      int keep0 = 0, keep1 = 0;
#pragma unroll
      for (int j = 0; j < 16; ++j) {
        const uint4 rw = R[j];
        if (more) R[j] = *(const uint4*)(tb + (size_t)peer_eid(sn, j) * 128);
        int d = __builtin_amdgcn_sdot4((int)rw.x, (int)s.a0.x, 0, false);
        d = __builtin_amdgcn_sdot4((int)rw.y, (int)s.a0.y, d, false);
        d = __builtin_amdgcn_sdot4((int)rw.z, (int)s.a0.z, d, false);
        d = __builtin_amdgcn_sdot4((int)rw.w, (int)s.a0.w, d, false);
        d += __builtin_amdgcn_update_dpp(0, d, 0xB1, 0xF, 0xF, false);
        d += __builtin_amdgcn_update_dpp(0, d, 0x4E, 0xF, 0xF, false);
        d += __builtin_amdgcn_update_dpp(0, d, 0x141, 0xF, 0xF, false);
        if (j < 8) keep0 = (c == j) ? d : keep0; else keep1 = (c == j - 8) ? d : keep1;
      }
      bf16_t* pd = p.PD + ((size_t)x * NTOK + tok) * 128 + r * 16 + c;
      pd[0] = f2bf((float)keep0); pd[8] = f2bf((float)keep1);
    } else {
      const float wsv[16] = {__uint_as_float(s.a0.x), __uint_as_float(s.a0.y), __uint_as_float(s.a0.z), __uint_as_float(s.a0.w),
                             __uint_as_float(s.a1.x), __uint_as_float(s.a1.y), __uint_as_float(s.a1.z), __uint_as_float(s.a1.w),
                             __uint_as_float(s.a2.x), __uint_as_float(s.a2.y), __uint_as_float(s.a2.z), __uint_as_float(s.a2.w),
                             __uint_as_float(s.a3.x), __uint_as_float(s.a3.y), __uint_as_float(s.a3.z), __uint_as_float(s.a3.w)};
      f32x2 acc2[8];
#pragma unroll
      for (int i = 0; i < 8; ++i) acc2[i] = (f32x2){0.f, 0.f};
#pragma unroll
      for (int j = 0; j < 16; ++j) {
        f32x2 f[8];
        unpack16_fp8x2(R[j], f);
        if (more) R[j] = *(const uint4*)(tb + (size_t)peer_eid(sn, j) * 128);
        const f32x2 w2 = (f32x2){wsv[j], wsv[j]};
#pragma unroll
        for (int i = 0; i < 8; ++i) acc2[i] += w2 * f[i];
      }
      float* slab = wbuf + (r * 8 + c) * 16;
      *(float4*)(slab) = make_float4(acc2[0][0], acc2[0][1], acc2[1][0], acc2[1][1]);
      *(float4*)(slab + 4) = make_float4(acc2[2][0], acc2[2][1], acc2[3][0], acc2[3][1]);
      *(float4*)(slab + 8) = make_float4(acc2[4][0], acc2[4][1], acc2[5][0], acc2[5][1]);
      *(float4*)(slab + 12) = make_float4(acc2[6][0], acc2[6][1], acc2[7][0], acc2[7][1]);
      asm volatile("s_waitcnt lgkmcnt(0)" ::: "memory");
      float o0 = 0.f, o1 = 0.f;
#pragma unroll
      for (int rr = 0; rr < 8; ++rr) {
        const float2 t = *(const float2*)(wbuf + (rr * 8 + (lane >> 3)) * 16 + 2 * (lane & 7));
        o0 += t.x; o1 += t.y;
      }
      asm volatile("s_waitcnt lgkmcnt(0)" ::: "memory");
      const int b = tok / LT, pp = tok % LT;
      const int mr = pp < LC ? 16 : b;
      const int col = x * 128 + 2 * lane;
      const float* g2 = p.modv + ((size_t)layer * 17 + mr) * 6144 + 5120 + col;
      unsigned* xp = (unsigned*)(p.X + (size_t)tok * D + col);
      const unsigned xu = *xp;
      *xp = pack2(bflo(xu) + g2[0] * o0, bfhi(xu) + g2[1] * o1);
    }
  };
  ld_pre(tok0, S[0]);
  ld_pre(tok0 + 1, S[1]);
#pragma unroll
  for (int j = 0; j < 16; ++j) R[j] = *(const uint4*)(tb + (size_t)peer_eid(S[0], j) * 128);
  ld_pre(tok0 + 2, S[2]);
#pragma unroll
  for (int t = 0; t < 8; ++t) {
    comp(tok0 + t, S[t % 3], S[(t + 1) % 3], t + 1 < 8);
    if (t + 3 < 8) ld_pre(tok0 + t + 3, S[t % 3]);
  }
}
DEV void ph_peer_w(const P& p) {
  for (size_t i8 = (size_t)bid_() * 256 + tid_(); i8 < (size_t)NTOK * 16; i8 += (size_t)gridDim.x * 256) {
    const size_t i = i8 * 8;
    float d[8];
#pragma unroll
    for (int q = 0; q < 8; ++q) d[q] = 0.f;
#pragma unroll
    for (int x = 0; x < 8; ++x) {
      const uint4 u = *(const uint4*)(p.PD + (size_t)x * NTOK * 128 + i);
      float f[8];
      unpack8(u, f);
#pragma unroll
      for (int q = 0; q < 8; ++q) d[q] += f[q];
    }
    const uint4 eu = *(const uint4*)(p.EL + i);
    const unsigned ew[4] = {eu.x, eu.y, eu.z, eu.w};
    const float hinv = p.HINV[i >> 7];
    float4 g0 = *(const float4*)(p.GT + i), g1 = *(const float4*)(p.GT + i + 4);
    float g[8] = {g0.x, g0.y, g0.z, g0.w, g1.x, g1.y, g1.z, g1.w};
#pragma unroll
    for (int q = 0; q < 8; ++q) {
      const unsigned e = (q & 1) ? (ew[q >> 1] >> 16) : (ew[q >> 1] & 0xFFFFu);
      g[q] = g[q] * gelu_exact(d[q] * p.PSU[e] * hinv) * p.PSV[e];
    }
    *(float4*)(p.GT + i) = make_float4(g[0], g[1], g[2], g[3]);
    *(float4*)(p.GT + i + 4) = make_float4(g[4], g[5], g[6], g[7]);
  }
}
template <int WHICH>
DEV void ph_peer_gather(const P& p, int layer, char* smem, volatile LAS unsigned* slot) {
  const int tid = tid_(), lane = tid & 63, wid = tid >> 6;
  unsigned* q = p.wq + 1024 + layer * 256 + WHICH * 128;
  const int my = (int)(xb_xcc_id() & 7u);
  float* wbuf = (float*)smem + wid * 1024;
#pragma unroll 1
  for (int rot = 0; rot < 8; ++rot) {
    const int x = (my + rot) & 7;
    for (;;) {
      __syncthreads();
      if (tid == 0) *slot = atomicAdd(q + x * 16, 1u);
      __syncthreads();
      const int it = (int)*slot;
      if (it >= NTOK / 32) break;
      peer_wave_run<WHICH>(p, layer, x, it * 32 + wid * 8, lane, wbuf);
    }
  }
}

DEV void ph_final(const P& p) {
  const int lane = tid_() & 63;
  int r0, r1;
  wave_range(r0, r1, NB * T);
  float gv[16];
#pragma unroll
  for (int hh = 0; hh < 2; ++hh)
#pragma unroll
    for (int i = 0; i < 8; ++i) gv[hh * 8 + i] = p.final_g[hh * 512 + 8 * lane + i];
  auto xrow = [&](int r) -> const bf16_t* { const int b = r / T, t = r % T; return p.X + ((size_t)b * LT + LC + t) * D; };
  uint4 n0 = make_uint4(0, 0, 0, 0), n1 = n0;
  if (r0 < r1) { const bf16_t* xr = xrow(r0); n0 = *(const uint4*)(xr + 8 * lane); n1 = *(const uint4*)(xr + 512 + 8 * lane); }
#pragma unroll 1
  for (int r = r0; r < r1; ++r) {
    const uint4 u0 = n0, u1 = n1;
    if (r + 1 < r1) { const bf16_t* xr = xrow(r + 1); n0 = *(const uint4*)(xr + 8 * lane); n1 = *(const uint4*)(xr + 512 + 8 * lane); }
    float v[16];
    unpack8(u0, v); unpack8(u1, v + 8);
    float ss = 0.f;
#pragma unroll
    for (int i = 0; i < 16; ++i) ss += v[i] * v[i];
    ss = wave_sum(ss);
    const float rstd = rsqrtf(ss * (1.f / 1024.f) + 1e-6f);
    float* o = p.out + (size_t)r * D;
#pragma unroll
    for (int hh = 0; hh < 2; ++hh) {
      const int col = hh * 512 + 8 * lane;
      *(float4*)(o + col) = make_float4(v[hh * 8 + 0] * rstd * gv[hh * 8 + 0], v[hh * 8 + 1] * rstd * gv[hh * 8 + 1], v[hh * 8 + 2] * rstd * gv[hh * 8 + 2], v[hh * 8 + 3] * rstd * gv[hh * 8 + 3]);
      *(float4*)(o + col + 4) = make_float4(v[hh * 8 + 4] * rstd * gv[hh * 8 + 4], v[hh * 8 + 5] * rstd * gv[hh * 8 + 5], v[hh * 8 + 6] * rstd * gv[hh * 8 + 6], v[hh * 8 + 7] * rstd * gv[hh * 8 + 7]);
    }
  }
}

DEV unsigned hw_cu_key() {
  const unsigned hwid = (unsigned)__builtin_amdgcn_s_getreg(((8 - 1) << 11) | (8 << 6) | 4);
  return (xb_xcc_id() << 8) | (hwid & 0xFFu);
}
DEV void mixB(const P& p, int layer, char* smem, volatile LAS unsigned* slot) {
  unsigned* qa = p.wq + layer * 64;
  unsigned* qs = qa + 16;
  unsigned* claim = p.cuclaim + layer * 4096;
  __syncthreads();
  if (tid_() == 0) {
    unsigned u = 0xFFFFFFFFu;
    if (atomicAdd(&claim[hw_cu_key() & 4095u], 1u) == 0u) u = atomicAdd(qs, 1u);
    *slot = u;
  }
  __syncthreads();
  {
    const unsigned u = *slot;
    if (u < 128u) scanc_unit(p, layer, (int)u, smem);
  }
  for (;;) {
    __syncthreads();
    if (tid_() == 0) *slot = atomicAdd(qa, 1u);
    __syncthreads();
    const int u = (int)*slot;
    if (u >= 8704) break;
    if (u < 4352) attn_unit(p, layer, u, smem); else hyena_conv_unit(p, layer, u - 4352, smem);
  }
  if (layer + 1 < DEPTH) {
    unsigned* qp = qa + 32;
    for (;;) {
      __syncthreads();
      if (tid_() == 0) *slot = atomicAdd(qp, 1u);
      __syncthreads();
      const int u = (int)*slot;
      if (u >= PREPA_N) break;
      prep_unit(p, layer + 1, prepA_unit_index(u), smem);
    }
  }
  for (;;) {
    __syncthreads();
    if (tid_() == 0) *slot = atomicAdd(qs, 1u);
    __syncthreads();
    const unsigned u = *slot;
    if (u >= 128u) break;
    scanc_unit(p, layer, (int)u, smem);
  }
}
DEV void mixA(const P& p, int layer, char* smem) {
  for (int u = bid_(); u < 1088; u += gridDim.x) hyena_pre_unit(p, layer, u);
  ph_lora(p, layer, smem);
  ph_rwkv_prep(p, layer);
}
DEV void mixC(const P& p, int layer, char* smem) {
  for (int u = bid_(); u < 1088; u += gridDim.x) hyena_post_unit(p, layer, u, smem);
  ph_rwkv_post(p, layer);
  ph_attn_post(p, layer);
}

__global__ void __launch_bounds__(256, 2) k_mega(P p) {
  extern __shared__ __attribute__((aligned(16))) char smem_all[];
  char* smem = smem_all;
  volatile LAS unsigned* xbw = (volatile LAS unsigned*)(smem_all + SMEM_BYTES);
  if (threadIdx.x == 0) { xbw[0] = 0u; xbw[1] = 0u; xbw[2] = 0u; xbw[3] = 0u; }
  __syncthreads();
  XcdBarrier bar = xcd_barrier_post(p.bar, xbw);
  ph_copy(p);
  ph_rope(p);
  for (int u = blockIdx.x; u < 96; u += gridDim.x) modv_unit(p, u, smem);
  ph_prep(p, 0, smem, false);
  xcd_barrier(bar);
  for (int layer = 0; layer < DEPTH; ++layer) {
    ph_norm(p, layer, 0);
    xcd_barrier(bar);
    ph_gemm1(p, smem);
    xcd_barrier(bar);
    mixA(p, layer, smem);
    xcd_barrier(bar);
    mixB(p, layer, smem, (volatile LAS unsigned*)(smem_all + SMEM_BYTES + 16));
    xcd_barrier(bar);
    mixC(p, layer, smem);
    xcd_barrier(bar);
    ph_gemm2(p, layer, smem);
    ph_peerconv(p, layer);
    xcd_barrier(bar);
    ph_norm(p, layer, 1);
    xcd_barrier(bar);
    ph_gemm3(p, smem);
    xcd_barrier(bar);
    ph_peer_select(p);
    xcd_barrier(bar);
    ph_peer_gather<0>(p, layer, smem, (volatile LAS unsigned*)(smem_all + SMEM_BYTES + 16));
    xcd_barrier(bar);
    ph_peer_w(p);
    xcd_barrier(bar);
    ph_peer_gather<1>(p, layer, smem, (volatile LAS unsigned*)(smem_all + SMEM_BYTES + 16));
    if (layer + 1 < DEPTH) ph_prep(p, layer + 1, smem, true);
    xcd_barrier(bar);
  }
  ph_final(p);
}

static inline size_t al256(size_t x) { return (x + 255) & ~(size_t)255; }

extern "C" void kernel_launch(void* const* d_in, const int* in_sizes, int n_in, void* d_out, int out_size, void* d_ws, size_t ws_size,
                              hipStream_t stream) {
  (void)in_sizes; (void)n_in; (void)out_size; (void)ws_size;
  P p{};
  const float** f = (const float**)&p;
  for (int i = 0; i < 39; ++i) f[i] = (const float*)d_in[i];
  p.out = (float*)d_out;
  char* w = (char*)d_ws;
  size_t off = 0;
  auto take = [&](size_t bytes) { char* r = w + off; off += al256(bytes); return r; };
  p.bar = (unsigned*)take(16384);
  p.modv = (float*)take((size_t)DEPTH * 17 * 6144 * 4);
  p.SSQ = (float*)take((size_t)DEPTH * 2 * 256 * 4);
  p.wq = (unsigned*)take(4096 + DEPTH * 1024);
  p.cuclaim = (unsigned*)take((size_t)DEPTH * 4096 * 4);
  const size_t zero_bytes = off;
  p.rope = (float*)take(64 * 16 * 2 * 4);
  p.X = (bf16_t*)take((size_t)NTOK * D * 2);
  p.H = (bf16_t*)take((size_t)NTOK * D * 2);
  p.Y = (bf16_t*)take((size_t)NTOK * D * 2);
  p.SC = (bf16_t*)take((size_t)NTOK * 1024 * 2);
  p.Z = (bf16_t*)take((size_t)NTOK * INW * 2);
  p.UTl = (bf16_t*)take((size_t)256 * 16 * T * 2);
  p.UTc = (bf16_t*)take((size_t)256 * 16 * LC * 2);
  p.YTl = (bf16_t*)take((size_t)256 * 16 * T * 2);
  p.YTc = (bf16_t*)take((size_t)256 * 16 * LC * 2);
  p.FL = (float*)take((size_t)256 * 2 * T * 4);
  p.FC = (float*)take((size_t)256 * 2 * LC * 4);
  p.W1t = (bf16_t*)take((size_t)INW * D * 2);
  p.W2t = (bf16_t*)take((size_t)D * D * 2);
  p.Wft = (bf16_t*)take((size_t)2048 * D * 2);
  p.Wlt = (bf16_t*)take((size_t)1024 * 256 * 2);
  p.Wgt = (bf16_t*)take((size_t)256 * 128 * 2);
  p.TK = (float*)p.Z;
  p.PU = (unsigned char*)p.Z + al256((size_t)NTOK * 256 * 4);
  p.PV = p.PU + (size_t)16384 * 1024;
  p.PSU = (float*)(p.PV + (size_t)16384 * 1024);
  p.PSV = p.PSU + 16384;
  p.GT = p.PSV + 16384;
  p.EL = (unsigned short*)(p.GT + (size_t)NTOK * 128);
  p.H8 = (unsigned char*)p.EL + al256((size_t)NTOK * 128 * 2);
  p.HINV = (float*)(p.H8 + (size_t)NTOK * 1024);
  p.PD = p.Y;

  (void)hipMemsetAsync(d_ws, 0, zero_bytes, stream);
  constexpr size_t kDynLds = SMEM_BYTES + 32;
  static int grid = 0;
  if (!grid) {
    int dev = 0, cus = 0, per_cu = 0;
    (void)hipGetDevice(&dev);
    (void)hipDeviceGetAttribute(&cus, hipDeviceAttributeMultiprocessorCount, dev);
    (void)hipFuncSetAttribute((const void*)k_mega, hipFuncAttributeMaxDynamicSharedMemorySize, (int)kDynLds);
    (void)hipOccupancyMaxActiveBlocksPerMultiprocessor(&per_cu, k_mega, 256, kDynLds);
    if (cus <= 0) cus = 256;
    if (per_cu > 2) per_cu = 2;
    if (per_cu < 1) per_cu = 1;
    grid = cus * per_cu;
  }
  k_mega<<<grid, 256, kDynLds, stream>>>(p);
}
```

```cpp
#include <hip/hip_runtime.h>
#include <stdint.h>
#include <type_traits>

#define DEV __device__ __forceinline__
typedef unsigned short bf16_t;
typedef short bf16x8 __attribute__((ext_vector_type(8)));
typedef float f32x2 __attribute__((ext_vector_type(2)));
constexpr size_t PSLICE = (size_t)16384 * 128;
typedef float f32x4 __attribute__((ext_vector_type(4)));
typedef float f32x16 __attribute__((ext_vector_type(16)));


constexpr int NB = 16, T = 4096, LC = 256, LT = 4352, D = 1024, NTOK = NB * LT, INW = 2688, DEPTH = 4;
constexpr int SMEM_BYTES = 65536;

struct P {
  const float *x, *c, *ctx, *c_ctx, *mod_w, *mod_b, *norm1_g, *norm2_g, *w_in, *conv_w, *conv_b;
  const float *hy_w1, *hy_b1, *hy_w2, *hy_b2, *hy_w3, *hy_b3, *hy_freq, *hy_bias;
  const float *rw_w0, *rw_w_up, *rw_a0, *rw_a_up, *rw_g_up, *rw_k_k, *rw_k_a, *rw_r_k, *rw_ln_w, *rw_ln_b;
  const float *attn_sink, *hy_out_g, *at_out_g, *w_out, *peer_wq, *peer_k1, *peer_k2, *peer_u, *peer_v, *final_g;
  float* out;
  unsigned* bar;
  float *modv, *SSQ, *rope, *FL, *FC, *TK;
  unsigned *wq, *cuclaim;
  bf16_t *X, *H, *Y, *SC, *Z, *UTl, *UTc, *YTl, *YTc;
  bf16_t *W1t, *W2t, *Wft, *Wlt, *Wgt;
  unsigned char *PU, *PV;
  float *PSU, *PSV, *GT, *HINV;
  bf16_t* PD;
  unsigned short* EL;
  unsigned char* H8;
};

typedef __bf16 hwbf2 __attribute__((ext_vector_type(2)));
DEV unsigned pack2(float a, float b) { f32x2 f = {a, b}; hwbf2 r = __builtin_convertvector(f, hwbf2); return __builtin_bit_cast(unsigned, r); }
DEV bf16_t f2bf(float f) { return (bf16_t)(pack2(f, 0.f) & 0xFFFFu); }
DEV float bf2f(bf16_t h) { return __uint_as_float(((unsigned)h) << 16); }
DEV float bflo(unsigned u) { return __uint_as_float(u << 16); }
DEV float bfhi(unsigned u) { return __uint_as_float(u & 0xFFFF0000u); }
DEV void unpack8(const uint4& u, float* v) {
  v[0] = bflo(u.x); v[1] = bfhi(u.x); v[2] = bflo(u.y); v[3] = bfhi(u.y);
  v[4] = bflo(u.z); v[5] = bfhi(u.z); v[6] = bflo(u.w); v[7] = bfhi(u.w);
}
DEV uint4 pack8(const float* v) { return make_uint4(pack2(v[0], v[1]), pack2(v[2], v[3]), pack2(v[4], v[5]), pack2(v[6], v[7])); }
DEV int pack_i8(float a, float b, float c, float d) {
  const int ia = __float2int_rn(a), ib = __float2int_rn(b), ic = __float2int_rn(c), id = __float2int_rn(d);
  return (ia & 0xFF) | ((ib & 0xFF) << 8) | ((ic & 0xFF) << 16) | ((id & 0xFF) << 24);
}
DEV float sigmoidf_(float x) { return __builtin_amdgcn_rcpf(1.f + __expf(-x)); }

template <int CTRL, int ROWMASK>
DEV float dpp0(float x) {
  return __builtin_bit_cast(float, __builtin_amdgcn_update_dpp(0, __builtin_bit_cast(int, x), CTRL, ROWMASK, 0xF, false));
}
template <int CTRL, int ROWMASK>
DEV float dppself(float x) {
  int xi = __builtin_bit_cast(int, x);
  return __builtin_bit_cast(float, __builtin_amdgcn_update_dpp(xi, xi, CTRL, ROWMASK, 0xF, false));
}
DEV float readlane_f(float x, int l) { return __builtin_bit_cast(float, __builtin_amdgcn_readlane(__builtin_bit_cast(int, x), l)); }
DEV int lane_id() { return (int)__builtin_amdgcn_mbcnt_hi(~0u, __builtin_amdgcn_mbcnt_lo(~0u, 0u)); }
DEV float writelane_f(float val, int l, float old) { return lane_id() == l ? val : old; }
DEV int writelane_i(int val, int l, int old) { return lane_id() == l ? val : old; }
DEV float wave_sum(float x) {
  x += dpp0<0x111, 0xF>(x); x += dpp0<0x112, 0xF>(x); x += dpp0<0x114, 0xF>(x); x += dpp0<0x118, 0xF>(x);
  x += dpp0<0x142, 0xA>(x); x += dpp0<0x143, 0xC>(x);
  return readlane_f(x, 63);
}
DEV float wave_max(float x) {
  x = fmaxf(x, dppself<0x111, 0xF>(x)); x = fmaxf(x, dppself<0x112, 0xF>(x)); x = fmaxf(x, dppself<0x114, 0xF>(x));
  x = fmaxf(x, dppself<0x118, 0xF>(x)); x = fmaxf(x, dppself<0x142, 0xA>(x)); x = fmaxf(x, dppself<0x143, 0xC>(x));
  return readlane_f(x, 63);
}
DEV float row16_sum(float x) {
  x += dpp0<0xB1, 0xF>(x); x += dpp0<0x4E, 0xF>(x); x += dpp0<0x141, 0xF>(x); x += dpp0<0x140, 0xF>(x);
  return x;
}
DEV float row16_max(float x) {
  x = fmaxf(x, dppself<0xB1, 0xF>(x)); x = fmaxf(x, dppself<0x4E, 0xF>(x)); x = fmaxf(x, dppself<0x141, 0xF>(x));
  x = fmaxf(x, dppself<0x140, 0xF>(x));
  return x;
}
DEV float quad_sum(float x) { x += dpp0<0xB1, 0xF>(x); x += dpp0<0x4E, 0xF>(x); return x; }

DEV f32x4 mfma16(bf16x8 a, bf16x8 b, f32x4 c) { return __builtin_amdgcn_mfma_f32_16x16x32_bf16(a, b, c, 0, 0, 0); }
DEV f32x16 mfma32(bf16x8 a, bf16x8 b, f32x16 c) { return __builtin_amdgcn_mfma_f32_32x32x16_bf16(a, b, c, 0, 0, 0); }


#define XB_TMO      128
#define XB_XCNT(j)  (256  + 64 * (j))
#define XB_XSUB(j)  (1280 + 64 * (j))
#define XB_XGEN(j)  (2304 + 64 * (j))
#define XB_TOP      3328
#define XB_TOPGEN   3392
#define XCD_BAR_WORDS 3456
#define XB_SPIN_CAP (1u << 23)
#define LAS __attribute__((address_space(3)))

__device__ __forceinline__ unsigned xb_ld(unsigned* p)              { return __hip_atomic_load(p, __ATOMIC_RELAXED, __HIP_MEMORY_SCOPE_AGENT); }
__device__ __forceinline__ unsigned xb_add(unsigned* p, unsigned v) { return __hip_atomic_fetch_add(p, v, __ATOMIC_RELAXED, __HIP_MEMORY_SCOPE_AGENT); }
__device__ __forceinline__ unsigned xb_xcc_id() { return (unsigned)__builtin_amdgcn_s_getreg((3 << 11) | 20) & 0xFu; }
#define XB_SPIN(cond, bar) do { unsigned _sp = 0; while (cond) { __builtin_amdgcn_s_sleep(1); \
    if ((++_sp & 255u) == 0u) { if (xb_ld(&(bar)[XB_TMO])) break; if (_sp > XB_SPIN_CAP) { atomicAdd(&(bar)[XB_TMO], 1u); break; } } } } while (0)

struct XcdBarrier {
    unsigned* bar; unsigned x;
    volatile LAS unsigned* st;
};
__device__ __forceinline__ XcdBarrier xcd_barrier_post(unsigned* bar, volatile LAS unsigned* st) {
    XcdBarrier b; b.bar = bar; b.x = xb_xcc_id(); b.st = st;
    if (threadIdx.x == 0) (void)xb_add(&bar[XB_XCNT(b.x)], 1u);
    return b;
}
__device__ __forceinline__ void xcd_barrier_complete(unsigned* bar, unsigned x, unsigned& nloc, unsigned& nx) {
    const unsigned G = gridDim.x * gridDim.y * gridDim.z;
    unsigned sum, cnt, mine, sp = 0u;
    for (;;) {
        sum = 0u; cnt = 0u; mine = 0u;
#pragma unroll
        for (unsigned j = 0; j < 16; ++j) { const unsigned c = xb_ld(&bar[XB_XCNT(j)]); sum += c; cnt += (c > 0u) ? 1u : 0u; mine = (j == x) ? c : mine; }
        if (sum == G) break;
        __builtin_amdgcn_s_sleep(1);
        if ((++sp & 255u) == 0u) { if (xb_ld(&bar[XB_TMO])) break; if (sp > XB_SPIN_CAP) { atomicAdd(&bar[XB_TMO], 1u); break; } }
    }
    nloc = mine > 0u ? mine : 1u; nx = cnt > 0u ? cnt : 1u;
}
__device__ __forceinline__ void xcd_barrier(const XcdBarrier& b) {
    asm volatile("s_waitcnt vmcnt(0)" ::: "memory");
    __syncthreads();
    if (threadIdx.x == 0) {
        unsigned* bar = b.bar;
        __builtin_amdgcn_s_waitcnt(0);
        unsigned nloc = b.st[0], nx = b.st[1];
        if (nloc == 0u) { xcd_barrier_complete(bar, b.x, nloc, nx); b.st[0] = nloc; b.st[1] = nx; }
        const unsigned old = xb_add(&bar[XB_XSUB(b.x)], 1u);
        const unsigned gen = old / nloc;
        if (old + 1u == (gen + 1u) * nloc) {
            __builtin_amdgcn_fence(__ATOMIC_RELEASE, "agent");
            asm volatile("s_waitcnt vmcnt(0)" ::: "memory");
            const unsigned og = xb_add(&bar[XB_TOP], 1u);
            const unsigned tg = og / nx;
            if (og + 1u == (tg + 1u) * nx) xb_add(&bar[XB_TOPGEN], 1u);
            else XB_SPIN(xb_ld(&bar[XB_TOPGEN]) == tg, bar);
            __builtin_amdgcn_fence(__ATOMIC_ACQUIRE, "agent");
            xb_add(&bar[XB_XGEN(b.x)], 1u);
            asm volatile("s_waitcnt vmcnt(0)" ::: "memory");
        } else {
            XB_SPIN(xb_ld(&bar[XB_XGEN(b.x)]) == gen, bar);
            __builtin_amdgcn_fence(__ATOMIC_ACQUIRE, "agent");
            asm volatile("s_waitcnt vmcnt(0)" ::: "memory");
        }
    }
    __syncthreads();
}

template <class Tp> DEV Tp* opq(Tp* q) { asm volatile("" : "+s"(q)); return q; }
DEV int tid_() { int t = threadIdx.x; asm volatile("" : "+v"(t)); return t; }
DEV int bid_() { int b = blockIdx.x; asm volatile("" : "+s"(b)); return b; }

DEV void glds16(const void* gsrc, char* lds_lane_ptr) {
  __builtin_amdgcn_global_load_lds((const unsigned*)gsrc, (__attribute__((address_space(3))) unsigned*)lds_lane_ptr, 16, 0, 0);
}
template <class Epi>
DEV void gemm_tile(const bf16_t* __restrict__ A, int lda, const bf16_t* __restrict__ Bt, int ldb, int K, char* smem, Epi& epi) {
  const int tid = tid_(), lane = tid & 63, wid = tid >> 6, wr = wid >> 1, wc = wid & 1, fr = lane & 15, fq = lane >> 4;
  f32x4 acc[4][4];
#pragma unroll
  for (int m = 0; m < 4; ++m)
#pragma unroll
    for (int n = 0; n < 4; ++n) acc[m][n] = (f32x4){0.f, 0.f, 0.f, 0.f};
  const int drow0 = 8 * wid + (lane >> 3), dpc = lane & 7;
  auto issue = [&](int kt, int buf) {
    char* sa = smem + buf * 32768;
    char* sb = sa + 16384;
#pragma unroll
    for (int i = 0; i < 4; ++i) {
      const int row = drow0 + 32 * i;
      const int kc = dpc ^ ((row >> 1) & 7);
      glds16(A + (size_t)row * lda + kt * 64 + kc * 8, sa + (i * 4 + wid) * 1024 + lane * 16);
      glds16(Bt + (size_t)row * ldb + kt * 64 + kc * 8, sb + (i * 4 + wid) * 1024 + lane * 16);
    }
  };
  __syncthreads();
  issue(0, 0);
  const int nk = K >> 6;
  const int sw = (fr >> 1) & 7;
  const int aoff = (wr * 64 + fr) * 128, boff = (wc * 64 + fr) * 128;
  for (int kt = 0; kt < nk; ++kt) {
    asm volatile("s_waitcnt vmcnt(0)" ::: "memory");
    __syncthreads();
    if (kt + 1 < nk) issue(kt + 1, (kt + 1) & 1);
    const char* sa = smem + (kt & 1) * 32768;
    const char* sb = sa + 16384;
#pragma unroll
    for (int kh = 0; kh < 2; ++kh) {
      const int pc = ((kh * 4 + fq) ^ sw) * 16;
      bf16x8 af[4], bfr[4];
#pragma unroll
      for (int m = 0; m < 4; ++m) af[m] = *(const bf16x8*)(sa + aoff + m * 2048 + pc);
#pragma unroll
      for (int n = 0; n < 4; ++n) bfr[n] = *(const bf16x8*)(sb + boff + n * 2048 + pc);
#pragma unroll
      for (int m = 0; m < 4; ++m)
#pragma unroll
        for (int n = 0; n < 4; ++n) acc[m][n] = mfma16(af[m], bfr[n], acc[m][n]);
    }
  }
  __syncthreads();
  epi(acc, wr, wc, fr, fq, smem);
}
DEV void stage_tile_bf16(const f32x4 (&acc)[4][4], char* smem, int wid, int fr, int fq) {
  bf16_t (*t)[72] = (bf16_t (*)[72])(smem + wid * 9216);
#pragma unroll
  for (int m = 0; m < 4; ++m)
#pragma unroll
    for (int n = 0; n < 4; ++n)
#pragma unroll
      for (int j = 0; j < 4; ++j) t[m * 16 + fq * 4 + j][n * 16 + fr] = f2bf(acc[m][n][j]);
  asm volatile("s_waitcnt lgkmcnt(0)" ::: "memory");
}

DEV void ph_copy(const P& p) {
  const size_t n8 = (size_t)NTOK * D / 8;
  const float* pctx = opq(p.ctx); const float* px = opq(p.x);
  for (size_t i = (size_t)bid_() * 256 + tid_(); i < n8; i += (size_t)gridDim.x * 256) {
    size_t e = i * 8;
    int row = (int)(e / D), col = (int)(e % D);
    int b = row / LT, pp = row % LT;
    const float* src = pp < LC ? pctx + ((size_t)(b * LC + pp)) * D + col : px + ((size_t)(b * T + pp - LC)) * D + col;
    float4 v0 = *(const float4*)src, v1 = *(const float4*)(src + 4);
    uint4 o = make_uint4(pack2(v0.x, v0.y), pack2(v0.z, v0.w), pack2(v1.x, v1.y), pack2(v1.z, v1.w));
    *(uint4*)(p.X + e) = o;
  }
}

DEV void ph_rope(const P& p) {
  for (int i = bid_() * 256 + tid_(); i < 64 * 16; i += gridDim.x * 256) {
    int pos = i >> 4, k = i & 15;
    float inv = powf(10000.f, -(float)k / 16.f);
    float ang = (float)pos * inv;
    p.rope[2 * i] = cosf(ang); p.rope[2 * i + 1] = sinf(ang);
  }
}

DEV void modv_unit(const P& p, int unit, char* smem) {
  const int cc = unit % 24, layer = unit / 24;
  float (*cs)[128] = (float (*)[128])smem;
  const int col = cc * 256 + tid_();
  const float* pc = opq(p.c); const float* pcc = opq(p.c_ctx);
  float acc[17];
#pragma unroll
  for (int r = 0; r < 17; ++r) acc[r] = 0.f;
  for (int ks = 0; ks < 8; ++ks) {
    __syncthreads();
    for (int i = tid_(); i < 17 * 128; i += 256) {
      int r = i >> 7, e = i & 127;
      float v = r < 16 ? pc[r * D + ks * 128 + e] : pcc[ks * 128 + e];
      cs[r][e] = v / (1.f + expf(-v));
    }
    __syncthreads();
    const float* w = p.mod_w + ((size_t)layer * D + ks * 128) * 6144 + col;
#pragma unroll 4
    for (int e = 0; e < 128; ++e) {
      float wv = w[(size_t)e * 6144];
#pragma unroll
      for (int r = 0; r < 17; ++r) acc[r] += cs[r][e] * wv;
    }
  }
  const float bias = p.mod_b[layer * 6144 + col];
#pragma unroll
  for (int r = 0; r < 17; ++r) p.modv[((size_t)layer * 17 + r) * 6144 + col] = acc[r] + bias;
}

DEV void transpose_unit(const float* __restrict__ src, bf16_t* __restrict__ dst, int R, int C, int tile, char* smem) {
  float (*t)[65] = (float (*)[65])smem;
  const int nct = C / 64;
  const int tr = tile / nct, tc = tile % nct;
  __syncthreads();
  for (int i = tid_(); i < 4096; i += 256) { int r = i >> 6, c = i & 63; t[r][c] = src[(size_t)(tr * 64 + r) * C + tc * 64 + c]; }
  __syncthreads();
  for (int i = tid_(); i < 4096; i += 256) { int c = i >> 6, r = i & 63; dst[(size_t)(tc * 64 + c) * R + tr * 64 + r] = f2bf(t[r][c]); }
}

DEV void wfold_unit(const P& p, int layer, int unit, char* smem) {
  const int hs = unit >> 5, ec = unit & 31, h = hs >> 1, s = hs & 1;
  const float* wq = p.peer_wq + (size_t)layer * D * 2048;
  const float* kk = (s ? opq(p.peer_k2) : opq(p.peer_k1)) + ((size_t)layer * 8 + h) * 128 * 128;
  float (*kS)[65] = (float (*)[65])smem;
  float (*wS)[64] = (float (*)[64])(smem + 33280);
  const int key = tid_() & 127, eh = tid_() >> 7;
  float acc[16];
#pragma unroll
  for (int i = 0; i < 16; ++i) acc[i] = 0.f;
  for (int dh = 0; dh < 2; ++dh) {
    __syncthreads();
    for (int i = tid_(); i < 128 * 64; i += 256) { int k2 = i >> 6, d = i & 63; kS[k2][d] = kk[k2 * 128 + dh * 64 + d]; }
    for (int i = tid_(); i < 32 * 64; i += 256) {
      int e = i >> 6, d = i & 63;
      wS[e][d] = wq[(size_t)(ec * 32 + e) * 2048 + h * 256 + s * 128 + dh * 64 + d];
    }
    __syncthreads();
#pragma unroll 2
    for (int d = 0; d < 64; ++d) {
      float kv = kS[key][d];
#pragma unroll
      for (int i = 0; i < 16; ++i) acc[i] += kv * wS[eh * 16 + i][d];
    }
  }
  bf16_t* dst = p.Wft + ((size_t)(hs * 128 + key)) * D + ec * 32 + eh * 16;
#pragma unroll
  for (int i = 0; i < 16; i += 2) *(unsigned*)(dst + i) = pack2(acc[i], acc[i + 1]);
}

DEV void filt_unit(const P& p, int layer, int unit, char* smem) {
  int kind, j0, L;
  if (unit < 1024) { kind = 0; j0 = unit * 4; L = T; } else { kind = 1; j0 = (unit - 1024) * 4; L = LC; }
  float* zs = (float*)smem;
  float* h1 = zs + 4 * 36;
  float* h2 = h1 + 256;
  const int jj = tid_() >> 6, o = tid_() & 63;
  const int j = j0 + jj;
  const float fj = (float)j;
  const float t = fj / (float)(L - 1);
  __syncthreads();
  if (o < 33) {
    float z;
    if (o == 0) z = t;
    else {
      int i = (o - 1) & 15;
      float band = 1e-4f + (float)i * ((15.0f - 1e-4f) / 15.0f);
      float ang = 6.283185307179586f * fj * band / (float)L;
      z = (o <= 16) ? cosf(ang) : -sinf(ang);
    }
    zs[jj * 36 + o] = z;
  }
  __syncthreads();
  {
    const float* w1 = p.hy_w1 + layer * 33 * 64;
    float a = p.hy_b1[layer * 64 + o];
#pragma unroll 3
    for (int i = 0; i < 33; ++i) a += zs[jj * 36 + i] * w1[i * 64 + o];
    h1[jj * 64 + o] = sinf(p.hy_freq[layer * 128 + o] * a);
  }
  __syncthreads();
  {
    const float* w2 = p.hy_w2 + layer * 64 * 64;
    float a = p.hy_b2[layer * 64 + o];
#pragma unroll 4
    for (int i = 0; i < 64; ++i) a += h1[jj * 64 + i] * w2[i * 64 + o];
    h2[jj * 64 + o] = sinf(p.hy_freq[layer * 128 + 64 + o] * a);
  }
  __syncthreads();
  const float* w3 = p.hy_w3 + layer * 64 * 512;
  float* F = kind ? opq(p.FC) : opq(p.FL);
  const float DMIN = -3.0701134573253945f, DMAX = -15.350567286626973f;
#pragma unroll 1
  for (int m = 0; m < 4; ++m) {
    int c = o + 64 * m;
    float af = p.hy_b3[layer * 512 + c], ab = p.hy_b3[layer * 512 + 256 + c];
#pragma unroll 4
    for (int i = 0; i < 64; ++i) { float hv = h2[jj * 64 + i]; af += hv * w3[i * 512 + c]; ab += hv * w3[i * 512 + 256 + c]; }
    float delta = fabsf(DMIN + (float)c * ((DMAX - DMIN) / 255.f));
    float win = expf(-t * delta) + 0.05f;
    af *= win; ab *= win;
    F[((size_t)c * 2 + 0) * L + j] = af;
    F[((size_t)c * 2 + 1) * L + j] = ab;
  }
}

constexpr int PREP_T0 = 672, PREP_T1 = PREP_T0 + 256, PREP_T2 = PREP_T1 + 8, PREP_T3 = PREP_T2 + 8, PREP_T4 = PREP_T3 + 8;
constexpr int PREP_WF = PREP_T4 + 512, PREP_N = PREP_WF + 1088;
DEV void prep_unit(const P& p, int layer, int u, char* smem) {
  if (u < PREP_T0) transpose_unit(p.w_in + (size_t)layer * D * INW, p.W1t, D, INW, u, smem);
  else if (u < PREP_T1) transpose_unit(p.w_out + (size_t)layer * D * D, p.W2t, D, D, u - PREP_T0, smem);
  else if (u < PREP_T3) {
    const int u0 = u - PREP_T1;
    for (int i = tid_(); i < 64 * 256; i += 256) {
      const int np = u0 * 64 + (i >> 8), kp = i & 255;
      const int ps = np & 3, chan = np >> 2, qp = kp >> 6, kk = kp & 63;
      const int is_a = ps & 1, d = ps >> 1;
      float v = 0.f;
      if (qp == (is_a ? 2 + d : d)) v = (is_a ? opq(p.rw_a_up) : opq(p.rw_w_up))[(((size_t)layer * 2 + d) * 64 + kk) * 256 + chan];
      p.Wlt[(size_t)np * 256 + kp] = f2bf(v);
    }
  }
  else if (u < PREP_T4) transpose_unit(p.rw_g_up + (size_t)layer * 128 * 256, p.Wgt, 128, 256, u - PREP_T3, smem);
  else if (u < PREP_WF) wfold_unit(p, layer, u - PREP_T4, smem);
  else filt_unit(p, layer, u - PREP_WF, smem);
}
constexpr int PREPA_N = PREP_T0 + (PREP_T4 - PREP_T1);
DEV int prepA_unit_index(int i) { return i < PREP_T0 ? i : PREP_T1 + (i - PREP_T0); }
DEV void ph_prep(const P& p, int layer, char* smem, bool onlyB) {
  for (int u = bid_(); u < PREP_N; u += gridDim.x) {
    const bool isA = (u < PREP_T0) || (u >= PREP_T1 && u < PREP_T4);
    if (onlyB && isA) continue;
    prep_unit(p, layer, u, smem);
  }
}

DEV void wave_range(int& r0, int& r1, int ntok) {
  const int gw = (bid_() * 256 + tid_()) >> 6, nw = gridDim.x * 4;
  const int per = (ntok + nw - 1) / nw;
  r0 = gw * per; r1 = r0 + per; if (r1 > ntok) r1 = ntok;
}
DEV void ph_norm(const P& p, int layer, int which) {
  const int lane = tid_() & 63;
  int r0, r1;
  wave_range(r0, r1, NTOK);
  const float* g = (which ? p.norm2_g : p.norm1_g) + layer * D;
  float gv[16], scv[16], shv[16];
#pragma unroll
  for (int hh = 0; hh < 2; ++hh)
#pragma unroll
    for (int i = 0; i < 8; ++i) gv[hh * 8 + i] = g[hh * 512 + 8 * lane + i];
  int mr_cur = -1;
  uint4 n0 = make_uint4(0, 0, 0, 0), n1 = n0;
  if (r0 < r1) { const bf16_t* xr = p.X + (size_t)r0 * D; n0 = *(const uint4*)(xr + 8 * lane); n1 = *(const uint4*)(xr + 512 + 8 * lane); }
#pragma unroll 1
  for (int row = r0; row < r1; ++row) {
    const uint4 u0 = n0, u1 = n1;
    if (row + 1 < r1) { const bf16_t* xr = p.X + (size_t)(row + 1) * D; n0 = *(const uint4*)(xr + 8 * lane); n1 = *(const uint4*)(xr + 512 + 8 * lane); }
    const int b = row / LT, pp = row % LT;
    const int mr = pp < LC ? 16 : b;
    if (mr != mr_cur) {
      mr_cur = mr;
      const float* mv = p.modv + ((size_t)layer * 17 + mr) * 6144 + (which ? 3072 : 0);
#pragma unroll
      for (int hh = 0; hh < 2; ++hh)
#pragma unroll
        for (int i = 0; i < 8; ++i) { shv[hh * 8 + i] = mv[hh * 512 + 8 * lane + i]; scv[hh * 8 + i] = 1.f + mv[1024 + hh * 512 + 8 * lane + i]; }
    }
    float v[16];
    unpack8(u0, v); unpack8(u1, v + 8);
    float ss = 0.f;
#pragma unroll
    for (int i = 0; i < 16; ++i) ss += v[i] * v[i];
    ss = wave_sum(ss);
    const float rstd = rsqrtf(ss * (1.f / 1024.f) + 1e-6f);
    float o[16];
#pragma unroll
    for (int i = 0; i < 16; ++i) o[i] = (v[i] * rstd * gv[i]) * scv[i] + shv[i];
    bf16_t* hr = p.H + (size_t)row * D;
    *(uint4*)(hr + 8 * lane) = pack8(o);
    *(uint4*)(hr + 512 + 8 * lane) = pack8(o + 8);
    if (which) {
      float am = 0.f;
#pragma unroll
      for (int i = 0; i < 16; ++i) am = fmaxf(am, fabsf(o[i]));
      am = wave_max(am);
      const float sc = am > 0.f ? 127.f / am : 1.f;
      unsigned char* h8 = p.H8 + (size_t)row * 1024;
      *(uint2*)(h8 + 8 * lane) = make_uint2((unsigned)pack_i8(o[0] * sc, o[1] * sc, o[2] * sc, o[3] * sc), (unsigned)pack_i8(o[4] * sc, o[5] * sc, o[6] * sc, o[7] * sc));
      *(uint2*)(h8 + 512 + 8 * lane) = make_uint2((unsigned)pack_i8(o[8] * sc, o[9] * sc, o[10] * sc, o[11] * sc), (unsigned)pack_i8(o[12] * sc, o[13] * sc, o[14] * sc, o[15] * sc));
      if (lane == 0) p.HINV[row] = am > 0.f ? am * (1.f / 127.f) : 1.f;
    }
  }
}

DEV bool gemm_unit(int it, int nct, int& rt, int& ct) {
  const int nslot = gridDim.x >> 3;
  const int x = bid_() & 7, sl = bid_() >> 3;
  if (sl >= nslot) return false;
  const int v = it * nslot + sl;
  if (v >= 68 * nct) return false;
  const int rg = v / (8 * nct), rem = v - rg * 8 * nct;
  const int rows = (rg == 8) ? 4 : 8;
  ct = rem / rows;
  rt = x * 68 + rg * 8 + (rem - ct * rows);
  return true;
}
struct Epi1 {
  const P& p; int row0, col0;
  DEV void operator()(f32x4 (&acc)[4][4], int wr, int wc, int fr, int fq, char* smem) const {
    const int cw = col0 + wc * 64;
    const int rbase = row0 + wr * 64;
    const bool lat = (row0 % LT) >= LC;
    if (cw >= 1536 && cw < 1664) {
#pragma unroll
      for (int m = 0; m < 4; ++m)
#pragma unroll
        for (int n = 0; n < 4; ++n)
#pragma unroll
          for (int j = 0; j < 4; ++j) acc[m][n][j] = 2.f * sigmoidf_(2.f * acc[m][n][j]) - 1.f;
    } else if (cw >= 1792 && cw < 1920) {
#pragma unroll
      for (int m = 0; m < 4; ++m)
#pragma unroll
        for (int n = 0; n < 4; ++n)
#pragma unroll
          for (int j = 0; j < 4; ++j) acc[m][n][j] = sigmoidf_(acc[m][n][j]);
    } else if (cw >= 1920 && cw < 2560 && lat) {
#pragma unroll
      for (int m = 0; m < 4; ++m)
#pragma unroll
        for (int j = 0; j < 4; ++j) {
          int row = rbase + m * 16 + fq * 4 + j;
          int pl = (row % LT) - LC;
          int ri = pl >> 6, ci = pl & 63;
          float2 cr = *(const float2*)(p.rope + 2 * (ri * 16 + fr));
          float2 cc = *(const float2*)(p.rope + 2 * (ci * 16 + fr));
          float x1 = acc[m][0][j], x2 = acc[m][1][j];
          acc[m][0][j] = x1 * cr.x - x2 * cr.y; acc[m][1][j] = x2 * cr.x + x1 * cr.y;
          x1 = acc[m][2][j]; x2 = acc[m][3][j];
          acc[m][2][j] = x1 * cc.x - x2 * cc.y; acc[m][3][j] = x2 * cc.x + x1 * cc.y;
        }
    }
    const int wid = wr * 2 + wc, lane = fq * 16 + fr;
    stage_tile_bf16(acc, smem, wid, fr, fq);
    const bf16_t (*t)[72] = (const bf16_t (*)[72])(smem + wid * 9216);
#pragma unroll
    for (int i = 0; i < 8; ++i) {
      const int rl = i * 8 + (lane >> 3), ch = lane & 7;
      *(uint4*)(p.Z + (size_t)(rbase + rl) * INW + cw + ch * 8) = *(const uint4*)&t[rl][ch * 8];
    }
  }
};
DEV void ph_gemm1(const P& p, char* smem) {
  const int nct = INW / 128;
  int rt, ct;
  for (int it = 0; gemm_unit(it, nct, rt, ct); ++it) {
    Epi1 epi{p, rt * 128, ct * 128};
    gemm_tile(p.H + (size_t)rt * 128 * D, D, p.W1t + (size_t)ct * 128 * D, D, D, smem, epi);
  }
}

struct EpiLoraA {
  const P& p; int layer, row0, col0;
  DEV void operator()(f32x4 (&acc)[4][4], int wr, int wc, int fr, int fq, char* smem) const {
    const int ps = fr & 3, is_a = ps & 1, dd = ps >> 1;
    const float scale = is_a ? 1.f : 0.6065306597126334f;
    const float* bias0 = (is_a ? opq(p.rw_a0) : opq(p.rw_w0)) + (layer * 2 + dd) * 256;
#pragma unroll
    for (int n = 0; n < 4; ++n) {
      const int chan = (col0 + wc * 64 + n * 16 + fr) >> 2;
      const float bias = bias0[chan];
#pragma unroll
      for (int m = 0; m < 4; ++m)
#pragma unroll
        for (int j = 0; j < 4; ++j) acc[m][n][j] = scale * sigmoidf_(acc[m][n][j] + bias);
    }
    const int wid = wr * 2 + wc, lane = fq * 16 + fr;
    stage_tile_bf16(acc, smem, wid, fr, fq);
    const bf16_t (*t)[72] = (const bf16_t (*)[72])(smem + wid * 9216);
#pragma unroll
    for (int i = 0; i < 8; ++i) {
      const int rl = i * 8 + (lane >> 3), ch = lane & 7;
      *(uint4*)(p.SC + (size_t)(row0 + wr * 64 + rl) * 1024 + col0 + wc * 64 + ch * 8) = *(const uint4*)&t[rl][ch * 8];
    }
  }
};
struct EpiLoraG {
  const P& p; int row0, col0;
  DEV void operator()(f32x4 (&acc)[4][4], int wr, int wc, int fr, int fq, char* smem) const {
    const int wid = wr * 2 + wc, lane = fq * 16 + fr;
    stage_tile_bf16(acc, smem, wid, fr, fq);
    const bf16_t (*t)[72] = (const bf16_t (*)[72])(smem + wid * 9216);
#pragma unroll
    for (int i = 0; i < 8; ++i) {
      const int rl = i * 8 + (lane >> 3), ch = lane & 7;
      *(uint4*)(p.Y + (size_t)(row0 + wr * 64 + rl) * D + 256 + col0 + wc * 64 + ch * 8) = *(const uint4*)&t[rl][ch * 8];
    }
  }
};
DEV void ph_lora(const P& p, int layer, char* smem) {
  int rt, ct;
  for (int it = 0; gemm_unit(it, 10, rt, ct); ++it) {
    if (ct < 8) {
      EpiLoraA epi{p, layer, rt * 128, ct * 128};
      gemm_tile(p.Z + (size_t)rt * 128 * INW + 1536, INW, p.Wlt + (size_t)ct * 128 * 256, 256, 256, smem, epi);
    } else {
      EpiLoraG epi{p, rt * 128, (ct - 8) * 128};
      gemm_tile(p.Z + (size_t)rt * 128 * INW + 1792, INW, p.Wgt + (size_t)(ct - 8) * 128 * 128, 128, 128, smem, epi);
    }
  }
}

DEV void ph_rwkv_prep(const P& p, int layer) {
  const int lane = tid_() & 63;
  int r0, r1;
  wave_range(r0, r1, NTOK);
  const float* cw = p.conv_w + (size_t)layer * 3 * 1536;
  const float* cb = p.conv_b + (size_t)layer * 1536;
  float w0[3][4], w1[3][4], w2[3][4], bb[3][4], kkw[4];
#pragma unroll
  for (int a = 0; a < 3; ++a)
#pragma unroll
    for (int i = 0; i < 4; ++i) {
      const int col = 768 + a * 256 + 4 * lane + i;
      w0[a][i] = cw[col]; w1[a][i] = cw[1536 + col]; w2[a][i] = cw[3072 + col]; bb[a][i] = cb[col];
    }
#pragma unroll
  for (int i = 0; i < 4; ++i) kkw[i] = p.rw_k_k[layer * 256 + 4 * lane + i];
  uint2 zm[3], zc[3], zp[3];
  auto ldz = [&](int row, uint2 (&z)[3]) {
#pragma unroll
    for (int a = 0; a < 3; ++a) z[a] = *(const uint2*)(p.Z + (size_t)row * INW + 768 + a * 256 + 4 * lane);
  };
  auto zero3 = [&](uint2 (&z)[3]) {
#pragma unroll
    for (int a = 0; a < 3; ++a) z[a] = make_uint2(0u, 0u);
  };
  if (r0 < r1) {
    if (r0 > 0) ldz(r0 - 1, zm); else zero3(zm);
    ldz(r0, zc);
  }
#pragma unroll 1
  for (int row = r0; row < r1; ++row) {
    if (row + 1 < NTOK) ldz(row + 1, zp); else zero3(zp);
    const int pp = row % LT;
    const bool hasm = (pp != 0) && (pp != LC);
    const bool hasp = (pp != LC - 1) && (pp != LT - 1);
    float res[3][4];
#pragma unroll
    for (int a = 0; a < 3; ++a) {
      const uint2 um = hasm ? zm[a] : make_uint2(0u, 0u), uc = zc[a], up = hasp ? zp[a] : make_uint2(0u, 0u);
      const float vm[4] = {bflo(um.x), bfhi(um.x), bflo(um.y), bfhi(um.y)};
      const float vc[4] = {bflo(uc.x), bfhi(uc.x), bflo(uc.y), bfhi(uc.y)};
      const float vp[4] = {bflo(up.x), bfhi(up.x), bflo(up.y), bfhi(up.y)};
#pragma unroll
      for (int i = 0; i < 4; ++i) res[a][i] = w0[a][i] * vm[i] + w1[a][i] * vc[i] + w2[a][i] * vp[i] + bb[a][i];
    }
    float kk[4], ss = 0.f;
#pragma unroll
    for (int i = 0; i < 4; ++i) { kk[i] = res[1][i] * kkw[i]; ss += kk[i] * kk[i]; }
    ss = row16_sum(ss);
    const float rs = rsqrtf(ss + 1e-12f);
    bf16_t* hr = p.H + (size_t)row * D + 16 * lane;
    *(uint4*)hr = make_uint4(pack2(res[0][0], res[1][0]), pack2(kk[0] * rs, res[2][0]), pack2(res[0][1], res[1][1]), pack2(kk[1] * rs, res[2][1]));
    *(uint4*)(hr + 8) = make_uint4(pack2(res[0][2], res[1][2]), pack2(kk[2] * rs, res[2][2]), pack2(res[0][3], res[1][3]), pack2(kk[3] * rs, res[2][3]));
#pragma unroll
    for (int a = 0; a < 3; ++a) { zm[a] = zc[a]; zc[a] = zp[a]; }
  }
}

DEV float oct_sum(float x) { x += dpp0<0xB1, 0xF>(x); x += dpp0<0x4E, 0xF>(x); x += dpp0<0x141, 0xF>(x); return x; }
DEV bf16x8 frag_join(uint2 lo, uint2 hi) { uint4 w = make_uint4(lo.x, lo.y, hi.x, hi.y); return __builtin_bit_cast(bf16x8, w); }
constexpr int SCS_SET = 17152, SCS_IMG = 3 * SCS_SET, SCS_W0 = SCS_IMG + 2 * 3072;
DEV void scanc_unit(const P& p, int layer, int unit, char* smem) {
  const int dir = unit & 1, h = (unit >> 1) & 3, b = unit >> 3;
  const int tid = tid_(), lane = tid & 63, fr = lane & 15, fq = lane >> 4;
  const int w = __builtin_amdgcn_readfirstlane(tid >> 6);
  bf16_t* IMG0 = (bf16_t*)(smem + SCS_W0);
  bf16_t* IMG1 = IMG0 + 512;
  bf16_t* IMG2 = IMG0 + 1024;
  __syncthreads();
  for (int i = tid; i < (2 * 3072 + 3072) / 4; i += 256) ((unsigned*)(smem + SCS_IMG))[i] = 0u;
  const float ka = p.rw_k_a[layer * 256 + h * 64 + lane];
  const size_t rowbase = (size_t)b * LT;
  const char* hbase = (const char*)p.H;
  const char* sbase = (const char*)p.SC;
  const unsigned hoff = (unsigned)(rowbase * 2048) + (unsigned)((h * 64 + lane) * 8);
  const unsigned soff = hoff + 4u * (unsigned)dir;
  bf16_t* yb = p.Z + rowbase * INW + 768 + dir * 256 + h * 64 + w * 16 + fr;
  auto pos0 = [&](int c) -> int { const int t = c * 16; return dir == 0 ? t : (t < LC ? LC - 1 - t : LT - 1 - (t - LC)); };
  const int pstep = dir == 0 ? 1 : -1;
  constexpr int NCH = LT / 16;
  struct Raw { unsigned sc[16]; uint2 hr[6]; };
  auto load_raw = [&](int c, Raw& rw) {
    if (w != 0) {
      const int p0 = pos0(c);
      const unsigned so = soff + (unsigned)(p0 * 2048);
      const int st = pstep * 2048;
#pragma unroll
      for (int i = 0; i < 16; ++i) rw.sc[i] = *(const unsigned*)(sbase + (so + (unsigned)(i * st)));
      const unsigned ho = hoff + (unsigned)((p0 + pstep * (w - 1)) * 2048);
#pragma unroll
      for (int q = 0; q < 6; ++q) {
        const int qq = ((w - 1) + 3 * q < 16) ? q : 4;
        rw.hr[q] = *(const uint2*)(hbase + (ho + (unsigned)(qq * 3 * st)));
      }
    }
  };
  auto stage1w = [&](int set, const Raw& rw, auto W1tag) {
    constexpr int W1 = decltype(W1tag)::value;
    char* base = smem + set * SCS_SET;
    bf16_t (*At)[72] = (bf16_t (*)[72])(base);
    bf16_t (*Rt)[72] = (bf16_t (*)[72])(base + 2304);
    bf16_t (*Bt)[72] = (bf16_t (*)[72])(base + 4608);
    bf16_t (*Kt)[72] = (bf16_t (*)[72])(base + 6912);
    bf16_t (*BKT)[36] = (bf16_t (*)[36])(base + 9216);
    bf16_t* VV = (bf16_t*)(base + 13824);
    float* G16 = (float*)(base + 16896);
    float Erun = 0.f;
#pragma unroll
    for (int i = 0; i < 16; ++i) {
      const float ev = bflo(rw.sc[i]);
      const float Eprev = Erun;
      Erun += ev;
      if ((i % 3) == W1) {
        const uint2 hrec = rw.hr[i / 3];
        const float rr = bflo(hrec.x), kr = bfhi(hrec.x), kkv = bflo(hrec.y);
        const float av = bfhi(rw.sc[i]);
        const float gp = __expf(-Eprev), gi = __expf(-Erun), ig = __expf(Erun);
        const float at = -kkv * gp, rt = rr * gi, bt = kkv * av * ig, kt2 = kr * (1.f + (av - 1.f) * ka) * ig;
        const unsigned ar = pack2(at, rt), bk = pack2(bt, kt2);
        At[i][lane] = (bf16_t)(ar & 0xFFFFu); Rt[i][lane] = (bf16_t)(ar >> 16);
        Bt[i][lane] = (bf16_t)(bk & 0xFFFFu); Kt[i][lane] = (bf16_t)(bk >> 16);
        BKT[lane][(i >> 2) * 8 + (i & 3)] = (bf16_t)(bk & 0xFFFFu);
        BKT[lane][(i >> 2) * 8 + 4 + (i & 3)] = (bf16_t)(bk >> 16);
        VV[((i >> 2) * 64 + lane) * 6 + (i & 3)] = (bf16_t)(hrec.y >> 16);
        if (i == 15) G16[lane] = gi;
      }
    }
  };
  auto stage1 = [&](int set, const Raw& rw) {
    if (w == 1) stage1w(set, rw, std::integral_constant<int, 0>{});
    else if (w == 2) stage1w(set, rw, std::integral_constant<int, 1>{});
    else if (w == 3) stage1w(set, rw, std::integral_constant<int, 2>{});
  };
  auto stage2 = [&](int set, int iset) {
    char* base = smem + set * SCS_SET;
    const bf16_t (*At)[72] = (const bf16_t (*)[72])(base);
    const bf16_t (*Rt)[72] = (const bf16_t (*)[72])(base + 2304);
    const bf16_t (*Bt)[72] = (const bf16_t (*)[72])(base + 4608);
    const bf16_t (*Kt)[72] = (const bf16_t (*)[72])(base + 6912);
    bf16_t* TT = (bf16_t*)(smem + SCS_IMG + iset * 3072);
    bf16_t* ARK = TT + 512;
    bf16_t* AAK = TT + 1024;
    const bf16_t (*X)[72] = (w < 2) ? At : Rt;
    const bf16_t (*Y)[72] = (w & 1) ? Kt : Bt;
    f32x4 cm = (f32x4){0.f, 0.f, 0.f, 0.f};
#pragma unroll
    for (int s = 0; s < 2; ++s) {
      bf16x8 af = *(const bf16x8*)&X[fr][32 * s + 8 * fq];
      bf16x8 bm = *(const bf16x8*)&Y[fr][32 * s + 8 * fq];
      cm = mfma16(af, bm, cm);
    }
#pragma unroll
    for (int jj = 0; jj < 4; ++jj) {
      const int i = 4 * fq + jj;
      const bool keep = (w < 2) ? (fr < i) : (fr <= i);
      cm[jj] = keep ? cm[jj] : 0.f;
    }
    const int io = (fr >> 2) * 8 + (fr & 3);
    auto wr_img = [&](bf16_t* img, const f32x4& Xv, int hi) {
#pragma unroll
      for (int jj = 0; jj < 4; ++jj) img[(4 * fq + jj) * 32 + io + hi] = f2bf(Xv[jj]);
    };
    if (w == 1) wr_img(AAK, cm, 0);
    else if (w == 2) wr_img(ARK, cm, 0);
    else if (w == 3) wr_img(ARK, cm, 4);
    else {
      auto bfrag = [&](const f32x4& Xv) { return frag_join(make_uint2(pack2(Xv[0], Xv[1]), pack2(Xv[2], Xv[3])), make_uint2(0u, 0u)); };
      auto afr = [&](const bf16_t* img) { return *(const bf16x8*)&img[(fr * 4 + fq) * 8]; };
      const f32x4 Z4 = (f32x4){0.f, 0.f, 0.f, 0.f};
      wr_img(IMG0, cm, 0);
      asm volatile("" ::: "memory");
      f32x4 A2 = mfma16(afr(IMG0), bfrag(cm), Z4);
      wr_img(IMG1, A2, 0);
      asm volatile("" ::: "memory");
      f32x4 A4 = mfma16(afr(IMG1), bfrag(A2), Z4);
      wr_img(IMG2, A4, 0);
      asm volatile("" ::: "memory");
      f32x4 Rm = mfma16(afr(IMG2), bfrag(A4), Z4);
#pragma unroll
      for (int jj = 0; jj < 4; ++jj) Rm[jj] += (fr == 4 * fq + jj) ? 1.f : 0.f;
      Rm = mfma16(afr(IMG2), bfrag(Rm), Rm);
      Rm = mfma16(afr(IMG1), bfrag(Rm), Rm);
      Rm = mfma16(afr(IMG0), bfrag(Rm), Rm);
      wr_img(TT, Rm, 0);
    }
  };
  f32x4 acc[4];
#pragma unroll
  for (int kt = 0; kt < 4; ++kt) acc[kt] = (f32x4){0.f, 0.f, 0.f, 0.f};
  auto part2 = [&](int c, int set, int iset) {
    char* base = smem + set * SCS_SET;
    const bf16_t (*At)[72] = (const bf16_t (*)[72])(base);
    const bf16_t (*Rt)[72] = (const bf16_t (*)[72])(base + 2304);
    const bf16_t (*BKT)[36] = (const bf16_t (*)[36])(base + 9216);
    const bf16_t* VV = (const bf16_t*)(base + 13824);
    const float* G16 = (const float*)(base + 16896);
    const bf16_t* TT = (const bf16_t*)(smem + SCS_IMG + iset * 3072);
    const bf16_t* ARK = TT + 512;
    const bf16_t* AAK = TT + 1024;
    bf16x8 Sb[2];
#pragma unroll
    for (int s = 0; s < 2; ++s) {
      uint4 t = make_uint4(pack2(acc[2 * s][0], acc[2 * s][1]), pack2(acc[2 * s][2], acc[2 * s][3]),
                           pack2(acc[2 * s + 1][0], acc[2 * s + 1][1]), pack2(acc[2 * s + 1][2], acc[2 * s + 1][3]));
      Sb[s] = __builtin_bit_cast(bf16x8, t);
    }
    const unsigned* vvp = (const unsigned*)&VV[(fq * 64 + w * 16 + fr) * 6];
    const uint2 vv = make_uint2(vvp[0], vvp[1]);
    const bf16x8 Vlow = frag_join(vv, make_uint2(0u, 0u));
    f32x4 Pm = (f32x4){0.f, 0.f, 0.f, 0.f};
#pragma unroll
    for (int s = 0; s < 2; ++s) {
      bf16x8 af = frag_join(*(const uint2*)&At[fr][32 * s + 4 * fq], *(const uint2*)&At[fr][32 * s + 16 + 4 * fq]);
      Pm = mfma16(af, Sb[s], Pm);
    }
    Pm = mfma16(*(const bf16x8*)&AAK[(fr * 4 + fq) * 8], Vlow, Pm);
    const bf16x8 Pb = frag_join(make_uint2(pack2(Pm[0], Pm[1]), pack2(Pm[2], Pm[3])), make_uint2(0u, 0u));
    f32x4 U = mfma16(*(const bf16x8*)&TT[(fr * 4 + fq) * 8], Pb, (f32x4){0.f, 0.f, 0.f, 0.f});
    const bf16x8 UV = frag_join(make_uint2(pack2(U[0], U[1]), pack2(U[2], U[3])), vv);
    f32x4 Yv = (f32x4){0.f, 0.f, 0.f, 0.f};
#pragma unroll
    for (int s = 0; s < 2; ++s) {
      bf16x8 af = frag_join(*(const uint2*)&Rt[fr][32 * s + 4 * fq], *(const uint2*)&Rt[fr][32 * s + 16 + 4 * fq]);
      Yv = mfma16(af, Sb[s], Yv);
    }
    Yv = mfma16(*(const bf16x8*)&ARK[(fr * 4 + fq) * 8], UV, Yv);
    {
      const int p0 = pos0(c);
#pragma unroll
      for (int jj = 0; jj < 4; ++jj) yb[(size_t)(p0 + pstep * (4 * fq + jj)) * INW] = f2bf(Yv[jj]);
    }
#pragma unroll
    for (int kt = 0; kt < 4; ++kt) {
      f32x4 t = mfma16(frag_join(*(const uint2*)&BKT[16 * kt + fr][fq * 8], *(const uint2*)&BKT[16 * kt + fr][fq * 8 + 4]), UV, acc[kt]);
      const float4 g4 = *(const float4*)&G16[16 * kt + 4 * fq];
      t[0] *= g4.x; t[1] *= g4.y; t[2] *= g4.z; t[3] *= g4.w;
      acc[kt] = t;
    }
  };
  __builtin_amdgcn_s_setprio(3);
  Raw r0, r1;
  load_raw(0, r0); load_raw(1, r1);
  stage1(0, r0);
  load_raw(2, r0);
  __syncthreads();
  stage2(0, 0);
  stage1(1, r1);
  load_raw(3, r1);
  __syncthreads();
  int s0 = 0, s1 = 1, s2 = 2;
  auto iter = [&](int c, Raw& rw) {
    if (c + 1 < NCH) stage2(s1, (c + 1) & 1);
    part2(c, s0, c & 1);
    if (c + 2 < NCH) {
      stage1(s2, rw);
      if (c + 4 < NCH) load_raw(c + 4, rw);
    }
    asm volatile("s_waitcnt lgkmcnt(0)" ::: "memory");
    __builtin_amdgcn_s_barrier();
    asm volatile("" ::: "memory");
    const int t = s0; s0 = s1; s1 = s2; s2 = t;
  };
#pragma unroll 1
  for (int c = 0; c < NCH; c += 2) {
    iter(c, r0); iter(c + 1, r1);
  }
  __builtin_amdgcn_s_setprio(0);
}

DEV void ph_rwkv_post(const P& p, int layer) {
  const int lane = tid_() & 63;
  int r0, r1;
  wave_range(r0, r1, NTOK);
  const int ch = 4 * lane;
  float kav[4], rkv[4], lnw[4], lnb[4];
#pragma unroll
  for (int i = 0; i < 4; ++i) {
    kav[i] = p.rw_k_a[layer * 256 + ch + i]; rkv[i] = p.rw_r_k[layer * 256 + ch + i];
    lnw[i] = p.rw_ln_w[layer * 256 + ch + i]; lnb[i] = p.rw_ln_b[layer * 256 + ch + i];
  }
  struct In { uint2 y0, y1, g; uint4 h0, h1, s0, s1; };
  auto ld = [&](int row, In& in) {
    const bf16_t* zr = p.Z + (size_t)row * INW + 768 + ch;
    in.y0 = *(const uint2*)zr; in.y1 = *(const uint2*)(zr + 256);
    const bf16_t* hr = p.H + (size_t)row * D + 4 * ch;
    in.h0 = *(const uint4*)hr; in.h1 = *(const uint4*)(hr + 8);
    const bf16_t* sr = p.SC + (size_t)row * 1024 + 4 * ch;
    in.s0 = *(const uint4*)sr; in.s1 = *(const uint4*)(sr + 8);
    in.g = *(const uint2*)(p.Y + (size_t)row * D + 256 + ch);
  };
  In nx;
  if (r0 < r1) ld(r0, nx);
#pragma unroll 1
  for (int row = r0; row < r1; ++row) {
    const In in = nx;
    if (row + 1 < r1) ld(row + 1, nx);
    float y[4] = {bflo(in.y0.x) + bflo(in.y1.x), bfhi(in.y0.x) + bfhi(in.y1.x), bflo(in.y0.y) + bflo(in.y1.y), bfhi(in.y0.y) + bfhi(in.y1.y)};
    const float mu = row16_sum(y[0] + y[1] + y[2] + y[3]) * (1.f / 64.f);
    float vs = 0.f;
#pragma unroll
    for (int i = 0; i < 4; ++i) { y[i] -= mu; vs += y[i] * y[i]; }
    const float var = row16_sum(vs) * (1.f / 64.f);
    const float rstd = rsqrtf(var + 64e-5f);
    const float r[4] = {bflo(in.h0.x), bflo(in.h0.z), bflo(in.h1.x), bflo(in.h1.z)};
    const float k[4] = {bfhi(in.h0.x), bfhi(in.h0.z), bfhi(in.h1.x), bfhi(in.h1.z)};
    const float v[4] = {bfhi(in.h0.y), bfhi(in.h0.w), bfhi(in.h1.y), bfhi(in.h1.w)};
    const float a0[4] = {bfhi(in.s0.x), bfhi(in.s0.z), bfhi(in.s1.x), bfhi(in.s1.z)};
    const float a1[4] = {bfhi(in.s0.y), bfhi(in.s0.w), bfhi(in.s1.y), bfhi(in.s1.w)};
    float sd = 0.f;
#pragma unroll
    for (int i = 0; i < 4; ++i) {
      const float kd0 = k[i] * (1.f + (a0[i] - 1.f) * kav[i]), kd1 = k[i] * (1.f + (a1[i] - 1.f) * kav[i]);
      sd += r[i] * (kd0 + kd1) * rkv[i];
    }
    sd = row16_sum(sd);
    const float g[4] = {bflo(in.g.x), bfhi(in.g.x), bflo(in.g.y), bfhi(in.g.y)};
    float o[4];
#pragma unroll
    for (int i = 0; i < 4; ++i) {
      const float yn = y[i] * rstd * lnw[i] + lnb[i];
      o[i] = (yn + sd * v[i]) * g[i];
    }
    *(uint2*)(p.Y + (size_t)row * D + 256 + ch) = make_uint2(pack2(o[0], o[1]), pack2(o[2], o[3]));
  }
}

DEV void hyena_pre_unit(const P& p, int layer, int unit) {
  int kind, b, t0, L;
  if (unit < 1024) { kind = 0; b = unit >> 6; t0 = (unit & 63) * 64; L = T; } else { int u = unit - 1024; kind = 1; b = u >> 2; t0 = (u & 3) * 64; L = LC; }
  const int c = tid_();
  const size_t row0 = (size_t)b * LT + (kind ? 0 : LC);
  const float* cw = p.conv_w + (size_t)layer * 3 * 1536;
  const float* cb = p.conv_b + (size_t)layer * 1536;
  const float w1a = cw[256 + c], w1b = cw[1536 + 256 + c], w1c = cw[3072 + 256 + c], b1 = cb[256 + c];
  const float w2a = cw[512 + c], w2b = cw[1536 + 512 + c], w2c = cw[3072 + 512 + c], b2 = cb[512 + c];
  auto ld = [&](int t, int col) -> float { return (t >= 0 && t < L) ? bf2f(p.Z[(row0 + t) * INW + col]) : 0.f; };
  float x1m = ld(t0 - 1, 256 + c), x1c = ld(t0, 256 + c), vm = ld(t0 - 1, 512 + c), vc = ld(t0, 512 + c);
  bf16_t* dst = (kind ? opq(p.UTc) : opq(p.UTl)) + ((size_t)c * 16 + b) * L + t0;
#pragma unroll 1
  for (int i8 = 0; i8 < 8; ++i8) {
    float uo[8];
#pragma unroll
    for (int i = 0; i < 8; ++i) {
      int t = t0 + i8 * 8 + i;
      float x1n = ld(t + 1, 256 + c), vn = ld(t + 1, 512 + c);
      float a = w1a * x1m + w1b * x1c + w1c * x1n + b1;
      float bb = w2a * vm + w2b * vc + w2c * vn + b2;
      uo[i] = a * bb;
      x1m = x1c; x1c = x1n; vm = vc; vc = vn;
    }
    *(uint4*)(dst + 8 * i8) = pack8(uo);
  }
}

DEV void hyena_conv_unit(const P& p, int layer, int unit, char* smem) {
  int kind, c, tb, L;
  if (unit < 4096) { kind = 0; c = unit >> 4; tb = (unit & 15) * 256; L = T; } else { kind = 1; c = unit - 4096; tb = 0; L = LC; }
  const int tid = tid_(), lane = tid & 63, wid = tid >> 6, fr = lane & 15, fq = lane >> 4;
  float* red = (float*)(smem + 2 * 16512);
  const float* F = (kind ? opq(p.FC) : opq(p.FL)) + (size_t)c * 2 * L;
  float scale;
  {
    float part = 0.f;
    for (int i = tid; i < 2 * L; i += 256) { float fv = F[i]; part += (i != L) ? fv * fv : 0.f; }
    part = wave_sum(part);
    __syncthreads();
    if (lane == 0) red[wid] = part;
    __syncthreads();
    scale = rsqrtf(((red[0] + red[1]) + (red[2] + red[3])) + 1e-6f);
  }
  const bf16_t* U = (kind ? opq(p.UTc) : opq(p.UTl)) + (size_t)c * 16 * L;
  f32x4 acc[4];
#pragma unroll
  for (int m = 0; m < 4; ++m) acc[m] = (f32x4){0.f, 0.f, 0.f, 0.f};
  const int nch = L / 256;
  float fw0, fw1, fw2;
  uint4 ru0, ru1;
  auto ldchunk = [&](int ch) {
    const int sc = ch * 256;
    const int D0 = tb + 256 - sc;
    auto tap = [&](int n) -> float {
      int d = D0 - n;
      float v = 0.f;
      if (d > -L && d < L) v = (d >= 0 ? F[d] : F[L - d]);
      return v;
    };
    fw0 = tap(tid); fw1 = tap(tid + 256); fw2 = (tid < 8) ? tap(tid + 512) : 0.f;
    const int bb = tid >> 4, sg0 = tid & 15;
    ru0 = *(const uint4*)(U + (size_t)bb * L + sc + 8 * sg0);
    ru1 = *(const uint4*)(U + (size_t)bb * L + sc + 8 * (sg0 + 16));
  };
  auto stchunk = [&](int buf) {
    bf16_t* Cq = (bf16_t*)(smem + buf * 16512);
    bf16_t* Us = (bf16_t*)(smem + buf * 16512 + 8320);
    const bf16_t h0 = f2bf(fw0 * scale), h1 = f2bf(fw1 * scale), h2 = f2bf(fw2 * scale);
#pragma unroll
    for (int rho = 0; rho < 8; ++rho) {
      int m = tid + rho;
      Cq[((m >> 3) * 8 + rho) * 8 + (m & 7)] = h0;
      m = tid + 256 + rho;
      if (m < 520) Cq[((m >> 3) * 8 + rho) * 8 + (m & 7)] = h1;
      m = tid + 512 + rho;
      if (tid < 8 && m < 520) Cq[((m >> 3) * 8 + rho) * 8 + (m & 7)] = h2;
    }
    if (tid < 8) {
#pragma unroll
      for (int rho = 1; rho < 8; ++rho) if (tid < rho) Cq[(rho) * 8 + tid] = 0;
    }
    const int bb = tid >> 4, sg0 = tid & 15;
    *(uint4*)&Us[(sg0 * 16 + bb) * 8] = ru0;
    *(uint4*)&Us[((sg0 + 16) * 16 + bb) * 8] = ru1;
  };
  ldchunk(0);
#pragma unroll 1
  for (int ch = 0; ch < nch; ++ch) {
    const int buf = ch & 1;
    stchunk(buf);
    __syncthreads();
    if (ch + 1 < nch) ldchunk(ch + 1);
    const bf16_t* Cq = (const bf16_t*)(smem + buf * 16512);
    const bf16_t* Us = (const bf16_t*)(smem + buf * 16512 + 8320);
#pragma unroll
    for (int kk = 0; kk < 8; ++kk) {
      bf16x8 bf = *(const bf16x8*)&Us[((4 * kk + fq) * 16 + fr) * 8];
#pragma unroll
      for (int m = 0; m < 4; ++m) {
        int it = wid * 4 + m;
        int base = 256 - 16 * it + 32 * kk + 8 * fq;
        int m0 = base - 8 * (fr >> 3);
        bf16x8 af = *(const bf16x8*)&Cq[((m0 >> 3) * 8 + (fr & 7)) * 8];
        acc[m] = mfma16(af, bf, acc[m]);
      }
    }
  }
  __syncthreads();
  bf16_t* Yt = (kind ? opq(p.YTc) : opq(p.YTl)) + ((size_t)c * 16 + fr) * L + tb;
#pragma unroll
  for (int m = 0; m < 4; ++m) {
    int t = (wid * 4 + m) * 16 + fq * 4;
    *(uint2*)(Yt + t) = make_uint2(pack2(acc[m][0], acc[m][1]), pack2(acc[m][2], acc[m][3]));
  }
}

DEV void hyena_post_unit(const P& p, int layer, int unit, char* smem) {
  int kind, b, t0, L;
  if (unit < 1024) { kind = 0; b = unit >> 6; t0 = (unit & 63) * 64; L = T; } else { int u = unit - 1024; kind = 1; b = u >> 2; t0 = (u & 3) * 64; L = LC; }
  const int c = tid_(), lane = c & 63, wid = c >> 6;
  const size_t row0 = (size_t)b * LT + (kind ? 0 : LC);
  bf16_t (*tile)[264] = (bf16_t (*)[264])smem;
  const float* cw = p.conv_w + (size_t)layer * 3 * 1536;
  const float wa = cw[c], wb = cw[1536 + c], wcc = cw[3072 + c], b0 = p.conv_b[layer * 1536 + c];
  const float bias = p.hy_bias[layer * 256 + c];
  const bf16_t* yt = (kind ? opq(p.YTc) : opq(p.YTl)) + ((size_t)c * 16 + b) * L + t0;
  const bf16_t* ut = (kind ? opq(p.UTc) : opq(p.UTl)) + ((size_t)c * 16 + b) * L + t0;
  auto ld = [&](int t) -> float { return (t >= 0 && t < L) ? bf2f(p.Z[(row0 + t) * INW + c]) : 0.f; };
  float xm = ld(t0 - 1), xc = ld(t0);
  __syncthreads();
#pragma unroll 1
  for (int i8 = 0; i8 < 8; ++i8) {
    uint4 yu = *(const uint4*)(yt + 8 * i8), uu = *(const uint4*)(ut + 8 * i8);
    float yv[8], uv[8];
    unpack8(yu, yv); unpack8(uu, uv);
#pragma unroll
    for (int i = 0; i < 8; ++i) {
      int t = t0 + i8 * 8 + i;
      float xn = ld(t + 1);
      float x0 = wa * xm + wb * xc + wcc * xn + b0;
      float o = x0 * (yv[i] + uv[i] * bias);
      tile[i8 * 8 + i][c] = f2bf(o);
      xm = xc; xc = xn;
    }
  }
  __syncthreads();
  for (int i = 0; i < 16; ++i) {
    int tl = wid * 16 + i;
    uint2 ou = *(const uint2*)&tile[tl][4 * lane];
    float o[4] = {bflo(ou.x), bfhi(ou.x), bflo(ou.y), bfhi(ou.y)};
    float ss = wave_sum(o[0] * o[0] + o[1] * o[1] + o[2] * o[2] + o[3] * o[3]);
    float rstd = rsqrtf(ss * (1.f / 256.f) + 1e-6f);
#pragma unroll
    for (int q = 0; q < 4; ++q) {
      o[q] = o[q] * rstd * p.hy_out_g[layer * 256 + 4 * lane + q];
    }
    *(uint2*)(p.Y + (row0 + t0 + tl) * D + 4 * lane) = make_uint2(pack2(o[0], o[1]), pack2(o[2], o[3]));
  }
}

DEV void attn_unit(const P& p, int layer, int unit, char* smem) {
  const bool isctx = unit >= 4096;
  int b, qb, hq;
  if (!isctx) { b = unit >> 8; qb = (unit >> 3) & 31; hq = unit & 7; } else { int u = unit - 4096; b = u >> 4; qb = (u >> 3) & 1; hq = u & 7; }
  const int g = hq >> 2;
  const int tid = tid_(), lane = tid & 63, wid = tid >> 6, qn = lane & 31, hh = lane >> 5;
  const int qpos = qb * 128 + wid * 32 + qn;
  const size_t qrow = (size_t)b * LT + (isctx ? qpos : LC + qpos);
  const bf16_t* qptr = p.Z + qrow * INW + 1920 + hq * 64;
  bf16x8 qf[4];
#pragma unroll
  for (int s = 0; s < 4; ++s) qf[s] = *(const bf16x8*)(qptr + 16 * s + 8 * hh);
  const float sink = p.attn_sink[layer * 8 + hq];
  float m_run = sink, l_run = 1.f;
  f32x16 o0, o1;
#pragma unroll
  for (int i = 0; i < 16; ++i) { o0[i] = 0.f; o1[i] = 0.f; }
  typedef bf16_t KTile[64][72];
  KTile* Ks = (KTile*)smem;
  KTile* Vt = (KTile*)(smem + 18432);
  const int ntl = isctx ? 0 : 6;
  const int ntiles = ntl + 4;
  const int skey = tid >> 3, sseg = tid & 7;
  const bf16_t* kvbase = p.Z + (size_t)b * LT * INW + 1920 + 512 + g * 64 + sseg * 8;
  uint4 rk0, rk1, rv0, rv1;
  auto ldtile = [&](int kt) {
    const bool ctxk = kt >= ntl;
    const int kbase = ctxk ? (kt - ntl) * 64 : qb * 128 - 128 + kt * 64;
    const int kp0 = kbase + skey, kp1 = kp0 + 32;
    rk0 = rk1 = rv0 = rv1 = make_uint4(0, 0, 0, 0);
    if (ctxk || (kp0 >= 0 && kp0 < T)) { const bf16_t* src = kvbase + (size_t)(ctxk ? kp0 : LC + kp0) * INW; rk0 = *(const uint4*)src; rv0 = *(const uint4*)(src + 128); }
    if (ctxk || (kp1 >= 0 && kp1 < T)) { const bf16_t* src = kvbase + (size_t)(ctxk ? kp1 : LC + kp1) * INW; rk1 = *(const uint4*)src; rv1 = *(const uint4*)(src + 128); }
  };
  auto sttile = [&](int buf) {
    *(uint4*)&Ks[buf][skey][sseg * 8] = rk0;
    *(uint4*)&Ks[buf][skey + 32][sseg * 8] = rk1;
    bf16_t (*vt)[72] = Vt[buf];
    vt[sseg * 8 + 0][skey] = (bf16_t)(rv0.x & 0xFFFF); vt[sseg * 8 + 1][skey] = (bf16_t)(rv0.x >> 16);
    vt[sseg * 8 + 2][skey] = (bf16_t)(rv0.y & 0xFFFF); vt[sseg * 8 + 3][skey] = (bf16_t)(rv0.y >> 16);
    vt[sseg * 8 + 4][skey] = (bf16_t)(rv0.z & 0xFFFF); vt[sseg * 8 + 5][skey] = (bf16_t)(rv0.z >> 16);
    vt[sseg * 8 + 6][skey] = (bf16_t)(rv0.w & 0xFFFF); vt[sseg * 8 + 7][skey] = (bf16_t)(rv0.w >> 16);
    vt[sseg * 8 + 0][skey + 32] = (bf16_t)(rv1.x & 0xFFFF); vt[sseg * 8 + 1][skey + 32] = (bf16_t)(rv1.x >> 16);
    vt[sseg * 8 + 2][skey + 32] = (bf16_t)(rv1.y & 0xFFFF); vt[sseg * 8 + 3][skey + 32] = (bf16_t)(rv1.y >> 16);
    vt[sseg * 8 + 4][skey + 32] = (bf16_t)(rv1.z & 0xFFFF); vt[sseg * 8 + 5][skey + 32] = (bf16_t)(rv1.z >> 16);
    vt[sseg * 8 + 6][skey + 32] = (bf16_t)(rv1.w & 0xFFFF); vt[sseg * 8 + 7][skey + 32] = (bf16_t)(rv1.w >> 16);
  };
  ldtile(0);
#pragma unroll 1
  for (int kt = 0; kt < ntiles; ++kt) {
    const int buf = kt & 1;
    sttile(buf);
    __syncthreads();
    if (kt + 1 < ntiles) ldtile(kt + 1);
    const bool ctxk = kt >= ntl;
    const int kbase = ctxk ? (kt - ntl) * 64 : qb * 128 - 128 + kt * 64;
#pragma unroll
    for (int sub = 0; sub < 2; ++sub) {
      const int kb2 = kbase + sub * 32;
      bool need = true;
      if (!ctxk) {
        int q0 = qb * 128 + wid * 32;
        if (kb2 + 31 < q0 - 128 || kb2 > q0 + 31 + 128 || kb2 + 31 < 0 || kb2 >= T) need = false;
      }
      if (need) {
        f32x16 sv;
#pragma unroll
        for (int i = 0; i < 16; ++i) sv[i] = 0.f;
#pragma unroll
        for (int ks = 0; ks < 4; ++ks) {
          bf16x8 kf = *(const bf16x8*)&Ks[buf][sub * 32 + qn][16 * ks + 8 * hh];
          sv = mfma32(kf, qf[ks], sv);
        }
        float mt = -3e38f;
#pragma unroll
        for (int rg = 0; rg < 16; ++rg) {
          float v = sv[rg] * 0.125f;
          if (!ctxk) {
            int kp = kb2 + (rg & 3) + 8 * (rg >> 2) + 4 * hh;
            int dl = qpos - kp;
            bool ok = (dl <= 128) && (dl >= -128) && (kp >= 0) && (kp < T);
            v = ok ? v : -1e30f;
          }
          sv[rg] = v;
          mt = fmaxf(mt, v);
        }
        mt = fmaxf(mt, __shfl_xor(mt, 32));
        float m_new = fmaxf(m_run, mt);
        float corr = __expf(m_run - m_new);
        float ps = 0.f;
#pragma unroll
        for (int rg = 0; rg < 16; ++rg) { float pv = __expf(sv[rg] - m_new); sv[rg] = pv; ps += pv; }
        ps += __shfl_xor(ps, 32);
        l_run = l_run * corr + ps;
        m_run = m_new;
#pragma unroll
        for (int i = 0; i < 16; ++i) { o0[i] *= corr; o1[i] *= corr; }
#pragma unroll
        for (int sp = 0; sp < 2; ++sp) {
          bf16x8 pf;
#pragma unroll
          for (int j = 0; j < 8; ++j) pf[j] = (short)f2bf(sv[8 * sp + j]);
          const int kc = sub * 32 + 16 * sp + 4 * hh;
          uint2 va = *(const uint2*)&Vt[buf][qn][kc], vb = *(const uint2*)&Vt[buf][qn][kc + 8];
          uint2 vc = *(const uint2*)&Vt[buf][32 + qn][kc], vd = *(const uint2*)&Vt[buf][32 + qn][kc + 8];
          uint4 w0 = make_uint4(va.x, va.y, vb.x, vb.y), w1 = make_uint4(vc.x, vc.y, vd.x, vd.y);
          bf16x8 v0 = __builtin_bit_cast(bf16x8, w0), v1 = __builtin_bit_cast(bf16x8, w1);
          o0 = mfma32(v0, pf, o0);
          o1 = mfma32(v1, pf, o1);
        }
      }
    }
  }
  __syncthreads();
  const float inv = 1.f / l_run;
  bf16_t* optr = p.Y + qrow * D + 512 + hq * 64;
#pragma unroll
  for (int rg = 0; rg < 4; ++rg) {
    int d0 = 8 * rg + 4 * hh;
    *(uint2*)(optr + d0) = make_uint2(pack2(o0[4 * rg] * inv, o0[4 * rg + 1] * inv), pack2(o0[4 * rg + 2] * inv, o0[4 * rg + 3] * inv));
    *(uint2*)(optr + 32 + d0) = make_uint2(pack2(o1[4 * rg] * inv, o1[4 * rg + 1] * inv), pack2(o1[4 * rg + 2] * inv, o1[4 * rg + 3] * inv));
  }
}

DEV void ph_attn_post(const P& p, int layer) {
  const int lane = tid_() & 63;
  int r0, r1;
  wave_range(r0, r1, NTOK);
  float gv[8];
#pragma unroll
  for (int i = 0; i < 8; ++i) gv[i] = p.at_out_g[layer * 512 + 8 * lane + i];
  uint4 nx = make_uint4(0, 0, 0, 0);
  if (r0 < r1) nx = *(const uint4*)(p.Y + (size_t)r0 * D + 512 + 8 * lane);
#pragma unroll 1
  for (int row = r0; row < r1; ++row) {
    const uint4 u = nx;
    if (row + 1 < r1) nx = *(const uint4*)(p.Y + (size_t)(row + 1) * D + 512 + 8 * lane);
    float v[8];
    unpack8(u, v);
    float ss = 0.f;
#pragma unroll
    for (int i = 0; i < 8; ++i) ss += v[i] * v[i];
    ss = wave_sum(ss);
    const float rstd = rsqrtf(ss * (1.f / 512.f) + 1e-6f);
#pragma unroll
    for (int i = 0; i < 8; ++i) {
      v[i] = v[i] * rstd * gv[i];
    }
    *(uint4*)(p.Y + (size_t)row * D + 512 + 8 * lane) = pack8(v);
  }
}

struct Epi2 {
  const P& p; int layer, row0, col0;
  DEV void operator()(f32x4 (&acc)[4][4], int wr, int wc, int fr, int fq, char* smem) const {
    const int b = row0 / LT, pp = row0 % LT;
    const int mr = pp < LC ? 16 : b;
    const float* g1 = p.modv + ((size_t)layer * 17 + mr) * 6144 + 2048 + col0 + wc * 64;
#pragma unroll
    for (int n = 0; n < 4; ++n) {
      const float gv = g1[n * 16 + fr];
#pragma unroll
      for (int m = 0; m < 4; ++m)
#pragma unroll
        for (int j = 0; j < 4; ++j) acc[m][n][j] *= gv;
    }
    const int wid = wr * 2 + wc, lane = fq * 16 + fr;
    stage_tile_bf16(acc, smem, wid, fr, fq);
    const bf16_t (*t)[72] = (const bf16_t (*)[72])(smem + wid * 9216);
#pragma unroll
    for (int i = 0; i < 8; ++i) {
      const int rl = i * 8 + (lane >> 3), ch = lane & 7;
      bf16_t* xp = p.X + (size_t)(row0 + wr * 64 + rl) * D + col0 + wc * 64 + ch * 8;
      float xv[8], dv[8];
      uint4 xu = *(const uint4*)xp, du = *(const uint4*)&t[rl][ch * 8];
      unpack8(xu, xv); unpack8(du, dv);
#pragma unroll
      for (int q = 0; q < 8; ++q) xv[q] += dv[q];
      *(uint4*)xp = pack8(xv);
    }
  }
};
DEV void ph_gemm2(const P& p, int layer, char* smem) {
  int rt, ct;
  for (int it = 0; gemm_unit(it, 8, rt, ct); ++it) {
    Epi2 epi{p, layer, rt * 128, ct * 128};
    gemm_tile(p.Y + (size_t)rt * 128 * D, D, p.W2t + (size_t)ct * 128 * D, D, D, smem, epi);
  }
}

DEV void ph_peerconv(const P& p, int layer) {
  const int gw = (bid_() * 256 + tid_()) >> 6, nw = gridDim.x * 4, lane = tid_() & 63;
  const float* su = opq(p.peer_u) + (size_t)layer * 16384 * 1024;
  const float* sv = opq(p.peer_v) + (size_t)layer * 16384 * 1024;
  unsigned char* pu = opq(p.PU); unsigned char* pv = opq(p.PV);
  float* psu = opq(p.PSU); float* psv = opq(p.PSV);
#pragma unroll 1
  for (int r = gw; r < 32768; r += nw) {
    const bool isv = r >= 16384;
    const int e = r & 16383;
    const float* src = (isv ? sv : su) + (size_t)e * 1024 + 16 * lane;
    float4 f0 = *(const float4*)src, f1 = *(const float4*)(src + 4), f2 = *(const float4*)(src + 8), f3 = *(const float4*)(src + 12);
    float am = fmaxf(fmaxf(fmaxf(fabsf(f0.x), fabsf(f0.y)), fmaxf(fabsf(f0.z), fabsf(f0.w))), fmaxf(fmaxf(fabsf(f1.x), fabsf(f1.y)), fmaxf(fabsf(f1.z), fabsf(f1.w))));
    am = fmaxf(am, fmaxf(fmaxf(fmaxf(fabsf(f2.x), fabsf(f2.y)), fmaxf(fabsf(f2.z), fabsf(f2.w))), fmaxf(fmaxf(fabsf(f3.x), fabsf(f3.y)), fmaxf(fabsf(f3.z), fabsf(f3.w)))));
    am = wave_max(am);
    int w0, w1, w2, w3;
    float inv;
    if (isv) {
      const float sc = am > 0.f ? 224.f / am : 1.f;
      inv = am > 0.f ? am * (1.f / 224.f) : 1.f;
      w0 = __builtin_amdgcn_cvt_pk_fp8_f32(f0.x * sc, f0.y * sc, 0, false); w0 = __builtin_amdgcn_cvt_pk_fp8_f32(f0.z * sc, f0.w * sc, w0, true);
      w1 = __builtin_amdgcn_cvt_pk_fp8_f32(f1.x * sc, f1.y * sc, 0, false); w1 = __builtin_amdgcn_cvt_pk_fp8_f32(f1.z * sc, f1.w * sc, w1, true);
      w2 = __builtin_amdgcn_cvt_pk_fp8_f32(f2.x * sc, f2.y * sc, 0, false); w2 = __builtin_amdgcn_cvt_pk_fp8_f32(f2.z * sc, f2.w * sc, w2, true);
      w3 = __builtin_amdgcn_cvt_pk_fp8_f32(f3.x * sc, f3.y * sc, 0, false); w3 = __builtin_amdgcn_cvt_pk_fp8_f32(f3.z * sc, f3.w * sc, w3, true);
    } else {
      const float sc = am > 0.f ? 127.f / am : 1.f;
      inv = am > 0.f ? am * (1.f / 127.f) : 1.f;
      w0 = pack_i8(f0.x * sc, f0.y * sc, f0.z * sc, f0.w * sc); w1 = pack_i8(f1.x * sc, f1.y * sc, f1.z * sc, f1.w * sc);
      w2 = pack_i8(f2.x * sc, f2.y * sc, f2.z * sc, f2.w * sc); w3 = pack_i8(f3.x * sc, f3.y * sc, f3.z * sc, f3.w * sc);
    }
    *(uint4*)((isv ? pv : pu) + (size_t)(lane >> 3) * PSLICE + (size_t)e * 128 + 16 * (lane & 7)) = make_uint4((unsigned)w0, (unsigned)w1, (unsigned)w2, (unsigned)w3);
    if (lane == 0) (isv ? psv : psu)[e] = inv;
  }
}
DEV void unpack16_fp8x2(const uint4& u, f32x2* f) {
  f[0] = __builtin_amdgcn_cvt_pk_f32_fp8((int)u.x, false); f[1] = __builtin_amdgcn_cvt_pk_f32_fp8((int)u.x, true);
  f[2] = __builtin_amdgcn_cvt_pk_f32_fp8((int)u.y, false); f[3] = __builtin_amdgcn_cvt_pk_f32_fp8((int)u.y, true);
  f[4] = __builtin_amdgcn_cvt_pk_f32_fp8((int)u.z, false); f[5] = __builtin_amdgcn_cvt_pk_f32_fp8((int)u.z, true);
  f[6] = __builtin_amdgcn_cvt_pk_f32_fp8((int)u.w, false); f[7] = __builtin_amdgcn_cvt_pk_f32_fp8((int)u.w, true);
}

DEV void bitonic_sort16_desc(float (&v)[16]) {
#pragma unroll
  for (int k = 2; k <= 16; k <<= 1)
#pragma unroll
    for (int j = k >> 1; j >= 1; j >>= 1)
#pragma unroll
      for (int i = 0; i < 16; ++i) {
        const int l = i ^ j;
        if (l > i) {
          const float hi = fmaxf(v[i], v[l]), lo = fminf(v[i], v[l]);
          if ((i & k) == 0) { v[i] = hi; v[l] = lo; } else { v[i] = lo; v[l] = hi; }
        }
      }
}
DEV void peer_cand_ij(int c, int& ci, int& cj) {
  if (c < 16) { ci = 0; cj = c; } else if (c < 24) { ci = 1; cj = c - 16; } else if (c < 29) { ci = 2; cj = c - 24; }
  else if (c < 33) { ci = 3; cj = c - 29; } else if (c < 36) { ci = 4; cj = c - 33; } else if (c < 38) { ci = 5; cj = c - 36; }
  else if (c < 40) { ci = 6; cj = c - 38; } else if (c < 42) { ci = 7; cj = c - 40; } else { ci = (c - 42 + 8) & 15; cj = 0; }
}
template <int S>
struct Epi3K {
  const P& p; int row0, head; float (&keep)[2][16];
  DEV void operator()(f32x4 (&acc)[4][4], int wr, int wc, int fr, int fq, char* smem) const {
    float* sc = (float*)smem;
    float* L1s = (float*)(smem + 36864);
    float* L2s = (float*)(smem + 45056);
    const int tid = tid_();
#pragma unroll
    for (int pass = 0; pass < 2; ++pass) {
      __syncthreads();
      if (wr == pass) {
#pragma unroll
        for (int m = 0; m < 4; ++m)
#pragma unroll
          for (int n = 0; n < 4; ++n)
#pragma unroll
            for (int j = 0; j < 4; ++j) {
              int rl = m * 16 + fq * 4 + j, col = wc * 64 + n * 16 + fr;
              unsigned bits = (__float_as_uint(acc[m][n][j]) & ~127u) | (unsigned)col;
              sc[rl * 133 + (col >> 5) * 33 + (col & 31)] = __uint_as_float(bits);
            }
      }
      __syncthreads();
      const int rl = tid >> 2, q = tid & 3;
      const float* src = sc + rl * 133 + q * 33;
      float Ls[16], Hs[16];
#pragma unroll
      for (int i = 0; i < 16; ++i) { Ls[i] = src[i]; Hs[i] = src[16 + i]; }
      bitonic_sort16_desc(Ls);
      bitonic_sort16_desc(Hs);
#pragma unroll
      for (int i = 0; i < 16; ++i) Ls[i] = fmaxf(Ls[i], Hs[15 - i]);
#pragma unroll
      for (int d = 8; d >= 1; d >>= 1)
#pragma unroll
        for (int i = 0; i < 16; ++i)
          if ((i & d) == 0) { float hi = fmaxf(Ls[i], Ls[i + d]), lo = fminf(Ls[i], Ls[i + d]); Ls[i] = hi; Ls[i + d] = lo; }
      float Cs[16];
#pragma unroll
      for (int i = 0; i < 16; ++i) Cs[i] = fmaxf(Ls[i], dppself<0xB1, 0xF>(Ls[15 - i]));
#pragma unroll
      for (int d = 8; d >= 1; d >>= 1)
#pragma unroll
        for (int i = 0; i < 16; ++i)
          if ((i & d) == 0) { float hi = fmaxf(Cs[i], Cs[i + d]), lo = fminf(Cs[i], Cs[i + d]); Cs[i] = hi; Cs[i + d] = lo; }
      float Ds[16];
#pragma unroll
      for (int i = 0; i < 16; ++i) Ds[i] = fmaxf(Cs[i], dppself<0x4E, 0xF>(Cs[15 - i]));
#pragma unroll
      for (int d = 8; d >= 1; d >>= 1)
#pragma unroll
        for (int i = 0; i < 16; ++i)
          if ((i & d) == 0) { float hi = fmaxf(Ds[i], Ds[i + d]), lo = fminf(Ds[i], Ds[i + d]); Ds[i] = hi; Ds[i + d] = lo; }
      if (S == 0) {
#pragma unroll
        for (int i = 0; i < 16; ++i) keep[pass][i] = Ds[i];
      } else if (q == 0) {
        float* d1 = L1s + (pass * 64 + rl) * 16;
        float* d2 = L2s + (pass * 64 + rl) * 16;
#pragma unroll
        for (int i = 0; i < 4; ++i) {
          *(float4*)(d1 + 4 * i) = make_float4(keep[pass][4 * i], keep[pass][4 * i + 1], keep[pass][4 * i + 2], keep[pass][4 * i + 3]);
          *(float4*)(d2 + 4 * i) = make_float4(Ds[4 * i], Ds[4 * i + 1], Ds[4 * i + 2], Ds[4 * i + 3]);
        }
      }
    }
    if (S == 1) {
      __syncthreads();
      const int lane = tid & 63, wid = tid >> 6;
      int ci, cj;
      peer_cand_ij(lane, ci, cj);
      const bool cand = lane < 50;
      float n1 = L1s[(wid * 32) * 16 + ci], n2 = L2s[(wid * 32) * 16 + cj];
#pragma unroll 1
      for (int r = 0; r < 32; ++r) {
        const int row = wid * 32 + r;
        const float v1 = n1, v2 = n2;
        if (r + 1 < 32) { n1 = L1s[(row + 1) * 16 + ci]; n2 = L2s[(row + 1) * 16 + cj]; }
        float val = v1 + v2;
        val = __uint_as_float((__float_as_uint(val) & ~63u) | (unsigned)lane);
        val = cand ? val : -3e38f;
        int rank = 0;
#pragma unroll
        for (int q = 0; q < 50; ++q) rank += (readlane_f(val, q) > val) ? 1 : 0;
        const bool sel = cand && rank < 16;
        const float mx = readlane_f(val, 0);
        const float ex = sel ? __expf(val - mx) : 0.f;
        const float sm = wave_sum(ex);
        if (sel) {
          const int e = (int)(__float_as_uint(v1) & 127u) * 128 + (int)(__float_as_uint(v2) & 127u);
          const size_t o = (size_t)(row0 + row) * 128 + head * 16 + rank;
          p.EL[o] = (unsigned short)e;
          p.GT[o] = ex / sm;
        }
      }
    }
  }
};
DEV void ph_gemm3(const P& p, char* smem) {
  int rt, hd;
  for (int it = 0; gemm_unit(it, 8, rt, hd); ++it) {
    float keep[2][16];
    {
      Epi3K<0> epi{p, rt * 128, hd, keep};
      gemm_tile(p.H + (size_t)rt * 128 * D, D, p.Wft + (size_t)(2 * hd) * 128 * D, D, D, smem, epi);
    }
    {
      Epi3K<1> epi{p, rt * 128, hd, keep};
      gemm_tile(p.H + (size_t)rt * 128 * D, D, p.Wft + (size_t)(2 * hd + 1) * 128 * D, D, D, smem, epi);
    }
  }
}

DEV float peer_gate(float scr) {
  float mx = row16_max(scr);
  float ex = __expf(scr - mx);
  float sm = row16_sum(ex);
  return ex / sm;
}
DEV float gelu_exact(float x) { return 0.5f * x * (1.f + erff(x * 0.7071067811865476f)); }

struct PeerPre { uint4 e0, e1, a0, a1, a2, a3; };
DEV unsigned peer_eid(const PeerPre& s, int j) {
  const unsigned w = (j < 8) ? ((j >> 1) == 0 ? s.e0.x : (j >> 1) == 1 ? s.e0.y : (j >> 1) == 2 ? s.e0.z : s.e0.w)
                             : (((j - 8) >> 1) == 0 ? s.e1.x : ((j - 8) >> 1) == 1 ? s.e1.y : ((j - 8) >> 1) == 2 ? s.e1.z : s.e1.w);
  return (j & 1) ? (w >> 16) : (w & 0xFFFFu);
}
template <int WHICH>
DEV void peer_wave_run(const P& p, int layer, int x, int tok0, int lane, float* wbuf) {
  const int r = lane >> 3, c = lane & 7;
  const unsigned char* tb = (WHICH == 0 ? p.PU : p.PV) + (size_t)x * PSLICE + c * 16;
  PeerPre S[3];
  uint4 R[16];
  auto ld_pre = [&](int tok, PeerPre& s) {
    const uint4* elp = (const uint4*)(p.EL + (size_t)tok * 128 + r * 16);
    s.e0 = elp[0]; s.e1 = elp[1];
    if (WHICH == 0) {
      s.a0 = *(const uint4*)(p.H8 + (size_t)tok * 1024 + x * 128 + c * 16);
    } else {
      const uint4* wtp = (const uint4*)(p.GT + (size_t)tok * 128 + r * 16);
      s.a0 = wtp[0]; s.a1 = wtp[1]; s.a2 = wtp[2]; s.a3 = wtp[3];
    }
  };
  auto comp = [&](int tok, const PeerPre& s, const PeerPre& sn, bool more) {
    if (WHICH == 0) {
      int keep0 = 0, keep1 = 0;
#pragma unroll
      for (int j = 0; j < 16; ++j) {
        const uint4 rw = R[j];
        if (more) R[j] = *(const uint4*)(tb + (size_t)peer_eid(sn, j) * 128);
        int d = __builtin_amdgcn_sdot4((int)rw.x, (int)s.a0.x, 0, false);
        d = __builtin_amdgcn_sdot4((int)rw.y, (int)s.a0.y, d, false);
        d = __builtin_amdgcn_sdot4((int)rw.z, (int)s.a0.z, d, false);
        d = __builtin_amdgcn_sdot4((int)rw.w, (int)s.a0.w, d, false);
        d += __builtin_amdgcn_update_dpp(0, d, 0xB1, 0xF, 0xF, false);
        d += __builtin_amdgcn_update_dpp(0, d, 0x4E, 0xF, 0xF, false);
        d += __builtin_amdgcn_update_dpp(0, d, 0x141, 0xF, 0xF, false);
        if (j < 8) keep0 = (c == j) ? d : keep0; else keep1 = (c == j - 8) ? d : keep1;
      }
      bf16_t* pd = p.PD + ((size_t)x * NTOK + tok) * 128 + r * 16 + c;
      pd[0] = f2bf((float)keep0); pd[8] = f2bf((float)keep1);
    } else {
      const float wsv[16] = {__uint_as_float(s.a0.x), __uint_as_float(s.a0.y), __uint_as_float(s.a0.z), __uint_as_float(s.a0.w),
                             __uint_as_float(s.a1.x), __uint_as_float(s.a1.y), __uint_as_float(s.a1.z), __uint_as_float(s.a1.w),
                             __uint_as_float(s.a2.x), __uint_as_float(s.a2.y), __uint_as_float(s.a2.z), __uint_as_float(s.a2.w),
                             __uint_as_float(s.a3.x), __uint_as_float(s.a3.y), __uint_as_float(s.a3.z), __uint_as_float(s.a3.w)};
      f32x2 acc2[8];
#pragma unroll
      for (int i = 0; i < 8; ++i) acc2[i] = (f32x2){0.f, 0.f};
#pragma unroll
      for (int j = 0; j < 16; ++j) {
        f32x2 f[8];
        unpack16_fp8x2(R[j], f);
        if (more) R[j] = *(const uint4*)(tb + (size_t)peer_eid(sn, j) * 128);
        const f32x2 w2 = (f32x2){wsv[j], wsv[j]};
#pragma unroll
        for (int i = 0; i < 8; ++i) acc2[i] += w2 * f[i];
      }
      float* slab = wbuf + (r * 8 + c) * 16;
      *(float4*)(slab) = make_float4(acc2[0][0], acc2[0][1], acc2[1][0], acc2[1][1]);
      *(float4*)(slab + 4) = make_float4(acc2[2][0], acc2[2][1], acc2[3][0], acc2[3][1]);
      *(float4*)(slab + 8) = make_float4(acc2[4][0], acc2[4][1], acc2[5][0], acc2[5][1]);
      *(float4*)(slab + 12) = make_float4(acc2[6][0], acc2[6][1], acc2[7][0], acc2[7][1]);
      asm volatile("s_waitcnt lgkmcnt(0)" ::: "memory");
      float o0 = 0.f, o1 = 0.f;
#pragma unroll
      for (int rr = 0; rr < 8; ++rr) {
        const float2 t = *(const float2*)(wbuf + (rr * 8 + (lane >> 3)) * 16 + 2 * (lane & 7));
        o0 += t.x; o1 += t.y;
      }
      asm volatile("s_waitcnt lgkmcnt(0)" ::: "memory");
      const int b = tok / LT, pp = tok % LT;
      const int mr = pp < LC ? 16 : b;
      const int col = x * 128 + 2 * lane;
      const float* g2 = p.modv + ((size_t)layer * 17 + mr) * 6144 + 5120 + col;
      unsigned* xp = (unsigned*)(p.X + (size_t)tok * D + col);
      const unsigned xu = *xp;
      *xp = pack2(bflo(xu) + g2[0] * o0, bfhi(xu) + g2[1] * o1);
    }
  };
  ld_pre(tok0, S[0]);
  ld_pre(tok0 + 1, S[1]);
#pragma unroll
  for (int j = 0; j < 16; ++j) R[j] = *(const uint4*)(tb + (size_t)peer_eid(S[0], j) * 128);
  ld_pre(tok0 + 2, S[2]);
#pragma unroll
  for (int t = 0; t < 8; ++t) {
    comp(tok0 + t, S[t % 3], S[(t + 1) % 3], t + 1 < 8);
    if (t + 3 < 8) ld_pre(tok0 + t + 3, S[t % 3]);
  }
}
DEV void ph_peer_w(const P& p) {
  for (size_t i8 = (size_t)bid_() * 256 + tid_(); i8 < (size_t)NTOK * 16; i8 += (size_t)gridDim.x * 256) {
    const size_t i = i8 * 8;
    float d[8];
#pragma unroll
    for (int q = 0; q < 8; ++q) d[q] = 0.f;
#pragma unroll
    for (int x = 0; x < 8; ++x) {
      const uint4 u = *(const uint4*)(p.PD + (size_t)x * NTOK * 128 + i);
      float f[8];
      unpack8(u, f);
#pragma unroll
      for (int q = 0; q < 8; ++q) d[q] += f[q];
    }
    const uint4 eu = *(const uint4*)(p.EL + i);
    const unsigned ew[4] = {eu.x, eu.y, eu.z, eu.w};
    const float hinv = p.HINV[i >> 7];
    float4 g0 = *(const float4*)(p.GT + i), g1 = *(const float4*)(p.GT + i + 4);
    float g[8] = {g0.x, g0.y, g0.z, g0.w, g1.x, g1.y, g1.z, g1.w};
#pragma unroll
    for (int q = 0; q < 8; ++q) {
      const unsigned e = (q & 1) ? (ew[q >> 1] >> 16) : (ew[q >> 1] & 0xFFFFu);
      g[q] = g[q] * gelu_exact(d[q] * p.PSU[e] * hinv) * p.PSV[e];
    }
    *(float4*)(p.GT + i) = make_float4(g[0], g[1], g[2], g[3]);
    *(float4*)(p.GT + i + 4) = make_float4(g[4], g[5], g[6], g[7]);
  }
}
template <int WHICH>
DEV void ph_peer_gather(const P& p, int layer, char* smem, volatile LAS unsigned* slot) {
  const int tid = tid_(), lane = tid & 63, wid = tid >> 6;
  unsigned* q = p.wq + 1024 + layer * 256 + WHICH * 128;
  const int my = (int)(xb_xcc_id() & 7u);
  float* wbuf = (float*)smem + wid * 1024;
#pragma unroll 1
  for (int rot = 0; rot < 8; ++rot) {
    const int x = (my + rot) & 7;
    for (;;) {
      __syncthreads();
      if (tid == 0) *slot = atomicAdd(q + x * 16, 1u);
      __syncthreads();
      const int it = (int)*slot;
      if (it >= NTOK / 32) break;
      peer_wave_run<WHICH>(p, layer, x, it * 32 + wid * 8, lane, wbuf);
    }
  }
}

DEV void ph_final(const P& p) {
  const int lane = tid_() & 63;
  int r0, r1;
  wave_range(r0, r1, NB * T);
  float gv[16];
#pragma unroll
  for (int hh = 0; hh < 2; ++hh)
#pragma unroll
    for (int i = 0; i < 8; ++i) gv[hh * 8 + i] = p.final_g[hh * 512 + 8 * lane + i];
  auto xrow = [&](int r) -> const bf16_t* { const int b = r / T, t = r % T; return p.X + ((size_t)b * LT + LC + t) * D; };
  uint4 n0 = make_uint4(0, 0, 0, 0), n1 = n0;
  if (r0 < r1) { const bf16_t* xr = xrow(r0); n0 = *(const uint4*)(xr + 8 * lane); n1 = *(const uint4*)(xr + 512 + 8 * lane); }
#pragma unroll 1
  for (int r = r0; r < r1; ++r) {
    const uint4 u0 = n0, u1 = n1;
    if (r + 1 < r1) { const bf16_t* xr = xrow(r + 1); n0 = *(const uint4*)(xr + 8 * lane); n1 = *(const uint4*)(xr + 512 + 8 * lane); }
    float v[16];
    unpack8(u0, v); unpack8(u1, v + 8);
    float ss = 0.f;
#pragma unroll
    for (int i = 0; i < 16; ++i) ss += v[i] * v[i];
    ss = wave_sum(ss);
    const float rstd = rsqrtf(ss * (1.f / 1024.f) + 1e-6f);
    float* o = p.out + (size_t)r * D;
#pragma unroll
    for (int hh = 0; hh < 2; ++hh) {
      const int col = hh * 512 + 8 * lane;
      *(float4*)(o + col) = make_float4(v[hh * 8 + 0] * rstd * gv[hh * 8 + 0], v[hh * 8 + 1] * rstd * gv[hh * 8 + 1], v[hh * 8 + 2] * rstd * gv[hh * 8 + 2], v[hh * 8 + 3] * rstd * gv[hh * 8 + 3]);
      *(float4*)(o + col + 4) = make_float4(v[hh * 8 + 4] * rstd * gv[hh * 8 + 4], v[hh * 8 + 5] * rstd * gv[hh * 8 + 5], v[hh * 8 + 6] * rstd * gv[hh * 8 + 6], v[hh * 8 + 7] * rstd * gv[hh * 8 + 7]);
    }
  }
}

DEV unsigned hw_cu_key() {
  const unsigned hwid = (unsigned)__builtin_amdgcn_s_getreg(((8 - 1) << 11) | (8 << 6) | 4);
  return (xb_xcc_id() << 8) | (hwid & 0xFFu);
}
DEV void mixB(const P& p, int layer, char* smem, volatile LAS unsigned* slot) {
  unsigned* qa = p.wq + layer * 64;
  unsigned* qs = qa + 16;
  unsigned* claim = p.cuclaim + layer * 4096;
  __syncthreads();
  if (tid_() == 0) {
    unsigned u = 0xFFFFFFFFu;
    if (atomicAdd(&claim[hw_cu_key() & 4095u], 1u) == 0u) u = atomicAdd(qs, 1u);
    *slot = u;
  }
  __syncthreads();
  {
    const unsigned u = *slot;
    if (u < 128u) scanc_unit(p, layer, (int)u, smem);
  }
  for (;;) {
    __syncthreads();
    if (tid_() == 0) *slot = atomicAdd(qa, 1u);
    __syncthreads();
    const int u = (int)*slot;
    if (u >= 8704) break;
    if (u < 4352) attn_unit(p, layer, u, smem); else hyena_conv_unit(p, layer, u - 4352, smem);
  }
  if (layer + 1 < DEPTH) {
    unsigned* qp = qa + 32;
    for (;;) {
      __syncthreads();
      if (tid_() == 0) *slot = atomicAdd(qp, 1u);
      __syncthreads();
      const int u = (int)*slot;
      if (u >= PREPA_N) break;
      prep_unit(p, layer + 1, prepA_unit_index(u), smem);
    }
  }
  for (;;) {
    __syncthreads();
    if (tid_() == 0) *slot = atomicAdd(qs, 1u);
    __syncthreads();
    const unsigned u = *slot;
    if (u >= 128u) break;
    scanc_unit(p, layer, (int)u, smem);
  }
}
DEV void mixA(const P& p, int layer, char* smem) {
  for (int u = bid_(); u < 1088; u += gridDim.x) hyena_pre_unit(p, layer, u);
  ph_lora(p, layer, smem);
  ph_rwkv_prep(p, layer);
}
DEV void mixC(const P& p, int layer, char* smem) {
  for (int u = bid_(); u < 1088; u += gridDim.x) hyena_post_unit(p, layer, u, smem);
  ph_rwkv_post(p, layer);
  ph_attn_post(p, layer);
}

__global__ void __launch_bounds__(256, 2) k_mega(P p) {
  extern __shared__ __attribute__((aligned(16))) char smem_all[];
  char* smem = smem_all;
  volatile LAS unsigned* xbw = (volatile LAS unsigned*)(smem_all + SMEM_BYTES);
  if (threadIdx.x == 0) { xbw[0] = 0u; xbw[1] = 0u; xbw[2] = 0u; xbw[3] = 0u; }
  __syncthreads();
  XcdBarrier bar = xcd_barrier_post(p.bar, xbw);
  ph_copy(p);
  ph_rope(p);
  for (int u = blockIdx.x; u < 96; u += gridDim.x) modv_unit(p, u, smem);
  ph_prep(p, 0, smem, false);
  xcd_barrier(bar);
  for (int layer = 0; layer < DEPTH; ++layer) {
    ph_norm(p, layer, 0);
    xcd_barrier(bar);
    ph_gemm1(p, smem);
    xcd_barrier(bar);
    mixA(p, layer, smem);
    xcd_barrier(bar);
    mixB(p, layer, smem, (volatile LAS unsigned*)(smem_all + SMEM_BYTES + 16));
    xcd_barrier(bar);
    mixC(p, layer, smem);
    xcd_barrier(bar);
    ph_gemm2(p, layer, smem);
    ph_peerconv(p, layer);
    xcd_barrier(bar);
    ph_norm(p, layer, 1);
    xcd_barrier(bar);
    ph_gemm3(p, smem);
    xcd_barrier(bar);
    ph_peer_gather<0>(p, layer, smem, (volatile LAS unsigned*)(smem_all + SMEM_BYTES + 16));
    xcd_barrier(bar);
    ph_peer_w(p);
    xcd_barrier(bar);
    ph_peer_gather<1>(p, layer, smem, (volatile LAS unsigned*)(smem_all + SMEM_BYTES + 16));
    if (layer + 1 < DEPTH) ph_prep(p, layer + 1, smem, true);
    xcd_barrier(bar);
  }
  ph_final(p);
}

static inline size_t al256(size_t x) { return (x + 255) & ~(size_t)255; }

extern "C" void kernel_launch(void* const* d_in, const int* in_sizes, int n_in, void* d_out, int out_size, void* d_ws, size_t ws_size,
                              hipStream_t stream) {
  (void)in_sizes; (void)n_in; (void)out_size; (void)ws_size;
  P p{};
  const float** f = (const float**)&p;
  for (int i = 0; i < 39; ++i) f[i] = (const float*)d_in[i];
  p.out = (float*)d_out;
  char* w = (char*)d_ws;
  size_t off = 0;
  auto take = [&](size_t bytes) { char* r = w + off; off += al256(bytes); return r; };
  p.bar = (unsigned*)take(16384);
  p.modv = (float*)take((size_t)DEPTH * 17 * 6144 * 4);
  p.SSQ = (float*)take((size_t)DEPTH * 2 * 256 * 4);
  p.wq = (unsigned*)take(4096 + DEPTH * 1024);
  p.cuclaim = (unsigned*)take((size_t)DEPTH * 4096 * 4);
  const size_t zero_bytes = off;
  p.rope = (float*)take(64 * 16 * 2 * 4);
  p.X = (bf16_t*)take((size_t)NTOK * D * 2);
  p.H = (bf16_t*)take((size_t)NTOK * D * 2);
  p.Y = (bf16_t*)take((size_t)NTOK * D * 2);
  p.SC = (bf16_t*)take((size_t)NTOK * 1024 * 2);
  p.Z = (bf16_t*)take((size_t)NTOK * INW * 2);
  p.UTl = (bf16_t*)take((size_t)256 * 16 * T * 2);
  p.UTc = (bf16_t*)take((size_t)256 * 16 * LC * 2);
  p.YTl = (bf16_t*)take((size_t)256 * 16 * T * 2);
  p.YTc = (bf16_t*)take((size_t)256 * 16 * LC * 2);
  p.FL = (float*)take((size_t)256 * 2 * T * 4);
  p.FC = (float*)take((size_t)256 * 2 * LC * 4);
  p.W1t = (bf16_t*)take((size_t)INW * D * 2);
  p.W2t = (bf16_t*)take((size_t)D * D * 2);
  p.Wft = (bf16_t*)take((size_t)2048 * D * 2);
  p.Wlt = (bf16_t*)take((size_t)1024 * 256 * 2);
  p.Wgt = (bf16_t*)take((size_t)256 * 128 * 2);
  p.TK = (float*)p.Z;
  p.PU = (unsigned char*)p.Z + al256((size_t)NTOK * 256 * 4);
  p.PV = p.PU + (size_t)16384 * 1024;
  p.PSU = (float*)(p.PV + (size_t)16384 * 1024);
  p.PSV = p.PSU + 16384;
  p.GT = p.PSV + 16384;
  p.EL = (unsigned short*)(p.GT + (size_t)NTOK * 128);
  p.H8 = (unsigned char*)p.EL + al256((size_t)NTOK * 128 * 2);
  p.HINV = (float*)(p.H8 + (size_t)NTOK * 1024);
  p.PD = p.Y;

  (void)hipMemsetAsync(d_ws, 0, zero_bytes, stream);
  constexpr size_t kDynLds = SMEM_BYTES + 32;
  static int grid = 0;
  if (!grid) {
    int dev = 0, cus = 0, per_cu = 0;
    (void)hipGetDevice(&dev);
    (void)hipDeviceGetAttribute(&cus, hipDeviceAttributeMultiprocessorCount, dev);
    (void)hipFuncSetAttribute((const void*)k_mega, hipFuncAttributeMaxDynamicSharedMemorySize, (int)kDynLds);
    (void)hipOccupancyMaxActiveBlocksPerMultiprocessor(&per_cu, k_mega, 256, kDynLds);
    if (cus <= 0) cus = 256;
    if (per_cu > 2) per_cu = 2;
    if (per_cu < 1) per_cu = 1;
    grid = cus * per_cu;
  }
  k_mega<<<grid, 256, kDynLds, stream>>>(p);
}
```

```cpp
#include <hip/hip_runtime.h>
#include <stdint.h>
#include <type_traits>

#define DEV __device__ __forceinline__
typedef unsigned short bf16_t;
typedef short bf16x8 __attribute__((ext_vector_type(8)));
typedef float f32x2 __attribute__((ext_vector_type(2)));
constexpr size_t PSLICE = (size_t)16384 * 128;
typedef float f32x4 __attribute__((ext_vector_type(4)));
typedef float f32x16 __attribute__((ext_vector_type(16)));


constexpr int NB = 16, T = 4096, LC = 256, LT = 4352, D = 1024, NTOK = NB * LT, INW = 2688, DEPTH = 4;
constexpr int SMEM_BYTES = 65536;

struct P {
  const float *x, *c, *ctx, *c_ctx, *mod_w, *mod_b, *norm1_g, *norm2_g, *w_in, *conv_w, *conv_b;
  const float *hy_w1, *hy_b1, *hy_w2, *hy_b2, *hy_w3, *hy_b3, *hy_freq, *hy_bias;
  const float *rw_w0, *rw_w_up, *rw_a0, *rw_a_up, *rw_g_up, *rw_k_k, *rw_k_a, *rw_r_k, *rw_ln_w, *rw_ln_b;
  const float *attn_sink, *hy_out_g, *at_out_g, *w_out, *peer_wq, *peer_k1, *peer_k2, *peer_u, *peer_v, *final_g;
  float* out;
  unsigned* bar;
  float *modv, *SSQ, *rope, *FL, *FC, *TK;
  unsigned *wq, *cuclaim;
  bf16_t *X, *H, *Y, *SC, *Z, *UTl, *UTc, *YTl, *YTc;
  bf16_t *W1t, *W2t, *Wft, *Wlt, *Wgt;
  unsigned char *PU, *PV;
  float *PSU, *PSV, *GT, *HINV;
  bf16_t* PD;
  unsigned short* EL;
  unsigned char* H8;
};

typedef __bf16 hwbf2 __attribute__((ext_vector_type(2)));
DEV unsigned pack2(float a, float b) { f32x2 f = {a, b}; hwbf2 r = __builtin_convertvector(f, hwbf2); return __builtin_bit_cast(unsigned, r); }
DEV bf16_t f2bf(float f) { return (bf16_t)(pack2(f, 0.f) & 0xFFFFu); }
DEV float bf2f(bf16_t h) { return __uint_as_float(((unsigned)h) << 16); }
DEV float bflo(unsigned u) { return __uint_as_float(u << 16); }
DEV float bfhi(unsigned u) { return __uint_as_float(u & 0xFFFF0000u); }
DEV void unpack8(const uint4& u, float* v) {
  v[0] = bflo(u.x); v[1] = bfhi(u.x); v[2] = bflo(u.y); v[3] = bfhi(u.y);
  v[4] = bflo(u.z); v[5] = bfhi(u.z); v[6] = bflo(u.w); v[7] = bfhi(u.w);
}
DEV uint4 pack8(const float* v) { return make_uint4(pack2(v[0], v[1]), pack2(v[2], v[3]), pack2(v[4], v[5]), pack2(v[6], v[7])); }
DEV int pack_i8(float a, float b, float c, float d) {
  const int ia = __float2int_rn(a), ib = __float2int_rn(b), ic = __float2int_rn(c), id = __float2int_rn(d);
  return (ia & 0xFF) | ((ib & 0xFF) << 8) | ((ic & 0xFF) << 16) | ((id & 0xFF) << 24);
}
DEV float sigmoidf_(float x) { return __builtin_amdgcn_rcpf(1.f + __expf(-x)); }

template <int CTRL, int ROWMASK>
DEV float dpp0(float x) {
  return __builtin_bit_cast(float, __builtin_amdgcn_update_dpp(0, __builtin_bit_cast(int, x), CTRL, ROWMASK, 0xF, false));
}
template <int CTRL, int ROWMASK>
DEV float dppself(float x) {
  int xi = __builtin_bit_cast(int, x);
  return __builtin_bit_cast(float, __builtin_amdgcn_update_dpp(xi, xi, CTRL, ROWMASK, 0xF, false));
}
DEV float readlane_f(float x, int l) { return __builtin_bit_cast(float, __builtin_amdgcn_readlane(__builtin_bit_cast(int, x), l)); }
DEV int lane_id() { return (int)__builtin_amdgcn_mbcnt_hi(~0u, __builtin_amdgcn_mbcnt_lo(~0u, 0u)); }
DEV float writelane_f(float val, int l, float old) { return lane_id() == l ? val : old; }
DEV int writelane_i(int val, int l, int old) { return lane_id() == l ? val : old; }
DEV float wave_sum(float x) {
  x += dpp0<0x111, 0xF>(x); x += dpp0<0x112, 0xF>(x); x += dpp0<0x114, 0xF>(x); x += dpp0<0x118, 0xF>(x);
  x += dpp0<0x142, 0xA>(x); x += dpp0<0x143, 0xC>(x);
  return readlane_f(x, 63);
}
DEV float wave_max(float x) {
  x = fmaxf(x, dppself<0x111, 0xF>(x)); x = fmaxf(x, dppself<0x112, 0xF>(x)); x = fmaxf(x, dppself<0x114, 0xF>(x));
  x = fmaxf(x, dppself<0x118, 0xF>(x)); x = fmaxf(x, dppself<0x142, 0xA>(x)); x = fmaxf(x, dppself<0x143, 0xC>(x));
  return readlane_f(x, 63);
}
DEV float row16_sum(float x) {
  x += dpp0<0xB1, 0xF>(x); x += dpp0<0x4E, 0xF>(x); x += dpp0<0x141, 0xF>(x); x += dpp0<0x140, 0xF>(x);
  return x;
}
DEV float row16_max(float x) {
  x = fmaxf(x, dppself<0xB1, 0xF>(x)); x = fmaxf(x, dppself<0x4E, 0xF>(x)); x = fmaxf(x, dppself<0x141, 0xF>(x));
  x = fmaxf(x, dppself<0x140, 0xF>(x));
  return x;
}
DEV float quad_sum(float x) { x += dpp0<0xB1, 0xF>(x); x += dpp0<0x4E, 0xF>(x); return x; }

DEV f32x4 mfma16(bf16x8 a, bf16x8 b, f32x4 c) { return __builtin_amdgcn_mfma_f32_16x16x32_bf16(a, b, c, 0, 0, 0); }
DEV f32x16 mfma32(bf16x8 a, bf16x8 b, f32x16 c) { return __builtin_amdgcn_mfma_f32_32x32x16_bf16(a, b, c, 0, 0, 0); }


#define XB_TMO      128
#define XB_XCNT(j)  (256  + 64 * (j))
#define XB_XSUB(j)  (1280 + 64 * (j))
#define XB_XGEN(j)  (2304 + 64 * (j))
#define XB_TOP      3328
#define XB_TOPGEN   3392
#define XCD_BAR_WORDS 3456
#define XB_SPIN_CAP (1u << 23)
#define LAS __attribute__((address_space(3)))

__device__ __forceinline__ unsigned xb_ld(unsigned* p)              { return __hip_atomic_load(p, __ATOMIC_RELAXED, __HIP_MEMORY_SCOPE_AGENT); }
__device__ __forceinline__ unsigned xb_add(unsigned* p, unsigned v) { return __hip_atomic_fetch_add(p, v, __ATOMIC_RELAXED, __HIP_MEMORY_SCOPE_AGENT); }
__device__ __forceinline__ unsigned xb_xcc_id() { return (unsigned)__builtin_amdgcn_s_getreg((3 << 11) | 20) & 0xFu; }
#define XB_SPIN(cond, bar) do { unsigned _sp = 0; while (cond) { __builtin_amdgcn_s_sleep(1); \
    if ((++_sp & 255u) == 0u) { if (xb_ld(&(bar)[XB_TMO])) break; if (_sp > XB_SPIN_CAP) { atomicAdd(&(bar)[XB_TMO], 1u); break; } } } } while (0)

struct XcdBarrier {
    unsigned* bar; unsigned x;
    volatile LAS unsigned* st;
};
__device__ __forceinline__ XcdBarrier xcd_barrier_post(unsigned* bar, volatile LAS unsigned* st) {
    XcdBarrier b; b.bar = bar; b.x = xb_xcc_id(); b.st = st;
    if (threadIdx.x == 0) (void)xb_add(&bar[XB_XCNT(b.x)], 1u);
    return b;
}
__device__ __forceinline__ void xcd_barrier_complete(unsigned* bar, unsigned x, unsigned& nloc, unsigned& nx) {
    const unsigned G = gridDim.x * gridDim.y * gridDim.z;
    unsigned sum, cnt, mine, sp = 0u;
    for (;;) {
        sum = 0u; cnt = 0u; mine = 0u;
#pragma unroll
        for (unsigned j = 0; j < 16; ++j) { const unsigned c = xb_ld(&bar[XB_XCNT(j)]); sum += c; cnt += (c > 0u) ? 1u : 0u; mine = (j == x) ? c : mine; }
        if (sum == G) break;
        __builtin_amdgcn_s_sleep(1);
        if ((++sp & 255u) == 0u) { if (xb_ld(&bar[XB_TMO])) break; if (sp > XB_SPIN_CAP) { atomicAdd(&bar[XB_TMO], 1u); break; } }
    }
    nloc = mine > 0u ? mine : 1u; nx = cnt > 0u ? cnt : 1u;
}
__device__ __forceinline__ void xcd_barrier(const XcdBarrier& b) {
    asm volatile("s_waitcnt vmcnt(0)" ::: "memory");
    __syncthreads();
    if (threadIdx.x == 0) {
        unsigned* bar = b.bar;
        __builtin_amdgcn_s_waitcnt(0);
        unsigned nloc = b.st[0], nx = b.st[1];
        if (nloc == 0u) { xcd_barrier_complete(bar, b.x, nloc, nx); b.st[0] = nloc; b.st[1] = nx; }
        const unsigned old = xb_add(&bar[XB_XSUB(b.x)], 1u);
        const unsigned gen = old / nloc;
        if (old + 1u == (gen + 1u) * nloc) {
            __builtin_amdgcn_fence(__ATOMIC_RELEASE, "agent");
            asm volatile("s_waitcnt vmcnt(0)" ::: "memory");
            const unsigned og = xb_add(&bar[XB_TOP], 1u);
            const unsigned tg = og / nx;
            if (og + 1u == (tg + 1u) * nx) xb_add(&bar[XB_TOPGEN], 1u);
            else XB_SPIN(xb_ld(&bar[XB_TOPGEN]) == tg, bar);
            __builtin_amdgcn_fence(__ATOMIC_ACQUIRE, "agent");
            xb_add(&bar[XB_XGEN(b.x)], 1u);
            asm volatile("s_waitcnt vmcnt(0)" ::: "memory");
        } else {
            XB_SPIN(xb_ld(&bar[XB_XGEN(b.x)]) == gen, bar);
            __builtin_amdgcn_fence(__ATOMIC_ACQUIRE, "agent");
            asm volatile("s_waitcnt vmcnt(0)" ::: "memory");
        }
    }
    __syncthreads();
}

template <class Tp> DEV Tp* opq(Tp* q) { asm volatile("" : "+s"(q)); return q; }
DEV int tid_() { int t = threadIdx.x; asm volatile("" : "+v"(t)); return t; }
DEV int bid_() { int b = blockIdx.x; asm volatile("" : "+s"(b)); return b; }

DEV void glds16(const void* gsrc, char* lds_lane_ptr) {
  __builtin_amdgcn_global_load_lds((const unsigned*)gsrc, (__attribute__((address_space(3))) unsigned*)lds_lane_ptr, 16, 0, 0);
}
template <class Epi>
DEV void gemm_tile(const bf16_t* __restrict__ A, int lda, const bf16_t* __restrict__ Bt, int ldb, int K, char* smem, Epi& epi) {
  const int tid = tid_(), lane = tid & 63, wid = tid >> 6, wr = wid >> 1, wc = wid & 1, fr = lane & 15, fq = lane >> 4;
  f32x4 acc[4][4];
#pragma unroll
  for (int m = 0; m < 4; ++m)
#pragma unroll
    for (int n = 0; n < 4; ++n) acc[m][n] = (f32x4){0.f, 0.f, 0.f, 0.f};
  const int drow0 = 8 * wid + (lane >> 3), dpc = lane & 7;
  auto issue = [&](int kt, int buf) {
    char* sa = smem + buf * 32768;
    char* sb = sa + 16384;
#pragma unroll
    for (int i = 0; i < 4; ++i) {
      const int row = drow0 + 32 * i;
      const int kc = dpc ^ ((row >> 1) & 7);
      glds16(A + (size_t)row * lda + kt * 64 + kc * 8, sa + (i * 4 + wid) * 1024 + lane * 16);
      glds16(Bt + (size_t)row * ldb + kt * 64 + kc * 8, sb + (i * 4 + wid) * 1024 + lane * 16);
    }
  };
  __syncthreads();
  issue(0, 0);
  const int nk = K >> 6;
  const int sw = (fr >> 1) & 7;
  const int aoff = (wr * 64 + fr) * 128, boff = (wc * 64 + fr) * 128;
  for (int kt = 0; kt < nk; ++kt) {
    asm volatile("s_waitcnt vmcnt(0)" ::: "memory");
    __syncthreads();
    if (kt + 1 < nk) issue(kt + 1, (kt + 1) & 1);
    const char* sa = smem + (kt & 1) * 32768;
    const char* sb = sa + 16384;
#pragma unroll
    for (int kh = 0; kh < 2; ++kh) {
      const int pc = ((kh * 4 + fq) ^ sw) * 16;
      bf16x8 af[4], bfr[4];
#pragma unroll
      for (int m = 0; m < 4; ++m) af[m] = *(const bf16x8*)(sa + aoff + m * 2048 + pc);
#pragma unroll
      for (int n = 0; n < 4; ++n) bfr[n] = *(const bf16x8*)(sb + boff + n * 2048 + pc);
#pragma unroll
      for (int m = 0; m < 4; ++m)
#pragma unroll
        for (int n = 0; n < 4; ++n) acc[m][n] = mfma16(bfr[n], af[m], acc[m][n]);
    }
  }
  __syncthreads();
  epi(acc, wr, wc, fr, fq, smem);
}
DEV void stage_tile_bf16(const f32x4 (&acc)[4][4], char* smem, int wid, int fr, int fq) {
  bf16_t (*t)[72] = (bf16_t (*)[72])(smem + wid * 9216);
#pragma unroll
  for (int m = 0; m < 4; ++m)
#pragma unroll
    for (int n = 0; n < 4; ++n)
      *(uint2*)&t[m * 16 + fr][n * 16 + 4 * fq] = make_uint2(pack2(acc[m][n][0], acc[m][n][1]), pack2(acc[m][n][2], acc[m][n][3]));
  asm volatile("s_waitcnt lgkmcnt(0)" ::: "memory");
}

DEV void ph_copy(const P& p) {
  const size_t n8 = (size_t)NTOK * D / 8;
  const float* pctx = opq(p.ctx); const float* px = opq(p.x);
  for (size_t i = (size_t)bid_() * 256 + tid_(); i < n8; i += (size_t)gridDim.x * 256) {
    size_t e = i * 8;
    int row = (int)(e / D), col = (int)(e % D);
    int b = row / LT, pp = row % LT;
    const float* src = pp < LC ? pctx + ((size_t)(b * LC + pp)) * D + col : px + ((size_t)(b * T + pp - LC)) * D + col;
    float4 v0 = *(const float4*)src, v1 = *(const float4*)(src + 4);
    uint4 o = make_uint4(pack2(v0.x, v0.y), pack2(v0.z, v0.w), pack2(v1.x, v1.y), pack2(v1.z, v1.w));
    *(uint4*)(p.X + e) = o;
  }
}

DEV void ph_rope(const P& p) {
  for (int i = bid_() * 256 + tid_(); i < 64 * 16; i += gridDim.x * 256) {
    int pos = i >> 4, k = i & 15;
    float inv = powf(10000.f, -(float)k / 16.f);
    float ang = (float)pos * inv;
    p.rope[2 * i] = cosf(ang); p.rope[2 * i + 1] = sinf(ang);
  }
}

DEV void modv_unit(const P& p, int unit, char* smem) {
  const int cc = unit % 24, layer = unit / 24;
  float (*cs)[128] = (float (*)[128])smem;
  const int col = cc * 256 + tid_();
  const float* pc = opq(p.c); const float* pcc = opq(p.c_ctx);
  float acc[17];
#pragma unroll
  for (int r = 0; r < 17; ++r) acc[r] = 0.f;
  for (int ks = 0; ks < 8; ++ks) {
    __syncthreads();
    for (int i = tid_(); i < 17 * 128; i += 256) {
      int r = i >> 7, e = i & 127;
      float v = r < 16 ? pc[r * D + ks * 128 + e] : pcc[ks * 128 + e];
      cs[r][e] = v / (1.f + expf(-v));
    }
    __syncthreads();
    const float* w = p.mod_w + ((size_t)layer * D + ks * 128) * 6144 + col;
#pragma unroll 4
    for (int e = 0; e < 128; ++e) {
      float wv = w[(size_t)e * 6144];
#pragma unroll
      for (int r = 0; r < 17; ++r) acc[r] += cs[r][e] * wv;
    }
  }
  const float bias = p.mod_b[layer * 6144 + col];
#pragma unroll
  for (int r = 0; r < 17; ++r) p.modv[((size_t)layer * 17 + r) * 6144 + col] = acc[r] + bias;
}

DEV void transpose_unit(const float* __restrict__ src, bf16_t* __restrict__ dst, int R, int C, int tile, char* smem) {
  float (*t)[65] = (float (*)[65])smem;
  const int nct = C / 64;
  const int tr = tile / nct, tc = tile % nct;
  __syncthreads();
  for (int i = tid_(); i < 4096; i += 256) { int r = i >> 6, c = i & 63; t[r][c] = src[(size_t)(tr * 64 + r) * C + tc * 64 + c]; }
  __syncthreads();
  for (int i = tid_(); i < 4096; i += 256) { int c = i >> 6, r = i & 63; dst[(size_t)(tc * 64 + c) * R + tr * 64 + r] = f2bf(t[r][c]); }
}

DEV void wfold_unit(const P& p, int layer, int unit, char* smem) {
  const int hs = unit >> 5, ec = unit & 31, h = hs >> 1, s = hs & 1;
  const float* wq = p.peer_wq + (size_t)layer * D * 2048;
  const float* kk = (s ? opq(p.peer_k2) : opq(p.peer_k1)) + ((size_t)layer * 8 + h) * 128 * 128;
  float (*kS)[65] = (float (*)[65])smem;
  float (*wS)[64] = (float (*)[64])(smem + 33280);
  const int key = tid_() & 127, eh = tid_() >> 7;
  float acc[16];
#pragma unroll
  for (int i = 0; i < 16; ++i) acc[i] = 0.f;
  for (int dh = 0; dh < 2; ++dh) {
    __syncthreads();
    for (int i = tid_(); i < 128 * 64; i += 256) { int k2 = i >> 6, d = i & 63; kS[k2][d] = kk[k2 * 128 + dh * 64 + d]; }
    for (int i = tid_(); i < 32 * 64; i += 256) {
      int e = i >> 6, d = i & 63;
      wS[e][d] = wq[(size_t)(ec * 32 + e) * 2048 + h * 256 + s * 128 + dh * 64 + d];
    }
    __syncthreads();
#pragma unroll 2
    for (int d = 0; d < 64; ++d) {
      float kv = kS[key][d];
#pragma unroll
      for (int i = 0; i < 16; ++i) acc[i] += kv * wS[eh * 16 + i][d];
    }
  }
  bf16_t* dst = p.Wft + ((size_t)(hs * 128 + key)) * D + ec * 32 + eh * 16;
#pragma unroll
  for (int i = 0; i < 16; i += 2) *(unsigned*)(dst + i) = pack2(acc[i], acc[i + 1]);
}

DEV void filt_unit(const P& p, int layer, int unit, char* smem) {
  int kind, j0, L;
  if (unit < 1024) { kind = 0; j0 = unit * 4; L = T; } else { kind = 1; j0 = (unit - 1024) * 4; L = LC; }
  float* zs = (float*)smem;
  float* h1 = zs + 4 * 36;
  float* h2 = h1 + 256;
  const int jj = tid_() >> 6, o = tid_() & 63;
  const int j = j0 + jj;
  const float fj = (float)j;
  const float t = fj / (float)(L - 1);
  __syncthreads();
  if (o < 33) {
    float z;
    if (o == 0) z = t;
    else {
      int i = (o - 1) & 15;
      float band = 1e-4f + (float)i * ((15.0f - 1e-4f) / 15.0f);
      float ang = 6.283185307179586f * fj * band / (float)L;
      z = (o <= 16) ? cosf(ang) : -sinf(ang);
    }
    zs[jj * 36 + o] = z;
  }
  __syncthreads();
  {
    const float* w1 = p.hy_w1 + layer * 33 * 64;
    float a = p.hy_b1[layer * 64 + o];
#pragma unroll 3
    for (int i = 0; i < 33; ++i) a += zs[jj * 36 + i] * w1[i * 64 + o];
    h1[jj * 64 + o] = sinf(p.hy_freq[layer * 128 + o] * a);
  }
  __syncthreads();
  {
    const float* w2 = p.hy_w2 + layer * 64 * 64;
    float a = p.hy_b2[layer * 64 + o];
#pragma unroll 4
    for (int i = 0; i < 64; ++i) a += h1[jj * 64 + i] * w2[i * 64 + o];
    h2[jj * 64 + o] = sinf(p.hy_freq[layer * 128 + 64 + o] * a);
  }
  __syncthreads();
  const float* w3 = p.hy_w3 + layer * 64 * 512;
  float* F = kind ? opq(p.FC) : opq(p.FL);
  const float DMIN = -3.0701134573253945f, DMAX = -15.350567286626973f;
#pragma unroll 1
  for (int m = 0; m < 4; ++m) {
    int c = o + 64 * m;
    float af = p.hy_b3[layer * 512 + c], ab = p.hy_b3[layer * 512 + 256 + c];
#pragma unroll 4
    for (int i = 0; i < 64; ++i) { float hv = h2[jj * 64 + i]; af += hv * w3[i * 512 + c]; ab += hv * w3[i * 512 + 256 + c]; }
    float delta = fabsf(DMIN + (float)c * ((DMAX - DMIN) / 255.f));
    float win = expf(-t * delta) + 0.05f;
    af *= win; ab *= win;
    F[((size_t)c * 2 + 0) * L + j] = af;
    F[((size_t)c * 2 + 1) * L + j] = ab;
  }
}

constexpr int PREP_T0 = 672, PREP_T1 = PREP_T0 + 256, PREP_T2 = PREP_T1 + 8, PREP_T3 = PREP_T2 + 8, PREP_T4 = PREP_T3 + 8;
constexpr int PREP_WF = PREP_T4 + 512, PREP_N = PREP_WF + 1088;
DEV void prep_unit(const P& p, int layer, int u, char* smem) {
  if (u < PREP_T0) transpose_unit(p.w_in + (size_t)layer * D * INW, p.W1t, D, INW, u, smem);
  else if (u < PREP_T1) transpose_unit(p.w_out + (size_t)layer * D * D, p.W2t, D, D, u - PREP_T0, smem);
  else if (u < PREP_T3) {
    const int u0 = u - PREP_T1;
    for (int i = tid_(); i < 64 * 256; i += 256) {
      const int np = u0 * 64 + (i >> 8), kp = i & 255;
      const int ps = np & 3, chan = np >> 2, qp = kp >> 6, kk = kp & 63;
      const int is_a = ps & 1, d = ps >> 1;
      float v = 0.f;
      if (qp == (is_a ? 2 + d : d)) v = (is_a ? opq(p.rw_a_up) : opq(p.rw_w_up))[(((size_t)layer * 2 + d) * 64 + kk) * 256 + chan];
      p.Wlt[(size_t)np * 256 + kp] = f2bf(v);
    }
  }
  else if (u < PREP_T4) transpose_unit(p.rw_g_up + (size_t)layer * 128 * 256, p.Wgt, 128, 256, u - PREP_T3, smem);
  else if (u < PREP_WF) wfold_unit(p, layer, u - PREP_T4, smem);
  else filt_unit(p, layer, u - PREP_WF, smem);
}
constexpr int PREPA_N = PREP_T0 + (PREP_T4 - PREP_T1);
DEV int prepA_unit_index(int i) { return i < PREP_T0 ? i : PREP_T1 + (i - PREP_T0); }
DEV void ph_prep(const P& p, int layer, char* smem, bool onlyB) {
  for (int u = bid_(); u < PREP_N; u += gridDim.x) {
    const bool isA = (u < PREP_T0) || (u >= PREP_T1 && u < PREP_T4);
    if (onlyB && isA) continue;
    prep_unit(p, layer, u, smem);
  }
}

DEV void wave_range(int& r0, int& r1, int ntok) {
  const int gw = (bid_() * 256 + tid_()) >> 6, nw = gridDim.x * 4;
  const int per = (ntok + nw - 1) / nw;
  r0 = gw * per; r1 = r0 + per; if (r1 > ntok) r1 = ntok;
}
DEV void ph_norm(const P& p, int layer, int which) {
  const int lane = tid_() & 63;
  int r0, r1;
  wave_range(r0, r1, NTOK);
  const float* g = (which ? p.norm2_g : p.norm1_g) + layer * D;
  float gv[16], scv[16], shv[16];
#pragma unroll
  for (int hh = 0; hh < 2; ++hh)
#pragma unroll
    for (int i = 0; i < 8; ++i) gv[hh * 8 + i] = g[hh * 512 + 8 * lane + i];
  int mr_cur = -1;
  uint4 n0 = make_uint4(0, 0, 0, 0), n1 = n0;
  if (r0 < r1) { const bf16_t* xr = p.X + (size_t)r0 * D; n0 = *(const uint4*)(xr + 8 * lane); n1 = *(const uint4*)(xr + 512 + 8 * lane); }
#pragma unroll 1
  for (int row = r0; row < r1; ++row) {
    const uint4 u0 = n0, u1 = n1;
    if (row + 1 < r1) { const bf16_t* xr = p.X + (size_t)(row + 1) * D; n0 = *(const uint4*)(xr + 8 * lane); n1 = *(const uint4*)(xr + 512 + 8 * lane); }
    const int b = row / LT, pp = row % LT;
    const int mr = pp < LC ? 16 : b;
    if (mr != mr_cur) {
      mr_cur = mr;
      const float* mv = p.modv + ((size_t)layer * 17 + mr) * 6144 + (which ? 3072 : 0);
#pragma unroll
      for (int hh = 0; hh < 2; ++hh)
#pragma unroll
        for (int i = 0; i < 8; ++i) { shv[hh * 8 + i] = mv[hh * 512 + 8 * lane + i]; scv[hh * 8 + i] = 1.f + mv[1024 + hh * 512 + 8 * lane + i]; }
    }
    float v[16];
    unpack8(u0, v); unpack8(u1, v + 8);
    float ss = 0.f;
#pragma unroll
    for (int i = 0; i < 16; ++i) ss += v[i] * v[i];
    ss = wave_sum(ss);
    const float rstd = rsqrtf(ss * (1.f / 1024.f) + 1e-6f);
    float o[16];
#pragma unroll
    for (int i = 0; i < 16; ++i) o[i] = (v[i] * rstd * gv[i]) * scv[i] + shv[i];
    bf16_t* hr = p.H + (size_t)row * D;
    *(uint4*)(hr + 8 * lane) = pack8(o);
    *(uint4*)(hr + 512 + 8 * lane) = pack8(o + 8);
    if (which) {
      float am = 0.f;
#pragma unroll
      for (int i = 0; i < 16; ++i) am = fmaxf(am, fabsf(o[i]));
      am = wave_max(am);
      const float sc = am > 0.f ? 127.f / am : 1.f;
      unsigned char* h8 = p.H8 + (size_t)row * 1024;
      *(uint2*)(h8 + 8 * lane) = make_uint2((unsigned)pack_i8(o[0] * sc, o[1] * sc, o[2] * sc, o[3] * sc), (unsigned)pack_i8(o[4] * sc, o[5] * sc, o[6] * sc, o[7] * sc));
      *(uint2*)(h8 + 512 + 8 * lane) = make_uint2((unsigned)pack_i8(o[8] * sc, o[9] * sc, o[10] * sc, o[11] * sc), (unsigned)pack_i8(o[12] * sc, o[13] * sc, o[14] * sc, o[15] * sc));
      if (lane == 0) p.HINV[row] = am > 0.f ? am * (1.f / 127.f) : 1.f;
    }
  }
}

DEV bool gemm_unit(int it, int nct, int& rt, int& ct) {
  const int nslot = gridDim.x >> 3;
  const int x = bid_() & 7, sl = bid_() >> 3;
  if (sl >= nslot) return false;
  const int v = it * nslot + sl;
  if (v >= 68 * nct) return false;
  const int rg = v / (8 * nct), rem = v - rg * 8 * nct;
  const int rows = (rg == 8) ? 4 : 8;
  ct = rem / rows;
  rt = x * 68 + rg * 8 + (rem - ct * rows);
  return true;
}
struct Epi1 {
  const P& p; int row0, col0;
  DEV void operator()(f32x4 (&acc)[4][4], int wr, int wc, int fr, int fq, char* smem) const {
    const int cw = col0 + wc * 64;
    const int rbase = row0 + wr * 64;
    const bool lat = (row0 % LT) >= LC;
    if (cw >= 1536 && cw < 1664) {
#pragma unroll
      for (int m = 0; m < 4; ++m)
#pragma unroll
        for (int n = 0; n < 4; ++n)
#pragma unroll
          for (int j = 0; j < 4; ++j) acc[m][n][j] = 2.f * sigmoidf_(2.f * acc[m][n][j]) - 1.f;
    } else if (cw >= 1792 && cw < 1920) {
#pragma unroll
      for (int m = 0; m < 4; ++m)
#pragma unroll
        for (int n = 0; n < 4; ++n)
#pragma unroll
          for (int j = 0; j < 4; ++j) acc[m][n][j] = sigmoidf_(acc[m][n][j]);
    } else if (cw >= 1920 && cw < 2560 && lat) {
#pragma unroll
      for (int m = 0; m < 4; ++m) {
        const int row = rbase + m * 16 + fr;
        const int pl = (row % LT) - LC;
        const int ri = pl >> 6, ci = pl & 63;
        const float4* crp = (const float4*)(p.rope + 2 * (ri * 16 + 4 * fq));
        const float4* ccp = (const float4*)(p.rope + 2 * (ci * 16 + 4 * fq));
        const float4 cr0 = crp[0], cr1 = crp[1], cc0 = ccp[0], cc1 = ccp[1];
        const float crc[4] = {cr0.x, cr0.z, cr1.x, cr1.z}, crs[4] = {cr0.y, cr0.w, cr1.y, cr1.w};
        const float ccc[4] = {cc0.x, cc0.z, cc1.x, cc1.z}, ccs[4] = {cc0.y, cc0.w, cc1.y, cc1.w};
#pragma unroll
        for (int j = 0; j < 4; ++j) {
          float x1 = acc[m][0][j], x2 = acc[m][1][j];
          acc[m][0][j] = x1 * crc[j] - x2 * crs[j]; acc[m][1][j] = x2 * crc[j] + x1 * crs[j];
          x1 = acc[m][2][j]; x2 = acc[m][3][j];
          acc[m][2][j] = x1 * ccc[j] - x2 * ccs[j]; acc[m][3][j] = x2 * ccc[j] + x1 * ccs[j];
        }
      }
    }
    const int wid = wr * 2 + wc, lane = fq * 16 + fr;
    stage_tile_bf16(acc, smem, wid, fr, fq);
    const bf16_t (*t)[72] = (const bf16_t (*)[72])(smem + wid * 9216);
#pragma unroll
    for (int i = 0; i < 8; ++i) {
      const int rl = i * 8 + (lane >> 3), ch = lane & 7;
      *(uint4*)(p.Z + (size_t)(rbase + rl) * INW + cw + ch * 8) = *(const uint4*)&t[rl][ch * 8];
    }
  }
};
DEV void ph_gemm1(const P& p, char* smem) {
  const int nct = INW / 128;
  int rt, ct;
  for (int it = 0; gemm_unit(it, nct, rt, ct); ++it) {
    Epi1 epi{p, rt * 128, ct * 128};
    gemm_tile(p.H + (size_t)rt * 128 * D, D, p.W1t + (size_t)ct * 128 * D, D, D, smem, epi);
  }
}

struct EpiLoraA {
  const P& p; int layer, row0, col0;
  DEV void operator()(f32x4 (&acc)[4][4], int wr, int wc, int fr, int fq, char* smem) const {
    const float* w0b = p.rw_w0 + layer * 512;
    const float* a0b = p.rw_a0 + layer * 512;
#pragma unroll
    for (int n = 0; n < 4; ++n) {
      const int chan = ((col0 + wc * 64 + n * 16) >> 2) + fq;
      const float be0 = w0b[chan], ba0 = a0b[chan], be1 = w0b[256 + chan], ba1 = a0b[256 + chan];
#pragma unroll
      for (int m = 0; m < 4; ++m) {
        acc[m][n][0] = 0.6065306597126334f * sigmoidf_(acc[m][n][0] + be0);
        acc[m][n][1] = sigmoidf_(acc[m][n][1] + ba0);
        acc[m][n][2] = 0.6065306597126334f * sigmoidf_(acc[m][n][2] + be1);
        acc[m][n][3] = sigmoidf_(acc[m][n][3] + ba1);
      }
    }
    const int wid = wr * 2 + wc, lane = fq * 16 + fr;
    stage_tile_bf16(acc, smem, wid, fr, fq);
    const bf16_t (*t)[72] = (const bf16_t (*)[72])(smem + wid * 9216);
#pragma unroll
    for (int i = 0; i < 8; ++i) {
      const int rl = i * 8 + (lane >> 3), ch = lane & 7;
      *(uint4*)(p.SC + (size_t)(row0 + wr * 64 + rl) * 1024 + col0 + wc * 64 + ch * 8) = *(const uint4*)&t[rl][ch * 8];
    }
  }
};
struct EpiLoraG {
  const P& p; int row0, col0;
  DEV void operator()(f32x4 (&acc)[4][4], int wr, int wc, int fr, int fq, char* smem) const {
    const int wid = wr * 2 + wc, lane = fq * 16 + fr;
    stage_tile_bf16(acc, smem, wid, fr, fq);
    const bf16_t (*t)[72] = (const bf16_t (*)[72])(smem + wid * 9216);
#pragma unroll
    for (int i = 0; i < 8; ++i) {
      const int rl = i * 8 + (lane >> 3), ch = lane & 7;
      *(uint4*)(p.Y + (size_t)(row0 + wr * 64 + rl) * D + 256 + col0 + wc * 64 + ch * 8) = *(const uint4*)&t[rl][ch * 8];
    }
  }
};
DEV void ph_lora(const P& p, int layer, char* smem) {
  int rt, ct;
  for (int it = 0; gemm_unit(it, 10, rt, ct); ++it) {
    if (ct < 8) {
      EpiLoraA epi{p, layer, rt * 128, ct * 128};
      gemm_tile(p.Z + (size_t)rt * 128 * INW + 1536, INW, p.Wlt + (size_t)ct * 128 * 256, 256, 256, smem, epi);
    } else {
      EpiLoraG epi{p, rt * 128, (ct - 8) * 128};
      gemm_tile(p.Z + (size_t)rt * 128 * INW + 1792, INW, p.Wgt + (size_t)(ct - 8) * 128 * 128, 128, 128, smem, epi);
    }
  }
}

DEV void ph_rwkv_prep(const P& p, int layer) {
  const int lane = tid_() & 63;
  int r0, r1;
  wave_range(r0, r1, NTOK);
  const float* cw = p.conv_w + (size_t)layer * 3 * 1536;
  const float* cb = p.conv_b + (size_t)layer * 1536;
  float w0[3][4], w1[3][4], w2[3][4], bb[3][4], kkw[4];
#pragma unroll
  for (int a = 0; a < 3; ++a)
#pragma unroll
    for (int i = 0; i < 4; ++i) {
      const int col = 768 + a * 256 + 4 * lane + i;
      w0[a][i] = cw[col]; w1[a][i] = cw[1536 + col]; w2[a][i] = cw[3072 + col]; bb[a][i] = cb[col];
    }
#pragma unroll
  for (int i = 0; i < 4; ++i) kkw[i] = p.rw_k_k[layer * 256 + 4 * lane + i];
  uint2 zm[3], zc[3], zp[3];
  auto ldz = [&](int row, uint2 (&z)[3]) {
#pragma unroll
    for (int a = 0; a < 3; ++a) z[a] = *(const uint2*)(p.Z + (size_t)row * INW + 768 + a * 256 + 4 * lane);
  };
  auto zero3 = [&](uint2 (&z)[3]) {
#pragma unroll
    for (int a = 0; a < 3; ++a) z[a] = make_uint2(0u, 0u);
  };
  if (r0 < r1) {
    if (r0 > 0) ldz(r0 - 1, zm); else zero3(zm);
    ldz(r0, zc);
  }
#pragma unroll 1
  for (int row = r0; row < r1; ++row) {
    if (row + 1 < NTOK) ldz(row + 1, zp); else zero3(zp);
    const int pp = row % LT;
    const bool hasm = (pp != 0) && (pp != LC);
    const bool hasp = (pp != LC - 1) && (pp != LT - 1);
    float res[3][4];
#pragma unroll
    for (int a = 0; a < 3; ++a) {
      const uint2 um = hasm ? zm[a] : make_uint2(0u, 0u), uc = zc[a], up = hasp ? zp[a] : make_uint2(0u, 0u);
      const float vm[4] = {bflo(um.x), bfhi(um.x), bflo(um.y), bfhi(um.y)};
      const float vc[4] = {bflo(uc.x), bfhi(uc.x), bflo(uc.y), bfhi(uc.y)};
      const float vp[4] = {bflo(up.x), bfhi(up.x), bflo(up.y), bfhi(up.y)};
#pragma unroll
      for (int i = 0; i < 4; ++i) res[a][i] = w0[a][i] * vm[i] + w1[a][i] * vc[i] + w2[a][i] * vp[i] + bb[a][i];
    }
    float kk[4], ss = 0.f;
#pragma unroll
    for (int i = 0; i < 4; ++i) { kk[i] = res[1][i] * kkw[i]; ss += kk[i] * kk[i]; }
    ss = row16_sum(ss);
    const float rs = rsqrtf(ss + 1e-12f);
    bf16_t* hr = p.H + (size_t)row * D + 16 * lane;
    *(uint4*)hr = make_uint4(pack2(res[0][0], res[1][0]), pack2(kk[0] * rs, res[2][0]), pack2(res[0][1], res[1][1]), pack2(kk[1] * rs, res[2][1]));
    *(uint4*)(hr + 8) = make_uint4(pack2(res[0][2], res[1][2]), pack2(kk[2] * rs, res[2][2]), pack2(res[0][3], res[1][3]), pack2(kk[3] * rs, res[2][3]));
#pragma unroll
    for (int a = 0; a < 3; ++a) { zm[a] = zc[a]; zc[a] = zp[a]; }
  }
}

DEV float oct_sum(float x) { x += dpp0<0xB1, 0xF>(x); x += dpp0<0x4E, 0xF>(x); x += dpp0<0x141, 0xF>(x); return x; }
DEV bf16x8 frag_join(uint2 lo, uint2 hi) { uint4 w = make_uint4(lo.x, lo.y, hi.x, hi.y); return __builtin_bit_cast(bf16x8, w); }
constexpr int SCS_SET = 17152, SCS_IMG = 3 * SCS_SET, SCS_W0 = SCS_IMG + 2 * 3072;
DEV void scanc_unit(const P& p, int layer, int unit, char* smem) {
  const int dir = unit & 1, h = (unit >> 1) & 3, b = unit >> 3;
  const int tid = tid_(), lane = tid & 63, fr = lane & 15, fq = lane >> 4;
  const int w = __builtin_amdgcn_readfirstlane(tid >> 6);
  bf16_t* IMG0 = (bf16_t*)(smem + SCS_W0);
  bf16_t* IMG1 = IMG0 + 512;
  bf16_t* IMG2 = IMG0 + 1024;
  __syncthreads();
  for (int i = tid; i < (2 * 3072 + 3072) / 4; i += 256) ((unsigned*)(smem + SCS_IMG))[i] = 0u;
  const float ka = p.rw_k_a[layer * 256 + h * 64 + lane];
  const size_t rowbase = (size_t)b * LT;
  const char* hbase = (const char*)p.H;
  const char* sbase = (const char*)p.SC;
  const unsigned hoff = (unsigned)(rowbase * 2048) + (unsigned)((h * 64 + lane) * 8);
  const unsigned soff = hoff + 4u * (unsigned)dir;
  bf16_t* yb = p.Z + rowbase * INW + 768 + dir * 256 + h * 64 + w * 16 + fr;
  auto pos0 = [&](int c) -> int { const int t = c * 16; return dir == 0 ? t : (t < LC ? LC - 1 - t : LT - 1 - (t - LC)); };
  const int pstep = dir == 0 ? 1 : -1;
  constexpr int NCH = LT / 16;
  struct Raw { unsigned sc[16]; uint2 hr[6]; };
  auto load_raw = [&](int c, Raw& rw) {
    if (w != 0) {
      const int p0 = pos0(c);
      const unsigned so = soff + (unsigned)(p0 * 2048);
      const int st = pstep * 2048;
#pragma unroll
      for (int i = 0; i < 16; ++i) rw.sc[i] = *(const unsigned*)(sbase + (so + (unsigned)(i * st)));
      const unsigned ho = hoff + (unsigned)((p0 + pstep * (w - 1)) * 2048);
#pragma unroll
      for (int q = 0; q < 6; ++q) {
        const int qq = ((w - 1) + 3 * q < 16) ? q : 4;
        rw.hr[q] = *(const uint2*)(hbase + (ho + (unsigned)(qq * 3 * st)));
      }
    }
  };
  auto stage1w = [&](int set, const Raw& rw, auto W1tag) {
    constexpr int W1 = decltype(W1tag)::value;
    char* base = smem + set * SCS_SET;
    bf16_t (*At)[72] = (bf16_t (*)[72])(base);
    bf16_t (*Rt)[72] = (bf16_t (*)[72])(base + 2304);
    bf16_t (*Bt)[72] = (bf16_t (*)[72])(base + 4608);
    bf16_t (*Kt)[72] = (bf16_t (*)[72])(base + 6912);
    bf16_t (*BKT)[36] = (bf16_t (*)[36])(base + 9216);
    bf16_t* VV = (bf16_t*)(base + 13824);
    float* G16 = (float*)(base + 16896);
    float Erun = 0.f;
#pragma unroll
    for (int i = 0; i < 16; ++i) {
      const float ev = bflo(rw.sc[i]);
      const float Eprev = Erun;
      Erun += ev;
      if ((i % 3) == W1) {
        const uint2 hrec = rw.hr[i / 3];
        const float rr = bflo(hrec.x), kr = bfhi(hrec.x), kkv = bflo(hrec.y);
        const float av = bfhi(rw.sc[i]);
        const float gp = __expf(-Eprev), gi = __expf(-Erun), ig = __expf(Erun);
        const float at = -kkv * gp, rt = rr * gi, bt = kkv * av * ig, kt2 = kr * (1.f + (av - 1.f) * ka) * ig;
        const unsigned ar = pack2(at, rt), bk = pack2(bt, kt2);
        At[i][lane] = (bf16_t)(ar & 0xFFFFu); Rt[i][lane] = (bf16_t)(ar >> 16);
        Bt[i][lane] = (bf16_t)(bk & 0xFFFFu); Kt[i][lane] = (bf16_t)(bk >> 16);
        BKT[lane][(i >> 2) * 8 + (i & 3)] = (bf16_t)(bk & 0xFFFFu);
        BKT[lane][(i >> 2) * 8 + 4 + (i & 3)] = (bf16_t)(bk >> 16);
        VV[((i >> 2) * 64 + lane) * 6 + (i & 3)] = (bf16_t)(hrec.y >> 16);
        if (i == 15) G16[lane] = gi;
      }
    }
  };
  auto stage1 = [&](int set, const Raw& rw) {
    if (w == 1) stage1w(set, rw, std::integral_constant<int, 0>{});
    else if (w == 2) stage1w(set, rw, std::integral_constant<int, 1>{});
    else if (w == 3) stage1w(set, rw, std::integral_constant<int, 2>{});
  };
  auto stage2 = [&](int set, int iset) {
    char* base = smem + set * SCS_SET;
    const bf16_t (*At)[72] = (const bf16_t (*)[72])(base);
    const bf16_t (*Rt)[72] = (const bf16_t (*)[72])(base + 2304);
    const bf16_t (*Bt)[72] = (const bf16_t (*)[72])(base + 4608);
    const bf16_t (*Kt)[72] = (const bf16_t (*)[72])(base + 6912);
    bf16_t* TT = (bf16_t*)(smem + SCS_IMG + iset * 3072);
    bf16_t* ARK = TT + 512;
    bf16_t* AAK = TT + 1024;
    const bf16_t (*X)[72] = (w < 2) ? At : Rt;
    const bf16_t (*Y)[72] = (w & 1) ? Kt : Bt;
    f32x4 cm = (f32x4){0.f, 0.f, 0.f, 0.f};
#pragma unroll
    for (int s = 0; s < 2; ++s) {
      bf16x8 af = *(const bf16x8*)&X[fr][32 * s + 8 * fq];
      bf16x8 bm = *(const bf16x8*)&Y[fr][32 * s + 8 * fq];
      cm = mfma16(af, bm, cm);
    }
#pragma unroll
    for (int jj = 0; jj < 4; ++jj) {
      const int i = 4 * fq + jj;
      const bool keep = (w < 2) ? (fr < i) : (fr <= i);
      cm[jj] = keep ? cm[jj] : 0.f;
    }
    const int io = (fr >> 2) * 8 + (fr & 3);
    auto wr_img = [&](bf16_t* img, const f32x4& Xv, int hi) {
#pragma unroll
      for (int jj = 0; jj < 4; ++jj) img[(4 * fq + jj) * 32 + io + hi] = f2bf(Xv[jj]);
    };
    if (w == 1) wr_img(AAK, cm, 0);
    else if (w == 2) wr_img(ARK, cm, 0);
    else if (w == 3) wr_img(ARK, cm, 4);
    else {
      auto bfrag = [&](const f32x4& Xv) { return frag_join(make_uint2(pack2(Xv[0], Xv[1]), pack2(Xv[2], Xv[3])), make_uint2(0u, 0u)); };
      auto afr = [&](const bf16_t* img) { return *(const bf16x8*)&img[(fr * 4 + fq) * 8]; };
      const f32x4 Z4 = (f32x4){0.f, 0.f, 0.f, 0.f};
      wr_img(IMG0, cm, 0);
      asm volatile("" ::: "memory");
      f32x4 A2 = mfma16(afr(IMG0), bfrag(cm), Z4);
      wr_img(IMG1, A2, 0);
      asm volatile("" ::: "memory");
      f32x4 A4 = mfma16(afr(IMG1), bfrag(A2), Z4);
      wr_img(IMG2, A4, 0);
      asm volatile("" ::: "memory");
      f32x4 Rm = mfma16(afr(IMG2), bfrag(A4), Z4);
#pragma unroll
      for (int jj = 0; jj < 4; ++jj) Rm[jj] += (fr == 4 * fq + jj) ? 1.f : 0.f;
      Rm = mfma16(afr(IMG2), bfrag(Rm), Rm);
      Rm = mfma16(afr(IMG1), bfrag(Rm), Rm);
      Rm = mfma16(afr(IMG0), bfrag(Rm), Rm);
      wr_img(TT, Rm, 0);
    }
  };
  f32x4 acc[4];
#pragma unroll
  for (int kt = 0; kt < 4; ++kt) acc[kt] = (f32x4){0.f, 0.f, 0.f, 0.f};
  auto part2 = [&](int c, int set, int iset) {
    char* base = smem + set * SCS_SET;
    const bf16_t (*At)[72] = (const bf16_t (*)[72])(base);
    const bf16_t (*Rt)[72] = (const bf16_t (*)[72])(base + 2304);
    const bf16_t (*BKT)[36] = (const bf16_t (*)[36])(base + 9216);
    const bf16_t* VV = (const bf16_t*)(base + 13824);
    const float* G16 = (const float*)(base + 16896);
    const bf16_t* TT = (const bf16_t*)(smem + SCS_IMG + iset * 3072);
    const bf16_t* ARK = TT + 512;
    const bf16_t* AAK = TT + 1024;
    bf16x8 Sb[2];
#pragma unroll
    for (int s = 0; s < 2; ++s) {
      uint4 t = make_uint4(pack2(acc[2 * s][0], acc[2 * s][1]), pack2(acc[2 * s][2], acc[2 * s][3]),
                           pack2(acc[2 * s + 1][0], acc[2 * s + 1][1]), pack2(acc[2 * s + 1][2], acc[2 * s + 1][3]));
      Sb[s] = __builtin_bit_cast(bf16x8, t);
    }
    const unsigned* vvp = (const unsigned*)&VV[(fq * 64 + w * 16 + fr) * 6];
    const uint2 vv = make_uint2(vvp[0], vvp[1]);
    const bf16x8 Vlow = frag_join(vv, make_uint2(0u, 0u));
    f32x4 Pm = (f32x4){0.f, 0.f, 0.f, 0.f};
#pragma unroll
    for (int s = 0; s < 2; ++s) {
      bf16x8 af = frag_join(*(const uint2*)&At[fr][32 * s + 4 * fq], *(const uint2*)&At[fr][32 * s + 16 + 4 * fq]);
      Pm = mfma16(af, Sb[s], Pm);
    }
    Pm = mfma16(*(const bf16x8*)&AAK[(fr * 4 + fq) * 8], Vlow, Pm);
    const bf16x8 Pb = frag_join(make_uint2(pack2(Pm[0], Pm[1]), pack2(Pm[2], Pm[3])), make_uint2(0u, 0u));
    f32x4 U = mfma16(*(const bf16x8*)&TT[(fr * 4 + fq) * 8], Pb, (f32x4){0.f, 0.f, 0.f, 0.f});
    const bf16x8 UV = frag_join(make_uint2(pack2(U[0], U[1]), pack2(U[2], U[3])), vv);
    f32x4 Yv = (f32x4){0.f, 0.f, 0.f, 0.f};
#pragma unroll
    for (int s = 0; s < 2; ++s) {
      bf16x8 af = frag_join(*(const uint2*)&Rt[fr][32 * s + 4 * fq], *(const uint2*)&Rt[fr][32 * s + 16 + 4 * fq]);
      Yv = mfma16(af, Sb[s], Yv);
    }
    Yv = mfma16(*(const bf16x8*)&ARK[(fr * 4 + fq) * 8], UV, Yv);
    {
      const int p0 = pos0(c);
#pragma unroll
      for (int jj = 0; jj < 4; ++jj) yb[(size_t)(p0 + pstep * (4 * fq + jj)) * INW] = f2bf(Yv[jj]);
    }
#pragma unroll
    for (int kt = 0; kt < 4; ++kt) {
      f32x4 t = mfma16(frag_join(*(const uint2*)&BKT[16 * kt + fr][fq * 8], *(const uint2*)&BKT[16 * kt + fr][fq * 8 + 4]), UV, acc[kt]);
      const float4 g4 = *(const float4*)&G16[16 * kt + 4 * fq];
      t[0] *= g4.x; t[1] *= g4.y; t[2] *= g4.z; t[3] *= g4.w;
      acc[kt] = t;
    }
  };
  __builtin_amdgcn_s_setprio(3);
  Raw r0, r1;
  load_raw(0, r0); load_raw(1, r1);
  stage1(0, r0);
  load_raw(2, r0);
  __syncthreads();
  stage2(0, 0);
  stage1(1, r1);
  load_raw(3, r1);
  __syncthreads();
  int s0 = 0, s1 = 1, s2 = 2;
  auto iter = [&](int c, Raw& rw) {
    if (c + 1 < NCH) stage2(s1, (c + 1) & 1);
    part2(c, s0, c & 1);
    if (c + 2 < NCH) {
      stage1(s2, rw);
      if (c + 4 < NCH) load_raw(c + 4, rw);
    }
    asm volatile("s_waitcnt lgkmcnt(0)" ::: "memory");
    __builtin_amdgcn_s_barrier();
    asm volatile("" ::: "memory");
    const int t = s0; s0 = s1; s1 = s2; s2 = t;
  };
#pragma unroll 1
  for (int c = 0; c < NCH; c += 2) {
    iter(c, r0); iter(c + 1, r1);
  }
  __builtin_amdgcn_s_setprio(0);
}

DEV void ph_rwkv_post(const P& p, int layer) {
  const int lane = tid_() & 63;
  int r0, r1;
  wave_range(r0, r1, NTOK);
  const int ch = 4 * lane;
  float kav[4], rkv[4], lnw[4], lnb[4];
#pragma unroll
  for (int i = 0; i < 4; ++i) {
    kav[i] = p.rw_k_a[layer * 256 + ch + i]; rkv[i] = p.rw_r_k[layer * 256 + ch + i];
    lnw[i] = p.rw_ln_w[layer * 256 + ch + i]; lnb[i] = p.rw_ln_b[layer * 256 + ch + i];
  }
  struct In { uint2 y0, y1, g; uint4 h0, h1, s0, s1; };
  auto ld = [&](int row, In& in) {
    const bf16_t* zr = p.Z + (size_t)row * INW + 768 + ch;
    in.y0 = *(const uint2*)zr; in.y1 = *(const uint2*)(zr + 256);
    const bf16_t* hr = p.H + (size_t)row * D + 4 * ch;
    in.h0 = *(const uint4*)hr; in.h1 = *(const uint4*)(hr + 8);
    const bf16_t* sr = p.SC + (size_t)row * 1024 + 4 * ch;
    in.s0 = *(const uint4*)sr; in.s1 = *(const uint4*)(sr + 8);
    in.g = *(const uint2*)(p.Y + (size_t)row * D + 256 + ch);
  };
  In nx;
  if (r0 < r1) ld(r0, nx);
#pragma unroll 1
  for (int row = r0; row < r1; ++row) {
    const In in = nx;
    if (row + 1 < r1) ld(row + 1, nx);
    float y[4] = {bflo(in.y0.x) + bflo(in.y1.x), bfhi(in.y0.x) + bfhi(in.y1.x), bflo(in.y0.y) + bflo(in.y1.y), bfhi(in.y0.y) + bfhi(in.y1.y)};
    const float mu = row16_sum(y[0] + y[1] + y[2] + y[3]) * (1.f / 64.f);
    float vs = 0.f;
#pragma unroll
    for (int i = 0; i < 4; ++i) { y[i] -= mu; vs += y[i] * y[i]; }
    const float var = row16_sum(vs) * (1.f / 64.f);
    const float rstd = rsqrtf(var + 64e-5f);
    const float r[4] = {bflo(in.h0.x), bflo(in.h0.z), bflo(in.h1.x), bflo(in.h1.z)};
    const float k[4] = {bfhi(in.h0.x), bfhi(in.h0.z), bfhi(in.h1.x), bfhi(in.h1.z)};
    const float v[4] = {bfhi(in.h0.y), bfhi(in.h0.w), bfhi(in.h1.y), bfhi(in.h1.w)};
    const float a0[4] = {bfhi(in.s0.x), bfhi(in.s0.z), bfhi(in.s1.x), bfhi(in.s1.z)};
    const float a1[4] = {bfhi(in.s0.y), bfhi(in.s0.w), bfhi(in.s1.y), bfhi(in.s1.w)};
    float sd = 0.f;
#pragma unroll
    for (int i = 0; i < 4; ++i) {
      const float kd0 = k[i] * (1.f + (a0[i] - 1.f) * kav[i]), kd1 = k[i] * (1.f + (a1[i] - 1.f) * kav[i]);
      sd += r[i] * (kd0 + kd1) * rkv[i];
    }
    sd = row16_sum(sd);
    const float g[4] = {bflo(in.g.x), bfhi(in.g.x), bflo(in.g.y), bfhi(in.g.y)};
    float o[4];
#pragma unroll
    for (int i = 0; i < 4; ++i) {
      const float yn = y[i] * rstd * lnw[i] + lnb[i];
      o[i] = (yn + sd * v[i]) * g[i];
    }
    *(uint2*)(p.Y + (size_t)row * D + 256 + ch) = make_uint2(pack2(o[0], o[1]), pack2(o[2], o[3]));
  }
}

DEV void hyena_pre_unit(const P& p, int layer, int unit) {
  int kind, b, t0, L;
  if (unit < 1024) { kind = 0; b = unit >> 6; t0 = (unit & 63) * 64; L = T; } else { int u = unit - 1024; kind = 1; b = u >> 2; t0 = (u & 3) * 64; L = LC; }
  const int c = tid_();
  const size_t row0 = (size_t)b * LT + (kind ? 0 : LC);
  const float* cw = p.conv_w + (size_t)layer * 3 * 1536;
  const float* cb = p.conv_b + (size_t)layer * 1536;
  const float w1a = cw[256 + c], w1b = cw[1536 + 256 + c], w1c = cw[3072 + 256 + c], b1 = cb[256 + c];
  const float w2a = cw[512 + c], w2b = cw[1536 + 512 + c], w2c = cw[3072 + 512 + c], b2 = cb[512 + c];
  auto ld = [&](int t, int col) -> float { return (t >= 0 && t < L) ? bf2f(p.Z[(row0 + t) * INW + col]) : 0.f; };
  float x1m = ld(t0 - 1, 256 + c), x1c = ld(t0, 256 + c), vm = ld(t0 - 1, 512 + c), vc = ld(t0, 512 + c);
  bf16_t* dst = (kind ? opq(p.UTc) : opq(p.UTl)) + ((size_t)c * 16 + b) * L + t0;
#pragma unroll 1
  for (int i8 = 0; i8 < 8; ++i8) {
    float uo[8];
#pragma unroll
    for (int i = 0; i < 8; ++i) {
      int t = t0 + i8 * 8 + i;
      float x1n = ld(t + 1, 256 + c), vn = ld(t + 1, 512 + c);
      float a = w1a * x1m + w1b * x1c + w1c * x1n + b1;
      float bb = w2a * vm + w2b * vc + w2c * vn + b2;
      uo[i] = a * bb;
      x1m = x1c; x1c = x1n; vm = vc; vc = vn;
    }
    *(uint4*)(dst + 8 * i8) = pack8(uo);
  }
}

DEV void hyena_conv_unit(const P& p, int layer, int unit, char* smem) {
  int kind, c, tb, L;
  if (unit < 4096) { kind = 0; c = unit >> 4; tb = (unit & 15) * 256; L = T; } else { kind = 1; c = unit - 4096; tb = 0; L = LC; }
  const int tid = tid_(), lane = tid & 63, wid = tid >> 6, fr = lane & 15, fq = lane >> 4;
  float* red = (float*)(smem + 2 * 16512);
  const float* F = (kind ? opq(p.FC) : opq(p.FL)) + (size_t)c * 2 * L;
  float scale;
  {
    float part = 0.f;
    for (int i = tid; i < 2 * L; i += 256) { float fv = F[i]; part += (i != L) ? fv * fv : 0.f; }
    part = wave_sum(part);
    __syncthreads();
    if (lane == 0) red[wid] = part;
    __syncthreads();
    scale = rsqrtf(((red[0] + red[1]) + (red[2] + red[3])) + 1e-6f);
  }
  const bf16_t* U = (kind ? opq(p.UTc) : opq(p.UTl)) + (size_t)c * 16 * L;
  f32x4 acc[4];
#pragma unroll
  for (int m = 0; m < 4; ++m) acc[m] = (f32x4){0.f, 0.f, 0.f, 0.f};
  const int nch = L / 256;
  float fw0, fw1, fw2;
  uint4 ru0, ru1;
  auto ldchunk = [&](int ch) {
    const int sc = ch * 256;
    const int D0 = tb + 256 - sc;
    auto tap = [&](int n) -> float {
      int d = D0 - n;
      float v = 0.f;
      if (d > -L && d < L) v = (d >= 0 ? F[d] : F[L - d]);
      return v;
    };
    fw0 = tap(tid); fw1 = tap(tid + 256); fw2 = (tid < 8) ? tap(tid + 512) : 0.f;
    const int bb = tid >> 4, sg0 = tid & 15;
    ru0 = *(const uint4*)(U + (size_t)bb * L + sc + 8 * sg0);
    ru1 = *(const uint4*)(U + (size_t)bb * L + sc + 8 * (sg0 + 16));
  };
  auto stchunk = [&](int buf) {
    bf16_t* Cq = (bf16_t*)(smem + buf * 16512);
    bf16_t* Us = (bf16_t*)(smem + buf * 16512 + 8320);
    const bf16_t h0 = f2bf(fw0 * scale), h1 = f2bf(fw1 * scale), h2 = f2bf(fw2 * scale);
#pragma unroll
    for (int rho = 0; rho < 8; ++rho) {
      int m = tid + rho;
      Cq[((m >> 3) * 8 + rho) * 8 + (m & 7)] = h0;
      m = tid + 256 + rho;
      if (m < 520) Cq[((m >> 3) * 8 + rho) * 8 + (m & 7)] = h1;
      m = tid + 512 + rho;
      if (tid < 8 && m < 520) Cq[((m >> 3) * 8 + rho) * 8 + (m & 7)] = h2;
    }
    if (tid < 8) {
#pragma unroll
      for (int rho = 1; rho < 8; ++rho) if (tid < rho) Cq[(rho) * 8 + tid] = 0;
    }
    const int bb = tid >> 4, sg0 = tid & 15;
    *(uint4*)&Us[(sg0 * 16 + bb) * 8] = ru0;
    *(uint4*)&Us[((sg0 + 16) * 16 + bb) * 8] = ru1;
  };
  ldchunk(0);
#pragma unroll 1
  for (int ch = 0; ch < nch; ++ch) {
    const int buf = ch & 1;
    stchunk(buf);
    __syncthreads();
    if (ch + 1 < nch) ldchunk(ch + 1);
    const bf16_t* Cq = (const bf16_t*)(smem + buf * 16512);
    const bf16_t* Us = (const bf16_t*)(smem + buf * 16512 + 8320);
#pragma unroll
    for (int kk = 0; kk < 8; ++kk) {
      bf16x8 bf = *(const bf16x8*)&Us[((4 * kk + fq) * 16 + fr) * 8];
#pragma unroll
      for (int m = 0; m < 4; ++m) {
        int it = wid * 4 + m;
        int base = 256 - 16 * it + 32 * kk + 8 * fq;
        int m0 = base - 8 * (fr >> 3);
        bf16x8 af = *(const bf16x8*)&Cq[((m0 >> 3) * 8 + (fr & 7)) * 8];
        acc[m] = mfma16(af, bf, acc[m]);
      }
    }
  }
  __syncthreads();
  bf16_t* Yt = (kind ? opq(p.YTc) : opq(p.YTl)) + ((size_t)c * 16 + fr) * L + tb;
#pragma unroll
  for (int m = 0; m < 4; ++m) {
    int t = (wid * 4 + m) * 16 + fq * 4;
    *(uint2*)(Yt + t) = make_uint2(pack2(acc[m][0], acc[m][1]), pack2(acc[m][2], acc[m][3]));
  }
}

DEV void hyena_post_unit(const P& p, int layer, int unit, char* smem) {
  int kind, b, t0, L;
  if (unit < 1024) { kind = 0; b = unit >> 6; t0 = (unit & 63) * 64; L = T; } else { int u = unit - 1024; kind = 1; b = u >> 2; t0 = (u & 3) * 64; L = LC; }
  const int c = tid_(), lane = c & 63, wid = c >> 6;
  const size_t row0 = (size_t)b * LT + (kind ? 0 : LC);
  bf16_t (*tile)[264] = (bf16_t (*)[264])smem;
  const float* cw = p.conv_w + (size_t)layer * 3 * 1536;
  const float wa = cw[c], wb = cw[1536 + c], wcc = cw[3072 + c], b0 = p.conv_b[layer * 1536 + c];
  const float bias = p.hy_bias[layer * 256 + c];
  const bf16_t* yt = (kind ? opq(p.YTc) : opq(p.YTl)) + ((size_t)c * 16 + b) * L + t0;
  const bf16_t* ut = (kind ? opq(p.UTc) : opq(p.UTl)) + ((size_t)c * 16 + b) * L + t0;
  auto ld = [&](int t) -> float { return (t >= 0 && t < L) ? bf2f(p.Z[(row0 + t) * INW + c]) : 0.f; };
  float xm = ld(t0 - 1), xc = ld(t0);
  __syncthreads();
#pragma unroll 1
  for (int i8 = 0; i8 < 8; ++i8) {
    uint4 yu = *(const uint4*)(yt + 8 * i8), uu = *(const uint4*)(ut + 8 * i8);
    float yv[8], uv[8];
    unpack8(yu, yv); unpack8(uu, uv);
#pragma unroll
    for (int i = 0; i < 8; ++i) {
      int t = t0 + i8 * 8 + i;
      float xn = ld(t + 1);
      float x0 = wa * xm + wb * xc + wcc * xn + b0;
      float o = x0 * (yv[i] + uv[i] * bias);
      tile[i8 * 8 + i][c] = f2bf(o);
      xm = xc; xc = xn;
    }
  }
  __syncthreads();
  for (int i = 0; i < 16; ++i) {
    int tl = wid * 16 + i;
    uint2 ou = *(const uint2*)&tile[tl][4 * lane];
    float o[4] = {bflo(ou.x), bfhi(ou.x), bflo(ou.y), bfhi(ou.y)};
    float ss = wave_sum(o[0] * o[0] + o[1] * o[1] + o[2] * o[2] + o[3] * o[3]);
    float rstd = rsqrtf(ss * (1.f / 256.f) + 1e-6f);
#pragma unroll
    for (int q = 0; q < 4; ++q) {
      o[q] = o[q] * rstd * p.hy_out_g[layer * 256 + 4 * lane + q];
    }
    *(uint2*)(p.Y + (row0 + t0 + tl) * D + 4 * lane) = make_uint2(pack2(o[0], o[1]), pack2(o[2], o[3]));
  }
}

DEV void attn_unit(const P& p, int layer, int unit, char* smem) {
  const bool isctx = unit >= 4096;
  int b, qb, hq;
  if (!isctx) { b = unit >> 8; qb = (unit >> 3) & 31; hq = unit & 7; } else { int u = unit - 4096; b = u >> 4; qb = (u >> 3) & 1; hq = u & 7; }
  const int g = hq >> 2;
  const int tid = tid_(), lane = tid & 63, wid = tid >> 6, qn = lane & 31, hh = lane >> 5;
  const int qpos = qb * 128 + wid * 32 + qn;
  const size_t qrow = (size_t)b * LT + (isctx ? qpos : LC + qpos);
  const bf16_t* qptr = p.Z + qrow * INW + 1920 + hq * 64;
  bf16x8 qf[4];
#pragma unroll
  for (int s = 0; s < 4; ++s) qf[s] = *(const bf16x8*)(qptr + 16 * s + 8 * hh);
  const float sink = p.attn_sink[layer * 8 + hq];
  float m_run = sink, l_run = 1.f;
  f32x16 o0, o1;
#pragma unroll
  for (int i = 0; i < 16; ++i) { o0[i] = 0.f; o1[i] = 0.f; }
  typedef bf16_t KTile[64][72];
  KTile* Ks = (KTile*)smem;
  KTile* Vt = (KTile*)(smem + 18432);
  const int ntl = isctx ? 0 : 6;
  const int ntiles = ntl + 4;
  const int skey = tid >> 3, sseg = tid & 7;
  const bf16_t* kvbase = p.Z + (size_t)b * LT * INW + 1920 + 512 + g * 64 + sseg * 8;
  uint4 rk0, rk1, rv0, rv1;
  auto ldtile = [&](int kt) {
    const bool ctxk = kt >= ntl;
    const int kbase = ctxk ? (kt - ntl) * 64 : qb * 128 - 128 + kt * 64;
    const int kp0 = kbase + skey, kp1 = kp0 + 32;
    rk0 = rk1 = rv0 = rv1 = make_uint4(0, 0, 0, 0);
    if (ctxk || (kp0 >= 0 && kp0 < T)) { const bf16_t* src = kvbase + (size_t)(ctxk ? kp0 : LC + kp0) * INW; rk0 = *(const uint4*)src; rv0 = *(const uint4*)(src + 128); }
    if (ctxk || (kp1 >= 0 && kp1 < T)) { const bf16_t* src = kvbase + (size_t)(ctxk ? kp1 : LC + kp1) * INW; rk1 = *(const uint4*)src; rv1 = *(const uint4*)(src + 128); }
  };
  auto sttile = [&](int buf) {
    *(uint4*)&Ks[buf][skey][sseg * 8] = rk0;
    *(uint4*)&Ks[buf][skey + 32][sseg * 8] = rk1;
    bf16_t (*vt)[72] = Vt[buf];
    vt[sseg * 8 + 0][skey] = (bf16_t)(rv0.x & 0xFFFF); vt[sseg * 8 + 1][skey] = (bf16_t)(rv0.x >> 16);
    vt[sseg * 8 + 2][skey] = (bf16_t)(rv0.y & 0xFFFF); vt[sseg * 8 + 3][skey] = (bf16_t)(rv0.y >> 16);
    vt[sseg * 8 + 4][skey] = (bf16_t)(rv0.z & 0xFFFF); vt[sseg * 8 + 5][skey] = (bf16_t)(rv0.z >> 16);
    vt[sseg * 8 + 6][skey] = (bf16_t)(rv0.w & 0xFFFF); vt[sseg * 8 + 7][skey] = (bf16_t)(rv0.w >> 16);
    vt[sseg * 8 + 0][skey + 32] = (bf16_t)(rv1.x & 0xFFFF); vt[sseg * 8 + 1][skey + 32] = (bf16_t)(rv1.x >> 16);
    vt[sseg * 8 + 2][skey + 32] = (bf16_t)(rv1.y & 0xFFFF); vt[sseg * 8 + 3][skey + 32] = (bf16_t)(rv1.y >> 16);
    vt[sseg * 8 + 4][skey + 32] = (bf16_t)(rv1.z & 0xFFFF); vt[sseg * 8 + 5][skey + 32] = (bf16_t)(rv1.z >> 16);
    vt[sseg * 8 + 6][skey + 32] = (bf16_t)(rv1.w & 0xFFFF); vt[sseg * 8 + 7][skey + 32] = (bf16_t)(rv1.w >> 16);
  };
  ldtile(0);
#pragma unroll 1
  for (int kt = 0; kt < ntiles; ++kt) {
    const int buf = kt & 1;
    sttile(buf);
    __syncthreads();
    if (kt + 1 < ntiles) ldtile(kt + 1);
    const bool ctxk = kt >= ntl;
    const int kbase = ctxk ? (kt - ntl) * 64 : qb * 128 - 128 + kt * 64;
#pragma unroll
    for (int sub = 0; sub < 2; ++sub) {
      const int kb2 = kbase + sub * 32;
      bool need = true;
      if (!ctxk) {
        int q0 = qb * 128 + wid * 32;
        if (kb2 + 31 < q0 - 128 || kb2 > q0 + 31 + 128 || kb2 + 31 < 0 || kb2 >= T) need = false;
      }
      if (need) {
        f32x16 sv;
#pragma unroll
        for (int i = 0; i < 16; ++i) sv[i] = 0.f;
#pragma unroll
        for (int ks = 0; ks < 4; ++ks) {
          bf16x8 kf = *(const bf16x8*)&Ks[buf][sub * 32 + qn][16 * ks + 8 * hh];
          sv = mfma32(kf, qf[ks], sv);
        }
        float mt = -3e38f;
#pragma unroll
        for (int rg = 0; rg < 16; ++rg) {
          float v = sv[rg] * 0.125f;
          if (!ctxk) {
            int kp = kb2 + (rg & 3) + 8 * (rg >> 2) + 4 * hh;
            int dl = qpos - kp;
            bool ok = (dl <= 128) && (dl >= -128) && (kp >= 0) && (kp < T);
            v = ok ? v : -1e30f;
          }
          sv[rg] = v;
          mt = fmaxf(mt, v);
        }
        mt = fmaxf(mt, __shfl_xor(mt, 32));
        float m_new = fmaxf(m_run, mt);
        float corr = __expf(m_run - m_new);
        float ps = 0.f;
#pragma unroll
        for (int rg = 0; rg < 16; ++rg) { float pv = __expf(sv[rg] - m_new); sv[rg] = pv; ps += pv; }
        ps += __shfl_xor(ps, 32);
        l_run = l_run * corr + ps;
        m_run = m_new;
#pragma unroll
        for (int i = 0; i < 16; ++i) { o0[i] *= corr; o1[i] *= corr; }
#pragma unroll
        for (int sp = 0; sp < 2; ++sp) {
          bf16x8 pf;
#pragma unroll
          for (int j = 0; j < 8; ++j) pf[j] = (short)f2bf(sv[8 * sp + j]);
          const int kc = sub * 32 + 16 * sp + 4 * hh;
          uint2 va = *(const uint2*)&Vt[buf][qn][kc], vb = *(const uint2*)&Vt[buf][qn][kc + 8];
          uint2 vc = *(const uint2*)&Vt[buf][32 + qn][kc], vd = *(const uint2*)&Vt[buf][32 + qn][kc + 8];
          uint4 w0 = make_uint4(va.x, va.y, vb.x, vb.y), w1 = make_uint4(vc.x, vc.y, vd.x, vd.y);
          bf16x8 v0 = __builtin_bit_cast(bf16x8, w0), v1 = __builtin_bit_cast(bf16x8, w1);
          o0 = mfma32(v0, pf, o0);
          o1 = mfma32(v1, pf, o1);
        }
      }
    }
  }
  __syncthreads();
  const float inv = 1.f / l_run;
  bf16_t* optr = p.Y + qrow * D + 512 + hq * 64;
#pragma unroll
  for (int rg = 0; rg < 4; ++rg) {
    int d0 = 8 * rg + 4 * hh;
    *(uint2*)(optr + d0) = make_uint2(pack2(o0[4 * rg] * inv, o0[4 * rg + 1] * inv), pack2(o0[4 * rg + 2] * inv, o0[4 * rg + 3] * inv));
    *(uint2*)(optr + 32 + d0) = make_uint2(pack2(o1[4 * rg] * inv, o1[4 * rg + 1] * inv), pack2(o1[4 * rg + 2] * inv, o1[4 * rg + 3] * inv));
  }
}

DEV void ph_attn_post(const P& p, int layer) {
  const int lane = tid_() & 63;
  int r0, r1;
  wave_range(r0, r1, NTOK);
  float gv[8];
#pragma unroll
  for (int i = 0; i < 8; ++i) gv[i] = p.at_out_g[layer * 512 + 8 * lane + i];
  uint4 nx = make_uint4(0, 0, 0, 0);
  if (r0 < r1) nx = *(const uint4*)(p.Y + (size_t)r0 * D + 512 + 8 * lane);
#pragma unroll 1
  for (int row = r0; row < r1; ++row) {
    const uint4 u = nx;
    if (row + 1 < r1) nx = *(const uint4*)(p.Y + (size_t)(row + 1) * D + 512 + 8 * lane);
    float v[8];
    unpack8(u, v);
    float ss = 0.f;
#pragma unroll
    for (int i = 0; i < 8; ++i) ss += v[i] * v[i];
    ss = wave_sum(ss);
    const float rstd = rsqrtf(ss * (1.f / 512.f) + 1e-6f);
#pragma unroll
    for (int i = 0; i < 8; ++i) {
      v[i] = v[i] * rstd * gv[i];
    }
    *(uint4*)(p.Y + (size_t)row * D + 512 + 8 * lane) = pack8(v);
  }
}

struct Epi2 {
  const P& p; int layer, row0, col0;
  DEV void operator()(f32x4 (&acc)[4][4], int wr, int wc, int fr, int fq, char* smem) const {
    const int b = row0 / LT, pp = row0 % LT;
    const int mr = pp < LC ? 16 : b;
    const float* g1 = p.modv + ((size_t)layer * 17 + mr) * 6144 + 2048 + col0 + wc * 64;
#pragma unroll
    for (int n = 0; n < 4; ++n) {
      const float4 gv = *(const float4*)(g1 + n * 16 + 4 * fq);
#pragma unroll
      for (int m = 0; m < 4; ++m) { acc[m][n][0] *= gv.x; acc[m][n][1] *= gv.y; acc[m][n][2] *= gv.z; acc[m][n][3] *= gv.w; }
    }
    const int wid = wr * 2 + wc, lane = fq * 16 + fr;
    stage_tile_bf16(acc, smem, wid, fr, fq);
    const bf16_t (*t)[72] = (const bf16_t (*)[72])(smem + wid * 9216);
#pragma unroll
    for (int i = 0; i < 8; ++i) {
      const int rl = i * 8 + (lane >> 3), ch = lane & 7;
      bf16_t* xp = p.X + (size_t)(row0 + wr * 64 + rl) * D + col0 + wc * 64 + ch * 8;
      float xv[8], dv[8];
      uint4 xu = *(const uint4*)xp, du = *(const uint4*)&t[rl][ch * 8];
      unpack8(xu, xv); unpack8(du, dv);
#pragma unroll
      for (int q = 0; q < 8; ++q) xv[q] += dv[q];
      *(uint4*)xp = pack8(xv);
    }
  }
};
DEV void ph_gemm2(const P& p, int layer, char* smem) {
  int rt, ct;
  for (int it = 0; gemm_unit(it, 8, rt, ct); ++it) {
    Epi2 epi{p, layer, rt * 128, ct * 128};
    gemm_tile(p.Y + (size_t)rt * 128 * D, D, p.W2t + (size_t)ct * 128 * D, D, D, smem, epi);
  }
}

DEV void ph_peerconv(const P& p, int layer) {
  const int gw = (bid_() * 256 + tid_()) >> 6, nw = gridDim.x * 4, lane = tid_() & 63;
  const float* su = opq(p.peer_u) + (size_t)layer * 16384 * 1024;
  const float* sv = opq(p.peer_v) + (size_t)layer * 16384 * 1024;
  unsigned char* pu = opq(p.PU); unsigned char* pv = opq(p.PV);
  float* psu = opq(p.PSU); float* psv = opq(p.PSV);
#pragma unroll 1
  for (int r = gw; r < 32768; r += nw) {
    const bool isv = r >= 16384;
    const int e = r & 16383;
    const float* src = (isv ? sv : su) + (size_t)e * 1024 + 16 * lane;
    float4 f0 = *(const float4*)src, f1 = *(const float4*)(src + 4), f2 = *(const float4*)(src + 8), f3 = *(const float4*)(src + 12);
    float am = fmaxf(fmaxf(fmaxf(fabsf(f0.x), fabsf(f0.y)), fmaxf(fabsf(f0.z), fabsf(f0.w))), fmaxf(fmaxf(fabsf(f1.x), fabsf(f1.y)), fmaxf(fabsf(f1.z), fabsf(f1.w))));
    am = fmaxf(am, fmaxf(fmaxf(fmaxf(fabsf(f2.x), fabsf(f2.y)), fmaxf(fabsf(f2.z), fabsf(f2.w))), fmaxf(fmaxf(fabsf(f3.x), fabsf(f3.y)), fmaxf(fabsf(f3.z), fabsf(f3.w)))));
    am = wave_max(am);
    int w0, w1, w2, w3;
    float inv;
    if (isv) {
      const float sc = am > 0.f ? 224.f / am : 1.f;
      inv = am > 0.f ? am * (1.f / 224.f) : 1.f;
      w0 = __builtin_amdgcn_cvt_pk_fp8_f32(f0.x * sc, f0.y * sc, 0, false); w0 = __builtin_amdgcn_cvt_pk_fp8_f32(f0.z * sc, f0.w * sc, w0, true);
      w1 = __builtin_amdgcn_cvt_pk_fp8_f32(f1.x * sc, f1.y * sc, 0, false); w1 = __builtin_amdgcn_cvt_pk_fp8_f32(f1.z * sc, f1.w * sc, w1, true);
      w2 = __builtin_amdgcn_cvt_pk_fp8_f32(f2.x * sc, f2.y * sc, 0, false); w2 = __builtin_amdgcn_cvt_pk_fp8_f32(f2.z * sc, f2.w * sc, w2, true);
      w3 = __builtin_amdgcn_cvt_pk_fp8_f32(f3.x * sc, f3.y * sc, 0, false); w3 = __builtin_amdgcn_cvt_pk_fp8_f32(f3.z * sc, f3.w * sc, w3, true);
    } else {
      const float sc = am > 0.f ? 127.f / am : 1.f;
      inv = am > 0.f ? am * (1.f / 127.f) : 1.f;
      w0 = pack_i8(f0.x * sc, f0.y * sc, f0.z * sc, f0.w * sc); w1 = pack_i8(f1.x * sc, f1.y * sc, f1.z * sc, f1.w * sc);
      w2 = pack_i8(f2.x * sc, f2.y * sc, f2.z * sc, f2.w * sc); w3 = pack_i8(f3.x * sc, f3.y * sc, f3.z * sc, f3.w * sc);
    }
    *(uint4*)((isv ? pv : pu) + (size_t)(lane >> 3) * PSLICE + (size_t)e * 128 + 16 * (lane & 7)) = make_uint4((unsigned)w0, (unsigned)w1, (unsigned)w2, (unsigned)w3);
    if (lane == 0) (isv ? psv : psu)[e] = inv;
  }
}
DEV void unpack16_fp8x2(const uint4& u, f32x2* f) {
  f[0] = __builtin_amdgcn_cvt_pk_f32_fp8((int)u.x, false); f[1] = __builtin_amdgcn_cvt_pk_f32_fp8((int)u.x, true);
  f[2] = __builtin_amdgcn_cvt_pk_f32_fp8((int)u.y, false); f[3] = __builtin_amdgcn_cvt_pk_f32_fp8((int)u.y, true);
  f[4] = __builtin_amdgcn_cvt_pk_f32_fp8((int)u.z, false); f[5] = __builtin_amdgcn_cvt_pk_f32_fp8((int)u.z, true);
  f[6] = __builtin_amdgcn_cvt_pk_f32_fp8((int)u.w, false); f[7] = __builtin_amdgcn_cvt_pk_f32_fp8((int)u.w, true);
}

DEV void bitonic_sort16_desc(float (&v)[16]) {
#pragma unroll
  for (int k = 2; k <= 16; k <<= 1)
#pragma unroll
    for (int j = k >> 1; j >= 1; j >>= 1)
#pragma unroll
      for (int i = 0; i < 16; ++i) {
        const int l = i ^ j;
        if (l > i) {
          const float hi = fmaxf(v[i], v[l]), lo = fminf(v[i], v[l]);
          if ((i & k) == 0) { v[i] = hi; v[l] = lo; } else { v[i] = lo; v[l] = hi; }
        }
      }
}
DEV void peer_cand_ij(int c, int& ci, int& cj) {
  if (c < 16) { ci = 0; cj = c; } else if (c < 24) { ci = 1; cj = c - 16; } else if (c < 29) { ci = 2; cj = c - 24; }
  else if (c < 33) { ci = 3; cj = c - 29; } else if (c < 36) { ci = 4; cj = c - 33; } else if (c < 38) { ci = 5; cj = c - 36; }
  else if (c < 40) { ci = 6; cj = c - 38; } else if (c < 42) { ci = 7; cj = c - 40; } else { ci = (c - 42 + 8) & 15; cj = 0; }
}
template <int S>
struct Epi3K {
  const P& p; int row0, head; float (&keep)[2][16];
  DEV void operator()(f32x4 (&acc)[4][4], int wr, int wc, int fr, int fq, char* smem) const {
    float* sc = (float*)smem;
    float* L1s = (float*)(smem + 36864);
    float* L2s = (float*)(smem + 45056);
    const int tid = tid_();
#pragma unroll
    for (int pass = 0; pass < 2; ++pass) {
      __syncthreads();
      if (wr == pass) {
#pragma unroll
        for (int m = 0; m < 4; ++m)
#pragma unroll
          for (int n = 0; n < 4; ++n)
#pragma unroll
            for (int j = 0; j < 4; ++j) {
              int rl = m * 16 + fr, col = wc * 64 + n * 16 + 4 * fq + j;
              unsigned bits = (__float_as_uint(acc[m][n][j]) & ~127u) | (unsigned)col;
              sc[rl * 133 + (col >> 5) * 33 + (col & 31)] = __uint_as_float(bits);
            }
      }
      __syncthreads();
      const int rl = tid >> 2, q = tid & 3;
      const float* src = sc + rl * 133 + q * 33;
      float Ls[16], Hs[16];
#pragma unroll
      for (int i = 0; i < 16; ++i) { Ls[i] = src[i]; Hs[i] = src[16 + i]; }
      bitonic_sort16_desc(Ls);
      bitonic_sort16_desc(Hs);
#pragma unroll
      for (int i = 0; i < 16; ++i) Ls[i] = fmaxf(Ls[i], Hs[15 - i]);
#pragma unroll
      for (int d = 8; d >= 1; d >>= 1)
#pragma unroll
        for (int i = 0; i < 16; ++i)
          if ((i & d) == 0) { float hi = fmaxf(Ls[i], Ls[i + d]), lo = fminf(Ls[i], Ls[i + d]); Ls[i] = hi; Ls[i + d] = lo; }
      float Cs[16];
#pragma unroll
      for (int i = 0; i < 16; ++i) Cs[i] = fmaxf(Ls[i], dppself<0xB1, 0xF>(Ls[15 - i]));
#pragma unroll
      for (int d = 8; d >= 1; d >>= 1)
#pragma unroll
        for (int i = 0; i < 16; ++i)
          if ((i & d) == 0) { float hi = fmaxf(Cs[i], Cs[i + d]), lo = fminf(Cs[i], Cs[i + d]); Cs[i] = hi; Cs[i + d] = lo; }
      float Ds[16];
#pragma unroll
      for (int i = 0; i < 16; ++i) Ds[i] = fmaxf(Cs[i], dppself<0x4E, 0xF>(Cs[15 - i]));
#pragma unroll
      for (int d = 8; d >= 1; d >>= 1)
#pragma unroll
        for (int i = 0; i < 16; ++i)
          if ((i & d) == 0) { float hi = fmaxf(Ds[i], Ds[i + d]), lo = fminf(Ds[i], Ds[i + d]); Ds[i] = hi; Ds[i + d] = lo; }
      if (S == 0) {
#pragma unroll
        for (int i = 0; i < 16; ++i) keep[pass][i] = Ds[i];
      } else if (q == 0) {
        float* d1 = L1s + (pass * 64 + rl) * 16;
        float* d2 = L2s + (pass * 64 + rl) * 16;
#pragma unroll
        for (int i = 0; i < 4; ++i) {
          *(float4*)(d1 + 4 * i) = make_float4(keep[pass][4 * i], keep[pass][4 * i + 1], keep[pass][4 * i + 2], keep[pass][4 * i + 3]);
          *(float4*)(d2 + 4 * i) = make_float4(Ds[4 * i], Ds[4 * i + 1], Ds[4 * i + 2], Ds[4 * i + 3]);
        }
      }
    }
    if (S == 1) {
      __syncthreads();
      const int lane = tid & 63, wid = tid >> 6;
      int ci, cj;
      peer_cand_ij(lane, ci, cj);
      const bool cand = lane < 50;
      float n1 = L1s[(wid * 32) * 16 + ci], n2 = L2s[(wid * 32) * 16 + cj];
#pragma unroll 1
      for (int r = 0; r < 32; ++r) {
        const int row = wid * 32 + r;
        const float v1 = n1, v2 = n2;
        if (r + 1 < 32) { n1 = L1s[(row + 1) * 16 + ci]; n2 = L2s[(row + 1) * 16 + cj]; }
        float val = v1 + v2;
        val = __uint_as_float((__float_as_uint(val) & ~63u) | (unsigned)lane);
        val = cand ? val : -3e38f;
        int rank = 0;
#pragma unroll
        for (int q = 0; q < 50; ++q) rank += (readlane_f(val, q) > val) ? 1 : 0;
        const bool sel = cand && rank < 16;
        const float mx = readlane_f(val, 0);
        const float ex = sel ? __expf(val - mx) : 0.f;
        const float sm = wave_sum(ex);
        if (sel) {
          const int e = (int)(__float_as_uint(v1) & 127u) * 128 + (int)(__float_as_uint(v2) & 127u);
          const size_t o = (size_t)(row0 + row) * 128 + head * 16 + rank;
          p.EL[o] = (unsigned short)e;
          p.GT[o] = ex / sm;
        }
      }
    }
  }
};
DEV void ph_gemm3(const P& p, char* smem) {
  int rt, hd;
  for (int it = 0; gemm_unit(it, 8, rt, hd); ++it) {
    float keep[2][16];
    {
      Epi3K<0> epi{p, rt * 128, hd, keep};
      gemm_tile(p.H + (size_t)rt * 128 * D, D, p.Wft + (size_t)(2 * hd) * 128 * D, D, D, smem, epi);
    }
    {
      Epi3K<1> epi{p, rt * 128, hd, keep};
      gemm_tile(p.H + (size_t)rt * 128 * D, D, p.Wft + (size_t)(2 * hd + 1) * 128 * D, D, D, smem, epi);
    }
  }
}

DEV float peer_gate(float scr) {
  float mx = row16_max(scr);
  float ex = __expf(scr - mx);
  float sm = row16_sum(ex);
  return ex / sm;
}
DEV float gelu_exact(float x) { return 0.5f * x * (1.f + erff(x * 0.7071067811865476f)); }

struct PeerPre { uint4 e0, e1, a0, a1, a2, a3; };
DEV unsigned peer_eid(const PeerPre& s, int j) {
  const unsigned w = (j < 8) ? ((j >> 1) == 0 ? s.e0.x : (j >> 1) == 1 ? s.e0.y : (j >> 1) == 2 ? s.e0.z : s.e0.w)
                             : (((j - 8) >> 1) == 0 ? s.e1.x : ((j - 8) >> 1) == 1 ? s.e1.y : ((j - 8) >> 1) == 2 ? s.e1.z : s.e1.w);
  return (j & 1) ? (w >> 16) : (w & 0xFFFFu);
}
template <int WHICH>
DEV void peer_wave_run(const P& p, int layer, int x, int tok0, int lane, float* wbuf) {
  const int r = lane >> 3, c = lane & 7;
  const unsigned char* tb = (WHICH == 0 ? p.PU : p.PV) + (size_t)x * PSLICE + c * 16;
  PeerPre S[3];
  uint4 R[16];
  auto ld_pre = [&](int tok, PeerPre& s) {
    const uint4* elp = (const uint4*)(p.EL + (size_t)tok * 128 + r * 16);
    s.e0 = elp[0]; s.e1 = elp[1];
    if (WHICH == 0) {
      s.a0 = *(const uint4*)(p.H8 + (size_t)tok * 1024 + x * 128 + c * 16);
    } else {
      const uint4* wtp = (const uint4*)(p.GT + (size_t)tok * 128 + r * 16);
      s.a0 = wtp[0]; s.a1 = wtp[1]; s.a2 = wtp[2]; s.a3 = wtp[3];
    }
  };
  auto comp = [&](int tok, const PeerPre& s, const PeerPre& sn, bool more) {
    if (WHICH == 0) {
      int keep0 = 0, keep1 = 0;
#pragma unroll
      for (int j = 0; j < 16; ++j) {
        const uint4 rw = R[j];
        if (more) R[j] = *(const uint4*)(tb + (size_t)peer_eid(sn, j) * 128);
        int d = __builtin_amdgcn_sdot4((int)rw.x, (int)s.a0.x, 0, false);
        d = __builtin_amdgcn_sdot4((int)rw.y, (int)s.a0.y, d, false);
        d = __builtin_amdgcn_sdot4((int)rw.z, (int)s.a0.z, d, false);
        d = __builtin_amdgcn_sdot4((int)rw.w, (int)s.a0.w, d, false);
        d += __builtin_amdgcn_update_dpp(0, d, 0xB1, 0xF, 0xF, false);
        d += __builtin_amdgcn_update_dpp(0, d, 0x4E, 0xF, 0xF, false);
        d += __builtin_amdgcn_update_dpp(0, d, 0x141, 0xF, 0xF, false);
        if (j < 8) keep0 = (c == j) ? d : keep0; else keep1 = (c == j - 8) ? d : keep1;
      }
      bf16_t* pd = p.PD + ((size_t)x * NTOK + tok) * 128 + r * 16 + c;
      pd[0] = f2bf((float)keep0); pd[8] = f2bf((float)keep1);
    } else {
      const float wsv[16] = {__uint_as_float(s.a0.x), __uint_as_float(s.a0.y), __uint_as_float(s.a0.z), __uint_as_float(s.a0.w),
                             __uint_as_float(s.a1.x), __uint_as_float(s.a1.y), __uint_as_float(s.a1.z), __uint_as_float(s.a1.w),
                             __uint_as_float(s.a2.x), __uint_as_float(s.a2.y), __uint_as_float(s.a2.z), __uint_as_float(s.a2.w),
                             __uint_as_float(s.a3.x), __uint_as_float(s.a3.y), __uint_as_float(s.a3.z), __uint_as_float(s.a3.w)};
      f32x2 acc2[8];
#pragma unroll
      for (int i = 0; i < 8; ++i) acc2[i] = (f32x2){0.f, 0.f};
#pragma unroll
      for (int j = 0; j < 16; ++j) {
        f32x2 f[8];
        unpack16_fp8x2(R[j], f);
        if (more) R[j] = *(const uint4*)(tb + (size_t)peer_eid(sn, j) * 128);
        const f32x2 w2 = (f32x2){wsv[j], wsv[j]};
#pragma unroll
        for (int i = 0; i < 8; ++i) acc2[i] += w2 * f[i];
      }
      float* slab = wbuf + (r * 8 + c) * 16;
      *(float4*)(slab) = make_float4(acc2[0][0], acc2[0][1], acc2[1][0], acc2[1][1]);
      *(float4*)(slab + 4) = make_float4(acc2[2][0], acc2[2][1], acc2[3][0], acc2[3][1]);
      *(float4*)(slab + 8) = make_float4(acc2[4][0], acc2[4][1], acc2[5][0], acc2[5][1]);
      *(float4*)(slab + 12) = make_float4(acc2[6][0], acc2[6][1], acc2[7][0], acc2[7][1]);
      asm volatile("s_waitcnt lgkmcnt(0)" ::: "memory");
      float o0 = 0.f, o1 = 0.f;
#pragma unroll
      for (int rr = 0; rr < 8; ++rr) {
        const float2 t = *(const float2*)(wbuf + (rr * 8 + (lane >> 3)) * 16 + 2 * (lane & 7));
        o0 += t.x; o1 += t.y;
      }
      asm volatile("s_waitcnt lgkmcnt(0)" ::: "memory");
      const int b = tok / LT, pp = tok % LT;
      const int mr = pp < LC ? 16 : b;
      const int col = x * 128 + 2 * lane;
      const float* g2 = p.modv + ((size_t)layer * 17 + mr) * 6144 + 5120 + col;
      unsigned* xp = (unsigned*)(p.X + (size_t)tok * D + col);
      const unsigned xu = *xp;
      *xp = pack2(bflo(xu) + g2[0] * o0, bfhi(xu) + g2[1] * o1);
    }
  };
  ld_pre(tok0, S[0]);
  ld_pre(tok0 + 1, S[1]);
#pragma unroll
  for (int j = 0; j < 16; ++j) R[j] = *(const uint4*)(tb + (size_t)peer_eid(S[0], j) * 128);
  ld_pre(tok0 + 2, S[2]);
#pragma unroll
  for (int t = 0; t < 8; ++t) {
    comp(tok0 + t, S[t % 3], S[(t + 1) % 3], t + 1 < 8);
    if (t + 3 < 8) ld_pre(tok0 + t + 3, S[t % 3]);
  }
}
DEV void ph_peer_w(const P& p) {
  for (size_t i8 = (size_t)bid_() * 256 + tid_(); i8 < (size_t)NTOK * 16; i8 += (size_t)gridDim.x * 256) {
    const size_t i = i8 * 8;
    float d[8];
#pragma unroll
    for (int q = 0; q < 8; ++q) d[q] = 0.f;
#pragma unroll
    for (int x = 0; x < 8; ++x) {
      const uint4 u = *(const uint4*)(p.PD + (size_t)x * NTOK * 128 + i);
      float f[8];
      unpack8(u, f);
#pragma unroll
      for (int q = 0; q < 8; ++q) d[q] += f[q];
    }
    const uint4 eu = *(const uint4*)(p.EL + i);
    const unsigned ew[4] = {eu.x, eu.y, eu.z, eu.w};
    const float hinv = p.HINV[i >> 7];
    float4 g0 = *(const float4*)(p.GT + i), g1 = *(const float4*)(p.GT + i + 4);
    float g[8] = {g0.x, g0.y, g0.z, g0.w, g1.x, g1.y, g1.z, g1.w};
#pragma unroll
    for (int q = 0; q < 8; ++q) {
      const unsigned e = (q & 1) ? (ew[q >> 1] >> 16) : (ew[q >> 1] & 0xFFFFu);
      g[q] = g[q] * gelu_exact(d[q] * p.PSU[e] * hinv) * p.PSV[e];
    }
    *(float4*)(p.GT + i) = make_float4(g[0], g[1], g[2], g[3]);
    *(float4*)(p.GT + i + 4) = make_float4(g[4], g[5], g[6], g[7]);
  }
}
template <int WHICH>
DEV void ph_peer_gather(const P& p, int layer, char* smem, volatile LAS unsigned* slot) {
  const int tid = tid_(), lane = tid & 63, wid = tid >> 6;
  unsigned* q = p.wq + 1024 + layer * 256 + WHICH * 128;
  const int my = (int)(xb_xcc_id() & 7u);
  float* wbuf = (float*)smem + wid * 1024;
#pragma unroll 1
  for (int rot = 0; rot < 8; ++rot) {
    const int x = (my + rot) & 7;
    for (;;) {
      __syncthreads();
      if (tid == 0) *slot = atomicAdd(q + x * 16, 1u);
      __syncthreads();
      const int it = (int)*slot;
      if (it >= NTOK / 32) break;
      peer_wave_run<WHICH>(p, layer, x, it * 32 + wid * 8, lane, wbuf);
    }
  }
}

DEV void ph_final(const P& p) {
  const int lane = tid_() & 63;
  int r0, r1;
  wave_range(r0, r1, NB * T);
  float gv[16];
#pragma unroll
  for (int hh = 0; hh < 2; ++hh)
#pragma unroll
    for (int i = 0; i < 8; ++i) gv[hh * 8 + i] = p.final_g[hh * 512 + 8 * lane + i];
  auto xrow = [&](int r) -> const bf16_t* { const int b = r / T, t = r % T; return p.X + ((size_t)b * LT + LC + t) * D; };
  uint4 n0 = make_uint4(0, 0, 0, 0), n1 = n0;
  if (r0 < r1) { const bf16_t* xr = xrow(r0); n0 = *(const uint4*)(xr + 8 * lane); n1 = *(const uint4*)(xr + 512 + 8 * lane); }
#pragma unroll 1
  for (int r = r0; r < r1; ++r) {
    const uint4 u0 = n0, u1 = n1;
    if (r + 1 < r1) { const bf16_t* xr = xrow(r + 1); n0 = *(const uint4*)(xr + 8 * lane); n1 = *(const uint4*)(xr + 512 + 8 * lane); }
    float v[16];
    unpack8(u0, v); unpack8(u1, v + 8);
    float ss = 0.f;
#pragma unroll
    for (int i = 0; i < 16; ++i) ss += v[i] * v[i];
    ss = wave_sum(ss);
    const float rstd = rsqrtf(ss * (1.f / 1024.f) + 1e-6f);
    float* o = p.out + (size_t)r * D;
#pragma unroll
    for (int hh = 0; hh < 2; ++hh) {
      const int col = hh * 512 + 8 * lane;
      *(float4*)(o + col) = make_float4(v[hh * 8 + 0] * rstd * gv[hh * 8 + 0], v[hh * 8 + 1] * rstd * gv[hh * 8 + 1], v[hh * 8 + 2] * rstd * gv[hh * 8 + 2], v[hh * 8 + 3] * rstd * gv[hh * 8 + 3]);
      *(float4*)(o + col + 4) = make_float4(v[hh * 8 + 4] * rstd * gv[hh * 8 + 4], v[hh * 8 + 5] * rstd * gv[hh * 8 + 5], v[hh * 8 + 6] * rstd * gv[hh * 8 + 6], v[hh * 8 + 7] * rstd * gv[hh * 8 + 7]);
    }
  }
}

DEV unsigned hw_cu_key() {
  const unsigned hwid = (unsigned)__builtin_amdgcn_s_getreg(((8 - 1) << 11) | (8 << 6) | 4);
  return (xb_xcc_id() << 8) | (hwid & 0xFFu);
}
DEV void mixB(const P& p, int layer, char* smem, volatile LAS unsigned* slot) {
  unsigned* qa = p.wq + layer * 64;
  unsigned* qs = qa + 16;
  unsigned* claim = p.cuclaim + layer * 4096;
  __syncthreads();
  if (tid_() == 0) {
    unsigned u = 0xFFFFFFFFu;
    if (atomicAdd(&claim[hw_cu_key() & 4095u], 1u) == 0u) u = atomicAdd(qs, 1u);
    *slot = u;
  }
  __syncthreads();
  {
    const unsigned u = *slot;
    if (u < 128u) scanc_unit(p, layer, (int)u, smem);
  }
  for (;;) {
    __syncthreads();
    if (tid_() == 0) *slot = atomicAdd(qa, 1u);
    __syncthreads();
    const int u = (int)*slot;
    if (u >= 8704) break;
    if (u < 4352) attn_unit(p, layer, u, smem); else hyena_conv_unit(p, layer, u - 4352, smem);
  }
  if (layer + 1 < DEPTH) {
    unsigned* qp = qa + 32;
    for (;;) {
      __syncthreads();
      if (tid_() == 0) *slot = atomicAdd(qp, 1u);
      __syncthreads();
      const int u = (int)*slot;
      if (u >= PREPA_N) break;
      prep_unit(p, layer + 1, prepA_unit_index(u), smem);
    }
  }
  for (;;) {
    __syncthreads();
    if (tid_() == 0) *slot = atomicAdd(qs, 1u);
    __syncthreads();
    const unsigned u = *slot;
    if (u >= 128u) break;
    scanc_unit(p, layer, (int)u, smem);
  }
}
DEV void mixA(const P& p, int layer, char* smem) {
  for (int u = bid_(); u < 1088; u += gridDim.x) hyena_pre_unit(p, layer, u);
  ph_lora(p, layer, smem);
  ph_rwkv_prep(p, layer);
}
DEV void mixC(const P& p, int layer, char* smem) {
  for (int u = bid_(); u < 1088; u += gridDim.x) hyena_post_unit(p, layer, u, smem);
  ph_rwkv_post(p, layer);
  ph_attn_post(p, layer);
}

__global__ void __launch_bounds__(256, 2) k_mega(P p) {
  extern __shared__ __attribute__((aligned(16))) char smem_all[];
  char* smem = smem_all;
  volatile LAS unsigned* xbw = (volatile LAS unsigned*)(smem_all + SMEM_BYTES);
  if (threadIdx.x == 0) { xbw[0] = 0u; xbw[1] = 0u; xbw[2] = 0u; xbw[3] = 0u; }
  __syncthreads();
  XcdBarrier bar = xcd_barrier_post(p.bar, xbw);
  ph_copy(p);
  ph_rope(p);
  for (int u = blockIdx.x; u < 96; u += gridDim.x) modv_unit(p, u, smem);
  ph_prep(p, 0, smem, false);
  xcd_barrier(bar);
  for (int layer = 0; layer < DEPTH; ++layer) {
    ph_norm(p, layer, 0);
    xcd_barrier(bar);
    ph_gemm1(p, smem);
    xcd_barrier(bar);
    mixA(p, layer, smem);
    xcd_barrier(bar);
    mixB(p, layer, smem, (volatile LAS unsigned*)(smem_all + SMEM_BYTES + 16));
    xcd_barrier(bar);
    mixC(p, layer, smem);
    xcd_barrier(bar);
    ph_gemm2(p, layer, smem);
    ph_peerconv(p, layer);
    xcd_barrier(bar);
    ph_norm(p, layer, 1);
    xcd_barrier(bar);
    ph_gemm3(p, smem);
    xcd_barrier(bar);
    ph_peer_gather<0>(p, layer, smem, (volatile LAS unsigned*)(smem_all + SMEM_BYTES + 16));
    xcd_barrier(bar);
    ph_peer_w(p);
    xcd_barrier(bar);
    ph_peer_gather<1>(p, layer, smem, (volatile LAS unsigned*)(smem_all + SMEM_BYTES + 16));
    if (layer + 1 < DEPTH) ph_prep(p, layer + 1, smem, true);
    xcd_barrier(bar);
  }
  ph_final(p);
}

static inline size_t al256(size_t x) { return (x + 255) & ~(size_t)255; }

extern "C" void kernel_launch(void* const* d_in, const int* in_sizes, int n_in, void* d_out, int out_size, void* d_ws, size_t ws_size,
                              hipStream_t stream) {
  (void)in_sizes; (void)n_in; (void)out_size; (void)ws_size;
  P p{};
  const float** f = (const float**)&p;
  for (int i = 0; i < 39; ++i) f[i] = (const float*)d_in[i];
  p.out = (float*)d_out;
  char* w = (char*)d_ws;
  size_t off = 0;
  auto take = [&](size_t bytes) { char* r = w + off; off += al256(bytes); return r; };
  p.bar = (unsigned*)take(16384);
  p.modv = (float*)take((size_t)DEPTH * 17 * 6144 * 4);
  p.SSQ = (float*)take((size_t)DEPTH * 2 * 256 * 4);
  p.wq = (unsigned*)take(4096 + DEPTH * 1024);
  p.cuclaim = (unsigned*)take((size_t)DEPTH * 4096 * 4);
  const size_t zero_bytes = off;
  p.rope = (float*)take(64 * 16 * 2 * 4);
  p.X = (bf16_t*)take((size_t)NTOK * D * 2);
  p.H = (bf16_t*)take((size_t)NTOK * D * 2);
  p.Y = (bf16_t*)take((size_t)NTOK * D * 2);
  p.SC = (bf16_t*)take((size_t)NTOK * 1024 * 2);
  p.Z = (bf16_t*)take((size_t)NTOK * INW * 2);
  p.UTl = (bf16_t*)take((size_t)256 * 16 * T * 2);
  p.UTc = (bf16_t*)take((size_t)256 * 16 * LC * 2);
  p.YTl = (bf16_t*)take((size_t)256 * 16 * T * 2);
  p.YTc = (bf16_t*)take((size_t)256 * 16 * LC * 2);
  p.FL = (float*)take((size_t)256 * 2 * T * 4);
  p.FC = (float*)take((size_t)256 * 2 * LC * 4);
  p.W1t = (bf16_t*)take((size_t)INW * D * 2);
  p.W2t = (bf16_t*)take((size_t)D * D * 2);
  p.Wft = (bf16_t*)take((size_t)2048 * D * 2);
  p.Wlt = (bf16_t*)take((size_t)1024 * 256 * 2);
  p.Wgt = (bf16_t*)take((size_t)256 * 128 * 2);
  p.TK = (float*)p.Z;
  p.PU = (unsigned char*)p.Z + al256((size_t)NTOK * 256 * 4);
  p.PV = p.PU + (size_t)16384 * 1024;
  p.PSU = (float*)(p.PV + (size_t)16384 * 1024);
  p.PSV = p.PSU + 16384;
  p.GT = p.PSV + 16384;
  p.EL = (unsigned short*)(p.GT + (size_t)NTOK * 128);
  p.H8 = (unsigned char*)p.EL + al256((size_t)NTOK * 128 * 2);
  p.HINV = (float*)(p.H8 + (size_t)NTOK * 1024);
  p.PD = p.Y;

  (void)hipMemsetAsync(d_ws, 0, zero_bytes, stream);
  constexpr size_t kDynLds = SMEM_BYTES + 32;
  static int grid = 0;
  if (!grid) {
    int dev = 0, cus = 0, per_cu = 0;
    (void)hipGetDevice(&dev);
    (void)hipDeviceGetAttribute(&cus, hipDeviceAttributeMultiprocessorCount, dev);
    (void)hipFuncSetAttribute((const void*)k_mega, hipFuncAttributeMaxDynamicSharedMemorySize, (int)kDynLds);
    (void)hipOccupancyMaxActiveBlocksPerMultiprocessor(&per_cu, k_mega, 256, kDynLds);
    if (cus <= 0) cus = 256;
    if (per_cu > 2) per_cu = 2;
    if (per_cu < 1) per_cu = 1;
    grid = cus * per_cu;
  }
  k_mega<<<grid, 256, kDynLds, stream>>>(p);
}
```

```cpp
#include <hip/hip_runtime.h>
#include <stdint.h>
#include <type_traits>

#define DEV __device__ __forceinline__
typedef unsigned short bf16_t;
typedef short bf16x8 __attribute__((ext_vector_type(8)));
typedef float f32x2 __attribute__((ext_vector_type(2)));
constexpr size_t PSLICE = (size_t)16384 * 128;
typedef float f32x4 __attribute__((ext_vector_type(4)));
typedef float f32x16 __attribute__((ext_vector_type(16)));


constexpr int NB = 16, T = 4096, LC = 256, LT = 4352, D = 1024, NTOK = NB * LT, INW = 2688, DEPTH = 4;
constexpr int SMEM_BYTES = 65536;

struct P {
  const float *x, *c, *ctx, *c_ctx, *mod_w, *mod_b, *norm1_g, *norm2_g, *w_in, *conv_w, *conv_b;
  const float *hy_w1, *hy_b1, *hy_w2, *hy_b2, *hy_w3, *hy_b3, *hy_freq, *hy_bias;
  const float *rw_w0, *rw_w_up, *rw_a0, *rw_a_up, *rw_g_up, *rw_k_k, *rw_k_a, *rw_r_k, *rw_ln_w, *rw_ln_b;
  const float *attn_sink, *hy_out_g, *at_out_g, *w_out, *peer_wq, *peer_k1, *peer_k2, *peer_u, *peer_v, *final_g;
  float* out;
  unsigned* bar;
  float *modv, *SSQ, *rope, *FL, *FC, *TK;
  unsigned *wq, *cuclaim;
  bf16_t *X, *H, *Y, *SC, *Z, *UTl, *UTc, *YTl, *YTc;
  bf16_t *W1t, *W2t, *Wft, *Wlt, *Wgt;
  unsigned char *PU, *PV;
  float *PSU, *PSV, *GT, *HINV;
  bf16_t* PD;
  unsigned short* EL;
  unsigned char* H8;
};

typedef __bf16 hwbf2 __attribute__((ext_vector_type(2)));
DEV unsigned pack2(float a, float b) { f32x2 f = {a, b}; hwbf2 r = __builtin_convertvector(f, hwbf2); return __builtin_bit_cast(unsigned, r); }
DEV bf16_t f2bf(float f) { return (bf16_t)(pack2(f, 0.f) & 0xFFFFu); }
DEV float bf2f(bf16_t h) { return __uint_as_float(((unsigned)h) << 16); }
DEV float bflo(unsigned u) { return __uint_as_float(u << 16); }
DEV float bfhi(unsigned u) { return __uint_as_float(u & 0xFFFF0000u); }
DEV void unpack8(const uint4& u, float* v) {
  v[0] = bflo(u.x); v[1] = bfhi(u.x); v[2] = bflo(u.y); v[3] = bfhi(u.y);
  v[4] = bflo(u.z); v[5] = bfhi(u.z); v[6] = bflo(u.w); v[7] = bfhi(u.w);
}
DEV uint4 pack8(const float* v) { return make_uint4(pack2(v[0], v[1]), pack2(v[2], v[3]), pack2(v[4], v[5]), pack2(v[6], v[7])); }
DEV int pack_i8(float a, float b, float c, float d) {
  const int ia = __float2int_rn(a), ib = __float2int_rn(b), ic = __float2int_rn(c), id = __float2int_rn(d);
  return (ia & 0xFF) | ((ib & 0xFF) << 8) | ((ic & 0xFF) << 16) | ((id & 0xFF) << 24);
}
DEV float sigmoidf_(float x) { return __builtin_amdgcn_rcpf(1.f + __expf(-x)); }

template <int CTRL, int ROWMASK>
DEV float dpp0(float x) {
  return __builtin_bit_cast(float, __builtin_amdgcn_update_dpp(0, __builtin_bit_cast(int, x), CTRL, ROWMASK, 0xF, false));
}
template <int CTRL, int ROWMASK>
DEV float dppself(float x) {
  int xi = __builtin_bit_cast(int, x);
  return __builtin_bit_cast(float, __builtin_amdgcn_update_dpp(xi, xi, CTRL, ROWMASK, 0xF, false));
}
DEV float readlane_f(float x, int l) { return __builtin_bit_cast(float, __builtin_amdgcn_readlane(__builtin_bit_cast(int, x), l)); }
DEV int lane_id() { return (int)__builtin_amdgcn_mbcnt_hi(~0u, __builtin_amdgcn_mbcnt_lo(~0u, 0u)); }
DEV float writelane_f(float val, int l, float old) { return lane_id() == l ? val : old; }
DEV int writelane_i(int val, int l, int old) { return lane_id() == l ? val : old; }
DEV float wave_sum(float x) {
  x += dpp0<0x111, 0xF>(x); x += dpp0<0x112, 0xF>(x); x += dpp0<0x114, 0xF>(x); x += dpp0<0x118, 0xF>(x);
  x += dpp0<0x142, 0xA>(x); x += dpp0<0x143, 0xC>(x);
  return readlane_f(x, 63);
}
DEV float wave_max(float x) {
  x = fmaxf(x, dppself<0x111, 0xF>(x)); x = fmaxf(x, dppself<0x112, 0xF>(x)); x = fmaxf(x, dppself<0x114, 0xF>(x));
  x = fmaxf(x, dppself<0x118, 0xF>(x)); x = fmaxf(x, dppself<0x142, 0xA>(x)); x = fmaxf(x, dppself<0x143, 0xC>(x));
  return readlane_f(x, 63);
}
DEV float row16_sum(float x) {
  x += dpp0<0xB1, 0xF>(x); x += dpp0<0x4E, 0xF>(x); x += dpp0<0x141, 0xF>(x); x += dpp0<0x140, 0xF>(x);
  return x;
}
DEV float row16_max(float x) {
  x = fmaxf(x, dppself<0xB1, 0xF>(x)); x = fmaxf(x, dppself<0x4E, 0xF>(x)); x = fmaxf(x, dppself<0x141, 0xF>(x));
  x = fmaxf(x, dppself<0x140, 0xF>(x));
  return x;
}
DEV float quad_sum(float x) { x += dpp0<0xB1, 0xF>(x); x += dpp0<0x4E, 0xF>(x); return x; }

DEV f32x4 mfma16(bf16x8 a, bf16x8 b, f32x4 c) { return __builtin_amdgcn_mfma_f32_16x16x32_bf16(a, b, c, 0, 0, 0); }
DEV f32x16 mfma32(bf16x8 a, bf16x8 b, f32x16 c) { return __builtin_amdgcn_mfma_f32_32x32x16_bf16(a, b, c, 0, 0, 0); }


#define XB_TMO      128
#define XB_XCNT(j)  (256  + 64 * (j))
#define XB_XSUB(j)  (1280 + 64 * (j))
#define XB_XGEN(j)  (2304 + 64 * (j))
#define XB_TOP      3328
#define XB_TOPGEN   3392
#define XCD_BAR_WORDS 3456
#define XB_SPIN_CAP (1u << 23)
#define LAS __attribute__((address_space(3)))

__device__ __forceinline__ unsigned xb_ld(unsigned* p)              { return __hip_atomic_load(p, __ATOMIC_RELAXED, __HIP_MEMORY_SCOPE_AGENT); }
__device__ __forceinline__ unsigned xb_add(unsigned* p, unsigned v) { return __hip_atomic_fetch_add(p, v, __ATOMIC_RELAXED, __HIP_MEMORY_SCOPE_AGENT); }
__device__ __forceinline__ unsigned xb_xcc_id() { return (unsigned)__builtin_amdgcn_s_getreg((3 << 11) | 20) & 0xFu; }
#define XB_SPIN(cond, bar) do { unsigned _sp = 0; while (cond) { __builtin_amdgcn_s_sleep(1); \
    if ((++_sp & 255u) == 0u) { if (xb_ld(&(bar)[XB_TMO])) break; if (_sp > XB_SPIN_CAP) { atomicAdd(&(bar)[XB_TMO], 1u); break; } } } } while (0)

struct XcdBarrier {
    unsigned* bar; unsigned x;
    volatile LAS unsigned* st;
};
__device__ __forceinline__ XcdBarrier xcd_barrier_post(unsigned* bar, volatile LAS unsigned* st) {
    XcdBarrier b; b.bar = bar; b.x = xb_xcc_id(); b.st = st;
    if (threadIdx.x == 0) (void)xb_add(&bar[XB_XCNT(b.x)], 1u);
    return b;
}
__device__ __forceinline__ void xcd_barrier_complete(unsigned* bar, unsigned x, unsigned& nloc, unsigned& nx) {
    const unsigned G = gridDim.x * gridDim.y * gridDim.z;
    unsigned sum, cnt, mine, sp = 0u;
    for (;;) {
        sum = 0u; cnt = 0u; mine = 0u;
#pragma unroll
        for (unsigned j = 0; j < 16; ++j) { const unsigned c = xb_ld(&bar[XB_XCNT(j)]); sum += c; cnt += (c > 0u) ? 1u : 0u; mine = (j == x) ? c : mine; }
        if (sum == G) break;
        __builtin_amdgcn_s_sleep(1);
        if ((++sp & 255u) == 0u) { if (xb_ld(&bar[XB_TMO])) break; if (sp > XB_SPIN_CAP) { atomicAdd(&bar[XB_TMO], 1u); break; } }
    }
    nloc = mine > 0u ? mine : 1u; nx = cnt > 0u ? cnt : 1u;
}
__device__ __forceinline__ void xcd_barrier(const XcdBarrier& b) {
    asm volatile("s_waitcnt vmcnt(0)" ::: "memory");
    __syncthreads();
    if (threadIdx.x == 0) {
        unsigned* bar = b.bar;
        __builtin_amdgcn_s_waitcnt(0);
        unsigned nloc = b.st[0], nx = b.st[1];
        if (nloc == 0u) { xcd_barrier_complete(bar, b.x, nloc, nx); b.st[0] = nloc; b.st[1] = nx; }
        const unsigned old = xb_add(&bar[XB_XSUB(b.x)], 1u);
        const unsigned gen = old / nloc;
        if (old + 1u == (gen + 1u) * nloc) {
            __builtin_amdgcn_fence(__ATOMIC_RELEASE, "agent");
            asm volatile("s_waitcnt vmcnt(0)" ::: "memory");
            const unsigned og = xb_add(&bar[XB_TOP], 1u);
            const unsigned tg = og / nx;
            if (og + 1u == (tg + 1u) * nx) xb_add(&bar[XB_TOPGEN], 1u);
            else XB_SPIN(xb_ld(&bar[XB_TOPGEN]) == tg, bar);
            __builtin_amdgcn_fence(__ATOMIC_ACQUIRE, "agent");
            xb_add(&bar[XB_XGEN(b.x)], 1u);
            asm volatile("s_waitcnt vmcnt(0)" ::: "memory");
        } else {
            XB_SPIN(xb_ld(&bar[XB_XGEN(b.x)]) == gen, bar);
            __builtin_amdgcn_fence(__ATOMIC_ACQUIRE, "agent");
            asm volatile("s_waitcnt vmcnt(0)" ::: "memory");
        }
    }
    __syncthreads();
}

template <class Tp> DEV Tp* opq(Tp* q) { asm volatile("" : "+s"(q)); return q; }
DEV int tid_() { int t = threadIdx.x; asm volatile("" : "+v"(t)); return t; }
DEV int bid_() { int b = blockIdx.x; asm volatile("" : "+s"(b)); return b; }

DEV void glds16(const void* gsrc, char* lds_lane_ptr) {
  __builtin_amdgcn_global_load_lds((const unsigned*)gsrc, (__attribute__((address_space(3))) unsigned*)lds_lane_ptr, 16, 0, 0);
}
template <class Epi>
DEV void gemm_tile(const bf16_t* __restrict__ A, int lda, const bf16_t* __restrict__ Bt, int ldb, int K, char* smem, Epi& epi) {
  const int tid = tid_(), lane = tid & 63, wid = tid >> 6, wr = wid >> 1, wc = wid & 1, fr = lane & 15, fq = lane >> 4;
  f32x4 acc[4][4];
#pragma unroll
  for (int m = 0; m < 4; ++m)
#pragma unroll
    for (int n = 0; n < 4; ++n) acc[m][n] = (f32x4){0.f, 0.f, 0.f, 0.f};
  const int drow0 = 8 * wid + (lane >> 3), dpc = lane & 7;
  auto issue = [&](int kt, int buf) {
    char* sa = smem + buf * 32768;
    char* sb = sa + 16384;
#pragma unroll
    for (int i = 0; i < 4; ++i) {
      const int row = drow0 + 32 * i;
      const int kc = dpc ^ ((row >> 1) & 7);
      glds16(A + (size_t)row * lda + kt * 64 + kc * 8, sa + (i * 4 + wid) * 1024 + lane * 16);
      glds16(Bt + (size_t)row * ldb + kt * 64 + kc * 8, sb + (i * 4 + wid) * 1024 + lane * 16);
    }
  };
  __syncthreads();
  issue(0, 0);
  const int nk = K >> 6;
  const int sw = (fr >> 1) & 7;
  const int aoff = (wr * 64 + fr) * 128, boff = (wc * 64 + fr) * 128;
  for (int kt = 0; kt < nk; ++kt) {
    asm volatile("s_waitcnt vmcnt(0)" ::: "memory");
    __syncthreads();
    if (kt + 1 < nk) issue(kt + 1, (kt + 1) & 1);
    const char* sa = smem + (kt & 1) * 32768;
    const char* sb = sa + 16384;
#pragma unroll
    for (int kh = 0; kh < 2; ++kh) {
      const int pc = ((kh * 4 + fq) ^ sw) * 16;
      bf16x8 af[4], bfr[4];
#pragma unroll
      for (int m = 0; m < 4; ++m) af[m] = *(const bf16x8*)(sa + aoff + m * 2048 + pc);
#pragma unroll
      for (int n = 0; n < 4; ++n) bfr[n] = *(const bf16x8*)(sb + boff + n * 2048 + pc);
#pragma unroll
      for (int m = 0; m < 4; ++m)
#pragma unroll
        for (int n = 0; n < 4; ++n) acc[m][n] = mfma16(bfr[n], af[m], acc[m][n]);
    }
  }
  __syncthreads();
  epi(acc, wr, wc, fr, fq, smem);
}
DEV void stage_tile_bf16(const f32x4 (&acc)[4][4], char* smem, int wid, int fr, int fq) {
  bf16_t (*t)[72] = (bf16_t (*)[72])(smem + wid * 9216);
#pragma unroll
  for (int m = 0; m < 4; ++m)
#pragma unroll
    for (int n = 0; n < 4; ++n)
      *(uint2*)&t[m * 16 + fr][n * 16 + 4 * fq] = make_uint2(pack2(acc[m][n][0], acc[m][n][1]), pack2(acc[m][n][2], acc[m][n][3]));
  asm volatile("s_waitcnt lgkmcnt(0)" ::: "memory");
}

DEV void ph_copy(const P& p) {
  const size_t n8 = (size_t)NTOK * D / 8;
  const float* pctx = opq(p.ctx); const float* px = opq(p.x);
  for (size_t i = (size_t)bid_() * 256 + tid_(); i < n8; i += (size_t)gridDim.x * 256) {
    size_t e = i * 8;
    int row = (int)(e / D), col = (int)(e % D);
    int b = row / LT, pp = row % LT;
    const float* src = pp < LC ? pctx + ((size_t)(b * LC + pp)) * D + col : px + ((size_t)(b * T + pp - LC)) * D + col;
    float4 v0 = *(const float4*)src, v1 = *(const float4*)(src + 4);
    uint4 o = make_uint4(pack2(v0.x, v0.y), pack2(v0.z, v0.w), pack2(v1.x, v1.y), pack2(v1.z, v1.w));
    *(uint4*)(p.X + e) = o;
  }
}

DEV void ph_rope(const P& p) {
  for (int i = bid_() * 256 + tid_(); i < 64 * 16; i += gridDim.x * 256) {
    int pos = i >> 4, k = i & 15;
    float inv = powf(10000.f, -(float)k / 16.f);
    float ang = (float)pos * inv;
    p.rope[2 * i] = cosf(ang); p.rope[2 * i + 1] = sinf(ang);
  }
}

DEV void modv_unit(const P& p, int unit, char* smem) {
  const int cc = unit % 24, layer = unit / 24;
  float (*cs)[128] = (float (*)[128])smem;
  const int col = cc * 256 + tid_();
  const float* pc = opq(p.c); const float* pcc = opq(p.c_ctx);
  float acc[17];
#pragma unroll
  for (int r = 0; r < 17; ++r) acc[r] = 0.f;
  for (int ks = 0; ks < 8; ++ks) {
    __syncthreads();
    for (int i = tid_(); i < 17 * 128; i += 256) {
      int r = i >> 7, e = i & 127;
      float v = r < 16 ? pc[r * D + ks * 128 + e] : pcc[ks * 128 + e];
      cs[r][e] = v / (1.f + expf(-v));
    }
    __syncthreads();
    const float* w = p.mod_w + ((size_t)layer * D + ks * 128) * 6144 + col;
#pragma unroll 2
    for (int e = 0; e < 128; e += 4) {
      const float w0 = w[(size_t)e * 6144], w1 = w[(size_t)(e + 1) * 6144], w2 = w[(size_t)(e + 2) * 6144], w3 = w[(size_t)(e + 3) * 6144];
#pragma unroll
      for (int r = 0; r < 17; ++r) {
        const float4 cv = *(const float4*)&cs[r][e];
        acc[r] += cv.x * w0 + cv.y * w1 + cv.z * w2 + cv.w * w3;
      }
    }
  }
  const float bias = p.mod_b[layer * 6144 + col];
#pragma unroll
  for (int r = 0; r < 17; ++r) p.modv[((size_t)layer * 17 + r) * 6144 + col] = acc[r] + bias;
}

DEV void transpose_unit(const float* __restrict__ src, bf16_t* __restrict__ dst, int R, int C, int tile, char* smem) {
  float (*t)[65] = (float (*)[65])smem;
  const int nct = C / 64;
  const int tr = tile / nct, tc = tile % nct;
  __syncthreads();
  for (int i = tid_(); i < 4096; i += 256) { int r = i >> 6, c = i & 63; t[r][c] = src[(size_t)(tr * 64 + r) * C + tc * 64 + c]; }
  __syncthreads();
  for (int i = tid_(); i < 4096; i += 256) { int c = i >> 6, r = i & 63; dst[(size_t)(tc * 64 + c) * R + tr * 64 + r] = f2bf(t[r][c]); }
}

DEV void wfold_unit(const P& p, int layer, int unit, char* smem) {
  const int hs = unit >> 5, ec = unit & 31, h = hs >> 1, s = hs & 1;
  const float* wq = p.peer_wq + (size_t)layer * D * 2048;
  const float* kk = (s ? opq(p.peer_k2) : opq(p.peer_k1)) + ((size_t)layer * 8 + h) * 128 * 128;
  float (*kS)[65] = (float (*)[65])smem;
  float (*wS)[64] = (float (*)[64])(smem + 33280);
  const int key = tid_() & 127, eh = tid_() >> 7;
  float acc[16];
#pragma unroll
  for (int i = 0; i < 16; ++i) acc[i] = 0.f;
  for (int dh = 0; dh < 2; ++dh) {
    __syncthreads();
    for (int i = tid_(); i < 128 * 64; i += 256) { int k2 = i >> 6, d = i & 63; kS[k2][d] = kk[k2 * 128 + dh * 64 + d]; }
    for (int i = tid_(); i < 32 * 64; i += 256) {
      int e = i >> 6, d = i & 63;
      wS[e][d] = wq[(size_t)(ec * 32 + e) * 2048 + h * 256 + s * 128 + dh * 64 + d];
    }
    __syncthreads();
#pragma unroll 2
    for (int d = 0; d < 64; d += 4) {
      const float k0 = kS[key][d], k1 = kS[key][d + 1], k2 = kS[key][d + 2], k3 = kS[key][d + 3];
#pragma unroll
      for (int i = 0; i < 16; ++i) {
        const float4 wv = *(const float4*)&wS[eh * 16 + i][d];
        acc[i] += k0 * wv.x + k1 * wv.y + k2 * wv.z + k3 * wv.w;
      }
    }
  }
  bf16_t* dst = p.Wft + ((size_t)(hs * 128 + key)) * D + ec * 32 + eh * 16;
#pragma unroll
  for (int i = 0; i < 16; i += 2) *(unsigned*)(dst + i) = pack2(acc[i], acc[i + 1]);
}

DEV void filt_unit(const P& p, int layer, int unit, char* smem) {
  int kind, j0, L;
  if (unit < 1024) { kind = 0; j0 = unit * 4; L = T; } else { kind = 1; j0 = (unit - 1024) * 4; L = LC; }
  float* zs = (float*)smem;
  float* h1 = zs + 4 * 36;
  float* h2 = h1 + 256;
  const int jj = tid_() >> 6, o = tid_() & 63;
  const int j = j0 + jj;
  const float fj = (float)j;
  const float t = fj / (float)(L - 1);
  __syncthreads();
  if (o < 33) {
    float z;
    if (o == 0) z = t;
    else {
      int i = (o - 1) & 15;
      float band = 1e-4f + (float)i * ((15.0f - 1e-4f) / 15.0f);
      float ang = 6.283185307179586f * fj * band / (float)L;
      z = (o <= 16) ? cosf(ang) : -sinf(ang);
    }
    zs[jj * 36 + o] = z;
  }
  __syncthreads();
  {
    const float* w1 = p.hy_w1 + layer * 33 * 64;
    float a = p.hy_b1[layer * 64 + o];
#pragma unroll 3
    for (int i = 0; i < 33; ++i) a += zs[jj * 36 + i] * w1[i * 64 + o];
    h1[jj * 64 + o] = sinf(p.hy_freq[layer * 128 + o] * a);
  }
  __syncthreads();
  {
    const float* w2 = p.hy_w2 + layer * 64 * 64;
    float a = p.hy_b2[layer * 64 + o];
#pragma unroll 4
    for (int i = 0; i < 64; ++i) a += h1[jj * 64 + i] * w2[i * 64 + o];
    h2[jj * 64 + o] = sinf(p.hy_freq[layer * 128 + 64 + o] * a);
  }
  __syncthreads();
  const float* w3 = p.hy_w3 + layer * 64 * 512;
  float* F = kind ? opq(p.FC) : opq(p.FL);
  const float DMIN = -3.0701134573253945f, DMAX = -15.350567286626973f;
#pragma unroll 1
  for (int m = 0; m < 4; ++m) {
    int c = o + 64 * m;
    float af = p.hy_b3[layer * 512 + c], ab = p.hy_b3[layer * 512 + 256 + c];
#pragma unroll 4
    for (int i = 0; i < 64; ++i) { float hv = h2[jj * 64 + i]; af += hv * w3[i * 512 + c]; ab += hv * w3[i * 512 + 256 + c]; }
    float delta = fabsf(DMIN + (float)c * ((DMAX - DMIN) / 255.f));
    float win = expf(-t * delta) + 0.05f;
    af *= win; ab *= win;
    F[((size_t)c * 2 + 0) * L + j] = af;
    F[((size_t)c * 2 + 1) * L + j] = ab;
  }
}

constexpr int PREP_T0 = 672, PREP_T1 = PREP_T0 + 256, PREP_T2 = PREP_T1 + 8, PREP_T3 = PREP_T2 + 8, PREP_T4 = PREP_T3 + 8;
constexpr int PREP_WF = PREP_T4 + 512, PREP_N = PREP_WF + 1088;
DEV void prep_unit(const P& p, int layer, int u, char* smem) {
  if (u < PREP_T0) transpose_unit(p.w_in + (size_t)layer * D * INW, p.W1t, D, INW, u, smem);
  else if (u < PREP_T1) transpose_unit(p.w_out + (size_t)layer * D * D, p.W2t, D, D, u - PREP_T0, smem);
  else if (u < PREP_T3) {
    const int u0 = u - PREP_T1;
    for (int i = tid_(); i < 64 * 256; i += 256) {
      const int np = u0 * 64 + (i >> 8), kp = i & 255;
      const int ps = np & 3, chan = np >> 2, qp = kp >> 6, kk = kp & 63;
      const int is_a = ps & 1, d = ps >> 1;
      float v = 0.f;
      if (qp == (is_a ? 2 + d : d)) v = (is_a ? opq(p.rw_a_up) : opq(p.rw_w_up))[(((size_t)layer * 2 + d) * 64 + kk) * 256 + chan];
      p.Wlt[(size_t)np * 256 + kp] = f2bf(v);
    }
  }
  else if (u < PREP_T4) transpose_unit(p.rw_g_up + (size_t)layer * 128 * 256, p.Wgt, 128, 256, u - PREP_T3, smem);
  else if (u < PREP_WF) wfold_unit(p, layer, u - PREP_T4, smem);
  else filt_unit(p, layer, u - PREP_WF, smem);
}
constexpr int PREPA_N = PREP_T0 + (PREP_T4 - PREP_T1);
DEV int prepA_unit_index(int i) { return i < PREP_T0 ? i : PREP_T1 + (i - PREP_T0); }
DEV void ph_prep(const P& p, int layer, char* smem, bool onlyB) {
  for (int u = bid_(); u < PREP_N; u += gridDim.x) {
    const bool isA = (u < PREP_T0) || (u >= PREP_T1 && u < PREP_T4);
    if (onlyB && isA) continue;
    prep_unit(p, layer, u, smem);
  }
}

DEV void wave_range(int& r0, int& r1, int ntok) {
  const int gw = (bid_() * 256 + tid_()) >> 6, nw = gridDim.x * 4;
  const int per = (ntok + nw - 1) / nw;
  r0 = gw * per; r1 = r0 + per; if (r1 > ntok) r1 = ntok;
}
DEV void ph_norm(const P& p, int layer, int which) {
  const int lane = tid_() & 63;
  int r0, r1;
  wave_range(r0, r1, NTOK);
  const float* g = (which ? p.norm2_g : p.norm1_g) + layer * D;
  float gv[16], scv[16], shv[16];
#pragma unroll
  for (int hh = 0; hh < 2; ++hh)
#pragma unroll
    for (int i = 0; i < 8; ++i) gv[hh * 8 + i] = g[hh * 512 + 8 * lane + i];
  int mr_cur = -1;
  uint4 n0 = make_uint4(0, 0, 0, 0), n1 = n0;
  if (r0 < r1) { const bf16_t* xr = p.X + (size_t)r0 * D; n0 = *(const uint4*)(xr + 8 * lane); n1 = *(const uint4*)(xr + 512 + 8 * lane); }
#pragma unroll 1
  for (int row = r0; row < r1; ++row) {
    const uint4 u0 = n0, u1 = n1;
    if (row + 1 < r1) { const bf16_t* xr = p.X + (size_t)(row + 1) * D; n0 = *(const uint4*)(xr + 8 * lane); n1 = *(const uint4*)(xr + 512 + 8 * lane); }
    const int b = row / LT, pp = row % LT;
    const int mr = pp < LC ? 16 : b;
    if (mr != mr_cur) {
      mr_cur = mr;
      const float* mv = p.modv + ((size_t)layer * 17 + mr) * 6144 + (which ? 3072 : 0);
#pragma unroll
      for (int hh = 0; hh < 2; ++hh)
#pragma unroll
        for (int i = 0; i < 8; ++i) { shv[hh * 8 + i] = mv[hh * 512 + 8 * lane + i]; scv[hh * 8 + i] = 1.f + mv[1024 + hh * 512 + 8 * lane + i]; }
    }
    float v[16];
    unpack8(u0, v); unpack8(u1, v + 8);
    float ss = 0.f;
#pragma unroll
    for (int i = 0; i < 16; ++i) ss += v[i] * v[i];
    ss = wave_sum(ss);
    const float rstd = rsqrtf(ss * (1.f / 1024.f) + 1e-6f);
    float o[16];
#pragma unroll
    for (int i = 0; i < 16; ++i) o[i] = (v[i] * rstd * gv[i]) * scv[i] + shv[i];
    bf16_t* hr = p.H + (size_t)row * D;
    *(uint4*)(hr + 8 * lane) = pack8(o);
    *(uint4*)(hr + 512 + 8 * lane) = pack8(o + 8);
    if (which) {
      float am = 0.f;
#pragma unroll
      for (int i = 0; i < 16; ++i) am = fmaxf(am, fabsf(o[i]));
      am = wave_max(am);
      const float sc = am > 0.f ? 127.f / am : 1.f;
      unsigned char* h8 = p.H8 + (size_t)row * 1024;
      *(uint2*)(h8 + 8 * lane) = make_uint2((unsigned)pack_i8(o[0] * sc, o[1] * sc, o[2] * sc, o[3] * sc), (unsigned)pack_i8(o[4] * sc, o[5] * sc, o[6] * sc, o[7] * sc));
      *(uint2*)(h8 + 512 + 8 * lane) = make_uint2((unsigned)pack_i8(o[8] * sc, o[9] * sc, o[10] * sc, o[11] * sc), (unsigned)pack_i8(o[12] * sc, o[13] * sc, o[14] * sc, o[15] * sc));
      if (lane == 0) p.HINV[row] = am > 0.f ? am * (1.f / 127.f) : 1.f;
    }
  }
}

DEV bool gemm_unit(int it, int nct, int& rt, int& ct) {
  const int nslot = gridDim.x >> 3;
  const int x = bid_() & 7, sl = bid_() >> 3;
  if (sl >= nslot) return false;
  const int v = it * nslot + sl;
  if (v >= 68 * nct) return false;
  const int rg = v / (8 * nct), rem = v - rg * 8 * nct;
  const int rows = (rg == 8) ? 4 : 8;
  ct = rem / rows;
  rt = x * 68 + rg * 8 + (rem - ct * rows);
  return true;
}
struct Epi1 {
  const P& p; int row0, col0;
  DEV void operator()(f32x4 (&acc)[4][4], int wr, int wc, int fr, int fq, char* smem) const {
    const int cw = col0 + wc * 64;
    const int rbase = row0 + wr * 64;
    const bool lat = (row0 % LT) >= LC;
    if (cw >= 1536 && cw < 1664) {
#pragma unroll
      for (int m = 0; m < 4; ++m)
#pragma unroll
        for (int n = 0; n < 4; ++n)
#pragma unroll
          for (int j = 0; j < 4; ++j) acc[m][n][j] = 2.f * sigmoidf_(2.f * acc[m][n][j]) - 1.f;
    } else if (cw >= 1792 && cw < 1920) {
#pragma unroll
      for (int m = 0; m < 4; ++m)
#pragma unroll
        for (int n = 0; n < 4; ++n)
#pragma unroll
          for (int j = 0; j < 4; ++j) acc[m][n][j] = sigmoidf_(acc[m][n][j]);
    } else if (cw >= 1920 && cw < 2560 && lat) {
#pragma unroll
      for (int m = 0; m < 4; ++m) {
        const int row = rbase + m * 16 + fr;
        const int pl = (row % LT) - LC;
        const int ri = pl >> 6, ci = pl & 63;
        const float4* crp = (const float4*)(p.rope + 2 * (ri * 16 + 4 * fq));
        const float4* ccp = (const float4*)(p.rope + 2 * (ci * 16 + 4 * fq));
        const float4 cr0 = crp[0], cr1 = crp[1], cc0 = ccp[0], cc1 = ccp[1];
        const float crc[4] = {cr0.x, cr0.z, cr1.x, cr1.z}, crs[4] = {cr0.y, cr0.w, cr1.y, cr1.w};
        const float ccc[4] = {cc0.x, cc0.z, cc1.x, cc1.z}, ccs[4] = {cc0.y, cc0.w, cc1.y, cc1.w};
#pragma unroll
        for (int j = 0; j < 4; ++j) {
          float x1 = acc[m][0][j], x2 = acc[m][1][j];
          acc[m][0][j] = x1 * crc[j] - x2 * crs[j]; acc[m][1][j] = x2 * crc[j] + x1 * crs[j];
          x1 = acc[m][2][j]; x2 = acc[m][3][j];
          acc[m][2][j] = x1 * ccc[j] - x2 * ccs[j]; acc[m][3][j] = x2 * ccc[j] + x1 * ccs[j];
        }
      }
    }
    const int wid = wr * 2 + wc, lane = fq * 16 + fr;
    stage_tile_bf16(acc, smem, wid, fr, fq);
    const bf16_t (*t)[72] = (const bf16_t (*)[72])(smem + wid * 9216);
#pragma unroll
    for (int i = 0; i < 8; ++i) {
      const int rl = i * 8 + (lane >> 3), ch = lane & 7;
      *(uint4*)(p.Z + (size_t)(rbase + rl) * INW + cw + ch * 8) = *(const uint4*)&t[rl][ch * 8];
    }
  }
};
DEV void ph_gemm1(const P& p, char* smem) {
  const int nct = INW / 128;
  int rt, ct;
  for (int it = 0; gemm_unit(it, nct, rt, ct); ++it) {
    Epi1 epi{p, rt * 128, ct * 128};
    gemm_tile(p.H + (size_t)rt * 128 * D, D, p.W1t + (size_t)ct * 128 * D, D, D, smem, epi);
  }
}

struct EpiLoraA {
  const P& p; int layer, row0, col0;
  DEV void operator()(f32x4 (&acc)[4][4], int wr, int wc, int fr, int fq, char* smem) const {
    const float* w0b = p.rw_w0 + layer * 512;
    const float* a0b = p.rw_a0 + layer * 512;
#pragma unroll
    for (int n = 0; n < 4; ++n) {
      const int chan = ((col0 + wc * 64 + n * 16) >> 2) + fq;
      const float be0 = w0b[chan], ba0 = a0b[chan], be1 = w0b[256 + chan], ba1 = a0b[256 + chan];
#pragma unroll
      for (int m = 0; m < 4; ++m) {
        acc[m][n][0] = 0.6065306597126334f * sigmoidf_(acc[m][n][0] + be0);
        acc[m][n][1] = sigmoidf_(acc[m][n][1] + ba0);
        acc[m][n][2] = 0.6065306597126334f * sigmoidf_(acc[m][n][2] + be1);
        acc[m][n][3] = sigmoidf_(acc[m][n][3] + ba1);
      }
    }
    const int wid = wr * 2 + wc, lane = fq * 16 + fr;
    stage_tile_bf16(acc, smem, wid, fr, fq);
    const bf16_t (*t)[72] = (const bf16_t (*)[72])(smem + wid * 9216);
#pragma unroll
    for (int i = 0; i < 8; ++i) {
      const int rl = i * 8 + (lane >> 3), ch = lane & 7;
      *(uint4*)(p.SC + (size_t)(row0 + wr * 64 + rl) * 1024 + col0 + wc * 64 + ch * 8) = *(const uint4*)&t[rl][ch * 8];
    }
  }
};
struct EpiLoraG {
  const P& p; int row0, col0;
  DEV void operator()(f32x4 (&acc)[4][4], int wr, int wc, int fr, int fq, char* smem) const {
    const int wid = wr * 2 + wc, lane = fq * 16 + fr;
    stage_tile_bf16(acc, smem, wid, fr, fq);
    const bf16_t (*t)[72] = (const bf16_t (*)[72])(smem + wid * 9216);
#pragma unroll
    for (int i = 0; i < 8; ++i) {
      const int rl = i * 8 + (lane >> 3), ch = lane & 7;
      *(uint4*)(p.Y + (size_t)(row0 + wr * 64 + rl) * D + 256 + col0 + wc * 64 + ch * 8) = *(const uint4*)&t[rl][ch * 8];
    }
  }
};
DEV void ph_lora(const P& p, int layer, char* smem) {
  int rt, ct;
  for (int it = 0; gemm_unit(it, 10, rt, ct); ++it) {
    if (ct < 8) {
      EpiLoraA epi{p, layer, rt * 128, ct * 128};
      gemm_tile(p.Z + (size_t)rt * 128 * INW + 1536, INW, p.Wlt + (size_t)ct * 128 * 256, 256, 256, smem, epi);
    } else {
      EpiLoraG epi{p, rt * 128, (ct - 8) * 128};
      gemm_tile(p.Z + (size_t)rt * 128 * INW + 1792, INW, p.Wgt + (size_t)(ct - 8) * 128 * 128, 128, 128, smem, epi);
    }
  }
}

DEV void ph_rwkv_prep(const P& p, int layer) {
  const int lane = tid_() & 63;
  int r0, r1;
  wave_range(r0, r1, NTOK);
  const float* cw = p.conv_w + (size_t)layer * 3 * 1536;
  const float* cb = p.conv_b + (size_t)layer * 1536;
  float w0[3][4], w1[3][4], w2[3][4], bb[3][4], kkw[4];
#pragma unroll
  for (int a = 0; a < 3; ++a)
#pragma unroll
    for (int i = 0; i < 4; ++i) {
      const int col = 768 + a * 256 + 4 * lane + i;
      w0[a][i] = cw[col]; w1[a][i] = cw[1536 + col]; w2[a][i] = cw[3072 + col]; bb[a][i] = cb[col];
    }
#pragma unroll
  for (int i = 0; i < 4; ++i) kkw[i] = p.rw_k_k[layer * 256 + 4 * lane + i];
  uint2 zm[3], zc[3], zp[3];
  auto ldz = [&](int row, uint2 (&z)[3]) {
#pragma unroll
    for (int a = 0; a < 3; ++a) z[a] = *(const uint2*)(p.Z + (size_t)row * INW + 768 + a * 256 + 4 * lane);
  };
  auto zero3 = [&](uint2 (&z)[3]) {
#pragma unroll
    for (int a = 0; a < 3; ++a) z[a] = make_uint2(0u, 0u);
  };
  if (r0 < r1) {
    if (r0 > 0) ldz(r0 - 1, zm); else zero3(zm);
    ldz(r0, zc);
  }
#pragma unroll 1
  for (int row = r0; row < r1; ++row) {
    if (row + 1 < NTOK) ldz(row + 1, zp); else zero3(zp);
    const int pp = row % LT;
    const bool hasm = (pp != 0) && (pp != LC);
    const bool hasp = (pp != LC - 1) && (pp != LT - 1);
    float res[3][4];
#pragma unroll
    for (int a = 0; a < 3; ++a) {
      const uint2 um = hasm ? zm[a] : make_uint2(0u, 0u), uc = zc[a], up = hasp ? zp[a] : make_uint2(0u, 0u);
      const float vm[4] = {bflo(um.x), bfhi(um.x), bflo(um.y), bfhi(um.y)};
      const float vc[4] = {bflo(uc.x), bfhi(uc.x), bflo(uc.y), bfhi(uc.y)};
      const float vp[4] = {bflo(up.x), bfhi(up.x), bflo(up.y), bfhi(up.y)};
#pragma unroll
      for (int i = 0; i < 4; ++i) res[a][i] = w0[a][i] * vm[i] + w1[a][i] * vc[i] + w2[a][i] * vp[i] + bb[a][i];
    }
    float kk[4], ss = 0.f;
#pragma unroll
    for (int i = 0; i < 4; ++i) { kk[i] = res[1][i] * kkw[i]; ss += kk[i] * kk[i]; }
    ss = row16_sum(ss);
    const float rs = rsqrtf(ss + 1e-12f);
    bf16_t* hr = p.H + (size_t)row * D + 16 * lane;
    *(uint4*)hr = make_uint4(pack2(res[0][0], res[1][0]), pack2(kk[0] * rs, res[2][0]), pack2(res[0][1], res[1][1]), pack2(kk[1] * rs, res[2][1]));
    *(uint4*)(hr + 8) = make_uint4(pack2(res[0][2], res[1][2]), pack2(kk[2] * rs, res[2][2]), pack2(res[0][3], res[1][3]), pack2(kk[3] * rs, res[2][3]));
#pragma unroll
    for (int a = 0; a < 3; ++a) { zm[a] = zc[a]; zc[a] = zp[a]; }
  }
}

DEV float oct_sum(float x) { x += dpp0<0xB1, 0xF>(x); x += dpp0<0x4E, 0xF>(x); x += dpp0<0x141, 0xF>(x); return x; }
DEV bf16x8 frag_join(uint2 lo, uint2 hi) { uint4 w = make_uint4(lo.x, lo.y, hi.x, hi.y); return __builtin_bit_cast(bf16x8, w); }
constexpr int SCS_SET = 17152, SCS_IMG = 3 * SCS_SET, SCS_W0 = SCS_IMG + 2 * 3072;
DEV void scanc_unit(const P& p, int layer, int unit, char* smem) {
  const int dir = unit & 1, h = (unit >> 1) & 3, b = unit >> 3;
  const int tid = tid_(), lane = tid & 63, fr = lane & 15, fq = lane >> 4;
  const int w = __builtin_amdgcn_readfirstlane(tid >> 6);
  bf16_t* IMG0 = (bf16_t*)(smem + SCS_W0);
  bf16_t* IMG1 = IMG0 + 512;
  bf16_t* IMG2 = IMG0 + 1024;
  __syncthreads();
  for (int i = tid; i < (2 * 3072 + 3072) / 4; i += 256) ((unsigned*)(smem + SCS_IMG))[i] = 0u;
  const float ka = p.rw_k_a[layer * 256 + h * 64 + lane];
  const size_t rowbase = (size_t)b * LT;
  const char* hbase = (const char*)p.H;
  const char* sbase = (const char*)p.SC;
  const unsigned hoff = (unsigned)(rowbase * 2048) + (unsigned)((h * 64 + lane) * 8);
  const unsigned soff = hoff + 4u * (unsigned)dir;
  bf16_t* yb = p.Z + rowbase * INW + 768 + dir * 256 + h * 64 + w * 16 + fr;
  auto pos0 = [&](int c) -> int { const int t = c * 16; return dir == 0 ? t : (t < LC ? LC - 1 - t : LT - 1 - (t - LC)); };
  const int pstep = dir == 0 ? 1 : -1;
  constexpr int NCH = LT / 16;
  struct Raw { unsigned sc[16]; uint2 hr[6]; };
  auto load_raw = [&](int c, Raw& rw) {
    if (w != 0) {
      const int p0 = pos0(c);
      const unsigned so = soff + (unsigned)(p0 * 2048);
      const int st = pstep * 2048;
#pragma unroll
      for (int i = 0; i < 16; ++i) rw.sc[i] = *(const unsigned*)(sbase + (so + (unsigned)(i * st)));
      const unsigned ho = hoff + (unsigned)((p0 + pstep * (w - 1)) * 2048);
#pragma unroll
      for (int q = 0; q < 6; ++q) {
        const int qq = ((w - 1) + 3 * q < 16) ? q : 4;
        rw.hr[q] = *(const uint2*)(hbase + (ho + (unsigned)(qq * 3 * st)));
      }
    }
  };
  auto stage1w = [&](int set, const Raw& rw, auto W1tag) {
    constexpr int W1 = decltype(W1tag)::value;
    char* base = smem + set * SCS_SET;
    bf16_t (*At)[72] = (bf16_t (*)[72])(base);
    bf16_t (*Rt)[72] = (bf16_t (*)[72])(base + 2304);
    bf16_t (*Bt)[72] = (bf16_t (*)[72])(base + 4608);
    bf16_t (*Kt)[72] = (bf16_t (*)[72])(base + 6912);
    bf16_t (*BKT)[36] = (bf16_t (*)[36])(base + 9216);
    bf16_t* VV = (bf16_t*)(base + 13824);
    float* G16 = (float*)(base + 16896);
    float Erun = 0.f;
#pragma unroll
    for (int i = 0; i < 16; ++i) {
      const float ev = bflo(rw.sc[i]);
      const float Eprev = Erun;
      Erun += ev;
      if ((i % 3) == W1) {
        const uint2 hrec = rw.hr[i / 3];
        const float rr = bflo(hrec.x), kr = bfhi(hrec.x), kkv = bflo(hrec.y);
        const float av = bfhi(rw.sc[i]);
        const float gp = __expf(-Eprev), gi = __expf(-Erun), ig = __expf(Erun);
        const float at = -kkv * gp, rt = rr * gi, bt = kkv * av * ig, kt2 = kr * (1.f + (av - 1.f) * ka) * ig;
        const unsigned ar = pack2(at, rt), bk = pack2(bt, kt2);
        At[i][lane] = (bf16_t)(ar & 0xFFFFu); Rt[i][lane] = (bf16_t)(ar >> 16);
        Bt[i][lane] = (bf16_t)(bk & 0xFFFFu); Kt[i][lane] = (bf16_t)(bk >> 16);
        BKT[lane][(i >> 2) * 8 + (i & 3)] = (bf16_t)(bk & 0xFFFFu);
        BKT[lane][(i >> 2) * 8 + 4 + (i & 3)] = (bf16_t)(bk >> 16);
        VV[((i >> 2) * 64 + lane) * 6 + (i & 3)] = (bf16_t)(hrec.y >> 16);
        if (i == 15) G16[lane] = gi;
      }
    }
  };
  auto stage1 = [&](int set, const Raw& rw) {
    if (w == 1) stage1w(set, rw, std::integral_constant<int, 0>{});
    else if (w == 2) stage1w(set, rw, std::integral_constant<int, 1>{});
    else if (w == 3) stage1w(set, rw, std::integral_constant<int, 2>{});
  };
  auto stage2 = [&](int set, int iset) {
    char* base = smem + set * SCS_SET;
    const bf16_t (*At)[72] = (const bf16_t (*)[72])(base);
    const bf16_t (*Rt)[72] = (const bf16_t (*)[72])(base + 2304);
    const bf16_t (*Bt)[72] = (const bf16_t (*)[72])(base + 4608);
    const bf16_t (*Kt)[72] = (const bf16_t (*)[72])(base + 6912);
    bf16_t* TT = (bf16_t*)(smem + SCS_IMG + iset * 3072);
    bf16_t* ARK = TT + 512;
    bf16_t* AAK = TT + 1024;
    const bf16_t (*X)[72] = (w < 2) ? At : Rt;
    const bf16_t (*Y)[72] = (w & 1) ? Kt : Bt;
    f32x4 cm = (f32x4){0.f, 0.f, 0.f, 0.f};
#pragma unroll
    for (int s = 0; s < 2; ++s) {
      bf16x8 af = *(const bf16x8*)&X[fr][32 * s + 8 * fq];
      bf16x8 bm = *(const bf16x8*)&Y[fr][32 * s + 8 * fq];
      cm = mfma16(af, bm, cm);
    }
#pragma unroll
    for (int jj = 0; jj < 4; ++jj) {
      const int i = 4 * fq + jj;
      const bool keep = (w < 2) ? (fr < i) : (fr <= i);
      cm[jj] = keep ? cm[jj] : 0.f;
    }
    const int io = (fr >> 2) * 8 + (fr & 3);
    auto wr_img = [&](bf16_t* img, const f32x4& Xv, int hi) {
#pragma unroll
      for (int jj = 0; jj < 4; ++jj) img[(4 * fq + jj) * 32 + io + hi] = f2bf(Xv[jj]);
    };
    if (w == 1) wr_img(AAK, cm, 0);
    else if (w == 2) wr_img(ARK, cm, 0);
    else if (w == 3) wr_img(ARK, cm, 4);
    else {
      auto bfrag = [&](const f32x4& Xv) { return frag_join(make_uint2(pack2(Xv[0], Xv[1]), pack2(Xv[2], Xv[3])), make_uint2(0u, 0u)); };
      auto afr = [&](const bf16_t* img) { return *(const bf16x8*)&img[(fr * 4 + fq) * 8]; };
      const f32x4 Z4 = (f32x4){0.f, 0.f, 0.f, 0.f};
      wr_img(IMG0, cm, 0);
      asm volatile("" ::: "memory");
      f32x4 A2 = mfma16(afr(IMG0), bfrag(cm), Z4);
      wr_img(IMG1, A2, 0);
      asm volatile("" ::: "memory");
      f32x4 A4 = mfma16(afr(IMG1), bfrag(A2), Z4);
      wr_img(IMG2, A4, 0);
      asm volatile("" ::: "memory");
      f32x4 Rm = mfma16(afr(IMG2), bfrag(A4), Z4);
#pragma unroll
      for (int jj = 0; jj < 4; ++jj) Rm[jj] += (fr == 4 * fq + jj) ? 1.f : 0.f;
      Rm = mfma16(afr(IMG2), bfrag(Rm), Rm);
      Rm = mfma16(afr(IMG1), bfrag(Rm), Rm);
      Rm = mfma16(afr(IMG0), bfrag(Rm), Rm);
      wr_img(TT, Rm, 0);
    }
  };
  f32x4 acc[4];
#pragma unroll
  for (int kt = 0; kt < 4; ++kt) acc[kt] = (f32x4){0.f, 0.f, 0.f, 0.f};
  auto part2 = [&](int c, int set, int iset) {
    char* base = smem + set * SCS_SET;
    const bf16_t (*At)[72] = (const bf16_t (*)[72])(base);
    const bf16_t (*Rt)[72] = (const bf16_t (*)[72])(base + 2304);
    const bf16_t (*BKT)[36] = (const bf16_t (*)[36])(base + 9216);
    const bf16_t* VV = (const bf16_t*)(base + 13824);
    const float* G16 = (const float*)(base + 16896);
    const bf16_t* TT = (const bf16_t*)(smem + SCS_IMG + iset * 3072);
    const bf16_t* ARK = TT + 512;
    const bf16_t* AAK = TT + 1024;
    bf16x8 Sb[2];
#pragma unroll
    for (int s = 0; s < 2; ++s) {
      uint4 t = make_uint4(pack2(acc[2 * s][0], acc[2 * s][1]), pack2(acc[2 * s][2], acc[2 * s][3]),
                           pack2(acc[2 * s + 1][0], acc[2 * s + 1][1]), pack2(acc[2 * s + 1][2], acc[2 * s + 1][3]));
      Sb[s] = __builtin_bit_cast(bf16x8, t);
    }
    const unsigned* vvp = (const unsigned*)&VV[(fq * 64 + w * 16 + fr) * 6];
    const uint2 vv = make_uint2(vvp[0], vvp[1]);
    const bf16x8 Vlow = frag_join(vv, make_uint2(0u, 0u));
    f32x4 Pm = (f32x4){0.f, 0.f, 0.f, 0.f};
#pragma unroll
    for (int s = 0; s < 2; ++s) {
      bf16x8 af = frag_join(*(const uint2*)&At[fr][32 * s + 4 * fq], *(const uint2*)&At[fr][32 * s + 16 + 4 * fq]);
      Pm = mfma16(af, Sb[s], Pm);
    }
    Pm = mfma16(*(const bf16x8*)&AAK[(fr * 4 + fq) * 8], Vlow, Pm);
    const bf16x8 Pb = frag_join(make_uint2(pack2(Pm[0], Pm[1]), pack2(Pm[2], Pm[3])), make_uint2(0u, 0u));
    f32x4 U = mfma16(*(const bf16x8*)&TT[(fr * 4 + fq) * 8], Pb, (f32x4){0.f, 0.f, 0.f, 0.f});
    const bf16x8 UV = frag_join(make_uint2(pack2(U[0], U[1]), pack2(U[2], U[3])), vv);
    f32x4 Yv = (f32x4){0.f, 0.f, 0.f, 0.f};
#pragma unroll
    for (int s = 0; s < 2; ++s) {
      bf16x8 af = frag_join(*(const uint2*)&Rt[fr][32 * s + 4 * fq], *(const uint2*)&Rt[fr][32 * s + 16 + 4 * fq]);
      Yv = mfma16(af, Sb[s], Yv);
    }
    Yv = mfma16(*(const bf16x8*)&ARK[(fr * 4 + fq) * 8], UV, Yv);
    {
      const int p0 = pos0(c);
#pragma unroll
      for (int jj = 0; jj < 4; ++jj) yb[(size_t)(p0 + pstep * (4 * fq + jj)) * INW] = f2bf(Yv[jj]);
    }
#pragma unroll
    for (int kt = 0; kt < 4; ++kt) {
      f32x4 t = mfma16(frag_join(*(const uint2*)&BKT[16 * kt + fr][fq * 8], *(const uint2*)&BKT[16 * kt + fr][fq * 8 + 4]), UV, acc[kt]);
      const float4 g4 = *(const float4*)&G16[16 * kt + 4 * fq];
      t[0] *= g4.x; t[1] *= g4.y; t[2] *= g4.z; t[3] *= g4.w;
      acc[kt] = t;
    }
  };
  __builtin_amdgcn_s_setprio(3);
  Raw r0, r1;
  load_raw(0, r0); load_raw(1, r1);
  stage1(0, r0);
  load_raw(2, r0);
  __syncthreads();
  stage2(0, 0);
  stage1(1, r1);
  load_raw(3, r1);
  __syncthreads();
  int s0 = 0, s1 = 1, s2 = 2;
  auto iter = [&](int c, Raw& rw) {
    if (c + 1 < NCH) stage2(s1, (c + 1) & 1);
    part2(c, s0, c & 1);
    if (c + 2 < NCH) {
      stage1(s2, rw);
      if (c + 4 < NCH) load_raw(c + 4, rw);
    }
    asm volatile("s_waitcnt lgkmcnt(0)" ::: "memory");
    __builtin_amdgcn_s_barrier();
    asm volatile("" ::: "memory");
    const int t = s0; s0 = s1; s1 = s2; s2 = t;
  };
#pragma unroll 1
  for (int c = 0; c < NCH; c += 2) {
    iter(c, r0); iter(c + 1, r1);
  }
  __builtin_amdgcn_s_setprio(0);
}

DEV void ph_rwkv_post(const P& p, int layer) {
  const int lane = tid_() & 63;
  int r0, r1;
  wave_range(r0, r1, NTOK);
  const int ch = 4 * lane;
  float kav[4], rkv[4], lnw[4], lnb[4];
#pragma unroll
  for (int i = 0; i < 4; ++i) {
    kav[i] = p.rw_k_a[layer * 256 + ch + i]; rkv[i] = p.rw_r_k[layer * 256 + ch + i];
    lnw[i] = p.rw_ln_w[layer * 256 + ch + i]; lnb[i] = p.rw_ln_b[layer * 256 + ch + i];
  }
  struct In { uint2 y0, y1, g; uint4 h0, h1, s0, s1; };
  auto ld = [&](int row, In& in) {
    const bf16_t* zr = p.Z + (size_t)row * INW + 768 + ch;
    in.y0 = *(const uint2*)zr; in.y1 = *(const uint2*)(zr + 256);
    const bf16_t* hr = p.H + (size_t)row * D + 4 * ch;
    in.h0 = *(const uint4*)hr; in.h1 = *(const uint4*)(hr + 8);
    const bf16_t* sr = p.SC + (size_t)row * 1024 + 4 * ch;
    in.s0 = *(const uint4*)sr; in.s1 = *(const uint4*)(sr + 8);
    in.g = *(const uint2*)(p.Y + (size_t)row * D + 256 + ch);
  };
  In nx;
  if (r0 < r1) ld(r0, nx);
#pragma unroll 1
  for (int row = r0; row < r1; ++row) {
    const In in = nx;
    if (row + 1 < r1) ld(row + 1, nx);
    float y[4] = {bflo(in.y0.x) + bflo(in.y1.x), bfhi(in.y0.x) + bfhi(in.y1.x), bflo(in.y0.y) + bflo(in.y1.y), bfhi(in.y0.y) + bfhi(in.y1.y)};
    const float mu = row16_sum(y[0] + y[1] + y[2] + y[3]) * (1.f / 64.f);
    float vs = 0.f;
#pragma unroll
    for (int i = 0; i < 4; ++i) { y[i] -= mu; vs += y[i] * y[i]; }
    const float var = row16_sum(vs) * (1.f / 64.f);
    const float rstd = rsqrtf(var + 64e-5f);
    const float r[4] = {bflo(in.h0.x), bflo(in.h0.z), bflo(in.h1.x), bflo(in.h1.z)};
    const float k[4] = {bfhi(in.h0.x), bfhi(in.h0.z), bfhi(in.h1.x), bfhi(in.h1.z)};
    const float v[4] = {bfhi(in.h0.y), bfhi(in.h0.w), bfhi(in.h1.y), bfhi(in.h1.w)};
    const float a0[4] = {bfhi(in.s0.x), bfhi(in.s0.z), bfhi(in.s1.x), bfhi(in.s1.z)};
    const float a1[4] = {bfhi(in.s0.y), bfhi(in.s0.w), bfhi(in.s1.y), bfhi(in.s1.w)};
    float sd = 0.f;
#pragma unroll
    for (int i = 0; i < 4; ++i) {
      const float kd0 = k[i] * (1.f + (a0[i] - 1.f) * kav[i]), kd1 = k[i] * (1.f + (a1[i] - 1.f) * kav[i]);
      sd += r[i] * (kd0 + kd1) * rkv[i];
    }
    sd = row16_sum(sd);
    const float g[4] = {bflo(in.g.x), bfhi(in.g.x), bflo(in.g.y), bfhi(in.g.y)};
    float o[4];
#pragma unroll
    for (int i = 0; i < 4; ++i) {
      const float yn = y[i] * rstd * lnw[i] + lnb[i];
      o[i] = (yn + sd * v[i]) * g[i];
    }
    *(uint2*)(p.Y + (size_t)row * D + 256 + ch) = make_uint2(pack2(o[0], o[1]), pack2(o[2], o[3]));
  }
}

DEV void hyena_pre_unit(const P& p, int layer, int unit) {
  int kind, b, t0, L;
  if (unit < 1024) { kind = 0; b = unit >> 6; t0 = (unit & 63) * 64; L = T; } else { int u = unit - 1024; kind = 1; b = u >> 2; t0 = (u & 3) * 64; L = LC; }
  const int c = tid_();
  const size_t row0 = (size_t)b * LT + (kind ? 0 : LC);
  const float* cw = p.conv_w + (size_t)layer * 3 * 1536;
  const float* cb = p.conv_b + (size_t)layer * 1536;
  const float w1a = cw[256 + c], w1b = cw[1536 + 256 + c], w1c = cw[3072 + 256 + c], b1 = cb[256 + c];
  const float w2a = cw[512 + c], w2b = cw[1536 + 512 + c], w2c = cw[3072 + 512 + c], b2 = cb[512 + c];
  auto ld = [&](int t, int col) -> float { return (t >= 0 && t < L) ? bf2f(p.Z[(row0 + t) * INW + col]) : 0.f; };
  float x1m = ld(t0 - 1, 256 + c), x1c = ld(t0, 256 + c), vm = ld(t0 - 1, 512 + c), vc = ld(t0, 512 + c);
  bf16_t* dst = (kind ? opq(p.UTc) : opq(p.UTl)) + ((size_t)c * 16 + b) * L + t0;
#pragma unroll 1
  for (int i8 = 0; i8 < 8; ++i8) {
    float uo[8];
#pragma unroll
    for (int i = 0; i < 8; ++i) {
      int t = t0 + i8 * 8 + i;
      float x1n = ld(t + 1, 256 + c), vn = ld(t + 1, 512 + c);
      float a = w1a * x1m + w1b * x1c + w1c * x1n + b1;
      float bb = w2a * vm + w2b * vc + w2c * vn + b2;
      uo[i] = a * bb;
      x1m = x1c; x1c = x1n; vm = vc; vc = vn;
    }
    *(uint4*)(dst + 8 * i8) = pack8(uo);
  }
}

DEV void hyena_conv_unit(const P& p, int layer, int unit, char* smem) {
  int kind, c, tb, L;
  if (unit < 4096) { kind = 0; c = unit >> 4; tb = (unit & 15) * 256; L = T; } else { kind = 1; c = unit - 4096; tb = 0; L = LC; }
  const int tid = tid_(), lane = tid & 63, wid = tid >> 6, fr = lane & 15, fq = lane >> 4;
  float* red = (float*)(smem + 2 * 16512);
  const float* F = (kind ? opq(p.FC) : opq(p.FL)) + (size_t)c * 2 * L;
  float scale;
  {
    float part = 0.f;
    for (int i = tid; i < 2 * L; i += 256) { float fv = F[i]; part += (i != L) ? fv * fv : 0.f; }
    part = wave_sum(part);
    __syncthreads();
    if (lane == 0) red[wid] = part;
    __syncthreads();
    scale = rsqrtf(((red[0] + red[1]) + (red[2] + red[3])) + 1e-6f);
  }
  const bf16_t* U = (kind ? opq(p.UTc) : opq(p.UTl)) + (size_t)c * 16 * L;
  f32x4 acc[4];
#pragma unroll
  for (int m = 0; m < 4; ++m) acc[m] = (f32x4){0.f, 0.f, 0.f, 0.f};
  const int nch = L / 256;
  float fw0, fw1, fw2;
  uint4 ru0, ru1;
  auto ldchunk = [&](int ch) {
    const int sc = ch * 256;
    const int D0 = tb + 256 - sc;
    auto tap = [&](int n) -> float {
      int d = D0 - n;
      float v = 0.f;
      if (d > -L && d < L) v = (d >= 0 ? F[d] : F[L - d]);
      return v;
    };
    fw0 = tap(tid); fw1 = tap(tid + 256); fw2 = (tid < 8) ? tap(tid + 512) : 0.f;
    const int bb = tid >> 4, sg0 = tid & 15;
    ru0 = *(const uint4*)(U + (size_t)bb * L + sc + 8 * sg0);
    ru1 = *(const uint4*)(U + (size_t)bb * L + sc + 8 * (sg0 + 16));
  };
  auto stchunk = [&](int buf) {
    bf16_t* Cq = (bf16_t*)(smem + buf * 16512);
    bf16_t* Us = (bf16_t*)(smem + buf * 16512 + 8320);
    const bf16_t h0 = f2bf(fw0 * scale), h1 = f2bf(fw1 * scale), h2 = f2bf(fw2 * scale);
#pragma unroll
    for (int rho = 0; rho < 8; ++rho) {
      int m = tid + rho;
      Cq[((m >> 3) * 8 + rho) * 8 + (m & 7)] = h0;
      m = tid + 256 + rho;
      if (m < 520) Cq[((m >> 3) * 8 + rho) * 8 + (m & 7)] = h1;
      m = tid + 512 + rho;
      if (tid < 8 && m < 520) Cq[((m >> 3) * 8 + rho) * 8 + (m & 7)] = h2;
    }
    if (tid < 8) {
#pragma unroll
      for (int rho = 1; rho < 8; ++rho) if (tid < rho) Cq[(rho) * 8 + tid] = 0;
    }
    const int bb = tid >> 4, sg0 = tid & 15;
    *(uint4*)&Us[(sg0 * 16 + bb) * 8] = ru0;
    *(uint4*)&Us[((sg0 + 16) * 16 + bb) * 8] = ru1;
  };
  ldchunk(0);
#pragma unroll 1
  for (int ch = 0; ch < nch; ++ch) {
    const int buf = ch & 1;
    stchunk(buf);
    __syncthreads();
    if (ch + 1 < nch) ldchunk(ch + 1);
    const bf16_t* Cq = (const bf16_t*)(smem + buf * 16512);
    const bf16_t* Us = (const bf16_t*)(smem + buf * 16512 + 8320);
#pragma unroll
    for (int kk = 0; kk < 8; ++kk) {
      bf16x8 bf = *(const bf16x8*)&Us[((4 * kk + fq) * 16 + fr) * 8];
#pragma unroll
      for (int m = 0; m < 4; ++m) {
        int it = wid * 4 + m;
        int base = 256 - 16 * it + 32 * kk + 8 * fq;
        int m0 = base - 8 * (fr >> 3);
        bf16x8 af = *(const bf16x8*)&Cq[((m0 >> 3) * 8 + (fr & 7)) * 8];
        acc[m] = mfma16(af, bf, acc[m]);
      }
    }
  }
  __syncthreads();
  bf16_t* Yt = (kind ? opq(p.YTc) : opq(p.YTl)) + ((size_t)c * 16 + fr) * L + tb;
#pragma unroll
  for (int m = 0; m < 4; ++m) {
    int t = (wid * 4 + m) * 16 + fq * 4;
    *(uint2*)(Yt + t) = make_uint2(pack2(acc[m][0], acc[m][1]), pack2(acc[m][2], acc[m][3]));
  }
}

DEV void hyena_post_unit(const P& p, int layer, int unit, char* smem) {
  int kind, b, t0, L;
  if (unit < 1024) { kind = 0; b = unit >> 6; t0 = (unit & 63) * 64; L = T; } else { int u = unit - 1024; kind = 1; b = u >> 2; t0 = (u & 3) * 64; L = LC; }
  const int c = tid_(), lane = c & 63, wid = c >> 6;
  const size_t row0 = (size_t)b * LT + (kind ? 0 : LC);
  bf16_t (*tile)[264] = (bf16_t (*)[264])smem;
  const float* cw = p.conv_w + (size_t)layer * 3 * 1536;
  const float wa = cw[c], wb = cw[1536 + c], wcc = cw[3072 + c], b0 = p.conv_b[layer * 1536 + c];
  const float bias = p.hy_bias[layer * 256 + c];
  const bf16_t* yt = (kind ? opq(p.YTc) : opq(p.YTl)) + ((size_t)c * 16 + b) * L + t0;
  const bf16_t* ut = (kind ? opq(p.UTc) : opq(p.UTl)) + ((size_t)c * 16 + b) * L + t0;
  auto ld = [&](int t) -> float { return (t >= 0 && t < L) ? bf2f(p.Z[(row0 + t) * INW + c]) : 0.f; };
  float xm = ld(t0 - 1), xc = ld(t0);
  __syncthreads();
#pragma unroll 1
  for (int i8 = 0; i8 < 8; ++i8) {
    uint4 yu = *(const uint4*)(yt + 8 * i8), uu = *(const uint4*)(ut + 8 * i8);
    float yv[8], uv[8];
    unpack8(yu, yv); unpack8(uu, uv);
#pragma unroll
    for (int i = 0; i < 8; ++i) {
      int t = t0 + i8 * 8 + i;
      float xn = ld(t + 1);
      float x0 = wa * xm + wb * xc + wcc * xn + b0;
      float o = x0 * (yv[i] + uv[i] * bias);
      tile[i8 * 8 + i][c] = f2bf(o);
      xm = xc; xc = xn;
    }
  }
  __syncthreads();
  for (int i = 0; i < 16; ++i) {
    int tl = wid * 16 + i;
    uint2 ou = *(const uint2*)&tile[tl][4 * lane];
    float o[4] = {bflo(ou.x), bfhi(ou.x), bflo(ou.y), bfhi(ou.y)};
    float ss = wave_sum(o[0] * o[0] + o[1] * o[1] + o[2] * o[2] + o[3] * o[3]);
    float rstd = rsqrtf(ss * (1.f / 256.f) + 1e-6f);
#pragma unroll
    for (int q = 0; q < 4; ++q) {
      o[q] = o[q] * rstd * p.hy_out_g[layer * 256 + 4 * lane + q];
    }
    *(uint2*)(p.Y + (row0 + t0 + tl) * D + 4 * lane) = make_uint2(pack2(o[0], o[1]), pack2(o[2], o[3]));
  }
}

DEV void attn_unit(const P& p, int layer, int unit, char* smem) {
  const bool isctx = unit >= 4096;
  int b, qb, hq;
  if (!isctx) { b = unit >> 8; qb = (unit >> 3) & 31; hq = unit & 7; } else { int u = unit - 4096; b = u >> 4; qb = (u >> 3) & 1; hq = u & 7; }
  const int g = hq >> 2;
  const int tid = tid_(), lane = tid & 63, wid = tid >> 6, qn = lane & 31, hh = lane >> 5;
  const int qpos = qb * 128 + wid * 32 + qn;
  const size_t qrow = (size_t)b * LT + (isctx ? qpos : LC + qpos);
  const bf16_t* qptr = p.Z + qrow * INW + 1920 + hq * 64;
  bf16x8 qf[4];
#pragma unroll
  for (int s = 0; s < 4; ++s) qf[s] = *(const bf16x8*)(qptr + 16 * s + 8 * hh);
  const float sink = p.attn_sink[layer * 8 + hq];
  float m_run = sink, l_run = 1.f;
  f32x16 o0, o1;
#pragma unroll
  for (int i = 0; i < 16; ++i) { o0[i] = 0.f; o1[i] = 0.f; }
  typedef bf16_t KTile[64][72];
  KTile* Ks = (KTile*)smem;
  KTile* Vt = (KTile*)(smem + 18432);
  const int ntl = isctx ? 0 : 6;
  const int ntiles = ntl + 4;
  const int skey = tid >> 3, sseg = tid & 7;
  const bf16_t* kvbase = p.Z + (size_t)b * LT * INW + 1920 + 512 + g * 64 + sseg * 8;
  uint4 rk0, rk1, rv0, rv1;
  auto ldtile = [&](int kt) {
    const bool ctxk = kt >= ntl;
    const int kbase = ctxk ? (kt - ntl) * 64 : qb * 128 - 128 + kt * 64;
    const int kp0 = kbase + skey, kp1 = kp0 + 32;
    rk0 = rk1 = rv0 = rv1 = make_uint4(0, 0, 0, 0);
    if (ctxk || (kp0 >= 0 && kp0 < T)) { const bf16_t* src = kvbase + (size_t)(ctxk ? kp0 : LC + kp0) * INW; rk0 = *(const uint4*)src; rv0 = *(const uint4*)(src + 128); }
    if (ctxk || (kp1 >= 0 && kp1 < T)) { const bf16_t* src = kvbase + (size_t)(ctxk ? kp1 : LC + kp1) * INW; rk1 = *(const uint4*)src; rv1 = *(const uint4*)(src + 128); }
  };
  auto sttile = [&](int buf) {
    *(uint4*)&Ks[buf][skey][sseg * 8] = rk0;
    *(uint4*)&Ks[buf][skey + 32][sseg * 8] = rk1;
    bf16_t (*vt)[72] = Vt[buf];
    vt[sseg * 8 + 0][skey] = (bf16_t)(rv0.x & 0xFFFF); vt[sseg * 8 + 1][skey] = (bf16_t)(rv0.x >> 16);
    vt[sseg * 8 + 2][skey] = (bf16_t)(rv0.y & 0xFFFF); vt[sseg * 8 + 3][skey] = (bf16_t)(rv0.y >> 16);
    vt[sseg * 8 + 4][skey] = (bf16_t)(rv0.z & 0xFFFF); vt[sseg * 8 + 5][skey] = (bf16_t)(rv0.z >> 16);
    vt[sseg * 8 + 6][skey] = (bf16_t)(rv0.w & 0xFFFF); vt[sseg * 8 + 7][skey] = (bf16_t)(rv0.w >> 16);
    vt[sseg * 8 + 0][skey + 32] = (bf16_t)(rv1.x & 0xFFFF); vt[sseg * 8 + 1][skey + 32] = (bf16_t)(rv1.x >> 16);
    vt[sseg * 8 + 2][skey + 32] = (bf16_t)(rv1.y & 0xFFFF); vt[sseg * 8 + 3][skey + 32] = (bf16_t)(rv1.y >> 16);
    vt[sseg * 8 + 4][skey + 32] = (bf16_t)(rv1.z & 0xFFFF); vt[sseg * 8 + 5][skey + 32] = (bf16_t)(rv1.z >> 16);
    vt[sseg * 8 + 6][skey + 32] = (bf16_t)(rv1.w & 0xFFFF); vt[sseg * 8 + 7][skey + 32] = (bf16_t)(rv1.w >> 16);
  };
  ldtile(0);
#pragma unroll 1
  for (int kt = 0; kt < ntiles; ++kt) {
    const int buf = kt & 1;
    sttile(buf);
    __syncthreads();
    if (kt + 1 < ntiles) ldtile(kt + 1);
    const bool ctxk = kt >= ntl;
    const int kbase = ctxk ? (kt - ntl) * 64 : qb * 128 - 128 + kt * 64;
#pragma unroll
    for (int sub = 0; sub < 2; ++sub) {
      const int kb2 = kbase + sub * 32;
      bool need = true;
      if (!ctxk) {
        int q0 = qb * 128 + wid * 32;
        if (kb2 + 31 < q0 - 128 || kb2 > q0 + 31 + 128 || kb2 + 31 < 0 || kb2 >= T) need = false;
      }
      if (need) {
        f32x16 sv;
#pragma unroll
        for (int i = 0; i < 16; ++i) sv[i] = 0.f;
#pragma unroll
        for (int ks = 0; ks < 4; ++ks) {
          bf16x8 kf = *(const bf16x8*)&Ks[buf][sub * 32 + qn][16 * ks + 8 * hh];
          sv = mfma32(kf, qf[ks], sv);
        }
        float mt = -3e38f;
#pragma unroll
        for (int rg = 0; rg < 16; ++rg) {
          float v = sv[rg] * 0.125f;
          if (!ctxk) {
            int kp = kb2 + (rg & 3) + 8 * (rg >> 2) + 4 * hh;
            int dl = qpos - kp;
            bool ok = (dl <= 128) && (dl >= -128) && (kp >= 0) && (kp < T);
            v = ok ? v : -1e30f;
          }
          sv[rg] = v;
          mt = fmaxf(mt, v);
        }
        mt = fmaxf(mt, __shfl_xor(mt, 32));
        float m_new = fmaxf(m_run, mt);
        float corr = __expf(m_run - m_new);
        float ps = 0.f;
#pragma unroll
        for (int rg = 0; rg < 16; ++rg) { float pv = __expf(sv[rg] - m_new); sv[rg] = pv; ps += pv; }
        ps += __shfl_xor(ps, 32);
        l_run = l_run * corr + ps;
        m_run = m_new;
#pragma unroll
        for (int i = 0; i < 16; ++i) { o0[i] *= corr; o1[i] *= corr; }
#pragma unroll
        for (int sp = 0; sp < 2; ++sp) {
          bf16x8 pf;
#pragma unroll
          for (int j = 0; j < 8; ++j) pf[j] = (short)f2bf(sv[8 * sp + j]);
          const int kc = sub * 32 + 16 * sp + 4 * hh;
          uint2 va = *(const uint2*)&Vt[buf][qn][kc], vb = *(const uint2*)&Vt[buf][qn][kc + 8];
          uint2 vc = *(const uint2*)&Vt[buf][32 + qn][kc], vd = *(const uint2*)&Vt[buf][32 + qn][kc + 8];
          uint4 w0 = make_uint4(va.x, va.y, vb.x, vb.y), w1 = make_uint4(vc.x, vc.y, vd.x, vd.y);
          bf16x8 v0 = __builtin_bit_cast(bf16x8, w0), v1 = __builtin_bit_cast(bf16x8, w1);
          o0 = mfma32(v0, pf, o0);
          o1 = mfma32(v1, pf, o1);
        }
      }
    }
  }
  __syncthreads();
  const float inv = 1.f / l_run;
  bf16_t* optr = p.Y + qrow * D + 512 + hq * 64;
#pragma unroll
  for (int rg = 0; rg < 4; ++rg) {
    int d0 = 8 * rg + 4 * hh;
    *(uint2*)(optr + d0) = make_uint2(pack2(o0[4 * rg] * inv, o0[4 * rg + 1] * inv), pack2(o0[4 * rg + 2] * inv, o0[4 * rg + 3] * inv));
    *(uint2*)(optr + 32 + d0) = make_uint2(pack2(o1[4 * rg] * inv, o1[4 * rg + 1] * inv), pack2(o1[4 * rg + 2] * inv, o1[4 * rg + 3] * inv));
  }
}

DEV void ph_attn_post(const P& p, int layer) {
  const int lane = tid_() & 63;
  int r0, r1;
  wave_range(r0, r1, NTOK);
  float gv[8];
#pragma unroll
  for (int i = 0; i < 8; ++i) gv[i] = p.at_out_g[layer * 512 + 8 * lane + i];
  uint4 nx = make_uint4(0, 0, 0, 0);
  if (r0 < r1) nx = *(const uint4*)(p.Y + (size_t)r0 * D + 512 + 8 * lane);
#pragma unroll 1
  for (int row = r0; row < r1; ++row) {
    const uint4 u = nx;
    if (row + 1 < r1) nx = *(const uint4*)(p.Y + (size_t)(row + 1) * D + 512 + 8 * lane);
    float v[8];
    unpack8(u, v);
    float ss = 0.f;
#pragma unroll
    for (int i = 0; i < 8; ++i) ss += v[i] * v[i];
    ss = wave_sum(ss);
    const float rstd = rsqrtf(ss * (1.f / 512.f) + 1e-6f);
#pragma unroll
    for (int i = 0; i < 8; ++i) {
      v[i] = v[i] * rstd * gv[i];
    }
    *(uint4*)(p.Y + (size_t)row * D + 512 + 8 * lane) = pack8(v);
  }
}

struct Epi2 {
  const P& p; int layer, row0, col0;
  DEV void operator()(f32x4 (&acc)[4][4], int wr, int wc, int fr, int fq, char* smem) const {
    const int b = row0 / LT, pp = row0 % LT;
    const int mr = pp < LC ? 16 : b;
    const float* g1 = p.modv + ((size_t)layer * 17 + mr) * 6144 + 2048 + col0 + wc * 64;
#pragma unroll
    for (int n = 0; n < 4; ++n) {
      const float4 gv = *(const float4*)(g1 + n * 16 + 4 * fq);
#pragma unroll
      for (int m = 0; m < 4; ++m) { acc[m][n][0] *= gv.x; acc[m][n][1] *= gv.y; acc[m][n][2] *= gv.z; acc[m][n][3] *= gv.w; }
    }
    const int wid = wr * 2 + wc, lane = fq * 16 + fr;
    stage_tile_bf16(acc, smem, wid, fr, fq);
    const bf16_t (*t)[72] = (const bf16_t (*)[72])(smem + wid * 9216);
#pragma unroll
    for (int i = 0; i < 8; ++i) {
      const int rl = i * 8 + (lane >> 3), ch = lane & 7;
      bf16_t* xp = p.X + (size_t)(row0 + wr * 64 + rl) * D + col0 + wc * 64 + ch * 8;
      float xv[8], dv[8];
      uint4 xu = *(const uint4*)xp, du = *(const uint4*)&t[rl][ch * 8];
      unpack8(xu, xv); unpack8(du, dv);
#pragma unroll
      for (int q = 0; q < 8; ++q) xv[q] += dv[q];
      *(uint4*)xp = pack8(xv);
    }
  }
};
DEV void ph_gemm2(const P& p, int layer, char* smem) {
  int rt, ct;
  for (int it = 0; gemm_unit(it, 8, rt, ct); ++it) {
    Epi2 epi{p, layer, rt * 128, ct * 128};
    gemm_tile(p.Y + (size_t)rt * 128 * D, D, p.W2t + (size_t)ct * 128 * D, D, D, smem, epi);
  }
}

DEV void ph_peerconv(const P& p, int layer) {
  const int gw = (bid_() * 256 + tid_()) >> 6, nw = gridDim.x * 4, lane = tid_() & 63;
  const float* su = opq(p.peer_u) + (size_t)layer * 16384 * 1024;
  const float* sv = opq(p.peer_v) + (size_t)layer * 16384 * 1024;
  unsigned char* pu = opq(p.PU); unsigned char* pv = opq(p.PV);
  float* psu = opq(p.PSU); float* psv = opq(p.PSV);
  auto ldrow = [&](int r, float4& a0, float4& a1, float4& a2, float4& a3) {
    const float* src = ((r >= 16384) ? sv : su) + (size_t)(r & 16383) * 1024 + 16 * lane;
    a0 = *(const float4*)src; a1 = *(const float4*)(src + 4); a2 = *(const float4*)(src + 8); a3 = *(const float4*)(src + 12);
  };
  float4 n0 = make_float4(0, 0, 0, 0), n1 = n0, n2 = n0, n3 = n0;
  if (gw < 32768) ldrow(gw, n0, n1, n2, n3);
#pragma unroll 1
  for (int r = gw; r < 32768; r += nw) {
    const bool isv = r >= 16384;
    const int e = r & 16383;
    const float4 f0 = n0, f1 = n1, f2 = n2, f3 = n3;
    if (r + nw < 32768) ldrow(r + nw, n0, n1, n2, n3);
    float am = fmaxf(fmaxf(fmaxf(fabsf(f0.x), fabsf(f0.y)), fmaxf(fabsf(f0.z), fabsf(f0.w))), fmaxf(fmaxf(fabsf(f1.x), fabsf(f1.y)), fmaxf(fabsf(f1.z), fabsf(f1.w))));
    am = fmaxf(am, fmaxf(fmaxf(fmaxf(fabsf(f2.x), fabsf(f2.y)), fmaxf(fabsf(f2.z), fabsf(f2.w))), fmaxf(fmaxf(fabsf(f3.x), fabsf(f3.y)), fmaxf(fabsf(f3.z), fabsf(f3.w)))));
    am = wave_max(am);
    int w0, w1, w2, w3;
    float inv;
    if (isv) {
      const float sc = am > 0.f ? 224.f / am : 1.f;
      inv = am > 0.f ? am * (1.f / 224.f) : 1.f;
      w0 = __builtin_amdgcn_cvt_pk_fp8_f32(f0.x * sc, f0.y * sc, 0, false); w0 = __builtin_amdgcn_cvt_pk_fp8_f32(f0.z * sc, f0.w * sc, w0, true);
      w1 = __builtin_amdgcn_cvt_pk_fp8_f32(f1.x * sc, f1.y * sc, 0, false); w1 = __builtin_amdgcn_cvt_pk_fp8_f32(f1.z * sc, f1.w * sc, w1, true);
      w2 = __builtin_amdgcn_cvt_pk_fp8_f32(f2.x * sc, f2.y * sc, 0, false); w2 = __builtin_amdgcn_cvt_pk_fp8_f32(f2.z * sc, f2.w * sc, w2, true);
      w3 = __builtin_amdgcn_cvt_pk_fp8_f32(f3.x * sc, f3.y * sc, 0, false); w3 = __builtin_amdgcn_cvt_pk_fp8_f32(f3.z * sc, f3.w * sc, w3, true);
    } else {
      const float sc = am > 0.f ? 127.f / am : 1.f;
      inv = am > 0.f ? am * (1.f / 127.f) : 1.f;
      w0 = pack_i8(f0.x * sc, f0.y * sc, f0.z * sc, f0.w * sc); w1 = pack_i8(f1.x * sc, f1.y * sc, f1.z * sc, f1.w * sc);
      w2 = pack_i8(f2.x * sc, f2.y * sc, f2.z * sc, f2.w * sc); w3 = pack_i8(f3.x * sc, f3.y * sc, f3.z * sc, f3.w * sc);
    }
    *(uint4*)((isv ? pv : pu) + (size_t)(lane >> 3) * PSLICE + (size_t)e * 128 + 16 * (lane & 7)) = make_uint4((unsigned)w0, (unsigned)w1, (unsigned)w2, (unsigned)w3);
    if (lane == 0) (isv ? psv : psu)[e] = inv;
  }
}
DEV void unpack16_fp8x2(const uint4& u, f32x2* f) {
  f[0] = __builtin_amdgcn_cvt_pk_f32_fp8((int)u.x, false); f[1] = __builtin_amdgcn_cvt_pk_f32_fp8((int)u.x, true);
  f[2] = __builtin_amdgcn_cvt_pk_f32_fp8((int)u.y, false); f[3] = __builtin_amdgcn_cvt_pk_f32_fp8((int)u.y, true);
  f[4] = __builtin_amdgcn_cvt_pk_f32_fp8((int)u.z, false); f[5] = __builtin_amdgcn_cvt_pk_f32_fp8((int)u.z, true);
  f[6] = __builtin_amdgcn_cvt_pk_f32_fp8((int)u.w, false); f[7] = __builtin_amdgcn_cvt_pk_f32_fp8((int)u.w, true);
}

DEV void bitonic_sort16_desc(float (&v)[16]) {
#pragma unroll
  for (int k = 2; k <= 16; k <<= 1)
#pragma unroll
    for (int j = k >> 1; j >= 1; j >>= 1)
#pragma unroll
      for (int i = 0; i < 16; ++i) {
        const int l = i ^ j;
        if (l > i) {
          const float hi = fmaxf(v[i], v[l]), lo = fminf(v[i], v[l]);
          if ((i & k) == 0) { v[i] = hi; v[l] = lo; } else { v[i] = lo; v[l] = hi; }
        }
      }
}
DEV void peer_cand_ij(int c, int& ci, int& cj) {
  if (c < 16) { ci = 0; cj = c; } else if (c < 24) { ci = 1; cj = c - 16; } else if (c < 29) { ci = 2; cj = c - 24; }
  else if (c < 33) { ci = 3; cj = c - 29; } else if (c < 36) { ci = 4; cj = c - 33; } else if (c < 38) { ci = 5; cj = c - 36; }
  else if (c < 40) { ci = 6; cj = c - 38; } else if (c < 42) { ci = 7; cj = c - 40; } else { ci = (c - 42 + 8) & 15; cj = 0; }
}
template <int S>
struct Epi3K {
  const P& p; int row0, head; float (&keep)[2][16];
  DEV void operator()(f32x4 (&acc)[4][4], int wr, int wc, int fr, int fq, char* smem) const {
    float* sc = (float*)smem;
    float* L1s = (float*)(smem + 36864);
    float* L2s = (float*)(smem + 45056);
    const int tid = tid_();
#pragma unroll
    for (int pass = 0; pass < 2; ++pass) {
      __syncthreads();
      if (wr == pass) {
#pragma unroll
        for (int m = 0; m < 4; ++m)
#pragma unroll
          for (int n = 0; n < 4; ++n)
#pragma unroll
            for (int j = 0; j < 4; ++j) {
              int rl = m * 16 + fr, col = wc * 64 + n * 16 + 4 * fq + j;
              unsigned bits = (__float_as_uint(acc[m][n][j]) & ~127u) | (unsigned)col;
              sc[rl * 133 + (col >> 5) * 33 + (col & 31)] = __uint_as_float(bits);
            }
      }
      __syncthreads();
      const int rl = tid >> 2, q = tid & 3;
      const float* src = sc + rl * 133 + q * 33;
      float Ls[16], Hs[16];
#pragma unroll
      for (int i = 0; i < 16; ++i) { Ls[i] = src[i]; Hs[i] = src[16 + i]; }
      bitonic_sort16_desc(Ls);
      bitonic_sort16_desc(Hs);
#pragma unroll
      for (int i = 0; i < 16; ++i) Ls[i] = fmaxf(Ls[i], Hs[15 - i]);
#pragma unroll
      for (int d = 8; d >= 1; d >>= 1)
#pragma unroll
        for (int i = 0; i < 16; ++i)
          if ((i & d) == 0) { float hi = fmaxf(Ls[i], Ls[i + d]), lo = fminf(Ls[i], Ls[i + d]); Ls[i] = hi; Ls[i + d] = lo; }
      float Cs[16];
#pragma unroll
      for (int i = 0; i < 16; ++i) Cs[i] = fmaxf(Ls[i], dppself<0xB1, 0xF>(Ls[15 - i]));
#pragma unroll
      for (int d = 8; d >= 1; d >>= 1)
#pragma unroll
        for (int i = 0; i < 16; ++i)
          if ((i & d) == 0) { float hi = fmaxf(Cs[i], Cs[i + d]), lo = fminf(Cs[i], Cs[i + d]); Cs[i] = hi; Cs[i + d] = lo; }
      float Ds[16];
#pragma unroll
      for (int i = 0; i < 16; ++i) Ds[i] = fmaxf(Cs[i], dppself<0x4E, 0xF>(Cs[15 - i]));
#pragma unroll
      for (int d = 8; d >= 1; d >>= 1)
#pragma unroll
        for (int i = 0; i < 16; ++i)
          if ((i & d) == 0) { float hi = fmaxf(Ds[i], Ds[i + d]), lo = fminf(Ds[i], Ds[i + d]); Ds[i] = hi; Ds[i + d] = lo; }
      if (S == 0) {
#pragma unroll
        for (int i = 0; i < 16; ++i) keep[pass][i] = Ds[i];
      } else if (q == 0) {
        float* d1 = L1s + (pass * 64 + rl) * 16;
        float* d2 = L2s + (pass * 64 + rl) * 16;
#pragma unroll
        for (int i = 0; i < 4; ++i) {
          *(float4*)(d1 + 4 * i) = make_float4(keep[pass][4 * i], keep[pass][4 * i + 1], keep[pass][4 * i + 2], keep[pass][4 * i + 3]);
          *(float4*)(d2 + 4 * i) = make_float4(Ds[4 * i], Ds[4 * i + 1], Ds[4 * i + 2], Ds[4 * i + 3]);
        }
      }
    }
    if (S == 1) {
      __syncthreads();
      const int lane = tid & 63, wid = tid >> 6;
      int ci, cj;
      peer_cand_ij(lane, ci, cj);
      const bool cand = lane < 50;
      float n1 = L1s[(wid * 32) * 16 + ci], n2 = L2s[(wid * 32) * 16 + cj];
#pragma unroll 1
      for (int r = 0; r < 32; ++r) {
        const int row = wid * 32 + r;
        const float v1 = n1, v2 = n2;
        if (r + 1 < 32) { n1 = L1s[(row + 1) * 16 + ci]; n2 = L2s[(row + 1) * 16 + cj]; }
        float val = v1 + v2;
        val = __uint_as_float((__float_as_uint(val) & ~63u) | (unsigned)lane);
        val = cand ? val : -3e38f;
        int rank = 0;
#pragma unroll
        for (int q = 0; q < 50; ++q) rank += (readlane_f(val, q) > val) ? 1 : 0;
        const bool sel = cand && rank < 16;
        const float mx = readlane_f(val, 0);
        const float ex = sel ? __expf(val - mx) : 0.f;
        const float sm = wave_sum(ex);
        if (sel) {
          const int e = (int)(__float_as_uint(v1) & 127u) * 128 + (int)(__float_as_uint(v2) & 127u);
          const size_t o = (size_t)(row0 + row) * 128 + head * 16 + rank;
          p.EL[o] = (unsigned short)e;
          p.GT[o] = ex / sm;
        }
      }
    }
  }
};
DEV void ph_gemm3(const P& p, char* smem) {
  int rt, hd;
  for (int it = 0; gemm_unit(it, 8, rt, hd); ++it) {
    float keep[2][16];
    {
      Epi3K<0> epi{p, rt * 128, hd, keep};
      gemm_tile(p.H + (size_t)rt * 128 * D, D, p.Wft + (size_t)(2 * hd) * 128 * D, D, D, smem, epi);
    }
    {
      Epi3K<1> epi{p, rt * 128, hd, keep};
      gemm_tile(p.H + (size_t)rt * 128 * D, D, p.Wft + (size_t)(2 * hd + 1) * 128 * D, D, D, smem, epi);
    }
  }
}

DEV float peer_gate(float scr) {
  float mx = row16_max(scr);
  float ex = __expf(scr - mx);
  float sm = row16_sum(ex);
  return ex / sm;
}
DEV float gelu_exact(float x) { return 0.5f * x * (1.f + erff(x * 0.7071067811865476f)); }

struct PeerPre { uint4 e0, e1, a0, a1, a2, a3; };
DEV unsigned peer_eid(const PeerPre& s, int j) {
  const unsigned w = (j < 8) ? ((j >> 1) == 0 ? s.e0.x : (j >> 1) == 1 ? s.e0.y : (j >> 1) == 2 ? s.e0.z : s.e0.w)
                             : (((j - 8) >> 1) == 0 ? s.e1.x : ((j - 8) >> 1) == 1 ? s.e1.y : ((j - 8) >> 1) == 2 ? s.e1.z : s.e1.w);
  return (j & 1) ? (w >> 16) : (w & 0xFFFFu);
}
template <int WHICH>
DEV void peer_wave_run(const P& p, int layer, int x, int tok0, int lane, float* wbuf) {
  const int r = lane >> 3, c = lane & 7;
  const unsigned char* tb = (WHICH == 0 ? p.PU : p.PV) + (size_t)x * PSLICE + c * 16;
  PeerPre S[3];
  uint4 R[16];
  auto ld_pre = [&](int tok, PeerPre& s) {
    const uint4* elp = (const uint4*)(p.EL + (size_t)tok * 128 + r * 16);
    s.e0 = elp[0]; s.e1 = elp[1];
    if (WHICH == 0) {
      s.a0 = *(const uint4*)(p.H8 + (size_t)tok * 1024 + x * 128 + c * 16);
    } else {
      const uint4* wtp = (const uint4*)(p.GT + (size_t)tok * 128 + r * 16);
      s.a0 = wtp[0]; s.a1 = wtp[1]; s.a2 = wtp[2]; s.a3 = wtp[3];
    }
  };
  auto comp = [&](int tok, const PeerPre& s, const PeerPre& sn, bool more) {
    if (WHICH == 0) {
      int keep0 = 0, keep1 = 0;
#pragma unroll
      for (int j = 0; j < 16; ++j) {
        const uint4 rw = R[j];
        if (more) R[j] = *(const uint4*)(tb + (size_t)peer_eid(sn, j) * 128);
        int d = __builtin_amdgcn_sdot4((int)rw.x, (int)s.a0.x, 0, false);
        d = __builtin_amdgcn_sdot4((int)rw.y, (int)s.a0.y, d, false);
        d = __builtin_amdgcn_sdot4((int)rw.z, (int)s.a0.z, d, false);
        d = __builtin_amdgcn_sdot4((int)rw.w, (int)s.a0.w, d, false);
        d += __builtin_amdgcn_update_dpp(0, d, 0xB1, 0xF, 0xF, false);
        d += __builtin_amdgcn_update_dpp(0, d, 0x4E, 0xF, 0xF, false);
        d += __builtin_amdgcn_update_dpp(0, d, 0x141, 0xF, 0xF, false);
        if (j < 8) keep0 = (c == j) ? d : keep0; else keep1 = (c == j - 8) ? d : keep1;
      }
      bf16_t* pd = p.PD + ((size_t)x * NTOK + tok) * 128 + r * 16 + c;
      pd[0] = f2bf((float)keep0); pd[8] = f2bf((float)keep1);
    } else {
      const float wsv[16] = {__uint_as_float(s.a0.x), __uint_as_float(s.a0.y), __uint_as_float(s.a0.z), __uint_as_float(s.a0.w),
                             __uint_as_float(s.a1.x), __uint_as_float(s.a1.y), __uint_as_float(s.a1.z), __uint_as_float(s.a1.w),
                             __uint_as_float(s.a2.x), __uint_as_float(s.a2.y), __uint_as_float(s.a2.z), __uint_as_float(s.a2.w),
                             __uint_as_float(s.a3.x), __uint_as_float(s.a3.y), __uint_as_float(s.a3.z), __uint_as_float(s.a3.w)};
      f32x2 acc2[8];
#pragma unroll
      for (int i = 0; i < 8; ++i) acc2[i] = (f32x2){0.f, 0.f};
#pragma unroll
      for (int j = 0; j < 16; ++j) {
        f32x2 f[8];
        unpack16_fp8x2(R[j], f);
        if (more) R[j] = *(const uint4*)(tb + (size_t)peer_eid(sn, j) * 128);
        const f32x2 w2 = (f32x2){wsv[j], wsv[j]};
#pragma unroll
        for (int i = 0; i < 8; ++i) acc2[i] += w2 * f[i];
      }
      float* slab = wbuf + (r * 8 + c) * 16;
      *(float4*)(slab) = make_float4(acc2[0][0], acc2[0][1], acc2[1][0], acc2[1][1]);
      *(float4*)(slab + 4) = make_float4(acc2[2][0], acc2[2][1], acc2[3][0], acc2[3][1]);
      *(float4*)(slab + 8) = make_float4(acc2[4][0], acc2[4][1], acc2[5][0], acc2[5][1]);
      *(float4*)(slab + 12) = make_float4(acc2[6][0], acc2[6][1], acc2[7][0], acc2[7][1]);
      asm volatile("s_waitcnt lgkmcnt(0)" ::: "memory");
      float o0 = 0.f, o1 = 0.f;
#pragma unroll
      for (int rr = 0; rr < 8; ++rr) {
        const float2 t = *(const float2*)(wbuf + (rr * 8 + (lane >> 3)) * 16 + 2 * (lane & 7));
        o0 += t.x; o1 += t.y;
      }
      asm volatile("s_waitcnt lgkmcnt(0)" ::: "memory");
      const int b = tok / LT, pp = tok % LT;
      const int mr = pp < LC ? 16 : b;
      const int col = x * 128 + 2 * lane;
      const float* g2 = p.modv + ((size_t)layer * 17 + mr) * 6144 + 5120 + col;
      unsigned* xp = (unsigned*)(p.X + (size_t)tok * D + col);
      const unsigned xu = *xp;
      *xp = pack2(bflo(xu) + g2[0] * o0, bfhi(xu) + g2[1] * o1);
    }
  };
  ld_pre(tok0, S[0]);
  ld_pre(tok0 + 1, S[1]);
#pragma unroll
  for (int j = 0; j < 16; ++j) R[j] = *(const uint4*)(tb + (size_t)peer_eid(S[0], j) * 128);
  ld_pre(tok0 + 2, S[2]);
#pragma unroll
  for (int t = 0; t < 8; ++t) {
    comp(tok0 + t, S[t % 3], S[(t + 1) % 3], t + 1 < 8);
    if (t + 3 < 8) ld_pre(tok0 + t + 3, S[t % 3]);
  }
}
DEV void ph_peer_w(const P& p) {
  for (size_t i8 = (size_t)bid_() * 256 + tid_(); i8 < (size_t)NTOK * 16; i8 += (size_t)gridDim.x * 256) {
    const size_t i = i8 * 8;
    float d[8];
#pragma unroll
    for (int q = 0; q < 8; ++q) d[q] = 0.f;
#pragma unroll
    for (int x = 0; x < 8; ++x) {
      const uint4 u = *(const uint4*)(p.PD + (size_t)x * NTOK * 128 + i);
      float f[8];
      unpack8(u, f);
#pragma unroll
      for (int q = 0; q < 8; ++q) d[q] += f[q];
    }
    const uint4 eu = *(const uint4*)(p.EL + i);
    const unsigned ew[4] = {eu.x, eu.y, eu.z, eu.w};
    const float hinv = p.HINV[i >> 7];
    float4 g0 = *(const float4*)(p.GT + i), g1 = *(const float4*)(p.GT + i + 4);
    float g[8] = {g0.x, g0.y, g0.z, g0.w, g1.x, g1.y, g1.z, g1.w};
#pragma unroll
    for (int q = 0; q < 8; ++q) {
      const unsigned e = (q & 1) ? (ew[q >> 1] >> 16) : (ew[q >> 1] & 0xFFFFu);
      g[q] = g[q] * gelu_exact(d[q] * p.PSU[e] * hinv) * p.PSV[e];
    }
    *(float4*)(p.GT + i) = make_float4(g[0], g[1], g[2], g[3]);
    *(float4*)(p.GT + i + 4) = make_float4(g[4], g[5], g[6], g[7]);
  }
}
template <int WHICH>
DEV void ph_peer_gather(const P& p, int layer, char* smem, volatile LAS unsigned* slot) {
  const int tid = tid_(), lane = tid & 63, wid = tid >> 6;
  unsigned* q = p.wq + 1024 + layer * 256 + WHICH * 128;
  const int my = (int)(xb_xcc_id() & 7u);
  float* wbuf = (float*)smem + wid * 1024;
#pragma unroll 1
  for (int rot = 0; rot < 8; ++rot) {
    const int x = (my + rot) & 7;
    for (;;) {
      __syncthreads();
      if (tid == 0) *slot = atomicAdd(q + x * 16, 1u);
      __syncthreads();
      const int it = (int)*slot;
      if (it >= NTOK / 64) break;
      peer_wave_run<WHICH>(p, layer, x, it * 64 + wid * 16, lane, wbuf);
      peer_wave_run<WHICH>(p, layer, x, it * 64 + wid * 16 + 8, lane, wbuf);
    }
  }
}

DEV void ph_final(const P& p) {
  const int lane = tid_() & 63;
  int r0, r1;
  wave_range(r0, r1, NB * T);
  float gv[16];
#pragma unroll
  for (int hh = 0; hh < 2; ++hh)
#pragma unroll
    for (int i = 0; i < 8; ++i) gv[hh * 8 + i] = p.final_g[hh * 512 + 8 * lane + i];
  auto xrow = [&](int r) -> const bf16_t* { const int b = r / T, t = r % T; return p.X + ((size_t)b * LT + LC + t) * D; };
  uint4 n0 = make_uint4(0, 0, 0, 0), n1 = n0;
  if (r0 < r1) { const bf16_t* xr = xrow(r0); n0 = *(const uint4*)(xr + 8 * lane); n1 = *(const uint4*)(xr + 512 + 8 * lane); }
#pragma unroll 1
  for (int r = r0; r < r1; ++r) {
    const uint4 u0 = n0, u1 = n1;
    if (r + 1 < r1) { const bf16_t* xr = xrow(r + 1); n0 = *(const uint4*)(xr + 8 * lane); n1 = *(const uint4*)(xr + 512 + 8 * lane); }
    float v[16];
    unpack8(u0, v); unpack8(u1, v + 8);
    float ss = 0.f;
#pragma unroll
    for (int i = 0; i < 16; ++i) ss += v[i] * v[i];
    ss = wave_sum(ss);
    const float rstd = rsqrtf(ss * (1.f / 1024.f) + 1e-6f);
    float* o = p.out + (size_t)r * D;
#pragma unroll
    for (int hh = 0; hh < 2; ++hh) {
      const int col = hh * 512 + 8 * lane;
      *(float4*)(o + col) = make_float4(v[hh * 8 + 0] * rstd * gv[hh * 8 + 0], v[hh * 8 + 1] * rstd * gv[hh * 8 + 1], v[hh * 8 + 2] * rstd * gv[hh * 8 + 2], v[hh * 8 + 3] * rstd * gv[hh * 8 + 3]);
      *(float4*)(o + col + 4) = make_float4(v[hh * 8 + 4] * rstd * gv[hh * 8 + 4], v[hh * 8 + 5] * rstd * gv[hh * 8 + 5], v[hh * 8 + 6] * rstd * gv[hh * 8 + 6], v[hh * 8 + 7] * rstd * gv[hh * 8 + 7]);
    }
  }
}

DEV unsigned hw_cu_key() {
  const unsigned hwid = (unsigned)__builtin_amdgcn_s_getreg(((8 - 1) << 11) | (8 << 6) | 4);
  return (xb_xcc_id() << 8) | (hwid & 0xFFu);
}
DEV void mixB(const P& p, int layer, char* smem, volatile LAS unsigned* slot) {
  unsigned* qa = p.wq + layer * 64;
  unsigned* qs = qa + 16;
  unsigned* claim = p.cuclaim + layer * 4096;
  __syncthreads();
  if (tid_() == 0) {
    unsigned u = 0xFFFFFFFFu;
    if (atomicAdd(&claim[hw_cu_key() & 4095u], 1u) == 0u) u = atomicAdd(qs, 1u);
    *slot = u;
  }
  __syncthreads();
  {
    const unsigned u = *slot;
    if (u < 128u) scanc_unit(p, layer, (int)u, smem);
  }
  for (;;) {
    __syncthreads();
    if (tid_() == 0) *slot = atomicAdd(qa, 1u);
    __syncthreads();
    const int u = (int)*slot;
    if (u >= 8704) break;
    if (u < 4352) attn_unit(p, layer, u, smem); else hyena_conv_unit(p, layer, u - 4352, smem);
  }
  if (layer + 1 < DEPTH) {
    unsigned* qp = qa + 32;
    for (;;) {
      __syncthreads();
      if (tid_() == 0) *slot = atomicAdd(qp, 1u);
      __syncthreads();
      const int u = (int)*slot;
      if (u >= PREPA_N) break;
      prep_unit(p, layer + 1, prepA_unit_index(u), smem);
    }
  }
  for (;;) {
    __syncthreads();
    if (tid_() == 0) *slot = atomicAdd(qs, 1u);
    __syncthreads();
    const unsigned u = *slot;
    if (u >= 128u) break;
    scanc_unit(p, layer, (int)u, smem);
  }
}
DEV void mixA(const P& p, int layer, char* smem) {
  for (int u = bid_(); u < 1088; u += gridDim.x) hyena_pre_unit(p, layer, u);
  ph_lora(p, layer, smem);
  ph_rwkv_prep(p, layer);
}
DEV void mixC(const P& p, int layer, char* smem) {
  for (int u = bid_(); u < 1088; u += gridDim.x) hyena_post_unit(p, layer, u, smem);
  ph_rwkv_post(p, layer);
  ph_attn_post(p, layer);
}

__global__ void __launch_bounds__(256, 2) k_mega(P p) {
  extern __shared__ __attribute__((aligned(16))) char smem_all[];
  char* smem = smem_all;
  volatile LAS unsigned* xbw = (volatile LAS unsigned*)(smem_all + SMEM_BYTES);
  if (threadIdx.x == 0) { xbw[0] = 0u; xbw[1] = 0u; xbw[2] = 0u; xbw[3] = 0u; }
  __syncthreads();
  XcdBarrier bar = xcd_barrier_post(p.bar, xbw);
  ph_copy(p);
  ph_rope(p);
  for (int u = blockIdx.x; u < 96; u += gridDim.x) modv_unit(p, u, smem);
  ph_prep(p, 0, smem, false);
  xcd_barrier(bar);
  for (int layer = 0; layer < DEPTH; ++layer) {
    ph_norm(p, layer, 0);
    xcd_barrier(bar);
    ph_gemm1(p, smem);
    xcd_barrier(bar);
    mixA(p, layer, smem);
    xcd_barrier(bar);
    mixB(p, layer, smem, (volatile LAS unsigned*)(smem_all + SMEM_BYTES + 16));
    xcd_barrier(bar);
    mixC(p, layer, smem);
    xcd_barrier(bar);
    ph_gemm2(p, layer, smem);
    ph_peerconv(p, layer);
    xcd_barrier(bar);
    ph_norm(p, layer, 1);
    xcd_barrier(bar);
    ph_gemm3(p, smem);
    xcd_barrier(bar);
    ph_peer_gather<0>(p, layer, smem, (volatile LAS unsigned*)(smem_all + SMEM_BYTES + 16));
    xcd_barrier(bar);
    ph_peer_w(p);
    xcd_barrier(bar);
    ph_peer_gather<1>(p, layer, smem, (volatile LAS unsigned*)(smem_all + SMEM_BYTES + 16));
    if (layer + 1 < DEPTH) ph_prep(p, layer + 1, smem, true);
    xcd_barrier(bar);
  }
  ph_final(p);
}

static inline size_t al256(size_t x) { return (x + 255) & ~(size_t)255; }

extern "C" void kernel_launch(void* const* d_in, const int* in_sizes, int n_in, void* d_out, int out_size, void* d_ws, size_t ws_size,
                              hipStream_t stream) {
  (void)in_sizes; (void)n_in; (void)out_size; (void)ws_size;
  P p{};
  const float** f = (const float**)&p;
  for (int i = 0; i < 39; ++i) f[i] = (const float*)d_in[i];
  p.out = (float*)d_out;
  char* w = (char*)d_ws;
  size_t off = 0;
  auto take = [&](size_t bytes) { char* r = w + off; off += al256(bytes); return r; };
  p.bar = (unsigned*)take(16384);
  p.modv = (float*)take((size_t)DEPTH * 17 * 6144 * 4);
  p.SSQ = (float*)take((size_t)DEPTH * 2 * 256 * 4);
  p.wq = (unsigned*)take(4096 + DEPTH * 1024);
  p.cuclaim = (unsigned*)take((size_t)DEPTH * 4096 * 4);
  const size_t zero_bytes = off;
  p.rope = (float*)take(64 * 16 * 2 * 4);
  p.X = (bf16_t*)take((size_t)NTOK * D * 2);
  p.H = (bf16_t*)take((size_t)NTOK * D * 2);
  p.Y = (bf16_t*)take((size_t)NTOK * D * 2);
  p.SC = (bf16_t*)take((size_t)NTOK * 1024 * 2);
  p.Z = (bf16_t*)take((size_t)NTOK * INW * 2);
  p.UTl = (bf16_t*)take((size_t)256 * 16 * T * 2);
  p.UTc = (bf16_t*)take((size_t)256 * 16 * LC * 2);
  p.YTl = (bf16_t*)take((size_t)256 * 16 * T * 2);
  p.YTc = (bf16_t*)take((size_t)256 * 16 * LC * 2);
  p.FL = (float*)take((size_t)256 * 2 * T * 4);
  p.FC = (float*)take((size_t)256 * 2 * LC * 4);
  p.W1t = (bf16_t*)take((size_t)INW * D * 2);
  p.W2t = (bf16_t*)take((size_t)D * D * 2);
  p.Wft = (bf16_t*)take((size_t)2048 * D * 2);
  p.Wlt = (bf16_t*)take((size_t)1024 * 256 * 2);
  p.Wgt = (bf16_t*)take((size_t)256 * 128 * 2);
  p.TK = (float*)p.Z;
  p.PU = (unsigned char*)p.Z + al256((size_t)NTOK * 256 * 4);
  p.PV = p.PU + (size_t)16384 * 1024;
  p.PSU = (float*)(p.PV + (size_t)16384 * 1024);
  p.PSV = p.PSU + 16384;
  p.GT = p.PSV + 16384;
  p.EL = (unsigned short*)(p.GT + (size_t)NTOK * 128);
  p.H8 = (unsigned char*)p.EL + al256((size_t)NTOK * 128 * 2);
  p.HINV = (float*)(p.H8 + (size_t)NTOK * 1024);
  p.PD = p.Y;

  (void)hipMemsetAsync(d_ws, 0, zero_bytes, stream);
  constexpr size_t kDynLds = SMEM_BYTES + 32;
  static int grid = 0;
  if (!grid) {
    int dev = 0, cus = 0, per_cu = 0;
    (void)hipGetDevice(&dev);
    (void)hipDeviceGetAttribute(&cus, hipDeviceAttributeMultiprocessorCount, dev);
    (void)hipFuncSetAttribute((const void*)k_mega, hipFuncAttributeMaxDynamicSharedMemorySize, (int)kDynLds);
    (void)hipOccupancyMaxActiveBlocksPerMultiprocessor(&per_cu, k_mega, 256, kDynLds);
    if (cus <= 0) cus = 256;
    if (per_cu > 2) per_cu = 2;
    if (per_cu < 1) per_cu = 1;
    grid = cus * per_cu;
  }
  k_mega<<<grid, 256, kDynLds, stream>>>(p);
}
```

```cpp
#include <hip/hip_runtime.h>
#include <stdint.h>
#include <type_traits>

#define DEV __device__ __forceinline__
typedef unsigned short bf16_t;
typedef short bf16x8 __attribute__((ext_vector_type(8)));
typedef float f32x2 __attribute__((ext_vector_type(2)));
constexpr size_t PSLICE = (size_t)16384 * 128;
typedef float f32x4 __attribute__((ext_vector_type(4)));
typedef float f32x16 __attribute__((ext_vector_type(16)));


constexpr int NB = 16, T = 4096, LC = 256, LT = 4352, D = 1024, NTOK = NB * LT, INW = 2688, DEPTH = 4;
constexpr int SMEM_BYTES = 65536;

struct P {
  const float *x, *c, *ctx, *c_ctx, *mod_w, *mod_b, *norm1_g, *norm2_g, *w_in, *conv_w, *conv_b;
  const float *hy_w1, *hy_b1, *hy_w2, *hy_b2, *hy_w3, *hy_b3, *hy_freq, *hy_bias;
  const float *rw_w0, *rw_w_up, *rw_a0, *rw_a_up, *rw_g_up, *rw_k_k, *rw_k_a, *rw_r_k, *rw_ln_w, *rw_ln_b;
  const float *attn_sink, *hy_out_g, *at_out_g, *w_out, *peer_wq, *peer_k1, *peer_k2, *peer_u, *peer_v, *final_g;
  float* out;
  unsigned* bar;
  float *modv, *SSQ, *rope, *FL, *FC, *TK;
  unsigned *wq, *cuclaim;
  bf16_t *X, *H, *Y, *SC, *Z, *UTl, *UTc, *YTl, *YTc;
  bf16_t *W1t, *W2t, *Wft, *Wlt, *Wgt;
  unsigned char *PU, *PV;
  float *PSU, *PSV, *GT, *HINV;
  bf16_t* PD;
  unsigned short* EL;
  unsigned char* H8;
};

typedef __bf16 hwbf2 __attribute__((ext_vector_type(2)));
DEV unsigned pack2(float a, float b) { f32x2 f = {a, b}; hwbf2 r = __builtin_convertvector(f, hwbf2); return __builtin_bit_cast(unsigned, r); }
DEV bf16_t f2bf(float f) { return (bf16_t)(pack2(f, 0.f) & 0xFFFFu); }
DEV float bf2f(bf16_t h) { return __uint_as_float(((unsigned)h) << 16); }
DEV float bflo(unsigned u) { return __uint_as_float(u << 16); }
DEV float bfhi(unsigned u) { return __uint_as_float(u & 0xFFFF0000u); }
DEV void unpack8(const uint4& u, float* v) {
  v[0] = bflo(u.x); v[1] = bfhi(u.x); v[2] = bflo(u.y); v[3] = bfhi(u.y);
  v[4] = bflo(u.z); v[5] = bfhi(u.z); v[6] = bflo(u.w); v[7] = bfhi(u.w);
}
DEV uint4 pack8(const float* v) { return make_uint4(pack2(v[0], v[1]), pack2(v[2], v[3]), pack2(v[4], v[5]), pack2(v[6], v[7])); }
DEV int pack_i8(float a, float b, float c, float d) {
  const int ia = __float2int_rn(a), ib = __float2int_rn(b), ic = __float2int_rn(c), id = __float2int_rn(d);
  return (ia & 0xFF) | ((ib & 0xFF) << 8) | ((ic & 0xFF) << 16) | ((id & 0xFF) << 24);
}
DEV float sigmoidf_(float x) { return __builtin_amdgcn_rcpf(1.f + __expf(-x)); }

template <int CTRL, int ROWMASK>
DEV float dpp0(float x) {
  return __builtin_bit_cast(float, __builtin_amdgcn_update_dpp(0, __builtin_bit_cast(int, x), CTRL, ROWMASK, 0xF, false));
}
template <int CTRL, int ROWMASK>
DEV float dppself(float x) {
  int xi = __builtin_bit_cast(int, x);
  return __builtin_bit_cast(float, __builtin_amdgcn_update_dpp(xi, xi, CTRL, ROWMASK, 0xF, false));
}
DEV float readlane_f(float x, int l) { return __builtin_bit_cast(float, __builtin_amdgcn_readlane(__builtin_bit_cast(int, x), l)); }
DEV int lane_id() { return (int)__builtin_amdgcn_mbcnt_hi(~0u, __builtin_amdgcn_mbcnt_lo(~0u, 0u)); }
DEV float writelane_f(float val, int l, float old) { return lane_id() == l ? val : old; }
DEV int writelane_i(int val, int l, int old) { return lane_id() == l ? val : old; }
DEV float wave_sum(float x) {
  x += dpp0<0x111, 0xF>(x); x += dpp0<0x112, 0xF>(x); x += dpp0<0x114, 0xF>(x); x += dpp0<0x118, 0xF>(x);
  x += dpp0<0x142, 0xA>(x); x += dpp0<0x143, 0xC>(x);
  return readlane_f(x, 63);
}
DEV float wave_max(float x) {
  x = fmaxf(x, dppself<0x111, 0xF>(x)); x = fmaxf(x, dppself<0x112, 0xF>(x)); x = fmaxf(x, dppself<0x114, 0xF>(x));
  x = fmaxf(x, dppself<0x118, 0xF>(x)); x = fmaxf(x, dppself<0x142, 0xA>(x)); x = fmaxf(x, dppself<0x143, 0xC>(x));
  return readlane_f(x, 63);
}
DEV float row16_sum(float x) {
  x += dpp0<0xB1, 0xF>(x); x += dpp0<0x4E, 0xF>(x); x += dpp0<0x141, 0xF>(x); x += dpp0<0x140, 0xF>(x);
  return x;
}
DEV float row16_max(float x) {
  x = fmaxf(x, dppself<0xB1, 0xF>(x)); x = fmaxf(x, dppself<0x4E, 0xF>(x)); x = fmaxf(x, dppself<0x141, 0xF>(x));
  x = fmaxf(x, dppself<0x140, 0xF>(x));
  return x;
}
DEV float quad_sum(float x) { x += dpp0<0xB1, 0xF>(x); x += dpp0<0x4E, 0xF>(x); return x; }

DEV f32x4 mfma16(bf16x8 a, bf16x8 b, f32x4 c) { return __builtin_amdgcn_mfma_f32_16x16x32_bf16(a, b, c, 0, 0, 0); }
DEV f32x16 mfma32(bf16x8 a, bf16x8 b, f32x16 c) { return __builtin_amdgcn_mfma_f32_32x32x16_bf16(a, b, c, 0, 0, 0); }


#define XB_TMO      128
#define XB_XCNT(j)  (256  + 64 * (j))
#define XB_XSUB(j)  (1280 + 64 * (j))
#define XB_XGEN(j)  (2304 + 64 * (j))
#define XB_TOP      3328
#define XB_TOPGEN   3392
#define XCD_BAR_WORDS 3456
#define XB_SPIN_CAP (1u << 23)
#define LAS __attribute__((address_space(3)))

__device__ __forceinline__ unsigned xb_ld(unsigned* p)              { return __hip_atomic_load(p, __ATOMIC_RELAXED, __HIP_MEMORY_SCOPE_AGENT); }
__device__ __forceinline__ unsigned xb_add(unsigned* p, unsigned v) { return __hip_atomic_fetch_add(p, v, __ATOMIC_RELAXED, __HIP_MEMORY_SCOPE_AGENT); }
__device__ __forceinline__ unsigned xb_xcc_id() { return (unsigned)__builtin_amdgcn_s_getreg((3 << 11) | 20) & 0xFu; }
#define XB_SPIN(cond, bar) do { unsigned _sp = 0; while (cond) { __builtin_amdgcn_s_sleep(1); \
    if ((++_sp & 255u) == 0u) { if (xb_ld(&(bar)[XB_TMO])) break; if (_sp > XB_SPIN_CAP) { atomicAdd(&(bar)[XB_TMO], 1u); break; } } } } while (0)

struct XcdBarrier {
    unsigned* bar; unsigned x;
    volatile LAS unsigned* st;
};
__device__ __forceinline__ XcdBarrier xcd_barrier_post(unsigned* bar, volatile LAS unsigned* st) {
    XcdBarrier b; b.bar = bar; b.x = xb_xcc_id(); b.st = st;
    if (threadIdx.x == 0) (void)xb_add(&bar[XB_XCNT(b.x)], 1u);
    return b;
}
__device__ __forceinline__ void xcd_barrier_complete(unsigned* bar, unsigned x, unsigned& nloc, unsigned& nx) {
    const unsigned G = gridDim.x * gridDim.y * gridDim.z;
    unsigned sum, cnt, mine, sp = 0u;
    for (;;) {
        sum = 0u; cnt = 0u; mine = 0u;
#pragma unroll
        for (unsigned j = 0; j < 16; ++j) { const unsigned c = xb_ld(&bar[XB_XCNT(j)]); sum += c; cnt += (c > 0u) ? 1u : 0u; mine = (j == x) ? c : mine; }
        if (sum == G) break;
        __builtin_amdgcn_s_sleep(1);
        if ((++sp & 255u) == 0u) { if (xb_ld(&bar[XB_TMO])) break; if (sp > XB_SPIN_CAP) { atomicAdd(&bar[XB_TMO], 1u); break; } }
    }
    nloc = mine > 0u ? mine : 1u; nx = cnt > 0u ? cnt : 1u;
}
__device__ __forceinline__ void xcd_barrier(const XcdBarrier& b) {
    asm volatile("s_waitcnt vmcnt(0)" ::: "memory");
    __syncthreads();
    if (threadIdx.x == 0) {
        unsigned* bar = b.bar;
        __builtin_amdgcn_s_waitcnt(0);
        unsigned nloc = b.st[0], nx = b.st[1];
        if (nloc == 0u) { xcd_barrier_complete(bar, b.x, nloc, nx); b.st[0] = nloc; b.st[1] = nx; }
        const unsigned old = xb_add(&bar[XB_XSUB(b.x)], 1u);
        const unsigned gen = old / nloc;
        if (old + 1u == (gen + 1u) * nloc) {
            __builtin_amdgcn_fence(__ATOMIC_RELEASE, "agent");
            asm volatile("s_waitcnt vmcnt(0)" ::: "memory");
            const unsigned og = xb_add(&bar[XB_TOP], 1u);
            const unsigned tg = og / nx;
            if (og + 1u == (tg + 1u) * nx) xb_add(&bar[XB_TOPGEN], 1u);
            else XB_SPIN(xb_ld(&bar[XB_TOPGEN]) == tg, bar);
            __builtin_amdgcn_fence(__ATOMIC_ACQUIRE, "agent");
            xb_add(&bar[XB_XGEN(b.x)], 1u);
            asm volatile("s_waitcnt vmcnt(0)" ::: "memory");
        } else {
            XB_SPIN(xb_ld(&bar[XB_XGEN(b.x)]) == gen, bar);
            __builtin_amdgcn_fence(__ATOMIC_ACQUIRE, "agent");
            asm volatile("s_waitcnt vmcnt(0)" ::: "memory");
        }
    }
    __syncthreads();
}

template <class Tp> DEV Tp* opq(Tp* q) { asm volatile("" : "+s"(q)); return q; }
DEV int tid_() { int t = threadIdx.x; asm volatile("" : "+v"(t)); return t; }
DEV int bid_() { int b = blockIdx.x; asm volatile("" : "+s"(b)); return b; }

DEV void glds16(const void* gsrc, char* lds_lane_ptr) {
  __builtin_amdgcn_global_load_lds((const unsigned*)gsrc, (__attribute__((address_space(3))) unsigned*)lds_lane_ptr, 16, 0, 0);
}
template <class Epi>
DEV void gemm_tile(const bf16_t* __restrict__ A, int lda, const bf16_t* __restrict__ Bt, int ldb, int K, char* smem, Epi& epi) {
  const int tid = tid_(), lane = tid & 63, wid = tid >> 6, wr = wid >> 1, wc = wid & 1, fr = lane & 15, fq = lane >> 4;
  f32x4 acc[4][4];
#pragma unroll
  for (int m = 0; m < 4; ++m)
#pragma unroll
    for (int n = 0; n < 4; ++n) acc[m][n] = (f32x4){0.f, 0.f, 0.f, 0.f};
  const int drow0 = 8 * wid + (lane >> 3), dpc = lane & 7;
  auto issue = [&](int kt, int buf) {
    char* sa = smem + buf * 32768;
    char* sb = sa + 16384;
#pragma unroll
    for (int i = 0; i < 4; ++i) {
      const int row = drow0 + 32 * i;
      const int kc = dpc ^ ((row >> 1) & 7);
      glds16(A + (size_t)row * lda + kt * 64 + kc * 8, sa + (i * 4 + wid) * 1024 + lane * 16);
      glds16(Bt + (size_t)row * ldb + kt * 64 + kc * 8, sb + (i * 4 + wid) * 1024 + lane * 16);
    }
  };
  __syncthreads();
  issue(0, 0);
  const int nk = K >> 6;
  const int sw = (fr >> 1) & 7;
  const int aoff = (wr * 64 + fr) * 128, boff = (wc * 64 + fr) * 128;
  for (int kt = 0; kt < nk; ++kt) {
    asm volatile("s_waitcnt vmcnt(0)" ::: "memory");
    __syncthreads();
    if (kt + 1 < nk) issue(kt + 1, (kt + 1) & 1);
    const char* sa = smem + (kt & 1) * 32768;
    const char* sb = sa + 16384;
#pragma unroll
    for (int kh = 0; kh < 2; ++kh) {
      const int pc = ((kh * 4 + fq) ^ sw) * 16;
      bf16x8 af[4], bfr[4];
#pragma unroll
      for (int m = 0; m < 4; ++m) af[m] = *(const bf16x8*)(sa + aoff + m * 2048 + pc);
#pragma unroll
      for (int n = 0; n < 4; ++n) bfr[n] = *(const bf16x8*)(sb + boff + n * 2048 + pc);
#pragma unroll
      for (int m = 0; m < 4; ++m)
#pragma unroll
        for (int n = 0; n < 4; ++n) acc[m][n] = mfma16(bfr[n], af[m], acc[m][n]);
    }
  }
  __syncthreads();
  epi(acc, wr, wc, fr, fq, smem);
}
DEV void stage_tile_bf16(const f32x4 (&acc)[4][4], char* smem, int wid, int fr, int fq) {
  bf16_t (*t)[72] = (bf16_t (*)[72])(smem + wid * 9216);
#pragma unroll
  for (int m = 0; m < 4; ++m)
#pragma unroll
    for (int n = 0; n < 4; ++n)
      *(uint2*)&t[m * 16 + fr][n * 16 + 4 * fq] = make_uint2(pack2(acc[m][n][0], acc[m][n][1]), pack2(acc[m][n][2], acc[m][n][3]));
  asm volatile("s_waitcnt lgkmcnt(0)" ::: "memory");
}

DEV void ph_copy(const P& p) {
  const size_t n8 = (size_t)NTOK * D / 8;
  const float* pctx = opq(p.ctx); const float* px = opq(p.x);
  for (size_t i = (size_t)bid_() * 256 + tid_(); i < n8; i += (size_t)gridDim.x * 256) {
    size_t e = i * 8;
    int row = (int)(e / D), col = (int)(e % D);
    int b = row / LT, pp = row % LT;
    const float* src = pp < LC ? pctx + ((size_t)(b * LC + pp)) * D + col : px + ((size_t)(b * T + pp - LC)) * D + col;
    float4 v0 = *(const float4*)src, v1 = *(const float4*)(src + 4);
    uint4 o = make_uint4(pack2(v0.x, v0.y), pack2(v0.z, v0.w), pack2(v1.x, v1.y), pack2(v1.z, v1.w));
    *(uint4*)(p.X + e) = o;
  }
}

DEV void ph_rope(const P& p) {
  for (int i = bid_() * 256 + tid_(); i < 64 * 16; i += gridDim.x * 256) {
    int pos = i >> 4, k = i & 15;
    float inv = powf(10000.f, -(float)k / 16.f);
    float ang = (float)pos * inv;
    p.rope[2 * i] = cosf(ang); p.rope[2 * i + 1] = sinf(ang);
  }
}

DEV void modv_unit(const P& p, int unit, char* smem) {
  const int cc = unit % 24, layer = unit / 24;
  float (*cs)[128] = (float (*)[128])smem;
  const int col = cc * 256 + tid_();
  const float* pc = opq(p.c); const float* pcc = opq(p.c_ctx);
  float acc[17];
#pragma unroll
  for (int r = 0; r < 17; ++r) acc[r] = 0.f;
  for (int ks = 0; ks < 8; ++ks) {
    __syncthreads();
    for (int i = tid_(); i < 17 * 128; i += 256) {
      int r = i >> 7, e = i & 127;
      float v = r < 16 ? pc[r * D + ks * 128 + e] : pcc[ks * 128 + e];
      cs[r][e] = v / (1.f + expf(-v));
    }
    __syncthreads();
    const float* w = p.mod_w + ((size_t)layer * D + ks * 128) * 6144 + col;
#pragma unroll 2
    for (int e = 0; e < 128; e += 4) {
      const float w0 = w[(size_t)e * 6144], w1 = w[(size_t)(e + 1) * 6144], w2 = w[(size_t)(e + 2) * 6144], w3 = w[(size_t)(e + 3) * 6144];
#pragma unroll
      for (int r = 0; r < 17; ++r) {
        const float4 cv = *(const float4*)&cs[r][e];
        acc[r] += cv.x * w0 + cv.y * w1 + cv.z * w2 + cv.w * w3;
      }
    }
  }
  const float bias = p.mod_b[layer * 6144 + col];
#pragma unroll
  for (int r = 0; r < 17; ++r) p.modv[((size_t)layer * 17 + r) * 6144 + col] = acc[r] + bias;
}

DEV void transpose_unit(const float* __restrict__ src, bf16_t* __restrict__ dst, int R, int C, int tile, char* smem) {
  float (*t)[65] = (float (*)[65])smem;
  const int nct = C / 64;
  const int tr = tile / nct, tc = tile % nct;
  __syncthreads();
  for (int i = tid_(); i < 4096; i += 256) { int r = i >> 6, c = i & 63; t[r][c] = src[(size_t)(tr * 64 + r) * C + tc * 64 + c]; }
  __syncthreads();
  for (int i = tid_(); i < 4096; i += 256) { int c = i >> 6, r = i & 63; dst[(size_t)(tc * 64 + c) * R + tr * 64 + r] = f2bf(t[r][c]); }
}

DEV void wfold_unit(const P& p, int layer, int unit, char* smem) {
  const int hs = unit >> 5, ec = unit & 31, h = hs >> 1, s = hs & 1;
  const float* wq = p.peer_wq + (size_t)layer * D * 2048;
  const float* kk = (s ? opq(p.peer_k2) : opq(p.peer_k1)) + ((size_t)layer * 8 + h) * 128 * 128;
  float (*kS)[65] = (float (*)[65])smem;
  float (*wS)[64] = (float (*)[64])(smem + 33280);
  const int key = tid_() & 127, eh = tid_() >> 7;
  float acc[16];
#pragma unroll
  for (int i = 0; i < 16; ++i) acc[i] = 0.f;
  for (int dh = 0; dh < 2; ++dh) {
    __syncthreads();
    for (int i = tid_(); i < 128 * 64; i += 256) { int k2 = i >> 6, d = i & 63; kS[k2][d] = kk[k2 * 128 + dh * 64 + d]; }
    for (int i = tid_(); i < 32 * 64; i += 256) {
      int e = i >> 6, d = i & 63;
      wS[e][d] = wq[(size_t)(ec * 32 + e) * 2048 + h * 256 + s * 128 + dh * 64 + d];
    }
    __syncthreads();
#pragma unroll 2
    for (int d = 0; d < 64; d += 4) {
      const float k0 = kS[key][d], k1 = kS[key][d + 1], k2 = kS[key][d + 2], k3 = kS[key][d + 3];
#pragma unroll
      for (int i = 0; i < 16; ++i) {
        const float4 wv = *(const float4*)&wS[eh * 16 + i][d];
        acc[i] += k0 * wv.x + k1 * wv.y + k2 * wv.z + k3 * wv.w;
      }
    }
  }
  bf16_t* dst = p.Wft + ((size_t)(hs * 128 + key)) * D + ec * 32 + eh * 16;
#pragma unroll
  for (int i = 0; i < 16; i += 2) *(unsigned*)(dst + i) = pack2(acc[i], acc[i + 1]);
}

DEV void filt_unit(const P& p, int layer, int unit, char* smem) {
  int kind, j0, L;
  if (unit < 1024) { kind = 0; j0 = unit * 4; L = T; } else { kind = 1; j0 = (unit - 1024) * 4; L = LC; }
  float* zs = (float*)smem;
  float* h1 = zs + 4 * 36;
  float* h2 = h1 + 256;
  const int jj = tid_() >> 6, o = tid_() & 63;
  const int j = j0 + jj;
  const float fj = (float)j;
  const float t = fj / (float)(L - 1);
  __syncthreads();
  if (o < 33) {
    float z;
    if (o == 0) z = t;
    else {
      int i = (o - 1) & 15;
      float band = 1e-4f + (float)i * ((15.0f - 1e-4f) / 15.0f);
      float ang = 6.283185307179586f * fj * band / (float)L;
      z = (o <= 16) ? cosf(ang) : -sinf(ang);
    }
    zs[jj * 36 + o] = z;
  }
  __syncthreads();
  {
    const float* w1 = p.hy_w1 + layer * 33 * 64;
    float a = p.hy_b1[layer * 64 + o];
#pragma unroll 3
    for (int i = 0; i < 33; ++i) a += zs[jj * 36 + i] * w1[i * 64 + o];
    h1[jj * 64 + o] = sinf(p.hy_freq[layer * 128 + o] * a);
  }
  __syncthreads();
  {
    const float* w2 = p.hy_w2 + layer * 64 * 64;
    float a = p.hy_b2[layer * 64 + o];
#pragma unroll 4
    for (int i = 0; i < 64; ++i) a += h1[jj * 64 + i] * w2[i * 64 + o];
    h2[jj * 64 + o] = sinf(p.hy_freq[layer * 128 + 64 + o] * a);
  }
  __syncthreads();
  const float* w3 = p.hy_w3 + layer * 64 * 512;
  float* F = kind ? opq(p.FC) : opq(p.FL);
  const float DMIN = -3.0701134573253945f, DMAX = -15.350567286626973f;
#pragma unroll 1
  for (int m = 0; m < 4; ++m) {
    int c = o + 64 * m;
    float af = p.hy_b3[layer * 512 + c], ab = p.hy_b3[layer * 512 + 256 + c];
#pragma unroll 4
    for (int i = 0; i < 64; ++i) { float hv = h2[jj * 64 + i]; af += hv * w3[i * 512 + c]; ab += hv * w3[i * 512 + 256 + c]; }
    float delta = fabsf(DMIN + (float)c * ((DMAX - DMIN) / 255.f));
    float win = expf(-t * delta) + 0.05f;
    af *= win; ab *= win;
    F[((size_t)c * 2 + 0) * L + j] = af;
    F[((size_t)c * 2 + 1) * L + j] = ab;
  }
}

constexpr int PREP_T0 = 672, PREP_T1 = PREP_T0 + 256, PREP_T2 = PREP_T1 + 8, PREP_T3 = PREP_T2 + 8, PREP_T4 = PREP_T3 + 8;
constexpr int PREP_WF = PREP_T4 + 512, PREP_N = PREP_WF + 1088;
DEV void prep_unit(const P& p, int layer, int u, char* smem) {
  if (u < PREP_T0) transpose_unit(p.w_in + (size_t)layer * D * INW, p.W1t, D, INW, u, smem);
  else if (u < PREP_T1) transpose_unit(p.w_out + (size_t)layer * D * D, p.W2t, D, D, u - PREP_T0, smem);
  else if (u < PREP_T3) {
    const int u0 = u - PREP_T1;
    for (int i = tid_(); i < 64 * 256; i += 256) {
      const int np = u0 * 64 + (i >> 8), kp = i & 255;
      const int ps = np & 3, chan = np >> 2, qp = kp >> 6, kk = kp & 63;
      const int is_a = ps & 1, d = ps >> 1;
      float v = 0.f;
      if (qp == (is_a ? 2 + d : d)) v = (is_a ? opq(p.rw_a_up) : opq(p.rw_w_up))[(((size_t)layer * 2 + d) * 64 + kk) * 256 + chan];
      p.Wlt[(size_t)np * 256 + kp] = f2bf(v);
    }
  }
  else if (u < PREP_T4) transpose_unit(p.rw_g_up + (size_t)layer * 128 * 256, p.Wgt, 128, 256, u - PREP_T3, smem);
  else if (u < PREP_WF) wfold_unit(p, layer, u - PREP_T4, smem);
  else filt_unit(p, layer, u - PREP_WF, smem);
}
constexpr int PREPA_N = PREP_T0 + (PREP_T4 - PREP_T1);
DEV int prepA_unit_index(int i) { return i < PREP_T0 ? i : PREP_T1 + (i - PREP_T0); }
DEV void ph_prep(const P& p, int layer, char* smem, bool onlyB) {
  for (int u = bid_(); u < PREP_N; u += gridDim.x) {
    const bool isA = (u < PREP_T0) || (u >= PREP_T1 && u < PREP_T4);
    if (onlyB && isA) continue;
    prep_unit(p, layer, u, smem);
  }
}

DEV void wave_range(int& r0, int& r1, int ntok) {
  const int gw = (bid_() * 256 + tid_()) >> 6, nw = gridDim.x * 4;
  const int per = (ntok + nw - 1) / nw;
  r0 = gw * per; r1 = r0 + per; if (r1 > ntok) r1 = ntok;
}
DEV void ph_norm(const P& p, int layer, int which) {
  const int lane = tid_() & 63;
  int r0, r1;
  wave_range(r0, r1, NTOK);
  const float* g = (which ? p.norm2_g : p.norm1_g) + layer * D;
  float gv[16], scv[16], shv[16];
#pragma unroll
  for (int hh = 0; hh < 2; ++hh)
#pragma unroll
    for (int i = 0; i < 8; ++i) gv[hh * 8 + i] = g[hh * 512 + 8 * lane + i];
  int mr_cur = -1;
  uint4 n0 = make_uint4(0, 0, 0, 0), n1 = n0;
  if (r0 < r1) { const bf16_t* xr = p.X + (size_t)r0 * D; n0 = *(const uint4*)(xr + 8 * lane); n1 = *(const uint4*)(xr + 512 + 8 * lane); }
#pragma unroll 1
  for (int row = r0; row < r1; ++row) {
    const uint4 u0 = n0, u1 = n1;
    if (row + 1 < r1) { const bf16_t* xr = p.X + (size_t)(row + 1) * D; n0 = *(const uint4*)(xr + 8 * lane); n1 = *(const uint4*)(xr + 512 + 8 * lane); }
    const int b = row / LT, pp = row % LT;
    const int mr = pp < LC ? 16 : b;
    if (mr != mr_cur) {
      mr_cur = mr;
      const float* mv = p.modv + ((size_t)layer * 17 + mr) * 6144 + (which ? 3072 : 0);
#pragma unroll
      for (int hh = 0; hh < 2; ++hh)
#pragma unroll
        for (int i = 0; i < 8; ++i) { shv[hh * 8 + i] = mv[hh * 512 + 8 * lane + i]; scv[hh * 8 + i] = 1.f + mv[1024 + hh * 512 + 8 * lane + i]; }
    }
    float v[16];
    unpack8(u0, v); unpack8(u1, v + 8);
    float ss = 0.f;
#pragma unroll
    for (int i = 0; i < 16; ++i) ss += v[i] * v[i];
    ss = wave_sum(ss);
    const float rstd = rsqrtf(ss * (1.f / 1024.f) + 1e-6f);
    float o[16];
#pragma unroll
    for (int i = 0; i < 16; ++i) o[i] = (v[i] * rstd * gv[i]) * scv[i] + shv[i];
    bf16_t* hr = p.H + (size_t)row * D;
    *(uint4*)(hr + 8 * lane) = pack8(o);
    *(uint4*)(hr + 512 + 8 * lane) = pack8(o + 8);
    if (which) {
      float am = 0.f;
#pragma unroll
      for (int i = 0; i < 16; ++i) am = fmaxf(am, fabsf(o[i]));
      am = wave_max(am);
      const float sc = am > 0.f ? 127.f / am : 1.f;
      unsigned char* h8 = p.H8 + (size_t)row * 1024;
      *(uint2*)(h8 + 8 * lane) = make_uint2((unsigned)pack_i8(o[0] * sc, o[1] * sc, o[2] * sc, o[3] * sc), (unsigned)pack_i8(o[4] * sc, o[5] * sc, o[6] * sc, o[7] * sc));
      *(uint2*)(h8 + 512 + 8 * lane) = make_uint2((unsigned)pack_i8(o[8] * sc, o[9] * sc, o[10] * sc, o[11] * sc), (unsigned)pack_i8(o[12] * sc, o[13] * sc, o[14] * sc, o[15] * sc));
      if (lane == 0) p.HINV[row] = am > 0.f ? am * (1.f / 127.f) : 1.f;
    }
  }
}

DEV bool gemm_unit(int it, int nct, int& rt, int& ct) {
  const int nslot = gridDim.x >> 3;
  const int x = bid_() & 7, sl = bid_() >> 3;
  if (sl >= nslot) return false;
  const int v = it * nslot + sl;
  if (v >= 68 * nct) return false;
  const int rg = v / (8 * nct), rem = v - rg * 8 * nct;
  const int rows = (rg == 8) ? 4 : 8;
  ct = rem / rows;
  rt = x * 68 + rg * 8 + (rem - ct * rows);
  return true;
}
struct Epi1 {
  const P& p; int row0, col0;
  DEV void operator()(f32x4 (&acc)[4][4], int wr, int wc, int fr, int fq, char* smem) const {
    const int cw = col0 + wc * 64;
    const int rbase = row0 + wr * 64;
    const bool lat = (row0 % LT) >= LC;
    if (cw >= 1536 && cw < 1664) {
#pragma unroll
      for (int m = 0; m < 4; ++m)
#pragma unroll
        for (int n = 0; n < 4; ++n)
#pragma unroll
          for (int j = 0; j < 4; ++j) acc[m][n][j] = 2.f * sigmoidf_(2.f * acc[m][n][j]) - 1.f;
    } else if (cw >= 1792 && cw < 1920) {
#pragma unroll
      for (int m = 0; m < 4; ++m)
#pragma unroll
        for (int n = 0; n < 4; ++n)
#pragma unroll
          for (int j = 0; j < 4; ++j) acc[m][n][j] = sigmoidf_(acc[m][n][j]);
    } else if (cw >= 1920 && cw < 2560 && lat) {
#pragma unroll
      for (int m = 0; m < 4; ++m) {
        const int row = rbase + m * 16 + fr;
        const int pl = (row % LT) - LC;
        const int ri = pl >> 6, ci = pl & 63;
        const float4* crp = (const float4*)(p.rope + 2 * (ri * 16 + 4 * fq));
        const float4* ccp = (const float4*)(p.rope + 2 * (ci * 16 + 4 * fq));
        const float4 cr0 = crp[0], cr1 = crp[1], cc0 = ccp[0], cc1 = ccp[1];
        const float crc[4] = {cr0.x, cr0.z, cr1.x, cr1.z}, crs[4] = {cr0.y, cr0.w, cr1.y, cr1.w};
        const float ccc[4] = {cc0.x, cc0.z, cc1.x, cc1.z}, ccs[4] = {cc0.y, cc0.w, cc1.y, cc1.w};
#pragma unroll
        for (int j = 0; j < 4; ++j) {
          float x1 = acc[m][0][j], x2 = acc[m][1][j];
          acc[m][0][j] = x1 * crc[j] - x2 * crs[j]; acc[m][1][j] = x2 * crc[j] + x1 * crs[j];
          x1 = acc[m][2][j]; x2 = acc[m][3][j];
          acc[m][2][j] = x1 * ccc[j] - x2 * ccs[j]; acc[m][3][j] = x2 * ccc[j] + x1 * ccs[j];
        }
      }
    }
    const int wid = wr * 2 + wc, lane = fq * 16 + fr;
    stage_tile_bf16(acc, smem, wid, fr, fq);
    const bf16_t (*t)[72] = (const bf16_t (*)[72])(smem + wid * 9216);
#pragma unroll
    for (int i = 0; i < 8; ++i) {
      const int rl = i * 8 + (lane >> 3), ch = lane & 7;
      *(uint4*)(p.Z + (size_t)(rbase + rl) * INW + cw + ch * 8) = *(const uint4*)&t[rl][ch * 8];
    }
  }
};
DEV void ph_gemm1(const P& p, char* smem) {
  const int nct = INW / 128;
  int rt, ct;
  for (int it = 0; gemm_unit(it, nct, rt, ct); ++it) {
    Epi1 epi{p, rt * 128, ct * 128};
    gemm_tile(p.H + (size_t)rt * 128 * D, D, p.W1t + (size_t)ct * 128 * D, D, D, smem, epi);
  }
}

struct EpiLoraA {
  const P& p; int layer, row0, col0;
  DEV void operator()(f32x4 (&acc)[4][4], int wr, int wc, int fr, int fq, char* smem) const {
    const float* w0b = p.rw_w0 + layer * 512;
    const float* a0b = p.rw_a0 + layer * 512;
#pragma unroll
    for (int n = 0; n < 4; ++n) {
      const int chan = ((col0 + wc * 64 + n * 16) >> 2) + fq;
      const float be0 = w0b[chan], ba0 = a0b[chan], be1 = w0b[256 + chan], ba1 = a0b[256 + chan];
#pragma unroll
      for (int m = 0; m < 4; ++m) {
        acc[m][n][0] = 0.6065306597126334f * sigmoidf_(acc[m][n][0] + be0);
        acc[m][n][1] = sigmoidf_(acc[m][n][1] + ba0);
        acc[m][n][2] = 0.6065306597126334f * sigmoidf_(acc[m][n][2] + be1);
        acc[m][n][3] = sigmoidf_(acc[m][n][3] + ba1);
      }
    }
    const int wid = wr * 2 + wc, lane = fq * 16 + fr;
    stage_tile_bf16(acc, smem, wid, fr, fq);
    const bf16_t (*t)[72] = (const bf16_t (*)[72])(smem + wid * 9216);
#pragma unroll
    for (int i = 0; i < 8; ++i) {
      const int rl = i * 8 + (lane >> 3), ch = lane & 7;
      *(uint4*)(p.SC + (size_t)(row0 + wr * 64 + rl) * 1024 + col0 + wc * 64 + ch * 8) = *(const uint4*)&t[rl][ch * 8];
    }
  }
};
struct EpiLoraG {
  const P& p; int row0, col0;
  DEV void operator()(f32x4 (&acc)[4][4], int wr, int wc, int fr, int fq, char* smem) const {
    const int wid = wr * 2 + wc, lane = fq * 16 + fr;
    stage_tile_bf16(acc, smem, wid, fr, fq);
    const bf16_t (*t)[72] = (const bf16_t (*)[72])(smem + wid * 9216);
#pragma unroll
    for (int i = 0; i < 8; ++i) {
      const int rl = i * 8 + (lane >> 3), ch = lane & 7;
      *(uint4*)(p.Y + (size_t)(row0 + wr * 64 + rl) * D + 256 + col0 + wc * 64 + ch * 8) = *(const uint4*)&t[rl][ch * 8];
    }
  }
};
DEV void ph_lora(const P& p, int layer, char* smem) {
  int rt, ct;
  for (int it = 0; gemm_unit(it, 10, rt, ct); ++it) {
    if (ct < 8) {
      EpiLoraA epi{p, layer, rt * 128, ct * 128};
      gemm_tile(p.Z + (size_t)rt * 128 * INW + 1536, INW, p.Wlt + (size_t)ct * 128 * 256, 256, 256, smem, epi);
    } else {
      EpiLoraG epi{p, rt * 128, (ct - 8) * 128};
      gemm_tile(p.Z + (size_t)rt * 128 * INW + 1792, INW, p.Wgt + (size_t)(ct - 8) * 128 * 128, 128, 128, smem, epi);
    }
  }
}

DEV void ph_rwkv_prep(const P& p, int layer) {
  const int lane = tid_() & 63;
  int r0, r1;
  wave_range(r0, r1, NTOK);
  const float* cw = p.conv_w + (size_t)layer * 3 * 1536;
  const float* cb = p.conv_b + (size_t)layer * 1536;
  float w0[3][4], w1[3][4], w2[3][4], bb[3][4], kkw[4];
#pragma unroll
  for (int a = 0; a < 3; ++a)
#pragma unroll
    for (int i = 0; i < 4; ++i) {
      const int col = 768 + a * 256 + 4 * lane + i;
      w0[a][i] = cw[col]; w1[a][i] = cw[1536 + col]; w2[a][i] = cw[3072 + col]; bb[a][i] = cb[col];
    }
#pragma unroll
  for (int i = 0; i < 4; ++i) kkw[i] = p.rw_k_k[layer * 256 + 4 * lane + i];
  uint2 zm[3], zc[3], zp[3];
  auto ldz = [&](int row, uint2 (&z)[3]) {
#pragma unroll
    for (int a = 0; a < 3; ++a) z[a] = *(const uint2*)(p.Z + (size_t)row * INW + 768 + a * 256 + 4 * lane);
  };
  auto zero3 = [&](uint2 (&z)[3]) {
#pragma unroll
    for (int a = 0; a < 3; ++a) z[a] = make_uint2(0u, 0u);
  };
  if (r0 < r1) {
    if (r0 > 0) ldz(r0 - 1, zm); else zero3(zm);
    ldz(r0, zc);
  }
#pragma unroll 1
  for (int row = r0; row < r1; ++row) {
    if (row + 1 < NTOK) ldz(row + 1, zp); else zero3(zp);
    const int pp = row % LT;
    const bool hasm = (pp != 0) && (pp != LC);
    const bool hasp = (pp != LC - 1) && (pp != LT - 1);
    float res[3][4];
#pragma unroll
    for (int a = 0; a < 3; ++a) {
      const uint2 um = hasm ? zm[a] : make_uint2(0u, 0u), uc = zc[a], up = hasp ? zp[a] : make_uint2(0u, 0u);
      const float vm[4] = {bflo(um.x), bfhi(um.x), bflo(um.y), bfhi(um.y)};
      const float vc[4] = {bflo(uc.x), bfhi(uc.x), bflo(uc.y), bfhi(uc.y)};
      const float vp[4] = {bflo(up.x), bfhi(up.x), bflo(up.y), bfhi(up.y)};
#pragma unroll
      for (int i = 0; i < 4; ++i) res[a][i] = w0[a][i] * vm[i] + w1[a][i] * vc[i] + w2[a][i] * vp[i] + bb[a][i];
    }
    float kk[4], ss = 0.f;
#pragma unroll
    for (int i = 0; i < 4; ++i) { kk[i] = res[1][i] * kkw[i]; ss += kk[i] * kk[i]; }
    ss = row16_sum(ss);
    const float rs = rsqrtf(ss + 1e-12f);
    bf16_t* hr = p.H + (size_t)row * D + 16 * lane;
    *(uint4*)hr = make_uint4(pack2(res[0][0], res[1][0]), pack2(kk[0] * rs, res[2][0]), pack2(res[0][1], res[1][1]), pack2(kk[1] * rs, res[2][1]));
    *(uint4*)(hr + 8) = make_uint4(pack2(res[0][2], res[1][2]), pack2(kk[2] * rs, res[2][2]), pack2(res[0][3], res[1][3]), pack2(kk[3] * rs, res[2][3]));
#pragma unroll
    for (int a = 0; a < 3; ++a) { zm[a] = zc[a]; zc[a] = zp[a]; }
  }
}

DEV float oct_sum(float x) { x += dpp0<0xB1, 0xF>(x); x += dpp0<0x4E, 0xF>(x); x += dpp0<0x141, 0xF>(x); return x; }
DEV bf16x8 frag_join(uint2 lo, uint2 hi) { uint4 w = make_uint4(lo.x, lo.y, hi.x, hi.y); return __builtin_bit_cast(bf16x8, w); }
constexpr int SCS_SET = 17152, SCS_IMG = 3 * SCS_SET, SCS_W0 = SCS_IMG + 2 * 3072;
DEV void scanc_unit(const P& p, int layer, int unit, char* smem) {
  const int dir = unit & 1, h = (unit >> 1) & 3, b = unit >> 3;
  const int tid = tid_(), lane = tid & 63, fr = lane & 15, fq = lane >> 4;
  const int w = __builtin_amdgcn_readfirstlane(tid >> 6);
  bf16_t* IMG0 = (bf16_t*)(smem + SCS_W0);
  bf16_t* IMG1 = IMG0 + 512;
  bf16_t* IMG2 = IMG0 + 1024;
  __syncthreads();
  for (int i = tid; i < (2 * 3072 + 3072) / 4; i += 256) ((unsigned*)(smem + SCS_IMG))[i] = 0u;
  const float ka = p.rw_k_a[layer * 256 + h * 64 + lane];
  const size_t rowbase = (size_t)b * LT;
  const char* hbase = (const char*)p.H;
  const char* sbase = (const char*)p.SC;
  const unsigned hoff = (unsigned)(rowbase * 2048) + (unsigned)((h * 64 + lane) * 8);
  const unsigned soff = hoff + 4u * (unsigned)dir;
  bf16_t* yb = p.Z + rowbase * INW + 768 + dir * 256 + h * 64 + w * 16 + fr;
  auto pos0 = [&](int c) -> int { const int t = c * 16; return dir == 0 ? t : (t < LC ? LC - 1 - t : LT - 1 - (t - LC)); };
  const int pstep = dir == 0 ? 1 : -1;
  constexpr int NCH = LT / 16;
  struct Raw { unsigned sc[16]; uint2 hr[6]; };
  auto load_raw = [&](int c, Raw& rw) {
    if (w != 0) {
      const int p0 = pos0(c);
      const unsigned so = soff + (unsigned)(p0 * 2048);
      const int st = pstep * 2048;
#pragma unroll
      for (int i = 0; i < 16; ++i) rw.sc[i] = *(const unsigned*)(sbase + (so + (unsigned)(i * st)));
      const unsigned ho = hoff + (unsigned)((p0 + pstep * (w - 1)) * 2048);
#pragma unroll
      for (int q = 0; q < 6; ++q) {
        const int qq = ((w - 1) + 3 * q < 16) ? q : 4;
        rw.hr[q] = *(const uint2*)(hbase + (ho + (unsigned)(qq * 3 * st)));
      }
    }
  };
  auto stage1w = [&](int set, const Raw& rw, auto W1tag) {
    constexpr int W1 = decltype(W1tag)::value;
    char* base = smem + set * SCS_SET;
    bf16_t (*At)[72] = (bf16_t (*)[72])(base);
    bf16_t (*Rt)[72] = (bf16_t (*)[72])(base + 2304);
    bf16_t (*Bt)[72] = (bf16_t (*)[72])(base + 4608);
    bf16_t (*Kt)[72] = (bf16_t (*)[72])(base + 6912);
    bf16_t (*BKT)[36] = (bf16_t (*)[36])(base + 9216);
    bf16_t* VV = (bf16_t*)(base + 13824);
    float* G16 = (float*)(base + 16896);
    float Erun = 0.f;
#pragma unroll
    for (int i = 0; i < 16; ++i) {
      const float ev = bflo(rw.sc[i]);
      const float Eprev = Erun;
      Erun += ev;
      if ((i % 3) == W1) {
        const uint2 hrec = rw.hr[i / 3];
        const float rr = bflo(hrec.x), kr = bfhi(hrec.x), kkv = bflo(hrec.y);
        const float av = bfhi(rw.sc[i]);
        const float gp = __expf(-Eprev), gi = __expf(-Erun), ig = __expf(Erun);
        const float at = -kkv * gp, rt = rr * gi, bt = kkv * av * ig, kt2 = kr * (1.f + (av - 1.f) * ka) * ig;
        const unsigned ar = pack2(at, rt), bk = pack2(bt, kt2);
        At[i][lane] = (bf16_t)(ar & 0xFFFFu); Rt[i][lane] = (bf16_t)(ar >> 16);
        Bt[i][lane] = (bf16_t)(bk & 0xFFFFu); Kt[i][lane] = (bf16_t)(bk >> 16);
        BKT[lane][(i >> 2) * 8 + (i & 3)] = (bf16_t)(bk & 0xFFFFu);
        BKT[lane][(i >> 2) * 8 + 4 + (i & 3)] = (bf16_t)(bk >> 16);
        VV[((i >> 2) * 64 + lane) * 6 + (i & 3)] = (bf16_t)(hrec.y >> 16);
        if (i == 15) G16[lane] = gi;
      }
    }
  };
  auto stage1 = [&](int set, const Raw& rw) {
    if (w == 1) stage1w(set, rw, std::integral_constant<int, 0>{});
    else if (w == 2) stage1w(set, rw, std::integral_constant<int, 1>{});
    else if (w == 3) stage1w(set, rw, std::integral_constant<int, 2>{});
  };
  auto stage2 = [&](int set, int iset) {
    char* base = smem + set * SCS_SET;
    const bf16_t (*At)[72] = (const bf16_t (*)[72])(base);
    const bf16_t (*Rt)[72] = (const bf16_t (*)[72])(base + 2304);
    const bf16_t (*Bt)[72] = (const bf16_t (*)[72])(base + 4608);
    const bf16_t (*Kt)[72] = (const bf16_t (*)[72])(base + 6912);
    bf16_t* TT = (bf16_t*)(smem + SCS_IMG + iset * 3072);
    bf16_t* ARK = TT + 512;
    bf16_t* AAK = TT + 1024;
    const bf16_t (*X)[72] = (w < 2) ? At : Rt;
    const bf16_t (*Y)[72] = (w & 1) ? Kt : Bt;
    f32x4 cm = (f32x4){0.f, 0.f, 0.f, 0.f};
#pragma unroll
    for (int s = 0; s < 2; ++s) {
      bf16x8 af = *(const bf16x8*)&X[fr][32 * s + 8 * fq];
      bf16x8 bm = *(const bf16x8*)&Y[fr][32 * s + 8 * fq];
      cm = mfma16(af, bm, cm);
    }
#pragma unroll
    for (int jj = 0; jj < 4; ++jj) {
      const int i = 4 * fq + jj;
      const bool keep = (w < 2) ? (fr < i) : (fr <= i);
      cm[jj] = keep ? cm[jj] : 0.f;
    }
    const int io = (fr >> 2) * 8 + (fr & 3);
    auto wr_img = [&](bf16_t* img, const f32x4& Xv, int hi) {
#pragma unroll
      for (int jj = 0; jj < 4; ++jj) img[(4 * fq + jj) * 32 + io + hi] = f2bf(Xv[jj]);
    };
    if (w == 1) wr_img(AAK, cm, 0);
    else if (w == 2) wr_img(ARK, cm, 0);
    else if (w == 3) wr_img(ARK, cm, 4);
    else {
      auto bfrag = [&](const f32x4& Xv) { return frag_join(make_uint2(pack2(Xv[0], Xv[1]), pack2(Xv[2], Xv[3])), make_uint2(0u, 0u)); };
      auto afr = [&](const bf16_t* img) { return *(const bf16x8*)&img[(fr * 4 + fq) * 8]; };
      const f32x4 Z4 = (f32x4){0.f, 0.f, 0.f, 0.f};
      wr_img(IMG0, cm, 0);
      asm volatile("" ::: "memory");
      f32x4 A2 = mfma16(afr(IMG0), bfrag(cm), Z4);
      wr_img(IMG1, A2, 0);
      asm volatile("" ::: "memory");
      f32x4 A4 = mfma16(afr(IMG1), bfrag(A2), Z4);
      wr_img(IMG2, A4, 0);
      asm volatile("" ::: "memory");
      f32x4 Rm = mfma16(afr(IMG2), bfrag(A4), Z4);
#pragma unroll
      for (int jj = 0; jj < 4; ++jj) Rm[jj] += (fr == 4 * fq + jj) ? 1.f : 0.f;
      Rm = mfma16(afr(IMG2), bfrag(Rm), Rm);
      Rm = mfma16(afr(IMG1), bfrag(Rm), Rm);
      Rm = mfma16(afr(IMG0), bfrag(Rm), Rm);
      wr_img(TT, Rm, 0);
    }
  };
  f32x4 acc[4];
#pragma unroll
  for (int kt = 0; kt < 4; ++kt) acc[kt] = (f32x4){0.f, 0.f, 0.f, 0.f};
  auto part2 = [&](int c, int set, int iset) {
    char* base = smem + set * SCS_SET;
    const bf16_t (*At)[72] = (const bf16_t (*)[72])(base);
    const bf16_t (*Rt)[72] = (const bf16_t (*)[72])(base + 2304);
    const bf16_t (*BKT)[36] = (const bf16_t (*)[36])(base + 9216);
    const bf16_t* VV = (const bf16_t*)(base + 13824);
    const float* G16 = (const float*)(base + 16896);
    const bf16_t* TT = (const bf16_t*)(smem + SCS_IMG + iset * 3072);
    const bf16_t* ARK = TT + 512;
    const bf16_t* AAK = TT + 1024;
    bf16x8 Sb[2];
#pragma unroll
    for (int s = 0; s < 2; ++s) {
      uint4 t = make_uint4(pack2(acc[2 * s][0], acc[2 * s][1]), pack2(acc[2 * s][2], acc[2 * s][3]),
                           pack2(acc[2 * s + 1][0], acc[2 * s + 1][1]), pack2(acc[2 * s + 1][2], acc[2 * s + 1][3]));
      Sb[s] = __builtin_bit_cast(bf16x8, t);
    }
    const unsigned* vvp = (const unsigned*)&VV[(fq * 64 + w * 16 + fr) * 6];
    const uint2 vv = make_uint2(vvp[0], vvp[1]);
    const bf16x8 Vlow = frag_join(vv, make_uint2(0u, 0u));
    f32x4 Pm = (f32x4){0.f, 0.f, 0.f, 0.f};
#pragma unroll
    for (int s = 0; s < 2; ++s) {
      bf16x8 af = frag_join(*(const uint2*)&At[fr][32 * s + 4 * fq], *(const uint2*)&At[fr][32 * s + 16 + 4 * fq]);
      Pm = mfma16(af, Sb[s], Pm);
    }
    Pm = mfma16(*(const bf16x8*)&AAK[(fr * 4 + fq) * 8], Vlow, Pm);
    const bf16x8 Pb = frag_join(make_uint2(pack2(Pm[0], Pm[1]), pack2(Pm[2], Pm[3])), make_uint2(0u, 0u));
    f32x4 U = mfma16(*(const bf16x8*)&TT[(fr * 4 + fq) * 8], Pb, (f32x4){0.f, 0.f, 0.f, 0.f});
    const bf16x8 UV = frag_join(make_uint2(pack2(U[0], U[1]), pack2(U[2], U[3])), vv);
    f32x4 Yv = (f32x4){0.f, 0.f, 0.f, 0.f};
#pragma unroll
    for (int s = 0; s < 2; ++s) {
      bf16x8 af = frag_join(*(const uint2*)&Rt[fr][32 * s + 4 * fq], *(const uint2*)&Rt[fr][32 * s + 16 + 4 * fq]);
      Yv = mfma16(af, Sb[s], Yv);
    }
    Yv = mfma16(*(const bf16x8*)&ARK[(fr * 4 + fq) * 8], UV, Yv);
    {
      const int p0 = pos0(c);
#pragma unroll
      for (int jj = 0; jj < 4; ++jj) yb[(size_t)(p0 + pstep * (4 * fq + jj)) * INW] = f2bf(Yv[jj]);
    }
#pragma unroll
    for (int kt = 0; kt < 4; ++kt) {
      f32x4 t = mfma16(frag_join(*(const uint2*)&BKT[16 * kt + fr][fq * 8], *(const uint2*)&BKT[16 * kt + fr][fq * 8 + 4]), UV, acc[kt]);
      const float4 g4 = *(const float4*)&G16[16 * kt + 4 * fq];
      t[0] *= g4.x; t[1] *= g4.y; t[2] *= g4.z; t[3] *= g4.w;
      acc[kt] = t;
    }
  };
  __builtin_amdgcn_s_setprio(3);
  Raw r0, r1;
  load_raw(0, r0); load_raw(1, r1);
  stage1(0, r0);
  load_raw(2, r0);
  __syncthreads();
  stage2(0, 0);
  stage1(1, r1);
  load_raw(3, r1);
  __syncthreads();
  int s0 = 0, s1 = 1, s2 = 2;
  auto iter = [&](int c, Raw& rw) {
    if (c + 1 < NCH) stage2(s1, (c + 1) & 1);
    part2(c, s0, c & 1);
    if (c + 2 < NCH) {
      stage1(s2, rw);
      if (c + 4 < NCH) load_raw(c + 4, rw);
    }
    asm volatile("s_waitcnt lgkmcnt(0)" ::: "memory");
    __builtin_amdgcn_s_barrier();
    asm volatile("" ::: "memory");
    const int t = s0; s0 = s1; s1 = s2; s2 = t;
  };
#pragma unroll 1
  for (int c = 0; c < NCH; c += 2) {
    iter(c, r0); iter(c + 1, r1);
  }
  __builtin_amdgcn_s_setprio(0);
}

DEV void ph_rwkv_post(const P& p, int layer) {
  const int lane = tid_() & 63;
  int r0, r1;
  wave_range(r0, r1, NTOK);
  const int ch = 4 * lane;
  float kav[4], rkv[4], lnw[4], lnb[4];
#pragma unroll
  for (int i = 0; i < 4; ++i) {
    kav[i] = p.rw_k_a[layer * 256 + ch + i]; rkv[i] = p.rw_r_k[layer * 256 + ch + i];
    lnw[i] = p.rw_ln_w[layer * 256 + ch + i]; lnb[i] = p.rw_ln_b[layer * 256 + ch + i];
  }
  struct In { uint2 y0, y1, g; uint4 h0, h1, s0, s1; };
  auto ld = [&](int row, In& in) {
    const bf16_t* zr = p.Z + (size_t)row * INW + 768 + ch;
    in.y0 = *(const uint2*)zr; in.y1 = *(const uint2*)(zr + 256);
    const bf16_t* hr = p.H + (size_t)row * D + 4 * ch;
    in.h0 = *(const uint4*)hr; in.h1 = *(const uint4*)(hr + 8);
    const bf16_t* sr = p.SC + (size_t)row * 1024 + 4 * ch;
    in.s0 = *(const uint4*)sr; in.s1 = *(const uint4*)(sr + 8);
    in.g = *(const uint2*)(p.Y + (size_t)row * D + 256 + ch);
  };
  In nx;
  if (r0 < r1) ld(r0, nx);
#pragma unroll 1
  for (int row = r0; row < r1; ++row) {
    const In in = nx;
    if (row + 1 < r1) ld(row + 1, nx);
    float y[4] = {bflo(in.y0.x) + bflo(in.y1.x), bfhi(in.y0.x) + bfhi(in.y1.x), bflo(in.y0.y) + bflo(in.y1.y), bfhi(in.y0.y) + bfhi(in.y1.y)};
    const float mu = row16_sum(y[0] + y[1] + y[2] + y[3]) * (1.f / 64.f);
    float vs = 0.f;
#pragma unroll
    for (int i = 0; i < 4; ++i) { y[i] -= mu; vs += y[i] * y[i]; }
    const float var = row16_sum(vs) * (1.f / 64.f);
    const float rstd = rsqrtf(var + 64e-5f);
    const float r[4] = {bflo(in.h0.x), bflo(in.h0.z), bflo(in.h1.x), bflo(in.h1.z)};
    const float k[4] = {bfhi(in.h0.x), bfhi(in.h0.z), bfhi(in.h1.x), bfhi(in.h1.z)};
    const float v[4] = {bfhi(in.h0.y), bfhi(in.h0.w), bfhi(in.h1.y), bfhi(in.h1.w)};
    const float a0[4] = {bfhi(in.s0.x), bfhi(in.s0.z), bfhi(in.s1.x), bfhi(in.s1.z)};
    const float a1[4] = {bfhi(in.s0.y), bfhi(in.s0.w), bfhi(in.s1.y), bfhi(in.s1.w)};
    float sd = 0.f;
#pragma unroll
    for (int i = 0; i < 4; ++i) {
      const float kd0 = k[i] * (1.f + (a0[i] - 1.f) * kav[i]), kd1 = k[i] * (1.f + (a1[i] - 1.f) * kav[i]);
      sd += r[i] * (kd0 + kd1) * rkv[i];
    }
    sd = row16_sum(sd);
    const float g[4] = {bflo(in.g.x), bfhi(in.g.x), bflo(in.g.y), bfhi(in.g.y)};
    float o[4];
#pragma unroll
    for (int i = 0; i < 4; ++i) {
      const float yn = y[i] * rstd * lnw[i] + lnb[i];
      o[i] = (yn + sd * v[i]) * g[i];
    }
    *(uint2*)(p.Y + (size_t)row * D + 256 + ch) = make_uint2(pack2(o[0], o[1]), pack2(o[2], o[3]));
  }
}

DEV void hyena_pre_unit(const P& p, int layer, int unit) {
  int kind, b, t0, L;
  if (unit < 1024) { kind = 0; b = unit >> 6; t0 = (unit & 63) * 64; L = T; } else { int u = unit - 1024; kind = 1; b = u >> 2; t0 = (u & 3) * 64; L = LC; }
  const int lane = tid_() & 63, wid = tid_() >> 6;
  const int tw = t0 + wid * 16;
  const size_t row0 = (size_t)b * LT + (kind ? 0 : LC);
  const float* cw = p.conv_w + (size_t)layer * 3 * 1536;
  const float* cb = p.conv_b + (size_t)layer * 1536;
  float wx[3][4], wv[3][4], bx[4], bv[4];
#pragma unroll
  for (int i = 0; i < 4; ++i) {
    const int cx = 256 + 4 * lane + i, cv = 512 + 4 * lane + i;
#pragma unroll
    for (int k = 0; k < 3; ++k) { wx[k][i] = cw[k * 1536 + cx]; wv[k][i] = cw[k * 1536 + cv]; }
    bx[i] = cb[cx]; bv[i] = cb[cv];
  }
  uint2 zx[18], zv[18];
#pragma unroll
  for (int i = 0; i < 18; ++i) {
    const int t = tw - 1 + i;
    if (t >= 0 && t < L) {
      const bf16_t* zr = p.Z + (row0 + t) * INW + 256 + 4 * lane;
      zx[i] = *(const uint2*)zr; zv[i] = *(const uint2*)(zr + 256);
    } else { zx[i] = make_uint2(0u, 0u); zv[i] = make_uint2(0u, 0u); }
  }
  float uo[4][16];
#pragma unroll
  for (int i = 0; i < 16; ++i) {
    const float xm[4] = {bflo(zx[i].x), bfhi(zx[i].x), bflo(zx[i].y), bfhi(zx[i].y)};
    const float xc[4] = {bflo(zx[i + 1].x), bfhi(zx[i + 1].x), bflo(zx[i + 1].y), bfhi(zx[i + 1].y)};
    const float xp[4] = {bflo(zx[i + 2].x), bfhi(zx[i + 2].x), bflo(zx[i + 2].y), bfhi(zx[i + 2].y)};
    const float vm[4] = {bflo(zv[i].x), bfhi(zv[i].x), bflo(zv[i].y), bfhi(zv[i].y)};
    const float vc[4] = {bflo(zv[i + 1].x), bfhi(zv[i + 1].x), bflo(zv[i + 1].y), bfhi(zv[i + 1].y)};
    const float vp[4] = {bflo(zv[i + 2].x), bfhi(zv[i + 2].x), bflo(zv[i + 2].y), bfhi(zv[i + 2].y)};
#pragma unroll
    for (int q = 0; q < 4; ++q) {
      const float a = wx[0][q] * xm[q] + wx[1][q] * xc[q] + wx[2][q] * xp[q] + bx[q];
      const float c2 = wv[0][q] * vm[q] + wv[1][q] * vc[q] + wv[2][q] * vp[q] + bv[q];
      uo[q][i] = a * c2;
    }
  }
  bf16_t* ut = kind ? opq(p.UTc) : opq(p.UTl);
#pragma unroll
  for (int q = 0; q < 4; ++q) {
    bf16_t* dst = ut + ((size_t)(4 * lane + q) * 16 + b) * L + tw;
    *(uint4*)dst = pack8(&uo[q][0]);
    *(uint4*)(dst + 8) = pack8(&uo[q][8]);
  }
}

DEV void hyena_conv_unit(const P& p, int layer, int unit, char* smem) {
  int kind, c, tb, L;
  if (unit < 4096) { kind = 0; c = unit >> 4; tb = (unit & 15) * 256; L = T; } else { kind = 1; c = unit - 4096; tb = 0; L = LC; }
  const int tid = tid_(), lane = tid & 63, wid = tid >> 6, fr = lane & 15, fq = lane >> 4;
  float* red = (float*)(smem + 2 * 16512);
  const float* F = (kind ? opq(p.FC) : opq(p.FL)) + (size_t)c * 2 * L;
  float scale;
  {
    float part = 0.f;
    for (int i = tid; i < 2 * L; i += 256) { float fv = F[i]; part += (i != L) ? fv * fv : 0.f; }
    part = wave_sum(part);
    __syncthreads();
    if (lane == 0) red[wid] = part;
    __syncthreads();
    scale = rsqrtf(((red[0] + red[1]) + (red[2] + red[3])) + 1e-6f);
  }
  const bf16_t* U = (kind ? opq(p.UTc) : opq(p.UTl)) + (size_t)c * 16 * L;
  f32x4 acc[4];
#pragma unroll
  for (int m = 0; m < 4; ++m) acc[m] = (f32x4){0.f, 0.f, 0.f, 0.f};
  const int nch = L / 256;
  float fw0, fw1, fw2;
  uint4 ru0, ru1;
  auto ldchunk = [&](int ch) {
    const int sc = ch * 256;
    const int D0 = tb + 256 - sc;
    auto tap = [&](int n) -> float {
      int d = D0 - n;
      float v = 0.f;
      if (d > -L && d < L) v = (d >= 0 ? F[d] : F[L - d]);
      return v;
    };
    fw0 = tap(tid); fw1 = tap(tid + 256); fw2 = (tid < 8) ? tap(tid + 512) : 0.f;
    const int bb = tid >> 4, sg0 = tid & 15;
    ru0 = *(const uint4*)(U + (size_t)bb * L + sc + 8 * sg0);
    ru1 = *(const uint4*)(U + (size_t)bb * L + sc + 8 * (sg0 + 16));
  };
  auto stchunk = [&](int buf) {
    bf16_t* Cq = (bf16_t*)(smem + buf * 16512);
    bf16_t* Us = (bf16_t*)(smem + buf * 16512 + 8320);
    const bf16_t h0 = f2bf(fw0 * scale), h1 = f2bf(fw1 * scale), h2 = f2bf(fw2 * scale);
#pragma unroll
    for (int rho = 0; rho < 8; ++rho) {
      int m = tid + rho;
      Cq[((m >> 3) * 8 + rho) * 8 + (m & 7)] = h0;
      m = tid + 256 + rho;
      if (m < 520) Cq[((m >> 3) * 8 + rho) * 8 + (m & 7)] = h1;
      m = tid + 512 + rho;
      if (tid < 8 && m < 520) Cq[((m >> 3) * 8 + rho) * 8 + (m & 7)] = h2;
    }
    if (tid < 8) {
#pragma unroll
      for (int rho = 1; rho < 8; ++rho) if (tid < rho) Cq[(rho) * 8 + tid] = 0;
    }
    const int bb = tid >> 4, sg0 = tid & 15;
    *(uint4*)&Us[(sg0 * 16 + bb) * 8] = ru0;
    *(uint4*)&Us[((sg0 + 16) * 16 + bb) * 8] = ru1;
  };
  ldchunk(0);
#pragma unroll 1
  for (int ch = 0; ch < nch; ++ch) {
    const int buf = ch & 1;
    stchunk(buf);
    __syncthreads();
    if (ch + 1 < nch) ldchunk(ch + 1);
    const bf16_t* Cq = (const bf16_t*)(smem + buf * 16512);
    const bf16_t* Us = (const bf16_t*)(smem + buf * 16512 + 8320);
#pragma unroll
    for (int kk = 0; kk < 8; ++kk) {
      bf16x8 bf = *(const bf16x8*)&Us[((4 * kk + fq) * 16 + fr) * 8];
#pragma unroll
      for (int m = 0; m < 4; ++m) {
        int it = wid * 4 + m;
        int base = 256 - 16 * it + 32 * kk + 8 * fq;
        int m0 = base - 8 * (fr >> 3);
        bf16x8 af = *(const bf16x8*)&Cq[((m0 >> 3) * 8 + (fr & 7)) * 8];
        acc[m] = mfma16(af, bf, acc[m]);
      }
    }
  }
  __syncthreads();
  bf16_t* Yt = (kind ? opq(p.YTc) : opq(p.YTl)) + ((size_t)c * 16 + fr) * L + tb;
#pragma unroll
  for (int m = 0; m < 4; ++m) {
    int t = (wid * 4 + m) * 16 + fq * 4;
    *(uint2*)(Yt + t) = make_uint2(pack2(acc[m][0], acc[m][1]), pack2(acc[m][2], acc[m][3]));
  }
}

DEV void hyena_post_unit(const P& p, int layer, int unit, char* smem) {
  (void)smem;
  int kind, b, t0, L;
  if (unit < 1024) { kind = 0; b = unit >> 6; t0 = (unit & 63) * 64; L = T; } else { int u = unit - 1024; kind = 1; b = u >> 2; t0 = (u & 3) * 64; L = LC; }
  const int lane = tid_() & 63, wid = tid_() >> 6;
  const int tw = t0 + wid * 16;
  const size_t row0 = (size_t)b * LT + (kind ? 0 : LC);
  const float* cw = p.conv_w + (size_t)layer * 3 * 1536;
  float w0[3][4], b0[4], bias[4], og[4];
#pragma unroll
  for (int i = 0; i < 4; ++i) {
    const int c = 4 * lane + i;
#pragma unroll
    for (int k = 0; k < 3; ++k) w0[k][i] = cw[k * 1536 + c];
    b0[i] = p.conv_b[layer * 1536 + c]; bias[i] = p.hy_bias[layer * 256 + c]; og[i] = p.hy_out_g[layer * 256 + c];
  }
  uint2 zx[18];
#pragma unroll
  for (int i = 0; i < 18; ++i) {
    const int t = tw - 1 + i;
    zx[i] = (t >= 0 && t < L) ? *(const uint2*)(p.Z + (row0 + t) * INW + 4 * lane) : make_uint2(0u, 0u);
  }
  const bf16_t* ytb = kind ? opq(p.YTc) : opq(p.YTl);
  const bf16_t* utb = kind ? opq(p.UTc) : opq(p.UTl);
  float o[4][16];
#pragma unroll
  for (int q = 0; q < 4; ++q) {
    const size_t off = ((size_t)(4 * lane + q) * 16 + b) * L + tw;
    float yv[16], uv[16];
    { uint4 a0 = *(const uint4*)(ytb + off), a1 = *(const uint4*)(ytb + off + 8); unpack8(a0, yv); unpack8(a1, yv + 8); }
    { uint4 a0 = *(const uint4*)(utb + off), a1 = *(const uint4*)(utb + off + 8); unpack8(a0, uv); unpack8(a1, uv + 8); }
#pragma unroll
    for (int i = 0; i < 16; ++i) o[q][i] = yv[i] + uv[i] * bias[q];
  }
#pragma unroll
  for (int i = 0; i < 16; ++i) {
    const float xm[4] = {bflo(zx[i].x), bfhi(zx[i].x), bflo(zx[i].y), bfhi(zx[i].y)};
    const float xc[4] = {bflo(zx[i + 1].x), bfhi(zx[i + 1].x), bflo(zx[i + 1].y), bfhi(zx[i + 1].y)};
    const float xp[4] = {bflo(zx[i + 2].x), bfhi(zx[i + 2].x), bflo(zx[i + 2].y), bfhi(zx[i + 2].y)};
    float ov[4], ss = 0.f;
#pragma unroll
    for (int q = 0; q < 4; ++q) {
      const float x0 = w0[0][q] * xm[q] + w0[1][q] * xc[q] + w0[2][q] * xp[q] + b0[q];
      ov[q] = bf2f(f2bf(x0 * o[q][i]));
      ss += ov[q] * ov[q];
    }
    ss = wave_sum(ss);
    const float rstd = rsqrtf(ss * (1.f / 256.f) + 1e-6f);
    *(uint2*)(p.Y + (row0 + tw + i) * D + 4 * lane) = make_uint2(pack2(ov[0] * rstd * og[0], ov[1] * rstd * og[1]), pack2(ov[2] * rstd * og[2], ov[3] * rstd * og[3]));
  }
}

DEV void attn_unit(const P& p, int layer, int unit, char* smem) {
  const bool isctx = unit >= 4096;
  int b, qb, hq;
  if (!isctx) { b = unit >> 8; qb = (unit >> 3) & 31; hq = unit & 7; } else { int u = unit - 4096; b = u >> 4; qb = (u >> 3) & 1; hq = u & 7; }
  const int g = hq >> 2;
  const int tid = tid_(), lane = tid & 63, wid = tid >> 6, qn = lane & 31, hh = lane >> 5;
  const int qpos = qb * 128 + wid * 32 + qn;
  const size_t qrow = (size_t)b * LT + (isctx ? qpos : LC + qpos);
  const bf16_t* qptr = p.Z + qrow * INW + 1920 + hq * 64;
  bf16x8 qf[4];
#pragma unroll
  for (int s = 0; s < 4; ++s) qf[s] = *(const bf16x8*)(qptr + 16 * s + 8 * hh);
  const float sink = p.attn_sink[layer * 8 + hq];
  float m_run = sink, l_run = 1.f;
  f32x16 o0, o1;
#pragma unroll
  for (int i = 0; i < 16; ++i) { o0[i] = 0.f; o1[i] = 0.f; }
  typedef bf16_t KTile[64][72];
  KTile* Ks = (KTile*)smem;
  KTile* Vt = (KTile*)(smem + 18432);
  const int ntl = isctx ? 0 : 6;
  const int ntiles = ntl + 4;
  const int skey = tid >> 3, sseg = tid & 7;
  const bf16_t* kvbase = p.Z + (size_t)b * LT * INW + 1920 + 512 + g * 64 + sseg * 8;
  uint4 rk0, rk1, rv0, rv1;
  auto ldtile = [&](int kt) {
    const bool ctxk = kt >= ntl;
    const int kbase = ctxk ? (kt - ntl) * 64 : qb * 128 - 128 + kt * 64;
    const int kp0 = kbase + skey, kp1 = kp0 + 32;
    rk0 = rk1 = rv0 = rv1 = make_uint4(0, 0, 0, 0);
    if (ctxk || (kp0 >= 0 && kp0 < T)) { const bf16_t* src = kvbase + (size_t)(ctxk ? kp0 : LC + kp0) * INW; rk0 = *(const uint4*)src; rv0 = *(const uint4*)(src + 128); }
    if (ctxk || (kp1 >= 0 && kp1 < T)) { const bf16_t* src = kvbase + (size_t)(ctxk ? kp1 : LC + kp1) * INW; rk1 = *(const uint4*)src; rv1 = *(const uint4*)(src + 128); }
  };
  auto sttile = [&](int buf) {
    *(uint4*)&Ks[buf][skey][sseg * 8] = rk0;
    *(uint4*)&Ks[buf][skey + 32][sseg * 8] = rk1;
    bf16_t (*vt)[72] = Vt[buf];
    vt[sseg * 8 + 0][skey] = (bf16_t)(rv0.x & 0xFFFF); vt[sseg * 8 + 1][skey] = (bf16_t)(rv0.x >> 16);
    vt[sseg * 8 + 2][skey] = (bf16_t)(rv0.y & 0xFFFF); vt[sseg * 8 + 3][skey] = (bf16_t)(rv0.y >> 16);
    vt[sseg * 8 + 4][skey] = (bf16_t)(rv0.z & 0xFFFF); vt[sseg * 8 + 5][skey] = (bf16_t)(rv0.z >> 16);
    vt[sseg * 8 + 6][skey] = (bf16_t)(rv0.w & 0xFFFF); vt[sseg * 8 + 7][skey] = (bf16_t)(rv0.w >> 16);
    vt[sseg * 8 + 0][skey + 32] = (bf16_t)(rv1.x & 0xFFFF); vt[sseg * 8 + 1][skey + 32] = (bf16_t)(rv1.x >> 16);
    vt[sseg * 8 + 2][skey + 32] = (bf16_t)(rv1.y & 0xFFFF); vt[sseg * 8 + 3][skey + 32] = (bf16_t)(rv1.y >> 16);
    vt[sseg * 8 + 4][skey + 32] = (bf16_t)(rv1.z & 0xFFFF); vt[sseg * 8 + 5][skey + 32] = (bf16_t)(rv1.z >> 16);
    vt[sseg * 8 + 6][skey + 32] = (bf16_t)(rv1.w & 0xFFFF); vt[sseg * 8 + 7][skey + 32] = (bf16_t)(rv1.w >> 16);
  };
  ldtile(0);
#pragma unroll 1
  for (int kt = 0; kt < ntiles; ++kt) {
    const int buf = kt & 1;
    sttile(buf);
    __syncthreads();
    if (kt + 1 < ntiles) ldtile(kt + 1);
    const bool ctxk = kt >= ntl;
    const int kbase = ctxk ? (kt - ntl) * 64 : qb * 128 - 128 + kt * 64;
#pragma unroll
    for (int sub = 0; sub < 2; ++sub) {
      const int kb2 = kbase + sub * 32;
      bool need = true;
      if (!ctxk) {
        int q0 = qb * 128 + wid * 32;
        if (kb2 + 31 < q0 - 128 || kb2 > q0 + 31 + 128 || kb2 + 31 < 0 || kb2 >= T) need = false;
      }
      if (need) {
        f32x16 sv;
#pragma unroll
        for (int i = 0; i < 16; ++i) sv[i] = 0.f;
#pragma unroll
        for (int ks = 0; ks < 4; ++ks) {
          bf16x8 kf = *(const bf16x8*)&Ks[buf][sub * 32 + qn][16 * ks + 8 * hh];
          sv = mfma32(kf, qf[ks], sv);
        }
        float mt = -3e38f;
#pragma unroll
        for (int rg = 0; rg < 16; ++rg) {
          float v = sv[rg] * 0.125f;
          if (!ctxk) {
            int kp = kb2 + (rg & 3) + 8 * (rg >> 2) + 4 * hh;
            int dl = qpos - kp;
            bool ok = (dl <= 128) && (dl >= -128) && (kp >= 0) && (kp < T);
            v = ok ? v : -1e30f;
          }
          sv[rg] = v;
          mt = fmaxf(mt, v);
        }
        mt = fmaxf(mt, __shfl_xor(mt, 32));
        float m_new = fmaxf(m_run, mt);
        float corr = __expf(m_run - m_new);
        float ps = 0.f;
#pragma unroll
        for (int rg = 0; rg < 16; ++rg) { float pv = __expf(sv[rg] - m_new); sv[rg] = pv; ps += pv; }
        ps += __shfl_xor(ps, 32);
        l_run = l_run * corr + ps;
        m_run = m_new;
#pragma unroll
        for (int i = 0; i < 16; ++i) { o0[i] *= corr; o1[i] *= corr; }
#pragma unroll
        for (int sp = 0; sp < 2; ++sp) {
          bf16x8 pf;
#pragma unroll
          for (int j = 0; j < 8; ++j) pf[j] = (short)f2bf(sv[8 * sp + j]);
          const int kc = sub * 32 + 16 * sp + 4 * hh;
          uint2 va = *(const uint2*)&Vt[buf][qn][kc], vb = *(const uint2*)&Vt[buf][qn][kc + 8];
          uint2 vc = *(const uint2*)&Vt[buf][32 + qn][kc], vd = *(const uint2*)&Vt[buf][32 + qn][kc + 8];
          uint4 w0 = make_uint4(va.x, va.y, vb.x, vb.y), w1 = make_uint4(vc.x, vc.y, vd.x, vd.y);
          bf16x8 v0 = __builtin_bit_cast(bf16x8, w0), v1 = __builtin_bit_cast(bf16x8, w1);
          o0 = mfma32(v0, pf, o0);
          o1 = mfma32(v1, pf, o1);
        }
      }
    }
  }
  __syncthreads();
  const float inv = 1.f / l_run;
  bf16_t* optr = p.Y + qrow * D + 512 + hq * 64;
#pragma unroll
  for (int rg = 0; rg < 4; ++rg) {
    int d0 = 8 * rg + 4 * hh;
    *(uint2*)(optr + d0) = make_uint2(pack2(o0[4 * rg] * inv, o0[4 * rg + 1] * inv), pack2(o0[4 * rg + 2] * inv, o0[4 * rg + 3] * inv));
    *(uint2*)(optr + 32 + d0) = make_uint2(pack2(o1[4 * rg] * inv, o1[4 * rg + 1] * inv), pack2(o1[4 * rg + 2] * inv, o1[4 * rg + 3] * inv));
  }
}

DEV void ph_attn_post(const P& p, int layer) {
  const int lane = tid_() & 63;
  int r0, r1;
  wave_range(r0, r1, NTOK);
  float gv[8];
#pragma unroll
  for (int i = 0; i < 8; ++i) gv[i] = p.at_out_g[layer * 512 + 8 * lane + i];
  uint4 nx = make_uint4(0, 0, 0, 0);
  if (r0 < r1) nx = *(const uint4*)(p.Y + (size_t)r0 * D + 512 + 8 * lane);
#pragma unroll 1
  for (int row = r0; row < r1; ++row) {
    const uint4 u = nx;
    if (row + 1 < r1) nx = *(const uint4*)(p.Y + (size_t)(row + 1) * D + 512 + 8 * lane);
    float v[8];
    unpack8(u, v);
    float ss = 0.f;
#pragma unroll
    for (int i = 0; i < 8; ++i) ss += v[i] * v[i];
    ss = wave_sum(ss);
    const float rstd = rsqrtf(ss * (1.f / 512.f) + 1e-6f);
#pragma unroll
    for (int i = 0; i < 8; ++i) {
      v[i] = v[i] * rstd * gv[i];
    }
    *(uint4*)(p.Y + (size_t)row * D + 512 + 8 * lane) = pack8(v);
  }
}

struct Epi2 {
  const P& p; int layer, row0, col0;
  DEV void operator()(f32x4 (&acc)[4][4], int wr, int wc, int fr, int fq, char* smem) const {
    const int b = row0 / LT, pp = row0 % LT;
    const int mr = pp < LC ? 16 : b;
    const float* g1 = p.modv + ((size_t)layer * 17 + mr) * 6144 + 2048 + col0 + wc * 64;
#pragma unroll
    for (int n = 0; n < 4; ++n) {
      const float4 gv = *(const float4*)(g1 + n * 16 + 4 * fq);
#pragma unroll
      for (int m = 0; m < 4; ++m) { acc[m][n][0] *= gv.x; acc[m][n][1] *= gv.y; acc[m][n][2] *= gv.z; acc[m][n][3] *= gv.w; }
    }
    const int wid = wr * 2 + wc, lane = fq * 16 + fr;
    stage_tile_bf16(acc, smem, wid, fr, fq);
    const bf16_t (*t)[72] = (const bf16_t (*)[72])(smem + wid * 9216);
#pragma unroll
    for (int i = 0; i < 8; ++i) {
      const int rl = i * 8 + (lane >> 3), ch = lane & 7;
      bf16_t* xp = p.X + (size_t)(row0 + wr * 64 + rl) * D + col0 + wc * 64 + ch * 8;
      float xv[8], dv[8];
      uint4 xu = *(const uint4*)xp, du = *(const uint4*)&t[rl][ch * 8];
      unpack8(xu, xv); unpack8(du, dv);
#pragma unroll
      for (int q = 0; q < 8; ++q) xv[q] += dv[q];
      *(uint4*)xp = pack8(xv);
    }
  }
};
DEV void ph_gemm2(const P& p, int layer, char* smem) {
  int rt, ct;
  for (int it = 0; gemm_unit(it, 8, rt, ct); ++it) {
    Epi2 epi{p, layer, rt * 128, ct * 128};
    gemm_tile(p.Y + (size_t)rt * 128 * D, D, p.W2t + (size_t)ct * 128 * D, D, D, smem, epi);
  }
}

DEV void ph_peerconv(const P& p, int layer) {
  const int gw = (bid_() * 256 + tid_()) >> 6, nw = gridDim.x * 4, lane = tid_() & 63;
  const float* su = opq(p.peer_u) + (size_t)layer * 16384 * 1024;
  const float* sv = opq(p.peer_v) + (size_t)layer * 16384 * 1024;
  unsigned char* pu = opq(p.PU); unsigned char* pv = opq(p.PV);
  float* psu = opq(p.PSU); float* psv = opq(p.PSV);
  auto ldrow = [&](int r, float4& a0, float4& a1, float4& a2, float4& a3) {
    const float* src = ((r >= 16384) ? sv : su) + (size_t)(r & 16383) * 1024 + 16 * lane;
    a0 = *(const float4*)src; a1 = *(const float4*)(src + 4); a2 = *(const float4*)(src + 8); a3 = *(const float4*)(src + 12);
  };
  float4 n0 = make_float4(0, 0, 0, 0), n1 = n0, n2 = n0, n3 = n0;
  if (gw < 32768) ldrow(gw, n0, n1, n2, n3);
#pragma unroll 1
  for (int r = gw; r < 32768; r += nw) {
    const bool isv = r >= 16384;
    const int e = r & 16383;
    const float4 f0 = n0, f1 = n1, f2 = n2, f3 = n3;
    if (r + nw < 32768) ldrow(r + nw, n0, n1, n2, n3);
    float am = fmaxf(fmaxf(fmaxf(fabsf(f0.x), fabsf(f0.y)), fmaxf(fabsf(f0.z), fabsf(f0.w))), fmaxf(fmaxf(fabsf(f1.x), fabsf(f1.y)), fmaxf(fabsf(f1.z), fabsf(f1.w))));
    am = fmaxf(am, fmaxf(fmaxf(fmaxf(fabsf(f2.x), fabsf(f2.y)), fmaxf(fabsf(f2.z), fabsf(f2.w))), fmaxf(fmaxf(fabsf(f3.x), fabsf(f3.y)), fmaxf(fabsf(f3.z), fabsf(f3.w)))));
    am = wave_max(am);
    int w0, w1, w2, w3;
    float inv;
    if (isv) {
      const float sc = am > 0.f ? 224.f / am : 1.f;
      inv = am > 0.f ? am * (1.f / 224.f) : 1.f;
      w0 = __builtin_amdgcn_cvt_pk_fp8_f32(f0.x * sc, f0.y * sc, 0, false); w0 = __builtin_amdgcn_cvt_pk_fp8_f32(f0.z * sc, f0.w * sc, w0, true);
      w1 = __builtin_amdgcn_cvt_pk_fp8_f32(f1.x * sc, f1.y * sc, 0, false); w1 = __builtin_amdgcn_cvt_pk_fp8_f32(f1.z * sc, f1.w * sc, w1, true);
      w2 = __builtin_amdgcn_cvt_pk_fp8_f32(f2.x * sc, f2.y * sc, 0, false); w2 = __builtin_amdgcn_cvt_pk_fp8_f32(f2.z * sc, f2.w * sc, w2, true);
      w3 = __builtin_amdgcn_cvt_pk_fp8_f32(f3.x * sc, f3.y * sc, 0, false); w3 = __builtin_amdgcn_cvt_pk_fp8_f32(f3.z * sc, f3.w * sc, w3, true);
    } else {
      const float sc = am > 0.f ? 127.f / am : 1.f;
      inv = am > 0.f ? am * (1.f / 127.f) : 1.f;
      w0 = pack_i8(f0.x * sc, f0.y * sc, f0.z * sc, f0.w * sc); w1 = pack_i8(f1.x * sc, f1.y * sc, f1.z * sc, f1.w * sc);
      w2 = pack_i8(f2.x * sc, f2.y * sc, f2.z * sc, f2.w * sc); w3 = pack_i8(f3.x * sc, f3.y * sc, f3.z * sc, f3.w * sc);
    }
    *(uint4*)((isv ? pv : pu) + (size_t)(lane >> 3) * PSLICE + (size_t)e * 128 + 16 * (lane & 7)) = make_uint4((unsigned)w0, (unsigned)w1, (unsigned)w2, (unsigned)w3);
    if (lane == 0) (isv ? psv : psu)[e] = inv;
  }
}
DEV void unpack16_fp8x2(const uint4& u, f32x2* f) {
  f[0] = __builtin_amdgcn_cvt_pk_f32_fp8((int)u.x, false); f[1] = __builtin_amdgcn_cvt_pk_f32_fp8((int)u.x, true);
  f[2] = __builtin_amdgcn_cvt_pk_f32_fp8((int)u.y, false); f[3] = __builtin_amdgcn_cvt_pk_f32_fp8((int)u.y, true);
  f[4] = __builtin_amdgcn_cvt_pk_f32_fp8((int)u.z, false); f[5] = __builtin_amdgcn_cvt_pk_f32_fp8((int)u.z, true);
  f[6] = __builtin_amdgcn_cvt_pk_f32_fp8((int)u.w, false); f[7] = __builtin_amdgcn_cvt_pk_f32_fp8((int)u.w, true);
}

DEV void bitonic_sort16_desc(float (&v)[16]) {
#pragma unroll
  for (int k = 2; k <= 16; k <<= 1)
#pragma unroll
    for (int j = k >> 1; j >= 1; j >>= 1)
#pragma unroll
      for (int i = 0; i < 16; ++i) {
        const int l = i ^ j;
        if (l > i) {
          const float hi = fmaxf(v[i], v[l]), lo = fminf(v[i], v[l]);
          if ((i & k) == 0) { v[i] = hi; v[l] = lo; } else { v[i] = lo; v[l] = hi; }
        }
      }
}
DEV void peer_cand_ij(int c, int& ci, int& cj) {
  if (c < 16) { ci = 0; cj = c; } else if (c < 24) { ci = 1; cj = c - 16; } else if (c < 29) { ci = 2; cj = c - 24; }
  else if (c < 33) { ci = 3; cj = c - 29; } else if (c < 36) { ci = 4; cj = c - 33; } else if (c < 38) { ci = 5; cj = c - 36; }
  else if (c < 40) { ci = 6; cj = c - 38; } else if (c < 42) { ci = 7; cj = c - 40; } else { ci = (c - 42 + 8) & 15; cj = 0; }
}
template <int S>
struct Epi3K {
  const P& p; int row0, head; float (&keep)[2][16];
  DEV void operator()(f32x4 (&acc)[4][4], int wr, int wc, int fr, int fq, char* smem) const {
    float* sc = (float*)smem;
    float* L1s = (float*)(smem + 36864);
    float* L2s = (float*)(smem + 45056);
    const int tid = tid_();
#pragma unroll
    for (int pass = 0; pass < 2; ++pass) {
      __syncthreads();
      if (wr == pass) {
#pragma unroll
        for (int m = 0; m < 4; ++m)
#pragma unroll
          for (int n = 0; n < 4; ++n)
#pragma unroll
            for (int j = 0; j < 4; ++j) {
              int rl = m * 16 + fr, col = wc * 64 + n * 16 + 4 * fq + j;
              unsigned bits = (__float_as_uint(acc[m][n][j]) & ~127u) | (unsigned)col;
              sc[rl * 133 + (col >> 5) * 33 + (col & 31)] = __uint_as_float(bits);
            }
      }
      __syncthreads();
      const int rl = tid >> 2, q = tid & 3;
      const float* src = sc + rl * 133 + q * 33;
      float Ls[16], Hs[16];
#pragma unroll
      for (int i = 0; i < 16; ++i) { Ls[i] = src[i]; Hs[i] = src[16 + i]; }
      bitonic_sort16_desc(Ls);
      bitonic_sort16_desc(Hs);
#pragma unroll
      for (int i = 0; i < 16; ++i) Ls[i] = fmaxf(Ls[i], Hs[15 - i]);
#pragma unroll
      for (int d = 8; d >= 1; d >>= 1)
#pragma unroll
        for (int i = 0; i < 16; ++i)
          if ((i & d) == 0) { float hi = fmaxf(Ls[i], Ls[i + d]), lo = fminf(Ls[i], Ls[i + d]); Ls[i] = hi; Ls[i + d] = lo; }
      float Cs[16];
#pragma unroll
      for (int i = 0; i < 16; ++i) Cs[i] = fmaxf(Ls[i], dppself<0xB1, 0xF>(Ls[15 - i]));
#pragma unroll
      for (int d = 8; d >= 1; d >>= 1)
#pragma unroll
        for (int i = 0; i < 16; ++i)
          if ((i & d) == 0) { float hi = fmaxf(Cs[i], Cs[i + d]), lo = fminf(Cs[i], Cs[i + d]); Cs[i] = hi; Cs[i + d] = lo; }
      float Ds[16];
#pragma unroll
      for (int i = 0; i < 16; ++i) Ds[i] = fmaxf(Cs[i], dppself<0x4E, 0xF>(Cs[15 - i]));
#pragma unroll
      for (int d = 8; d >= 1; d >>= 1)
#pragma unroll
        for (int i = 0; i < 16; ++i)
          if ((i & d) == 0) { float hi = fmaxf(Ds[i], Ds[i + d]), lo = fminf(Ds[i], Ds[i + d]); Ds[i] = hi; Ds[i + d] = lo; }
      if (S == 0) {
#pragma unroll
        for (int i = 0; i < 16; ++i) keep[pass][i] = Ds[i];
      } else if (q == 0) {
        float* d1 = L1s + (pass * 64 + rl) * 16;
        float* d2 = L2s + (pass * 64 + rl) * 16;
#pragma unroll
        for (int i = 0; i < 4; ++i) {
          *(float4*)(d1 + 4 * i) = make_float4(keep[pass][4 * i], keep[pass][4 * i + 1], keep[pass][4 * i + 2], keep[pass][4 * i + 3]);
          *(float4*)(d2 + 4 * i) = make_float4(Ds[4 * i], Ds[4 * i + 1], Ds[4 * i + 2], Ds[4 * i + 3]);
        }
      }
    }
    if (S == 1) {
      __syncthreads();
      const int lane = tid & 63, wid = tid >> 6;
      int ci, cj;
      peer_cand_ij(lane, ci, cj);
      const bool cand = lane < 50;
      float n1 = L1s[(wid * 32) * 16 + ci], n2 = L2s[(wid * 32) * 16 + cj];
#pragma unroll 1
      for (int r = 0; r < 32; ++r) {
        const int row = wid * 32 + r;
        const float v1 = n1, v2 = n2;
        if (r + 1 < 32) { n1 = L1s[(row + 1) * 16 + ci]; n2 = L2s[(row + 1) * 16 + cj]; }
        float val = v1 + v2;
        val = __uint_as_float((__float_as_uint(val) & ~63u) | (unsigned)lane);
        val = cand ? val : -3e38f;
        int rank = 0;
#pragma unroll
        for (int q = 0; q < 50; ++q) rank += (readlane_f(val, q) > val) ? 1 : 0;
        const bool sel = cand && rank < 16;
        const float mx = readlane_f(val, 0);
        const float ex = sel ? __expf(val - mx) : 0.f;
        const float sm = wave_sum(ex);
        if (sel) {
          const int e = (int)(__float_as_uint(v1) & 127u) * 128 + (int)(__float_as_uint(v2) & 127u);
          const size_t o = (size_t)(row0 + row) * 128 + head * 16 + rank;
          p.EL[o] = (unsigned short)e;
          p.GT[o] = ex / sm;
        }
      }
    }
  }
};
DEV void ph_gemm3(const P& p, char* smem) {
  int rt, hd;
  for (int it = 0; gemm_unit(it, 8, rt, hd); ++it) {
    float keep[2][16];
    {
      Epi3K<0> epi{p, rt * 128, hd, keep};
      gemm_tile(p.H + (size_t)rt * 128 * D, D, p.Wft + (size_t)(2 * hd) * 128 * D, D, D, smem, epi);
    }
    {
      Epi3K<1> epi{p, rt * 128, hd, keep};
      gemm_tile(p.H + (size_t)rt * 128 * D, D, p.Wft + (size_t)(2 * hd + 1) * 128 * D, D, D, smem, epi);
    }
  }
}

DEV float peer_gate(float scr) {
  float mx = row16_max(scr);
  float ex = __expf(scr - mx);
  float sm = row16_sum(ex);
  return ex / sm;
}
DEV float gelu_exact(float x) { return 0.5f * x * (1.f + erff(x * 0.7071067811865476f)); }

struct PeerPre { uint4 e0, e1, a0, a1, a2, a3; };
DEV unsigned peer_eid(const PeerPre& s, int j) {
  const unsigned w = (j < 8) ? ((j >> 1) == 0 ? s.e0.x : (j >> 1) == 1 ? s.e0.y : (j >> 1) == 2 ? s.e0.z : s.e0.w)
                             : (((j - 8) >> 1) == 0 ? s.e1.x : ((j - 8) >> 1) == 1 ? s.e1.y : ((j - 8) >> 1) == 2 ? s.e1.z : s.e1.w);
  return (j & 1) ? (w >> 16) : (w & 0xFFFFu);
}
template <int WHICH>
DEV void peer_wave_run(const P& p, int layer, int x, int tok0, int lane, float* wbuf) {
  const int r = lane >> 3, c = lane & 7;
  const unsigned char* tb = (WHICH == 0 ? p.PU : p.PV) + (size_t)x * PSLICE + c * 16;
  PeerPre S[3];
  uint4 R[16];
  auto ld_pre = [&](int tok, PeerPre& s) {
    const uint4* elp = (const uint4*)(p.EL + (size_t)tok * 128 + r * 16);
    s.e0 = elp[0]; s.e1 = elp[1];
    if (WHICH == 0) {
      s.a0 = *(const uint4*)(p.H8 + (size_t)tok * 1024 + x * 128 + c * 16);
    } else {
      const uint4* wtp = (const uint4*)(p.GT + (size_t)tok * 128 + r * 16);
      s.a0 = wtp[0]; s.a1 = wtp[1]; s.a2 = wtp[2]; s.a3 = wtp[3];
    }
  };
  auto comp = [&](int tok, const PeerPre& s, const PeerPre& sn, bool more) {
    if (WHICH == 0) {
      int keep0 = 0, keep1 = 0;
#pragma unroll
      for (int j = 0; j < 16; ++j) {
        const uint4 rw = R[j];
        if (more) R[j] = *(const uint4*)(tb + (size_t)peer_eid(sn, j) * 128);
        int d = __builtin_amdgcn_sdot4((int)rw.x, (int)s.a0.x, 0, false);
        d = __builtin_amdgcn_sdot4((int)rw.y, (int)s.a0.y, d, false);
        d = __builtin_amdgcn_sdot4((int)rw.z, (int)s.a0.z, d, false);
        d = __builtin_amdgcn_sdot4((int)rw.w, (int)s.a0.w, d, false);
        d += __builtin_amdgcn_update_dpp(0, d, 0xB1, 0xF, 0xF, false);
        d += __builtin_amdgcn_update_dpp(0, d, 0x4E, 0xF, 0xF, false);
        d += __builtin_amdgcn_update_dpp(0, d, 0x141, 0xF, 0xF, false);
        if (j < 8) keep0 = (c == j) ? d : keep0; else keep1 = (c == j - 8) ? d : keep1;
      }
      bf16_t* pd = p.PD + ((size_t)x * NTOK + tok) * 128 + r * 16 + c;
      pd[0] = f2bf((float)keep0); pd[8] = f2bf((float)keep1);
    } else {
      const float wsv[16] = {__uint_as_float(s.a0.x), __uint_as_float(s.a0.y), __uint_as_float(s.a0.z), __uint_as_float(s.a0.w),
                             __uint_as_float(s.a1.x), __uint_as_float(s.a1.y), __uint_as_float(s.a1.z), __uint_as_float(s.a1.w),
                             __uint_as_float(s.a2.x), __uint_as_float(s.a2.y), __uint_as_float(s.a2.z), __uint_as_float(s.a2.w),
                             __uint_as_float(s.a3.x), __uint_as_float(s.a3.y), __uint_as_float(s.a3.z), __uint_as_float(s.a3.w)};
      f32x2 acc2[8];
#pragma unroll
      for (int i = 0; i < 8; ++i) acc2[i] = (f32x2){0.f, 0.f};
#pragma unroll
      for (int j = 0; j < 16; ++j) {
        f32x2 f[8];
        unpack16_fp8x2(R[j], f);
        if (more) R[j] = *(const uint4*)(tb + (size_t)peer_eid(sn, j) * 128);
        const f32x2 w2 = (f32x2){wsv[j], wsv[j]};
#pragma unroll
        for (int i = 0; i < 8; ++i) acc2[i] += w2 * f[i];
      }
      float* slab = wbuf + (r * 8 + c) * 16;
      *(float4*)(slab) = make_float4(acc2[0][0], acc2[0][1], acc2[1][0], acc2[1][1]);
      *(float4*)(slab + 4) = make_float4(acc2[2][0], acc2[2][1], acc2[3][0], acc2[3][1]);
      *(float4*)(slab + 8) = make_float4(acc2[4][0], acc2[4][1], acc2[5][0], acc2[5][1]);
      *(float4*)(slab + 12) = make_float4(acc2[6][0], acc2[6][1], acc2[7][0], acc2[7][1]);
      asm volatile("s_waitcnt lgkmcnt(0)" ::: "memory");
      float o0 = 0.f, o1 = 0.f;
#pragma unroll
      for (int rr = 0; rr < 8; ++rr) {
        const float2 t = *(const float2*)(wbuf + (rr * 8 + (lane >> 3)) * 16 + 2 * (lane & 7));
        o0 += t.x; o1 += t.y;
      }
      asm volatile("s_waitcnt lgkmcnt(0)" ::: "memory");
      const int b = tok / LT, pp = tok % LT;
      const int mr = pp < LC ? 16 : b;
      const int col = x * 128 + 2 * lane;
      const float* g2 = p.modv + ((size_t)layer * 17 + mr) * 6144 + 5120 + col;
      unsigned* xp = (unsigned*)(p.X + (size_t)tok * D + col);
      const unsigned xu = *xp;
      *xp = pack2(bflo(xu) + g2[0] * o0, bfhi(xu) + g2[1] * o1);
    }
  };
  ld_pre(tok0, S[0]);
  ld_pre(tok0 + 1, S[1]);
#pragma unroll
  for (int j = 0; j < 16; ++j) R[j] = *(const uint4*)(tb + (size_t)peer_eid(S[0], j) * 128);
  ld_pre(tok0 + 2, S[2]);
#pragma unroll
  for (int t = 0; t < 8; ++t) {
    comp(tok0 + t, S[t % 3], S[(t + 1) % 3], t + 1 < 8);
    if (t + 3 < 8) ld_pre(tok0 + t + 3, S[t % 3]);
  }
}
DEV void ph_peer_w(const P& p) {
  for (size_t i8 = (size_t)bid_() * 256 + tid_(); i8 < (size_t)NTOK * 16; i8 += (size_t)gridDim.x * 256) {
    const size_t i = i8 * 8;
    float d[8];
#pragma unroll
    for (int q = 0; q < 8; ++q) d[q] = 0.f;
#pragma unroll
    for (int x = 0; x < 8; ++x) {
      const uint4 u = *(const uint4*)(p.PD + (size_t)x * NTOK * 128 + i);
      float f[8];
      unpack8(u, f);
#pragma unroll
      for (int q = 0; q < 8; ++q) d[q] += f[q];
    }
    const uint4 eu = *(const uint4*)(p.EL + i);
    const unsigned ew[4] = {eu.x, eu.y, eu.z, eu.w};
    const float hinv = p.HINV[i >> 7];
    float4 g0 = *(const float4*)(p.GT + i), g1 = *(const float4*)(p.GT + i + 4);
    float g[8] = {g0.x, g0.y, g0.z, g0.w, g1.x, g1.y, g1.z, g1.w};
#pragma unroll
    for (int q = 0; q < 8; ++q) {
      const unsigned e = (q & 1) ? (ew[q >> 1] >> 16) : (ew[q >> 1] & 0xFFFFu);
      g[q] = g[q] * gelu_exact(d[q] * p.PSU[e] * hinv) * p.PSV[e];
    }
    *(float4*)(p.GT + i) = make_float4(g[0], g[1], g[2], g[3]);
    *(float4*)(p.GT + i + 4) = make_float4(g[4], g[5], g[6], g[7]);
  }
}
template <int WHICH>
DEV void ph_peer_gather(const P& p, int layer, char* smem, volatile LAS unsigned* slot) {
  const int tid = tid_(), lane = tid & 63, wid = tid >> 6;
  unsigned* q = p.wq + 1024 + layer * 256 + WHICH * 128;
  const int my = (int)(xb_xcc_id() & 7u);
  float* wbuf = (float*)smem + wid * 1024;
#pragma unroll 1
  for (int rot = 0; rot < 8; ++rot) {
    const int x = (my + rot) & 7;
    for (;;) {
      __syncthreads();
      if (tid == 0) *slot = atomicAdd(q + x * 16, 1u);
      __syncthreads();
      const int it = (int)*slot;
      if (it >= NTOK / 64) break;
      peer_wave_run<WHICH>(p, layer, x, it * 64 + wid * 16, lane, wbuf);
      peer_wave_run<WHICH>(p, layer, x, it * 64 + wid * 16 + 8, lane, wbuf);
    }
  }
}

DEV void ph_final(const P& p) {
  const int lane = tid_() & 63;
  int r0, r1;
  wave_range(r0, r1, NB * T);
  float gv[16];
#pragma unroll
  for (int hh = 0; hh < 2; ++hh)
#pragma unroll
    for (int i = 0; i < 8; ++i) gv[hh * 8 + i] = p.final_g[hh * 512 + 8 * lane + i];
  auto xrow = [&](int r) -> const bf16_t* { const int b = r / T, t = r % T; return p.X + ((size_t)b * LT + LC + t) * D; };
  uint4 n0 = make_uint4(0, 0, 0, 0), n1 = n0;
  if (r0 < r1) { const bf16_t* xr = xrow(r0); n0 = *(const uint4*)(xr + 8 * lane); n1 = *(const uint4*)(xr + 512 + 8 * lane); }
#pragma unroll 1
  for (int r = r0; r < r1; ++r) {
    const uint4 u0 = n0, u1 = n1;
    if (r + 1 < r1) { const bf16_t* xr = xrow(r + 1); n0 = *(const uint4*)(xr + 8 * lane); n1 = *(const uint4*)(xr + 512 + 8 * lane); }
    float v[16];
    unpack8(u0, v); unpack8(u1, v + 8);
    float ss = 0.f;
#pragma unroll
    for (int i = 0; i < 16; ++i) ss += v[i] * v[i];
    ss = wave_sum(ss);
    const float rstd = rsqrtf(ss * (1.f / 1024.f) + 1e-6f);
    float* o = p.out + (size_t)r * D;
#pragma unroll
    for (int hh = 0; hh < 2; ++hh) {
      const int col = hh * 512 + 8 * lane;
      *(float4*)(o + col) = make_float4(v[hh * 8 + 0] * rstd * gv[hh * 8 + 0], v[hh * 8 + 1] * rstd * gv[hh * 8 + 1], v[hh * 8 + 2] * rstd * gv[hh * 8 + 2], v[hh * 8 + 3] * rstd * gv[hh * 8 + 3]);
      *(float4*)(o + col + 4) = make_float4(v[hh * 8 + 4] * rstd * gv[hh * 8 + 4], v[hh * 8 + 5] * rstd * gv[hh * 8 + 5], v[hh * 8 + 6] * rstd * gv[hh * 8 + 6], v[hh * 8 + 7] * rstd * gv[hh * 8 + 7]);
    }
  }
}

DEV unsigned hw_cu_key() {
  const unsigned hwid = (unsigned)__builtin_amdgcn_s_getreg(((8 - 1) << 11) | (8 << 6) | 4);
  return (xb_xcc_id() << 8) | (hwid & 0xFFu);
}
DEV void mixB(const P& p, int layer, char* smem, volatile LAS unsigned* slot) {
  unsigned* qa = p.wq + layer * 64;
  unsigned* qs = qa + 16;
  unsigned* claim = p.cuclaim + layer * 4096;
  __syncthreads();
  if (tid_() == 0) {
    unsigned u = 0xFFFFFFFFu;
    if (atomicAdd(&claim[hw_cu_key() & 4095u], 1u) == 0u) u = atomicAdd(qs, 1u);
    *slot = u;
  }
  __syncthreads();
  {
    const unsigned u = *slot;
    if (u < 128u) scanc_unit(p, layer, (int)u, smem);
  }
  for (;;) {
    __syncthreads();
    if (tid_() == 0) *slot = atomicAdd(qa, 1u);
    __syncthreads();
    const int u = (int)*slot;
    if (u >= 8704) break;
    if (u < 4352) attn_unit(p, layer, u, smem); else hyena_conv_unit(p, layer, u - 4352, smem);
  }
  if (layer + 1 < DEPTH) {
    unsigned* qp = qa + 32;
    for (;;) {
      __syncthreads();
      if (tid_() == 0) *slot = atomicAdd(qp, 1u);
      __syncthreads();
      const int u = (int)*slot;
      if (u >= PREPA_N) break;
      prep_unit(p, layer + 1, prepA_unit_index(u), smem);
    }
  }
  for (;;) {
    __syncthreads();
    if (tid_() == 0) *slot = atomicAdd(qs, 1u);
    __syncthreads();
    const unsigned u = *slot;
    if (u >= 128u) break;
    scanc_unit(p, layer, (int)u, smem);
  }
}
DEV void mixA(const P& p, int layer, char* smem) {
  for (int u = bid_(); u < 1088; u += gridDim.x) hyena_pre_unit(p, layer, u);
  ph_lora(p, layer, smem);
  ph_rwkv_prep(p, layer);
}
DEV void mixC(const P& p, int layer, char* smem) {
  for (int u = bid_(); u < 1088; u += gridDim.x) hyena_post_unit(p, layer, u, smem);
  ph_rwkv_post(p, layer);
  ph_attn_post(p, layer);
}

__global__ void __launch_bounds__(256, 2) k_mega(P p) {
  extern __shared__ __attribute__((aligned(16))) char smem_all[];
  char* smem = smem_all;
  volatile LAS unsigned* xbw = (volatile LAS unsigned*)(smem_all + SMEM_BYTES);
  if (threadIdx.x == 0) { xbw[0] = 0u; xbw[1] = 0u; xbw[2] = 0u; xbw[3] = 0u; }
  __syncthreads();
  XcdBarrier bar = xcd_barrier_post(p.bar, xbw);
  ph_copy(p);
  ph_rope(p);
  for (int u = blockIdx.x; u < 96; u += gridDim.x) modv_unit(p, u, smem);
  ph_prep(p, 0, smem, false);
  xcd_barrier(bar);
  for (int layer = 0; layer < DEPTH; ++layer) {
    ph_norm(p, layer, 0);
    xcd_barrier(bar);
    ph_gemm1(p, smem);
    xcd_barrier(bar);
    mixA(p, layer, smem);
    xcd_barrier(bar);
    mixB(p, layer, smem, (volatile LAS unsigned*)(smem_all + SMEM_BYTES + 16));
    xcd_barrier(bar);
    mixC(p, layer, smem);
    xcd_barrier(bar);
    ph_gemm2(p, layer, smem);
    ph_peerconv(p, layer);
    xcd_barrier(bar);
    ph_norm(p, layer, 1);
    xcd_barrier(bar);
    ph_gemm3(p, smem);
    xcd_barrier(bar);
    ph_peer_gather<0>(p, layer, smem, (volatile LAS unsigned*)(smem_all + SMEM_BYTES + 16));
    xcd_barrier(bar);
    ph_peer_w(p);
    xcd_barrier(bar);
    ph_peer_gather<1>(p, layer, smem, (volatile LAS unsigned*)(smem_all + SMEM_BYTES + 16));
    if (layer + 1 < DEPTH) ph_prep(p, layer + 1, smem, true);
    xcd_barrier(bar);
  }
  ph_final(p);
}

static inline size_t al256(size_t x) { return (x + 255) & ~(size_t)255; }

extern "C" void kernel_launch(void* const* d_in, const int* in_sizes, int n_in, void* d_out, int out_size, void* d_ws, size_t ws_size,
                              hipStream_t stream) {
  (void)in_sizes; (void)n_in; (void)out_size; (void)ws_size;
  P p{};
  const float** f = (const float**)&p;
  for (int i = 0; i < 39; ++i) f[i] = (const float*)d_in[i];
  p.out = (float*)d_out;
  char* w = (char*)d_ws;
  size_t off = 0;
  auto take = [&](size_t bytes) { char* r = w + off; off += al256(bytes); return r; };
  p.bar = (unsigned*)take(16384);
  p.modv = (float*)take((size_t)DEPTH * 17 * 6144 * 4);
  p.SSQ = (float*)take((size_t)DEPTH * 2 * 256 * 4);
  p.wq = (unsigned*)take(4096 + DEPTH * 1024);
  p.cuclaim = (unsigned*)take((size_t)DEPTH * 4096 * 4);
  const size_t zero_bytes = off;
  p.rope = (float*)take(64 * 16 * 2 * 4);
  p.X = (bf16_t*)take((size_t)NTOK * D * 2);
  p.H = (bf16_t*)take((size_t)NTOK * D * 2);
  p.Y = (bf16_t*)take((size_t)NTOK * D * 2);
  p.SC = (bf16_t*)take((size_t)NTOK * 1024 * 2);
  p.Z = (bf16_t*)take((size_t)NTOK * INW * 2);
  p.UTl = (bf16_t*)take((size_t)256 * 16 * T * 2);
  p.UTc = (bf16_t*)take((size_t)256 * 16 * LC * 2);
  p.YTl = (bf16_t*)take((size_t)256 * 16 * T * 2);
  p.YTc = (bf16_t*)take((size_t)256 * 16 * LC * 2);
  p.FL = (float*)take((size_t)256 * 2 * T * 4);
  p.FC = (float*)take((size_t)256 * 2 * LC * 4);
  p.W1t = (bf16_t*)take((size_t)INW * D * 2);
  p.W2t = (bf16_t*)take((size_t)D * D * 2);
  p.Wft = (bf16_t*)take((size_t)2048 * D * 2);
  p.Wlt = (bf16_t*)take((size_t)1024 * 256 * 2);
  p.Wgt = (bf16_t*)take((size_t)256 * 128 * 2);
  p.TK = (float*)p.Z;
  p.PU = (unsigned char*)p.Z + al256((size_t)NTOK * 256 * 4);
  p.PV = p.PU + (size_t)16384 * 1024;
  p.PSU = (float*)(p.PV + (size_t)16384 * 1024);
  p.PSV = p.PSU + 16384;
  p.GT = p.PSV + 16384;
  p.EL = (unsigned short*)(p.GT + (size_t)NTOK * 128);
  p.H8 = (unsigned char*)p.EL + al256((size_t)NTOK * 128 * 2);
  p.HINV = (float*)(p.H8 + (size_t)NTOK * 1024);
  p.PD = p.Y;

  (void)hipMemsetAsync(d_ws, 0, zero_bytes, stream);
  constexpr size_t kDynLds = SMEM_BYTES + 32;
  static int grid = 0;
  if (!grid) {
    int dev = 0, cus = 0, per_cu = 0;
    (void)hipGetDevice(&dev);
    (void)hipDeviceGetAttribute(&cus, hipDeviceAttributeMultiprocessorCount, dev);
    (void)hipFuncSetAttribute((const void*)k_mega, hipFuncAttributeMaxDynamicSharedMemorySize, (int)kDynLds);
    (void)hipOccupancyMaxActiveBlocksPerMultiprocessor(&per_cu, k_mega, 256, kDynLds);
    if (cus <= 0) cus = 256;
    if (per_cu > 2) per_cu = 2;
    if (per_cu < 1) per_cu = 1;
    grid = cus * per_cu;
  }
  k_mega<<<grid, 256, kDynLds, stream>>>(p);
}
```

```cpp
#include <hip/hip_runtime.h>
#include <stdint.h>
#include <type_traits>

#define DEV __device__ __forceinline__
typedef unsigned short bf16_t;
typedef short bf16x8 __attribute__((ext_vector_type(8)));
typedef float f32x2 __attribute__((ext_vector_type(2)));
constexpr size_t PSLICE = (size_t)16384 * 128;
typedef float f32x4 __attribute__((ext_vector_type(4)));
typedef float f32x16 __attribute__((ext_vector_type(16)));


constexpr int NB = 16, T = 4096, LC = 256, LT = 4352, D = 1024, NTOK = NB * LT, INW = 2688, DEPTH = 4;
constexpr int SMEM_BYTES = 65536;

struct P {
  const float *x, *c, *ctx, *c_ctx, *mod_w, *mod_b, *norm1_g, *norm2_g, *w_in, *conv_w, *conv_b;
  const float *hy_w1, *hy_b1, *hy_w2, *hy_b2, *hy_w3, *hy_b3, *hy_freq, *hy_bias;
  const float *rw_w0, *rw_w_up, *rw_a0, *rw_a_up, *rw_g_up, *rw_k_k, *rw_k_a, *rw_r_k, *rw_ln_w, *rw_ln_b;
  const float *attn_sink, *hy_out_g, *at_out_g, *w_out, *peer_wq, *peer_k1, *peer_k2, *peer_u, *peer_v, *final_g;
  float* out;
  unsigned* bar;
  float *modv, *SSQ, *rope, *FL, *FC, *TK;
  unsigned *wq, *cuclaim;
  bf16_t *X, *H, *Y, *SC, *Z, *UTl, *UTc, *YTl, *YTc;
  bf16_t *W1t, *W2t, *Wft, *Wlt, *Wgt;
  unsigned char *PU, *PV;
  float *PSU, *PSV, *GT, *HINV;
  bf16_t *PD, *GW;
  unsigned short* EL;
  unsigned char* H8;
};

typedef __bf16 hwbf2 __attribute__((ext_vector_type(2)));
DEV unsigned pack2(float a, float b) { f32x2 f = {a, b}; hwbf2 r = __builtin_convertvector(f, hwbf2); return __builtin_bit_cast(unsigned, r); }
DEV bf16_t f2bf(float f) { return (bf16_t)(pack2(f, 0.f) & 0xFFFFu); }
DEV float bf2f(bf16_t h) { return __uint_as_float(((unsigned)h) << 16); }
DEV float bflo(unsigned u) { return __uint_as_float(u << 16); }
DEV float bfhi(unsigned u) { return __uint_as_float(u & 0xFFFF0000u); }
DEV void unpack8(const uint4& u, float* v) {
  v[0] = bflo(u.x); v[1] = bfhi(u.x); v[2] = bflo(u.y); v[3] = bfhi(u.y);
  v[4] = bflo(u.z); v[5] = bfhi(u.z); v[6] = bflo(u.w); v[7] = bfhi(u.w);
}
DEV uint4 pack8(const float* v) { return make_uint4(pack2(v[0], v[1]), pack2(v[2], v[3]), pack2(v[4], v[5]), pack2(v[6], v[7])); }
DEV int pack_i8(float a, float b, float c, float d) {
  const int ia = __float2int_rn(a), ib = __float2int_rn(b), ic = __float2int_rn(c), id = __float2int_rn(d);
  return (ia & 0xFF) | ((ib & 0xFF) << 8) | ((ic & 0xFF) << 16) | ((id & 0xFF) << 24);
}
DEV float sigmoidf_(float x) { return __builtin_amdgcn_rcpf(1.f + __expf(-x)); }

template <int CTRL, int ROWMASK>
DEV float dpp0(float x) {
  return __builtin_bit_cast(float, __builtin_amdgcn_update_dpp(0, __builtin_bit_cast(int, x), CTRL, ROWMASK, 0xF, false));
}
template <int CTRL, int ROWMASK>
DEV float dppself(float x) {
  int xi = __builtin_bit_cast(int, x);
  return __builtin_bit_cast(float, __builtin_amdgcn_update_dpp(xi, xi, CTRL, ROWMASK, 0xF, false));
}
DEV float readlane_f(float x, int l) { return __builtin_bit_cast(float, __builtin_amdgcn_readlane(__builtin_bit_cast(int, x), l)); }
DEV int lane_id() { return (int)__builtin_amdgcn_mbcnt_hi(~0u, __builtin_amdgcn_mbcnt_lo(~0u, 0u)); }
DEV float writelane_f(float val, int l, float old) { return lane_id() == l ? val : old; }
DEV int writelane_i(int val, int l, int old) { return lane_id() == l ? val : old; }
DEV float wave_sum(float x) {
  x += dpp0<0x111, 0xF>(x); x += dpp0<0x112, 0xF>(x); x += dpp0<0x114, 0xF>(x); x += dpp0<0x118, 0xF>(x);
  x += dpp0<0x142, 0xA>(x); x += dpp0<0x143, 0xC>(x);
  return readlane_f(x, 63);
}
DEV float wave_max(float x) {
  x = fmaxf(x, dppself<0x111, 0xF>(x)); x = fmaxf(x, dppself<0x112, 0xF>(x)); x = fmaxf(x, dppself<0x114, 0xF>(x));
  x = fmaxf(x, dppself<0x118, 0xF>(x)); x = fmaxf(x, dppself<0x142, 0xA>(x)); x = fmaxf(x, dppself<0x143, 0xC>(x));
  return readlane_f(x, 63);
}
DEV float row16_sum(float x) {
  x += dpp0<0xB1, 0xF>(x); x += dpp0<0x4E, 0xF>(x); x += dpp0<0x141, 0xF>(x); x += dpp0<0x140, 0xF>(x);
  return x;
}
DEV float row16_max(float x) {
  x = fmaxf(x, dppself<0xB1, 0xF>(x)); x = fmaxf(x, dppself<0x4E, 0xF>(x)); x = fmaxf(x, dppself<0x141, 0xF>(x));
  x = fmaxf(x, dppself<0x140, 0xF>(x));
  return x;
}
DEV float quad_sum(float x) { x += dpp0<0xB1, 0xF>(x); x += dpp0<0x4E, 0xF>(x); return x; }

DEV f32x4 mfma16(bf16x8 a, bf16x8 b, f32x4 c) { return __builtin_amdgcn_mfma_f32_16x16x32_bf16(a, b, c, 0, 0, 0); }
DEV f32x16 mfma32(bf16x8 a, bf16x8 b, f32x16 c) { return __builtin_amdgcn_mfma_f32_32x32x16_bf16(a, b, c, 0, 0, 0); }


#define XB_TMO      128
#define XB_XCNT(j)  (256  + 64 * (j))
#define XB_XSUB(j)  (1280 + 64 * (j))
#define XB_XGEN(j)  (2304 + 64 * (j))
#define XB_TOP      3328
#define XB_TOPGEN   3392
#define XCD_BAR_WORDS 3456
#define XB_SPIN_CAP (1u << 23)
#define LAS __attribute__((address_space(3)))

__device__ __forceinline__ unsigned xb_ld(unsigned* p)              { return __hip_atomic_load(p, __ATOMIC_RELAXED, __HIP_MEMORY_SCOPE_AGENT); }
__device__ __forceinline__ unsigned xb_add(unsigned* p, unsigned v) { return __hip_atomic_fetch_add(p, v, __ATOMIC_RELAXED, __HIP_MEMORY_SCOPE_AGENT); }
__device__ __forceinline__ unsigned xb_xcc_id() { return (unsigned)__builtin_amdgcn_s_getreg((3 << 11) | 20) & 0xFu; }
#define XB_SPIN(cond, bar) do { unsigned _sp = 0; while (cond) { __builtin_amdgcn_s_sleep(1); \
    if ((++_sp & 255u) == 0u) { if (xb_ld(&(bar)[XB_TMO])) break; if (_sp > XB_SPIN_CAP) { atomicAdd(&(bar)[XB_TMO], 1u); break; } } } } while (0)

struct XcdBarrier {
    unsigned* bar; unsigned x;
    volatile LAS unsigned* st;
};
__device__ __forceinline__ XcdBarrier xcd_barrier_post(unsigned* bar, volatile LAS unsigned* st) {
    XcdBarrier b; b.bar = bar; b.x = xb_xcc_id(); b.st = st;
    if (threadIdx.x == 0) (void)xb_add(&bar[XB_XCNT(b.x)], 1u);
    return b;
}
__device__ __forceinline__ void xcd_barrier_complete(unsigned* bar, unsigned x, unsigned& nloc, unsigned& nx) {
    const unsigned G = gridDim.x * gridDim.y * gridDim.z;
    unsigned sum, cnt, mine, sp = 0u;
    for (;;) {
        sum = 0u; cnt = 0u; mine = 0u;
#pragma unroll
        for (unsigned j = 0; j < 16; ++j) { const unsigned c = xb_ld(&bar[XB_XCNT(j)]); sum += c; cnt += (c > 0u) ? 1u : 0u; mine = (j == x) ? c : mine; }
        if (sum == G) break;
        __builtin_amdgcn_s_sleep(1);
        if ((++sp & 255u) == 0u) { if (xb_ld(&bar[XB_TMO])) break; if (sp > XB_SPIN_CAP) { atomicAdd(&bar[XB_TMO], 1u); break; } }
    }
    nloc = mine > 0u ? mine : 1u; nx = cnt > 0u ? cnt : 1u;
}
__device__ __forceinline__ void xcd_barrier(const XcdBarrier& b) {
    asm volatile("s_waitcnt vmcnt(0)" ::: "memory");
    __syncthreads();
    if (threadIdx.x == 0) {
        unsigned* bar = b.bar;
        __builtin_amdgcn_s_waitcnt(0);
        unsigned nloc = b.st[0], nx = b.st[1];
        if (nloc == 0u) { xcd_barrier_complete(bar, b.x, nloc, nx); b.st[0] = nloc; b.st[1] = nx; }
        const unsigned old = xb_add(&bar[XB_XSUB(b.x)], 1u);
        const unsigned gen = old / nloc;
        if (old + 1u == (gen + 1u) * nloc) {
            __builtin_amdgcn_fence(__ATOMIC_RELEASE, "agent");
            asm volatile("s_waitcnt vmcnt(0)" ::: "memory");
            const unsigned og = xb_add(&bar[XB_TOP], 1u);
            const unsigned tg = og / nx;
            if (og + 1u == (tg + 1u) * nx) xb_add(&bar[XB_TOPGEN], 1u);
            else XB_SPIN(xb_ld(&bar[XB_TOPGEN]) == tg, bar);
            __builtin_amdgcn_fence(__ATOMIC_ACQUIRE, "agent");
            xb_add(&bar[XB_XGEN(b.x)], 1u);
            asm volatile("s_waitcnt vmcnt(0)" ::: "memory");
        } else {
            XB_SPIN(xb_ld(&bar[XB_XGEN(b.x)]) == gen, bar);
            __builtin_amdgcn_fence(__ATOMIC_ACQUIRE, "agent");
            asm volatile("s_waitcnt vmcnt(0)" ::: "memory");
        }
    }
    __syncthreads();
}

template <class Tp> DEV Tp* opq(Tp* q) { asm volatile("" : "+s"(q)); return q; }
DEV int tid_() { int t = threadIdx.x; asm volatile("" : "+v"(t)); return t; }
DEV int bid_() { int b = blockIdx.x; asm volatile("" : "+s"(b)); return b; }

DEV void glds16(const void* gsrc, char* lds_lane_ptr) {
  __builtin_amdgcn_global_load_lds((const unsigned*)gsrc, (__attribute__((address_space(3))) unsigned*)lds_lane_ptr, 16, 0, 0);
}
template <class Epi>
DEV void gemm_tile(const bf16_t* __restrict__ A, int lda, const bf16_t* __restrict__ Bt, int ldb, int K, char* smem, Epi& epi) {
  const int tid = tid_(), lane = tid & 63, wid = tid >> 6, wr = wid >> 1, wc = wid & 1, fr = lane & 15, fq = lane >> 4;
  f32x4 acc[4][4];
#pragma unroll
  for (int m = 0; m < 4; ++m)
#pragma unroll
    for (int n = 0; n < 4; ++n) acc[m][n] = (f32x4){0.f, 0.f, 0.f, 0.f};
  const int drow0 = 8 * wid + (lane >> 3), dpc = lane & 7;
  auto issue = [&](int kt, int buf) {
    char* sa = smem + buf * 32768;
    char* sb = sa + 16384;
#pragma unroll
    for (int i = 0; i < 4; ++i) {
      const int row = drow0 + 32 * i;
      const int kc = dpc ^ ((row >> 1) & 7);
      glds16(A + (size_t)row * lda + kt * 64 + kc * 8, sa + (i * 4 + wid) * 1024 + lane * 16);
      glds16(Bt + (size_t)row * ldb + kt * 64 + kc * 8, sb + (i * 4 + wid) * 1024 + lane * 16);
    }
  };
  __syncthreads();
  issue(0, 0);
  const int nk = K >> 6;
  const int sw = (fr >> 1) & 7;
  const int aoff = (wr * 64 + fr) * 128, boff = (wc * 64 + fr) * 128;
  for (int kt = 0; kt < nk; ++kt) {
    asm volatile("s_waitcnt vmcnt(0)" ::: "memory");
    __syncthreads();
    if (kt + 1 < nk) issue(kt + 1, (kt + 1) & 1);
    const char* sa = smem + (kt & 1) * 32768;
    const char* sb = sa + 16384;
#pragma unroll
    for (int kh = 0; kh < 2; ++kh) {
      const int pc = ((kh * 4 + fq) ^ sw) * 16;
      bf16x8 af[4], bfr[4];
#pragma unroll
      for (int m = 0; m < 4; ++m) af[m] = *(const bf16x8*)(sa + aoff + m * 2048 + pc);
#pragma unroll
      for (int n = 0; n < 4; ++n) bfr[n] = *(const bf16x8*)(sb + boff + n * 2048 + pc);
#pragma unroll
      for (int m = 0; m < 4; ++m)
#pragma unroll
        for (int n = 0; n < 4; ++n) acc[m][n] = mfma16(bfr[n], af[m], acc[m][n]);
    }
  }
  __syncthreads();
  epi(acc, wr, wc, fr, fq, smem);
}
DEV void stage_tile_bf16(const f32x4 (&acc)[4][4], char* smem, int wid, int fr, int fq) {
  bf16_t (*t)[72] = (bf16_t (*)[72])(smem + wid * 9216);
#pragma unroll
  for (int m = 0; m < 4; ++m)
#pragma unroll
    for (int n = 0; n < 4; ++n)
      *(uint2*)&t[m * 16 + fr][n * 16 + 4 * fq] = make_uint2(pack2(acc[m][n][0], acc[m][n][1]), pack2(acc[m][n][2], acc[m][n][3]));
  asm volatile("s_waitcnt lgkmcnt(0)" ::: "memory");
}

DEV void ph_copy(const P& p) {
  const size_t n8 = (size_t)NTOK * D / 8;
  const float* pctx = opq(p.ctx); const float* px = opq(p.x);
  for (size_t i = (size_t)bid_() * 256 + tid_(); i < n8; i += (size_t)gridDim.x * 256) {
    size_t e = i * 8;
    int row = (int)(e / D), col = (int)(e % D);
    int b = row / LT, pp = row % LT;
    const float* src = pp < LC ? pctx + ((size_t)(b * LC + pp)) * D + col : px + ((size_t)(b * T + pp - LC)) * D + col;
    float4 v0 = *(const float4*)src, v1 = *(const float4*)(src + 4);
    uint4 o = make_uint4(pack2(v0.x, v0.y), pack2(v0.z, v0.w), pack2(v1.x, v1.y), pack2(v1.z, v1.w));
    *(uint4*)(p.X + e) = o;
  }
}

DEV void ph_rope(const P& p) {
  for (int i = bid_() * 256 + tid_(); i < 64 * 16; i += gridDim.x * 256) {
    int pos = i >> 4, k = i & 15;
    float inv = powf(10000.f, -(float)k / 16.f);
    float ang = (float)pos * inv;
    p.rope[2 * i] = cosf(ang); p.rope[2 * i + 1] = sinf(ang);
  }
}

DEV void modv_unit(const P& p, int unit, char* smem) {
  const int cc = unit % 24, layer = unit / 24;
  float (*cs)[128] = (float (*)[128])smem;
  const int col = cc * 256 + tid_();
  const float* pc = opq(p.c); const float* pcc = opq(p.c_ctx);
  float acc[17];
#pragma unroll
  for (int r = 0; r < 17; ++r) acc[r] = 0.f;
  for (int ks = 0; ks < 8; ++ks) {
    __syncthreads();
    for (int i = tid_(); i < 17 * 128; i += 256) {
      int r = i >> 7, e = i & 127;
      float v = r < 16 ? pc[r * D + ks * 128 + e] : pcc[ks * 128 + e];
      cs[r][e] = v / (1.f + expf(-v));
    }
    __syncthreads();
    const float* w = p.mod_w + ((size_t)layer * D + ks * 128) * 6144 + col;
#pragma unroll 2
    for (int e = 0; e < 128; e += 4) {
      const float w0 = w[(size_t)e * 6144], w1 = w[(size_t)(e + 1) * 6144], w2 = w[(size_t)(e + 2) * 6144], w3 = w[(size_t)(e + 3) * 6144];
#pragma unroll
      for (int r = 0; r < 17; ++r) {
        const float4 cv = *(const float4*)&cs[r][e];
        acc[r] += cv.x * w0 + cv.y * w1 + cv.z * w2 + cv.w * w3;
      }
    }
  }
  const float bias = p.mod_b[layer * 6144 + col];
#pragma unroll
  for (int r = 0; r < 17; ++r) p.modv[((size_t)layer * 17 + r) * 6144 + col] = acc[r] + bias;
}

DEV void transpose_unit(const float* __restrict__ src, bf16_t* __restrict__ dst, int R, int C, int tile, char* smem) {
  float (*t)[65] = (float (*)[65])smem;
  const int nct = C / 64;
  const int tr = tile / nct, tc = tile % nct;
  __syncthreads();
  for (int i = tid_(); i < 4096; i += 256) { int r = i >> 6, c = i & 63; t[r][c] = src[(size_t)(tr * 64 + r) * C + tc * 64 + c]; }
  __syncthreads();
  for (int i = tid_(); i < 4096; i += 256) { int c = i >> 6, r = i & 63; dst[(size_t)(tc * 64 + c) * R + tr * 64 + r] = f2bf(t[r][c]); }
}

DEV void wfold_unit(const P& p, int layer, int unit, char* smem) {
  const int hs = unit >> 5, ec = unit & 31, h = hs >> 1, s = hs & 1;
  const float* wq = p.peer_wq + (size_t)layer * D * 2048;
  const float* kk = (s ? opq(p.peer_k2) : opq(p.peer_k1)) + ((size_t)layer * 8 + h) * 128 * 128;
  float (*kS)[65] = (float (*)[65])smem;
  float (*wS)[64] = (float (*)[64])(smem + 33280);
  const int key = tid_() & 127, eh = tid_() >> 7;
  float acc[16];
#pragma unroll
  for (int i = 0; i < 16; ++i) acc[i] = 0.f;
  for (int dh = 0; dh < 2; ++dh) {
    __syncthreads();
    for (int i = tid_(); i < 128 * 64; i += 256) { int k2 = i >> 6, d = i & 63; kS[k2][d] = kk[k2 * 128 + dh * 64 + d]; }
    for (int i = tid_(); i < 32 * 64; i += 256) {
      int e = i >> 6, d = i & 63;
      wS[e][d] = wq[(size_t)(ec * 32 + e) * 2048 + h * 256 + s * 128 + dh * 64 + d];
    }
    __syncthreads();
#pragma unroll 2
    for (int d = 0; d < 64; d += 4) {
      const float k0 = kS[key][d], k1 = kS[key][d + 1], k2 = kS[key][d + 2], k3 = kS[key][d + 3];
#pragma unroll
      for (int i = 0; i < 16; ++i) {
        const float4 wv = *(const float4*)&wS[eh * 16 + i][d];
        acc[i] += k0 * wv.x + k1 * wv.y + k2 * wv.z + k3 * wv.w;
      }
    }
  }
  bf16_t* dst = p.Wft + ((size_t)(hs * 128 + key)) * D + ec * 32 + eh * 16;
#pragma unroll
  for (int i = 0; i < 16; i += 2) *(unsigned*)(dst + i) = pack2(acc[i], acc[i + 1]);
}

DEV void filt_unit(const P& p, int layer, int unit, char* smem) {
  int kind, j0, L;
  if (unit < 1024) { kind = 0; j0 = unit * 4; L = T; } else { kind = 1; j0 = (unit - 1024) * 4; L = LC; }
  float* zs = (float*)smem;
  float* h1 = zs + 4 * 36;
  float* h2 = h1 + 256;
  const int jj = tid_() >> 6, o = tid_() & 63;
  const int j = j0 + jj;
  const float fj = (float)j;
  const float t = fj / (float)(L - 1);
  __syncthreads();
  if (o < 33) {
    float z;
    if (o == 0) z = t;
    else {
      int i = (o - 1) & 15;
      float band = 1e-4f + (float)i * ((15.0f - 1e-4f) / 15.0f);
      float ang = 6.283185307179586f * fj * band / (float)L;
      z = (o <= 16) ? cosf(ang) : -sinf(ang);
    }
    zs[jj * 36 + o] = z;
  }
  __syncthreads();
  {
    const float* w1 = p.hy_w1 + layer * 33 * 64;
    float a = p.hy_b1[layer * 64 + o];
#pragma unroll 3
    for (int i = 0; i < 33; ++i) a += zs[jj * 36 + i] * w1[i * 64 + o];
    h1[jj * 64 + o] = sinf(p.hy_freq[layer * 128 + o] * a);
  }
  __syncthreads();
  {
    const float* w2 = p.hy_w2 + layer * 64 * 64;
    float a = p.hy_b2[layer * 64 + o];
#pragma unroll 4
    for (int i = 0; i < 64; ++i) a += h1[jj * 64 + i] * w2[i * 64 + o];
    h2[jj * 64 + o] = sinf(p.hy_freq[layer * 128 + 64 + o] * a);
  }
  __syncthreads();
  const float* w3 = p.hy_w3 + layer * 64 * 512;
  float* F = kind ? opq(p.FC) : opq(p.FL);
  const float DMIN = -3.0701134573253945f, DMAX = -15.350567286626973f;
#pragma unroll 1
  for (int m = 0; m < 4; ++m) {
    int c = o + 64 * m;
    float af = p.hy_b3[layer * 512 + c], ab = p.hy_b3[layer * 512 + 256 + c];
#pragma unroll 4
    for (int i = 0; i < 64; ++i) { float hv = h2[jj * 64 + i]; af += hv * w3[i * 512 + c]; ab += hv * w3[i * 512 + 256 + c]; }
    float delta = fabsf(DMIN + (float)c * ((DMAX - DMIN) / 255.f));
    float win = expf(-t * delta) + 0.05f;
    af *= win; ab *= win;
    F[((size_t)c * 2 + 0) * L + j] = af;
    F[((size_t)c * 2 + 1) * L + j] = ab;
  }
}

constexpr int PREP_T0 = 672, PREP_T1 = PREP_T0 + 256, PREP_T2 = PREP_T1 + 8, PREP_T3 = PREP_T2 + 8, PREP_T4 = PREP_T3 + 8;
constexpr int PREP_WF = PREP_T4 + 512, PREP_N = PREP_WF + 1088;
DEV void prep_unit(const P& p, int layer, int u, char* smem) {
  if (u < PREP_T0) transpose_unit(p.w_in + (size_t)layer * D * INW, p.W1t, D, INW, u, smem);
  else if (u < PREP_T1) transpose_unit(p.w_out + (size_t)layer * D * D, p.W2t, D, D, u - PREP_T0, smem);
  else if (u < PREP_T3) {
    const int u0 = u - PREP_T1;
    for (int i = tid_(); i < 64 * 256; i += 256) {
      const int np = u0 * 64 + (i >> 8), kp = i & 255;
      const int ps = np & 3, chan = np >> 2, qp = kp >> 6, kk = kp & 63;
      const int is_a = ps & 1, d = ps >> 1;
      float v = 0.f;
      if (qp == (is_a ? 2 + d : d)) v = (is_a ? opq(p.rw_a_up) : opq(p.rw_w_up))[(((size_t)layer * 2 + d) * 64 + kk) * 256 + chan];
      p.Wlt[(size_t)np * 256 + kp] = f2bf(v);
    }
  }
  else if (u < PREP_T4) transpose_unit(p.rw_g_up + (size_t)layer * 128 * 256, p.Wgt, 128, 256, u - PREP_T3, smem);
  else if (u < PREP_WF) wfold_unit(p, layer, u - PREP_T4, smem);
  else filt_unit(p, layer, u - PREP_WF, smem);
}
constexpr int PREPA_N = PREP_T0 + (PREP_T4 - PREP_T1);
DEV int prepA_unit_index(int i) { return i < PREP_T0 ? i : PREP_T1 + (i - PREP_T0); }
DEV void ph_prep(const P& p, int layer, char* smem, bool onlyB) {
  for (int u = bid_(); u < PREP_N; u += gridDim.x) {
    const bool isA = (u < PREP_T0) || (u >= PREP_T1 && u < PREP_T4);
    if (onlyB && isA) continue;
    prep_unit(p, layer, u, smem);
  }
}

DEV void wave_range(int& r0, int& r1, int ntok) {
  const int gw = (bid_() * 256 + tid_()) >> 6, nw = gridDim.x * 4;
  const int per = (ntok + nw - 1) / nw;
  r0 = gw * per; r1 = r0 + per; if (r1 > ntok) r1 = ntok;
}
DEV void ph_norm(const P& p, int layer, int which) {
  const int lane = tid_() & 63;
  int r0, r1;
  wave_range(r0, r1, NTOK);
  const float* g = (which ? p.norm2_g : p.norm1_g) + layer * D;
  float gv[16], scv[16], shv[16];
#pragma unroll
  for (int hh = 0; hh < 2; ++hh)
#pragma unroll
    for (int i = 0; i < 8; ++i) gv[hh * 8 + i] = g[hh * 512 + 8 * lane + i];
  int mr_cur = -1;
  uint4 n0 = make_uint4(0, 0, 0, 0), n1 = n0;
  if (r0 < r1) { const bf16_t* xr = p.X + (size_t)r0 * D; n0 = *(const uint4*)(xr + 8 * lane); n1 = *(const uint4*)(xr + 512 + 8 * lane); }
#pragma unroll 1
  for (int row = r0; row < r1; ++row) {
    const uint4 u0 = n0, u1 = n1;
    if (row + 1 < r1) { const bf16_t* xr = p.X + (size_t)(row + 1) * D; n0 = *(const uint4*)(xr + 8 * lane); n1 = *(const uint4*)(xr + 512 + 8 * lane); }
    const int b = row / LT, pp = row % LT;
    const int mr = pp < LC ? 16 : b;
    if (mr != mr_cur) {
      mr_cur = mr;
      const float* mv = p.modv + ((size_t)layer * 17 + mr) * 6144 + (which ? 3072 : 0);
#pragma unroll
      for (int hh = 0; hh < 2; ++hh)
#pragma unroll
        for (int i = 0; i < 8; ++i) { shv[hh * 8 + i] = mv[hh * 512 + 8 * lane + i]; scv[hh * 8 + i] = 1.f + mv[1024 + hh * 512 + 8 * lane + i]; }
    }
    float v[16];
    unpack8(u0, v); unpack8(u1, v + 8);
    float ss = 0.f;
#pragma unroll
    for (int i = 0; i < 16; ++i) ss += v[i] * v[i];
    ss = wave_sum(ss);
    const float rstd = rsqrtf(ss * (1.f / 1024.f) + 1e-6f);
    float o[16];
#pragma unroll
    for (int i = 0; i < 16; ++i) o[i] = (v[i] * rstd * gv[i]) * scv[i] + shv[i];
    bf16_t* hr = p.H + (size_t)row * D;
    *(uint4*)(hr + 8 * lane) = pack8(o);
    *(uint4*)(hr + 512 + 8 * lane) = pack8(o + 8);
    if (which) {
      float am = 0.f;
#pragma unroll
      for (int i = 0; i < 16; ++i) am = fmaxf(am, fabsf(o[i]));
      am = wave_max(am);
      const float sc = am > 0.f ? 127.f / am : 1.f;
      unsigned char* h8 = p.H8 + (size_t)row * 1024;
      *(uint2*)(h8 + 8 * lane) = make_uint2((unsigned)pack_i8(o[0] * sc, o[1] * sc, o[2] * sc, o[3] * sc), (unsigned)pack_i8(o[4] * sc, o[5] * sc, o[6] * sc, o[7] * sc));
      *(uint2*)(h8 + 512 + 8 * lane) = make_uint2((unsigned)pack_i8(o[8] * sc, o[9] * sc, o[10] * sc, o[11] * sc), (unsigned)pack_i8(o[12] * sc, o[13] * sc, o[14] * sc, o[15] * sc));
      if (lane == 0) p.HINV[row] = am > 0.f ? am * (1.f / 127.f) : 1.f;
    }
  }
}

DEV bool gemm_unit(int it, int nct, int& rt, int& ct) {
  const int nslot = gridDim.x >> 3;
  const int x = bid_() & 7, sl = bid_() >> 3;
  if (sl >= nslot) return false;
  const int v = it * nslot + sl;
  if (v >= 68 * nct) return false;
  const int rg = v / (8 * nct), rem = v - rg * 8 * nct;
  const int rows = (rg == 8) ? 4 : 8;
  ct = rem / rows;
  rt = x * 68 + rg * 8 + (rem - ct * rows);
  return true;
}
struct Epi1 {
  const P& p; int row0, col0;
  DEV void operator()(f32x4 (&acc)[4][4], int wr, int wc, int fr, int fq, char* smem) const {
    const int cw = col0 + wc * 64;
    const int rbase = row0 + wr * 64;
    const bool lat = (row0 % LT) >= LC;
    if (cw >= 1536 && cw < 1664) {
#pragma unroll
      for (int m = 0; m < 4; ++m)
#pragma unroll
        for (int n = 0; n < 4; ++n)
#pragma unroll
          for (int j = 0; j < 4; ++j) acc[m][n][j] = 2.f * sigmoidf_(2.f * acc[m][n][j]) - 1.f;
    } else if (cw >= 1792 && cw < 1920) {
#pragma unroll
      for (int m = 0; m < 4; ++m)
#pragma unroll
        for (int n = 0; n < 4; ++n)
#pragma unroll
          for (int j = 0; j < 4; ++j) acc[m][n][j] = sigmoidf_(acc[m][n][j]);
    } else if (cw >= 1920 && cw < 2560 && lat) {
#pragma unroll
      for (int m = 0; m < 4; ++m) {
        const int row = rbase + m * 16 + fr;
        const int pl = (row % LT) - LC;
        const int ri = pl >> 6, ci = pl & 63;
        const float4* crp = (const float4*)(p.rope + 2 * (ri * 16 + 4 * fq));
        const float4* ccp = (const float4*)(p.rope + 2 * (ci * 16 + 4 * fq));
        const float4 cr0 = crp[0], cr1 = crp[1], cc0 = ccp[0], cc1 = ccp[1];
        const float crc[4] = {cr0.x, cr0.z, cr1.x, cr1.z}, crs[4] = {cr0.y, cr0.w, cr1.y, cr1.w};
        const float ccc[4] = {cc0.x, cc0.z, cc1.x, cc1.z}, ccs[4] = {cc0.y, cc0.w, cc1.y, cc1.w};
#pragma unroll
        for (int j = 0; j < 4; ++j) {
          float x1 = acc[m][0][j], x2 = acc[m][1][j];
          acc[m][0][j] = x1 * crc[j] - x2 * crs[j]; acc[m][1][j] = x2 * crc[j] + x1 * crs[j];
          x1 = acc[m][2][j]; x2 = acc[m][3][j];
          acc[m][2][j] = x1 * ccc[j] - x2 * ccs[j]; acc[m][3][j] = x2 * ccc[j] + x1 * ccs[j];
        }
      }
    }
    const int wid = wr * 2 + wc, lane = fq * 16 + fr;
    stage_tile_bf16(acc, smem, wid, fr, fq);
    const bf16_t (*t)[72] = (const bf16_t (*)[72])(smem + wid * 9216);
#pragma unroll
    for (int i = 0; i < 8; ++i) {
      const int rl = i * 8 + (lane >> 3), ch = lane & 7;
      *(uint4*)(p.Z + (size_t)(rbase + rl) * INW + cw + ch * 8) = *(const uint4*)&t[rl][ch * 8];
    }
  }
};
DEV void ph_gemm1(const P& p, char* smem) {
  const int nct = INW / 128;
  int rt, ct;
  for (int it = 0; gemm_unit(it, nct, rt, ct); ++it) {
    Epi1 epi{p, rt * 128, ct * 128};
    gemm_tile(p.H + (size_t)rt * 128 * D, D, p.W1t + (size_t)ct * 128 * D, D, D, smem, epi);
  }
}

struct EpiLoraA {
  const P& p; int layer, row0, col0;
  DEV void operator()(f32x4 (&acc)[4][4], int wr, int wc, int fr, int fq, char* smem) const {
    const float* w0b = p.rw_w0 + layer * 512;
    const float* a0b = p.rw_a0 + layer * 512;
#pragma unroll
    for (int n = 0; n < 4; ++n) {
      const int chan = ((col0 + wc * 64 + n * 16) >> 2) + fq;
      const float be0 = w0b[chan], ba0 = a0b[chan], be1 = w0b[256 + chan], ba1 = a0b[256 + chan];
#pragma unroll
      for (int m = 0; m < 4; ++m) {
        acc[m][n][0] = 0.6065306597126334f * sigmoidf_(acc[m][n][0] + be0);
        acc[m][n][1] = sigmoidf_(acc[m][n][1] + ba0);
        acc[m][n][2] = 0.6065306597126334f * sigmoidf_(acc[m][n][2] + be1);
        acc[m][n][3] = sigmoidf_(acc[m][n][3] + ba1);
      }
    }
    const int wid = wr * 2 + wc, lane = fq * 16 + fr;
    stage_tile_bf16(acc, smem, wid, fr, fq);
    const bf16_t (*t)[72] = (const bf16_t (*)[72])(smem + wid * 9216);
#pragma unroll
    for (int i = 0; i < 8; ++i) {
      const int rl = i * 8 + (lane >> 3), ch = lane & 7;
      *(uint4*)(p.SC + (size_t)(row0 + wr * 64 + rl) * 1024 + col0 + wc * 64 + ch * 8) = *(const uint4*)&t[rl][ch * 8];
    }
  }
};
struct EpiLoraG {
  const P& p; int row0, col0;
  DEV void operator()(f32x4 (&acc)[4][4], int wr, int wc, int fr, int fq, char* smem) const {
    const int wid = wr * 2 + wc, lane = fq * 16 + fr;
    stage_tile_bf16(acc, smem, wid, fr, fq);
    const bf16_t (*t)[72] = (const bf16_t (*)[72])(smem + wid * 9216);
#pragma unroll
    for (int i = 0; i < 8; ++i) {
      const int rl = i * 8 + (lane >> 3), ch = lane & 7;
      *(uint4*)(p.Y + (size_t)(row0 + wr * 64 + rl) * D + 256 + col0 + wc * 64 + ch * 8) = *(const uint4*)&t[rl][ch * 8];
    }
  }
};
DEV void ph_lora(const P& p, int layer, char* smem) {
  int rt, ct;
  for (int it = 0; gemm_unit(it, 10, rt, ct); ++it) {
    if (ct < 8) {
      EpiLoraA epi{p, layer, rt * 128, ct * 128};
      gemm_tile(p.Z + (size_t)rt * 128 * INW + 1536, INW, p.Wlt + (size_t)ct * 128 * 256, 256, 256, smem, epi);
    } else {
      EpiLoraG epi{p, rt * 128, (ct - 8) * 128};
      gemm_tile(p.Z + (size_t)rt * 128 * INW + 1792, INW, p.Wgt + (size_t)(ct - 8) * 128 * 128, 128, 128, smem, epi);
    }
  }
}

DEV void ph_rwkv_prep(const P& p, int layer) {
  const int lane = tid_() & 63;
  int r0, r1;
  wave_range(r0, r1, NTOK);
  const float* cw = p.conv_w + (size_t)layer * 3 * 1536;
  const float* cb = p.conv_b + (size_t)layer * 1536;
  float w0[3][4], w1[3][4], w2[3][4], bb[3][4], kkw[4];
#pragma unroll
  for (int a = 0; a < 3; ++a)
#pragma unroll
    for (int i = 0; i < 4; ++i) {
      const int col = 768 + a * 256 + 4 * lane + i;
      w0[a][i] = cw[col]; w1[a][i] = cw[1536 + col]; w2[a][i] = cw[3072 + col]; bb[a][i] = cb[col];
    }
#pragma unroll
  for (int i = 0; i < 4; ++i) kkw[i] = p.rw_k_k[layer * 256 + 4 * lane + i];
  uint2 zm[3], zc[3], zp[3];
  auto ldz = [&](int row, uint2 (&z)[3]) {
#pragma unroll
    for (int a = 0; a < 3; ++a) z[a] = *(const uint2*)(p.Z + (size_t)row * INW + 768 + a * 256 + 4 * lane);
  };
  auto zero3 = [&](uint2 (&z)[3]) {
#pragma unroll
    for (int a = 0; a < 3; ++a) z[a] = make_uint2(0u, 0u);
  };
  if (r0 < r1) {
    if (r0 > 0) ldz(r0 - 1, zm); else zero3(zm);
    ldz(r0, zc);
  }
#pragma unroll 1
  for (int row = r0; row < r1; ++row) {
    if (row + 1 < NTOK) ldz(row + 1, zp); else zero3(zp);
    const int pp = row % LT;
    const bool hasm = (pp != 0) && (pp != LC);
    const bool hasp = (pp != LC - 1) && (pp != LT - 1);
    float res[3][4];
#pragma unroll
    for (int a = 0; a < 3; ++a) {
      const uint2 um = hasm ? zm[a] : make_uint2(0u, 0u), uc = zc[a], up = hasp ? zp[a] : make_uint2(0u, 0u);
      const float vm[4] = {bflo(um.x), bfhi(um.x), bflo(um.y), bfhi(um.y)};
      const float vc[4] = {bflo(uc.x), bfhi(uc.x), bflo(uc.y), bfhi(uc.y)};
      const float vp[4] = {bflo(up.x), bfhi(up.x), bflo(up.y), bfhi(up.y)};
#pragma unroll
      for (int i = 0; i < 4; ++i) res[a][i] = w0[a][i] * vm[i] + w1[a][i] * vc[i] + w2[a][i] * vp[i] + bb[a][i];
    }
    float kk[4], ss = 0.f;
#pragma unroll
    for (int i = 0; i < 4; ++i) { kk[i] = res[1][i] * kkw[i]; ss += kk[i] * kk[i]; }
    ss = row16_sum(ss);
    const float rs = rsqrtf(ss + 1e-12f);
    bf16_t* hr = p.H + (size_t)row * D + 16 * lane;
    *(uint4*)hr = make_uint4(pack2(res[0][0], res[1][0]), pack2(kk[0] * rs, res[2][0]), pack2(res[0][1], res[1][1]), pack2(kk[1] * rs, res[2][1]));
    *(uint4*)(hr + 8) = make_uint4(pack2(res[0][2], res[1][2]), pack2(kk[2] * rs, res[2][2]), pack2(res[0][3], res[1][3]), pack2(kk[3] * rs, res[2][3]));
#pragma unroll
    for (int a = 0; a < 3; ++a) { zm[a] = zc[a]; zc[a] = zp[a]; }
  }
}

DEV float oct_sum(float x) { x += dpp0<0xB1, 0xF>(x); x += dpp0<0x4E, 0xF>(x); x += dpp0<0x141, 0xF>(x); return x; }
DEV bf16x8 frag_join(uint2 lo, uint2 hi) { uint4 w = make_uint4(lo.x, lo.y, hi.x, hi.y); return __builtin_bit_cast(bf16x8, w); }
constexpr int SCS_SET = 17152, SCS_IMG = 3 * SCS_SET, SCS_W0 = SCS_IMG + 2 * 3072;
DEV void scanc_unit(const P& p, int layer, int unit, char* smem) {
  const int dir = unit & 1, h = (unit >> 1) & 3, b = unit >> 3;
  const int tid = tid_(), lane = tid & 63, fr = lane & 15, fq = lane >> 4;
  const int w = __builtin_amdgcn_readfirstlane(tid >> 6);
  bf16_t* IMG0 = (bf16_t*)(smem + SCS_W0);
  bf16_t* IMG1 = IMG0 + 512;
  bf16_t* IMG2 = IMG0 + 1024;
  __syncthreads();
  for (int i = tid; i < (2 * 3072 + 3072) / 4; i += 256) ((unsigned*)(smem + SCS_IMG))[i] = 0u;
  const float ka = p.rw_k_a[layer * 256 + h * 64 + lane];
  const size_t rowbase = (size_t)b * LT;
  const char* hbase = (const char*)p.H;
  const char* sbase = (const char*)p.SC;
  const unsigned hoff = (unsigned)(rowbase * 2048) + (unsigned)((h * 64 + lane) * 8);
  const unsigned soff = hoff + 4u * (unsigned)dir;
  bf16_t* yb = p.Z + rowbase * INW + 768 + dir * 256 + h * 64 + w * 16 + fr;
  auto pos0 = [&](int c) -> int { const int t = c * 16; return dir == 0 ? t : (t < LC ? LC - 1 - t : LT - 1 - (t - LC)); };
  const int pstep = dir == 0 ? 1 : -1;
  constexpr int NCH = LT / 16;
  struct Raw { unsigned sc[16]; uint2 hr[6]; };
  auto load_raw = [&](int c, Raw& rw) {
    if (w != 0) {
      const int p0 = pos0(c);
      const unsigned so = soff + (unsigned)(p0 * 2048);
      const int st = pstep * 2048;
#pragma unroll
      for (int i = 0; i < 16; ++i) rw.sc[i] = *(const unsigned*)(sbase + (so + (unsigned)(i * st)));
      const unsigned ho = hoff + (unsigned)((p0 + pstep * (w - 1)) * 2048);
#pragma unroll
      for (int q = 0; q < 6; ++q) {
        const int qq = ((w - 1) + 3 * q < 16) ? q : 4;
        rw.hr[q] = *(const uint2*)(hbase + (ho + (unsigned)(qq * 3 * st)));
      }
    }
  };
  auto stage1w = [&](int set, const Raw& rw, auto W1tag) {
    constexpr int W1 = decltype(W1tag)::value;
    char* base = smem + set * SCS_SET;
    bf16_t (*At)[72] = (bf16_t (*)[72])(base);
    bf16_t (*Rt)[72] = (bf16_t (*)[72])(base + 2304);
    bf16_t (*Bt)[72] = (bf16_t (*)[72])(base + 4608);
    bf16_t (*Kt)[72] = (bf16_t (*)[72])(base + 6912);
    bf16_t (*BKT)[36] = (bf16_t (*)[36])(base + 9216);
    bf16_t* VV = (bf16_t*)(base + 13824);
    float* G16 = (float*)(base + 16896);
    float Erun = 0.f;
#pragma unroll
    for (int i = 0; i < 16; ++i) {
      const float ev = bflo(rw.sc[i]);
      const float Eprev = Erun;
      Erun += ev;
      if ((i % 3) == W1) {
        const uint2 hrec = rw.hr[i / 3];
        const float rr = bflo(hrec.x), kr = bfhi(hrec.x), kkv = bflo(hrec.y);
        const float av = bfhi(rw.sc[i]);
        const float gp = __expf(-Eprev), gi = __expf(-Erun), ig = __expf(Erun);
        const float at = -kkv * gp, rt = rr * gi, bt = kkv * av * ig, kt2 = kr * (1.f + (av - 1.f) * ka) * ig;
        const unsigned ar = pack2(at, rt), bk = pack2(bt, kt2);
        At[i][lane] = (bf16_t)(ar & 0xFFFFu); Rt[i][lane] = (bf16_t)(ar >> 16);
        Bt[i][lane] = (bf16_t)(bk & 0xFFFFu); Kt[i][lane] = (bf16_t)(bk >> 16);
        BKT[lane][(i >> 2) * 8 + (i & 3)] = (bf16_t)(bk & 0xFFFFu);
        BKT[lane][(i >> 2) * 8 + 4 + (i & 3)] = (bf16_t)(bk >> 16);
        VV[((i >> 2) * 64 + lane) * 6 + (i & 3)] = (bf16_t)(hrec.y >> 16);
        if (i == 15) G16[lane] = gi;
      }
    }
  };
  auto stage1 = [&](int set, const Raw& rw) {
    if (w == 1) stage1w(set, rw, std::integral_constant<int, 0>{});
    else if (w == 2) stage1w(set, rw, std::integral_constant<int, 1>{});
    else if (w == 3) stage1w(set, rw, std::integral_constant<int, 2>{});
  };
  auto stage2 = [&](int set, int iset) {
    char* base = smem + set * SCS_SET;
    const bf16_t (*At)[72] = (const bf16_t (*)[72])(base);
    const bf16_t (*Rt)[72] = (const bf16_t (*)[72])(base + 2304);
    const bf16_t (*Bt)[72] = (const bf16_t (*)[72])(base + 4608);
    const bf16_t (*Kt)[72] = (const bf16_t (*)[72])(base + 6912);
    bf16_t* TT = (bf16_t*)(smem + SCS_IMG + iset * 3072);
    bf16_t* ARK = TT + 512;
    bf16_t* AAK = TT + 1024;
    const bf16_t (*X)[72] = (w < 2) ? At : Rt;
    const bf16_t (*Y)[72] = (w & 1) ? Kt : Bt;
    f32x4 cm = (f32x4){0.f, 0.f, 0.f, 0.f};
#pragma unroll
    for (int s = 0; s < 2; ++s) {
      bf16x8 af = *(const bf16x8*)&X[fr][32 * s + 8 * fq];
      bf16x8 bm = *(const bf16x8*)&Y[fr][32 * s + 8 * fq];
      cm = mfma16(af, bm, cm);
    }
#pragma unroll
    for (int jj = 0; jj < 4; ++jj) {
      const int i = 4 * fq + jj;
      const bool keep = (w < 2) ? (fr < i) : (fr <= i);
      cm[jj] = keep ? cm[jj] : 0.f;
    }
    const int io = (fr >> 2) * 8 + (fr & 3);
    auto wr_img = [&](bf16_t* img, const f32x4& Xv, int hi) {
#pragma unroll
      for (int jj = 0; jj < 4; ++jj) img[(4 * fq + jj) * 32 + io + hi] = f2bf(Xv[jj]);
    };
    if (w == 1) wr_img(AAK, cm, 0);
    else if (w == 2) wr_img(ARK, cm, 0);
    else if (w == 3) wr_img(ARK, cm, 4);
    else {
      auto bfrag = [&](const f32x4& Xv) { return frag_join(make_uint2(pack2(Xv[0], Xv[1]), pack2(Xv[2], Xv[3])), make_uint2(0u, 0u)); };
      auto afr = [&](const bf16_t* img) { return *(const bf16x8*)&img[(fr * 4 + fq) * 8]; };
      const f32x4 Z4 = (f32x4){0.f, 0.f, 0.f, 0.f};
      wr_img(IMG0, cm, 0);
      asm volatile("" ::: "memory");
      f32x4 A2 = mfma16(afr(IMG0), bfrag(cm), Z4);
      wr_img(IMG1, A2, 0);
      asm volatile("" ::: "memory");
      f32x4 A4 = mfma16(afr(IMG1), bfrag(A2), Z4);
      wr_img(IMG2, A4, 0);
      asm volatile("" ::: "memory");
      f32x4 Rm = mfma16(afr(IMG2), bfrag(A4), Z4);
#pragma unroll
      for (int jj = 0; jj < 4; ++jj) Rm[jj] += (fr == 4 * fq + jj) ? 1.f : 0.f;
      Rm = mfma16(afr(IMG2), bfrag(Rm), Rm);
      Rm = mfma16(afr(IMG1), bfrag(Rm), Rm);
      Rm = mfma16(afr(IMG0), bfrag(Rm), Rm);
      wr_img(TT, Rm, 0);
    }
  };
  f32x4 acc[4];
#pragma unroll
  for (int kt = 0; kt < 4; ++kt) acc[kt] = (f32x4){0.f, 0.f, 0.f, 0.f};
  auto part2 = [&](int c, int set, int iset) {
    char* base = smem + set * SCS_SET;
    const bf16_t (*At)[72] = (const bf16_t (*)[72])(base);
    const bf16_t (*Rt)[72] = (const bf16_t (*)[72])(base + 2304);
    const bf16_t (*BKT)[36] = (const bf16_t (*)[36])(base + 9216);
    const bf16_t* VV = (const bf16_t*)(base + 13824);
    const float* G16 = (const float*)(base + 16896);
    const bf16_t* TT = (const bf16_t*)(smem + SCS_IMG + iset * 3072);
    const bf16_t* ARK = TT + 512;
    const bf16_t* AAK = TT + 1024;
    bf16x8 Sb[2];
#pragma unroll
    for (int s = 0; s < 2; ++s) {
      uint4 t = make_uint4(pack2(acc[2 * s][0], acc[2 * s][1]), pack2(acc[2 * s][2], acc[2 * s][3]),
                           pack2(acc[2 * s + 1][0], acc[2 * s + 1][1]), pack2(acc[2 * s + 1][2], acc[2 * s + 1][3]));
      Sb[s] = __builtin_bit_cast(bf16x8, t);
    }
    const unsigned* vvp = (const unsigned*)&VV[(fq * 64 + w * 16 + fr) * 6];
    const uint2 vv = make_uint2(vvp[0], vvp[1]);
    const bf16x8 Vlow = frag_join(vv, make_uint2(0u, 0u));
    f32x4 Pm = (f32x4){0.f, 0.f, 0.f, 0.f};
#pragma unroll
    for (int s = 0; s < 2; ++s) {
      bf16x8 af = frag_join(*(const uint2*)&At[fr][32 * s + 4 * fq], *(const uint2*)&At[fr][32 * s + 16 + 4 * fq]);
      Pm = mfma16(af, Sb[s], Pm);
    }
    Pm = mfma16(*(const bf16x8*)&AAK[(fr * 4 + fq) * 8], Vlow, Pm);
    const bf16x8 Pb = frag_join(make_uint2(pack2(Pm[0], Pm[1]), pack2(Pm[2], Pm[3])), make_uint2(0u, 0u));
    f32x4 U = mfma16(*(const bf16x8*)&TT[(fr * 4 + fq) * 8], Pb, (f32x4){0.f, 0.f, 0.f, 0.f});
    const bf16x8 UV = frag_join(make_uint2(pack2(U[0], U[1]), pack2(U[2], U[3])), vv);
    f32x4 Yv = (f32x4){0.f, 0.f, 0.f, 0.f};
#pragma unroll
    for (int s = 0; s < 2; ++s) {
      bf16x8 af = frag_join(*(const uint2*)&Rt[fr][32 * s + 4 * fq], *(const uint2*)&Rt[fr][32 * s + 16 + 4 * fq]);
      Yv = mfma16(af, Sb[s], Yv);
    }
    Yv = mfma16(*(const bf16x8*)&ARK[(fr * 4 + fq) * 8], UV, Yv);
    {
      const int p0 = pos0(c);
#pragma unroll
      for (int jj = 0; jj < 4; ++jj) yb[(size_t)(p0 + pstep * (4 * fq + jj)) * INW] = f2bf(Yv[jj]);
    }
#pragma unroll
    for (int kt = 0; kt < 4; ++kt) {
      f32x4 t = mfma16(frag_join(*(const uint2*)&BKT[16 * kt + fr][fq * 8], *(const uint2*)&BKT[16 * kt + fr][fq * 8 + 4]), UV, acc[kt]);
      const float4 g4 = *(const float4*)&G16[16 * kt + 4 * fq];
      t[0] *= g4.x; t[1] *= g4.y; t[2] *= g4.z; t[3] *= g4.w;
      acc[kt] = t;
    }
  };
  __builtin_amdgcn_s_setprio(3);
  Raw r0, r1;
  load_raw(0, r0); load_raw(1, r1);
  stage1(0, r0);
  load_raw(2, r0);
  __syncthreads();
  stage2(0, 0);
  stage1(1, r1);
  load_raw(3, r1);
  __syncthreads();
  int s0 = 0, s1 = 1, s2 = 2;
  auto iter = [&](int c, Raw& rw) {
    if (c + 1 < NCH) stage2(s1, (c + 1) & 1);
    part2(c, s0, c & 1);
    if (c + 2 < NCH) {
      stage1(s2, rw);
      if (c + 4 < NCH) load_raw(c + 4, rw);
    }
    asm volatile("s_waitcnt lgkmcnt(0)" ::: "memory");
    __builtin_amdgcn_s_barrier();
    asm volatile("" ::: "memory");
    const int t = s0; s0 = s1; s1 = s2; s2 = t;
  };
#pragma unroll 1
  for (int c = 0; c < NCH; c += 2) {
    iter(c, r0); iter(c + 1, r1);
  }
  __builtin_amdgcn_s_setprio(0);
}

DEV void ph_rwkv_post(const P& p, int layer) {
  const int lane = tid_() & 63;
  int r0, r1;
  wave_range(r0, r1, NTOK);
  const int ch = 4 * lane;
  float kav[4], rkv[4], lnw[4], lnb[4];
#pragma unroll
  for (int i = 0; i < 4; ++i) {
    kav[i] = p.rw_k_a[layer * 256 + ch + i]; rkv[i] = p.rw_r_k[layer * 256 + ch + i];
    lnw[i] = p.rw_ln_w[layer * 256 + ch + i]; lnb[i] = p.rw_ln_b[layer * 256 + ch + i];
  }
  struct In { uint2 y0, y1, g; uint4 h0, h1, s0, s1; };
  auto ld = [&](int row, In& in) {
    const bf16_t* zr = p.Z + (size_t)row * INW + 768 + ch;
    in.y0 = *(const uint2*)zr; in.y1 = *(const uint2*)(zr + 256);
    const bf16_t* hr = p.H + (size_t)row * D + 4 * ch;
    in.h0 = *(const uint4*)hr; in.h1 = *(const uint4*)(hr + 8);
    const bf16_t* sr = p.SC + (size_t)row * 1024 + 4 * ch;
    in.s0 = *(const uint4*)sr; in.s1 = *(const uint4*)(sr + 8);
    in.g = *(const uint2*)(p.Y + (size_t)row * D + 256 + ch);
  };
  In nx;
  if (r0 < r1) ld(r0, nx);
#pragma unroll 1
  for (int row = r0; row < r1; ++row) {
    const In in = nx;
    if (row + 1 < r1) ld(row + 1, nx);
    float y[4] = {bflo(in.y0.x) + bflo(in.y1.x), bfhi(in.y0.x) + bfhi(in.y1.x), bflo(in.y0.y) + bflo(in.y1.y), bfhi(in.y0.y) + bfhi(in.y1.y)};
    const float mu = row16_sum(y[0] + y[1] + y[2] + y[3]) * (1.f / 64.f);
    float vs = 0.f;
#pragma unroll
    for (int i = 0; i < 4; ++i) { y[i] -= mu; vs += y[i] * y[i]; }
    const float var = row16_sum(vs) * (1.f / 64.f);
    const float rstd = rsqrtf(var + 64e-5f);
    const float r[4] = {bflo(in.h0.x), bflo(in.h0.z), bflo(in.h1.x), bflo(in.h1.z)};
    const float k[4] = {bfhi(in.h0.x), bfhi(in.h0.z), bfhi(in.h1.x), bfhi(in.h1.z)};
    const float v[4] = {bfhi(in.h0.y), bfhi(in.h0.w), bfhi(in.h1.y), bfhi(in.h1.w)};
    const float a0[4] = {bfhi(in.s0.x), bfhi(in.s0.z), bfhi(in.s1.x), bfhi(in.s1.z)};
    const float a1[4] = {bfhi(in.s0.y), bfhi(in.s0.w), bfhi(in.s1.y), bfhi(in.s1.w)};
    float sd = 0.f;
#pragma unroll
    for (int i = 0; i < 4; ++i) {
      const float kd0 = k[i] * (1.f + (a0[i] - 1.f) * kav[i]), kd1 = k[i] * (1.f + (a1[i] - 1.f) * kav[i]);
      sd += r[i] * (kd0 + kd1) * rkv[i];
    }
    sd = row16_sum(sd);
    const float g[4] = {bflo(in.g.x), bfhi(in.g.x), bflo(in.g.y), bfhi(in.g.y)};
    float o[4];
#pragma unroll
    for (int i = 0; i < 4; ++i) {
      const float yn = y[i] * rstd * lnw[i] + lnb[i];
      o[i] = (yn + sd * v[i]) * g[i];
    }
    *(uint2*)(p.Y + (size_t)row * D + 256 + ch) = make_uint2(pack2(o[0], o[1]), pack2(o[2], o[3]));
  }
}

DEV void hyena_pre_unit(const P& p, int layer, int unit) {
  int kind, b, t0, L;
  if (unit < 1024) { kind = 0; b = unit >> 6; t0 = (unit & 63) * 64; L = T; } else { int u = unit - 1024; kind = 1; b = u >> 2; t0 = (u & 3) * 64; L = LC; }
  const int lane = tid_() & 63, wid = tid_() >> 6;
  const int tw = t0 + wid * 16;
  const size_t row0 = (size_t)b * LT + (kind ? 0 : LC);
  const float* cw = p.conv_w + (size_t)layer * 3 * 1536;
  const float* cb = p.conv_b + (size_t)layer * 1536;
  float wx[3][4], wv[3][4], bx[4], bv[4];
#pragma unroll
  for (int i = 0; i < 4; ++i) {
    const int cx = 256 + 4 * lane + i, cv = 512 + 4 * lane + i;
#pragma unroll
    for (int k = 0; k < 3; ++k) { wx[k][i] = cw[k * 1536 + cx]; wv[k][i] = cw[k * 1536 + cv]; }
    bx[i] = cb[cx]; bv[i] = cb[cv];
  }
  uint2 zx[18], zv[18];
#pragma unroll
  for (int i = 0; i < 18; ++i) {
    const int t = tw - 1 + i;
    if (t >= 0 && t < L) {
      const bf16_t* zr = p.Z + (row0 + t) * INW + 256 + 4 * lane;
      zx[i] = *(const uint2*)zr; zv[i] = *(const uint2*)(zr + 256);
    } else { zx[i] = make_uint2(0u, 0u); zv[i] = make_uint2(0u, 0u); }
  }
  float uo[4][16];
#pragma unroll
  for (int i = 0; i < 16; ++i) {
    const float xm[4] = {bflo(zx[i].x), bfhi(zx[i].x), bflo(zx[i].y), bfhi(zx[i].y)};
    const float xc[4] = {bflo(zx[i + 1].x), bfhi(zx[i + 1].x), bflo(zx[i + 1].y), bfhi(zx[i + 1].y)};
    const float xp[4] = {bflo(zx[i + 2].x), bfhi(zx[i + 2].x), bflo(zx[i + 2].y), bfhi(zx[i + 2].y)};
    const float vm[4] = {bflo(zv[i].x), bfhi(zv[i].x), bflo(zv[i].y), bfhi(zv[i].y)};
    const float vc[4] = {bflo(zv[i + 1].x), bfhi(zv[i + 1].x), bflo(zv[i + 1].y), bfhi(zv[i + 1].y)};
    const float vp[4] = {bflo(zv[i + 2].x), bfhi(zv[i + 2].x), bflo(zv[i + 2].y), bfhi(zv[i + 2].y)};
#pragma unroll
    for (int q = 0; q < 4; ++q) {
      const float a = wx[0][q] * xm[q] + wx[1][q] * xc[q] + wx[2][q] * xp[q] + bx[q];
      const float c2 = wv[0][q] * vm[q] + wv[1][q] * vc[q] + wv[2][q] * vp[q] + bv[q];
      uo[q][i] = a * c2;
    }
  }
  bf16_t* ut = kind ? opq(p.UTc) : opq(p.UTl);
#pragma unroll
  for (int q = 0; q < 4; ++q) {
    bf16_t* dst = ut + ((size_t)(4 * lane + q) * 16 + b) * L + tw;
    *(uint4*)dst = pack8(&uo[q][0]);
    *(uint4*)(dst + 8) = pack8(&uo[q][8]);
  }
}

DEV void hyena_conv_unit(const P& p, int layer, int unit, char* smem) {
  int kind, c, tb, L;
  if (unit < 4096) { kind = 0; c = unit >> 4; tb = (unit & 15) * 256; L = T; } else { kind = 1; c = unit - 4096; tb = 0; L = LC; }
  const int tid = tid_(), lane = tid & 63, wid = tid >> 6, fr = lane & 15, fq = lane >> 4;
  float* red = (float*)(smem + 2 * 16512);
  const float* F = (kind ? opq(p.FC) : opq(p.FL)) + (size_t)c * 2 * L;
  float scale;
  {
    float part = 0.f;
    for (int i = tid; i < 2 * L; i += 256) { float fv = F[i]; part += (i != L) ? fv * fv : 0.f; }
    part = wave_sum(part);
    __syncthreads();
    if (lane == 0) red[wid] = part;
    __syncthreads();
    scale = rsqrtf(((red[0] + red[1]) + (red[2] + red[3])) + 1e-6f);
  }
  const bf16_t* U = (kind ? opq(p.UTc) : opq(p.UTl)) + (size_t)c * 16 * L;
  f32x4 acc[4];
#pragma unroll
  for (int m = 0; m < 4; ++m) acc[m] = (f32x4){0.f, 0.f, 0.f, 0.f};
  const int nch = L / 256;
  float fw0, fw1, fw2;
  uint4 ru0, ru1;
  auto ldchunk = [&](int ch) {
    const int sc = ch * 256;
    const int D0 = tb + 256 - sc;
    auto tap = [&](int n) -> float {
      int d = D0 - n;
      float v = 0.f;
      if (d > -L && d < L) v = (d >= 0 ? F[d] : F[L - d]);
      return v;
    };
    fw0 = tap(tid); fw1 = tap(tid + 256); fw2 = (tid < 8) ? tap(tid + 512) : 0.f;
    const int bb = tid >> 4, sg0 = tid & 15;
    ru0 = *(const uint4*)(U + (size_t)bb * L + sc + 8 * sg0);
    ru1 = *(const uint4*)(U + (size_t)bb * L + sc + 8 * (sg0 + 16));
  };
  auto stchunk = [&](int buf) {
    bf16_t* Cq = (bf16_t*)(smem + buf * 16512);
    bf16_t* Us = (bf16_t*)(smem + buf * 16512 + 8320);
    const bf16_t h0 = f2bf(fw0 * scale), h1 = f2bf(fw1 * scale), h2 = f2bf(fw2 * scale);
#pragma unroll
    for (int rho = 0; rho < 8; ++rho) {
      int m = tid + rho;
      Cq[((m >> 3) * 8 + rho) * 8 + (m & 7)] = h0;
      m = tid + 256 + rho;
      if (m < 520) Cq[((m >> 3) * 8 + rho) * 8 + (m & 7)] = h1;
      m = tid + 512 + rho;
      if (tid < 8 && m < 520) Cq[((m >> 3) * 8 + rho) * 8 + (m & 7)] = h2;
    }
    if (tid < 8) {
#pragma unroll
      for (int rho = 1; rho < 8; ++rho) if (tid < rho) Cq[(rho) * 8 + tid] = 0;
    }
    const int bb = tid >> 4, sg0 = tid & 15;
    *(uint4*)&Us[(sg0 * 16 + bb) * 8] = ru0;
    *(uint4*)&Us[((sg0 + 16) * 16 + bb) * 8] = ru1;
  };
  ldchunk(0);
#pragma unroll 1
  for (int ch = 0; ch < nch; ++ch) {
    const int buf = ch & 1;
    stchunk(buf);
    __syncthreads();
    if (ch + 1 < nch) ldchunk(ch + 1);
    const bf16_t* Cq = (const bf16_t*)(smem + buf * 16512);
    const bf16_t* Us = (const bf16_t*)(smem + buf * 16512 + 8320);
#pragma unroll
    for (int kk = 0; kk < 8; ++kk) {
      bf16x8 bf = *(const bf16x8*)&Us[((4 * kk + fq) * 16 + fr) * 8];
#pragma unroll
      for (int m = 0; m < 4; ++m) {
        int it = wid * 4 + m;
        int base = 256 - 16 * it + 32 * kk + 8 * fq;
        int m0 = base - 8 * (fr >> 3);
        bf16x8 af = *(const bf16x8*)&Cq[((m0 >> 3) * 8 + (fr & 7)) * 8];
        acc[m] = mfma16(af, bf, acc[m]);
      }
    }
  }
  __syncthreads();
  bf16_t* Yt = (kind ? opq(p.YTc) : opq(p.YTl)) + ((size_t)c * 16 + fr) * L + tb;
#pragma unroll
  for (int m = 0; m < 4; ++m) {
    int t = (wid * 4 + m) * 16 + fq * 4;
    *(uint2*)(Yt + t) = make_uint2(pack2(acc[m][0], acc[m][1]), pack2(acc[m][2], acc[m][3]));
  }
}

DEV void hyena_post_unit(const P& p, int layer, int unit, char* smem) {
  (void)smem;
  int kind, b, t0, L;
  if (unit < 1024) { kind = 0; b = unit >> 6; t0 = (unit & 63) * 64; L = T; } else { int u = unit - 1024; kind = 1; b = u >> 2; t0 = (u & 3) * 64; L = LC; }
  const int lane = tid_() & 63, wid = tid_() >> 6;
  const int tw = t0 + wid * 16;
  const size_t row0 = (size_t)b * LT + (kind ? 0 : LC);
  const float* cw = p.conv_w + (size_t)layer * 3 * 1536;
  float w0[3][4], b0[4], bias[4], og[4];
#pragma unroll
  for (int i = 0; i < 4; ++i) {
    const int c = 4 * lane + i;
#pragma unroll
    for (int k = 0; k < 3; ++k) w0[k][i] = cw[k * 1536 + c];
    b0[i] = p.conv_b[layer * 1536 + c]; bias[i] = p.hy_bias[layer * 256 + c]; og[i] = p.hy_out_g[layer * 256 + c];
  }
  uint2 zx[18];
#pragma unroll
  for (int i = 0; i < 18; ++i) {
    const int t = tw - 1 + i;
    zx[i] = (t >= 0 && t < L) ? *(const uint2*)(p.Z + (row0 + t) * INW + 4 * lane) : make_uint2(0u, 0u);
  }
  const bf16_t* ytb = kind ? opq(p.YTc) : opq(p.YTl);
  const bf16_t* utb = kind ? opq(p.UTc) : opq(p.UTl);
  float o[4][16];
#pragma unroll
  for (int q = 0; q < 4; ++q) {
    const size_t off = ((size_t)(4 * lane + q) * 16 + b) * L + tw;
    float yv[16], uv[16];
    { uint4 a0 = *(const uint4*)(ytb + off), a1 = *(const uint4*)(ytb + off + 8); unpack8(a0, yv); unpack8(a1, yv + 8); }
    { uint4 a0 = *(const uint4*)(utb + off), a1 = *(const uint4*)(utb + off + 8); unpack8(a0, uv); unpack8(a1, uv + 8); }
#pragma unroll
    for (int i = 0; i < 16; ++i) o[q][i] = yv[i] + uv[i] * bias[q];
  }
#pragma unroll
  for (int i = 0; i < 16; ++i) {
    const float xm[4] = {bflo(zx[i].x), bfhi(zx[i].x), bflo(zx[i].y), bfhi(zx[i].y)};
    const float xc[4] = {bflo(zx[i + 1].x), bfhi(zx[i + 1].x), bflo(zx[i + 1].y), bfhi(zx[i + 1].y)};
    const float xp[4] = {bflo(zx[i + 2].x), bfhi(zx[i + 2].x), bflo(zx[i + 2].y), bfhi(zx[i + 2].y)};
    float ov[4], ss = 0.f;
#pragma unroll
    for (int q = 0; q < 4; ++q) {
      const float x0 = w0[0][q] * xm[q] + w0[1][q] * xc[q] + w0[2][q] * xp[q] + b0[q];
      ov[q] = bf2f(f2bf(x0 * o[q][i]));
      ss += ov[q] * ov[q];
    }
    ss = wave_sum(ss);
    const float rstd = rsqrtf(ss * (1.f / 256.f) + 1e-6f);
    *(uint2*)(p.Y + (row0 + tw + i) * D + 4 * lane) = make_uint2(pack2(ov[0] * rstd * og[0], ov[1] * rstd * og[1]), pack2(ov[2] * rstd * og[2], ov[3] * rstd * og[3]));
  }
}

DEV void attn_unit(const P& p, int layer, int unit, char* smem) {
  const bool isctx = unit >= 4096;
  int b, qb, hq;
  if (!isctx) { b = unit >> 8; qb = (unit >> 3) & 31; hq = unit & 7; } else { int u = unit - 4096; b = u >> 4; qb = (u >> 3) & 1; hq = u & 7; }
  const int g = hq >> 2;
  const int tid = tid_(), lane = tid & 63, wid = tid >> 6, qn = lane & 31, hh = lane >> 5;
  const int qpos = qb * 128 + wid * 32 + qn;
  const size_t qrow = (size_t)b * LT + (isctx ? qpos : LC + qpos);
  const bf16_t* qptr = p.Z + qrow * INW + 1920 + hq * 64;
  bf16x8 qf[4];
#pragma unroll
  for (int s = 0; s < 4; ++s) qf[s] = *(const bf16x8*)(qptr + 16 * s + 8 * hh);
  const float sink = p.attn_sink[layer * 8 + hq];
  float m_run = sink, l_run = 1.f;
  f32x16 o0, o1;
#pragma unroll
  for (int i = 0; i < 16; ++i) { o0[i] = 0.f; o1[i] = 0.f; }
  typedef bf16_t KTile[64][72];
  KTile* Ks = (KTile*)smem;
  KTile* Vt = (KTile*)(smem + 18432);
  const int ntl = isctx ? 0 : 6;
  const int ntiles = ntl + 4;
  const int skey = tid >> 3, sseg = tid & 7;
  const bf16_t* kvbase = p.Z + (size_t)b * LT * INW + 1920 + 512 + g * 64 + sseg * 8;
  uint4 rk0, rk1, rv0, rv1;
  auto ldtile = [&](int kt) {
    const bool ctxk = kt >= ntl;
    const int kbase = ctxk ? (kt - ntl) * 64 : qb * 128 - 128 + kt * 64;
    const int kp0 = kbase + skey, kp1 = kp0 + 32;
    rk0 = rk1 = rv0 = rv1 = make_uint4(0, 0, 0, 0);
    if (ctxk || (kp0 >= 0 && kp0 < T)) { const bf16_t* src = kvbase + (size_t)(ctxk ? kp0 : LC + kp0) * INW; rk0 = *(const uint4*)src; rv0 = *(const uint4*)(src + 128); }
    if (ctxk || (kp1 >= 0 && kp1 < T)) { const bf16_t* src = kvbase + (size_t)(ctxk ? kp1 : LC + kp1) * INW; rk1 = *(const uint4*)src; rv1 = *(const uint4*)(src + 128); }
  };
  auto sttile = [&](int buf) {
    *(uint4*)&Ks[buf][skey][sseg * 8] = rk0;
    *(uint4*)&Ks[buf][skey + 32][sseg * 8] = rk1;
    bf16_t (*vt)[72] = Vt[buf];
    vt[sseg * 8 + 0][skey] = (bf16_t)(rv0.x & 0xFFFF); vt[sseg * 8 + 1][skey] = (bf16_t)(rv0.x >> 16);
    vt[sseg * 8 + 2][skey] = (bf16_t)(rv0.y & 0xFFFF); vt[sseg * 8 + 3][skey] = (bf16_t)(rv0.y >> 16);
    vt[sseg * 8 + 4][skey] = (bf16_t)(rv0.z & 0xFFFF); vt[sseg * 8 + 5][skey] = (bf16_t)(rv0.z >> 16);
    vt[sseg * 8 + 6][skey] = (bf16_t)(rv0.w & 0xFFFF); vt[sseg * 8 + 7][skey] = (bf16_t)(rv0.w >> 16);
    vt[sseg * 8 + 0][skey + 32] = (bf16_t)(rv1.x & 0xFFFF); vt[sseg * 8 + 1][skey + 32] = (bf16_t)(rv1.x >> 16);
    vt[sseg * 8 + 2][skey + 32] = (bf16_t)(rv1.y & 0xFFFF); vt[sseg * 8 + 3][skey + 32] = (bf16_t)(rv1.y >> 16);
    vt[sseg * 8 + 4][skey + 32] = (bf16_t)(rv1.z & 0xFFFF); vt[sseg * 8 + 5][skey + 32] = (bf16_t)(rv1.z >> 16);
    vt[sseg * 8 + 6][skey + 32] = (bf16_t)(rv1.w & 0xFFFF); vt[sseg * 8 + 7][skey + 32] = (bf16_t)(rv1.w >> 16);
  };
  ldtile(0);
#pragma unroll 1
  for (int kt = 0; kt < ntiles; ++kt) {
    const int buf = kt & 1;
    sttile(buf);
    __syncthreads();
    if (kt + 1 < ntiles) ldtile(kt + 1);
    const bool ctxk = kt >= ntl;
    const int kbase = ctxk ? (kt - ntl) * 64 : qb * 128 - 128 + kt * 64;
#pragma unroll
    for (int sub = 0; sub < 2; ++sub) {
      const int kb2 = kbase + sub * 32;
      bool need = true;
      if (!ctxk) {
        int q0 = qb * 128 + wid * 32;
        if (kb2 + 31 < q0 - 128 || kb2 > q0 + 31 + 128 || kb2 + 31 < 0 || kb2 >= T) need = false;
      }
      if (need) {
        f32x16 sv;
#pragma unroll
        for (int i = 0; i < 16; ++i) sv[i] = 0.f;
#pragma unroll
        for (int ks = 0; ks < 4; ++ks) {
          bf16x8 kf = *(const bf16x8*)&Ks[buf][sub * 32 + qn][16 * ks + 8 * hh];
          sv = mfma32(kf, qf[ks], sv);
        }
        float mt = -3e38f;
#pragma unroll
        for (int rg = 0; rg < 16; ++rg) {
          float v = sv[rg] * 0.125f;
          if (!ctxk) {
            int kp = kb2 + (rg & 3) + 8 * (rg >> 2) + 4 * hh;
            int dl = qpos - kp;
            bool ok = (dl <= 128) && (dl >= -128) && (kp >= 0) && (kp < T);
            v = ok ? v : -1e30f;
          }
          sv[rg] = v;
          mt = fmaxf(mt, v);
        }
        mt = fmaxf(mt, __shfl_xor(mt, 32));
        float m_new = fmaxf(m_run, mt);
        float corr = __expf(m_run - m_new);
        float ps = 0.f;
#pragma unroll
        for (int rg = 0; rg < 16; ++rg) { float pv = __expf(sv[rg] - m_new); sv[rg] = pv; ps += pv; }
        ps += __shfl_xor(ps, 32);
        l_run = l_run * corr + ps;
        m_run = m_new;
#pragma unroll
        for (int i = 0; i < 16; ++i) { o0[i] *= corr; o1[i] *= corr; }
#pragma unroll
        for (int sp = 0; sp < 2; ++sp) {
          bf16x8 pf;
#pragma unroll
          for (int j = 0; j < 8; ++j) pf[j] = (short)f2bf(sv[8 * sp + j]);
          const int kc = sub * 32 + 16 * sp + 4 * hh;
          uint2 va = *(const uint2*)&Vt[buf][qn][kc], vb = *(const uint2*)&Vt[buf][qn][kc + 8];
          uint2 vc = *(const uint2*)&Vt[buf][32 + qn][kc], vd = *(const uint2*)&Vt[buf][32 + qn][kc + 8];
          uint4 w0 = make_uint4(va.x, va.y, vb.x, vb.y), w1 = make_uint4(vc.x, vc.y, vd.x, vd.y);
          bf16x8 v0 = __builtin_bit_cast(bf16x8, w0), v1 = __builtin_bit_cast(bf16x8, w1);
          o0 = mfma32(v0, pf, o0);
          o1 = mfma32(v1, pf, o1);
        }
      }
    }
  }
  __syncthreads();
  const float inv = 1.f / l_run;
  bf16_t* optr = p.Y + qrow * D + 512 + hq * 64;
#pragma unroll
  for (int rg = 0; rg < 4; ++rg) {
    int d0 = 8 * rg + 4 * hh;
    *(uint2*)(optr + d0) = make_uint2(pack2(o0[4 * rg] * inv, o0[4 * rg + 1] * inv), pack2(o0[4 * rg + 2] * inv, o0[4 * rg + 3] * inv));
    *(uint2*)(optr + 32 + d0) = make_uint2(pack2(o1[4 * rg] * inv, o1[4 * rg + 1] * inv), pack2(o1[4 * rg + 2] * inv, o1[4 * rg + 3] * inv));
  }
}

DEV void ph_attn_post(const P& p, int layer) {
  const int lane = tid_() & 63;
  int r0, r1;
  wave_range(r0, r1, NTOK);
  float gv[8];
#pragma unroll
  for (int i = 0; i < 8; ++i) gv[i] = p.at_out_g[layer * 512 + 8 * lane + i];
  uint4 nx = make_uint4(0, 0, 0, 0);
  if (r0 < r1) nx = *(const uint4*)(p.Y + (size_t)r0 * D + 512 + 8 * lane);
#pragma unroll 1
  for (int row = r0; row < r1; ++row) {
    const uint4 u = nx;
    if (row + 1 < r1) nx = *(const uint4*)(p.Y + (size_t)(row + 1) * D + 512 + 8 * lane);
    float v[8];
    unpack8(u, v);
    float ss = 0.f;
#pragma unroll
    for (int i = 0; i < 8; ++i) ss += v[i] * v[i];
    ss = wave_sum(ss);
    const float rstd = rsqrtf(ss * (1.f / 512.f) + 1e-6f);
#pragma unroll
    for (int i = 0; i < 8; ++i) {
      v[i] = v[i] * rstd * gv[i];
    }
    *(uint4*)(p.Y + (size_t)row * D + 512 + 8 * lane) = pack8(v);
  }
}

struct Epi2 {
  const P& p; int layer, row0, col0;
  DEV void operator()(f32x4 (&acc)[4][4], int wr, int wc, int fr, int fq, char* smem) const {
    const int b = row0 / LT, pp = row0 % LT;
    const int mr = pp < LC ? 16 : b;
    const float* g1 = p.modv + ((size_t)layer * 17 + mr) * 6144 + 2048 + col0 + wc * 64;
#pragma unroll
    for (int n = 0; n < 4; ++n) {
      const float4 gv = *(const float4*)(g1 + n * 16 + 4 * fq);
#pragma unroll
      for (int m = 0; m < 4; ++m) { acc[m][n][0] *= gv.x; acc[m][n][1] *= gv.y; acc[m][n][2] *= gv.z; acc[m][n][3] *= gv.w; }
    }
    const int wid = wr * 2 + wc, lane = fq * 16 + fr;
    stage_tile_bf16(acc, smem, wid, fr, fq);
    const bf16_t (*t)[72] = (const bf16_t (*)[72])(smem + wid * 9216);
#pragma unroll
    for (int i = 0; i < 8; ++i) {
      const int rl = i * 8 + (lane >> 3), ch = lane & 7;
      bf16_t* xp = p.X + (size_t)(row0 + wr * 64 + rl) * D + col0 + wc * 64 + ch * 8;
      float xv[8], dv[8];
      uint4 xu = *(const uint4*)xp, du = *(const uint4*)&t[rl][ch * 8];
      unpack8(xu, xv); unpack8(du, dv);
#pragma unroll
      for (int q = 0; q < 8; ++q) xv[q] += dv[q];
      *(uint4*)xp = pack8(xv);
    }
  }
};
DEV void ph_gemm2(const P& p, int layer, char* smem) {
  int rt, ct;
  for (int it = 0; gemm_unit(it, 8, rt, ct); ++it) {
    Epi2 epi{p, layer, rt * 128, ct * 128};
    gemm_tile(p.Y + (size_t)rt * 128 * D, D, p.W2t + (size_t)ct * 128 * D, D, D, smem, epi);
  }
}

DEV void ph_peerconv(const P& p, int layer) {
  const int gw = (bid_() * 256 + tid_()) >> 6, nw = gridDim.x * 4, lane = tid_() & 63;
  const float* su = opq(p.peer_u) + (size_t)layer * 16384 * 1024;
  const float* sv = opq(p.peer_v) + (size_t)layer * 16384 * 1024;
  unsigned char* pu = opq(p.PU); unsigned char* pv = opq(p.PV);
  float* psu = opq(p.PSU); float* psv = opq(p.PSV);
  auto ldrow = [&](int r, float4& a0, float4& a1, float4& a2, float4& a3) {
    const float* src = ((r >= 16384) ? sv : su) + (size_t)(r & 16383) * 1024 + 16 * lane;
    a0 = *(const float4*)src; a1 = *(const float4*)(src + 4); a2 = *(const float4*)(src + 8); a3 = *(const float4*)(src + 12);
  };
  float4 n0 = make_float4(0, 0, 0, 0), n1 = n0, n2 = n0, n3 = n0;
  if (gw < 32768) ldrow(gw, n0, n1, n2, n3);
#pragma unroll 1
  for (int r = gw; r < 32768; r += nw) {
    const bool isv = r >= 16384;
    const int e = r & 16383;
    const float4 f0 = n0, f1 = n1, f2 = n2, f3 = n3;
    if (r + nw < 32768) ldrow(r + nw, n0, n1, n2, n3);
    float am = fmaxf(fmaxf(fmaxf(fabsf(f0.x), fabsf(f0.y)), fmaxf(fabsf(f0.z), fabsf(f0.w))), fmaxf(fmaxf(fabsf(f1.x), fabsf(f1.y)), fmaxf(fabsf(f1.z), fabsf(f1.w))));
    am = fmaxf(am, fmaxf(fmaxf(fmaxf(fabsf(f2.x), fabsf(f2.y)), fmaxf(fabsf(f2.z), fabsf(f2.w))), fmaxf(fmaxf(fabsf(f3.x), fabsf(f3.y)), fmaxf(fabsf(f3.z), fabsf(f3.w)))));
    am = wave_max(am);
    int w0, w1, w2, w3;
    float inv;
    if (isv) {
      const float sc = am > 0.f ? 224.f / am : 1.f;
      inv = am > 0.f ? am * (1.f / 224.f) : 1.f;
      w0 = __builtin_amdgcn_cvt_pk_fp8_f32(f0.x * sc, f0.y * sc, 0, false); w0 = __builtin_amdgcn_cvt_pk_fp8_f32(f0.z * sc, f0.w * sc, w0, true);
      w1 = __builtin_amdgcn_cvt_pk_fp8_f32(f1.x * sc, f1.y * sc, 0, false); w1 = __builtin_amdgcn_cvt_pk_fp8_f32(f1.z * sc, f1.w * sc, w1, true);
      w2 = __builtin_amdgcn_cvt_pk_fp8_f32(f2.x * sc, f2.y * sc, 0, false); w2 = __builtin_amdgcn_cvt_pk_fp8_f32(f2.z * sc, f2.w * sc, w2, true);
      w3 = __builtin_amdgcn_cvt_pk_fp8_f32(f3.x * sc, f3.y * sc, 0, false); w3 = __builtin_amdgcn_cvt_pk_fp8_f32(f3.z * sc, f3.w * sc, w3, true);
    } else {
      const float sc = am > 0.f ? 127.f / am : 1.f;
      inv = am > 0.f ? am * (1.f / 127.f) : 1.f;
      w0 = pack_i8(f0.x * sc, f0.y * sc, f0.z * sc, f0.w * sc); w1 = pack_i8(f1.x * sc, f1.y * sc, f1.z * sc, f1.w * sc);
      w2 = pack_i8(f2.x * sc, f2.y * sc, f2.z * sc, f2.w * sc); w3 = pack_i8(f3.x * sc, f3.y * sc, f3.z * sc, f3.w * sc);
    }
    *(uint4*)((isv ? pv : pu) + (size_t)(lane >> 3) * PSLICE + (size_t)e * 128 + 16 * (lane & 7)) = make_uint4((unsigned)w0, (unsigned)w1, (unsigned)w2, (unsigned)w3);
    if (lane == 0) (isv ? psv : psu)[e] = inv;
  }
}
DEV void unpack16_fp8x2(const uint4& u, f32x2* f) {
  f[0] = __builtin_amdgcn_cvt_pk_f32_fp8((int)u.x, false); f[1] = __builtin_amdgcn_cvt_pk_f32_fp8((int)u.x, true);
  f[2] = __builtin_amdgcn_cvt_pk_f32_fp8((int)u.y, false); f[3] = __builtin_amdgcn_cvt_pk_f32_fp8((int)u.y, true);
  f[4] = __builtin_amdgcn_cvt_pk_f32_fp8((int)u.z, false); f[5] = __builtin_amdgcn_cvt_pk_f32_fp8((int)u.z, true);
  f[6] = __builtin_amdgcn_cvt_pk_f32_fp8((int)u.w, false); f[7] = __builtin_amdgcn_cvt_pk_f32_fp8((int)u.w, true);
}

DEV void bitonic_sort16_desc(float (&v)[16]) {
#pragma unroll
  for (int k = 2; k <= 16; k <<= 1)
#pragma unroll
    for (int j = k >> 1; j >= 1; j >>= 1)
#pragma unroll
      for (int i = 0; i < 16; ++i) {
        const int l = i ^ j;
        if (l > i) {
          const float hi = fmaxf(v[i], v[l]), lo = fminf(v[i], v[l]);
          if ((i & k) == 0) { v[i] = hi; v[l] = lo; } else { v[i] = lo; v[l] = hi; }
        }
      }
}
DEV void peer_cand_ij(int c, int& ci, int& cj) {
  if (c < 16) { ci = 0; cj = c; } else if (c < 24) { ci = 1; cj = c - 16; } else if (c < 29) { ci = 2; cj = c - 24; }
  else if (c < 33) { ci = 3; cj = c - 29; } else if (c < 36) { ci = 4; cj = c - 33; } else if (c < 38) { ci = 5; cj = c - 36; }
  else if (c < 40) { ci = 6; cj = c - 38; } else if (c < 42) { ci = 7; cj = c - 40; } else { ci = (c - 42 + 8) & 15; cj = 0; }
}
template <int S>
struct Epi3K {
  const P& p; int row0, head; float (&keep)[2][16];
  DEV void operator()(f32x4 (&acc)[4][4], int wr, int wc, int fr, int fq, char* smem) const {
    float* sc = (float*)smem;
    float* L1s = (float*)(smem + 36864);
    float* L2s = (float*)(smem + 45056);
    const int tid = tid_();
#pragma unroll
    for (int pass = 0; pass < 2; ++pass) {
      __syncthreads();
      if (wr == pass) {
#pragma unroll
        for (int m = 0; m < 4; ++m)
#pragma unroll
          for (int n = 0; n < 4; ++n)
#pragma unroll
            for (int j = 0; j < 4; ++j) {
              int rl = m * 16 + fr, col = wc * 64 + n * 16 + 4 * fq + j;
              unsigned bits = (__float_as_uint(acc[m][n][j]) & ~127u) | (unsigned)col;
              sc[rl * 133 + (col >> 5) * 33 + (col & 31)] = __uint_as_float(bits);
            }
      }
      __syncthreads();
      const int rl = tid >> 2, q = tid & 3;
      const float* src = sc + rl * 133 + q * 33;
      float Ls[16], Hs[16];
#pragma unroll
      for (int i = 0; i < 16; ++i) { Ls[i] = src[i]; Hs[i] = src[16 + i]; }
      bitonic_sort16_desc(Ls);
      bitonic_sort16_desc(Hs);
#pragma unroll
      for (int i = 0; i < 16; ++i) Ls[i] = fmaxf(Ls[i], Hs[15 - i]);
#pragma unroll
      for (int d = 8; d >= 1; d >>= 1)
#pragma unroll
        for (int i = 0; i < 16; ++i)
          if ((i & d) == 0) { float hi = fmaxf(Ls[i], Ls[i + d]), lo = fminf(Ls[i], Ls[i + d]); Ls[i] = hi; Ls[i + d] = lo; }
      float Cs[16];
#pragma unroll
      for (int i = 0; i < 16; ++i) Cs[i] = fmaxf(Ls[i], dppself<0xB1, 0xF>(Ls[15 - i]));
#pragma unroll
      for (int d = 8; d >= 1; d >>= 1)
#pragma unroll
        for (int i = 0; i < 16; ++i)
          if ((i & d) == 0) { float hi = fmaxf(Cs[i], Cs[i + d]), lo = fminf(Cs[i], Cs[i + d]); Cs[i] = hi; Cs[i + d] = lo; }
      float Ds[16];
#pragma unroll
      for (int i = 0; i < 16; ++i) Ds[i] = fmaxf(Cs[i], dppself<0x4E, 0xF>(Cs[15 - i]));
#pragma unroll
      for (int d = 8; d >= 1; d >>= 1)
#pragma unroll
        for (int i = 0; i < 16; ++i)
          if ((i & d) == 0) { float hi = fmaxf(Ds[i], Ds[i + d]), lo = fminf(Ds[i], Ds[i + d]); Ds[i] = hi; Ds[i + d] = lo; }
      if (S == 0) {
#pragma unroll
        for (int i = 0; i < 16; ++i) keep[pass][i] = Ds[i];
      } else if (q == 0) {
        float* d1 = L1s + (pass * 64 + rl) * 16;
        float* d2 = L2s + (pass * 64 + rl) * 16;
#pragma unroll
        for (int i = 0; i < 4; ++i) {
          *(float4*)(d1 + 4 * i) = make_float4(keep[pass][4 * i], keep[pass][4 * i + 1], keep[pass][4 * i + 2], keep[pass][4 * i + 3]);
          *(float4*)(d2 + 4 * i) = make_float4(Ds[4 * i], Ds[4 * i + 1], Ds[4 * i + 2], Ds[4 * i + 3]);
        }
      }
    }
    if (S == 1) {
      __syncthreads();
      const int lane = tid & 63, wid = tid >> 6;
      int ci, cj;
      peer_cand_ij(lane, ci, cj);
      const bool cand = lane < 50;
      float n1 = L1s[(wid * 32) * 16 + ci], n2 = L2s[(wid * 32) * 16 + cj];
#pragma unroll 1
      for (int r = 0; r < 32; ++r) {
        const int row = wid * 32 + r;
        const float v1 = n1, v2 = n2;
        if (r + 1 < 32) { n1 = L1s[(row + 1) * 16 + ci]; n2 = L2s[(row + 1) * 16 + cj]; }
        float val = v1 + v2;
        val = __uint_as_float((__float_as_uint(val) & ~63u) | (unsigned)lane);
        val = cand ? val : -3e38f;
        int rank = 0;
#pragma unroll
        for (int q = 0; q < 50; ++q) rank += (readlane_f(val, q) > val) ? 1 : 0;
        const bool sel = cand && rank < 16;
        const float mx = readlane_f(val, 0);
        const float ex = sel ? __expf(val - mx) : 0.f;
        const float sm = wave_sum(ex);
        if (sel) {
          const int e = (int)(__float_as_uint(v1) & 127u) * 128 + (int)(__float_as_uint(v2) & 127u);
          const size_t o = (size_t)(row0 + row) * 128 + head * 16 + rank;
          p.EL[o] = (unsigned short)e;
          p.GT[o] = ex / sm;
        }
      }
    }
  }
};
DEV void ph_gemm3(const P& p, char* smem) {
  int rt, hd;
  for (int it = 0; gemm_unit(it, 8, rt, hd); ++it) {
    float keep[2][16];
    {
      Epi3K<0> epi{p, rt * 128, hd, keep};
      gemm_tile(p.H + (size_t)rt * 128 * D, D, p.Wft + (size_t)(2 * hd) * 128 * D, D, D, smem, epi);
    }
    {
      Epi3K<1> epi{p, rt * 128, hd, keep};
      gemm_tile(p.H + (size_t)rt * 128 * D, D, p.Wft + (size_t)(2 * hd + 1) * 128 * D, D, D, smem, epi);
    }
  }
}

DEV float peer_gate(float scr) {
  float mx = row16_max(scr);
  float ex = __expf(scr - mx);
  float sm = row16_sum(ex);
  return ex / sm;
}
DEV float gelu_exact(float x) { return 0.5f * x * (1.f + erff(x * 0.7071067811865476f)); }

struct PeerPre { uint4 e0, e1, a0, a1; };
DEV unsigned peer_eid(const PeerPre& s, int j) {
  const unsigned w = (j < 8) ? ((j >> 1) == 0 ? s.e0.x : (j >> 1) == 1 ? s.e0.y : (j >> 1) == 2 ? s.e0.z : s.e0.w)
                             : (((j - 8) >> 1) == 0 ? s.e1.x : ((j - 8) >> 1) == 1 ? s.e1.y : ((j - 8) >> 1) == 2 ? s.e1.z : s.e1.w);
  return (j & 1) ? (w >> 16) : (w & 0xFFFFu);
}
template <int WHICH>
DEV void peer_wave_run(const P& p, int layer, int x, int tok0, int lane, float* wbuf) {
  const int r = lane >> 3, c = lane & 7;
  const unsigned char* tb = (WHICH == 0 ? p.PU : p.PV) + (size_t)x * PSLICE + c * 16;
  PeerPre S[3];
  uint4 R[16];
  auto ld_pre = [&](int tok, PeerPre& s) {
    const uint4* elp = (const uint4*)(p.EL + (size_t)tok * 128 + r * 16);
    s.e0 = elp[0]; s.e1 = elp[1];
    if (WHICH == 0) {
      s.a0 = *(const uint4*)(p.H8 + (size_t)tok * 1024 + x * 128 + c * 16);
    } else {
      const uint4* wtp = (const uint4*)(p.GW + (size_t)tok * 128 + r * 16);
      s.a0 = wtp[0]; s.a1 = wtp[1];
    }
  };
  auto comp = [&](int tok, const PeerPre& s, const PeerPre& sn, bool more) {
    if (WHICH == 0) {
      int keep0 = 0, keep1 = 0;
#pragma unroll
      for (int j = 0; j < 16; ++j) {
        const uint4 rw = R[j];
        if (more) R[j] = *(const uint4*)(tb + (size_t)peer_eid(sn, j) * 128);
        int d = __builtin_amdgcn_sdot4((int)rw.x, (int)s.a0.x, 0, false);
        d = __builtin_amdgcn_sdot4((int)rw.y, (int)s.a0.y, d, false);
        d = __builtin_amdgcn_sdot4((int)rw.z, (int)s.a0.z, d, false);
        d = __builtin_amdgcn_sdot4((int)rw.w, (int)s.a0.w, d, false);
        d += __builtin_amdgcn_update_dpp(0, d, 0xB1, 0xF, 0xF, false);
        d += __builtin_amdgcn_update_dpp(0, d, 0x4E, 0xF, 0xF, false);
        d += __builtin_amdgcn_update_dpp(0, d, 0x141, 0xF, 0xF, false);
        if (j < 8) keep0 = (c == j) ? d : keep0; else keep1 = (c == j - 8) ? d : keep1;
      }
      bf16_t* pd = p.PD + ((size_t)x * NTOK + tok) * 128 + r * 16 + c;
      pd[0] = f2bf((float)keep0); pd[8] = f2bf((float)keep1);
    } else {
      float wsv[16];
      unpack8(s.a0, wsv); unpack8(s.a1, wsv + 8);
      f32x2 acc2[8];
#pragma unroll
      for (int i = 0; i < 8; ++i) acc2[i] = (f32x2){0.f, 0.f};
#pragma unroll
      for (int j = 0; j < 16; ++j) {
        f32x2 f[8];
        unpack16_fp8x2(R[j], f);
        if (more) R[j] = *(const uint4*)(tb + (size_t)peer_eid(sn, j) * 128);
        const f32x2 w2 = (f32x2){wsv[j], wsv[j]};
#pragma unroll
        for (int i = 0; i < 8; ++i) acc2[i] += w2 * f[i];
      }
      float* slab = wbuf + (r * 8 + c) * 16;
      *(float4*)(slab) = make_float4(acc2[0][0], acc2[0][1], acc2[1][0], acc2[1][1]);
      *(float4*)(slab + 4) = make_float4(acc2[2][0], acc2[2][1], acc2[3][0], acc2[3][1]);
      *(float4*)(slab + 8) = make_float4(acc2[4][0], acc2[4][1], acc2[5][0], acc2[5][1]);
      *(float4*)(slab + 12) = make_float4(acc2[6][0], acc2[6][1], acc2[7][0], acc2[7][1]);
      asm volatile("s_waitcnt lgkmcnt(0)" ::: "memory");
      float o0 = 0.f, o1 = 0.f;
#pragma unroll
      for (int rr = 0; rr < 8; ++rr) {
        const float2 t = *(const float2*)(wbuf + (rr * 8 + (lane >> 3)) * 16 + 2 * (lane & 7));
        o0 += t.x; o1 += t.y;
      }
      asm volatile("s_waitcnt lgkmcnt(0)" ::: "memory");
      const int b = tok / LT, pp = tok % LT;
      const int mr = pp < LC ? 16 : b;
      const int col = x * 128 + 2 * lane;
      const float* g2 = p.modv + ((size_t)layer * 17 + mr) * 6144 + 5120 + col;
      unsigned* xp = (unsigned*)(p.X + (size_t)tok * D + col);
      const unsigned xu = *xp;
      *xp = pack2(bflo(xu) + g2[0] * o0, bfhi(xu) + g2[1] * o1);
    }
  };
  ld_pre(tok0, S[0]);
  ld_pre(tok0 + 1, S[1]);
#pragma unroll
  for (int j = 0; j < 16; ++j) R[j] = *(const uint4*)(tb + (size_t)peer_eid(S[0], j) * 128);
  ld_pre(tok0 + 2, S[2]);
#pragma unroll
  for (int t = 0; t < 8; ++t) {
    comp(tok0 + t, S[t % 3], S[(t + 1) % 3], t + 1 < 8);
    if (t + 3 < 8) ld_pre(tok0 + t + 3, S[t % 3]);
  }
}
DEV void ph_peer_w(const P& p) {
  for (size_t i8 = (size_t)bid_() * 256 + tid_(); i8 < (size_t)NTOK * 16; i8 += (size_t)gridDim.x * 256) {
    const size_t i = i8 * 8;
    float d[8];
#pragma unroll
    for (int q = 0; q < 8; ++q) d[q] = 0.f;
#pragma unroll
    for (int x = 0; x < 8; ++x) {
      const uint4 u = *(const uint4*)(p.PD + (size_t)x * NTOK * 128 + i);
      float f[8];
      unpack8(u, f);
#pragma unroll
      for (int q = 0; q < 8; ++q) d[q] += f[q];
    }
    const uint4 eu = *(const uint4*)(p.EL + i);
    const unsigned ew[4] = {eu.x, eu.y, eu.z, eu.w};
    const float hinv = p.HINV[i >> 7];
    float4 g0 = *(const float4*)(p.GT + i), g1 = *(const float4*)(p.GT + i + 4);
    float g[8] = {g0.x, g0.y, g0.z, g0.w, g1.x, g1.y, g1.z, g1.w};
#pragma unroll
    for (int q = 0; q < 8; ++q) {
      const unsigned e = (q & 1) ? (ew[q >> 1] >> 16) : (ew[q >> 1] & 0xFFFFu);
      g[q] = g[q] * gelu_exact(d[q] * p.PSU[e] * hinv) * p.PSV[e];
    }
    *(uint4*)(p.GW + i) = pack8(g);
  }
}
template <int WHICH>
DEV void ph_peer_gather(const P& p, int layer, char* smem, volatile LAS unsigned* slot) {
  const int tid = tid_(), lane = tid & 63, wid = tid >> 6;
  unsigned* q = p.wq + 1024 + layer * 256 + WHICH * 128;
  const int my = (int)(xb_xcc_id() & 7u);
  float* wbuf = (float*)smem + wid * 1024;
#pragma unroll 1
  for (int rot = 0; rot < 8; ++rot) {
    const int x = (my + rot) & 7;
    for (;;) {
      __syncthreads();
      if (tid == 0) *slot = atomicAdd(q + x * 16, 1u);
      __syncthreads();
      const int it = (int)*slot;
      if (it >= NTOK / 64) break;
      peer_wave_run<WHICH>(p, layer, x, it * 64 + wid * 16, lane, wbuf);
      peer_wave_run<WHICH>(p, layer, x, it * 64 + wid * 16 + 8, lane, wbuf);
    }
  }
}

DEV void ph_final(const P& p) {
  const int lane = tid_() & 63;
  int r0, r1;
  wave_range(r0, r1, NB * T);
  float gv[16];
#pragma unroll
  for (int hh = 0; hh < 2; ++hh)
#pragma unroll
    for (int i = 0; i < 8; ++i) gv[hh * 8 + i] = p.final_g[hh * 512 + 8 * lane + i];
  auto xrow = [&](int r) -> const bf16_t* { const int b = r / T, t = r % T; return p.X + ((size_t)b * LT + LC + t) * D; };
  uint4 n0 = make_uint4(0, 0, 0, 0), n1 = n0;
  if (r0 < r1) { const bf16_t* xr = xrow(r0); n0 = *(const uint4*)(xr + 8 * lane); n1 = *(const uint4*)(xr + 512 + 8 * lane); }
#pragma unroll 1
  for (int r = r0; r < r1; ++r) {
    const uint4 u0 = n0, u1 = n1;
    if (r + 1 < r1) { const bf16_t* xr = xrow(r + 1); n0 = *(const uint4*)(xr + 8 * lane); n1 = *(const uint4*)(xr + 512 + 8 * lane); }
    float v[16];
    unpack8(u0, v); unpack8(u1, v + 8);
    float ss = 0.f;
#pragma unroll
    for (int i = 0; i < 16; ++i) ss += v[i] * v[i];
    ss = wave_sum(ss);
    const float rstd = rsqrtf(ss * (1.f / 1024.f) + 1e-6f);
    float* o = p.out + (size_t)r * D;
#pragma unroll
    for (int hh = 0; hh < 2; ++hh) {
      const int col = hh * 512 + 8 * lane;
      *(float4*)(o + col) = make_float4(v[hh * 8 + 0] * rstd * gv[hh * 8 + 0], v[hh * 8 + 1] * rstd * gv[hh * 8 + 1], v[hh * 8 + 2] * rstd * gv[hh * 8 + 2], v[hh * 8 + 3] * rstd * gv[hh * 8 + 3]);
      *(float4*)(o + col + 4) = make_float4(v[hh * 8 + 4] * rstd * gv[hh * 8 + 4], v[hh * 8 + 5] * rstd * gv[hh * 8 + 5], v[hh * 8 + 6] * rstd * gv[hh * 8 + 6], v[hh * 8 + 7] * rstd * gv[hh * 8 + 7]);
    }
  }
}

DEV unsigned hw_cu_key() {
  const unsigned hwid = (unsigned)__builtin_amdgcn_s_getreg(((8 - 1) << 11) | (8 << 6) | 4);
  return (xb_xcc_id() << 8) | (hwid & 0xFFu);
}
DEV void mixB(const P& p, int layer, char* smem, volatile LAS unsigned* slot) {
  unsigned* qa = p.wq + layer * 64;
  unsigned* qs = qa + 16;
  unsigned* claim = p.cuclaim + layer * 4096;
  __syncthreads();
  if (tid_() == 0) {
    unsigned u = 0xFFFFFFFFu;
    if (atomicAdd(&claim[hw_cu_key() & 4095u], 1u) == 0u) u = atomicAdd(qs, 1u);
    *slot = u;
  }
  __syncthreads();
  {
    const unsigned u = *slot;
    if (u < 128u) scanc_unit(p, layer, (int)u, smem);
  }
  for (;;) {
    __syncthreads();
    if (tid_() == 0) *slot = atomicAdd(qa, 1u);
    __syncthreads();
    const int u = (int)*slot;
    if (u >= 8704) break;
    if (u < 4352) attn_unit(p, layer, u, smem); else hyena_conv_unit(p, layer, u - 4352, smem);
  }
  if (layer + 1 < DEPTH) {
    unsigned* qp = qa + 32;
    for (;;) {
      __syncthreads();
      if (tid_() == 0) *slot = atomicAdd(qp, 1u);
      __syncthreads();
      const int u = (int)*slot;
      if (u >= PREPA_N) break;
      prep_unit(p, layer + 1, prepA_unit_index(u), smem);
    }
  }
  for (;;) {
    __syncthreads();
    if (tid_() == 0) *slot = atomicAdd(qs, 1u);
    __syncthreads();
    const unsigned u = *slot;
    if (u >= 128u) break;
    scanc_unit(p, layer, (int)u, smem);
  }
}
DEV void mixA(const P& p, int layer, char* smem) {
  for (int u = bid_(); u < 1088; u += gridDim.x) hyena_pre_unit(p, layer, u);
  ph_lora(p, layer, smem);
  ph_rwkv_prep(p, layer);
}
DEV void mixC(const P& p, int layer, char* smem) {
  for (int u = bid_(); u < 1088; u += gridDim.x) hyena_post_unit(p, layer, u, smem);
  ph_rwkv_post(p, layer);
  ph_attn_post(p, layer);
}

__global__ void __launch_bounds__(256, 2) k_mega(P p) {
  extern __shared__ __attribute__((aligned(16))) char smem_all[];
  char* smem = smem_all;
  volatile LAS unsigned* xbw = (volatile LAS unsigned*)(smem_all + SMEM_BYTES);
  if (threadIdx.x == 0) { xbw[0] = 0u; xbw[1] = 0u; xbw[2] = 0u; xbw[3] = 0u; }
  __syncthreads();
  XcdBarrier bar = xcd_barrier_post(p.bar, xbw);
  ph_copy(p);
  ph_rope(p);
  for (int u = blockIdx.x; u < 96; u += gridDim.x) modv_unit(p, u, smem);
  ph_prep(p, 0, smem, false);
  xcd_barrier(bar);
  for (int layer = 0; layer < DEPTH; ++layer) {
    ph_norm(p, layer, 0);
    xcd_barrier(bar);
    ph_gemm1(p, smem);
    xcd_barrier(bar);
    mixA(p, layer, smem);
    xcd_barrier(bar);
    mixB(p, layer, smem, (volatile LAS unsigned*)(smem_all + SMEM_BYTES + 16));
    xcd_barrier(bar);
    mixC(p, layer, smem);
    xcd_barrier(bar);
    ph_gemm2(p, layer, smem);
    ph_peerconv(p, layer);
    xcd_barrier(bar);
    ph_norm(p, layer, 1);
    xcd_barrier(bar);
    ph_gemm3(p, smem);
    xcd_barrier(bar);
    ph_peer_gather<0>(p, layer, smem, (volatile LAS unsigned*)(smem_all + SMEM_BYTES + 16));
    xcd_barrier(bar);
    ph_peer_w(p);
    xcd_barrier(bar);
    ph_peer_gather<1>(p, layer, smem, (volatile LAS unsigned*)(smem_all + SMEM_BYTES + 16));
    if (layer + 1 < DEPTH) ph_prep(p, layer + 1, smem, true);
    xcd_barrier(bar);
  }
  ph_final(p);
}

static inline size_t al256(size_t x) { return (x + 255) & ~(size_t)255; }

extern "C" void kernel_launch(void* const* d_in, const int* in_sizes, int n_in, void* d_out, int out_size, void* d_ws, size_t ws_size,
                              hipStream_t stream) {
  (void)in_sizes; (void)n_in; (void)out_size; (void)ws_size;
  P p{};
  const float** f = (const float**)&p;
  for (int i = 0; i < 39; ++i) f[i] = (const float*)d_in[i];
  p.out = (float*)d_out;
  char* w = (char*)d_ws;
  size_t off = 0;
  auto take = [&](size_t bytes) { char* r = w + off; off += al256(bytes); return r; };
  p.bar = (unsigned*)take(16384);
  p.modv = (float*)take((size_t)DEPTH * 17 * 6144 * 4);
  p.SSQ = (float*)take((size_t)DEPTH * 2 * 256 * 4);
  p.wq = (unsigned*)take(4096 + DEPTH * 1024);
  p.cuclaim = (unsigned*)take((size_t)DEPTH * 4096 * 4);
  const size_t zero_bytes = off;
  p.rope = (float*)take(64 * 16 * 2 * 4);
  p.X = (bf16_t*)take((size_t)NTOK * D * 2);
  p.H = (bf16_t*)take((size_t)NTOK * D * 2);
  p.Y = (bf16_t*)take((size_t)NTOK * D * 2);
  p.SC = (bf16_t*)take((size_t)NTOK * 1024 * 2);
  p.Z = (bf16_t*)take((size_t)NTOK * INW * 2);
  p.UTl = (bf16_t*)take((size_t)256 * 16 * T * 2);
  p.UTc = (bf16_t*)take((size_t)256 * 16 * LC * 2);
  p.YTl = (bf16_t*)take((size_t)256 * 16 * T * 2);
  p.YTc = (bf16_t*)take((size_t)256 * 16 * LC * 2);
  p.FL = (float*)take((size_t)256 * 2 * T * 4);
  p.FC = (float*)take((size_t)256 * 2 * LC * 4);
  p.W1t = (bf16_t*)take((size_t)INW * D * 2);
  p.W2t = (bf16_t*)take((size_t)D * D * 2);
  p.Wft = (bf16_t*)take((size_t)2048 * D * 2);
  p.Wlt = (bf16_t*)take((size_t)1024 * 256 * 2);
  p.Wgt = (bf16_t*)take((size_t)256 * 128 * 2);
  p.TK = (float*)p.Z;
  p.PU = (unsigned char*)p.Z + al256((size_t)NTOK * 256 * 4);
  p.PV = p.PU + (size_t)16384 * 1024;
  p.PSU = (float*)(p.PV + (size_t)16384 * 1024);
  p.PSV = p.PSU + 16384;
  p.GT = p.PSV + 16384;
  p.EL = (unsigned short*)(p.GT + (size_t)NTOK * 128);
  p.H8 = (unsigned char*)p.EL + al256((size_t)NTOK * 128 * 2);
  p.HINV = (float*)(p.H8 + (size_t)NTOK * 1024);
  p.GW = (bf16_t*)((char*)p.HINV + al256((size_t)NTOK * 4));
  p.PD = p.Y;

  (void)hipMemsetAsync(d_ws, 0, zero_bytes, stream);
  constexpr size_t kDynLds = SMEM_BYTES + 32;
  static int grid = 0;
  if (!grid) {
    int dev = 0, cus = 0, per_cu = 0;
    (void)hipGetDevice(&dev);
    (void)hipDeviceGetAttribute(&cus, hipDeviceAttributeMultiprocessorCount, dev);
    (void)hipFuncSetAttribute((const void*)k_mega, hipFuncAttributeMaxDynamicSharedMemorySize, (int)kDynLds);
    (void)hipOccupancyMaxActiveBlocksPerMultiprocessor(&per_cu, k_mega, 256, kDynLds);
    if (cus <= 0) cus = 256;
    if (per_cu > 2) per_cu = 2;
    if (per_cu < 1) per_cu = 1;
    grid = cus * per_cu;
  }
  k_mega<<<grid, 256, kDynLds, stream>>>(p);
}
```

```cpp
#include <hip/hip_runtime.h>
#include <stdint.h>
#include <type_traits>

#define DEV __device__ __forceinline__
typedef unsigned short bf16_t;
typedef short bf16x8 __attribute__((ext_vector_type(8)));
typedef float f32x2 __attribute__((ext_vector_type(2)));
constexpr size_t PSLICE = (size_t)16384 * 128;
typedef float f32x4 __attribute__((ext_vector_type(4)));
typedef float f32x16 __attribute__((ext_vector_type(16)));


constexpr int NB = 16, T = 4096, LC = 256, LT = 4352, D = 1024, NTOK = NB * LT, INW = 2688, DEPTH = 4;
constexpr int SMEM_BYTES = 65536;

struct P {
  const float *x, *c, *ctx, *c_ctx, *mod_w, *mod_b, *norm1_g, *norm2_g, *w_in, *conv_w, *conv_b;
  const float *hy_w1, *hy_b1, *hy_w2, *hy_b2, *hy_w3, *hy_b3, *hy_freq, *hy_bias;
  const float *rw_w0, *rw_w_up, *rw_a0, *rw_a_up, *rw_g_up, *rw_k_k, *rw_k_a, *rw_r_k, *rw_ln_w, *rw_ln_b;
  const float *attn_sink, *hy_out_g, *at_out_g, *w_out, *peer_wq, *peer_k1, *peer_k2, *peer_u, *peer_v, *final_g;
  float* out;
  unsigned* bar;
  float *modv, *SSQ, *rope, *FL, *FC, *TK;
  unsigned *wq, *cuclaim;
  bf16_t *X, *H, *Y, *SC, *Z, *UTl, *UTc, *YTl, *YTc;
  bf16_t *W1t, *W2t, *Wft, *Wlt, *Wgt;
  unsigned char *PU, *PV;
  float *PSU, *PSV, *GT, *HINV;
  bf16_t *PD, *GW;
  unsigned short* EL;
  unsigned char* H8;
};

typedef __bf16 hwbf2 __attribute__((ext_vector_type(2)));
DEV unsigned pack2(float a, float b) { f32x2 f = {a, b}; hwbf2 r = __builtin_convertvector(f, hwbf2); return __builtin_bit_cast(unsigned, r); }
DEV bf16_t f2bf(float f) { return (bf16_t)(pack2(f, 0.f) & 0xFFFFu); }
DEV float bf2f(bf16_t h) { return __uint_as_float(((unsigned)h) << 16); }
DEV float bflo(unsigned u) { return __uint_as_float(u << 16); }
DEV float bfhi(unsigned u) { return __uint_as_float(u & 0xFFFF0000u); }
DEV void unpack8(const uint4& u, float* v) {
  v[0] = bflo(u.x); v[1] = bfhi(u.x); v[2] = bflo(u.y); v[3] = bfhi(u.y);
  v[4] = bflo(u.z); v[5] = bfhi(u.z); v[6] = bflo(u.w); v[7] = bfhi(u.w);
}
DEV uint4 pack8(const float* v) { return make_uint4(pack2(v[0], v[1]), pack2(v[2], v[3]), pack2(v[4], v[5]), pack2(v[6], v[7])); }
DEV int pack_i8(float a, float b, float c, float d) {
  const int ia = __float2int_rn(a), ib = __float2int_rn(b), ic = __float2int_rn(c), id = __float2int_rn(d);
  return (ia & 0xFF) | ((ib & 0xFF) << 8) | ((ic & 0xFF) << 16) | ((id & 0xFF) << 24);
}
DEV float sigmoidf_(float x) { return __builtin_amdgcn_rcpf(1.f + __expf(-x)); }

template <int CTRL, int ROWMASK>
DEV float dpp0(float x) {
  return __builtin_bit_cast(float, __builtin_amdgcn_update_dpp(0, __builtin_bit_cast(int, x), CTRL, ROWMASK, 0xF, false));
}
template <int CTRL, int ROWMASK>
DEV float dppself(float x) {
  int xi = __builtin_bit_cast(int, x);
  return __builtin_bit_cast(float, __builtin_amdgcn_update_dpp(xi, xi, CTRL, ROWMASK, 0xF, false));
}
DEV float readlane_f(float x, int l) { return __builtin_bit_cast(float, __builtin_amdgcn_readlane(__builtin_bit_cast(int, x), l)); }
DEV int lane_id() { return (int)__builtin_amdgcn_mbcnt_hi(~0u, __builtin_amdgcn_mbcnt_lo(~0u, 0u)); }
DEV float writelane_f(float val, int l, float old) { return lane_id() == l ? val : old; }
DEV int writelane_i(int val, int l, int old) { return lane_id() == l ? val : old; }
DEV float wave_sum(float x) {
  x += dpp0<0x111, 0xF>(x); x += dpp0<0x112, 0xF>(x); x += dpp0<0x114, 0xF>(x); x += dpp0<0x118, 0xF>(x);
  x += dpp0<0x142, 0xA>(x); x += dpp0<0x143, 0xC>(x);
  return readlane_f(x, 63);
}
DEV float wave_max(float x) {
  x = fmaxf(x, dppself<0x111, 0xF>(x)); x = fmaxf(x, dppself<0x112, 0xF>(x)); x = fmaxf(x, dppself<0x114, 0xF>(x));
  x = fmaxf(x, dppself<0x118, 0xF>(x)); x = fmaxf(x, dppself<0x142, 0xA>(x)); x = fmaxf(x, dppself<0x143, 0xC>(x));
  return readlane_f(x, 63);
}
DEV float row16_sum(float x) {
  x += dpp0<0xB1, 0xF>(x); x += dpp0<0x4E, 0xF>(x); x += dpp0<0x141, 0xF>(x); x += dpp0<0x140, 0xF>(x);
  return x;
}
DEV float row16_max(float x) {
  x = fmaxf(x, dppself<0xB1, 0xF>(x)); x = fmaxf(x, dppself<0x4E, 0xF>(x)); x = fmaxf(x, dppself<0x141, 0xF>(x));
  x = fmaxf(x, dppself<0x140, 0xF>(x));
  return x;
}
DEV float quad_sum(float x) { x += dpp0<0xB1, 0xF>(x); x += dpp0<0x4E, 0xF>(x); return x; }

DEV f32x4 mfma16(bf16x8 a, bf16x8 b, f32x4 c) { return __builtin_amdgcn_mfma_f32_16x16x32_bf16(a, b, c, 0, 0, 0); }
DEV f32x16 mfma32(bf16x8 a, bf16x8 b, f32x16 c) { return __builtin_amdgcn_mfma_f32_32x32x16_bf16(a, b, c, 0, 0, 0); }


#define XB_TMO      128
#define XB_XCNT(j)  (256  + 64 * (j))
#define XB_XSUB(j)  (1280 + 64 * (j))
#define XB_XGEN(j)  (2304 + 64 * (j))
#define XB_TOP      3328
#define XB_TOPGEN   3392
#define XCD_BAR_WORDS 3456
#define XB_SPIN_CAP (1u << 23)
#define LAS __attribute__((address_space(3)))

__device__ __forceinline__ unsigned xb_ld(unsigned* p)              { return __hip_atomic_load(p, __ATOMIC_RELAXED, __HIP_MEMORY_SCOPE_AGENT); }
__device__ __forceinline__ unsigned xb_add(unsigned* p, unsigned v) { return __hip_atomic_fetch_add(p, v, __ATOMIC_RELAXED, __HIP_MEMORY_SCOPE_AGENT); }
__device__ __forceinline__ unsigned xb_xcc_id() { return (unsigned)__builtin_amdgcn_s_getreg((3 << 11) | 20) & 0xFu; }
#define XB_SPIN(cond, bar) do { unsigned _sp = 0; while (cond) { __builtin_amdgcn_s_sleep(1); \
    if ((++_sp & 255u) == 0u) { if (xb_ld(&(bar)[XB_TMO])) break; if (_sp > XB_SPIN_CAP) { atomicAdd(&(bar)[XB_TMO], 1u); break; } } } } while (0)

struct XcdBarrier {
    unsigned* bar; unsigned x;
    volatile LAS unsigned* st;
};
__device__ __forceinline__ XcdBarrier xcd_barrier_post(unsigned* bar, volatile LAS unsigned* st) {
    XcdBarrier b; b.bar = bar; b.x = xb_xcc_id(); b.st = st;
    if (threadIdx.x == 0) (void)xb_add(&bar[XB_XCNT(b.x)], 1u);
    return b;
}
__device__ __forceinline__ void xcd_barrier_complete(unsigned* bar, unsigned x, unsigned& nloc, unsigned& nx) {
    const unsigned G = gridDim.x * gridDim.y * gridDim.z;
    unsigned sum, cnt, mine, sp = 0u;
    for (;;) {
        sum = 0u; cnt = 0u; mine = 0u;
#pragma unroll
        for (unsigned j = 0; j < 16; ++j) { const unsigned c = xb_ld(&bar[XB_XCNT(j)]); sum += c; cnt += (c > 0u) ? 1u : 0u; mine = (j == x) ? c : mine; }
        if (sum == G) break;
        __builtin_amdgcn_s_sleep(1);
        if ((++sp & 255u) == 0u) { if (xb_ld(&bar[XB_TMO])) break; if (sp > XB_SPIN_CAP) { atomicAdd(&bar[XB_TMO], 1u); break; } }
    }
    nloc = mine > 0u ? mine : 1u; nx = cnt > 0u ? cnt : 1u;
}
__device__ __forceinline__ void xcd_barrier(const XcdBarrier& b) {
    asm volatile("s_waitcnt vmcnt(0)" ::: "memory");
    __syncthreads();
    if (threadIdx.x == 0) {
        unsigned* bar = b.bar;
        __builtin_amdgcn_s_waitcnt(0);
        unsigned nloc = b.st[0], nx = b.st[1];
        if (nloc == 0u) { xcd_barrier_complete(bar, b.x, nloc, nx); b.st[0] = nloc; b.st[1] = nx; }
        const unsigned old = xb_add(&bar[XB_XSUB(b.x)], 1u);
        const unsigned gen = old / nloc;
        if (old + 1u == (gen + 1u) * nloc) {
            __builtin_amdgcn_fence(__ATOMIC_RELEASE, "agent");
            asm volatile("s_waitcnt vmcnt(0)" ::: "memory");
            const unsigned og = xb_add(&bar[XB_TOP], 1u);
            const unsigned tg = og / nx;
            if (og + 1u == (tg + 1u) * nx) xb_add(&bar[XB_TOPGEN], 1u);
            else XB_SPIN(xb_ld(&bar[XB_TOPGEN]) == tg, bar);
            __builtin_amdgcn_fence(__ATOMIC_ACQUIRE, "agent");
            xb_add(&bar[XB_XGEN(b.x)], 1u);
            asm volatile("s_waitcnt vmcnt(0)" ::: "memory");
        } else {
            XB_SPIN(xb_ld(&bar[XB_XGEN(b.x)]) == gen, bar);
            __builtin_amdgcn_fence(__ATOMIC_ACQUIRE, "agent");
            asm volatile("s_waitcnt vmcnt(0)" ::: "memory");
        }
    }
    __syncthreads();
}

template <class Tp> DEV Tp* opq(Tp* q) { asm volatile("" : "+s"(q)); return q; }
DEV int tid_() { int t = threadIdx.x; asm volatile("" : "+v"(t)); return t; }
DEV int bid_() { int b = blockIdx.x; asm volatile("" : "+s"(b)); return b; }

DEV void glds16(const void* gsrc, char* lds_lane_ptr) {
  __builtin_amdgcn_global_load_lds((const unsigned*)gsrc, (__attribute__((address_space(3))) unsigned*)lds_lane_ptr, 16, 0, 0);
}
template <class Epi>
DEV void gemm_tile(const bf16_t* __restrict__ A, int lda, const bf16_t* __restrict__ Bt, int ldb, int K, char* smem, Epi& epi) {
  const int tid = tid_(), lane = tid & 63, wid = tid >> 6, wr = wid >> 1, wc = wid & 1, fr = lane & 15, fq = lane >> 4;
  f32x4 acc[4][4];
#pragma unroll
  for (int m = 0; m < 4; ++m)
#pragma unroll
    for (int n = 0; n < 4; ++n) acc[m][n] = (f32x4){0.f, 0.f, 0.f, 0.f};
  const int drow0 = 8 * wid + (lane >> 3), dpc = lane & 7;
  auto issue = [&](int kt, int buf) {
    char* sa = smem + buf * 32768;
    char* sb = sa + 16384;
#pragma unroll
    for (int i = 0; i < 4; ++i) {
      const int row = drow0 + 32 * i;
      const int kc = dpc ^ ((row >> 1) & 7);
      glds16(A + (size_t)row * lda + kt * 64 + kc * 8, sa + (i * 4 + wid) * 1024 + lane * 16);
      glds16(Bt + (size_t)row * ldb + kt * 64 + kc * 8, sb + (i * 4 + wid) * 1024 + lane * 16);
    }
  };
  __syncthreads();
  issue(0, 0);
  const int nk = K >> 6;
  const int sw = (fr >> 1) & 7;
  const int aoff = (wr * 64 + fr) * 128, boff = (wc * 64 + fr) * 128;
  for (int kt = 0; kt < nk; ++kt) {
    asm volatile("s_waitcnt vmcnt(0)" ::: "memory");
    __syncthreads();
    if (kt + 1 < nk) issue(kt + 1, (kt + 1) & 1);
    const char* sa = smem + (kt & 1) * 32768;
    const char* sb = sa + 16384;
#pragma unroll
    for (int kh = 0; kh < 2; ++kh) {
      const int pc = ((kh * 4 + fq) ^ sw) * 16;
      bf16x8 af[4], bfr[4];
#pragma unroll
      for (int m = 0; m < 4; ++m) af[m] = *(const bf16x8*)(sa + aoff + m * 2048 + pc);
#pragma unroll
      for (int n = 0; n < 4; ++n) bfr[n] = *(const bf16x8*)(sb + boff + n * 2048 + pc);
#pragma unroll
      for (int m = 0; m < 4; ++m)
#pragma unroll
        for (int n = 0; n < 4; ++n) acc[m][n] = mfma16(bfr[n], af[m], acc[m][n]);
    }
  }
  __syncthreads();
  epi(acc, wr, wc, fr, fq, smem);
}
DEV void stage_tile_bf16(const f32x4 (&acc)[4][4], char* smem, int wid, int fr, int fq) {
  bf16_t (*t)[72] = (bf16_t (*)[72])(smem + wid * 9216);
#pragma unroll
  for (int m = 0; m < 4; ++m)
#pragma unroll
    for (int n = 0; n < 4; ++n)
      *(uint2*)&t[m * 16 + fr][n * 16 + 4 * fq] = make_uint2(pack2(acc[m][n][0], acc[m][n][1]), pack2(acc[m][n][2], acc[m][n][3]));
  asm volatile("s_waitcnt lgkmcnt(0)" ::: "memory");
}

DEV void ph_copy(const P& p) {
  const size_t n8 = (size_t)NTOK * D / 8;
  const float* pctx = opq(p.ctx); const float* px = opq(p.x);
  for (size_t i = (size_t)bid_() * 256 + tid_(); i < n8; i += (size_t)gridDim.x * 256) {
    size_t e = i * 8;
    int row = (int)(e / D), col = (int)(e % D);
    int b = row / LT, pp = row % LT;
    const float* src = pp < LC ? pctx + ((size_t)(b * LC + pp)) * D + col : px + ((size_t)(b * T + pp - LC)) * D + col;
    float4 v0 = *(const float4*)src, v1 = *(const float4*)(src + 4);
    uint4 o = make_uint4(pack2(v0.x, v0.y), pack2(v0.z, v0.w), pack2(v1.x, v1.y), pack2(v1.z, v1.w));
    *(uint4*)(p.X + e) = o;
  }
}

DEV void ph_rope(const P& p) {
  for (int i = bid_() * 256 + tid_(); i < 64 * 16; i += gridDim.x * 256) {
    int pos = i >> 4, k = i & 15;
    float inv = powf(10000.f, -(float)k / 16.f);
    float ang = (float)pos * inv;
    p.rope[2 * i] = cosf(ang); p.rope[2 * i + 1] = sinf(ang);
  }
}

DEV void modv_unit(const P& p, int unit, char* smem) {
  const int cc = unit % 24, layer = unit / 24;
  float (*cs)[128] = (float (*)[128])smem;
  const int col = cc * 256 + tid_();
  const float* pc = opq(p.c); const float* pcc = opq(p.c_ctx);
  float acc[17];
#pragma unroll
  for (int r = 0; r < 17; ++r) acc[r] = 0.f;
  for (int ks = 0; ks < 8; ++ks) {
    __syncthreads();
    for (int i = tid_(); i < 17 * 128; i += 256) {
      int r = i >> 7, e = i & 127;
      float v = r < 16 ? pc[r * D + ks * 128 + e] : pcc[ks * 128 + e];
      cs[r][e] = v / (1.f + expf(-v));
    }
    __syncthreads();
    const float* w = p.mod_w + ((size_t)layer * D + ks * 128) * 6144 + col;
#pragma unroll 1
    for (int e0 = 0; e0 < 128; e0 += 32) {
      float wv[32];
#pragma unroll
      for (int q = 0; q < 32; ++q) wv[q] = w[(size_t)(e0 + q) * 6144];
#pragma unroll
      for (int q4 = 0; q4 < 8; ++q4) {
      const int e = e0 + 4 * q4;
      const float w0 = wv[4 * q4], w1 = wv[4 * q4 + 1], w2 = wv[4 * q4 + 2], w3 = wv[4 * q4 + 3];
#pragma unroll
      for (int r = 0; r < 17; ++r) {
        const float4 cv = *(const float4*)&cs[r][e];
        acc[r] += cv.x * w0 + cv.y * w1 + cv.z * w2 + cv.w * w3;
      }
      }
    }
  }
  const float bias = p.mod_b[layer * 6144 + col];
#pragma unroll
  for (int r = 0; r < 17; ++r) p.modv[((size_t)layer * 17 + r) * 6144 + col] = acc[r] + bias;
}

DEV void transpose_unit(const float* __restrict__ src, bf16_t* __restrict__ dst, int R, int C, int tile, char* smem) {
  float (*t)[65] = (float (*)[65])smem;
  const int nct = C / 64;
  const int tr = tile / nct, tc = tile % nct;
  __syncthreads();
  for (int i = tid_(); i < 4096; i += 256) { int r = i >> 6, c = i & 63; t[r][c] = src[(size_t)(tr * 64 + r) * C + tc * 64 + c]; }
  __syncthreads();
  for (int i = tid_(); i < 4096; i += 256) { int c = i >> 6, r = i & 63; dst[(size_t)(tc * 64 + c) * R + tr * 64 + r] = f2bf(t[r][c]); }
}

DEV void wfold_unit(const P& p, int layer, int unit, char* smem) {
  const int hs = unit >> 5, ec = unit & 31, h = hs >> 1, s = hs & 1;
  const float* wq = p.peer_wq + (size_t)layer * D * 2048;
  const float* kk = (s ? opq(p.peer_k2) : opq(p.peer_k1)) + ((size_t)layer * 8 + h) * 128 * 128;
  float (*kS)[65] = (float (*)[65])smem;
  float (*wS)[64] = (float (*)[64])(smem + 33280);
  const int key = tid_() & 127, eh = tid_() >> 7;
  float acc[16];
#pragma unroll
  for (int i = 0; i < 16; ++i) acc[i] = 0.f;
  for (int dh = 0; dh < 2; ++dh) {
    __syncthreads();
    for (int i = tid_(); i < 128 * 64; i += 256) { int k2 = i >> 6, d = i & 63; kS[k2][d] = kk[k2 * 128 + dh * 64 + d]; }
    for (int i = tid_(); i < 32 * 64; i += 256) {
      int e = i >> 6, d = i & 63;
      wS[e][d] = wq[(size_t)(ec * 32 + e) * 2048 + h * 256 + s * 128 + dh * 64 + d];
    }
    __syncthreads();
#pragma unroll 2
    for (int d = 0; d < 64; d += 4) {
      const float k0 = kS[key][d], k1 = kS[key][d + 1], k2 = kS[key][d + 2], k3 = kS[key][d + 3];
#pragma unroll
      for (int i = 0; i < 16; ++i) {
        const float4 wv = *(const float4*)&wS[eh * 16 + i][d];
        acc[i] += k0 * wv.x + k1 * wv.y + k2 * wv.z + k3 * wv.w;
      }
    }
  }
  bf16_t* dst = p.Wft + ((size_t)(hs * 128 + key)) * D + ec * 32 + eh * 16;
#pragma unroll
  for (int i = 0; i < 16; i += 2) *(unsigned*)(dst + i) = pack2(acc[i], acc[i + 1]);
}

DEV void filt_unit(const P& p, int layer, int unit, char* smem) {
  int kind, j0, L;
  if (unit < 1024) { kind = 0; j0 = unit * 4; L = T; } else { kind = 1; j0 = (unit - 1024) * 4; L = LC; }
  float* zs = (float*)smem;
  float* h1 = zs + 4 * 36;
  float* h2 = h1 + 256;
  const int jj = tid_() >> 6, o = tid_() & 63;
  const int j = j0 + jj;
  const float fj = (float)j;
  const float t = fj / (float)(L - 1);
  __syncthreads();
  if (o < 33) {
    float z;
    if (o == 0) z = t;
    else {
      int i = (o - 1) & 15;
      float band = 1e-4f + (float)i * ((15.0f - 1e-4f) / 15.0f);
      float ang = 6.283185307179586f * fj * band / (float)L;
      z = (o <= 16) ? cosf(ang) : -sinf(ang);
    }
    zs[jj * 36 + o] = z;
  }
  __syncthreads();
  {
    const float* w1 = p.hy_w1 + layer * 33 * 64;
    float a = p.hy_b1[layer * 64 + o];
#pragma unroll 3
    for (int i = 0; i < 33; ++i) a += zs[jj * 36 + i] * w1[i * 64 + o];
    h1[jj * 64 + o] = sinf(p.hy_freq[layer * 128 + o] * a);
  }
  __syncthreads();
  {
    const float* w2 = p.hy_w2 + layer * 64 * 64;
    float a = p.hy_b2[layer * 64 + o];
#pragma unroll 4
    for (int i = 0; i < 64; ++i) a += h1[jj * 64 + i] * w2[i * 64 + o];
    h2[jj * 64 + o] = sinf(p.hy_freq[layer * 128 + 64 + o] * a);
  }
  __syncthreads();
  const float* w3 = p.hy_w3 + layer * 64 * 512;
  float* F = kind ? opq(p.FC) : opq(p.FL);
  const float DMIN = -3.0701134573253945f, DMAX = -15.350567286626973f;
#pragma unroll 1
  for (int m = 0; m < 4; ++m) {
    int c = o + 64 * m;
    float af = p.hy_b3[layer * 512 + c], ab = p.hy_b3[layer * 512 + 256 + c];
#pragma unroll 4
    for (int i = 0; i < 64; ++i) { float hv = h2[jj * 64 + i]; af += hv * w3[i * 512 + c]; ab += hv * w3[i * 512 + 256 + c]; }
    float delta = fabsf(DMIN + (float)c * ((DMAX - DMIN) / 255.f));
    float win = expf(-t * delta) + 0.05f;
    af *= win; ab *= win;
    F[((size_t)c * 2 + 0) * L + j] = af;
    F[((size_t)c * 2 + 1) * L + j] = ab;
  }
}

constexpr int PREP_T0 = 672, PREP_T1 = PREP_T0 + 256, PREP_T2 = PREP_T1 + 8, PREP_T3 = PREP_T2 + 8, PREP_T4 = PREP_T3 + 8;
constexpr int PREP_WF = PREP_T4 + 512, PREP_N = PREP_WF + 1088;
DEV void prep_unit(const P& p, int layer, int u, char* smem) {
  if (u < PREP_T0) transpose_unit(p.w_in + (size_t)layer * D * INW, p.W1t, D, INW, u, smem);
  else if (u < PREP_T1) transpose_unit(p.w_out + (size_t)layer * D * D, p.W2t, D, D, u - PREP_T0, smem);
  else if (u < PREP_T3) {
    const int u0 = u - PREP_T1;
    for (int i = tid_(); i < 64 * 256; i += 256) {
      const int np = u0 * 64 + (i >> 8), kp = i & 255;
      const int ps = np & 3, chan = np >> 2, qp = kp >> 6, kk = kp & 63;
      const int is_a = ps & 1, d = ps >> 1;
      float v = 0.f;
      if (qp == (is_a ? 2 + d : d)) v = (is_a ? opq(p.rw_a_up) : opq(p.rw_w_up))[(((size_t)layer * 2 + d) * 64 + kk) * 256 + chan];
      p.Wlt[(size_t)np * 256 + kp] = f2bf(v);
    }
  }
  else if (u < PREP_T4) transpose_unit(p.rw_g_up + (size_t)layer * 128 * 256, p.Wgt, 128, 256, u - PREP_T3, smem);
  else if (u < PREP_WF) wfold_unit(p, layer, u - PREP_T4, smem);
  else filt_unit(p, layer, u - PREP_WF, smem);
}
constexpr int PREPA_N = PREP_T0 + (PREP_T4 - PREP_T1);
DEV int prepA_unit_index(int i) { return i < PREP_T0 ? i : PREP_T1 + (i - PREP_T0); }
DEV void ph_prep(const P& p, int layer, char* smem, bool onlyB) {
  for (int u = bid_(); u < PREP_N; u += gridDim.x) {
    const bool isA = (u < PREP_T0) || (u >= PREP_T1 && u < PREP_T4);
    if (onlyB && isA) continue;
    prep_unit(p, layer, u, smem);
  }
}

DEV void wave_range(int& r0, int& r1, int ntok) {
  const int gw = (bid_() * 256 + tid_()) >> 6, nw = gridDim.x * 4;
  const int per = (ntok + nw - 1) / nw;
  r0 = gw * per; r1 = r0 + per; if (r1 > ntok) r1 = ntok;
}
DEV void ph_norm(const P& p, int layer, int which) {
  const int lane = tid_() & 63;
  int r0, r1;
  wave_range(r0, r1, NTOK);
  const float* g = (which ? p.norm2_g : p.norm1_g) + layer * D;
  float gv[16], scv[16], shv[16];
#pragma unroll
  for (int hh = 0; hh < 2; ++hh)
#pragma unroll
    for (int i = 0; i < 8; ++i) gv[hh * 8 + i] = g[hh * 512 + 8 * lane + i];
  int mr_cur = -1;
  uint4 n0 = make_uint4(0, 0, 0, 0), n1 = n0;
  if (r0 < r1) { const bf16_t* xr = p.X + (size_t)r0 * D; n0 = *(const uint4*)(xr + 8 * lane); n1 = *(const uint4*)(xr + 512 + 8 * lane); }
#pragma unroll 1
  for (int row = r0; row < r1; ++row) {
    const uint4 u0 = n0, u1 = n1;
    if (row + 1 < r1) { const bf16_t* xr = p.X + (size_t)(row + 1) * D; n0 = *(const uint4*)(xr + 8 * lane); n1 = *(const uint4*)(xr + 512 + 8 * lane); }
    const int b = row / LT, pp = row % LT;
    const int mr = pp < LC ? 16 : b;
    if (mr != mr_cur) {
      mr_cur = mr;
      const float* mv = p.modv + ((size_t)layer * 17 + mr) * 6144 + (which ? 3072 : 0);
#pragma unroll
      for (int hh = 0; hh < 2; ++hh)
#pragma unroll
        for (int i = 0; i < 8; ++i) { shv[hh * 8 + i] = mv[hh * 512 + 8 * lane + i]; scv[hh * 8 + i] = 1.f + mv[1024 + hh * 512 + 8 * lane + i]; }
    }
    float v[16];
    unpack8(u0, v); unpack8(u1, v + 8);
    float ss = 0.f;
#pragma unroll
    for (int i = 0; i < 16; ++i) ss += v[i] * v[i];
    ss = wave_sum(ss);
    const float rstd = rsqrtf(ss * (1.f / 1024.f) + 1e-6f);
    float o[16];
#pragma unroll
    for (int i = 0; i < 16; ++i) o[i] = (v[i] * rstd * gv[i]) * scv[i] + shv[i];
    bf16_t* hr = p.H + (size_t)row * D;
    *(uint4*)(hr + 8 * lane) = pack8(o);
    *(uint4*)(hr + 512 + 8 * lane) = pack8(o + 8);
    if (which) {
      float am = 0.f;
#pragma unroll
      for (int i = 0; i < 16; ++i) am = fmaxf(am, fabsf(o[i]));
      am = wave_max(am);
      const float sc = am > 0.f ? 127.f / am : 1.f;
      unsigned char* h8 = p.H8 + (size_t)row * 1024;
      *(uint2*)(h8 + 8 * lane) = make_uint2((unsigned)pack_i8(o[0] * sc, o[1] * sc, o[2] * sc, o[3] * sc), (unsigned)pack_i8(o[4] * sc, o[5] * sc, o[6] * sc, o[7] * sc));
      *(uint2*)(h8 + 512 + 8 * lane) = make_uint2((unsigned)pack_i8(o[8] * sc, o[9] * sc, o[10] * sc, o[11] * sc), (unsigned)pack_i8(o[12] * sc, o[13] * sc, o[14] * sc, o[15] * sc));
      if (lane == 0) p.HINV[row] = am > 0.f ? am * (1.f / 127.f) : 1.f;
    }
  }
}

DEV bool gemm_unit(int it, int nct, int& rt, int& ct) {
  const int nslot = gridDim.x >> 3;
  const int x = bid_() & 7, sl = bid_() >> 3;
  if (sl >= nslot) return false;
  const int v = it * nslot + sl;
  if (v >= 68 * nct) return false;
  const int rg = v / (8 * nct), rem = v - rg * 8 * nct;
  const int rows = (rg == 8) ? 4 : 8;
  ct = rem / rows;
  rt = x * 68 + rg * 8 + (rem - ct * rows);
  return true;
}
struct Epi1 {
  const P& p; int row0, col0;
  DEV void operator()(f32x4 (&acc)[4][4], int wr, int wc, int fr, int fq, char* smem) const {
    const int cw = col0 + wc * 64;
    const int rbase = row0 + wr * 64;
    const bool lat = (row0 % LT) >= LC;
    if (cw >= 1536 && cw < 1664) {
#pragma unroll
      for (int m = 0; m < 4; ++m)
#pragma unroll
        for (int n = 0; n < 4; ++n)
#pragma unroll
          for (int j = 0; j < 4; ++j) acc[m][n][j] = 2.f * sigmoidf_(2.f * acc[m][n][j]) - 1.f;
    } else if (cw >= 1792 && cw < 1920) {
#pragma unroll
      for (int m = 0; m < 4; ++m)
#pragma unroll
        for (int n = 0; n < 4; ++n)
#pragma unroll
          for (int j = 0; j < 4; ++j) acc[m][n][j] = sigmoidf_(acc[m][n][j]);
    } else if (cw >= 1920 && cw < 2560 && lat) {
#pragma unroll
      for (int m = 0; m < 4; ++m) {
        const int row = rbase + m * 16 + fr;
        const int pl = (row % LT) - LC;
        const int ri = pl >> 6, ci = pl & 63;
        const float4* crp = (const float4*)(p.rope + 2 * (ri * 16 + 4 * fq));
        const float4* ccp = (const float4*)(p.rope + 2 * (ci * 16 + 4 * fq));
        const float4 cr0 = crp[0], cr1 = crp[1], cc0 = ccp[0], cc1 = ccp[1];
        const float crc[4] = {cr0.x, cr0.z, cr1.x, cr1.z}, crs[4] = {cr0.y, cr0.w, cr1.y, cr1.w};
        const float ccc[4] = {cc0.x, cc0.z, cc1.x, cc1.z}, ccs[4] = {cc0.y, cc0.w, cc1.y, cc1.w};
#pragma unroll
        for (int j = 0; j < 4; ++j) {
          float x1 = acc[m][0][j], x2 = acc[m][1][j];
          acc[m][0][j] = x1 * crc[j] - x2 * crs[j]; acc[m][1][j] = x2 * crc[j] + x1 * crs[j];
          x1 = acc[m][2][j]; x2 = acc[m][3][j];
          acc[m][2][j] = x1 * ccc[j] - x2 * ccs[j]; acc[m][3][j] = x2 * ccc[j] + x1 * ccs[j];
        }
      }
    }
    const int wid = wr * 2 + wc, lane = fq * 16 + fr;
    stage_tile_bf16(acc, smem, wid, fr, fq);
    const bf16_t (*t)[72] = (const bf16_t (*)[72])(smem + wid * 9216);
#pragma unroll
    for (int i = 0; i < 8; ++i) {
      const int rl = i * 8 + (lane >> 3), ch = lane & 7;
      *(uint4*)(p.Z + (size_t)(rbase + rl) * INW + cw + ch * 8) = *(const uint4*)&t[rl][ch * 8];
    }
  }
};
DEV void ph_gemm1(const P& p, char* smem) {
  const int nct = INW / 128;
  int rt, ct;
  for (int it = 0; gemm_unit(it, nct, rt, ct); ++it) {
    Epi1 epi{p, rt * 128, ct * 128};
    gemm_tile(p.H + (size_t)rt * 128 * D, D, p.W1t + (size_t)ct * 128 * D, D, D, smem, epi);
  }
}

struct EpiLoraA {
  const P& p; int layer, row0, col0;
  DEV void operator()(f32x4 (&acc)[4][4], int wr, int wc, int fr, int fq, char* smem) const {
    const float* w0b = p.rw_w0 + layer * 512;
    const float* a0b = p.rw_a0 + layer * 512;
#pragma unroll
    for (int n = 0; n < 4; ++n) {
      const int chan = ((col0 + wc * 64 + n * 16) >> 2) + fq;
      const float be0 = w0b[chan], ba0 = a0b[chan], be1 = w0b[256 + chan], ba1 = a0b[256 + chan];
#pragma unroll
      for (int m = 0; m < 4; ++m) {
        acc[m][n][0] = 0.6065306597126334f * sigmoidf_(acc[m][n][0] + be0);
        acc[m][n][1] = sigmoidf_(acc[m][n][1] + ba0);
        acc[m][n][2] = 0.6065306597126334f * sigmoidf_(acc[m][n][2] + be1);
        acc[m][n][3] = sigmoidf_(acc[m][n][3] + ba1);
      }
    }
    const int wid = wr * 2 + wc, lane = fq * 16 + fr;
    stage_tile_bf16(acc, smem, wid, fr, fq);
    const bf16_t (*t)[72] = (const bf16_t (*)[72])(smem + wid * 9216);
#pragma unroll
    for (int i = 0; i < 8; ++i) {
      const int rl = i * 8 + (lane >> 3), ch = lane & 7;
      *(uint4*)(p.SC + (size_t)(row0 + wr * 64 + rl) * 1024 + col0 + wc * 64 + ch * 8) = *(const uint4*)&t[rl][ch * 8];
    }
  }
};
struct EpiLoraG {
  const P& p; int row0, col0;
  DEV void operator()(f32x4 (&acc)[4][4], int wr, int wc, int fr, int fq, char* smem) const {
    const int wid = wr * 2 + wc, lane = fq * 16 + fr;
    stage_tile_bf16(acc, smem, wid, fr, fq);
    const bf16_t (*t)[72] = (const bf16_t (*)[72])(smem + wid * 9216);
#pragma unroll
    for (int i = 0; i < 8; ++i) {
      const int rl = i * 8 + (lane >> 3), ch = lane & 7;
      *(uint4*)(p.Y + (size_t)(row0 + wr * 64 + rl) * D + 256 + col0 + wc * 64 + ch * 8) = *(const uint4*)&t[rl][ch * 8];
    }
  }
};
DEV void ph_lora(const P& p, int layer, char* smem) {
  int rt, ct;
  for (int it = 0; gemm_unit(it, 10, rt, ct); ++it) {
    if (ct < 8) {
      EpiLoraA epi{p, layer, rt * 128, ct * 128};
      gemm_tile(p.Z + (size_t)rt * 128 * INW + 1536, INW, p.Wlt + (size_t)ct * 128 * 256, 256, 256, smem, epi);
    } else {
      EpiLoraG epi{p, rt * 128, (ct - 8) * 128};
      gemm_tile(p.Z + (size_t)rt * 128 * INW + 1792, INW, p.Wgt + (size_t)(ct - 8) * 128 * 128, 128, 128, smem, epi);
    }
  }
}

DEV void ph_rwkv_prep(const P& p, int layer) {
  const int lane = tid_() & 63;
  int r0, r1;
  wave_range(r0, r1, NTOK);
  const float* cw = p.conv_w + (size_t)layer * 3 * 1536;
  const float* cb = p.conv_b + (size_t)layer * 1536;
  float w0[3][4], w1[3][4], w2[3][4], bb[3][4], kkw[4];
#pragma unroll
  for (int a = 0; a < 3; ++a)
#pragma unroll
    for (int i = 0; i < 4; ++i) {
      const int col = 768 + a * 256 + 4 * lane + i;
      w0[a][i] = cw[col]; w1[a][i] = cw[1536 + col]; w2[a][i] = cw[3072 + col]; bb[a][i] = cb[col];
    }
#pragma unroll
  for (int i = 0; i < 4; ++i) kkw[i] = p.rw_k_k[layer * 256 + 4 * lane + i];
  uint2 zm[3], zc[3], zp[3];
  auto ldz = [&](int row, uint2 (&z)[3]) {
#pragma unroll
    for (int a = 0; a < 3; ++a) z[a] = *(const uint2*)(p.Z + (size_t)row * INW + 768 + a * 256 + 4 * lane);
  };
  auto zero3 = [&](uint2 (&z)[3]) {
#pragma unroll
    for (int a = 0; a < 3; ++a) z[a] = make_uint2(0u, 0u);
  };
  if (r0 < r1) {
    if (r0 > 0) ldz(r0 - 1, zm); else zero3(zm);
    ldz(r0, zc);
  }
#pragma unroll 1
  for (int row = r0; row < r1; ++row) {
    if (row + 1 < NTOK) ldz(row + 1, zp); else zero3(zp);
    const int pp = row % LT;
    const bool hasm = (pp != 0) && (pp != LC);
    const bool hasp = (pp != LC - 1) && (pp != LT - 1);
    float res[3][4];
#pragma unroll
    for (int a = 0; a < 3; ++a) {
      const uint2 um = hasm ? zm[a] : make_uint2(0u, 0u), uc = zc[a], up = hasp ? zp[a] : make_uint2(0u, 0u);
      const float vm[4] = {bflo(um.x), bfhi(um.x), bflo(um.y), bfhi(um.y)};
      const float vc[4] = {bflo(uc.x), bfhi(uc.x), bflo(uc.y), bfhi(uc.y)};
      const float vp[4] = {bflo(up.x), bfhi(up.x), bflo(up.y), bfhi(up.y)};
#pragma unroll
      for (int i = 0; i < 4; ++i) res[a][i] = w0[a][i] * vm[i] + w1[a][i] * vc[i] + w2[a][i] * vp[i] + bb[a][i];
    }
    float kk[4], ss = 0.f;
#pragma unroll
    for (int i = 0; i < 4; ++i) { kk[i] = res[1][i] * kkw[i]; ss += kk[i] * kk[i]; }
    ss = row16_sum(ss);
    const float rs = rsqrtf(ss + 1e-12f);
    bf16_t* hr = p.H + (size_t)row * D + 16 * lane;
    *(uint4*)hr = make_uint4(pack2(res[0][0], res[1][0]), pack2(kk[0] * rs, res[2][0]), pack2(res[0][1], res[1][1]), pack2(kk[1] * rs, res[2][1]));
    *(uint4*)(hr + 8) = make_uint4(pack2(res[0][2], res[1][2]), pack2(kk[2] * rs, res[2][2]), pack2(res[0][3], res[1][3]), pack2(kk[3] * rs, res[2][3]));
#pragma unroll
    for (int a = 0; a < 3; ++a) { zm[a] = zc[a]; zc[a] = zp[a]; }
  }
}

DEV float oct_sum(float x) { x += dpp0<0xB1, 0xF>(x); x += dpp0<0x4E, 0xF>(x); x += dpp0<0x141, 0xF>(x); return x; }
DEV bf16x8 frag_join(uint2 lo, uint2 hi) { uint4 w = make_uint4(lo.x, lo.y, hi.x, hi.y); return __builtin_bit_cast(bf16x8, w); }
constexpr int SCS_SET = 17152, SCS_IMG = 3 * SCS_SET, SCS_W0 = SCS_IMG + 2 * 3072;
DEV void scanc_unit(const P& p, int layer, int unit, char* smem) {
  const int dir = unit & 1, h = (unit >> 1) & 3, b = unit >> 3;
  const int tid = tid_(), lane = tid & 63, fr = lane & 15, fq = lane >> 4;
  const int w = __builtin_amdgcn_readfirstlane(tid >> 6);
  bf16_t* IMG0 = (bf16_t*)(smem + SCS_W0);
  bf16_t* IMG1 = IMG0 + 512;
  bf16_t* IMG2 = IMG0 + 1024;
  __syncthreads();
  for (int i = tid; i < (2 * 3072 + 3072) / 4; i += 256) ((unsigned*)(smem + SCS_IMG))[i] = 0u;
  const float ka = p.rw_k_a[layer * 256 + h * 64 + lane];
  const size_t rowbase = (size_t)b * LT;
  const char* hbase = (const char*)p.H;
  const char* sbase = (const char*)p.SC;
  const unsigned hoff = (unsigned)(rowbase * 2048) + (unsigned)((h * 64 + lane) * 8);
  const unsigned soff = hoff + 4u * (unsigned)dir;
  bf16_t* yb = p.Z + rowbase * INW + 768 + dir * 256 + h * 64 + w * 16 + fr;
  auto pos0 = [&](int c) -> int { const int t = c * 16; return dir == 0 ? t : (t < LC ? LC - 1 - t : LT - 1 - (t - LC)); };
  const int pstep = dir == 0 ? 1 : -1;
  constexpr int NCH = LT / 16;
  struct Raw { unsigned sc[16]; uint2 hr[6]; };
  auto load_raw = [&](int c, Raw& rw) {
    if (w != 0) {
      const int p0 = pos0(c);
      const unsigned so = soff + (unsigned)(p0 * 2048);
      const int st = pstep * 2048;
#pragma unroll
      for (int i = 0; i < 16; ++i) rw.sc[i] = *(const unsigned*)(sbase + (so + (unsigned)(i * st)));
      const unsigned ho = hoff + (unsigned)((p0 + pstep * (w - 1)) * 2048);
#pragma unroll
      for (int q = 0; q < 6; ++q) {
        const int qq = ((w - 1) + 3 * q < 16) ? q : 4;
        rw.hr[q] = *(const uint2*)(hbase + (ho + (unsigned)(qq * 3 * st)));
      }
    }
  };
  auto stage1w = [&](int set, const Raw& rw, auto W1tag) {
    constexpr int W1 = decltype(W1tag)::value;
    char* base = smem + set * SCS_SET;
    bf16_t (*At)[72] = (bf16_t (*)[72])(base);
    bf16_t (*Rt)[72] = (bf16_t (*)[72])(base + 2304);
    bf16_t (*Bt)[72] = (bf16_t (*)[72])(base + 4608);
    bf16_t (*Kt)[72] = (bf16_t (*)[72])(base + 6912);
    bf16_t (*BKT)[36] = (bf16_t (*)[36])(base + 9216);
    bf16_t* VV = (bf16_t*)(base + 13824);
    float* G16 = (float*)(base + 16896);
    float Erun = 0.f;
#pragma unroll
    for (int i = 0; i < 16; ++i) {
      const float ev = bflo(rw.sc[i]);
      const float Eprev = Erun;
      Erun += ev;
      if ((i % 3) == W1) {
        const uint2 hrec = rw.hr[i / 3];
        const float rr = bflo(hrec.x), kr = bfhi(hrec.x), kkv = bflo(hrec.y);
        const float av = bfhi(rw.sc[i]);
        const float gp = __expf(-Eprev), gi = __expf(-Erun), ig = __expf(Erun);
        const float at = -kkv * gp, rt = rr * gi, bt = kkv * av * ig, kt2 = kr * (1.f + (av - 1.f) * ka) * ig;
        const unsigned ar = pack2(at, rt), bk = pack2(bt, kt2);
        At[i][lane] = (bf16_t)(ar & 0xFFFFu); Rt[i][lane] = (bf16_t)(ar >> 16);
        Bt[i][lane] = (bf16_t)(bk & 0xFFFFu); Kt[i][lane] = (bf16_t)(bk >> 16);
        BKT[lane][(i >> 2) * 8 + (i & 3)] = (bf16_t)(bk & 0xFFFFu);
        BKT[lane][(i >> 2) * 8 + 4 + (i & 3)] = (bf16_t)(bk >> 16);
        VV[((i >> 2) * 64 + lane) * 6 + (i & 3)] = (bf16_t)(hrec.y >> 16);
        if (i == 15) G16[lane] = gi;
      }
    }
  };
  auto stage1 = [&](int set, const Raw& rw) {
    if (w == 1) stage1w(set, rw, std::integral_constant<int, 0>{});
    else if (w == 2) stage1w(set, rw, std::integral_constant<int, 1>{});
    else if (w == 3) stage1w(set, rw, std::integral_constant<int, 2>{});
  };
  auto stage2 = [&](int set, int iset) {
    char* base = smem + set * SCS_SET;
    const bf16_t (*At)[72] = (const bf16_t (*)[72])(base);
    const bf16_t (*Rt)[72] = (const bf16_t (*)[72])(base + 2304);
    const bf16_t (*Bt)[72] = (const bf16_t (*)[72])(base + 4608);
    const bf16_t (*Kt)[72] = (const bf16_t (*)[72])(base + 6912);
    bf16_t* TT = (bf16_t*)(smem + SCS_IMG + iset * 3072);
    bf16_t* ARK = TT + 512;
    bf16_t* AAK = TT + 1024;
    const bf16_t (*X)[72] = (w < 2) ? At : Rt;
    const bf16_t (*Y)[72] = (w & 1) ? Kt : Bt;
    f32x4 cm = (f32x4){0.f, 0.f, 0.f, 0.f};
#pragma unroll
    for (int s = 0; s < 2; ++s) {
      bf16x8 af = *(const bf16x8*)&X[fr][32 * s + 8 * fq];
      bf16x8 bm = *(const bf16x8*)&Y[fr][32 * s + 8 * fq];
      cm = mfma16(af, bm, cm);
    }
#pragma unroll
    for (int jj = 0; jj < 4; ++jj) {
      const int i = 4 * fq + jj;
      const bool keep = (w < 2) ? (fr < i) : (fr <= i);
      cm[jj] = keep ? cm[jj] : 0.f;
    }
    const int io = (fr >> 2) * 8 + (fr & 3);
    auto wr_img = [&](bf16_t* img, const f32x4& Xv, int hi) {
#pragma unroll
      for (int jj = 0; jj < 4; ++jj) img[(4 * fq + jj) * 32 + io + hi] = f2bf(Xv[jj]);
    };
    if (w == 1) wr_img(AAK, cm, 0);
    else if (w == 2) wr_img(ARK, cm, 0);
    else if (w == 3) wr_img(ARK, cm, 4);
    else {
      auto bfrag = [&](const f32x4& Xv) { return frag_join(make_uint2(pack2(Xv[0], Xv[1]), pack2(Xv[2], Xv[3])), make_uint2(0u, 0u)); };
      auto afr = [&](const bf16_t* img) { return *(const bf16x8*)&img[(fr * 4 + fq) * 8]; };
      const f32x4 Z4 = (f32x4){0.f, 0.f, 0.f, 0.f};
      wr_img(IMG0, cm, 0);
      asm volatile("" ::: "memory");
      f32x4 A2 = mfma16(afr(IMG0), bfrag(cm), Z4);
      wr_img(IMG1, A2, 0);
      asm volatile("" ::: "memory");
      f32x4 A4 = mfma16(afr(IMG1), bfrag(A2), Z4);
      wr_img(IMG2, A4, 0);
      asm volatile("" ::: "memory");
      f32x4 Rm = mfma16(afr(IMG2), bfrag(A4), Z4);
#pragma unroll
      for (int jj = 0; jj < 4; ++jj) Rm[jj] += (fr == 4 * fq + jj) ? 1.f : 0.f;
      Rm = mfma16(afr(IMG2), bfrag(Rm), Rm);
      Rm = mfma16(afr(IMG1), bfrag(Rm), Rm);
      Rm = mfma16(afr(IMG0), bfrag(Rm), Rm);
      wr_img(TT, Rm, 0);
    }
  };
  f32x4 acc[4];
#pragma unroll
  for (int kt = 0; kt < 4; ++kt) acc[kt] = (f32x4){0.f, 0.f, 0.f, 0.f};
  auto part2 = [&](int c, int set, int iset) {
    char* base = smem + set * SCS_SET;
    const bf16_t (*At)[72] = (const bf16_t (*)[72])(base);
    const bf16_t (*Rt)[72] = (const bf16_t (*)[72])(base + 2304);
    const bf16_t (*BKT)[36] = (const bf16_t (*)[36])(base + 9216);
    const bf16_t* VV = (const bf16_t*)(base + 13824);
    const float* G16 = (const float*)(base + 16896);
    const bf16_t* TT = (const bf16_t*)(smem + SCS_IMG + iset * 3072);
    const bf16_t* ARK = TT + 512;
    const bf16_t* AAK = TT + 1024;
    bf16x8 Sb[2];
#pragma unroll
    for (int s = 0; s < 2; ++s) {
      uint4 t = make_uint4(pack2(acc[2 * s][0], acc[2 * s][1]), pack2(acc[2 * s][2], acc[2 * s][3]),
                           pack2(acc[2 * s + 1][0], acc[2 * s + 1][1]), pack2(acc[2 * s + 1][2], acc[2 * s + 1][3]));
      Sb[s] = __builtin_bit_cast(bf16x8, t);
    }
    const unsigned* vvp = (const unsigned*)&VV[(fq * 64 + w * 16 + fr) * 6];
    const uint2 vv = make_uint2(vvp[0], vvp[1]);
    const bf16x8 Vlow = frag_join(vv, make_uint2(0u, 0u));
    f32x4 Pm = (f32x4){0.f, 0.f, 0.f, 0.f};
#pragma unroll
    for (int s = 0; s < 2; ++s) {
      bf16x8 af = frag_join(*(const uint2*)&At[fr][32 * s + 4 * fq], *(const uint2*)&At[fr][32 * s + 16 + 4 * fq]);
      Pm = mfma16(af, Sb[s], Pm);
    }
    Pm = mfma16(*(const bf16x8*)&AAK[(fr * 4 + fq) * 8], Vlow, Pm);
    const bf16x8 Pb = frag_join(make_uint2(pack2(Pm[0], Pm[1]), pack2(Pm[2], Pm[3])), make_uint2(0u, 0u));
    f32x4 U = mfma16(*(const bf16x8*)&TT[(fr * 4 + fq) * 8], Pb, (f32x4){0.f, 0.f, 0.f, 0.f});
    const bf16x8 UV = frag_join(make_uint2(pack2(U[0], U[1]), pack2(U[2], U[3])), vv);
    f32x4 Yv = (f32x4){0.f, 0.f, 0.f, 0.f};
#pragma unroll
    for (int s = 0; s < 2; ++s) {
      bf16x8 af = frag_join(*(const uint2*)&Rt[fr][32 * s + 4 * fq], *(const uint2*)&Rt[fr][32 * s + 16 + 4 * fq]);
      Yv = mfma16(af, Sb[s], Yv);
    }
    Yv = mfma16(*(const bf16x8*)&ARK[(fr * 4 + fq) * 8], UV, Yv);
    {
      const int p0 = pos0(c);
#pragma unroll
      for (int jj = 0; jj < 4; ++jj) yb[(size_t)(p0 + pstep * (4 * fq + jj)) * INW] = f2bf(Yv[jj]);
    }
#pragma unroll
    for (int kt = 0; kt < 4; ++kt) {
      f32x4 t = mfma16(frag_join(*(const uint2*)&BKT[16 * kt + fr][fq * 8], *(const uint2*)&BKT[16 * kt + fr][fq * 8 + 4]), UV, acc[kt]);
      const float4 g4 = *(const float4*)&G16[16 * kt + 4 * fq];
      t[0] *= g4.x; t[1] *= g4.y; t[2] *= g4.z; t[3] *= g4.w;
      acc[kt] = t;
    }
  };
  __builtin_amdgcn_s_setprio(3);
  Raw r0, r1;
  load_raw(0, r0); load_raw(1, r1);
  stage1(0, r0);
  load_raw(2, r0);
  __syncthreads();
  stage2(0, 0);
  stage1(1, r1);
  load_raw(3, r1);
  __syncthreads();
  int s0 = 0, s1 = 1, s2 = 2;
  auto iter = [&](int c, Raw& rw) {
    if (c + 1 < NCH) stage2(s1, (c + 1) & 1);
    part2(c, s0, c & 1);
    if (c + 2 < NCH) {
      stage1(s2, rw);
      if (c + 4 < NCH) load_raw(c + 4, rw);
    }
    asm volatile("s_waitcnt lgkmcnt(0)" ::: "memory");
    __builtin_amdgcn_s_barrier();
    asm volatile("" ::: "memory");
    const int t = s0; s0 = s1; s1 = s2; s2 = t;
  };
#pragma unroll 1
  for (int c = 0; c < NCH; c += 2) {
    iter(c, r0); iter(c + 1, r1);
  }
  __builtin_amdgcn_s_setprio(0);
}

DEV void ph_rwkv_post(const P& p, int layer) {
  const int lane = tid_() & 63;
  int r0, r1;
  wave_range(r0, r1, NTOK);
  const int ch = 4 * lane;
  float kav[4], rkv[4], lnw[4], lnb[4];
#pragma unroll
  for (int i = 0; i < 4; ++i) {
    kav[i] = p.rw_k_a[layer * 256 + ch + i]; rkv[i] = p.rw_r_k[layer * 256 + ch + i];
    lnw[i] = p.rw_ln_w[layer * 256 + ch + i]; lnb[i] = p.rw_ln_b[layer * 256 + ch + i];
  }
  struct In { uint2 y0, y1, g; uint4 h0, h1, s0, s1; };
  auto ld = [&](int row, In& in) {
    const bf16_t* zr = p.Z + (size_t)row * INW + 768 + ch;
    in.y0 = *(const uint2*)zr; in.y1 = *(const uint2*)(zr + 256);
    const bf16_t* hr = p.H + (size_t)row * D + 4 * ch;
    in.h0 = *(const uint4*)hr; in.h1 = *(const uint4*)(hr + 8);
    const bf16_t* sr = p.SC + (size_t)row * 1024 + 4 * ch;
    in.s0 = *(const uint4*)sr; in.s1 = *(const uint4*)(sr + 8);
    in.g = *(const uint2*)(p.Y + (size_t)row * D + 256 + ch);
  };
  In nx;
  if (r0 < r1) ld(r0, nx);
#pragma unroll 1
  for (int row = r0; row < r1; ++row) {
    const In in = nx;
    if (row + 1 < r1) ld(row + 1, nx);
    float y[4] = {bflo(in.y0.x) + bflo(in.y1.x), bfhi(in.y0.x) + bfhi(in.y1.x), bflo(in.y0.y) + bflo(in.y1.y), bfhi(in.y0.y) + bfhi(in.y1.y)};
    const float mu = row16_sum(y[0] + y[1] + y[2] + y[3]) * (1.f / 64.f);
    float vs = 0.f;
#pragma unroll
    for (int i = 0; i < 4; ++i) { y[i] -= mu; vs += y[i] * y[i]; }
    const float var = row16_sum(vs) * (1.f / 64.f);
    const float rstd = rsqrtf(var + 64e-5f);
    const float r[4] = {bflo(in.h0.x), bflo(in.h0.z), bflo(in.h1.x), bflo(in.h1.z)};
    const float k[4] = {bfhi(in.h0.x), bfhi(in.h0.z), bfhi(in.h1.x), bfhi(in.h1.z)};
    const float v[4] = {bfhi(in.h0.y), bfhi(in.h0.w), bfhi(in.h1.y), bfhi(in.h1.w)};
    const float a0[4] = {bfhi(in.s0.x), bfhi(in.s0.z), bfhi(in.s1.x), bfhi(in.s1.z)};
    const float a1[4] = {bfhi(in.s0.y), bfhi(in.s0.w), bfhi(in.s1.y), bfhi(in.s1.w)};
    float sd = 0.f;
#pragma unroll
    for (int i = 0; i < 4; ++i) {
      const float kd0 = k[i] * (1.f + (a0[i] - 1.f) * kav[i]), kd1 = k[i] * (1.f + (a1[i] - 1.f) * kav[i]);
      sd += r[i] * (kd0 + kd1) * rkv[i];
    }
    sd = row16_sum(sd);
    const float g[4] = {bflo(in.g.x), bfhi(in.g.x), bflo(in.g.y), bfhi(in.g.y)};
    float o[4];
#pragma unroll
    for (int i = 0; i < 4; ++i) {
      const float yn = y[i] * rstd * lnw[i] + lnb[i];
      o[i] = (yn + sd * v[i]) * g[i];
    }
    *(uint2*)(p.Y + (size_t)row * D + 256 + ch) = make_uint2(pack2(o[0], o[1]), pack2(o[2], o[3]));
  }
}

DEV void hyena_pre_unit(const P& p, int layer, int unit) {
  int kind, b, t0, L;
  if (unit < 1024) { kind = 0; b = unit >> 6; t0 = (unit & 63) * 64; L = T; } else { int u = unit - 1024; kind = 1; b = u >> 2; t0 = (u & 3) * 64; L = LC; }
  const int lane = tid_() & 63, wid = tid_() >> 6;
  const int tw = t0 + wid * 16;
  const size_t row0 = (size_t)b * LT + (kind ? 0 : LC);
  const float* cw = p.conv_w + (size_t)layer * 3 * 1536;
  const float* cb = p.conv_b + (size_t)layer * 1536;
  float wx[3][4], wv[3][4], bx[4], bv[4];
#pragma unroll
  for (int i = 0; i < 4; ++i) {
    const int cx = 256 + 4 * lane + i, cv = 512 + 4 * lane + i;
#pragma unroll
    for (int k = 0; k < 3; ++k) { wx[k][i] = cw[k * 1536 + cx]; wv[k][i] = cw[k * 1536 + cv]; }
    bx[i] = cb[cx]; bv[i] = cb[cv];
  }
  uint2 zx[18], zv[18];
#pragma unroll
  for (int i = 0; i < 18; ++i) {
    const int t = tw - 1 + i;
    if (t >= 0 && t < L) {
      const bf16_t* zr = p.Z + (row0 + t) * INW + 256 + 4 * lane;
      zx[i] = *(const uint2*)zr; zv[i] = *(const uint2*)(zr + 256);
    } else { zx[i] = make_uint2(0u, 0u); zv[i] = make_uint2(0u, 0u); }
  }
  float uo[4][16];
#pragma unroll
  for (int i = 0; i < 16; ++i) {
    const float xm[4] = {bflo(zx[i].x), bfhi(zx[i].x), bflo(zx[i].y), bfhi(zx[i].y)};
    const float xc[4] = {bflo(zx[i + 1].x), bfhi(zx[i + 1].x), bflo(zx[i + 1].y), bfhi(zx[i + 1].y)};
    const float xp[4] = {bflo(zx[i + 2].x), bfhi(zx[i + 2].x), bflo(zx[i + 2].y), bfhi(zx[i + 2].y)};
    const float vm[4] = {bflo(zv[i].x), bfhi(zv[i].x), bflo(zv[i].y), bfhi(zv[i].y)};
    const float vc[4] = {bflo(zv[i + 1].x), bfhi(zv[i + 1].x), bflo(zv[i + 1].y), bfhi(zv[i + 1].y)};
    const float vp[4] = {bflo(zv[i + 2].x), bfhi(zv[i + 2].x), bflo(zv[i + 2].y), bfhi(zv[i + 2].y)};
#pragma unroll
    for (int q = 0; q < 4; ++q) {
      const float a = wx[0][q] * xm[q] + wx[1][q] * xc[q] + wx[2][q] * xp[q] + bx[q];
      const float c2 = wv[0][q] * vm[q] + wv[1][q] * vc[q] + wv[2][q] * vp[q] + bv[q];
      uo[q][i] = a * c2;
    }
  }
  bf16_t* ut = kind ? opq(p.UTc) : opq(p.UTl);
#pragma unroll
  for (int q = 0; q < 4; ++q) {
    bf16_t* dst = ut + ((size_t)(4 * lane + q) * 16 + b) * L + tw;
    *(uint4*)dst = pack8(&uo[q][0]);
    *(uint4*)(dst + 8) = pack8(&uo[q][8]);
  }
}

DEV void hyena_conv_unit(const P& p, int layer, int unit, char* smem) {
  int kind, c, tb, L;
  if (unit < 4096) { kind = 0; c = unit >> 4; tb = (unit & 15) * 256; L = T; } else { kind = 1; c = unit - 4096; tb = 0; L = LC; }
  const int tid = tid_(), lane = tid & 63, wid = tid >> 6, fr = lane & 15, fq = lane >> 4;
  float* red = (float*)(smem + 2 * 16512);
  const float* F = (kind ? opq(p.FC) : opq(p.FL)) + (size_t)c * 2 * L;
  float scale;
  {
    float part = 0.f;
    for (int i = tid; i < 2 * L; i += 256) { float fv = F[i]; part += (i != L) ? fv * fv : 0.f; }
    part = wave_sum(part);
    __syncthreads();
    if (lane == 0) red[wid] = part;
    __syncthreads();
    scale = rsqrtf(((red[0] + red[1]) + (red[2] + red[3])) + 1e-6f);
  }
  const bf16_t* U = (kind ? opq(p.UTc) : opq(p.UTl)) + (size_t)c * 16 * L;
  f32x4 acc[4];
#pragma unroll
  for (int m = 0; m < 4; ++m) acc[m] = (f32x4){0.f, 0.f, 0.f, 0.f};
  const int nch = L / 256;
  float fw0, fw1, fw2;
  uint4 ru0, ru1;
  auto ldchunk = [&](int ch) {
    const int sc = ch * 256;
    const int D0 = tb + 256 - sc;
    auto tap = [&](int n) -> float {
      int d = D0 - n;
      float v = 0.f;
      if (d > -L && d < L) v = (d >= 0 ? F[d] : F[L - d]);
      return v;
    };
    fw0 = tap(tid); fw1 = tap(tid + 256); fw2 = (tid < 8) ? tap(tid + 512) : 0.f;
    const int bb = tid >> 4, sg0 = tid & 15;
    ru0 = *(const uint4*)(U + (size_t)bb * L + sc + 8 * sg0);
    ru1 = *(const uint4*)(U + (size_t)bb * L + sc + 8 * (sg0 + 16));
  };
  auto stchunk = [&](int buf) {
    bf16_t* Cq = (bf16_t*)(smem + buf * 16512);
    bf16_t* Us = (bf16_t*)(smem + buf * 16512 + 8320);
    const bf16_t h0 = f2bf(fw0 * scale), h1 = f2bf(fw1 * scale), h2 = f2bf(fw2 * scale);
#pragma unroll
    for (int rho = 0; rho < 8; ++rho) {
      int m = tid + rho;
      Cq[((m >> 3) * 8 + rho) * 8 + (m & 7)] = h0;
      m = tid + 256 + rho;
      if (m < 520) Cq[((m >> 3) * 8 + rho) * 8 + (m & 7)] = h1;
      m = tid + 512 + rho;
      if (tid < 8 && m < 520) Cq[((m >> 3) * 8 + rho) * 8 + (m & 7)] = h2;
    }
    if (tid < 8) {
#pragma unroll
      for (int rho = 1; rho < 8; ++rho) if (tid < rho) Cq[(rho) * 8 + tid] = 0;
    }
    const int bb = tid >> 4, sg0 = tid & 15;
    *(uint4*)&Us[(sg0 * 16 + bb) * 8] = ru0;
    *(uint4*)&Us[((sg0 + 16) * 16 + bb) * 8] = ru1;
  };
  ldchunk(0);
#pragma unroll 1
  for (int ch = 0; ch < nch; ++ch) {
    const int buf = ch & 1;
    stchunk(buf);
    __syncthreads();
    if (ch + 1 < nch) ldchunk(ch + 1);
    const bf16_t* Cq = (const bf16_t*)(smem + buf * 16512);
    const bf16_t* Us = (const bf16_t*)(smem + buf * 16512 + 8320);
#pragma unroll
    for (int kk = 0; kk < 8; ++kk) {
      bf16x8 bf = *(const bf16x8*)&Us[((4 * kk + fq) * 16 + fr) * 8];
#pragma unroll
      for (int m = 0; m < 4; ++m) {
        int it = wid * 4 + m;
        int base = 256 - 16 * it + 32 * kk + 8 * fq;
        int m0 = base - 8 * (fr >> 3);
        bf16x8 af = *(const bf16x8*)&Cq[((m0 >> 3) * 8 + (fr & 7)) * 8];
        acc[m] = mfma16(af, bf, acc[m]);
      }
    }
  }
  __syncthreads();
  bf16_t* Yt = (kind ? opq(p.YTc) : opq(p.YTl)) + ((size_t)c * 16 + fr) * L + tb;
#pragma unroll
  for (int m = 0; m < 4; ++m) {
    int t = (wid * 4 + m) * 16 + fq * 4;
    *(uint2*)(Yt + t) = make_uint2(pack2(acc[m][0], acc[m][1]), pack2(acc[m][2], acc[m][3]));
  }
}

DEV void hyena_post_unit(const P& p, int layer, int unit, char* smem) {
  (void)smem;
  int kind, b, t0, L;
  if (unit < 1024) { kind = 0; b = unit >> 6; t0 = (unit & 63) * 64; L = T; } else { int u = unit - 1024; kind = 1; b = u >> 2; t0 = (u & 3) * 64; L = LC; }
  const int lane = tid_() & 63, wid = tid_() >> 6;
  const int tw = t0 + wid * 16;
  const size_t row0 = (size_t)b * LT + (kind ? 0 : LC);
  const float* cw = p.conv_w + (size_t)layer * 3 * 1536;
  float w0[3][4], b0[4], bias[4], og[4];
#pragma unroll
  for (int i = 0; i < 4; ++i) {
    const int c = 4 * lane + i;
#pragma unroll
    for (int k = 0; k < 3; ++k) w0[k][i] = cw[k * 1536 + c];
    b0[i] = p.conv_b[layer * 1536 + c]; bias[i] = p.hy_bias[layer * 256 + c]; og[i] = p.hy_out_g[layer * 256 + c];
  }
  uint2 zx[18];
#pragma unroll
  for (int i = 0; i < 18; ++i) {
    const int t = tw - 1 + i;
    zx[i] = (t >= 0 && t < L) ? *(const uint2*)(p.Z + (row0 + t) * INW + 4 * lane) : make_uint2(0u, 0u);
  }
  const bf16_t* ytb = kind ? opq(p.YTc) : opq(p.YTl);
  const bf16_t* utb = kind ? opq(p.UTc) : opq(p.UTl);
  float o[4][16];
#pragma unroll
  for (int q = 0; q < 4; ++q) {
    const size_t off = ((size_t)(4 * lane + q) * 16 + b) * L + tw;
    float yv[16], uv[16];
    { uint4 a0 = *(const uint4*)(ytb + off), a1 = *(const uint4*)(ytb + off + 8); unpack8(a0, yv); unpack8(a1, yv + 8); }
    { uint4 a0 = *(const uint4*)(utb + off), a1 = *(const uint4*)(utb + off + 8); unpack8(a0, uv); unpack8(a1, uv + 8); }
#pragma unroll
    for (int i = 0; i < 16; ++i) o[q][i] = yv[i] + uv[i] * bias[q];
  }
#pragma unroll
  for (int i = 0; i < 16; ++i) {
    const float xm[4] = {bflo(zx[i].x), bfhi(zx[i].x), bflo(zx[i].y), bfhi(zx[i].y)};
    const float xc[4] = {bflo(zx[i + 1].x), bfhi(zx[i + 1].x), bflo(zx[i + 1].y), bfhi(zx[i + 1].y)};
    const float xp[4] = {bflo(zx[i + 2].x), bfhi(zx[i + 2].x), bflo(zx[i + 2].y), bfhi(zx[i + 2].y)};
    float ov[4], ss = 0.f;
#pragma unroll
    for (int q = 0; q < 4; ++q) {
      const float x0 = w0[0][q] * xm[q] + w0[1][q] * xc[q] + w0[2][q] * xp[q] + b0[q];
      ov[q] = bf2f(f2bf(x0 * o[q][i]));
      ss += ov[q] * ov[q];
    }
    ss = wave_sum(ss);
    const float rstd = rsqrtf(ss * (1.f / 256.f) + 1e-6f);
    *(uint2*)(p.Y + (row0 + tw + i) * D + 4 * lane) = make_uint2(pack2(ov[0] * rstd * og[0], ov[1] * rstd * og[1]), pack2(ov[2] * rstd * og[2], ov[3] * rstd * og[3]));
  }
}

DEV void attn_unit(const P& p, int layer, int unit, char* smem) {
  const bool isctx = unit >= 4096;
  int b, qb, hq;
  if (!isctx) { b = unit >> 8; qb = (unit >> 3) & 31; hq = unit & 7; } else { int u = unit - 4096; b = u >> 4; qb = (u >> 3) & 1; hq = u & 7; }
  const int g = hq >> 2;
  const int tid = tid_(), lane = tid & 63, wid = tid >> 6, qn = lane & 31, hh = lane >> 5;
  const int qpos = qb * 128 + wid * 32 + qn;
  const size_t qrow = (size_t)b * LT + (isctx ? qpos : LC + qpos);
  const bf16_t* qptr = p.Z + qrow * INW + 1920 + hq * 64;
  bf16x8 qf[4];
#pragma unroll
  for (int s = 0; s < 4; ++s) qf[s] = *(const bf16x8*)(qptr + 16 * s + 8 * hh);
  const float sink = p.attn_sink[layer * 8 + hq];
  float m_run = sink, l_run = 1.f;
  f32x16 o0, o1;
#pragma unroll
  for (int i = 0; i < 16; ++i) { o0[i] = 0.f; o1[i] = 0.f; }
  typedef bf16_t KTile[64][72];
  KTile* Ks = (KTile*)smem;
  KTile* Vt = (KTile*)(smem + 18432);
  const int ntl = isctx ? 0 : 6;
  const int ntiles = ntl + 4;
  const int skey = tid >> 3, sseg = tid & 7;
  const bf16_t* kvbase = p.Z + (size_t)b * LT * INW + 1920 + 512 + g * 64 + sseg * 8;
  uint4 rk0, rk1, rv0, rv1;
  auto ldtile = [&](int kt) {
    const bool ctxk = kt >= ntl;
    const int kbase = ctxk ? (kt - ntl) * 64 : qb * 128 - 128 + kt * 64;
    const int kp0 = kbase + skey, kp1 = kp0 + 32;
    rk0 = rk1 = rv0 = rv1 = make_uint4(0, 0, 0, 0);
    if (ctxk || (kp0 >= 0 && kp0 < T)) { const bf16_t* src = kvbase + (size_t)(ctxk ? kp0 : LC + kp0) * INW; rk0 = *(const uint4*)src; rv0 = *(const uint4*)(src + 128); }
    if (ctxk || (kp1 >= 0 && kp1 < T)) { const bf16_t* src = kvbase + (size_t)(ctxk ? kp1 : LC + kp1) * INW; rk1 = *(const uint4*)src; rv1 = *(const uint4*)(src + 128); }
  };
  auto sttile = [&](int buf) {
    *(uint4*)&Ks[buf][skey][sseg * 8] = rk0;
    *(uint4*)&Ks[buf][skey + 32][sseg * 8] = rk1;
    bf16_t (*vt)[72] = Vt[buf];
    vt[sseg * 8 + 0][skey] = (bf16_t)(rv0.x & 0xFFFF); vt[sseg * 8 + 1][skey] = (bf16_t)(rv0.x >> 16);
    vt[sseg * 8 + 2][skey] = (bf16_t)(rv0.y & 0xFFFF); vt[sseg * 8 + 3][skey] = (bf16_t)(rv0.y >> 16);
    vt[sseg * 8 + 4][skey] = (bf16_t)(rv0.z & 0xFFFF); vt[sseg * 8 + 5][skey] = (bf16_t)(rv0.z >> 16);
    vt[sseg * 8 + 6][skey] = (bf16_t)(rv0.w & 0xFFFF); vt[sseg * 8 + 7][skey] = (bf16_t)(rv0.w >> 16);
    vt[sseg * 8 + 0][skey + 32] = (bf16_t)(rv1.x & 0xFFFF); vt[sseg * 8 + 1][skey + 32] = (bf16_t)(rv1.x >> 16);
    vt[sseg * 8 + 2][skey + 32] = (bf16_t)(rv1.y & 0xFFFF); vt[sseg * 8 + 3][skey + 32] = (bf16_t)(rv1.y >> 16);
    vt[sseg * 8 + 4][skey + 32] = (bf16_t)(rv1.z & 0xFFFF); vt[sseg * 8 + 5][skey + 32] = (bf16_t)(rv1.z >> 16);
    vt[sseg * 8 + 6][skey + 32] = (bf16_t)(rv1.w & 0xFFFF); vt[sseg * 8 + 7][skey + 32] = (bf16_t)(rv1.w >> 16);
  };
  ldtile(0);
#pragma unroll 1
  for (int kt = 0; kt < ntiles; ++kt) {
    const int buf = kt & 1;
    sttile(buf);
    __syncthreads();
    if (kt + 1 < ntiles) ldtile(kt + 1);
    const bool ctxk = kt >= ntl;
    const int kbase = ctxk ? (kt - ntl) * 64 : qb * 128 - 128 + kt * 64;
#pragma unroll
    for (int sub = 0; sub < 2; ++sub) {
      const int kb2 = kbase + sub * 32;
      bool need = true;
      if (!ctxk) {
        int q0 = qb * 128 + wid * 32;
        if (kb2 + 31 < q0 - 128 || kb2 > q0 + 31 + 128 || kb2 + 31 < 0 || kb2 >= T) need = false;
      }
      if (need) {
        f32x16 sv;
#pragma unroll
        for (int i = 0; i < 16; ++i) sv[i] = 0.f;
#pragma unroll
        for (int ks = 0; ks < 4; ++ks) {
          bf16x8 kf = *(const bf16x8*)&Ks[buf][sub * 32 + qn][16 * ks + 8 * hh];
          sv = mfma32(kf, qf[ks], sv);
        }
        float mt = -3e38f;
#pragma unroll
        for (int rg = 0; rg < 16; ++rg) {
          float v = sv[rg] * 0.125f;
          if (!ctxk) {
            int kp = kb2 + (rg & 3) + 8 * (rg >> 2) + 4 * hh;
            int dl = qpos - kp;
            bool ok = (dl <= 128) && (dl >= -128) && (kp >= 0) && (kp < T);
            v = ok ? v : -1e30f;
          }
          sv[rg] = v;
          mt = fmaxf(mt, v);
        }
        mt = fmaxf(mt, __shfl_xor(mt, 32));
        float m_new = fmaxf(m_run, mt);
        float corr = __expf(m_run - m_new);
        float ps = 0.f;
#pragma unroll
        for (int rg = 0; rg < 16; ++rg) { float pv = __expf(sv[rg] - m_new); sv[rg] = pv; ps += pv; }
        ps += __shfl_xor(ps, 32);
        l_run = l_run * corr + ps;
        m_run = m_new;
#pragma unroll
        for (int i = 0; i < 16; ++i) { o0[i] *= corr; o1[i] *= corr; }
#pragma unroll
        for (int sp = 0; sp < 2; ++sp) {
          bf16x8 pf;
#pragma unroll
          for (int j = 0; j < 8; ++j) pf[j] = (short)f2bf(sv[8 * sp + j]);
          const int kc = sub * 32 + 16 * sp + 4 * hh;
          uint2 va = *(const uint2*)&Vt[buf][qn][kc], vb = *(const uint2*)&Vt[buf][qn][kc + 8];
          uint2 vc = *(const uint2*)&Vt[buf][32 + qn][kc], vd = *(const uint2*)&Vt[buf][32 + qn][kc + 8];
          uint4 w0 = make_uint4(va.x, va.y, vb.x, vb.y), w1 = make_uint4(vc.x, vc.y, vd.x, vd.y);
          bf16x8 v0 = __builtin_bit_cast(bf16x8, w0), v1 = __builtin_bit_cast(bf16x8, w1);
          o0 = mfma32(v0, pf, o0);
          o1 = mfma32(v1, pf, o1);
        }
      }
    }
  }
  __syncthreads();
  const float inv = 1.f / l_run;
  bf16_t* optr = p.Y + qrow * D + 512 + hq * 64;
#pragma unroll
  for (int rg = 0; rg < 4; ++rg) {
    int d0 = 8 * rg + 4 * hh;
    *(uint2*)(optr + d0) = make_uint2(pack2(o0[4 * rg] * inv, o0[4 * rg + 1] * inv), pack2(o0[4 * rg + 2] * inv, o0[4 * rg + 3] * inv));
    *(uint2*)(optr + 32 + d0) = make_uint2(pack2(o1[4 * rg] * inv, o1[4 * rg + 1] * inv), pack2(o1[4 * rg + 2] * inv, o1[4 * rg + 3] * inv));
  }
}

DEV void ph_attn_post(const P& p, int layer) {
  const int lane = tid_() & 63;
  int r0, r1;
  wave_range(r0, r1, NTOK);
  float gv[8];
#pragma unroll
  for (int i = 0; i < 8; ++i) gv[i] = p.at_out_g[layer * 512 + 8 * lane + i];
  uint4 nx = make_uint4(0, 0, 0, 0);
  if (r0 < r1) nx = *(const uint4*)(p.Y + (size_t)r0 * D + 512 + 8 * lane);
#pragma unroll 1
  for (int row = r0; row < r1; ++row) {
    const uint4 u = nx;
    if (row + 1 < r1) nx = *(const uint4*)(p.Y + (size_t)(row + 1) * D + 512 + 8 * lane);
    float v[8];
    unpack8(u, v);
    float ss = 0.f;
#pragma unroll
    for (int i = 0; i < 8; ++i) ss += v[i] * v[i];
    ss = wave_sum(ss);
    const float rstd = rsqrtf(ss * (1.f / 512.f) + 1e-6f);
#pragma unroll
    for (int i = 0; i < 8; ++i) {
      v[i] = v[i] * rstd * gv[i];
    }
    *(uint4*)(p.Y + (size_t)row * D + 512 + 8 * lane) = pack8(v);
  }
}

struct Epi2 {
  const P& p; int layer, row0, col0;
  DEV void operator()(f32x4 (&acc)[4][4], int wr, int wc, int fr, int fq, char* smem) const {
    const int b = row0 / LT, pp = row0 % LT;
    const int mr = pp < LC ? 16 : b;
    const float* g1 = p.modv + ((size_t)layer * 17 + mr) * 6144 + 2048 + col0 + wc * 64;
#pragma unroll
    for (int n = 0; n < 4; ++n) {
      const float4 gv = *(const float4*)(g1 + n * 16 + 4 * fq);
#pragma unroll
      for (int m = 0; m < 4; ++m) { acc[m][n][0] *= gv.x; acc[m][n][1] *= gv.y; acc[m][n][2] *= gv.z; acc[m][n][3] *= gv.w; }
    }
    const int wid = wr * 2 + wc, lane = fq * 16 + fr;
    stage_tile_bf16(acc, smem, wid, fr, fq);
    const bf16_t (*t)[72] = (const bf16_t (*)[72])(smem + wid * 9216);
#pragma unroll
    for (int i = 0; i < 8; ++i) {
      const int rl = i * 8 + (lane >> 3), ch = lane & 7;
      bf16_t* xp = p.X + (size_t)(row0 + wr * 64 + rl) * D + col0 + wc * 64 + ch * 8;
      float xv[8], dv[8];
      uint4 xu = *(const uint4*)xp, du = *(const uint4*)&t[rl][ch * 8];
      unpack8(xu, xv); unpack8(du, dv);
#pragma unroll
      for (int q = 0; q < 8; ++q) xv[q] += dv[q];
      *(uint4*)xp = pack8(xv);
    }
  }
};
DEV void ph_gemm2(const P& p, int layer, char* smem) {
  int rt, ct;
  for (int it = 0; gemm_unit(it, 8, rt, ct); ++it) {
    Epi2 epi{p, layer, rt * 128, ct * 128};
    gemm_tile(p.Y + (size_t)rt * 128 * D, D, p.W2t + (size_t)ct * 128 * D, D, D, smem, epi);
  }
}

DEV void ph_peerconv(const P& p, int layer) {
  const int gw = (bid_() * 256 + tid_()) >> 6, nw = gridDim.x * 4, lane = tid_() & 63;
  const float* su = opq(p.peer_u) + (size_t)layer * 16384 * 1024;
  const float* sv = opq(p.peer_v) + (size_t)layer * 16384 * 1024;
  unsigned char* pu = opq(p.PU); unsigned char* pv = opq(p.PV);
  float* psu = opq(p.PSU); float* psv = opq(p.PSV);
  auto ldrow = [&](int r, float4& a0, float4& a1, float4& a2, float4& a3) {
    const float* src = ((r >= 16384) ? sv : su) + (size_t)(r & 16383) * 1024 + 16 * lane;
    a0 = *(const float4*)src; a1 = *(const float4*)(src + 4); a2 = *(const float4*)(src + 8); a3 = *(const float4*)(src + 12);
  };
  float4 n0 = make_float4(0, 0, 0, 0), n1 = n0, n2 = n0, n3 = n0;
  if (gw < 32768) ldrow(gw, n0, n1, n2, n3);
#pragma unroll 1
  for (int r = gw; r < 32768; r += nw) {
    const bool isv = r >= 16384;
    const int e = r & 16383;
    const float4 f0 = n0, f1 = n1, f2 = n2, f3 = n3;
    if (r + nw < 32768) ldrow(r + nw, n0, n1, n2, n3);
    float am = fmaxf(fmaxf(fmaxf(fabsf(f0.x), fabsf(f0.y)), fmaxf(fabsf(f0.z), fabsf(f0.w))), fmaxf(fmaxf(fabsf(f1.x), fabsf(f1.y)), fmaxf(fabsf(f1.z), fabsf(f1.w))));
    am = fmaxf(am, fmaxf(fmaxf(fmaxf(fabsf(f2.x), fabsf(f2.y)), fmaxf(fabsf(f2.z), fabsf(f2.w))), fmaxf(fmaxf(fabsf(f3.x), fabsf(f3.y)), fmaxf(fabsf(f3.z), fabsf(f3.w)))));
    am = wave_max(am);
    int w0, w1, w2, w3;
    float inv;
    if (isv) {
      const float sc = am > 0.f ? 224.f / am : 1.f;
      inv = am > 0.f ? am * (1.f / 224.f) : 1.f;
      w0 = __builtin_amdgcn_cvt_pk_fp8_f32(f0.x * sc, f0.y * sc, 0, false); w0 = __builtin_amdgcn_cvt_pk_fp8_f32(f0.z * sc, f0.w * sc, w0, true);
      w1 = __builtin_amdgcn_cvt_pk_fp8_f32(f1.x * sc, f1.y * sc, 0, false); w1 = __builtin_amdgcn_cvt_pk_fp8_f32(f1.z * sc, f1.w * sc, w1, true);
      w2 = __builtin_amdgcn_cvt_pk_fp8_f32(f2.x * sc, f2.y * sc, 0, false); w2 = __builtin_amdgcn_cvt_pk_fp8_f32(f2.z * sc, f2.w * sc, w2, true);
      w3 = __builtin_amdgcn_cvt_pk_fp8_f32(f3.x * sc, f3.y * sc, 0, false); w3 = __builtin_amdgcn_cvt_pk_fp8_f32(f3.z * sc, f3.w * sc, w3, true);
    } else {
      const float sc = am > 0.f ? 127.f / am : 1.f;
      inv = am > 0.f ? am * (1.f / 127.f) : 1.f;
      w0 = pack_i8(f0.x * sc, f0.y * sc, f0.z * sc, f0.w * sc); w1 = pack_i8(f1.x * sc, f1.y * sc, f1.z * sc, f1.w * sc);
      w2 = pack_i8(f2.x * sc, f2.y * sc, f2.z * sc, f2.w * sc); w3 = pack_i8(f3.x * sc, f3.y * sc, f3.z * sc, f3.w * sc);
    }
    *(uint4*)((isv ? pv : pu) + (size_t)(lane >> 3) * PSLICE + (size_t)e * 128 + 16 * (lane & 7)) = make_uint4((unsigned)w0, (unsigned)w1, (unsigned)w2, (unsigned)w3);
    if (lane == 0) (isv ? psv : psu)[e] = inv;
  }
}
DEV void unpack16_fp8x2(const uint4& u, f32x2* f) {
  f[0] = __builtin_amdgcn_cvt_pk_f32_fp8((int)u.x, false); f[1] = __builtin_amdgcn_cvt_pk_f32_fp8((int)u.x, true);
  f[2] = __builtin_amdgcn_cvt_pk_f32_fp8((int)u.y, false); f[3] = __builtin_amdgcn_cvt_pk_f32_fp8((int)u.y, true);
  f[4] = __builtin_amdgcn_cvt_pk_f32_fp8((int)u.z, false); f[5] = __builtin_amdgcn_cvt_pk_f32_fp8((int)u.z, true);
  f[6] = __builtin_amdgcn_cvt_pk_f32_fp8((int)u.w, false); f[7] = __builtin_amdgcn_cvt_pk_f32_fp8((int)u.w, true);
}

DEV void bitonic_sort16_desc(float (&v)[16]) {
#pragma unroll
  for (int k = 2; k <= 16; k <<= 1)
#pragma unroll
    for (int j = k >> 1; j >= 1; j >>= 1)
#pragma unroll
      for (int i = 0; i < 16; ++i) {
        const int l = i ^ j;
        if (l > i) {
          const float hi = fmaxf(v[i], v[l]), lo = fminf(v[i], v[l]);
          if ((i & k) == 0) { v[i] = hi; v[l] = lo; } else { v[i] = lo; v[l] = hi; }
        }
      }
}
DEV void peer_cand_ij(int c, int& ci, int& cj) {
  if (c < 16) { ci = 0; cj = c; } else if (c < 24) { ci = 1; cj = c - 16; } else if (c < 29) { ci = 2; cj = c - 24; }
  else if (c < 33) { ci = 3; cj = c - 29; } else if (c < 36) { ci = 4; cj = c - 33; } else if (c < 38) { ci = 5; cj = c - 36; }
  else if (c < 40) { ci = 6; cj = c - 38; } else if (c < 42) { ci = 7; cj = c - 40; } else { ci = (c - 42 + 8) & 15; cj = 0; }
}
template <int S>
struct Epi3K {
  const P& p; int row0, head; float (&keep)[2][16];
  DEV void operator()(f32x4 (&acc)[4][4], int wr, int wc, int fr, int fq, char* smem) const {
    float* sc = (float*)smem;
    float* L1s = (float*)(smem + 36864);
    float* L2s = (float*)(smem + 45056);
    const int tid = tid_();
#pragma unroll
    for (int pass = 0; pass < 2; ++pass) {
      __syncthreads();
      if (wr == pass) {
#pragma unroll
        for (int m = 0; m < 4; ++m)
#pragma unroll
          for (int n = 0; n < 4; ++n)
#pragma unroll
            for (int j = 0; j < 4; ++j) {
              int rl = m * 16 + fr, col = wc * 64 + n * 16 + 4 * fq + j;
              unsigned bits = (__float_as_uint(acc[m][n][j]) & ~127u) | (unsigned)col;
              sc[rl * 133 + (col >> 5) * 33 + (col & 31)] = __uint_as_float(bits);
            }
      }
      __syncthreads();
      const int rl = tid >> 2, q = tid & 3;
      const float* src = sc + rl * 133 + q * 33;
      float Ls[16], Hs[16];
#pragma unroll
      for (int i = 0; i < 16; ++i) { Ls[i] = src[i]; Hs[i] = src[16 + i]; }
      bitonic_sort16_desc(Ls);
      bitonic_sort16_desc(Hs);
#pragma unroll
      for (int i = 0; i < 16; ++i) Ls[i] = fmaxf(Ls[i], Hs[15 - i]);
#pragma unroll
      for (int d = 8; d >= 1; d >>= 1)
#pragma unroll
        for (int i = 0; i < 16; ++i)
          if ((i & d) == 0) { float hi = fmaxf(Ls[i], Ls[i + d]), lo = fminf(Ls[i], Ls[i + d]); Ls[i] = hi; Ls[i + d] = lo; }
      float Cs[16];
#pragma unroll
      for (int i = 0; i < 16; ++i) Cs[i] = fmaxf(Ls[i], dppself<0xB1, 0xF>(Ls[15 - i]));
#pragma unroll
      for (int d = 8; d >= 1; d >>= 1)
#pragma unroll
        for (int i = 0; i < 16; ++i)
          if ((i & d) == 0) { float hi = fmaxf(Cs[i], Cs[i + d]), lo = fminf(Cs[i], Cs[i + d]); Cs[i] = hi; Cs[i + d] = lo; }
      float Ds[16];
#pragma unroll
      for (int i = 0; i < 16; ++i) Ds[i] = fmaxf(Cs[i], dppself<0x4E, 0xF>(Cs[15 - i]));
#pragma unroll
      for (int d = 8; d >= 1; d >>= 1)
#pragma unroll
        for (int i = 0; i < 16; ++i)
          if ((i & d) == 0) { float hi = fmaxf(Ds[i], Ds[i + d]), lo = fminf(Ds[i], Ds[i + d]); Ds[i] = hi; Ds[i + d] = lo; }
      if (S == 0) {
#pragma unroll
        for (int i = 0; i < 16; ++i) keep[pass][i] = Ds[i];
      } else if (q == 0) {
        float* d1 = L1s + (pass * 64 + rl) * 16;
        float* d2 = L2s + (pass * 64 + rl) * 16;
#pragma unroll
        for (int i = 0; i < 4; ++i) {
          *(float4*)(d1 + 4 * i) = make_float4(keep[pass][4 * i], keep[pass][4 * i + 1], keep[pass][4 * i + 2], keep[pass][4 * i + 3]);
          *(float4*)(d2 + 4 * i) = make_float4(Ds[4 * i], Ds[4 * i + 1], Ds[4 * i + 2], Ds[4 * i + 3]);
        }
      }
    }
    if (S == 1) {
      __syncthreads();
      const int lane = tid & 63, wid = tid >> 6;
      int ci, cj;
      peer_cand_ij(lane, ci, cj);
      const bool cand = lane < 50;
      float n1 = L1s[(wid * 32) * 16 + ci], n2 = L2s[(wid * 32) * 16 + cj];
#pragma unroll 1
      for (int r = 0; r < 32; ++r) {
        const int row = wid * 32 + r;
        const float v1 = n1, v2 = n2;
        if (r + 1 < 32) { n1 = L1s[(row + 1) * 16 + ci]; n2 = L2s[(row + 1) * 16 + cj]; }
        float val = v1 + v2;
        val = __uint_as_float((__float_as_uint(val) & ~63u) | (unsigned)lane);
        val = cand ? val : -3e38f;
        int rank = 0;
#pragma unroll
        for (int q = 0; q < 50; ++q) rank += (readlane_f(val, q) > val) ? 1 : 0;
        const bool sel = cand && rank < 16;
        const float mx = readlane_f(val, 0);
        const float ex = sel ? __expf(val - mx) : 0.f;
        const float sm = wave_sum(ex);
        if (sel) {
          const int e = (int)(__float_as_uint(v1) & 127u) * 128 + (int)(__float_as_uint(v2) & 127u);
          const size_t o = (size_t)(row0 + row) * 128 + head * 16 + rank;
          p.EL[o] = (unsigned short)e;
          p.GT[o] = ex / sm;
        }
      }
    }
  }
};
DEV void ph_gemm3(const P& p, char* smem) {
  int rt, hd;
  for (int it = 0; gemm_unit(it, 8, rt, hd); ++it) {
    float keep[2][16];
    {
      Epi3K<0> epi{p, rt * 128, hd, keep};
      gemm_tile(p.H + (size_t)rt * 128 * D, D, p.Wft + (size_t)(2 * hd) * 128 * D, D, D, smem, epi);
    }
    {
      Epi3K<1> epi{p, rt * 128, hd, keep};
      gemm_tile(p.H + (size_t)rt * 128 * D, D, p.Wft + (size_t)(2 * hd + 1) * 128 * D, D, D, smem, epi);
    }
  }
}

DEV float peer_gate(float scr) {
  float mx = row16_max(scr);
  float ex = __expf(scr - mx);
  float sm = row16_sum(ex);
  return ex / sm;
}
DEV float gelu_exact(float x) { return 0.5f * x * (1.f + erff(x * 0.7071067811865476f)); }

struct PeerPre { uint4 e0, e1, a0, a1; };
DEV unsigned peer_eid(const PeerPre& s, int j) {
  const unsigned w = (j < 8) ? ((j >> 1) == 0 ? s.e0.x : (j >> 1) == 1 ? s.e0.y : (j >> 1) == 2 ? s.e0.z : s.e0.w)
                             : (((j - 8) >> 1) == 0 ? s.e1.x : ((j - 8) >> 1) == 1 ? s.e1.y : ((j - 8) >> 1) == 2 ? s.e1.z : s.e1.w);
  return (j & 1) ? (w >> 16) : (w & 0xFFFFu);
}
template <int WHICH>
DEV void peer_wave_run(const P& p, int layer, int x, int tok0, int lane, float* wbuf) {
  const int r = lane >> 3, c = lane & 7;
  const unsigned char* tb = (WHICH == 0 ? p.PU : p.PV) + (size_t)x * PSLICE + c * 16;
  PeerPre S[3];
  uint4 R[16];
  auto ld_pre = [&](int tok, PeerPre& s) {
    const uint4* elp = (const uint4*)(p.EL + (size_t)tok * 128 + r * 16);
    s.e0 = elp[0]; s.e1 = elp[1];
    if (WHICH == 0) {
      s.a0 = *(const uint4*)(p.H8 + (size_t)tok * 1024 + x * 128 + c * 16);
    } else {
      const uint4* wtp = (const uint4*)(p.GW + (size_t)tok * 128 + r * 16);
      s.a0 = wtp[0]; s.a1 = wtp[1];
    }
  };
  auto comp = [&](int tok, const PeerPre& s, const PeerPre& sn, bool more) {
    if (WHICH == 0) {
      int keep0 = 0, keep1 = 0;
#pragma unroll
      for (int j = 0; j < 16; ++j) {
        const uint4 rw = R[j];
        if (more) R[j] = *(const uint4*)(tb + (size_t)peer_eid(sn, j) * 128);
        int d = __builtin_amdgcn_sdot4((int)rw.x, (int)s.a0.x, 0, false);
        d = __builtin_amdgcn_sdot4((int)rw.y, (int)s.a0.y, d, false);
        d = __builtin_amdgcn_sdot4((int)rw.z, (int)s.a0.z, d, false);
        d = __builtin_amdgcn_sdot4((int)rw.w, (int)s.a0.w, d, false);
        d += __builtin_amdgcn_update_dpp(0, d, 0xB1, 0xF, 0xF, false);
        d += __builtin_amdgcn_update_dpp(0, d, 0x4E, 0xF, 0xF, false);
        d += __builtin_amdgcn_update_dpp(0, d, 0x141, 0xF, 0xF, false);
        if (j < 8) keep0 = (c == j) ? d : keep0; else keep1 = (c == j - 8) ? d : keep1;
      }
      bf16_t* pd = p.PD + ((size_t)x * NTOK + tok) * 128 + r * 16 + c;
      pd[0] = f2bf((float)keep0); pd[8] = f2bf((float)keep1);
    } else {
      float wsv[16];
      unpack8(s.a0, wsv); unpack8(s.a1, wsv + 8);
      f32x2 acc2[8];
#pragma unroll
      for (int i = 0; i < 8; ++i) acc2[i] = (f32x2){0.f, 0.f};
#pragma unroll
      for (int j = 0; j < 16; ++j) {
        f32x2 f[8];
        unpack16_fp8x2(R[j], f);
        if (more) R[j] = *(const uint4*)(tb + (size_t)peer_eid(sn, j) * 128);
        const f32x2 w2 = (f32x2){wsv[j], wsv[j]};
#pragma unroll
        for (int i = 0; i < 8; ++i) acc2[i] += w2 * f[i];
      }
      float* slab = wbuf + (r * 8 + c) * 16;
      *(float4*)(slab) = make_float4(acc2[0][0], acc2[0][1], acc2[1][0], acc2[1][1]);
      *(float4*)(slab + 4) = make_float4(acc2[2][0], acc2[2][1], acc2[3][0], acc2[3][1]);
      *(float4*)(slab + 8) = make_float4(acc2[4][0], acc2[4][1], acc2[5][0], acc2[5][1]);
      *(float4*)(slab + 12) = make_float4(acc2[6][0], acc2[6][1], acc2[7][0], acc2[7][1]);
      asm volatile("s_waitcnt lgkmcnt(0)" ::: "memory");
      float o0 = 0.f, o1 = 0.f;
#pragma unroll
      for (int rr = 0; rr < 8; ++rr) {
        const float2 t = *(const float2*)(wbuf + (rr * 8 + (lane >> 3)) * 16 + 2 * (lane & 7));
        o0 += t.x; o1 += t.y;
      }
      asm volatile("s_waitcnt lgkmcnt(0)" ::: "memory");
      const int b = tok / LT, pp = tok % LT;
      const int mr = pp < LC ? 16 : b;
      const int col = x * 128 + 2 * lane;
      const float* g2 = p.modv + ((size_t)layer * 17 + mr) * 6144 + 5120 + col;
      unsigned* xp = (unsigned*)(p.X + (size_t)tok * D + col);
      const unsigned xu = *xp;
      *xp = pack2(bflo(xu) + g2[0] * o0, bfhi(xu) + g2[1] * o1);
    }
  };
  ld_pre(tok0, S[0]);
  ld_pre(tok0 + 1, S[1]);
#pragma unroll
  for (int j = 0; j < 16; ++j) R[j] = *(const uint4*)(tb + (size_t)peer_eid(S[0], j) * 128);
  ld_pre(tok0 + 2, S[2]);
#pragma unroll
  for (int t = 0; t < 8; ++t) {
    comp(tok0 + t, S[t % 3], S[(t + 1) % 3], t + 1 < 8);
    if (t + 3 < 8) ld_pre(tok0 + t + 3, S[t % 3]);
  }
}
DEV void ph_peer_w(const P& p) {
  for (size_t i8 = (size_t)bid_() * 256 + tid_(); i8 < (size_t)NTOK * 16; i8 += (size_t)gridDim.x * 256) {
    const size_t i = i8 * 8;
    float d[8];
#pragma unroll
    for (int q = 0; q < 8; ++q) d[q] = 0.f;
#pragma unroll
    for (int x = 0; x < 8; ++x) {
      const uint4 u = *(const uint4*)(p.PD + (size_t)x * NTOK * 128 + i);
      float f[8];
      unpack8(u, f);
#pragma unroll
      for (int q = 0; q < 8; ++q) d[q] += f[q];
    }
    const uint4 eu = *(const uint4*)(p.EL + i);
    const unsigned ew[4] = {eu.x, eu.y, eu.z, eu.w};
    const float hinv = p.HINV[i >> 7];
    float4 g0 = *(const float4*)(p.GT + i), g1 = *(const float4*)(p.GT + i + 4);
    float g[8] = {g0.x, g0.y, g0.z, g0.w, g1.x, g1.y, g1.z, g1.w};
#pragma unroll
    for (int q = 0; q < 8; ++q) {
      const unsigned e = (q & 1) ? (ew[q >> 1] >> 16) : (ew[q >> 1] & 0xFFFFu);
      g[q] = g[q] * gelu_exact(d[q] * p.PSU[e] * hinv) * p.PSV[e];
    }
    *(uint4*)(p.GW + i) = pack8(g);
  }
}
template <int WHICH>
DEV void ph_peer_gather(const P& p, int layer, char* smem, volatile LAS unsigned* slot) {
  const int tid = tid_(), lane = tid & 63, wid = tid >> 6;
  unsigned* q = p.wq + 1024 + layer * 256 + WHICH * 128;
  const int my = (int)(xb_xcc_id() & 7u);
  float* wbuf = (float*)smem + wid * 1024;
#pragma unroll 1
  for (int rot = 0; rot < 8; ++rot) {
    const int x = (my + rot) & 7;
    for (;;) {
      __syncthreads();
      if (tid == 0) *slot = atomicAdd(q + x * 16, 1u);
      __syncthreads();
      const int it = (int)*slot;
      if (it >= NTOK / 64) break;
      peer_wave_run<WHICH>(p, layer, x, it * 64 + wid * 16, lane, wbuf);
      peer_wave_run<WHICH>(p, layer, x, it * 64 + wid * 16 + 8, lane, wbuf);
    }
  }
}

DEV void ph_final(const P& p) {
  const int lane = tid_() & 63;
  int r0, r1;
  wave_range(r0, r1, NB * T);
  float gv[16];
#pragma unroll
  for (int hh = 0; hh < 2; ++hh)
#pragma unroll
    for (int i = 0; i < 8; ++i) gv[hh * 8 + i] = p.final_g[hh * 512 + 8 * lane + i];
  auto xrow = [&](int r) -> const bf16_t* { const int b = r / T, t = r % T; return p.X + ((size_t)b * LT + LC + t) * D; };
  uint4 n0 = make_uint4(0, 0, 0, 0), n1 = n0;
  if (r0 < r1) { const bf16_t* xr = xrow(r0); n0 = *(const uint4*)(xr + 8 * lane); n1 = *(const uint4*)(xr + 512 + 8 * lane); }
#pragma unroll 1
  for (int r = r0; r < r1; ++r) {
    const uint4 u0 = n0, u1 = n1;
    if (r + 1 < r1) { const bf16_t* xr = xrow(r + 1); n0 = *(const uint4*)(xr + 8 * lane); n1 = *(const uint4*)(xr + 512 + 8 * lane); }
    float v[16];
    unpack8(u0, v); unpack8(u1, v + 8);
    float ss = 0.f;
#pragma unroll
    for (int i = 0; i < 16; ++i) ss += v[i] * v[i];
    ss = wave_sum(ss);
    const float rstd = rsqrtf(ss * (1.f / 1024.f) + 1e-6f);
    float* o = p.out + (size_t)r * D;
#pragma unroll
    for (int hh = 0; hh < 2; ++hh) {
      const int col = hh * 512 + 8 * lane;
      *(float4*)(o + col) = make_float4(v[hh * 8 + 0] * rstd * gv[hh * 8 + 0], v[hh * 8 + 1] * rstd * gv[hh * 8 + 1], v[hh * 8 + 2] * rstd * gv[hh * 8 + 2], v[hh * 8 + 3] * rstd * gv[hh * 8 + 3]);
      *(float4*)(o + col + 4) = make_float4(v[hh * 8 + 4] * rstd * gv[hh * 8 + 4], v[hh * 8 + 5] * rstd * gv[hh * 8 + 5], v[hh * 8 + 6] * rstd * gv[hh * 8 + 6], v[hh * 8 + 7] * rstd * gv[hh * 8 + 7]);
    }
  }
}

DEV unsigned hw_cu_key() {
  const unsigned hwid = (unsigned)__builtin_amdgcn_s_getreg(((8 - 1) << 11) | (8 << 6) | 4);
  return (xb_xcc_id() << 8) | (hwid & 0xFFu);
}
DEV void mixB(const P& p, int layer, char* smem, volatile LAS unsigned* slot) {
  unsigned* qa = p.wq + layer * 64;
  unsigned* qs = qa + 16;
  unsigned* claim = p.cuclaim + layer * 4096;
  __syncthreads();
  if (tid_() == 0) {
    unsigned u = 0xFFFFFFFFu;
    if (atomicAdd(&claim[hw_cu_key() & 4095u], 1u) == 0u) u = atomicAdd(qs, 1u);
    *slot = u;
  }
  __syncthreads();
  {
    const unsigned u = *slot;
    if (u < 128u) scanc_unit(p, layer, (int)u, smem);
  }
  for (;;) {
    __syncthreads();
    if (tid_() == 0) *slot = atomicAdd(qa, 1u);
    __syncthreads();
    const int u = (int)*slot;
    if (u >= 8704) break;
    if (u < 4352) attn_unit(p, layer, u, smem); else hyena_conv_unit(p, layer, u - 4352, smem);
  }
  if (layer + 1 < DEPTH) {
    unsigned* qp = qa + 32;
    for (;;) {
      __syncthreads();
      if (tid_() == 0) *slot = atomicAdd(qp, 1u);
      __syncthreads();
      const int u = (int)*slot;
      if (u >= PREPA_N) break;
      prep_unit(p, layer + 1, prepA_unit_index(u), smem);
    }
  }
  for (;;) {
    __syncthreads();
    if (tid_() == 0) *slot = atomicAdd(qs, 1u);
    __syncthreads();
    const unsigned u = *slot;
    if (u >= 128u) break;
    scanc_unit(p, layer, (int)u, smem);
  }
}
DEV void mixA(const P& p, int layer, char* smem) {
  for (int u = bid_(); u < 1088; u += gridDim.x) hyena_pre_unit(p, layer, u);
  ph_lora(p, layer, smem);
  ph_rwkv_prep(p, layer);
}
DEV void mixC(const P& p, int layer, char* smem) {
  for (int u = bid_(); u < 1088; u += gridDim.x) hyena_post_unit(p, layer, u, smem);
  ph_rwkv_post(p, layer);
  ph_attn_post(p, layer);
}

__global__ void __launch_bounds__(256, 2) k_mega(P p) {
  extern __shared__ __attribute__((aligned(16))) char smem_all[];
  char* smem = smem_all;
  volatile LAS unsigned* xbw = (volatile LAS unsigned*)(smem_all + SMEM_BYTES);
  if (threadIdx.x == 0) { xbw[0] = 0u; xbw[1] = 0u; xbw[2] = 0u; xbw[3] = 0u; }
  __syncthreads();
  XcdBarrier bar = xcd_barrier_post(p.bar, xbw);
  ph_copy(p);
  ph_rope(p);
  for (int u = blockIdx.x; u < 96; u += gridDim.x) modv_unit(p, u, smem);
  ph_prep(p, 0, smem, false);
  xcd_barrier(bar);
  for (int layer = 0; layer < DEPTH; ++layer) {
    ph_norm(p, layer, 0);
    xcd_barrier(bar);
    ph_gemm1(p, smem);
    xcd_barrier(bar);
    mixA(p, layer, smem);
    xcd_barrier(bar);
    mixB(p, layer, smem, (volatile LAS unsigned*)(smem_all + SMEM_BYTES + 16));
    xcd_barrier(bar);
    mixC(p, layer, smem);
    xcd_barrier(bar);
    ph_gemm2(p, layer, smem);
    ph_peerconv(p, layer);
    xcd_barrier(bar);
    ph_norm(p, layer, 1);
    xcd_barrier(bar);
    ph_gemm3(p, smem);
    xcd_barrier(bar);
    ph_peer_gather<0>(p, layer, smem, (volatile LAS unsigned*)(smem_all + SMEM_BYTES + 16));
    xcd_barrier(bar);
    ph_peer_w(p);
    xcd_barrier(bar);
    ph_peer_gather<1>(p, layer, smem, (volatile LAS unsigned*)(smem_all + SMEM_BYTES + 16));
    if (layer + 1 < DEPTH) ph_prep(p, layer + 1, smem, true);
    xcd_barrier(bar);
  }
  ph_final(p);
}

static inline size_t al256(size_t x) { return (x + 255) & ~(size_t)255; }

extern "C" void kernel_launch(void* const* d_in, const int* in_sizes, int n_in, void* d_out, int out_size, void* d_ws, size_t ws_size,
                              hipStream_t stream) {
  (void)in_sizes; (void)n_in; (void)out_size; (void)ws_size;
  P p{};
  const float** f = (const float**)&p;
  for (int i = 0; i < 39; ++i) f[i] = (const float*)d_in[i];
  p.out = (float*)d_out;
  char* w = (char*)d_ws;
  size_t off = 0;
  auto take = [&](size_t bytes) { char* r = w + off; off += al256(bytes); return r; };
  p.bar = (unsigned*)take(16384);
  p.modv = (float*)take((size_t)DEPTH * 17 * 6144 * 4);
  p.SSQ = (float*)take((size_t)DEPTH * 2 * 256 * 4);
  p.wq = (unsigned*)take(4096 + DEPTH * 1024);
  p.cuclaim = (unsigned*)take((size_t)DEPTH * 4096 * 4);
  const size_t zero_bytes = off;
  p.rope = (float*)take(64 * 16 * 2 * 4);
  p.X = (bf16_t*)take((size_t)NTOK * D * 2);
  p.H = (bf16_t*)take((size_t)NTOK * D * 2);
  p.Y = (bf16_t*)take((size_t)NTOK * D * 2);
  p.SC = (bf16_t*)take((size_t)NTOK * 1024 * 2);
  p.Z = (bf16_t*)take((size_t)NTOK * INW * 2);
  p.UTl = (bf16_t*)take((size_t)256 * 16 * T * 2);
  p.UTc = (bf16_t*)take((size_t)256 * 16 * LC * 2);
  p.YTl = (bf16_t*)take((size_t)256 * 16 * T * 2);
  p.YTc = (bf16_t*)take((size_t)256 * 16 * LC * 2);
  p.FL = (float*)take((size_t)256 * 2 * T * 4);
  p.FC = (float*)take((size_t)256 * 2 * LC * 4);
  p.W1t = (bf16_t*)take((size_t)INW * D * 2);
  p.W2t = (bf16_t*)take((size_t)D * D * 2);
  p.Wft = (bf16_t*)take((size_t)2048 * D * 2);
  p.Wlt = (bf16_t*)take((size_t)1024 * 256 * 2);
  p.Wgt = (bf16_t*)take((size_t)256 * 128 * 2);
  p.TK = (float*)p.Z;
  p.PU = (unsigned char*)p.Z + al256((size_t)NTOK * 256 * 4);
  p.PV = p.PU + (size_t)16384 * 1024;
  p.PSU = (float*)(p.PV + (size_t)16384 * 1024);
  p.PSV = p.PSU + 16384;
  p.GT = p.PSV + 16384;
  p.EL = (unsigned short*)(p.GT + (size_t)NTOK * 128);
  p.H8 = (unsigned char*)p.EL + al256((size_t)NTOK * 128 * 2);
  p.HINV = (float*)(p.H8 + (size_t)NTOK * 1024);
  p.GW = (bf16_t*)((char*)p.HINV + al256((size_t)NTOK * 4));
  p.PD = p.Y;

  (void)hipMemsetAsync(d_ws, 0, zero_bytes, stream);
  constexpr size_t kDynLds = SMEM_BYTES + 32;
  static int grid = 0;
  if (!grid) {
    int dev = 0, cus = 0, per_cu = 0;
    (void)hipGetDevice(&dev);
    (void)hipDeviceGetAttribute(&cus, hipDeviceAttributeMultiprocessorCount, dev);
    (void)hipFuncSetAttribute((const void*)k_mega, hipFuncAttributeMaxDynamicSharedMemorySize, (int)kDynLds);
    (void)hipOccupancyMaxActiveBlocksPerMultiprocessor(&per_cu, k_mega, 256, kDynLds);
    if (cus <= 0) cus = 256;
    if (per_cu > 2) per_cu = 2;
    if (per_cu < 1) per_cu = 1;
    grid = cus * per_cu;
  }
  k_mega<<<grid, 256, kDynLds, stream>>>(p);
}
```

```cpp
#include <hip/hip_runtime.h>
#include <stdint.h>
#include <type_traits>

#define DEV __device__ __forceinline__
typedef unsigned short bf16_t;
typedef short bf16x8 __attribute__((ext_vector_type(8)));
typedef float f32x2 __attribute__((ext_vector_type(2)));
constexpr size_t PSLICE = (size_t)16384 * 128;
typedef float f32x4 __attribute__((ext_vector_type(4)));
typedef float f32x16 __attribute__((ext_vector_type(16)));


constexpr int NB = 16, T = 4096, LC = 256, LT = 4352, D = 1024, NTOK = NB * LT, INW = 2688, DEPTH = 4;
constexpr int SMEM_BYTES = 65536;

struct P {
  const float *x, *c, *ctx, *c_ctx, *mod_w, *mod_b, *norm1_g, *norm2_g, *w_in, *conv_w, *conv_b;
  const float *hy_w1, *hy_b1, *hy_w2, *hy_b2, *hy_w3, *hy_b3, *hy_freq, *hy_bias;
  const float *rw_w0, *rw_w_up, *rw_a0, *rw_a_up, *rw_g_up, *rw_k_k, *rw_k_a, *rw_r_k, *rw_ln_w, *rw_ln_b;
  const float *attn_sink, *hy_out_g, *at_out_g, *w_out, *peer_wq, *peer_k1, *peer_k2, *peer_u, *peer_v, *final_g;
  float* out;
  unsigned* bar;
  float *modv, *SSQ, *rope, *FL, *FC, *TK;
  unsigned *wq, *cuclaim;
  bf16_t *X, *H, *Y, *SC, *Z, *UTl, *UTc, *YTl, *YTc;
  bf16_t *W1t, *W2t, *Wft, *Wlt, *Wgt;
  unsigned char *PU, *PV;
  float *PSU, *PSV, *GT, *HINV;
  bf16_t *PD, *GW;
  unsigned short* EL;
  unsigned char* H8;
};

typedef __bf16 hwbf2 __attribute__((ext_vector_type(2)));
DEV unsigned pack2(float a, float b) { f32x2 f = {a, b}; hwbf2 r = __builtin_convertvector(f, hwbf2); return __builtin_bit_cast(unsigned, r); }
DEV bf16_t f2bf(float f) { return (bf16_t)(pack2(f, 0.f) & 0xFFFFu); }
DEV float bf2f(bf16_t h) { return __uint_as_float(((unsigned)h) << 16); }
DEV float bflo(unsigned u) { return __uint_as_float(u << 16); }
DEV float bfhi(unsigned u) { return __uint_as_float(u & 0xFFFF0000u); }
DEV void unpack8(const uint4& u, float* v) {
  v[0] = bflo(u.x); v[1] = bfhi(u.x); v[2] = bflo(u.y); v[3] = bfhi(u.y);
  v[4] = bflo(u.z); v[5] = bfhi(u.z); v[6] = bflo(u.w); v[7] = bfhi(u.w);
}
DEV uint4 pack8(const float* v) { return make_uint4(pack2(v[0], v[1]), pack2(v[2], v[3]), pack2(v[4], v[5]), pack2(v[6], v[7])); }
DEV int pack_i8(float a, float b, float c, float d) {
  const int ia = __float2int_rn(a), ib = __float2int_rn(b), ic = __float2int_rn(c), id = __float2int_rn(d);
  return (ia & 0xFF) | ((ib & 0xFF) << 8) | ((ic & 0xFF) << 16) | ((id & 0xFF) << 24);
}
DEV float sigmoidf_(float x) { return __builtin_amdgcn_rcpf(1.f + __expf(-x)); }

template <int CTRL, int ROWMASK>
DEV float dpp0(float x) {
  return __builtin_bit_cast(float, __builtin_amdgcn_update_dpp(0, __builtin_bit_cast(int, x), CTRL, ROWMASK, 0xF, false));
}
template <int CTRL, int ROWMASK>
DEV float dppself(float x) {
  int xi = __builtin_bit_cast(int, x);
  return __builtin_bit_cast(float, __builtin_amdgcn_update_dpp(xi, xi, CTRL, ROWMASK, 0xF, false));
}
DEV float readlane_f(float x, int l) { return __builtin_bit_cast(float, __builtin_amdgcn_readlane(__builtin_bit_cast(int, x), l)); }
DEV int lane_id() { return (int)__builtin_amdgcn_mbcnt_hi(~0u, __builtin_amdgcn_mbcnt_lo(~0u, 0u)); }
DEV float writelane_f(float val, int l, float old) { return lane_id() == l ? val : old; }
DEV int writelane_i(int val, int l, int old) { return lane_id() == l ? val : old; }
DEV float wave_sum(float x) {
  x += dpp0<0x111, 0xF>(x); x += dpp0<0x112, 0xF>(x); x += dpp0<0x114, 0xF>(x); x += dpp0<0x118, 0xF>(x);
  x += dpp0<0x142, 0xA>(x); x += dpp0<0x143, 0xC>(x);
  return readlane_f(x, 63);
}
DEV float wave_max(float x) {
  x = fmaxf(x, dppself<0x111, 0xF>(x)); x = fmaxf(x, dppself<0x112, 0xF>(x)); x = fmaxf(x, dppself<0x114, 0xF>(x));
  x = fmaxf(x, dppself<0x118, 0xF>(x)); x = fmaxf(x, dppself<0x142, 0xA>(x)); x = fmaxf(x, dppself<0x143, 0xC>(x));
  return readlane_f(x, 63);
}
DEV float row16_sum(float x) {
  x += dpp0<0xB1, 0xF>(x); x += dpp0<0x4E, 0xF>(x); x += dpp0<0x141, 0xF>(x); x += dpp0<0x140, 0xF>(x);
  return x;
}
DEV float row16_max(float x) {
  x = fmaxf(x, dppself<0xB1, 0xF>(x)); x = fmaxf(x, dppself<0x4E, 0xF>(x)); x = fmaxf(x, dppself<0x141, 0xF>(x));
  x = fmaxf(x, dppself<0x140, 0xF>(x));
  return x;
}
DEV float quad_sum(float x) { x += dpp0<0xB1, 0xF>(x); x += dpp0<0x4E, 0xF>(x); return x; }

DEV f32x4 mfma16(bf16x8 a, bf16x8 b, f32x4 c) { return __builtin_amdgcn_mfma_f32_16x16x32_bf16(a, b, c, 0, 0, 0); }
DEV f32x16 mfma32(bf16x8 a, bf16x8 b, f32x16 c) { return __builtin_amdgcn_mfma_f32_32x32x16_bf16(a, b, c, 0, 0, 0); }


#define XB_TMO      128
#define XB_XCNT(j)  (256  + 64 * (j))
#define XB_XSUB(j)  (1280 + 64 * (j))
#define XB_XGEN(j)  (2304 + 64 * (j))
#define XB_TOP      3328
#define XB_TOPGEN   3392
#define XCD_BAR_WORDS 3456
#define XB_SPIN_CAP (1u << 23)
#define LAS __attribute__((address_space(3)))

__device__ __forceinline__ unsigned xb_ld(unsigned* p)              { return __hip_atomic_load(p, __ATOMIC_RELAXED, __HIP_MEMORY_SCOPE_AGENT); }
__device__ __forceinline__ unsigned xb_add(unsigned* p, unsigned v) { return __hip_atomic_fetch_add(p, v, __ATOMIC_RELAXED, __HIP_MEMORY_SCOPE_AGENT); }
__device__ __forceinline__ unsigned xb_xcc_id() { return (unsigned)__builtin_amdgcn_s_getreg((3 << 11) | 20) & 0xFu; }
#define XB_SPIN(cond, bar) do { unsigned _sp = 0; while (cond) { __builtin_amdgcn_s_sleep(1); \
    if ((++_sp & 255u) == 0u) { if (xb_ld(&(bar)[XB_TMO])) break; if (_sp > XB_SPIN_CAP) { atomicAdd(&(bar)[XB_TMO], 1u); break; } } } } while (0)

struct XcdBarrier {
    unsigned* bar; unsigned x;
    volatile LAS unsigned* st;
};
__device__ __forceinline__ XcdBarrier xcd_barrier_post(unsigned* bar, volatile LAS unsigned* st) {
    XcdBarrier b; b.bar = bar; b.x = xb_xcc_id(); b.st = st;
    if (threadIdx.x == 0) (void)xb_add(&bar[XB_XCNT(b.x)], 1u);
    return b;
}
__device__ __forceinline__ void xcd_barrier_complete(unsigned* bar, unsigned x, unsigned& nloc, unsigned& nx) {
    const unsigned G = gridDim.x * gridDim.y * gridDim.z;
    unsigned sum, cnt, mine, sp = 0u;
    for (;;) {
        sum = 0u; cnt = 0u; mine = 0u;
#pragma unroll
        for (unsigned j = 0; j < 16; ++j) { const unsigned c = xb_ld(&bar[XB_XCNT(j)]); sum += c; cnt += (c > 0u) ? 1u : 0u; mine = (j == x) ? c : mine; }
        if (sum == G) break;
        __builtin_amdgcn_s_sleep(1);
        if ((++sp & 255u) == 0u) { if (xb_ld(&bar[XB_TMO])) break; if (sp > XB_SPIN_CAP) { atomicAdd(&bar[XB_TMO], 1u); break; } }
    }
    nloc = mine > 0u ? mine : 1u; nx = cnt > 0u ? cnt : 1u;
}
__device__ __forceinline__ void xcd_barrier(const XcdBarrier& b) {
    asm volatile("s_waitcnt vmcnt(0)" ::: "memory");
    __syncthreads();
    if (threadIdx.x == 0) {
        unsigned* bar = b.bar;
        __builtin_amdgcn_s_waitcnt(0);
        unsigned nloc = b.st[0], nx = b.st[1];
        if (nloc == 0u) { xcd_barrier_complete(bar, b.x, nloc, nx); b.st[0] = nloc; b.st[1] = nx; }
        const unsigned old = xb_add(&bar[XB_XSUB(b.x)], 1u);
        const unsigned gen = old / nloc;
        if (old + 1u == (gen + 1u) * nloc) {
            __builtin_amdgcn_fence(__ATOMIC_RELEASE, "agent");
            asm volatile("s_waitcnt vmcnt(0)" ::: "memory");
            const unsigned og = xb_add(&bar[XB_TOP], 1u);
            const unsigned tg = og / nx;
            if (og + 1u == (tg + 1u) * nx) xb_add(&bar[XB_TOPGEN], 1u);
            else XB_SPIN(xb_ld(&bar[XB_TOPGEN]) == tg, bar);
            __builtin_amdgcn_fence(__ATOMIC_ACQUIRE, "agent");
            xb_add(&bar[XB_XGEN(b.x)], 1u);
            asm volatile("s_waitcnt vmcnt(0)" ::: "memory");
        } else {
            XB_SPIN(xb_ld(&bar[XB_XGEN(b.x)]) == gen, bar);
            __builtin_amdgcn_fence(__ATOMIC_ACQUIRE, "agent");
            asm volatile("s_waitcnt vmcnt(0)" ::: "memory");
        }
    }
    __syncthreads();
}

template <class Tp> DEV Tp* opq(Tp* q) { asm volatile("" : "+s"(q)); return q; }
DEV int tid_() { int t = threadIdx.x; asm volatile("" : "+v"(t)); return t; }
DEV int bid_() { int b = blockIdx.x; asm volatile("" : "+s"(b)); return b; }

DEV void glds16(const void* gsrc, char* lds_lane_ptr) {
  __builtin_amdgcn_global_load_lds((const unsigned*)gsrc, (__attribute__((address_space(3))) unsigned*)lds_lane_ptr, 16, 0, 0);
}
template <class Epi>
DEV void gemm_tile(const bf16_t* __restrict__ A, int lda, const bf16_t* __restrict__ Bt, int ldb, int K, char* smem, Epi& epi) {
  const int tid = tid_(), lane = tid & 63, wid = tid >> 6, wr = wid >> 1, wc = wid & 1, fr = lane & 15, fq = lane >> 4;
  f32x4 acc[4][4];
#pragma unroll
  for (int m = 0; m < 4; ++m)
#pragma unroll
    for (int n = 0; n < 4; ++n) acc[m][n] = (f32x4){0.f, 0.f, 0.f, 0.f};
  const int drow0 = 8 * wid + (lane >> 3), dpc = lane & 7;
  auto issue = [&](int kt, int buf) {
    char* sa = smem + buf * 32768;
    char* sb = sa + 16384;
#pragma unroll
    for (int i = 0; i < 4; ++i) {
      const int row = drow0 + 32 * i;
      const int kc = dpc ^ ((row >> 1) & 7);
      glds16(A + (size_t)row * lda + kt * 64 + kc * 8, sa + (i * 4 + wid) * 1024 + lane * 16);
      glds16(Bt + (size_t)row * ldb + kt * 64 + kc * 8, sb + (i * 4 + wid) * 1024 + lane * 16);
    }
  };
  __syncthreads();
  issue(0, 0);
  const int nk = K >> 6;
  const int sw = (fr >> 1) & 7;
  const int aoff = (wr * 64 + fr) * 128, boff = (wc * 64 + fr) * 128;
  for (int kt = 0; kt < nk; ++kt) {
    asm volatile("s_waitcnt vmcnt(0)" ::: "memory");
    __syncthreads();
    if (kt + 1 < nk) issue(kt + 1, (kt + 1) & 1);
    const char* sa = smem + (kt & 1) * 32768;
    const char* sb = sa + 16384;
#pragma unroll
    for (int kh = 0; kh < 2; ++kh) {
      const int pc = ((kh * 4 + fq) ^ sw) * 16;
      bf16x8 af[4], bfr[4];
#pragma unroll
      for (int m = 0; m < 4; ++m) af[m] = *(const bf16x8*)(sa + aoff + m * 2048 + pc);
#pragma unroll
      for (int n = 0; n < 4; ++n) bfr[n] = *(const bf16x8*)(sb + boff + n * 2048 + pc);
#pragma unroll
      for (int m = 0; m < 4; ++m)
#pragma unroll
        for (int n = 0; n < 4; ++n) acc[m][n] = mfma16(bfr[n], af[m], acc[m][n]);
    }
  }
  __syncthreads();
  epi(acc, wr, wc, fr, fq, smem);
}
DEV void stage_tile_bf16(const f32x4 (&acc)[4][4], char* smem, int wid, int fr, int fq) {
  bf16_t (*t)[72] = (bf16_t (*)[72])(smem + wid * 9216);
#pragma unroll
  for (int m = 0; m < 4; ++m)
#pragma unroll
    for (int n = 0; n < 4; ++n)
      *(uint2*)&t[m * 16 + fr][n * 16 + 4 * fq] = make_uint2(pack2(acc[m][n][0], acc[m][n][1]), pack2(acc[m][n][2], acc[m][n][3]));
  asm volatile("s_waitcnt lgkmcnt(0)" ::: "memory");
}

DEV void ph_copy(const P& p) {
  const size_t n8 = (size_t)NTOK * D / 8;
  const float* pctx = opq(p.ctx); const float* px = opq(p.x);
  for (size_t i = (size_t)bid_() * 256 + tid_(); i < n8; i += (size_t)gridDim.x * 256) {
    size_t e = i * 8;
    int row = (int)(e / D), col = (int)(e % D);
    int b = row / LT, pp = row % LT;
    const float* src = pp < LC ? pctx + ((size_t)(b * LC + pp)) * D + col : px + ((size_t)(b * T + pp - LC)) * D + col;
    float4 v0 = *(const float4*)src, v1 = *(const float4*)(src + 4);
    uint4 o = make_uint4(pack2(v0.x, v0.y), pack2(v0.z, v0.w), pack2(v1.x, v1.y), pack2(v1.z, v1.w));
    *(uint4*)(p.X + e) = o;
  }
}

DEV void ph_rope(const P& p) {
  for (int i = bid_() * 256 + tid_(); i < 64 * 16; i += gridDim.x * 256) {
    int pos = i >> 4, k = i & 15;
    float inv = powf(10000.f, -(float)k / 16.f);
    float ang = (float)pos * inv;
    p.rope[2 * i] = cosf(ang); p.rope[2 * i + 1] = sinf(ang);
  }
}

DEV void modv_unit(const P& p, int unit, char* smem) {
  const int cc = unit % 24, layer = unit / 24;
  float (*cs)[128] = (float (*)[128])smem;
  const int col = cc * 256 + tid_();
  const float* pc = opq(p.c); const float* pcc = opq(p.c_ctx);
  float acc[17];
#pragma unroll
  for (int r = 0; r < 17; ++r) acc[r] = 0.f;
  for (int ks = 0; ks < 8; ++ks) {
    __syncthreads();
    for (int i = tid_(); i < 17 * 128; i += 256) {
      int r = i >> 7, e = i & 127;
      float v = r < 16 ? pc[r * D + ks * 128 + e] : pcc[ks * 128 + e];
      cs[r][e] = v / (1.f + expf(-v));
    }
    __syncthreads();
    const float* w = p.mod_w + ((size_t)layer * D + ks * 128) * 6144 + col;
#pragma unroll 1
    for (int e0 = 0; e0 < 128; e0 += 32) {
      float wv[32];
#pragma unroll
      for (int q = 0; q < 32; ++q) wv[q] = w[(size_t)(e0 + q) * 6144];
#pragma unroll
      for (int q4 = 0; q4 < 8; ++q4) {
      const int e = e0 + 4 * q4;
      const float w0 = wv[4 * q4], w1 = wv[4 * q4 + 1], w2 = wv[4 * q4 + 2], w3 = wv[4 * q4 + 3];
#pragma unroll
      for (int r = 0; r < 17; ++r) {
        const float4 cv = *(const float4*)&cs[r][e];
        acc[r] += cv.x * w0 + cv.y * w1 + cv.z * w2 + cv.w * w3;
      }
      }
    }
  }
  const float bias = p.mod_b[layer * 6144 + col];
#pragma unroll
  for (int r = 0; r < 17; ++r) p.modv[((size_t)layer * 17 + r) * 6144 + col] = acc[r] + bias;
}

DEV void transpose_unit(const float* __restrict__ src, bf16_t* __restrict__ dst, int R, int C, int tile, char* smem) {
  float (*t)[65] = (float (*)[65])smem;
  const int nct = C / 64;
  const int tr = tile / nct, tc = tile % nct;
  __syncthreads();
  for (int i = tid_(); i < 4096; i += 256) { int r = i >> 6, c = i & 63; t[r][c] = src[(size_t)(tr * 64 + r) * C + tc * 64 + c]; }
  __syncthreads();
  for (int i = tid_(); i < 4096; i += 256) { int c = i >> 6, r = i & 63; dst[(size_t)(tc * 64 + c) * R + tr * 64 + r] = f2bf(t[r][c]); }
}

DEV void wfold_unit(const P& p, int layer, int unit, char* smem) {
  const int hs = unit >> 5, ec = unit & 31, h = hs >> 1, s = hs & 1;
  const float* wq = p.peer_wq + (size_t)layer * D * 2048;
  const float* kk = (s ? opq(p.peer_k2) : opq(p.peer_k1)) + ((size_t)layer * 8 + h) * 128 * 128;
  float (*kS)[65] = (float (*)[65])smem;
  float (*wS)[64] = (float (*)[64])(smem + 33280);
  const int key = tid_() & 127, eh = tid_() >> 7;
  float acc[16];
#pragma unroll
  for (int i = 0; i < 16; ++i) acc[i] = 0.f;
  for (int dh = 0; dh < 2; ++dh) {
    __syncthreads();
    for (int i = tid_(); i < 128 * 64; i += 256) { int k2 = i >> 6, d = i & 63; kS[k2][d] = kk[k2 * 128 + dh * 64 + d]; }
    for (int i = tid_(); i < 32 * 64; i += 256) {
      int e = i >> 6, d = i & 63;
      wS[e][d] = wq[(size_t)(ec * 32 + e) * 2048 + h * 256 + s * 128 + dh * 64 + d];
    }
    __syncthreads();
#pragma unroll 2
    for (int d = 0; d < 64; d += 4) {
      const float k0 = kS[key][d], k1 = kS[key][d + 1], k2 = kS[key][d + 2], k3 = kS[key][d + 3];
#pragma unroll
      for (int i = 0; i < 16; ++i) {
        const float4 wv = *(const float4*)&wS[eh * 16 + i][d];
        acc[i] += k0 * wv.x + k1 * wv.y + k2 * wv.z + k3 * wv.w;
      }
    }
  }
  bf16_t* dst = p.Wft + ((size_t)(hs * 128 + key)) * D + ec * 32 + eh * 16;
#pragma unroll
  for (int i = 0; i < 16; i += 2) *(unsigned*)(dst + i) = pack2(acc[i], acc[i + 1]);
}

DEV void filt_unit(const P& p, int layer, int unit, char* smem) {
  int kind, j0, L;
  if (unit < 1024) { kind = 0; j0 = unit * 4; L = T; } else { kind = 1; j0 = (unit - 1024) * 4; L = LC; }
  float* zs = (float*)smem;
  float* h1 = zs + 4 * 36;
  float* h2 = h1 + 256;
  const int jj = tid_() >> 6, o = tid_() & 63;
  const int j = j0 + jj;
  const float fj = (float)j;
  const float t = fj / (float)(L - 1);
  __syncthreads();
  if (o < 33) {
    float z;
    if (o == 0) z = t;
    else {
      int i = (o - 1) & 15;
      float band = 1e-4f + (float)i * ((15.0f - 1e-4f) / 15.0f);
      float ang = 6.283185307179586f * fj * band / (float)L;
      z = (o <= 16) ? cosf(ang) : -sinf(ang);
    }
    zs[jj * 36 + o] = z;
  }
  __syncthreads();
  {
    const float* w1 = p.hy_w1 + layer * 33 * 64;
    float a = p.hy_b1[layer * 64 + o];
#pragma unroll 3
    for (int i = 0; i < 33; ++i) a += zs[jj * 36 + i] * w1[i * 64 + o];
    h1[jj * 64 + o] = sinf(p.hy_freq[layer * 128 + o] * a);
  }
  __syncthreads();
  {
    const float* w2 = p.hy_w2 + layer * 64 * 64;
    float a = p.hy_b2[layer * 64 + o];
#pragma unroll 4
    for (int i = 0; i < 64; ++i) a += h1[jj * 64 + i] * w2[i * 64 + o];
    h2[jj * 64 + o] = sinf(p.hy_freq[layer * 128 + 64 + o] * a);
  }
  __syncthreads();
  const float* w3 = p.hy_w3 + layer * 64 * 512;
  float* F = kind ? opq(p.FC) : opq(p.FL);
  const float DMIN = -3.0701134573253945f, DMAX = -15.350567286626973f;
#pragma unroll 1
  for (int m = 0; m < 4; ++m) {
    int c = o + 64 * m;
    float af = p.hy_b3[layer * 512 + c], ab = p.hy_b3[layer * 512 + 256 + c];
#pragma unroll 4
    for (int i = 0; i < 64; ++i) { float hv = h2[jj * 64 + i]; af += hv * w3[i * 512 + c]; ab += hv * w3[i * 512 + 256 + c]; }
    float delta = fabsf(DMIN + (float)c * ((DMAX - DMIN) / 255.f));
    float win = expf(-t * delta) + 0.05f;
    af *= win; ab *= win;
    F[((size_t)c * 2 + 0) * L + j] = af;
    F[((size_t)c * 2 + 1) * L + j] = ab;
  }
}

constexpr int PREP_T0 = 672, PREP_T1 = PREP_T0 + 256, PREP_T2 = PREP_T1 + 8, PREP_T3 = PREP_T2 + 8, PREP_T4 = PREP_T3 + 8;
constexpr int PREP_WF = PREP_T4 + 512, PREP_N = PREP_WF + 1088;
DEV void prep_unit(const P& p, int layer, int u, char* smem) {
  if (u < PREP_T0) transpose_unit(p.w_in + (size_t)layer * D * INW, p.W1t, D, INW, u, smem);
  else if (u < PREP_T1) transpose_unit(p.w_out + (size_t)layer * D * D, p.W2t, D, D, u - PREP_T0, smem);
  else if (u < PREP_T3) {
    const int u0 = u - PREP_T1;
    for (int i = tid_(); i < 64 * 256; i += 256) {
      const int np = u0 * 64 + (i >> 8), kp = i & 255;
      const int ps = np & 3, chan = np >> 2, qp = kp >> 6, kk = kp & 63;
      const int is_a = ps & 1, d = ps >> 1;
      float v = 0.f;
      if (qp == (is_a ? 2 + d : d)) v = (is_a ? opq(p.rw_a_up) : opq(p.rw_w_up))[(((size_t)layer * 2 + d) * 64 + kk) * 256 + chan];
      p.Wlt[(size_t)np * 256 + kp] = f2bf(v);
    }
  }
  else if (u < PREP_T4) transpose_unit(p.rw_g_up + (size_t)layer * 128 * 256, p.Wgt, 128, 256, u - PREP_T3, smem);
  else if (u < PREP_WF) wfold_unit(p, layer, u - PREP_T4, smem);
  else filt_unit(p, layer, u - PREP_WF, smem);
}
constexpr int PREPA_N = PREP_T0 + (PREP_T4 - PREP_T1);
DEV int prepA_unit_index(int i) { return i < PREP_T0 ? i : PREP_T1 + (i - PREP_T0); }
DEV void ph_prep(const P& p, int layer, char* smem, bool onlyB) {
  for (int u = bid_(); u < PREP_N; u += gridDim.x) {
    const bool isA = (u < PREP_T0) || (u >= PREP_T1 && u < PREP_T4);
    if (onlyB && isA) continue;
    prep_unit(p, layer, u, smem);
  }
}

DEV void wave_range(int& r0, int& r1, int ntok) {
  const int gw = (bid_() * 256 + tid_()) >> 6, nw = gridDim.x * 4;
  const int per = (ntok + nw - 1) / nw;
  r0 = gw * per; r1 = r0 + per; if (r1 > ntok) r1 = ntok;
}
DEV void ph_norm_first(const P& p) {
  const int lane = tid_() & 63;
  int r0, r1;
  wave_range(r0, r1, NTOK);
  const float* pctx = opq(p.ctx); const float* px = opq(p.x);
  float gv[16], scv[16], shv[16];
#pragma unroll
  for (int hh = 0; hh < 2; ++hh)
#pragma unroll
    for (int i = 0; i < 8; ++i) gv[hh * 8 + i] = p.norm1_g[hh * 512 + 8 * lane + i];
  int mr_cur = -1;
  auto srcrow = [&](int row) -> const float* {
    const int b = row / LT, pp = row % LT;
    return pp < LC ? pctx + ((size_t)(b * LC + pp)) * D : px + ((size_t)(b * T + pp - LC)) * D;
  };
  float4 n0, n1, n2, n3;
  auto ld = [&](int row) { const float* s0 = srcrow(row) + 8 * lane; n0 = *(const float4*)s0; n1 = *(const float4*)(s0 + 4); n2 = *(const float4*)(s0 + 512); n3 = *(const float4*)(s0 + 516); };
  if (r0 < r1) ld(r0);
#pragma unroll 1
  for (int row = r0; row < r1; ++row) {
    float v[16] = {n0.x, n0.y, n0.z, n0.w, n1.x, n1.y, n1.z, n1.w, n2.x, n2.y, n2.z, n2.w, n3.x, n3.y, n3.z, n3.w};
    if (row + 1 < r1) ld(row + 1);
    const int b = row / LT, pp = row % LT;
    const int mr = pp < LC ? 16 : b;
    if (mr != mr_cur) {
      mr_cur = mr;
      const float* mv = p.modv + (size_t)mr * 6144;
#pragma unroll
      for (int hh = 0; hh < 2; ++hh)
#pragma unroll
        for (int i = 0; i < 8; ++i) { shv[hh * 8 + i] = mv[hh * 512 + 8 * lane + i]; scv[hh * 8 + i] = 1.f + mv[1024 + hh * 512 + 8 * lane + i]; }
    }
    bf16_t* xr = p.X + (size_t)row * D;
    const uint4 x0 = pack8(v), x1 = pack8(v + 8);
    *(uint4*)(xr + 8 * lane) = x0;
    *(uint4*)(xr + 512 + 8 * lane) = x1;
    unpack8(x0, v); unpack8(x1, v + 8);
    float ss = 0.f;
#pragma unroll
    for (int i = 0; i < 16; ++i) ss += v[i] * v[i];
    ss = wave_sum(ss);
    const float rstd = rsqrtf(ss * (1.f / 1024.f) + 1e-6f);
    float o[16];
#pragma unroll
    for (int i = 0; i < 16; ++i) o[i] = (v[i] * rstd * gv[i]) * scv[i] + shv[i];
    bf16_t* hr = p.H + (size_t)row * D;
    *(uint4*)(hr + 8 * lane) = pack8(o);
    *(uint4*)(hr + 512 + 8 * lane) = pack8(o + 8);
  }
}
DEV void ph_norm(const P& p, int layer, int which) {
  const int lane = tid_() & 63;
  int r0, r1;
  wave_range(r0, r1, NTOK);
  const float* g = (which ? p.norm2_g : p.norm1_g) + layer * D;
  float gv[16], scv[16], shv[16];
#pragma unroll
  for (int hh = 0; hh < 2; ++hh)
#pragma unroll
    for (int i = 0; i < 8; ++i) gv[hh * 8 + i] = g[hh * 512 + 8 * lane + i];
  int mr_cur = -1;
  uint4 n0 = make_uint4(0, 0, 0, 0), n1 = n0;
  if (r0 < r1) { const bf16_t* xr = p.X + (size_t)r0 * D; n0 = *(const uint4*)(xr + 8 * lane); n1 = *(const uint4*)(xr + 512 + 8 * lane); }
#pragma unroll 1
  for (int row = r0; row < r1; ++row) {
    const uint4 u0 = n0, u1 = n1;
    if (row + 1 < r1) { const bf16_t* xr = p.X + (size_t)(row + 1) * D; n0 = *(const uint4*)(xr + 8 * lane); n1 = *(const uint4*)(xr + 512 + 8 * lane); }
    const int b = row / LT, pp = row % LT;
    const int mr = pp < LC ? 16 : b;
    if (mr != mr_cur) {
      mr_cur = mr;
      const float* mv = p.modv + ((size_t)layer * 17 + mr) * 6144 + (which ? 3072 : 0);
#pragma unroll
      for (int hh = 0; hh < 2; ++hh)
#pragma unroll
        for (int i = 0; i < 8; ++i) { shv[hh * 8 + i] = mv[hh * 512 + 8 * lane + i]; scv[hh * 8 + i] = 1.f + mv[1024 + hh * 512 + 8 * lane + i]; }
    }
    float v[16];
    unpack8(u0, v); unpack8(u1, v + 8);
    float ss = 0.f;
#pragma unroll
    for (int i = 0; i < 16; ++i) ss += v[i] * v[i];
    ss = wave_sum(ss);
    const float rstd = rsqrtf(ss * (1.f / 1024.f) + 1e-6f);
    float o[16];
#pragma unroll
    for (int i = 0; i < 16; ++i) o[i] = (v[i] * rstd * gv[i]) * scv[i] + shv[i];
    bf16_t* hr = p.H + (size_t)row * D;
    *(uint4*)(hr + 8 * lane) = pack8(o);
    *(uint4*)(hr + 512 + 8 * lane) = pack8(o + 8);
    if (which) {
      float am = 0.f;
#pragma unroll
      for (int i = 0; i < 16; ++i) am = fmaxf(am, fabsf(o[i]));
      am = wave_max(am);
      const float sc = am > 0.f ? 127.f / am : 1.f;
      unsigned char* h8 = p.H8 + (size_t)row * 1024;
      *(uint2*)(h8 + 8 * lane) = make_uint2((unsigned)pack_i8(o[0] * sc, o[1] * sc, o[2] * sc, o[3] * sc), (unsigned)pack_i8(o[4] * sc, o[5] * sc, o[6] * sc, o[7] * sc));
      *(uint2*)(h8 + 512 + 8 * lane) = make_uint2((unsigned)pack_i8(o[8] * sc, o[9] * sc, o[10] * sc, o[11] * sc), (unsigned)pack_i8(o[12] * sc, o[13] * sc, o[14] * sc, o[15] * sc));
      if (lane == 0) p.HINV[row] = am > 0.f ? am * (1.f / 127.f) : 1.f;
    }
  }
}

DEV bool gemm_unit(int it, int nct, int& rt, int& ct) {
  const int nslot = gridDim.x >> 3;
  const int x = bid_() & 7, sl = bid_() >> 3;
  if (sl >= nslot) return false;
  const int v = it * nslot + sl;
  if (v >= 68 * nct) return false;
  const int rg = v / (8 * nct), rem = v - rg * 8 * nct;
  const int rows = (rg == 8) ? 4 : 8;
  ct = rem / rows;
  rt = x * 68 + rg * 8 + (rem - ct * rows);
  return true;
}
struct Epi1 {
  const P& p; int row0, col0;
  DEV void operator()(f32x4 (&acc)[4][4], int wr, int wc, int fr, int fq, char* smem) const {
    const int cw = col0 + wc * 64;
    const int rbase = row0 + wr * 64;
    const bool lat = (row0 % LT) >= LC;
    if (cw >= 1536 && cw < 1664) {
#pragma unroll
      for (int m = 0; m < 4; ++m)
#pragma unroll
        for (int n = 0; n < 4; ++n)
#pragma unroll
          for (int j = 0; j < 4; ++j) acc[m][n][j] = 2.f * sigmoidf_(2.f * acc[m][n][j]) - 1.f;
    } else if (cw >= 1792 && cw < 1920) {
#pragma unroll
      for (int m = 0; m < 4; ++m)
#pragma unroll
        for (int n = 0; n < 4; ++n)
#pragma unroll
          for (int j = 0; j < 4; ++j) acc[m][n][j] = sigmoidf_(acc[m][n][j]);
    } else if (cw >= 1920 && cw < 2560 && lat) {
#pragma unroll
      for (int m = 0; m < 4; ++m) {
        const int row = rbase + m * 16 + fr;
        const int pl = (row % LT) - LC;
        const int ri = pl >> 6, ci = pl & 63;
        const float4* crp = (const float4*)(p.rope + 2 * (ri * 16 + 4 * fq));
        const float4* ccp = (const float4*)(p.rope + 2 * (ci * 16 + 4 * fq));
        const float4 cr0 = crp[0], cr1 = crp[1], cc0 = ccp[0], cc1 = ccp[1];
        const float crc[4] = {cr0.x, cr0.z, cr1.x, cr1.z}, crs[4] = {cr0.y, cr0.w, cr1.y, cr1.w};
        const float ccc[4] = {cc0.x, cc0.z, cc1.x, cc1.z}, ccs[4] = {cc0.y, cc0.w, cc1.y, cc1.w};
#pragma unroll
        for (int j = 0; j < 4; ++j) {
          float x1 = acc[m][0][j], x2 = acc[m][1][j];
          acc[m][0][j] = x1 * crc[j] - x2 * crs[j]; acc[m][1][j] = x2 * crc[j] + x1 * crs[j];
          x1 = acc[m][2][j]; x2 = acc[m][3][j];
          acc[m][2][j] = x1 * ccc[j] - x2 * ccs[j]; acc[m][3][j] = x2 * ccc[j] + x1 * ccs[j];
        }
      }
    }
    const int wid = wr * 2 + wc, lane = fq * 16 + fr;
    stage_tile_bf16(acc, smem, wid, fr, fq);
    const bf16_t (*t)[72] = (const bf16_t (*)[72])(smem + wid * 9216);
#pragma unroll
    for (int i = 0; i < 8; ++i) {
      const int rl = i * 8 + (lane >> 3), ch = lane & 7;
      *(uint4*)(p.Z + (size_t)(rbase + rl) * INW + cw + ch * 8) = *(const uint4*)&t[rl][ch * 8];
    }
  }
};
DEV void ph_gemm1(const P& p, char* smem) {
  const int nct = INW / 128;
  int rt, ct;
  for (int it = 0; gemm_unit(it, nct, rt, ct); ++it) {
    Epi1 epi{p, rt * 128, ct * 128};
    gemm_tile(p.H + (size_t)rt * 128 * D, D, p.W1t + (size_t)ct * 128 * D, D, D, smem, epi);
  }
}

struct EpiLoraA {
  const P& p; int layer, row0, col0;
  DEV void operator()(f32x4 (&acc)[4][4], int wr, int wc, int fr, int fq, char* smem) const {
    const float* w0b = p.rw_w0 + layer * 512;
    const float* a0b = p.rw_a0 + layer * 512;
#pragma unroll
    for (int n = 0; n < 4; ++n) {
      const int chan = ((col0 + wc * 64 + n * 16) >> 2) + fq;
      const float be0 = w0b[chan], ba0 = a0b[chan], be1 = w0b[256 + chan], ba1 = a0b[256 + chan];
#pragma unroll
      for (int m = 0; m < 4; ++m) {
        acc[m][n][0] = 0.6065306597126334f * sigmoidf_(acc[m][n][0] + be0);
        acc[m][n][1] = sigmoidf_(acc[m][n][1] + ba0);
        acc[m][n][2] = 0.6065306597126334f * sigmoidf_(acc[m][n][2] + be1);
        acc[m][n][3] = sigmoidf_(acc[m][n][3] + ba1);
      }
    }
    const int wid = wr * 2 + wc, lane = fq * 16 + fr;
    stage_tile_bf16(acc, smem, wid, fr, fq);
    const bf16_t (*t)[72] = (const bf16_t (*)[72])(smem + wid * 9216);
#pragma unroll
    for (int i = 0; i < 8; ++i) {
      const int rl = i * 8 + (lane >> 3), ch = lane & 7;
      *(uint4*)(p.SC + (size_t)(row0 + wr * 64 + rl) * 1024 + col0 + wc * 64 + ch * 8) = *(const uint4*)&t[rl][ch * 8];
    }
  }
};
struct EpiLoraG {
  const P& p; int row0, col0;
  DEV void operator()(f32x4 (&acc)[4][4], int wr, int wc, int fr, int fq, char* smem) const {
    const int wid = wr * 2 + wc, lane = fq * 16 + fr;
    stage_tile_bf16(acc, smem, wid, fr, fq);
    const bf16_t (*t)[72] = (const bf16_t (*)[72])(smem + wid * 9216);
#pragma unroll
    for (int i = 0; i < 8; ++i) {
      const int rl = i * 8 + (lane >> 3), ch = lane & 7;
      *(uint4*)(p.Y + (size_t)(row0 + wr * 64 + rl) * D + 256 + col0 + wc * 64 + ch * 8) = *(const uint4*)&t[rl][ch * 8];
    }
  }
};
DEV void ph_lora(const P& p, int layer, char* smem) {
  int rt, ct;
  for (int it = 0; gemm_unit(it, 10, rt, ct); ++it) {
    if (ct < 8) {
      EpiLoraA epi{p, layer, rt * 128, ct * 128};
      gemm_tile(p.Z + (size_t)rt * 128 * INW + 1536, INW, p.Wlt + (size_t)ct * 128 * 256, 256, 256, smem, epi);
    } else {
      EpiLoraG epi{p, rt * 128, (ct - 8) * 128};
      gemm_tile(p.Z + (size_t)rt * 128 * INW + 1792, INW, p.Wgt + (size_t)(ct - 8) * 128 * 128, 128, 128, smem, epi);
    }
  }
}

DEV void ph_rwkv_prep(const P& p, int layer) {
  const int lane = tid_() & 63;
  int r0, r1;
  wave_range(r0, r1, NTOK);
  const float* cw = p.conv_w + (size_t)layer * 3 * 1536;
  const float* cb = p.conv_b + (size_t)layer * 1536;
  float w0[3][4], w1[3][4], w2[3][4], bb[3][4], kkw[4];
#pragma unroll
  for (int a = 0; a < 3; ++a)
#pragma unroll
    for (int i = 0; i < 4; ++i) {
      const int col = 768 + a * 256 + 4 * lane + i;
      w0[a][i] = cw[col]; w1[a][i] = cw[1536 + col]; w2[a][i] = cw[3072 + col]; bb[a][i] = cb[col];
    }
#pragma unroll
  for (int i = 0; i < 4; ++i) kkw[i] = p.rw_k_k[layer * 256 + 4 * lane + i];
  uint2 zm[3], zc[3], zp[3];
  auto ldz = [&](int row, uint2 (&z)[3]) {
#pragma unroll
    for (int a = 0; a < 3; ++a) z[a] = *(const uint2*)(p.Z + (size_t)row * INW + 768 + a * 256 + 4 * lane);
  };
  auto zero3 = [&](uint2 (&z)[3]) {
#pragma unroll
    for (int a = 0; a < 3; ++a) z[a] = make_uint2(0u, 0u);
  };
  if (r0 < r1) {
    if (r0 > 0) ldz(r0 - 1, zm); else zero3(zm);
    ldz(r0, zc);
  }
#pragma unroll 1
  for (int row = r0; row < r1; ++row) {
    if (row + 1 < NTOK) ldz(row + 1, zp); else zero3(zp);
    const int pp = row % LT;
    const bool hasm = (pp != 0) && (pp != LC);
    const bool hasp = (pp != LC - 1) && (pp != LT - 1);
    float res[3][4];
#pragma unroll
    for (int a = 0; a < 3; ++a) {
      const uint2 um = hasm ? zm[a] : make_uint2(0u, 0u), uc = zc[a], up = hasp ? zp[a] : make_uint2(0u, 0u);
      const float vm[4] = {bflo(um.x), bfhi(um.x), bflo(um.y), bfhi(um.y)};
      const float vc[4] = {bflo(uc.x), bfhi(uc.x), bflo(uc.y), bfhi(uc.y)};
      const float vp[4] = {bflo(up.x), bfhi(up.x), bflo(up.y), bfhi(up.y)};
#pragma unroll
      for (int i = 0; i < 4; ++i) res[a][i] = w0[a][i] * vm[i] + w1[a][i] * vc[i] + w2[a][i] * vp[i] + bb[a][i];
    }
    float kk[4], ss = 0.f;
#pragma unroll
    for (int i = 0; i < 4; ++i) { kk[i] = res[1][i] * kkw[i]; ss += kk[i] * kk[i]; }
    ss = row16_sum(ss);
    const float rs = rsqrtf(ss + 1e-12f);
    bf16_t* hr = p.H + (size_t)row * D + 16 * lane;
    *(uint4*)hr = make_uint4(pack2(res[0][0], res[1][0]), pack2(kk[0] * rs, res[2][0]), pack2(res[0][1], res[1][1]), pack2(kk[1] * rs, res[2][1]));
    *(uint4*)(hr + 8) = make_uint4(pack2(res[0][2], res[1][2]), pack2(kk[2] * rs, res[2][2]), pack2(res[0][3], res[1][3]), pack2(kk[3] * rs, res[2][3]));
#pragma unroll
    for (int a = 0; a < 3; ++a) { zm[a] = zc[a]; zc[a] = zp[a]; }
  }
}

DEV float oct_sum(float x) { x += dpp0<0xB1, 0xF>(x); x += dpp0<0x4E, 0xF>(x); x += dpp0<0x141, 0xF>(x); return x; }
DEV bf16x8 frag_join(uint2 lo, uint2 hi) { uint4 w = make_uint4(lo.x, lo.y, hi.x, hi.y); return __builtin_bit_cast(bf16x8, w); }
constexpr int SCS_SET = 17152, SCS_IMG = 3 * SCS_SET, SCS_W0 = SCS_IMG + 2 * 3072;
DEV void scanc_unit(const P& p, int layer, int unit, char* smem) {
  const int dir = unit & 1, h = (unit >> 1) & 3, b = unit >> 3;
  const int tid = tid_(), lane = tid & 63, fr = lane & 15, fq = lane >> 4;
  const int w = __builtin_amdgcn_readfirstlane(tid >> 6);
  bf16_t* IMG0 = (bf16_t*)(smem + SCS_W0);
  bf16_t* IMG1 = IMG0 + 512;
  bf16_t* IMG2 = IMG0 + 1024;
  __syncthreads();
  for (int i = tid; i < (2 * 3072 + 3072) / 4; i += 256) ((unsigned*)(smem + SCS_IMG))[i] = 0u;
  const float ka = p.rw_k_a[layer * 256 + h * 64 + lane];
  const size_t rowbase = (size_t)b * LT;
  const char* hbase = (const char*)p.H;
  const char* sbase = (const char*)p.SC;
  const unsigned hoff = (unsigned)(rowbase * 2048) + (unsigned)((h * 64 + lane) * 8);
  const unsigned soff = hoff + 4u * (unsigned)dir;
  bf16_t* yb = p.Z + rowbase * INW + 768 + dir * 256 + h * 64 + w * 16 + fr;
  auto pos0 = [&](int c) -> int { const int t = c * 16; return dir == 0 ? t : (t < LC ? LC - 1 - t : LT - 1 - (t - LC)); };
  const int pstep = dir == 0 ? 1 : -1;
  constexpr int NCH = LT / 16;
  struct Raw { unsigned sc[16]; uint2 hr[6]; };
  auto load_raw = [&](int c, Raw& rw) {
    if (w != 0) {
      const int p0 = pos0(c);
      const unsigned so = soff + (unsigned)(p0 * 2048);
      const int st = pstep * 2048;
#pragma unroll
      for (int i = 0; i < 16; ++i) rw.sc[i] = *(const unsigned*)(sbase + (so + (unsigned)(i * st)));
      const unsigned ho = hoff + (unsigned)((p0 + pstep * (w - 1)) * 2048);
#pragma unroll
      for (int q = 0; q < 6; ++q) {
        const int qq = ((w - 1) + 3 * q < 16) ? q : 4;
        rw.hr[q] = *(const uint2*)(hbase + (ho + (unsigned)(qq * 3 * st)));
      }
    }
  };
  auto stage1w = [&](int set, const Raw& rw, auto W1tag) {
    constexpr int W1 = decltype(W1tag)::value;
    char* base = smem + set * SCS_SET;
    bf16_t (*At)[72] = (bf16_t (*)[72])(base);
    bf16_t (*Rt)[72] = (bf16_t (*)[72])(base + 2304);
    bf16_t (*Bt)[72] = (bf16_t (*)[72])(base + 4608);
    bf16_t (*Kt)[72] = (bf16_t (*)[72])(base + 6912);
    bf16_t (*BKT)[36] = (bf16_t (*)[36])(base + 9216);
    bf16_t* VV = (bf16_t*)(base + 13824);
    float* G16 = (float*)(base + 16896);
    float Erun = 0.f;
#pragma unroll
    for (int i = 0; i < 16; ++i) {
      const float ev = bflo(rw.sc[i]);
      const float Eprev = Erun;
      Erun += ev;
      if ((i % 3) == W1) {
        const uint2 hrec = rw.hr[i / 3];
        const float rr = bflo(hrec.x), kr = bfhi(hrec.x), kkv = bflo(hrec.y);
        const float av = bfhi(rw.sc[i]);
        const float gp = __expf(-Eprev), gi = __expf(-Erun), ig = __expf(Erun);
        const float at = -kkv * gp, rt = rr * gi, bt = kkv * av * ig, kt2 = kr * (1.f + (av - 1.f) * ka) * ig;
        const unsigned ar = pack2(at, rt), bk = pack2(bt, kt2);
        At[i][lane] = (bf16_t)(ar & 0xFFFFu); Rt[i][lane] = (bf16_t)(ar >> 16);
        Bt[i][lane] = (bf16_t)(bk & 0xFFFFu); Kt[i][lane] = (bf16_t)(bk >> 16);
        BKT[lane][(i >> 2) * 8 + (i & 3)] = (bf16_t)(bk & 0xFFFFu);
        BKT[lane][(i >> 2) * 8 + 4 + (i & 3)] = (bf16_t)(bk >> 16);
        VV[((i >> 2) * 64 + lane) * 6 + (i & 3)] = (bf16_t)(hrec.y >> 16);
        if (i == 15) G16[lane] = gi;
      }
    }
  };
  auto stage1 = [&](int set, const Raw& rw) {
    if (w == 1) stage1w(set, rw, std::integral_constant<int, 0>{});
    else if (w == 2) stage1w(set, rw, std::integral_constant<int, 1>{});
    else if (w == 3) stage1w(set, rw, std::integral_constant<int, 2>{});
  };
  auto stage2 = [&](int set, int iset) {
    char* base = smem + set * SCS_SET;
    const bf16_t (*At)[72] = (const bf16_t (*)[72])(base);
    const bf16_t (*Rt)[72] = (const bf16_t (*)[72])(base + 2304);
    const bf16_t (*Bt)[72] = (const bf16_t (*)[72])(base + 4608);
    const bf16_t (*Kt)[72] = (const bf16_t (*)[72])(base + 6912);
    bf16_t* TT = (bf16_t*)(smem + SCS_IMG + iset * 3072);
    bf16_t* ARK = TT + 512;
    bf16_t* AAK = TT + 1024;
    const bf16_t (*X)[72] = (w < 2) ? At : Rt;
    const bf16_t (*Y)[72] = (w & 1) ? Kt : Bt;
    f32x4 cm = (f32x4){0.f, 0.f, 0.f, 0.f};
#pragma unroll
    for (int s = 0; s < 2; ++s) {
      bf16x8 af = *(const bf16x8*)&X[fr][32 * s + 8 * fq];
      bf16x8 bm = *(const bf16x8*)&Y[fr][32 * s + 8 * fq];
      cm = mfma16(af, bm, cm);
    }
#pragma unroll
    for (int jj = 0; jj < 4; ++jj) {
      const int i = 4 * fq + jj;
      const bool keep = (w < 2) ? (fr < i) : (fr <= i);
      cm[jj] = keep ? cm[jj] : 0.f;
    }
    const int io = (fr >> 2) * 8 + (fr & 3);
    auto wr_img = [&](bf16_t* img, const f32x4& Xv, int hi) {
#pragma unroll
      for (int jj = 0; jj < 4; ++jj) img[(4 * fq + jj) * 32 + io + hi] = f2bf(Xv[jj]);
    };
    if (w == 1) wr_img(AAK, cm, 0);
    else if (w == 2) wr_img(ARK, cm, 0);
    else if (w == 3) wr_img(ARK, cm, 4);
    else {
      auto bfrag = [&](const f32x4& Xv) { return frag_join(make_uint2(pack2(Xv[0], Xv[1]), pack2(Xv[2], Xv[3])), make_uint2(0u, 0u)); };
      auto afr = [&](const bf16_t* img) { return *(const bf16x8*)&img[(fr * 4 + fq) * 8]; };
      const f32x4 Z4 = (f32x4){0.f, 0.f, 0.f, 0.f};
      wr_img(IMG0, cm, 0);
      asm volatile("" ::: "memory");
      f32x4 A2 = mfma16(afr(IMG0), bfrag(cm), Z4);
      wr_img(IMG1, A2, 0);
      asm volatile("" ::: "memory");
      f32x4 A4 = mfma16(afr(IMG1), bfrag(A2), Z4);
      wr_img(IMG2, A4, 0);
      asm volatile("" ::: "memory");
      f32x4 Rm = mfma16(afr(IMG2), bfrag(A4), Z4);
#pragma unroll
      for (int jj = 0; jj < 4; ++jj) Rm[jj] += (fr == 4 * fq + jj) ? 1.f : 0.f;
      Rm = mfma16(afr(IMG2), bfrag(Rm), Rm);
      Rm = mfma16(afr(IMG1), bfrag(Rm), Rm);
      Rm = mfma16(afr(IMG0), bfrag(Rm), Rm);
      wr_img(TT, Rm, 0);
    }
  };
  f32x4 acc[4];
#pragma unroll
  for (int kt = 0; kt < 4; ++kt) acc[kt] = (f32x4){0.f, 0.f, 0.f, 0.f};
  auto part2 = [&](int c, int set, int iset) {
    char* base = smem + set * SCS_SET;
    const bf16_t (*At)[72] = (const bf16_t (*)[72])(base);
    const bf16_t (*Rt)[72] = (const bf16_t (*)[72])(base + 2304);
    const bf16_t (*BKT)[36] = (const bf16_t (*)[36])(base + 9216);
    const bf16_t* VV = (const bf16_t*)(base + 13824);
    const float* G16 = (const float*)(base + 16896);
    const bf16_t* TT = (const bf16_t*)(smem + SCS_IMG + iset * 3072);
    const bf16_t* ARK = TT + 512;
    const bf16_t* AAK = TT + 1024;
    bf16x8 Sb[2];
#pragma unroll
    for (int s = 0; s < 2; ++s) {
      uint4 t = make_uint4(pack2(acc[2 * s][0], acc[2 * s][1]), pack2(acc[2 * s][2], acc[2 * s][3]),
                           pack2(acc[2 * s + 1][0], acc[2 * s + 1][1]), pack2(acc[2 * s + 1][2], acc[2 * s + 1][3]));
      Sb[s] = __builtin_bit_cast(bf16x8, t);
    }
    const unsigned* vvp = (const unsigned*)&VV[(fq * 64 + w * 16 + fr) * 6];
    const uint2 vv = make_uint2(vvp[0], vvp[1]);
    const bf16x8 Vlow = frag_join(vv, make_uint2(0u, 0u));
    f32x4 Pm = (f32x4){0.f, 0.f, 0.f, 0.f};
#pragma unroll
    for (int s = 0; s < 2; ++s) {
      bf16x8 af = frag_join(*(const uint2*)&At[fr][32 * s + 4 * fq], *(const uint2*)&At[fr][32 * s + 16 + 4 * fq]);
      Pm = mfma16(af, Sb[s], Pm);
    }
    Pm = mfma16(*(const bf16x8*)&AAK[(fr * 4 + fq) * 8], Vlow, Pm);
    const bf16x8 Pb = frag_join(make_uint2(pack2(Pm[0], Pm[1]), pack2(Pm[2], Pm[3])), make_uint2(0u, 0u));
    f32x4 U = mfma16(*(const bf16x8*)&TT[(fr * 4 + fq) * 8], Pb, (f32x4){0.f, 0.f, 0.f, 0.f});
    const bf16x8 UV = frag_join(make_uint2(pack2(U[0], U[1]), pack2(U[2], U[3])), vv);
    f32x4 Yv = (f32x4){0.f, 0.f, 0.f, 0.f};
#pragma unroll
    for (int s = 0; s < 2; ++s) {
      bf16x8 af = frag_join(*(const uint2*)&Rt[fr][32 * s + 4 * fq], *(const uint2*)&Rt[fr][32 * s + 16 + 4 * fq]);
      Yv = mfma16(af, Sb[s], Yv);
    }
    Yv = mfma16(*(const bf16x8*)&ARK[(fr * 4 + fq) * 8], UV, Yv);
    {
      const int p0 = pos0(c);
#pragma unroll
      for (int jj = 0; jj < 4; ++jj) yb[(size_t)(p0 + pstep * (4 * fq + jj)) * INW] = f2bf(Yv[jj]);
    }
#pragma unroll
    for (int kt = 0; kt < 4; ++kt) {
      f32x4 t = mfma16(frag_join(*(const uint2*)&BKT[16 * kt + fr][fq * 8], *(const uint2*)&BKT[16 * kt + fr][fq * 8 + 4]), UV, acc[kt]);
      const float4 g4 = *(const float4*)&G16[16 * kt + 4 * fq];
      t[0] *= g4.x; t[1] *= g4.y; t[2] *= g4.z; t[3] *= g4.w;
      acc[kt] = t;
    }
  };
  __builtin_amdgcn_s_setprio(3);
  Raw r0, r1;
  load_raw(0, r0); load_raw(1, r1);
  stage1(0, r0);
  load_raw(2, r0);
  __syncthreads();
  stage2(0, 0);
  stage1(1, r1);
  load_raw(3, r1);
  __syncthreads();
  int s0 = 0, s1 = 1, s2 = 2;
  auto iter = [&](int c, Raw& rw) {
    if (c + 1 < NCH) stage2(s1, (c + 1) & 1);
    part2(c, s0, c & 1);
    if (c + 2 < NCH) {
      stage1(s2, rw);
      if (c + 4 < NCH) load_raw(c + 4, rw);
    }
    asm volatile("s_waitcnt lgkmcnt(0)" ::: "memory");
    __builtin_amdgcn_s_barrier();
    asm volatile("" ::: "memory");
    const int t = s0; s0 = s1; s1 = s2; s2 = t;
  };
#pragma unroll 1
  for (int c = 0; c < NCH; c += 2) {
    iter(c, r0); iter(c + 1, r1);
  }
  __builtin_amdgcn_s_setprio(0);
}

DEV void ph_rwkv_post(const P& p, int layer) {
  const int lane = tid_() & 63;
  int r0, r1;
  wave_range(r0, r1, NTOK);
  const int ch = 4 * lane;
  float kav[4], rkv[4], lnw[4], lnb[4];
#pragma unroll
  for (int i = 0; i < 4; ++i) {
    kav[i] = p.rw_k_a[layer * 256 + ch + i]; rkv[i] = p.rw_r_k[layer * 256 + ch + i];
    lnw[i] = p.rw_ln_w[layer * 256 + ch + i]; lnb[i] = p.rw_ln_b[layer * 256 + ch + i];
  }
  struct In { uint2 y0, y1, g; uint4 h0, h1, s0, s1; };
  auto ld = [&](int row, In& in) {
    const bf16_t* zr = p.Z + (size_t)row * INW + 768 + ch;
    in.y0 = *(const uint2*)zr; in.y1 = *(const uint2*)(zr + 256);
    const bf16_t* hr = p.H + (size_t)row * D + 4 * ch;
    in.h0 = *(const uint4*)hr; in.h1 = *(const uint4*)(hr + 8);
    const bf16_t* sr = p.SC + (size_t)row * 1024 + 4 * ch;
    in.s0 = *(const uint4*)sr; in.s1 = *(const uint4*)(sr + 8);
    in.g = *(const uint2*)(p.Y + (size_t)row * D + 256 + ch);
  };
  In nx;
  if (r0 < r1) ld(r0, nx);
#pragma unroll 1
  for (int row = r0; row < r1; ++row) {
    const In in = nx;
    if (row + 1 < r1) ld(row + 1, nx);
    float y[4] = {bflo(in.y0.x) + bflo(in.y1.x), bfhi(in.y0.x) + bfhi(in.y1.x), bflo(in.y0.y) + bflo(in.y1.y), bfhi(in.y0.y) + bfhi(in.y1.y)};
    const float mu = row16_sum(y[0] + y[1] + y[2] + y[3]) * (1.f / 64.f);
    float vs = 0.f;
#pragma unroll
    for (int i = 0; i < 4; ++i) { y[i] -= mu; vs += y[i] * y[i]; }
    const float var = row16_sum(vs) * (1.f / 64.f);
    const float rstd = rsqrtf(var + 64e-5f);
    const float r[4] = {bflo(in.h0.x), bflo(in.h0.z), bflo(in.h1.x), bflo(in.h1.z)};
    const float k[4] = {bfhi(in.h0.x), bfhi(in.h0.z), bfhi(in.h1.x), bfhi(in.h1.z)};
    const float v[4] = {bfhi(in.h0.y), bfhi(in.h0.w), bfhi(in.h1.y), bfhi(in.h1.w)};
    const float a0[4] = {bfhi(in.s0.x), bfhi(in.s0.z), bfhi(in.s1.x), bfhi(in.s1.z)};
    const float a1[4] = {bfhi(in.s0.y), bfhi(in.s0.w), bfhi(in.s1.y), bfhi(in.s1.w)};
    float sd = 0.f;
#pragma unroll
    for (int i = 0; i < 4; ++i) {
      const float kd0 = k[i] * (1.f + (a0[i] - 1.f) * kav[i]), kd1 = k[i] * (1.f + (a1[i] - 1.f) * kav[i]);
      sd += r[i] * (kd0 + kd1) * rkv[i];
    }
    sd = row16_sum(sd);
    const float g[4] = {bflo(in.g.x), bfhi(in.g.x), bflo(in.g.y), bfhi(in.g.y)};
    float o[4];
#pragma unroll
    for (int i = 0; i < 4; ++i) {
      const float yn = y[i] * rstd * lnw[i] + lnb[i];
      o[i] = (yn + sd * v[i]) * g[i];
    }
    *(uint2*)(p.Y + (size_t)row * D + 256 + ch) = make_uint2(pack2(o[0], o[1]), pack2(o[2], o[3]));
  }
}

DEV void hyena_pre_unit(const P& p, int layer, int unit) {
  int kind, b, t0, L;
  if (unit < 1024) { kind = 0; b = unit >> 6; t0 = (unit & 63) * 64; L = T; } else { int u = unit - 1024; kind = 1; b = u >> 2; t0 = (u & 3) * 64; L = LC; }
  const int lane = tid_() & 63, wid = tid_() >> 6;
  const int tw = t0 + wid * 16;
  const size_t row0 = (size_t)b * LT + (kind ? 0 : LC);
  const float* cw = p.conv_w + (size_t)layer * 3 * 1536;
  const float* cb = p.conv_b + (size_t)layer * 1536;
  float wx[3][4], wv[3][4], bx[4], bv[4];
#pragma unroll
  for (int i = 0; i < 4; ++i) {
    const int cx = 256 + 4 * lane + i, cv = 512 + 4 * lane + i;
#pragma unroll
    for (int k = 0; k < 3; ++k) { wx[k][i] = cw[k * 1536 + cx]; wv[k][i] = cw[k * 1536 + cv]; }
    bx[i] = cb[cx]; bv[i] = cb[cv];
  }
  uint2 zx[18], zv[18];
#pragma unroll
  for (int i = 0; i < 18; ++i) {
    const int t = tw - 1 + i;
    if (t >= 0 && t < L) {
      const bf16_t* zr = p.Z + (row0 + t) * INW + 256 + 4 * lane;
      zx[i] = *(const uint2*)zr; zv[i] = *(const uint2*)(zr + 256);
    } else { zx[i] = make_uint2(0u, 0u); zv[i] = make_uint2(0u, 0u); }
  }
  float uo[4][16];
#pragma unroll
  for (int i = 0; i < 16; ++i) {
    const float xm[4] = {bflo(zx[i].x), bfhi(zx[i].x), bflo(zx[i].y), bfhi(zx[i].y)};
    const float xc[4] = {bflo(zx[i + 1].x), bfhi(zx[i + 1].x), bflo(zx[i + 1].y), bfhi(zx[i + 1].y)};
    const float xp[4] = {bflo(zx[i + 2].x), bfhi(zx[i + 2].x), bflo(zx[i + 2].y), bfhi(zx[i + 2].y)};
    const float vm[4] = {bflo(zv[i].x), bfhi(zv[i].x), bflo(zv[i].y), bfhi(zv[i].y)};
    const float vc[4] = {bflo(zv[i + 1].x), bfhi(zv[i + 1].x), bflo(zv[i + 1].y), bfhi(zv[i + 1].y)};
    const float vp[4] = {bflo(zv[i + 2].x), bfhi(zv[i + 2].x), bflo(zv[i + 2].y), bfhi(zv[i + 2].y)};
#pragma unroll
    for (int q = 0; q < 4; ++q) {
      const float a = wx[0][q] * xm[q] + wx[1][q] * xc[q] + wx[2][q] * xp[q] + bx[q];
      const float c2 = wv[0][q] * vm[q] + wv[1][q] * vc[q] + wv[2][q] * vp[q] + bv[q];
      uo[q][i] = a * c2;
    }
  }
  bf16_t* ut = kind ? opq(p.UTc) : opq(p.UTl);
#pragma unroll
  for (int q = 0; q < 4; ++q) {
    bf16_t* dst = ut + ((size_t)(4 * lane + q) * 16 + b) * L + tw;
    *(uint4*)dst = pack8(&uo[q][0]);
    *(uint4*)(dst + 8) = pack8(&uo[q][8]);
  }
}

DEV void hyena_conv_unit(const P& p, int layer, int unit, char* smem) {
  int kind, c, tb, L;
  if (unit < 4096) { kind = 0; c = unit >> 4; tb = (unit & 15) * 256; L = T; } else { kind = 1; c = unit - 4096; tb = 0; L = LC; }
  const int tid = tid_(), lane = tid & 63, wid = tid >> 6, fr = lane & 15, fq = lane >> 4;
  float* red = (float*)(smem + 2 * 16512);
  const float* F = (kind ? opq(p.FC) : opq(p.FL)) + (size_t)c * 2 * L;
  float scale;
  {
    float part = 0.f;
    for (int i = tid; i < 2 * L; i += 256) { float fv = F[i]; part += (i != L) ? fv * fv : 0.f; }
    part = wave_sum(part);
    __syncthreads();
    if (lane == 0) red[wid] = part;
    __syncthreads();
    scale = rsqrtf(((red[0] + red[1]) + (red[2] + red[3])) + 1e-6f);
  }
  const bf16_t* U = (kind ? opq(p.UTc) : opq(p.UTl)) + (size_t)c * 16 * L;
  f32x4 acc[4];
#pragma unroll
  for (int m = 0; m < 4; ++m) acc[m] = (f32x4){0.f, 0.f, 0.f, 0.f};
  const int nch = L / 256;
  float fw0, fw1, fw2;
  uint4 ru0, ru1;
  auto ldchunk = [&](int ch) {
    const int sc = ch * 256;
    const int D0 = tb + 256 - sc;
    auto tap = [&](int n) -> float {
      int d = D0 - n;
      float v = 0.f;
      if (d > -L && d < L) v = (d >= 0 ? F[d] : F[L - d]);
      return v;
    };
    fw0 = tap(tid); fw1 = tap(tid + 256); fw2 = (tid < 8) ? tap(tid + 512) : 0.f;
    const int bb = tid >> 4, sg0 = tid & 15;
    ru0 = *(const uint4*)(U + (size_t)bb * L + sc + 8 * sg0);
    ru1 = *(const uint4*)(U + (size_t)bb * L + sc + 8 * (sg0 + 16));
  };
  auto stchunk = [&](int buf) {
    bf16_t* Cq = (bf16_t*)(smem + buf * 16512);
    bf16_t* Us = (bf16_t*)(smem + buf * 16512 + 8320);
    const bf16_t h0 = f2bf(fw0 * scale), h1 = f2bf(fw1 * scale), h2 = f2bf(fw2 * scale);
#pragma unroll
    for (int rho = 0; rho < 8; ++rho) {
      int m = tid + rho;
      Cq[((m >> 3) * 8 + rho) * 8 + (m & 7)] = h0;
      m = tid + 256 + rho;
      if (m < 520) Cq[((m >> 3) * 8 + rho) * 8 + (m & 7)] = h1;
      m = tid + 512 + rho;
      if (tid < 8 && m < 520) Cq[((m >> 3) * 8 + rho) * 8 + (m & 7)] = h2;
    }
    if (tid < 8) {
#pragma unroll
      for (int rho = 1; rho < 8; ++rho) if (tid < rho) Cq[(rho) * 8 + tid] = 0;
    }
    const int bb = tid >> 4, sg0 = tid & 15;
    *(uint4*)&Us[(sg0 * 16 + bb) * 8] = ru0;
    *(uint4*)&Us[((sg0 + 16) * 16 + bb) * 8] = ru1;
  };
  ldchunk(0);
#pragma unroll 1
  for (int ch = 0; ch < nch; ++ch) {
    const int buf = ch & 1;
    stchunk(buf);
    __syncthreads();
    if (ch + 1 < nch) ldchunk(ch + 1);
    const bf16_t* Cq = (const bf16_t*)(smem + buf * 16512);
    const bf16_t* Us = (const bf16_t*)(smem + buf * 16512 + 8320);
#pragma unroll
    for (int kk = 0; kk < 8; ++kk) {
      bf16x8 bf = *(const bf16x8*)&Us[((4 * kk + fq) * 16 + fr) * 8];
#pragma unroll
      for (int m = 0; m < 4; ++m) {
        int it = wid * 4 + m;
        int base = 256 - 16 * it + 32 * kk + 8 * fq;
        int m0 = base - 8 * (fr >> 3);
        bf16x8 af = *(const bf16x8*)&Cq[((m0 >> 3) * 8 + (fr & 7)) * 8];
        acc[m] = mfma16(af, bf, acc[m]);
      }
    }
  }
  __syncthreads();
  bf16_t* Yt = (kind ? opq(p.YTc) : opq(p.YTl)) + ((size_t)c * 16 + fr) * L + tb;
#pragma unroll
  for (int m = 0; m < 4; ++m) {
    int t = (wid * 4 + m) * 16 + fq * 4;
    *(uint2*)(Yt + t) = make_uint2(pack2(acc[m][0], acc[m][1]), pack2(acc[m][2], acc[m][3]));
  }
}

DEV void hyena_post_unit(const P& p, int layer, int unit, char* smem) {
  (void)smem;
  int kind, b, t0, L;
  if (unit < 1024) { kind = 0; b = unit >> 6; t0 = (unit & 63) * 64; L = T; } else { int u = unit - 1024; kind = 1; b = u >> 2; t0 = (u & 3) * 64; L = LC; }
  const int lane = tid_() & 63, wid = tid_() >> 6;
  const int tw = t0 + wid * 16;
  const size_t row0 = (size_t)b * LT + (kind ? 0 : LC);
  const float* cw = p.conv_w + (size_t)layer * 3 * 1536;
  float w0[3][4], b0[4], bias[4], og[4];
#pragma unroll
  for (int i = 0; i < 4; ++i) {
    const int c = 4 * lane + i;
#pragma unroll
    for (int k = 0; k < 3; ++k) w0[k][i] = cw[k * 1536 + c];
    b0[i] = p.conv_b[layer * 1536 + c]; bias[i] = p.hy_bias[layer * 256 + c]; og[i] = p.hy_out_g[layer * 256 + c];
  }
  uint2 zx[18];
#pragma unroll
  for (int i = 0; i < 18; ++i) {
    const int t = tw - 1 + i;
    zx[i] = (t >= 0 && t < L) ? *(const uint2*)(p.Z + (row0 + t) * INW + 4 * lane) : make_uint2(0u, 0u);
  }
  const bf16_t* ytb = kind ? opq(p.YTc) : opq(p.YTl);
  const bf16_t* utb = kind ? opq(p.UTc) : opq(p.UTl);
  float o[4][16];
#pragma unroll
  for (int q = 0; q < 4; ++q) {
    const size_t off = ((size_t)(4 * lane + q) * 16 + b) * L + tw;
    float yv[16], uv[16];
    { uint4 a0 = *(const uint4*)(ytb + off), a1 = *(const uint4*)(ytb + off + 8); unpack8(a0, yv); unpack8(a1, yv + 8); }
    { uint4 a0 = *(const uint4*)(utb + off), a1 = *(const uint4*)(utb + off + 8); unpack8(a0, uv); unpack8(a1, uv + 8); }
#pragma unroll
    for (int i = 0; i < 16; ++i) o[q][i] = yv[i] + uv[i] * bias[q];
  }
#pragma unroll
  for (int i = 0; i < 16; ++i) {
    const float xm[4] = {bflo(zx[i].x), bfhi(zx[i].x), bflo(zx[i].y), bfhi(zx[i].y)};
    const float xc[4] = {bflo(zx[i + 1].x), bfhi(zx[i + 1].x), bflo(zx[i + 1].y), bfhi(zx[i + 1].y)};
    const float xp[4] = {bflo(zx[i + 2].x), bfhi(zx[i + 2].x), bflo(zx[i + 2].y), bfhi(zx[i + 2].y)};
    float ov[4], ss = 0.f;
#pragma unroll
    for (int q = 0; q < 4; ++q) {
      const float x0 = w0[0][q] * xm[q] + w0[1][q] * xc[q] + w0[2][q] * xp[q] + b0[q];
      ov[q] = bf2f(f2bf(x0 * o[q][i]));
      ss += ov[q] * ov[q];
    }
    ss = wave_sum(ss);
    const float rstd = rsqrtf(ss * (1.f / 256.f) + 1e-6f);
    *(uint2*)(p.Y + (row0 + tw + i) * D + 4 * lane) = make_uint2(pack2(ov[0] * rstd * og[0], ov[1] * rstd * og[1]), pack2(ov[2] * rstd * og[2], ov[3] * rstd * og[3]));
  }
}

DEV void attn_unit(const P& p, int layer, int unit, char* smem) {
  const bool isctx = unit >= 4096;
  int b, qb, hq;
  if (!isctx) { b = unit >> 8; qb = (unit >> 3) & 31; hq = unit & 7; } else { int u = unit - 4096; b = u >> 4; qb = (u >> 3) & 1; hq = u & 7; }
  const int g = hq >> 2;
  const int tid = tid_(), lane = tid & 63, wid = tid >> 6, qn = lane & 31, hh = lane >> 5;
  const int qpos = qb * 128 + wid * 32 + qn;
  const size_t qrow = (size_t)b * LT + (isctx ? qpos : LC + qpos);
  const bf16_t* qptr = p.Z + qrow * INW + 1920 + hq * 64;
  bf16x8 qf[4];
#pragma unroll
  for (int s = 0; s < 4; ++s) qf[s] = *(const bf16x8*)(qptr + 16 * s + 8 * hh);
  const float sink = p.attn_sink[layer * 8 + hq];
  float m_run = sink, l_run = 1.f;
  f32x16 o0, o1;
#pragma unroll
  for (int i = 0; i < 16; ++i) { o0[i] = 0.f; o1[i] = 0.f; }
  typedef bf16_t KTile[64][72];
  KTile* Ks = (KTile*)smem;
  KTile* Vt = (KTile*)(smem + 18432);
  const int ntl = isctx ? 0 : 6;
  const int ntiles = ntl + 4;
  const int skey = tid >> 3, sseg = tid & 7;
  const bf16_t* kvbase = p.Z + (size_t)b * LT * INW + 1920 + 512 + g * 64 + sseg * 8;
  uint4 rk0, rk1, rv0, rv1;
  auto ldtile = [&](int kt) {
    const bool ctxk = kt >= ntl;
    const int kbase = ctxk ? (kt - ntl) * 64 : qb * 128 - 128 + kt * 64;
    const int kp0 = kbase + skey, kp1 = kp0 + 32;
    rk0 = rk1 = rv0 = rv1 = make_uint4(0, 0, 0, 0);
    if (ctxk || (kp0 >= 0 && kp0 < T)) { const bf16_t* src = kvbase + (size_t)(ctxk ? kp0 : LC + kp0) * INW; rk0 = *(const uint4*)src; rv0 = *(const uint4*)(src + 128); }
    if (ctxk || (kp1 >= 0 && kp1 < T)) { const bf16_t* src = kvbase + (size_t)(ctxk ? kp1 : LC + kp1) * INW; rk1 = *(const uint4*)src; rv1 = *(const uint4*)(src + 128); }
  };
  auto sttile = [&](int buf) {
    *(uint4*)&Ks[buf][skey][sseg * 8] = rk0;
    *(uint4*)&Ks[buf][skey + 32][sseg * 8] = rk1;
    bf16_t (*vt)[72] = Vt[buf];
    vt[sseg * 8 + 0][skey] = (bf16_t)(rv0.x & 0xFFFF); vt[sseg * 8 + 1][skey] = (bf16_t)(rv0.x >> 16);
    vt[sseg * 8 + 2][skey] = (bf16_t)(rv0.y & 0xFFFF); vt[sseg * 8 + 3][skey] = (bf16_t)(rv0.y >> 16);
    vt[sseg * 8 + 4][skey] = (bf16_t)(rv0.z & 0xFFFF); vt[sseg * 8 + 5][skey] = (bf16_t)(rv0.z >> 16);
    vt[sseg * 8 + 6][skey] = (bf16_t)(rv0.w & 0xFFFF); vt[sseg * 8 + 7][skey] = (bf16_t)(rv0.w >> 16);
    vt[sseg * 8 + 0][skey + 32] = (bf16_t)(rv1.x & 0xFFFF); vt[sseg * 8 + 1][skey + 32] = (bf16_t)(rv1.x >> 16);
    vt[sseg * 8 + 2][skey + 32] = (bf16_t)(rv1.y & 0xFFFF); vt[sseg * 8 + 3][skey + 32] = (bf16_t)(rv1.y >> 16);
    vt[sseg * 8 + 4][skey + 32] = (bf16_t)(rv1.z & 0xFFFF); vt[sseg * 8 + 5][skey + 32] = (bf16_t)(rv1.z >> 16);
    vt[sseg * 8 + 6][skey + 32] = (bf16_t)(rv1.w & 0xFFFF); vt[sseg * 8 + 7][skey + 32] = (bf16_t)(rv1.w >> 16);
  };
  ldtile(0);
#pragma unroll 1
  for (int kt = 0; kt < ntiles; ++kt) {
    const int buf = kt & 1;
    sttile(buf);
    __syncthreads();
    if (kt + 1 < ntiles) ldtile(kt + 1);
    const bool ctxk = kt >= ntl;
    const int kbase = ctxk ? (kt - ntl) * 64 : qb * 128 - 128 + kt * 64;
#pragma unroll
    for (int sub = 0; sub < 2; ++sub) {
      const int kb2 = kbase + sub * 32;
      bool need = true;
      if (!ctxk) {
        int q0 = qb * 128 + wid * 32;
        if (kb2 + 31 < q0 - 128 || kb2 > q0 + 31 + 128 || kb2 + 31 < 0 || kb2 >= T) need = false;
      }
      if (need) {
        f32x16 sv;
#pragma unroll
        for (int i = 0; i < 16; ++i) sv[i] = 0.f;
#pragma unroll
        for (int ks = 0; ks < 4; ++ks) {
          bf16x8 kf = *(const bf16x8*)&Ks[buf][sub * 32 + qn][16 * ks + 8 * hh];
          sv = mfma32(kf, qf[ks], sv);
        }
        float mt = -3e38f;
#pragma unroll
        for (int rg = 0; rg < 16; ++rg) {
          float v = sv[rg] * 0.125f;
          if (!ctxk) {
            int kp = kb2 + (rg & 3) + 8 * (rg >> 2) + 4 * hh;
            int dl = qpos - kp;
            bool ok = (dl <= 128) && (dl >= -128) && (kp >= 0) && (kp < T);
            v = ok ? v : -1e30f;
          }
          sv[rg] = v;
          mt = fmaxf(mt, v);
        }
        mt = fmaxf(mt, __shfl_xor(mt, 32));
        float m_new = fmaxf(m_run, mt);
        float corr = __expf(m_run - m_new);
        float ps = 0.f;
#pragma unroll
        for (int rg = 0; rg < 16; ++rg) { float pv = __expf(sv[rg] - m_new); sv[rg] = pv; ps += pv; }
        ps += __shfl_xor(ps, 32);
        l_run = l_run * corr + ps;
        m_run = m_new;
#pragma unroll
        for (int i = 0; i < 16; ++i) { o0[i] *= corr; o1[i] *= corr; }
#pragma unroll
        for (int sp = 0; sp < 2; ++sp) {
          bf16x8 pf;
#pragma unroll
          for (int j = 0; j < 8; ++j) pf[j] = (short)f2bf(sv[8 * sp + j]);
          const int kc = sub * 32 + 16 * sp + 4 * hh;
          uint2 va = *(const uint2*)&Vt[buf][qn][kc], vb = *(const uint2*)&Vt[buf][qn][kc + 8];
          uint2 vc = *(const uint2*)&Vt[buf][32 + qn][kc], vd = *(const uint2*)&Vt[buf][32 + qn][kc + 8];
          uint4 w0 = make_uint4(va.x, va.y, vb.x, vb.y), w1 = make_uint4(vc.x, vc.y, vd.x, vd.y);
          bf16x8 v0 = __builtin_bit_cast(bf16x8, w0), v1 = __builtin_bit_cast(bf16x8, w1);
          o0 = mfma32(v0, pf, o0);
          o1 = mfma32(v1, pf, o1);
        }
      }
    }
  }
  __syncthreads();
  const float inv = 1.f / l_run;
  bf16_t* optr = p.Y + qrow * D + 512 + hq * 64;
#pragma unroll
  for (int rg = 0; rg < 4; ++rg) {
    int d0 = 8 * rg + 4 * hh;
    *(uint2*)(optr + d0) = make_uint2(pack2(o0[4 * rg] * inv, o0[4 * rg + 1] * inv), pack2(o0[4 * rg + 2] * inv, o0[4 * rg + 3] * inv));
    *(uint2*)(optr + 32 + d0) = make_uint2(pack2(o1[4 * rg] * inv, o1[4 * rg + 1] * inv), pack2(o1[4 * rg + 2] * inv, o1[4 * rg + 3] * inv));
  }
}

DEV void ph_attn_post(const P& p, int layer) {
  const int lane = tid_() & 63;
  int r0, r1;
  wave_range(r0, r1, NTOK);
  float gv[8];
#pragma unroll
  for (int i = 0; i < 8; ++i) gv[i] = p.at_out_g[layer * 512 + 8 * lane + i];
  uint4 nx = make_uint4(0, 0, 0, 0);
  if (r0 < r1) nx = *(const uint4*)(p.Y + (size_t)r0 * D + 512 + 8 * lane);
#pragma unroll 1
  for (int row = r0; row < r1; ++row) {
    const uint4 u = nx;
    if (row + 1 < r1) nx = *(const uint4*)(p.Y + (size_t)(row + 1) * D + 512 + 8 * lane);
    float v[8];
    unpack8(u, v);
    float ss = 0.f;
#pragma unroll
    for (int i = 0; i < 8; ++i) ss += v[i] * v[i];
    ss = wave_sum(ss);
    const float rstd = rsqrtf(ss * (1.f / 512.f) + 1e-6f);
#pragma unroll
    for (int i = 0; i < 8; ++i) {
      v[i] = v[i] * rstd * gv[i];
    }
    *(uint4*)(p.Y + (size_t)row * D + 512 + 8 * lane) = pack8(v);
  }
}

struct Epi2 {
  const P& p; int layer, row0, col0;
  DEV void operator()(f32x4 (&acc)[4][4], int wr, int wc, int fr, int fq, char* smem) const {
    const int b = row0 / LT, pp = row0 % LT;
    const int mr = pp < LC ? 16 : b;
    const float* g1 = p.modv + ((size_t)layer * 17 + mr) * 6144 + 2048 + col0 + wc * 64;
#pragma unroll
    for (int n = 0; n < 4; ++n) {
      const float4 gv = *(const float4*)(g1 + n * 16 + 4 * fq);
#pragma unroll
      for (int m = 0; m < 4; ++m) { acc[m][n][0] *= gv.x; acc[m][n][1] *= gv.y; acc[m][n][2] *= gv.z; acc[m][n][3] *= gv.w; }
    }
    const int wid = wr * 2 + wc, lane = fq * 16 + fr;
    stage_tile_bf16(acc, smem, wid, fr, fq);
    const bf16_t (*t)[72] = (const bf16_t (*)[72])(smem + wid * 9216);
#pragma unroll
    for (int i = 0; i < 8; ++i) {
      const int rl = i * 8 + (lane >> 3), ch = lane & 7;
      bf16_t* xp = p.X + (size_t)(row0 + wr * 64 + rl) * D + col0 + wc * 64 + ch * 8;
      float xv[8], dv[8];
      uint4 xu = *(const uint4*)xp, du = *(const uint4*)&t[rl][ch * 8];
      unpack8(xu, xv); unpack8(du, dv);
#pragma unroll
      for (int q = 0; q < 8; ++q) xv[q] += dv[q];
      *(uint4*)xp = pack8(xv);
    }
  }
};
DEV void ph_gemm2(const P& p, int layer, char* smem) {
  int rt, ct;
  for (int it = 0; gemm_unit(it, 8, rt, ct); ++it) {
    Epi2 epi{p, layer, rt * 128, ct * 128};
    gemm_tile(p.Y + (size_t)rt * 128 * D, D, p.W2t + (size_t)ct * 128 * D, D, D, smem, epi);
  }
}

DEV void ph_peerconv(const P& p, int layer) {
  const int gw = (bid_() * 256 + tid_()) >> 6, nw = gridDim.x * 4, lane = tid_() & 63;
  const float* su = opq(p.peer_u) + (size_t)layer * 16384 * 1024;
  const float* sv = opq(p.peer_v) + (size_t)layer * 16384 * 1024;
  unsigned char* pu = opq(p.PU); unsigned char* pv = opq(p.PV);
  float* psu = opq(p.PSU); float* psv = opq(p.PSV);
  auto ldrow = [&](int r, float4& a0, float4& a1, float4& a2, float4& a3) {
    const float* src = ((r >= 16384) ? sv : su) + (size_t)(r & 16383) * 1024 + 16 * lane;
    a0 = *(const float4*)src; a1 = *(const float4*)(src + 4); a2 = *(const float4*)(src + 8); a3 = *(const float4*)(src + 12);
  };
  float4 n0 = make_float4(0, 0, 0, 0), n1 = n0, n2 = n0, n3 = n0;
  if (gw < 32768) ldrow(gw, n0, n1, n2, n3);
#pragma unroll 1
  for (int r = gw; r < 32768; r += nw) {
    const bool isv = r >= 16384;
    const int e = r & 16383;
    const float4 f0 = n0, f1 = n1, f2 = n2, f3 = n3;
    if (r + nw < 32768) ldrow(r + nw, n0, n1, n2, n3);
    float am = fmaxf(fmaxf(fmaxf(fabsf(f0.x), fabsf(f0.y)), fmaxf(fabsf(f0.z), fabsf(f0.w))), fmaxf(fmaxf(fabsf(f1.x), fabsf(f1.y)), fmaxf(fabsf(f1.z), fabsf(f1.w))));
    am = fmaxf(am, fmaxf(fmaxf(fmaxf(fabsf(f2.x), fabsf(f2.y)), fmaxf(fabsf(f2.z), fabsf(f2.w))), fmaxf(fmaxf(fabsf(f3.x), fabsf(f3.y)), fmaxf(fabsf(f3.z), fabsf(f3.w)))));
    am = wave_max(am);
    int w0, w1, w2, w3;
    float inv;
    if (isv) {
      const float sc = am > 0.f ? 224.f / am : 1.f;
      inv = am > 0.f ? am * (1.f / 224.f) : 1.f;
      w0 = __builtin_amdgcn_cvt_pk_fp8_f32(f0.x * sc, f0.y * sc, 0, false); w0 = __builtin_amdgcn_cvt_pk_fp8_f32(f0.z * sc, f0.w * sc, w0, true);
      w1 = __builtin_amdgcn_cvt_pk_fp8_f32(f1.x * sc, f1.y * sc, 0, false); w1 = __builtin_amdgcn_cvt_pk_fp8_f32(f1.z * sc, f1.w * sc, w1, true);
      w2 = __builtin_amdgcn_cvt_pk_fp8_f32(f2.x * sc, f2.y * sc, 0, false); w2 = __builtin_amdgcn_cvt_pk_fp8_f32(f2.z * sc, f2.w * sc, w2, true);
      w3 = __builtin_amdgcn_cvt_pk_fp8_f32(f3.x * sc, f3.y * sc, 0, false); w3 = __builtin_amdgcn_cvt_pk_fp8_f32(f3.z * sc, f3.w * sc, w3, true);
    } else {
      const float sc = am > 0.f ? 127.f / am : 1.f;
      inv = am > 0.f ? am * (1.f / 127.f) : 1.f;
      w0 = pack_i8(f0.x * sc, f0.y * sc, f0.z * sc, f0.w * sc); w1 = pack_i8(f1.x * sc, f1.y * sc, f1.z * sc, f1.w * sc);
      w2 = pack_i8(f2.x * sc, f2.y * sc, f2.z * sc, f2.w * sc); w3 = pack_i8(f3.x * sc, f3.y * sc, f3.z * sc, f3.w * sc);
    }
    *(uint4*)((isv ? pv : pu) + (size_t)(lane >> 3) * PSLICE + (size_t)e * 128 + 16 * (lane & 7)) = make_uint4((unsigned)w0, (unsigned)w1, (unsigned)w2, (unsigned)w3);
    if (lane == 0) (isv ? psv : psu)[e] = inv;
  }
}
DEV void unpack16_fp8x2(const uint4& u, f32x2* f) {
  f[0] = __builtin_amdgcn_cvt_pk_f32_fp8((int)u.x, false); f[1] = __builtin_amdgcn_cvt_pk_f32_fp8((int)u.x, true);
  f[2] = __builtin_amdgcn_cvt_pk_f32_fp8((int)u.y, false); f[3] = __builtin_amdgcn_cvt_pk_f32_fp8((int)u.y, true);
  f[4] = __builtin_amdgcn_cvt_pk_f32_fp8((int)u.z, false); f[5] = __builtin_amdgcn_cvt_pk_f32_fp8((int)u.z, true);
  f[6] = __builtin_amdgcn_cvt_pk_f32_fp8((int)u.w, false); f[7] = __builtin_amdgcn_cvt_pk_f32_fp8((int)u.w, true);
}

DEV void bitonic_sort16_desc(float (&v)[16]) {
#pragma unroll
  for (int k = 2; k <= 16; k <<= 1)
#pragma unroll
    for (int j = k >> 1; j >= 1; j >>= 1)
#pragma unroll
      for (int i = 0; i < 16; ++i) {
        const int l = i ^ j;
        if (l > i) {
          const float hi = fmaxf(v[i], v[l]), lo = fminf(v[i], v[l]);
          if ((i & k) == 0) { v[i] = hi; v[l] = lo; } else { v[i] = lo; v[l] = hi; }
        }
      }
}
DEV void peer_cand_ij(int c, int& ci, int& cj) {
  if (c < 16) { ci = 0; cj = c; } else if (c < 24) { ci = 1; cj = c - 16; } else if (c < 29) { ci = 2; cj = c - 24; }
  else if (c < 33) { ci = 3; cj = c - 29; } else if (c < 36) { ci = 4; cj = c - 33; } else if (c < 38) { ci = 5; cj = c - 36; }
  else if (c < 40) { ci = 6; cj = c - 38; } else if (c < 42) { ci = 7; cj = c - 40; } else { ci = (c - 42 + 8) & 15; cj = 0; }
}
template <int S>
struct Epi3K {
  const P& p; int row0, head; float (&keep)[2][16];
  DEV void operator()(f32x4 (&acc)[4][4], int wr, int wc, int fr, int fq, char* smem) const {
    float* sc = (float*)smem;
    float* L1s = (float*)(smem + 36864);
    float* L2s = (float*)(smem + 45056);
    const int tid = tid_();
#pragma unroll
    for (int pass = 0; pass < 2; ++pass) {
      __syncthreads();
      if (wr == pass) {
#pragma unroll
        for (int m = 0; m < 4; ++m)
#pragma unroll
          for (int n = 0; n < 4; ++n)
#pragma unroll
            for (int j = 0; j < 4; ++j) {
              int rl = m * 16 + fr, col = wc * 64 + n * 16 + 4 * fq + j;
              unsigned bits = (__float_as_uint(acc[m][n][j]) & ~127u) | (unsigned)col;
              sc[rl * 133 + (col >> 5) * 33 + (col & 31)] = __uint_as_float(bits);
            }
      }
      __syncthreads();
      const int rl = tid >> 2, q = tid & 3;
      const float* src = sc + rl * 133 + q * 33;
      float Ls[16], Hs[16];
#pragma unroll
      for (int i = 0; i < 16; ++i) { Ls[i] = src[i]; Hs[i] = src[16 + i]; }
      bitonic_sort16_desc(Ls);
      bitonic_sort16_desc(Hs);
#pragma unroll
      for (int i = 0; i < 16; ++i) Ls[i] = fmaxf(Ls[i], Hs[15 - i]);
#pragma unroll
      for (int d = 8; d >= 1; d >>= 1)
#pragma unroll
        for (int i = 0; i < 16; ++i)
          if ((i & d) == 0) { float hi = fmaxf(Ls[i], Ls[i + d]), lo = fminf(Ls[i], Ls[i + d]); Ls[i] = hi; Ls[i + d] = lo; }
      float Cs[16];
#pragma unroll
      for (int i = 0; i < 16; ++i) Cs[i] = fmaxf(Ls[i], dppself<0xB1, 0xF>(Ls[15 - i]));
#pragma unroll
      for (int d = 8; d >= 1; d >>= 1)
#pragma unroll
        for (int i = 0; i < 16; ++i)
          if ((i & d) == 0) { float hi = fmaxf(Cs[i], Cs[i + d]), lo = fminf(Cs[i], Cs[i + d]); Cs[i] = hi; Cs[i + d] = lo; }
      float Ds[16];
#pragma unroll
      for (int i = 0; i < 16; ++i) Ds[i] = fmaxf(Cs[i], dppself<0x4E, 0xF>(Cs[15 - i]));
#pragma unroll
      for (int d = 8; d >= 1; d >>= 1)
#pragma unroll
        for (int i = 0; i < 16; ++i)
          if ((i & d) == 0) { float hi = fmaxf(Ds[i], Ds[i + d]), lo = fminf(Ds[i], Ds[i + d]); Ds[i] = hi; Ds[i + d] = lo; }
      if (S == 0) {
#pragma unroll
        for (int i = 0; i < 16; ++i) keep[pass][i] = Ds[i];
      } else if (q == 0) {
        float* d1 = L1s + (pass * 64 + rl) * 16;
        float* d2 = L2s + (pass * 64 + rl) * 16;
#pragma unroll
        for (int i = 0; i < 4; ++i) {
          *(float4*)(d1 + 4 * i) = make_float4(keep[pass][4 * i], keep[pass][4 * i + 1], keep[pass][4 * i + 2], keep[pass][4 * i + 3]);
          *(float4*)(d2 + 4 * i) = make_float4(Ds[4 * i], Ds[4 * i + 1], Ds[4 * i + 2], Ds[4 * i + 3]);
        }
      }
    }
    if (S == 1) {
      __syncthreads();
      const int lane = tid & 63, wid = tid >> 6;
      int ci, cj;
      peer_cand_ij(lane, ci, cj);
      const bool cand = lane < 50;
      float n1 = L1s[(wid * 32) * 16 + ci], n2 = L2s[(wid * 32) * 16 + cj];
#pragma unroll 1
      for (int r = 0; r < 32; ++r) {
        const int row = wid * 32 + r;
        const float v1 = n1, v2 = n2;
        if (r + 1 < 32) { n1 = L1s[(row + 1) * 16 + ci]; n2 = L2s[(row + 1) * 16 + cj]; }
        float val = v1 + v2;
        val = __uint_as_float((__float_as_uint(val) & ~63u) | (unsigned)lane);
        val = cand ? val : -3e38f;
        int rank = 0;
#pragma unroll
        for (int q = 0; q < 50; ++q) rank += (readlane_f(val, q) > val) ? 1 : 0;
        const bool sel = cand && rank < 16;
        const float mx = readlane_f(val, 0);
        const float ex = sel ? __expf(val - mx) : 0.f;
        const float sm = wave_sum(ex);
        if (sel) {
          const int e = (int)(__float_as_uint(v1) & 127u) * 128 + (int)(__float_as_uint(v2) & 127u);
          const size_t o = (size_t)(row0 + row) * 128 + head * 16 + rank;
          p.EL[o] = (unsigned short)e;
          p.GT[o] = ex / sm;
        }
      }
    }
  }
};
DEV void ph_gemm3(const P& p, char* smem) {
  int rt, hd;
  for (int it = 0; gemm_unit(it, 8, rt, hd); ++it) {
    float keep[2][16];
    {
      Epi3K<0> epi{p, rt * 128, hd, keep};
      gemm_tile(p.H + (size_t)rt * 128 * D, D, p.Wft + (size_t)(2 * hd) * 128 * D, D, D, smem, epi);
    }
    {
      Epi3K<1> epi{p, rt * 128, hd, keep};
      gemm_tile(p.H + (size_t)rt * 128 * D, D, p.Wft + (size_t)(2 * hd + 1) * 128 * D, D, D, smem, epi);
    }
  }
}

DEV float peer_gate(float scr) {
  float mx = row16_max(scr);
  float ex = __expf(scr - mx);
  float sm = row16_sum(ex);
  return ex / sm;
}
DEV float gelu_exact(float x) { return 0.5f * x * (1.f + erff(x * 0.7071067811865476f)); }

struct PeerPre { uint4 e0, e1, a0, a1; };
DEV unsigned peer_eid(const PeerPre& s, int j) {
  const unsigned w = (j < 8) ? ((j >> 1) == 0 ? s.e0.x : (j >> 1) == 1 ? s.e0.y : (j >> 1) == 2 ? s.e0.z : s.e0.w)
                             : (((j - 8) >> 1) == 0 ? s.e1.x : ((j - 8) >> 1) == 1 ? s.e1.y : ((j - 8) >> 1) == 2 ? s.e1.z : s.e1.w);
  return (j & 1) ? (w >> 16) : (w & 0xFFFFu);
}
template <int WHICH>
DEV void peer_wave_run(const P& p, int layer, int x, int tok0, int lane, float* wbuf) {
  const int r = lane >> 3, c = lane & 7;
  const unsigned char* tb = (WHICH == 0 ? p.PU : p.PV) + (size_t)x * PSLICE + c * 16;
  PeerPre S[3];
  uint4 R[16];
  auto ld_pre = [&](int tok, PeerPre& s) {
    const uint4* elp = (const uint4*)(p.EL + (size_t)tok * 128 + r * 16);
    s.e0 = elp[0]; s.e1 = elp[1];
    if (WHICH == 0) {
      s.a0 = *(const uint4*)(p.H8 + (size_t)tok * 1024 + x * 128 + c * 16);
    } else {
      const uint4* wtp = (const uint4*)(p.GW + (size_t)tok * 128 + r * 16);
      s.a0 = wtp[0]; s.a1 = wtp[1];
    }
  };
  auto comp = [&](int tok, const PeerPre& s, const PeerPre& sn, bool more) {
    if (WHICH == 0) {
      int keep0 = 0, keep1 = 0;
#pragma unroll
      for (int j = 0; j < 16; ++j) {
        const uint4 rw = R[j];
        if (more) R[j] = *(const uint4*)(tb + (size_t)peer_eid(sn, j) * 128);
        int d = __builtin_amdgcn_sdot4((int)rw.x, (int)s.a0.x, 0, false);
        d = __builtin_amdgcn_sdot4((int)rw.y, (int)s.a0.y, d, false);
        d = __builtin_amdgcn_sdot4((int)rw.z, (int)s.a0.z, d, false);
        d = __builtin_amdgcn_sdot4((int)rw.w, (int)s.a0.w, d, false);
        d += __builtin_amdgcn_update_dpp(0, d, 0xB1, 0xF, 0xF, false);
        d += __builtin_amdgcn_update_dpp(0, d, 0x4E, 0xF, 0xF, false);
        d += __builtin_amdgcn_update_dpp(0, d, 0x141, 0xF, 0xF, false);
        if (j < 8) keep0 = (c == j) ? d : keep0; else keep1 = (c == j - 8) ? d : keep1;
      }
      bf16_t* pd = p.PD + ((size_t)x * NTOK + tok) * 128 + r * 16 + c;
      pd[0] = f2bf((float)keep0); pd[8] = f2bf((float)keep1);
    } else {
      float wsv[16];
      unpack8(s.a0, wsv); unpack8(s.a1, wsv + 8);
      f32x2 acc2[8];
#pragma unroll
      for (int i = 0; i < 8; ++i) acc2[i] = (f32x2){0.f, 0.f};
#pragma unroll
      for (int j = 0; j < 16; ++j) {
        f32x2 f[8];
        unpack16_fp8x2(R[j], f);
        if (more) R[j] = *(const uint4*)(tb + (size_t)peer_eid(sn, j) * 128);
        const f32x2 w2 = (f32x2){wsv[j], wsv[j]};
#pragma unroll
        for (int i = 0; i < 8; ++i) acc2[i] += w2 * f[i];
      }
      float* slab = wbuf + (r * 8 + c) * 16;
      *(float4*)(slab) = make_float4(acc2[0][0], acc2[0][1], acc2[1][0], acc2[1][1]);
      *(float4*)(slab + 4) = make_float4(acc2[2][0], acc2[2][1], acc2[3][0], acc2[3][1]);
      *(float4*)(slab + 8) = make_float4(acc2[4][0], acc2[4][1], acc2[5][0], acc2[5][1]);
      *(float4*)(slab + 12) = make_float4(acc2[6][0], acc2[6][1], acc2[7][0], acc2[7][1]);
      asm volatile("s_waitcnt lgkmcnt(0)" ::: "memory");
      float o0 = 0.f, o1 = 0.f;
#pragma unroll
      for (int rr = 0; rr < 8; ++rr) {
        const float2 t = *(const float2*)(wbuf + (rr * 8 + (lane >> 3)) * 16 + 2 * (lane & 7));
        o0 += t.x; o1 += t.y;
      }
      asm volatile("s_waitcnt lgkmcnt(0)" ::: "memory");
      const int b = tok / LT, pp = tok % LT;
      const int mr = pp < LC ? 16 : b;
      const int col = x * 128 + 2 * lane;
      const float* g2 = p.modv + ((size_t)layer * 17 + mr) * 6144 + 5120 + col;
      unsigned* xp = (unsigned*)(p.X + (size_t)tok * D + col);
      const unsigned xu = *xp;
      *xp = pack2(bflo(xu) + g2[0] * o0, bfhi(xu) + g2[1] * o1);
    }
  };
  ld_pre(tok0, S[0]);
  ld_pre(tok0 + 1, S[1]);
#pragma unroll
  for (int j = 0; j < 16; ++j) R[j] = *(const uint4*)(tb + (size_t)peer_eid(S[0], j) * 128);
  ld_pre(tok0 + 2, S[2]);
#pragma unroll
  for (int t = 0; t < 8; ++t) {
    comp(tok0 + t, S[t % 3], S[(t + 1) % 3], t + 1 < 8);
    if (t + 3 < 8) ld_pre(tok0 + t + 3, S[t % 3]);
  }
}
DEV void ph_peer_w(const P& p) {
  for (size_t i8 = (size_t)bid_() * 256 + tid_(); i8 < (size_t)NTOK * 16; i8 += (size_t)gridDim.x * 256) {
    const size_t i = i8 * 8;
    float d[8];
#pragma unroll
    for (int q = 0; q < 8; ++q) d[q] = 0.f;
#pragma unroll
    for (int x = 0; x < 8; ++x) {
      const uint4 u = *(const uint4*)(p.PD + (size_t)x * NTOK * 128 + i);
      float f[8];
      unpack8(u, f);
#pragma unroll
      for (int q = 0; q < 8; ++q) d[q] += f[q];
    }
    const uint4 eu = *(const uint4*)(p.EL + i);
    const unsigned ew[4] = {eu.x, eu.y, eu.z, eu.w};
    const float hinv = p.HINV[i >> 7];
    float4 g0 = *(const float4*)(p.GT + i), g1 = *(const float4*)(p.GT + i + 4);
    float g[8] = {g0.x, g0.y, g0.z, g0.w, g1.x, g1.y, g1.z, g1.w};
#pragma unroll
    for (int q = 0; q < 8; ++q) {
      const unsigned e = (q & 1) ? (ew[q >> 1] >> 16) : (ew[q >> 1] & 0xFFFFu);
      g[q] = g[q] * gelu_exact(d[q] * p.PSU[e] * hinv) * p.PSV[e];
    }
    *(uint4*)(p.GW + i) = pack8(g);
  }
}
template <int WHICH>
DEV void ph_peer_gather(const P& p, int layer, char* smem, volatile LAS unsigned* slot) {
  const int tid = tid_(), lane = tid & 63, wid = tid >> 6;
  unsigned* q = p.wq + 1024 + layer * 256 + WHICH * 128;
  const int my = (int)(xb_xcc_id() & 7u);
  float* wbuf = (float*)smem + wid * 1024;
#pragma unroll 1
  for (int rot = 0; rot < 8; ++rot) {
    const int x = (my + rot) & 7;
    for (;;) {
      __syncthreads();
      if (tid == 0) *slot = atomicAdd(q + x * 16, 1u);
      __syncthreads();
      const int it = (int)*slot;
      if (it >= NTOK / 64) break;
      peer_wave_run<WHICH>(p, layer, x, it * 64 + wid * 16, lane, wbuf);
      peer_wave_run<WHICH>(p, layer, x, it * 64 + wid * 16 + 8, lane, wbuf);
    }
  }
}

DEV void ph_final(const P& p) {
  const int lane = tid_() & 63;
  int r0, r1;
  wave_range(r0, r1, NB * T);
  float gv[16];
#pragma unroll
  for (int hh = 0; hh < 2; ++hh)
#pragma unroll
    for (int i = 0; i < 8; ++i) gv[hh * 8 + i] = p.final_g[hh * 512 + 8 * lane + i];
  auto xrow = [&](int r) -> const bf16_t* { const int b = r / T, t = r % T; return p.X + ((size_t)b * LT + LC + t) * D; };
  uint4 n0 = make_uint4(0, 0, 0, 0), n1 = n0;
  if (r0 < r1) { const bf16_t* xr = xrow(r0); n0 = *(const uint4*)(xr + 8 * lane); n1 = *(const uint4*)(xr + 512 + 8 * lane); }
#pragma unroll 1
  for (int r = r0; r < r1; ++r) {
    const uint4 u0 = n0, u1 = n1;
    if (r + 1 < r1) { const bf16_t* xr = xrow(r + 1); n0 = *(const uint4*)(xr + 8 * lane); n1 = *(const uint4*)(xr + 512 + 8 * lane); }
    float v[16];
    unpack8(u0, v); unpack8(u1, v + 8);
    float ss = 0.f;
#pragma unroll
    for (int i = 0; i < 16; ++i) ss += v[i] * v[i];
    ss = wave_sum(ss);
    const float rstd = rsqrtf(ss * (1.f / 1024.f) + 1e-6f);
    float* o = p.out + (size_t)r * D;
#pragma unroll
    for (int hh = 0; hh < 2; ++hh) {
      const int col = hh * 512 + 8 * lane;
      *(float4*)(o + col) = make_float4(v[hh * 8 + 0] * rstd * gv[hh * 8 + 0], v[hh * 8 + 1] * rstd * gv[hh * 8 + 1], v[hh * 8 + 2] * rstd * gv[hh * 8 + 2], v[hh * 8 + 3] * rstd * gv[hh * 8 + 3]);
      *(float4*)(o + col + 4) = make_float4(v[hh * 8 + 4] * rstd * gv[hh * 8 + 4], v[hh * 8 + 5] * rstd * gv[hh * 8 + 5], v[hh * 8 + 6] * rstd * gv[hh * 8 + 6], v[hh * 8 + 7] * rstd * gv[hh * 8 + 7]);
    }
  }
}

DEV unsigned hw_cu_key() {
  const unsigned hwid = (unsigned)__builtin_amdgcn_s_getreg(((8 - 1) << 11) | (8 << 6) | 4);
  return (xb_xcc_id() << 8) | (hwid & 0xFFu);
}
DEV void mixB(const P& p, int layer, char* smem, volatile LAS unsigned* slot) {
  unsigned* qa = p.wq + layer * 64;
  unsigned* qs = qa + 16;
  unsigned* claim = p.cuclaim + layer * 4096;
  __syncthreads();
  if (tid_() == 0) {
    unsigned u = 0xFFFFFFFFu;
    if (atomicAdd(&claim[hw_cu_key() & 4095u], 1u) == 0u) u = atomicAdd(qs, 1u);
    *slot = u;
  }
  __syncthreads();
  {
    const unsigned u = *slot;
    if (u < 128u) scanc_unit(p, layer, (int)u, smem);
  }
  for (;;) {
    __syncthreads();
    if (tid_() == 0) *slot = atomicAdd(qa, 1u);
    __syncthreads();
    const int u = (int)*slot;
    if (u >= 8704) break;
    if (u < 4352) attn_unit(p, layer, u, smem); else hyena_conv_unit(p, layer, u - 4352, smem);
  }
  if (layer + 1 < DEPTH) {
    unsigned* qp = qa + 32;
    for (;;) {
      __syncthreads();
      if (tid_() == 0) *slot = atomicAdd(qp, 1u);
      __syncthreads();
      const int u = (int)*slot;
      if (u >= PREPA_N) break;
      prep_unit(p, layer + 1, prepA_unit_index(u), smem);
    }
  }
  for (;;) {
    __syncthreads();
    if (tid_() == 0) *slot = atomicAdd(qs, 1u);
    __syncthreads();
    const unsigned u = *slot;
    if (u >= 128u) break;
    scanc_unit(p, layer, (int)u, smem);
  }
}
DEV void mixA(const P& p, int layer, char* smem) {
  for (int u = bid_(); u < 1088; u += gridDim.x) hyena_pre_unit(p, layer, u);
  ph_lora(p, layer, smem);
  ph_rwkv_prep(p, layer);
}
DEV void mixC(const P& p, int layer, char* smem) {
  for (int u = bid_(); u < 1088; u += gridDim.x) hyena_post_unit(p, layer, u, smem);
  ph_rwkv_post(p, layer);
  ph_attn_post(p, layer);
}

__global__ void __launch_bounds__(256, 2) k_mega(P p) {
  extern __shared__ __attribute__((aligned(16))) char smem_all[];
  char* smem = smem_all;
  volatile LAS unsigned* xbw = (volatile LAS unsigned*)(smem_all + SMEM_BYTES);
  if (threadIdx.x == 0) { xbw[0] = 0u; xbw[1] = 0u; xbw[2] = 0u; xbw[3] = 0u; }
  __syncthreads();
  XcdBarrier bar = xcd_barrier_post(p.bar, xbw);
  ph_rope(p);
  for (int u = blockIdx.x; u < 96; u += gridDim.x) modv_unit(p, u, smem);
  ph_prep(p, 0, smem, false);
  xcd_barrier(bar);
  for (int layer = 0; layer < DEPTH; ++layer) {
    if (layer == 0) ph_norm_first(p); else ph_norm(p, layer, 0);
    xcd_barrier(bar);
    ph_gemm1(p, smem);
    xcd_barrier(bar);
    mixA(p, layer, smem);
    xcd_barrier(bar);
    mixB(p, layer, smem, (volatile LAS unsigned*)(smem_all + SMEM_BYTES + 16));
    xcd_barrier(bar);
    mixC(p, layer, smem);
    xcd_barrier(bar);
    ph_gemm2(p, layer, smem);
    ph_peerconv(p, layer);
    xcd_barrier(bar);
    ph_norm(p, layer, 1);
    xcd_barrier(bar);
    ph_gemm3(p, smem);
    xcd_barrier(bar);
    ph_peer_gather<0>(p, layer, smem, (volatile LAS unsigned*)(smem_all + SMEM_BYTES + 16));
    xcd_barrier(bar);
    ph_peer_w(p);
    xcd_barrier(bar);
    ph_peer_gather<1>(p, layer, smem, (volatile LAS unsigned*)(smem_all + SMEM_BYTES + 16));
    if (layer + 1 < DEPTH) ph_prep(p, layer + 1, smem, true);
    xcd_barrier(bar);
  }
  ph_final(p);
}

static inline size_t al256(size_t x) { return (x + 255) & ~(size_t)255; }

extern "C" void kernel_launch(void* const* d_in, const int* in_sizes, int n_in, void* d_out, int out_size, void* d_ws, size_t ws_size,
                              hipStream_t stream) {
  (void)in_sizes; (void)n_in; (void)out_size; (void)ws_size;
  P p{};
  const float** f = (const float**)&p;
  for (int i = 0; i < 39; ++i) f[i] = (const float*)d_in[i];
  p.out = (float*)d_out;
  char* w = (char*)d_ws;
  size_t off = 0;
  auto take = [&](size_t bytes) { char* r = w + off; off += al256(bytes); return r; };
  p.bar = (unsigned*)take(16384);
  p.modv = (float*)take((size_t)DEPTH * 17 * 6144 * 4);
  p.SSQ = (float*)take((size_t)DEPTH * 2 * 256 * 4);
  p.wq = (unsigned*)take(4096 + DEPTH * 1024);
  p.cuclaim = (unsigned*)take((size_t)DEPTH * 4096 * 4);
  const size_t zero_bytes = off;
  p.rope = (float*)take(64 * 16 * 2 * 4);
  p.X = (bf16_t*)take((size_t)NTOK * D * 2);
  p.H = (bf16_t*)take((size_t)NTOK * D * 2);
  p.Y = (bf16_t*)take((size_t)NTOK * D * 2);
  p.SC = (bf16_t*)take((size_t)NTOK * 1024 * 2);
  p.Z = (bf16_t*)take((size_t)NTOK * INW * 2);
  p.UTl = (bf16_t*)take((size_t)256 * 16 * T * 2);
  p.UTc = (bf16_t*)take((size_t)256 * 16 * LC * 2);
  p.YTl = (bf16_t*)take((size_t)256 * 16 * T * 2);
  p.YTc = (bf16_t*)take((size_t)256 * 16 * LC * 2);
  p.FL = (float*)take((size_t)256 * 2 * T * 4);
  p.FC = (float*)take((size_t)256 * 2 * LC * 4);
  p.W1t = (bf16_t*)take((size_t)INW * D * 2);
  p.W2t = (bf16_t*)take((size_t)D * D * 2);
  p.Wft = (bf16_t*)take((size_t)2048 * D * 2);
  p.Wlt = (bf16_t*)take((size_t)1024 * 256 * 2);
  p.Wgt = (bf16_t*)take((size_t)256 * 128 * 2);
  p.TK = (float*)p.Z;
  p.PU = (unsigned char*)p.Z + al256((size_t)NTOK * 256 * 4);
  p.PV = p.PU + (size_t)16384 * 1024;
  p.PSU = (float*)(p.PV + (size_t)16384 * 1024);
  p.PSV = p.PSU + 16384;
  p.GT = p.PSV + 16384;
  p.EL = (unsigned short*)(p.GT + (size_t)NTOK * 128);
  p.H8 = (unsigned char*)p.EL + al256((size_t)NTOK * 128 * 2);
  p.HINV = (float*)(p.H8 + (size_t)NTOK * 1024);
  p.GW = (bf16_t*)((char*)p.HINV + al256((size_t)NTOK * 4));
  p.PD = p.Y;

  (void)hipMemsetAsync(d_ws, 0, zero_bytes, stream);
  constexpr size_t kDynLds = SMEM_BYTES + 32;
  static int grid = 0;
  if (!grid) {
    int dev = 0, cus = 0, per_cu = 0;
    (void)hipGetDevice(&dev);
    (void)hipDeviceGetAttribute(&cus, hipDeviceAttributeMultiprocessorCount, dev);
    (void)hipFuncSetAttribute((const void*)k_mega, hipFuncAttributeMaxDynamicSharedMemorySize, (int)kDynLds);
    (void)hipOccupancyMaxActiveBlocksPerMultiprocessor(&per_cu, k_mega, 256, kDynLds);
    if (cus <= 0) cus = 256;
    if (per_cu > 2) per_cu = 2;
    if (per_cu < 1) per_cu = 1;
    grid = cus * per_cu;
  }
  k_mega<<<grid, 256, kDynLds, stream>>>(p);
}
```

```cpp
#include <hip/hip_runtime.h>
#include <stdint.h>
#include <type_traits>

#define DEV __device__ __forceinline__
typedef unsigned short bf16_t;
typedef short bf16x8 __attribute__((ext_vector_type(8)));
typedef float f32x2 __attribute__((ext_vector_type(2)));
constexpr size_t PSLICE = (size_t)16384 * 128;
typedef float f32x4 __attribute__((ext_vector_type(4)));
typedef float f32x16 __attribute__((ext_vector_type(16)));


constexpr int NB = 16, T = 4096, LC = 256, LT = 4352, D = 1024, NTOK = NB * LT, INW = 2688, DEPTH = 4;
constexpr int SMEM_BYTES = 65536;

struct P {
  const float *x, *c, *ctx, *c_ctx, *mod_w, *mod_b, *norm1_g, *norm2_g, *w_in, *conv_w, *conv_b;
  const float *hy_w1, *hy_b1, *hy_w2, *hy_b2, *hy_w3, *hy_b3, *hy_freq, *hy_bias;
  const float *rw_w0, *rw_w_up, *rw_a0, *rw_a_up, *rw_g_up, *rw_k_k, *rw_k_a, *rw_r_k, *rw_ln_w, *rw_ln_b;
  const float *attn_sink, *hy_out_g, *at_out_g, *w_out, *peer_wq, *peer_k1, *peer_k2, *peer_u, *peer_v, *final_g;
  float* out;
  unsigned* bar;
  float *modv, *SSQ, *rope, *FL, *FC, *TK;
  unsigned *wq, *cuclaim;
  bf16_t *X, *H, *Y, *SC, *Z, *UTl, *UTc, *YTl, *YTc;
  bf16_t *W1t, *W2t, *Wft, *Wlt, *Wgt;
  unsigned char *PU, *PV;
  float *PSU, *PSV, *GT, *HINV;
  bf16_t *PD, *GW;
  unsigned short* EL;
  unsigned char* H8;
};

typedef __bf16 hwbf2 __attribute__((ext_vector_type(2)));
DEV unsigned pack2(float a, float b) { f32x2 f = {a, b}; hwbf2 r = __builtin_convertvector(f, hwbf2); return __builtin_bit_cast(unsigned, r); }
DEV bf16_t f2bf(float f) { return (bf16_t)(pack2(f, 0.f) & 0xFFFFu); }
DEV float bf2f(bf16_t h) { return __uint_as_float(((unsigned)h) << 16); }
DEV float bflo(unsigned u) { return __uint_as_float(u << 16); }
DEV float bfhi(unsigned u) { return __uint_as_float(u & 0xFFFF0000u); }
DEV void unpack8(const uint4& u, float* v) {
  v[0] = bflo(u.x); v[1] = bfhi(u.x); v[2] = bflo(u.y); v[3] = bfhi(u.y);
  v[4] = bflo(u.z); v[5] = bfhi(u.z); v[6] = bflo(u.w); v[7] = bfhi(u.w);
}
DEV uint4 pack8(const float* v) { return make_uint4(pack2(v[0], v[1]), pack2(v[2], v[3]), pack2(v[4], v[5]), pack2(v[6], v[7])); }
DEV int pack_i8(float a, float b, float c, float d) {
  const int ia = __float2int_rn(a), ib = __float2int_rn(b), ic = __float2int_rn(c), id = __float2int_rn(d);
  return (ia & 0xFF) | ((ib & 0xFF) << 8) | ((ic & 0xFF) << 16) | ((id & 0xFF) << 24);
}
DEV float sigmoidf_(float x) { return __builtin_amdgcn_rcpf(1.f + __expf(-x)); }

template <int CTRL, int ROWMASK>
DEV float dpp0(float x) {
  return __builtin_bit_cast(float, __builtin_amdgcn_update_dpp(0, __builtin_bit_cast(int, x), CTRL, ROWMASK, 0xF, false));
}
template <int CTRL, int ROWMASK>
DEV float dppself(float x) {
  int xi = __builtin_bit_cast(int, x);
  return __builtin_bit_cast(float, __builtin_amdgcn_update_dpp(xi, xi, CTRL, ROWMASK, 0xF, false));
}
DEV float readlane_f(float x, int l) { return __builtin_bit_cast(float, __builtin_amdgcn_readlane(__builtin_bit_cast(int, x), l)); }
DEV int lane_id() { return (int)__builtin_amdgcn_mbcnt_hi(~0u, __builtin_amdgcn_mbcnt_lo(~0u, 0u)); }
DEV float writelane_f(float val, int l, float old) { return lane_id() == l ? val : old; }
DEV int writelane_i(int val, int l, int old) { return lane_id() == l ? val : old; }
DEV float wave_sum(float x) {
  x += dpp0<0x111, 0xF>(x); x += dpp0<0x112, 0xF>(x); x += dpp0<0x114, 0xF>(x); x += dpp0<0x118, 0xF>(x);
  x += dpp0<0x142, 0xA>(x); x += dpp0<0x143, 0xC>(x);
  return readlane_f(x, 63);
}
DEV float wave_max(float x) {
  x = fmaxf(x, dppself<0x111, 0xF>(x)); x = fmaxf(x, dppself<0x112, 0xF>(x)); x = fmaxf(x, dppself<0x114, 0xF>(x));
  x = fmaxf(x, dppself<0x118, 0xF>(x)); x = fmaxf(x, dppself<0x142, 0xA>(x)); x = fmaxf(x, dppself<0x143, 0xC>(x));
  return readlane_f(x, 63);
}
DEV float row16_sum(float x) {
  x += dpp0<0xB1, 0xF>(x); x += dpp0<0x4E, 0xF>(x); x += dpp0<0x141, 0xF>(x); x += dpp0<0x140, 0xF>(x);
  return x;
}
DEV float row16_max(float x) {
  x = fmaxf(x, dppself<0xB1, 0xF>(x)); x = fmaxf(x, dppself<0x4E, 0xF>(x)); x = fmaxf(x, dppself<0x141, 0xF>(x));
  x = fmaxf(x, dppself<0x140, 0xF>(x));
  return x;
}
DEV float quad_sum(float x) { x += dpp0<0xB1, 0xF>(x); x += dpp0<0x4E, 0xF>(x); return x; }

DEV f32x4 mfma16(bf16x8 a, bf16x8 b, f32x4 c) { return __builtin_amdgcn_mfma_f32_16x16x32_bf16(a, b, c, 0, 0, 0); }
DEV f32x16 mfma32(bf16x8 a, bf16x8 b, f32x16 c) { return __builtin_amdgcn_mfma_f32_32x32x16_bf16(a, b, c, 0, 0, 0); }


#define XB_TMO      128
#define XB_XCNT(j)  (256  + 64 * (j))
#define XB_XSUB(j)  (1280 + 64 * (j))
#define XB_XGEN(j)  (2304 + 64 * (j))
#define XB_TOP      3328
#define XB_TOPGEN   3392
#define XCD_BAR_WORDS 3456
#define XB_SPIN_CAP (1u << 23)
#define LAS __attribute__((address_space(3)))

__device__ __forceinline__ unsigned xb_ld(unsigned* p)              { return __hip_atomic_load(p, __ATOMIC_RELAXED, __HIP_MEMORY_SCOPE_AGENT); }
__device__ __forceinline__ unsigned xb_add(unsigned* p, unsigned v) { return __hip_atomic_fetch_add(p, v, __ATOMIC_RELAXED, __HIP_MEMORY_SCOPE_AGENT); }
__device__ __forceinline__ unsigned xb_xcc_id() { return (unsigned)__builtin_amdgcn_s_getreg((3 << 11) | 20) & 0xFu; }
#define XB_SPIN(cond, bar) do { unsigned _sp = 0; while (cond) { __builtin_amdgcn_s_sleep(1); \
    if ((++_sp & 255u) == 0u) { if (xb_ld(&(bar)[XB_TMO])) break; if (_sp > XB_SPIN_CAP) { atomicAdd(&(bar)[XB_TMO], 1u); break; } } } } while (0)

struct XcdBarrier {
    unsigned* bar; unsigned x;
    volatile LAS unsigned* st;
};
__device__ __forceinline__ XcdBarrier xcd_barrier_post(unsigned* bar, volatile LAS unsigned* st) {
    XcdBarrier b; b.bar = bar; b.x = xb_xcc_id(); b.st = st;
    if (threadIdx.x == 0) (void)xb_add(&bar[XB_XCNT(b.x)], 1u);
    return b;
}
__device__ __forceinline__ void xcd_barrier_complete(unsigned* bar, unsigned x, unsigned& nloc, unsigned& nx) {
    const unsigned G = gridDim.x * gridDim.y * gridDim.z;
    unsigned sum, cnt, mine, sp = 0u;
    for (;;) {
        sum = 0u; cnt = 0u; mine = 0u;
#pragma unroll
        for (unsigned j = 0; j < 16; ++j) { const unsigned c = xb_ld(&bar[XB_XCNT(j)]); sum += c; cnt += (c > 0u) ? 1u : 0u; mine = (j == x) ? c : mine; }
        if (sum == G) break;
        __builtin_amdgcn_s_sleep(1);
        if ((++sp & 255u) == 0u) { if (xb_ld(&bar[XB_TMO])) break; if (sp > XB_SPIN_CAP) { atomicAdd(&bar[XB_TMO], 1u); break; } }
    }
    nloc = mine > 0u ? mine : 1u; nx = cnt > 0u ? cnt : 1u;
}
__device__ __forceinline__ void xcd_barrier(const XcdBarrier& b) {
    asm volatile("s_waitcnt vmcnt(0)" ::: "memory");
    __syncthreads();
    if (threadIdx.x == 0) {
        unsigned* bar = b.bar;
        __builtin_amdgcn_s_waitcnt(0);
        unsigned nloc = b.st[0], nx = b.st[1];
        if (nloc == 0u) { xcd_barrier_complete(bar, b.x, nloc, nx); b.st[0] = nloc; b.st[1] = nx; }
        const unsigned old = xb_add(&bar[XB_XSUB(b.x)], 1u);
        const unsigned gen = old / nloc;
        if (old + 1u == (gen + 1u) * nloc) {
            __builtin_amdgcn_fence(__ATOMIC_RELEASE, "agent");
            asm volatile("s_waitcnt vmcnt(0)" ::: "memory");
            const unsigned og = xb_add(&bar[XB_TOP], 1u);
            const unsigned tg = og / nx;
            if (og + 1u == (tg + 1u) * nx) xb_add(&bar[XB_TOPGEN], 1u);
            else XB_SPIN(xb_ld(&bar[XB_TOPGEN]) == tg, bar);
            __builtin_amdgcn_fence(__ATOMIC_ACQUIRE, "agent");
            xb_add(&bar[XB_XGEN(b.x)], 1u);
            asm volatile("s_waitcnt vmcnt(0)" ::: "memory");
        } else {
            XB_SPIN(xb_ld(&bar[XB_XGEN(b.x)]) == gen, bar);
            __builtin_amdgcn_fence(__ATOMIC_ACQUIRE, "agent");
            asm volatile("s_waitcnt vmcnt(0)" ::: "memory");
        }
    }
    __syncthreads();
}

template <class Tp> DEV Tp* opq(Tp* q) { asm volatile("" : "+s"(q)); return q; }
DEV int tid_() { int t = threadIdx.x; asm volatile("" : "+v"(t)); return t; }
DEV int bid_() { int b = blockIdx.x; asm volatile("" : "+s"(b)); return b; }

DEV void glds16(const void* gsrc, char* lds_lane_ptr) {
  __builtin_amdgcn_global_load_lds((const unsigned*)gsrc, (__attribute__((address_space(3))) unsigned*)lds_lane_ptr, 16, 0, 0);
}
template <class Epi>
DEV void gemm_tile(const bf16_t* __restrict__ A, int lda, const bf16_t* __restrict__ Bt, int ldb, int K, char* smem, Epi& epi) {
  const int tid = tid_(), lane = tid & 63, wid = tid >> 6, wr = wid >> 1, wc = wid & 1, fr = lane & 15, fq = lane >> 4;
  f32x4 acc[4][4];
#pragma unroll
  for (int m = 0; m < 4; ++m)
#pragma unroll
    for (int n = 0; n < 4; ++n) acc[m][n] = (f32x4){0.f, 0.f, 0.f, 0.f};
  const int drow0 = 8 * wid + (lane >> 3), dpc = lane & 7;
  auto issue = [&](int kt, int buf) {
    char* sa = smem + buf * 32768;
    char* sb = sa + 16384;
#pragma unroll
    for (int i = 0; i < 4; ++i) {
      const int row = drow0 + 32 * i;
      const int kc = dpc ^ ((row >> 1) & 7);
      glds16(A + (size_t)row * lda + kt * 64 + kc * 8, sa + (i * 4 + wid) * 1024 + lane * 16);
      glds16(Bt + (size_t)row * ldb + kt * 64 + kc * 8, sb + (i * 4 + wid) * 1024 + lane * 16);
    }
  };
  __syncthreads();
  issue(0, 0);
  const int nk = K >> 6;
  const int sw = (fr >> 1) & 7;
  const int aoff = (wr * 64 + fr) * 128, boff = (wc * 64 + fr) * 128;
  for (int kt = 0; kt < nk; ++kt) {
    asm volatile("s_waitcnt vmcnt(0)" ::: "memory");
    __syncthreads();
    if (kt + 1 < nk) issue(kt + 1, (kt + 1) & 1);
    const char* sa = smem + (kt & 1) * 32768;
    const char* sb = sa + 16384;
#pragma unroll
    for (int kh = 0; kh < 2; ++kh) {
      const int pc = ((kh * 4 + fq) ^ sw) * 16;
      bf16x8 af[4], bfr[4];
#pragma unroll
      for (int m = 0; m < 4; ++m) af[m] = *(const bf16x8*)(sa + aoff + m * 2048 + pc);
#pragma unroll
      for (int n = 0; n < 4; ++n) bfr[n] = *(const bf16x8*)(sb + boff + n * 2048 + pc);
#pragma unroll
      for (int m = 0; m < 4; ++m)
#pragma unroll
        for (int n = 0; n < 4; ++n) acc[m][n] = mfma16(bfr[n], af[m], acc[m][n]);
    }
  }
  __syncthreads();
  epi(acc, wr, wc, fr, fq, smem);
}
DEV void stage_tile_bf16(const f32x4 (&acc)[4][4], char* smem, int wid, int fr, int fq) {
  bf16_t (*t)[72] = (bf16_t (*)[72])(smem + wid * 9216);
#pragma unroll
  for (int m = 0; m < 4; ++m)
#pragma unroll
    for (int n = 0; n < 4; ++n)
      *(uint2*)&t[m * 16 + fr][n * 16 + 4 * fq] = make_uint2(pack2(acc[m][n][0], acc[m][n][1]), pack2(acc[m][n][2], acc[m][n][3]));
  asm volatile("s_waitcnt lgkmcnt(0)" ::: "memory");
}

DEV void ph_copy(const P& p) {
  const size_t n8 = (size_t)NTOK * D / 8;
  const float* pctx = opq(p.ctx); const float* px = opq(p.x);
  for (size_t i = (size_t)bid_() * 256 + tid_(); i < n8; i += (size_t)gridDim.x * 256) {
    size_t e = i * 8;
    int row = (int)(e / D), col = (int)(e % D);
    int b = row / LT, pp = row % LT;
    const float* src = pp < LC ? pctx + ((size_t)(b * LC + pp)) * D + col : px + ((size_t)(b * T + pp - LC)) * D + col;
    float4 v0 = *(const float4*)src, v1 = *(const float4*)(src + 4);
    uint4 o = make_uint4(pack2(v0.x, v0.y), pack2(v0.z, v0.w), pack2(v1.x, v1.y), pack2(v1.z, v1.w));
    *(uint4*)(p.X + e) = o;
  }
}

DEV void ph_rope(const P& p) {
  for (int i = bid_() * 256 + tid_(); i < 64 * 16; i += gridDim.x * 256) {
    int pos = i >> 4, k = i & 15;
    float inv = powf(10000.f, -(float)k / 16.f);
    float ang = (float)pos * inv;
    p.rope[2 * i] = cosf(ang); p.rope[2 * i + 1] = sinf(ang);
  }
}

DEV void modv_unit(const P& p, int unit, char* smem) {
  const int cc = unit % 24, layer = unit / 24;
  float (*cs)[128] = (float (*)[128])smem;
  const int col = cc * 256 + tid_();
  const float* pc = opq(p.c); const float* pcc = opq(p.c_ctx);
  float acc[17];
#pragma unroll
  for (int r = 0; r < 17; ++r) acc[r] = 0.f;
  for (int ks = 0; ks < 8; ++ks) {
    __syncthreads();
    for (int i = tid_(); i < 17 * 128; i += 256) {
      int r = i >> 7, e = i & 127;
      float v = r < 16 ? pc[r * D + ks * 128 + e] : pcc[ks * 128 + e];
      cs[r][e] = v / (1.f + expf(-v));
    }
    __syncthreads();
    const float* w = p.mod_w + ((size_t)layer * D + ks * 128) * 6144 + col;
#pragma unroll 1
    for (int e0 = 0; e0 < 128; e0 += 32) {
      float wv[32];
#pragma unroll
      for (int q = 0; q < 32; ++q) wv[q] = w[(size_t)(e0 + q) * 6144];
#pragma unroll
      for (int q4 = 0; q4 < 8; ++q4) {
      const int e = e0 + 4 * q4;
      const float w0 = wv[4 * q4], w1 = wv[4 * q4 + 1], w2 = wv[4 * q4 + 2], w3 = wv[4 * q4 + 3];
#pragma unroll
      for (int r = 0; r < 17; ++r) {
        const float4 cv = *(const float4*)&cs[r][e];
        acc[r] += cv.x * w0 + cv.y * w1 + cv.z * w2 + cv.w * w3;
      }
      }
    }
  }
  const float bias = p.mod_b[layer * 6144 + col];
#pragma unroll
  for (int r = 0; r < 17; ++r) p.modv[((size_t)layer * 17 + r) * 6144 + col] = acc[r] + bias;
}

DEV void transpose_unit(const float* __restrict__ src, bf16_t* __restrict__ dst, int R, int C, int tile, char* smem) {
  float (*t)[65] = (float (*)[65])smem;
  const int nct = C / 64;
  const int tr = tile / nct, tc = tile % nct;
  __syncthreads();
  for (int i = tid_(); i < 4096; i += 256) { int r = i >> 6, c = i & 63; t[r][c] = src[(size_t)(tr * 64 + r) * C + tc * 64 + c]; }
  __syncthreads();
  for (int i = tid_(); i < 4096; i += 256) { int c = i >> 6, r = i & 63; dst[(size_t)(tc * 64 + c) * R + tr * 64 + r] = f2bf(t[r][c]); }
}

DEV void wfold_unit(const P& p, int layer, int unit, char* smem) {
  const int hs = unit >> 5, ec = unit & 31, h = hs >> 1, s = hs & 1;
  const float* wq = p.peer_wq + (size_t)layer * D * 2048;
  const float* kk = (s ? opq(p.peer_k2) : opq(p.peer_k1)) + ((size_t)layer * 8 + h) * 128 * 128;
  float (*kS)[65] = (float (*)[65])smem;
  float (*wS)[64] = (float (*)[64])(smem + 33280);
  const int key = tid_() & 127, eh = tid_() >> 7;
  float acc[16];
#pragma unroll
  for (int i = 0; i < 16; ++i) acc[i] = 0.f;
  for (int dh = 0; dh < 2; ++dh) {
    __syncthreads();
    for (int i = tid_(); i < 128 * 64; i += 256) { int k2 = i >> 6, d = i & 63; kS[k2][d] = kk[k2 * 128 + dh * 64 + d]; }
    for (int i = tid_(); i < 32 * 64; i += 256) {
      int e = i >> 6, d = i & 63;
      wS[e][d] = wq[(size_t)(ec * 32 + e) * 2048 + h * 256 + s * 128 + dh * 64 + d];
    }
    __syncthreads();
#pragma unroll 2
    for (int d = 0; d < 64; d += 4) {
      const float k0 = kS[key][d], k1 = kS[key][d + 1], k2 = kS[key][d + 2], k3 = kS[key][d + 3];
#pragma unroll
      for (int i = 0; i < 16; ++i) {
        const float4 wv = *(const float4*)&wS[eh * 16 + i][d];
        acc[i] += k0 * wv.x + k1 * wv.y + k2 * wv.z + k3 * wv.w;
      }
    }
  }
  bf16_t* dst = p.Wft + ((size_t)(hs * 128 + key)) * D + ec * 32 + eh * 16;
#pragma unroll
  for (int i = 0; i < 16; i += 2) *(unsigned*)(dst + i) = pack2(acc[i], acc[i + 1]);
}

DEV void filt_unit(const P& p, int layer, int unit, char* smem) {
  int kind, j0, L;
  if (unit < 1024) { kind = 0; j0 = unit * 4; L = T; } else { kind = 1; j0 = (unit - 1024) * 4; L = LC; }
  float* zs = (float*)smem;
  float* h1 = zs + 4 * 36;
  float* h2 = h1 + 256;
  const int jj = tid_() >> 6, o = tid_() & 63;
  const int j = j0 + jj;
  const float fj = (float)j;
  const float t = fj / (float)(L - 1);
  __syncthreads();
  if (o < 33) {
    float z;
    if (o == 0) z = t;
    else {
      int i = (o - 1) & 15;
      float band = 1e-4f + (float)i * ((15.0f - 1e-4f) / 15.0f);
      float ang = 6.283185307179586f * fj * band / (float)L;
      z = (o <= 16) ? cosf(ang) : -sinf(ang);
    }
    zs[jj * 36 + o] = z;
  }
  __syncthreads();
  {
    const float* w1 = p.hy_w1 + layer * 33 * 64;
    float a = p.hy_b1[layer * 64 + o];
#pragma unroll 3
    for (int i = 0; i < 33; ++i) a += zs[jj * 36 + i] * w1[i * 64 + o];
    h1[jj * 64 + o] = sinf(p.hy_freq[layer * 128 + o] * a);
  }
  __syncthreads();
  {
    const float* w2 = p.hy_w2 + layer * 64 * 64;
    float a = p.hy_b2[layer * 64 + o];
#pragma unroll 4
    for (int i = 0; i < 64; ++i) a += h1[jj * 64 + i] * w2[i * 64 + o];
    h2[jj * 64 + o] = sinf(p.hy_freq[layer * 128 + 64 + o] * a);
  }
  __syncthreads();
  const float* w3 = p.hy_w3 + layer * 64 * 512;
  float* F = kind ? opq(p.FC) : opq(p.FL);
  const float DMIN = -3.0701134573253945f, DMAX = -15.350567286626973f;
#pragma unroll 1
  for (int m = 0; m < 4; ++m) {
    int c = o + 64 * m;
    float af = p.hy_b3[layer * 512 + c], ab = p.hy_b3[layer * 512 + 256 + c];
#pragma unroll 4
    for (int i = 0; i < 64; ++i) { float hv = h2[jj * 64 + i]; af += hv * w3[i * 512 + c]; ab += hv * w3[i * 512 + 256 + c]; }
    float delta = fabsf(DMIN + (float)c * ((DMAX - DMIN) / 255.f));
    float win = expf(-t * delta) + 0.05f;
    af *= win; ab *= win;
    F[((size_t)c * 2 + 0) * L + j] = af;
    F[((size_t)c * 2 + 1) * L + j] = ab;
  }
}

constexpr int PREP_T0 = 672, PREP_T1 = PREP_T0 + 256, PREP_T2 = PREP_T1 + 8, PREP_T3 = PREP_T2 + 8, PREP_T4 = PREP_T3 + 8;
constexpr int PREP_WF = PREP_T4 + 512, PREP_N = PREP_WF + 1088;
DEV void prep_unit(const P& p, int layer, int u, char* smem) {
  if (u < PREP_T0) transpose_unit(p.w_in + (size_t)layer * D * INW, p.W1t, D, INW, u, smem);
  else if (u < PREP_T1) transpose_unit(p.w_out + (size_t)layer * D * D, p.W2t, D, D, u - PREP_T0, smem);
  else if (u < PREP_T3) {
    const int u0 = u - PREP_T1;
    for (int i = tid_(); i < 64 * 256; i += 256) {
      const int np = u0 * 64 + (i >> 8), kp = i & 255;
      const int ps = np & 3, chan = np >> 2, qp = kp >> 6, kk = kp & 63;
      const int is_a = ps & 1, d = ps >> 1;
      float v = 0.f;
      if (qp == (is_a ? 2 + d : d)) v = (is_a ? opq(p.rw_a_up) : opq(p.rw_w_up))[(((size_t)layer * 2 + d) * 64 + kk) * 256 + chan];
      p.Wlt[(size_t)np * 256 + kp] = f2bf(v);
    }
  }
  else if (u < PREP_T4) transpose_unit(p.rw_g_up + (size_t)layer * 128 * 256, p.Wgt, 128, 256, u - PREP_T3, smem);
  else if (u < PREP_WF) wfold_unit(p, layer, u - PREP_T4, smem);
  else filt_unit(p, layer, u - PREP_WF, smem);
}
constexpr int PREPA_N = PREP_T0 + (PREP_T4 - PREP_T1);
DEV int prepA_unit_index(int i) { return i < PREP_T0 ? i : PREP_T1 + (i - PREP_T0); }
DEV void ph_prep(const P& p, int layer, char* smem, bool onlyB) {
  for (int u = bid_(); u < PREP_N; u += gridDim.x) {
    const bool isA = (u < PREP_T0) || (u >= PREP_T1 && u < PREP_T4);
    if (onlyB && isA) continue;
    prep_unit(p, layer, u, smem);
  }
}

DEV void wave_range(int& r0, int& r1, int ntok) {
  const int gw = (bid_() * 256 + tid_()) >> 6, nw = gridDim.x * 4;
  const int per = (ntok + nw - 1) / nw;
  r0 = gw * per; r1 = r0 + per; if (r1 > ntok) r1 = ntok;
}
DEV void ph_norm_first(const P& p) {
  const int lane = tid_() & 63;
  int r0, r1;
  wave_range(r0, r1, NTOK);
  const float* pctx = opq(p.ctx); const float* px = opq(p.x);
  float gv[16], scv[16], shv[16];
#pragma unroll
  for (int hh = 0; hh < 2; ++hh)
#pragma unroll
    for (int i = 0; i < 8; ++i) gv[hh * 8 + i] = p.norm1_g[hh * 512 + 8 * lane + i];
  int mr_cur = -1;
  auto srcrow = [&](int row) -> const float* {
    const int b = row / LT, pp = row % LT;
    return pp < LC ? pctx + ((size_t)(b * LC + pp)) * D : px + ((size_t)(b * T + pp - LC)) * D;
  };
  float4 n0, n1, n2, n3;
  auto ld = [&](int row) { const float* s0 = srcrow(row) + 8 * lane; n0 = *(const float4*)s0; n1 = *(const float4*)(s0 + 4); n2 = *(const float4*)(s0 + 512); n3 = *(const float4*)(s0 + 516); };
  if (r0 < r1) ld(r0);
#pragma unroll 1
  for (int row = r0; row < r1; ++row) {
    float v[16] = {n0.x, n0.y, n0.z, n0.w, n1.x, n1.y, n1.z, n1.w, n2.x, n2.y, n2.z, n2.w, n3.x, n3.y, n3.z, n3.w};
    if (row + 1 < r1) ld(row + 1);
    const int b = row / LT, pp = row % LT;
    const int mr = pp < LC ? 16 : b;
    if (mr != mr_cur) {
      mr_cur = mr;
      const float* mv = p.modv + (size_t)mr * 6144;
#pragma unroll
      for (int hh = 0; hh < 2; ++hh)
#pragma unroll
        for (int i = 0; i < 8; ++i) { shv[hh * 8 + i] = mv[hh * 512 + 8 * lane + i]; scv[hh * 8 + i] = 1.f + mv[1024 + hh * 512 + 8 * lane + i]; }
    }
    bf16_t* xr = p.X + (size_t)row * D;
    const uint4 x0 = pack8(v), x1 = pack8(v + 8);
    *(uint4*)(xr + 8 * lane) = x0;
    *(uint4*)(xr + 512 + 8 * lane) = x1;
    unpack8(x0, v); unpack8(x1, v + 8);
    float ss = 0.f;
#pragma unroll
    for (int i = 0; i < 16; ++i) ss += v[i] * v[i];
    ss = wave_sum(ss);
    const float rstd = rsqrtf(ss * (1.f / 1024.f) + 1e-6f);
    float o[16];
#pragma unroll
    for (int i = 0; i < 16; ++i) o[i] = (v[i] * rstd * gv[i]) * scv[i] + shv[i];
    bf16_t* hr = p.H + (size_t)row * D;
    *(uint4*)(hr + 8 * lane) = pack8(o);
    *(uint4*)(hr + 512 + 8 * lane) = pack8(o + 8);
  }
}
DEV void ph_norm(const P& p, int layer, int which) {
  const int lane = tid_() & 63;
  int r0, r1;
  wave_range(r0, r1, NTOK);
  const float* g = (which ? p.norm2_g : p.norm1_g) + layer * D;
  float gv[16], scv[16], shv[16];
#pragma unroll
  for (int hh = 0; hh < 2; ++hh)
#pragma unroll
    for (int i = 0; i < 8; ++i) gv[hh * 8 + i] = g[hh * 512 + 8 * lane + i];
  int mr_cur = -1;
  uint4 n0 = make_uint4(0, 0, 0, 0), n1 = n0;
  if (r0 < r1) { const bf16_t* xr = p.X + (size_t)r0 * D; n0 = *(const uint4*)(xr + 8 * lane); n1 = *(const uint4*)(xr + 512 + 8 * lane); }
#pragma unroll 1
  for (int row = r0; row < r1; ++row) {
    const uint4 u0 = n0, u1 = n1;
    if (row + 1 < r1) { const bf16_t* xr = p.X + (size_t)(row + 1) * D; n0 = *(const uint4*)(xr + 8 * lane); n1 = *(const uint4*)(xr + 512 + 8 * lane); }
    const int b = row / LT, pp = row % LT;
    const int mr = pp < LC ? 16 : b;
    if (mr != mr_cur) {
      mr_cur = mr;
      const float* mv = p.modv + ((size_t)layer * 17 + mr) * 6144 + (which ? 3072 : 0);
#pragma unroll
      for (int hh = 0; hh < 2; ++hh)
#pragma unroll
        for (int i = 0; i < 8; ++i) { shv[hh * 8 + i] = mv[hh * 512 + 8 * lane + i]; scv[hh * 8 + i] = 1.f + mv[1024 + hh * 512 + 8 * lane + i]; }
    }
    float v[16];
    unpack8(u0, v); unpack8(u1, v + 8);
    float ss = 0.f;
#pragma unroll
    for (int i = 0; i < 16; ++i) ss += v[i] * v[i];
    ss = wave_sum(ss);
    const float rstd = rsqrtf(ss * (1.f / 1024.f) + 1e-6f);
    float o[16];
#pragma unroll
    for (int i = 0; i < 16; ++i) o[i] = (v[i] * rstd * gv[i]) * scv[i] + shv[i];
    bf16_t* hr = p.H + (size_t)row * D;
    *(uint4*)(hr + 8 * lane) = pack8(o);
    *(uint4*)(hr + 512 + 8 * lane) = pack8(o + 8);
    if (which) {
      float am = 0.f;
#pragma unroll
      for (int i = 0; i < 16; ++i) am = fmaxf(am, fabsf(o[i]));
      am = wave_max(am);
      const float sc = am > 0.f ? 127.f / am : 1.f;
      unsigned char* h8 = p.H8 + (size_t)row * 1024;
      *(uint2*)(h8 + 8 * lane) = make_uint2((unsigned)pack_i8(o[0] * sc, o[1] * sc, o[2] * sc, o[3] * sc), (unsigned)pack_i8(o[4] * sc, o[5] * sc, o[6] * sc, o[7] * sc));
      *(uint2*)(h8 + 512 + 8 * lane) = make_uint2((unsigned)pack_i8(o[8] * sc, o[9] * sc, o[10] * sc, o[11] * sc), (unsigned)pack_i8(o[12] * sc, o[13] * sc, o[14] * sc, o[15] * sc));
      if (lane == 0) p.HINV[row] = am > 0.f ? am * (1.f / 127.f) : 1.f;
    }
  }
}

DEV bool gemm_unit(int it, int nct, int& rt, int& ct) {
  const int nslot = gridDim.x >> 3;
  const int x = bid_() & 7, sl = bid_() >> 3;
  if (sl >= nslot) return false;
  const int v = it * nslot + sl;
  if (v >= 68 * nct) return false;
  const int rg = v / (8 * nct), rem = v - rg * 8 * nct;
  const int rows = (rg == 8) ? 4 : 8;
  ct = rem / rows;
  rt = x * 68 + rg * 8 + (rem - ct * rows);
  return true;
}
struct Epi1 {
  const P& p; int row0, col0;
  DEV void operator()(f32x4 (&acc)[4][4], int wr, int wc, int fr, int fq, char* smem) const {
    const int cw = col0 + wc * 64;
    const int rbase = row0 + wr * 64;
    const bool lat = (row0 % LT) >= LC;
    if (cw >= 1536 && cw < 1664) {
#pragma unroll
      for (int m = 0; m < 4; ++m)
#pragma unroll
        for (int n = 0; n < 4; ++n)
#pragma unroll
          for (int j = 0; j < 4; ++j) acc[m][n][j] = 2.f * sigmoidf_(2.f * acc[m][n][j]) - 1.f;
    } else if (cw >= 1792 && cw < 1920) {
#pragma unroll
      for (int m = 0; m < 4; ++m)
#pragma unroll
        for (int n = 0; n < 4; ++n)
#pragma unroll
          for (int j = 0; j < 4; ++j) acc[m][n][j] = sigmoidf_(acc[m][n][j]);
    } else if (cw >= 1920 && cw < 2560 && lat) {
#pragma unroll
      for (int m = 0; m < 4; ++m) {
        const int row = rbase + m * 16 + fr;
        const int pl = (row % LT) - LC;
        const int ri = pl >> 6, ci = pl & 63;
        const float4* crp = (const float4*)(p.rope + 2 * (ri * 16 + 4 * fq));
        const float4* ccp = (const float4*)(p.rope + 2 * (ci * 16 + 4 * fq));
        const float4 cr0 = crp[0], cr1 = crp[1], cc0 = ccp[0], cc1 = ccp[1];
        const float crc[4] = {cr0.x, cr0.z, cr1.x, cr1.z}, crs[4] = {cr0.y, cr0.w, cr1.y, cr1.w};
        const float ccc[4] = {cc0.x, cc0.z, cc1.x, cc1.z}, ccs[4] = {cc0.y, cc0.w, cc1.y, cc1.w};
#pragma unroll
        for (int j = 0; j < 4; ++j) {
          float x1 = acc[m][0][j], x2 = acc[m][1][j];
          acc[m][0][j] = x1 * crc[j] - x2 * crs[j]; acc[m][1][j] = x2 * crc[j] + x1 * crs[j];
          x1 = acc[m][2][j]; x2 = acc[m][3][j];
          acc[m][2][j] = x1 * ccc[j] - x2 * ccs[j]; acc[m][3][j] = x2 * ccc[j] + x1 * ccs[j];
        }
      }
    }
    const int wid = wr * 2 + wc, lane = fq * 16 + fr;
    stage_tile_bf16(acc, smem, wid, fr, fq);
    const bf16_t (*t)[72] = (const bf16_t (*)[72])(smem + wid * 9216);
#pragma unroll
    for (int i = 0; i < 8; ++i) {
      const int rl = i * 8 + (lane >> 3), ch = lane & 7;
      *(uint4*)(p.Z + (size_t)(rbase + rl) * INW + cw + ch * 8) = *(const uint4*)&t[rl][ch * 8];
    }
  }
};
DEV void ph_gemm1(const P& p, char* smem) {
  const int nct = INW / 128;
  int rt, ct;
  for (int it = 0; gemm_unit(it, nct, rt, ct); ++it) {
    Epi1 epi{p, rt * 128, ct * 128};
    gemm_tile(p.H + (size_t)rt * 128 * D, D, p.W1t + (size_t)ct * 128 * D, D, D, smem, epi);
  }
}

struct EpiLoraA {
  const P& p; int layer, row0, col0;
  DEV void operator()(f32x4 (&acc)[4][4], int wr, int wc, int fr, int fq, char* smem) const {
    const float* w0b = p.rw_w0 + layer * 512;
    const float* a0b = p.rw_a0 + layer * 512;
#pragma unroll
    for (int n = 0; n < 4; ++n) {
      const int chan = ((col0 + wc * 64 + n * 16) >> 2) + fq;
      const float be0 = w0b[chan], ba0 = a0b[chan], be1 = w0b[256 + chan], ba1 = a0b[256 + chan];
#pragma unroll
      for (int m = 0; m < 4; ++m) {
        acc[m][n][0] = 0.6065306597126334f * sigmoidf_(acc[m][n][0] + be0);
        acc[m][n][1] = sigmoidf_(acc[m][n][1] + ba0);
        acc[m][n][2] = 0.6065306597126334f * sigmoidf_(acc[m][n][2] + be1);
        acc[m][n][3] = sigmoidf_(acc[m][n][3] + ba1);
      }
    }
    const int wid = wr * 2 + wc, lane = fq * 16 + fr;
    stage_tile_bf16(acc, smem, wid, fr, fq);
    const bf16_t (*t)[72] = (const bf16_t (*)[72])(smem + wid * 9216);
#pragma unroll
    for (int i = 0; i < 8; ++i) {
      const int rl = i * 8 + (lane >> 3), ch = lane & 7;
      *(uint4*)(p.SC + (size_t)(row0 + wr * 64 + rl) * 1024 + col0 + wc * 64 + ch * 8) = *(const uint4*)&t[rl][ch * 8];
    }
  }
};
struct EpiLoraG {
  const P& p; int row0, col0;
  DEV void operator()(f32x4 (&acc)[4][4], int wr, int wc, int fr, int fq, char* smem) const {
    const int wid = wr * 2 + wc, lane = fq * 16 + fr;
    stage_tile_bf16(acc, smem, wid, fr, fq);
    const bf16_t (*t)[72] = (const bf16_t (*)[72])(smem + wid * 9216);
#pragma unroll
    for (int i = 0; i < 8; ++i) {
      const int rl = i * 8 + (lane >> 3), ch = lane & 7;
      *(uint4*)(p.Y + (size_t)(row0 + wr * 64 + rl) * D + 256 + col0 + wc * 64 + ch * 8) = *(const uint4*)&t[rl][ch * 8];
    }
  }
};
DEV void ph_lora(const P& p, int layer, char* smem) {
  int rt, ct;
  for (int it = 0; gemm_unit(it, 10, rt, ct); ++it) {
    if (ct < 8) {
      EpiLoraA epi{p, layer, rt * 128, ct * 128};
      gemm_tile(p.Z + (size_t)rt * 128 * INW + 1536, INW, p.Wlt + (size_t)ct * 128 * 256, 256, 256, smem, epi);
    } else {
      EpiLoraG epi{p, rt * 128, (ct - 8) * 128};
      gemm_tile(p.Z + (size_t)rt * 128 * INW + 1792, INW, p.Wgt + (size_t)(ct - 8) * 128 * 128, 128, 128, smem, epi);
    }
  }
}

DEV void ph_rwkv_prep(const P& p, int layer) {
  const int lane = tid_() & 63;
  int r0, r1;
  wave_range(r0, r1, NTOK);
  const float* cw = p.conv_w + (size_t)layer * 3 * 1536;
  const float* cb = p.conv_b + (size_t)layer * 1536;
  float w0[3][4], w1[3][4], w2[3][4], bb[3][4], kkw[4];
#pragma unroll
  for (int a = 0; a < 3; ++a)
#pragma unroll
    for (int i = 0; i < 4; ++i) {
      const int col = 768 + a * 256 + 4 * lane + i;
      w0[a][i] = cw[col]; w1[a][i] = cw[1536 + col]; w2[a][i] = cw[3072 + col]; bb[a][i] = cb[col];
    }
#pragma unroll
  for (int i = 0; i < 4; ++i) kkw[i] = p.rw_k_k[layer * 256 + 4 * lane + i];
  uint2 zm[3], zc[3], zp[3];
  auto ldz = [&](int row, uint2 (&z)[3]) {
#pragma unroll
    for (int a = 0; a < 3; ++a) z[a] = *(const uint2*)(p.Z + (size_t)row * INW + 768 + a * 256 + 4 * lane);
  };
  auto zero3 = [&](uint2 (&z)[3]) {
#pragma unroll
    for (int a = 0; a < 3; ++a) z[a] = make_uint2(0u, 0u);
  };
  if (r0 < r1) {
    if (r0 > 0) ldz(r0 - 1, zm); else zero3(zm);
    ldz(r0, zc);
  }
#pragma unroll 1
  for (int row = r0; row < r1; ++row) {
    if (row + 1 < NTOK) ldz(row + 1, zp); else zero3(zp);
    const int pp = row % LT;
    const bool hasm = (pp != 0) && (pp != LC);
    const bool hasp = (pp != LC - 1) && (pp != LT - 1);
    float res[3][4];
#pragma unroll
    for (int a = 0; a < 3; ++a) {
      const uint2 um = hasm ? zm[a] : make_uint2(0u, 0u), uc = zc[a], up = hasp ? zp[a] : make_uint2(0u, 0u);
      const float vm[4] = {bflo(um.x), bfhi(um.x), bflo(um.y), bfhi(um.y)};
      const float vc[4] = {bflo(uc.x), bfhi(uc.x), bflo(uc.y), bfhi(uc.y)};
      const float vp[4] = {bflo(up.x), bfhi(up.x), bflo(up.y), bfhi(up.y)};
#pragma unroll
      for (int i = 0; i < 4; ++i) res[a][i] = w0[a][i] * vm[i] + w1[a][i] * vc[i] + w2[a][i] * vp[i] + bb[a][i];
    }
    float kk[4], ss = 0.f;
#pragma unroll
    for (int i = 0; i < 4; ++i) { kk[i] = res[1][i] * kkw[i]; ss += kk[i] * kk[i]; }
    ss = row16_sum(ss);
    const float rs = rsqrtf(ss + 1e-12f);
    bf16_t* hr = p.H + (size_t)row * D + 16 * lane;
    *(uint4*)hr = make_uint4(pack2(res[0][0], res[1][0]), pack2(kk[0] * rs, res[2][0]), pack2(res[0][1], res[1][1]), pack2(kk[1] * rs, res[2][1]));
    *(uint4*)(hr + 8) = make_uint4(pack2(res[0][2], res[1][2]), pack2(kk[2] * rs, res[2][2]), pack2(res[0][3], res[1][3]), pack2(kk[3] * rs, res[2][3]));
#pragma unroll
    for (int a = 0; a < 3; ++a) { zm[a] = zc[a]; zc[a] = zp[a]; }
  }
}

DEV float oct_sum(float x) { x += dpp0<0xB1, 0xF>(x); x += dpp0<0x4E, 0xF>(x); x += dpp0<0x141, 0xF>(x); return x; }
DEV bf16x8 frag_join(uint2 lo, uint2 hi) { uint4 w = make_uint4(lo.x, lo.y, hi.x, hi.y); return __builtin_bit_cast(bf16x8, w); }
constexpr int SCS_SET = 17152, SCS_IMG = 3 * SCS_SET, SCS_W0 = SCS_IMG + 2 * 3072;
DEV void scanc_unit(const P& p, int layer, int unit, char* smem) {
  const int dir = unit & 1, h = (unit >> 1) & 3, b = unit >> 3;
  const int tid = tid_(), lane = tid & 63, fr = lane & 15, fq = lane >> 4;
  const int w = __builtin_amdgcn_readfirstlane(tid >> 6);
  bf16_t* IMG0 = (bf16_t*)(smem + SCS_W0);
  bf16_t* IMG1 = IMG0 + 512;
  bf16_t* IMG2 = IMG0 + 1024;
  __syncthreads();
  for (int i = tid; i < (2 * 3072 + 3072) / 4; i += 256) ((unsigned*)(smem + SCS_IMG))[i] = 0u;
  const float ka = p.rw_k_a[layer * 256 + h * 64 + lane];
  const size_t rowbase = (size_t)b * LT;
  const char* hbase = (const char*)p.H;
  const char* sbase = (const char*)p.SC;
  const unsigned hoff = (unsigned)(rowbase * 2048) + (unsigned)((h * 64 + lane) * 8);
  const unsigned soff = hoff + 4u * (unsigned)dir;
  bf16_t* yb = p.Z + rowbase * INW + 768 + dir * 256 + h * 64 + w * 16 + fr;
  auto pos0 = [&](int c) -> int { const int t = c * 16; return dir == 0 ? t : (t < LC ? LC - 1 - t : LT - 1 - (t - LC)); };
  const int pstep = dir == 0 ? 1 : -1;
  constexpr int NCH = LT / 16;
  struct Raw { unsigned sc[16]; uint2 hr[6]; };
  auto load_raw = [&](int c, Raw& rw) {
    if (w != 0) {
      const int p0 = pos0(c);
      const unsigned so = soff + (unsigned)(p0 * 2048);
      const int st = pstep * 2048;
#pragma unroll
      for (int i = 0; i < 16; ++i) rw.sc[i] = *(const unsigned*)(sbase + (so + (unsigned)(i * st)));
      const unsigned ho = hoff + (unsigned)((p0 + pstep * (w - 1)) * 2048);
#pragma unroll
      for (int q = 0; q < 6; ++q) {
        const int qq = ((w - 1) + 3 * q < 16) ? q : 4;
        rw.hr[q] = *(const uint2*)(hbase + (ho + (unsigned)(qq * 3 * st)));
      }
    }
  };
  auto stage1w = [&](int set, const Raw& rw, auto W1tag) {
    constexpr int W1 = decltype(W1tag)::value;
    char* base = smem + set * SCS_SET;
    bf16_t (*At)[72] = (bf16_t (*)[72])(base);
    bf16_t (*Rt)[72] = (bf16_t (*)[72])(base + 2304);
    bf16_t (*Bt)[72] = (bf16_t (*)[72])(base + 4608);
    bf16_t (*Kt)[72] = (bf16_t (*)[72])(base + 6912);
    bf16_t (*BKT)[36] = (bf16_t (*)[36])(base + 9216);
    bf16_t* VV = (bf16_t*)(base + 13824);
    float* G16 = (float*)(base + 16896);
    float Erun = 0.f;
#pragma unroll
    for (int i = 0; i < 16; ++i) {
      const float ev = bflo(rw.sc[i]);
      const float Eprev = Erun;
      Erun += ev;
      if ((i % 3) == W1) {
        const uint2 hrec = rw.hr[i / 3];
        const float rr = bflo(hrec.x), kr = bfhi(hrec.x), kkv = bflo(hrec.y);
        const float av = bfhi(rw.sc[i]);
        const float gp = __expf(-Eprev), gi = __expf(-Erun), ig = __expf(Erun);
        const float at = -kkv * gp, rt = rr * gi, bt = kkv * av * ig, kt2 = kr * (1.f + (av - 1.f) * ka) * ig;
        const unsigned ar = pack2(at, rt), bk = pack2(bt, kt2);
        At[i][lane] = (bf16_t)(ar & 0xFFFFu); Rt[i][lane] = (bf16_t)(ar >> 16);
        Bt[i][lane] = (bf16_t)(bk & 0xFFFFu); Kt[i][lane] = (bf16_t)(bk >> 16);
        BKT[lane][(i >> 2) * 8 + (i & 3)] = (bf16_t)(bk & 0xFFFFu);
        BKT[lane][(i >> 2) * 8 + 4 + (i & 3)] = (bf16_t)(bk >> 16);
        VV[((i >> 2) * 64 + lane) * 6 + (i & 3)] = (bf16_t)(hrec.y >> 16);
        if (i == 15) G16[lane] = gi;
      }
    }
  };
  auto stage1 = [&](int set, const Raw& rw) {
    if (w == 1) stage1w(set, rw, std::integral_constant<int, 0>{});
    else if (w == 2) stage1w(set, rw, std::integral_constant<int, 1>{});
    else if (w == 3) stage1w(set, rw, std::integral_constant<int, 2>{});
  };
  auto stage2 = [&](int set, int iset) {
    char* base = smem + set * SCS_SET;
    const bf16_t (*At)[72] = (const bf16_t (*)[72])(base);
    const bf16_t (*Rt)[72] = (const bf16_t (*)[72])(base + 2304);
    const bf16_t (*Bt)[72] = (const bf16_t (*)[72])(base + 4608);
    const bf16_t (*Kt)[72] = (const bf16_t (*)[72])(base + 6912);
    bf16_t* TT = (bf16_t*)(smem + SCS_IMG + iset * 3072);
    bf16_t* ARK = TT + 512;
    bf16_t* AAK = TT + 1024;
    const bf16_t (*X)[72] = (w < 2) ? At : Rt;
    const bf16_t (*Y)[72] = (w & 1) ? Kt : Bt;
    f32x4 cm = (f32x4){0.f, 0.f, 0.f, 0.f};
#pragma unroll
    for (int s = 0; s < 2; ++s) {
      bf16x8 af = *(const bf16x8*)&X[fr][32 * s + 8 * fq];
      bf16x8 bm = *(const bf16x8*)&Y[fr][32 * s + 8 * fq];
      cm = mfma16(af, bm, cm);
    }
#pragma unroll
    for (int jj = 0; jj < 4; ++jj) {
      const int i = 4 * fq + jj;
      const bool keep = (w < 2) ? (fr < i) : (fr <= i);
      cm[jj] = keep ? cm[jj] : 0.f;
    }
    const int io = (fr >> 2) * 8 + (fr & 3);
    auto wr_img = [&](bf16_t* img, const f32x4& Xv, int hi) {
#pragma unroll
      for (int jj = 0; jj < 4; ++jj) img[(4 * fq + jj) * 32 + io + hi] = f2bf(Xv[jj]);
    };
    if (w == 1) wr_img(AAK, cm, 0);
    else if (w == 2) wr_img(ARK, cm, 0);
    else if (w == 3) wr_img(ARK, cm, 4);
    else {
      auto bfrag = [&](const f32x4& Xv) { return frag_join(make_uint2(pack2(Xv[0], Xv[1]), pack2(Xv[2], Xv[3])), make_uint2(0u, 0u)); };
      auto afr = [&](const bf16_t* img) { return *(const bf16x8*)&img[(fr * 4 + fq) * 8]; };
      const f32x4 Z4 = (f32x4){0.f, 0.f, 0.f, 0.f};
      wr_img(IMG0, cm, 0);
      asm volatile("" ::: "memory");
      f32x4 A2 = mfma16(afr(IMG0), bfrag(cm), Z4);
      wr_img(IMG1, A2, 0);
      asm volatile("" ::: "memory");
      f32x4 A4 = mfma16(afr(IMG1), bfrag(A2), Z4);
      wr_img(IMG2, A4, 0);
      asm volatile("" ::: "memory");
      f32x4 Rm = mfma16(afr(IMG2), bfrag(A4), Z4);
#pragma unroll
      for (int jj = 0; jj < 4; ++jj) Rm[jj] += (fr == 4 * fq + jj) ? 1.f : 0.f;
      Rm = mfma16(afr(IMG2), bfrag(Rm), Rm);
      Rm = mfma16(afr(IMG1), bfrag(Rm), Rm);
      Rm = mfma16(afr(IMG0), bfrag(Rm), Rm);
      wr_img(TT, Rm, 0);
    }
  };
  f32x4 acc[4];
#pragma unroll
  for (int kt = 0; kt < 4; ++kt) acc[kt] = (f32x4){0.f, 0.f, 0.f, 0.f};
  auto part2 = [&](int c, int set, int iset) {
    char* base = smem + set * SCS_SET;
    const bf16_t (*At)[72] = (const bf16_t (*)[72])(base);
    const bf16_t (*Rt)[72] = (const bf16_t (*)[72])(base + 2304);
    const bf16_t (*BKT)[36] = (const bf16_t (*)[36])(base + 9216);
    const bf16_t* VV = (const bf16_t*)(base + 13824);
    const float* G16 = (const float*)(base + 16896);
    const bf16_t* TT = (const bf16_t*)(smem + SCS_IMG + iset * 3072);
    const bf16_t* ARK = TT + 512;
    const bf16_t* AAK = TT + 1024;
    bf16x8 Sb[2];
#pragma unroll
    for (int s = 0; s < 2; ++s) {
      uint4 t = make_uint4(pack2(acc[2 * s][0], acc[2 * s][1]), pack2(acc[2 * s][2], acc[2 * s][3]),
                           pack2(acc[2 * s + 1][0], acc[2 * s + 1][1]), pack2(acc[2 * s + 1][2], acc[2 * s + 1][3]));
      Sb[s] = __builtin_bit_cast(bf16x8, t);
    }
    const unsigned* vvp = (const unsigned*)&VV[(fq * 64 + w * 16 + fr) * 6];
    const uint2 vv = make_uint2(vvp[0], vvp[1]);
    const bf16x8 Vlow = frag_join(vv, make_uint2(0u, 0u));
    f32x4 Pm = (f32x4){0.f, 0.f, 0.f, 0.f};
#pragma unroll
    for (int s = 0; s < 2; ++s) {
      bf16x8 af = frag_join(*(const uint2*)&At[fr][32 * s + 4 * fq], *(const uint2*)&At[fr][32 * s + 16 + 4 * fq]);
      Pm = mfma16(af, Sb[s], Pm);
    }
    Pm = mfma16(*(const bf16x8*)&AAK[(fr * 4 + fq) * 8], Vlow, Pm);
    const bf16x8 Pb = frag_join(make_uint2(pack2(Pm[0], Pm[1]), pack2(Pm[2], Pm[3])), make_uint2(0u, 0u));
    f32x4 U = mfma16(*(const bf16x8*)&TT[(fr * 4 + fq) * 8], Pb, (f32x4){0.f, 0.f, 0.f, 0.f});
    const bf16x8 UV = frag_join(make_uint2(pack2(U[0], U[1]), pack2(U[2], U[3])), vv);
    f32x4 Yv = (f32x4){0.f, 0.f, 0.f, 0.f};
#pragma unroll
    for (int s = 0; s < 2; ++s) {
      bf16x8 af = frag_join(*(const uint2*)&Rt[fr][32 * s + 4 * fq], *(const uint2*)&Rt[fr][32 * s + 16 + 4 * fq]);
      Yv = mfma16(af, Sb[s], Yv);
    }
    Yv = mfma16(*(const bf16x8*)&ARK[(fr * 4 + fq) * 8], UV, Yv);
    {
      const int p0 = pos0(c);
#pragma unroll
      for (int jj = 0; jj < 4; ++jj) yb[(size_t)(p0 + pstep * (4 * fq + jj)) * INW] = f2bf(Yv[jj]);
    }
#pragma unroll
    for (int kt = 0; kt < 4; ++kt) {
      f32x4 t = mfma16(frag_join(*(const uint2*)&BKT[16 * kt + fr][fq * 8], *(const uint2*)&BKT[16 * kt + fr][fq * 8 + 4]), UV, acc[kt]);
      const float4 g4 = *(const float4*)&G16[16 * kt + 4 * fq];
      t[0] *= g4.x; t[1] *= g4.y; t[2] *= g4.z; t[3] *= g4.w;
      acc[kt] = t;
    }
  };
  __builtin_amdgcn_s_setprio(3);
  Raw r0, r1;
  load_raw(0, r0); load_raw(1, r1);
  stage1(0, r0);
  load_raw(2, r0);
  __syncthreads();
  stage2(0, 0);
  stage1(1, r1);
  load_raw(3, r1);
  __syncthreads();
  int s0 = 0, s1 = 1, s2 = 2;
  auto iter = [&](int c, Raw& rw) {
    if (c + 1 < NCH) stage2(s1, (c + 1) & 1);
    part2(c, s0, c & 1);
    if (c + 2 < NCH) {
      stage1(s2, rw);
      if (c + 4 < NCH) load_raw(c + 4, rw);
    }
    asm volatile("s_waitcnt lgkmcnt(0)" ::: "memory");
    __builtin_amdgcn_s_barrier();
    asm volatile("" ::: "memory");
    const int t = s0; s0 = s1; s1 = s2; s2 = t;
  };
#pragma unroll 1
  for (int c = 0; c < NCH; c += 2) {
    iter(c, r0); iter(c + 1, r1);
  }
  __builtin_amdgcn_s_setprio(0);
}

DEV void ph_rwkv_post(const P& p, int layer) {
  const int lane = tid_() & 63;
  int r0, r1;
  wave_range(r0, r1, NTOK);
  const int ch = 4 * lane;
  float kav[4], rkv[4], lnw[4], lnb[4];
#pragma unroll
  for (int i = 0; i < 4; ++i) {
    kav[i] = p.rw_k_a[layer * 256 + ch + i]; rkv[i] = p.rw_r_k[layer * 256 + ch + i];
    lnw[i] = p.rw_ln_w[layer * 256 + ch + i]; lnb[i] = p.rw_ln_b[layer * 256 + ch + i];
  }
  struct In { uint2 y0, y1, g; uint4 h0, h1, s0, s1; };
  auto ld = [&](int row, In& in) {
    const bf16_t* zr = p.Z + (size_t)row * INW + 768 + ch;
    in.y0 = *(const uint2*)zr; in.y1 = *(const uint2*)(zr + 256);
    const bf16_t* hr = p.H + (size_t)row * D + 4 * ch;
    in.h0 = *(const uint4*)hr; in.h1 = *(const uint4*)(hr + 8);
    const bf16_t* sr = p.SC + (size_t)row * 1024 + 4 * ch;
    in.s0 = *(const uint4*)sr; in.s1 = *(const uint4*)(sr + 8);
    in.g = *(const uint2*)(p.Y + (size_t)row * D + 256 + ch);
  };
  In nx;
  if (r0 < r1) ld(r0, nx);
#pragma unroll 1
  for (int row = r0; row < r1; ++row) {
    const In in = nx;
    if (row + 1 < r1) ld(row + 1, nx);
    float y[4] = {bflo(in.y0.x) + bflo(in.y1.x), bfhi(in.y0.x) + bfhi(in.y1.x), bflo(in.y0.y) + bflo(in.y1.y), bfhi(in.y0.y) + bfhi(in.y1.y)};
    const float mu = row16_sum(y[0] + y[1] + y[2] + y[3]) * (1.f / 64.f);
    float vs = 0.f;
#pragma unroll
    for (int i = 0; i < 4; ++i) { y[i] -= mu; vs += y[i] * y[i]; }
    const float var = row16_sum(vs) * (1.f / 64.f);
    const float rstd = rsqrtf(var + 64e-5f);
    const float r[4] = {bflo(in.h0.x), bflo(in.h0.z), bflo(in.h1.x), bflo(in.h1.z)};
    const float k[4] = {bfhi(in.h0.x), bfhi(in.h0.z), bfhi(in.h1.x), bfhi(in.h1.z)};
    const float v[4] = {bfhi(in.h0.y), bfhi(in.h0.w), bfhi(in.h1.y), bfhi(in.h1.w)};
    const float a0[4] = {bfhi(in.s0.x), bfhi(in.s0.z), bfhi(in.s1.x), bfhi(in.s1.z)};
    const float a1[4] = {bfhi(in.s0.y), bfhi(in.s0.w), bfhi(in.s1.y), bfhi(in.s1.w)};
    float sd = 0.f;
#pragma unroll
    for (int i = 0; i < 4; ++i) {
      const float kd0 = k[i] * (1.f + (a0[i] - 1.f) * kav[i]), kd1 = k[i] * (1.f + (a1[i] - 1.f) * kav[i]);
      sd += r[i] * (kd0 + kd1) * rkv[i];
    }
    sd = row16_sum(sd);
    const float g[4] = {bflo(in.g.x), bfhi(in.g.x), bflo(in.g.y), bfhi(in.g.y)};
    float o[4];
#pragma unroll
    for (int i = 0; i < 4; ++i) {
      const float yn = y[i] * rstd * lnw[i] + lnb[i];
      o[i] = (yn + sd * v[i]) * g[i];
    }
    *(uint2*)(p.Y + (size_t)row * D + 256 + ch) = make_uint2(pack2(o[0], o[1]), pack2(o[2], o[3]));
  }
}

DEV void hyena_pre_unit(const P& p, int layer, int unit) {
  int kind, b, t0, L;
  if (unit < 1024) { kind = 0; b = unit >> 6; t0 = (unit & 63) * 64; L = T; } else { int u = unit - 1024; kind = 1; b = u >> 2; t0 = (u & 3) * 64; L = LC; }
  const int lane = tid_() & 63, wid = tid_() >> 6;
  const int tw = t0 + wid * 16;
  const size_t row0 = (size_t)b * LT + (kind ? 0 : LC);
  const float* cw = p.conv_w + (size_t)layer * 3 * 1536;
  const float* cb = p.conv_b + (size_t)layer * 1536;
  float wx[3][4], wv[3][4], bx[4], bv[4];
#pragma unroll
  for (int i = 0; i < 4; ++i) {
    const int cx = 256 + 4 * lane + i, cv = 512 + 4 * lane + i;
#pragma unroll
    for (int k = 0; k < 3; ++k) { wx[k][i] = cw[k * 1536 + cx]; wv[k][i] = cw[k * 1536 + cv]; }
    bx[i] = cb[cx]; bv[i] = cb[cv];
  }
  uint2 zx[18], zv[18];
#pragma unroll
  for (int i = 0; i < 18; ++i) {
    const int t = tw - 1 + i;
    if (t >= 0 && t < L) {
      const bf16_t* zr = p.Z + (row0 + t) * INW + 256 + 4 * lane;
      zx[i] = *(const uint2*)zr; zv[i] = *(const uint2*)(zr + 256);
    } else { zx[i] = make_uint2(0u, 0u); zv[i] = make_uint2(0u, 0u); }
  }
  float uo[4][16];
#pragma unroll
  for (int i = 0; i < 16; ++i) {
    const float xm[4] = {bflo(zx[i].x), bfhi(zx[i].x), bflo(zx[i].y), bfhi(zx[i].y)};
    const float xc[4] = {bflo(zx[i + 1].x), bfhi(zx[i + 1].x), bflo(zx[i + 1].y), bfhi(zx[i + 1].y)};
    const float xp[4] = {bflo(zx[i + 2].x), bfhi(zx[i + 2].x), bflo(zx[i + 2].y), bfhi(zx[i + 2].y)};
    const float vm[4] = {bflo(zv[i].x), bfhi(zv[i].x), bflo(zv[i].y), bfhi(zv[i].y)};
    const float vc[4] = {bflo(zv[i + 1].x), bfhi(zv[i + 1].x), bflo(zv[i + 1].y), bfhi(zv[i + 1].y)};
    const float vp[4] = {bflo(zv[i + 2].x), bfhi(zv[i + 2].x), bflo(zv[i + 2].y), bfhi(zv[i + 2].y)};
#pragma unroll
    for (int q = 0; q < 4; ++q) {
      const float a = wx[0][q] * xm[q] + wx[1][q] * xc[q] + wx[2][q] * xp[q] + bx[q];
      const float c2 = wv[0][q] * vm[q] + wv[1][q] * vc[q] + wv[2][q] * vp[q] + bv[q];
      uo[q][i] = a * c2;
    }
  }
  bf16_t* ut = kind ? opq(p.UTc) : opq(p.UTl);
#pragma unroll
  for (int q = 0; q < 4; ++q) {
    bf16_t* dst = ut + ((size_t)(4 * lane + q) * 16 + b) * L + tw;
    *(uint4*)dst = pack8(&uo[q][0]);
    *(uint4*)(dst + 8) = pack8(&uo[q][8]);
  }
}

DEV void hyena_conv_unit(const P& p, int layer, int unit, char* smem) {
  int kind, c, tb, L;
  if (unit < 4096) { kind = 0; c = unit >> 4; tb = (unit & 15) * 256; L = T; } else { kind = 1; c = unit - 4096; tb = 0; L = LC; }
  const int tid = tid_(), lane = tid & 63, wid = tid >> 6, fr = lane & 15, fq = lane >> 4;
  float* red = (float*)(smem + 2 * 16512);
  const float* F = (kind ? opq(p.FC) : opq(p.FL)) + (size_t)c * 2 * L;
  float scale;
  {
    float part = 0.f;
    for (int i = tid; i < 2 * L; i += 256) { float fv = F[i]; part += (i != L) ? fv * fv : 0.f; }
    part = wave_sum(part);
    __syncthreads();
    if (lane == 0) red[wid] = part;
    __syncthreads();
    scale = rsqrtf(((red[0] + red[1]) + (red[2] + red[3])) + 1e-6f);
  }
  const bf16_t* U = (kind ? opq(p.UTc) : opq(p.UTl)) + (size_t)c * 16 * L;
  f32x4 acc[4];
#pragma unroll
  for (int m = 0; m < 4; ++m) acc[m] = (f32x4){0.f, 0.f, 0.f, 0.f};
  const int nch = L / 256;
  float fw0, fw1, fw2;
  uint4 ru0, ru1;
  auto ldchunk = [&](int ch) {
    const int sc = ch * 256;
    const int D0 = tb + 256 - sc;
    auto tap = [&](int n) -> float {
      int d = D0 - n;
      float v = 0.f;
      if (d > -L && d < L) v = (d >= 0 ? F[d] : F[L - d]);
      return v;
    };
    fw0 = tap(tid); fw1 = tap(tid + 256); fw2 = (tid < 8) ? tap(tid + 512) : 0.f;
    const int bb = tid >> 4, sg0 = tid & 15;
    ru0 = *(const uint4*)(U + (size_t)bb * L + sc + 8 * sg0);
    ru1 = *(const uint4*)(U + (size_t)bb * L + sc + 8 * (sg0 + 16));
  };
  auto stchunk = [&](int buf) {
    bf16_t* Cq = (bf16_t*)(smem + buf * 16512);
    bf16_t* Us = (bf16_t*)(smem + buf * 16512 + 8320);
    const bf16_t h0 = f2bf(fw0 * scale), h1 = f2bf(fw1 * scale), h2 = f2bf(fw2 * scale);
#pragma unroll
    for (int rho = 0; rho < 8; ++rho) {
      int m = tid + rho;
      Cq[((m >> 3) * 8 + rho) * 8 + (m & 7)] = h0;
      m = tid + 256 + rho;
      if (m < 520) Cq[((m >> 3) * 8 + rho) * 8 + (m & 7)] = h1;
      m = tid + 512 + rho;
      if (tid < 8 && m < 520) Cq[((m >> 3) * 8 + rho) * 8 + (m & 7)] = h2;
    }
    if (tid < 8) {
#pragma unroll
      for (int rho = 1; rho < 8; ++rho) if (tid < rho) Cq[(rho) * 8 + tid] = 0;
    }
    const int bb = tid >> 4, sg0 = tid & 15;
    *(uint4*)&Us[(sg0 * 16 + bb) * 8] = ru0;
    *(uint4*)&Us[((sg0 + 16) * 16 + bb) * 8] = ru1;
  };
  ldchunk(0);
#pragma unroll 1
  for (int ch = 0; ch < nch; ++ch) {
    const int buf = ch & 1;
    stchunk(buf);
    __syncthreads();
    if (ch + 1 < nch) ldchunk(ch + 1);
    const bf16_t* Cq = (const bf16_t*)(smem + buf * 16512);
    const bf16_t* Us = (const bf16_t*)(smem + buf * 16512 + 8320);
#pragma unroll
    for (int kk = 0; kk < 8; ++kk) {
      bf16x8 bf = *(const bf16x8*)&Us[((4 * kk + fq) * 16 + fr) * 8];
#pragma unroll
      for (int m = 0; m < 4; ++m) {
        int it = wid * 4 + m;
        int base = 256 - 16 * it + 32 * kk + 8 * fq;
        int m0 = base - 8 * (fr >> 3);
        bf16x8 af = *(const bf16x8*)&Cq[((m0 >> 3) * 8 + (fr & 7)) * 8];
        acc[m] = mfma16(af, bf, acc[m]);
      }
    }
  }
  __syncthreads();
  bf16_t* Yt = (kind ? opq(p.YTc) : opq(p.YTl)) + ((size_t)c * 16 + fr) * L + tb;
#pragma unroll
  for (int m = 0; m < 4; ++m) {
    int t = (wid * 4 + m) * 16 + fq * 4;
    *(uint2*)(Yt + t) = make_uint2(pack2(acc[m][0], acc[m][1]), pack2(acc[m][2], acc[m][3]));
  }
}

DEV void hyena_post_unit(const P& p, int layer, int unit, char* smem) {
  (void)smem;
  int kind, b, t0, L;
  if (unit < 1024) { kind = 0; b = unit >> 6; t0 = (unit & 63) * 64; L = T; } else { int u = unit - 1024; kind = 1; b = u >> 2; t0 = (u & 3) * 64; L = LC; }
  const int lane = tid_() & 63, wid = tid_() >> 6;
  const int tw = t0 + wid * 16;
  const size_t row0 = (size_t)b * LT + (kind ? 0 : LC);
  const float* cw = p.conv_w + (size_t)layer * 3 * 1536;
  float w0[3][4], b0[4], bias[4], og[4];
#pragma unroll
  for (int i = 0; i < 4; ++i) {
    const int c = 4 * lane + i;
#pragma unroll
    for (int k = 0; k < 3; ++k) w0[k][i] = cw[k * 1536 + c];
    b0[i] = p.conv_b[layer * 1536 + c]; bias[i] = p.hy_bias[layer * 256 + c]; og[i] = p.hy_out_g[layer * 256 + c];
  }
  uint2 zx[18];
#pragma unroll
  for (int i = 0; i < 18; ++i) {
    const int t = tw - 1 + i;
    zx[i] = (t >= 0 && t < L) ? *(const uint2*)(p.Z + (row0 + t) * INW + 4 * lane) : make_uint2(0u, 0u);
  }
  const bf16_t* ytb = kind ? opq(p.YTc) : opq(p.YTl);
  const bf16_t* utb = kind ? opq(p.UTc) : opq(p.UTl);
  float o[4][16];
#pragma unroll
  for (int q = 0; q < 4; ++q) {
    const size_t off = ((size_t)(4 * lane + q) * 16 + b) * L + tw;
    float yv[16], uv[16];
    { uint4 a0 = *(const uint4*)(ytb + off), a1 = *(const uint4*)(ytb + off + 8); unpack8(a0, yv); unpack8(a1, yv + 8); }
    { uint4 a0 = *(const uint4*)(utb + off), a1 = *(const uint4*)(utb + off + 8); unpack8(a0, uv); unpack8(a1, uv + 8); }
#pragma unroll
    for (int i = 0; i < 16; ++i) o[q][i] = yv[i] + uv[i] * bias[q];
  }
#pragma unroll
  for (int i = 0; i < 16; ++i) {
    const float xm[4] = {bflo(zx[i].x), bfhi(zx[i].x), bflo(zx[i].y), bfhi(zx[i].y)};
    const float xc[4] = {bflo(zx[i + 1].x), bfhi(zx[i + 1].x), bflo(zx[i + 1].y), bfhi(zx[i + 1].y)};
    const float xp[4] = {bflo(zx[i + 2].x), bfhi(zx[i + 2].x), bflo(zx[i + 2].y), bfhi(zx[i + 2].y)};
    float ov[4], ss = 0.f;
#pragma unroll
    for (int q = 0; q < 4; ++q) {
      const float x0 = w0[0][q] * xm[q] + w0[1][q] * xc[q] + w0[2][q] * xp[q] + b0[q];
      ov[q] = bf2f(f2bf(x0 * o[q][i]));
      ss += ov[q] * ov[q];
    }
    ss = wave_sum(ss);
    const float rstd = rsqrtf(ss * (1.f / 256.f) + 1e-6f);
    *(uint2*)(p.Y + (row0 + tw + i) * D + 4 * lane) = make_uint2(pack2(ov[0] * rstd * og[0], ov[1] * rstd * og[1]), pack2(ov[2] * rstd * og[2], ov[3] * rstd * og[3]));
  }
}

DEV void attn_unit(const P& p, int layer, int unit, char* smem) {
  const bool isctx = unit >= 4096;
  int b, qb, hq;
  if (!isctx) { b = unit >> 8; qb = (unit >> 3) & 31; hq = unit & 7; } else { int u = unit - 4096; b = u >> 4; qb = (u >> 3) & 1; hq = u & 7; }
  const int g = hq >> 2;
  const int tid = tid_(), lane = tid & 63, wid = tid >> 6, qn = lane & 31, hh = lane >> 5;
  const int qpos = qb * 128 + wid * 32 + qn;
  const size_t qrow = (size_t)b * LT + (isctx ? qpos : LC + qpos);
  const bf16_t* qptr = p.Z + qrow * INW + 1920 + hq * 64;
  bf16x8 qf[4];
#pragma unroll
  for (int s = 0; s < 4; ++s) qf[s] = *(const bf16x8*)(qptr + 16 * s + 8 * hh);
  const float sink = p.attn_sink[layer * 8 + hq];
  float m_run = sink, l_run = 1.f;
  f32x16 o0, o1;
#pragma unroll
  for (int i = 0; i < 16; ++i) { o0[i] = 0.f; o1[i] = 0.f; }
  typedef bf16_t KTile[64][72];
  KTile* Ks = (KTile*)smem;
  KTile* Vt = (KTile*)(smem + 18432);
  const int ntl = isctx ? 0 : 6;
  const int ntiles = ntl + 4;
  const int skey = tid >> 3, sseg = tid & 7;
  const bf16_t* kvbase = p.Z + (size_t)b * LT * INW + 1920 + 512 + g * 64 + sseg * 8;
  uint4 rk0, rk1, rv0, rv1;
  auto ldtile = [&](int kt) {
    const bool ctxk = kt >= ntl;
    const int kbase = ctxk ? (kt - ntl) * 64 : qb * 128 - 128 + kt * 64;
    const int kp0 = kbase + skey, kp1 = kp0 + 32;
    rk0 = rk1 = rv0 = rv1 = make_uint4(0, 0, 0, 0);
    if (ctxk || (kp0 >= 0 && kp0 < T)) { const bf16_t* src = kvbase + (size_t)(ctxk ? kp0 : LC + kp0) * INW; rk0 = *(const uint4*)src; rv0 = *(const uint4*)(src + 128); }
    if (ctxk || (kp1 >= 0 && kp1 < T)) { const bf16_t* src = kvbase + (size_t)(ctxk ? kp1 : LC + kp1) * INW; rk1 = *(const uint4*)src; rv1 = *(const uint4*)(src + 128); }
  };
  auto sttile = [&](int buf) {
    *(uint4*)&Ks[buf][skey][sseg * 8] = rk0;
    *(uint4*)&Ks[buf][skey + 32][sseg * 8] = rk1;
    bf16_t (*vt)[72] = Vt[buf];
    vt[sseg * 8 + 0][skey] = (bf16_t)(rv0.x & 0xFFFF); vt[sseg * 8 + 1][skey] = (bf16_t)(rv0.x >> 16);
    vt[sseg * 8 + 2][skey] = (bf16_t)(rv0.y & 0xFFFF); vt[sseg * 8 + 3][skey] = (bf16_t)(rv0.y >> 16);
    vt[sseg * 8 + 4][skey] = (bf16_t)(rv0.z & 0xFFFF); vt[sseg * 8 + 5][skey] = (bf16_t)(rv0.z >> 16);
    vt[sseg * 8 + 6][skey] = (bf16_t)(rv0.w & 0xFFFF); vt[sseg * 8 + 7][skey] = (bf16_t)(rv0.w >> 16);
    vt[sseg * 8 + 0][skey + 32] = (bf16_t)(rv1.x & 0xFFFF); vt[sseg * 8 + 1][skey + 32] = (bf16_t)(rv1.x >> 16);
    vt[sseg * 8 + 2][skey + 32] = (bf16_t)(rv1.y & 0xFFFF); vt[sseg * 8 + 3][skey + 32] = (bf16_t)(rv1.y >> 16);
    vt[sseg * 8 + 4][skey + 32] = (bf16_t)(rv1.z & 0xFFFF); vt[sseg * 8 + 5][skey + 32] = (bf16_t)(rv1.z >> 16);
    vt[sseg * 8 + 6][skey + 32] = (bf16_t)(rv1.w & 0xFFFF); vt[sseg * 8 + 7][skey + 32] = (bf16_t)(rv1.w >> 16);
  };
  ldtile(0);
#pragma unroll 1
  for (int kt = 0; kt < ntiles; ++kt) {
    const int buf = kt & 1;
    sttile(buf);
    __syncthreads();
    if (kt + 1 < ntiles) ldtile(kt + 1);
    const bool ctxk = kt >= ntl;
    const int kbase = ctxk ? (kt - ntl) * 64 : qb * 128 - 128 + kt * 64;
#pragma unroll
    for (int sub = 0; sub < 2; ++sub) {
      const int kb2 = kbase + sub * 32;
      bool need = true;
      if (!ctxk) {
        int q0 = qb * 128 + wid * 32;
        if (kb2 + 31 < q0 - 128 || kb2 > q0 + 31 + 128 || kb2 + 31 < 0 || kb2 >= T) need = false;
      }
      if (need) {
        f32x16 sv;
#pragma unroll
        for (int i = 0; i < 16; ++i) sv[i] = 0.f;
#pragma unroll
        for (int ks = 0; ks < 4; ++ks) {
          bf16x8 kf = *(const bf16x8*)&Ks[buf][sub * 32 + qn][16 * ks + 8 * hh];
          sv = mfma32(kf, qf[ks], sv);
        }
        float mt = -3e38f;
#pragma unroll
        for (int rg = 0; rg < 16; ++rg) {
          float v = sv[rg] * 0.125f;
          if (!ctxk) {
            int kp = kb2 + (rg & 3) + 8 * (rg >> 2) + 4 * hh;
            int dl = qpos - kp;
            bool ok = (dl <= 128) && (dl >= -128) && (kp >= 0) && (kp < T);
            v = ok ? v : -1e30f;
          }
          sv[rg] = v;
          mt = fmaxf(mt, v);
        }
        mt = fmaxf(mt, __shfl_xor(mt, 32));
        float m_new = fmaxf(m_run, mt);
        float corr = __expf(m_run - m_new);
        float ps = 0.f;
#pragma unroll
        for (int rg = 0; rg < 16; ++rg) { float pv = __expf(sv[rg] - m_new); sv[rg] = pv; ps += pv; }
        ps += __shfl_xor(ps, 32);
        l_run = l_run * corr + ps;
        m_run = m_new;
#pragma unroll
        for (int i = 0; i < 16; ++i) { o0[i] *= corr; o1[i] *= corr; }
#pragma unroll
        for (int sp = 0; sp < 2; ++sp) {
          bf16x8 pf;
#pragma unroll
          for (int j = 0; j < 8; ++j) pf[j] = (short)f2bf(sv[8 * sp + j]);
          const int kc = sub * 32 + 16 * sp + 4 * hh;
          uint2 va = *(const uint2*)&Vt[buf][qn][kc], vb = *(const uint2*)&Vt[buf][qn][kc + 8];
          uint2 vc = *(const uint2*)&Vt[buf][32 + qn][kc], vd = *(const uint2*)&Vt[buf][32 + qn][kc + 8];
          uint4 w0 = make_uint4(va.x, va.y, vb.x, vb.y), w1 = make_uint4(vc.x, vc.y, vd.x, vd.y);
          bf16x8 v0 = __builtin_bit_cast(bf16x8, w0), v1 = __builtin_bit_cast(bf16x8, w1);
          o0 = mfma32(v0, pf, o0);
          o1 = mfma32(v1, pf, o1);
        }
      }
    }
  }
  __syncthreads();
  const float inv = 1.f / l_run;
  bf16_t* optr = p.Y + qrow * D + 512 + hq * 64;
#pragma unroll
  for (int rg = 0; rg < 4; ++rg) {
    int d0 = 8 * rg + 4 * hh;
    *(uint2*)(optr + d0) = make_uint2(pack2(o0[4 * rg] * inv, o0[4 * rg + 1] * inv), pack2(o0[4 * rg + 2] * inv, o0[4 * rg + 3] * inv));
    *(uint2*)(optr + 32 + d0) = make_uint2(pack2(o1[4 * rg] * inv, o1[4 * rg + 1] * inv), pack2(o1[4 * rg + 2] * inv, o1[4 * rg + 3] * inv));
  }
}

DEV void ph_attn_post(const P& p, int layer) {
  const int lane = tid_() & 63;
  int r0, r1;
  wave_range(r0, r1, NTOK);
  float gv[8];
#pragma unroll
  for (int i = 0; i < 8; ++i) gv[i] = p.at_out_g[layer * 512 + 8 * lane + i];
  uint4 nx = make_uint4(0, 0, 0, 0);
  if (r0 < r1) nx = *(const uint4*)(p.Y + (size_t)r0 * D + 512 + 8 * lane);
#pragma unroll 1
  for (int row = r0; row < r1; ++row) {
    const uint4 u = nx;
    if (row + 1 < r1) nx = *(const uint4*)(p.Y + (size_t)(row + 1) * D + 512 + 8 * lane);
    float v[8];
    unpack8(u, v);
    float ss = 0.f;
#pragma unroll
    for (int i = 0; i < 8; ++i) ss += v[i] * v[i];
    ss = wave_sum(ss);
    const float rstd = rsqrtf(ss * (1.f / 512.f) + 1e-6f);
#pragma unroll
    for (int i = 0; i < 8; ++i) {
      v[i] = v[i] * rstd * gv[i];
    }
    *(uint4*)(p.Y + (size_t)row * D + 512 + 8 * lane) = pack8(v);
  }
}

struct Epi2 {
  const P& p; int layer, row0, col0;
  DEV void operator()(f32x4 (&acc)[4][4], int wr, int wc, int fr, int fq, char* smem) const {
    const int b = row0 / LT, pp = row0 % LT;
    const int mr = pp < LC ? 16 : b;
    const float* g1 = p.modv + ((size_t)layer * 17 + mr) * 6144 + 2048 + col0 + wc * 64;
#pragma unroll
    for (int n = 0; n < 4; ++n) {
      const float4 gv = *(const float4*)(g1 + n * 16 + 4 * fq);
#pragma unroll
      for (int m = 0; m < 4; ++m) { acc[m][n][0] *= gv.x; acc[m][n][1] *= gv.y; acc[m][n][2] *= gv.z; acc[m][n][3] *= gv.w; }
    }
    const int wid = wr * 2 + wc, lane = fq * 16 + fr;
    stage_tile_bf16(acc, smem, wid, fr, fq);
    const bf16_t (*t)[72] = (const bf16_t (*)[72])(smem + wid * 9216);
#pragma unroll
    for (int i = 0; i < 8; ++i) {
      const int rl = i * 8 + (lane >> 3), ch = lane & 7;
      bf16_t* xp = p.X + (size_t)(row0 + wr * 64 + rl) * D + col0 + wc * 64 + ch * 8;
      float xv[8], dv[8];
      uint4 xu = *(const uint4*)xp, du = *(const uint4*)&t[rl][ch * 8];
      unpack8(xu, xv); unpack8(du, dv);
#pragma unroll
      for (int q = 0; q < 8; ++q) xv[q] += dv[q];
      *(uint4*)xp = pack8(xv);
    }
  }
};
DEV void ph_gemm2(const P& p, int layer, char* smem) {
  int rt, ct;
  for (int it = 0; gemm_unit(it, 8, rt, ct); ++it) {
    Epi2 epi{p, layer, rt * 128, ct * 128};
    gemm_tile(p.Y + (size_t)rt * 128 * D, D, p.W2t + (size_t)ct * 128 * D, D, D, smem, epi);
  }
}

DEV void ph_peerconv(const P& p, int layer) {
  const int gw = (bid_() * 256 + tid_()) >> 6, nw = gridDim.x * 4, lane = tid_() & 63;
  const float* su = opq(p.peer_u) + (size_t)layer * 16384 * 1024;
  const float* sv = opq(p.peer_v) + (size_t)layer * 16384 * 1024;
  unsigned char* pu = opq(p.PU); unsigned char* pv = opq(p.PV);
  float* psu = opq(p.PSU); float* psv = opq(p.PSV);
  auto ldrow = [&](int r, float4& a0, float4& a1, float4& a2, float4& a3) {
    const float* src = ((r >= 16384) ? sv : su) + (size_t)(r & 16383) * 1024 + 16 * lane;
    a0 = *(const float4*)src; a1 = *(const float4*)(src + 4); a2 = *(const float4*)(src + 8); a3 = *(const float4*)(src + 12);
  };
  float4 n0 = make_float4(0, 0, 0, 0), n1 = n0, n2 = n0, n3 = n0;
  if (gw < 32768) ldrow(gw, n0, n1, n2, n3);
#pragma unroll 1
  for (int r = gw; r < 32768; r += nw) {
    const bool isv = r >= 16384;
    const int e = r & 16383;
    const float4 f0 = n0, f1 = n1, f2 = n2, f3 = n3;
    if (r + nw < 32768) ldrow(r + nw, n0, n1, n2, n3);
    float am = fmaxf(fmaxf(fmaxf(fabsf(f0.x), fabsf(f0.y)), fmaxf(fabsf(f0.z), fabsf(f0.w))), fmaxf(fmaxf(fabsf(f1.x), fabsf(f1.y)), fmaxf(fabsf(f1.z), fabsf(f1.w))));
    am = fmaxf(am, fmaxf(fmaxf(fmaxf(fabsf(f2.x), fabsf(f2.y)), fmaxf(fabsf(f2.z), fabsf(f2.w))), fmaxf(fmaxf(fabsf(f3.x), fabsf(f3.y)), fmaxf(fabsf(f3.z), fabsf(f3.w)))));
    am = wave_max(am);
    int w0, w1, w2, w3;
    float inv;
    if (isv) {
      const float sc = am > 0.f ? 224.f / am : 1.f;
      inv = am > 0.f ? am * (1.f / 224.f) : 1.f;
      w0 = __builtin_amdgcn_cvt_pk_fp8_f32(f0.x * sc, f0.y * sc, 0, false); w0 = __builtin_amdgcn_cvt_pk_fp8_f32(f0.z * sc, f0.w * sc, w0, true);
      w1 = __builtin_amdgcn_cvt_pk_fp8_f32(f1.x * sc, f1.y * sc, 0, false); w1 = __builtin_amdgcn_cvt_pk_fp8_f32(f1.z * sc, f1.w * sc, w1, true);
      w2 = __builtin_amdgcn_cvt_pk_fp8_f32(f2.x * sc, f2.y * sc, 0, false); w2 = __builtin_amdgcn_cvt_pk_fp8_f32(f2.z * sc, f2.w * sc, w2, true);
      w3 = __builtin_amdgcn_cvt_pk_fp8_f32(f3.x * sc, f3.y * sc, 0, false); w3 = __builtin_amdgcn_cvt_pk_fp8_f32(f3.z * sc, f3.w * sc, w3, true);
    } else {
      const float sc = am > 0.f ? 127.f / am : 1.f;
      inv = am > 0.f ? am * (1.f / 127.f) : 1.f;
      w0 = pack_i8(f0.x * sc, f0.y * sc, f0.z * sc, f0.w * sc); w1 = pack_i8(f1.x * sc, f1.y * sc, f1.z * sc, f1.w * sc);
      w2 = pack_i8(f2.x * sc, f2.y * sc, f2.z * sc, f2.w * sc); w3 = pack_i8(f3.x * sc, f3.y * sc, f3.z * sc, f3.w * sc);
    }
    *(uint4*)((isv ? pv : pu) + (size_t)(lane >> 3) * PSLICE + (size_t)e * 128 + 16 * (lane & 7)) = make_uint4((unsigned)w0, (unsigned)w1, (unsigned)w2, (unsigned)w3);
    if (lane == 0) (isv ? psv : psu)[e] = inv;
  }
}
DEV void unpack16_fp8x2(const uint4& u, f32x2* f) {
  f[0] = __builtin_amdgcn_cvt_pk_f32_fp8((int)u.x, false); f[1] = __builtin_amdgcn_cvt_pk_f32_fp8((int)u.x, true);
  f[2] = __builtin_amdgcn_cvt_pk_f32_fp8((int)u.y, false); f[3] = __builtin_amdgcn_cvt_pk_f32_fp8((int)u.y, true);
  f[4] = __builtin_amdgcn_cvt_pk_f32_fp8((int)u.z, false); f[5] = __builtin_amdgcn_cvt_pk_f32_fp8((int)u.z, true);
  f[6] = __builtin_amdgcn_cvt_pk_f32_fp8((int)u.w, false); f[7] = __builtin_amdgcn_cvt_pk_f32_fp8((int)u.w, true);
}

DEV void bitonic_sort16_desc(float (&v)[16]) {
#pragma unroll
  for (int k = 2; k <= 16; k <<= 1)
#pragma unroll
    for (int j = k >> 1; j >= 1; j >>= 1)
#pragma unroll
      for (int i = 0; i < 16; ++i) {
        const int l = i ^ j;
        if (l > i) {
          const float hi = fmaxf(v[i], v[l]), lo = fminf(v[i], v[l]);
          if ((i & k) == 0) { v[i] = hi; v[l] = lo; } else { v[i] = lo; v[l] = hi; }
        }
      }
}
DEV void peer_cand_ij(int c, int& ci, int& cj) {
  if (c < 16) { ci = 0; cj = c; } else if (c < 24) { ci = 1; cj = c - 16; } else if (c < 29) { ci = 2; cj = c - 24; }
  else if (c < 33) { ci = 3; cj = c - 29; } else if (c < 36) { ci = 4; cj = c - 33; } else if (c < 38) { ci = 5; cj = c - 36; }
  else if (c < 40) { ci = 6; cj = c - 38; } else if (c < 42) { ci = 7; cj = c - 40; } else { ci = (c - 42 + 8) & 15; cj = 0; }
}
DEV void ce_desc(float& a, float& b) { const float hi = fmaxf(a, b), lo = fminf(a, b); a = hi; b = lo; }
DEV void bitonic_merge16_desc(float (&v)[16]) {
#pragma unroll
  for (int d = 8; d >= 1; d >>= 1)
#pragma unroll
    for (int i = 0; i < 16; ++i)
      if ((i & d) == 0) ce_desc(v[i], v[i + d]);
}
template <int N>
DEV void merge_trunc16(float (&T)[16], const float (&B)[N]) {
#pragma unroll
  for (int k = 0; k < N; ++k) T[15 - k] = fmaxf(T[15 - k], B[k]);
  bitonic_merge16_desc(T);
}
DEV float pk_sum(float a, float b, int i, int j) {
  return __uint_as_float((__float_as_uint(a + b) & ~255u) | (unsigned)(255 - (i * 16 + j)));
}
template <int S>
struct Epi3K {
  const P& p; int row0, head; float (&keep)[2][16];
  DEV void operator()(f32x4 (&acc)[4][4], int wr, int wc, int fr, int fq, char* smem) const {
    float* sc = (float*)smem;
    float* L1s = (float*)(smem + 36864);
    float* L2s = (float*)(smem + 47104);
    const int tid = tid_();
#pragma unroll
    for (int pass = 0; pass < 2; ++pass) {
      __syncthreads();
      if (wr == pass) {
#pragma unroll
        for (int m = 0; m < 4; ++m)
#pragma unroll
          for (int n = 0; n < 4; ++n)
#pragma unroll
            for (int j = 0; j < 4; ++j) {
              int rl = m * 16 + fr, col = wc * 64 + n * 16 + 4 * fq + j;
              unsigned bits = (__float_as_uint(acc[m][n][j]) & ~127u) | (unsigned)col;
              sc[rl * 133 + (col >> 5) * 33 + (col & 31)] = __uint_as_float(bits);
            }
      }
      __syncthreads();
      const int rl = tid >> 2, q = tid & 3;
      const float* src = sc + rl * 133 + q * 33;
      float Ls[16], Hs[16];
#pragma unroll
      for (int i = 0; i < 16; ++i) { Ls[i] = src[i]; Hs[i] = src[16 + i]; }
      bitonic_sort16_desc(Ls);
      bitonic_sort16_desc(Hs);
#pragma unroll
      for (int i = 0; i < 16; ++i) Ls[i] = fmaxf(Ls[i], Hs[15 - i]);
#pragma unroll
      for (int d = 8; d >= 1; d >>= 1)
#pragma unroll
        for (int i = 0; i < 16; ++i)
          if ((i & d) == 0) { float hi = fmaxf(Ls[i], Ls[i + d]), lo = fminf(Ls[i], Ls[i + d]); Ls[i] = hi; Ls[i + d] = lo; }
      float Cs[16];
#pragma unroll
      for (int i = 0; i < 16; ++i) Cs[i] = fmaxf(Ls[i], dppself<0xB1, 0xF>(Ls[15 - i]));
#pragma unroll
      for (int d = 8; d >= 1; d >>= 1)
#pragma unroll
        for (int i = 0; i < 16; ++i)
          if ((i & d) == 0) { float hi = fmaxf(Cs[i], Cs[i + d]), lo = fminf(Cs[i], Cs[i + d]); Cs[i] = hi; Cs[i + d] = lo; }
      float Ds[16];
#pragma unroll
      for (int i = 0; i < 16; ++i) Ds[i] = fmaxf(Cs[i], dppself<0x4E, 0xF>(Cs[15 - i]));
#pragma unroll
      for (int d = 8; d >= 1; d >>= 1)
#pragma unroll
        for (int i = 0; i < 16; ++i)
          if ((i & d) == 0) { float hi = fmaxf(Ds[i], Ds[i + d]), lo = fminf(Ds[i], Ds[i + d]); Ds[i] = hi; Ds[i + d] = lo; }
      if (S == 0) {
#pragma unroll
        for (int i = 0; i < 16; ++i) keep[pass][i] = Ds[i];
      } else if (q == 0) {
        float* d1 = L1s + (pass * 64 + rl) * 20;
        float* d2 = L2s + (pass * 64 + rl) * 20;
#pragma unroll
        for (int i = 0; i < 4; ++i) {
          *(float4*)(d1 + 4 * i) = make_float4(keep[pass][4 * i], keep[pass][4 * i + 1], keep[pass][4 * i + 2], keep[pass][4 * i + 3]);
          *(float4*)(d2 + 4 * i) = make_float4(Ds[4 * i], Ds[4 * i + 1], Ds[4 * i + 2], Ds[4 * i + 3]);
        }
      }
    }
    if (S == 1) {
      __syncthreads();
      if (tid < 128) {
        const int row = tid;
        float A[16], Bv[16];
        const float* l1 = L1s + row * 20;
        const float* l2 = L2s + row * 20;
#pragma unroll
        for (int i = 0; i < 4; ++i) {
          const float4 x = *(const float4*)(l1 + 4 * i), y = *(const float4*)(l2 + 4 * i);
          A[4 * i] = x.x; A[4 * i + 1] = x.y; A[4 * i + 2] = x.z; A[4 * i + 3] = x.w;
          Bv[4 * i] = y.x; Bv[4 * i + 1] = y.y; Bv[4 * i + 2] = y.z; Bv[4 * i + 3] = y.w;
        }
        float T[16];
#pragma unroll
        for (int j = 0; j < 16; ++j) T[j] = pk_sum(A[0], Bv[j], 0, j);
        {
          float C0[15];
#pragma unroll
          for (int i = 1; i < 16; ++i) C0[i - 1] = pk_sum(A[i], Bv[0], i, 0);
          merge_trunc16(T, C0);
        }
        {
          float R1[7];
#pragma unroll
          for (int j = 1; j < 8; ++j) R1[j - 1] = pk_sum(A[1], Bv[j], 1, j);
          merge_trunc16(T, R1);
        }
        {
          float C1[6];
#pragma unroll
          for (int i = 2; i < 8; ++i) C1[i - 2] = pk_sum(A[i], Bv[1], i, 1);
          merge_trunc16(T, C1);
        }
        {
          float R2[3];
#pragma unroll
          for (int j = 2; j < 5; ++j) R2[j - 2] = pk_sum(A[2], Bv[j], 2, j);
          merge_trunc16(T, R2);
        }
        {
          float C2[2] = {pk_sum(A[3], Bv[2], 3, 2), pk_sum(A[4], Bv[2], 4, 2)};
          merge_trunc16(T, C2);
        }
        {
          float X3[1] = {pk_sum(A[3], Bv[3], 3, 3)};
          merge_trunc16(T, X3);
        }
        const float mx = T[0];
        float ex[16], sm = 0.f;
        unsigned ee[16];
#pragma unroll
        for (int k = 0; k < 16; ++k) {
          const unsigned tg = 255u - (__float_as_uint(T[k]) & 255u);
          const unsigned k1 = __float_as_uint(l1[tg >> 4]) & 127u, k2 = __float_as_uint(l2[tg & 15u]) & 127u;
          ee[k] = k1 * 128u + k2;
          ex[k] = __expf(T[k] - mx);
          sm += ex[k];
        }
        const float rs = 1.f / sm;
        const size_t o = (size_t)(row0 + row) * 128 + head * 16;
        uint4* elp = (uint4*)(p.EL + o);
        elp[0] = make_uint4(ee[0] | (ee[1] << 16), ee[2] | (ee[3] << 16), ee[4] | (ee[5] << 16), ee[6] | (ee[7] << 16));
        elp[1] = make_uint4(ee[8] | (ee[9] << 16), ee[10] | (ee[11] << 16), ee[12] | (ee[13] << 16), ee[14] | (ee[15] << 16));
        float4* gtp = (float4*)(p.GT + o);
#pragma unroll
        for (int i = 0; i < 4; ++i) gtp[i] = make_float4(ex[4 * i] * rs, ex[4 * i + 1] * rs, ex[4 * i + 2] * rs, ex[4 * i + 3] * rs);
      }
    }
  }
};
DEV void ph_gemm3(const P& p, char* smem) {
  int rt, hd;
  for (int it = 0; gemm_unit(it, 8, rt, hd); ++it) {
    float keep[2][16];
    {
      Epi3K<0> epi{p, rt * 128, hd, keep};
      gemm_tile(p.H + (size_t)rt * 128 * D, D, p.Wft + (size_t)(2 * hd) * 128 * D, D, D, smem, epi);
    }
    {
      Epi3K<1> epi{p, rt * 128, hd, keep};
      gemm_tile(p.H + (size_t)rt * 128 * D, D, p.Wft + (size_t)(2 * hd + 1) * 128 * D, D, D, smem, epi);
    }
  }
}

DEV float peer_gate(float scr) {
  float mx = row16_max(scr);
  float ex = __expf(scr - mx);
  float sm = row16_sum(ex);
  return ex / sm;
}
DEV float gelu_exact(float x) { return 0.5f * x * (1.f + erff(x * 0.7071067811865476f)); }

struct PeerPre { uint4 e0, e1, a0, a1; };
DEV unsigned peer_eid(const PeerPre& s, int j) {
  const unsigned w = (j < 8) ? ((j >> 1) == 0 ? s.e0.x : (j >> 1) == 1 ? s.e0.y : (j >> 1) == 2 ? s.e0.z : s.e0.w)
                             : (((j - 8) >> 1) == 0 ? s.e1.x : ((j - 8) >> 1) == 1 ? s.e1.y : ((j - 8) >> 1) == 2 ? s.e1.z : s.e1.w);
  return (j & 1) ? (w >> 16) : (w & 0xFFFFu);
}
template <int WHICH>
DEV void peer_wave_run(const P& p, int layer, int x, int tok0, int lane, float* wbuf) {
  const int r = lane >> 3, c = lane & 7;
  const unsigned char* tb = (WHICH == 0 ? p.PU : p.PV) + (size_t)x * PSLICE + c * 16;
  PeerPre S[3];
  uint4 R[16];
  auto ld_pre = [&](int tok, PeerPre& s) {
    const uint4* elp = (const uint4*)(p.EL + (size_t)tok * 128 + r * 16);
    s.e0 = elp[0]; s.e1 = elp[1];
    if (WHICH == 0) {
      s.a0 = *(const uint4*)(p.H8 + (size_t)tok * 1024 + x * 128 + c * 16);
    } else {
      const uint4* wtp = (const uint4*)(p.GW + (size_t)tok * 128 + r * 16);
      s.a0 = wtp[0]; s.a1 = wtp[1];
    }
  };
  auto comp = [&](int tok, const PeerPre& s, const PeerPre& sn, bool more) {
    if (WHICH == 0) {
      int keep0 = 0, keep1 = 0;
#pragma unroll
      for (int j = 0; j < 16; ++j) {
        const uint4 rw = R[j];
        if (more) R[j] = *(const uint4*)(tb + (size_t)peer_eid(sn, j) * 128);
        int d = __builtin_amdgcn_sdot4((int)rw.x, (int)s.a0.x, 0, false);
        d = __builtin_amdgcn_sdot4((int)rw.y, (int)s.a0.y, d, false);
        d = __builtin_amdgcn_sdot4((int)rw.z, (int)s.a0.z, d, false);
        d = __builtin_amdgcn_sdot4((int)rw.w, (int)s.a0.w, d, false);
        d += __builtin_amdgcn_update_dpp(0, d, 0xB1, 0xF, 0xF, false);
        d += __builtin_amdgcn_update_dpp(0, d, 0x4E, 0xF, 0xF, false);
        d += __builtin_amdgcn_update_dpp(0, d, 0x141, 0xF, 0xF, false);
        if (j < 8) keep0 = (c == j) ? d : keep0; else keep1 = (c == j - 8) ? d : keep1;
      }
      bf16_t* pd = p.PD + ((size_t)x * NTOK + tok) * 128 + r * 16 + c;
      pd[0] = f2bf((float)keep0); pd[8] = f2bf((float)keep1);
    } else {
      float wsv[16];
      unpack8(s.a0, wsv); unpack8(s.a1, wsv + 8);
      f32x2 acc2[8];
#pragma unroll
      for (int i = 0; i < 8; ++i) acc2[i] = (f32x2){0.f, 0.f};
#pragma unroll
      for (int j = 0; j < 16; ++j) {
        f32x2 f[8];
        unpack16_fp8x2(R[j], f);
        if (more) R[j] = *(const uint4*)(tb + (size_t)peer_eid(sn, j) * 128);
        const f32x2 w2 = (f32x2){wsv[j], wsv[j]};
#pragma unroll
        for (int i = 0; i < 8; ++i) acc2[i] += w2 * f[i];
      }
      float* slab = wbuf + (r * 8 + c) * 16;
      *(float4*)(slab) = make_float4(acc2[0][0], acc2[0][1], acc2[1][0], acc2[1][1]);
      *(float4*)(slab + 4) = make_float4(acc2[2][0], acc2[2][1], acc2[3][0], acc2[3][1]);
      *(float4*)(slab + 8) = make_float4(acc2[4][0], acc2[4][1], acc2[5][0], acc2[5][1]);
      *(float4*)(slab + 12) = make_float4(acc2[6][0], acc2[6][1], acc2[7][0], acc2[7][1]);
      asm volatile("s_waitcnt lgkmcnt(0)" ::: "memory");
      float o0 = 0.f, o1 = 0.f;
#pragma unroll
      for (int rr = 0; rr < 8; ++rr) {
        const float2 t = *(const float2*)(wbuf + (rr * 8 + (lane >> 3)) * 16 + 2 * (lane & 7));
        o0 += t.x; o1 += t.y;
      }
      asm volatile("s_waitcnt lgkmcnt(0)" ::: "memory");
      const int b = tok / LT, pp = tok % LT;
      const int mr = pp < LC ? 16 : b;
      const int col = x * 128 + 2 * lane;
      const float* g2 = p.modv + ((size_t)layer * 17 + mr) * 6144 + 5120 + col;
      unsigned* xp = (unsigned*)(p.X + (size_t)tok * D + col);
      const unsigned xu = *xp;
      *xp = pack2(bflo(xu) + g2[0] * o0, bfhi(xu) + g2[1] * o1);
    }
  };
  ld_pre(tok0, S[0]);
  ld_pre(tok0 + 1, S[1]);
#pragma unroll
  for (int j = 0; j < 16; ++j) R[j] = *(const uint4*)(tb + (size_t)peer_eid(S[0], j) * 128);
  ld_pre(tok0 + 2, S[2]);
#pragma unroll
  for (int t = 0; t < 8; ++t) {
    comp(tok0 + t, S[t % 3], S[(t + 1) % 3], t + 1 < 8);
    if (t + 3 < 8) ld_pre(tok0 + t + 3, S[t % 3]);
  }
}
DEV void ph_peer_w(const P& p) {
  for (size_t i8 = (size_t)bid_() * 256 + tid_(); i8 < (size_t)NTOK * 16; i8 += (size_t)gridDim.x * 256) {
    const size_t i = i8 * 8;
    float d[8];
#pragma unroll
    for (int q = 0; q < 8; ++q) d[q] = 0.f;
#pragma unroll
    for (int x = 0; x < 8; ++x) {
      const uint4 u = *(const uint4*)(p.PD + (size_t)x * NTOK * 128 + i);
      float f[8];
      unpack8(u, f);
#pragma unroll
      for (int q = 0; q < 8; ++q) d[q] += f[q];
    }
    const uint4 eu = *(const uint4*)(p.EL + i);
    const unsigned ew[4] = {eu.x, eu.y, eu.z, eu.w};
    const float hinv = p.HINV[i >> 7];
    float4 g0 = *(const float4*)(p.GT + i), g1 = *(const float4*)(p.GT + i + 4);
    float g[8] = {g0.x, g0.y, g0.z, g0.w, g1.x, g1.y, g1.z, g1.w};
#pragma unroll
    for (int q = 0; q < 8; ++q) {
      const unsigned e = (q & 1) ? (ew[q >> 1] >> 16) : (ew[q >> 1] & 0xFFFFu);
      g[q] = g[q] * gelu_exact(d[q] * p.PSU[e] * hinv) * p.PSV[e];
    }
    *(uint4*)(p.GW + i) = pack8(g);
  }
}
template <int WHICH>
DEV void ph_peer_gather(const P& p, int layer, char* smem, volatile LAS unsigned* slot) {
  const int tid = tid_(), lane = tid & 63, wid = tid >> 6;
  unsigned* q = p.wq + 1024 + layer * 256 + WHICH * 128;
  const int my = (int)(xb_xcc_id() & 7u);
  float* wbuf = (float*)smem + wid * 1024;
#pragma unroll 1
  for (int rot = 0; rot < 8; ++rot) {
    const int x = (my + rot) & 7;
    for (;;) {
      __syncthreads();
      if (tid == 0) *slot = atomicAdd(q + x * 16, 1u);
      __syncthreads();
      const int it = (int)*slot;
      if (it >= NTOK / 64) break;
      peer_wave_run<WHICH>(p, layer, x, it * 64 + wid * 16, lane, wbuf);
      peer_wave_run<WHICH>(p, layer, x, it * 64 + wid * 16 + 8, lane, wbuf);
    }
  }
}

DEV void ph_final(const P& p) {
  const int lane = tid_() & 63;
  int r0, r1;
  wave_range(r0, r1, NB * T);
  float gv[16];
#pragma unroll
  for (int hh = 0; hh < 2; ++hh)
#pragma unroll
    for (int i = 0; i < 8; ++i) gv[hh * 8 + i] = p.final_g[hh * 512 + 8 * lane + i];
  auto xrow = [&](int r) -> const bf16_t* { const int b = r / T, t = r % T; return p.X + ((size_t)b * LT + LC + t) * D; };
  uint4 n0 = make_uint4(0, 0, 0, 0), n1 = n0;
  if (r0 < r1) { const bf16_t* xr = xrow(r0); n0 = *(const uint4*)(xr + 8 * lane); n1 = *(const uint4*)(xr + 512 + 8 * lane); }
#pragma unroll 1
  for (int r = r0; r < r1; ++r) {
    const uint4 u0 = n0, u1 = n1;
    if (r + 1 < r1) { const bf16_t* xr = xrow(r + 1); n0 = *(const uint4*)(xr + 8 * lane); n1 = *(const uint4*)(xr + 512 + 8 * lane); }
    float v[16];
    unpack8(u0, v); unpack8(u1, v + 8);
    float ss = 0.f;
#pragma unroll
    for (int i = 0; i < 16; ++i) ss += v[i] * v[i];
    ss = wave_sum(ss);
    const float rstd = rsqrtf(ss * (1.f / 1024.f) + 1e-6f);
    float* o = p.out + (size_t)r * D;
#pragma unroll
    for (int hh = 0; hh < 2; ++hh) {
      const int col = hh * 512 + 8 * lane;
      *(float4*)(o + col) = make_float4(v[hh * 8 + 0] * rstd * gv[hh * 8 + 0], v[hh * 8 + 1] * rstd * gv[hh * 8 + 1], v[hh * 8 + 2] * rstd * gv[hh * 8 + 2], v[hh * 8 + 3] * rstd * gv[hh * 8 + 3]);
      *(float4*)(o + col + 4) = make_float4(v[hh * 8 + 4] * rstd * gv[hh * 8 + 4], v[hh * 8 + 5] * rstd * gv[hh * 8 + 5], v[hh * 8 + 6] * rstd * gv[hh * 8 + 6], v[hh * 8 + 7] * rstd * gv[hh * 8 + 7]);
    }
  }
}

DEV unsigned hw_cu_key() {
  const unsigned hwid = (unsigned)__builtin_amdgcn_s_getreg(((8 - 1) << 11) | (8 << 6) | 4);
  return (xb_xcc_id() << 8) | (hwid & 0xFFu);
}
DEV void mixB(const P& p, int layer, char* smem, volatile LAS unsigned* slot) {
  unsigned* qa = p.wq + layer * 64;
  unsigned* qs = qa + 16;
  unsigned* claim = p.cuclaim + layer * 4096;
  __syncthreads();
  if (tid_() == 0) {
    unsigned u = 0xFFFFFFFFu;
    if (atomicAdd(&claim[hw_cu_key() & 4095u], 1u) == 0u) u = atomicAdd(qs, 1u);
    *slot = u;
  }
  __syncthreads();
  {
    const unsigned u = *slot;
    if (u < 128u) scanc_unit(p, layer, (int)u, smem);
  }
  for (;;) {
    __syncthreads();
    if (tid_() == 0) *slot = atomicAdd(qa, 1u);
    __syncthreads();
    const int u = (int)*slot;
    if (u >= 8704) break;
    if (u < 4352) attn_unit(p, layer, u, smem); else hyena_conv_unit(p, layer, u - 4352, smem);
  }
  if (layer + 1 < DEPTH) {
    unsigned* qp = qa + 32;
    for (;;) {
      __syncthreads();
      if (tid_() == 0) *slot = atomicAdd(qp, 1u);
      __syncthreads();
      const int u = (int)*slot;
      if (u >= PREPA_N) break;
      prep_unit(p, layer + 1, prepA_unit_index(u), smem);
    }
  }
  for (;;) {
    __syncthreads();
    if (tid_() == 0) *slot = atomicAdd(qs, 1u);
    __syncthreads();
    const unsigned u = *slot;
    if (u >= 128u) break;
    scanc_unit(p, layer, (int)u, smem);
  }
}
DEV void mixA(const P& p, int layer, char* smem) {
  for (int u = bid_(); u < 1088; u += gridDim.x) hyena_pre_unit(p, layer, u);
  ph_lora(p, layer, smem);
  ph_rwkv_prep(p, layer);
}
DEV void mixC(const P& p, int layer, char* smem) {
  for (int u = bid_(); u < 1088; u += gridDim.x) hyena_post_unit(p, layer, u, smem);
  ph_rwkv_post(p, layer);
  ph_attn_post(p, layer);
}

__global__ void __launch_bounds__(256, 2) k_mega(P p) {
  extern __shared__ __attribute__((aligned(16))) char smem_all[];
  char* smem = smem_all;
  volatile LAS unsigned* xbw = (volatile LAS unsigned*)(smem_all + SMEM_BYTES);
  if (threadIdx.x == 0) { xbw[0] = 0u; xbw[1] = 0u; xbw[2] = 0u; xbw[3] = 0u; }
  __syncthreads();
  XcdBarrier bar = xcd_barrier_post(p.bar, xbw);
  ph_rope(p);
  for (int u = blockIdx.x; u < 96; u += gridDim.x) modv_unit(p, u, smem);
  ph_prep(p, 0, smem, false);
  xcd_barrier(bar);
  for (int layer = 0; layer < DEPTH; ++layer) {
    if (layer == 0) ph_norm_first(p); else ph_norm(p, layer, 0);
    xcd_barrier(bar);
    ph_gemm1(p, smem);
    xcd_barrier(bar);
    mixA(p, layer, smem);
    xcd_barrier(bar);
    mixB(p, layer, smem, (volatile LAS unsigned*)(smem_all + SMEM_BYTES + 16));
    xcd_barrier(bar);
    mixC(p, layer, smem);
    xcd_barrier(bar);
    ph_gemm2(p, layer, smem);
    ph_peerconv(p, layer);
    xcd_barrier(bar);
    ph_norm(p, layer, 1);
    xcd_barrier(bar);
    ph_gemm3(p, smem);
    xcd_barrier(bar);
    ph_peer_gather<0>(p, layer, smem, (volatile LAS unsigned*)(smem_all + SMEM_BYTES + 16));
    xcd_barrier(bar);
    ph_peer_w(p);
    xcd_barrier(bar);
    ph_peer_gather<1>(p, layer, smem, (volatile LAS unsigned*)(smem_all + SMEM_BYTES + 16));
    if (layer + 1 < DEPTH) ph_prep(p, layer + 1, smem, true);
    xcd_barrier(bar);
  }
  ph_final(p);
}

static inline size_t al256(size_t x) { return (x + 255) & ~(size_t)255; }

extern "C" void kernel_launch(void* const* d_in, const int* in_sizes, int n_in, void* d_out, int out_size, void* d_ws, size_t ws_size,
                              hipStream_t stream) {
  (void)in_sizes; (void)n_in; (void)out_size; (void)ws_size;
  P p{};
  const float** f = (const float**)&p;
  for (int i = 0; i < 39; ++i) f[i] = (const float*)d_in[i];
  p.out = (float*)d_out;
  char* w = (char*)d_ws;
  size_t off = 0;
  auto take = [&](size_t bytes) { char* r = w + off; off += al256(bytes); return r; };
  p.bar = (unsigned*)take(16384);
  p.modv = (float*)take((size_t)DEPTH * 17 * 6144 * 4);
  p.SSQ = (float*)take((size_t)DEPTH * 2 * 256 * 4);
  p.wq = (unsigned*)take(4096 + DEPTH * 1024);
  p.cuclaim = (unsigned*)take((size_t)DEPTH * 4096 * 4);
  const size_t zero_bytes = off;
  p.rope = (float*)take(64 * 16 * 2 * 4);
  p.X = (bf16_t*)take((size_t)NTOK * D * 2);
  p.H = (bf16_t*)take((size_t)NTOK * D * 2);
  p.Y = (bf16_t*)take((size_t)NTOK * D * 2);
  p.SC = (bf16_t*)take((size_t)NTOK * 1024 * 2);
  p.Z = (bf16_t*)take((size_t)NTOK * INW * 2);
  p.UTl = (bf16_t*)take((size_t)256 * 16 * T * 2);
  p.UTc = (bf16_t*)take((size_t)256 * 16 * LC * 2);
  p.YTl = (bf16_t*)take((size_t)256 * 16 * T * 2);
  p.YTc = (bf16_t*)take((size_t)256 * 16 * LC * 2);
  p.FL = (float*)take((size_t)256 * 2 * T * 4);
  p.FC = (float*)take((size_t)256 * 2 * LC * 4);
  p.W1t = (bf16_t*)take((size_t)INW * D * 2);
  p.W2t = (bf16_t*)take((size_t)D * D * 2);
  p.Wft = (bf16_t*)take((size_t)2048 * D * 2);
  p.Wlt = (bf16_t*)take((size_t)1024 * 256 * 2);
  p.Wgt = (bf16_t*)take((size_t)256 * 128 * 2);
  p.TK = (float*)p.Z;
  p.PU = (unsigned char*)p.Z + al256((size_t)NTOK * 256 * 4);
  p.PV = p.PU + (size_t)16384 * 1024;
  p.PSU = (float*)(p.PV + (size_t)16384 * 1024);
  p.PSV = p.PSU + 16384;
  p.GT = p.PSV + 16384;
  p.EL = (unsigned short*)(p.GT + (size_t)NTOK * 128);
  p.H8 = (unsigned char*)p.EL + al256((size_t)NTOK * 128 * 2);
  p.HINV = (float*)(p.H8 + (size_t)NTOK * 1024);
  p.GW = (bf16_t*)((char*)p.HINV + al256((size_t)NTOK * 4));
  p.PD = p.Y;

  (void)hipMemsetAsync(d_ws, 0, zero_bytes, stream);
  constexpr size_t kDynLds = SMEM_BYTES + 32;
  static int grid = 0;
  if (!grid) {
    int dev = 0, cus = 0, per_cu = 0;
    (void)hipGetDevice(&dev);
    (void)hipDeviceGetAttribute(&cus, hipDeviceAttributeMultiprocessorCount, dev);
    (void)hipFuncSetAttribute((const void*)k_mega, hipFuncAttributeMaxDynamicSharedMemorySize, (int)kDynLds);
    (void)hipOccupancyMaxActiveBlocksPerMultiprocessor(&per_cu, k_mega, 256, kDynLds);
    if (cus <= 0) cus = 256;
    if (per_cu > 2) per_cu = 2;
    if (per_cu < 1) per_cu = 1;
    grid = cus * per_cu;
  }
  k_mega<<<grid, 256, kDynLds, stream>>>(p);
}
```

```cpp
#include <hip/hip_runtime.h>
#include <stdint.h>
#include <type_traits>

#define DEV __device__ __forceinline__
typedef unsigned short bf16_t;
typedef short bf16x8 __attribute__((ext_vector_type(8)));
typedef float f32x2 __attribute__((ext_vector_type(2)));
constexpr size_t PSLICE = (size_t)16384 * 128;
typedef float f32x4 __attribute__((ext_vector_type(4)));
typedef float f32x16 __attribute__((ext_vector_type(16)));


constexpr int NB = 16, T = 4096, LC = 256, LT = 4352, D = 1024, NTOK = NB * LT, INW = 2688, DEPTH = 4;
constexpr int SMEM_BYTES = 65536;

struct P {
  const float *x, *c, *ctx, *c_ctx, *mod_w, *mod_b, *norm1_g, *norm2_g, *w_in, *conv_w, *conv_b;
  const float *hy_w1, *hy_b1, *hy_w2, *hy_b2, *hy_w3, *hy_b3, *hy_freq, *hy_bias;
  const float *rw_w0, *rw_w_up, *rw_a0, *rw_a_up, *rw_g_up, *rw_k_k, *rw_k_a, *rw_r_k, *rw_ln_w, *rw_ln_b;
  const float *attn_sink, *hy_out_g, *at_out_g, *w_out, *peer_wq, *peer_k1, *peer_k2, *peer_u, *peer_v, *final_g;
  float* out;
  unsigned* bar;
  float *modv, *SSQ, *rope, *FL, *FC, *TK;
  unsigned *wq, *cuclaim;
  bf16_t *X, *H, *Y, *SC, *Z, *UTl, *UTc, *YTl, *YTc;
  bf16_t *W1t, *W2t, *Wft, *Wlt, *Wgt;
  unsigned char *PU, *PV;
  float *PSU, *PSV, *GT, *HINV;
  bf16_t *PD, *GW;
  unsigned short* EL;
  unsigned char* H8;
};

typedef __bf16 hwbf2 __attribute__((ext_vector_type(2)));
DEV unsigned pack2(float a, float b) { f32x2 f = {a, b}; hwbf2 r = __builtin_convertvector(f, hwbf2); return __builtin_bit_cast(unsigned, r); }
DEV bf16_t f2bf(float f) { return (bf16_t)(pack2(f, 0.f) & 0xFFFFu); }
DEV float bf2f(bf16_t h) { return __uint_as_float(((unsigned)h) << 16); }
DEV float bflo(unsigned u) { return __uint_as_float(u << 16); }
DEV float bfhi(unsigned u) { return __uint_as_float(u & 0xFFFF0000u); }
DEV void unpack8(const uint4& u, float* v) {
  v[0] = bflo(u.x); v[1] = bfhi(u.x); v[2] = bflo(u.y); v[3] = bfhi(u.y);
  v[4] = bflo(u.z); v[5] = bfhi(u.z); v[6] = bflo(u.w); v[7] = bfhi(u.w);
}
DEV uint4 pack8(const float* v) { return make_uint4(pack2(v[0], v[1]), pack2(v[2], v[3]), pack2(v[4], v[5]), pack2(v[6], v[7])); }
DEV int pack_i8(float a, float b, float c, float d) {
  const int ia = __float2int_rn(a), ib = __float2int_rn(b), ic = __float2int_rn(c), id = __float2int_rn(d);
  return (ia & 0xFF) | ((ib & 0xFF) << 8) | ((ic & 0xFF) << 16) | ((id & 0xFF) << 24);
}
DEV float sigmoidf_(float x) { return __builtin_amdgcn_rcpf(1.f + __expf(-x)); }

template <int CTRL, int ROWMASK>
DEV float dpp0(float x) {
  return __builtin_bit_cast(float, __builtin_amdgcn_update_dpp(0, __builtin_bit_cast(int, x), CTRL, ROWMASK, 0xF, false));
}
template <int CTRL, int ROWMASK>
DEV float dppself(float x) {
  int xi = __builtin_bit_cast(int, x);
  return __builtin_bit_cast(float, __builtin_amdgcn_update_dpp(xi, xi, CTRL, ROWMASK, 0xF, false));
}
DEV float readlane_f(float x, int l) { return __builtin_bit_cast(float, __builtin_amdgcn_readlane(__builtin_bit_cast(int, x), l)); }
DEV int lane_id() { return (int)__builtin_amdgcn_mbcnt_hi(~0u, __builtin_amdgcn_mbcnt_lo(~0u, 0u)); }
DEV float writelane_f(float val, int l, float old) { return lane_id() == l ? val : old; }
DEV int writelane_i(int val, int l, int old) { return lane_id() == l ? val : old; }
DEV float wave_sum(float x) {
  x += dpp0<0x111, 0xF>(x); x += dpp0<0x112, 0xF>(x); x += dpp0<0x114, 0xF>(x); x += dpp0<0x118, 0xF>(x);
  x += dpp0<0x142, 0xA>(x); x += dpp0<0x143, 0xC>(x);
  return readlane_f(x, 63);
}
DEV float wave_max(float x) {
  x = fmaxf(x, dppself<0x111, 0xF>(x)); x = fmaxf(x, dppself<0x112, 0xF>(x)); x = fmaxf(x, dppself<0x114, 0xF>(x));
  x = fmaxf(x, dppself<0x118, 0xF>(x)); x = fmaxf(x, dppself<0x142, 0xA>(x)); x = fmaxf(x, dppself<0x143, 0xC>(x));
  return readlane_f(x, 63);
}
DEV float row16_sum(float x) {
  x += dpp0<0xB1, 0xF>(x); x += dpp0<0x4E, 0xF>(x); x += dpp0<0x141, 0xF>(x); x += dpp0<0x140, 0xF>(x);
  return x;
}
DEV float row16_max(float x) {
  x = fmaxf(x, dppself<0xB1, 0xF>(x)); x = fmaxf(x, dppself<0x4E, 0xF>(x)); x = fmaxf(x, dppself<0x141, 0xF>(x));
  x = fmaxf(x, dppself<0x140, 0xF>(x));
  return x;
}
DEV float quad_sum(float x) { x += dpp0<0xB1, 0xF>(x); x += dpp0<0x4E, 0xF>(x); return x; }

DEV f32x4 mfma16(bf16x8 a, bf16x8 b, f32x4 c) { return __builtin_amdgcn_mfma_f32_16x16x32_bf16(a, b, c, 0, 0, 0); }
DEV f32x16 mfma32(bf16x8 a, bf16x8 b, f32x16 c) { return __builtin_amdgcn_mfma_f32_32x32x16_bf16(a, b, c, 0, 0, 0); }


#define XB_TMO      128
#define XB_XCNT(j)  (256  + 64 * (j))
#define XB_XSUB(j)  (1280 + 64 * (j))
#define XB_XGEN(j)  (2304 + 64 * (j))
#define XB_TOP      3328
#define XB_TOPGEN   3392
#define XCD_BAR_WORDS 3456
#define XB_SPIN_CAP (1u << 23)
#define LAS __attribute__((address_space(3)))

__device__ __forceinline__ unsigned xb_ld(unsigned* p)              { return __hip_atomic_load(p, __ATOMIC_RELAXED, __HIP_MEMORY_SCOPE_AGENT); }
__device__ __forceinline__ unsigned xb_add(unsigned* p, unsigned v) { return __hip_atomic_fetch_add(p, v, __ATOMIC_RELAXED, __HIP_MEMORY_SCOPE_AGENT); }
__device__ __forceinline__ unsigned xb_xcc_id() { return (unsigned)__builtin_amdgcn_s_getreg((3 << 11) | 20) & 0xFu; }
#define XB_SPIN(cond, bar) do { unsigned _sp = 0; while (cond) { __builtin_amdgcn_s_sleep(1); \
    if ((++_sp & 255u) == 0u) { if (xb_ld(&(bar)[XB_TMO])) break; if (_sp > XB_SPIN_CAP) { atomicAdd(&(bar)[XB_TMO], 1u); break; } } } } while (0)

struct XcdBarrier {
    unsigned* bar; unsigned x;
    volatile LAS unsigned* st;
};
__device__ __forceinline__ XcdBarrier xcd_barrier_post(unsigned* bar, volatile LAS unsigned* st) {
    XcdBarrier b; b.bar = bar; b.x = xb_xcc_id(); b.st = st;
    if (threadIdx.x == 0) (void)xb_add(&bar[XB_XCNT(b.x)], 1u);
    return b;
}
__device__ __forceinline__ void xcd_barrier_complete(unsigned* bar, unsigned x, unsigned& nloc, unsigned& nx) {
    const unsigned G = gridDim.x * gridDim.y * gridDim.z;
    unsigned sum, cnt, mine, sp = 0u;
    for (;;) {
        sum = 0u; cnt = 0u; mine = 0u;
#pragma unroll
        for (unsigned j = 0; j < 16; ++j) { const unsigned c = xb_ld(&bar[XB_XCNT(j)]); sum += c; cnt += (c > 0u) ? 1u : 0u; mine = (j == x) ? c : mine; }
        if (sum == G) break;
        __builtin_amdgcn_s_sleep(1);
        if ((++sp & 255u) == 0u) { if (xb_ld(&bar[XB_TMO])) break; if (sp > XB_SPIN_CAP) { atomicAdd(&bar[XB_TMO], 1u); break; } }
    }
    nloc = mine > 0u ? mine : 1u; nx = cnt > 0u ? cnt : 1u;
}
__device__ __forceinline__ void xcd_barrier(const XcdBarrier& b) {
    asm volatile("s_waitcnt vmcnt(0)" ::: "memory");
    __syncthreads();
    if (threadIdx.x == 0) {
        unsigned* bar = b.bar;
        __builtin_amdgcn_s_waitcnt(0);
        unsigned nloc = b.st[0], nx = b.st[1];
        if (nloc == 0u) { xcd_barrier_complete(bar, b.x, nloc, nx); b.st[0] = nloc; b.st[1] = nx; }
        const unsigned old = xb_add(&bar[XB_XSUB(b.x)], 1u);
        const unsigned gen = old / nloc;
        if (old + 1u == (gen + 1u) * nloc) {
            __builtin_amdgcn_fence(__ATOMIC_RELEASE, "agent");
            asm volatile("s_waitcnt vmcnt(0)" ::: "memory");
            const unsigned og = xb_add(&bar[XB_TOP], 1u);
            const unsigned tg = og / nx;
            if (og + 1u == (tg + 1u) * nx) xb_add(&bar[XB_TOPGEN], 1u);
            else XB_SPIN(xb_ld(&bar[XB_TOPGEN]) == tg, bar);
            __builtin_amdgcn_fence(__ATOMIC_ACQUIRE, "agent");
            xb_add(&bar[XB_XGEN(b.x)], 1u);
            asm volatile("s_waitcnt vmcnt(0)" ::: "memory");
        } else {
            XB_SPIN(xb_ld(&bar[XB_XGEN(b.x)]) == gen, bar);
            __builtin_amdgcn_fence(__ATOMIC_ACQUIRE, "agent");
            asm volatile("s_waitcnt vmcnt(0)" ::: "memory");
        }
    }
    __syncthreads();
}

template <class Tp> DEV Tp* opq(Tp* q) { asm volatile("" : "+s"(q)); return q; }
DEV int tid_() { int t = threadIdx.x; asm volatile("" : "+v"(t)); return t; }
DEV int bid_() { int b = blockIdx.x; asm volatile("" : "+s"(b)); return b; }

DEV void glds16(const void* gsrc, char* lds_lane_ptr) {
  __builtin_amdgcn_global_load_lds((const unsigned*)gsrc, (__attribute__((address_space(3))) unsigned*)lds_lane_ptr, 16, 0, 0);
}
template <class Epi>
DEV void gemm_tile(const bf16_t* __restrict__ A, int lda, const bf16_t* __restrict__ Bt, int ldb, int K, char* smem, Epi& epi) {
  const int tid = tid_(), lane = tid & 63, wid = tid >> 6, wr = wid >> 1, wc = wid & 1, fr = lane & 15, fq = lane >> 4;
  f32x4 acc[4][4];
#pragma unroll
  for (int m = 0; m < 4; ++m)
#pragma unroll
    for (int n = 0; n < 4; ++n) acc[m][n] = (f32x4){0.f, 0.f, 0.f, 0.f};
  const int drow0 = 8 * wid + (lane >> 3), dpc = lane & 7;
  auto issue = [&](int kt, int buf) {
    char* sa = smem + buf * 32768;
    char* sb = sa + 16384;
#pragma unroll
    for (int i = 0; i < 4; ++i) {
      const int row = drow0 + 32 * i;
      const int kc = dpc ^ ((row >> 1) & 7);
      glds16(A + (size_t)row * lda + kt * 64 + kc * 8, sa + (i * 4 + wid) * 1024 + lane * 16);
      glds16(Bt + (size_t)row * ldb + kt * 64 + kc * 8, sb + (i * 4 + wid) * 1024 + lane * 16);
    }
  };
  __syncthreads();
  issue(0, 0);
  const int nk = K >> 6;
  const int sw = (fr >> 1) & 7;
  const int aoff = (wr * 64 + fr) * 128, boff = (wc * 64 + fr) * 128;
  for (int kt = 0; kt < nk; ++kt) {
    asm volatile("s_waitcnt vmcnt(0)" ::: "memory");
    __syncthreads();
    if (kt + 1 < nk) issue(kt + 1, (kt + 1) & 1);
    const char* sa = smem + (kt & 1) * 32768;
    const char* sb = sa + 16384;
#pragma unroll
    for (int kh = 0; kh < 2; ++kh) {
      const int pc = ((kh * 4 + fq) ^ sw) * 16;
      bf16x8 af[4], bfr[4];
#pragma unroll
      for (int m = 0; m < 4; ++m) af[m] = *(const bf16x8*)(sa + aoff + m * 2048 + pc);
#pragma unroll
      for (int n = 0; n < 4; ++n) bfr[n] = *(const bf16x8*)(sb + boff + n * 2048 + pc);
#pragma unroll
      for (int m = 0; m < 4; ++m)
#pragma unroll
        for (int n = 0; n < 4; ++n) acc[m][n] = mfma16(bfr[n], af[m], acc[m][n]);
    }
  }
  __syncthreads();
  epi(acc, wr, wc, fr, fq, smem);
}
DEV void stage_tile_bf16(const f32x4 (&acc)[4][4], char* smem, int wid, int fr, int fq) {
  bf16_t (*t)[72] = (bf16_t (*)[72])(smem + wid * 9216);
#pragma unroll
  for (int m = 0; m < 4; ++m)
#pragma unroll
    for (int n = 0; n < 4; ++n)
      *(uint2*)&t[m * 16 + fr][n * 16 + 4 * fq] = make_uint2(pack2(acc[m][n][0], acc[m][n][1]), pack2(acc[m][n][2], acc[m][n][3]));
  asm volatile("s_waitcnt lgkmcnt(0)" ::: "memory");
}

DEV void ph_copy(const P& p) {
  const size_t n8 = (size_t)NTOK * D / 8;
  const float* pctx = opq(p.ctx); const float* px = opq(p.x);
  for (size_t i = (size_t)bid_() * 256 + tid_(); i < n8; i += (size_t)gridDim.x * 256) {
    size_t e = i * 8;
    int row = (int)(e / D), col = (int)(e % D);
    int b = row / LT, pp = row % LT;
    const float* src = pp < LC ? pctx + ((size_t)(b * LC + pp)) * D + col : px + ((size_t)(b * T + pp - LC)) * D + col;
    float4 v0 = *(const float4*)src, v1 = *(const float4*)(src + 4);
    uint4 o = make_uint4(pack2(v0.x, v0.y), pack2(v0.z, v0.w), pack2(v1.x, v1.y), pack2(v1.z, v1.w));
    *(uint4*)(p.X + e) = o;
  }
}

DEV void ph_rope(const P& p) {
  for (int i = bid_() * 256 + tid_(); i < 64 * 16; i += gridDim.x * 256) {
    int pos = i >> 4, k = i & 15;
    float inv = powf(10000.f, -(float)k / 16.f);
    float ang = (float)pos * inv;
    p.rope[2 * i] = cosf(ang); p.rope[2 * i + 1] = sinf(ang);
  }
}

DEV void modv_unit(const P& p, int unit, char* smem) {
  const int cc = unit % 24, layer = unit / 24;
  float (*cs)[128] = (float (*)[128])smem;
  const int col = cc * 256 + tid_();
  const float* pc = opq(p.c); const float* pcc = opq(p.c_ctx);
  float acc[17];
#pragma unroll
  for (int r = 0; r < 17; ++r) acc[r] = 0.f;
  for (int ks = 0; ks < 8; ++ks) {
    __syncthreads();
    for (int i = tid_(); i < 17 * 128; i += 256) {
      int r = i >> 7, e = i & 127;
      float v = r < 16 ? pc[r * D + ks * 128 + e] : pcc[ks * 128 + e];
      cs[r][e] = v / (1.f + expf(-v));
    }
    __syncthreads();
    const float* w = p.mod_w + ((size_t)layer * D + ks * 128) * 6144 + col;
#pragma unroll 1
    for (int e0 = 0; e0 < 128; e0 += 32) {
      float wv[32];
#pragma unroll
      for (int q = 0; q < 32; ++q) wv[q] = w[(size_t)(e0 + q) * 6144];
#pragma unroll
      for (int q4 = 0; q4 < 8; ++q4) {
      const int e = e0 + 4 * q4;
      const float w0 = wv[4 * q4], w1 = wv[4 * q4 + 1], w2 = wv[4 * q4 + 2], w3 = wv[4 * q4 + 3];
#pragma unroll
      for (int r = 0; r < 17; ++r) {
        const float4 cv = *(const float4*)&cs[r][e];
        acc[r] += cv.x * w0 + cv.y * w1 + cv.z * w2 + cv.w * w3;
      }
      }
    }
  }
  const float bias = p.mod_b[layer * 6144 + col];
#pragma unroll
  for (int r = 0; r < 17; ++r) p.modv[((size_t)layer * 17 + r) * 6144 + col] = acc[r] + bias;
}

DEV void transpose_unit(const float* __restrict__ src, bf16_t* __restrict__ dst, int R, int C, int tile, char* smem) {
  float (*t)[65] = (float (*)[65])smem;
  const int nct = C / 64;
  const int tr = tile / nct, tc = tile % nct;
  __syncthreads();
  for (int i = tid_(); i < 4096; i += 256) { int r = i >> 6, c = i & 63; t[r][c] = src[(size_t)(tr * 64 + r) * C + tc * 64 + c]; }
  __syncthreads();
  for (int i = tid_(); i < 4096; i += 256) { int c = i >> 6, r = i & 63; dst[(size_t)(tc * 64 + c) * R + tr * 64 + r] = f2bf(t[r][c]); }
}

DEV void wfold_unit(const P& p, int layer, int unit, char* smem) {
  const int hs = unit >> 5, ec = unit & 31, h = hs >> 1, s = hs & 1;
  const float* wq = p.peer_wq + (size_t)layer * D * 2048;
  const float* kk = (s ? opq(p.peer_k2) : opq(p.peer_k1)) + ((size_t)layer * 8 + h) * 128 * 128;
  float (*kS)[65] = (float (*)[65])smem;
  float (*wS)[64] = (float (*)[64])(smem + 33280);
  const int key = tid_() & 127, eh = tid_() >> 7;
  float acc[16];
#pragma unroll
  for (int i = 0; i < 16; ++i) acc[i] = 0.f;
  for (int dh = 0; dh < 2; ++dh) {
    __syncthreads();
    for (int i = tid_(); i < 128 * 64; i += 256) { int k2 = i >> 6, d = i & 63; kS[k2][d] = kk[k2 * 128 + dh * 64 + d]; }
    for (int i = tid_(); i < 32 * 64; i += 256) {
      int e = i >> 6, d = i & 63;
      wS[e][d] = wq[(size_t)(ec * 32 + e) * 2048 + h * 256 + s * 128 + dh * 64 + d];
    }
    __syncthreads();
#pragma unroll 2
    for (int d = 0; d < 64; d += 4) {
      const float k0 = kS[key][d], k1 = kS[key][d + 1], k2 = kS[key][d + 2], k3 = kS[key][d + 3];
#pragma unroll
      for (int i = 0; i < 16; ++i) {
        const float4 wv = *(const float4*)&wS[eh * 16 + i][d];
        acc[i] += k0 * wv.x + k1 * wv.y + k2 * wv.z + k3 * wv.w;
      }
    }
  }
  bf16_t* dst = p.Wft + ((size_t)(hs * 128 + key)) * D + ec * 32 + eh * 16;
#pragma unroll
  for (int i = 0; i < 16; i += 2) *(unsigned*)(dst + i) = pack2(acc[i], acc[i + 1]);
}

DEV void filt_unit(const P& p, int layer, int unit, char* smem) {
  int kind, j0, L;
  if (unit < 1024) { kind = 0; j0 = unit * 4; L = T; } else { kind = 1; j0 = (unit - 1024) * 4; L = LC; }
  float* zs = (float*)smem;
  float* h1 = zs + 4 * 36;
  float* h2 = h1 + 256;
  const int jj = tid_() >> 6, o = tid_() & 63;
  const int j = j0 + jj;
  const float fj = (float)j;
  const float t = fj / (float)(L - 1);
  __syncthreads();
  if (o < 33) {
    float z;
    if (o == 0) z = t;
    else {
      int i = (o - 1) & 15;
      float band = 1e-4f + (float)i * ((15.0f - 1e-4f) / 15.0f);
      float ang = 6.283185307179586f * fj * band / (float)L;
      z = (o <= 16) ? cosf(ang) : -sinf(ang);
    }
    zs[jj * 36 + o] = z;
  }
  __syncthreads();
  {
    const float* w1 = p.hy_w1 + layer * 33 * 64;
    float a = p.hy_b1[layer * 64 + o];
#pragma unroll 3
    for (int i = 0; i < 33; ++i) a += zs[jj * 36 + i] * w1[i * 64 + o];
    h1[jj * 64 + o] = sinf(p.hy_freq[layer * 128 + o] * a);
  }
  __syncthreads();
  {
    const float* w2 = p.hy_w2 + layer * 64 * 64;
    float a = p.hy_b2[layer * 64 + o];
#pragma unroll 4
    for (int i = 0; i < 64; ++i) a += h1[jj * 64 + i] * w2[i * 64 + o];
    h2[jj * 64 + o] = sinf(p.hy_freq[layer * 128 + 64 + o] * a);
  }
  __syncthreads();
  const float* w3 = p.hy_w3 + layer * 64 * 512;
  float* F = kind ? opq(p.FC) : opq(p.FL);
  const float DMIN = -3.0701134573253945f, DMAX = -15.350567286626973f;
#pragma unroll 1
  for (int m = 0; m < 4; ++m) {
    int c = o + 64 * m;
    float af = p.hy_b3[layer * 512 + c], ab = p.hy_b3[layer * 512 + 256 + c];
#pragma unroll 4
    for (int i = 0; i < 64; ++i) { float hv = h2[jj * 64 + i]; af += hv * w3[i * 512 + c]; ab += hv * w3[i * 512 + 256 + c]; }
    float delta = fabsf(DMIN + (float)c * ((DMAX - DMIN) / 255.f));
    float win = expf(-t * delta) + 0.05f;
    af *= win; ab *= win;
    F[((size_t)c * 2 + 0) * L + j] = af;
    F[((size_t)c * 2 + 1) * L + j] = ab;
  }
}

constexpr int PREP_T0 = 672, PREP_T1 = PREP_T0 + 256, PREP_T2 = PREP_T1 + 8, PREP_T3 = PREP_T2 + 8, PREP_T4 = PREP_T3 + 8;
constexpr int PREP_WF = PREP_T4 + 512, PREP_N = PREP_WF + 1088;
DEV void prep_unit(const P& p, int layer, int u, char* smem) {
  if (u < PREP_T0) transpose_unit(p.w_in + (size_t)layer * D * INW, p.W1t, D, INW, u, smem);
  else if (u < PREP_T1) transpose_unit(p.w_out + (size_t)layer * D * D, p.W2t, D, D, u - PREP_T0, smem);
  else if (u < PREP_T3) {
    const int u0 = u - PREP_T1;
    for (int i = tid_(); i < 64 * 256; i += 256) {
      const int np = u0 * 64 + (i >> 8), kp = i & 255;
      const int ps = np & 3, chan = np >> 2, qp = kp >> 6, kk = kp & 63;
      const int is_a = ps & 1, d = ps >> 1;
      float v = 0.f;
      if (qp == (is_a ? 2 + d : d)) v = (is_a ? opq(p.rw_a_up) : opq(p.rw_w_up))[(((size_t)layer * 2 + d) * 64 + kk) * 256 + chan];
      p.Wlt[(size_t)np * 256 + kp] = f2bf(v);
    }
  }
  else if (u < PREP_T4) transpose_unit(p.rw_g_up + (size_t)layer * 128 * 256, p.Wgt, 128, 256, u - PREP_T3, smem);
  else if (u < PREP_WF) wfold_unit(p, layer, u - PREP_T4, smem);
  else filt_unit(p, layer, u - PREP_WF, smem);
}
constexpr int PREPA_N = PREP_T0 + (PREP_T4 - PREP_T1);
DEV int prepA_unit_index(int i) { return i < PREP_T0 ? i : PREP_T1 + (i - PREP_T0); }
DEV void ph_prep(const P& p, int layer, char* smem, bool onlyB) {
  for (int u = bid_(); u < PREP_N; u += gridDim.x) {
    const bool isA = (u < PREP_T0) || (u >= PREP_T1 && u < PREP_T4);
    if (onlyB && isA) continue;
    prep_unit(p, layer, u, smem);
  }
}

DEV void wave_range(int& r0, int& r1, int ntok) {
  const int gw = (bid_() * 256 + tid_()) >> 6, nw = gridDim.x * 4;
  const int per = (ntok + nw - 1) / nw;
  r0 = gw * per; r1 = r0 + per; if (r1 > ntok) r1 = ntok;
}
DEV void ph_norm_first(const P& p) {
  const int lane = tid_() & 63;
  int r0, r1;
  wave_range(r0, r1, NTOK);
  const float* pctx = opq(p.ctx); const float* px = opq(p.x);
  float gv[16], scv[16], shv[16];
#pragma unroll
  for (int hh = 0; hh < 2; ++hh)
#pragma unroll
    for (int i = 0; i < 8; ++i) gv[hh * 8 + i] = p.norm1_g[hh * 512 + 8 * lane + i];
  int mr_cur = -1;
  auto srcrow = [&](int row) -> const float* {
    const int b = row / LT, pp = row % LT;
    return pp < LC ? pctx + ((size_t)(b * LC + pp)) * D : px + ((size_t)(b * T + pp - LC)) * D;
  };
  float4 n0, n1, n2, n3;
  auto ld = [&](int row) { const float* s0 = srcrow(row) + 8 * lane; n0 = *(const float4*)s0; n1 = *(const float4*)(s0 + 4); n2 = *(const float4*)(s0 + 512); n3 = *(const float4*)(s0 + 516); };
  if (r0 < r1) ld(r0);
#pragma unroll 1
  for (int row = r0; row < r1; ++row) {
    float v[16] = {n0.x, n0.y, n0.z, n0.w, n1.x, n1.y, n1.z, n1.w, n2.x, n2.y, n2.z, n2.w, n3.x, n3.y, n3.z, n3.w};
    if (row + 1 < r1) ld(row + 1);
    const int b = row / LT, pp = row % LT;
    const int mr = pp < LC ? 16 : b;
    if (mr != mr_cur) {
      mr_cur = mr;
      const float* mv = p.modv + (size_t)mr * 6144;
#pragma unroll
      for (int hh = 0; hh < 2; ++hh)
#pragma unroll
        for (int i = 0; i < 8; ++i) { shv[hh * 8 + i] = mv[hh * 512 + 8 * lane + i]; scv[hh * 8 + i] = 1.f + mv[1024 + hh * 512 + 8 * lane + i]; }
    }
    bf16_t* xr = p.X + (size_t)row * D;
    const uint4 x0 = pack8(v), x1 = pack8(v + 8);
    *(uint4*)(xr + 8 * lane) = x0;
    *(uint4*)(xr + 512 + 8 * lane) = x1;
    unpack8(x0, v); unpack8(x1, v + 8);
    float ss = 0.f;
#pragma unroll
    for (int i = 0; i < 16; ++i) ss += v[i] * v[i];
    ss = wave_sum(ss);
    const float rstd = rsqrtf(ss * (1.f / 1024.f) + 1e-6f);
    float o[16];
#pragma unroll
    for (int i = 0; i < 16; ++i) o[i] = (v[i] * rstd * gv[i]) * scv[i] + shv[i];
    bf16_t* hr = p.H + (size_t)row * D;
    *(uint4*)(hr + 8 * lane) = pack8(o);
    *(uint4*)(hr + 512 + 8 * lane) = pack8(o + 8);
  }
}
DEV void ph_norm(const P& p, int layer, int which) {
  const int lane = tid_() & 63;
  int r0, r1;
  wave_range(r0, r1, NTOK);
  const float* g = (which ? p.norm2_g : p.norm1_g) + layer * D;
  float gv[16], scv[16], shv[16];
#pragma unroll
  for (int hh = 0; hh < 2; ++hh)
#pragma unroll
    for (int i = 0; i < 8; ++i) gv[hh * 8 + i] = g[hh * 512 + 8 * lane + i];
  int mr_cur = -1;
  uint4 n0 = make_uint4(0, 0, 0, 0), n1 = n0;
  if (r0 < r1) { const bf16_t* xr = p.X + (size_t)r0 * D; n0 = *(const uint4*)(xr + 8 * lane); n1 = *(const uint4*)(xr + 512 + 8 * lane); }
#pragma unroll 1
  for (int row = r0; row < r1; ++row) {
    const uint4 u0 = n0, u1 = n1;
    if (row + 1 < r1) { const bf16_t* xr = p.X + (size_t)(row + 1) * D; n0 = *(const uint4*)(xr + 8 * lane); n1 = *(const uint4*)(xr + 512 + 8 * lane); }
    const int b = row / LT, pp = row % LT;
    const int mr = pp < LC ? 16 : b;
    if (mr != mr_cur) {
      mr_cur = mr;
      const float* mv = p.modv + ((size_t)layer * 17 + mr) * 6144 + (which ? 3072 : 0);
#pragma unroll
      for (int hh = 0; hh < 2; ++hh)
#pragma unroll
        for (int i = 0; i < 8; ++i) { shv[hh * 8 + i] = mv[hh * 512 + 8 * lane + i]; scv[hh * 8 + i] = 1.f + mv[1024 + hh * 512 + 8 * lane + i]; }
    }
    float v[16];
    unpack8(u0, v); unpack8(u1, v + 8);
    float ss = 0.f;
#pragma unroll
    for (int i = 0; i < 16; ++i) ss += v[i] * v[i];
    ss = wave_sum(ss);
    const float rstd = rsqrtf(ss * (1.f / 1024.f) + 1e-6f);
    float o[16];
#pragma unroll
    for (int i = 0; i < 16; ++i) o[i] = (v[i] * rstd * gv[i]) * scv[i] + shv[i];
    bf16_t* hr = p.H + (size_t)row * D;
    *(uint4*)(hr + 8 * lane) = pack8(o);
    *(uint4*)(hr + 512 + 8 * lane) = pack8(o + 8);
    if (which) {
      float am = 0.f;
#pragma unroll
      for (int i = 0; i < 16; ++i) am = fmaxf(am, fabsf(o[i]));
      am = wave_max(am);
      const float sc = am > 0.f ? 127.f / am : 1.f;
      unsigned char* h8 = p.H8 + (size_t)row * 1024;
      *(uint2*)(h8 + 8 * lane) = make_uint2((unsigned)pack_i8(o[0] * sc, o[1] * sc, o[2] * sc, o[3] * sc), (unsigned)pack_i8(o[4] * sc, o[5] * sc, o[6] * sc, o[7] * sc));
      *(uint2*)(h8 + 512 + 8 * lane) = make_uint2((unsigned)pack_i8(o[8] * sc, o[9] * sc, o[10] * sc, o[11] * sc), (unsigned)pack_i8(o[12] * sc, o[13] * sc, o[14] * sc, o[15] * sc));
      if (lane == 0) p.HINV[row] = am > 0.f ? am * (1.f / 127.f) : 1.f;
    }
  }
}

DEV bool gemm_unit(int it, int nct, int& rt, int& ct) {
  const int nslot = gridDim.x >> 3;
  const int x = bid_() & 7, sl = bid_() >> 3;
  if (sl >= nslot) return false;
  const int v = it * nslot + sl;
  if (v >= 68 * nct) return false;
  const int rg = v / (8 * nct), rem = v - rg * 8 * nct;
  const int rows = (rg == 8) ? 4 : 8;
  ct = rem / rows;
  rt = x * 68 + rg * 8 + (rem - ct * rows);
  return true;
}
struct Epi1 {
  const P& p; int row0, col0;
  DEV void operator()(f32x4 (&acc)[4][4], int wr, int wc, int fr, int fq, char* smem) const {
    const int cw = col0 + wc * 64;
    const int rbase = row0 + wr * 64;
    const bool lat = (row0 % LT) >= LC;
    if (cw >= 1536 && cw < 1664) {
#pragma unroll
      for (int m = 0; m < 4; ++m)
#pragma unroll
        for (int n = 0; n < 4; ++n)
#pragma unroll
          for (int j = 0; j < 4; ++j) acc[m][n][j] = 2.f * sigmoidf_(2.f * acc[m][n][j]) - 1.f;
    } else if (cw >= 1792 && cw < 1920) {
#pragma unroll
      for (int m = 0; m < 4; ++m)
#pragma unroll
        for (int n = 0; n < 4; ++n)
#pragma unroll
          for (int j = 0; j < 4; ++j) acc[m][n][j] = sigmoidf_(acc[m][n][j]);
    } else if (cw >= 1920 && cw < 2560 && lat) {
#pragma unroll
      for (int m = 0; m < 4; ++m) {
        const int row = rbase + m * 16 + fr;
        const int pl = (row % LT) - LC;
        const int ri = pl >> 6, ci = pl & 63;
        const float4* crp = (const float4*)(p.rope + 2 * (ri * 16 + 4 * fq));
        const float4* ccp = (const float4*)(p.rope + 2 * (ci * 16 + 4 * fq));
        const float4 cr0 = crp[0], cr1 = crp[1], cc0 = ccp[0], cc1 = ccp[1];
        const float crc[4] = {cr0.x, cr0.z, cr1.x, cr1.z}, crs[4] = {cr0.y, cr0.w, cr1.y, cr1.w};
        const float ccc[4] = {cc0.x, cc0.z, cc1.x, cc1.z}, ccs[4] = {cc0.y, cc0.w, cc1.y, cc1.w};
#pragma unroll
        for (int j = 0; j < 4; ++j) {
          float x1 = acc[m][0][j], x2 = acc[m][1][j];
          acc[m][0][j] = x1 * crc[j] - x2 * crs[j]; acc[m][1][j] = x2 * crc[j] + x1 * crs[j];
          x1 = acc[m][2][j]; x2 = acc[m][3][j];
          acc[m][2][j] = x1 * ccc[j] - x2 * ccs[j]; acc[m][3][j] = x2 * ccc[j] + x1 * ccs[j];
        }
      }
    }
    const int wid = wr * 2 + wc, lane = fq * 16 + fr;
    stage_tile_bf16(acc, smem, wid, fr, fq);
    const bf16_t (*t)[72] = (const bf16_t (*)[72])(smem + wid * 9216);
#pragma unroll
    for (int i = 0; i < 8; ++i) {
      const int rl = i * 8 + (lane >> 3), ch = lane & 7;
      *(uint4*)(p.Z + (size_t)(rbase + rl) * INW + cw + ch * 8) = *(const uint4*)&t[rl][ch * 8];
    }
  }
};
DEV void ph_gemm1(const P& p, char* smem) {
  const int nct = INW / 128;
  int rt, ct;
  for (int it = 0; gemm_unit(it, nct, rt, ct); ++it) {
    Epi1 epi{p, rt * 128, ct * 128};
    gemm_tile(p.H + (size_t)rt * 128 * D, D, p.W1t + (size_t)ct * 128 * D, D, D, smem, epi);
  }
}

struct EpiLoraA {
  const P& p; int layer, row0, col0;
  DEV void operator()(f32x4 (&acc)[4][4], int wr, int wc, int fr, int fq, char* smem) const {
    const float* w0b = p.rw_w0 + layer * 512;
    const float* a0b = p.rw_a0 + layer * 512;
#pragma unroll
    for (int n = 0; n < 4; ++n) {
      const int chan = ((col0 + wc * 64 + n * 16) >> 2) + fq;
      const float be0 = w0b[chan], ba0 = a0b[chan], be1 = w0b[256 + chan], ba1 = a0b[256 + chan];
#pragma unroll
      for (int m = 0; m < 4; ++m) {
        acc[m][n][0] = 0.6065306597126334f * sigmoidf_(acc[m][n][0] + be0);
        acc[m][n][1] = sigmoidf_(acc[m][n][1] + ba0);
        acc[m][n][2] = 0.6065306597126334f * sigmoidf_(acc[m][n][2] + be1);
        acc[m][n][3] = sigmoidf_(acc[m][n][3] + ba1);
      }
    }
    const int wid = wr * 2 + wc, lane = fq * 16 + fr;
    stage_tile_bf16(acc, smem, wid, fr, fq);
    const bf16_t (*t)[72] = (const bf16_t (*)[72])(smem + wid * 9216);
#pragma unroll
    for (int i = 0; i < 8; ++i) {
      const int rl = i * 8 + (lane >> 3), ch = lane & 7;
      *(uint4*)(p.SC + (size_t)(row0 + wr * 64 + rl) * 1024 + col0 + wc * 64 + ch * 8) = *(const uint4*)&t[rl][ch * 8];
    }
  }
};
struct EpiLoraG {
  const P& p; int row0, col0;
  DEV void operator()(f32x4 (&acc)[4][4], int wr, int wc, int fr, int fq, char* smem) const {
    const int wid = wr * 2 + wc, lane = fq * 16 + fr;
    stage_tile_bf16(acc, smem, wid, fr, fq);
    const bf16_t (*t)[72] = (const bf16_t (*)[72])(smem + wid * 9216);
#pragma unroll
    for (int i = 0; i < 8; ++i) {
      const int rl = i * 8 + (lane >> 3), ch = lane & 7;
      *(uint4*)(p.Y + (size_t)(row0 + wr * 64 + rl) * D + 256 + col0 + wc * 64 + ch * 8) = *(const uint4*)&t[rl][ch * 8];
    }
  }
};
DEV void ph_lora(const P& p, int layer, char* smem) {
  int rt, ct;
  for (int it = 0; gemm_unit(it, 10, rt, ct); ++it) {
    if (ct < 8) {
      EpiLoraA epi{p, layer, rt * 128, ct * 128};
      gemm_tile(p.Z + (size_t)rt * 128 * INW + 1536, INW, p.Wlt + (size_t)ct * 128 * 256, 256, 256, smem, epi);
    } else {
      EpiLoraG epi{p, rt * 128, (ct - 8) * 128};
      gemm_tile(p.Z + (size_t)rt * 128 * INW + 1792, INW, p.Wgt + (size_t)(ct - 8) * 128 * 128, 128, 128, smem, epi);
    }
  }
}

DEV void ph_rwkv_prep(const P& p, int layer) {
  const int lane = tid_() & 63;
  int r0, r1;
  wave_range(r0, r1, NTOK);
  const float* cw = p.conv_w + (size_t)layer * 3 * 1536;
  const float* cb = p.conv_b + (size_t)layer * 1536;
  float w0[3][4], w1[3][4], w2[3][4], bb[3][4], kkw[4];
#pragma unroll
  for (int a = 0; a < 3; ++a)
#pragma unroll
    for (int i = 0; i < 4; ++i) {
      const int col = 768 + a * 256 + 4 * lane + i;
      w0[a][i] = cw[col]; w1[a][i] = cw[1536 + col]; w2[a][i] = cw[3072 + col]; bb[a][i] = cb[col];
    }
#pragma unroll
  for (int i = 0; i < 4; ++i) kkw[i] = p.rw_k_k[layer * 256 + 4 * lane + i];
  uint2 zm[3], zc[3], zp[3];
  auto ldz = [&](int row, uint2 (&z)[3]) {
#pragma unroll
    for (int a = 0; a < 3; ++a) z[a] = *(const uint2*)(p.Z + (size_t)row * INW + 768 + a * 256 + 4 * lane);
  };
  auto zero3 = [&](uint2 (&z)[3]) {
#pragma unroll
    for (int a = 0; a < 3; ++a) z[a] = make_uint2(0u, 0u);
  };
  if (r0 < r1) {
    if (r0 > 0) ldz(r0 - 1, zm); else zero3(zm);
    ldz(r0, zc);
  }
#pragma unroll 1
  for (int row = r0; row < r1; ++row) {
    if (row + 1 < NTOK) ldz(row + 1, zp); else zero3(zp);
    const int pp = row % LT;
    const bool hasm = (pp != 0) && (pp != LC);
    const bool hasp = (pp != LC - 1) && (pp != LT - 1);
    float res[3][4];
#pragma unroll
    for (int a = 0; a < 3; ++a) {
      const uint2 um = hasm ? zm[a] : make_uint2(0u, 0u), uc = zc[a], up = hasp ? zp[a] : make_uint2(0u, 0u);
      const float vm[4] = {bflo(um.x), bfhi(um.x), bflo(um.y), bfhi(um.y)};
      const float vc[4] = {bflo(uc.x), bfhi(uc.x), bflo(uc.y), bfhi(uc.y)};
      const float vp[4] = {bflo(up.x), bfhi(up.x), bflo(up.y), bfhi(up.y)};
#pragma unroll
      for (int i = 0; i < 4; ++i) res[a][i] = w0[a][i] * vm[i] + w1[a][i] * vc[i] + w2[a][i] * vp[i] + bb[a][i];
    }
    float kk[4], ss = 0.f;
#pragma unroll
    for (int i = 0; i < 4; ++i) { kk[i] = res[1][i] * kkw[i]; ss += kk[i] * kk[i]; }
    ss = row16_sum(ss);
    const float rs = rsqrtf(ss + 1e-12f);
    bf16_t* hr = p.H + (size_t)row * D + 16 * lane;
    *(uint4*)hr = make_uint4(pack2(res[0][0], res[1][0]), pack2(kk[0] * rs, res[2][0]), pack2(res[0][1], res[1][1]), pack2(kk[1] * rs, res[2][1]));
    *(uint4*)(hr + 8) = make_uint4(pack2(res[0][2], res[1][2]), pack2(kk[2] * rs, res[2][2]), pack2(res[0][3], res[1][3]), pack2(kk[3] * rs, res[2][3]));
#pragma unroll
    for (int a = 0; a < 3; ++a) { zm[a] = zc[a]; zc[a] = zp[a]; }
  }
}

DEV float oct_sum(float x) { x += dpp0<0xB1, 0xF>(x); x += dpp0<0x4E, 0xF>(x); x += dpp0<0x141, 0xF>(x); return x; }
DEV bf16x8 frag_join(uint2 lo, uint2 hi) { uint4 w = make_uint4(lo.x, lo.y, hi.x, hi.y); return __builtin_bit_cast(bf16x8, w); }
constexpr int SCS_SET = 17152, SCS_IMG = 3 * SCS_SET, SCS_W0 = SCS_IMG + 2 * 3072;
DEV void scanc_unit(const P& p, int layer, int unit, char* smem) {
  const int dir = unit & 1, h = (unit >> 1) & 3, b = unit >> 3;
  const int tid = tid_(), lane = tid & 63, fr = lane & 15, fq = lane >> 4;
  const int w = __builtin_amdgcn_readfirstlane(tid >> 6);
  bf16_t* IMG0 = (bf16_t*)(smem + SCS_W0);
  bf16_t* IMG1 = IMG0 + 512;
  bf16_t* IMG2 = IMG0 + 1024;
  __syncthreads();
  for (int i = tid; i < (2 * 3072 + 3072) / 4; i += 256) ((unsigned*)(smem + SCS_IMG))[i] = 0u;
  const float ka = p.rw_k_a[layer * 256 + h * 64 + lane];
  const size_t rowbase = (size_t)b * LT;
  const char* hbase = (const char*)p.H;
  const char* sbase = (const char*)p.SC;
  const unsigned hoff = (unsigned)(rowbase * 2048) + (unsigned)((h * 64 + lane) * 8);
  const unsigned soff = hoff + 4u * (unsigned)dir;
  bf16_t* yb = p.Z + rowbase * INW + 768 + dir * 256 + h * 64 + w * 16 + fr;
  auto pos0 = [&](int c) -> int { const int t = c * 16; return dir == 0 ? t : (t < LC ? LC - 1 - t : LT - 1 - (t - LC)); };
  const int pstep = dir == 0 ? 1 : -1;
  constexpr int NCH = LT / 16;
  struct Raw { unsigned sc[16]; uint2 hr[6]; };
  auto load_raw = [&](int c, Raw& rw) {
    if (w != 0) {
      const int p0 = pos0(c);
      const unsigned so = soff + (unsigned)(p0 * 2048);
      const int st = pstep * 2048;
#pragma unroll
      for (int i = 0; i < 16; ++i) rw.sc[i] = *(const unsigned*)(sbase + (so + (unsigned)(i * st)));
      const unsigned ho = hoff + (unsigned)((p0 + pstep * (w - 1)) * 2048);
#pragma unroll
      for (int q = 0; q < 6; ++q) {
        const int qq = ((w - 1) + 3 * q < 16) ? q : 4;
        rw.hr[q] = *(const uint2*)(hbase + (ho + (unsigned)(qq * 3 * st)));
      }
    }
  };
  auto stage1w = [&](int set, const Raw& rw, auto W1tag) {
    constexpr int W1 = decltype(W1tag)::value;
    char* base = smem + set * SCS_SET;
    bf16_t (*At)[72] = (bf16_t (*)[72])(base);
    bf16_t (*Rt)[72] = (bf16_t (*)[72])(base + 2304);
    bf16_t (*Bt)[72] = (bf16_t (*)[72])(base + 4608);
    bf16_t (*Kt)[72] = (bf16_t (*)[72])(base + 6912);
    bf16_t (*BKT)[36] = (bf16_t (*)[36])(base + 9216);
    bf16_t* VV = (bf16_t*)(base + 13824);
    float* G16 = (float*)(base + 16896);
    float Erun = 0.f;
#pragma unroll
    for (int i = 0; i < 16; ++i) {
      const float ev = bflo(rw.sc[i]);
      const float Eprev = Erun;
      Erun += ev;
      if ((i % 3) == W1) {
        const uint2 hrec = rw.hr[i / 3];
        const float rr = bflo(hrec.x), kr = bfhi(hrec.x), kkv = bflo(hrec.y);
        const float av = bfhi(rw.sc[i]);
        const float gp = __expf(-Eprev), gi = __expf(-Erun), ig = __expf(Erun);
        const float at = -kkv * gp, rt = rr * gi, bt = kkv * av * ig, kt2 = kr * (1.f + (av - 1.f) * ka) * ig;
        const unsigned ar = pack2(at, rt), bk = pack2(bt, kt2);
        At[i][lane] = (bf16_t)(ar & 0xFFFFu); Rt[i][lane] = (bf16_t)(ar >> 16);
        Bt[i][lane] = (bf16_t)(bk & 0xFFFFu); Kt[i][lane] = (bf16_t)(bk >> 16);
        BKT[lane][(i >> 2) * 8 + (i & 3)] = (bf16_t)(bk & 0xFFFFu);
        BKT[lane][(i >> 2) * 8 + 4 + (i & 3)] = (bf16_t)(bk >> 16);
        VV[((i >> 2) * 64 + lane) * 6 + (i & 3)] = (bf16_t)(hrec.y >> 16);
        if (i == 15) G16[lane] = gi;
      }
    }
  };
  auto stage1 = [&](int set, const Raw& rw) {
    if (w == 1) stage1w(set, rw, std::integral_constant<int, 0>{});
    else if (w == 2) stage1w(set, rw, std::integral_constant<int, 1>{});
    else if (w == 3) stage1w(set, rw, std::integral_constant<int, 2>{});
  };
  auto stage2 = [&](int set, int iset) {
    char* base = smem + set * SCS_SET;
    const bf16_t (*At)[72] = (const bf16_t (*)[72])(base);
    const bf16_t (*Rt)[72] = (const bf16_t (*)[72])(base + 2304);
    const bf16_t (*Bt)[72] = (const bf16_t (*)[72])(base + 4608);
    const bf16_t (*Kt)[72] = (const bf16_t (*)[72])(base + 6912);
    bf16_t* TT = (bf16_t*)(smem + SCS_IMG + iset * 3072);
    bf16_t* ARK = TT + 512;
    bf16_t* AAK = TT + 1024;
    const bf16_t (*X)[72] = (w < 2) ? At : Rt;
    const bf16_t (*Y)[72] = (w & 1) ? Kt : Bt;
    f32x4 cm = (f32x4){0.f, 0.f, 0.f, 0.f};
#pragma unroll
    for (int s = 0; s < 2; ++s) {
      bf16x8 af = *(const bf16x8*)&X[fr][32 * s + 8 * fq];
      bf16x8 bm = *(const bf16x8*)&Y[fr][32 * s + 8 * fq];
      cm = mfma16(af, bm, cm);
    }
#pragma unroll
    for (int jj = 0; jj < 4; ++jj) {
      const int i = 4 * fq + jj;
      const bool keep = (w < 2) ? (fr < i) : (fr <= i);
      cm[jj] = keep ? cm[jj] : 0.f;
    }
    const int io = (fr >> 2) * 8 + (fr & 3);
    auto wr_img = [&](bf16_t* img, const f32x4& Xv, int hi) {
#pragma unroll
      for (int jj = 0; jj < 4; ++jj) img[(4 * fq + jj) * 32 + io + hi] = f2bf(Xv[jj]);
    };
    if (w == 1) wr_img(AAK, cm, 0);
    else if (w == 2) wr_img(ARK, cm, 0);
    else if (w == 3) wr_img(ARK, cm, 4);
    else {
      auto bfrag = [&](const f32x4& Xv) { return frag_join(make_uint2(pack2(Xv[0], Xv[1]), pack2(Xv[2], Xv[3])), make_uint2(0u, 0u)); };
      auto afr = [&](const bf16_t* img) { return *(const bf16x8*)&img[(fr * 4 + fq) * 8]; };
      const f32x4 Z4 = (f32x4){0.f, 0.f, 0.f, 0.f};
      wr_img(IMG0, cm, 0);
      asm volatile("" ::: "memory");
      f32x4 A2 = mfma16(afr(IMG0), bfrag(cm), Z4);
      wr_img(IMG1, A2, 0);
      asm volatile("" ::: "memory");
      f32x4 A4 = mfma16(afr(IMG1), bfrag(A2), Z4);
      wr_img(IMG2, A4, 0);
      asm volatile("" ::: "memory");
      f32x4 Rm = mfma16(afr(IMG2), bfrag(A4), Z4);
#pragma unroll
      for (int jj = 0; jj < 4; ++jj) Rm[jj] += (fr == 4 * fq + jj) ? 1.f : 0.f;
      Rm = mfma16(afr(IMG2), bfrag(Rm), Rm);
      Rm = mfma16(afr(IMG1), bfrag(Rm), Rm);
      Rm = mfma16(afr(IMG0), bfrag(Rm), Rm);
      wr_img(TT, Rm, 0);
    }
  };
  f32x4 acc[4];
#pragma unroll
  for (int kt = 0; kt < 4; ++kt) acc[kt] = (f32x4){0.f, 0.f, 0.f, 0.f};
  auto part2 = [&](int c, int set, int iset) {
    char* base = smem + set * SCS_SET;
    const bf16_t (*At)[72] = (const bf16_t (*)[72])(base);
    const bf16_t (*Rt)[72] = (const bf16_t (*)[72])(base + 2304);
    const bf16_t (*BKT)[36] = (const bf16_t (*)[36])(base + 9216);
    const bf16_t* VV = (const bf16_t*)(base + 13824);
    const float* G16 = (const float*)(base + 16896);
    const bf16_t* TT = (const bf16_t*)(smem + SCS_IMG + iset * 3072);
    const bf16_t* ARK = TT + 512;
    const bf16_t* AAK = TT + 1024;
    bf16x8 Sb[2];
#pragma unroll
    for (int s = 0; s < 2; ++s) {
      uint4 t = make_uint4(pack2(acc[2 * s][0], acc[2 * s][1]), pack2(acc[2 * s][2], acc[2 * s][3]),
                           pack2(acc[2 * s + 1][0], acc[2 * s + 1][1]), pack2(acc[2 * s + 1][2], acc[2 * s + 1][3]));
      Sb[s] = __builtin_bit_cast(bf16x8, t);
    }
    const unsigned* vvp = (const unsigned*)&VV[(fq * 64 + w * 16 + fr) * 6];
    const uint2 vv = make_uint2(vvp[0], vvp[1]);
    const bf16x8 Vlow = frag_join(vv, make_uint2(0u, 0u));
    f32x4 Pm = (f32x4){0.f, 0.f, 0.f, 0.f};
#pragma unroll
    for (int s = 0; s < 2; ++s) {
      bf16x8 af = frag_join(*(const uint2*)&At[fr][32 * s + 4 * fq], *(const uint2*)&At[fr][32 * s + 16 + 4 * fq]);
      Pm = mfma16(af, Sb[s], Pm);
    }
    Pm = mfma16(*(const bf16x8*)&AAK[(fr * 4 + fq) * 8], Vlow, Pm);
    const bf16x8 Pb = frag_join(make_uint2(pack2(Pm[0], Pm[1]), pack2(Pm[2], Pm[3])), make_uint2(0u, 0u));
    f32x4 U = mfma16(*(const bf16x8*)&TT[(fr * 4 + fq) * 8], Pb, (f32x4){0.f, 0.f, 0.f, 0.f});
    const bf16x8 UV = frag_join(make_uint2(pack2(U[0], U[1]), pack2(U[2], U[3])), vv);
    f32x4 Yv = (f32x4){0.f, 0.f, 0.f, 0.f};
#pragma unroll
    for (int s = 0; s < 2; ++s) {
      bf16x8 af = frag_join(*(const uint2*)&Rt[fr][32 * s + 4 * fq], *(const uint2*)&Rt[fr][32 * s + 16 + 4 * fq]);
      Yv = mfma16(af, Sb[s], Yv);
    }
    Yv = mfma16(*(const bf16x8*)&ARK[(fr * 4 + fq) * 8], UV, Yv);
    {
      const int p0 = pos0(c);
#pragma unroll
      for (int jj = 0; jj < 4; ++jj) yb[(size_t)(p0 + pstep * (4 * fq + jj)) * INW] = f2bf(Yv[jj]);
    }
#pragma unroll
    for (int kt = 0; kt < 4; ++kt) {
      f32x4 t = mfma16(frag_join(*(const uint2*)&BKT[16 * kt + fr][fq * 8], *(const uint2*)&BKT[16 * kt + fr][fq * 8 + 4]), UV, acc[kt]);
      const float4 g4 = *(const float4*)&G16[16 * kt + 4 * fq];
      t[0] *= g4.x; t[1] *= g4.y; t[2] *= g4.z; t[3] *= g4.w;
      acc[kt] = t;
    }
  };
  __builtin_amdgcn_s_setprio(3);
  Raw r0, r1;
  load_raw(0, r0); load_raw(1, r1);
  stage1(0, r0);
  load_raw(2, r0);
  __syncthreads();
  stage2(0, 0);
  stage1(1, r1);
  load_raw(3, r1);
  __syncthreads();
  int s0 = 0, s1 = 1, s2 = 2;
  auto iter = [&](int c, Raw& rw) {
    if (c + 1 < NCH) stage2(s1, (c + 1) & 1);
    part2(c, s0, c & 1);
    if (c + 2 < NCH) {
      stage1(s2, rw);
      if (c + 4 < NCH) load_raw(c + 4, rw);
    }
    asm volatile("s_waitcnt lgkmcnt(0)" ::: "memory");
    __builtin_amdgcn_s_barrier();
    asm volatile("" ::: "memory");
    const int t = s0; s0 = s1; s1 = s2; s2 = t;
  };
#pragma unroll 1
  for (int c = 0; c < NCH; c += 2) {
    iter(c, r0); iter(c + 1, r1);
  }
  __builtin_amdgcn_s_setprio(0);
}

DEV void ph_rwkv_post(const P& p, int layer) {
  const int lane = tid_() & 63;
  int r0, r1;
  wave_range(r0, r1, NTOK);
  const int ch = 4 * lane;
  float kav[4], rkv[4], lnw[4], lnb[4];
#pragma unroll
  for (int i = 0; i < 4; ++i) {
    kav[i] = p.rw_k_a[layer * 256 + ch + i]; rkv[i] = p.rw_r_k[layer * 256 + ch + i];
    lnw[i] = p.rw_ln_w[layer * 256 + ch + i]; lnb[i] = p.rw_ln_b[layer * 256 + ch + i];
  }
  struct In { uint2 y0, y1, g; uint4 h0, h1, s0, s1; };
  auto ld = [&](int row, In& in) {
    const bf16_t* zr = p.Z + (size_t)row * INW + 768 + ch;
    in.y0 = *(const uint2*)zr; in.y1 = *(const uint2*)(zr + 256);
    const bf16_t* hr = p.H + (size_t)row * D + 4 * ch;
    in.h0 = *(const uint4*)hr; in.h1 = *(const uint4*)(hr + 8);
    const bf16_t* sr = p.SC + (size_t)row * 1024 + 4 * ch;
    in.s0 = *(const uint4*)sr; in.s1 = *(const uint4*)(sr + 8);
    in.g = *(const uint2*)(p.Y + (size_t)row * D + 256 + ch);
  };
  In nx;
  if (r0 < r1) ld(r0, nx);
#pragma unroll 1
  for (int row = r0; row < r1; ++row) {
    const In in = nx;
    if (row + 1 < r1) ld(row + 1, nx);
    float y[4] = {bflo(in.y0.x) + bflo(in.y1.x), bfhi(in.y0.x) + bfhi(in.y1.x), bflo(in.y0.y) + bflo(in.y1.y), bfhi(in.y0.y) + bfhi(in.y1.y)};
    const float mu = row16_sum(y[0] + y[1] + y[2] + y[3]) * (1.f / 64.f);
    float vs = 0.f;
#pragma unroll
    for (int i = 0; i < 4; ++i) { y[i] -= mu; vs += y[i] * y[i]; }
    const float var = row16_sum(vs) * (1.f / 64.f);
    const float rstd = rsqrtf(var + 64e-5f);
    const float r[4] = {bflo(in.h0.x), bflo(in.h0.z), bflo(in.h1.x), bflo(in.h1.z)};
    const float k[4] = {bfhi(in.h0.x), bfhi(in.h0.z), bfhi(in.h1.x), bfhi(in.h1.z)};
    const float v[4] = {bfhi(in.h0.y), bfhi(in.h0.w), bfhi(in.h1.y), bfhi(in.h1.w)};
    const float a0[4] = {bfhi(in.s0.x), bfhi(in.s0.z), bfhi(in.s1.x), bfhi(in.s1.z)};
    const float a1[4] = {bfhi(in.s0.y), bfhi(in.s0.w), bfhi(in.s1.y), bfhi(in.s1.w)};
    float sd = 0.f;
#pragma unroll
    for (int i = 0; i < 4; ++i) {
      const float kd0 = k[i] * (1.f + (a0[i] - 1.f) * kav[i]), kd1 = k[i] * (1.f + (a1[i] - 1.f) * kav[i]);
      sd += r[i] * (kd0 + kd1) * rkv[i];
    }
    sd = row16_sum(sd);
    const float g[4] = {bflo(in.g.x), bfhi(in.g.x), bflo(in.g.y), bfhi(in.g.y)};
    float o[4];
#pragma unroll
    for (int i = 0; i < 4; ++i) {
      const float yn = y[i] * rstd * lnw[i] + lnb[i];
      o[i] = (yn + sd * v[i]) * g[i];
    }
    *(uint2*)(p.Y + (size_t)row * D + 256 + ch) = make_uint2(pack2(o[0], o[1]), pack2(o[2], o[3]));
  }
}

DEV void hyena_pre_unit(const P& p, int layer, int unit) {
  int kind, b, t0, L;
  if (unit < 1024) { kind = 0; b = unit >> 6; t0 = (unit & 63) * 64; L = T; } else { int u = unit - 1024; kind = 1; b = u >> 2; t0 = (u & 3) * 64; L = LC; }
  const int lane = tid_() & 63, wid = tid_() >> 6;
  const int tw = t0 + wid * 16;
  const size_t row0 = (size_t)b * LT + (kind ? 0 : LC);
  const float* cw = p.conv_w + (size_t)layer * 3 * 1536;
  const float* cb = p.conv_b + (size_t)layer * 1536;
  float wx[3][4], wv[3][4], bx[4], bv[4];
#pragma unroll
  for (int i = 0; i < 4; ++i) {
    const int cx = 256 + 4 * lane + i, cv = 512 + 4 * lane + i;
#pragma unroll
    for (int k = 0; k < 3; ++k) { wx[k][i] = cw[k * 1536 + cx]; wv[k][i] = cw[k * 1536 + cv]; }
    bx[i] = cb[cx]; bv[i] = cb[cv];
  }
  uint2 zx[18], zv[18];
#pragma unroll
  for (int i = 0; i < 18; ++i) {
    const int t = tw - 1 + i;
    if (t >= 0 && t < L) {
      const bf16_t* zr = p.Z + (row0 + t) * INW + 256 + 4 * lane;
      zx[i] = *(const uint2*)zr; zv[i] = *(const uint2*)(zr + 256);
    } else { zx[i] = make_uint2(0u, 0u); zv[i] = make_uint2(0u, 0u); }
  }
  float uo[4][16];
#pragma unroll
  for (int i = 0; i < 16; ++i) {
    const float xm[4] = {bflo(zx[i].x), bfhi(zx[i].x), bflo(zx[i].y), bfhi(zx[i].y)};
    const float xc[4] = {bflo(zx[i + 1].x), bfhi(zx[i + 1].x), bflo(zx[i + 1].y), bfhi(zx[i + 1].y)};
    const float xp[4] = {bflo(zx[i + 2].x), bfhi(zx[i + 2].x), bflo(zx[i + 2].y), bfhi(zx[i + 2].y)};
    const float vm[4] = {bflo(zv[i].x), bfhi(zv[i].x), bflo(zv[i].y), bfhi(zv[i].y)};
    const float vc[4] = {bflo(zv[i + 1].x), bfhi(zv[i + 1].x), bflo(zv[i + 1].y), bfhi(zv[i + 1].y)};
    const float vp[4] = {bflo(zv[i + 2].x), bfhi(zv[i + 2].x), bflo(zv[i + 2].y), bfhi(zv[i + 2].y)};
#pragma unroll
    for (int q = 0; q < 4; ++q) {
      const float a = wx[0][q] * xm[q] + wx[1][q] * xc[q] + wx[2][q] * xp[q] + bx[q];
      const float c2 = wv[0][q] * vm[q] + wv[1][q] * vc[q] + wv[2][q] * vp[q] + bv[q];
      uo[q][i] = a * c2;
    }
  }
  bf16_t* ut = kind ? opq(p.UTc) : opq(p.UTl);
#pragma unroll
  for (int q = 0; q < 4; ++q) {
    bf16_t* dst = ut + ((size_t)(4 * lane + q) * 16 + b) * L + tw;
    *(uint4*)dst = pack8(&uo[q][0]);
    *(uint4*)(dst + 8) = pack8(&uo[q][8]);
  }
}

DEV void lds_barrier() {
  asm volatile("s_waitcnt lgkmcnt(0)" ::: "memory");
  __builtin_amdgcn_s_barrier();
  asm volatile("" ::: "memory");
}
DEV void hyena_scale_unit(const P& p, int layer, int u, char* smem) {
  const int kind = u >> 8, c = u & 255, L = kind ? LC : T;
  const float* F = (kind ? opq(p.FC) : opq(p.FL)) + (size_t)c * 2 * L;
  float* red = (float*)smem;
  const int tid = tid_(), lane = tid & 63, wid = tid >> 6;
  float part = 0.f;
  for (int i = tid; i < 2 * L; i += 256) { float fv = F[i]; part += (i != L) ? fv * fv : 0.f; }
  part = wave_sum(part);
  __syncthreads();
  if (lane == 0) red[wid] = part;
  __syncthreads();
  if (tid == 0) p.SSQ[(layer * 2 + kind) * 256 + c] = rsqrtf(((red[0] + red[1]) + (red[2] + red[3])) + 1e-6f);
}
constexpr int HC_CQ = 65 * 144, HC_US = 32 * 272, HC_BUF = HC_CQ + HC_US;
typedef const __attribute__((address_space(1))) float* gfloat_p;
typedef unsigned u32x4_t __attribute__((ext_vector_type(4)));
typedef const __attribute__((address_space(1))) u32x4_t* guint4_p;
DEV void hyena_conv_unit(const P& p, int layer, int unit, char* smem) {
  int kind, c, tb, L;
  if (unit < 4096) { kind = 0; c = unit >> 4; tb = (unit & 15) * 256; L = T; } else { kind = 1; c = unit - 4096; tb = 0; L = LC; }
  const int tid = tid_(), lane = tid & 63, wid = tid >> 6, fr = lane & 15, fq = lane >> 4;
  const gfloat_p F = (gfloat_p)((kind ? opq(p.FC) : opq(p.FL)) + (size_t)c * 2 * L);
  const int nch = L / 256;
  const int bb = tid >> 4, sg0 = tid & 15;
  const guint4_p U = (guint4_p)((kind ? opq(p.UTc) : opq(p.UTl)) + (size_t)c * 16 * L + (size_t)bb * L + 8 * sg0);
  auto ldchunk = [&](int ch, float& f0, float& f1, float& f2, uint4& u0, uint4& u1) {
    const int D0 = tb + 256 - ch * 256;
    auto tap = [&](int n) -> float {
      const int d = D0 - n;
      const bool ok = (d > -L) && (d < L);
      int idx = d >= 0 ? d : L - d;
      idx = ok ? idx : 0;
      return F[idx];
    };
    f0 = tap(tid); f1 = tap(tid + 256); f2 = tap(tid < 8 ? tid + 512 : 100000);
    const u32x4_t w0 = U[ch * 32], w1 = U[ch * 32 + 16];
    u0 = make_uint4(w0.x, w0.y, w0.z, w0.w); u1 = make_uint4(w1.x, w1.y, w1.z, w1.w);
  };
  const float scale = p.SSQ[(layer * 2 + kind) * 256 + c];
  float fa0, fa1, fa2, fb0, fb1, fb2, fc0, fc1, fc2;
  uint4 ua0, ua1, ub0, ub1, uc0, uc1;
  const int lastc = nch - 1;
  ldchunk(0, fa0, fa1, fa2, ua0, ua1);
  ldchunk(min(1, lastc), fb0, fb1, fb2, ub0, ub1);
  ldchunk(min(2, lastc), fc0, fc1, fc2, uc0, uc1);
  auto stchunk = [&](int ch, float f0, float f1, float f2, const uint4& u0, const uint4& u1) {
    const int buf = ch & 1;
    bf16_t* Cq = (bf16_t*)(smem + buf * HC_BUF);
    char* Us = smem + buf * HC_BUF + HC_CQ;
    const int d0 = tb + 256 - ch * 256 - tid, d1 = d0 - 256, d2 = d0 - 512;
    const bf16_t h0 = f2bf((d0 > -L && d0 < L) ? f0 * scale : 0.f), h1 = f2bf((d1 > -L && d1 < L) ? f1 * scale : 0.f);
    const bf16_t h2 = f2bf((d2 > -L && d2 < L) ? f2 * scale : 0.f);
#pragma unroll
    for (int rho = 0; rho < 8; ++rho) {
      int m = tid + rho;
      Cq[(m >> 3) * 72 + rho * 8 + (m & 7)] = h0;
      m = tid + 256 + rho;
      if (m < 520) Cq[(m >> 3) * 72 + rho * 8 + (m & 7)] = h1;
      m = tid + 512 + rho;
      if (tid < 8 && m < 520) Cq[(m >> 3) * 72 + rho * 8 + (m & 7)] = h2;
    }
    if (tid < 8) {
#pragma unroll
      for (int rho = 1; rho < 8; ++rho) if (tid < rho) Cq[rho * 8 + tid] = 0;
    }
    *(uint4*)(Us + sg0 * 272 + bb * 16) = u0;
    *(uint4*)(Us + (sg0 + 16) * 272 + bb * 16) = u1;
  };
  f32x4 acc[4];
#pragma unroll
  for (int m = 0; m < 4; ++m) acc[m] = (f32x4){0.f, 0.f, 0.f, 0.f};
  const int a0 = (32 - 8 * wid + fq - (fr >> 3)) * 144 + (fr & 7) * 16;
  auto compute = [&](int buf) {
    const char* Cq = smem + buf * HC_BUF + a0;
    const char* Us = smem + buf * HC_BUF + HC_CQ + fq * 272 + fr * 16;
    bf16x8 fa[4];
#pragma unroll
    for (int m = 0; m < 4; ++m) fa[m] = *(const bf16x8*)(Cq - m * 288);
#pragma unroll
    for (int kk = 0; kk < 8; ++kk) {
      const bf16x8 bf = *(const bf16x8*)(Us + kk * 4 * 272);
      if (kk > 0) {
        fa[3] = fa[1]; fa[2] = fa[0];
        fa[1] = *(const bf16x8*)(Cq + (2 * kk - 1) * 288);
        fa[0] = *(const bf16x8*)(Cq + (2 * kk) * 288);
      }
#pragma unroll
      for (int m = 0; m < 4; ++m) acc[m] = mfma16(fa[m], bf, acc[m]);
    }
  };
  __syncthreads();
  int ch = 0;
#pragma unroll 1
  for (; ch + 3 <= lastc; ch += 3) {
    stchunk(ch, fa0, fa1, fa2, ua0, ua1);
    lds_barrier();
    ldchunk(min(ch + 3, lastc), fa0, fa1, fa2, ua0, ua1);
    compute(ch & 1);
    stchunk(ch + 1, fb0, fb1, fb2, ub0, ub1);
    lds_barrier();
    ldchunk(min(ch + 4, lastc), fb0, fb1, fb2, ub0, ub1);
    compute((ch + 1) & 1);
    stchunk(ch + 2, fc0, fc1, fc2, uc0, uc1);
    lds_barrier();
    ldchunk(min(ch + 5, lastc), fc0, fc1, fc2, uc0, uc1);
    compute(ch & 1);
  }
  stchunk(ch, fa0, fa1, fa2, ua0, ua1);
  lds_barrier();
  compute(ch & 1);
  bf16_t* Yt = (kind ? opq(p.YTc) : opq(p.YTl)) + ((size_t)c * 16 + fr) * L + tb;
#pragma unroll
  for (int m = 0; m < 4; ++m) {
    int t = (wid * 4 + m) * 16 + fq * 4;
    *(uint2*)(Yt + t) = make_uint2(pack2(acc[m][0], acc[m][1]), pack2(acc[m][2], acc[m][3]));
  }
}

DEV void hyena_post_unit(const P& p, int layer, int unit, char* smem) {
  (void)smem;
  int kind, b, t0, L;
  if (unit < 1024) { kind = 0; b = unit >> 6; t0 = (unit & 63) * 64; L = T; } else { int u = unit - 1024; kind = 1; b = u >> 2; t0 = (u & 3) * 64; L = LC; }
  const int lane = tid_() & 63, wid = tid_() >> 6;
  const int tw = t0 + wid * 16;
  const size_t row0 = (size_t)b * LT + (kind ? 0 : LC);
  const float* cw = p.conv_w + (size_t)layer * 3 * 1536;
  float w0[3][4], b0[4], bias[4], og[4];
#pragma unroll
  for (int i = 0; i < 4; ++i) {
    const int c = 4 * lane + i;
#pragma unroll
    for (int k = 0; k < 3; ++k) w0[k][i] = cw[k * 1536 + c];
    b0[i] = p.conv_b[layer * 1536 + c]; bias[i] = p.hy_bias[layer * 256 + c]; og[i] = p.hy_out_g[layer * 256 + c];
  }
  uint2 zx[18];
#pragma unroll
  for (int i = 0; i < 18; ++i) {
    const int t = tw - 1 + i;
    zx[i] = (t >= 0 && t < L) ? *(const uint2*)(p.Z + (row0 + t) * INW + 4 * lane) : make_uint2(0u, 0u);
  }
  const bf16_t* ytb = kind ? opq(p.YTc) : opq(p.YTl);
  const bf16_t* utb = kind ? opq(p.UTc) : opq(p.UTl);
  float o[4][16];
#pragma unroll
  for (int q = 0; q < 4; ++q) {
    const size_t off = ((size_t)(4 * lane + q) * 16 + b) * L + tw;
    float yv[16], uv[16];
    { uint4 a0 = *(const uint4*)(ytb + off), a1 = *(const uint4*)(ytb + off + 8); unpack8(a0, yv); unpack8(a1, yv + 8); }
    { uint4 a0 = *(const uint4*)(utb + off), a1 = *(const uint4*)(utb + off + 8); unpack8(a0, uv); unpack8(a1, uv + 8); }
#pragma unroll
    for (int i = 0; i < 16; ++i) o[q][i] = yv[i] + uv[i] * bias[q];
  }
#pragma unroll
  for (int i = 0; i < 16; ++i) {
    const float xm[4] = {bflo(zx[i].x), bfhi(zx[i].x), bflo(zx[i].y), bfhi(zx[i].y)};
    const float xc[4] = {bflo(zx[i + 1].x), bfhi(zx[i + 1].x), bflo(zx[i + 1].y), bfhi(zx[i + 1].y)};
    const float xp[4] = {bflo(zx[i + 2].x), bfhi(zx[i + 2].x), bflo(zx[i + 2].y), bfhi(zx[i + 2].y)};
    float ov[4], ss = 0.f;
#pragma unroll
    for (int q = 0; q < 4; ++q) {
      const float x0 = w0[0][q] * xm[q] + w0[1][q] * xc[q] + w0[2][q] * xp[q] + b0[q];
      ov[q] = bf2f(f2bf(x0 * o[q][i]));
      ss += ov[q] * ov[q];
    }
    ss = wave_sum(ss);
    const float rstd = rsqrtf(ss * (1.f / 256.f) + 1e-6f);
    *(uint2*)(p.Y + (row0 + tw + i) * D + 4 * lane) = make_uint2(pack2(ov[0] * rstd * og[0], ov[1] * rstd * og[1]), pack2(ov[2] * rstd * og[2], ov[3] * rstd * og[3]));
  }
}

DEV void attn_unit(const P& p, int layer, int unit, char* smem) {
  const bool isctx = unit >= 4096;
  int b, qb, hq;
  if (!isctx) { b = unit >> 8; qb = (unit >> 3) & 31; hq = unit & 7; } else { int u = unit - 4096; b = u >> 4; qb = (u >> 3) & 1; hq = u & 7; }
  const int g = hq >> 2;
  const int tid = tid_(), lane = tid & 63, wid = tid >> 6, qn = lane & 31, hh = lane >> 5;
  const int qpos = qb * 128 + wid * 32 + qn;
  const size_t qrow = (size_t)b * LT + (isctx ? qpos : LC + qpos);
  const bf16_t* qptr = p.Z + qrow * INW + 1920 + hq * 64;
  bf16x8 qf[4];
#pragma unroll
  for (int s = 0; s < 4; ++s) qf[s] = *(const bf16x8*)(qptr + 16 * s + 8 * hh);
  const float sink = p.attn_sink[layer * 8 + hq];
  float m_run = sink, l_run = 1.f;
  f32x16 o0, o1;
#pragma unroll
  for (int i = 0; i < 16; ++i) { o0[i] = 0.f; o1[i] = 0.f; }
  typedef bf16_t KTile[64][72];
  KTile* Ks = (KTile*)smem;
  KTile* Vt = (KTile*)(smem + 18432);
  const int ntl = isctx ? 0 : 6;
  const int ntiles = ntl + 4;
  const int skey = tid >> 3, sseg = tid & 7;
  const bf16_t* kvbase = p.Z + (size_t)b * LT * INW + 1920 + 512 + g * 64 + sseg * 8;
  uint4 rk0, rk1, rv0, rv1;
  auto ldtile = [&](int kt) {
    const bool ctxk = kt >= ntl;
    const int kbase = ctxk ? (kt - ntl) * 64 : qb * 128 - 128 + kt * 64;
    const int kp0 = kbase + skey, kp1 = kp0 + 32;
    rk0 = rk1 = rv0 = rv1 = make_uint4(0, 0, 0, 0);
    if (ctxk || (kp0 >= 0 && kp0 < T)) { const bf16_t* src = kvbase + (size_t)(ctxk ? kp0 : LC + kp0) * INW; rk0 = *(const uint4*)src; rv0 = *(const uint4*)(src + 128); }
    if (ctxk || (kp1 >= 0 && kp1 < T)) { const bf16_t* src = kvbase + (size_t)(ctxk ? kp1 : LC + kp1) * INW; rk1 = *(const uint4*)src; rv1 = *(const uint4*)(src + 128); }
  };
  auto sttile = [&](int buf) {
    *(uint4*)&Ks[buf][skey][sseg * 8] = rk0;
    *(uint4*)&Ks[buf][skey + 32][sseg * 8] = rk1;
    bf16_t (*vt)[72] = Vt[buf];
    vt[sseg * 8 + 0][skey] = (bf16_t)(rv0.x & 0xFFFF); vt[sseg * 8 + 1][skey] = (bf16_t)(rv0.x >> 16);
    vt[sseg * 8 + 2][skey] = (bf16_t)(rv0.y & 0xFFFF); vt[sseg * 8 + 3][skey] = (bf16_t)(rv0.y >> 16);
    vt[sseg * 8 + 4][skey] = (bf16_t)(rv0.z & 0xFFFF); vt[sseg * 8 + 5][skey] = (bf16_t)(rv0.z >> 16);
    vt[sseg * 8 + 6][skey] = (bf16_t)(rv0.w & 0xFFFF); vt[sseg * 8 + 7][skey] = (bf16_t)(rv0.w >> 16);
    vt[sseg * 8 + 0][skey + 32] = (bf16_t)(rv1.x & 0xFFFF); vt[sseg * 8 + 1][skey + 32] = (bf16_t)(rv1.x >> 16);
    vt[sseg * 8 + 2][skey + 32] = (bf16_t)(rv1.y & 0xFFFF); vt[sseg * 8 + 3][skey + 32] = (bf16_t)(rv1.y >> 16);
    vt[sseg * 8 + 4][skey + 32] = (bf16_t)(rv1.z & 0xFFFF); vt[sseg * 8 + 5][skey + 32] = (bf16_t)(rv1.z >> 16);
    vt[sseg * 8 + 6][skey + 32] = (bf16_t)(rv1.w & 0xFFFF); vt[sseg * 8 + 7][skey + 32] = (bf16_t)(rv1.w >> 16);
  };
  ldtile(0);
#pragma unroll 1
  for (int kt = 0; kt < ntiles; ++kt) {
    const int buf = kt & 1;
    sttile(buf);
    __syncthreads();
    if (kt + 1 < ntiles) ldtile(kt + 1);
    const bool ctxk = kt >= ntl;
    const int kbase = ctxk ? (kt - ntl) * 64 : qb * 128 - 128 + kt * 64;
#pragma unroll
    for (int sub = 0; sub < 2; ++sub) {
      const int kb2 = kbase + sub * 32;
      bool need = true;
      if (!ctxk) {
        int q0 = qb * 128 + wid * 32;
        if (kb2 + 31 < q0 - 128 || kb2 > q0 + 31 + 128 || kb2 + 31 < 0 || kb2 >= T) need = false;
      }
      if (need) {
        f32x16 sv;
#pragma unroll
        for (int i = 0; i < 16; ++i) sv[i] = 0.f;
#pragma unroll
        for (int ks = 0; ks < 4; ++ks) {
          bf16x8 kf = *(const bf16x8*)&Ks[buf][sub * 32 + qn][16 * ks + 8 * hh];
          sv = mfma32(kf, qf[ks], sv);
        }
        float mt = -3e38f;
#pragma unroll
        for (int rg = 0; rg < 16; ++rg) {
          float v = sv[rg] * 0.125f;
          if (!ctxk) {
            int kp = kb2 + (rg & 3) + 8 * (rg >> 2) + 4 * hh;
            int dl = qpos - kp;
            bool ok = (dl <= 128) && (dl >= -128) && (kp >= 0) && (kp < T);
            v = ok ? v : -1e30f;
          }
          sv[rg] = v;
          mt = fmaxf(mt, v);
        }
        mt = fmaxf(mt, __shfl_xor(mt, 32));
        float m_new = fmaxf(m_run, mt);
        float corr = __expf(m_run - m_new);
        float ps = 0.f;
#pragma unroll
        for (int rg = 0; rg < 16; ++rg) { float pv = __expf(sv[rg] - m_new); sv[rg] = pv; ps += pv; }
        ps += __shfl_xor(ps, 32);
        l_run = l_run * corr + ps;
        m_run = m_new;
#pragma unroll
        for (int i = 0; i < 16; ++i) { o0[i] *= corr; o1[i] *= corr; }
#pragma unroll
        for (int sp = 0; sp < 2; ++sp) {
          bf16x8 pf;
#pragma unroll
          for (int j = 0; j < 8; ++j) pf[j] = (short)f2bf(sv[8 * sp + j]);
          const int kc = sub * 32 + 16 * sp + 4 * hh;
          uint2 va = *(const uint2*)&Vt[buf][qn][kc], vb = *(const uint2*)&Vt[buf][qn][kc + 8];
          uint2 vc = *(const uint2*)&Vt[buf][32 + qn][kc], vd = *(const uint2*)&Vt[buf][32 + qn][kc + 8];
          uint4 w0 = make_uint4(va.x, va.y, vb.x, vb.y), w1 = make_uint4(vc.x, vc.y, vd.x, vd.y);
          bf16x8 v0 = __builtin_bit_cast(bf16x8, w0), v1 = __builtin_bit_cast(bf16x8, w1);
          o0 = mfma32(v0, pf, o0);
          o1 = mfma32(v1, pf, o1);
        }
      }
    }
  }
  __syncthreads();
  const float inv = 1.f / l_run;
  bf16_t* optr = p.Y + qrow * D + 512 + hq * 64;
#pragma unroll
  for (int rg = 0; rg < 4; ++rg) {
    int d0 = 8 * rg + 4 * hh;
    *(uint2*)(optr + d0) = make_uint2(pack2(o0[4 * rg] * inv, o0[4 * rg + 1] * inv), pack2(o0[4 * rg + 2] * inv, o0[4 * rg + 3] * inv));
    *(uint2*)(optr + 32 + d0) = make_uint2(pack2(o1[4 * rg] * inv, o1[4 * rg + 1] * inv), pack2(o1[4 * rg + 2] * inv, o1[4 * rg + 3] * inv));
  }
}

DEV void ph_attn_post(const P& p, int layer) {
  const int lane = tid_() & 63;
  int r0, r1;
  wave_range(r0, r1, NTOK);
  float gv[8];
#pragma unroll
  for (int i = 0; i < 8; ++i) gv[i] = p.at_out_g[layer * 512 + 8 * lane + i];
  uint4 nx = make_uint4(0, 0, 0, 0);
  if (r0 < r1) nx = *(const uint4*)(p.Y + (size_t)r0 * D + 512 + 8 * lane);
#pragma unroll 1
  for (int row = r0; row < r1; ++row) {
    const uint4 u = nx;
    if (row + 1 < r1) nx = *(const uint4*)(p.Y + (size_t)(row + 1) * D + 512 + 8 * lane);
    float v[8];
    unpack8(u, v);
    float ss = 0.f;
#pragma unroll
    for (int i = 0; i < 8; ++i) ss += v[i] * v[i];
    ss = wave_sum(ss);
    const float rstd = rsqrtf(ss * (1.f / 512.f) + 1e-6f);
#pragma unroll
    for (int i = 0; i < 8; ++i) {
      v[i] = v[i] * rstd * gv[i];
    }
    *(uint4*)(p.Y + (size_t)row * D + 512 + 8 * lane) = pack8(v);
  }
}

struct Epi2 {
  const P& p; int layer, row0, col0;
  DEV void operator()(f32x4 (&acc)[4][4], int wr, int wc, int fr, int fq, char* smem) const {
    const int b = row0 / LT, pp = row0 % LT;
    const int mr = pp < LC ? 16 : b;
    const float* g1 = p.modv + ((size_t)layer * 17 + mr) * 6144 + 2048 + col0 + wc * 64;
#pragma unroll
    for (int n = 0; n < 4; ++n) {
      const float4 gv = *(const float4*)(g1 + n * 16 + 4 * fq);
#pragma unroll
      for (int m = 0; m < 4; ++m) { acc[m][n][0] *= gv.x; acc[m][n][1] *= gv.y; acc[m][n][2] *= gv.z; acc[m][n][3] *= gv.w; }
    }
    const int wid = wr * 2 + wc, lane = fq * 16 + fr;
    stage_tile_bf16(acc, smem, wid, fr, fq);
    const bf16_t (*t)[72] = (const bf16_t (*)[72])(smem + wid * 9216);
#pragma unroll
    for (int i = 0; i < 8; ++i) {
      const int rl = i * 8 + (lane >> 3), ch = lane & 7;
      bf16_t* xp = p.X + (size_t)(row0 + wr * 64 + rl) * D + col0 + wc * 64 + ch * 8;
      float xv[8], dv[8];
      uint4 xu = *(const uint4*)xp, du = *(const uint4*)&t[rl][ch * 8];
      unpack8(xu, xv); unpack8(du, dv);
#pragma unroll
      for (int q = 0; q < 8; ++q) xv[q] += dv[q];
      *(uint4*)xp = pack8(xv);
    }
  }
};
DEV void ph_gemm2(const P& p, int layer, char* smem) {
  int rt, ct;
  for (int it = 0; gemm_unit(it, 8, rt, ct); ++it) {
    Epi2 epi{p, layer, rt * 128, ct * 128};
    gemm_tile(p.Y + (size_t)rt * 128 * D, D, p.W2t + (size_t)ct * 128 * D, D, D, smem, epi);
  }
}

DEV void ph_peerconv(const P& p, int layer) {
  const int gw = (bid_() * 256 + tid_()) >> 6, nw = gridDim.x * 4, lane = tid_() & 63;
  const float* su = opq(p.peer_u) + (size_t)layer * 16384 * 1024;
  const float* sv = opq(p.peer_v) + (size_t)layer * 16384 * 1024;
  unsigned char* pu = opq(p.PU); unsigned char* pv = opq(p.PV);
  float* psu = opq(p.PSU); float* psv = opq(p.PSV);
  auto ldrow = [&](int r, float4& a0, float4& a1, float4& a2, float4& a3) {
    const float* src = ((r >= 16384) ? sv : su) + (size_t)(r & 16383) * 1024 + 16 * lane;
    a0 = *(const float4*)src; a1 = *(const float4*)(src + 4); a2 = *(const float4*)(src + 8); a3 = *(const float4*)(src + 12);
  };
  float4 n0 = make_float4(0, 0, 0, 0), n1 = n0, n2 = n0, n3 = n0;
  if (gw < 32768) ldrow(gw, n0, n1, n2, n3);
#pragma unroll 1
  for (int r = gw; r < 32768; r += nw) {
    const bool isv = r >= 16384;
    const int e = r & 16383;
    const float4 f0 = n0, f1 = n1, f2 = n2, f3 = n3;
    if (r + nw < 32768) ldrow(r + nw, n0, n1, n2, n3);
    float am = fmaxf(fmaxf(fmaxf(fabsf(f0.x), fabsf(f0.y)), fmaxf(fabsf(f0.z), fabsf(f0.w))), fmaxf(fmaxf(fabsf(f1.x), fabsf(f1.y)), fmaxf(fabsf(f1.z), fabsf(f1.w))));
    am = fmaxf(am, fmaxf(fmaxf(fmaxf(fabsf(f2.x), fabsf(f2.y)), fmaxf(fabsf(f2.z), fabsf(f2.w))), fmaxf(fmaxf(fabsf(f3.x), fabsf(f3.y)), fmaxf(fabsf(f3.z), fabsf(f3.w)))));
    am = wave_max(am);
    int w0, w1, w2, w3;
    float inv;
    if (isv) {
      const float sc = am > 0.f ? 224.f / am : 1.f;
      inv = am > 0.f ? am * (1.f / 224.f) : 1.f;
      w0 = __builtin_amdgcn_cvt_pk_fp8_f32(f0.x * sc, f0.y * sc, 0, false); w0 = __builtin_amdgcn_cvt_pk_fp8_f32(f0.z * sc, f0.w * sc, w0, true);
      w1 = __builtin_amdgcn_cvt_pk_fp8_f32(f1.x * sc, f1.y * sc, 0, false); w1 = __builtin_amdgcn_cvt_pk_fp8_f32(f1.z * sc, f1.w * sc, w1, true);
      w2 = __builtin_amdgcn_cvt_pk_fp8_f32(f2.x * sc, f2.y * sc, 0, false); w2 = __builtin_amdgcn_cvt_pk_fp8_f32(f2.z * sc, f2.w * sc, w2, true);
      w3 = __builtin_amdgcn_cvt_pk_fp8_f32(f3.x * sc, f3.y * sc, 0, false); w3 = __builtin_amdgcn_cvt_pk_fp8_f32(f3.z * sc, f3.w * sc, w3, true);
    } else {
      const float sc = am > 0.f ? 127.f / am : 1.f;
      inv = am > 0.f ? am * (1.f / 127.f) : 1.f;
      w0 = pack_i8(f0.x * sc, f0.y * sc, f0.z * sc, f0.w * sc); w1 = pack_i8(f1.x * sc, f1.y * sc, f1.z * sc, f1.w * sc);
      w2 = pack_i8(f2.x * sc, f2.y * sc, f2.z * sc, f2.w * sc); w3 = pack_i8(f3.x * sc, f3.y * sc, f3.z * sc, f3.w * sc);
    }
    *(uint4*)((isv ? pv : pu) + (size_t)(lane >> 3) * PSLICE + (size_t)e * 128 + 16 * (lane & 7)) = make_uint4((unsigned)w0, (unsigned)w1, (unsigned)w2, (unsigned)w3);
    if (lane == 0) (isv ? psv : psu)[e] = inv;
  }
}
DEV void unpack16_fp8x2(const uint4& u, f32x2* f) {
  f[0] = __builtin_amdgcn_cvt_pk_f32_fp8((int)u.x, false); f[1] = __builtin_amdgcn_cvt_pk_f32_fp8((int)u.x, true);
  f[2] = __builtin_amdgcn_cvt_pk_f32_fp8((int)u.y, false); f[3] = __builtin_amdgcn_cvt_pk_f32_fp8((int)u.y, true);
  f[4] = __builtin_amdgcn_cvt_pk_f32_fp8((int)u.z, false); f[5] = __builtin_amdgcn_cvt_pk_f32_fp8((int)u.z, true);
  f[6] = __builtin_amdgcn_cvt_pk_f32_fp8((int)u.w, false); f[7] = __builtin_amdgcn_cvt_pk_f32_fp8((int)u.w, true);
}

DEV void bitonic_sort16_desc(float (&v)[16]) {
#pragma unroll
  for (int k = 2; k <= 16; k <<= 1)
#pragma unroll
    for (int j = k >> 1; j >= 1; j >>= 1)
#pragma unroll
      for (int i = 0; i < 16; ++i) {
        const int l = i ^ j;
        if (l > i) {
          const float hi = fmaxf(v[i], v[l]), lo = fminf(v[i], v[l]);
          if ((i & k) == 0) { v[i] = hi; v[l] = lo; } else { v[i] = lo; v[l] = hi; }
        }
      }
}
DEV void peer_cand_ij(int c, int& ci, int& cj) {
  if (c < 16) { ci = 0; cj = c; } else if (c < 24) { ci = 1; cj = c - 16; } else if (c < 29) { ci = 2; cj = c - 24; }
  else if (c < 33) { ci = 3; cj = c - 29; } else if (c < 36) { ci = 4; cj = c - 33; } else if (c < 38) { ci = 5; cj = c - 36; }
  else if (c < 40) { ci = 6; cj = c - 38; } else if (c < 42) { ci = 7; cj = c - 40; } else { ci = (c - 42 + 8) & 15; cj = 0; }
}
DEV void ce_desc(float& a, float& b) { const float hi = fmaxf(a, b), lo = fminf(a, b); a = hi; b = lo; }
DEV void bitonic_merge16_desc(float (&v)[16]) {
#pragma unroll
  for (int d = 8; d >= 1; d >>= 1)
#pragma unroll
    for (int i = 0; i < 16; ++i)
      if ((i & d) == 0) ce_desc(v[i], v[i + d]);
}
template <int N>
DEV void merge_trunc16(float (&T)[16], const float (&B)[N]) {
#pragma unroll
  for (int k = 0; k < N; ++k) T[15 - k] = fmaxf(T[15 - k], B[k]);
  bitonic_merge16_desc(T);
}
DEV float pk_sum(float a, float b, int i, int j) {
  return __uint_as_float((__float_as_uint(a + b) & ~255u) | (unsigned)(255 - (i * 16 + j)));
}
template <int S>
struct Epi3K {
  const P& p; int row0, head; float (&keep)[2][16];
  DEV void operator()(f32x4 (&acc)[4][4], int wr, int wc, int fr, int fq, char* smem) const {
    float* sc = (float*)smem;
    float* L1s = (float*)(smem + 36864);
    float* L2s = (float*)(smem + 47104);
    const int tid = tid_();
#pragma unroll
    for (int pass = 0; pass < 2; ++pass) {
      __syncthreads();
      if (wr == pass) {
#pragma unroll
        for (int m = 0; m < 4; ++m)
#pragma unroll
          for (int n = 0; n < 4; ++n)
#pragma unroll
            for (int j = 0; j < 4; ++j) {
              int rl = m * 16 + fr, col = wc * 64 + n * 16 + 4 * fq + j;
              unsigned bits = (__float_as_uint(acc[m][n][j]) & ~127u) | (unsigned)col;
              sc[rl * 133 + (col >> 5) * 33 + (col & 31)] = __uint_as_float(bits);
            }
      }
      __syncthreads();
      const int rl = tid >> 2, q = tid & 3;
      const float* src = sc + rl * 133 + q * 33;
      float Ls[16], Hs[16];
#pragma unroll
      for (int i = 0; i < 16; ++i) { Ls[i] = src[i]; Hs[i] = src[16 + i]; }
      bitonic_sort16_desc(Ls);
      bitonic_sort16_desc(Hs);
#pragma unroll
      for (int i = 0; i < 16; ++i) Ls[i] = fmaxf(Ls[i], Hs[15 - i]);
#pragma unroll
      for (int d = 8; d >= 1; d >>= 1)
#pragma unroll
        for (int i = 0; i < 16; ++i)
          if ((i & d) == 0) { float hi = fmaxf(Ls[i], Ls[i + d]), lo = fminf(Ls[i], Ls[i + d]); Ls[i] = hi; Ls[i + d] = lo; }
      float Cs[16];
#pragma unroll
      for (int i = 0; i < 16; ++i) Cs[i] = fmaxf(Ls[i], dppself<0xB1, 0xF>(Ls[15 - i]));
#pragma unroll
      for (int d = 8; d >= 1; d >>= 1)
#pragma unroll
        for (int i = 0; i < 16; ++i)
          if ((i & d) == 0) { float hi = fmaxf(Cs[i], Cs[i + d]), lo = fminf(Cs[i], Cs[i + d]); Cs[i] = hi; Cs[i + d] = lo; }
      float Ds[16];
#pragma unroll
      for (int i = 0; i < 16; ++i) Ds[i] = fmaxf(Cs[i], dppself<0x4E, 0xF>(Cs[15 - i]));
#pragma unroll
      for (int d = 8; d >= 1; d >>= 1)
#pragma unroll
        for (int i = 0; i < 16; ++i)
          if ((i & d) == 0) { float hi = fmaxf(Ds[i], Ds[i + d]), lo = fminf(Ds[i], Ds[i + d]); Ds[i] = hi; Ds[i + d] = lo; }
      if (S == 0) {
#pragma unroll
        for (int i = 0; i < 16; ++i) keep[pass][i] = Ds[i];
      } else if (q == 0) {
        float* d1 = L1s + (pass * 64 + rl) * 20;
        float* d2 = L2s + (pass * 64 + rl) * 20;
#pragma unroll
        for (int i = 0; i < 4; ++i) {
          *(float4*)(d1 + 4 * i) = make_float4(keep[pass][4 * i], keep[pass][4 * i + 1], keep[pass][4 * i + 2], keep[pass][4 * i + 3]);
          *(float4*)(d2 + 4 * i) = make_float4(Ds[4 * i], Ds[4 * i + 1], Ds[4 * i + 2], Ds[4 * i + 3]);
        }
      }
    }
    if (S == 1) {
      __syncthreads();
      if (tid < 128) {
        const int row = tid;
        float A[16], Bv[16];
        const float* l1 = L1s + row * 20;
        const float* l2 = L2s + row * 20;
#pragma unroll
        for (int i = 0; i < 4; ++i) {
          const float4 x = *(const float4*)(l1 + 4 * i), y = *(const float4*)(l2 + 4 * i);
          A[4 * i] = x.x; A[4 * i + 1] = x.y; A[4 * i + 2] = x.z; A[4 * i + 3] = x.w;
          Bv[4 * i] = y.x; Bv[4 * i + 1] = y.y; Bv[4 * i + 2] = y.z; Bv[4 * i + 3] = y.w;
        }
        float T[16];
#pragma unroll
        for (int j = 0; j < 16; ++j) T[j] = pk_sum(A[0], Bv[j], 0, j);
        {
          float C0[15];
#pragma unroll
          for (int i = 1; i < 16; ++i) C0[i - 1] = pk_sum(A[i], Bv[0], i, 0);
          merge_trunc16(T, C0);
        }
        {
          float R1[7];
#pragma unroll
          for (int j = 1; j < 8; ++j) R1[j - 1] = pk_sum(A[1], Bv[j], 1, j);
          merge_trunc16(T, R1);
        }
        {
          float C1[6];
#pragma unroll
          for (int i = 2; i < 8; ++i) C1[i - 2] = pk_sum(A[i], Bv[1], i, 1);
          merge_trunc16(T, C1);
        }
        {
          float R2[3];
#pragma unroll
          for (int j = 2; j < 5; ++j) R2[j - 2] = pk_sum(A[2], Bv[j], 2, j);
          merge_trunc16(T, R2);
        }
        {
          float C2[2] = {pk_sum(A[3], Bv[2], 3, 2), pk_sum(A[4], Bv[2], 4, 2)};
          merge_trunc16(T, C2);
        }
        {
          float X3[1] = {pk_sum(A[3], Bv[3], 3, 3)};
          merge_trunc16(T, X3);
        }
        const float mx = T[0];
        float ex[16], sm = 0.f;
        unsigned ee[16];
#pragma unroll
        for (int k = 0; k < 16; ++k) {
          const unsigned tg = 255u - (__float_as_uint(T[k]) & 255u);
          const unsigned k1 = __float_as_uint(l1[tg >> 4]) & 127u, k2 = __float_as_uint(l2[tg & 15u]) & 127u;
          ee[k] = k1 * 128u + k2;
          ex[k] = __expf(T[k] - mx);
          sm += ex[k];
        }
        const float rs = 1.f / sm;
        const size_t o = (size_t)(row0 + row) * 128 + head * 16;
        uint4* elp = (uint4*)(p.EL + o);
        elp[0] = make_uint4(ee[0] | (ee[1] << 16), ee[2] | (ee[3] << 16), ee[4] | (ee[5] << 16), ee[6] | (ee[7] << 16));
        elp[1] = make_uint4(ee[8] | (ee[9] << 16), ee[10] | (ee[11] << 16), ee[12] | (ee[13] << 16), ee[14] | (ee[15] << 16));
        float4* gtp = (float4*)(p.GT + o);
#pragma unroll
        for (int i = 0; i < 4; ++i) gtp[i] = make_float4(ex[4 * i] * rs, ex[4 * i + 1] * rs, ex[4 * i + 2] * rs, ex[4 * i + 3] * rs);
      }
    }
  }
};
DEV void ph_gemm3(const P& p, char* smem) {
  int rt, hd;
  for (int it = 0; gemm_unit(it, 8, rt, hd); ++it) {
    float keep[2][16];
    {
      Epi3K<0> epi{p, rt * 128, hd, keep};
      gemm_tile(p.H + (size_t)rt * 128 * D, D, p.Wft + (size_t)(2 * hd) * 128 * D, D, D, smem, epi);
    }
    {
      Epi3K<1> epi{p, rt * 128, hd, keep};
      gemm_tile(p.H + (size_t)rt * 128 * D, D, p.Wft + (size_t)(2 * hd + 1) * 128 * D, D, D, smem, epi);
    }
  }
}

DEV float peer_gate(float scr) {
  float mx = row16_max(scr);
  float ex = __expf(scr - mx);
  float sm = row16_sum(ex);
  return ex / sm;
}
DEV float gelu_exact(float x) { return 0.5f * x * (1.f + erff(x * 0.7071067811865476f)); }

struct PeerPre { uint4 e0, e1, a0, a1; };
DEV unsigned peer_eid(const PeerPre& s, int j) {
  const unsigned w = (j < 8) ? ((j >> 1) == 0 ? s.e0.x : (j >> 1) == 1 ? s.e0.y : (j >> 1) == 2 ? s.e0.z : s.e0.w)
                             : (((j - 8) >> 1) == 0 ? s.e1.x : ((j - 8) >> 1) == 1 ? s.e1.y : ((j - 8) >> 1) == 2 ? s.e1.z : s.e1.w);
  return (j & 1) ? (w >> 16) : (w & 0xFFFFu);
}
template <int WHICH>
DEV void peer_wave_run(const P& p, int layer, int x, int tok0, int lane, float* wbuf) {
  const int r = lane >> 3, c = lane & 7;
  const unsigned char* tb = (WHICH == 0 ? p.PU : p.PV) + (size_t)x * PSLICE + c * 16;
  PeerPre S[3];
  uint4 R[16];
  auto ld_pre = [&](int tok, PeerPre& s) {
    const uint4* elp = (const uint4*)(p.EL + (size_t)tok * 128 + r * 16);
    s.e0 = elp[0]; s.e1 = elp[1];
    if (WHICH == 0) {
      s.a0 = *(const uint4*)(p.H8 + (size_t)tok * 1024 + x * 128 + c * 16);
    } else {
      const uint4* wtp = (const uint4*)(p.GW + (size_t)tok * 128 + r * 16);
      s.a0 = wtp[0]; s.a1 = wtp[1];
    }
  };
  auto comp = [&](int tok, const PeerPre& s, const PeerPre& sn, bool more) {
    if (WHICH == 0) {
      int keep0 = 0, keep1 = 0;
#pragma unroll
      for (int j = 0; j < 16; ++j) {
        const uint4 rw = R[j];
        if (more) R[j] = *(const uint4*)(tb + (size_t)peer_eid(sn, j) * 128);
        int d = __builtin_amdgcn_sdot4((int)rw.x, (int)s.a0.x, 0, false);
        d = __builtin_amdgcn_sdot4((int)rw.y, (int)s.a0.y, d, false);
        d = __builtin_amdgcn_sdot4((int)rw.z, (int)s.a0.z, d, false);
        d = __builtin_amdgcn_sdot4((int)rw.w, (int)s.a0.w, d, false);
        d += __builtin_amdgcn_update_dpp(0, d, 0xB1, 0xF, 0xF, false);
        d += __builtin_amdgcn_update_dpp(0, d, 0x4E, 0xF, 0xF, false);
        d += __builtin_amdgcn_update_dpp(0, d, 0x141, 0xF, 0xF, false);
        if (j < 8) keep0 = (c == j) ? d : keep0; else keep1 = (c == j - 8) ? d : keep1;
      }
      bf16_t* pd = p.PD + ((size_t)x * NTOK + tok) * 128 + r * 16 + c;
      pd[0] = f2bf((float)keep0); pd[8] = f2bf((float)keep1);
    } else {
      float wsv[16];
      unpack8(s.a0, wsv); unpack8(s.a1, wsv + 8);
      f32x2 acc2[8];
#pragma unroll
      for (int i = 0; i < 8; ++i) acc2[i] = (f32x2){0.f, 0.f};
#pragma unroll
      for (int j = 0; j < 16; ++j) {
        f32x2 f[8];
        unpack16_fp8x2(R[j], f);
        if (more) R[j] = *(const uint4*)(tb + (size_t)peer_eid(sn, j) * 128);
        const f32x2 w2 = (f32x2){wsv[j], wsv[j]};
#pragma unroll
        for (int i = 0; i < 8; ++i) acc2[i] += w2 * f[i];
      }
      float* slab = wbuf + (r * 8 + c) * 16;
      *(float4*)(slab) = make_float4(acc2[0][0], acc2[0][1], acc2[1][0], acc2[1][1]);
      *(float4*)(slab + 4) = make_float4(acc2[2][0], acc2[2][1], acc2[3][0], acc2[3][1]);
      *(float4*)(slab + 8) = make_float4(acc2[4][0], acc2[4][1], acc2[5][0], acc2[5][1]);
      *(float4*)(slab + 12) = make_float4(acc2[6][0], acc2[6][1], acc2[7][0], acc2[7][1]);
      asm volatile("s_waitcnt lgkmcnt(0)" ::: "memory");
      float o0 = 0.f, o1 = 0.f;
#pragma unroll
      for (int rr = 0; rr < 8; ++rr) {
        const float2 t = *(const float2*)(wbuf + (rr * 8 + (lane >> 3)) * 16 + 2 * (lane & 7));
        o0 += t.x; o1 += t.y;
      }
      asm volatile("s_waitcnt lgkmcnt(0)" ::: "memory");
      const int b = tok / LT, pp = tok % LT;
      const int mr = pp < LC ? 16 : b;
      const int col = x * 128 + 2 * lane;
      const float* g2 = p.modv + ((size_t)layer * 17 + mr) * 6144 + 5120 + col;
      unsigned* xp = (unsigned*)(p.X + (size_t)tok * D + col);
      const unsigned xu = *xp;
      *xp = pack2(bflo(xu) + g2[0] * o0, bfhi(xu) + g2[1] * o1);
    }
  };
  ld_pre(tok0, S[0]);
  ld_pre(tok0 + 1, S[1]);
#pragma unroll
  for (int j = 0; j < 16; ++j) R[j] = *(const uint4*)(tb + (size_t)peer_eid(S[0], j) * 128);
  ld_pre(tok0 + 2, S[2]);
#pragma unroll
  for (int t = 0; t < 8; ++t) {
    comp(tok0 + t, S[t % 3], S[(t + 1) % 3], t + 1 < 8);
    if (t + 3 < 8) ld_pre(tok0 + t + 3, S[t % 3]);
  }
}
DEV void ph_peer_w(const P& p) {
  for (size_t i8 = (size_t)bid_() * 256 + tid_(); i8 < (size_t)NTOK * 16; i8 += (size_t)gridDim.x * 256) {
    const size_t i = i8 * 8;
    float d[8];
#pragma unroll
    for (int q = 0; q < 8; ++q) d[q] = 0.f;
#pragma unroll
    for (int x = 0; x < 8; ++x) {
      const uint4 u = *(const uint4*)(p.PD + (size_t)x * NTOK * 128 + i);
      float f[8];
      unpack8(u, f);
#pragma unroll
      for (int q = 0; q < 8; ++q) d[q] += f[q];
    }
    const uint4 eu = *(const uint4*)(p.EL + i);
    const unsigned ew[4] = {eu.x, eu.y, eu.z, eu.w};
    const float hinv = p.HINV[i >> 7];
    float4 g0 = *(const float4*)(p.GT + i), g1 = *(const float4*)(p.GT + i + 4);
    float g[8] = {g0.x, g0.y, g0.z, g0.w, g1.x, g1.y, g1.z, g1.w};
#pragma unroll
    for (int q = 0; q < 8; ++q) {
      const unsigned e = (q & 1) ? (ew[q >> 1] >> 16) : (ew[q >> 1] & 0xFFFFu);
      g[q] = g[q] * gelu_exact(d[q] * p.PSU[e] * hinv) * p.PSV[e];
    }
    *(uint4*)(p.GW + i) = pack8(g);
  }
}
template <int WHICH>
DEV void ph_peer_gather(const P& p, int layer, char* smem, volatile LAS unsigned* slot) {
  const int tid = tid_(), lane = tid & 63, wid = tid >> 6;
  unsigned* q = p.wq + 1024 + layer * 256 + WHICH * 128;
  const int my = (int)(xb_xcc_id() & 7u);
  float* wbuf = (float*)smem + wid * 1024;
#pragma unroll 1
  for (int rot = 0; rot < 8; ++rot) {
    const int x = (my + rot) & 7;
    for (;;) {
      __syncthreads();
      if (tid == 0) *slot = atomicAdd(q + x * 16, 1u);
      __syncthreads();
      const int it = (int)*slot;
      if (it >= NTOK / 64) break;
      peer_wave_run<WHICH>(p, layer, x, it * 64 + wid * 16, lane, wbuf);
      peer_wave_run<WHICH>(p, layer, x, it * 64 + wid * 16 + 8, lane, wbuf);
    }
  }
}

DEV void ph_final(const P& p) {
  const int lane = tid_() & 63;
  int r0, r1;
  wave_range(r0, r1, NB * T);
  float gv[16];
#pragma unroll
  for (int hh = 0; hh < 2; ++hh)
#pragma unroll
    for (int i = 0; i < 8; ++i) gv[hh * 8 + i] = p.final_g[hh * 512 + 8 * lane + i];
  auto xrow = [&](int r) -> const bf16_t* { const int b = r / T, t = r % T; return p.X + ((size_t)b * LT + LC + t) * D; };
  uint4 n0 = make_uint4(0, 0, 0, 0), n1 = n0;
  if (r0 < r1) { const bf16_t* xr = xrow(r0); n0 = *(const uint4*)(xr + 8 * lane); n1 = *(const uint4*)(xr + 512 + 8 * lane); }
#pragma unroll 1
  for (int r = r0; r < r1; ++r) {
    const uint4 u0 = n0, u1 = n1;
    if (r + 1 < r1) { const bf16_t* xr = xrow(r + 1); n0 = *(const uint4*)(xr + 8 * lane); n1 = *(const uint4*)(xr + 512 + 8 * lane); }
    float v[16];
    unpack8(u0, v); unpack8(u1, v + 8);
    float ss = 0.f;
#pragma unroll
    for (int i = 0; i < 16; ++i) ss += v[i] * v[i];
    ss = wave_sum(ss);
    const float rstd = rsqrtf(ss * (1.f / 1024.f) + 1e-6f);
    float* o = p.out + (size_t)r * D;
#pragma unroll
    for (int hh = 0; hh < 2; ++hh) {
      const int col = hh * 512 + 8 * lane;
      *(float4*)(o + col) = make_float4(v[hh * 8 + 0] * rstd * gv[hh * 8 + 0], v[hh * 8 + 1] * rstd * gv[hh * 8 + 1], v[hh * 8 + 2] * rstd * gv[hh * 8 + 2], v[hh * 8 + 3] * rstd * gv[hh * 8 + 3]);
      *(float4*)(o + col + 4) = make_float4(v[hh * 8 + 4] * rstd * gv[hh * 8 + 4], v[hh * 8 + 5] * rstd * gv[hh * 8 + 5], v[hh * 8 + 6] * rstd * gv[hh * 8 + 6], v[hh * 8 + 7] * rstd * gv[hh * 8 + 7]);
    }
  }
}

DEV unsigned hw_cu_key() {
  const unsigned hwid = (unsigned)__builtin_amdgcn_s_getreg(((8 - 1) << 11) | (8 << 6) | 4);
  return (xb_xcc_id() << 8) | (hwid & 0xFFu);
}
DEV void mixB(const P& p, int layer, char* smem, volatile LAS unsigned* slot) {
  unsigned* qa = p.wq + layer * 64;
  unsigned* qs = qa + 16;
  unsigned* claim = p.cuclaim + layer * 4096;
  __syncthreads();
  if (tid_() == 0) {
    unsigned u = 0xFFFFFFFFu;
    if (atomicAdd(&claim[hw_cu_key() & 4095u], 1u) == 0u) u = atomicAdd(qs, 1u);
    *slot = u;
  }
  __syncthreads();
  {
    const unsigned u = *slot;
    if (u < 128u) scanc_unit(p, layer, (int)u, smem);
  }
  for (;;) {
    __syncthreads();
    if (tid_() == 0) *slot = atomicAdd(qa, 1u);
    __syncthreads();
    const int u = (int)*slot;
    if (u >= 8704) break;
    if (u < 4352) attn_unit(p, layer, u, smem); else hyena_conv_unit(p, layer, u - 4352, smem);
  }
  if (layer + 1 < DEPTH) {
    unsigned* qp = qa + 32;
    for (;;) {
      __syncthreads();
      if (tid_() == 0) *slot = atomicAdd(qp, 1u);
      __syncthreads();
      const int u = (int)*slot;
      if (u >= PREPA_N) break;
      prep_unit(p, layer + 1, prepA_unit_index(u), smem);
    }
  }
  for (;;) {
    __syncthreads();
    if (tid_() == 0) *slot = atomicAdd(qs, 1u);
    __syncthreads();
    const unsigned u = *slot;
    if (u >= 128u) break;
    scanc_unit(p, layer, (int)u, smem);
  }
}
DEV void mixA(const P& p, int layer, char* smem) {
  for (int u = bid_(); u < 1088; u += gridDim.x) hyena_pre_unit(p, layer, u);
  for (int u = bid_(); u < 512; u += gridDim.x) hyena_scale_unit(p, layer, u, smem);
  ph_lora(p, layer, smem);
  ph_rwkv_prep(p, layer);
}
DEV void mixC(const P& p, int layer, char* smem) {
  for (int u = bid_(); u < 1088; u += gridDim.x) hyena_post_unit(p, layer, u, smem);
  ph_rwkv_post(p, layer);
  ph_attn_post(p, layer);
}

__global__ void __launch_bounds__(256, 2) k_mega(P p) {
  extern __shared__ __attribute__((aligned(16))) char smem_all[];
  char* smem = smem_all;
  volatile LAS unsigned* xbw = (volatile LAS unsigned*)(smem_all + SMEM_BYTES);
  if (threadIdx.x == 0) { xbw[0] = 0u; xbw[1] = 0u; xbw[2] = 0u; xbw[3] = 0u; }
  __syncthreads();
  XcdBarrier bar = xcd_barrier_post(p.bar, xbw);
  ph_rope(p);
  for (int u = blockIdx.x; u < 96; u += gridDim.x) modv_unit(p, u, smem);
  ph_prep(p, 0, smem, false);
  xcd_barrier(bar);
  for (int layer = 0; layer < DEPTH; ++layer) {
    if (layer == 0) ph_norm_first(p); else ph_norm(p, layer, 0);
    xcd_barrier(bar);
    ph_gemm1(p, smem);
    xcd_barrier(bar);
    mixA(p, layer, smem);
    xcd_barrier(bar);
    mixB(p, layer, smem, (volatile LAS unsigned*)(smem_all + SMEM_BYTES + 16));
    xcd_barrier(bar);
    mixC(p, layer, smem);
    xcd_barrier(bar);
    ph_gemm2(p, layer, smem);
    ph_peerconv(p, layer);
    xcd_barrier(bar);
    ph_norm(p, layer, 1);
    xcd_barrier(bar);
    ph_gemm3(p, smem);
    xcd_barrier(bar);
    ph_peer_gather<0>(p, layer, smem, (volatile LAS unsigned*)(smem_all + SMEM_BYTES + 16));
    xcd_barrier(bar);
    ph_peer_w(p);
    xcd_barrier(bar);
    ph_peer_gather<1>(p, layer, smem, (volatile LAS unsigned*)(smem_all + SMEM_BYTES + 16));
    if (layer + 1 < DEPTH) ph_prep(p, layer + 1, smem, true);
    xcd_barrier(bar);
  }
  ph_final(p);
}

static inline size_t al256(size_t x) { return (x + 255) & ~(size_t)255; }

extern "C" void kernel_launch(void* const* d_in, const int* in_sizes, int n_in, void* d_out, int out_size, void* d_ws, size_t ws_size,
                              hipStream_t stream) {
  (void)in_sizes; (void)n_in; (void)out_size; (void)ws_size;
  P p{};
  const float** f = (const float**)&p;
  for (int i = 0; i < 39; ++i) f[i] = (const float*)d_in[i];
  p.out = (float*)d_out;
  char* w = (char*)d_ws;
  size_t off = 0;
  auto take = [&](size_t bytes) { char* r = w + off; off += al256(bytes); return r; };
  p.bar = (unsigned*)take(16384);
  p.modv = (float*)take((size_t)DEPTH * 17 * 6144 * 4);
  p.SSQ = (float*)take((size_t)DEPTH * 2 * 256 * 4);
  p.wq = (unsigned*)take(4096 + DEPTH * 1024);
  p.cuclaim = (unsigned*)take((size_t)DEPTH * 4096 * 4);
  const size_t zero_bytes = off;
  p.rope = (float*)take(64 * 16 * 2 * 4);
  p.X = (bf16_t*)take((size_t)NTOK * D * 2);
  p.H = (bf16_t*)take((size_t)NTOK * D * 2);
  p.Y = (bf16_t*)take((size_t)NTOK * D * 2);
  p.SC = (bf16_t*)take((size_t)NTOK * 1024 * 2);
  p.Z = (bf16_t*)take((size_t)NTOK * INW * 2);
  p.UTl = (bf16_t*)take((size_t)256 * 16 * T * 2);
  p.UTc = (bf16_t*)take((size_t)256 * 16 * LC * 2);
  p.YTl = (bf16_t*)take((size_t)256 * 16 * T * 2);
  p.YTc = (bf16_t*)take((size_t)256 * 16 * LC * 2);
  p.FL = (float*)take((size_t)256 * 2 * T * 4);
  p.FC = (float*)take((size_t)256 * 2 * LC * 4);
  p.W1t = (bf16_t*)take((size_t)INW * D * 2);
  p.W2t = (bf16_t*)take((size_t)D * D * 2);
  p.Wft = (bf16_t*)take((size_t)2048 * D * 2);
  p.Wlt = (bf16_t*)take((size_t)1024 * 256 * 2);
  p.Wgt = (bf16_t*)take((size_t)256 * 128 * 2);
  p.TK = (float*)p.Z;
  p.PU = (unsigned char*)p.Z + al256((size_t)NTOK * 256 * 4);
  p.PV = p.PU + (size_t)16384 * 1024;
  p.PSU = (float*)(p.PV + (size_t)16384 * 1024);
  p.PSV = p.PSU + 16384;
  p.GT = p.PSV + 16384;
  p.EL = (unsigned short*)(p.GT + (size_t)NTOK * 128);
  p.H8 = (unsigned char*)p.EL + al256((size_t)NTOK * 128 * 2);
  p.HINV = (float*)(p.H8 + (size_t)NTOK * 1024);
  p.GW = (bf16_t*)((char*)p.HINV + al256((size_t)NTOK * 4));
  p.PD = p.Y;

  (void)hipMemsetAsync(d_ws, 0, zero_bytes, stream);
  constexpr size_t kDynLds = SMEM_BYTES + 32;
  static int grid = 0;
  if (!grid) {
    int dev = 0, cus = 0, per_cu = 0;
    (void)hipGetDevice(&dev);
    (void)hipDeviceGetAttribute(&cus, hipDeviceAttributeMultiprocessorCount, dev);
    (void)hipFuncSetAttribute((const void*)k_mega, hipFuncAttributeMaxDynamicSharedMemorySize, (int)kDynLds);
    (void)hipOccupancyMaxActiveBlocksPerMultiprocessor(&per_cu, k_mega, 256, kDynLds);
    if (cus <= 0) cus = 256;
    if (per_cu > 2) per_cu = 2;
    if (per_cu < 1) per_cu = 1;
    grid = cus * per_cu;
  }
  k_mega<<<grid, 256, kDynLds, stream>>>(p);
}
```

```cpp
#include <hip/hip_runtime.h>
#include <stdint.h>
#include <type_traits>

#define DEV __device__ __forceinline__
typedef unsigned short bf16_t;
typedef short bf16x8 __attribute__((ext_vector_type(8)));
typedef float f32x2 __attribute__((ext_vector_type(2)));
constexpr size_t PSLICE = (size_t)16384 * 128;
typedef float f32x4 __attribute__((ext_vector_type(4)));
typedef float f32x16 __attribute__((ext_vector_type(16)));


constexpr int NB = 16, T = 4096, LC = 256, LT = 4352, D = 1024, NTOK = NB * LT, INW = 2688, DEPTH = 4;
constexpr int SMEM_BYTES = 65536;

struct P {
  const float *x, *c, *ctx, *c_ctx, *mod_w, *mod_b, *norm1_g, *norm2_g, *w_in, *conv_w, *conv_b;
  const float *hy_w1, *hy_b1, *hy_w2, *hy_b2, *hy_w3, *hy_b3, *hy_freq, *hy_bias;
  const float *rw_w0, *rw_w_up, *rw_a0, *rw_a_up, *rw_g_up, *rw_k_k, *rw_k_a, *rw_r_k, *rw_ln_w, *rw_ln_b;
  const float *attn_sink, *hy_out_g, *at_out_g, *w_out, *peer_wq, *peer_k1, *peer_k2, *peer_u, *peer_v, *final_g;
  float* out;
  unsigned* bar;
  float *modv, *SSQ, *rope, *FL, *FC, *TK;
  unsigned *wq, *cuclaim;
  bf16_t *X, *H, *Y, *SC, *Z, *UTl, *UTc, *YTl, *YTc;
  bf16_t *W1t, *W2t, *Wft, *Wlt, *Wgt;
  unsigned char *PU, *PV;
  float *PSU, *PSV, *GT, *HINV;
  bf16_t *PD, *GW;
  unsigned short* EL;
  unsigned char* H8;
};

typedef __bf16 hwbf2 __attribute__((ext_vector_type(2)));
DEV unsigned pack2(float a, float b) { f32x2 f = {a, b}; hwbf2 r = __builtin_convertvector(f, hwbf2); return __builtin_bit_cast(unsigned, r); }
DEV bf16_t f2bf(float f) { return (bf16_t)(pack2(f, 0.f) & 0xFFFFu); }
DEV float bf2f(bf16_t h) { return __uint_as_float(((unsigned)h) << 16); }
DEV float bflo(unsigned u) { return __uint_as_float(u << 16); }
DEV float bfhi(unsigned u) { return __uint_as_float(u & 0xFFFF0000u); }
DEV void unpack8(const uint4& u, float* v) {
  v[0] = bflo(u.x); v[1] = bfhi(u.x); v[2] = bflo(u.y); v[3] = bfhi(u.y);
  v[4] = bflo(u.z); v[5] = bfhi(u.z); v[6] = bflo(u.w); v[7] = bfhi(u.w);
}
DEV uint4 pack8(const float* v) { return make_uint4(pack2(v[0], v[1]), pack2(v[2], v[3]), pack2(v[4], v[5]), pack2(v[6], v[7])); }
DEV int pack_i8(float a, float b, float c, float d) {
  const int ia = __float2int_rn(a), ib = __float2int_rn(b), ic = __float2int_rn(c), id = __float2int_rn(d);
  return (ia & 0xFF) | ((ib & 0xFF) << 8) | ((ic & 0xFF) << 16) | ((id & 0xFF) << 24);
}
DEV float sigmoidf_(float x) { return __builtin_amdgcn_rcpf(1.f + __expf(-x)); }

template <int CTRL, int ROWMASK>
DEV float dpp0(float x) {
  return __builtin_bit_cast(float, __builtin_amdgcn_update_dpp(0, __builtin_bit_cast(int, x), CTRL, ROWMASK, 0xF, false));
}
template <int CTRL, int ROWMASK>
DEV float dppself(float x) {
  int xi = __builtin_bit_cast(int, x);
  return __builtin_bit_cast(float, __builtin_amdgcn_update_dpp(xi, xi, CTRL, ROWMASK, 0xF, false));
}
DEV float readlane_f(float x, int l) { return __builtin_bit_cast(float, __builtin_amdgcn_readlane(__builtin_bit_cast(int, x), l)); }
DEV int lane_id() { return (int)__builtin_amdgcn_mbcnt_hi(~0u, __builtin_amdgcn_mbcnt_lo(~0u, 0u)); }
DEV float writelane_f(float val, int l, float old) { return lane_id() == l ? val : old; }
DEV int writelane_i(int val, int l, int old) { return lane_id() == l ? val : old; }
DEV float wave_sum(float x) {
  x += dpp0<0x111, 0xF>(x); x += dpp0<0x112, 0xF>(x); x += dpp0<0x114, 0xF>(x); x += dpp0<0x118, 0xF>(x);
  x += dpp0<0x142, 0xA>(x); x += dpp0<0x143, 0xC>(x);
  return readlane_f(x, 63);
}
DEV float wave_max(float x) {
  x = fmaxf(x, dppself<0x111, 0xF>(x)); x = fmaxf(x, dppself<0x112, 0xF>(x)); x = fmaxf(x, dppself<0x114, 0xF>(x));
  x = fmaxf(x, dppself<0x118, 0xF>(x)); x = fmaxf(x, dppself<0x142, 0xA>(x)); x = fmaxf(x, dppself<0x143, 0xC>(x));
  return readlane_f(x, 63);
}
DEV float row16_sum(float x) {
  x += dpp0<0xB1, 0xF>(x); x += dpp0<0x4E, 0xF>(x); x += dpp0<0x141, 0xF>(x); x += dpp0<0x140, 0xF>(x);
  return x;
}
DEV float row16_max(float x) {
  x = fmaxf(x, dppself<0xB1, 0xF>(x)); x = fmaxf(x, dppself<0x4E, 0xF>(x)); x = fmaxf(x, dppself<0x141, 0xF>(x));
  x = fmaxf(x, dppself<0x140, 0xF>(x));
  return x;
}
DEV float quad_sum(float x) { x += dpp0<0xB1, 0xF>(x); x += dpp0<0x4E, 0xF>(x); return x; }

DEV f32x4 mfma16(bf16x8 a, bf16x8 b, f32x4 c) { return __builtin_amdgcn_mfma_f32_16x16x32_bf16(a, b, c, 0, 0, 0); }
DEV f32x16 mfma32(bf16x8 a, bf16x8 b, f32x16 c) { return __builtin_amdgcn_mfma_f32_32x32x16_bf16(a, b, c, 0, 0, 0); }


#define XB_TMO      128
#define XB_XCNT(j)  (256  + 64 * (j))
#define XB_XSUB(j)  (1280 + 64 * (j))
#define XB_XGEN(j)  (2304 + 64 * (j))
#define XB_TOP      3328
#define XB_TOPGEN   3392
#define XCD_BAR_WORDS 3456
#define XB_SPIN_CAP (1u << 23)
#define LAS __attribute__((address_space(3)))

__device__ __forceinline__ unsigned xb_ld(unsigned* p)              { return __hip_atomic_load(p, __ATOMIC_RELAXED, __HIP_MEMORY_SCOPE_AGENT); }
__device__ __forceinline__ unsigned xb_add(unsigned* p, unsigned v) { return __hip_atomic_fetch_add(p, v, __ATOMIC_RELAXED, __HIP_MEMORY_SCOPE_AGENT); }
__device__ __forceinline__ unsigned xb_xcc_id() { return (unsigned)__builtin_amdgcn_s_getreg((3 << 11) | 20) & 0xFu; }
#define XB_SPIN(cond, bar) do { unsigned _sp = 0; while (cond) { __builtin_amdgcn_s_sleep(1); \
    if ((++_sp & 255u) == 0u) { if (xb_ld(&(bar)[XB_TMO])) break; if (_sp > XB_SPIN_CAP) { atomicAdd(&(bar)[XB_TMO], 1u); break; } } } } while (0)

struct XcdBarrier {
    unsigned* bar; unsigned x;
    volatile LAS unsigned* st;
};
__device__ __forceinline__ XcdBarrier xcd_barrier_post(unsigned* bar, volatile LAS unsigned* st) {
    XcdBarrier b; b.bar = bar; b.x = xb_xcc_id(); b.st = st;
    if (threadIdx.x == 0) (void)xb_add(&bar[XB_XCNT(b.x)], 1u);
    return b;
}
__device__ __forceinline__ void xcd_barrier_complete(unsigned* bar, unsigned x, unsigned& nloc, unsigned& nx) {
    const unsigned G = gridDim.x * gridDim.y * gridDim.z;
    unsigned sum, cnt, mine, sp = 0u;
    for (;;) {
        sum = 0u; cnt = 0u; mine = 0u;
#pragma unroll
        for (unsigned j = 0; j < 16; ++j) { const unsigned c = xb_ld(&bar[XB_XCNT(j)]); sum += c; cnt += (c > 0u) ? 1u : 0u; mine = (j == x) ? c : mine; }
        if (sum == G) break;
        __builtin_amdgcn_s_sleep(1);
        if ((++sp & 255u) == 0u) { if (xb_ld(&bar[XB_TMO])) break; if (sp > XB_SPIN_CAP) { atomicAdd(&bar[XB_TMO], 1u); break; } }
    }
    nloc = mine > 0u ? mine : 1u; nx = cnt > 0u ? cnt : 1u;
}
__device__ __forceinline__ void xcd_barrier(const XcdBarrier& b) {
    asm volatile("s_waitcnt vmcnt(0)" ::: "memory");
    __syncthreads();
    if (threadIdx.x == 0) {
        unsigned* bar = b.bar;
        __builtin_amdgcn_s_waitcnt(0);
        unsigned nloc = b.st[0], nx = b.st[1];
        if (nloc == 0u) { xcd_barrier_complete(bar, b.x, nloc, nx); b.st[0] = nloc; b.st[1] = nx; }
        const unsigned old = xb_add(&bar[XB_XSUB(b.x)], 1u);
        const unsigned gen = old / nloc;
        if (old + 1u == (gen + 1u) * nloc) {
            __builtin_amdgcn_fence(__ATOMIC_RELEASE, "agent");
            asm volatile("s_waitcnt vmcnt(0)" ::: "memory");
            const unsigned og = xb_add(&bar[XB_TOP], 1u);
            const unsigned tg = og / nx;
            if (og + 1u == (tg + 1u) * nx) xb_add(&bar[XB_TOPGEN], 1u);
            else XB_SPIN(xb_ld(&bar[XB_TOPGEN]) == tg, bar);
            __builtin_amdgcn_fence(__ATOMIC_ACQUIRE, "agent");
            xb_add(&bar[XB_XGEN(b.x)], 1u);
            asm volatile("s_waitcnt vmcnt(0)" ::: "memory");
        } else {
            XB_SPIN(xb_ld(&bar[XB_XGEN(b.x)]) == gen, bar);
            __builtin_amdgcn_fence(__ATOMIC_ACQUIRE, "agent");
            asm volatile("s_waitcnt vmcnt(0)" ::: "memory");
        }
    }
    __syncthreads();
}

template <class Tp> DEV Tp* opq(Tp* q) { asm volatile("" : "+s"(q)); return q; }
DEV int tid_() { int t = threadIdx.x; asm volatile("" : "+v"(t)); return t; }
DEV int bid_() { int b = blockIdx.x; asm volatile("" : "+s"(b)); return b; }

DEV void glds16(const void* gsrc, char* lds_lane_ptr) {
  __builtin_amdgcn_global_load_lds((const unsigned*)gsrc, (__attribute__((address_space(3))) unsigned*)lds_lane_ptr, 16, 0, 0);
}
template <class Epi>
DEV void gemm_tile(const bf16_t* __restrict__ A, int lda, const bf16_t* __restrict__ Bt, int ldb, int K, char* smem, Epi& epi) {
  const int tid = tid_(), lane = tid & 63, wid = tid >> 6, wr = wid >> 1, wc = wid & 1, fr = lane & 15, fq = lane >> 4;
  f32x4 acc[4][4];
#pragma unroll
  for (int m = 0; m < 4; ++m)
#pragma unroll
    for (int n = 0; n < 4; ++n) acc[m][n] = (f32x4){0.f, 0.f, 0.f, 0.f};
  const int drow0 = 8 * wid + (lane >> 3), dpc = lane & 7;
  auto issue = [&](int kt, int buf) {
    char* sa = smem + buf * 32768;
    char* sb = sa + 16384;
#pragma unroll
    for (int i = 0; i < 4; ++i) {
      const int row = drow0 + 32 * i;
      const int kc = dpc ^ ((row >> 1) & 7);
      glds16(A + (size_t)row * lda + kt * 64 + kc * 8, sa + (i * 4 + wid) * 1024 + lane * 16);
      glds16(Bt + (size_t)row * ldb + kt * 64 + kc * 8, sb + (i * 4 + wid) * 1024 + lane * 16);
    }
  };
  __syncthreads();
  issue(0, 0);
  const int nk = K >> 6;
  const int sw = (fr >> 1) & 7;
  const int aoff = (wr * 64 + fr) * 128, boff = (wc * 64 + fr) * 128;
  for (int kt = 0; kt < nk; ++kt) {
    asm volatile("s_waitcnt vmcnt(0)" ::: "memory");
    __syncthreads();
    if (kt + 1 < nk) issue(kt + 1, (kt + 1) & 1);
    const char* sa = smem + (kt & 1) * 32768;
    const char* sb = sa + 16384;
#pragma unroll
    for (int kh = 0; kh < 2; ++kh) {
      const int pc = ((kh * 4 + fq) ^ sw) * 16;
      bf16x8 af[4], bfr[4];
#pragma unroll
      for (int m = 0; m < 4; ++m) af[m] = *(const bf16x8*)(sa + aoff + m * 2048 + pc);
#pragma unroll
      for (int n = 0; n < 4; ++n) bfr[n] = *(const bf16x8*)(sb + boff + n * 2048 + pc);
#pragma unroll
      for (int m = 0; m < 4; ++m)
#pragma unroll
        for (int n = 0; n < 4; ++n) acc[m][n] = mfma16(bfr[n], af[m], acc[m][n]);
    }
  }
  __syncthreads();
  epi(acc, wr, wc, fr, fq, smem);
}
DEV void stage_tile_bf16(const f32x4 (&acc)[4][4], char* smem, int wid, int fr, int fq) {
  bf16_t (*t)[72] = (bf16_t (*)[72])(smem + wid * 9216);
#pragma unroll
  for (int m = 0; m < 4; ++m)
#pragma unroll
    for (int n = 0; n < 4; ++n)
      *(uint2*)&t[m * 16 + fr][n * 16 + 4 * fq] = make_uint2(pack2(acc[m][n][0], acc[m][n][1]), pack2(acc[m][n][2], acc[m][n][3]));
  asm volatile("s_waitcnt lgkmcnt(0)" ::: "memory");
}

DEV void ph_copy(const P& p) {
  const size_t n8 = (size_t)NTOK * D / 8;
  const float* pctx = opq(p.ctx); const float* px = opq(p.x);
  for (size_t i = (size_t)bid_() * 256 + tid_(); i < n8; i += (size_t)gridDim.x * 256) {
    size_t e = i * 8;
    int row = (int)(e / D), col = (int)(e % D);
    int b = row / LT, pp = row % LT;
    const float* src = pp < LC ? pctx + ((size_t)(b * LC + pp)) * D + col : px + ((size_t)(b * T + pp - LC)) * D + col;
    float4 v0 = *(const float4*)src, v1 = *(const float4*)(src + 4);
    uint4 o = make_uint4(pack2(v0.x, v0.y), pack2(v0.z, v0.w), pack2(v1.x, v1.y), pack2(v1.z, v1.w));
    *(uint4*)(p.X + e) = o;
  }
}

DEV void ph_rope(const P& p) {
  for (int i = bid_() * 256 + tid_(); i < 64 * 16; i += gridDim.x * 256) {
    int pos = i >> 4, k = i & 15;
    float inv = powf(10000.f, -(float)k / 16.f);
    float ang = (float)pos * inv;
    p.rope[2 * i] = cosf(ang); p.rope[2 * i + 1] = sinf(ang);
  }
}

DEV void modv_unit(const P& p, int unit, char* smem) {
  const int cc = unit % 24, layer = unit / 24;
  float (*cs)[128] = (float (*)[128])smem;
  const int col = cc * 256 + tid_();
  const float* pc = opq(p.c); const float* pcc = opq(p.c_ctx);
  float acc[17];
#pragma unroll
  for (int r = 0; r < 17; ++r) acc[r] = 0.f;
  for (int ks = 0; ks < 8; ++ks) {
    __syncthreads();
    for (int i = tid_(); i < 17 * 128; i += 256) {
      int r = i >> 7, e = i & 127;
      float v = r < 16 ? pc[r * D + ks * 128 + e] : pcc[ks * 128 + e];
      cs[r][e] = v / (1.f + expf(-v));
    }
    __syncthreads();
    const float* w = p.mod_w + ((size_t)layer * D + ks * 128) * 6144 + col;
#pragma unroll 1
    for (int e0 = 0; e0 < 128; e0 += 32) {
      float wv[32];
#pragma unroll
      for (int q = 0; q < 32; ++q) wv[q] = w[(size_t)(e0 + q) * 6144];
#pragma unroll
      for (int q4 = 0; q4 < 8; ++q4) {
      const int e = e0 + 4 * q4;
      const float w0 = wv[4 * q4], w1 = wv[4 * q4 + 1], w2 = wv[4 * q4 + 2], w3 = wv[4 * q4 + 3];
#pragma unroll
      for (int r = 0; r < 17; ++r) {
        const float4 cv = *(const float4*)&cs[r][e];
        acc[r] += cv.x * w0 + cv.y * w1 + cv.z * w2 + cv.w * w3;
      }
      }
    }
  }
  const float bias = p.mod_b[layer * 6144 + col];
#pragma unroll
  for (int r = 0; r < 17; ++r) p.modv[((size_t)layer * 17 + r) * 6144 + col] = acc[r] + bias;
}

DEV void transpose_unit(const float* __restrict__ src, bf16_t* __restrict__ dst, int R, int C, int tile, char* smem) {
  float (*t)[65] = (float (*)[65])smem;
  const int nct = C / 64;
  const int tr = tile / nct, tc = tile % nct;
  __syncthreads();
  for (int i = tid_(); i < 4096; i += 256) { int r = i >> 6, c = i & 63; t[r][c] = src[(size_t)(tr * 64 + r) * C + tc * 64 + c]; }
  __syncthreads();
  for (int i = tid_(); i < 4096; i += 256) { int c = i >> 6, r = i & 63; dst[(size_t)(tc * 64 + c) * R + tr * 64 + r] = f2bf(t[r][c]); }
}

DEV void wfold_unit(const P& p, int layer, int unit, char* smem) {
  const int hs = unit >> 5, ec = unit & 31, h = hs >> 1, s = hs & 1;
  const float* wq = p.peer_wq + (size_t)layer * D * 2048;
  const float* kk = (s ? opq(p.peer_k2) : opq(p.peer_k1)) + ((size_t)layer * 8 + h) * 128 * 128;
  float (*kS)[65] = (float (*)[65])smem;
  float (*wS)[64] = (float (*)[64])(smem + 33280);
  const int key = tid_() & 127, eh = tid_() >> 7;
  float acc[16];
#pragma unroll
  for (int i = 0; i < 16; ++i) acc[i] = 0.f;
  for (int dh = 0; dh < 2; ++dh) {
    __syncthreads();
    for (int i = tid_(); i < 128 * 64; i += 256) { int k2 = i >> 6, d = i & 63; kS[k2][d] = kk[k2 * 128 + dh * 64 + d]; }
    for (int i = tid_(); i < 32 * 64; i += 256) {
      int e = i >> 6, d = i & 63;
      wS[e][d] = wq[(size_t)(ec * 32 + e) * 2048 + h * 256 + s * 128 + dh * 64 + d];
    }
    __syncthreads();
#pragma unroll 2
    for (int d = 0; d < 64; d += 4) {
      const float k0 = kS[key][d], k1 = kS[key][d + 1], k2 = kS[key][d + 2], k3 = kS[key][d + 3];
#pragma unroll
      for (int i = 0; i < 16; ++i) {
        const float4 wv = *(const float4*)&wS[eh * 16 + i][d];
        acc[i] += k0 * wv.x + k1 * wv.y + k2 * wv.z + k3 * wv.w;
      }
    }
  }
  bf16_t* dst = p.Wft + ((size_t)(hs * 128 + key)) * D + ec * 32 + eh * 16;
#pragma unroll
  for (int i = 0; i < 16; i += 2) *(unsigned*)(dst + i) = pack2(acc[i], acc[i + 1]);
}

DEV void filt_unit(const P& p, int layer, int unit, char* smem) {
  int kind, j0, L;
  if (unit < 1024) { kind = 0; j0 = unit * 4; L = T; } else { kind = 1; j0 = (unit - 1024) * 4; L = LC; }
  float* zs = (float*)smem;
  float* h1 = zs + 4 * 36;
  float* h2 = h1 + 256;
  const int jj = tid_() >> 6, o = tid_() & 63;
  const int j = j0 + jj;
  const float fj = (float)j;
  const float t = fj / (float)(L - 1);
  __syncthreads();
  if (o < 33) {
    float z;
    if (o == 0) z = t;
    else {
      int i = (o - 1) & 15;
      float band = 1e-4f + (float)i * ((15.0f - 1e-4f) / 15.0f);
      float ang = 6.283185307179586f * fj * band / (float)L;
      z = (o <= 16) ? cosf(ang) : -sinf(ang);
    }
    zs[jj * 36 + o] = z;
  }
  __syncthreads();
  {
    const float* w1 = p.hy_w1 + layer * 33 * 64;
    float a = p.hy_b1[layer * 64 + o];
#pragma unroll 3
    for (int i = 0; i < 33; ++i) a += zs[jj * 36 + i] * w1[i * 64 + o];
    h1[jj * 64 + o] = sinf(p.hy_freq[layer * 128 + o] * a);
  }
  __syncthreads();
  {
    const float* w2 = p.hy_w2 + layer * 64 * 64;
    float a = p.hy_b2[layer * 64 + o];
#pragma unroll 4
    for (int i = 0; i < 64; ++i) a += h1[jj * 64 + i] * w2[i * 64 + o];
    h2[jj * 64 + o] = sinf(p.hy_freq[layer * 128 + 64 + o] * a);
  }
  __syncthreads();
  const float* w3 = p.hy_w3 + layer * 64 * 512;
  float* F = kind ? opq(p.FC) : opq(p.FL);
  const float DMIN = -3.0701134573253945f, DMAX = -15.350567286626973f;
#pragma unroll 1
  for (int m = 0; m < 4; ++m) {
    int c = o + 64 * m;
    float af = p.hy_b3[layer * 512 + c], ab = p.hy_b3[layer * 512 + 256 + c];
#pragma unroll 4
    for (int i = 0; i < 64; ++i) { float hv = h2[jj * 64 + i]; af += hv * w3[i * 512 + c]; ab += hv * w3[i * 512 + 256 + c]; }
    float delta = fabsf(DMIN + (float)c * ((DMAX - DMIN) / 255.f));
    float win = expf(-t * delta) + 0.05f;
    af *= win; ab *= win;
    F[((size_t)c * 2 + 0) * L + j] = af;
    F[((size_t)c * 2 + 1) * L + j] = ab;
  }
}

constexpr int PREP_T0 = 672, PREP_T1 = PREP_T0 + 256, PREP_T2 = PREP_T1 + 8, PREP_T3 = PREP_T2 + 8, PREP_T4 = PREP_T3 + 8;
constexpr int PREP_WF = PREP_T4 + 512, PREP_N = PREP_WF + 1088;
DEV void prep_unit(const P& p, int layer, int u, char* smem) {
  if (u < PREP_T0) transpose_unit(p.w_in + (size_t)layer * D * INW, p.W1t, D, INW, u, smem);
  else if (u < PREP_T1) transpose_unit(p.w_out + (size_t)layer * D * D, p.W2t, D, D, u - PREP_T0, smem);
  else if (u < PREP_T3) {
    const int u0 = u - PREP_T1;
    for (int i = tid_(); i < 64 * 256; i += 256) {
      const int np = u0 * 64 + (i >> 8), kp = i & 255;
      const int ps = np & 3, chan = np >> 2, qp = kp >> 6, kk = kp & 63;
      const int is_a = ps & 1, d = ps >> 1;
      float v = 0.f;
      if (qp == (is_a ? 2 + d : d)) v = (is_a ? opq(p.rw_a_up) : opq(p.rw_w_up))[(((size_t)layer * 2 + d) * 64 + kk) * 256 + chan];
      p.Wlt[(size_t)np * 256 + kp] = f2bf(v);
    }
  }
  else if (u < PREP_T4) transpose_unit(p.rw_g_up + (size_t)layer * 128 * 256, p.Wgt, 128, 256, u - PREP_T3, smem);
  else if (u < PREP_WF) wfold_unit(p, layer, u - PREP_T4, smem);
  else filt_unit(p, layer, u - PREP_WF, smem);
}
constexpr int PREPA_N = PREP_T0 + (PREP_T4 - PREP_T1);
DEV int prepA_unit_index(int i) { return i < PREP_T0 ? i : PREP_T1 + (i - PREP_T0); }
DEV void ph_prep(const P& p, int layer, char* smem, bool onlyB) {
  for (int u = bid_(); u < PREP_N; u += gridDim.x) {
    const bool isA = (u < PREP_T0) || (u >= PREP_T1 && u < PREP_T4);
    if (onlyB && isA) continue;
    prep_unit(p, layer, u, smem);
  }
}

DEV void wave_range(int& r0, int& r1, int ntok) {
  const int gw = (bid_() * 256 + tid_()) >> 6, nw = gridDim.x * 4;
  const int per = (ntok + nw - 1) / nw;
  r0 = gw * per; r1 = r0 + per; if (r1 > ntok) r1 = ntok;
}
DEV void ph_norm_first(const P& p) {
  const int lane = tid_() & 63;
  int r0, r1;
  wave_range(r0, r1, NTOK);
  const float* pctx = opq(p.ctx); const float* px = opq(p.x);
  float gv[16], scv[16], shv[16];
#pragma unroll
  for (int hh = 0; hh < 2; ++hh)
#pragma unroll
    for (int i = 0; i < 8; ++i) gv[hh * 8 + i] = p.norm1_g[hh * 512 + 8 * lane + i];
  int mr_cur = -1;
  auto srcrow = [&](int row) -> const float* {
    const int b = row / LT, pp = row % LT;
    return pp < LC ? pctx + ((size_t)(b * LC + pp)) * D : px + ((size_t)(b * T + pp - LC)) * D;
  };
  float4 n0, n1, n2, n3;
  auto ld = [&](int row) { const float* s0 = srcrow(row) + 8 * lane; n0 = *(const float4*)s0; n1 = *(const float4*)(s0 + 4); n2 = *(const float4*)(s0 + 512); n3 = *(const float4*)(s0 + 516); };
  if (r0 < r1) ld(r0);
#pragma unroll 1
  for (int row = r0; row < r1; ++row) {
    float v[16] = {n0.x, n0.y, n0.z, n0.w, n1.x, n1.y, n1.z, n1.w, n2.x, n2.y, n2.z, n2.w, n3.x, n3.y, n3.z, n3.w};
    if (row + 1 < r1) ld(row + 1);
    const int b = row / LT, pp = row % LT;
    const int mr = pp < LC ? 16 : b;
    if (mr != mr_cur) {
      mr_cur = mr;
      const float* mv = p.modv + (size_t)mr * 6144;
#pragma unroll
      for (int hh = 0; hh < 2; ++hh)
#pragma unroll
        for (int i = 0; i < 8; ++i) { shv[hh * 8 + i] = mv[hh * 512 + 8 * lane + i]; scv[hh * 8 + i] = 1.f + mv[1024 + hh * 512 + 8 * lane + i]; }
    }
    bf16_t* xr = p.X + (size_t)row * D;
    const uint4 x0 = pack8(v), x1 = pack8(v + 8);
    *(uint4*)(xr + 8 * lane) = x0;
    *(uint4*)(xr + 512 + 8 * lane) = x1;
    unpack8(x0, v); unpack8(x1, v + 8);
    float ss = 0.f;
#pragma unroll
    for (int i = 0; i < 16; ++i) ss += v[i] * v[i];
    ss = wave_sum(ss);
    const float rstd = rsqrtf(ss * (1.f / 1024.f) + 1e-6f);
    float o[16];
#pragma unroll
    for (int i = 0; i < 16; ++i) o[i] = (v[i] * rstd * gv[i]) * scv[i] + shv[i];
    bf16_t* hr = p.H + (size_t)row * D;
    *(uint4*)(hr + 8 * lane) = pack8(o);
    *(uint4*)(hr + 512 + 8 * lane) = pack8(o + 8);
  }
}
DEV void ph_norm(const P& p, int layer, int which) {
  const int lane = tid_() & 63;
  int r0, r1;
  wave_range(r0, r1, NTOK);
  const float* g = (which ? p.norm2_g : p.norm1_g) + layer * D;
  float gv[16], scv[16], shv[16];
#pragma unroll
  for (int hh = 0; hh < 2; ++hh)
#pragma unroll
    for (int i = 0; i < 8; ++i) gv[hh * 8 + i] = g[hh * 512 + 8 * lane + i];
  int mr_cur = -1;
  uint4 n0 = make_uint4(0, 0, 0, 0), n1 = n0;
  if (r0 < r1) { const bf16_t* xr = p.X + (size_t)r0 * D; n0 = *(const uint4*)(xr + 8 * lane); n1 = *(const uint4*)(xr + 512 + 8 * lane); }
#pragma unroll 1
  for (int row = r0; row < r1; ++row) {
    const uint4 u0 = n0, u1 = n1;
    if (row + 1 < r1) { const bf16_t* xr = p.X + (size_t)(row + 1) * D; n0 = *(const uint4*)(xr + 8 * lane); n1 = *(const uint4*)(xr + 512 + 8 * lane); }
    const int b = row / LT, pp = row % LT;
    const int mr = pp < LC ? 16 : b;
    if (mr != mr_cur) {
      mr_cur = mr;
      const float* mv = p.modv + ((size_t)layer * 17 + mr) * 6144 + (which ? 3072 : 0);
#pragma unroll
      for (int hh = 0; hh < 2; ++hh)
#pragma unroll
        for (int i = 0; i < 8; ++i) { shv[hh * 8 + i] = mv[hh * 512 + 8 * lane + i]; scv[hh * 8 + i] = 1.f + mv[1024 + hh * 512 + 8 * lane + i]; }
    }
    float v[16];
    unpack8(u0, v); unpack8(u1, v + 8);
    float ss = 0.f;
#pragma unroll
    for (int i = 0; i < 16; ++i) ss += v[i] * v[i];
    ss = wave_sum(ss);
    const float rstd = rsqrtf(ss * (1.f / 1024.f) + 1e-6f);
    float o[16];
#pragma unroll
    for (int i = 0; i < 16; ++i) o[i] = (v[i] * rstd * gv[i]) * scv[i] + shv[i];
    bf16_t* hr = p.H + (size_t)row * D;
    *(uint4*)(hr + 8 * lane) = pack8(o);
    *(uint4*)(hr + 512 + 8 * lane) = pack8(o + 8);
    if (which) {
      float am = 0.f;
#pragma unroll
      for (int i = 0; i < 16; ++i) am = fmaxf(am, fabsf(o[i]));
      am = wave_max(am);
      const float sc = am > 0.f ? 127.f / am : 1.f;
      unsigned char* h8 = p.H8 + (size_t)row * 1024;
      *(uint2*)(h8 + 8 * lane) = make_uint2((unsigned)pack_i8(o[0] * sc, o[1] * sc, o[2] * sc, o[3] * sc), (unsigned)pack_i8(o[4] * sc, o[5] * sc, o[6] * sc, o[7] * sc));
      *(uint2*)(h8 + 512 + 8 * lane) = make_uint2((unsigned)pack_i8(o[8] * sc, o[9] * sc, o[10] * sc, o[11] * sc), (unsigned)pack_i8(o[12] * sc, o[13] * sc, o[14] * sc, o[15] * sc));
      if (lane == 0) p.HINV[row] = am > 0.f ? am * (1.f / 127.f) : 1.f;
    }
  }
}

DEV bool gemm_unit(int it, int nct, int& rt, int& ct) {
  const int nslot = gridDim.x >> 3;
  const int x = bid_() & 7, sl = bid_() >> 3;
  if (sl >= nslot) return false;
  const int v = it * nslot + sl;
  if (v >= 68 * nct) return false;
  const int rg = v / (8 * nct), rem = v - rg * 8 * nct;
  const int rows = (rg == 8) ? 4 : 8;
  ct = rem / rows;
  rt = x * 68 + rg * 8 + (rem - ct * rows);
  return true;
}
struct Epi1 {
  const P& p; int row0, col0;
  DEV void operator()(f32x4 (&acc)[4][4], int wr, int wc, int fr, int fq, char* smem) const {
    const int cw = col0 + wc * 64;
    const int rbase = row0 + wr * 64;
    const bool lat = (row0 % LT) >= LC;
    if (cw >= 1536 && cw < 1664) {
#pragma unroll
      for (int m = 0; m < 4; ++m)
#pragma unroll
        for (int n = 0; n < 4; ++n)
#pragma unroll
          for (int j = 0; j < 4; ++j) acc[m][n][j] = 2.f * sigmoidf_(2.f * acc[m][n][j]) - 1.f;
    } else if (cw >= 1792 && cw < 1920) {
#pragma unroll
      for (int m = 0; m < 4; ++m)
#pragma unroll
        for (int n = 0; n < 4; ++n)
#pragma unroll
          for (int j = 0; j < 4; ++j) acc[m][n][j] = sigmoidf_(acc[m][n][j]);
    } else if (cw >= 1920 && cw < 2560 && lat) {
#pragma unroll
      for (int m = 0; m < 4; ++m) {
        const int row = rbase + m * 16 + fr;
        const int pl = (row % LT) - LC;
        const int ri = pl >> 6, ci = pl & 63;
        const float4* crp = (const float4*)(p.rope + 2 * (ri * 16 + 4 * fq));
        const float4* ccp = (const float4*)(p.rope + 2 * (ci * 16 + 4 * fq));
        const float4 cr0 = crp[0], cr1 = crp[1], cc0 = ccp[0], cc1 = ccp[1];
        const float crc[4] = {cr0.x, cr0.z, cr1.x, cr1.z}, crs[4] = {cr0.y, cr0.w, cr1.y, cr1.w};
        const float ccc[4] = {cc0.x, cc0.z, cc1.x, cc1.z}, ccs[4] = {cc0.y, cc0.w, cc1.y, cc1.w};
#pragma unroll
        for (int j = 0; j < 4; ++j) {
          float x1 = acc[m][0][j], x2 = acc[m][1][j];
          acc[m][0][j] = x1 * crc[j] - x2 * crs[j]; acc[m][1][j] = x2 * crc[j] + x1 * crs[j];
          x1 = acc[m][2][j]; x2 = acc[m][3][j];
          acc[m][2][j] = x1 * ccc[j] - x2 * ccs[j]; acc[m][3][j] = x2 * ccc[j] + x1 * ccs[j];
        }
      }
    }
    const int wid = wr * 2 + wc, lane = fq * 16 + fr;
    stage_tile_bf16(acc, smem, wid, fr, fq);
    const bf16_t (*t)[72] = (const bf16_t (*)[72])(smem + wid * 9216);
#pragma unroll
    for (int i = 0; i < 8; ++i) {
      const int rl = i * 8 + (lane >> 3), ch = lane & 7;
      *(uint4*)(p.Z + (size_t)(rbase + rl) * INW + cw + ch * 8) = *(const uint4*)&t[rl][ch * 8];
    }
  }
};
DEV void ph_gemm1(const P& p, char* smem) {
  const int nct = INW / 128;
  int rt, ct;
  for (int it = 0; gemm_unit(it, nct, rt, ct); ++it) {
    Epi1 epi{p, rt * 128, ct * 128};
    gemm_tile(p.H + (size_t)rt * 128 * D, D, p.W1t + (size_t)ct * 128 * D, D, D, smem, epi);
  }
}

struct EpiLoraA {
  const P& p; int layer, row0, col0;
  DEV void operator()(f32x4 (&acc)[4][4], int wr, int wc, int fr, int fq, char* smem) const {
    const float* w0b = p.rw_w0 + layer * 512;
    const float* a0b = p.rw_a0 + layer * 512;
#pragma unroll
    for (int n = 0; n < 4; ++n) {
      const int chan = ((col0 + wc * 64 + n * 16) >> 2) + fq;
      const float be0 = w0b[chan], ba0 = a0b[chan], be1 = w0b[256 + chan], ba1 = a0b[256 + chan];
#pragma unroll
      for (int m = 0; m < 4; ++m) {
        acc[m][n][0] = 0.6065306597126334f * sigmoidf_(acc[m][n][0] + be0);
        acc[m][n][1] = sigmoidf_(acc[m][n][1] + ba0);
        acc[m][n][2] = 0.6065306597126334f * sigmoidf_(acc[m][n][2] + be1);
        acc[m][n][3] = sigmoidf_(acc[m][n][3] + ba1);
      }
    }
    const int wid = wr * 2 + wc, lane = fq * 16 + fr;
    stage_tile_bf16(acc, smem, wid, fr, fq);
    const bf16_t (*t)[72] = (const bf16_t (*)[72])(smem + wid * 9216);
#pragma unroll
    for (int i = 0; i < 8; ++i) {
      const int rl = i * 8 + (lane >> 3), ch = lane & 7;
      *(uint4*)(p.SC + (size_t)(row0 + wr * 64 + rl) * 1024 + col0 + wc * 64 + ch * 8) = *(const uint4*)&t[rl][ch * 8];
    }
  }
};
struct EpiLoraG {
  const P& p; int row0, col0;
  DEV void operator()(f32x4 (&acc)[4][4], int wr, int wc, int fr, int fq, char* smem) const {
    const int wid = wr * 2 + wc, lane = fq * 16 + fr;
    stage_tile_bf16(acc, smem, wid, fr, fq);
    const bf16_t (*t)[72] = (const bf16_t (*)[72])(smem + wid * 9216);
#pragma unroll
    for (int i = 0; i < 8; ++i) {
      const int rl = i * 8 + (lane >> 3), ch = lane & 7;
      *(uint4*)(p.Y + (size_t)(row0 + wr * 64 + rl) * D + 256 + col0 + wc * 64 + ch * 8) = *(const uint4*)&t[rl][ch * 8];
    }
  }
};
DEV void ph_lora(const P& p, int layer, char* smem) {
  int rt, ct;
  for (int it = 0; gemm_unit(it, 10, rt, ct); ++it) {
    if (ct < 8) {
      EpiLoraA epi{p, layer, rt * 128, ct * 128};
      gemm_tile(p.Z + (size_t)rt * 128 * INW + 1536, INW, p.Wlt + (size_t)ct * 128 * 256, 256, 256, smem, epi);
    } else {
      EpiLoraG epi{p, rt * 128, (ct - 8) * 128};
      gemm_tile(p.Z + (size_t)rt * 128 * INW + 1792, INW, p.Wgt + (size_t)(ct - 8) * 128 * 128, 128, 128, smem, epi);
    }
  }
}

DEV void ph_rwkv_prep(const P& p, int layer) {
  const int lane = tid_() & 63;
  int r0, r1;
  wave_range(r0, r1, NTOK);
  const float* cw = p.conv_w + (size_t)layer * 3 * 1536;
  const float* cb = p.conv_b + (size_t)layer * 1536;
  float w0[3][4], w1[3][4], w2[3][4], bb[3][4], kkw[4];
#pragma unroll
  for (int a = 0; a < 3; ++a)
#pragma unroll
    for (int i = 0; i < 4; ++i) {
      const int col = 768 + a * 256 + 4 * lane + i;
      w0[a][i] = cw[col]; w1[a][i] = cw[1536 + col]; w2[a][i] = cw[3072 + col]; bb[a][i] = cb[col];
    }
#pragma unroll
  for (int i = 0; i < 4; ++i) kkw[i] = p.rw_k_k[layer * 256 + 4 * lane + i];
  uint2 zm[3], zc[3], zp[3];
  auto ldz = [&](int row, uint2 (&z)[3]) {
#pragma unroll
    for (int a = 0; a < 3; ++a) z[a] = *(const uint2*)(p.Z + (size_t)row * INW + 768 + a * 256 + 4 * lane);
  };
  auto zero3 = [&](uint2 (&z)[3]) {
#pragma unroll
    for (int a = 0; a < 3; ++a) z[a] = make_uint2(0u, 0u);
  };
  if (r0 < r1) {
    if (r0 > 0) ldz(r0 - 1, zm); else zero3(zm);
    ldz(r0, zc);
  }
#pragma unroll 1
  for (int row = r0; row < r1; ++row) {
    if (row + 1 < NTOK) ldz(row + 1, zp); else zero3(zp);
    const int pp = row % LT;
    const bool hasm = (pp != 0) && (pp != LC);
    const bool hasp = (pp != LC - 1) && (pp != LT - 1);
    float res[3][4];
#pragma unroll
    for (int a = 0; a < 3; ++a) {
      const uint2 um = hasm ? zm[a] : make_uint2(0u, 0u), uc = zc[a], up = hasp ? zp[a] : make_uint2(0u, 0u);
      const float vm[4] = {bflo(um.x), bfhi(um.x), bflo(um.y), bfhi(um.y)};
      const float vc[4] = {bflo(uc.x), bfhi(uc.x), bflo(uc.y), bfhi(uc.y)};
      const float vp[4] = {bflo(up.x), bfhi(up.x), bflo(up.y), bfhi(up.y)};
#pragma unroll
      for (int i = 0; i < 4; ++i) res[a][i] = w0[a][i] * vm[i] + w1[a][i] * vc[i] + w2[a][i] * vp[i] + bb[a][i];
    }
    float kk[4], ss = 0.f;
#pragma unroll
    for (int i = 0; i < 4; ++i) { kk[i] = res[1][i] * kkw[i]; ss += kk[i] * kk[i]; }
    ss = row16_sum(ss);
    const float rs = rsqrtf(ss + 1e-12f);
    bf16_t* hr = p.H + (size_t)row * D + 16 * lane;
    *(uint4*)hr = make_uint4(pack2(res[0][0], res[1][0]), pack2(kk[0] * rs, res[2][0]), pack2(res[0][1], res[1][1]), pack2(kk[1] * rs, res[2][1]));
    *(uint4*)(hr + 8) = make_uint4(pack2(res[0][2], res[1][2]), pack2(kk[2] * rs, res[2][2]), pack2(res[0][3], res[1][3]), pack2(kk[3] * rs, res[2][3]));
#pragma unroll
    for (int a = 0; a < 3; ++a) { zm[a] = zc[a]; zc[a] = zp[a]; }
  }
}

DEV float oct_sum(float x) { x += dpp0<0xB1, 0xF>(x); x += dpp0<0x4E, 0xF>(x); x += dpp0<0x141, 0xF>(x); return x; }
DEV bf16x8 frag_join(uint2 lo, uint2 hi) { uint4 w = make_uint4(lo.x, lo.y, hi.x, hi.y); return __builtin_bit_cast(bf16x8, w); }
constexpr int SCS_SET = 17152, SCS_IMG = 3 * SCS_SET, SCS_W0 = SCS_IMG + 2 * 3072;
DEV void scanc_unit(const P& p, int layer, int unit, char* smem) {
  const int dir = unit & 1, h = (unit >> 1) & 3, b = unit >> 3;
  const int tid = tid_(), lane = tid & 63, fr = lane & 15, fq = lane >> 4;
  const int w = __builtin_amdgcn_readfirstlane(tid >> 6);
  bf16_t* IMG0 = (bf16_t*)(smem + SCS_W0);
  bf16_t* IMG1 = IMG0 + 512;
  bf16_t* IMG2 = IMG0 + 1024;
  __syncthreads();
  for (int i = tid; i < (2 * 3072 + 3072) / 4; i += 256) ((unsigned*)(smem + SCS_IMG))[i] = 0u;
  const float ka = p.rw_k_a[layer * 256 + h * 64 + lane];
  const size_t rowbase = (size_t)b * LT;
  const char* hbase = (const char*)p.H;
  const char* sbase = (const char*)p.SC;
  const unsigned hoff = (unsigned)(rowbase * 2048) + (unsigned)((h * 64 + lane) * 8);
  const unsigned soff = hoff + 4u * (unsigned)dir;
  bf16_t* yb = p.Z + rowbase * INW + 768 + dir * 256 + h * 64 + w * 16 + fr;
  auto pos0 = [&](int c) -> int { const int t = c * 16; return dir == 0 ? t : (t < LC ? LC - 1 - t : LT - 1 - (t - LC)); };
  const int pstep = dir == 0 ? 1 : -1;
  constexpr int NCH = LT / 16;
  struct Raw { unsigned sc[16]; uint2 hr[6]; };
  auto load_raw = [&](int c, Raw& rw) {
    if (w != 0) {
      const int p0 = pos0(c);
      const unsigned so = soff + (unsigned)(p0 * 2048);
      const int st = pstep * 2048;
#pragma unroll
      for (int i = 0; i < 16; ++i) rw.sc[i] = *(const unsigned*)(sbase + (so + (unsigned)(i * st)));
      const unsigned ho = hoff + (unsigned)((p0 + pstep * (w - 1)) * 2048);
#pragma unroll
      for (int q = 0; q < 6; ++q) {
        const int qq = ((w - 1) + 3 * q < 16) ? q : 4;
        rw.hr[q] = *(const uint2*)(hbase + (ho + (unsigned)(qq * 3 * st)));
      }
    }
  };
  auto stage1w = [&](int set, const Raw& rw, auto W1tag) {
    constexpr int W1 = decltype(W1tag)::value;
    char* base = smem + set * SCS_SET;
    bf16_t (*At)[72] = (bf16_t (*)[72])(base);
    bf16_t (*Rt)[72] = (bf16_t (*)[72])(base + 2304);
    bf16_t (*Bt)[72] = (bf16_t (*)[72])(base + 4608);
    bf16_t (*Kt)[72] = (bf16_t (*)[72])(base + 6912);
    bf16_t (*BKT)[36] = (bf16_t (*)[36])(base + 9216);
    bf16_t* VV = (bf16_t*)(base + 13824);
    float* G16 = (float*)(base + 16896);
    float Erun = 0.f;
#pragma unroll
    for (int i = 0; i < 16; ++i) {
      const float ev = bflo(rw.sc[i]);
      const float Eprev = Erun;
      Erun += ev;
      if ((i % 3) == W1) {
        const uint2 hrec = rw.hr[i / 3];
        const float rr = bflo(hrec.x), kr = bfhi(hrec.x), kkv = bflo(hrec.y);
        const float av = bfhi(rw.sc[i]);
        const float gp = __expf(-Eprev), gi = __expf(-Erun), ig = __expf(Erun);
        const float at = -kkv * gp, rt = rr * gi, bt = kkv * av * ig, kt2 = kr * (1.f + (av - 1.f) * ka) * ig;
        const unsigned ar = pack2(at, rt), bk = pack2(bt, kt2);
        At[i][lane] = (bf16_t)(ar & 0xFFFFu); Rt[i][lane] = (bf16_t)(ar >> 16);
        Bt[i][lane] = (bf16_t)(bk & 0xFFFFu); Kt[i][lane] = (bf16_t)(bk >> 16);
        BKT[lane][(i >> 2) * 8 + (i & 3)] = (bf16_t)(bk & 0xFFFFu);
        BKT[lane][(i >> 2) * 8 + 4 + (i & 3)] = (bf16_t)(bk >> 16);
        VV[((i >> 2) * 64 + lane) * 6 + (i & 3)] = (bf16_t)(hrec.y >> 16);
        if (i == 15) G16[lane] = gi;
      }
    }
  };
  auto stage1 = [&](int set, const Raw& rw) {
    if (w == 1) stage1w(set, rw, std::integral_constant<int, 0>{});
    else if (w == 2) stage1w(set, rw, std::integral_constant<int, 1>{});
    else if (w == 3) stage1w(set, rw, std::integral_constant<int, 2>{});
  };
  auto stage2 = [&](int set, int iset) {
    char* base = smem + set * SCS_SET;
    const bf16_t (*At)[72] = (const bf16_t (*)[72])(base);
    const bf16_t (*Rt)[72] = (const bf16_t (*)[72])(base + 2304);
    const bf16_t (*Bt)[72] = (const bf16_t (*)[72])(base + 4608);
    const bf16_t (*Kt)[72] = (const bf16_t (*)[72])(base + 6912);
    bf16_t* TT = (bf16_t*)(smem + SCS_IMG + iset * 3072);
    bf16_t* ARK = TT + 512;
    bf16_t* AAK = TT + 1024;
    const bf16_t (*X)[72] = (w < 2) ? At : Rt;
    const bf16_t (*Y)[72] = (w & 1) ? Kt : Bt;
    f32x4 cm = (f32x4){0.f, 0.f, 0.f, 0.f};
#pragma unroll
    for (int s = 0; s < 2; ++s) {
      bf16x8 af = *(const bf16x8*)&X[fr][32 * s + 8 * fq];
      bf16x8 bm = *(const bf16x8*)&Y[fr][32 * s + 8 * fq];
      cm = mfma16(af, bm, cm);
    }
#pragma unroll
    for (int jj = 0; jj < 4; ++jj) {
      const int i = 4 * fq + jj;
      const bool keep = (w < 2) ? (fr < i) : (fr <= i);
      cm[jj] = keep ? cm[jj] : 0.f;
    }
    const int io = (fr >> 2) * 8 + (fr & 3);
    auto wr_img = [&](bf16_t* img, const f32x4& Xv, int hi) {
#pragma unroll
      for (int jj = 0; jj < 4; ++jj) img[(4 * fq + jj) * 32 + io + hi] = f2bf(Xv[jj]);
    };
    if (w == 1) wr_img(AAK, cm, 0);
    else if (w == 2) wr_img(ARK, cm, 0);
    else if (w == 3) wr_img(ARK, cm, 4);
    else {
      auto bfrag = [&](const f32x4& Xv) { return frag_join(make_uint2(pack2(Xv[0], Xv[1]), pack2(Xv[2], Xv[3])), make_uint2(0u, 0u)); };
      auto afr = [&](const bf16_t* img) { return *(const bf16x8*)&img[(fr * 4 + fq) * 8]; };
      const f32x4 Z4 = (f32x4){0.f, 0.f, 0.f, 0.f};
      wr_img(IMG0, cm, 0);
      asm volatile("" ::: "memory");
      f32x4 A2 = mfma16(afr(IMG0), bfrag(cm), Z4);
      wr_img(IMG1, A2, 0);
      asm volatile("" ::: "memory");
      f32x4 A4 = mfma16(afr(IMG1), bfrag(A2), Z4);
      wr_img(IMG2, A4, 0);
      asm volatile("" ::: "memory");
      f32x4 Rm = mfma16(afr(IMG2), bfrag(A4), Z4);
#pragma unroll
      for (int jj = 0; jj < 4; ++jj) Rm[jj] += (fr == 4 * fq + jj) ? 1.f : 0.f;
      Rm = mfma16(afr(IMG2), bfrag(Rm), Rm);
      Rm = mfma16(afr(IMG1), bfrag(Rm), Rm);
      Rm = mfma16(afr(IMG0), bfrag(Rm), Rm);
      wr_img(TT, Rm, 0);
    }
  };
  f32x4 acc[4];
#pragma unroll
  for (int kt = 0; kt < 4; ++kt) acc[kt] = (f32x4){0.f, 0.f, 0.f, 0.f};
  auto part2 = [&](int c, int set, int iset) {
    char* base = smem + set * SCS_SET;
    const bf16_t (*At)[72] = (const bf16_t (*)[72])(base);
    const bf16_t (*Rt)[72] = (const bf16_t (*)[72])(base + 2304);
    const bf16_t (*BKT)[36] = (const bf16_t (*)[36])(base + 9216);
    const bf16_t* VV = (const bf16_t*)(base + 13824);
    const float* G16 = (const float*)(base + 16896);
    const bf16_t* TT = (const bf16_t*)(smem + SCS_IMG + iset * 3072);
    const bf16_t* ARK = TT + 512;
    const bf16_t* AAK = TT + 1024;
    bf16x8 Sb[2];
#pragma unroll
    for (int s = 0; s < 2; ++s) {
      uint4 t = make_uint4(pack2(acc[2 * s][0], acc[2 * s][1]), pack2(acc[2 * s][2], acc[2 * s][3]),
                           pack2(acc[2 * s + 1][0], acc[2 * s + 1][1]), pack2(acc[2 * s + 1][2], acc[2 * s + 1][3]));
      Sb[s] = __builtin_bit_cast(bf16x8, t);
    }
    const unsigned* vvp = (const unsigned*)&VV[(fq * 64 + w * 16 + fr) * 6];
    const uint2 vv = make_uint2(vvp[0], vvp[1]);
    const bf16x8 Vlow = frag_join(vv, make_uint2(0u, 0u));
    f32x4 Pm = (f32x4){0.f, 0.f, 0.f, 0.f};
#pragma unroll
    for (int s = 0; s < 2; ++s) {
      bf16x8 af = frag_join(*(const uint2*)&At[fr][32 * s + 4 * fq], *(const uint2*)&At[fr][32 * s + 16 + 4 * fq]);
      Pm = mfma16(af, Sb[s], Pm);
    }
    Pm = mfma16(*(const bf16x8*)&AAK[(fr * 4 + fq) * 8], Vlow, Pm);
    const bf16x8 Pb = frag_join(make_uint2(pack2(Pm[0], Pm[1]), pack2(Pm[2], Pm[3])), make_uint2(0u, 0u));
    f32x4 U = mfma16(*(const bf16x8*)&TT[(fr * 4 + fq) * 8], Pb, (f32x4){0.f, 0.f, 0.f, 0.f});
    const bf16x8 UV = frag_join(make_uint2(pack2(U[0], U[1]), pack2(U[2], U[3])), vv);
    f32x4 Yv = (f32x4){0.f, 0.f, 0.f, 0.f};
#pragma unroll
    for (int s = 0; s < 2; ++s) {
      bf16x8 af = frag_join(*(const uint2*)&Rt[fr][32 * s + 4 * fq], *(const uint2*)&Rt[fr][32 * s + 16 + 4 * fq]);
      Yv = mfma16(af, Sb[s], Yv);
    }
    Yv = mfma16(*(const bf16x8*)&ARK[(fr * 4 + fq) * 8], UV, Yv);
    {
      const int p0 = pos0(c);
#pragma unroll
      for (int jj = 0; jj < 4; ++jj) yb[(size_t)(p0 + pstep * (4 * fq + jj)) * INW] = f2bf(Yv[jj]);
    }
#pragma unroll
    for (int kt = 0; kt < 4; ++kt) {
      f32x4 t = mfma16(frag_join(*(const uint2*)&BKT[16 * kt + fr][fq * 8], *(const uint2*)&BKT[16 * kt + fr][fq * 8 + 4]), UV, acc[kt]);
      const float4 g4 = *(const float4*)&G16[16 * kt + 4 * fq];
      t[0] *= g4.x; t[1] *= g4.y; t[2] *= g4.z; t[3] *= g4.w;
      acc[kt] = t;
    }
  };
  __builtin_amdgcn_s_setprio(3);
  Raw r0, r1;
  load_raw(0, r0); load_raw(1, r1);
  stage1(0, r0);
  load_raw(2, r0);
  __syncthreads();
  stage2(0, 0);
  stage1(1, r1);
  load_raw(3, r1);
  __syncthreads();
  int s0 = 0, s1 = 1, s2 = 2;
  auto iter = [&](int c, Raw& rw) {
    if (c + 1 < NCH) stage2(s1, (c + 1) & 1);
    part2(c, s0, c & 1);
    if (c + 2 < NCH) {
      stage1(s2, rw);
      if (c + 4 < NCH) load_raw(c + 4, rw);
    }
    asm volatile("s_waitcnt lgkmcnt(0)" ::: "memory");
    __builtin_amdgcn_s_barrier();
    asm volatile("" ::: "memory");
    const int t = s0; s0 = s1; s1 = s2; s2 = t;
  };
#pragma unroll 1
  for (int c = 0; c < NCH; c += 2) {
    iter(c, r0); iter(c + 1, r1);
  }
  __builtin_amdgcn_s_setprio(0);
}

DEV void ph_rwkv_post(const P& p, int layer) {
  const int lane = tid_() & 63;
  int r0, r1;
  wave_range(r0, r1, NTOK);
  const int ch = 4 * lane;
  float kav[4], rkv[4], lnw[4], lnb[4];
#pragma unroll
  for (int i = 0; i < 4; ++i) {
    kav[i] = p.rw_k_a[layer * 256 + ch + i]; rkv[i] = p.rw_r_k[layer * 256 + ch + i];
    lnw[i] = p.rw_ln_w[layer * 256 + ch + i]; lnb[i] = p.rw_ln_b[layer * 256 + ch + i];
  }
  struct In { uint2 y0, y1, g; uint4 h0, h1, s0, s1; };
  auto ld = [&](int row, In& in) {
    const bf16_t* zr = p.Z + (size_t)row * INW + 768 + ch;
    in.y0 = *(const uint2*)zr; in.y1 = *(const uint2*)(zr + 256);
    const bf16_t* hr = p.H + (size_t)row * D + 4 * ch;
    in.h0 = *(const uint4*)hr; in.h1 = *(const uint4*)(hr + 8);
    const bf16_t* sr = p.SC + (size_t)row * 1024 + 4 * ch;
    in.s0 = *(const uint4*)sr; in.s1 = *(const uint4*)(sr + 8);
    in.g = *(const uint2*)(p.Y + (size_t)row * D + 256 + ch);
  };
  In nx;
  if (r0 < r1) ld(r0, nx);
#pragma unroll 1
  for (int row = r0; row < r1; ++row) {
    const In in = nx;
    if (row + 1 < r1) ld(row + 1, nx);
    float y[4] = {bflo(in.y0.x) + bflo(in.y1.x), bfhi(in.y0.x) + bfhi(in.y1.x), bflo(in.y0.y) + bflo(in.y1.y), bfhi(in.y0.y) + bfhi(in.y1.y)};
    const float mu = row16_sum(y[0] + y[1] + y[2] + y[3]) * (1.f / 64.f);
    float vs = 0.f;
#pragma unroll
    for (int i = 0; i < 4; ++i) { y[i] -= mu; vs += y[i] * y[i]; }
    const float var = row16_sum(vs) * (1.f / 64.f);
    const float rstd = rsqrtf(var + 64e-5f);
    const float r[4] = {bflo(in.h0.x), bflo(in.h0.z), bflo(in.h1.x), bflo(in.h1.z)};
    const float k[4] = {bfhi(in.h0.x), bfhi(in.h0.z), bfhi(in.h1.x), bfhi(in.h1.z)};
    const float v[4] = {bfhi(in.h0.y), bfhi(in.h0.w), bfhi(in.h1.y), bfhi(in.h1.w)};
    const float a0[4] = {bfhi(in.s0.x), bfhi(in.s0.z), bfhi(in.s1.x), bfhi(in.s1.z)};
    const float a1[4] = {bfhi(in.s0.y), bfhi(in.s0.w), bfhi(in.s1.y), bfhi(in.s1.w)};
    float sd = 0.f;
#pragma unroll
    for (int i = 0; i < 4; ++i) {
      const float kd0 = k[i] * (1.f + (a0[i] - 1.f) * kav[i]), kd1 = k[i] * (1.f + (a1[i] - 1.f) * kav[i]);
      sd += r[i] * (kd0 + kd1) * rkv[i];
    }
    sd = row16_sum(sd);
    const float g[4] = {bflo(in.g.x), bfhi(in.g.x), bflo(in.g.y), bfhi(in.g.y)};
    float o[4];
#pragma unroll
    for (int i = 0; i < 4; ++i) {
      const float yn = y[i] * rstd * lnw[i] + lnb[i];
      o[i] = (yn + sd * v[i]) * g[i];
    }
    *(uint2*)(p.Y + (size_t)row * D + 256 + ch) = make_uint2(pack2(o[0], o[1]), pack2(o[2], o[3]));
  }
}

DEV void hyena_pre_unit(const P& p, int layer, int unit) {
  int kind, b, t0, L;
  if (unit < 1024) { kind = 0; b = unit >> 6; t0 = (unit & 63) * 64; L = T; } else { int u = unit - 1024; kind = 1; b = u >> 2; t0 = (u & 3) * 64; L = LC; }
  const int lane = tid_() & 63, wid = tid_() >> 6;
  const int tw = t0 + wid * 16;
  const size_t row0 = (size_t)b * LT + (kind ? 0 : LC);
  const float* cw = p.conv_w + (size_t)layer * 3 * 1536;
  const float* cb = p.conv_b + (size_t)layer * 1536;
  float wx[3][4], wv[3][4], bx[4], bv[4];
#pragma unroll
  for (int i = 0; i < 4; ++i) {
    const int cx = 256 + 4 * lane + i, cv = 512 + 4 * lane + i;
#pragma unroll
    for (int k = 0; k < 3; ++k) { wx[k][i] = cw[k * 1536 + cx]; wv[k][i] = cw[k * 1536 + cv]; }
    bx[i] = cb[cx]; bv[i] = cb[cv];
  }
  uint2 zx[18], zv[18];
#pragma unroll
  for (int i = 0; i < 18; ++i) {
    const int t = tw - 1 + i;
    if (t >= 0 && t < L) {
      const bf16_t* zr = p.Z + (row0 + t) * INW + 256 + 4 * lane;
      zx[i] = *(const uint2*)zr; zv[i] = *(const uint2*)(zr + 256);
    } else { zx[i] = make_uint2(0u, 0u); zv[i] = make_uint2(0u, 0u); }
  }
  float uo[4][16];
#pragma unroll
  for (int i = 0; i < 16; ++i) {
    const float xm[4] = {bflo(zx[i].x), bfhi(zx[i].x), bflo(zx[i].y), bfhi(zx[i].y)};
    const float xc[4] = {bflo(zx[i + 1].x), bfhi(zx[i + 1].x), bflo(zx[i + 1].y), bfhi(zx[i + 1].y)};
    const float xp[4] = {bflo(zx[i + 2].x), bfhi(zx[i + 2].x), bflo(zx[i + 2].y), bfhi(zx[i + 2].y)};
    const float vm[4] = {bflo(zv[i].x), bfhi(zv[i].x), bflo(zv[i].y), bfhi(zv[i].y)};
    const float vc[4] = {bflo(zv[i + 1].x), bfhi(zv[i + 1].x), bflo(zv[i + 1].y), bfhi(zv[i + 1].y)};
    const float vp[4] = {bflo(zv[i + 2].x), bfhi(zv[i + 2].x), bflo(zv[i + 2].y), bfhi(zv[i + 2].y)};
#pragma unroll
    for (int q = 0; q < 4; ++q) {
      const float a = wx[0][q] * xm[q] + wx[1][q] * xc[q] + wx[2][q] * xp[q] + bx[q];
      const float c2 = wv[0][q] * vm[q] + wv[1][q] * vc[q] + wv[2][q] * vp[q] + bv[q];
      uo[q][i] = a * c2;
    }
  }
  bf16_t* ut = kind ? opq(p.UTc) : opq(p.UTl);
#pragma unroll
  for (int q = 0; q < 4; ++q) {
    bf16_t* dst = ut + ((size_t)(4 * lane + q) * 16 + b) * L + tw;
    *(uint4*)dst = pack8(&uo[q][0]);
    *(uint4*)(dst + 8) = pack8(&uo[q][8]);
  }
}

DEV void lds_barrier() {
  asm volatile("s_waitcnt lgkmcnt(0)" ::: "memory");
  __builtin_amdgcn_s_barrier();
  asm volatile("" ::: "memory");
}
DEV void hyena_scale_unit(const P& p, int layer, int u, char* smem) {
  const int kind = u >> 8, c = u & 255, L = kind ? LC : T;
  const float* F = (kind ? opq(p.FC) : opq(p.FL)) + (size_t)c * 2 * L;
  float* red = (float*)smem;
  const int tid = tid_(), lane = tid & 63, wid = tid >> 6;
  float part = 0.f;
  for (int i = tid; i < 2 * L; i += 256) { float fv = F[i]; part += (i != L) ? fv * fv : 0.f; }
  part = wave_sum(part);
  __syncthreads();
  if (lane == 0) red[wid] = part;
  __syncthreads();
  if (tid == 0) p.SSQ[(layer * 2 + kind) * 256 + c] = rsqrtf(((red[0] + red[1]) + (red[2] + red[3])) + 1e-6f);
}
constexpr int HC_CQ = 65 * 144, HC_US = 32 * 272, HC_BUF = HC_CQ + HC_US;
typedef const __attribute__((address_space(1))) float* gfloat_p;
typedef unsigned u32x4_t __attribute__((ext_vector_type(4)));
typedef const __attribute__((address_space(1))) u32x4_t* guint4_p;
DEV void hyena_conv_unit(const P& p, int layer, int unit, char* smem) {
  int kind, c, tb, L;
  if (unit < 4096) { kind = 0; c = unit >> 4; tb = (unit & 15) * 256; L = T; } else { kind = 1; c = unit - 4096; tb = 0; L = LC; }
  const int tid = tid_(), lane = tid & 63, wid = tid >> 6, fr = lane & 15, fq = lane >> 4;
  const gfloat_p F = (gfloat_p)((kind ? opq(p.FC) : opq(p.FL)) + (size_t)c * 2 * L);
  const int nch = L / 256;
  const int bb = tid >> 4, sg0 = tid & 15;
  const guint4_p U = (guint4_p)((kind ? opq(p.UTc) : opq(p.UTl)) + (size_t)c * 16 * L + (size_t)bb * L + 8 * sg0);
  auto ldchunk = [&](int ch, float& f0, float& f1, float& f2, uint4& u0, uint4& u1) {
    const int D0 = tb + 256 - ch * 256;
    auto tap = [&](int n) -> float {
      const int d = D0 - n;
      const bool ok = (d > -L) && (d < L);
      int idx = d >= 0 ? d : L - d;
      idx = ok ? idx : 0;
      return F[idx];
    };
    f0 = tap(tid); f1 = tap(tid + 256); f2 = tap(tid < 8 ? tid + 512 : 100000);
    const u32x4_t w0 = U[ch * 32], w1 = U[ch * 32 + 16];
    u0 = make_uint4(w0.x, w0.y, w0.z, w0.w); u1 = make_uint4(w1.x, w1.y, w1.z, w1.w);
  };
  const float scale = p.SSQ[(layer * 2 + kind) * 256 + c];
  float fa0, fa1, fa2, fb0, fb1, fb2, fc0, fc1, fc2;
  uint4 ua0, ua1, ub0, ub1, uc0, uc1;
  const int lastc = nch - 1;
  ldchunk(0, fa0, fa1, fa2, ua0, ua1);
  ldchunk(min(1, lastc), fb0, fb1, fb2, ub0, ub1);
  ldchunk(min(2, lastc), fc0, fc1, fc2, uc0, uc1);
  auto stchunk = [&](int ch, float f0, float f1, float f2, const uint4& u0, const uint4& u1) {
    const int buf = ch & 1;
    bf16_t* Cq = (bf16_t*)(smem + buf * HC_BUF);
    char* Us = smem + buf * HC_BUF + HC_CQ;
    const int d0 = tb + 256 - ch * 256 - tid, d1 = d0 - 256, d2 = d0 - 512;
    const bf16_t h0 = f2bf((d0 > -L && d0 < L) ? f0 * scale : 0.f), h1 = f2bf((d1 > -L && d1 < L) ? f1 * scale : 0.f);
    const bf16_t h2 = f2bf((d2 > -L && d2 < L) ? f2 * scale : 0.f);
#pragma unroll
    for (int rho = 0; rho < 8; ++rho) {
      int m = tid + rho;
      Cq[(m >> 3) * 72 + rho * 8 + (m & 7)] = h0;
      m = tid + 256 + rho;
      if (m < 520) Cq[(m >> 3) * 72 + rho * 8 + (m & 7)] = h1;
      m = tid + 512 + rho;
      if (tid < 8 && m < 520) Cq[(m >> 3) * 72 + rho * 8 + (m & 7)] = h2;
    }
    if (tid < 8) {
#pragma unroll
      for (int rho = 1; rho < 8; ++rho) if (tid < rho) Cq[rho * 8 + tid] = 0;
    }
    *(uint4*)(Us + sg0 * 272 + bb * 16) = u0;
    *(uint4*)(Us + (sg0 + 16) * 272 + bb * 16) = u1;
  };
  f32x4 acc[4];
#pragma unroll
  for (int m = 0; m < 4; ++m) acc[m] = (f32x4){0.f, 0.f, 0.f, 0.f};
  const int a0 = (32 - 8 * wid + fq - (fr >> 3)) * 144 + (fr & 7) * 16;
  auto compute = [&](int buf) {
    const char* Cq = smem + buf * HC_BUF + a0;
    const char* Us = smem + buf * HC_BUF + HC_CQ + fq * 272 + fr * 16;
    bf16x8 fa[4];
#pragma unroll
    for (int m = 0; m < 4; ++m) fa[m] = *(const bf16x8*)(Cq - m * 288);
#pragma unroll
    for (int kk = 0; kk < 8; ++kk) {
      const bf16x8 bf = *(const bf16x8*)(Us + kk * 4 * 272);
      if (kk > 0) {
        fa[3] = fa[1]; fa[2] = fa[0];
        fa[1] = *(const bf16x8*)(Cq + (2 * kk - 1) * 288);
        fa[0] = *(const bf16x8*)(Cq + (2 * kk) * 288);
      }
#pragma unroll
      for (int m = 0; m < 4; ++m) acc[m] = mfma16(fa[m], bf, acc[m]);
    }
  };
  __syncthreads();
  int ch = 0;
#pragma unroll 1
  for (; ch + 3 <= lastc; ch += 3) {
    stchunk(ch, fa0, fa1, fa2, ua0, ua1);
    lds_barrier();
    ldchunk(min(ch + 3, lastc), fa0, fa1, fa2, ua0, ua1);
    compute(ch & 1);
    stchunk(ch + 1, fb0, fb1, fb2, ub0, ub1);
    lds_barrier();
    ldchunk(min(ch + 4, lastc), fb0, fb1, fb2, ub0, ub1);
    compute((ch + 1) & 1);
    stchunk(ch + 2, fc0, fc1, fc2, uc0, uc1);
    lds_barrier();
    ldchunk(min(ch + 5, lastc), fc0, fc1, fc2, uc0, uc1);
    compute(ch & 1);
  }
  stchunk(ch, fa0, fa1, fa2, ua0, ua1);
  lds_barrier();
  compute(ch & 1);
  bf16_t* Yt = (kind ? opq(p.YTc) : opq(p.YTl)) + ((size_t)c * 16 + fr) * L + tb;
#pragma unroll
  for (int m = 0; m < 4; ++m) {
    int t = (wid * 4 + m) * 16 + fq * 4;
    *(uint2*)(Yt + t) = make_uint2(pack2(acc[m][0], acc[m][1]), pack2(acc[m][2], acc[m][3]));
  }
}

DEV void hyena_post_unit(const P& p, int layer, int unit, char* smem) {
  (void)smem;
  int kind, b, t0, L;
  if (unit < 1024) { kind = 0; b = unit >> 6; t0 = (unit & 63) * 64; L = T; } else { int u = unit - 1024; kind = 1; b = u >> 2; t0 = (u & 3) * 64; L = LC; }
  const int lane = tid_() & 63, wid = tid_() >> 6;
  const int tw = t0 + wid * 16;
  const size_t row0 = (size_t)b * LT + (kind ? 0 : LC);
  const float* cw = p.conv_w + (size_t)layer * 3 * 1536;
  float w0[3][4], b0[4], bias[4], og[4];
#pragma unroll
  for (int i = 0; i < 4; ++i) {
    const int c = 4 * lane + i;
#pragma unroll
    for (int k = 0; k < 3; ++k) w0[k][i] = cw[k * 1536 + c];
    b0[i] = p.conv_b[layer * 1536 + c]; bias[i] = p.hy_bias[layer * 256 + c]; og[i] = p.hy_out_g[layer * 256 + c];
  }
  uint2 zx[18];
#pragma unroll
  for (int i = 0; i < 18; ++i) {
    const int t = tw - 1 + i;
    zx[i] = (t >= 0 && t < L) ? *(const uint2*)(p.Z + (row0 + t) * INW + 4 * lane) : make_uint2(0u, 0u);
  }
  const bf16_t* ytb = kind ? opq(p.YTc) : opq(p.YTl);
  const bf16_t* utb = kind ? opq(p.UTc) : opq(p.UTl);
  float o[4][16];
#pragma unroll
  for (int q = 0; q < 4; ++q) {
    const size_t off = ((size_t)(4 * lane + q) * 16 + b) * L + tw;
    float yv[16], uv[16];
    { uint4 a0 = *(const uint4*)(ytb + off), a1 = *(const uint4*)(ytb + off + 8); unpack8(a0, yv); unpack8(a1, yv + 8); }
    { uint4 a0 = *(const uint4*)(utb + off), a1 = *(const uint4*)(utb + off + 8); unpack8(a0, uv); unpack8(a1, uv + 8); }
#pragma unroll
    for (int i = 0; i < 16; ++i) o[q][i] = yv[i] + uv[i] * bias[q];
  }
#pragma unroll
  for (int i = 0; i < 16; ++i) {
    const float xm[4] = {bflo(zx[i].x), bfhi(zx[i].x), bflo(zx[i].y), bfhi(zx[i].y)};
    const float xc[4] = {bflo(zx[i + 1].x), bfhi(zx[i + 1].x), bflo(zx[i + 1].y), bfhi(zx[i + 1].y)};
    const float xp[4] = {bflo(zx[i + 2].x), bfhi(zx[i + 2].x), bflo(zx[i + 2].y), bfhi(zx[i + 2].y)};
    float ov[4], ss = 0.f;
#pragma unroll
    for (int q = 0; q < 4; ++q) {
      const float x0 = w0[0][q] * xm[q] + w0[1][q] * xc[q] + w0[2][q] * xp[q] + b0[q];
      ov[q] = bf2f(f2bf(x0 * o[q][i]));
      ss += ov[q] * ov[q];
    }
    ss = wave_sum(ss);
    const float rstd = rsqrtf(ss * (1.f / 256.f) + 1e-6f);
    *(uint2*)(p.Y + (row0 + tw + i) * D + 4 * lane) = make_uint2(pack2(ov[0] * rstd * og[0], ov[1] * rstd * og[1]), pack2(ov[2] * rstd * og[2], ov[3] * rstd * og[3]));
  }
}

DEV void attn_unit(const P& p, int layer, int unit, char* smem) {
  const bool isctx = unit >= 4096;
  int b, qb, hq;
  if (!isctx) { b = unit >> 8; qb = (unit >> 3) & 31; hq = unit & 7; } else { int u = unit - 4096; b = u >> 4; qb = (u >> 3) & 1; hq = u & 7; }
  const int g = hq >> 2;
  const int tid = tid_(), lane = tid & 63, wid = tid >> 6, qn = lane & 31, hh = lane >> 5;
  const int qpos = qb * 128 + wid * 32 + qn;
  const size_t qrow = (size_t)b * LT + (isctx ? qpos : LC + qpos);
  const bf16_t* qptr = p.Z + qrow * INW + 1920 + hq * 64;
  bf16x8 qf[4];
#pragma unroll
  for (int s = 0; s < 4; ++s) qf[s] = *(const bf16x8*)(qptr + 16 * s + 8 * hh);
  const float sink = p.attn_sink[layer * 8 + hq];
  float m_run = sink, l_run = 1.f;
  f32x16 o0, o1;
#pragma unroll
  for (int i = 0; i < 16; ++i) { o0[i] = 0.f; o1[i] = 0.f; }
  typedef bf16_t KTile[64][72];
  typedef bf16_t VTile[64][68];
  KTile* Ks = (KTile*)smem;
  VTile* Vt = (VTile*)(smem + 18432);
  const int ntl = isctx ? 0 : 6;
  const int ntiles = ntl + 4;
  const int skey = tid >> 3, sseg = tid & 7;
  const bf16_t* kvbase = p.Z + (size_t)b * LT * INW + 1920 + 512 + g * 64 + sseg * 8;
  auto ldtile = [&](int kt, uint4& rk0, uint4& rk1, uint4& rv0, uint4& rv1) {
    const bool ctxk = kt >= ntl;
    const int kbase = ctxk ? (kt - ntl) * 64 : qb * 128 - 128 + kt * 64;
    int kp0 = kbase + skey, kp1 = kp0 + 32;
    if (!ctxk) { kp0 = min(max(kp0, 0), T - 1) + LC; kp1 = min(max(kp1, 0), T - 1) + LC; }
    const bf16_t* s0 = kvbase + (size_t)kp0 * INW;
    const bf16_t* s1 = kvbase + (size_t)kp1 * INW;
    rk0 = *(const uint4*)s0; rv0 = *(const uint4*)(s0 + 128);
    rk1 = *(const uint4*)s1; rv1 = *(const uint4*)(s1 + 128);
  };
  auto sttile = [&](int buf, const uint4& rk0, const uint4& rk1, const uint4& rv0, const uint4& rv1) {
    *(uint4*)&Ks[buf][skey][sseg * 8] = rk0;
    *(uint4*)&Ks[buf][skey + 32][sseg * 8] = rk1;
    bf16_t (*vt)[68] = Vt[buf];
    vt[sseg * 8 + 0][skey] = (bf16_t)(rv0.x & 0xFFFF); vt[sseg * 8 + 1][skey] = (bf16_t)(rv0.x >> 16);
    vt[sseg * 8 + 2][skey] = (bf16_t)(rv0.y & 0xFFFF); vt[sseg * 8 + 3][skey] = (bf16_t)(rv0.y >> 16);
    vt[sseg * 8 + 4][skey] = (bf16_t)(rv0.z & 0xFFFF); vt[sseg * 8 + 5][skey] = (bf16_t)(rv0.z >> 16);
    vt[sseg * 8 + 6][skey] = (bf16_t)(rv0.w & 0xFFFF); vt[sseg * 8 + 7][skey] = (bf16_t)(rv0.w >> 16);
    vt[sseg * 8 + 0][skey + 32] = (bf16_t)(rv1.x & 0xFFFF); vt[sseg * 8 + 1][skey + 32] = (bf16_t)(rv1.x >> 16);
    vt[sseg * 8 + 2][skey + 32] = (bf16_t)(rv1.y & 0xFFFF); vt[sseg * 8 + 3][skey + 32] = (bf16_t)(rv1.y >> 16);
    vt[sseg * 8 + 4][skey + 32] = (bf16_t)(rv1.z & 0xFFFF); vt[sseg * 8 + 5][skey + 32] = (bf16_t)(rv1.z >> 16);
    vt[sseg * 8 + 6][skey + 32] = (bf16_t)(rv1.w & 0xFFFF); vt[sseg * 8 + 7][skey + 32] = (bf16_t)(rv1.w >> 16);
  };
  auto compute = [&](int kt) {
    const int buf = kt & 1;
    const bool ctxk = kt >= ntl;
    const int kbase = ctxk ? (kt - ntl) * 64 : qb * 128 - 128 + kt * 64;
#pragma unroll
    for (int sub = 0; sub < 2; ++sub) {
      const int kb2 = kbase + sub * 32;
      bool need = true;
      if (!ctxk) {
        int q0 = qb * 128 + wid * 32;
        if (kb2 + 31 < q0 - 128 || kb2 > q0 + 31 + 128 || kb2 + 31 < 0 || kb2 >= T) need = false;
      }
      if (need) {
        f32x16 sv;
#pragma unroll
        for (int i = 0; i < 16; ++i) sv[i] = 0.f;
#pragma unroll
        for (int ks = 0; ks < 4; ++ks) {
          bf16x8 kf = *(const bf16x8*)&Ks[buf][sub * 32 + qn][16 * ks + 8 * hh];
          sv = mfma32(kf, qf[ks], sv);
        }
        float mt = -3e38f;
#pragma unroll
        for (int rg = 0; rg < 16; ++rg) {
          float v = sv[rg] * 0.125f;
          if (!ctxk) {
            int kp = kb2 + (rg & 3) + 8 * (rg >> 2) + 4 * hh;
            int dl = qpos - kp;
            bool ok = (dl <= 128) && (dl >= -128) && (kp >= 0) && (kp < T);
            v = ok ? v : -1e30f;
          }
          sv[rg] = v;
          mt = fmaxf(mt, v);
        }
        mt = fmaxf(mt, __shfl_xor(mt, 32));
        float m_new = fmaxf(m_run, mt);
        float corr = __expf(m_run - m_new);
        float ps = 0.f;
#pragma unroll
        for (int rg = 0; rg < 16; ++rg) { float pv = __expf(sv[rg] - m_new); sv[rg] = pv; ps += pv; }
        ps += __shfl_xor(ps, 32);
        l_run = l_run * corr + ps;
        m_run = m_new;
#pragma unroll
        for (int i = 0; i < 16; ++i) { o0[i] *= corr; o1[i] *= corr; }
#pragma unroll
        for (int sp = 0; sp < 2; ++sp) {
          bf16x8 pf;
#pragma unroll
          for (int j = 0; j < 8; ++j) pf[j] = (short)f2bf(sv[8 * sp + j]);
          const int kc = sub * 32 + 16 * sp + 4 * hh;
          uint2 va = *(const uint2*)&Vt[buf][qn][kc], vb = *(const uint2*)&Vt[buf][qn][kc + 8];
          uint2 vc = *(const uint2*)&Vt[buf][32 + qn][kc], vd = *(const uint2*)&Vt[buf][32 + qn][kc + 8];
          uint4 w0 = make_uint4(va.x, va.y, vb.x, vb.y), w1 = make_uint4(vc.x, vc.y, vd.x, vd.y);
          bf16x8 v0 = __builtin_bit_cast(bf16x8, w0), v1 = __builtin_bit_cast(bf16x8, w1);
          o0 = mfma32(v0, pf, o0);
          o1 = mfma32(v1, pf, o1);
        }
      }
    }
  };
  uint4 ak0, ak1, av0, av1, bk0, bk1, bv0, bv1;
  ldtile(0, ak0, ak1, av0, av1);
  ldtile(1, bk0, bk1, bv0, bv1);
  __syncthreads();
#pragma unroll 1
  for (int kt = 0; kt < ntiles; kt += 2) {
    sttile(0, ak0, ak1, av0, av1);
    lds_barrier();
    ldtile(min(kt + 2, ntiles - 1), ak0, ak1, av0, av1);
    compute(kt);
    sttile(1, bk0, bk1, bv0, bv1);
    lds_barrier();
    ldtile(min(kt + 3, ntiles - 1), bk0, bk1, bv0, bv1);
    compute(kt + 1);
  }
  __syncthreads();
  const float inv = 1.f / l_run;
  bf16_t* optr = p.Y + qrow * D + 512 + hq * 64;
#pragma unroll
  for (int rg = 0; rg < 4; ++rg) {
    int d0 = 8 * rg + 4 * hh;
    *(uint2*)(optr + d0) = make_uint2(pack2(o0[4 * rg] * inv, o0[4 * rg + 1] * inv), pack2(o0[4 * rg + 2] * inv, o0[4 * rg + 3] * inv));
    *(uint2*)(optr + 32 + d0) = make_uint2(pack2(o1[4 * rg] * inv, o1[4 * rg + 1] * inv), pack2(o1[4 * rg + 2] * inv, o1[4 * rg + 3] * inv));
  }
}

DEV void ph_attn_post(const P& p, int layer) {
  const int lane = tid_() & 63;
  int r0, r1;
  wave_range(r0, r1, NTOK);
  float gv[8];
#pragma unroll
  for (int i = 0; i < 8; ++i) gv[i] = p.at_out_g[layer * 512 + 8 * lane + i];
  uint4 nx = make_uint4(0, 0, 0, 0);
  if (r0 < r1) nx = *(const uint4*)(p.Y + (size_t)r0 * D + 512 + 8 * lane);
#pragma unroll 1
  for (int row = r0; row < r1; ++row) {
    const uint4 u = nx;
    if (row + 1 < r1) nx = *(const uint4*)(p.Y + (size_t)(row + 1) * D + 512 + 8 * lane);
    float v[8];
    unpack8(u, v);
    float ss = 0.f;
#pragma unroll
    for (int i = 0; i < 8; ++i) ss += v[i] * v[i];
    ss = wave_sum(ss);
    const float rstd = rsqrtf(ss * (1.f / 512.f) + 1e-6f);
#pragma unroll
    for (int i = 0; i < 8; ++i) {
      v[i] = v[i] * rstd * gv[i];
    }
    *(uint4*)(p.Y + (size_t)row * D + 512 + 8 * lane) = pack8(v);
  }
}

struct Epi2 {
  const P& p; int layer, row0, col0;
  DEV void operator()(f32x4 (&acc)[4][4], int wr, int wc, int fr, int fq, char* smem) const {
    const int b = row0 / LT, pp = row0 % LT;
    const int mr = pp < LC ? 16 : b;
    const float* g1 = p.modv + ((size_t)layer * 17 + mr) * 6144 + 2048 + col0 + wc * 64;
#pragma unroll
    for (int n = 0; n < 4; ++n) {
      const float4 gv = *(const float4*)(g1 + n * 16 + 4 * fq);
#pragma unroll
      for (int m = 0; m < 4; ++m) { acc[m][n][0] *= gv.x; acc[m][n][1] *= gv.y; acc[m][n][2] *= gv.z; acc[m][n][3] *= gv.w; }
    }
    const int wid = wr * 2 + wc, lane = fq * 16 + fr;
    stage_tile_bf16(acc, smem, wid, fr, fq);
    const bf16_t (*t)[72] = (const bf16_t (*)[72])(smem + wid * 9216);
#pragma unroll
    for (int i = 0; i < 8; ++i) {
      const int rl = i * 8 + (lane >> 3), ch = lane & 7;
      bf16_t* xp = p.X + (size_t)(row0 + wr * 64 + rl) * D + col0 + wc * 64 + ch * 8;
      float xv[8], dv[8];
      uint4 xu = *(const uint4*)xp, du = *(const uint4*)&t[rl][ch * 8];
      unpack8(xu, xv); unpack8(du, dv);
#pragma unroll
      for (int q = 0; q < 8; ++q) xv[q] += dv[q];
      *(uint4*)xp = pack8(xv);
    }
  }
};
DEV void ph_gemm2(const P& p, int layer, char* smem) {
  int rt, ct;
  for (int it = 0; gemm_unit(it, 8, rt, ct); ++it) {
    Epi2 epi{p, layer, rt * 128, ct * 128};
    gemm_tile(p.Y + (size_t)rt * 128 * D, D, p.W2t + (size_t)ct * 128 * D, D, D, smem, epi);
  }
}

DEV void ph_peerconv(const P& p, int layer) {
  const int gw = (bid_() * 256 + tid_()) >> 6, nw = gridDim.x * 4, lane = tid_() & 63;
  const float* su = opq(p.peer_u) + (size_t)layer * 16384 * 1024;
  const float* sv = opq(p.peer_v) + (size_t)layer * 16384 * 1024;
  unsigned char* pu = opq(p.PU); unsigned char* pv = opq(p.PV);
  float* psu = opq(p.PSU); float* psv = opq(p.PSV);
  auto ldrow = [&](int r, float4& a0, float4& a1, float4& a2, float4& a3) {
    const float* src = ((r >= 16384) ? sv : su) + (size_t)(r & 16383) * 1024 + 16 * lane;
    a0 = *(const float4*)src; a1 = *(const float4*)(src + 4); a2 = *(const float4*)(src + 8); a3 = *(const float4*)(src + 12);
  };
  float4 n0 = make_float4(0, 0, 0, 0), n1 = n0, n2 = n0, n3 = n0;
  if (gw < 32768) ldrow(gw, n0, n1, n2, n3);
#pragma unroll 1
  for (int r = gw; r < 32768; r += nw) {
    const bool isv = r >= 16384;
    const int e = r & 16383;
    const float4 f0 = n0, f1 = n1, f2 = n2, f3 = n3;
    if (r + nw < 32768) ldrow(r + nw, n0, n1, n2, n3);
    float am = fmaxf(fmaxf(fmaxf(fabsf(f0.x), fabsf(f0.y)), fmaxf(fabsf(f0.z), fabsf(f0.w))), fmaxf(fmaxf(fabsf(f1.x), fabsf(f1.y)), fmaxf(fabsf(f1.z), fabsf(f1.w))));
    am = fmaxf(am, fmaxf(fmaxf(fmaxf(fabsf(f2.x), fabsf(f2.y)), fmaxf(fabsf(f2.z), fabsf(f2.w))), fmaxf(fmaxf(fabsf(f3.x), fabsf(f3.y)), fmaxf(fabsf(f3.z), fabsf(f3.w)))));
    am = wave_max(am);
    int w0, w1, w2, w3;
    float inv;
    if (isv) {
      const float sc = am > 0.f ? 224.f / am : 1.f;
      inv = am > 0.f ? am * (1.f / 224.f) : 1.f;
      w0 = __builtin_amdgcn_cvt_pk_fp8_f32(f0.x * sc, f0.y * sc, 0, false); w0 = __builtin_amdgcn_cvt_pk_fp8_f32(f0.z * sc, f0.w * sc, w0, true);
      w1 = __builtin_amdgcn_cvt_pk_fp8_f32(f1.x * sc, f1.y * sc, 0, false); w1 = __builtin_amdgcn_cvt_pk_fp8_f32(f1.z * sc, f1.w * sc, w1, true);
      w2 = __builtin_amdgcn_cvt_pk_fp8_f32(f2.x * sc, f2.y * sc, 0, false); w2 = __builtin_amdgcn_cvt_pk_fp8_f32(f2.z * sc, f2.w * sc, w2, true);
      w3 = __builtin_amdgcn_cvt_pk_fp8_f32(f3.x * sc, f3.y * sc, 0, false); w3 = __builtin_amdgcn_cvt_pk_fp8_f32(f3.z * sc, f3.w * sc, w3, true);
    } else {
      const float sc = am > 0.f ? 127.f / am : 1.f;
      inv = am > 0.f ? am * (1.f / 127.f) : 1.f;
      w0 = pack_i8(f0.x * sc, f0.y * sc, f0.z * sc, f0.w * sc); w1 = pack_i8(f1.x * sc, f1.y * sc, f1.z * sc, f1.w * sc);
      w2 = pack_i8(f2.x * sc, f2.y * sc, f2.z * sc, f2.w * sc); w3 = pack_i8(f3.x * sc, f3.y * sc, f3.z * sc, f3.w * sc);
    }
    *(uint4*)((isv ? pv : pu) + (size_t)(lane >> 3) * PSLICE + (size_t)e * 128 + 16 * (lane & 7)) = make_uint4((unsigned)w0, (unsigned)w1, (unsigned)w2, (unsigned)w3);
    if (lane == 0) (isv ? psv : psu)[e] = inv;
  }
}
DEV void unpack16_fp8x2(const uint4& u, f32x2* f) {
  f[0] = __builtin_amdgcn_cvt_pk_f32_fp8((int)u.x, false); f[1] = __builtin_amdgcn_cvt_pk_f32_fp8((int)u.x, true);
  f[2] = __builtin_amdgcn_cvt_pk_f32_fp8((int)u.y, false); f[3] = __builtin_amdgcn_cvt_pk_f32_fp8((int)u.y, true);
  f[4] = __builtin_amdgcn_cvt_pk_f32_fp8((int)u.z, false); f[5] = __builtin_amdgcn_cvt_pk_f32_fp8((int)u.z, true);
  f[6] = __builtin_amdgcn_cvt_pk_f32_fp8((int)u.w, false); f[7] = __builtin_amdgcn_cvt_pk_f32_fp8((int)u.w, true);
}

DEV void bitonic_sort16_desc(float (&v)[16]) {
#pragma unroll
  for (int k = 2; k <= 16; k <<= 1)
#pragma unroll
    for (int j = k >> 1; j >= 1; j >>= 1)
#pragma unroll
      for (int i = 0; i < 16; ++i) {
        const int l = i ^ j;
        if (l > i) {
          const float hi = fmaxf(v[i], v[l]), lo = fminf(v[i], v[l]);
          if ((i & k) == 0) { v[i] = hi; v[l] = lo; } else { v[i] = lo; v[l] = hi; }
        }
      }
}
DEV void peer_cand_ij(int c, int& ci, int& cj) {
  if (c < 16) { ci = 0; cj = c; } else if (c < 24) { ci = 1; cj = c - 16; } else if (c < 29) { ci = 2; cj = c - 24; }
  else if (c < 33) { ci = 3; cj = c - 29; } else if (c < 36) { ci = 4; cj = c - 33; } else if (c < 38) { ci = 5; cj = c - 36; }
  else if (c < 40) { ci = 6; cj = c - 38; } else if (c < 42) { ci = 7; cj = c - 40; } else { ci = (c - 42 + 8) & 15; cj = 0; }
}
DEV void ce_desc(float& a, float& b) { const float hi = fmaxf(a, b), lo = fminf(a, b); a = hi; b = lo; }
DEV void bitonic_merge16_desc(float (&v)[16]) {
#pragma unroll
  for (int d = 8; d >= 1; d >>= 1)
#pragma unroll
    for (int i = 0; i < 16; ++i)
      if ((i & d) == 0) ce_desc(v[i], v[i + d]);
}
template <int N>
DEV void merge_trunc16(float (&T)[16], const float (&B)[N]) {
#pragma unroll
  for (int k = 0; k < N; ++k) T[15 - k] = fmaxf(T[15 - k], B[k]);
  bitonic_merge16_desc(T);
}
DEV float pk_sum(float a, float b, int i, int j) {
  return __uint_as_float((__float_as_uint(a + b) & ~255u) | (unsigned)(255 - (i * 16 + j)));
}
template <int S>
struct Epi3K {
  const P& p; int row0, head; float (&keep)[2][16];
  DEV void operator()(f32x4 (&acc)[4][4], int wr, int wc, int fr, int fq, char* smem) const {
    float* sc = (float*)smem;
    float* L1s = (float*)(smem + 36864);
    float* L2s = (float*)(smem + 47104);
    const int tid = tid_();
#pragma unroll
    for (int pass = 0; pass < 2; ++pass) {
      __syncthreads();
      if (wr == pass) {
#pragma unroll
        for (int m = 0; m < 4; ++m)
#pragma unroll
          for (int n = 0; n < 4; ++n)
#pragma unroll
            for (int j = 0; j < 4; ++j) {
              int rl = m * 16 + fr, col = wc * 64 + n * 16 + 4 * fq + j;
              unsigned bits = (__float_as_uint(acc[m][n][j]) & ~127u) | (unsigned)col;
              sc[rl * 133 + (col >> 5) * 33 + (col & 31)] = __uint_as_float(bits);
            }
      }
      __syncthreads();
      const int rl = tid >> 2, q = tid & 3;
      const float* src = sc + rl * 133 + q * 33;
      float Ls[16], Hs[16];
#pragma unroll
      for (int i = 0; i < 16; ++i) { Ls[i] = src[i]; Hs[i] = src[16 + i]; }
      bitonic_sort16_desc(Ls);
      bitonic_sort16_desc(Hs);
#pragma unroll
      for (int i = 0; i < 16; ++i) Ls[i] = fmaxf(Ls[i], Hs[15 - i]);
#pragma unroll
      for (int d = 8; d >= 1; d >>= 1)
#pragma unroll
        for (int i = 0; i < 16; ++i)
          if ((i & d) == 0) { float hi = fmaxf(Ls[i], Ls[i + d]), lo = fminf(Ls[i], Ls[i + d]); Ls[i] = hi; Ls[i + d] = lo; }
      float Cs[16];
#pragma unroll
      for (int i = 0; i < 16; ++i) Cs[i] = fmaxf(Ls[i], dppself<0xB1, 0xF>(Ls[15 - i]));
#pragma unroll
      for (int d = 8; d >= 1; d >>= 1)
#pragma unroll
        for (int i = 0; i < 16; ++i)
          if ((i & d) == 0) { float hi = fmaxf(Cs[i], Cs[i + d]), lo = fminf(Cs[i], Cs[i + d]); Cs[i] = hi; Cs[i + d] = lo; }
      float Ds[16];
#pragma unroll
      for (int i = 0; i < 16; ++i) Ds[i] = fmaxf(Cs[i], dppself<0x4E, 0xF>(Cs[15 - i]));
#pragma unroll
      for (int d = 8; d >= 1; d >>= 1)
#pragma unroll
        for (int i = 0; i < 16; ++i)
          if ((i & d) == 0) { float hi = fmaxf(Ds[i], Ds[i + d]), lo = fminf(Ds[i], Ds[i + d]); Ds[i] = hi; Ds[i + d] = lo; }
      if (S == 0) {
#pragma unroll
        for (int i = 0; i < 16; ++i) keep[pass][i] = Ds[i];
      } else if (q == 0) {
        float* d1 = L1s + (pass * 64 + rl) * 20;
        float* d2 = L2s + (pass * 64 + rl) * 20;
#pragma unroll
        for (int i = 0; i < 4; ++i) {
          *(float4*)(d1 + 4 * i) = make_float4(keep[pass][4 * i], keep[pass][4 * i + 1], keep[pass][4 * i + 2], keep[pass][4 * i + 3]);
          *(float4*)(d2 + 4 * i) = make_float4(Ds[4 * i], Ds[4 * i + 1], Ds[4 * i + 2], Ds[4 * i + 3]);
        }
      }
    }
    if (S == 1) {
      __syncthreads();
      if (tid < 128) {
        const int row = tid;
        float A[16], Bv[16];
        const float* l1 = L1s + row * 20;
        const float* l2 = L2s + row * 20;
#pragma unroll
        for (int i = 0; i < 4; ++i) {
          const float4 x = *(const float4*)(l1 + 4 * i), y = *(const float4*)(l2 + 4 * i);
          A[4 * i] = x.x; A[4 * i + 1] = x.y; A[4 * i + 2] = x.z; A[4 * i + 3] = x.w;
          Bv[4 * i] = y.x; Bv[4 * i + 1] = y.y; Bv[4 * i + 2] = y.z; Bv[4 * i + 3] = y.w;
        }
        float T[16];
#pragma unroll
        for (int j = 0; j < 16; ++j) T[j] = pk_sum(A[0], Bv[j], 0, j);
        {
          float C0[15];
#pragma unroll
          for (int i = 1; i < 16; ++i) C0[i - 1] = pk_sum(A[i], Bv[0], i, 0);
          merge_trunc16(T, C0);
        }
        {
          float R1[7];
#pragma unroll
          for (int j = 1; j < 8; ++j) R1[j - 1] = pk_sum(A[1], Bv[j], 1, j);
          merge_trunc16(T, R1);
        }
        {
          float C1[6];
#pragma unroll
          for (int i = 2; i < 8; ++i) C1[i - 2] = pk_sum(A[i], Bv[1], i, 1);
          merge_trunc16(T, C1);
        }
        {
          float R2[3];
#pragma unroll
          for (int j = 2; j < 5; ++j) R2[j - 2] = pk_sum(A[2], Bv[j], 2, j);
          merge_trunc16(T, R2);
        }
        {
          float C2[2] = {pk_sum(A[3], Bv[2], 3, 2), pk_sum(A[4], Bv[2], 4, 2)};
          merge_trunc16(T, C2);
        }
        {
          float X3[1] = {pk_sum(A[3], Bv[3], 3, 3)};
          merge_trunc16(T, X3);
        }
        const float mx = T[0];
        float ex[16], sm = 0.f;
        unsigned ee[16];
#pragma unroll
        for (int k = 0; k < 16; ++k) {
          const unsigned tg = 255u - (__float_as_uint(T[k]) & 255u);
          const unsigned k1 = __float_as_uint(l1[tg >> 4]) & 127u, k2 = __float_as_uint(l2[tg & 15u]) & 127u;
          ee[k] = k1 * 128u + k2;
          ex[k] = __expf(T[k] - mx);
          sm += ex[k];
        }
        const float rs = 1.f / sm;
        const size_t o = (size_t)(row0 + row) * 128 + head * 16;
        uint4* elp = (uint4*)(p.EL + o);
        elp[0] = make_uint4(ee[0] | (ee[1] << 16), ee[2] | (ee[3] << 16), ee[4] | (ee[5] << 16), ee[6] | (ee[7] << 16));
        elp[1] = make_uint4(ee[8] | (ee[9] << 16), ee[10] | (ee[11] << 16), ee[12] | (ee[13] << 16), ee[14] | (ee[15] << 16));
        float4* gtp = (float4*)(p.GT + o);
#pragma unroll
        for (int i = 0; i < 4; ++i) gtp[i] = make_float4(ex[4 * i] * rs, ex[4 * i + 1] * rs, ex[4 * i + 2] * rs, ex[4 * i + 3] * rs);
      }
    }
  }
};
DEV void ph_gemm3(const P& p, char* smem) {
  int rt, hd;
  for (int it = 0; gemm_unit(it, 8, rt, hd); ++it) {
    float keep[2][16];
    {
      Epi3K<0> epi{p, rt * 128, hd, keep};
      gemm_tile(p.H + (size_t)rt * 128 * D, D, p.Wft + (size_t)(2 * hd) * 128 * D, D, D, smem, epi);
    }
    {
      Epi3K<1> epi{p, rt * 128, hd, keep};
      gemm_tile(p.H + (size_t)rt * 128 * D, D, p.Wft + (size_t)(2 * hd + 1) * 128 * D, D, D, smem, epi);
    }
  }
}

DEV float peer_gate(float scr) {
  float mx = row16_max(scr);
  float ex = __expf(scr - mx);
  float sm = row16_sum(ex);
  return ex / sm;
}
DEV float gelu_exact(float x) { return 0.5f * x * (1.f + erff(x * 0.7071067811865476f)); }

struct PeerPre { uint4 e0, e1, a0, a1; };
DEV unsigned peer_eid(const PeerPre& s, int j) {
  const unsigned w = (j < 8) ? ((j >> 1) == 0 ? s.e0.x : (j >> 1) == 1 ? s.e0.y : (j >> 1) == 2 ? s.e0.z : s.e0.w)
                             : (((j - 8) >> 1) == 0 ? s.e1.x : ((j - 8) >> 1) == 1 ? s.e1.y : ((j - 8) >> 1) == 2 ? s.e1.z : s.e1.w);
  return (j & 1) ? (w >> 16) : (w & 0xFFFFu);
}
template <int WHICH>
DEV void peer_wave_run(const P& p, int layer, int x, int tok0, int lane, float* wbuf) {
  const int r = lane >> 3, c = lane & 7;
  const unsigned char* tb = (WHICH == 0 ? p.PU : p.PV) + (size_t)x * PSLICE + c * 16;
  PeerPre S[3];
  uint4 R[16];
  auto ld_pre = [&](int tok, PeerPre& s) {
    const uint4* elp = (const uint4*)(p.EL + (size_t)tok * 128 + r * 16);
    s.e0 = elp[0]; s.e1 = elp[1];
    if (WHICH == 0) {
      s.a0 = *(const uint4*)(p.H8 + (size_t)tok * 1024 + x * 128 + c * 16);
    } else {
      const uint4* wtp = (const uint4*)(p.GW + (size_t)tok * 128 + r * 16);
      s.a0 = wtp[0]; s.a1 = wtp[1];
    }
  };
  auto comp = [&](int tok, const PeerPre& s, const PeerPre& sn, bool more) {
    if (WHICH == 0) {
      int keep0 = 0, keep1 = 0;
#pragma unroll
      for (int j = 0; j < 16; ++j) {
        const uint4 rw = R[j];
        if (more) R[j] = *(const uint4*)(tb + (size_t)peer_eid(sn, j) * 128);
        int d = __builtin_amdgcn_sdot4((int)rw.x, (int)s.a0.x, 0, false);
        d = __builtin_amdgcn_sdot4((int)rw.y, (int)s.a0.y, d, false);
        d = __builtin_amdgcn_sdot4((int)rw.z, (int)s.a0.z, d, false);
        d = __builtin_amdgcn_sdot4((int)rw.w, (int)s.a0.w, d, false);
        d += __builtin_amdgcn_update_dpp(0, d, 0xB1, 0xF, 0xF, false);
        d += __builtin_amdgcn_update_dpp(0, d, 0x4E, 0xF, 0xF, false);
        d += __builtin_amdgcn_update_dpp(0, d, 0x141, 0xF, 0xF, false);
        if (j < 8) keep0 = (c == j) ? d : keep0; else keep1 = (c == j - 8) ? d : keep1;
      }
      bf16_t* pd = p.PD + ((size_t)x * NTOK + tok) * 128 + r * 16 + c;
      pd[0] = f2bf((float)keep0); pd[8] = f2bf((float)keep1);
    } else {
      float wsv[16];
      unpack8(s.a0, wsv); unpack8(s.a1, wsv + 8);
      f32x2 acc2[8];
#pragma unroll
      for (int i = 0; i < 8; ++i) acc2[i] = (f32x2){0.f, 0.f};
#pragma unroll
      for (int j = 0; j < 16; ++j) {
        f32x2 f[8];
        unpack16_fp8x2(R[j], f);
        if (more) R[j] = *(const uint4*)(tb + (size_t)peer_eid(sn, j) * 128);
        const f32x2 w2 = (f32x2){wsv[j], wsv[j]};
#pragma unroll
        for (int i = 0; i < 8; ++i) acc2[i] += w2 * f[i];
      }
      float* slab = wbuf + (r * 8 + c) * 16;
      *(float4*)(slab) = make_float4(acc2[0][0], acc2[0][1], acc2[1][0], acc2[1][1]);
      *(float4*)(slab + 4) = make_float4(acc2[2][0], acc2[2][1], acc2[3][0], acc2[3][1]);
      *(float4*)(slab + 8) = make_float4(acc2[4][0], acc2[4][1], acc2[5][0], acc2[5][1]);
      *(float4*)(slab + 12) = make_float4(acc2[6][0], acc2[6][1], acc2[7][0], acc2[7][1]);
      asm volatile("s_waitcnt lgkmcnt(0)" ::: "memory");
      float o0 = 0.f, o1 = 0.f;
#pragma unroll
      for (int rr = 0; rr < 8; ++rr) {
        const float2 t = *(const float2*)(wbuf + (rr * 8 + (lane >> 3)) * 16 + 2 * (lane & 7));
        o0 += t.x; o1 += t.y;
      }
      asm volatile("s_waitcnt lgkmcnt(0)" ::: "memory");
      const int b = tok / LT, pp = tok % LT;
      const int mr = pp < LC ? 16 : b;
      const int col = x * 128 + 2 * lane;
      const float* g2 = p.modv + ((size_t)layer * 17 + mr) * 6144 + 5120 + col;
      unsigned* xp = (unsigned*)(p.X + (size_t)tok * D + col);
      const unsigned xu = *xp;
      *xp = pack2(bflo(xu) + g2[0] * o0, bfhi(xu) + g2[1] * o1);
    }
  };
  ld_pre(tok0, S[0]);
  ld_pre(tok0 + 1, S[1]);
#pragma unroll
  for (int j = 0; j < 16; ++j) R[j] = *(const uint4*)(tb + (size_t)peer_eid(S[0], j) * 128);
  ld_pre(tok0 + 2, S[2]);
#pragma unroll
  for (int t = 0; t < 8; ++t) {
    comp(tok0 + t, S[t % 3], S[(t + 1) % 3], t + 1 < 8);
    if (t + 3 < 8) ld_pre(tok0 + t + 3, S[t % 3]);
  }
}
DEV void ph_peer_w(const P& p) {
  for (size_t i8 = (size_t)bid_() * 256 + tid_(); i8 < (size_t)NTOK * 16; i8 += (size_t)gridDim.x * 256) {
    const size_t i = i8 * 8;
    float d[8];
#pragma unroll
    for (int q = 0; q < 8; ++q) d[q] = 0.f;
#pragma unroll
    for (int x = 0; x < 8; ++x) {
      const uint4 u = *(const uint4*)(p.PD + (size_t)x * NTOK * 128 + i);
      float f[8];
      unpack8(u, f);
#pragma unroll
      for (int q = 0; q < 8; ++q) d[q] += f[q];
    }
    const uint4 eu = *(const uint4*)(p.EL + i);
    const unsigned ew[4] = {eu.x, eu.y, eu.z, eu.w};
    const float hinv = p.HINV[i >> 7];
    float4 g0 = *(const float4*)(p.GT + i), g1 = *(const float4*)(p.GT + i + 4);
    float g[8] = {g0.x, g0.y, g0.z, g0.w, g1.x, g1.y, g1.z, g1.w};
#pragma unroll
    for (int q = 0; q < 8; ++q) {
      const unsigned e = (q & 1) ? (ew[q >> 1] >> 16) : (ew[q >> 1] & 0xFFFFu);
      g[q] = g[q] * gelu_exact(d[q] * p.PSU[e] * hinv) * p.PSV[e];
    }
    *(uint4*)(p.GW + i) = pack8(g);
  }
}
template <int WHICH>
DEV void ph_peer_gather(const P& p, int layer, char* smem, volatile LAS unsigned* slot) {
  const int tid = tid_(), lane = tid & 63, wid = tid >> 6;
  unsigned* q = p.wq + 1024 + layer * 256 + WHICH * 128;
  const int my = (int)(xb_xcc_id() & 7u);
  float* wbuf = (float*)smem + wid * 1024;
#pragma unroll 1
  for (int rot = 0; rot < 8; ++rot) {
    const int x = (my + rot) & 7;
    for (;;) {
      __syncthreads();
      if (tid == 0) *slot = atomicAdd(q + x * 16, 1u);
      __syncthreads();
      const int it = (int)*slot;
      if (it >= NTOK / 64) break;
      peer_wave_run<WHICH>(p, layer, x, it * 64 + wid * 16, lane, wbuf);
      peer_wave_run<WHICH>(p, layer, x, it * 64 + wid * 16 + 8, lane, wbuf);
    }
  }
}

DEV void ph_final(const P& p) {
  const int lane = tid_() & 63;
  int r0, r1;
  wave_range(r0, r1, NB * T);
  float gv[16];
#pragma unroll
  for (int hh = 0; hh < 2; ++hh)
#pragma unroll
    for (int i = 0; i < 8; ++i) gv[hh * 8 + i] = p.final_g[hh * 512 + 8 * lane + i];
  auto xrow = [&](int r) -> const bf16_t* { const int b = r / T, t = r % T; return p.X + ((size_t)b * LT + LC + t) * D; };
  uint4 n0 = make_uint4(0, 0, 0, 0), n1 = n0;
  if (r0 < r1) { const bf16_t* xr = xrow(r0); n0 = *(const uint4*)(xr + 8 * lane); n1 = *(const uint4*)(xr + 512 + 8 * lane); }
#pragma unroll 1
  for (int r = r0; r < r1; ++r) {
    const uint4 u0 = n0, u1 = n1;
    if (r + 1 < r1) { const bf16_t* xr = xrow(r + 1); n0 = *(const uint4*)(xr + 8 * lane); n1 = *(const uint4*)(xr + 512 + 8 * lane); }
    float v[16];
    unpack8(u0, v); unpack8(u1, v + 8);
    float ss = 0.f;
#pragma unroll
    for (int i = 0; i < 16; ++i) ss += v[i] * v[i];
    ss = wave_sum(ss);
    const float rstd = rsqrtf(ss * (1.f / 1024.f) + 1e-6f);
    float* o = p.out + (size_t)r * D;
#pragma unroll
    for (int hh = 0; hh < 2; ++hh) {
      const int col = hh * 512 + 8 * lane;
      *(float4*)(o + col) = make_float4(v[hh * 8 + 0] * rstd * gv[hh * 8 + 0], v[hh * 8 + 1] * rstd * gv[hh * 8 + 1], v[hh * 8 + 2] * rstd * gv[hh * 8 + 2], v[hh * 8 + 3] * rstd * gv[hh * 8 + 3]);
      *(float4*)(o + col + 4) = make_float4(v[hh * 8 + 4] * rstd * gv[hh * 8 + 4], v[hh * 8 + 5] * rstd * gv[hh * 8 + 5], v[hh * 8 + 6] * rstd * gv[hh * 8 + 6], v[hh * 8 + 7] * rstd * gv[hh * 8 + 7]);
    }
  }
}

DEV unsigned hw_cu_key() {
  const unsigned hwid = (unsigned)__builtin_amdgcn_s_getreg(((8 - 1) << 11) | (8 << 6) | 4);
  return (xb_xcc_id() << 8) | (hwid & 0xFFu);
}
DEV void mixB(const P& p, int layer, char* smem, volatile LAS unsigned* slot) {
  unsigned* qa = p.wq + layer * 64;
  unsigned* qs = qa + 16;
  unsigned* claim = p.cuclaim + layer * 4096;
  __syncthreads();
  if (tid_() == 0) {
    unsigned u = 0xFFFFFFFFu;
    if (atomicAdd(&claim[hw_cu_key() & 4095u], 1u) == 0u) u = atomicAdd(qs, 1u);
    *slot = u;
  }
  __syncthreads();
  {
    const unsigned u = *slot;
    if (u < 128u) scanc_unit(p, layer, (int)u, smem);
  }
  for (;;) {
    __syncthreads();
    if (tid_() == 0) *slot = atomicAdd(qa, 1u);
    __syncthreads();
    const int u = (int)*slot;
    if (u >= 8704) break;
    if (u < 4352) attn_unit(p, layer, u, smem); else hyena_conv_unit(p, layer, u - 4352, smem);
  }
  if (layer + 1 < DEPTH) {
    unsigned* qp = qa + 32;
    for (;;) {
      __syncthreads();
      if (tid_() == 0) *slot = atomicAdd(qp, 1u);
      __syncthreads();
      const int u = (int)*slot;
      if (u >= PREPA_N) break;
      prep_unit(p, layer + 1, prepA_unit_index(u), smem);
    }
  }
  for (;;) {
    __syncthreads();
    if (tid_() == 0) *slot = atomicAdd(qs, 1u);
    __syncthreads();
    const unsigned u = *slot;
    if (u >= 128u) break;
    scanc_unit(p, layer, (int)u, smem);
  }
}
DEV void mixA(const P& p, int layer, char* smem) {
  for (int u = bid_(); u < 1088; u += gridDim.x) hyena_pre_unit(p, layer, u);
  for (int u = bid_(); u < 512; u += gridDim.x) hyena_scale_unit(p, layer, u, smem);
  ph_lora(p, layer, smem);
  ph_rwkv_prep(p, layer);
}
DEV void mixC(const P& p, int layer, char* smem) {
  for (int u = bid_(); u < 1088; u += gridDim.x) hyena_post_unit(p, layer, u, smem);
  ph_rwkv_post(p, layer);
  ph_attn_post(p, layer);
}

__global__ void __launch_bounds__(256, 2) k_mega(P p) {
  extern __shared__ __attribute__((aligned(16))) char smem_all[];
  char* smem = smem_all;
  volatile LAS unsigned* xbw = (volatile LAS unsigned*)(smem_all + SMEM_BYTES);
  if (threadIdx.x == 0) { xbw[0] = 0u; xbw[1] = 0u; xbw[2] = 0u; xbw[3] = 0u; }
  __syncthreads();
  XcdBarrier bar = xcd_barrier_post(p.bar, xbw);
  ph_rope(p);
  for (int u = blockIdx.x; u < 96; u += gridDim.x) modv_unit(p, u, smem);
  ph_prep(p, 0, smem, false);
  xcd_barrier(bar);
  for (int layer = 0; layer < DEPTH; ++layer) {
    if (layer == 0) ph_norm_first(p); else ph_norm(p, layer, 0);
    xcd_barrier(bar);
    ph_gemm1(p, smem);
    xcd_barrier(bar);
    mixA(p, layer, smem);
    xcd_barrier(bar);
    mixB(p, layer, smem, (volatile LAS unsigned*)(smem_all + SMEM_BYTES + 16));
    xcd_barrier(bar);
    mixC(p, layer, smem);
    xcd_barrier(bar);
    ph_gemm2(p, layer, smem);
    ph_peerconv(p, layer);
    xcd_barrier(bar);
    ph_norm(p, layer, 1);
    xcd_barrier(bar);
    ph_gemm3(p, smem);
    xcd_barrier(bar);
    ph_peer_gather<0>(p, layer, smem, (volatile LAS unsigned*)(smem_all + SMEM_BYTES + 16));
    xcd_barrier(bar);
    ph_peer_w(p);
    xcd_barrier(bar);
    ph_peer_gather<1>(p, layer, smem, (volatile LAS unsigned*)(smem_all + SMEM_BYTES + 16));
    if (layer + 1 < DEPTH) ph_prep(p, layer + 1, smem, true);
    xcd_barrier(bar);
  }
  ph_final(p);
}

static inline size_t al256(size_t x) { return (x + 255) & ~(size_t)255; }

extern "C" void kernel_launch(void* const* d_in, const int* in_sizes, int n_in, void* d_out, int out_size, void* d_ws, size_t ws_size,
                              hipStream_t stream) {
  (void)in_sizes; (void)n_in; (void)out_size; (void)ws_size;
  P p{};
  const float** f = (const float**)&p;
  for (int i = 0; i < 39; ++i) f[i] = (const float*)d_in[i];
  p.out = (float*)d_out;
  char* w = (char*)d_ws;
  size_t off = 0;
  auto take = [&](size_t bytes) { char* r = w + off; off += al256(bytes); return r; };
  p.bar = (unsigned*)take(16384);
  p.modv = (float*)take((size_t)DEPTH * 17 * 6144 * 4);
  p.SSQ = (float*)take((size_t)DEPTH * 2 * 256 * 4);
  p.wq = (unsigned*)take(4096 + DEPTH * 1024);
  p.cuclaim = (unsigned*)take((size_t)DEPTH * 4096 * 4);
  const size_t zero_bytes = off;
  p.rope = (float*)take(64 * 16 * 2 * 4);
  p.X = (bf16_t*)take((size_t)NTOK * D * 2);
  p.H = (bf16_t*)take((size_t)NTOK * D * 2);
  p.Y = (bf16_t*)take((size_t)NTOK * D * 2);
  p.SC = (bf16_t*)take((size_t)NTOK * 1024 * 2);
  p.Z = (bf16_t*)take((size_t)NTOK * INW * 2);
  p.UTl = (bf16_t*)take((size_t)256 * 16 * T * 2);
  p.UTc = (bf16_t*)take((size_t)256 * 16 * LC * 2);
  p.YTl = (bf16_t*)take((size_t)256 * 16 * T * 2);
  p.YTc = (bf16_t*)take((size_t)256 * 16 * LC * 2);
  p.FL = (float*)take((size_t)256 * 2 * T * 4);
  p.FC = (float*)take((size_t)256 * 2 * LC * 4);
  p.W1t = (bf16_t*)take((size_t)INW * D * 2);
  p.W2t = (bf16_t*)take((size_t)D * D * 2);
  p.Wft = (bf16_t*)take((size_t)2048 * D * 2);
  p.Wlt = (bf16_t*)take((size_t)1024 * 256 * 2);
  p.Wgt = (bf16_t*)take((size_t)256 * 128 * 2);
  p.TK = (float*)p.Z;
  p.PU = (unsigned char*)p.Z + al256((size_t)NTOK * 256 * 4);
  p.PV = p.PU + (size_t)16384 * 1024;
  p.PSU = (float*)(p.PV + (size_t)16384 * 1024);
  p.PSV = p.PSU + 16384;
  p.GT = p.PSV + 16384;
  p.EL = (unsigned short*)(p.GT + (size_t)NTOK * 128);
  p.H8 = (unsigned char*)p.EL + al256((size_t)NTOK * 128 * 2);
  p.HINV = (float*)(p.H8 + (size_t)NTOK * 1024);
  p.GW = (bf16_t*)((char*)p.HINV + al256((size_t)NTOK * 4));
  p.PD = p.Y;

  (void)hipMemsetAsync(d_ws, 0, zero_bytes, stream);
  constexpr size_t kDynLds = SMEM_BYTES + 32;
  static int grid = 0;
  if (!grid) {
    int dev = 0, cus = 0, per_cu = 0;
    (void)hipGetDevice(&dev);
    (void)hipDeviceGetAttribute(&cus, hipDeviceAttributeMultiprocessorCount, dev);
    (void)hipFuncSetAttribute((const void*)k_mega, hipFuncAttributeMaxDynamicSharedMemorySize, (int)kDynLds);
    (void)hipOccupancyMaxActiveBlocksPerMultiprocessor(&per_cu, k_mega, 256, kDynLds);
    if (cus <= 0) cus = 256;
    if (per_cu > 2) per_cu = 2;
    if (per_cu < 1) per_cu = 1;
    grid = cus * per_cu;
  }
  k_mega<<<grid, 256, kDynLds, stream>>>(p);
}
```

```cpp
#include <hip/hip_runtime.h>
#include <stdint.h>
#include <type_traits>

#define DEV __device__ __forceinline__
typedef unsigned short bf16_t;
typedef short bf16x8 __attribute__((ext_vector_type(8)));
typedef float f32x2 __attribute__((ext_vector_type(2)));
constexpr size_t PSLICE = (size_t)16384 * 128;
typedef float f32x4 __attribute__((ext_vector_type(4)));
typedef float f32x16 __attribute__((ext_vector_type(16)));


constexpr int NB = 16, T = 4096, LC = 256, LT = 4352, D = 1024, NTOK = NB * LT, INW = 2688, DEPTH = 4;
constexpr int SMEM_BYTES = 65536;

struct P {
  const float *x, *c, *ctx, *c_ctx, *mod_w, *mod_b, *norm1_g, *norm2_g, *w_in, *conv_w, *conv_b;
  const float *hy_w1, *hy_b1, *hy_w2, *hy_b2, *hy_w3, *hy_b3, *hy_freq, *hy_bias;
  const float *rw_w0, *rw_w_up, *rw_a0, *rw_a_up, *rw_g_up, *rw_k_k, *rw_k_a, *rw_r_k, *rw_ln_w, *rw_ln_b;
  const float *attn_sink, *hy_out_g, *at_out_g, *w_out, *peer_wq, *peer_k1, *peer_k2, *peer_u, *peer_v, *final_g;
  float* out;
  unsigned* bar;
  float *modv, *SSQ, *rope, *FL, *FC, *TK;
  unsigned *wq, *cuclaim;
  bf16_t *X, *H, *Y, *SC, *Z, *UTl, *UTc, *YTl, *YTc;
  bf16_t *W1t, *W2t, *Wft, *Wlt, *Wgt;
  unsigned char *PU, *PV;
  float *PSU, *PSV, *GT, *HINV;
  bf16_t *PD, *GW;
  unsigned short* EL;
  unsigned char* H8;
};

typedef __bf16 hwbf2 __attribute__((ext_vector_type(2)));
DEV unsigned pack2(float a, float b) { f32x2 f = {a, b}; hwbf2 r = __builtin_convertvector(f, hwbf2); return __builtin_bit_cast(unsigned, r); }
DEV bf16_t f2bf(float f) { return (bf16_t)(pack2(f, 0.f) & 0xFFFFu); }
DEV float bf2f(bf16_t h) { return __uint_as_float(((unsigned)h) << 16); }
DEV float bflo(unsigned u) { return __uint_as_float(u << 16); }
DEV float bfhi(unsigned u) { return __uint_as_float(u & 0xFFFF0000u); }
DEV void unpack8(const uint4& u, float* v) {
  v[0] = bflo(u.x); v[1] = bfhi(u.x); v[2] = bflo(u.y); v[3] = bfhi(u.y);
  v[4] = bflo(u.z); v[5] = bfhi(u.z); v[6] = bflo(u.w); v[7] = bfhi(u.w);
}
DEV uint4 pack8(const float* v) { return make_uint4(pack2(v[0], v[1]), pack2(v[2], v[3]), pack2(v[4], v[5]), pack2(v[6], v[7])); }
DEV int pack_i8(float a, float b, float c, float d) {
  const int ia = __float2int_rn(a), ib = __float2int_rn(b), ic = __float2int_rn(c), id = __float2int_rn(d);
  return (ia & 0xFF) | ((ib & 0xFF) << 8) | ((ic & 0xFF) << 16) | ((id & 0xFF) << 24);
}
DEV float sigmoidf_(float x) { return __builtin_amdgcn_rcpf(1.f + __expf(-x)); }

template <int CTRL, int ROWMASK>
DEV float dpp0(float x) {
  return __builtin_bit_cast(float, __builtin_amdgcn_update_dpp(0, __builtin_bit_cast(int, x), CTRL, ROWMASK, 0xF, false));
}
template <int CTRL, int ROWMASK>
DEV float dppself(float x) {
  int xi = __builtin_bit_cast(int, x);
  return __builtin_bit_cast(float, __builtin_amdgcn_update_dpp(xi, xi, CTRL, ROWMASK, 0xF, false));
}
DEV float readlane_f(float x, int l) { return __builtin_bit_cast(float, __builtin_amdgcn_readlane(__builtin_bit_cast(int, x), l)); }
DEV int lane_id() { return (int)__builtin_amdgcn_mbcnt_hi(~0u, __builtin_amdgcn_mbcnt_lo(~0u, 0u)); }
DEV float writelane_f(float val, int l, float old) { return lane_id() == l ? val : old; }
DEV int writelane_i(int val, int l, int old) { return lane_id() == l ? val : old; }
DEV float wave_sum(float x) {
  x += dpp0<0x111, 0xF>(x); x += dpp0<0x112, 0xF>(x); x += dpp0<0x114, 0xF>(x); x += dpp0<0x118, 0xF>(x);
  x += dpp0<0x142, 0xA>(x); x += dpp0<0x143, 0xC>(x);
  return readlane_f(x, 63);
}
DEV float wave_max(float x) {
  x = fmaxf(x, dppself<0x111, 0xF>(x)); x = fmaxf(x, dppself<0x112, 0xF>(x)); x = fmaxf(x, dppself<0x114, 0xF>(x));
  x = fmaxf(x, dppself<0x118, 0xF>(x)); x = fmaxf(x, dppself<0x142, 0xA>(x)); x = fmaxf(x, dppself<0x143, 0xC>(x));
  return readlane_f(x, 63);
}
DEV float row16_sum(float x) {
  x += dpp0<0xB1, 0xF>(x); x += dpp0<0x4E, 0xF>(x); x += dpp0<0x141, 0xF>(x); x += dpp0<0x140, 0xF>(x);
  return x;
}
DEV float row16_max(float x) {
  x = fmaxf(x, dppself<0xB1, 0xF>(x)); x = fmaxf(x, dppself<0x4E, 0xF>(x)); x = fmaxf(x, dppself<0x141, 0xF>(x));
  x = fmaxf(x, dppself<0x140, 0xF>(x));
  return x;
}
DEV float quad_sum(float x) { x += dpp0<0xB1, 0xF>(x); x += dpp0<0x4E, 0xF>(x); return x; }

DEV f32x4 mfma16(bf16x8 a, bf16x8 b, f32x4 c) { return __builtin_amdgcn_mfma_f32_16x16x32_bf16(a, b, c, 0, 0, 0); }
DEV f32x16 mfma32(bf16x8 a, bf16x8 b, f32x16 c) { return __builtin_amdgcn_mfma_f32_32x32x16_bf16(a, b, c, 0, 0, 0); }


#define XB_TMO      128
#define XB_XCNT(j)  (256  + 64 * (j))
#define XB_XSUB(j)  (1280 + 64 * (j))
#define XB_XGEN(j)  (2304 + 64 * (j))
#define XB_TOP      3328
#define XB_TOPGEN   3392
#define XCD_BAR_WORDS 3456
#define XB_SPIN_CAP (1u << 23)
#define LAS __attribute__((address_space(3)))

__device__ __forceinline__ unsigned xb_ld(unsigned* p)              { return __hip_atomic_load(p, __ATOMIC_RELAXED, __HIP_MEMORY_SCOPE_AGENT); }
__device__ __forceinline__ unsigned xb_add(unsigned* p, unsigned v) { return __hip_atomic_fetch_add(p, v, __ATOMIC_RELAXED, __HIP_MEMORY_SCOPE_AGENT); }
__device__ __forceinline__ unsigned xb_xcc_id() { return (unsigned)__builtin_amdgcn_s_getreg((3 << 11) | 20) & 0xFu; }
#define XB_SPIN(cond, bar) do { unsigned _sp = 0; while (cond) { __builtin_amdgcn_s_sleep(1); \
    if ((++_sp & 255u) == 0u) { if (xb_ld(&(bar)[XB_TMO])) break; if (_sp > XB_SPIN_CAP) { atomicAdd(&(bar)[XB_TMO], 1u); break; } } } } while (0)

struct XcdBarrier {
    unsigned* bar; unsigned x;
    volatile LAS unsigned* st;
};
__device__ __forceinline__ XcdBarrier xcd_barrier_post(unsigned* bar, volatile LAS unsigned* st) {
    XcdBarrier b; b.bar = bar; b.x = xb_xcc_id(); b.st = st;
    if (threadIdx.x == 0) (void)xb_add(&bar[XB_XCNT(b.x)], 1u);
    return b;
}
__device__ __forceinline__ void xcd_barrier_complete(unsigned* bar, unsigned x, unsigned& nloc, unsigned& nx) {
    const unsigned G = gridDim.x * gridDim.y * gridDim.z;
    unsigned sum, cnt, mine, sp = 0u;
    for (;;) {
        sum = 0u; cnt = 0u; mine = 0u;
#pragma unroll
        for (unsigned j = 0; j < 16; ++j) { const unsigned c = xb_ld(&bar[XB_XCNT(j)]); sum += c; cnt += (c > 0u) ? 1u : 0u; mine = (j == x) ? c : mine; }
        if (sum == G) break;
        __builtin_amdgcn_s_sleep(1);
        if ((++sp & 255u) == 0u) { if (xb_ld(&bar[XB_TMO])) break; if (sp > XB_SPIN_CAP) { atomicAdd(&bar[XB_TMO], 1u); break; } }
    }
    nloc = mine > 0u ? mine : 1u; nx = cnt > 0u ? cnt : 1u;
}
__device__ __forceinline__ void xcd_barrier(const XcdBarrier& b) {
    asm volatile("s_waitcnt vmcnt(0)" ::: "memory");
    __syncthreads();
    if (threadIdx.x == 0) {
        unsigned* bar = b.bar;
        __builtin_amdgcn_s_waitcnt(0);
        unsigned nloc = b.st[0], nx = b.st[1];
        if (nloc == 0u) { xcd_barrier_complete(bar, b.x, nloc, nx); b.st[0] = nloc; b.st[1] = nx; }
        const unsigned old = xb_add(&bar[XB_XSUB(b.x)], 1u);
        const unsigned gen = old / nloc;
        if (old + 1u == (gen + 1u) * nloc) {
            __builtin_amdgcn_fence(__ATOMIC_RELEASE, "agent");
            asm volatile("s_waitcnt vmcnt(0)" ::: "memory");
            const unsigned og = xb_add(&bar[XB_TOP], 1u);
            const unsigned tg = og / nx;
            if (og + 1u == (tg + 1u) * nx) xb_add(&bar[XB_TOPGEN], 1u);
            else XB_SPIN(xb_ld(&bar[XB_TOPGEN]) == tg, bar);
            __builtin_amdgcn_fence(__ATOMIC_ACQUIRE, "agent");
            xb_add(&bar[XB_XGEN(b.x)], 1u);
            asm volatile("s_waitcnt vmcnt(0)" ::: "memory");
        } else {
            XB_SPIN(xb_ld(&bar[XB_XGEN(b.x)]) == gen, bar);
            __builtin_amdgcn_fence(__ATOMIC_ACQUIRE, "agent");
            asm volatile("s_waitcnt vmcnt(0)" ::: "memory");
        }
    }
    __syncthreads();
}

template <class Tp> DEV Tp* opq(Tp* q) { asm volatile("" : "+s"(q)); return q; }
DEV int tid_() { int t = threadIdx.x; asm volatile("" : "+v"(t)); return t; }
DEV int bid_() { int b = blockIdx.x; asm volatile("" : "+s"(b)); return b; }

DEV void glds16(const void* gsrc, char* lds_lane_ptr) {
  __builtin_amdgcn_global_load_lds((const unsigned*)gsrc, (__attribute__((address_space(3))) unsigned*)lds_lane_ptr, 16, 0, 0);
}
template <class Epi>
DEV void gemm_tile(const bf16_t* __restrict__ A, int lda, const bf16_t* __restrict__ Bt, int ldb, int K, char* smem, Epi& epi) {
  const int tid = tid_(), lane = tid & 63, wid = tid >> 6, wr = wid >> 1, wc = wid & 1, fr = lane & 15, fq = lane >> 4;
  f32x4 acc[4][4];
#pragma unroll
  for (int m = 0; m < 4; ++m)
#pragma unroll
    for (int n = 0; n < 4; ++n) acc[m][n] = (f32x4){0.f, 0.f, 0.f, 0.f};
  const int drow0 = 8 * wid + (lane >> 3), dpc = lane & 7;
  auto issue = [&](int kt, int buf) {
    char* sa = smem + buf * 32768;
    char* sb = sa + 16384;
#pragma unroll
    for (int i = 0; i < 4; ++i) {
      const int row = drow0 + 32 * i;
      const int kc = dpc ^ ((row >> 1) & 7);
      glds16(A + (size_t)row * lda + kt * 64 + kc * 8, sa + (i * 4 + wid) * 1024 + lane * 16);
      glds16(Bt + (size_t)row * ldb + kt * 64 + kc * 8, sb + (i * 4 + wid) * 1024 + lane * 16);
    }
  };
  __syncthreads();
  issue(0, 0);
  const int nk = K >> 6;
  const int sw = (fr >> 1) & 7;
  const int aoff = (wr * 64 + fr) * 128, boff = (wc * 64 + fr) * 128;
  for (int kt = 0; kt < nk; ++kt) {
    asm volatile("s_waitcnt vmcnt(0)" ::: "memory");
    __syncthreads();
    if (kt + 1 < nk) issue(kt + 1, (kt + 1) & 1);
    const char* sa = smem + (kt & 1) * 32768;
    const char* sb = sa + 16384;
#pragma unroll
    for (int kh = 0; kh < 2; ++kh) {
      const int pc = ((kh * 4 + fq) ^ sw) * 16;
      bf16x8 af[4], bfr[4];
#pragma unroll
      for (int m = 0; m < 4; ++m) af[m] = *(const bf16x8*)(sa + aoff + m * 2048 + pc);
#pragma unroll
      for (int n = 0; n < 4; ++n) bfr[n] = *(const bf16x8*)(sb + boff + n * 2048 + pc);
#pragma unroll
      for (int m = 0; m < 4; ++m)
#pragma unroll
        for (int n = 0; n < 4; ++n) acc[m][n] = mfma16(bfr[n], af[m], acc[m][n]);
    }
  }
  __syncthreads();
  epi(acc, wr, wc, fr, fq, smem);
}
DEV void stage_tile_bf16(const f32x4 (&acc)[4][4], char* smem, int wid, int fr, int fq) {
  bf16_t (*t)[72] = (bf16_t (*)[72])(smem + wid * 9216);
#pragma unroll
  for (int m = 0; m < 4; ++m)
#pragma unroll
    for (int n = 0; n < 4; ++n)
      *(uint2*)&t[m * 16 + fr][n * 16 + 4 * fq] = make_uint2(pack2(acc[m][n][0], acc[m][n][1]), pack2(acc[m][n][2], acc[m][n][3]));
  asm volatile("s_waitcnt lgkmcnt(0)" ::: "memory");
}

DEV void ph_copy(const P& p) {
  const size_t n8 = (size_t)NTOK * D / 8;
  const float* pctx = opq(p.ctx); const float* px = opq(p.x);
  for (size_t i = (size_t)bid_() * 256 + tid_(); i < n8; i += (size_t)gridDim.x * 256) {
    size_t e = i * 8;
    int row = (int)(e / D), col = (int)(e % D);
    int b = row / LT, pp = row % LT;
    const float* src = pp < LC ? pctx + ((size_t)(b * LC + pp)) * D + col : px + ((size_t)(b * T + pp - LC)) * D + col;
    float4 v0 = *(const float4*)src, v1 = *(const float4*)(src + 4);
    uint4 o = make_uint4(pack2(v0.x, v0.y), pack2(v0.z, v0.w), pack2(v1.x, v1.y), pack2(v1.z, v1.w));
    *(uint4*)(p.X + e) = o;
  }
}

DEV void ph_rope(const P& p) {
  for (int i = bid_() * 256 + tid_(); i < 64 * 16; i += gridDim.x * 256) {
    int pos = i >> 4, k = i & 15;
    float inv = powf(10000.f, -(float)k / 16.f);
    float ang = (float)pos * inv;
    p.rope[2 * i] = cosf(ang); p.rope[2 * i + 1] = sinf(ang);
  }
}

DEV void modv_unit(const P& p, int unit, char* smem) {
  const int cc = unit % 24, layer = unit / 24;
  float (*cs)[128] = (float (*)[128])smem;
  const int col = cc * 256 + tid_();
  const float* pc = opq(p.c); const float* pcc = opq(p.c_ctx);
  float acc[17];
#pragma unroll
  for (int r = 0; r < 17; ++r) acc[r] = 0.f;
  for (int ks = 0; ks < 8; ++ks) {
    __syncthreads();
    for (int i = tid_(); i < 17 * 128; i += 256) {
      int r = i >> 7, e = i & 127;
      float v = r < 16 ? pc[r * D + ks * 128 + e] : pcc[ks * 128 + e];
      cs[r][e] = v / (1.f + expf(-v));
    }
    __syncthreads();
    const float* w = p.mod_w + ((size_t)layer * D + ks * 128) * 6144 + col;
#pragma unroll 1
    for (int e0 = 0; e0 < 128; e0 += 32) {
      float wv[32];
#pragma unroll
      for (int q = 0; q < 32; ++q) wv[q] = w[(size_t)(e0 + q) * 6144];
#pragma unroll
      for (int q4 = 0; q4 < 8; ++q4) {
      const int e = e0 + 4 * q4;
      const float w0 = wv[4 * q4], w1 = wv[4 * q4 + 1], w2 = wv[4 * q4 + 2], w3 = wv[4 * q4 + 3];
#pragma unroll
      for (int r = 0; r < 17; ++r) {
        const float4 cv = *(const float4*)&cs[r][e];
        acc[r] += cv.x * w0 + cv.y * w1 + cv.z * w2 + cv.w * w3;
      }
      }
    }
  }
  const float bias = p.mod_b[layer * 6144 + col];
#pragma unroll
  for (int r = 0; r < 17; ++r) p.modv[((size_t)layer * 17 + r) * 6144 + col] = acc[r] + bias;
}

DEV void transpose_unit(const float* __restrict__ src, bf16_t* __restrict__ dst, int R, int C, int tile, char* smem) {
  float (*t)[65] = (float (*)[65])smem;
  const int nct = C / 64;
  const int tr = tile / nct, tc = tile % nct;
  __syncthreads();
  for (int i = tid_(); i < 4096; i += 256) { int r = i >> 6, c = i & 63; t[r][c] = src[(size_t)(tr * 64 + r) * C + tc * 64 + c]; }
  __syncthreads();
  for (int i = tid_(); i < 4096; i += 256) { int c = i >> 6, r = i & 63; dst[(size_t)(tc * 64 + c) * R + tr * 64 + r] = f2bf(t[r][c]); }
}

DEV void wfold_unit(const P& p, int layer, int unit, char* smem) {
  const int hs = unit >> 5, ec = unit & 31, h = hs >> 1, s = hs & 1;
  const float* wq = p.peer_wq + (size_t)layer * D * 2048;
  const float* kk = (s ? opq(p.peer_k2) : opq(p.peer_k1)) + ((size_t)layer * 8 + h) * 128 * 128;
  float (*kS)[65] = (float (*)[65])smem;
  float (*wS)[64] = (float (*)[64])(smem + 33280);
  const int key = tid_() & 127, eh = tid_() >> 7;
  float acc[16];
#pragma unroll
  for (int i = 0; i < 16; ++i) acc[i] = 0.f;
  for (int dh = 0; dh < 2; ++dh) {
    __syncthreads();
    for (int i = tid_(); i < 128 * 64; i += 256) { int k2 = i >> 6, d = i & 63; kS[k2][d] = kk[k2 * 128 + dh * 64 + d]; }
    for (int i = tid_(); i < 32 * 64; i += 256) {
      int e = i >> 6, d = i & 63;
      wS[e][d] = wq[(size_t)(ec * 32 + e) * 2048 + h * 256 + s * 128 + dh * 64 + d];
    }
    __syncthreads();
#pragma unroll 2
    for (int d = 0; d < 64; d += 4) {
      const float k0 = kS[key][d], k1 = kS[key][d + 1], k2 = kS[key][d + 2], k3 = kS[key][d + 3];
#pragma unroll
      for (int i = 0; i < 16; ++i) {
        const float4 wv = *(const float4*)&wS[eh * 16 + i][d];
        acc[i] += k0 * wv.x + k1 * wv.y + k2 * wv.z + k3 * wv.w;
      }
    }
  }
  bf16_t* dst = p.Wft + ((size_t)(hs * 128 + key)) * D + ec * 32 + eh * 16;
#pragma unroll
  for (int i = 0; i < 16; i += 2) *(unsigned*)(dst + i) = pack2(acc[i], acc[i + 1]);
}

DEV void filt_unit(const P& p, int layer, int unit, char* smem) {
  int kind, j0, L;
  if (unit < 1024) { kind = 0; j0 = unit * 4; L = T; } else { kind = 1; j0 = (unit - 1024) * 4; L = LC; }
  float* zs = (float*)smem;
  float* h1 = zs + 4 * 36;
  float* h2 = h1 + 256;
  const int jj = tid_() >> 6, o = tid_() & 63;
  const int j = j0 + jj;
  const float fj = (float)j;
  const float t = fj / (float)(L - 1);
  __syncthreads();
  if (o < 33) {
    float z;
    if (o == 0) z = t;
    else {
      int i = (o - 1) & 15;
      float band = 1e-4f + (float)i * ((15.0f - 1e-4f) / 15.0f);
      float ang = 6.283185307179586f * fj * band / (float)L;
      z = (o <= 16) ? cosf(ang) : -sinf(ang);
    }
    zs[jj * 36 + o] = z;
  }
  __syncthreads();
  {
    const float* w1 = p.hy_w1 + layer * 33 * 64;
    float a = p.hy_b1[layer * 64 + o];
#pragma unroll 3
    for (int i = 0; i < 33; ++i) a += zs[jj * 36 + i] * w1[i * 64 + o];
    h1[jj * 64 + o] = sinf(p.hy_freq[layer * 128 + o] * a);
  }
  __syncthreads();
  {
    const float* w2 = p.hy_w2 + layer * 64 * 64;
    float a = p.hy_b2[layer * 64 + o];
#pragma unroll 4
    for (int i = 0; i < 64; ++i) a += h1[jj * 64 + i] * w2[i * 64 + o];
    h2[jj * 64 + o] = sinf(p.hy_freq[layer * 128 + 64 + o] * a);
  }
  __syncthreads();
  const float* w3 = p.hy_w3 + layer * 64 * 512;
  float* F = kind ? opq(p.FC) : opq(p.FL);
  const float DMIN = -3.0701134573253945f, DMAX = -15.350567286626973f;
#pragma unroll 1
  for (int m = 0; m < 4; ++m) {
    int c = o + 64 * m;
    float af = p.hy_b3[layer * 512 + c], ab = p.hy_b3[layer * 512 + 256 + c];
#pragma unroll 4
    for (int i = 0; i < 64; ++i) { float hv = h2[jj * 64 + i]; af += hv * w3[i * 512 + c]; ab += hv * w3[i * 512 + 256 + c]; }
    float delta = fabsf(DMIN + (float)c * ((DMAX - DMIN) / 255.f));
    float win = expf(-t * delta) + 0.05f;
    af *= win; ab *= win;
    F[((size_t)c * 2 + 0) * L + j] = af;
    F[((size_t)c * 2 + 1) * L + j] = ab;
  }
}

constexpr int PREP_T0 = 672, PREP_T1 = PREP_T0 + 256, PREP_T2 = PREP_T1 + 8, PREP_T3 = PREP_T2 + 8, PREP_T4 = PREP_T3 + 8;
constexpr int PREP_WF = PREP_T4 + 512, PREP_N = PREP_WF + 1088;
DEV void prep_unit(const P& p, int layer, int u, char* smem) {
  if (u < PREP_T0) transpose_unit(p.w_in + (size_t)layer * D * INW, p.W1t, D, INW, u, smem);
  else if (u < PREP_T1) transpose_unit(p.w_out + (size_t)layer * D * D, p.W2t, D, D, u - PREP_T0, smem);
  else if (u < PREP_T3) {
    const int u0 = u - PREP_T1;
    for (int i = tid_(); i < 64 * 256; i += 256) {
      const int np = u0 * 64 + (i >> 8), kp = i & 255;
      const int ps = np & 3, chan = np >> 2, qp = kp >> 6, kk = kp & 63;
      const int is_a = ps & 1, d = ps >> 1;
      float v = 0.f;
      if (qp == (is_a ? 2 + d : d)) v = (is_a ? opq(p.rw_a_up) : opq(p.rw_w_up))[(((size_t)layer * 2 + d) * 64 + kk) * 256 + chan];
      p.Wlt[(size_t)np * 256 + kp] = f2bf(v);
    }
  }
  else if (u < PREP_T4) transpose_unit(p.rw_g_up + (size_t)layer * 128 * 256, p.Wgt, 128, 256, u - PREP_T3, smem);
  else if (u < PREP_WF) wfold_unit(p, layer, u - PREP_T4, smem);
  else filt_unit(p, layer, u - PREP_WF, smem);
}
constexpr int PREPA_N = PREP_T0 + (PREP_T4 - PREP_T1);
DEV int prepA_unit_index(int i) { return i < PREP_T0 ? i : PREP_T1 + (i - PREP_T0); }
DEV void ph_prep(const P& p, int layer, char* smem, bool onlyB) {
  for (int u = bid_(); u < PREP_N; u += gridDim.x) {
    const bool isA = (u < PREP_T0) || (u >= PREP_T1 && u < PREP_T4);
    if (onlyB && isA) continue;
    prep_unit(p, layer, u, smem);
  }
}

DEV void wave_range(int& r0, int& r1, int ntok) {
  const int gw = (bid_() * 256 + tid_()) >> 6, nw = gridDim.x * 4;
  const int per = (ntok + nw - 1) / nw;
  r0 = gw * per; r1 = r0 + per; if (r1 > ntok) r1 = ntok;
}
DEV void ph_norm_first(const P& p) {
  const int lane = tid_() & 63;
  int r0, r1;
  wave_range(r0, r1, NTOK);
  const float* pctx = opq(p.ctx); const float* px = opq(p.x);
  float gv[16], scv[16], shv[16];
#pragma unroll
  for (int hh = 0; hh < 2; ++hh)
#pragma unroll
    for (int i = 0; i < 8; ++i) gv[hh * 8 + i] = p.norm1_g[hh * 512 + 8 * lane + i];
  int mr_cur = -1;
  auto srcrow = [&](int row) -> const float* {
    const int b = row / LT, pp = row % LT;
    return pp < LC ? pctx + ((size_t)(b * LC + pp)) * D : px + ((size_t)(b * T + pp - LC)) * D;
  };
  float4 n0, n1, n2, n3;
  auto ld = [&](int row) { const float* s0 = srcrow(row) + 8 * lane; n0 = *(const float4*)s0; n1 = *(const float4*)(s0 + 4); n2 = *(const float4*)(s0 + 512); n3 = *(const float4*)(s0 + 516); };
  if (r0 < r1) ld(r0);
#pragma unroll 1
  for (int row = r0; row < r1; ++row) {
    float v[16] = {n0.x, n0.y, n0.z, n0.w, n1.x, n1.y, n1.z, n1.w, n2.x, n2.y, n2.z, n2.w, n3.x, n3.y, n3.z, n3.w};
    if (row + 1 < r1) ld(row + 1);
    const int b = row / LT, pp = row % LT;
    const int mr = pp < LC ? 16 : b;
    if (mr != mr_cur) {
      mr_cur = mr;
      const float* mv = p.modv + (size_t)mr * 6144;
#pragma unroll
      for (int hh = 0; hh < 2; ++hh)
#pragma unroll
        for (int i = 0; i < 8; ++i) { shv[hh * 8 + i] = mv[hh * 512 + 8 * lane + i]; scv[hh * 8 + i] = 1.f + mv[1024 + hh * 512 + 8 * lane + i]; }
    }
    bf16_t* xr = p.X + (size_t)row * D;
    const uint4 x0 = pack8(v), x1 = pack8(v + 8);
    *(uint4*)(xr + 8 * lane) = x0;
    *(uint4*)(xr + 512 + 8 * lane) = x1;
    unpack8(x0, v); unpack8(x1, v + 8);
    float ss = 0.f;
#pragma unroll
    for (int i = 0; i < 16; ++i) ss += v[i] * v[i];
    ss = wave_sum(ss);
    const float rstd = rsqrtf(ss * (1.f / 1024.f) + 1e-6f);
    float o[16];
#pragma unroll
    for (int i = 0; i < 16; ++i) o[i] = (v[i] * rstd * gv[i]) * scv[i] + shv[i];
    bf16_t* hr = p.H + (size_t)row * D;
    *(uint4*)(hr + 8 * lane) = pack8(o);
    *(uint4*)(hr + 512 + 8 * lane) = pack8(o + 8);
  }
}
DEV void ph_norm(const P& p, int layer, int which) {
  const int lane = tid_() & 63;
  int r0, r1;
  wave_range(r0, r1, NTOK);
  const float* g = (which ? p.norm2_g : p.norm1_g) + layer * D;
  float gv[16], scv[16], shv[16];
#pragma unroll
  for (int hh = 0; hh < 2; ++hh)
#pragma unroll
    for (int i = 0; i < 8; ++i) gv[hh * 8 + i] = g[hh * 512 + 8 * lane + i];
  int mr_cur = -1;
  uint4 n0 = make_uint4(0, 0, 0, 0), n1 = n0;
  if (r0 < r1) { const bf16_t* xr = p.X + (size_t)r0 * D; n0 = *(const uint4*)(xr + 8 * lane); n1 = *(const uint4*)(xr + 512 + 8 * lane); }
#pragma unroll 1
  for (int row = r0; row < r1; ++row) {
    const uint4 u0 = n0, u1 = n1;
    if (row + 1 < r1) { const bf16_t* xr = p.X + (size_t)(row + 1) * D; n0 = *(const uint4*)(xr + 8 * lane); n1 = *(const uint4*)(xr + 512 + 8 * lane); }
    const int b = row / LT, pp = row % LT;
    const int mr = pp < LC ? 16 : b;
    if (mr != mr_cur) {
      mr_cur = mr;
      const float* mv = p.modv + ((size_t)layer * 17 + mr) * 6144 + (which ? 3072 : 0);
#pragma unroll
      for (int hh = 0; hh < 2; ++hh)
#pragma unroll
        for (int i = 0; i < 8; ++i) { shv[hh * 8 + i] = mv[hh * 512 + 8 * lane + i]; scv[hh * 8 + i] = 1.f + mv[1024 + hh * 512 + 8 * lane + i]; }
    }
    float v[16];
    unpack8(u0, v); unpack8(u1, v + 8);
    float ss = 0.f;
#pragma unroll
    for (int i = 0; i < 16; ++i) ss += v[i] * v[i];
    ss = wave_sum(ss);
    const float rstd = rsqrtf(ss * (1.f / 1024.f) + 1e-6f);
    float o[16];
#pragma unroll
    for (int i = 0; i < 16; ++i) o[i] = (v[i] * rstd * gv[i]) * scv[i] + shv[i];
    bf16_t* hr = p.H + (size_t)row * D;
    *(uint4*)(hr + 8 * lane) = pack8(o);
    *(uint4*)(hr + 512 + 8 * lane) = pack8(o + 8);
    if (which) {
      float am = 0.f;
#pragma unroll
      for (int i = 0; i < 16; ++i) am = fmaxf(am, fabsf(o[i]));
      am = wave_max(am);
      const float sc = am > 0.f ? 127.f / am : 1.f;
      unsigned char* h8 = p.H8 + (size_t)row * 1024;
      *(uint2*)(h8 + 8 * lane) = make_uint2((unsigned)pack_i8(o[0] * sc, o[1] * sc, o[2] * sc, o[3] * sc), (unsigned)pack_i8(o[4] * sc, o[5] * sc, o[6] * sc, o[7] * sc));
      *(uint2*)(h8 + 512 + 8 * lane) = make_uint2((unsigned)pack_i8(o[8] * sc, o[9] * sc, o[10] * sc, o[11] * sc), (unsigned)pack_i8(o[12] * sc, o[13] * sc, o[14] * sc, o[15] * sc));
      if (lane == 0) p.HINV[row] = am > 0.f ? am * (1.f / 127.f) : 1.f;
    }
  }
}

DEV bool gemm_unit(int it, int nct, int& rt, int& ct) {
  const int nslot = gridDim.x >> 3;
  const int x = bid_() & 7, sl = bid_() >> 3;
  if (sl >= nslot) return false;
  const int v = it * nslot + sl;
  if (v >= 68 * nct) return false;
  const int rg = v / (8 * nct), rem = v - rg * 8 * nct;
  const int rows = (rg == 8) ? 4 : 8;
  ct = rem / rows;
  rt = x * 68 + rg * 8 + (rem - ct * rows);
  return true;
}
struct Epi1 {
  const P& p; int row0, col0;
  DEV void operator()(f32x4 (&acc)[4][4], int wr, int wc, int fr, int fq, char* smem) const {
    const int cw = col0 + wc * 64;
    const int rbase = row0 + wr * 64;
    const bool lat = (row0 % LT) >= LC;
    if (cw >= 1536 && cw < 1664) {
#pragma unroll
      for (int m = 0; m < 4; ++m)
#pragma unroll
        for (int n = 0; n < 4; ++n)
#pragma unroll
          for (int j = 0; j < 4; ++j) acc[m][n][j] = 2.f * sigmoidf_(2.f * acc[m][n][j]) - 1.f;
    } else if (cw >= 1792 && cw < 1920) {
#pragma unroll
      for (int m = 0; m < 4; ++m)
#pragma unroll
        for (int n = 0; n < 4; ++n)
#pragma unroll
          for (int j = 0; j < 4; ++j) acc[m][n][j] = sigmoidf_(acc[m][n][j]);
    } else if (cw >= 1920 && cw < 2560 && lat) {
#pragma unroll
      for (int m = 0; m < 4; ++m) {
        const int row = rbase + m * 16 + fr;
        const int pl = (row % LT) - LC;
        const int ri = pl >> 6, ci = pl & 63;
        const float4* crp = (const float4*)(p.rope + 2 * (ri * 16 + 4 * fq));
        const float4* ccp = (const float4*)(p.rope + 2 * (ci * 16 + 4 * fq));
        const float4 cr0 = crp[0], cr1 = crp[1], cc0 = ccp[0], cc1 = ccp[1];
        const float crc[4] = {cr0.x, cr0.z, cr1.x, cr1.z}, crs[4] = {cr0.y, cr0.w, cr1.y, cr1.w};
        const float ccc[4] = {cc0.x, cc0.z, cc1.x, cc1.z}, ccs[4] = {cc0.y, cc0.w, cc1.y, cc1.w};
#pragma unroll
        for (int j = 0; j < 4; ++j) {
          float x1 = acc[m][0][j], x2 = acc[m][1][j];
          acc[m][0][j] = x1 * crc[j] - x2 * crs[j]; acc[m][1][j] = x2 * crc[j] + x1 * crs[j];
          x1 = acc[m][2][j]; x2 = acc[m][3][j];
          acc[m][2][j] = x1 * ccc[j] - x2 * ccs[j]; acc[m][3][j] = x2 * ccc[j] + x1 * ccs[j];
        }
      }
    }
    const int wid = wr * 2 + wc, lane = fq * 16 + fr;
    stage_tile_bf16(acc, smem, wid, fr, fq);
    const bf16_t (*t)[72] = (const bf16_t (*)[72])(smem + wid * 9216);
#pragma unroll
    for (int i = 0; i < 8; ++i) {
      const int rl = i * 8 + (lane >> 3), ch = lane & 7;
      *(uint4*)(p.Z + (size_t)(rbase + rl) * INW + cw + ch * 8) = *(const uint4*)&t[rl][ch * 8];
    }
  }
};
DEV void ph_gemm1(const P& p, char* smem) {
  const int nct = INW / 128;
  int rt, ct;
  for (int it = 0; gemm_unit(it, nct, rt, ct); ++it) {
    Epi1 epi{p, rt * 128, ct * 128};
    gemm_tile(p.H + (size_t)rt * 128 * D, D, p.W1t + (size_t)ct * 128 * D, D, D, smem, epi);
  }
}

struct EpiLoraA {
  const P& p; int layer, row0, col0;
  DEV void operator()(f32x4 (&acc)[4][4], int wr, int wc, int fr, int fq, char* smem) const {
    const float* w0b = p.rw_w0 + layer * 512;
    const float* a0b = p.rw_a0 + layer * 512;
#pragma unroll
    for (int n = 0; n < 4; ++n) {
      const int chan = ((col0 + wc * 64 + n * 16) >> 2) + fq;
      const float be0 = w0b[chan], ba0 = a0b[chan], be1 = w0b[256 + chan], ba1 = a0b[256 + chan];
#pragma unroll
      for (int m = 0; m < 4; ++m) {
        acc[m][n][0] = 0.6065306597126334f * sigmoidf_(acc[m][n][0] + be0);
        acc[m][n][1] = sigmoidf_(acc[m][n][1] + ba0);
        acc[m][n][2] = 0.6065306597126334f * sigmoidf_(acc[m][n][2] + be1);
        acc[m][n][3] = sigmoidf_(acc[m][n][3] + ba1);
      }
    }
    const int wid = wr * 2 + wc, lane = fq * 16 + fr;
    stage_tile_bf16(acc, smem, wid, fr, fq);
    const bf16_t (*t)[72] = (const bf16_t (*)[72])(smem + wid * 9216);
#pragma unroll
    for (int i = 0; i < 8; ++i) {
      const int rl = i * 8 + (lane >> 3), ch = lane & 7;
      *(uint4*)(p.SC + (size_t)(row0 + wr * 64 + rl) * 1024 + col0 + wc * 64 + ch * 8) = *(const uint4*)&t[rl][ch * 8];
    }
  }
};
struct EpiLoraG {
  const P& p; int row0, col0;
  DEV void operator()(f32x4 (&acc)[4][4], int wr, int wc, int fr, int fq, char* smem) const {
    const int wid = wr * 2 + wc, lane = fq * 16 + fr;
    stage_tile_bf16(acc, smem, wid, fr, fq);
    const bf16_t (*t)[72] = (const bf16_t (*)[72])(smem + wid * 9216);
#pragma unroll
    for (int i = 0; i < 8; ++i) {
      const int rl = i * 8 + (lane >> 3), ch = lane & 7;
      *(uint4*)(p.Y + (size_t)(row0 + wr * 64 + rl) * D + 256 + col0 + wc * 64 + ch * 8) = *(const uint4*)&t[rl][ch * 8];
    }
  }
};
DEV void ph_lora(const P& p, int layer, char* smem) {
  int rt, ct;
  for (int it = 0; gemm_unit(it, 10, rt, ct); ++it) {
    if (ct < 8) {
      EpiLoraA epi{p, layer, rt * 128, ct * 128};
      gemm_tile(p.Z + (size_t)rt * 128 * INW + 1536, INW, p.Wlt + (size_t)ct * 128 * 256, 256, 256, smem, epi);
    } else {
      EpiLoraG epi{p, rt * 128, (ct - 8) * 128};
      gemm_tile(p.Z + (size_t)rt * 128 * INW + 1792, INW, p.Wgt + (size_t)(ct - 8) * 128 * 128, 128, 128, smem, epi);
    }
  }
}

DEV void ph_rwkv_prep(const P& p, int layer) {
  const int lane = tid_() & 63;
  int r0, r1;
  wave_range(r0, r1, NTOK);
  const float* cw = p.conv_w + (size_t)layer * 3 * 1536;
  const float* cb = p.conv_b + (size_t)layer * 1536;
  float w0[3][4], w1[3][4], w2[3][4], bb[3][4], kkw[4];
#pragma unroll
  for (int a = 0; a < 3; ++a)
#pragma unroll
    for (int i = 0; i < 4; ++i) {
      const int col = 768 + a * 256 + 4 * lane + i;
      w0[a][i] = cw[col]; w1[a][i] = cw[1536 + col]; w2[a][i] = cw[3072 + col]; bb[a][i] = cb[col];
    }
#pragma unroll
  for (int i = 0; i < 4; ++i) kkw[i] = p.rw_k_k[layer * 256 + 4 * lane + i];
  uint2 zm[3], zc[3], zp[3];
  auto ldz = [&](int row, uint2 (&z)[3]) {
#pragma unroll
    for (int a = 0; a < 3; ++a) z[a] = *(const uint2*)(p.Z + (size_t)row * INW + 768 + a * 256 + 4 * lane);
  };
  auto zero3 = [&](uint2 (&z)[3]) {
#pragma unroll
    for (int a = 0; a < 3; ++a) z[a] = make_uint2(0u, 0u);
  };
  if (r0 < r1) {
    if (r0 > 0) ldz(r0 - 1, zm); else zero3(zm);
    ldz(r0, zc);
  }
#pragma unroll 1
  for (int row = r0; row < r1; ++row) {
    if (row + 1 < NTOK) ldz(row + 1, zp); else zero3(zp);
    const int pp = row % LT;
    const bool hasm = (pp != 0) && (pp != LC);
    const bool hasp = (pp != LC - 1) && (pp != LT - 1);
    float res[3][4];
#pragma unroll
    for (int a = 0; a < 3; ++a) {
      const uint2 um = hasm ? zm[a] : make_uint2(0u, 0u), uc = zc[a], up = hasp ? zp[a] : make_uint2(0u, 0u);
      const float vm[4] = {bflo(um.x), bfhi(um.x), bflo(um.y), bfhi(um.y)};
      const float vc[4] = {bflo(uc.x), bfhi(uc.x), bflo(uc.y), bfhi(uc.y)};
      const float vp[4] = {bflo(up.x), bfhi(up.x), bflo(up.y), bfhi(up.y)};
#pragma unroll
      for (int i = 0; i < 4; ++i) res[a][i] = w0[a][i] * vm[i] + w1[a][i] * vc[i] + w2[a][i] * vp[i] + bb[a][i];
    }
    float kk[4], ss = 0.f;
#pragma unroll
    for (int i = 0; i < 4; ++i) { kk[i] = res[1][i] * kkw[i]; ss += kk[i] * kk[i]; }
    ss = row16_sum(ss);
    const float rs = rsqrtf(ss + 1e-12f);
    bf16_t* hr = p.H + (size_t)row * D + 16 * lane;
    *(uint4*)hr = make_uint4(pack2(res[0][0], res[1][0]), pack2(kk[0] * rs, res[2][0]), pack2(res[0][1], res[1][1]), pack2(kk[1] * rs, res[2][1]));
    *(uint4*)(hr + 8) = make_uint4(pack2(res[0][2], res[1][2]), pack2(kk[2] * rs, res[2][2]), pack2(res[0][3], res[1][3]), pack2(kk[3] * rs, res[2][3]));
#pragma unroll
    for (int a = 0; a < 3; ++a) { zm[a] = zc[a]; zc[a] = zp[a]; }
  }
}

DEV float oct_sum(float x) { x += dpp0<0xB1, 0xF>(x); x += dpp0<0x4E, 0xF>(x); x += dpp0<0x141, 0xF>(x); return x; }
DEV bf16x8 frag_join(uint2 lo, uint2 hi) { uint4 w = make_uint4(lo.x, lo.y, hi.x, hi.y); return __builtin_bit_cast(bf16x8, w); }
constexpr int SCS_SET = 17152, SCS_IMG = 3 * SCS_SET, SCS_W0 = SCS_IMG + 2 * 3072;
DEV void scanc_unit(const P& p, int layer, int unit, char* smem) {
  const int dir = unit & 1, h = (unit >> 1) & 3, b = unit >> 3;
  const int tid = tid_(), lane = tid & 63, fr = lane & 15, fq = lane >> 4;
  const int w = __builtin_amdgcn_readfirstlane(tid >> 6);
  bf16_t* IMG0 = (bf16_t*)(smem + SCS_W0);
  bf16_t* IMG1 = IMG0 + 512;
  bf16_t* IMG2 = IMG0 + 1024;
  __syncthreads();
  for (int i = tid; i < (2 * 3072 + 3072) / 4; i += 256) ((unsigned*)(smem + SCS_IMG))[i] = 0u;
  const float ka = p.rw_k_a[layer * 256 + h * 64 + lane];
  const size_t rowbase = (size_t)b * LT;
  const char* hbase = (const char*)p.H;
  const char* sbase = (const char*)p.SC;
  const unsigned hoff = (unsigned)(rowbase * 2048) + (unsigned)((h * 64 + lane) * 8);
  const unsigned soff = hoff + 4u * (unsigned)dir;
  bf16_t* yb = p.Z + rowbase * INW + 768 + dir * 256 + h * 64 + w * 16 + fr;
  auto pos0 = [&](int c) -> int { const int t = c * 16; return dir == 0 ? t : (t < LC ? LC - 1 - t : LT - 1 - (t - LC)); };
  const int pstep = dir == 0 ? 1 : -1;
  constexpr int NCH = LT / 16;
  struct Raw { unsigned sc[16]; uint2 hr[6]; };
  auto load_raw = [&](int c, Raw& rw) {
    if (w != 0) {
      const int p0 = pos0(c);
      const unsigned so = soff + (unsigned)(p0 * 2048);
      const int st = pstep * 2048;
#pragma unroll
      for (int i = 0; i < 16; ++i) rw.sc[i] = *(const unsigned*)(sbase + (so + (unsigned)(i * st)));
      const unsigned ho = hoff + (unsigned)((p0 + pstep * (w - 1)) * 2048);
#pragma unroll
      for (int q = 0; q < 6; ++q) {
        const int qq = ((w - 1) + 3 * q < 16) ? q : 4;
        rw.hr[q] = *(const uint2*)(hbase + (ho + (unsigned)(qq * 3 * st)));
      }
    }
  };
  auto stage1w = [&](int set, const Raw& rw, auto W1tag) {
    constexpr int W1 = decltype(W1tag)::value;
    char* base = smem + set * SCS_SET;
    bf16_t (*At)[72] = (bf16_t (*)[72])(base);
    bf16_t (*Rt)[72] = (bf16_t (*)[72])(base + 2304);
    bf16_t (*Bt)[72] = (bf16_t (*)[72])(base + 4608);
    bf16_t (*Kt)[72] = (bf16_t (*)[72])(base + 6912);
    bf16_t (*BKT)[36] = (bf16_t (*)[36])(base + 9216);
    bf16_t* VV = (bf16_t*)(base + 13824);
    float* G16 = (float*)(base + 16896);
    float Erun = 0.f;
#pragma unroll
    for (int i = 0; i < 16; ++i) {
      const float ev = bflo(rw.sc[i]);
      const float Eprev = Erun;
      Erun += ev;
      if ((i % 3) == W1) {
        const uint2 hrec = rw.hr[i / 3];
        const float rr = bflo(hrec.x), kr = bfhi(hrec.x), kkv = bflo(hrec.y);
        const float av = bfhi(rw.sc[i]);
        const float gp = __expf(-Eprev), gi = __expf(-Erun), ig = __expf(Erun);
        const float at = -kkv * gp, rt = rr * gi, bt = kkv * av * ig, kt2 = kr * (1.f + (av - 1.f) * ka) * ig;
        const unsigned ar = pack2(at, rt), bk = pack2(bt, kt2);
        At[i][lane] = (bf16_t)(ar & 0xFFFFu); Rt[i][lane] = (bf16_t)(ar >> 16);
        Bt[i][lane] = (bf16_t)(bk & 0xFFFFu); Kt[i][lane] = (bf16_t)(bk >> 16);
        BKT[lane][(i >> 2) * 8 + (i & 3)] = (bf16_t)(bk & 0xFFFFu);
        BKT[lane][(i >> 2) * 8 + 4 + (i & 3)] = (bf16_t)(bk >> 16);
        VV[((i >> 2) * 64 + lane) * 6 + (i & 3)] = (bf16_t)(hrec.y >> 16);
        if (i == 15) G16[lane] = gi;
      }
    }
  };
  auto stage1 = [&](int set, const Raw& rw) {
    if (w == 1) stage1w(set, rw, std::integral_constant<int, 0>{});
    else if (w == 2) stage1w(set, rw, std::integral_constant<int, 1>{});
    else if (w == 3) stage1w(set, rw, std::integral_constant<int, 2>{});
  };
  auto stage2 = [&](int set, int iset) {
    char* base = smem + set * SCS_SET;
    const bf16_t (*At)[72] = (const bf16_t (*)[72])(base);
    const bf16_t (*Rt)[72] = (const bf16_t (*)[72])(base + 2304);
    const bf16_t (*Bt)[72] = (const bf16_t (*)[72])(base + 4608);
    const bf16_t (*Kt)[72] = (const bf16_t (*)[72])(base + 6912);
    bf16_t* TT = (bf16_t*)(smem + SCS_IMG + iset * 3072);
    bf16_t* ARK = TT + 512;
    bf16_t* AAK = TT + 1024;
    const bf16_t (*X)[72] = (w < 2) ? At : Rt;
    const bf16_t (*Y)[72] = (w & 1) ? Kt : Bt;
    f32x4 cm = (f32x4){0.f, 0.f, 0.f, 0.f};
#pragma unroll
    for (int s = 0; s < 2; ++s) {
      bf16x8 af = *(const bf16x8*)&X[fr][32 * s + 8 * fq];
      bf16x8 bm = *(const bf16x8*)&Y[fr][32 * s + 8 * fq];
      cm = mfma16(af, bm, cm);
    }
#pragma unroll
    for (int jj = 0; jj < 4; ++jj) {
      const int i = 4 * fq + jj;
      const bool keep = (w < 2) ? (fr < i) : (fr <= i);
      cm[jj] = keep ? cm[jj] : 0.f;
    }
    const int io = (fr >> 2) * 8 + (fr & 3);
    auto wr_img = [&](bf16_t* img, const f32x4& Xv, int hi) {
#pragma unroll
      for (int jj = 0; jj < 4; ++jj) img[(4 * fq + jj) * 32 + io + hi] = f2bf(Xv[jj]);
    };
    if (w == 1) wr_img(AAK, cm, 0);
    else if (w == 2) wr_img(ARK, cm, 0);
    else if (w == 3) wr_img(ARK, cm, 4);
    else {
      auto bfrag = [&](const f32x4& Xv) { return frag_join(make_uint2(pack2(Xv[0], Xv[1]), pack2(Xv[2], Xv[3])), make_uint2(0u, 0u)); };
      auto afr = [&](const bf16_t* img) { return *(const bf16x8*)&img[(fr * 4 + fq) * 8]; };
      const f32x4 Z4 = (f32x4){0.f, 0.f, 0.f, 0.f};
      wr_img(IMG0, cm, 0);
      asm volatile("" ::: "memory");
      f32x4 A2 = mfma16(afr(IMG0), bfrag(cm), Z4);
      wr_img(IMG1, A2, 0);
      asm volatile("" ::: "memory");
      f32x4 A4 = mfma16(afr(IMG1), bfrag(A2), Z4);
      wr_img(IMG2, A4, 0);
      asm volatile("" ::: "memory");
      f32x4 Rm = mfma16(afr(IMG2), bfrag(A4), Z4);
#pragma unroll
      for (int jj = 0; jj < 4; ++jj) Rm[jj] += (fr == 4 * fq + jj) ? 1.f : 0.f;
      Rm = mfma16(afr(IMG2), bfrag(Rm), Rm);
      Rm = mfma16(afr(IMG1), bfrag(Rm), Rm);
      Rm = mfma16(afr(IMG0), bfrag(Rm), Rm);
      wr_img(TT, Rm, 0);
    }
  };
  f32x4 acc[4];
#pragma unroll
  for (int kt = 0; kt < 4; ++kt) acc[kt] = (f32x4){0.f, 0.f, 0.f, 0.f};
  auto part2 = [&](int c, int set, int iset) {
    char* base = smem + set * SCS_SET;
    const bf16_t (*At)[72] = (const bf16_t (*)[72])(base);
    const bf16_t (*Rt)[72] = (const bf16_t (*)[72])(base + 2304);
    const bf16_t (*BKT)[36] = (const bf16_t (*)[36])(base + 9216);
    const bf16_t* VV = (const bf16_t*)(base + 13824);
    const float* G16 = (const float*)(base + 16896);
    const bf16_t* TT = (const bf16_t*)(smem + SCS_IMG + iset * 3072);
    const bf16_t* ARK = TT + 512;
    const bf16_t* AAK = TT + 1024;
    bf16x8 Sb[2];
#pragma unroll
    for (int s = 0; s < 2; ++s) {
      uint4 t = make_uint4(pack2(acc[2 * s][0], acc[2 * s][1]), pack2(acc[2 * s][2], acc[2 * s][3]),
                           pack2(acc[2 * s + 1][0], acc[2 * s + 1][1]), pack2(acc[2 * s + 1][2], acc[2 * s + 1][3]));
      Sb[s] = __builtin_bit_cast(bf16x8, t);
    }
    const unsigned* vvp = (const unsigned*)&VV[(fq * 64 + w * 16 + fr) * 6];
    const uint2 vv = make_uint2(vvp[0], vvp[1]);
    const bf16x8 Vlow = frag_join(vv, make_uint2(0u, 0u));
    f32x4 Pm = (f32x4){0.f, 0.f, 0.f, 0.f};
#pragma unroll
    for (int s = 0; s < 2; ++s) {
      bf16x8 af = frag_join(*(const uint2*)&At[fr][32 * s + 4 * fq], *(const uint2*)&At[fr][32 * s + 16 + 4 * fq]);
      Pm = mfma16(af, Sb[s], Pm);
    }
    Pm = mfma16(*(const bf16x8*)&AAK[(fr * 4 + fq) * 8], Vlow, Pm);
    const bf16x8 Pb = frag_join(make_uint2(pack2(Pm[0], Pm[1]), pack2(Pm[2], Pm[3])), make_uint2(0u, 0u));
    f32x4 U = mfma16(*(const bf16x8*)&TT[(fr * 4 + fq) * 8], Pb, (f32x4){0.f, 0.f, 0.f, 0.f});
    const bf16x8 UV = frag_join(make_uint2(pack2(U[0], U[1]), pack2(U[2], U[3])), vv);
    f32x4 Yv = (f32x4){0.f, 0.f, 0.f, 0.f};
#pragma unroll
    for (int s = 0; s < 2; ++s) {
      bf16x8 af = frag_join(*(const uint2*)&Rt[fr][32 * s + 4 * fq], *(const uint2*)&Rt[fr][32 * s + 16 + 4 * fq]);
      Yv = mfma16(af, Sb[s], Yv);
    }
    Yv = mfma16(*(const bf16x8*)&ARK[(fr * 4 + fq) * 8], UV, Yv);
    {
      const int p0 = pos0(c);
#pragma unroll
      for (int jj = 0; jj < 4; ++jj) yb[(size_t)(p0 + pstep * (4 * fq + jj)) * INW] = f2bf(Yv[jj]);
    }
#pragma unroll
    for (int kt = 0; kt < 4; ++kt) {
      f32x4 t = mfma16(frag_join(*(const uint2*)&BKT[16 * kt + fr][fq * 8], *(const uint2*)&BKT[16 * kt + fr][fq * 8 + 4]), UV, acc[kt]);
      const float4 g4 = *(const float4*)&G16[16 * kt + 4 * fq];
      t[0] *= g4.x; t[1] *= g4.y; t[2] *= g4.z; t[3] *= g4.w;
      acc[kt] = t;
    }
  };
  __builtin_amdgcn_s_setprio(3);
  Raw r0, r1;
  load_raw(0, r0); load_raw(1, r1);
  stage1(0, r0);
  load_raw(2, r0);
  __syncthreads();
  stage2(0, 0);
  stage1(1, r1);
  load_raw(3, r1);
  __syncthreads();
  int s0 = 0, s1 = 1, s2 = 2;
  auto iter = [&](int c, Raw& rw) {
    if (c + 1 < NCH) stage2(s1, (c + 1) & 1);
    part2(c, s0, c & 1);
    if (c + 2 < NCH) {
      stage1(s2, rw);
      if (c + 4 < NCH) load_raw(c + 4, rw);
    }
    asm volatile("s_waitcnt lgkmcnt(0)" ::: "memory");
    __builtin_amdgcn_s_barrier();
    asm volatile("" ::: "memory");
    const int t = s0; s0 = s1; s1 = s2; s2 = t;
  };
#pragma unroll 1
  for (int c = 0; c < NCH; c += 2) {
    iter(c, r0); iter(c + 1, r1);
  }
  __builtin_amdgcn_s_setprio(0);
}

DEV void ph_rwkv_post(const P& p, int layer) {
  const int lane = tid_() & 63;
  int r0, r1;
  wave_range(r0, r1, NTOK);
  const int ch = 4 * lane;
  float kav[4], rkv[4], lnw[4], lnb[4];
#pragma unroll
  for (int i = 0; i < 4; ++i) {
    kav[i] = p.rw_k_a[layer * 256 + ch + i]; rkv[i] = p.rw_r_k[layer * 256 + ch + i];
    lnw[i] = p.rw_ln_w[layer * 256 + ch + i]; lnb[i] = p.rw_ln_b[layer * 256 + ch + i];
  }
  struct In { uint2 y0, y1, g; uint4 h0, h1, s0, s1; };
  auto ld = [&](int row, In& in) {
    const bf16_t* zr = p.Z + (size_t)row * INW + 768 + ch;
    in.y0 = *(const uint2*)zr; in.y1 = *(const uint2*)(zr + 256);
    const bf16_t* hr = p.H + (size_t)row * D + 4 * ch;
    in.h0 = *(const uint4*)hr; in.h1 = *(const uint4*)(hr + 8);
    const bf16_t* sr = p.SC + (size_t)row * 1024 + 4 * ch;
    in.s0 = *(const uint4*)sr; in.s1 = *(const uint4*)(sr + 8);
    in.g = *(const uint2*)(p.Y + (size_t)row * D + 256 + ch);
  };
  In nx;
  if (r0 < r1) ld(r0, nx);
#pragma unroll 1
  for (int row = r0; row < r1; ++row) {
    const In in = nx;
    if (row + 1 < r1) ld(row + 1, nx);
    float y[4] = {bflo(in.y0.x) + bflo(in.y1.x), bfhi(in.y0.x) + bfhi(in.y1.x), bflo(in.y0.y) + bflo(in.y1.y), bfhi(in.y0.y) + bfhi(in.y1.y)};
    const float mu = row16_sum(y[0] + y[1] + y[2] + y[3]) * (1.f / 64.f);
    float vs = 0.f;
#pragma unroll
    for (int i = 0; i < 4; ++i) { y[i] -= mu; vs += y[i] * y[i]; }
    const float var = row16_sum(vs) * (1.f / 64.f);
    const float rstd = rsqrtf(var + 64e-5f);
    const float r[4] = {bflo(in.h0.x), bflo(in.h0.z), bflo(in.h1.x), bflo(in.h1.z)};
    const float k[4] = {bfhi(in.h0.x), bfhi(in.h0.z), bfhi(in.h1.x), bfhi(in.h1.z)};
    const float v[4] = {bfhi(in.h0.y), bfhi(in.h0.w), bfhi(in.h1.y), bfhi(in.h1.w)};
    const float a0[4] = {bfhi(in.s0.x), bfhi(in.s0.z), bfhi(in.s1.x), bfhi(in.s1.z)};
    const float a1[4] = {bfhi(in.s0.y), bfhi(in.s0.w), bfhi(in.s1.y), bfhi(in.s1.w)};
    float sd = 0.f;
#pragma unroll
    for (int i = 0; i < 4; ++i) {
      const float kd0 = k[i] * (1.f + (a0[i] - 1.f) * kav[i]), kd1 = k[i] * (1.f + (a1[i] - 1.f) * kav[i]);
      sd += r[i] * (kd0 + kd1) * rkv[i];
    }
    sd = row16_sum(sd);
    const float g[4] = {bflo(in.g.x), bfhi(in.g.x), bflo(in.g.y), bfhi(in.g.y)};
    float o[4];
#pragma unroll
    for (int i = 0; i < 4; ++i) {
      const float yn = y[i] * rstd * lnw[i] + lnb[i];
      o[i] = (yn + sd * v[i]) * g[i];
    }
    *(uint2*)(p.Y + (size_t)row * D + 256 + ch) = make_uint2(pack2(o[0], o[1]), pack2(o[2], o[3]));
  }
}

DEV void hyena_pre_unit(const P& p, int layer, int unit) {
  int kind, b, t0, L;
  if (unit < 1024) { kind = 0; b = unit >> 6; t0 = (unit & 63) * 64; L = T; } else { int u = unit - 1024; kind = 1; b = u >> 2; t0 = (u & 3) * 64; L = LC; }
  const int lane = tid_() & 63, wid = tid_() >> 6;
  const int tw = t0 + wid * 16;
  const size_t row0 = (size_t)b * LT + (kind ? 0 : LC);
  const float* cw = p.conv_w + (size_t)layer * 3 * 1536;
  const float* cb = p.conv_b + (size_t)layer * 1536;
  float wx[3][4], wv[3][4], bx[4], bv[4];
#pragma unroll
  for (int i = 0; i < 4; ++i) {
    const int cx = 256 + 4 * lane + i, cv = 512 + 4 * lane + i;
#pragma unroll
    for (int k = 0; k < 3; ++k) { wx[k][i] = cw[k * 1536 + cx]; wv[k][i] = cw[k * 1536 + cv]; }
    bx[i] = cb[cx]; bv[i] = cb[cv];
  }
  uint2 zx[18], zv[18];
#pragma unroll
  for (int i = 0; i < 18; ++i) {
    const int t = tw - 1 + i;
    if (t >= 0 && t < L) {
      const bf16_t* zr = p.Z + (row0 + t) * INW + 256 + 4 * lane;
      zx[i] = *(const uint2*)zr; zv[i] = *(const uint2*)(zr + 256);
    } else { zx[i] = make_uint2(0u, 0u); zv[i] = make_uint2(0u, 0u); }
  }
  float uo[4][16];
#pragma unroll
  for (int i = 0; i < 16; ++i) {
    const float xm[4] = {bflo(zx[i].x), bfhi(zx[i].x), bflo(zx[i].y), bfhi(zx[i].y)};
    const float xc[4] = {bflo(zx[i + 1].x), bfhi(zx[i + 1].x), bflo(zx[i + 1].y), bfhi(zx[i + 1].y)};
    const float xp[4] = {bflo(zx[i + 2].x), bfhi(zx[i + 2].x), bflo(zx[i + 2].y), bfhi(zx[i + 2].y)};
    const float vm[4] = {bflo(zv[i].x), bfhi(zv[i].x), bflo(zv[i].y), bfhi(zv[i].y)};
    const float vc[4] = {bflo(zv[i + 1].x), bfhi(zv[i + 1].x), bflo(zv[i + 1].y), bfhi(zv[i + 1].y)};
    const float vp[4] = {bflo(zv[i + 2].x), bfhi(zv[i + 2].x), bflo(zv[i + 2].y), bfhi(zv[i + 2].y)};
#pragma unroll
    for (int q = 0; q < 4; ++q) {
      const float a = wx[0][q] * xm[q] + wx[1][q] * xc[q] + wx[2][q] * xp[q] + bx[q];
      const float c2 = wv[0][q] * vm[q] + wv[1][q] * vc[q] + wv[2][q] * vp[q] + bv[q];
      uo[q][i] = a * c2;
    }
  }
  bf16_t* ut = kind ? opq(p.UTc) : opq(p.UTl);
#pragma unroll
  for (int q = 0; q < 4; ++q) {
    bf16_t* dst = ut + ((size_t)(4 * lane + q) * 16 + b) * L + tw;
    *(uint4*)dst = pack8(&uo[q][0]);
    *(uint4*)(dst + 8) = pack8(&uo[q][8]);
  }
}

DEV void lds_barrier() {
  asm volatile("s_waitcnt lgkmcnt(0)" ::: "memory");
  __builtin_amdgcn_s_barrier();
  asm volatile("" ::: "memory");
}
DEV void hyena_scale_unit(const P& p, int layer, int u, char* smem) {
  const int kind = u >> 8, c = u & 255, L = kind ? LC : T;
  const float* F = (kind ? opq(p.FC) : opq(p.FL)) + (size_t)c * 2 * L;
  float* red = (float*)smem;
  const int tid = tid_(), lane = tid & 63, wid = tid >> 6;
  float part = 0.f;
  for (int i = tid; i < 2 * L; i += 256) { float fv = F[i]; part += (i != L) ? fv * fv : 0.f; }
  part = wave_sum(part);
  __syncthreads();
  if (lane == 0) red[wid] = part;
  __syncthreads();
  if (tid == 0) p.SSQ[(layer * 2 + kind) * 256 + c] = rsqrtf(((red[0] + red[1]) + (red[2] + red[3])) + 1e-6f);
}
constexpr int HC_CQ = 65 * 144, HC_US = 32 * 272, HC_BUF = HC_CQ + HC_US;
typedef const __attribute__((address_space(1))) float* gfloat_p;
typedef unsigned u32x4_t __attribute__((ext_vector_type(4)));
typedef const __attribute__((address_space(1))) u32x4_t* guint4_p;
DEV void hyena_conv_unit(const P& p, int layer, int unit, char* smem) {
  int kind, c, tb, L;
  if (unit < 4096) { kind = 0; c = unit >> 4; tb = (unit & 15) * 256; L = T; } else { kind = 1; c = unit - 4096; tb = 0; L = LC; }
  const int tid = tid_(), lane = tid & 63, wid = tid >> 6, fr = lane & 15, fq = lane >> 4;
  const gfloat_p F = (gfloat_p)((kind ? opq(p.FC) : opq(p.FL)) + (size_t)c * 2 * L);
  const int nch = L / 256;
  const int bb = tid >> 4, sg0 = tid & 15;
  const guint4_p U = (guint4_p)((kind ? opq(p.UTc) : opq(p.UTl)) + (size_t)c * 16 * L + (size_t)bb * L + 8 * sg0);
  auto ldchunk = [&](int ch, float& f0, float& f1, float& f2, uint4& u0, uint4& u1) {
    const int D0 = tb + 256 - ch * 256;
    auto tap = [&](int n) -> float {
      const int d = D0 - n;
      const bool ok = (d > -L) && (d < L);
      int idx = d >= 0 ? d : L - d;
      idx = ok ? idx : 0;
      return F[idx];
    };
    f0 = tap(tid); f1 = tap(tid + 256); f2 = tap(tid < 8 ? tid + 512 : 100000);
    const u32x4_t w0 = U[ch * 32], w1 = U[ch * 32 + 16];
    u0 = make_uint4(w0.x, w0.y, w0.z, w0.w); u1 = make_uint4(w1.x, w1.y, w1.z, w1.w);
  };
  const float scale = p.SSQ[(layer * 2 + kind) * 256 + c];
  float fa0, fa1, fa2, fb0, fb1, fb2, fc0, fc1, fc2;
  uint4 ua0, ua1, ub0, ub1, uc0, uc1;
  const int lastc = nch - 1;
  ldchunk(0, fa0, fa1, fa2, ua0, ua1);
  ldchunk(min(1, lastc), fb0, fb1, fb2, ub0, ub1);
  ldchunk(min(2, lastc), fc0, fc1, fc2, uc0, uc1);
  auto stchunk = [&](int ch, float f0, float f1, float f2, const uint4& u0, const uint4& u1) {
    const int buf = ch & 1;
    bf16_t* Cq = (bf16_t*)(smem + buf * HC_BUF);
    char* Us = smem + buf * HC_BUF + HC_CQ;
    const int d0 = tb + 256 - ch * 256 - tid, d1 = d0 - 256, d2 = d0 - 512;
    const bf16_t h0 = f2bf((d0 > -L && d0 < L) ? f0 * scale : 0.f), h1 = f2bf((d1 > -L && d1 < L) ? f1 * scale : 0.f);
    const bf16_t h2 = f2bf((d2 > -L && d2 < L) ? f2 * scale : 0.f);
#pragma unroll
    for (int rho = 0; rho < 8; ++rho) {
      int m = tid + rho;
      Cq[(m >> 3) * 72 + rho * 8 + (m & 7)] = h0;
      m = tid + 256 + rho;
      if (m < 520) Cq[(m >> 3) * 72 + rho * 8 + (m & 7)] = h1;
      m = tid + 512 + rho;
      if (tid < 8 && m < 520) Cq[(m >> 3) * 72 + rho * 8 + (m & 7)] = h2;
    }
    if (tid < 8) {
#pragma unroll
      for (int rho = 1; rho < 8; ++rho) if (tid < rho) Cq[rho * 8 + tid] = 0;
    }
    *(uint4*)(Us + sg0 * 272 + bb * 16) = u0;
    *(uint4*)(Us + (sg0 + 16) * 272 + bb * 16) = u1;
  };
  f32x4 acc[4];
#pragma unroll
  for (int m = 0; m < 4; ++m) acc[m] = (f32x4){0.f, 0.f, 0.f, 0.f};
  const int a0 = (32 - 8 * wid + fq - (fr >> 3)) * 144 + (fr & 7) * 16;
  auto compute = [&](int buf) {
    const char* Cq = smem + buf * HC_BUF + a0;
    const char* Us = smem + buf * HC_BUF + HC_CQ + fq * 272 + fr * 16;
    bf16x8 fa[4];
#pragma unroll
    for (int m = 0; m < 4; ++m) fa[m] = *(const bf16x8*)(Cq - m * 288);
#pragma unroll
    for (int kk = 0; kk < 8; ++kk) {
      const bf16x8 bf = *(const bf16x8*)(Us + kk * 4 * 272);
      if (kk > 0) {
        fa[3] = fa[1]; fa[2] = fa[0];
        fa[1] = *(const bf16x8*)(Cq + (2 * kk - 1) * 288);
        fa[0] = *(const bf16x8*)(Cq + (2 * kk) * 288);
      }
#pragma unroll
      for (int m = 0; m < 4; ++m) acc[m] = mfma16(fa[m], bf, acc[m]);
    }
  };
  __syncthreads();
  int ch = 0;
#pragma unroll 1
  for (; ch + 3 <= lastc; ch += 3) {
    stchunk(ch, fa0, fa1, fa2, ua0, ua1);
    lds_barrier();
    ldchunk(min(ch + 3, lastc), fa0, fa1, fa2, ua0, ua1);
    compute(ch & 1);
    stchunk(ch + 1, fb0, fb1, fb2, ub0, ub1);
    lds_barrier();
    ldchunk(min(ch + 4, lastc), fb0, fb1, fb2, ub0, ub1);
    compute((ch + 1) & 1);
    stchunk(ch + 2, fc0, fc1, fc2, uc0, uc1);
    lds_barrier();
    ldchunk(min(ch + 5, lastc), fc0, fc1, fc2, uc0, uc1);
    compute(ch & 1);
  }
  stchunk(ch, fa0, fa1, fa2, ua0, ua1);
  lds_barrier();
  compute(ch & 1);
  bf16_t* Yt = (kind ? opq(p.YTc) : opq(p.YTl)) + ((size_t)c * 16 + fr) * L + tb;
#pragma unroll
  for (int m = 0; m < 4; ++m) {
    int t = (wid * 4 + m) * 16 + fq * 4;
    *(uint2*)(Yt + t) = make_uint2(pack2(acc[m][0], acc[m][1]), pack2(acc[m][2], acc[m][3]));
  }
}

DEV void hyena_post_unit(const P& p, int layer, int unit, char* smem) {
  (void)smem;
  int kind, b, t0, L;
  if (unit < 1024) { kind = 0; b = unit >> 6; t0 = (unit & 63) * 64; L = T; } else { int u = unit - 1024; kind = 1; b = u >> 2; t0 = (u & 3) * 64; L = LC; }
  const int lane = tid_() & 63, wid = tid_() >> 6;
  const int tw = t0 + wid * 16;
  const size_t row0 = (size_t)b * LT + (kind ? 0 : LC);
  const float* cw = p.conv_w + (size_t)layer * 3 * 1536;
  float w0[3][4], b0[4], bias[4], og[4];
#pragma unroll
  for (int i = 0; i < 4; ++i) {
    const int c = 4 * lane + i;
#pragma unroll
    for (int k = 0; k < 3; ++k) w0[k][i] = cw[k * 1536 + c];
    b0[i] = p.conv_b[layer * 1536 + c]; bias[i] = p.hy_bias[layer * 256 + c]; og[i] = p.hy_out_g[layer * 256 + c];
  }
  uint2 zx[18];
#pragma unroll
  for (int i = 0; i < 18; ++i) {
    const int t = tw - 1 + i;
    zx[i] = (t >= 0 && t < L) ? *(const uint2*)(p.Z + (row0 + t) * INW + 4 * lane) : make_uint2(0u, 0u);
  }
  const bf16_t* ytb = kind ? opq(p.YTc) : opq(p.YTl);
  const bf16_t* utb = kind ? opq(p.UTc) : opq(p.UTl);
  float o[4][16];
#pragma unroll
  for (int q = 0; q < 4; ++q) {
    const size_t off = ((size_t)(4 * lane + q) * 16 + b) * L + tw;
    float yv[16], uv[16];
    { uint4 a0 = *(const uint4*)(ytb + off), a1 = *(const uint4*)(ytb + off + 8); unpack8(a0, yv); unpack8(a1, yv + 8); }
    { uint4 a0 = *(const uint4*)(utb + off), a1 = *(const uint4*)(utb + off + 8); unpack8(a0, uv); unpack8(a1, uv + 8); }
#pragma unroll
    for (int i = 0; i < 16; ++i) o[q][i] = yv[i] + uv[i] * bias[q];
  }
#pragma unroll
  for (int i = 0; i < 16; ++i) {
    const float xm[4] = {bflo(zx[i].x), bfhi(zx[i].x), bflo(zx[i].y), bfhi(zx[i].y)};
    const float xc[4] = {bflo(zx[i + 1].x), bfhi(zx[i + 1].x), bflo(zx[i + 1].y), bfhi(zx[i + 1].y)};
    const float xp[4] = {bflo(zx[i + 2].x), bfhi(zx[i + 2].x), bflo(zx[i + 2].y), bfhi(zx[i + 2].y)};
    float ov[4], ss = 0.f;
#pragma unroll
    for (int q = 0; q < 4; ++q) {
      const float x0 = w0[0][q] * xm[q] + w0[1][q] * xc[q] + w0[2][q] * xp[q] + b0[q];
      ov[q] = bf2f(f2bf(x0 * o[q][i]));
      ss += ov[q] * ov[q];
    }
    ss = wave_sum(ss);
    const float rstd = rsqrtf(ss * (1.f / 256.f) + 1e-6f);
    *(uint2*)(p.Y + (row0 + tw + i) * D + 4 * lane) = make_uint2(pack2(ov[0] * rstd * og[0], ov[1] * rstd * og[1]), pack2(ov[2] * rstd * og[2], ov[3] * rstd * og[3]));
  }
}

DEV void attn_unit(const P& p, int layer, int unit, char* smem) {
  const bool isctx = unit >= 4096;
  int b, qb, hq;
  if (!isctx) { b = unit >> 8; qb = (unit >> 3) & 31; hq = unit & 7; } else { int u = unit - 4096; b = u >> 4; qb = (u >> 3) & 1; hq = u & 7; }
  const int g = hq >> 2;
  const int tid = tid_(), lane = tid & 63, wid = tid >> 6, qn = lane & 31, hh = lane >> 5;
  const int qpos = qb * 128 + wid * 32 + qn;
  const size_t qrow = (size_t)b * LT + (isctx ? qpos : LC + qpos);
  const bf16_t* qptr = p.Z + qrow * INW + 1920 + hq * 64;
  bf16x8 qf[4];
#pragma unroll
  for (int s = 0; s < 4; ++s) qf[s] = *(const bf16x8*)(qptr + 16 * s + 8 * hh);
  const float c2 = 0.125f * 1.4426950408889634f;
  const int q0w = qb * 128 + wid * 32;
  float m_run = p.attn_sink[layer * 8 + hq] * 1.4426950408889634f, l_run = 1.f;
  f32x16 o0, o1;
#pragma unroll
  for (int i = 0; i < 16; ++i) { o0[i] = 0.f; o1[i] = 0.f; }
  typedef bf16_t KTile[64][72];
  typedef bf16_t VTile[64][68];
  KTile* Ks = (KTile*)smem;
  VTile* Vt = (VTile*)(smem + 18432);
  const int ntl = isctx ? 0 : 6;
  const int ntiles = ntl + 4;
  const int skey = tid >> 3, sseg = tid & 7;
  const bf16_t* kvbase = p.Z + (size_t)b * LT * INW + 1920 + 512 + g * 64 + sseg * 8;
  auto ldtile = [&](int kt, uint4& rk0, uint4& rk1, uint4& rv0, uint4& rv1) {
    const bool ctxk = kt >= ntl;
    const int kbase = ctxk ? (kt - ntl) * 64 : qb * 128 - 128 + kt * 64;
    int kp0 = kbase + skey, kp1 = kp0 + 32;
    if (!ctxk) { kp0 = min(max(kp0, 0), T - 1) + LC; kp1 = min(max(kp1, 0), T - 1) + LC; }
    const bf16_t* s0 = kvbase + (size_t)kp0 * INW;
    const bf16_t* s1 = kvbase + (size_t)kp1 * INW;
    rk0 = *(const uint4*)s0; rv0 = *(const uint4*)(s0 + 128);
    rk1 = *(const uint4*)s1; rv1 = *(const uint4*)(s1 + 128);
  };
  auto sttile = [&](int buf, const uint4& rk0, const uint4& rk1, const uint4& rv0, const uint4& rv1) {
    *(uint4*)&Ks[buf][skey][sseg * 8] = rk0;
    *(uint4*)&Ks[buf][skey + 32][sseg * 8] = rk1;
    bf16_t (*vt)[68] = Vt[buf];
    vt[sseg * 8 + 0][skey] = (bf16_t)(rv0.x & 0xFFFF); vt[sseg * 8 + 1][skey] = (bf16_t)(rv0.x >> 16);
    vt[sseg * 8 + 2][skey] = (bf16_t)(rv0.y & 0xFFFF); vt[sseg * 8 + 3][skey] = (bf16_t)(rv0.y >> 16);
    vt[sseg * 8 + 4][skey] = (bf16_t)(rv0.z & 0xFFFF); vt[sseg * 8 + 5][skey] = (bf16_t)(rv0.z >> 16);
    vt[sseg * 8 + 6][skey] = (bf16_t)(rv0.w & 0xFFFF); vt[sseg * 8 + 7][skey] = (bf16_t)(rv0.w >> 16);
    vt[sseg * 8 + 0][skey + 32] = (bf16_t)(rv1.x & 0xFFFF); vt[sseg * 8 + 1][skey + 32] = (bf16_t)(rv1.x >> 16);
    vt[sseg * 8 + 2][skey + 32] = (bf16_t)(rv1.y & 0xFFFF); vt[sseg * 8 + 3][skey + 32] = (bf16_t)(rv1.y >> 16);
    vt[sseg * 8 + 4][skey + 32] = (bf16_t)(rv1.z & 0xFFFF); vt[sseg * 8 + 5][skey + 32] = (bf16_t)(rv1.z >> 16);
    vt[sseg * 8 + 6][skey + 32] = (bf16_t)(rv1.w & 0xFFFF); vt[sseg * 8 + 7][skey + 32] = (bf16_t)(rv1.w >> 16);
  };
  auto compute = [&](int kt) {
    const int buf = kt & 1;
    const bool ctxk = kt >= ntl;
    const int kbase = ctxk ? (kt - ntl) * 64 : qb * 128 - 128 + kt * 64;
#pragma unroll
    for (int sub = 0; sub < 2; ++sub) {
      const int kb2 = kbase + sub * 32;
      bool need = true;
      if (!ctxk && (kb2 + 31 < q0w - 128 || kb2 > q0w + 31 + 128 || kb2 + 31 < 0 || kb2 >= T)) need = false;
      if (need) {
        f32x16 sv;
#pragma unroll
        for (int i = 0; i < 16; ++i) sv[i] = 0.f;
#pragma unroll
        for (int ks = 0; ks < 4; ++ks) {
          bf16x8 kf = *(const bf16x8*)&Ks[buf][sub * 32 + qn][16 * ks + 8 * hh];
          sv = mfma32(kf, qf[ks], sv);
        }
        if (!ctxk && (kb2 < q0w - 96 || kb2 > q0w + 96)) {
#pragma unroll
          for (int rg = 0; rg < 16; ++rg) {
            const int kp = kb2 + (rg & 3) + 8 * (rg >> 2) + 4 * hh;
            const int dl = qpos - kp;
            sv[rg] = ((dl <= 128) && (dl >= -128)) ? sv[rg] : -1e30f;
          }
        }
        float mt = fmaxf(fmaxf(sv[0], sv[1]), sv[2]);
#pragma unroll
        for (int rg = 3; rg < 15; rg += 2) mt = fmaxf(fmaxf(mt, sv[rg]), sv[rg + 1]);
        mt = fmaxf(mt, sv[15]);
        mt = fmaxf(mt, __shfl_xor(mt, 32));
        const float m_new = fmaxf(m_run, mt * c2);
        if (__ballot(m_new > m_run) != 0ull) {
          const float corr = __builtin_amdgcn_exp2f(m_run - m_new);
          l_run *= corr;
          m_run = m_new;
#pragma unroll
          for (int i = 0; i < 16; ++i) { o0[i] *= corr; o1[i] *= corr; }
        }
        float ps = 0.f;
#pragma unroll
        for (int rg = 0; rg < 16; ++rg) { const float pv = __builtin_amdgcn_exp2f(__builtin_fmaf(sv[rg], c2, -m_run)); sv[rg] = pv; ps += pv; }
        ps += __shfl_xor(ps, 32);
        l_run += ps;
#pragma unroll
        for (int sp = 0; sp < 2; ++sp) {
          const uint4 pw = make_uint4(pack2(sv[8 * sp], sv[8 * sp + 1]), pack2(sv[8 * sp + 2], sv[8 * sp + 3]), pack2(sv[8 * sp + 4], sv[8 * sp + 5]), pack2(sv[8 * sp + 6], sv[8 * sp + 7]));
          const bf16x8 pf = __builtin_bit_cast(bf16x8, pw);
          const int kc = sub * 32 + 16 * sp + 4 * hh;
          uint2 va = *(const uint2*)&Vt[buf][qn][kc], vb = *(const uint2*)&Vt[buf][qn][kc + 8];
          uint2 vc = *(const uint2*)&Vt[buf][32 + qn][kc], vd = *(const uint2*)&Vt[buf][32 + qn][kc + 8];
          uint4 w0 = make_uint4(va.x, va.y, vb.x, vb.y), w1 = make_uint4(vc.x, vc.y, vd.x, vd.y);
          bf16x8 v0 = __builtin_bit_cast(bf16x8, w0), v1 = __builtin_bit_cast(bf16x8, w1);
          o0 = mfma32(v0, pf, o0);
          o1 = mfma32(v1, pf, o1);
        }
      }
    }
  };
  uint4 ak0, ak1, av0, av1, bk0, bk1, bv0, bv1;
  ldtile(0, ak0, ak1, av0, av1);
  ldtile(1, bk0, bk1, bv0, bv1);
  __syncthreads();
#pragma unroll 1
  for (int kt = 0; kt < ntiles; kt += 2) {
    sttile(0, ak0, ak1, av0, av1);
    lds_barrier();
    ldtile(min(kt + 2, ntiles - 1), ak0, ak1, av0, av1);
    compute(kt);
    sttile(1, bk0, bk1, bv0, bv1);
    lds_barrier();
    ldtile(min(kt + 3, ntiles - 1), bk0, bk1, bv0, bv1);
    compute(kt + 1);
  }
  __syncthreads();
  const float inv = 1.f / l_run;
  bf16_t* optr = p.Y + qrow * D + 512 + hq * 64;
#pragma unroll
  for (int rg = 0; rg < 4; ++rg) {
    int d0 = 8 * rg + 4 * hh;
    *(uint2*)(optr + d0) = make_uint2(pack2(o0[4 * rg] * inv, o0[4 * rg + 1] * inv), pack2(o0[4 * rg + 2] * inv, o0[4 * rg + 3] * inv));
    *(uint2*)(optr + 32 + d0) = make_uint2(pack2(o1[4 * rg] * inv, o1[4 * rg + 1] * inv), pack2(o1[4 * rg + 2] * inv, o1[4 * rg + 3] * inv));
  }
}

DEV void ph_attn_post(const P& p, int layer) {
  const int lane = tid_() & 63;
  int r0, r1;
  wave_range(r0, r1, NTOK);
  float gv[8];
#pragma unroll
  for (int i = 0; i < 8; ++i) gv[i] = p.at_out_g[layer * 512 + 8 * lane + i];
  uint4 nx = make_uint4(0, 0, 0, 0);
  if (r0 < r1) nx = *(const uint4*)(p.Y + (size_t)r0 * D + 512 + 8 * lane);
#pragma unroll 1
  for (int row = r0; row < r1; ++row) {
    const uint4 u = nx;
    if (row + 1 < r1) nx = *(const uint4*)(p.Y + (size_t)(row + 1) * D + 512 + 8 * lane);
    float v[8];
    unpack8(u, v);
    float ss = 0.f;
#pragma unroll
    for (int i = 0; i < 8; ++i) ss += v[i] * v[i];
    ss = wave_sum(ss);
    const float rstd = rsqrtf(ss * (1.f / 512.f) + 1e-6f);
#pragma unroll
    for (int i = 0; i < 8; ++i) {
      v[i] = v[i] * rstd * gv[i];
    }
    *(uint4*)(p.Y + (size_t)row * D + 512 + 8 * lane) = pack8(v);
  }
}

struct Epi2 {
  const P& p; int layer, row0, col0;
  DEV void operator()(f32x4 (&acc)[4][4], int wr, int wc, int fr, int fq, char* smem) const {
    const int b = row0 / LT, pp = row0 % LT;
    const int mr = pp < LC ? 16 : b;
    const float* g1 = p.modv + ((size_t)layer * 17 + mr) * 6144 + 2048 + col0 + wc * 64;
#pragma unroll
    for (int n = 0; n < 4; ++n) {
      const float4 gv = *(const float4*)(g1 + n * 16 + 4 * fq);
#pragma unroll
      for (int m = 0; m < 4; ++m) { acc[m][n][0] *= gv.x; acc[m][n][1] *= gv.y; acc[m][n][2] *= gv.z; acc[m][n][3] *= gv.w; }
    }
    const int wid = wr * 2 + wc, lane = fq * 16 + fr;
    stage_tile_bf16(acc, smem, wid, fr, fq);
    const bf16_t (*t)[72] = (const bf16_t (*)[72])(smem + wid * 9216);
#pragma unroll
    for (int i = 0; i < 8; ++i) {
      const int rl = i * 8 + (lane >> 3), ch = lane & 7;
      bf16_t* xp = p.X + (size_t)(row0 + wr * 64 + rl) * D + col0 + wc * 64 + ch * 8;
      float xv[8], dv[8];
      uint4 xu = *(const uint4*)xp, du = *(const uint4*)&t[rl][ch * 8];
      unpack8(xu, xv); unpack8(du, dv);
#pragma unroll
      for (int q = 0; q < 8; ++q) xv[q] += dv[q];
      *(uint4*)xp = pack8(xv);
    }
  }
};
DEV void ph_gemm2(const P& p, int layer, char* smem) {
  int rt, ct;
  for (int it = 0; gemm_unit(it, 8, rt, ct); ++it) {
    Epi2 epi{p, layer, rt * 128, ct * 128};
    gemm_tile(p.Y + (size_t)rt * 128 * D, D, p.W2t + (size_t)ct * 128 * D, D, D, smem, epi);
  }
}

DEV void ph_peerconv(const P& p, int layer) {
  const int gw = (bid_() * 256 + tid_()) >> 6, nw = gridDim.x * 4, lane = tid_() & 63;
  const float* su = opq(p.peer_u) + (size_t)layer * 16384 * 1024;
  const float* sv = opq(p.peer_v) + (size_t)layer * 16384 * 1024;
  unsigned char* pu = opq(p.PU); unsigned char* pv = opq(p.PV);
  float* psu = opq(p.PSU); float* psv = opq(p.PSV);
  auto ldrow = [&](int r, float4& a0, float4& a1, float4& a2, float4& a3) {
    const float* src = ((r >= 16384) ? sv : su) + (size_t)(r & 16383) * 1024 + 16 * lane;
    a0 = *(const float4*)src; a1 = *(const float4*)(src + 4); a2 = *(const float4*)(src + 8); a3 = *(const float4*)(src + 12);
  };
  float4 n0 = make_float4(0, 0, 0, 0), n1 = n0, n2 = n0, n3 = n0;
  if (gw < 32768) ldrow(gw, n0, n1, n2, n3);
#pragma unroll 1
  for (int r = gw; r < 32768; r += nw) {
    const bool isv = r >= 16384;
    const int e = r & 16383;
    const float4 f0 = n0, f1 = n1, f2 = n2, f3 = n3;
    if (r + nw < 32768) ldrow(r + nw, n0, n1, n2, n3);
    float am = fmaxf(fmaxf(fmaxf(fabsf(f0.x), fabsf(f0.y)), fmaxf(fabsf(f0.z), fabsf(f0.w))), fmaxf(fmaxf(fabsf(f1.x), fabsf(f1.y)), fmaxf(fabsf(f1.z), fabsf(f1.w))));
    am = fmaxf(am, fmaxf(fmaxf(fmaxf(fabsf(f2.x), fabsf(f2.y)), fmaxf(fabsf(f2.z), fabsf(f2.w))), fmaxf(fmaxf(fabsf(f3.x), fabsf(f3.y)), fmaxf(fabsf(f3.z), fabsf(f3.w)))));
    am = wave_max(am);
    int w0, w1, w2, w3;
    float inv;
    if (isv) {
      const float sc = am > 0.f ? 224.f / am : 1.f;
      inv = am > 0.f ? am * (1.f / 224.f) : 1.f;
      w0 = __builtin_amdgcn_cvt_pk_fp8_f32(f0.x * sc, f0.y * sc, 0, false); w0 = __builtin_amdgcn_cvt_pk_fp8_f32(f0.z * sc, f0.w * sc, w0, true);
      w1 = __builtin_amdgcn_cvt_pk_fp8_f32(f1.x * sc, f1.y * sc, 0, false); w1 = __builtin_amdgcn_cvt_pk_fp8_f32(f1.z * sc, f1.w * sc, w1, true);
      w2 = __builtin_amdgcn_cvt_pk_fp8_f32(f2.x * sc, f2.y * sc, 0, false); w2 = __builtin_amdgcn_cvt_pk_fp8_f32(f2.z * sc, f2.w * sc, w2, true);
      w3 = __builtin_amdgcn_cvt_pk_fp8_f32(f3.x * sc, f3.y * sc, 0, false); w3 = __builtin_amdgcn_cvt_pk_fp8_f32(f3.z * sc, f3.w * sc, w3, true);
    } else {
      const float sc = am > 0.f ? 127.f / am : 1.f;
      inv = am > 0.f ? am * (1.f / 127.f) : 1.f;
      w0 = pack_i8(f0.x * sc, f0.y * sc, f0.z * sc, f0.w * sc); w1 = pack_i8(f1.x * sc, f1.y * sc, f1.z * sc, f1.w * sc);
      w2 = pack_i8(f2.x * sc, f2.y * sc, f2.z * sc, f2.w * sc); w3 = pack_i8(f3.x * sc, f3.y * sc, f3.z * sc, f3.w * sc);
    }
    *(uint4*)((isv ? pv : pu) + (size_t)(lane >> 3) * PSLICE + (size_t)e * 128 + 16 * (lane & 7)) = make_uint4((unsigned)w0, (unsigned)w1, (unsigned)w2, (unsigned)w3);
    if (lane == 0) (isv ? psv : psu)[e] = inv;
  }
}
DEV void unpack16_fp8x2(const uint4& u, f32x2* f) {
  f[0] = __builtin_amdgcn_cvt_pk_f32_fp8((int)u.x, false); f[1] = __builtin_amdgcn_cvt_pk_f32_fp8((int)u.x, true);
  f[2] = __builtin_amdgcn_cvt_pk_f32_fp8((int)u.y, false); f[3] = __builtin_amdgcn_cvt_pk_f32_fp8((int)u.y, true);
  f[4] = __builtin_amdgcn_cvt_pk_f32_fp8((int)u.z, false); f[5] = __builtin_amdgcn_cvt_pk_f32_fp8((int)u.z, true);
  f[6] = __builtin_amdgcn_cvt_pk_f32_fp8((int)u.w, false); f[7] = __builtin_amdgcn_cvt_pk_f32_fp8((int)u.w, true);
}

DEV void bitonic_sort16_desc(float (&v)[16]) {
#pragma unroll
  for (int k = 2; k <= 16; k <<= 1)
#pragma unroll
    for (int j = k >> 1; j >= 1; j >>= 1)
#pragma unroll
      for (int i = 0; i < 16; ++i) {
        const int l = i ^ j;
        if (l > i) {
          const float hi = fmaxf(v[i], v[l]), lo = fminf(v[i], v[l]);
          if ((i & k) == 0) { v[i] = hi; v[l] = lo; } else { v[i] = lo; v[l] = hi; }
        }
      }
}
DEV void peer_cand_ij(int c, int& ci, int& cj) {
  if (c < 16) { ci = 0; cj = c; } else if (c < 24) { ci = 1; cj = c - 16; } else if (c < 29) { ci = 2; cj = c - 24; }
  else if (c < 33) { ci = 3; cj = c - 29; } else if (c < 36) { ci = 4; cj = c - 33; } else if (c < 38) { ci = 5; cj = c - 36; }
  else if (c < 40) { ci = 6; cj = c - 38; } else if (c < 42) { ci = 7; cj = c - 40; } else { ci = (c - 42 + 8) & 15; cj = 0; }
}
DEV void ce_desc(float& a, float& b) { const float hi = fmaxf(a, b), lo = fminf(a, b); a = hi; b = lo; }
DEV void bitonic_merge16_desc(float (&v)[16]) {
#pragma unroll
  for (int d = 8; d >= 1; d >>= 1)
#pragma unroll
    for (int i = 0; i < 16; ++i)
      if ((i & d) == 0) ce_desc(v[i], v[i + d]);
}
template <int N>
DEV void merge_trunc16(float (&T)[16], const float (&B)[N]) {
#pragma unroll
  for (int k = 0; k < N; ++k) T[15 - k] = fmaxf(T[15 - k], B[k]);
  bitonic_merge16_desc(T);
}
DEV float pk_sum(float a, float b, int i, int j) {
  return __uint_as_float((__float_as_uint(a + b) & ~255u) | (unsigned)(255 - (i * 16 + j)));
}
template <int S>
struct Epi3K {
  const P& p; int row0, head; float (&keep)[2][16];
  DEV void operator()(f32x4 (&acc)[4][4], int wr, int wc, int fr, int fq, char* smem) const {
    float* sc = (float*)smem;
    float* L1s = (float*)(smem + 36864);
    float* L2s = (float*)(smem + 47104);
    const int tid = tid_();
#pragma unroll
    for (int pass = 0; pass < 2; ++pass) {
      __syncthreads();
      if (wr == pass) {
#pragma unroll
        for (int m = 0; m < 4; ++m)
#pragma unroll
          for (int n = 0; n < 4; ++n)
#pragma unroll
            for (int j = 0; j < 4; ++j) {
              int rl = m * 16 + fr, col = wc * 64 + n * 16 + 4 * fq + j;
              unsigned bits = (__float_as_uint(acc[m][n][j]) & ~127u) | (unsigned)col;
              sc[rl * 133 + (col >> 5) * 33 + (col & 31)] = __uint_as_float(bits);
            }
      }
      __syncthreads();
      const int rl = tid >> 2, q = tid & 3;
      const float* src = sc + rl * 133 + q * 33;
      float Ls[16], Hs[16];
#pragma unroll
      for (int i = 0; i < 16; ++i) { Ls[i] = src[i]; Hs[i] = src[16 + i]; }
      bitonic_sort16_desc(Ls);
      bitonic_sort16_desc(Hs);
#pragma unroll
      for (int i = 0; i < 16; ++i) Ls[i] = fmaxf(Ls[i], Hs[15 - i]);
#pragma unroll
      for (int d = 8; d >= 1; d >>= 1)
#pragma unroll
        for (int i = 0; i < 16; ++i)
          if ((i & d) == 0) { float hi = fmaxf(Ls[i], Ls[i + d]), lo = fminf(Ls[i], Ls[i + d]); Ls[i] = hi; Ls[i + d] = lo; }
      float Cs[16];
#pragma unroll
      for (int i = 0; i < 16; ++i) Cs[i] = fmaxf(Ls[i], dppself<0xB1, 0xF>(Ls[15 - i]));
#pragma unroll
      for (int d = 8; d >= 1; d >>= 1)
#pragma unroll
        for (int i = 0; i < 16; ++i)
          if ((i & d) == 0) { float hi = fmaxf(Cs[i], Cs[i + d]), lo = fminf(Cs[i], Cs[i + d]); Cs[i] = hi; Cs[i + d] = lo; }
      float Ds[16];
#pragma unroll
      for (int i = 0; i < 16; ++i) Ds[i] = fmaxf(Cs[i], dppself<0x4E, 0xF>(Cs[15 - i]));
#pragma unroll
      for (int d = 8; d >= 1; d >>= 1)
#pragma unroll
        for (int i = 0; i < 16; ++i)
          if ((i & d) == 0) { float hi = fmaxf(Ds[i], Ds[i + d]), lo = fminf(Ds[i], Ds[i + d]); Ds[i] = hi; Ds[i + d] = lo; }
      if (S == 0) {
#pragma unroll
        for (int i = 0; i < 16; ++i) keep[pass][i] = Ds[i];
      } else if (q == 0) {
        float* d1 = L1s + (pass * 64 + rl) * 20;
        float* d2 = L2s + (pass * 64 + rl) * 20;
#pragma unroll
        for (int i = 0; i < 4; ++i) {
          *(float4*)(d1 + 4 * i) = make_float4(keep[pass][4 * i], keep[pass][4 * i + 1], keep[pass][4 * i + 2], keep[pass][4 * i + 3]);
          *(float4*)(d2 + 4 * i) = make_float4(Ds[4 * i], Ds[4 * i + 1], Ds[4 * i + 2], Ds[4 * i + 3]);
        }
      }
    }
    if (S == 1) {
      __syncthreads();
      if (tid < 128) {
        const int row = tid;
        float A[16], Bv[16];
        const float* l1 = L1s + row * 20;
        const float* l2 = L2s + row * 20;
#pragma unroll
        for (int i = 0; i < 4; ++i) {
          const float4 x = *(const float4*)(l1 + 4 * i), y = *(const float4*)(l2 + 4 * i);
          A[4 * i] = x.x; A[4 * i + 1] = x.y; A[4 * i + 2] = x.z; A[4 * i + 3] = x.w;
          Bv[4 * i] = y.x; Bv[4 * i + 1] = y.y; Bv[4 * i + 2] = y.z; Bv[4 * i + 3] = y.w;
        }
        float T[16];
#pragma unroll
        for (int j = 0; j < 16; ++j) T[j] = pk_sum(A[0], Bv[j], 0, j);
        {
          float C0[15];
#pragma unroll
          for (int i = 1; i < 16; ++i) C0[i - 1] = pk_sum(A[i], Bv[0], i, 0);
          merge_trunc16(T, C0);
        }
        {
          float R1[7];
#pragma unroll
          for (int j = 1; j < 8; ++j) R1[j - 1] = pk_sum(A[1], Bv[j], 1, j);
          merge_trunc16(T, R1);
        }
        {
          float C1[6];
#pragma unroll
          for (int i = 2; i < 8; ++i) C1[i - 2] = pk_sum(A[i], Bv[1], i, 1);
          merge_trunc16(T, C1);
        }
        {
          float R2[3];
#pragma unroll
          for (int j = 2; j < 5; ++j) R2[j - 2] = pk_sum(A[2], Bv[j], 2, j);
          merge_trunc16(T, R2);
        }
        {
          float C2[2] = {pk_sum(A[3], Bv[2], 3, 2), pk_sum(A[4], Bv[2], 4, 2)};
          merge_trunc16(T, C2);
        }
        {
          float X3[1] = {pk_sum(A[3], Bv[3], 3, 3)};
          merge_trunc16(T, X3);
        }
        const float mx = T[0];
        float ex[16], sm = 0.f;
        unsigned ee[16];
#pragma unroll
        for (int k = 0; k < 16; ++k) {
          const unsigned tg = 255u - (__float_as_uint(T[k]) & 255u);
          const unsigned k1 = __float_as_uint(l1[tg >> 4]) & 127u, k2 = __float_as_uint(l2[tg & 15u]) & 127u;
          ee[k] = k1 * 128u + k2;
          ex[k] = __expf(T[k] - mx);
          sm += ex[k];
        }
        const float rs = 1.f / sm;
        const size_t o = (size_t)(row0 + row) * 128 + head * 16;
        uint4* elp = (uint4*)(p.EL + o);
        elp[0] = make_uint4(ee[0] | (ee[1] << 16), ee[2] | (ee[3] << 16), ee[4] | (ee[5] << 16), ee[6] | (ee[7] << 16));
        elp[1] = make_uint4(ee[8] | (ee[9] << 16), ee[10] | (ee[11] << 16), ee[12] | (ee[13] << 16), ee[14] | (ee[15] << 16));
        float4* gtp = (float4*)(p.GT + o);
#pragma unroll
        for (int i = 0; i < 4; ++i) gtp[i] = make_float4(ex[4 * i] * rs, ex[4 * i + 1] * rs, ex[4 * i + 2] * rs, ex[4 * i + 3] * rs);
      }
    }
  }
};
DEV void ph_gemm3(const P& p, char* smem) {
  int rt, hd;
  for (int it = 0; gemm_unit(it, 8, rt, hd); ++it) {
    float keep[2][16];
    {
      Epi3K<0> epi{p, rt * 128, hd, keep};
      gemm_tile(p.H + (size_t)rt * 128 * D, D, p.Wft + (size_t)(2 * hd) * 128 * D, D, D, smem, epi);
    }
    {
      Epi3K<1> epi{p, rt * 128, hd, keep};
      gemm_tile(p.H + (size_t)rt * 128 * D, D, p.Wft + (size_t)(2 * hd + 1) * 128 * D, D, D, smem, epi);
    }
  }
}

DEV float peer_gate(float scr) {
  float mx = row16_max(scr);
  float ex = __expf(scr - mx);
  float sm = row16_sum(ex);
  return ex / sm;
}
DEV float gelu_exact(float x) { return 0.5f * x * (1.f + erff(x * 0.7071067811865476f)); }

struct PeerPre { uint4 e0, e1, a0, a1; };
DEV unsigned peer_eid(const PeerPre& s, int j) {
  const unsigned w = (j < 8) ? ((j >> 1) == 0 ? s.e0.x : (j >> 1) == 1 ? s.e0.y : (j >> 1) == 2 ? s.e0.z : s.e0.w)
                             : (((j - 8) >> 1) == 0 ? s.e1.x : ((j - 8) >> 1) == 1 ? s.e1.y : ((j - 8) >> 1) == 2 ? s.e1.z : s.e1.w);
  return (j & 1) ? (w >> 16) : (w & 0xFFFFu);
}
template <int WHICH>
DEV void peer_wave_run(const P& p, int layer, int x, int tok0, int lane, float* wbuf) {
  const int r = lane >> 3, c = lane & 7;
  const unsigned char* tb = (WHICH == 0 ? p.PU : p.PV) + (size_t)x * PSLICE + c * 16;
  PeerPre S[3];
  uint4 R[16];
  auto ld_pre = [&](int tok, PeerPre& s) {
    const uint4* elp = (const uint4*)(p.EL + (size_t)tok * 128 + r * 16);
    s.e0 = elp[0]; s.e1 = elp[1];
    if (WHICH == 0) {
      s.a0 = *(const uint4*)(p.H8 + (size_t)tok * 1024 + x * 128 + c * 16);
    } else {
      const uint4* wtp = (const uint4*)(p.GW + (size_t)tok * 128 + r * 16);
      s.a0 = wtp[0]; s.a1 = wtp[1];
    }
  };
  auto comp = [&](int tok, const PeerPre& s, const PeerPre& sn, bool more) {
    if (WHICH == 0) {
      int keep0 = 0, keep1 = 0;
#pragma unroll
      for (int j = 0; j < 16; ++j) {
        const uint4 rw = R[j];
        if (more) R[j] = *(const uint4*)(tb + (size_t)peer_eid(sn, j) * 128);
        int d = __builtin_amdgcn_sdot4((int)rw.x, (int)s.a0.x, 0, false);
        d = __builtin_amdgcn_sdot4((int)rw.y, (int)s.a0.y, d, false);
        d = __builtin_amdgcn_sdot4((int)rw.z, (int)s.a0.z, d, false);
        d = __builtin_amdgcn_sdot4((int)rw.w, (int)s.a0.w, d, false);
        d += __builtin_amdgcn_update_dpp(0, d, 0xB1, 0xF, 0xF, false);
        d += __builtin_amdgcn_update_dpp(0, d, 0x4E, 0xF, 0xF, false);
        d += __builtin_amdgcn_update_dpp(0, d, 0x141, 0xF, 0xF, false);
        if (j < 8) keep0 = (c == j) ? d : keep0; else keep1 = (c == j - 8) ? d : keep1;
      }
      bf16_t* pd = p.PD + ((size_t)x * NTOK + tok) * 128 + r * 16 + c;
      pd[0] = f2bf((float)keep0); pd[8] = f2bf((float)keep1);
    } else {
      float wsv[16];
      unpack8(s.a0, wsv); unpack8(s.a1, wsv + 8);
      f32x2 acc2[8];
#pragma unroll
      for (int i = 0; i < 8; ++i) acc2[i] = (f32x2){0.f, 0.f};
#pragma unroll
      for (int j = 0; j < 16; ++j) {
        f32x2 f[8];
        unpack16_fp8x2(R[j], f);
        if (more) R[j] = *(const uint4*)(tb + (size_t)peer_eid(sn, j) * 128);
        const f32x2 w2 = (f32x2){wsv[j], wsv[j]};
#pragma unroll
        for (int i = 0; i < 8; ++i) acc2[i] += w2 * f[i];
      }
      float* slab = wbuf + (r * 8 + c) * 16;
      *(float4*)(slab) = make_float4(acc2[0][0], acc2[0][1], acc2[1][0], acc2[1][1]);
      *(float4*)(slab + 4) = make_float4(acc2[2][0], acc2[2][1], acc2[3][0], acc2[3][1]);
      *(float4*)(slab + 8) = make_float4(acc2[4][0], acc2[4][1], acc2[5][0], acc2[5][1]);
      *(float4*)(slab + 12) = make_float4(acc2[6][0], acc2[6][1], acc2[7][0], acc2[7][1]);
      asm volatile("s_waitcnt lgkmcnt(0)" ::: "memory");
      float o0 = 0.f, o1 = 0.f;
#pragma unroll
      for (int rr = 0; rr < 8; ++rr) {
        const float2 t = *(const float2*)(wbuf + (rr * 8 + (lane >> 3)) * 16 + 2 * (lane & 7));
        o0 += t.x; o1 += t.y;
      }
      asm volatile("s_waitcnt lgkmcnt(0)" ::: "memory");
      const int b = tok / LT, pp = tok % LT;
      const int mr = pp < LC ? 16 : b;
      const int col = x * 128 + 2 * lane;
      const float* g2 = p.modv + ((size_t)layer * 17 + mr) * 6144 + 5120 + col;
      unsigned* xp = (unsigned*)(p.X + (size_t)tok * D + col);
      const unsigned xu = *xp;
      *xp = pack2(bflo(xu) + g2[0] * o0, bfhi(xu) + g2[1] * o1);
    }
  };
  ld_pre(tok0, S[0]);
  ld_pre(tok0 + 1, S[1]);
#pragma unroll
  for (int j = 0; j < 16; ++j) R[j] = *(const uint4*)(tb + (size_t)peer_eid(S[0], j) * 128);
  ld_pre(tok0 + 2, S[2]);
#pragma unroll
  for (int t = 0; t < 8; ++t) {
    comp(tok0 + t, S[t % 3], S[(t + 1) % 3], t + 1 < 8);
    if (t + 3 < 8) ld_pre(tok0 + t + 3, S[t % 3]);
  }
}
DEV void ph_peer_w(const P& p) {
  for (size_t i8 = (size_t)bid_() * 256 + tid_(); i8 < (size_t)NTOK * 16; i8 += (size_t)gridDim.x * 256) {
    const size_t i = i8 * 8;
    float d[8];
#pragma unroll
    for (int q = 0; q < 8; ++q) d[q] = 0.f;
#pragma unroll
    for (int x = 0; x < 8; ++x) {
      const uint4 u = *(const uint4*)(p.PD + (size_t)x * NTOK * 128 + i);
      float f[8];
      unpack8(u, f);
#pragma unroll
      for (int q = 0; q < 8; ++q) d[q] += f[q];
    }
    const uint4 eu = *(const uint4*)(p.EL + i);
    const unsigned ew[4] = {eu.x, eu.y, eu.z, eu.w};
    const float hinv = p.HINV[i >> 7];
    float4 g0 = *(const float4*)(p.GT + i), g1 = *(const float4*)(p.GT + i + 4);
    float g[8] = {g0.x, g0.y, g0.z, g0.w, g1.x, g1.y, g1.z, g1.w};
#pragma unroll
    for (int q = 0; q < 8; ++q) {
      const unsigned e = (q & 1) ? (ew[q >> 1] >> 16) : (ew[q >> 1] & 0xFFFFu);
      g[q] = g[q] * gelu_exact(d[q] * p.PSU[e] * hinv) * p.PSV[e];
    }
    *(uint4*)(p.GW + i) = pack8(g);
  }
}
template <int WHICH>
DEV void ph_peer_gather(const P& p, int layer, char* smem, volatile LAS unsigned* slot) {
  const int tid = tid_(), lane = tid & 63, wid = tid >> 6;
  unsigned* q = p.wq + 1024 + layer * 256 + WHICH * 128;
  const int my = (int)(xb_xcc_id() & 7u);
  float* wbuf = (float*)smem + wid * 1024;
#pragma unroll 1
  for (int rot = 0; rot < 8; ++rot) {
    const int x = (my + rot) & 7;
    for (;;) {
      __syncthreads();
      if (tid == 0) *slot = atomicAdd(q + x * 16, 1u);
      __syncthreads();
      const int it = (int)*slot;
      if (it >= NTOK / 64) break;
      peer_wave_run<WHICH>(p, layer, x, it * 64 + wid * 16, lane, wbuf);
      peer_wave_run<WHICH>(p, layer, x, it * 64 + wid * 16 + 8, lane, wbuf);
    }
  }
}

DEV void ph_final(const P& p) {
  const int lane = tid_() & 63;
  int r0, r1;
  wave_range(r0, r1, NB * T);
  float gv[16];
#pragma unroll
  for (int hh = 0; hh < 2; ++hh)
#pragma unroll
    for (int i = 0; i < 8; ++i) gv[hh * 8 + i] = p.final_g[hh * 512 + 8 * lane + i];
  auto xrow = [&](int r) -> const bf16_t* { const int b = r / T, t = r % T; return p.X + ((size_t)b * LT + LC + t) * D; };
  uint4 n0 = make_uint4(0, 0, 0, 0), n1 = n0;
  if (r0 < r1) { const bf16_t* xr = xrow(r0); n0 = *(const uint4*)(xr + 8 * lane); n1 = *(const uint4*)(xr + 512 + 8 * lane); }
#pragma unroll 1
  for (int r = r0; r < r1; ++r) {
    const uint4 u0 = n0, u1 = n1;
    if (r + 1 < r1) { const bf16_t* xr = xrow(r + 1); n0 = *(const uint4*)(xr + 8 * lane); n1 = *(const uint4*)(xr + 512 + 8 * lane); }
    float v[16];
    unpack8(u0, v); unpack8(u1, v + 8);
    float ss = 0.f;
#pragma unroll
    for (int i = 0; i < 16; ++i) ss += v[i] * v[i];
    ss = wave_sum(ss);
    const float rstd = rsqrtf(ss * (1.f / 1024.f) + 1e-6f);
    float* o = p.out + (size_t)r * D;
#pragma unroll
    for (int hh = 0; hh < 2; ++hh) {
      const int col = hh * 512 + 8 * lane;
      *(float4*)(o + col) = make_float4(v[hh * 8 + 0] * rstd * gv[hh * 8 + 0], v[hh * 8 + 1] * rstd * gv[hh * 8 + 1], v[hh * 8 + 2] * rstd * gv[hh * 8 + 2], v[hh * 8 + 3] * rstd * gv[hh * 8 + 3]);
      *(float4*)(o + col + 4) = make_float4(v[hh * 8 + 4] * rstd * gv[hh * 8 + 4], v[hh * 8 + 5] * rstd * gv[hh * 8 + 5], v[hh * 8 + 6] * rstd * gv[hh * 8 + 6], v[hh * 8 + 7] * rstd * gv[hh * 8 + 7]);
    }
  }
}

DEV unsigned hw_cu_key() {
  const unsigned hwid = (unsigned)__builtin_amdgcn_s_getreg(((8 - 1) << 11) | (8 << 6) | 4);
  return (xb_xcc_id() << 8) | (hwid & 0xFFu);
}
DEV void mixB(const P& p, int layer, char* smem, volatile LAS unsigned* slot) {
  unsigned* qa = p.wq + layer * 64;
  unsigned* qs = qa + 16;
  unsigned* claim = p.cuclaim + layer * 4096;
  __syncthreads();
  if (tid_() == 0) {
    unsigned u = 0xFFFFFFFFu;
    if (atomicAdd(&claim[hw_cu_key() & 4095u], 1u) == 0u) u = atomicAdd(qs, 1u);
    *slot = u;
  }
  __syncthreads();
  {
    const unsigned u = *slot;
    if (u < 128u) scanc_unit(p, layer, (int)u, smem);
  }
  for (;;) {
    __syncthreads();
    if (tid_() == 0) *slot = atomicAdd(qa, 1u);
    __syncthreads();
    const int u = (int)*slot;
    if (u >= 8704) break;
    if (u < 4352) attn_unit(p, layer, u, smem); else hyena_conv_unit(p, layer, u - 4352, smem);
  }
  if (layer + 1 < DEPTH) {
    unsigned* qp = qa + 32;
    for (;;) {
      __syncthreads();
      if (tid_() == 0) *slot = atomicAdd(qp, 1u);
      __syncthreads();
      const int u = (int)*slot;
      if (u >= PREPA_N) break;
      prep_unit(p, layer + 1, prepA_unit_index(u), smem);
    }
  }
  for (;;) {
    __syncthreads();
    if (tid_() == 0) *slot = atomicAdd(qs, 1u);
    __syncthreads();
    const unsigned u = *slot;
    if (u >= 128u) break;
    scanc_unit(p, layer, (int)u, smem);
  }
}
DEV void mixA(const P& p, int layer, char* smem) {
  for (int u = bid_(); u < 1088; u += gridDim.x) hyena_pre_unit(p, layer, u);
  for (int u = bid_(); u < 512; u += gridDim.x) hyena_scale_unit(p, layer, u, smem);
  ph_lora(p, layer, smem);
  ph_rwkv_prep(p, layer);
}
DEV void mixC(const P& p, int layer, char* smem) {
  for (int u = bid_(); u < 1088; u += gridDim.x) hyena_post_unit(p, layer, u, smem);
  ph_rwkv_post(p, layer);
  ph_attn_post(p, layer);
}

__global__ void __launch_bounds__(256, 2) k_mega(P p) {
  extern __shared__ __attribute__((aligned(16))) char smem_all[];
  char* smem = smem_all;
  volatile LAS unsigned* xbw = (volatile LAS unsigned*)(smem_all + SMEM_BYTES);
  if (threadIdx.x == 0) { xbw[0] = 0u; xbw[1] = 0u; xbw[2] = 0u; xbw[3] = 0u; }
  __syncthreads();
  XcdBarrier bar = xcd_barrier_post(p.bar, xbw);
  ph_rope(p);
  for (int u = blockIdx.x; u < 96; u += gridDim.x) modv_unit(p, u, smem);
  ph_prep(p, 0, smem, false);
  xcd_barrier(bar);
  for (int layer = 0; layer < DEPTH; ++layer) {
    if (layer == 0) ph_norm_first(p); else ph_norm(p, layer, 0);
    xcd_barrier(bar);
    ph_gemm1(p, smem);
    xcd_barrier(bar);
    mixA(p, layer, smem);
    xcd_barrier(bar);
    mixB(p, layer, smem, (volatile LAS unsigned*)(smem_all + SMEM_BYTES + 16));
    xcd_barrier(bar);
    mixC(p, layer, smem);
    xcd_barrier(bar);
    ph_gemm2(p, layer, smem);
    ph_peerconv(p, layer);
    xcd_barrier(bar);
    ph_norm(p, layer, 1);
    xcd_barrier(bar);
    ph_gemm3(p, smem);
    xcd_barrier(bar);
    ph_peer_gather<0>(p, layer, smem, (volatile LAS unsigned*)(smem_all + SMEM_BYTES + 16));
    xcd_barrier(bar);
    ph_peer_w(p);
    xcd_barrier(bar);
    ph_peer_gather<1>(p, layer, smem, (volatile LAS unsigned*)(smem_all + SMEM_BYTES + 16));
    if (layer + 1 < DEPTH) ph_prep(p, layer + 1, smem, true);
    xcd_barrier(bar);
  }
  ph_final(p);
}

static inline size_t al256(size_t x) { return (x + 255) & ~(size_t)255; }

extern "C" void kernel_launch(void* const* d_in, const int* in_sizes, int n_in, void* d_out, int out_size, void* d_ws, size_t ws_size,
                              hipStream_t stream) {
  (void)in_sizes; (void)n_in; (void)out_size; (void)ws_size;
  P p{};
  const float** f = (const float**)&p;
  for (int i = 0; i < 39; ++i) f[i] = (const float*)d_in[i];
  p.out = (float*)d_out;
  char* w = (char*)d_ws;
  size_t off = 0;
  auto take = [&](size_t bytes) { char* r = w + off; off += al256(bytes); return r; };
  p.bar = (unsigned*)take(16384);
  p.modv = (float*)take((size_t)DEPTH * 17 * 6144 * 4);
  p.SSQ = (float*)take((size_t)DEPTH * 2 * 256 * 4);
  p.wq = (unsigned*)take(4096 + DEPTH * 1024);
  p.cuclaim = (unsigned*)take((size_t)DEPTH * 4096 * 4);
  const size_t zero_bytes = off;
  p.rope = (float*)take(64 * 16 * 2 * 4);
  p.X = (bf16_t*)take((size_t)NTOK * D * 2);
  p.H = (bf16_t*)take((size_t)NTOK * D * 2);
  p.Y = (bf16_t*)take((size_t)NTOK * D * 2);
  p.SC = (bf16_t*)take((size_t)NTOK * 1024 * 2);
  p.Z = (bf16_t*)take((size_t)NTOK * INW * 2);
  p.UTl = (bf16_t*)take((size_t)256 * 16 * T * 2);
  p.UTc = (bf16_t*)take((size_t)256 * 16 * LC * 2);
  p.YTl = (bf16_t*)take((size_t)256 * 16 * T * 2);
  p.YTc = (bf16_t*)take((size_t)256 * 16 * LC * 2);
  p.FL = (float*)take((size_t)256 * 2 * T * 4);
  p.FC = (float*)take((size_t)256 * 2 * LC * 4);
  p.W1t = (bf16_t*)take((size_t)INW * D * 2);
  p.W2t = (bf16_t*)take((size_t)D * D * 2);
  p.Wft = (bf16_t*)take((size_t)2048 * D * 2);
  p.Wlt = (bf16_t*)take((size_t)1024 * 256 * 2);
  p.Wgt = (bf16_t*)take((size_t)256 * 128 * 2);
  p.TK = (float*)p.Z;
  p.PU = (unsigned char*)p.Z + al256((size_t)NTOK * 256 * 4);
  p.PV = p.PU + (size_t)16384 * 1024;
  p.PSU = (float*)(p.PV + (size_t)16384 * 1024);
  p.PSV = p.PSU + 16384;
  p.GT = p.PSV + 16384;
  p.EL = (unsigned short*)(p.GT + (size_t)NTOK * 128);
  p.H8 = (unsigned char*)p.EL + al256((size_t)NTOK * 128 * 2);
  p.HINV = (float*)(p.H8 + (size_t)NTOK * 1024);
  p.GW = (bf16_t*)((char*)p.HINV + al256((size_t)NTOK * 4));
  p.PD = p.Y;

  (void)hipMemsetAsync(d_ws, 0, zero_bytes, stream);
  constexpr size_t kDynLds = SMEM_BYTES + 32;
  static int grid = 0;
  if (!grid) {
    int dev = 0, cus = 0, per_cu = 0;
    (void)hipGetDevice(&dev);
    (void)hipDeviceGetAttribute(&cus, hipDeviceAttributeMultiprocessorCount, dev);
    (void)hipFuncSetAttribute((const void*)k_mega, hipFuncAttributeMaxDynamicSharedMemorySize, (int)kDynLds);
    (void)hipOccupancyMaxActiveBlocksPerMultiprocessor(&per_cu, k_mega, 256, kDynLds);
    if (cus <= 0) cus = 256;
    if (per_cu > 2) per_cu = 2;
    if (per_cu < 1) per_cu = 1;
    grid = cus * per_cu;
  }
  k_mega<<<grid, 256, kDynLds, stream>>>(p);
}
```

```cpp
#include <hip/hip_runtime.h>
#include <stdint.h>
#include <type_traits>

#define DEV __device__ __forceinline__
typedef unsigned short bf16_t;
typedef short bf16x8 __attribute__((ext_vector_type(8)));
typedef float f32x2 __attribute__((ext_vector_type(2)));
constexpr size_t PSLICE = (size_t)16384 * 128;
typedef float f32x4 __attribute__((ext_vector_type(4)));
typedef float f32x16 __attribute__((ext_vector_type(16)));


constexpr int NB = 16, T = 4096, LC = 256, LT = 4352, D = 1024, NTOK = NB * LT, INW = 2688, DEPTH = 4;
constexpr int SMEM_BYTES = 65536;

struct P {
  const float *x, *c, *ctx, *c_ctx, *mod_w, *mod_b, *norm1_g, *norm2_g, *w_in, *conv_w, *conv_b;
  const float *hy_w1, *hy_b1, *hy_w2, *hy_b2, *hy_w3, *hy_b3, *hy_freq, *hy_bias;
  const float *rw_w0, *rw_w_up, *rw_a0, *rw_a_up, *rw_g_up, *rw_k_k, *rw_k_a, *rw_r_k, *rw_ln_w, *rw_ln_b;
  const float *attn_sink, *hy_out_g, *at_out_g, *w_out, *peer_wq, *peer_k1, *peer_k2, *peer_u, *peer_v, *final_g;
  float* out;
  unsigned* bar;
  float *modv, *SSQ, *rope, *FL, *FC, *TK;
  unsigned *wq, *cuclaim;
  bf16_t *X, *H, *Y, *SC, *Z, *UTl, *UTc, *YTl, *YTc;
  bf16_t *W1t, *W2t, *Wft, *Wlt, *Wgt;
  unsigned char *PU, *PV;
  float *PSU, *PSV, *GT, *HINV;
  bf16_t *PD, *GW;
  unsigned short* EL;
  unsigned char* H8;
};

typedef __bf16 hwbf2 __attribute__((ext_vector_type(2)));
DEV unsigned pack2(float a, float b) { f32x2 f = {a, b}; hwbf2 r = __builtin_convertvector(f, hwbf2); return __builtin_bit_cast(unsigned, r); }
DEV bf16_t f2bf(float f) { return (bf16_t)(pack2(f, 0.f) & 0xFFFFu); }
DEV float bf2f(bf16_t h) { return __uint_as_float(((unsigned)h) << 16); }
DEV float bflo(unsigned u) { return __uint_as_float(u << 16); }
DEV float bfhi(unsigned u) { return __uint_as_float(u & 0xFFFF0000u); }
DEV void unpack8(const uint4& u, float* v) {
  v[0] = bflo(u.x); v[1] = bfhi(u.x); v[2] = bflo(u.y); v[3] = bfhi(u.y);
  v[4] = bflo(u.z); v[5] = bfhi(u.z); v[6] = bflo(u.w); v[7] = bfhi(u.w);
}
DEV uint4 pack8(const float* v) { return make_uint4(pack2(v[0], v[1]), pack2(v[2], v[3]), pack2(v[4], v[5]), pack2(v[6], v[7])); }
DEV int pack_i8(float a, float b, float c, float d) {
  const int ia = __float2int_rn(a), ib = __float2int_rn(b), ic = __float2int_rn(c), id = __float2int_rn(d);
  return (ia & 0xFF) | ((ib & 0xFF) << 8) | ((ic & 0xFF) << 16) | ((id & 0xFF) << 24);
}
DEV float sigmoidf_(float x) { return __builtin_amdgcn_rcpf(1.f + __expf(-x)); }

template <int CTRL, int ROWMASK>
DEV float dpp0(float x) {
  return __builtin_bit_cast(float, __builtin_amdgcn_update_dpp(0, __builtin_bit_cast(int, x), CTRL, ROWMASK, 0xF, false));
}
template <int CTRL, int ROWMASK>
DEV float dppself(float x) {
  int xi = __builtin_bit_cast(int, x);
  return __builtin_bit_cast(float, __builtin_amdgcn_update_dpp(xi, xi, CTRL, ROWMASK, 0xF, false));
}
DEV float readlane_f(float x, int l) { return __builtin_bit_cast(float, __builtin_amdgcn_readlane(__builtin_bit_cast(int, x), l)); }
DEV int lane_id() { return (int)__builtin_amdgcn_mbcnt_hi(~0u, __builtin_amdgcn_mbcnt_lo(~0u, 0u)); }
DEV float writelane_f(float val, int l, float old) { return lane_id() == l ? val : old; }
DEV int writelane_i(int val, int l, int old) { return lane_id() == l ? val : old; }
DEV float wave_sum(float x) {
  x += dpp0<0x111, 0xF>(x); x += dpp0<0x112, 0xF>(x); x += dpp0<0x114, 0xF>(x); x += dpp0<0x118, 0xF>(x);
  x += dpp0<0x142, 0xA>(x); x += dpp0<0x143, 0xC>(x);
  return readlane_f(x, 63);
}
DEV float wave_max(float x) {
  x = fmaxf(x, dppself<0x111, 0xF>(x)); x = fmaxf(x, dppself<0x112, 0xF>(x)); x = fmaxf(x, dppself<0x114, 0xF>(x));
  x = fmaxf(x, dppself<0x118, 0xF>(x)); x = fmaxf(x, dppself<0x142, 0xA>(x)); x = fmaxf(x, dppself<0x143, 0xC>(x));
  return readlane_f(x, 63);
}
DEV float row16_sum(float x) {
  x += dpp0<0xB1, 0xF>(x); x += dpp0<0x4E, 0xF>(x); x += dpp0<0x141, 0xF>(x); x += dpp0<0x140, 0xF>(x);
  return x;
}
DEV float row16_max(float x) {
  x = fmaxf(x, dppself<0xB1, 0xF>(x)); x = fmaxf(x, dppself<0x4E, 0xF>(x)); x = fmaxf(x, dppself<0x141, 0xF>(x));
  x = fmaxf(x, dppself<0x140, 0xF>(x));
  return x;
}
DEV float quad_sum(float x) { x += dpp0<0xB1, 0xF>(x); x += dpp0<0x4E, 0xF>(x); return x; }

DEV f32x4 mfma16(bf16x8 a, bf16x8 b, f32x4 c) { return __builtin_amdgcn_mfma_f32_16x16x32_bf16(a, b, c, 0, 0, 0); }
DEV f32x16 mfma32(bf16x8 a, bf16x8 b, f32x16 c) { return __builtin_amdgcn_mfma_f32_32x32x16_bf16(a, b, c, 0, 0, 0); }


#define XB_TMO      128
#define XB_XCNT(j)  (256  + 64 * (j))
#define XB_XSUB(j)  (1280 + 64 * (j))
#define XB_XGEN(j)  (2304 + 64 * (j))
#define XB_TOP      3328
#define XB_TOPGEN   3392
#define XCD_BAR_WORDS 3456
#define XB_SPIN_CAP (1u << 23)
#define LAS __attribute__((address_space(3)))

__device__ __forceinline__ unsigned xb_ld(unsigned* p)              { return __hip_atomic_load(p, __ATOMIC_RELAXED, __HIP_MEMORY_SCOPE_AGENT); }
__device__ __forceinline__ unsigned xb_add(unsigned* p, unsigned v) { return __hip_atomic_fetch_add(p, v, __ATOMIC_RELAXED, __HIP_MEMORY_SCOPE_AGENT); }
__device__ __forceinline__ unsigned xb_xcc_id() { return (unsigned)__builtin_amdgcn_s_getreg((3 << 11) | 20) & 0xFu; }
#define XB_SPIN(cond, bar) do { unsigned _sp = 0; while (cond) { __builtin_amdgcn_s_sleep(1); \
    if ((++_sp & 255u) == 0u) { if (xb_ld(&(bar)[XB_TMO])) break; if (_sp > XB_SPIN_CAP) { atomicAdd(&(bar)[XB_TMO], 1u); break; } } } } while (0)

struct XcdBarrier {
    unsigned* bar; unsigned x;
    volatile LAS unsigned* st;
};
__device__ __forceinline__ XcdBarrier xcd_barrier_post(unsigned* bar, volatile LAS unsigned* st) {
    XcdBarrier b; b.bar = bar; b.x = xb_xcc_id(); b.st = st;
    if (threadIdx.x == 0) (void)xb_add(&bar[XB_XCNT(b.x)], 1u);
    return b;
}
__device__ __forceinline__ void xcd_barrier_complete(unsigned* bar, unsigned x, unsigned& nloc, unsigned& nx) {
    const unsigned G = gridDim.x * gridDim.y * gridDim.z;
    unsigned sum, cnt, mine, sp = 0u;
    for (;;) {
        sum = 0u; cnt = 0u; mine = 0u;
#pragma unroll
        for (unsigned j = 0; j < 16; ++j) { const unsigned c = xb_ld(&bar[XB_XCNT(j)]); sum += c; cnt += (c > 0u) ? 1u : 0u; mine = (j == x) ? c : mine; }
        if (sum == G) break;
        __builtin_amdgcn_s_sleep(1);
        if ((++sp & 255u) == 0u) { if (xb_ld(&bar[XB_TMO])) break; if (sp > XB_SPIN_CAP) { atomicAdd(&bar[XB_TMO], 1u); break; } }
    }
    nloc = mine > 0u ? mine : 1u; nx = cnt > 0u ? cnt : 1u;
}
__device__ __forceinline__ void xcd_barrier(const XcdBarrier& b) {
    asm volatile("s_waitcnt vmcnt(0)" ::: "memory");
    __syncthreads();
    if (threadIdx.x == 0) {
        unsigned* bar = b.bar;
        __builtin_amdgcn_s_waitcnt(0);
        unsigned nloc = b.st[0], nx = b.st[1];
        if (nloc == 0u) { xcd_barrier_complete(bar, b.x, nloc, nx); b.st[0] = nloc; b.st[1] = nx; }
        const unsigned old = xb_add(&bar[XB_XSUB(b.x)], 1u);
        const unsigned gen = old / nloc;
        if (old + 1u == (gen + 1u) * nloc) {
            __builtin_amdgcn_fence(__ATOMIC_RELEASE, "agent");
            asm volatile("s_waitcnt vmcnt(0)" ::: "memory");
            const unsigned og = xb_add(&bar[XB_TOP], 1u);
            const unsigned tg = og / nx;
            if (og + 1u == (tg + 1u) * nx) xb_add(&bar[XB_TOPGEN], 1u);
            else XB_SPIN(xb_ld(&bar[XB_TOPGEN]) == tg, bar);
            __builtin_amdgcn_fence(__ATOMIC_ACQUIRE, "agent");
            xb_add(&bar[XB_XGEN(b.x)], 1u);
            asm volatile("s_waitcnt vmcnt(0)" ::: "memory");
        } else {
            XB_SPIN(xb_ld(&bar[XB_XGEN(b.x)]) == gen, bar);
            __builtin_amdgcn_fence(__ATOMIC_ACQUIRE, "agent");
            asm volatile("s_waitcnt vmcnt(0)" ::: "memory");
        }
    }
    __syncthreads();
}

template <class Tp> DEV Tp* opq(Tp* q) { asm volatile("" : "+s"(q)); return q; }
DEV int tid_() { int t = threadIdx.x; asm volatile("" : "+v"(t)); return t; }
DEV int bid_() { int b = blockIdx.x; asm volatile("" : "+s"(b)); return b; }

DEV void glds16(const void* gsrc, char* lds_lane_ptr) {
  __builtin_amdgcn_global_load_lds((const unsigned*)gsrc, (__attribute__((address_space(3))) unsigned*)lds_lane_ptr, 16, 0, 0);
}
template <class Epi>
DEV void gemm_tile(const bf16_t* __restrict__ A, int lda, const bf16_t* __restrict__ Bt, int ldb, int K, char* smem, Epi& epi) {
  const int tid = tid_(), lane = tid & 63, wid = tid >> 6, wr = wid >> 1, wc = wid & 1, fr = lane & 15, fq = lane >> 4;
  f32x4 acc[4][4];
#pragma unroll
  for (int m = 0; m < 4; ++m)
#pragma unroll
    for (int n = 0; n < 4; ++n) acc[m][n] = (f32x4){0.f, 0.f, 0.f, 0.f};
  const int drow0 = 8 * wid + (lane >> 3), dpc = lane & 7;
  auto issue = [&](int kt, int buf) {
    char* sa = smem + buf * 32768;
    char* sb = sa + 16384;
#pragma unroll
    for (int i = 0; i < 4; ++i) {
      const int row = drow0 + 32 * i;
      const int kc = dpc ^ ((row >> 1) & 7);
      glds16(A + (size_t)row * lda + kt * 64 + kc * 8, sa + (i * 4 + wid) * 1024 + lane * 16);
      glds16(Bt + (size_t)row * ldb + kt * 64 + kc * 8, sb + (i * 4 + wid) * 1024 + lane * 16);
    }
  };
  __syncthreads();
  issue(0, 0);
  const int nk = K >> 6;
  const int sw = (fr >> 1) & 7;
  const int aoff = (wr * 64 + fr) * 128, boff = (wc * 64 + fr) * 128;
  for (int kt = 0; kt < nk; ++kt) {
    asm volatile("s_waitcnt vmcnt(0)" ::: "memory");
    __syncthreads();
    if (kt + 1 < nk) issue(kt + 1, (kt + 1) & 1);
    const char* sa = smem + (kt & 1) * 32768;
    const char* sb = sa + 16384;
#pragma unroll
    for (int kh = 0; kh < 2; ++kh) {
      const int pc = ((kh * 4 + fq) ^ sw) * 16;
      bf16x8 af[4], bfr[4];
#pragma unroll
      for (int m = 0; m < 4; ++m) af[m] = *(const bf16x8*)(sa + aoff + m * 2048 + pc);
#pragma unroll
      for (int n = 0; n < 4; ++n) bfr[n] = *(const bf16x8*)(sb + boff + n * 2048 + pc);
#pragma unroll
      for (int m = 0; m < 4; ++m)
#pragma unroll
        for (int n = 0; n < 4; ++n) acc[m][n] = mfma16(bfr[n], af[m], acc[m][n]);
    }
  }
  __syncthreads();
  epi(acc, wr, wc, fr, fq, smem);
}
DEV void stage_tile_bf16(const f32x4 (&acc)[4][4], char* smem, int wid, int fr, int fq) {
  bf16_t (*t)[72] = (bf16_t (*)[72])(smem + wid * 9216);
#pragma unroll
  for (int m = 0; m < 4; ++m)
#pragma unroll
    for (int n = 0; n < 4; ++n)
      *(uint2*)&t[m * 16 + fr][n * 16 + 4 * fq] = make_uint2(pack2(acc[m][n][0], acc[m][n][1]), pack2(acc[m][n][2], acc[m][n][3]));
  asm volatile("s_waitcnt lgkmcnt(0)" ::: "memory");
}

DEV void ph_copy(const P& p) {
  const size_t n8 = (size_t)NTOK * D / 8;
  const float* pctx = opq(p.ctx); const float* px = opq(p.x);
  for (size_t i = (size_t)bid_() * 256 + tid_(); i < n8; i += (size_t)gridDim.x * 256) {
    size_t e = i * 8;
    int row = (int)(e / D), col = (int)(e % D);
    int b = row / LT, pp = row % LT;
    const float* src = pp < LC ? pctx + ((size_t)(b * LC + pp)) * D + col : px + ((size_t)(b * T + pp - LC)) * D + col;
    float4 v0 = *(const float4*)src, v1 = *(const float4*)(src + 4);
    uint4 o = make_uint4(pack2(v0.x, v0.y), pack2(v0.z, v0.w), pack2(v1.x, v1.y), pack2(v1.z, v1.w));
    *(uint4*)(p.X + e) = o;
  }
}

DEV void ph_rope(const P& p) {
  for (int i = bid_() * 256 + tid_(); i < 64 * 16; i += gridDim.x * 256) {
    int pos = i >> 4, k = i & 15;
    float inv = powf(10000.f, -(float)k / 16.f);
    float ang = (float)pos * inv;
    p.rope[2 * i] = cosf(ang); p.rope[2 * i + 1] = sinf(ang);
  }
}

DEV void modv_unit(const P& p, int unit, char* smem) {
  const int cc = unit % 24, layer = unit / 24;
  float (*cs)[128] = (float (*)[128])smem;
  const int col = cc * 256 + tid_();
  const float* pc = opq(p.c); const float* pcc = opq(p.c_ctx);
  float acc[17];
#pragma unroll
  for (int r = 0; r < 17; ++r) acc[r] = 0.f;
  for (int ks = 0; ks < 8; ++ks) {
    __syncthreads();
    for (int i = tid_(); i < 17 * 128; i += 256) {
      int r = i >> 7, e = i & 127;
      float v = r < 16 ? pc[r * D + ks * 128 + e] : pcc[ks * 128 + e];
      cs[r][e] = v / (1.f + expf(-v));
    }
    __syncthreads();
    const float* w = p.mod_w + ((size_t)layer * D + ks * 128) * 6144 + col;
#pragma unroll 1
    for (int e0 = 0; e0 < 128; e0 += 32) {
      float wv[32];
#pragma unroll
      for (int q = 0; q < 32; ++q) wv[q] = w[(size_t)(e0 + q) * 6144];
#pragma unroll
      for (int q4 = 0; q4 < 8; ++q4) {
      const int e = e0 + 4 * q4;
      const float w0 = wv[4 * q4], w1 = wv[4 * q4 + 1], w2 = wv[4 * q4 + 2], w3 = wv[4 * q4 + 3];
#pragma unroll
      for (int r = 0; r < 17; ++r) {
        const float4 cv = *(const float4*)&cs[r][e];
        acc[r] += cv.x * w0 + cv.y * w1 + cv.z * w2 + cv.w * w3;
      }
      }
    }
  }
  const float bias = p.mod_b[layer * 6144 + col];
#pragma unroll
  for (int r = 0; r < 17; ++r) p.modv[((size_t)layer * 17 + r) * 6144 + col] = acc[r] + bias;
}

DEV void transpose_unit(const float* __restrict__ src, bf16_t* __restrict__ dst, int R, int C, int tile, char* smem) {
  float (*t)[65] = (float (*)[65])smem;
  const int nct = C / 64;
  const int tr = tile / nct, tc = tile % nct;
  __syncthreads();
  for (int i = tid_(); i < 4096; i += 256) { int r = i >> 6, c = i & 63; t[r][c] = src[(size_t)(tr * 64 + r) * C + tc * 64 + c]; }
  __syncthreads();
  for (int i = tid_(); i < 4096; i += 256) { int c = i >> 6, r = i & 63; dst[(size_t)(tc * 64 + c) * R + tr * 64 + r] = f2bf(t[r][c]); }
}

DEV void wfold_unit(const P& p, int layer, int unit, char* smem) {
  const int hs = unit >> 5, ec = unit & 31, h = hs >> 1, s = hs & 1;
  const float* wq = p.peer_wq + (size_t)layer * D * 2048;
  const float* kk = (s ? opq(p.peer_k2) : opq(p.peer_k1)) + ((size_t)layer * 8 + h) * 128 * 128;
  float (*kS)[65] = (float (*)[65])smem;
  float (*wS)[64] = (float (*)[64])(smem + 33280);
  const int key = tid_() & 127, eh = tid_() >> 7;
  float acc[16];
#pragma unroll
  for (int i = 0; i < 16; ++i) acc[i] = 0.f;
  for (int dh = 0; dh < 2; ++dh) {
    __syncthreads();
    for (int i = tid_(); i < 128 * 64; i += 256) { int k2 = i >> 6, d = i & 63; kS[k2][d] = kk[k2 * 128 + dh * 64 + d]; }
    for (int i = tid_(); i < 32 * 64; i += 256) {
      int e = i >> 6, d = i & 63;
      wS[e][d] = wq[(size_t)(ec * 32 + e) * 2048 + h * 256 + s * 128 + dh * 64 + d];
    }
    __syncthreads();
#pragma unroll 2
    for (int d = 0; d < 64; d += 4) {
      const float k0 = kS[key][d], k1 = kS[key][d + 1], k2 = kS[key][d + 2], k3 = kS[key][d + 3];
#pragma unroll
      for (int i = 0; i < 16; ++i) {
        const float4 wv = *(const float4*)&wS[eh * 16 + i][d];
        acc[i] += k0 * wv.x + k1 * wv.y + k2 * wv.z + k3 * wv.w;
      }
    }
  }
  bf16_t* dst = p.Wft + ((size_t)(hs * 128 + key)) * D + ec * 32 + eh * 16;
#pragma unroll
  for (int i = 0; i < 16; i += 2) *(unsigned*)(dst + i) = pack2(acc[i], acc[i + 1]);
}

DEV void filt_unit(const P& p, int layer, int unit, char* smem) {
  int kind, j0, L;
  if (unit < 256) { kind = 0; j0 = unit * 16; L = T; } else { kind = 1; j0 = (unit - 256) * 16; L = LC; }
  float* zs = (float*)smem;
  float* h1 = zs + 16 * 36;
  float* h2 = h1 + 16 * 64;
  const int tid = tid_();
  __syncthreads();
  for (int idx = tid; idx < 16 * 33; idx += 256) {
    const int jj = idx / 33, o = idx - jj * 33;
    const float fj = (float)(j0 + jj);
    float z;
    if (o == 0) z = fj / (float)(L - 1);
    else {
      const int i = (o - 1) & 15;
      const float band = 1e-4f + (float)i * ((15.0f - 1e-4f) / 15.0f);
      const float ang = 6.283185307179586f * fj * band / (float)L;
      z = (o <= 16) ? cosf(ang) : -sinf(ang);
    }
    zs[jj * 36 + o] = z;
  }
  __syncthreads();
  const int o = tid & 63, jq = tid >> 6;
  {
    const float* w1 = p.hy_w1 + layer * 33 * 64;
    const float b1 = p.hy_b1[layer * 64 + o];
    float a[4] = {b1, b1, b1, b1};
#pragma unroll 3
    for (int i = 0; i < 33; ++i) {
      const float w = w1[i * 64 + o];
#pragma unroll
      for (int q = 0; q < 4; ++q) a[q] += zs[(jq * 4 + q) * 36 + i] * w;
    }
    const float fr1 = p.hy_freq[layer * 128 + o];
#pragma unroll
    for (int q = 0; q < 4; ++q) h1[(jq * 4 + q) * 64 + o] = sinf(fr1 * a[q]);
  }
  __syncthreads();
  {
    const float* w2 = p.hy_w2 + layer * 64 * 64;
    const float b2 = p.hy_b2[layer * 64 + o];
    float a[4] = {b2, b2, b2, b2};
#pragma unroll 4
    for (int i = 0; i < 64; ++i) {
      const float w = w2[i * 64 + o];
#pragma unroll
      for (int q = 0; q < 4; ++q) a[q] += h1[(jq * 4 + q) * 64 + i] * w;
    }
    const float fr2 = p.hy_freq[layer * 128 + 64 + o];
#pragma unroll
    for (int q = 0; q < 4; ++q) h2[o * 16 + jq * 4 + q] = sinf(fr2 * a[q]);
  }
  __syncthreads();
  const float* w3 = p.hy_w3 + layer * 64 * 512;
  const int c = tid;
  float af[16], ab[16];
  {
    const float bf0 = p.hy_b3[layer * 512 + c], bb0 = p.hy_b3[layer * 512 + 256 + c];
#pragma unroll
    for (int q = 0; q < 16; ++q) { af[q] = bf0; ab[q] = bb0; }
  }
#pragma unroll 1
  for (int i0 = 0; i0 < 64; i0 += 8) {
    float wf[8], wb[8];
#pragma unroll
    for (int k = 0; k < 8; ++k) { wf[k] = w3[(i0 + k) * 512 + c]; wb[k] = w3[(i0 + k) * 512 + 256 + c]; }
#pragma unroll
    for (int k = 0; k < 8; ++k) {
#pragma unroll
      for (int q4 = 0; q4 < 4; ++q4) {
        const float4 hv = *(const float4*)&h2[(i0 + k) * 16 + 4 * q4];
        af[4 * q4] += hv.x * wf[k]; af[4 * q4 + 1] += hv.y * wf[k]; af[4 * q4 + 2] += hv.z * wf[k]; af[4 * q4 + 3] += hv.w * wf[k];
        ab[4 * q4] += hv.x * wb[k]; ab[4 * q4 + 1] += hv.y * wb[k]; ab[4 * q4 + 2] += hv.z * wb[k]; ab[4 * q4 + 3] += hv.w * wb[k];
      }
    }
  }
  float* F = kind ? opq(p.FC) : opq(p.FL);
  const float DMIN = -3.0701134573253945f, DMAX = -15.350567286626973f;
  const float delta = fabsf(DMIN + (float)c * ((DMAX - DMIN) / 255.f));
#pragma unroll
  for (int q = 0; q < 16; ++q) {
    const float t = (float)(j0 + q) / (float)(L - 1);
    const float win = expf(-t * delta) + 0.05f;
    af[q] *= win; ab[q] *= win;
  }
  float* df = F + ((size_t)c * 2 + 0) * L + j0;
  float* db = F + ((size_t)c * 2 + 1) * L + j0;
#pragma unroll
  for (int q4 = 0; q4 < 4; ++q4) {
    *(float4*)(df + 4 * q4) = make_float4(af[4 * q4], af[4 * q4 + 1], af[4 * q4 + 2], af[4 * q4 + 3]);
    *(float4*)(db + 4 * q4) = make_float4(ab[4 * q4], ab[4 * q4 + 1], ab[4 * q4 + 2], ab[4 * q4 + 3]);
  }
}

constexpr int PREP_T0 = 672, PREP_T1 = PREP_T0 + 256, PREP_T2 = PREP_T1 + 8, PREP_T3 = PREP_T2 + 8, PREP_T4 = PREP_T3 + 8;
constexpr int PREP_WF = PREP_T4 + 512, PREP_N = PREP_WF + 272;
DEV void prep_unit(const P& p, int layer, int u, char* smem) {
  if (u < PREP_T0) transpose_unit(p.w_in + (size_t)layer * D * INW, p.W1t, D, INW, u, smem);
  else if (u < PREP_T1) transpose_unit(p.w_out + (size_t)layer * D * D, p.W2t, D, D, u - PREP_T0, smem);
  else if (u < PREP_T3) {
    const int u0 = u - PREP_T1;
    for (int i = tid_(); i < 64 * 256; i += 256) {
      const int np = u0 * 64 + (i >> 8), kp = i & 255;
      const int ps = np & 3, chan = np >> 2, qp = kp >> 6, kk = kp & 63;
      const int is_a = ps & 1, d = ps >> 1;
      float v = 0.f;
      if (qp == (is_a ? 2 + d : d)) v = (is_a ? opq(p.rw_a_up) : opq(p.rw_w_up))[(((size_t)layer * 2 + d) * 64 + kk) * 256 + chan];
      p.Wlt[(size_t)np * 256 + kp] = f2bf(v);
    }
  }
  else if (u < PREP_T4) transpose_unit(p.rw_g_up + (size_t)layer * 128 * 256, p.Wgt, 128, 256, u - PREP_T3, smem);
  else if (u < PREP_WF) wfold_unit(p, layer, u - PREP_T4, smem);
  else filt_unit(p, layer, u - PREP_WF, smem);
}
constexpr int PREPA_N = PREP_T0 + (PREP_T4 - PREP_T1);
DEV int prepA_unit_index(int i) { return i < PREP_T0 ? i : PREP_T1 + (i - PREP_T0); }
DEV void ph_prep(const P& p, int layer, char* smem, bool onlyB) {
  for (int u = bid_(); u < PREP_N; u += gridDim.x) {
    const bool isA = (u < PREP_T0) || (u >= PREP_T1 && u < PREP_T4);
    if (onlyB && isA) continue;
    prep_unit(p, layer, u, smem);
  }
}

DEV void wave_range(int& r0, int& r1, int ntok) {
  const int gw = (bid_() * 256 + tid_()) >> 6, nw = gridDim.x * 4;
  const int per = (ntok + nw - 1) / nw;
  r0 = gw * per; r1 = r0 + per; if (r1 > ntok) r1 = ntok;
}
DEV void ph_norm_first(const P& p) {
  const int lane = tid_() & 63;
  int r0, r1;
  wave_range(r0, r1, NTOK);
  const float* pctx = opq(p.ctx); const float* px = opq(p.x);
  float gv[16], scv[16], shv[16];
#pragma unroll
  for (int hh = 0; hh < 2; ++hh)
#pragma unroll
    for (int i = 0; i < 8; ++i) gv[hh * 8 + i] = p.norm1_g[hh * 512 + 8 * lane + i];
  int mr_cur = -1;
  auto srcrow = [&](int row) -> const float* {
    const int b = row / LT, pp = row % LT;
    return pp < LC ? pctx + ((size_t)(b * LC + pp)) * D : px + ((size_t)(b * T + pp - LC)) * D;
  };
  float4 n0, n1, n2, n3;
  auto ld = [&](int row) { const float* s0 = srcrow(row) + 8 * lane; n0 = *(const float4*)s0; n1 = *(const float4*)(s0 + 4); n2 = *(const float4*)(s0 + 512); n3 = *(const float4*)(s0 + 516); };
  if (r0 < r1) ld(r0);
#pragma unroll 1
  for (int row = r0; row < r1; ++row) {
    float v[16] = {n0.x, n0.y, n0.z, n0.w, n1.x, n1.y, n1.z, n1.w, n2.x, n2.y, n2.z, n2.w, n3.x, n3.y, n3.z, n3.w};
    if (row + 1 < r1) ld(row + 1);
    const int b = row / LT, pp = row % LT;
    const int mr = pp < LC ? 16 : b;
    if (mr != mr_cur) {
      mr_cur = mr;
      const float* mv = p.modv + (size_t)mr * 6144;
#pragma unroll
      for (int hh = 0; hh < 2; ++hh)
#pragma unroll
        for (int i = 0; i < 8; ++i) { shv[hh * 8 + i] = mv[hh * 512 + 8 * lane + i]; scv[hh * 8 + i] = 1.f + mv[1024 + hh * 512 + 8 * lane + i]; }
    }
    bf16_t* xr = p.X + (size_t)row * D;
    const uint4 x0 = pack8(v), x1 = pack8(v + 8);
    *(uint4*)(xr + 8 * lane) = x0;
    *(uint4*)(xr + 512 + 8 * lane) = x1;
    unpack8(x0, v); unpack8(x1, v + 8);
    float ss = 0.f;
#pragma unroll
    for (int i = 0; i < 16; ++i) ss += v[i] * v[i];
    ss = wave_sum(ss);
    const float rstd = rsqrtf(ss * (1.f / 1024.f) + 1e-6f);
    float o[16];
#pragma unroll
    for (int i = 0; i < 16; ++i) o[i] = (v[i] * rstd * gv[i]) * scv[i] + shv[i];
    bf16_t* hr = p.H + (size_t)row * D;
    *(uint4*)(hr + 8 * lane) = pack8(o);
    *(uint4*)(hr + 512 + 8 * lane) = pack8(o + 8);
  }
}
DEV void ph_norm(const P& p, int layer, int which) {
  const int lane = tid_() & 63;
  int r0, r1;
  wave_range(r0, r1, NTOK);
  const float* g = (which ? p.norm2_g : p.norm1_g) + layer * D;
  float gv[16], scv[16], shv[16];
#pragma unroll
  for (int hh = 0; hh < 2; ++hh)
#pragma unroll
    for (int i = 0; i < 8; ++i) gv[hh * 8 + i] = g[hh * 512 + 8 * lane + i];
  int mr_cur = -1;
  uint4 n0 = make_uint4(0, 0, 0, 0), n1 = n0;
  if (r0 < r1) { const bf16_t* xr = p.X + (size_t)r0 * D; n0 = *(const uint4*)(xr + 8 * lane); n1 = *(const uint4*)(xr + 512 + 8 * lane); }
#pragma unroll 1
  for (int row = r0; row < r1; ++row) {
    const uint4 u0 = n0, u1 = n1;
    if (row + 1 < r1) { const bf16_t* xr = p.X + (size_t)(row + 1) * D; n0 = *(const uint4*)(xr + 8 * lane); n1 = *(const uint4*)(xr + 512 + 8 * lane); }
    const int b = row / LT, pp = row % LT;
    const int mr = pp < LC ? 16 : b;
    if (mr != mr_cur) {
      mr_cur = mr;
      const float* mv = p.modv + ((size_t)layer * 17 + mr) * 6144 + (which ? 3072 : 0);
#pragma unroll
      for (int hh = 0; hh < 2; ++hh)
#pragma unroll
        for (int i = 0; i < 8; ++i) { shv[hh * 8 + i] = mv[hh * 512 + 8 * lane + i]; scv[hh * 8 + i] = 1.f + mv[1024 + hh * 512 + 8 * lane + i]; }
    }
    float v[16];
    unpack8(u0, v); unpack8(u1, v + 8);
    float ss = 0.f;
#pragma unroll
    for (int i = 0; i < 16; ++i) ss += v[i] * v[i];
    ss = wave_sum(ss);
    const float rstd = rsqrtf(ss * (1.f / 1024.f) + 1e-6f);
    float o[16];
#pragma unroll
    for (int i = 0; i < 16; ++i) o[i] = (v[i] * rstd * gv[i]) * scv[i] + shv[i];
    bf16_t* hr = p.H + (size_t)row * D;
    *(uint4*)(hr + 8 * lane) = pack8(o);
    *(uint4*)(hr + 512 + 8 * lane) = pack8(o + 8);
    if (which) {
      float am = 0.f;
#pragma unroll
      for (int i = 0; i < 16; ++i) am = fmaxf(am, fabsf(o[i]));
      am = wave_max(am);
      const float sc = am > 0.f ? 127.f / am : 1.f;
      unsigned char* h8 = p.H8 + (size_t)row * 1024;
      *(uint2*)(h8 + 8 * lane) = make_uint2((unsigned)pack_i8(o[0] * sc, o[1] * sc, o[2] * sc, o[3] * sc), (unsigned)pack_i8(o[4] * sc, o[5] * sc, o[6] * sc, o[7] * sc));
      *(uint2*)(h8 + 512 + 8 * lane) = make_uint2((unsigned)pack_i8(o[8] * sc, o[9] * sc, o[10] * sc, o[11] * sc), (unsigned)pack_i8(o[12] * sc, o[13] * sc, o[14] * sc, o[15] * sc));
      if (lane == 0) p.HINV[row] = am > 0.f ? am * (1.f / 127.f) : 1.f;
    }
  }
}

DEV bool gemm_unit(int it, int nct, int& rt, int& ct) {
  const int nslot = gridDim.x >> 3;
  const int x = bid_() & 7, sl = bid_() >> 3;
  if (sl >= nslot) return false;
  const int v = it * nslot + sl;
  if (v >= 68 * nct) return false;
  const int rg = v / (8 * nct), rem = v - rg * 8 * nct;
  const int rows = (rg == 8) ? 4 : 8;
  ct = rem / rows;
  rt = x * 68 + rg * 8 + (rem - ct * rows);
  return true;
}
struct Epi1 {
  const P& p; int row0, col0;
  DEV void operator()(f32x4 (&acc)[4][4], int wr, int wc, int fr, int fq, char* smem) const {
    const int cw = col0 + wc * 64;
    const int rbase = row0 + wr * 64;
    const bool lat = (row0 % LT) >= LC;
    if (cw >= 1536 && cw < 1664) {
#pragma unroll
      for (int m = 0; m < 4; ++m)
#pragma unroll
        for (int n = 0; n < 4; ++n)
#pragma unroll
          for (int j = 0; j < 4; ++j) acc[m][n][j] = 2.f * sigmoidf_(2.f * acc[m][n][j]) - 1.f;
    } else if (cw >= 1792 && cw < 1920) {
#pragma unroll
      for (int m = 0; m < 4; ++m)
#pragma unroll
        for (int n = 0; n < 4; ++n)
#pragma unroll
          for (int j = 0; j < 4; ++j) acc[m][n][j] = sigmoidf_(acc[m][n][j]);
    } else if (cw >= 1920 && cw < 2560 && lat) {
#pragma unroll
      for (int m = 0; m < 4; ++m) {
        const int row = rbase + m * 16 + fr;
        const int pl = (row % LT) - LC;
        const int ri = pl >> 6, ci = pl & 63;
        const float4* crp = (const float4*)(p.rope + 2 * (ri * 16 + 4 * fq));
        const float4* ccp = (const float4*)(p.rope + 2 * (ci * 16 + 4 * fq));
        const float4 cr0 = crp[0], cr1 = crp[1], cc0 = ccp[0], cc1 = ccp[1];
        const float crc[4] = {cr0.x, cr0.z, cr1.x, cr1.z}, crs[4] = {cr0.y, cr0.w, cr1.y, cr1.w};
        const float ccc[4] = {cc0.x, cc0.z, cc1.x, cc1.z}, ccs[4] = {cc0.y, cc0.w, cc1.y, cc1.w};
#pragma unroll
        for (int j = 0; j < 4; ++j) {
          float x1 = acc[m][0][j], x2 = acc[m][1][j];
          acc[m][0][j] = x1 * crc[j] - x2 * crs[j]; acc[m][1][j] = x2 * crc[j] + x1 * crs[j];
          x1 = acc[m][2][j]; x2 = acc[m][3][j];
          acc[m][2][j] = x1 * ccc[j] - x2 * ccs[j]; acc[m][3][j] = x2 * ccc[j] + x1 * ccs[j];
        }
      }
    }
    const int wid = wr * 2 + wc, lane = fq * 16 + fr;
    stage_tile_bf16(acc, smem, wid, fr, fq);
    const bf16_t (*t)[72] = (const bf16_t (*)[72])(smem + wid * 9216);
#pragma unroll
    for (int i = 0; i < 8; ++i) {
      const int rl = i * 8 + (lane >> 3), ch = lane & 7;
      *(uint4*)(p.Z + (size_t)(rbase + rl) * INW + cw + ch * 8) = *(const uint4*)&t[rl][ch * 8];
    }
  }
};
DEV void ph_gemm1(const P& p, char* smem) {
  const int nct = INW / 128;
  int rt, ct;
  for (int it = 0; gemm_unit(it, nct, rt, ct); ++it) {
    Epi1 epi{p, rt * 128, ct * 128};
    gemm_tile(p.H + (size_t)rt * 128 * D, D, p.W1t + (size_t)ct * 128 * D, D, D, smem, epi);
  }
}

struct EpiLoraA {
  const P& p; int layer, row0, col0;
  DEV void operator()(f32x4 (&acc)[4][4], int wr, int wc, int fr, int fq, char* smem) const {
    const float* w0b = p.rw_w0 + layer * 512;
    const float* a0b = p.rw_a0 + layer * 512;
#pragma unroll
    for (int n = 0; n < 4; ++n) {
      const int chan = ((col0 + wc * 64 + n * 16) >> 2) + fq;
      const float be0 = w0b[chan], ba0 = a0b[chan], be1 = w0b[256 + chan], ba1 = a0b[256 + chan];
#pragma unroll
      for (int m = 0; m < 4; ++m) {
        acc[m][n][0] = 0.6065306597126334f * sigmoidf_(acc[m][n][0] + be0);
        acc[m][n][1] = sigmoidf_(acc[m][n][1] + ba0);
        acc[m][n][2] = 0.6065306597126334f * sigmoidf_(acc[m][n][2] + be1);
        acc[m][n][3] = sigmoidf_(acc[m][n][3] + ba1);
      }
    }
    const int wid = wr * 2 + wc, lane = fq * 16 + fr;
    stage_tile_bf16(acc, smem, wid, fr, fq);
    const bf16_t (*t)[72] = (const bf16_t (*)[72])(smem + wid * 9216);
#pragma unroll
    for (int i = 0; i < 8; ++i) {
      const int rl = i * 8 + (lane >> 3), ch = lane & 7;
      *(uint4*)(p.SC + (size_t)(row0 + wr * 64 + rl) * 1024 + col0 + wc * 64 + ch * 8) = *(const uint4*)&t[rl][ch * 8];
    }
  }
};
struct EpiLoraG {
  const P& p; int row0, col0;
  DEV void operator()(f32x4 (&acc)[4][4], int wr, int wc, int fr, int fq, char* smem) const {
    const int wid = wr * 2 + wc, lane = fq * 16 + fr;
    stage_tile_bf16(acc, smem, wid, fr, fq);
    const bf16_t (*t)[72] = (const bf16_t (*)[72])(smem + wid * 9216);
#pragma unroll
    for (int i = 0; i < 8; ++i) {
      const int rl = i * 8 + (lane >> 3), ch = lane & 7;
      *(uint4*)(p.Y + (size_t)(row0 + wr * 64 + rl) * D + 256 + col0 + wc * 64 + ch * 8) = *(const uint4*)&t[rl][ch * 8];
    }
  }
};
DEV void ph_lora(const P& p, int layer, char* smem) {
  int rt, ct;
  for (int it = 0; gemm_unit(it, 10, rt, ct); ++it) {
    if (ct < 8) {
      EpiLoraA epi{p, layer, rt * 128, ct * 128};
      gemm_tile(p.Z + (size_t)rt * 128 * INW + 1536, INW, p.Wlt + (size_t)ct * 128 * 256, 256, 256, smem, epi);
    } else {
      EpiLoraG epi{p, rt * 128, (ct - 8) * 128};
      gemm_tile(p.Z + (size_t)rt * 128 * INW + 1792, INW, p.Wgt + (size_t)(ct - 8) * 128 * 128, 128, 128, smem, epi);
    }
  }
}

DEV void ph_rwkv_prep(const P& p, int layer) {
  const int lane = tid_() & 63;
  int r0, r1;
  wave_range(r0, r1, NTOK);
  const float* cw = p.conv_w + (size_t)layer * 3 * 1536;
  const float* cb = p.conv_b + (size_t)layer * 1536;
  float w0[3][4], w1[3][4], w2[3][4], bb[3][4], kkw[4];
#pragma unroll
  for (int a = 0; a < 3; ++a)
#pragma unroll
    for (int i = 0; i < 4; ++i) {
      const int col = 768 + a * 256 + 4 * lane + i;
      w0[a][i] = cw[col]; w1[a][i] = cw[1536 + col]; w2[a][i] = cw[3072 + col]; bb[a][i] = cb[col];
    }
#pragma unroll
  for (int i = 0; i < 4; ++i) kkw[i] = p.rw_k_k[layer * 256 + 4 * lane + i];
  uint2 zm[3], zc[3], zp[3];
  auto ldz = [&](int row, uint2 (&z)[3]) {
#pragma unroll
    for (int a = 0; a < 3; ++a) z[a] = *(const uint2*)(p.Z + (size_t)row * INW + 768 + a * 256 + 4 * lane);
  };
  auto zero3 = [&](uint2 (&z)[3]) {
#pragma unroll
    for (int a = 0; a < 3; ++a) z[a] = make_uint2(0u, 0u);
  };
  if (r0 < r1) {
    if (r0 > 0) ldz(r0 - 1, zm); else zero3(zm);
    ldz(r0, zc);
  }
#pragma unroll 1
  for (int row = r0; row < r1; ++row) {
    if (row + 1 < NTOK) ldz(row + 1, zp); else zero3(zp);
    const int pp = row % LT;
    const bool hasm = (pp != 0) && (pp != LC);
    const bool hasp = (pp != LC - 1) && (pp != LT - 1);
    float res[3][4];
#pragma unroll
    for (int a = 0; a < 3; ++a) {
      const uint2 um = hasm ? zm[a] : make_uint2(0u, 0u), uc = zc[a], up = hasp ? zp[a] : make_uint2(0u, 0u);
      const float vm[4] = {bflo(um.x), bfhi(um.x), bflo(um.y), bfhi(um.y)};
      const float vc[4] = {bflo(uc.x), bfhi(uc.x), bflo(uc.y), bfhi(uc.y)};
      const float vp[4] = {bflo(up.x), bfhi(up.x), bflo(up.y), bfhi(up.y)};
#pragma unroll
      for (int i = 0; i < 4; ++i) res[a][i] = w0[a][i] * vm[i] + w1[a][i] * vc[i] + w2[a][i] * vp[i] + bb[a][i];
    }
    float kk[4], ss = 0.f;
#pragma unroll
    for (int i = 0; i < 4; ++i) { kk[i] = res[1][i] * kkw[i]; ss += kk[i] * kk[i]; }
    ss = row16_sum(ss);
    const float rs = rsqrtf(ss + 1e-12f);
    bf16_t* hr = p.H + (size_t)row * D + 16 * lane;
    *(uint4*)hr = make_uint4(pack2(res[0][0], res[1][0]), pack2(kk[0] * rs, res[2][0]), pack2(res[0][1], res[1][1]), pack2(kk[1] * rs, res[2][1]));
    *(uint4*)(hr + 8) = make_uint4(pack2(res[0][2], res[1][2]), pack2(kk[2] * rs, res[2][2]), pack2(res[0][3], res[1][3]), pack2(kk[3] * rs, res[2][3]));
#pragma unroll
    for (int a = 0; a < 3; ++a) { zm[a] = zc[a]; zc[a] = zp[a]; }
  }
}

DEV float oct_sum(float x) { x += dpp0<0xB1, 0xF>(x); x += dpp0<0x4E, 0xF>(x); x += dpp0<0x141, 0xF>(x); return x; }
DEV bf16x8 frag_join(uint2 lo, uint2 hi) { uint4 w = make_uint4(lo.x, lo.y, hi.x, hi.y); return __builtin_bit_cast(bf16x8, w); }
constexpr int SCS_SET = 17152, SCS_IMG = 3 * SCS_SET, SCS_W0 = SCS_IMG + 2 * 3072;
DEV void scanc_unit(const P& p, int layer, int unit, char* smem) {
  const int dir = unit & 1, h = (unit >> 1) & 3, b = unit >> 3;
  const int tid = tid_(), lane = tid & 63, fr = lane & 15, fq = lane >> 4;
  const int w = __builtin_amdgcn_readfirstlane(tid >> 6);
  bf16_t* IMG0 = (bf16_t*)(smem + SCS_W0);
  bf16_t* IMG1 = IMG0 + 512;
  bf16_t* IMG2 = IMG0 + 1024;
  __syncthreads();
  for (int i = tid; i < (2 * 3072 + 3072) / 4; i += 256) ((unsigned*)(smem + SCS_IMG))[i] = 0u;
  const float ka = p.rw_k_a[layer * 256 + h * 64 + lane];
  const size_t rowbase = (size_t)b * LT;
  const char* hbase = (const char*)p.H;
  const char* sbase = (const char*)p.SC;
  const unsigned hoff = (unsigned)(rowbase * 2048) + (unsigned)((h * 64 + lane) * 8);
  const unsigned soff = hoff + 4u * (unsigned)dir;
  bf16_t* yb = p.Z + rowbase * INW + 768 + dir * 256 + h * 64 + w * 16 + fr;
  auto pos0 = [&](int c) -> int { const int t = c * 16; return dir == 0 ? t : (t < LC ? LC - 1 - t : LT - 1 - (t - LC)); };
  const int pstep = dir == 0 ? 1 : -1;
  constexpr int NCH = LT / 16;
  struct Raw { unsigned sc[16]; uint2 hr[6]; };
  auto load_raw = [&](int c, Raw& rw) {
    if (w != 0) {
      const int p0 = pos0(c);
      const unsigned so = soff + (unsigned)(p0 * 2048);
      const int st = pstep * 2048;
#pragma unroll
      for (int i = 0; i < 16; ++i) rw.sc[i] = *(const unsigned*)(sbase + (so + (unsigned)(i * st)));
      const unsigned ho = hoff + (unsigned)((p0 + pstep * (w - 1)) * 2048);
#pragma unroll
      for (int q = 0; q < 6; ++q) {
        const int qq = ((w - 1) + 3 * q < 16) ? q : 4;
        rw.hr[q] = *(const uint2*)(hbase + (ho + (unsigned)(qq * 3 * st)));
      }
    }
  };
  auto stage1w = [&](int set, const Raw& rw, auto W1tag) {
    constexpr int W1 = decltype(W1tag)::value;
    char* base = smem + set * SCS_SET;
    bf16_t (*At)[72] = (bf16_t (*)[72])(base);
    bf16_t (*Rt)[72] = (bf16_t (*)[72])(base + 2304);
    bf16_t (*Bt)[72] = (bf16_t (*)[72])(base + 4608);
    bf16_t (*Kt)[72] = (bf16_t (*)[72])(base + 6912);
    bf16_t (*BKT)[36] = (bf16_t (*)[36])(base + 9216);
    bf16_t* VV = (bf16_t*)(base + 13824);
    float* G16 = (float*)(base + 16896);
    float Erun = 0.f;
#pragma unroll
    for (int i = 0; i < 16; ++i) {
      const float ev = bflo(rw.sc[i]);
      const float Eprev = Erun;
      Erun += ev;
      if ((i % 3) == W1) {
        const uint2 hrec = rw.hr[i / 3];
        const float rr = bflo(hrec.x), kr = bfhi(hrec.x), kkv = bflo(hrec.y);
        const float av = bfhi(rw.sc[i]);
        const float gp = __expf(-Eprev), gi = __expf(-Erun), ig = __expf(Erun);
        const float at = -kkv * gp, rt = rr * gi, bt = kkv * av * ig, kt2 = kr * (1.f + (av - 1.f) * ka) * ig;
        const unsigned ar = pack2(at, rt), bk = pack2(bt, kt2);
        At[i][lane] = (bf16_t)(ar & 0xFFFFu); Rt[i][lane] = (bf16_t)(ar >> 16);
        Bt[i][lane] = (bf16_t)(bk & 0xFFFFu); Kt[i][lane] = (bf16_t)(bk >> 16);
        BKT[lane][(i >> 2) * 8 + (i & 3)] = (bf16_t)(bk & 0xFFFFu);
        BKT[lane][(i >> 2) * 8 + 4 + (i & 3)] = (bf16_t)(bk >> 16);
        VV[((i >> 2) * 64 + lane) * 6 + (i & 3)] = (bf16_t)(hrec.y >> 16);
        if (i == 15) G16[lane] = gi;
      }
    }
  };
  auto stage1 = [&](int set, const Raw& rw) {
    if (w == 1) stage1w(set, rw, std::integral_constant<int, 0>{});
    else if (w == 2) stage1w(set, rw, std::integral_constant<int, 1>{});
    else if (w == 3) stage1w(set, rw, std::integral_constant<int, 2>{});
  };
  auto stage2 = [&](int set, int iset) {
    char* base = smem + set * SCS_SET;
    const bf16_t (*At)[72] = (const bf16_t (*)[72])(base);
    const bf16_t (*Rt)[72] = (const bf16_t (*)[72])(base + 2304);
    const bf16_t (*Bt)[72] = (const bf16_t (*)[72])(base + 4608);
    const bf16_t (*Kt)[72] = (const bf16_t (*)[72])(base + 6912);
    bf16_t* TT = (bf16_t*)(smem + SCS_IMG + iset * 3072);
    bf16_t* ARK = TT + 512;
    bf16_t* AAK = TT + 1024;
    const bf16_t (*X)[72] = (w < 2) ? At : Rt;
    const bf16_t (*Y)[72] = (w & 1) ? Kt : Bt;
    f32x4 cm = (f32x4){0.f, 0.f, 0.f, 0.f};
#pragma unroll
    for (int s = 0; s < 2; ++s) {
      bf16x8 af = *(const bf16x8*)&X[fr][32 * s + 8 * fq];
      bf16x8 bm = *(const bf16x8*)&Y[fr][32 * s + 8 * fq];
      cm = mfma16(af, bm, cm);
    }
#pragma unroll
    for (int jj = 0; jj < 4; ++jj) {
      const int i = 4 * fq + jj;
      const bool keep = (w < 2) ? (fr < i) : (fr <= i);
      cm[jj] = keep ? cm[jj] : 0.f;
    }
    const int io = (fr >> 2) * 8 + (fr & 3);
    auto wr_img = [&](bf16_t* img, const f32x4& Xv, int hi) {
#pragma unroll
      for (int jj = 0; jj < 4; ++jj) img[(4 * fq + jj) * 32 + io + hi] = f2bf(Xv[jj]);
    };
    if (w == 1) wr_img(AAK, cm, 0);
    else if (w == 2) wr_img(ARK, cm, 0);
    else if (w == 3) wr_img(ARK, cm, 4);
    else {
      auto bfrag = [&](const f32x4& Xv) { return frag_join(make_uint2(pack2(Xv[0], Xv[1]), pack2(Xv[2], Xv[3])), make_uint2(0u, 0u)); };
      auto afr = [&](const bf16_t* img) { return *(const bf16x8*)&img[(fr * 4 + fq) * 8]; };
      const f32x4 Z4 = (f32x4){0.f, 0.f, 0.f, 0.f};
      wr_img(IMG0, cm, 0);
      asm volatile("" ::: "memory");
      f32x4 A2 = mfma16(afr(IMG0), bfrag(cm), Z4);
      wr_img(IMG1, A2, 0);
      asm volatile("" ::: "memory");
      f32x4 A4 = mfma16(afr(IMG1), bfrag(A2), Z4);
      wr_img(IMG2, A4, 0);
      asm volatile("" ::: "memory");
      f32x4 Rm = mfma16(afr(IMG2), bfrag(A4), Z4);
#pragma unroll
      for (int jj = 0; jj < 4; ++jj) Rm[jj] += (fr == 4 * fq + jj) ? 1.f : 0.f;
      Rm = mfma16(afr(IMG2), bfrag(Rm), Rm);
      Rm = mfma16(afr(IMG1), bfrag(Rm), Rm);
      Rm = mfma16(afr(IMG0), bfrag(Rm), Rm);
      wr_img(TT, Rm, 0);
    }
  };
  f32x4 acc[4];
#pragma unroll
  for (int kt = 0; kt < 4; ++kt) acc[kt] = (f32x4){0.f, 0.f, 0.f, 0.f};
  auto part2 = [&](int c, int set, int iset) {
    char* base = smem + set * SCS_SET;
    const bf16_t (*At)[72] = (const bf16_t (*)[72])(base);
    const bf16_t (*Rt)[72] = (const bf16_t (*)[72])(base + 2304);
    const bf16_t (*BKT)[36] = (const bf16_t (*)[36])(base + 9216);
    const bf16_t* VV = (const bf16_t*)(base + 13824);
    const float* G16 = (const float*)(base + 16896);
    const bf16_t* TT = (const bf16_t*)(smem + SCS_IMG + iset * 3072);
    const bf16_t* ARK = TT + 512;
    const bf16_t* AAK = TT + 1024;
    bf16x8 Sb[2];
#pragma unroll
    for (int s = 0; s < 2; ++s) {
      uint4 t = make_uint4(pack2(acc[2 * s][0], acc[2 * s][1]), pack2(acc[2 * s][2], acc[2 * s][3]),
                           pack2(acc[2 * s + 1][0], acc[2 * s + 1][1]), pack2(acc[2 * s + 1][2], acc[2 * s + 1][3]));
      Sb[s] = __builtin_bit_cast(bf16x8, t);
    }
    const unsigned* vvp = (const unsigned*)&VV[(fq * 64 + w * 16 + fr) * 6];
    const uint2 vv = make_uint2(vvp[0], vvp[1]);
    const bf16x8 Vlow = frag_join(vv, make_uint2(0u, 0u));
    f32x4 Pm = (f32x4){0.f, 0.f, 0.f, 0.f};
#pragma unroll
    for (int s = 0; s < 2; ++s) {
      bf16x8 af = frag_join(*(const uint2*)&At[fr][32 * s + 4 * fq], *(const uint2*)&At[fr][32 * s + 16 + 4 * fq]);
      Pm = mfma16(af, Sb[s], Pm);
    }
    Pm = mfma16(*(const bf16x8*)&AAK[(fr * 4 + fq) * 8], Vlow, Pm);
    const bf16x8 Pb = frag_join(make_uint2(pack2(Pm[0], Pm[1]), pack2(Pm[2], Pm[3])), make_uint2(0u, 0u));
    f32x4 U = mfma16(*(const bf16x8*)&TT[(fr * 4 + fq) * 8], Pb, (f32x4){0.f, 0.f, 0.f, 0.f});
    const bf16x8 UV = frag_join(make_uint2(pack2(U[0], U[1]), pack2(U[2], U[3])), vv);
    f32x4 Yv = (f32x4){0.f, 0.f, 0.f, 0.f};
#pragma unroll
    for (int s = 0; s < 2; ++s) {
      bf16x8 af = frag_join(*(const uint2*)&Rt[fr][32 * s + 4 * fq], *(const uint2*)&Rt[fr][32 * s + 16 + 4 * fq]);
      Yv = mfma16(af, Sb[s], Yv);
    }
    Yv = mfma16(*(const bf16x8*)&ARK[(fr * 4 + fq) * 8], UV, Yv);
    {
      const int p0 = pos0(c);
#pragma unroll
      for (int jj = 0; jj < 4; ++jj) yb[(size_t)(p0 + pstep * (4 * fq + jj)) * INW] = f2bf(Yv[jj]);
    }
#pragma unroll
    for (int kt = 0; kt < 4; ++kt) {
      f32x4 t = mfma16(frag_join(*(const uint2*)&BKT[16 * kt + fr][fq * 8], *(const uint2*)&BKT[16 * kt + fr][fq * 8 + 4]), UV, acc[kt]);
      const float4 g4 = *(const float4*)&G16[16 * kt + 4 * fq];
      t[0] *= g4.x; t[1] *= g4.y; t[2] *= g4.z; t[3] *= g4.w;
      acc[kt] = t;
    }
  };
  __builtin_amdgcn_s_setprio(3);
  Raw r0, r1;
  load_raw(0, r0); load_raw(1, r1);
  stage1(0, r0);
  load_raw(2, r0);
  __syncthreads();
  stage2(0, 0);
  stage1(1, r1);
  load_raw(3, r1);
  __syncthreads();
  int s0 = 0, s1 = 1, s2 = 2;
  auto iter = [&](int c, Raw& rw) {
    if (c + 1 < NCH) stage2(s1, (c + 1) & 1);
    part2(c, s0, c & 1);
    if (c + 2 < NCH) {
      stage1(s2, rw);
      if (c + 4 < NCH) load_raw(c + 4, rw);
    }
    asm volatile("s_waitcnt lgkmcnt(0)" ::: "memory");
    __builtin_amdgcn_s_barrier();
    asm volatile("" ::: "memory");
    const int t = s0; s0 = s1; s1 = s2; s2 = t;
  };
#pragma unroll 1
  for (int c = 0; c < NCH; c += 2) {
    iter(c, r0); iter(c + 1, r1);
  }
  __builtin_amdgcn_s_setprio(0);
}

DEV void ph_rwkv_post(const P& p, int layer) {
  const int lane = tid_() & 63;
  int r0, r1;
  wave_range(r0, r1, NTOK);
  const int ch = 4 * lane;
  float kav[4], rkv[4], lnw[4], lnb[4];
#pragma unroll
  for (int i = 0; i < 4; ++i) {
    kav[i] = p.rw_k_a[layer * 256 + ch + i]; rkv[i] = p.rw_r_k[layer * 256 + ch + i];
    lnw[i] = p.rw_ln_w[layer * 256 + ch + i]; lnb[i] = p.rw_ln_b[layer * 256 + ch + i];
  }
  struct In { uint2 y0, y1, g; uint4 h0, h1, s0, s1; };
  auto ld = [&](int row, In& in) {
    const bf16_t* zr = p.Z + (size_t)row * INW + 768 + ch;
    in.y0 = *(const uint2*)zr; in.y1 = *(const uint2*)(zr + 256);
    const bf16_t* hr = p.H + (size_t)row * D + 4 * ch;
    in.h0 = *(const uint4*)hr; in.h1 = *(const uint4*)(hr + 8);
    const bf16_t* sr = p.SC + (size_t)row * 1024 + 4 * ch;
    in.s0 = *(const uint4*)sr; in.s1 = *(const uint4*)(sr + 8);
    in.g = *(const uint2*)(p.Y + (size_t)row * D + 256 + ch);
  };
  In nx;
  if (r0 < r1) ld(r0, nx);
#pragma unroll 1
  for (int row = r0; row < r1; ++row) {
    const In in = nx;
    if (row + 1 < r1) ld(row + 1, nx);
    float y[4] = {bflo(in.y0.x) + bflo(in.y1.x), bfhi(in.y0.x) + bfhi(in.y1.x), bflo(in.y0.y) + bflo(in.y1.y), bfhi(in.y0.y) + bfhi(in.y1.y)};
    const float mu = row16_sum(y[0] + y[1] + y[2] + y[3]) * (1.f / 64.f);
    float vs = 0.f;
#pragma unroll
    for (int i = 0; i < 4; ++i) { y[i] -= mu; vs += y[i] * y[i]; }
    const float var = row16_sum(vs) * (1.f / 64.f);
    const float rstd = rsqrtf(var + 64e-5f);
    const float r[4] = {bflo(in.h0.x), bflo(in.h0.z), bflo(in.h1.x), bflo(in.h1.z)};
    const float k[4] = {bfhi(in.h0.x), bfhi(in.h0.z), bfhi(in.h1.x), bfhi(in.h1.z)};
    const float v[4] = {bfhi(in.h0.y), bfhi(in.h0.w), bfhi(in.h1.y), bfhi(in.h1.w)};
    const float a0[4] = {bfhi(in.s0.x), bfhi(in.s0.z), bfhi(in.s1.x), bfhi(in.s1.z)};
    const float a1[4] = {bfhi(in.s0.y), bfhi(in.s0.w), bfhi(in.s1.y), bfhi(in.s1.w)};
    float sd = 0.f;
#pragma unroll
    for (int i = 0; i < 4; ++i) {
      const float kd0 = k[i] * (1.f + (a0[i] - 1.f) * kav[i]), kd1 = k[i] * (1.f + (a1[i] - 1.f) * kav[i]);
      sd += r[i] * (kd0 + kd1) * rkv[i];
    }
    sd = row16_sum(sd);
    const float g[4] = {bflo(in.g.x), bfhi(in.g.x), bflo(in.g.y), bfhi(in.g.y)};
    float o[4];
#pragma unroll
    for (int i = 0; i < 4; ++i) {
      const float yn = y[i] * rstd * lnw[i] + lnb[i];
      o[i] = (yn + sd * v[i]) * g[i];
    }
    *(uint2*)(p.Y + (size_t)row * D + 256 + ch) = make_uint2(pack2(o[0], o[1]), pack2(o[2], o[3]));
  }
}

DEV void hyena_pre_unit(const P& p, int layer, int unit) {
  int kind, b, t0, L;
  if (unit < 1024) { kind = 0; b = unit >> 6; t0 = (unit & 63) * 64; L = T; } else { int u = unit - 1024; kind = 1; b = u >> 2; t0 = (u & 3) * 64; L = LC; }
  const int lane = tid_() & 63, wid = tid_() >> 6;
  const int tw = t0 + wid * 16;
  const size_t row0 = (size_t)b * LT + (kind ? 0 : LC);
  const float* cw = p.conv_w + (size_t)layer * 3 * 1536;
  const float* cb = p.conv_b + (size_t)layer * 1536;
  float wx[3][4], wv[3][4], bx[4], bv[4];
#pragma unroll
  for (int i = 0; i < 4; ++i) {
    const int cx = 256 + 4 * lane + i, cv = 512 + 4 * lane + i;
#pragma unroll
    for (int k = 0; k < 3; ++k) { wx[k][i] = cw[k * 1536 + cx]; wv[k][i] = cw[k * 1536 + cv]; }
    bx[i] = cb[cx]; bv[i] = cb[cv];
  }
  uint2 zx[18], zv[18];
#pragma unroll
  for (int i = 0; i < 18; ++i) {
    const int t = tw - 1 + i;
    if (t >= 0 && t < L) {
      const bf16_t* zr = p.Z + (row0 + t) * INW + 256 + 4 * lane;
      zx[i] = *(const uint2*)zr; zv[i] = *(const uint2*)(zr + 256);
    } else { zx[i] = make_uint2(0u, 0u); zv[i] = make_uint2(0u, 0u); }
  }
  float uo[4][16];
#pragma unroll
  for (int i = 0; i < 16; ++i) {
    const float xm[4] = {bflo(zx[i].x), bfhi(zx[i].x), bflo(zx[i].y), bfhi(zx[i].y)};
    const float xc[4] = {bflo(zx[i + 1].x), bfhi(zx[i + 1].x), bflo(zx[i + 1].y), bfhi(zx[i + 1].y)};
    const float xp[4] = {bflo(zx[i + 2].x), bfhi(zx[i + 2].x), bflo(zx[i + 2].y), bfhi(zx[i + 2].y)};
    const float vm[4] = {bflo(zv[i].x), bfhi(zv[i].x), bflo(zv[i].y), bfhi(zv[i].y)};
    const float vc[4] = {bflo(zv[i + 1].x), bfhi(zv[i + 1].x), bflo(zv[i + 1].y), bfhi(zv[i + 1].y)};
    const float vp[4] = {bflo(zv[i + 2].x), bfhi(zv[i + 2].x), bflo(zv[i + 2].y), bfhi(zv[i + 2].y)};
#pragma unroll
    for (int q = 0; q < 4; ++q) {
      const float a = wx[0][q] * xm[q] + wx[1][q] * xc[q] + wx[2][q] * xp[q] + bx[q];
      const float c2 = wv[0][q] * vm[q] + wv[1][q] * vc[q] + wv[2][q] * vp[q] + bv[q];
      uo[q][i] = a * c2;
    }
  }
  bf16_t* ut = kind ? opq(p.UTc) : opq(p.UTl);
#pragma unroll
  for (int q = 0; q < 4; ++q) {
    bf16_t* dst = ut + ((size_t)(4 * lane + q) * 16 + b) * L + tw;
    *(uint4*)dst = pack8(&uo[q][0]);
    *(uint4*)(dst + 8) = pack8(&uo[q][8]);
  }
}

DEV void lds_barrier() {
  asm volatile("s_waitcnt lgkmcnt(0)" ::: "memory");
  __builtin_amdgcn_s_barrier();
  asm volatile("" ::: "memory");
}
DEV void hyena_scale_unit(const P& p, int layer, int u, char* smem) {
  const int kind = u >> 8, c = u & 255, L = kind ? LC : T;
  const float* F = (kind ? opq(p.FC) : opq(p.FL)) + (size_t)c * 2 * L;
  float* red = (float*)smem;
  const int tid = tid_(), lane = tid & 63, wid = tid >> 6;
  float part = 0.f;
  for (int i = tid; i < 2 * L; i += 256) { float fv = F[i]; part += (i != L) ? fv * fv : 0.f; }
  part = wave_sum(part);
  __syncthreads();
  if (lane == 0) red[wid] = part;
  __syncthreads();
  if (tid == 0) p.SSQ[(layer * 2 + kind) * 256 + c] = rsqrtf(((red[0] + red[1]) + (red[2] + red[3])) + 1e-6f);
}
constexpr int HC_CQ = 65 * 144, HC_US = 32 * 272, HC_BUF = HC_CQ + HC_US;
typedef const __attribute__((address_space(1))) float* gfloat_p;
typedef unsigned u32x4_t __attribute__((ext_vector_type(4)));
typedef const __attribute__((address_space(1))) u32x4_t* guint4_p;
DEV void hyena_conv_unit(const P& p, int layer, int unit, char* smem) {
  int kind, c, tb, L;
  if (unit < 4096) { kind = 0; c = unit >> 4; tb = (unit & 15) * 256; L = T; } else { kind = 1; c = unit - 4096; tb = 0; L = LC; }
  const int tid = tid_(), lane = tid & 63, wid = tid >> 6, fr = lane & 15, fq = lane >> 4;
  const gfloat_p F = (gfloat_p)((kind ? opq(p.FC) : opq(p.FL)) + (size_t)c * 2 * L);
  const int nch = L / 256;
  const int bb = tid >> 4, sg0 = tid & 15;
  const guint4_p U = (guint4_p)((kind ? opq(p.UTc) : opq(p.UTl)) + (size_t)c * 16 * L + (size_t)bb * L + 8 * sg0);
  auto ldchunk = [&](int ch, float& f0, float& f1, float& f2, uint4& u0, uint4& u1) {
    const int D0 = tb + 256 - ch * 256;
    auto tap = [&](int n) -> float {
      const int d = D0 - n;
      const bool ok = (d > -L) && (d < L);
      int idx = d >= 0 ? d : L - d;
      idx = ok ? idx : 0;
      return F[idx];
    };
    f0 = tap(tid); f1 = tap(tid + 256); f2 = tap(tid < 8 ? tid + 512 : 100000);
    const u32x4_t w0 = U[ch * 32], w1 = U[ch * 32 + 16];
    u0 = make_uint4(w0.x, w0.y, w0.z, w0.w); u1 = make_uint4(w1.x, w1.y, w1.z, w1.w);
  };
  const float scale = p.SSQ[(layer * 2 + kind) * 256 + c];
  float fa0, fa1, fa2, fb0, fb1, fb2, fc0, fc1, fc2;
  uint4 ua0, ua1, ub0, ub1, uc0, uc1;
  const int lastc = nch - 1;
  ldchunk(0, fa0, fa1, fa2, ua0, ua1);
  ldchunk(min(1, lastc), fb0, fb1, fb2, ub0, ub1);
  ldchunk(min(2, lastc), fc0, fc1, fc2, uc0, uc1);
  auto stchunk = [&](int ch, float f0, float f1, float f2, const uint4& u0, const uint4& u1) {
    const int buf = ch & 1;
    bf16_t* Cq = (bf16_t*)(smem + buf * HC_BUF);
    char* Us = smem + buf * HC_BUF + HC_CQ;
    const int d0 = tb + 256 - ch * 256 - tid, d1 = d0 - 256, d2 = d0 - 512;
    const bf16_t h0 = f2bf((d0 > -L && d0 < L) ? f0 * scale : 0.f), h1 = f2bf((d1 > -L && d1 < L) ? f1 * scale : 0.f);
    const bf16_t h2 = f2bf((d2 > -L && d2 < L) ? f2 * scale : 0.f);
#pragma unroll
    for (int rho = 0; rho < 8; ++rho) {
      int m = tid + rho;
      Cq[(m >> 3) * 72 + rho * 8 + (m & 7)] = h0;
      m = tid + 256 + rho;
      if (m < 520) Cq[(m >> 3) * 72 + rho * 8 + (m & 7)] = h1;
      m = tid + 512 + rho;
      if (tid < 8 && m < 520) Cq[(m >> 3) * 72 + rho * 8 + (m & 7)] = h2;
    }
    if (tid < 8) {
#pragma unroll
      for (int rho = 1; rho < 8; ++rho) if (tid < rho) Cq[rho * 8 + tid] = 0;
    }
    *(uint4*)(Us + sg0 * 272 + bb * 16) = u0;
    *(uint4*)(Us + (sg0 + 16) * 272 + bb * 16) = u1;
  };
  f32x4 acc[4];
#pragma unroll
  for (int m = 0; m < 4; ++m) acc[m] = (f32x4){0.f, 0.f, 0.f, 0.f};
  const int a0 = (32 - 8 * wid + fq - (fr >> 3)) * 144 + (fr & 7) * 16;
  auto compute = [&](int buf) {
    const char* Cq = smem + buf * HC_BUF + a0;
    const char* Us = smem + buf * HC_BUF + HC_CQ + fq * 272 + fr * 16;
    bf16x8 fa[4];
#pragma unroll
    for (int m = 0; m < 4; ++m) fa[m] = *(const bf16x8*)(Cq - m * 288);
#pragma unroll
    for (int kk = 0; kk < 8; ++kk) {
      const bf16x8 bf = *(const bf16x8*)(Us + kk * 4 * 272);
      if (kk > 0) {
        fa[3] = fa[1]; fa[2] = fa[0];
        fa[1] = *(const bf16x8*)(Cq + (2 * kk - 1) * 288);
        fa[0] = *(const bf16x8*)(Cq + (2 * kk) * 288);
      }
#pragma unroll
      for (int m = 0; m < 4; ++m) acc[m] = mfma16(fa[m], bf, acc[m]);
    }
  };
  __syncthreads();
  int ch = 0;
#pragma unroll 1
  for (; ch + 3 <= lastc; ch += 3) {
    stchunk(ch, fa0, fa1, fa2, ua0, ua1);
    lds_barrier();
    ldchunk(min(ch + 3, lastc), fa0, fa1, fa2, ua0, ua1);
    compute(ch & 1);
    stchunk(ch + 1, fb0, fb1, fb2, ub0, ub1);
    lds_barrier();
    ldchunk(min(ch + 4, lastc), fb0, fb1, fb2, ub0, ub1);
    compute((ch + 1) & 1);
    stchunk(ch + 2, fc0, fc1, fc2, uc0, uc1);
    lds_barrier();
    ldchunk(min(ch + 5, lastc), fc0, fc1, fc2, uc0, uc1);
    compute(ch & 1);
  }
  stchunk(ch, fa0, fa1, fa2, ua0, ua1);
  lds_barrier();
  compute(ch & 1);
  bf16_t* Yt = (kind ? opq(p.YTc) : opq(p.YTl)) + ((size_t)c * 16 + fr) * L + tb;
#pragma unroll
  for (int m = 0; m < 4; ++m) {
    int t = (wid * 4 + m) * 16 + fq * 4;
    *(uint2*)(Yt + t) = make_uint2(pack2(acc[m][0], acc[m][1]), pack2(acc[m][2], acc[m][3]));
  }
}

DEV void hyena_post_unit(const P& p, int layer, int unit, char* smem) {
  (void)smem;
  int kind, b, t0, L;
  if (unit < 1024) { kind = 0; b = unit >> 6; t0 = (unit & 63) * 64; L = T; } else { int u = unit - 1024; kind = 1; b = u >> 2; t0 = (u & 3) * 64; L = LC; }
  const int lane = tid_() & 63, wid = tid_() >> 6;
  const int tw = t0 + wid * 16;
  const size_t row0 = (size_t)b * LT + (kind ? 0 : LC);
  const float* cw = p.conv_w + (size_t)layer * 3 * 1536;
  float w0[3][4], b0[4], bias[4], og[4];
#pragma unroll
  for (int i = 0; i < 4; ++i) {
    const int c = 4 * lane + i;
#pragma unroll
    for (int k = 0; k < 3; ++k) w0[k][i] = cw[k * 1536 + c];
    b0[i] = p.conv_b[layer * 1536 + c]; bias[i] = p.hy_bias[layer * 256 + c]; og[i] = p.hy_out_g[layer * 256 + c];
  }
  uint2 zx[18];
#pragma unroll
  for (int i = 0; i < 18; ++i) {
    const int t = tw - 1 + i;
    zx[i] = (t >= 0 && t < L) ? *(const uint2*)(p.Z + (row0 + t) * INW + 4 * lane) : make_uint2(0u, 0u);
  }
  const bf16_t* ytb = kind ? opq(p.YTc) : opq(p.YTl);
  const bf16_t* utb = kind ? opq(p.UTc) : opq(p.UTl);
  float o[4][16];
#pragma unroll
  for (int q = 0; q < 4; ++q) {
    const size_t off = ((size_t)(4 * lane + q) * 16 + b) * L + tw;
    float yv[16], uv[16];
    { uint4 a0 = *(const uint4*)(ytb + off), a1 = *(const uint4*)(ytb + off + 8); unpack8(a0, yv); unpack8(a1, yv + 8); }
    { uint4 a0 = *(const uint4*)(utb + off), a1 = *(const uint4*)(utb + off + 8); unpack8(a0, uv); unpack8(a1, uv + 8); }
#pragma unroll
    for (int i = 0; i < 16; ++i) o[q][i] = yv[i] + uv[i] * bias[q];
  }
#pragma unroll
  for (int i = 0; i < 16; ++i) {
    const float xm[4] = {bflo(zx[i].x), bfhi(zx[i].x), bflo(zx[i].y), bfhi(zx[i].y)};
    const float xc[4] = {bflo(zx[i + 1].x), bfhi(zx[i + 1].x), bflo(zx[i + 1].y), bfhi(zx[i + 1].y)};
    const float xp[4] = {bflo(zx[i + 2].x), bfhi(zx[i + 2].x), bflo(zx[i + 2].y), bfhi(zx[i + 2].y)};
    float ov[4], ss = 0.f;
#pragma unroll
    for (int q = 0; q < 4; ++q) {
      const float x0 = w0[0][q] * xm[q] + w0[1][q] * xc[q] + w0[2][q] * xp[q] + b0[q];
      ov[q] = bf2f(f2bf(x0 * o[q][i]));
      ss += ov[q] * ov[q];
    }
    ss = wave_sum(ss);
    const float rstd = rsqrtf(ss * (1.f / 256.f) + 1e-6f);
    *(uint2*)(p.Y + (row0 + tw + i) * D + 4 * lane) = make_uint2(pack2(ov[0] * rstd * og[0], ov[1] * rstd * og[1]), pack2(ov[2] * rstd * og[2], ov[3] * rstd * og[3]));
  }
}

DEV void attn_unit(const P& p, int layer, int unit, char* smem) {
  const bool isctx = unit >= 4096;
  int b, qb, hq;
  if (!isctx) { b = unit >> 8; qb = (unit >> 3) & 31; hq = unit & 7; } else { int u = unit - 4096; b = u >> 4; qb = (u >> 3) & 1; hq = u & 7; }
  const int g = hq >> 2;
  const int tid = tid_(), lane = tid & 63, wid = tid >> 6, qn = lane & 31, hh = lane >> 5;
  const int qpos = qb * 128 + wid * 32 + qn;
  const size_t qrow = (size_t)b * LT + (isctx ? qpos : LC + qpos);
  const bf16_t* qptr = p.Z + qrow * INW + 1920 + hq * 64;
  bf16x8 qf[4];
#pragma unroll
  for (int s = 0; s < 4; ++s) qf[s] = *(const bf16x8*)(qptr + 16 * s + 8 * hh);
  const float c2 = 0.125f * 1.4426950408889634f;
  const int q0w = qb * 128 + wid * 32;
  float m_run = p.attn_sink[layer * 8 + hq] * 1.4426950408889634f, l_run = 1.f;
  f32x16 o0, o1;
#pragma unroll
  for (int i = 0; i < 16; ++i) { o0[i] = 0.f; o1[i] = 0.f; }
  typedef bf16_t KTile[64][72];
  typedef bf16_t VTile[64][68];
  KTile* Ks = (KTile*)smem;
  VTile* Vt = (VTile*)(smem + 18432);
  const int ntl = isctx ? 0 : 6;
  const int ntiles = ntl + 4;
  const int skey = tid >> 3, sseg = tid & 7;
  const bf16_t* kvbase = p.Z + (size_t)b * LT * INW + 1920 + 512 + g * 64 + sseg * 8;
  auto ldtile = [&](int kt, uint4& rk0, uint4& rk1, uint4& rv0, uint4& rv1) {
    const bool ctxk = kt >= ntl;
    const int kbase = ctxk ? (kt - ntl) * 64 : qb * 128 - 128 + kt * 64;
    int kp0 = kbase + skey, kp1 = kp0 + 32;
    if (!ctxk) { kp0 = min(max(kp0, 0), T - 1) + LC; kp1 = min(max(kp1, 0), T - 1) + LC; }
    const bf16_t* s0 = kvbase + (size_t)kp0 * INW;
    const bf16_t* s1 = kvbase + (size_t)kp1 * INW;
    rk0 = *(const uint4*)s0; rv0 = *(const uint4*)(s0 + 128);
    rk1 = *(const uint4*)s1; rv1 = *(const uint4*)(s1 + 128);
  };
  auto sttile = [&](int buf, const uint4& rk0, const uint4& rk1, const uint4& rv0, const uint4& rv1) {
    *(uint4*)&Ks[buf][skey][sseg * 8] = rk0;
    *(uint4*)&Ks[buf][skey + 32][sseg * 8] = rk1;
    bf16_t (*vt)[68] = Vt[buf];
    vt[sseg * 8 + 0][skey] = (bf16_t)(rv0.x & 0xFFFF); vt[sseg * 8 + 1][skey] = (bf16_t)(rv0.x >> 16);
    vt[sseg * 8 + 2][skey] = (bf16_t)(rv0.y & 0xFFFF); vt[sseg * 8 + 3][skey] = (bf16_t)(rv0.y >> 16);
    vt[sseg * 8 + 4][skey] = (bf16_t)(rv0.z & 0xFFFF); vt[sseg * 8 + 5][skey] = (bf16_t)(rv0.z >> 16);
    vt[sseg * 8 + 6][skey] = (bf16_t)(rv0.w & 0xFFFF); vt[sseg * 8 + 7][skey] = (bf16_t)(rv0.w >> 16);
    vt[sseg * 8 + 0][skey + 32] = (bf16_t)(rv1.x & 0xFFFF); vt[sseg * 8 + 1][skey + 32] = (bf16_t)(rv1.x >> 16);
    vt[sseg * 8 + 2][skey + 32] = (bf16_t)(rv1.y & 0xFFFF); vt[sseg * 8 + 3][skey + 32] = (bf16_t)(rv1.y >> 16);
    vt[sseg * 8 + 4][skey + 32] = (bf16_t)(rv1.z & 0xFFFF); vt[sseg * 8 + 5][skey + 32] = (bf16_t)(rv1.z >> 16);
    vt[sseg * 8 + 6][skey + 32] = (bf16_t)(rv1.w & 0xFFFF); vt[sseg * 8 + 7][skey + 32] = (bf16_t)(rv1.w >> 16);
  };
  auto edge_mask = [&](f32x16& sv, int kb2) {
    if (kb2 < q0w - 96 || kb2 > q0w + 96) {
#pragma unroll
      for (int rg = 0; rg < 16; ++rg) {
        const int kp = kb2 + (rg & 3) + 8 * (rg >> 2) + 4 * hh;
        const int dl = qpos - kp;
        sv[rg] = ((dl <= 128) && (dl >= -128)) ? sv[rg] : -1e30f;
      }
    }
  };
  auto max16 = [&](const f32x16& sv) -> float {
    float mt = fmaxf(fmaxf(sv[0], sv[1]), sv[2]);
#pragma unroll
    for (int rg = 3; rg < 15; rg += 2) mt = fmaxf(fmaxf(mt, sv[rg]), sv[rg + 1]);
    return fmaxf(mt, sv[15]);
  };
  auto new_max = [&](float mt) {
    mt = fmaxf(mt, __shfl_xor(mt, 32));
    const float m_new = fmaxf(m_run, mt * c2);
    if (__ballot(m_new > m_run) != 0ull) {
      const float corr = __builtin_amdgcn_exp2f(m_run - m_new);
      l_run *= corr;
      m_run = m_new;
#pragma unroll
      for (int i = 0; i < 16; ++i) { o0[i] *= corr; o1[i] *= corr; }
    }
  };
  auto exp16 = [&](f32x16& sv) -> float {
    float ps = 0.f;
#pragma unroll
    for (int rg = 0; rg < 16; ++rg) { const float pv = __builtin_amdgcn_exp2f(__builtin_fmaf(sv[rg], c2, -m_run)); sv[rg] = pv; ps += pv; }
    return ps;
  };
  auto pv_acc = [&](int buf, int sub, const f32x16& sv) {
#pragma unroll
    for (int sp = 0; sp < 2; ++sp) {
      const uint4 pw = make_uint4(pack2(sv[8 * sp], sv[8 * sp + 1]), pack2(sv[8 * sp + 2], sv[8 * sp + 3]), pack2(sv[8 * sp + 4], sv[8 * sp + 5]), pack2(sv[8 * sp + 6], sv[8 * sp + 7]));
      const bf16x8 pf = __builtin_bit_cast(bf16x8, pw);
      const int kc = sub * 32 + 16 * sp + 4 * hh;
      uint2 va = *(const uint2*)&Vt[buf][qn][kc], vb = *(const uint2*)&Vt[buf][qn][kc + 8];
      uint2 vc = *(const uint2*)&Vt[buf][32 + qn][kc], vd = *(const uint2*)&Vt[buf][32 + qn][kc + 8];
      uint4 w0 = make_uint4(va.x, va.y, vb.x, vb.y), w1 = make_uint4(vc.x, vc.y, vd.x, vd.y);
      bf16x8 v0 = __builtin_bit_cast(bf16x8, w0), v1 = __builtin_bit_cast(bf16x8, w1);
      o0 = mfma32(v0, pf, o0);
      o1 = mfma32(v1, pf, o1);
    }
  };
  auto compute = [&](int kt) {
    const int buf = kt & 1;
    const bool ctxk = kt >= ntl;
    const int kbase = ctxk ? (kt - ntl) * 64 : qb * 128 - 128 + kt * 64;
    bool n0 = true, n1 = true;
    if (!ctxk) {
      const int k1 = kbase + 32;
      n0 = !(kbase + 31 < q0w - 128 || kbase > q0w + 31 + 128 || kbase + 31 < 0 || kbase >= T);
      n1 = !(k1 + 31 < q0w - 128 || k1 > q0w + 31 + 128 || k1 + 31 < 0 || k1 >= T);
    }
    if (n0 && n1) {
      f32x16 s0, s1;
#pragma unroll
      for (int i = 0; i < 16; ++i) { s0[i] = 0.f; s1[i] = 0.f; }
#pragma unroll
      for (int ks = 0; ks < 4; ++ks) {
        const bf16x8 kf0 = *(const bf16x8*)&Ks[buf][qn][16 * ks + 8 * hh];
        const bf16x8 kf1 = *(const bf16x8*)&Ks[buf][32 + qn][16 * ks + 8 * hh];
        s0 = mfma32(kf0, qf[ks], s0);
        s1 = mfma32(kf1, qf[ks], s1);
      }
      if (!ctxk) { edge_mask(s0, kbase); edge_mask(s1, kbase + 32); }
      new_max(fmaxf(max16(s0), max16(s1)));
      float ps = exp16(s0) + exp16(s1);
      ps += __shfl_xor(ps, 32);
      l_run += ps;
      pv_acc(buf, 0, s0);
      pv_acc(buf, 1, s1);
    } else if (n0 || n1) {
      const int sub = n0 ? 0 : 1;
      f32x16 sv;
#pragma unroll
      for (int i = 0; i < 16; ++i) sv[i] = 0.f;
#pragma unroll
      for (int ks = 0; ks < 4; ++ks) {
        const bf16x8 kf = *(const bf16x8*)&Ks[buf][sub * 32 + qn][16 * ks + 8 * hh];
        sv = mfma32(kf, qf[ks], sv);
      }
      if (!ctxk) edge_mask(sv, kbase + sub * 32);
      new_max(max16(sv));
      float ps = exp16(sv);
      ps += __shfl_xor(ps, 32);
      l_run += ps;
      pv_acc(buf, sub, sv);
    }
  };
  uint4 ak0, ak1, av0, av1, bk0, bk1, bv0, bv1;
  ldtile(0, ak0, ak1, av0, av1);
  ldtile(1, bk0, bk1, bv0, bv1);
  __syncthreads();
#pragma unroll 1
  for (int kt = 0; kt < ntiles; kt += 2) {
    sttile(0, ak0, ak1, av0, av1);
    lds_barrier();
    ldtile(min(kt + 2, ntiles - 1), ak0, ak1, av0, av1);
    compute(kt);
    sttile(1, bk0, bk1, bv0, bv1);
    lds_barrier();
    ldtile(min(kt + 3, ntiles - 1), bk0, bk1, bv0, bv1);
    compute(kt + 1);
  }
  __syncthreads();
  const float inv = 1.f / l_run;
  bf16_t* optr = p.Y + qrow * D + 512 + hq * 64;
#pragma unroll
  for (int rg = 0; rg < 4; ++rg) {
    int d0 = 8 * rg + 4 * hh;
    *(uint2*)(optr + d0) = make_uint2(pack2(o0[4 * rg] * inv, o0[4 * rg + 1] * inv), pack2(o0[4 * rg + 2] * inv, o0[4 * rg + 3] * inv));
    *(uint2*)(optr + 32 + d0) = make_uint2(pack2(o1[4 * rg] * inv, o1[4 * rg + 1] * inv), pack2(o1[4 * rg + 2] * inv, o1[4 * rg + 3] * inv));
  }
}

DEV void ph_attn_post(const P& p, int layer) {
  const int lane = tid_() & 63;
  int r0, r1;
  wave_range(r0, r1, NTOK);
  float gv[8];
#pragma unroll
  for (int i = 0; i < 8; ++i) gv[i] = p.at_out_g[layer * 512 + 8 * lane + i];
  uint4 nx = make_uint4(0, 0, 0, 0);
  if (r0 < r1) nx = *(const uint4*)(p.Y + (size_t)r0 * D + 512 + 8 * lane);
#pragma unroll 1
  for (int row = r0; row < r1; ++row) {
    const uint4 u = nx;
    if (row + 1 < r1) nx = *(const uint4*)(p.Y + (size_t)(row + 1) * D + 512 + 8 * lane);
    float v[8];
    unpack8(u, v);
    float ss = 0.f;
#pragma unroll
    for (int i = 0; i < 8; ++i) ss += v[i] * v[i];
    ss = wave_sum(ss);
    const float rstd = rsqrtf(ss * (1.f / 512.f) + 1e-6f);
#pragma unroll
    for (int i = 0; i < 8; ++i) {
      v[i] = v[i] * rstd * gv[i];
    }
    *(uint4*)(p.Y + (size_t)row * D + 512 + 8 * lane) = pack8(v);
  }
}

struct Epi2 {
  const P& p; int layer, row0, col0;
  DEV void operator()(f32x4 (&acc)[4][4], int wr, int wc, int fr, int fq, char* smem) const {
    const int b = row0 / LT, pp = row0 % LT;
    const int mr = pp < LC ? 16 : b;
    const float* g1 = p.modv + ((size_t)layer * 17 + mr) * 6144 + 2048 + col0 + wc * 64;
#pragma unroll
    for (int n = 0; n < 4; ++n) {
      const float4 gv = *(const float4*)(g1 + n * 16 + 4 * fq);
#pragma unroll
      for (int m = 0; m < 4; ++m) { acc[m][n][0] *= gv.x; acc[m][n][1] *= gv.y; acc[m][n][2] *= gv.z; acc[m][n][3] *= gv.w; }
    }
    const int wid = wr * 2 + wc, lane = fq * 16 + fr;
    stage_tile_bf16(acc, smem, wid, fr, fq);
    const bf16_t (*t)[72] = (const bf16_t (*)[72])(smem + wid * 9216);
#pragma unroll
    for (int i = 0; i < 8; ++i) {
      const int rl = i * 8 + (lane >> 3), ch = lane & 7;
      bf16_t* xp = p.X + (size_t)(row0 + wr * 64 + rl) * D + col0 + wc * 64 + ch * 8;
      float xv[8], dv[8];
      uint4 xu = *(const uint4*)xp, du = *(const uint4*)&t[rl][ch * 8];
      unpack8(xu, xv); unpack8(du, dv);
#pragma unroll
      for (int q = 0; q < 8; ++q) xv[q] += dv[q];
      *(uint4*)xp = pack8(xv);
    }
  }
};
DEV void ph_gemm2(const P& p, int layer, char* smem) {
  int rt, ct;
  for (int it = 0; gemm_unit(it, 8, rt, ct); ++it) {
    Epi2 epi{p, layer, rt * 128, ct * 128};
    gemm_tile(p.Y + (size_t)rt * 128 * D, D, p.W2t + (size_t)ct * 128 * D, D, D, smem, epi);
  }
}

DEV void ph_peerconv(const P& p, int layer) {
  const int gw = (bid_() * 256 + tid_()) >> 6, nw = gridDim.x * 4, lane = tid_() & 63;
  const float* su = opq(p.peer_u) + (size_t)layer * 16384 * 1024;
  const float* sv = opq(p.peer_v) + (size_t)layer * 16384 * 1024;
  unsigned char* pu = opq(p.PU); unsigned char* pv = opq(p.PV);
  float* psu = opq(p.PSU); float* psv = opq(p.PSV);
  auto ldrow = [&](int r, float4& a0, float4& a1, float4& a2, float4& a3) {
    const float* src = ((r >= 16384) ? sv : su) + (size_t)(r & 16383) * 1024 + 16 * lane;
    a0 = *(const float4*)src; a1 = *(const float4*)(src + 4); a2 = *(const float4*)(src + 8); a3 = *(const float4*)(src + 12);
  };
  float4 n0 = make_float4(0, 0, 0, 0), n1 = n0, n2 = n0, n3 = n0;
  if (gw < 32768) ldrow(gw, n0, n1, n2, n3);
#pragma unroll 1
  for (int r = gw; r < 32768; r += nw) {
    const bool isv = r >= 16384;
    const int e = r & 16383;
    const float4 f0 = n0, f1 = n1, f2 = n2, f3 = n3;
    if (r + nw < 32768) ldrow(r + nw, n0, n1, n2, n3);
    float am = fmaxf(fmaxf(fmaxf(fabsf(f0.x), fabsf(f0.y)), fmaxf(fabsf(f0.z), fabsf(f0.w))), fmaxf(fmaxf(fabsf(f1.x), fabsf(f1.y)), fmaxf(fabsf(f1.z), fabsf(f1.w))));
    am = fmaxf(am, fmaxf(fmaxf(fmaxf(fabsf(f2.x), fabsf(f2.y)), fmaxf(fabsf(f2.z), fabsf(f2.w))), fmaxf(fmaxf(fabsf(f3.x), fabsf(f3.y)), fmaxf(fabsf(f3.z), fabsf(f3.w)))));
    am = wave_max(am);
    int w0, w1, w2, w3;
    float inv;
    if (isv) {
      const float sc = am > 0.f ? 224.f / am : 1.f;
      inv = am > 0.f ? am * (1.f / 224.f) : 1.f;
      w0 = __builtin_amdgcn_cvt_pk_fp8_f32(f0.x * sc, f0.y * sc, 0, false); w0 = __builtin_amdgcn_cvt_pk_fp8_f32(f0.z * sc, f0.w * sc, w0, true);
      w1 = __builtin_amdgcn_cvt_pk_fp8_f32(f1.x * sc, f1.y * sc, 0, false); w1 = __builtin_amdgcn_cvt_pk_fp8_f32(f1.z * sc, f1.w * sc, w1, true);
      w2 = __builtin_amdgcn_cvt_pk_fp8_f32(f2.x * sc, f2.y * sc, 0, false); w2 = __builtin_amdgcn_cvt_pk_fp8_f32(f2.z * sc, f2.w * sc, w2, true);
      w3 = __builtin_amdgcn_cvt_pk_fp8_f32(f3.x * sc, f3.y * sc, 0, false); w3 = __builtin_amdgcn_cvt_pk_fp8_f32(f3.z * sc, f3.w * sc, w3, true);
    } else {
      const float sc = am > 0.f ? 127.f / am : 1.f;
      inv = am > 0.f ? am * (1.f / 127.f) : 1.f;
      w0 = pack_i8(f0.x * sc, f0.y * sc, f0.z * sc, f0.w * sc); w1 = pack_i8(f1.x * sc, f1.y * sc, f1.z * sc, f1.w * sc);
      w2 = pack_i8(f2.x * sc, f2.y * sc, f2.z * sc, f2.w * sc); w3 = pack_i8(f3.x * sc, f3.y * sc, f3.z * sc, f3.w * sc);
    }
    *(uint4*)((isv ? pv : pu) + (size_t)(lane >> 3) * PSLICE + (size_t)e * 128 + 16 * (lane & 7)) = make_uint4((unsigned)w0, (unsigned)w1, (unsigned)w2, (unsigned)w3);
    if (lane == 0) (isv ? psv : psu)[e] = inv;
  }
}
DEV void unpack16_fp8x2(const uint4& u, f32x2* f) {
  f[0] = __builtin_amdgcn_cvt_pk_f32_fp8((int)u.x, false); f[1] = __builtin_amdgcn_cvt_pk_f32_fp8((int)u.x, true);
  f[2] = __builtin_amdgcn_cvt_pk_f32_fp8((int)u.y, false); f[3] = __builtin_amdgcn_cvt_pk_f32_fp8((int)u.y, true);
  f[4] = __builtin_amdgcn_cvt_pk_f32_fp8((int)u.z, false); f[5] = __builtin_amdgcn_cvt_pk_f32_fp8((int)u.z, true);
  f[6] = __builtin_amdgcn_cvt_pk_f32_fp8((int)u.w, false); f[7] = __builtin_amdgcn_cvt_pk_f32_fp8((int)u.w, true);
}

DEV void bitonic_sort16_desc(float (&v)[16]) {
#pragma unroll
  for (int k = 2; k <= 16; k <<= 1)
#pragma unroll
    for (int j = k >> 1; j >= 1; j >>= 1)
#pragma unroll
      for (int i = 0; i < 16; ++i) {
        const int l = i ^ j;
        if (l > i) {
          const float hi = fmaxf(v[i], v[l]), lo = fminf(v[i], v[l]);
          if ((i & k) == 0) { v[i] = hi; v[l] = lo; } else { v[i] = lo; v[l] = hi; }
        }
      }
}
DEV void peer_cand_ij(int c, int& ci, int& cj) {
  if (c < 16) { ci = 0; cj = c; } else if (c < 24) { ci = 1; cj = c - 16; } else if (c < 29) { ci = 2; cj = c - 24; }
  else if (c < 33) { ci = 3; cj = c - 29; } else if (c < 36) { ci = 4; cj = c - 33; } else if (c < 38) { ci = 5; cj = c - 36; }
  else if (c < 40) { ci = 6; cj = c - 38; } else if (c < 42) { ci = 7; cj = c - 40; } else { ci = (c - 42 + 8) & 15; cj = 0; }
}
DEV void ce_desc(float& a, float& b) { const float hi = fmaxf(a, b), lo = fminf(a, b); a = hi; b = lo; }
DEV void bitonic_merge16_desc(float (&v)[16]) {
#pragma unroll
  for (int d = 8; d >= 1; d >>= 1)
#pragma unroll
    for (int i = 0; i < 16; ++i)
      if ((i & d) == 0) ce_desc(v[i], v[i + d]);
}
template <int N>
DEV void merge_trunc16(float (&T)[16], const float (&B)[N]) {
#pragma unroll
  for (int k = 0; k < N; ++k) T[15 - k] = fmaxf(T[15 - k], B[k]);
  bitonic_merge16_desc(T);
}
DEV float pk_sum(float a, float b, int i, int j) {
  return __uint_as_float((__float_as_uint(a + b) & ~255u) | (unsigned)(255 - (i * 16 + j)));
}
template <int S>
struct Epi3K {
  const P& p; int row0, head; float (&keep)[2][16];
  DEV void operator()(f32x4 (&acc)[4][4], int wr, int wc, int fr, int fq, char* smem) const {
    float* sc = (float*)smem;
    float* L1s = (float*)(smem + 36864);
    float* L2s = (float*)(smem + 47104);
    const int tid = tid_();
#pragma unroll
    for (int pass = 0; pass < 2; ++pass) {
      __syncthreads();
      if (wr == pass) {
#pragma unroll
        for (int m = 0; m < 4; ++m)
#pragma unroll
          for (int n = 0; n < 4; ++n)
#pragma unroll
            for (int j = 0; j < 4; ++j) {
              int rl = m * 16 + fr, col = wc * 64 + n * 16 + 4 * fq + j;
              unsigned bits = (__float_as_uint(acc[m][n][j]) & ~127u) | (unsigned)col;
              sc[rl * 133 + (col >> 5) * 33 + (col & 31)] = __uint_as_float(bits);
            }
      }
      __syncthreads();
      const int rl = tid >> 2, q = tid & 3;
      const float* src = sc + rl * 133 + q * 33;
      float Ls[16], Hs[16];
#pragma unroll
      for (int i = 0; i < 16; ++i) { Ls[i] = src[i]; Hs[i] = src[16 + i]; }
      bitonic_sort16_desc(Ls);
      bitonic_sort16_desc(Hs);
#pragma unroll
      for (int i = 0; i < 16; ++i) Ls[i] = fmaxf(Ls[i], Hs[15 - i]);
#pragma unroll
      for (int d = 8; d >= 1; d >>= 1)
#pragma unroll
        for (int i = 0; i < 16; ++i)
          if ((i & d) == 0) { float hi = fmaxf(Ls[i], Ls[i + d]), lo = fminf(Ls[i], Ls[i + d]); Ls[i] = hi; Ls[i + d] = lo; }
      float Cs[16];
#pragma unroll
      for (int i = 0; i < 16; ++i) Cs[i] = fmaxf(Ls[i], dppself<0xB1, 0xF>(Ls[15 - i]));
#pragma unroll
      for (int d = 8; d >= 1; d >>= 1)
#pragma unroll
        for (int i = 0; i < 16; ++i)
          if ((i & d) == 0) { float hi = fmaxf(Cs[i], Cs[i + d]), lo = fminf(Cs[i], Cs[i + d]); Cs[i] = hi; Cs[i + d] = lo; }
      float Ds[16];
#pragma unroll
      for (int i = 0; i < 16; ++i) Ds[i] = fmaxf(Cs[i], dppself<0x4E, 0xF>(Cs[15 - i]));
#pragma unroll
      for (int d = 8; d >= 1; d >>= 1)
#pragma unroll
        for (int i = 0; i < 16; ++i)
          if ((i & d) == 0) { float hi = fmaxf(Ds[i], Ds[i + d]), lo = fminf(Ds[i], Ds[i + d]); Ds[i] = hi; Ds[i + d] = lo; }
      if (S == 0) {
#pragma unroll
        for (int i = 0; i < 16; ++i) keep[pass][i] = Ds[i];
      } else if (q == 0) {
        float* d1 = L1s + (pass * 64 + rl) * 20;
        float* d2 = L2s + (pass * 64 + rl) * 20;
#pragma unroll
        for (int i = 0; i < 4; ++i) {
          *(float4*)(d1 + 4 * i) = make_float4(keep[pass][4 * i], keep[pass][4 * i + 1], keep[pass][4 * i + 2], keep[pass][4 * i + 3]);
          *(float4*)(d2 + 4 * i) = make_float4(Ds[4 * i], Ds[4 * i + 1], Ds[4 * i + 2], Ds[4 * i + 3]);
        }
      }
    }
    if (S == 1) {
      __syncthreads();
      if (tid < 128) {
        const int row = tid;
        float A[16], Bv[16];
        const float* l1 = L1s + row * 20;
        const float* l2 = L2s + row * 20;
#pragma unroll
        for (int i = 0; i < 4; ++i) {
          const float4 x = *(const float4*)(l1 + 4 * i), y = *(const float4*)(l2 + 4 * i);
          A[4 * i] = x.x; A[4 * i + 1] = x.y; A[4 * i + 2] = x.z; A[4 * i + 3] = x.w;
          Bv[4 * i] = y.x; Bv[4 * i + 1] = y.y; Bv[4 * i + 2] = y.z; Bv[4 * i + 3] = y.w;
        }
        float T[16];
#pragma unroll
        for (int j = 0; j < 16; ++j) T[j] = pk_sum(A[0], Bv[j], 0, j);
        {
          float C0[15];
#pragma unroll
          for (int i = 1; i < 16; ++i) C0[i - 1] = pk_sum(A[i], Bv[0], i, 0);
          merge_trunc16(T, C0);
        }
        {
          float R1[7];
#pragma unroll
          for (int j = 1; j < 8; ++j) R1[j - 1] = pk_sum(A[1], Bv[j], 1, j);
          merge_trunc16(T, R1);
        }
        {
          float C1[6];
#pragma unroll
          for (int i = 2; i < 8; ++i) C1[i - 2] = pk_sum(A[i], Bv[1], i, 1);
          merge_trunc16(T, C1);
        }
        {
          float R2[3];
#pragma unroll
          for (int j = 2; j < 5; ++j) R2[j - 2] = pk_sum(A[2], Bv[j], 2, j);
          merge_trunc16(T, R2);
        }
        {
          float C2[2] = {pk_sum(A[3], Bv[2], 3, 2), pk_sum(A[4], Bv[2], 4, 2)};
          merge_trunc16(T, C2);
        }
        {
          float X3[1] = {pk_sum(A[3], Bv[3], 3, 3)};
          merge_trunc16(T, X3);
        }
        const float mx = T[0];
        float ex[16], sm = 0.f;
        unsigned ee[16];
#pragma unroll
        for (int k = 0; k < 16; ++k) {
          const unsigned tg = 255u - (__float_as_uint(T[k]) & 255u);
          const unsigned k1 = __float_as_uint(l1[tg >> 4]) & 127u, k2 = __float_as_uint(l2[tg & 15u]) & 127u;
          ee[k] = k1 * 128u + k2;
          ex[k] = __expf(T[k] - mx);
          sm += ex[k];
        }
        const float rs = 1.f / sm;
        const size_t o = (size_t)(row0 + row) * 128 + head * 16;
        uint4* elp = (uint4*)(p.EL + o);
        elp[0] = make_uint4(ee[0] | (ee[1] << 16), ee[2] | (ee[3] << 16), ee[4] | (ee[5] << 16), ee[6] | (ee[7] << 16));
        elp[1] = make_uint4(ee[8] | (ee[9] << 16), ee[10] | (ee[11] << 16), ee[12] | (ee[13] << 16), ee[14] | (ee[15] << 16));
        float4* gtp = (float4*)(p.GT + o);
#pragma unroll
        for (int i = 0; i < 4; ++i) gtp[i] = make_float4(ex[4 * i] * rs, ex[4 * i + 1] * rs, ex[4 * i + 2] * rs, ex[4 * i + 3] * rs);
      }
    }
  }
};
DEV void ph_gemm3(const P& p, char* smem) {
  int rt, hd;
  for (int it = 0; gemm_unit(it, 8, rt, hd); ++it) {
    float keep[2][16];
    {
      Epi3K<0> epi{p, rt * 128, hd, keep};
      gemm_tile(p.H + (size_t)rt * 128 * D, D, p.Wft + (size_t)(2 * hd) * 128 * D, D, D, smem, epi);
    }
    {
      Epi3K<1> epi{p, rt * 128, hd, keep};
      gemm_tile(p.H + (size_t)rt * 128 * D, D, p.Wft + (size_t)(2 * hd + 1) * 128 * D, D, D, smem, epi);
    }
  }
}

DEV float peer_gate(float scr) {
  float mx = row16_max(scr);
  float ex = __expf(scr - mx);
  float sm = row16_sum(ex);
  return ex / sm;
}
DEV float gelu_exact(float x) { return 0.5f * x * (1.f + erff(x * 0.7071067811865476f)); }

struct PeerPre { uint4 e0, e1, a0, a1; };
DEV unsigned peer_eid(const PeerPre& s, int j) {
  const unsigned w = (j < 8) ? ((j >> 1) == 0 ? s.e0.x : (j >> 1) == 1 ? s.e0.y : (j >> 1) == 2 ? s.e0.z : s.e0.w)
                             : (((j - 8) >> 1) == 0 ? s.e1.x : ((j - 8) >> 1) == 1 ? s.e1.y : ((j - 8) >> 1) == 2 ? s.e1.z : s.e1.w);
  return (j & 1) ? (w >> 16) : (w & 0xFFFFu);
}
template <int WHICH>
DEV void peer_wave_run(const P& p, int layer, int x, int tok0, int lane, float* wbuf) {
  const int r = lane >> 3, c = lane & 7;
  const unsigned char* tb = (WHICH == 0 ? p.PU : p.PV) + (size_t)x * PSLICE + c * 16;
  PeerPre S[3];
  uint4 R[16];
  auto ld_pre = [&](int tok, PeerPre& s) {
    const uint4* elp = (const uint4*)(p.EL + (size_t)tok * 128 + r * 16);
    s.e0 = elp[0]; s.e1 = elp[1];
    if (WHICH == 0) {
      s.a0 = *(const uint4*)(p.H8 + (size_t)tok * 1024 + x * 128 + c * 16);
    } else {
      const uint4* wtp = (const uint4*)(p.GW + (size_t)tok * 128 + r * 16);
      s.a0 = wtp[0]; s.a1 = wtp[1];
    }
  };
  auto comp = [&](int tok, const PeerPre& s, const PeerPre& sn, bool more) {
    if (WHICH == 0) {
      int keep0 = 0, keep1 = 0;
#pragma unroll
      for (int j = 0; j < 16; ++j) {
        const uint4 rw = R[j];
        if (more) R[j] = *(const uint4*)(tb + (size_t)peer_eid(sn, j) * 128);
        int d = __builtin_amdgcn_sdot4((int)rw.x, (int)s.a0.x, 0, false);
        d = __builtin_amdgcn_sdot4((int)rw.y, (int)s.a0.y, d, false);
        d = __builtin_amdgcn_sdot4((int)rw.z, (int)s.a0.z, d, false);
        d = __builtin_amdgcn_sdot4((int)rw.w, (int)s.a0.w, d, false);
        d += __builtin_amdgcn_update_dpp(0, d, 0xB1, 0xF, 0xF, false);
        d += __builtin_amdgcn_update_dpp(0, d, 0x4E, 0xF, 0xF, false);
        d += __builtin_amdgcn_update_dpp(0, d, 0x141, 0xF, 0xF, false);
        if (j < 8) keep0 = (c == j) ? d : keep0; else keep1 = (c == j - 8) ? d : keep1;
      }
      bf16_t* pd = p.PD + ((size_t)x * NTOK + tok) * 128 + r * 16 + c;
      pd[0] = f2bf((float)keep0); pd[8] = f2bf((float)keep1);
    } else {
      float wsv[16];
      unpack8(s.a0, wsv); unpack8(s.a1, wsv + 8);
      f32x2 acc2[8];
#pragma unroll
      for (int i = 0; i < 8; ++i) acc2[i] = (f32x2){0.f, 0.f};
#pragma unroll
      for (int j = 0; j < 16; ++j) {
        f32x2 f[8];
        unpack16_fp8x2(R[j], f);
        if (more) R[j] = *(const uint4*)(tb + (size_t)peer_eid(sn, j) * 128);
        const f32x2 w2 = (f32x2){wsv[j], wsv[j]};
#pragma unroll
        for (int i = 0; i < 8; ++i) acc2[i] += w2 * f[i];
      }
      float* slab = wbuf + (r * 8 + c) * 16;
      *(float4*)(slab) = make_float4(acc2[0][0], acc2[0][1], acc2[1][0], acc2[1][1]);
      *(float4*)(slab + 4) = make_float4(acc2[2][0], acc2[2][1], acc2[3][0], acc2[3][1]);
      *(float4*)(slab + 8) = make_float4(acc2[4][0], acc2[4][1], acc2[5][0], acc2[5][1]);
      *(float4*)(slab + 12) = make_float4(acc2[6][0], acc2[6][1], acc2[7][0], acc2[7][1]);
      asm volatile("s_waitcnt lgkmcnt(0)" ::: "memory");
      float o0 = 0.f, o1 = 0.f;
#pragma unroll
      for (int rr = 0; rr < 8; ++rr) {
        const float2 t = *(const float2*)(wbuf + (rr * 8 + (lane >> 3)) * 16 + 2 * (lane & 7));
        o0 += t.x; o1 += t.y;
      }
      asm volatile("s_waitcnt lgkmcnt(0)" ::: "memory");
      const int b = tok / LT, pp = tok % LT;
      const int mr = pp < LC ? 16 : b;
      const int col = x * 128 + 2 * lane;
      const float* g2 = p.modv + ((size_t)layer * 17 + mr) * 6144 + 5120 + col;
      unsigned* xp = (unsigned*)(p.X + (size_t)tok * D + col);
      const unsigned xu = *xp;
      *xp = pack2(bflo(xu) + g2[0] * o0, bfhi(xu) + g2[1] * o1);
    }
  };
  ld_pre(tok0, S[0]);
  ld_pre(tok0 + 1, S[1]);
#pragma unroll
  for (int j = 0; j < 16; ++j) R[j] = *(const uint4*)(tb + (size_t)peer_eid(S[0], j) * 128);
  ld_pre(tok0 + 2, S[2]);
#pragma unroll
  for (int t = 0; t < 8; ++t) {
    comp(tok0 + t, S[t % 3], S[(t + 1) % 3], t + 1 < 8);
    if (t + 3 < 8) ld_pre(tok0 + t + 3, S[t % 3]);
  }
}
DEV void ph_peer_w(const P& p) {
  for (size_t i8 = (size_t)bid_() * 256 + tid_(); i8 < (size_t)NTOK * 16; i8 += (size_t)gridDim.x * 256) {
    const size_t i = i8 * 8;
    float d[8];
#pragma unroll
    for (int q = 0; q < 8; ++q) d[q] = 0.f;
#pragma unroll
    for (int x = 0; x < 8; ++x) {
      const uint4 u = *(const uint4*)(p.PD + (size_t)x * NTOK * 128 + i);
      float f[8];
      unpack8(u, f);
#pragma unroll
      for (int q = 0; q < 8; ++q) d[q] += f[q];
    }
    const uint4 eu = *(const uint4*)(p.EL + i);
    const unsigned ew[4] = {eu.x, eu.y, eu.z, eu.w};
    const float hinv = p.HINV[i >> 7];
    float4 g0 = *(const float4*)(p.GT + i), g1 = *(const float4*)(p.GT + i + 4);
    float g[8] = {g0.x, g0.y, g0.z, g0.w, g1.x, g1.y, g1.z, g1.w};
#pragma unroll
    for (int q = 0; q < 8; ++q) {
      const unsigned e = (q & 1) ? (ew[q >> 1] >> 16) : (ew[q >> 1] & 0xFFFFu);
      g[q] = g[q] * gelu_exact(d[q] * p.PSU[e] * hinv) * p.PSV[e];
    }
    *(uint4*)(p.GW + i) = pack8(g);
  }
}
template <int WHICH>
DEV void ph_peer_gather(const P& p, int layer, char* smem, volatile LAS unsigned* slot) {
  const int tid = tid_(), lane = tid & 63, wid = tid >> 6;
  unsigned* q = p.wq + 1024 + layer * 256 + WHICH * 128;
  const int my = (int)(xb_xcc_id() & 7u);
  float* wbuf = (float*)smem + wid * 1024;
#pragma unroll 1
  for (int rot = 0; rot < 8; ++rot) {
    const int x = (my + rot) & 7;
    for (;;) {
      __syncthreads();
      if (tid == 0) *slot = atomicAdd(q + x * 16, 1u);
      __syncthreads();
      const int it = (int)*slot;
      if (it >= NTOK / 64) break;
      peer_wave_run<WHICH>(p, layer, x, it * 64 + wid * 16, lane, wbuf);
      peer_wave_run<WHICH>(p, layer, x, it * 64 + wid * 16 + 8, lane, wbuf);
    }
  }
}

DEV void ph_final(const P& p) {
  const int lane = tid_() & 63;
  int r0, r1;
  wave_range(r0, r1, NB * T);
  float gv[16];
#pragma unroll
  for (int hh = 0; hh < 2; ++hh)
#pragma unroll
    for (int i = 0; i < 8; ++i) gv[hh * 8 + i] = p.final_g[hh * 512 + 8 * lane + i];
  auto xrow = [&](int r) -> const bf16_t* { const int b = r / T, t = r % T; return p.X + ((size_t)b * LT + LC + t) * D; };
  uint4 n0 = make_uint4(0, 0, 0, 0), n1 = n0;
  if (r0 < r1) { const bf16_t* xr = xrow(r0); n0 = *(const uint4*)(xr + 8 * lane); n1 = *(const uint4*)(xr + 512 + 8 * lane); }
#pragma unroll 1
  for (int r = r0; r < r1; ++r) {
    const uint4 u0 = n0, u1 = n1;
    if (r + 1 < r1) { const bf16_t* xr = xrow(r + 1); n0 = *(const uint4*)(xr + 8 * lane); n1 = *(const uint4*)(xr + 512 + 8 * lane); }
    float v[16];
    unpack8(u0, v); unpack8(u1, v + 8);
    float ss = 0.f;
#pragma unroll
    for (int i = 0; i < 16; ++i) ss += v[i] * v[i];
    ss = wave_sum(ss);
    const float rstd = rsqrtf(ss * (1.f / 1024.f) + 1e-6f);
    float* o = p.out + (size_t)r * D;
#pragma unroll
    for (int hh = 0; hh < 2; ++hh) {
      const int col = hh * 512 + 8 * lane;
      *(float4*)(o + col) = make_float4(v[hh * 8 + 0] * rstd * gv[hh * 8 + 0], v[hh * 8 + 1] * rstd * gv[hh * 8 + 1], v[hh * 8 + 2] * rstd * gv[hh * 8 + 2], v[hh * 8 + 3] * rstd * gv[hh * 8 + 3]);
      *(float4*)(o + col + 4) = make_float4(v[hh * 8 + 4] * rstd * gv[hh * 8 + 4], v[hh * 8 + 5] * rstd * gv[hh * 8 + 5], v[hh * 8 + 6] * rstd * gv[hh * 8 + 6], v[hh * 8 + 7] * rstd * gv[hh * 8 + 7]);
    }
  }
}

DEV unsigned hw_cu_key() {
  const unsigned hwid = (unsigned)__builtin_amdgcn_s_getreg(((8 - 1) << 11) | (8 << 6) | 4);
  return (xb_xcc_id() << 8) | (hwid & 0xFFu);
}
DEV void mixB(const P& p, int layer, char* smem, volatile LAS unsigned* slot) {
  unsigned* qa = p.wq + layer * 64;
  unsigned* qs = qa + 16;
  unsigned* claim = p.cuclaim + layer * 4096;
  __syncthreads();
  if (tid_() == 0) {
    unsigned u = 0xFFFFFFFFu;
    if (atomicAdd(&claim[hw_cu_key() & 4095u], 1u) == 0u) u = atomicAdd(qs, 1u);
    *slot = u;
  }
  __syncthreads();
  {
    const unsigned u = *slot;
    if (u < 128u) scanc_unit(p, layer, (int)u, smem);
  }
  for (;;) {
    __syncthreads();
    if (tid_() == 0) *slot = atomicAdd(qa, 1u);
    __syncthreads();
    const int u = (int)*slot;
    if (u >= 8704) break;
    if (u < 4352) attn_unit(p, layer, u, smem); else hyena_conv_unit(p, layer, u - 4352, smem);
  }
  if (layer + 1 < DEPTH) {
    unsigned* qp = qa + 32;
    for (;;) {
      __syncthreads();
      if (tid_() == 0) *slot = atomicAdd(qp, 1u);
      __syncthreads();
      const int u = (int)*slot;
      if (u >= PREPA_N) break;
      prep_unit(p, layer + 1, prepA_unit_index(u), smem);
    }
  }
  for (;;) {
    __syncthreads();
    if (tid_() == 0) *slot = atomicAdd(qs, 1u);
    __syncthreads();
    const unsigned u = *slot;
    if (u >= 128u) break;
    scanc_unit(p, layer, (int)u, smem);
  }
}
DEV void mixA(const P& p, int layer, char* smem) {
  for (int u = bid_(); u < 1088; u += gridDim.x) hyena_pre_unit(p, layer, u);
  for (int u = bid_(); u < 512; u += gridDim.x) hyena_scale_unit(p, layer, u, smem);
  ph_lora(p, layer, smem);
  ph_rwkv_prep(p, layer);
}
DEV void mixC(const P& p, int layer, char* smem) {
  for (int u = bid_(); u < 1088; u += gridDim.x) hyena_post_unit(p, layer, u, smem);
  ph_rwkv_post(p, layer);
  ph_attn_post(p, layer);
}

__global__ void __launch_bounds__(256, 2) k_mega(P p) {
  extern __shared__ __attribute__((aligned(16))) char smem_all[];
  char* smem = smem_all;
  volatile LAS unsigned* xbw = (volatile LAS unsigned*)(smem_all + SMEM_BYTES);
  if (threadIdx.x == 0) { xbw[0] = 0u; xbw[1] = 0u; xbw[2] = 0u; xbw[3] = 0u; }
  __syncthreads();
  XcdBarrier bar = xcd_barrier_post(p.bar, xbw);
  ph_rope(p);
  for (int u = blockIdx.x; u < 96; u += gridDim.x) modv_unit(p, u, smem);
  ph_prep(p, 0, smem, false);
  xcd_barrier(bar);
  for (int layer = 0; layer < DEPTH; ++layer) {
    if (layer == 0) ph_norm_first(p); else ph_norm(p, layer, 0);
    xcd_barrier(bar);
    ph_gemm1(p, smem);
    xcd_barrier(bar);
    mixA(p, layer, smem);
    xcd_barrier(bar);
    mixB(p, layer, smem, (volatile LAS unsigned*)(smem_all + SMEM_BYTES + 16));
    xcd_barrier(bar);
    mixC(p, layer, smem);
    xcd_barrier(bar);
    ph_gemm2(p, layer, smem);
    ph_peerconv(p, layer);
    xcd_barrier(bar);
    ph_norm(p, layer, 1);
    xcd_barrier(bar);
    ph_gemm3(p, smem);
    xcd_barrier(bar);
    ph_peer_gather<0>(p, layer, smem, (volatile LAS unsigned*)(smem_all + SMEM_BYTES + 16));
    xcd_barrier(bar);
    ph_peer_w(p);
    xcd_barrier(bar);
    ph_peer_gather<1>(p, layer, smem, (volatile LAS unsigned*)(smem_all + SMEM_BYTES + 16));
    if (layer + 1 < DEPTH) ph_prep(p, layer + 1, smem, true);
    xcd_barrier(bar);
  }
  ph_final(p);
}

static inline size_t al256(size_t x) { return (x + 255) & ~(size_t)255; }

extern "C" void kernel_launch(void* const* d_in, const int* in_sizes, int n_in, void* d_out, int out_size, void* d_ws, size_t ws_size,
                              hipStream_t stream) {
  (void)in_sizes; (void)n_in; (void)out_size; (void)ws_size;
  P p{};
  const float** f = (const float**)&p;
  for (int i = 0; i < 39; ++i) f[i] = (const float*)d_in[i];
  p.out = (float*)d_out;
  char* w = (char*)d_ws;
  size_t off = 0;
  auto take = [&](size_t bytes) { char* r = w + off; off += al256(bytes); return r; };
  p.bar = (unsigned*)take(16384);
  p.modv = (float*)take((size_t)DEPTH * 17 * 6144 * 4);
  p.SSQ = (float*)take((size_t)DEPTH * 2 * 256 * 4);
  p.wq = (unsigned*)take(4096 + DEPTH * 1024);
  p.cuclaim = (unsigned*)take((size_t)DEPTH * 4096 * 4);
  const size_t zero_bytes = off;
  p.rope = (float*)take(64 * 16 * 2 * 4);
  p.X = (bf16_t*)take((size_t)NTOK * D * 2);
  p.H = (bf16_t*)take((size_t)NTOK * D * 2);
  p.Y = (bf16_t*)take((size_t)NTOK * D * 2);
  p.SC = (bf16_t*)take((size_t)NTOK * 1024 * 2);
  p.Z = (bf16_t*)take((size_t)NTOK * INW * 2);
  p.UTl = (bf16_t*)take((size_t)256 * 16 * T * 2);
  p.UTc = (bf16_t*)take((size_t)256 * 16 * LC * 2);
  p.YTl = (bf16_t*)take((size_t)256 * 16 * T * 2);
  p.YTc = (bf16_t*)take((size_t)256 * 16 * LC * 2);
  p.FL = (float*)take((size_t)256 * 2 * T * 4);
  p.FC = (float*)take((size_t)256 * 2 * LC * 4);
  p.W1t = (bf16_t*)take((size_t)INW * D * 2);
  p.W2t = (bf16_t*)take((size_t)D * D * 2);
  p.Wft = (bf16_t*)take((size_t)2048 * D * 2);
  p.Wlt = (bf16_t*)take((size_t)1024 * 256 * 2);
  p.Wgt = (bf16_t*)take((size_t)256 * 128 * 2);
  p.TK = (float*)p.Z;
  p.PU = (unsigned char*)p.Z + al256((size_t)NTOK * 256 * 4);
  p.PV = p.PU + (size_t)16384 * 1024;
  p.PSU = (float*)(p.PV + (size_t)16384 * 1024);
  p.PSV = p.PSU + 16384;
  p.GT = p.PSV + 16384;
  p.EL = (unsigned short*)(p.GT + (size_t)NTOK * 128);
  p.H8 = (unsigned char*)p.EL + al256((size_t)NTOK * 128 * 2);
  p.HINV = (float*)(p.H8 + (size_t)NTOK * 1024);
  p.GW = (bf16_t*)((char*)p.HINV + al256((size_t)NTOK * 4));
  p.PD = p.Y;

  (void)hipMemsetAsync(d_ws, 0, zero_bytes, stream);
  constexpr size_t kDynLds = SMEM_BYTES + 32;
  static int grid = 0;
  if (!grid) {
    int dev = 0, cus = 0, per_cu = 0;
    (void)hipGetDevice(&dev);
    (void)hipDeviceGetAttribute(&cus, hipDeviceAttributeMultiprocessorCount, dev);
    (void)hipFuncSetAttribute((const void*)k_mega, hipFuncAttributeMaxDynamicSharedMemorySize, (int)kDynLds);
    (void)hipOccupancyMaxActiveBlocksPerMultiprocessor(&per_cu, k_mega, 256, kDynLds);
    if (cus <= 0) cus = 256;
    if (per_cu > 2) per_cu = 2;
    if (per_cu < 1) per_cu = 1;
    grid = cus * per_cu;
  }
  k_mega<<<grid, 256, kDynLds, stream>>>(p);
}
```

```cpp
#include <hip/hip_runtime.h>
#include <stdint.h>
#include <type_traits>

#define DEV __device__ __forceinline__
typedef unsigned short bf16_t;
typedef short bf16x8 __attribute__((ext_vector_type(8)));
typedef float f32x2 __attribute__((ext_vector_type(2)));
constexpr size_t PSLICE = (size_t)16384 * 128;
typedef float f32x4 __attribute__((ext_vector_type(4)));
typedef float f32x16 __attribute__((ext_vector_type(16)));


constexpr int NB = 16, T = 4096, LC = 256, LT = 4352, D = 1024, NTOK = NB * LT, INW = 2688, DEPTH = 4;
constexpr int SMEM_BYTES = 65536;

struct P {
  const float *x, *c, *ctx, *c_ctx, *mod_w, *mod_b, *norm1_g, *norm2_g, *w_in, *conv_w, *conv_b;
  const float *hy_w1, *hy_b1, *hy_w2, *hy_b2, *hy_w3, *hy_b3, *hy_freq, *hy_bias;
  const float *rw_w0, *rw_w_up, *rw_a0, *rw_a_up, *rw_g_up, *rw_k_k, *rw_k_a, *rw_r_k, *rw_ln_w, *rw_ln_b;
  const float *attn_sink, *hy_out_g, *at_out_g, *w_out, *peer_wq, *peer_k1, *peer_k2, *peer_u, *peer_v, *final_g;
  float* out;
  unsigned* bar;
  float *modv, *SSQ, *rope, *FL, *FC, *TK;
  unsigned *wq, *cuclaim;
  bf16_t *X, *H, *Y, *SC, *Z, *UTl, *UTc, *YTl, *YTc;
  bf16_t *W1t, *W2t, *Wft, *Wlt, *Wgt;
  unsigned char *PU, *PV;
  float *PSU, *PSV, *GT, *HINV;
  bf16_t *PD, *GW;
  unsigned short* EL;
  unsigned char* H8;
};

typedef __bf16 hwbf2 __attribute__((ext_vector_type(2)));
DEV unsigned pack2(float a, float b) { f32x2 f = {a, b}; hwbf2 r = __builtin_convertvector(f, hwbf2); return __builtin_bit_cast(unsigned, r); }
DEV bf16_t f2bf(float f) { return (bf16_t)(pack2(f, 0.f) & 0xFFFFu); }
DEV float bf2f(bf16_t h) { return __uint_as_float(((unsigned)h) << 16); }
DEV float bflo(unsigned u) { return __uint_as_float(u << 16); }
DEV float bfhi(unsigned u) { return __uint_as_float(u & 0xFFFF0000u); }
DEV void unpack8(const uint4& u, float* v) {
  v[0] = bflo(u.x); v[1] = bfhi(u.x); v[2] = bflo(u.y); v[3] = bfhi(u.y);
  v[4] = bflo(u.z); v[5] = bfhi(u.z); v[6] = bflo(u.w); v[7] = bfhi(u.w);
}
DEV uint4 pack8(const float* v) { return make_uint4(pack2(v[0], v[1]), pack2(v[2], v[3]), pack2(v[4], v[5]), pack2(v[6], v[7])); }
DEV int pack_i8(float a, float b, float c, float d) {
  const int ia = __float2int_rn(a), ib = __float2int_rn(b), ic = __float2int_rn(c), id = __float2int_rn(d);
  return (ia & 0xFF) | ((ib & 0xFF) << 8) | ((ic & 0xFF) << 16) | ((id & 0xFF) << 24);
}
DEV float sigmoidf_(float x) { return __builtin_amdgcn_rcpf(1.f + __expf(-x)); }

template <int CTRL, int ROWMASK>
DEV float dpp0(float x) {
  return __builtin_bit_cast(float, __builtin_amdgcn_update_dpp(0, __builtin_bit_cast(int, x), CTRL, ROWMASK, 0xF, false));
}
template <int CTRL, int ROWMASK>
DEV float dppself(float x) {
  int xi = __builtin_bit_cast(int, x);
  return __builtin_bit_cast(float, __builtin_amdgcn_update_dpp(xi, xi, CTRL, ROWMASK, 0xF, false));
}
DEV float readlane_f(float x, int l) { return __builtin_bit_cast(float, __builtin_amdgcn_readlane(__builtin_bit_cast(int, x), l)); }
DEV int lane_id() { return (int)__builtin_amdgcn_mbcnt_hi(~0u, __builtin_amdgcn_mbcnt_lo(~0u, 0u)); }
DEV float writelane_f(float val, int l, float old) { return lane_id() == l ? val : old; }
DEV int writelane_i(int val, int l, int old) { return lane_id() == l ? val : old; }
DEV float wave_sum(float x) {
  x += dpp0<0x111, 0xF>(x); x += dpp0<0x112, 0xF>(x); x += dpp0<0x114, 0xF>(x); x += dpp0<0x118, 0xF>(x);
  x += dpp0<0x142, 0xA>(x); x += dpp0<0x143, 0xC>(x);
  return readlane_f(x, 63);
}
DEV float wave_max(float x) {
  x = fmaxf(x, dppself<0x111, 0xF>(x)); x = fmaxf(x, dppself<0x112, 0xF>(x)); x = fmaxf(x, dppself<0x114, 0xF>(x));
  x = fmaxf(x, dppself<0x118, 0xF>(x)); x = fmaxf(x, dppself<0x142, 0xA>(x)); x = fmaxf(x, dppself<0x143, 0xC>(x));
  return readlane_f(x, 63);
}
DEV float row16_sum(float x) {
  x += dpp0<0xB1, 0xF>(x); x += dpp0<0x4E, 0xF>(x); x += dpp0<0x141, 0xF>(x); x += dpp0<0x140, 0xF>(x);
  return x;
}
DEV float row16_max(float x) {
  x = fmaxf(x, dppself<0xB1, 0xF>(x)); x = fmaxf(x, dppself<0x4E, 0xF>(x)); x = fmaxf(x, dppself<0x141, 0xF>(x));
  x = fmaxf(x, dppself<0x140, 0xF>(x));
  return x;
}
DEV float quad_sum(float x) { x += dpp0<0xB1, 0xF>(x); x += dpp0<0x4E, 0xF>(x); return x; }

DEV f32x4 mfma16(bf16x8 a, bf16x8 b, f32x4 c) { return __builtin_amdgcn_mfma_f32_16x16x32_bf16(a, b, c, 0, 0, 0); }
DEV f32x16 mfma32(bf16x8 a, bf16x8 b, f32x16 c) { return __builtin_amdgcn_mfma_f32_32x32x16_bf16(a, b, c, 0, 0, 0); }


#define XB_TMO      128
#define XB_XCNT(j)  (256  + 64 * (j))
#define XB_XSUB(j)  (1280 + 64 * (j))
#define XB_XGEN(j)  (2304 + 64 * (j))
#define XB_TOP      3328
#define XB_TOPGEN   3392
#define XCD_BAR_WORDS 3456
#define XB_SPIN_CAP (1u << 23)
#define LAS __attribute__((address_space(3)))

__device__ __forceinline__ unsigned xb_ld(unsigned* p)              { return __hip_atomic_load(p, __ATOMIC_RELAXED, __HIP_MEMORY_SCOPE_AGENT); }
__device__ __forceinline__ unsigned xb_add(unsigned* p, unsigned v) { return __hip_atomic_fetch_add(p, v, __ATOMIC_RELAXED, __HIP_MEMORY_SCOPE_AGENT); }
__device__ __forceinline__ unsigned xb_xcc_id() { return (unsigned)__builtin_amdgcn_s_getreg((3 << 11) | 20) & 0xFu; }
#define XB_SPIN(cond, bar) do { unsigned _sp = 0; while (cond) { __builtin_amdgcn_s_sleep(1); \
    if ((++_sp & 255u) == 0u) { if (xb_ld(&(bar)[XB_TMO])) break; if (_sp > XB_SPIN_CAP) { atomicAdd(&(bar)[XB_TMO], 1u); break; } } } } while (0)

struct XcdBarrier {
    unsigned* bar; unsigned x;
    volatile LAS unsigned* st;
};
__device__ __forceinline__ XcdBarrier xcd_barrier_post(unsigned* bar, volatile LAS unsigned* st) {
    XcdBarrier b; b.bar = bar; b.x = xb_xcc_id(); b.st = st;
    if (threadIdx.x == 0) (void)xb_add(&bar[XB_XCNT(b.x)], 1u);
    return b;
}
__device__ __forceinline__ void xcd_barrier_complete(unsigned* bar, unsigned x, unsigned& nloc, unsigned& nx) {
    const unsigned G = gridDim.x * gridDim.y * gridDim.z;
    unsigned sum, cnt, mine, sp = 0u;
    for (;;) {
        sum = 0u; cnt = 0u; mine = 0u;
#pragma unroll
        for (unsigned j = 0; j < 16; ++j) { const unsigned c = xb_ld(&bar[XB_XCNT(j)]); sum += c; cnt += (c > 0u) ? 1u : 0u; mine = (j == x) ? c : mine; }
        if (sum == G) break;
        __builtin_amdgcn_s_sleep(1);
        if ((++sp & 255u) == 0u) { if (xb_ld(&bar[XB_TMO])) break; if (sp > XB_SPIN_CAP) { atomicAdd(&bar[XB_TMO], 1u); break; } }
    }
    nloc = mine > 0u ? mine : 1u; nx = cnt > 0u ? cnt : 1u;
}
__device__ __forceinline__ void xcd_barrier(const XcdBarrier& b) {
    asm volatile("s_waitcnt vmcnt(0)" ::: "memory");
    __syncthreads();
    if (threadIdx.x == 0) {
        unsigned* bar = b.bar;
        __builtin_amdgcn_s_waitcnt(0);
        unsigned nloc = b.st[0], nx = b.st[1];
        if (nloc == 0u) { xcd_barrier_complete(bar, b.x, nloc, nx); b.st[0] = nloc; b.st[1] = nx; }
        const unsigned old = xb_add(&bar[XB_XSUB(b.x)], 1u);
        const unsigned gen = old / nloc;
        if (old + 1u == (gen + 1u) * nloc) {
            __builtin_amdgcn_fence(__ATOMIC_RELEASE, "agent");
            asm volatile("s_waitcnt vmcnt(0)" ::: "memory");
            const unsigned og = xb_add(&bar[XB_TOP], 1u);
            const unsigned tg = og / nx;
            if (og + 1u == (tg + 1u) * nx) xb_add(&bar[XB_TOPGEN], 1u);
            else XB_SPIN(xb_ld(&bar[XB_TOPGEN]) == tg, bar);
            __builtin_amdgcn_fence(__ATOMIC_ACQUIRE, "agent");
            xb_add(&bar[XB_XGEN(b.x)], 1u);
            asm volatile("s_waitcnt vmcnt(0)" ::: "memory");
        } else {
            XB_SPIN(xb_ld(&bar[XB_XGEN(b.x)]) == gen, bar);
            __builtin_amdgcn_fence(__ATOMIC_ACQUIRE, "agent");
            asm volatile("s_waitcnt vmcnt(0)" ::: "memory");
        }
    }
    __syncthreads();
}

template <class Tp> DEV Tp* opq(Tp* q) { asm volatile("" : "+s"(q)); return q; }
DEV int tid_() { int t = threadIdx.x; asm volatile("" : "+v"(t)); return t; }
DEV int bid_() { int b = blockIdx.x; asm volatile("" : "+s"(b)); return b; }

DEV void glds16(const void* gsrc, char* lds_lane_ptr) {
  __builtin_amdgcn_global_load_lds((const unsigned*)gsrc, (__attribute__((address_space(3))) unsigned*)lds_lane_ptr, 16, 0, 0);
}
template <class Epi>
DEV void gemm_tile(const bf16_t* __restrict__ A, int lda, const bf16_t* __restrict__ Bt, int ldb, int K, char* smem, Epi& epi) {
  const int tid = tid_(), lane = tid & 63, wid = tid >> 6, wr = wid >> 1, wc = wid & 1, fr = lane & 15, fq = lane >> 4;
  f32x4 acc[4][4];
#pragma unroll
  for (int m = 0; m < 4; ++m)
#pragma unroll
    for (int n = 0; n < 4; ++n) acc[m][n] = (f32x4){0.f, 0.f, 0.f, 0.f};
  const int drow0 = 8 * wid + (lane >> 3), dpc = lane & 7;
  auto issue = [&](int kt, int buf) {
    char* sa = smem + buf * 32768;
    char* sb = sa + 16384;
#pragma unroll
    for (int i = 0; i < 4; ++i) {
      const int row = drow0 + 32 * i;
      const int kc = dpc ^ ((row >> 1) & 7);
      glds16(A + (size_t)row * lda + kt * 64 + kc * 8, sa + (i * 4 + wid) * 1024 + lane * 16);
      glds16(Bt + (size_t)row * ldb + kt * 64 + kc * 8, sb + (i * 4 + wid) * 1024 + lane * 16);
    }
  };
  __syncthreads();
  issue(0, 0);
  const int nk = K >> 6;
  const int sw = (fr >> 1) & 7;
  const int aoff = (wr * 64 + fr) * 128, boff = (wc * 64 + fr) * 128;
  for (int kt = 0; kt < nk; ++kt) {
    asm volatile("s_waitcnt vmcnt(0)" ::: "memory");
    __syncthreads();
    if (kt + 1 < nk) issue(kt + 1, (kt + 1) & 1);
    else epi.pre(wr, wc, lane);
    const char* sa = smem + (kt & 1) * 32768;
    const char* sb = sa + 16384;
#pragma unroll
    for (int kh = 0; kh < 2; ++kh) {
      const int pc = ((kh * 4 + fq) ^ sw) * 16;
      bf16x8 af[4], bfr[4];
#pragma unroll
      for (int m = 0; m < 4; ++m) af[m] = *(const bf16x8*)(sa + aoff + m * 2048 + pc);
#pragma unroll
      for (int n = 0; n < 4; ++n) bfr[n] = *(const bf16x8*)(sb + boff + n * 2048 + pc);
#pragma unroll
      for (int m = 0; m < 4; ++m)
#pragma unroll
        for (int n = 0; n < 4; ++n) acc[m][n] = mfma16(bfr[n], af[m], acc[m][n]);
    }
  }
  __syncthreads();
  epi(acc, wr, wc, fr, fq, smem);
}
DEV void stage_tile_bf16(const f32x4 (&acc)[4][4], char* smem, int wid, int fr, int fq) {
  bf16_t (*t)[72] = (bf16_t (*)[72])(smem + wid * 9216);
#pragma unroll
  for (int m = 0; m < 4; ++m)
#pragma unroll
    for (int n = 0; n < 4; ++n)
      *(uint2*)&t[m * 16 + fr][n * 16 + 4 * fq] = make_uint2(pack2(acc[m][n][0], acc[m][n][1]), pack2(acc[m][n][2], acc[m][n][3]));
  asm volatile("s_waitcnt lgkmcnt(0)" ::: "memory");
}

DEV void ph_copy(const P& p) {
  const size_t n8 = (size_t)NTOK * D / 8;
  const float* pctx = opq(p.ctx); const float* px = opq(p.x);
  for (size_t i = (size_t)bid_() * 256 + tid_(); i < n8; i += (size_t)gridDim.x * 256) {
    size_t e = i * 8;
    int row = (int)(e / D), col = (int)(e % D);
    int b = row / LT, pp = row % LT;
    const float* src = pp < LC ? pctx + ((size_t)(b * LC + pp)) * D + col : px + ((size_t)(b * T + pp - LC)) * D + col;
    float4 v0 = *(const float4*)src, v1 = *(const float4*)(src + 4);
    uint4 o = make_uint4(pack2(v0.x, v0.y), pack2(v0.z, v0.w), pack2(v1.x, v1.y), pack2(v1.z, v1.w));
    *(uint4*)(p.X + e) = o;
  }
}

DEV void ph_rope(const P& p) {
  for (int i = bid_() * 256 + tid_(); i < 64 * 16; i += gridDim.x * 256) {
    int pos = i >> 4, k = i & 15;
    float inv = powf(10000.f, -(float)k / 16.f);
    float ang = (float)pos * inv;
    p.rope[2 * i] = cosf(ang); p.rope[2 * i + 1] = sinf(ang);
  }
}

DEV void modv_unit(const P& p, int unit, char* smem) {
  const int cc = unit % 24, layer = unit / 24;
  float (*cs)[128] = (float (*)[128])smem;
  const int col = cc * 256 + tid_();
  const float* pc = opq(p.c); const float* pcc = opq(p.c_ctx);
  float acc[17];
#pragma unroll
  for (int r = 0; r < 17; ++r) acc[r] = 0.f;
  for (int ks = 0; ks < 8; ++ks) {
    __syncthreads();
    for (int i = tid_(); i < 17 * 128; i += 256) {
      int r = i >> 7, e = i & 127;
      float v = r < 16 ? pc[r * D + ks * 128 + e] : pcc[ks * 128 + e];
      cs[r][e] = v / (1.f + expf(-v));
    }
    __syncthreads();
    const float* w = p.mod_w + ((size_t)layer * D + ks * 128) * 6144 + col;
#pragma unroll 1
    for (int e0 = 0; e0 < 128; e0 += 32) {
      float wv[32];
#pragma unroll
      for (int q = 0; q < 32; ++q) wv[q] = w[(size_t)(e0 + q) * 6144];
#pragma unroll
      for (int q4 = 0; q4 < 8; ++q4) {
      const int e = e0 + 4 * q4;
      const float w0 = wv[4 * q4], w1 = wv[4 * q4 + 1], w2 = wv[4 * q4 + 2], w3 = wv[4 * q4 + 3];
#pragma unroll
      for (int r = 0; r < 17; ++r) {
        const float4 cv = *(const float4*)&cs[r][e];
        acc[r] += cv.x * w0 + cv.y * w1 + cv.z * w2 + cv.w * w3;
      }
      }
    }
  }
  const float bias = p.mod_b[layer * 6144 + col];
#pragma unroll
  for (int r = 0; r < 17; ++r) p.modv[((size_t)layer * 17 + r) * 6144 + col] = acc[r] + bias;
}

DEV void transpose_unit(const float* __restrict__ src, bf16_t* __restrict__ dst, int R, int C, int tile, char* smem) {
  float (*t)[65] = (float (*)[65])smem;
  const int nct = C / 64;
  const int tr = tile / nct, tc = tile % nct;
  __syncthreads();
  for (int i = tid_(); i < 4096; i += 256) { int r = i >> 6, c = i & 63; t[r][c] = src[(size_t)(tr * 64 + r) * C + tc * 64 + c]; }
  __syncthreads();
  for (int i = tid_(); i < 4096; i += 256) { int c = i >> 6, r = i & 63; dst[(size_t)(tc * 64 + c) * R + tr * 64 + r] = f2bf(t[r][c]); }
}

DEV void wfold_unit(const P& p, int layer, int unit, char* smem) {
  const int hs = unit >> 5, ec = unit & 31, h = hs >> 1, s = hs & 1;
  const float* wq = p.peer_wq + (size_t)layer * D * 2048;
  const float* kk = (s ? opq(p.peer_k2) : opq(p.peer_k1)) + ((size_t)layer * 8 + h) * 128 * 128;
  float (*kS)[65] = (float (*)[65])smem;
  float (*wS)[64] = (float (*)[64])(smem + 33280);
  const int key = tid_() & 127, eh = tid_() >> 7;
  float acc[16];
#pragma unroll
  for (int i = 0; i < 16; ++i) acc[i] = 0.f;
  for (int dh = 0; dh < 2; ++dh) {
    __syncthreads();
    for (int i = tid_(); i < 128 * 64; i += 256) { int k2 = i >> 6, d = i & 63; kS[k2][d] = kk[k2 * 128 + dh * 64 + d]; }
    for (int i = tid_(); i < 32 * 64; i += 256) {
      int e = i >> 6, d = i & 63;
      wS[e][d] = wq[(size_t)(ec * 32 + e) * 2048 + h * 256 + s * 128 + dh * 64 + d];
    }
    __syncthreads();
#pragma unroll 2
    for (int d = 0; d < 64; d += 4) {
      const float k0 = kS[key][d], k1 = kS[key][d + 1], k2 = kS[key][d + 2], k3 = kS[key][d + 3];
#pragma unroll
      for (int i = 0; i < 16; ++i) {
        const float4 wv = *(const float4*)&wS[eh * 16 + i][d];
        acc[i] += k0 * wv.x + k1 * wv.y + k2 * wv.z + k3 * wv.w;
      }
    }
  }
  bf16_t* dst = p.Wft + ((size_t)(hs * 128 + key)) * D + ec * 32 + eh * 16;
#pragma unroll
  for (int i = 0; i < 16; i += 2) *(unsigned*)(dst + i) = pack2(acc[i], acc[i + 1]);
}

DEV void filt_unit(const P& p, int layer, int unit, char* smem) {
  int kind, j0, L;
  if (unit < 256) { kind = 0; j0 = unit * 16; L = T; } else { kind = 1; j0 = (unit - 256) * 16; L = LC; }
  float* zs = (float*)smem;
  float* h1 = zs + 16 * 36;
  float* h2 = h1 + 16 * 64;
  const int tid = tid_();
  __syncthreads();
  for (int idx = tid; idx < 16 * 33; idx += 256) {
    const int jj = idx / 33, o = idx - jj * 33;
    const float fj = (float)(j0 + jj);
    float z;
    if (o == 0) z = fj / (float)(L - 1);
    else {
      const int i = (o - 1) & 15;
      const float band = 1e-4f + (float)i * ((15.0f - 1e-4f) / 15.0f);
      const float ang = 6.283185307179586f * fj * band / (float)L;
      z = (o <= 16) ? cosf(ang) : -sinf(ang);
    }
    zs[jj * 36 + o] = z;
  }
  __syncthreads();
  const int o = tid & 63, jq = tid >> 6;
  {
    const float* w1 = p.hy_w1 + layer * 33 * 64;
    const float b1 = p.hy_b1[layer * 64 + o];
    float a[4] = {b1, b1, b1, b1};
#pragma unroll 3
    for (int i = 0; i < 33; ++i) {
      const float w = w1[i * 64 + o];
#pragma unroll
      for (int q = 0; q < 4; ++q) a[q] += zs[(jq * 4 + q) * 36 + i] * w;
    }
    const float fr1 = p.hy_freq[layer * 128 + o];
#pragma unroll
    for (int q = 0; q < 4; ++q) h1[(jq * 4 + q) * 64 + o] = sinf(fr1 * a[q]);
  }
  __syncthreads();
  {
    const float* w2 = p.hy_w2 + layer * 64 * 64;
    const float b2 = p.hy_b2[layer * 64 + o];
    float a[4] = {b2, b2, b2, b2};
#pragma unroll 4
    for (int i = 0; i < 64; ++i) {
      const float w = w2[i * 64 + o];
#pragma unroll
      for (int q = 0; q < 4; ++q) a[q] += h1[(jq * 4 + q) * 64 + i] * w;
    }
    const float fr2 = p.hy_freq[layer * 128 + 64 + o];
#pragma unroll
    for (int q = 0; q < 4; ++q) h2[o * 16 + jq * 4 + q] = sinf(fr2 * a[q]);
  }
  __syncthreads();
  const float* w3 = p.hy_w3 + layer * 64 * 512;
  const int c = tid;
  float af[16], ab[16];
  {
    const float bf0 = p.hy_b3[layer * 512 + c], bb0 = p.hy_b3[layer * 512 + 256 + c];
#pragma unroll
    for (int q = 0; q < 16; ++q) { af[q] = bf0; ab[q] = bb0; }
  }
#pragma unroll 1
  for (int i0 = 0; i0 < 64; i0 += 8) {
    float wf[8], wb[8];
#pragma unroll
    for (int k = 0; k < 8; ++k) { wf[k] = w3[(i0 + k) * 512 + c]; wb[k] = w3[(i0 + k) * 512 + 256 + c]; }
#pragma unroll
    for (int k = 0; k < 8; ++k) {
#pragma unroll
      for (int q4 = 0; q4 < 4; ++q4) {
        const float4 hv = *(const float4*)&h2[(i0 + k) * 16 + 4 * q4];
        af[4 * q4] += hv.x * wf[k]; af[4 * q4 + 1] += hv.y * wf[k]; af[4 * q4 + 2] += hv.z * wf[k]; af[4 * q4 + 3] += hv.w * wf[k];
        ab[4 * q4] += hv.x * wb[k]; ab[4 * q4 + 1] += hv.y * wb[k]; ab[4 * q4 + 2] += hv.z * wb[k]; ab[4 * q4 + 3] += hv.w * wb[k];
      }
    }
  }
  float* F = kind ? opq(p.FC) : opq(p.FL);
  const float DMIN = -3.0701134573253945f, DMAX = -15.350567286626973f;
  const float delta = fabsf(DMIN + (float)c * ((DMAX - DMIN) / 255.f));
#pragma unroll
  for (int q = 0; q < 16; ++q) {
    const float t = (float)(j0 + q) / (float)(L - 1);
    const float win = expf(-t * delta) + 0.05f;
    af[q] *= win; ab[q] *= win;
  }
  float* df = F + ((size_t)c * 2 + 0) * L + j0;
  float* db = F + ((size_t)c * 2 + 1) * L + j0;
#pragma unroll
  for (int q4 = 0; q4 < 4; ++q4) {
    *(float4*)(df + 4 * q4) = make_float4(af[4 * q4], af[4 * q4 + 1], af[4 * q4 + 2], af[4 * q4 + 3]);
    *(float4*)(db + 4 * q4) = make_float4(ab[4 * q4], ab[4 * q4 + 1], ab[4 * q4 + 2], ab[4 * q4 + 3]);
  }
}

constexpr int PREP_T0 = 672, PREP_T1 = PREP_T0 + 256, PREP_T2 = PREP_T1 + 8, PREP_T3 = PREP_T2 + 8, PREP_T4 = PREP_T3 + 8;
constexpr int PREP_WF = PREP_T4 + 512, PREP_N = PREP_WF + 272;
DEV void prep_unit(const P& p, int layer, int u, char* smem) {
  if (u < PREP_T0) transpose_unit(p.w_in + (size_t)layer * D * INW, p.W1t, D, INW, u, smem);
  else if (u < PREP_T1) transpose_unit(p.w_out + (size_t)layer * D * D, p.W2t, D, D, u - PREP_T0, smem);
  else if (u < PREP_T3) {
    const int u0 = u - PREP_T1;
    for (int i = tid_(); i < 64 * 256; i += 256) {
      const int np = u0 * 64 + (i >> 8), kp = i & 255;
      const int ps = np & 3, chan = np >> 2, qp = kp >> 6, kk = kp & 63;
      const int is_a = ps & 1, d = ps >> 1;
      float v = 0.f;
      if (qp == (is_a ? 2 + d : d)) v = (is_a ? opq(p.rw_a_up) : opq(p.rw_w_up))[(((size_t)layer * 2 + d) * 64 + kk) * 256 + chan];
      p.Wlt[(size_t)np * 256 + kp] = f2bf(v);
    }
  }
  else if (u < PREP_T4) transpose_unit(p.rw_g_up + (size_t)layer * 128 * 256, p.Wgt, 128, 256, u - PREP_T3, smem);
  else if (u < PREP_WF) wfold_unit(p, layer, u - PREP_T4, smem);
  else filt_unit(p, layer, u - PREP_WF, smem);
}
constexpr int PREPA_N = PREP_T0 + (PREP_T4 - PREP_T1);
DEV int prepA_unit_index(int i) { return i < PREP_T0 ? i : PREP_T1 + (i - PREP_T0); }
DEV void ph_prep(const P& p, int layer, char* smem, bool onlyB) {
  for (int u = bid_(); u < PREP_N; u += gridDim.x) {
    const bool isA = (u < PREP_T0) || (u >= PREP_T1 && u < PREP_T4);
    if (onlyB && isA) continue;
    prep_unit(p, layer, u, smem);
  }
}

DEV void wave_range(int& r0, int& r1, int ntok) {
  const int gw = (bid_() * 256 + tid_()) >> 6, nw = gridDim.x * 4;
  const int per = (ntok + nw - 1) / nw;
  r0 = gw * per; r1 = r0 + per; if (r1 > ntok) r1 = ntok;
}
DEV void ph_norm_first(const P& p) {
  const int lane = tid_() & 63;
  int r0, r1;
  wave_range(r0, r1, NTOK);
  const float* pctx = opq(p.ctx); const float* px = opq(p.x);
  float gv[16], scv[16], shv[16];
#pragma unroll
  for (int hh = 0; hh < 2; ++hh)
#pragma unroll
    for (int i = 0; i < 8; ++i) gv[hh * 8 + i] = p.norm1_g[hh * 512 + 8 * lane + i];
  int mr_cur = -1;
  auto srcrow = [&](int row) -> const float* {
    const int b = row / LT, pp = row % LT;
    return pp < LC ? pctx + ((size_t)(b * LC + pp)) * D : px + ((size_t)(b * T + pp - LC)) * D;
  };
  float4 n0, n1, n2, n3;
  auto ld = [&](int row) { const float* s0 = srcrow(row) + 8 * lane; n0 = *(const float4*)s0; n1 = *(const float4*)(s0 + 4); n2 = *(const float4*)(s0 + 512); n3 = *(const float4*)(s0 + 516); };
  if (r0 < r1) ld(r0);
#pragma unroll 1
  for (int row = r0; row < r1; ++row) {
    float v[16] = {n0.x, n0.y, n0.z, n0.w, n1.x, n1.y, n1.z, n1.w, n2.x, n2.y, n2.z, n2.w, n3.x, n3.y, n3.z, n3.w};
    if (row + 1 < r1) ld(row + 1);
    const int b = row / LT, pp = row % LT;
    const int mr = pp < LC ? 16 : b;
    if (mr != mr_cur) {
      mr_cur = mr;
      const float* mv = p.modv + (size_t)mr * 6144;
#pragma unroll
      for (int hh = 0; hh < 2; ++hh)
#pragma unroll
        for (int i = 0; i < 8; ++i) { shv[hh * 8 + i] = mv[hh * 512 + 8 * lane + i]; scv[hh * 8 + i] = 1.f + mv[1024 + hh * 512 + 8 * lane + i]; }
    }
    bf16_t* xr = p.X + (size_t)row * D;
    const uint4 x0 = pack8(v), x1 = pack8(v + 8);
    *(uint4*)(xr + 8 * lane) = x0;
    *(uint4*)(xr + 512 + 8 * lane) = x1;
    unpack8(x0, v); unpack8(x1, v + 8);
    float ss = 0.f;
#pragma unroll
    for (int i = 0; i < 16; ++i) ss += v[i] * v[i];
    ss = wave_sum(ss);
    const float rstd = rsqrtf(ss * (1.f / 1024.f) + 1e-6f);
    float o[16];
#pragma unroll
    for (int i = 0; i < 16; ++i) o[i] = (v[i] * rstd * gv[i]) * scv[i] + shv[i];
    bf16_t* hr = p.H + (size_t)row * D;
    *(uint4*)(hr + 8 * lane) = pack8(o);
    *(uint4*)(hr + 512 + 8 * lane) = pack8(o + 8);
  }
}
DEV void ph_norm(const P& p, int layer, int which) {
  const int lane = tid_() & 63;
  int r0, r1;
  wave_range(r0, r1, NTOK);
  const float* g = (which ? p.norm2_g : p.norm1_g) + layer * D;
  float gv[16], scv[16], shv[16];
#pragma unroll
  for (int hh = 0; hh < 2; ++hh)
#pragma unroll
    for (int i = 0; i < 8; ++i) gv[hh * 8 + i] = g[hh * 512 + 8 * lane + i];
  int mr_cur = -1;
  uint4 n0 = make_uint4(0, 0, 0, 0), n1 = n0;
  if (r0 < r1) { const bf16_t* xr = p.X + (size_t)r0 * D; n0 = *(const uint4*)(xr + 8 * lane); n1 = *(const uint4*)(xr + 512 + 8 * lane); }
#pragma unroll 1
  for (int row = r0; row < r1; ++row) {
    const uint4 u0 = n0, u1 = n1;
    if (row + 1 < r1) { const bf16_t* xr = p.X + (size_t)(row + 1) * D; n0 = *(const uint4*)(xr + 8 * lane); n1 = *(const uint4*)(xr + 512 + 8 * lane); }
    const int b = row / LT, pp = row % LT;
    const int mr = pp < LC ? 16 : b;
    if (mr != mr_cur) {
      mr_cur = mr;
      const float* mv = p.modv + ((size_t)layer * 17 + mr) * 6144 + (which ? 3072 : 0);
#pragma unroll
      for (int hh = 0; hh < 2; ++hh)
#pragma unroll
        for (int i = 0; i < 8; ++i) { shv[hh * 8 + i] = mv[hh * 512 + 8 * lane + i]; scv[hh * 8 + i] = 1.f + mv[1024 + hh * 512 + 8 * lane + i]; }
    }
    float v[16];
    unpack8(u0, v); unpack8(u1, v + 8);
    float ss = 0.f;
#pragma unroll
    for (int i = 0; i < 16; ++i) ss += v[i] * v[i];
    ss = wave_sum(ss);
    const float rstd = rsqrtf(ss * (1.f / 1024.f) + 1e-6f);
    float o[16];
#pragma unroll
    for (int i = 0; i < 16; ++i) o[i] = (v[i] * rstd * gv[i]) * scv[i] + shv[i];
    bf16_t* hr = p.H + (size_t)row * D;
    *(uint4*)(hr + 8 * lane) = pack8(o);
    *(uint4*)(hr + 512 + 8 * lane) = pack8(o + 8);
    if (which) {
      float am = 0.f;
#pragma unroll
      for (int i = 0; i < 16; ++i) am = fmaxf(am, fabsf(o[i]));
      am = wave_max(am);
      const float sc = am > 0.f ? 127.f / am : 1.f;
      unsigned char* h8 = p.H8 + (size_t)row * 1024;
      *(uint2*)(h8 + 8 * lane) = make_uint2((unsigned)pack_i8(o[0] * sc, o[1] * sc, o[2] * sc, o[3] * sc), (unsigned)pack_i8(o[4] * sc, o[5] * sc, o[6] * sc, o[7] * sc));
      *(uint2*)(h8 + 512 + 8 * lane) = make_uint2((unsigned)pack_i8(o[8] * sc, o[9] * sc, o[10] * sc, o[11] * sc), (unsigned)pack_i8(o[12] * sc, o[13] * sc, o[14] * sc, o[15] * sc));
      if (lane == 0) p.HINV[row] = am > 0.f ? am * (1.f / 127.f) : 1.f;
    }
  }
}

DEV bool gemm_unit(int it, int nct, int& rt, int& ct) {
  const int nslot = gridDim.x >> 3;
  const int x = bid_() & 7, sl = bid_() >> 3;
  if (sl >= nslot) return false;
  const int v = it * nslot + sl;
  if (v >= 68 * nct) return false;
  const int rg = v / (8 * nct), rem = v - rg * 8 * nct;
  const int rows = (rg == 8) ? 4 : 8;
  ct = rem / rows;
  rt = x * 68 + rg * 8 + (rem - ct * rows);
  return true;
}
struct Epi1 {
  const P& p; int row0, col0;
  DEV void pre(int, int, int) {}
  DEV void operator()(f32x4 (&acc)[4][4], int wr, int wc, int fr, int fq, char* smem) const {
    const int cw = col0 + wc * 64;
    const int rbase = row0 + wr * 64;
    const bool lat = (row0 % LT) >= LC;
    if (cw >= 1536 && cw < 1664) {
#pragma unroll
      for (int m = 0; m < 4; ++m)
#pragma unroll
        for (int n = 0; n < 4; ++n)
#pragma unroll
          for (int j = 0; j < 4; ++j) acc[m][n][j] = 2.f * sigmoidf_(2.f * acc[m][n][j]) - 1.f;
    } else if (cw >= 1792 && cw < 1920) {
#pragma unroll
      for (int m = 0; m < 4; ++m)
#pragma unroll
        for (int n = 0; n < 4; ++n)
#pragma unroll
          for (int j = 0; j < 4; ++j) acc[m][n][j] = sigmoidf_(acc[m][n][j]);
    } else if (cw >= 1920 && cw < 2560 && lat) {
#pragma unroll
      for (int m = 0; m < 4; ++m) {
        const int row = rbase + m * 16 + fr;
        const int pl = (row % LT) - LC;
        const int ri = pl >> 6, ci = pl & 63;
        const float4* crp = (const float4*)(p.rope + 2 * (ri * 16 + 4 * fq));
        const float4* ccp = (const float4*)(p.rope + 2 * (ci * 16 + 4 * fq));
        const float4 cr0 = crp[0], cr1 = crp[1], cc0 = ccp[0], cc1 = ccp[1];
        const float crc[4] = {cr0.x, cr0.z, cr1.x, cr1.z}, crs[4] = {cr0.y, cr0.w, cr1.y, cr1.w};
        const float ccc[4] = {cc0.x, cc0.z, cc1.x, cc1.z}, ccs[4] = {cc0.y, cc0.w, cc1.y, cc1.w};
#pragma unroll
        for (int j = 0; j < 4; ++j) {
          float x1 = acc[m][0][j], x2 = acc[m][1][j];
          acc[m][0][j] = x1 * crc[j] - x2 * crs[j]; acc[m][1][j] = x2 * crc[j] + x1 * crs[j];
          x1 = acc[m][2][j]; x2 = acc[m][3][j];
          acc[m][2][j] = x1 * ccc[j] - x2 * ccs[j]; acc[m][3][j] = x2 * ccc[j] + x1 * ccs[j];
        }
      }
    }
    const int wid = wr * 2 + wc, lane = fq * 16 + fr;
    stage_tile_bf16(acc, smem, wid, fr, fq);
    const bf16_t (*t)[72] = (const bf16_t (*)[72])(smem + wid * 9216);
#pragma unroll
    for (int i = 0; i < 8; ++i) {
      const int rl = i * 8 + (lane >> 3), ch = lane & 7;
      *(uint4*)(p.Z + (size_t)(rbase + rl) * INW + cw + ch * 8) = *(const uint4*)&t[rl][ch * 8];
    }
  }
};
DEV void ph_gemm1(const P& p, char* smem) {
  const int nct = INW / 128;
  int rt, ct;
  for (int it = 0; gemm_unit(it, nct, rt, ct); ++it) {
    Epi1 epi{p, rt * 128, ct * 128};
    gemm_tile(p.H + (size_t)rt * 128 * D, D, p.W1t + (size_t)ct * 128 * D, D, D, smem, epi);
  }
}

struct EpiLoraA {
  const P& p; int layer, row0, col0;
  DEV void pre(int, int, int) {}
  DEV void operator()(f32x4 (&acc)[4][4], int wr, int wc, int fr, int fq, char* smem) const {
    const float* w0b = p.rw_w0 + layer * 512;
    const float* a0b = p.rw_a0 + layer * 512;
#pragma unroll
    for (int n = 0; n < 4; ++n) {
      const int chan = ((col0 + wc * 64 + n * 16) >> 2) + fq;
      const float be0 = w0b[chan], ba0 = a0b[chan], be1 = w0b[256 + chan], ba1 = a0b[256 + chan];
#pragma unroll
      for (int m = 0; m < 4; ++m) {
        acc[m][n][0] = 0.6065306597126334f * sigmoidf_(acc[m][n][0] + be0);
        acc[m][n][1] = sigmoidf_(acc[m][n][1] + ba0);
        acc[m][n][2] = 0.6065306597126334f * sigmoidf_(acc[m][n][2] + be1);
        acc[m][n][3] = sigmoidf_(acc[m][n][3] + ba1);
      }
    }
    const int wid = wr * 2 + wc, lane = fq * 16 + fr;
    stage_tile_bf16(acc, smem, wid, fr, fq);
    const bf16_t (*t)[72] = (const bf16_t (*)[72])(smem + wid * 9216);
#pragma unroll
    for (int i = 0; i < 8; ++i) {
      const int rl = i * 8 + (lane >> 3), ch = lane & 7;
      *(uint4*)(p.SC + (size_t)(row0 + wr * 64 + rl) * 1024 + col0 + wc * 64 + ch * 8) = *(const uint4*)&t[rl][ch * 8];
    }
  }
};
struct EpiLoraG {
  const P& p; int row0, col0;
  DEV void pre(int, int, int) {}
  DEV void operator()(f32x4 (&acc)[4][4], int wr, int wc, int fr, int fq, char* smem) const {
    const int wid = wr * 2 + wc, lane = fq * 16 + fr;
    stage_tile_bf16(acc, smem, wid, fr, fq);
    const bf16_t (*t)[72] = (const bf16_t (*)[72])(smem + wid * 9216);
#pragma unroll
    for (int i = 0; i < 8; ++i) {
      const int rl = i * 8 + (lane >> 3), ch = lane & 7;
      *(uint4*)(p.Y + (size_t)(row0 + wr * 64 + rl) * D + 256 + col0 + wc * 64 + ch * 8) = *(const uint4*)&t[rl][ch * 8];
    }
  }
};
DEV void ph_lora(const P& p, int layer, char* smem) {
  int rt, ct;
  for (int it = 0; gemm_unit(it, 10, rt, ct); ++it) {
    if (ct < 8) {
      EpiLoraA epi{p, layer, rt * 128, ct * 128};
      gemm_tile(p.Z + (size_t)rt * 128 * INW + 1536, INW, p.Wlt + (size_t)ct * 128 * 256, 256, 256, smem, epi);
    } else {
      EpiLoraG epi{p, rt * 128, (ct - 8) * 128};
      gemm_tile(p.Z + (size_t)rt * 128 * INW + 1792, INW, p.Wgt + (size_t)(ct - 8) * 128 * 128, 128, 128, smem, epi);
    }
  }
}

DEV void ph_rwkv_prep(const P& p, int layer) {
  const int lane = tid_() & 63;
  int r0, r1;
  wave_range(r0, r1, NTOK);
  const float* cw = p.conv_w + (size_t)layer * 3 * 1536;
  const float* cb = p.conv_b + (size_t)layer * 1536;
  float w0[3][4], w1[3][4], w2[3][4], bb[3][4], kkw[4];
#pragma unroll
  for (int a = 0; a < 3; ++a)
#pragma unroll
    for (int i = 0; i < 4; ++i) {
      const int col = 768 + a * 256 + 4 * lane + i;
      w0[a][i] = cw[col]; w1[a][i] = cw[1536 + col]; w2[a][i] = cw[3072 + col]; bb[a][i] = cb[col];
    }
#pragma unroll
  for (int i = 0; i < 4; ++i) kkw[i] = p.rw_k_k[layer * 256 + 4 * lane + i];
  uint2 zm[3], zc[3], zp[3];
  auto ldz = [&](int row, uint2 (&z)[3]) {
#pragma unroll
    for (int a = 0; a < 3; ++a) z[a] = *(const uint2*)(p.Z + (size_t)row * INW + 768 + a * 256 + 4 * lane);
  };
  auto zero3 = [&](uint2 (&z)[3]) {
#pragma unroll
    for (int a = 0; a < 3; ++a) z[a] = make_uint2(0u, 0u);
  };
  if (r0 < r1) {
    if (r0 > 0) ldz(r0 - 1, zm); else zero3(zm);
    ldz(r0, zc);
  }
#pragma unroll 1
  for (int row = r0; row < r1; ++row) {
    if (row + 1 < NTOK) ldz(row + 1, zp); else zero3(zp);
    const int pp = row % LT;
    const bool hasm = (pp != 0) && (pp != LC);
    const bool hasp = (pp != LC - 1) && (pp != LT - 1);
    float res[3][4];
#pragma unroll
    for (int a = 0; a < 3; ++a) {
      const uint2 um = hasm ? zm[a] : make_uint2(0u, 0u), uc = zc[a], up = hasp ? zp[a] : make_uint2(0u, 0u);
      const float vm[4] = {bflo(um.x), bfhi(um.x), bflo(um.y), bfhi(um.y)};
      const float vc[4] = {bflo(uc.x), bfhi(uc.x), bflo(uc.y), bfhi(uc.y)};
      const float vp[4] = {bflo(up.x), bfhi(up.x), bflo(up.y), bfhi(up.y)};
#pragma unroll
      for (int i = 0; i < 4; ++i) res[a][i] = w0[a][i] * vm[i] + w1[a][i] * vc[i] + w2[a][i] * vp[i] + bb[a][i];
    }
    float kk[4], ss = 0.f;
#pragma unroll
    for (int i = 0; i < 4; ++i) { kk[i] = res[1][i] * kkw[i]; ss += kk[i] * kk[i]; }
    ss = row16_sum(ss);
    const float rs = rsqrtf(ss + 1e-12f);
    bf16_t* hr = p.H + (size_t)row * D + 16 * lane;
    *(uint4*)hr = make_uint4(pack2(res[0][0], res[1][0]), pack2(kk[0] * rs, res[2][0]), pack2(res[0][1], res[1][1]), pack2(kk[1] * rs, res[2][1]));
    *(uint4*)(hr + 8) = make_uint4(pack2(res[0][2], res[1][2]), pack2(kk[2] * rs, res[2][2]), pack2(res[0][3], res[1][3]), pack2(kk[3] * rs, res[2][3]));
#pragma unroll
    for (int a = 0; a < 3; ++a) { zm[a] = zc[a]; zc[a] = zp[a]; }
  }
}

DEV float oct_sum(float x) { x += dpp0<0xB1, 0xF>(x); x += dpp0<0x4E, 0xF>(x); x += dpp0<0x141, 0xF>(x); return x; }
DEV bf16x8 frag_join(uint2 lo, uint2 hi) { uint4 w = make_uint4(lo.x, lo.y, hi.x, hi.y); return __builtin_bit_cast(bf16x8, w); }
constexpr int SCS_SET = 17152, SCS_IMG = 3 * SCS_SET, SCS_W0 = SCS_IMG + 2 * 3072;
DEV void scanc_unit(const P& p, int layer, int unit, char* smem) {
  const int dir = unit & 1, h = (unit >> 1) & 3, b = unit >> 3;
  const int tid = tid_(), lane = tid & 63, fr = lane & 15, fq = lane >> 4;
  const int w = __builtin_amdgcn_readfirstlane(tid >> 6);
  bf16_t* IMG0 = (bf16_t*)(smem + SCS_W0);
  bf16_t* IMG1 = IMG0 + 512;
  bf16_t* IMG2 = IMG0 + 1024;
  __syncthreads();
  for (int i = tid; i < (2 * 3072 + 3072) / 4; i += 256) ((unsigned*)(smem + SCS_IMG))[i] = 0u;
  const float ka = p.rw_k_a[layer * 256 + h * 64 + lane];
  const size_t rowbase = (size_t)b * LT;
  const char* hbase = (const char*)p.H;
  const char* sbase = (const char*)p.SC;
  const unsigned hoff = (unsigned)(rowbase * 2048) + (unsigned)((h * 64 + lane) * 8);
  const unsigned soff = hoff + 4u * (unsigned)dir;
  bf16_t* yb = p.Z + rowbase * INW + 768 + dir * 256 + h * 64 + w * 16 + fr;
  auto pos0 = [&](int c) -> int { const int t = c * 16; return dir == 0 ? t : (t < LC ? LC - 1 - t : LT - 1 - (t - LC)); };
  const int pstep = dir == 0 ? 1 : -1;
  constexpr int NCH = LT / 16;
  struct Raw { unsigned sc[16]; uint2 hr[6]; };
  auto load_raw = [&](int c, Raw& rw) {
    if (w != 0) {
      const int p0 = pos0(c);
      const unsigned so = soff + (unsigned)(p0 * 2048);
      const int st = pstep * 2048;
#pragma unroll
      for (int i = 0; i < 16; ++i) rw.sc[i] = *(const unsigned*)(sbase + (so + (unsigned)(i * st)));
      const unsigned ho = hoff + (unsigned)((p0 + pstep * (w - 1)) * 2048);
#pragma unroll
      for (int q = 0; q < 6; ++q) {
        const int qq = ((w - 1) + 3 * q < 16) ? q : 4;
        rw.hr[q] = *(const uint2*)(hbase + (ho + (unsigned)(qq * 3 * st)));
      }
    }
  };
  auto stage1w = [&](int set, const Raw& rw, auto W1tag) {
    constexpr int W1 = decltype(W1tag)::value;
    char* base = smem + set * SCS_SET;
    bf16_t (*At)[72] = (bf16_t (*)[72])(base);
    bf16_t (*Rt)[72] = (bf16_t (*)[72])(base + 2304);
    bf16_t (*Bt)[72] = (bf16_t (*)[72])(base + 4608);
    bf16_t (*Kt)[72] = (bf16_t (*)[72])(base + 6912);
    bf16_t (*BKT)[36] = (bf16_t (*)[36])(base + 9216);
    bf16_t* VV = (bf16_t*)(base + 13824);
    float* G16 = (float*)(base + 16896);
    float Erun = 0.f;
#pragma unroll
    for (int i = 0; i < 16; ++i) {
      const float ev = bflo(rw.sc[i]);
      const float Eprev = Erun;
      Erun += ev;
      if ((i % 3) == W1) {
        const uint2 hrec = rw.hr[i / 3];
        const float rr = bflo(hrec.x), kr = bfhi(hrec.x), kkv = bflo(hrec.y);
        const float av = bfhi(rw.sc[i]);
        const float gp = __expf(-Eprev), gi = __expf(-Erun), ig = __expf(Erun);
        const float at = -kkv * gp, rt = rr * gi, bt = kkv * av * ig, kt2 = kr * (1.f + (av - 1.f) * ka) * ig;
        const unsigned ar = pack2(at, rt), bk = pack2(bt, kt2);
        At[i][lane] = (bf16_t)(ar & 0xFFFFu); Rt[i][lane] = (bf16_t)(ar >> 16);
        Bt[i][lane] = (bf16_t)(bk & 0xFFFFu); Kt[i][lane] = (bf16_t)(bk >> 16);
        BKT[lane][(i >> 2) * 8 + (i & 3)] = (bf16_t)(bk & 0xFFFFu);
        BKT[lane][(i >> 2) * 8 + 4 + (i & 3)] = (bf16_t)(bk >> 16);
        VV[((i >> 2) * 64 + lane) * 6 + (i & 3)] = (bf16_t)(hrec.y >> 16);
        if (i == 15) G16[lane] = gi;
      }
    }
  };
  auto stage1 = [&](int set, const Raw& rw) {
    if (w == 1) stage1w(set, rw, std::integral_constant<int, 0>{});
    else if (w == 2) stage1w(set, rw, std::integral_constant<int, 1>{});
    else if (w == 3) stage1w(set, rw, std::integral_constant<int, 2>{});
  };
  auto stage2 = [&](int set, int iset) {
    char* base = smem + set * SCS_SET;
    const bf16_t (*At)[72] = (const bf16_t (*)[72])(base);
    const bf16_t (*Rt)[72] = (const bf16_t (*)[72])(base + 2304);
    const bf16_t (*Bt)[72] = (const bf16_t (*)[72])(base + 4608);
    const bf16_t (*Kt)[72] = (const bf16_t (*)[72])(base + 6912);
    bf16_t* TT = (bf16_t*)(smem + SCS_IMG + iset * 3072);
    bf16_t* ARK = TT + 512;
    bf16_t* AAK = TT + 1024;
    const bf16_t (*X)[72] = (w < 2) ? At : Rt;
    const bf16_t (*Y)[72] = (w & 1) ? Kt : Bt;
    f32x4 cm = (f32x4){0.f, 0.f, 0.f, 0.f};
#pragma unroll
    for (int s = 0; s < 2; ++s) {
      bf16x8 af = *(const bf16x8*)&X[fr][32 * s + 8 * fq];
      bf16x8 bm = *(const bf16x8*)&Y[fr][32 * s + 8 * fq];
      cm = mfma16(af, bm, cm);
    }
#pragma unroll
    for (int jj = 0; jj < 4; ++jj) {
      const int i = 4 * fq + jj;
      const bool keep = (w < 2) ? (fr < i) : (fr <= i);
      cm[jj] = keep ? cm[jj] : 0.f;
    }
    const int io = (fr >> 2) * 8 + (fr & 3);
    auto wr_img = [&](bf16_t* img, const f32x4& Xv, int hi) {
#pragma unroll
      for (int jj = 0; jj < 4; ++jj) img[(4 * fq + jj) * 32 + io + hi] = f2bf(Xv[jj]);
    };
    if (w == 1) wr_img(AAK, cm, 0);
    else if (w == 2) wr_img(ARK, cm, 0);
    else if (w == 3) wr_img(ARK, cm, 4);
    else {
      auto bfrag = [&](const f32x4& Xv) { return frag_join(make_uint2(pack2(Xv[0], Xv[1]), pack2(Xv[2], Xv[3])), make_uint2(0u, 0u)); };
      auto afr = [&](const bf16_t* img) { return *(const bf16x8*)&img[(fr * 4 + fq) * 8]; };
      const f32x4 Z4 = (f32x4){0.f, 0.f, 0.f, 0.f};
      wr_img(IMG0, cm, 0);
      asm volatile("" ::: "memory");
      f32x4 A2 = mfma16(afr(IMG0), bfrag(cm), Z4);
      wr_img(IMG1, A2, 0);
      asm volatile("" ::: "memory");
      f32x4 A4 = mfma16(afr(IMG1), bfrag(A2), Z4);
      wr_img(IMG2, A4, 0);
      asm volatile("" ::: "memory");
      f32x4 Rm = mfma16(afr(IMG2), bfrag(A4), Z4);
#pragma unroll
      for (int jj = 0; jj < 4; ++jj) Rm[jj] += (fr == 4 * fq + jj) ? 1.f : 0.f;
      Rm = mfma16(afr(IMG2), bfrag(Rm), Rm);
      Rm = mfma16(afr(IMG1), bfrag(Rm), Rm);
      Rm = mfma16(afr(IMG0), bfrag(Rm), Rm);
      wr_img(TT, Rm, 0);
    }
  };
  f32x4 acc[4];
#pragma unroll
  for (int kt = 0; kt < 4; ++kt) acc[kt] = (f32x4){0.f, 0.f, 0.f, 0.f};
  auto part2 = [&](int c, int set, int iset) {
    char* base = smem + set * SCS_SET;
    const bf16_t (*At)[72] = (const bf16_t (*)[72])(base);
    const bf16_t (*Rt)[72] = (const bf16_t (*)[72])(base + 2304);
    const bf16_t (*BKT)[36] = (const bf16_t (*)[36])(base + 9216);
    const bf16_t* VV = (const bf16_t*)(base + 13824);
    const float* G16 = (const float*)(base + 16896);
    const bf16_t* TT = (const bf16_t*)(smem + SCS_IMG + iset * 3072);
    const bf16_t* ARK = TT + 512;
    const bf16_t* AAK = TT + 1024;
    bf16x8 Sb[2];
#pragma unroll
    for (int s = 0; s < 2; ++s) {
      uint4 t = make_uint4(pack2(acc[2 * s][0], acc[2 * s][1]), pack2(acc[2 * s][2], acc[2 * s][3]),
                           pack2(acc[2 * s + 1][0], acc[2 * s + 1][1]), pack2(acc[2 * s + 1][2], acc[2 * s + 1][3]));
      Sb[s] = __builtin_bit_cast(bf16x8, t);
    }
    const unsigned* vvp = (const unsigned*)&VV[(fq * 64 + w * 16 + fr) * 6];
    const uint2 vv = make_uint2(vvp[0], vvp[1]);
    const bf16x8 Vlow = frag_join(vv, make_uint2(0u, 0u));
    f32x4 Pm = (f32x4){0.f, 0.f, 0.f, 0.f};
#pragma unroll
    for (int s = 0; s < 2; ++s) {
      bf16x8 af = frag_join(*(const uint2*)&At[fr][32 * s + 4 * fq], *(const uint2*)&At[fr][32 * s + 16 + 4 * fq]);
      Pm = mfma16(af, Sb[s], Pm);
    }
    Pm = mfma16(*(const bf16x8*)&AAK[(fr * 4 + fq) * 8], Vlow, Pm);
    const bf16x8 Pb = frag_join(make_uint2(pack2(Pm[0], Pm[1]), pack2(Pm[2], Pm[3])), make_uint2(0u, 0u));
    f32x4 U = mfma16(*(const bf16x8*)&TT[(fr * 4 + fq) * 8], Pb, (f32x4){0.f, 0.f, 0.f, 0.f});
    const bf16x8 UV = frag_join(make_uint2(pack2(U[0], U[1]), pack2(U[2], U[3])), vv);
    f32x4 Yv = (f32x4){0.f, 0.f, 0.f, 0.f};
#pragma unroll
    for (int s = 0; s < 2; ++s) {
      bf16x8 af = frag_join(*(const uint2*)&Rt[fr][32 * s + 4 * fq], *(const uint2*)&Rt[fr][32 * s + 16 + 4 * fq]);
      Yv = mfma16(af, Sb[s], Yv);
    }
    Yv = mfma16(*(const bf16x8*)&ARK[(fr * 4 + fq) * 8], UV, Yv);
    {
      const int p0 = pos0(c);
#pragma unroll
      for (int jj = 0; jj < 4; ++jj) yb[(size_t)(p0 + pstep * (4 * fq + jj)) * INW] = f2bf(Yv[jj]);
    }
#pragma unroll
    for (int kt = 0; kt < 4; ++kt) {
      f32x4 t = mfma16(frag_join(*(const uint2*)&BKT[16 * kt + fr][fq * 8], *(const uint2*)&BKT[16 * kt + fr][fq * 8 + 4]), UV, acc[kt]);
      const float4 g4 = *(const float4*)&G16[16 * kt + 4 * fq];
      t[0] *= g4.x; t[1] *= g4.y; t[2] *= g4.z; t[3] *= g4.w;
      acc[kt] = t;
    }
  };
  __builtin_amdgcn_s_setprio(3);
  Raw r0, r1;
  load_raw(0, r0); load_raw(1, r1);
  stage1(0, r0);
  load_raw(2, r0);
  __syncthreads();
  stage2(0, 0);
  stage1(1, r1);
  load_raw(3, r1);
  __syncthreads();
  int s0 = 0, s1 = 1, s2 = 2;
  auto iter = [&](int c, Raw& rw) {
    if (c + 1 < NCH) stage2(s1, (c + 1) & 1);
    part2(c, s0, c & 1);
    if (c + 2 < NCH) {
      stage1(s2, rw);
      if (c + 4 < NCH) load_raw(c + 4, rw);
    }
    asm volatile("s_waitcnt lgkmcnt(0)" ::: "memory");
    __builtin_amdgcn_s_barrier();
    asm volatile("" ::: "memory");
    const int t = s0; s0 = s1; s1 = s2; s2 = t;
  };
#pragma unroll 1
  for (int c = 0; c < NCH; c += 2) {
    iter(c, r0); iter(c + 1, r1);
  }
  __builtin_amdgcn_s_setprio(0);
}

DEV void ph_rwkv_post(const P& p, int layer) {
  const int lane = tid_() & 63;
  int r0, r1;
  wave_range(r0, r1, NTOK);
  const int ch = 4 * lane;
  float kav[4], rkv[4], lnw[4], lnb[4];
#pragma unroll
  for (int i = 0; i < 4; ++i) {
    kav[i] = p.rw_k_a[layer * 256 + ch + i]; rkv[i] = p.rw_r_k[layer * 256 + ch + i];
    lnw[i] = p.rw_ln_w[layer * 256 + ch + i]; lnb[i] = p.rw_ln_b[layer * 256 + ch + i];
  }
  struct In { uint2 y0, y1, g; uint4 h0, h1, s0, s1; };
  auto ld = [&](int row, In& in) {
    const bf16_t* zr = p.Z + (size_t)row * INW + 768 + ch;
    in.y0 = *(const uint2*)zr; in.y1 = *(const uint2*)(zr + 256);
    const bf16_t* hr = p.H + (size_t)row * D + 4 * ch;
    in.h0 = *(const uint4*)hr; in.h1 = *(const uint4*)(hr + 8);
    const bf16_t* sr = p.SC + (size_t)row * 1024 + 4 * ch;
    in.s0 = *(const uint4*)sr; in.s1 = *(const uint4*)(sr + 8);
    in.g = *(const uint2*)(p.Y + (size_t)row * D + 256 + ch);
  };
  In nx;
  if (r0 < r1) ld(r0, nx);
#pragma unroll 1
  for (int row = r0; row < r1; ++row) {
    const In in = nx;
    if (row + 1 < r1) ld(row + 1, nx);
    float y[4] = {bflo(in.y0.x) + bflo(in.y1.x), bfhi(in.y0.x) + bfhi(in.y1.x), bflo(in.y0.y) + bflo(in.y1.y), bfhi(in.y0.y) + bfhi(in.y1.y)};
    const float mu = row16_sum(y[0] + y[1] + y[2] + y[3]) * (1.f / 64.f);
    float vs = 0.f;
#pragma unroll
    for (int i = 0; i < 4; ++i) { y[i] -= mu; vs += y[i] * y[i]; }
    const float var = row16_sum(vs) * (1.f / 64.f);
    const float rstd = rsqrtf(var + 64e-5f);
    const float r[4] = {bflo(in.h0.x), bflo(in.h0.z), bflo(in.h1.x), bflo(in.h1.z)};
    const float k[4] = {bfhi(in.h0.x), bfhi(in.h0.z), bfhi(in.h1.x), bfhi(in.h1.z)};
    const float v[4] = {bfhi(in.h0.y), bfhi(in.h0.w), bfhi(in.h1.y), bfhi(in.h1.w)};
    const float a0[4] = {bfhi(in.s0.x), bfhi(in.s0.z), bfhi(in.s1.x), bfhi(in.s1.z)};
    const float a1[4] = {bfhi(in.s0.y), bfhi(in.s0.w), bfhi(in.s1.y), bfhi(in.s1.w)};
    float sd = 0.f;
#pragma unroll
    for (int i = 0; i < 4; ++i) {
      const float kd0 = k[i] * (1.f + (a0[i] - 1.f) * kav[i]), kd1 = k[i] * (1.f + (a1[i] - 1.f) * kav[i]);
      sd += r[i] * (kd0 + kd1) * rkv[i];
    }
    sd = row16_sum(sd);
    const float g[4] = {bflo(in.g.x), bfhi(in.g.x), bflo(in.g.y), bfhi(in.g.y)};
    float o[4];
#pragma unroll
    for (int i = 0; i < 4; ++i) {
      const float yn = y[i] * rstd * lnw[i] + lnb[i];
      o[i] = (yn + sd * v[i]) * g[i];
    }
    *(uint2*)(p.Y + (size_t)row * D + 256 + ch) = make_uint2(pack2(o[0], o[1]), pack2(o[2], o[3]));
  }
}

DEV void hyena_pre_unit(const P& p, int layer, int unit) {
  int kind, b, t0, L;
  if (unit < 1024) { kind = 0; b = unit >> 6; t0 = (unit & 63) * 64; L = T; } else { int u = unit - 1024; kind = 1; b = u >> 2; t0 = (u & 3) * 64; L = LC; }
  const int lane = tid_() & 63, wid = tid_() >> 6;
  const int tw = t0 + wid * 16;
  const size_t row0 = (size_t)b * LT + (kind ? 0 : LC);
  const float* cw = p.conv_w + (size_t)layer * 3 * 1536;
  const float* cb = p.conv_b + (size_t)layer * 1536;
  float wx[3][4], wv[3][4], bx[4], bv[4];
#pragma unroll
  for (int i = 0; i < 4; ++i) {
    const int cx = 256 + 4 * lane + i, cv = 512 + 4 * lane + i;
#pragma unroll
    for (int k = 0; k < 3; ++k) { wx[k][i] = cw[k * 1536 + cx]; wv[k][i] = cw[k * 1536 + cv]; }
    bx[i] = cb[cx]; bv[i] = cb[cv];
  }
  uint2 zx[18], zv[18];
#pragma unroll
  for (int i = 0; i < 18; ++i) {
    const int t = tw - 1 + i;
    if (t >= 0 && t < L) {
      const bf16_t* zr = p.Z + (row0 + t) * INW + 256 + 4 * lane;
      zx[i] = *(const uint2*)zr; zv[i] = *(const uint2*)(zr + 256);
    } else { zx[i] = make_uint2(0u, 0u); zv[i] = make_uint2(0u, 0u); }
  }
  float uo[4][16];
#pragma unroll
  for (int i = 0; i < 16; ++i) {
    const float xm[4] = {bflo(zx[i].x), bfhi(zx[i].x), bflo(zx[i].y), bfhi(zx[i].y)};
    const float xc[4] = {bflo(zx[i + 1].x), bfhi(zx[i + 1].x), bflo(zx[i + 1].y), bfhi(zx[i + 1].y)};
    const float xp[4] = {bflo(zx[i + 2].x), bfhi(zx[i + 2].x), bflo(zx[i + 2].y), bfhi(zx[i + 2].y)};
    const float vm[4] = {bflo(zv[i].x), bfhi(zv[i].x), bflo(zv[i].y), bfhi(zv[i].y)};
    const float vc[4] = {bflo(zv[i + 1].x), bfhi(zv[i + 1].x), bflo(zv[i + 1].y), bfhi(zv[i + 1].y)};
    const float vp[4] = {bflo(zv[i + 2].x), bfhi(zv[i + 2].x), bflo(zv[i + 2].y), bfhi(zv[i + 2].y)};
#pragma unroll
    for (int q = 0; q < 4; ++q) {
      const float a = wx[0][q] * xm[q] + wx[1][q] * xc[q] + wx[2][q] * xp[q] + bx[q];
      const float c2 = wv[0][q] * vm[q] + wv[1][q] * vc[q] + wv[2][q] * vp[q] + bv[q];
      uo[q][i] = a * c2;
    }
  }
  bf16_t* ut = kind ? opq(p.UTc) : opq(p.UTl);
#pragma unroll
  for (int q = 0; q < 4; ++q) {
    bf16_t* dst = ut + ((size_t)(4 * lane + q) * 16 + b) * L + tw;
    *(uint4*)dst = pack8(&uo[q][0]);
    *(uint4*)(dst + 8) = pack8(&uo[q][8]);
  }
}

DEV void lds_barrier() {
  asm volatile("s_waitcnt lgkmcnt(0)" ::: "memory");
  __builtin_amdgcn_s_barrier();
  asm volatile("" ::: "memory");
}
DEV void hyena_scale_unit(const P& p, int layer, int u, char* smem) {
  const int kind = u >> 8, c = u & 255, L = kind ? LC : T;
  const float* F = (kind ? opq(p.FC) : opq(p.FL)) + (size_t)c * 2 * L;
  float* red = (float*)smem;
  const int tid = tid_(), lane = tid & 63, wid = tid >> 6;
  float part = 0.f;
  for (int i = tid; i < 2 * L; i += 256) { float fv = F[i]; part += (i != L) ? fv * fv : 0.f; }
  part = wave_sum(part);
  __syncthreads();
  if (lane == 0) red[wid] = part;
  __syncthreads();
  if (tid == 0) p.SSQ[(layer * 2 + kind) * 256 + c] = rsqrtf(((red[0] + red[1]) + (red[2] + red[3])) + 1e-6f);
}
constexpr int HC_CQ = 65 * 144, HC_US = 32 * 272, HC_BUF = HC_CQ + HC_US;
typedef const __attribute__((address_space(1))) float* gfloat_p;
typedef unsigned u32x4_t __attribute__((ext_vector_type(4)));
typedef const __attribute__((address_space(1))) u32x4_t* guint4_p;
DEV void hyena_conv_unit(const P& p, int layer, int unit, char* smem) {
  int kind, c, tb, L;
  if (unit < 4096) { kind = 0; c = unit >> 4; tb = (unit & 15) * 256; L = T; } else { kind = 1; c = unit - 4096; tb = 0; L = LC; }
  const int tid = tid_(), lane = tid & 63, wid = tid >> 6, fr = lane & 15, fq = lane >> 4;
  const gfloat_p F = (gfloat_p)((kind ? opq(p.FC) : opq(p.FL)) + (size_t)c * 2 * L);
  const int nch = L / 256;
  const int bb = tid >> 4, sg0 = tid & 15;
  const guint4_p U = (guint4_p)((kind ? opq(p.UTc) : opq(p.UTl)) + (size_t)c * 16 * L + (size_t)bb * L + 8 * sg0);
  auto ldchunk = [&](int ch, float& f0, float& f1, float& f2, uint4& u0, uint4& u1) {
    const int D0 = tb + 256 - ch * 256;
    auto tap = [&](int n) -> float {
      const int d = D0 - n;
      const bool ok = (d > -L) && (d < L);
      int idx = d >= 0 ? d : L - d;
      idx = ok ? idx : 0;
      return F[idx];
    };
    f0 = tap(tid); f1 = tap(tid + 256); f2 = tap(tid < 8 ? tid + 512 : 100000);
    const u32x4_t w0 = U[ch * 32], w1 = U[ch * 32 + 16];
    u0 = make_uint4(w0.x, w0.y, w0.z, w0.w); u1 = make_uint4(w1.x, w1.y, w1.z, w1.w);
  };
  const float scale = p.SSQ[(layer * 2 + kind) * 256 + c];
  float fa0, fa1, fa2, fb0, fb1, fb2, fc0, fc1, fc2;
  uint4 ua0, ua1, ub0, ub1, uc0, uc1;
  const int lastc = nch - 1;
  ldchunk(0, fa0, fa1, fa2, ua0, ua1);
  ldchunk(min(1, lastc), fb0, fb1, fb2, ub0, ub1);
  ldchunk(min(2, lastc), fc0, fc1, fc2, uc0, uc1);
  auto stchunk = [&](int ch, float f0, float f1, float f2, const uint4& u0, const uint4& u1) {
    const int buf = ch & 1;
    bf16_t* Cq = (bf16_t*)(smem + buf * HC_BUF);
    char* Us = smem + buf * HC_BUF + HC_CQ;
    const int d0 = tb + 256 - ch * 256 - tid, d1 = d0 - 256, d2 = d0 - 512;
    const bf16_t h0 = f2bf((d0 > -L && d0 < L) ? f0 * scale : 0.f), h1 = f2bf((d1 > -L && d1 < L) ? f1 * scale : 0.f);
    const bf16_t h2 = f2bf((d2 > -L && d2 < L) ? f2 * scale : 0.f);
#pragma unroll
    for (int rho = 0; rho < 8; ++rho) {
      int m = tid + rho;
      Cq[(m >> 3) * 72 + rho * 8 + (m & 7)] = h0;
      m = tid + 256 + rho;
      if (m < 520) Cq[(m >> 3) * 72 + rho * 8 + (m & 7)] = h1;
      m = tid + 512 + rho;
      if (tid < 8 && m < 520) Cq[(m >> 3) * 72 + rho * 8 + (m & 7)] = h2;
    }
    if (tid < 8) {
#pragma unroll
      for (int rho = 1; rho < 8; ++rho) if (tid < rho) Cq[rho * 8 + tid] = 0;
    }
    *(uint4*)(Us + sg0 * 272 + bb * 16) = u0;
    *(uint4*)(Us + (sg0 + 16) * 272 + bb * 16) = u1;
  };
  f32x4 acc[4];
#pragma unroll
  for (int m = 0; m < 4; ++m) acc[m] = (f32x4){0.f, 0.f, 0.f, 0.f};
  const int a0 = (32 - 8 * wid + fq - (fr >> 3)) * 144 + (fr & 7) * 16;
  auto compute = [&](int buf) {
    const char* Cq = smem + buf * HC_BUF + a0;
    const char* Us = smem + buf * HC_BUF + HC_CQ + fq * 272 + fr * 16;
    bf16x8 fa[4];
#pragma unroll
    for (int m = 0; m < 4; ++m) fa[m] = *(const bf16x8*)(Cq - m * 288);
#pragma unroll
    for (int kk = 0; kk < 8; ++kk) {
      const bf16x8 bf = *(const bf16x8*)(Us + kk * 4 * 272);
      if (kk > 0) {
        fa[3] = fa[1]; fa[2] = fa[0];
        fa[1] = *(const bf16x8*)(Cq + (2 * kk - 1) * 288);
        fa[0] = *(const bf16x8*)(Cq + (2 * kk) * 288);
      }
#pragma unroll
      for (int m = 0; m < 4; ++m) acc[m] = mfma16(fa[m], bf, acc[m]);
    }
  };
  __syncthreads();
  int ch = 0;
#pragma unroll 1
  for (; ch + 3 <= lastc; ch += 3) {
    stchunk(ch, fa0, fa1, fa2, ua0, ua1);
    lds_barrier();
    ldchunk(min(ch + 3, lastc), fa0, fa1, fa2, ua0, ua1);
    compute(ch & 1);
    stchunk(ch + 1, fb0, fb1, fb2, ub0, ub1);
    lds_barrier();
    ldchunk(min(ch + 4, lastc), fb0, fb1, fb2, ub0, ub1);
    compute((ch + 1) & 1);
    stchunk(ch + 2, fc0, fc1, fc2, uc0, uc1);
    lds_barrier();
    ldchunk(min(ch + 5, lastc), fc0, fc1, fc2, uc0, uc1);
    compute(ch & 1);
  }
  stchunk(ch, fa0, fa1, fa2, ua0, ua1);
  lds_barrier();
  compute(ch & 1);
  bf16_t* Yt = (kind ? opq(p.YTc) : opq(p.YTl)) + ((size_t)c * 16 + fr) * L + tb;
#pragma unroll
  for (int m = 0; m < 4; ++m) {
    int t = (wid * 4 + m) * 16 + fq * 4;
    *(uint2*)(Yt + t) = make_uint2(pack2(acc[m][0], acc[m][1]), pack2(acc[m][2], acc[m][3]));
  }
}

DEV void hyena_post_unit(const P& p, int layer, int unit, char* smem) {
  (void)smem;
  int kind, b, t0, L;
  if (unit < 1024) { kind = 0; b = unit >> 6; t0 = (unit & 63) * 64; L = T; } else { int u = unit - 1024; kind = 1; b = u >> 2; t0 = (u & 3) * 64; L = LC; }
  const int lane = tid_() & 63, wid = tid_() >> 6;
  const int tw = t0 + wid * 16;
  const size_t row0 = (size_t)b * LT + (kind ? 0 : LC);
  const float* cw = p.conv_w + (size_t)layer * 3 * 1536;
  float w0[3][4], b0[4], bias[4], og[4];
#pragma unroll
  for (int i = 0; i < 4; ++i) {
    const int c = 4 * lane + i;
#pragma unroll
    for (int k = 0; k < 3; ++k) w0[k][i] = cw[k * 1536 + c];
    b0[i] = p.conv_b[layer * 1536 + c]; bias[i] = p.hy_bias[layer * 256 + c]; og[i] = p.hy_out_g[layer * 256 + c];
  }
  uint2 zx[18];
#pragma unroll
  for (int i = 0; i < 18; ++i) {
    const int t = tw - 1 + i;
    zx[i] = (t >= 0 && t < L) ? *(const uint2*)(p.Z + (row0 + t) * INW + 4 * lane) : make_uint2(0u, 0u);
  }
  const bf16_t* ytb = kind ? opq(p.YTc) : opq(p.YTl);
  const bf16_t* utb = kind ? opq(p.UTc) : opq(p.UTl);
  float o[4][16];
#pragma unroll
  for (int q = 0; q < 4; ++q) {
    const size_t off = ((size_t)(4 * lane + q) * 16 + b) * L + tw;
    float yv[16], uv[16];
    { uint4 a0 = *(const uint4*)(ytb + off), a1 = *(const uint4*)(ytb + off + 8); unpack8(a0, yv); unpack8(a1, yv + 8); }
    { uint4 a0 = *(const uint4*)(utb + off), a1 = *(const uint4*)(utb + off + 8); unpack8(a0, uv); unpack8(a1, uv + 8); }
#pragma unroll
    for (int i = 0; i < 16; ++i) o[q][i] = yv[i] + uv[i] * bias[q];
  }
#pragma unroll
  for (int i = 0; i < 16; ++i) {
    const float xm[4] = {bflo(zx[i].x), bfhi(zx[i].x), bflo(zx[i].y), bfhi(zx[i].y)};
    const float xc[4] = {bflo(zx[i + 1].x), bfhi(zx[i + 1].x), bflo(zx[i + 1].y), bfhi(zx[i + 1].y)};
    const float xp[4] = {bflo(zx[i + 2].x), bfhi(zx[i + 2].x), bflo(zx[i + 2].y), bfhi(zx[i + 2].y)};
    float ov[4], ss = 0.f;
#pragma unroll
    for (int q = 0; q < 4; ++q) {
      const float x0 = w0[0][q] * xm[q] + w0[1][q] * xc[q] + w0[2][q] * xp[q] + b0[q];
      ov[q] = bf2f(f2bf(x0 * o[q][i]));
      ss += ov[q] * ov[q];
    }
    ss = wave_sum(ss);
    const float rstd = rsqrtf(ss * (1.f / 256.f) + 1e-6f);
    *(uint2*)(p.Y + (row0 + tw + i) * D + 4 * lane) = make_uint2(pack2(ov[0] * rstd * og[0], ov[1] * rstd * og[1]), pack2(ov[2] * rstd * og[2], ov[3] * rstd * og[3]));
  }
}

DEV void attn_unit(const P& p, int layer, int unit, char* smem) {
  const bool isctx = unit >= 4096;
  int b, qb, hq;
  if (!isctx) { b = unit >> 8; qb = (unit >> 3) & 31; hq = unit & 7; } else { int u = unit - 4096; b = u >> 4; qb = (u >> 3) & 1; hq = u & 7; }
  const int g = hq >> 2;
  const int tid = tid_(), lane = tid & 63, wid = tid >> 6, qn = lane & 31, hh = lane >> 5;
  const int qpos = qb * 128 + wid * 32 + qn;
  const size_t qrow = (size_t)b * LT + (isctx ? qpos : LC + qpos);
  const bf16_t* qptr = p.Z + qrow * INW + 1920 + hq * 64;
  bf16x8 qf[4];
#pragma unroll
  for (int s = 0; s < 4; ++s) qf[s] = *(const bf16x8*)(qptr + 16 * s + 8 * hh);
  const float c2 = 0.125f * 1.4426950408889634f;
  const int q0w = qb * 128 + wid * 32;
  float m_run = p.attn_sink[layer * 8 + hq] * 1.4426950408889634f, l_run = 1.f;
  f32x16 o0, o1;
#pragma unroll
  for (int i = 0; i < 16; ++i) { o0[i] = 0.f; o1[i] = 0.f; }
  typedef bf16_t KTile[64][72];
  typedef bf16_t VTile[64][68];
  KTile* Ks = (KTile*)smem;
  VTile* Vt = (VTile*)(smem + 18432);
  const int ntl = isctx ? 0 : 6;
  const int ntiles = ntl + 4;
  const int skey = tid >> 3, sseg = tid & 7;
  const bf16_t* kvbase = p.Z + (size_t)b * LT * INW + 1920 + 512 + g * 64 + sseg * 8;
  auto ldtile = [&](int kt, uint4& rk0, uint4& rk1, uint4& rv0, uint4& rv1) {
    const bool ctxk = kt >= ntl;
    const int kbase = ctxk ? (kt - ntl) * 64 : qb * 128 - 128 + kt * 64;
    int kp0 = kbase + skey, kp1 = kp0 + 32;
    if (!ctxk) { kp0 = min(max(kp0, 0), T - 1) + LC; kp1 = min(max(kp1, 0), T - 1) + LC; }
    const bf16_t* s0 = kvbase + (size_t)kp0 * INW;
    const bf16_t* s1 = kvbase + (size_t)kp1 * INW;
    rk0 = *(const uint4*)s0; rv0 = *(const uint4*)(s0 + 128);
    rk1 = *(const uint4*)s1; rv1 = *(const uint4*)(s1 + 128);
  };
  auto sttile = [&](int buf, const uint4& rk0, const uint4& rk1, const uint4& rv0, const uint4& rv1) {
    *(uint4*)&Ks[buf][skey][sseg * 8] = rk0;
    *(uint4*)&Ks[buf][skey + 32][sseg * 8] = rk1;
    bf16_t (*vt)[68] = Vt[buf];
    vt[sseg * 8 + 0][skey] = (bf16_t)(rv0.x & 0xFFFF); vt[sseg * 8 + 1][skey] = (bf16_t)(rv0.x >> 16);
    vt[sseg * 8 + 2][skey] = (bf16_t)(rv0.y & 0xFFFF); vt[sseg * 8 + 3][skey] = (bf16_t)(rv0.y >> 16);
    vt[sseg * 8 + 4][skey] = (bf16_t)(rv0.z & 0xFFFF); vt[sseg * 8 + 5][skey] = (bf16_t)(rv0.z >> 16);
    vt[sseg * 8 + 6][skey] = (bf16_t)(rv0.w & 0xFFFF); vt[sseg * 8 + 7][skey] = (bf16_t)(rv0.w >> 16);
    vt[sseg * 8 + 0][skey + 32] = (bf16_t)(rv1.x & 0xFFFF); vt[sseg * 8 + 1][skey + 32] = (bf16_t)(rv1.x >> 16);
    vt[sseg * 8 + 2][skey + 32] = (bf16_t)(rv1.y & 0xFFFF); vt[sseg * 8 + 3][skey + 32] = (bf16_t)(rv1.y >> 16);
    vt[sseg * 8 + 4][skey + 32] = (bf16_t)(rv1.z & 0xFFFF); vt[sseg * 8 + 5][skey + 32] = (bf16_t)(rv1.z >> 16);
    vt[sseg * 8 + 6][skey + 32] = (bf16_t)(rv1.w & 0xFFFF); vt[sseg * 8 + 7][skey + 32] = (bf16_t)(rv1.w >> 16);
  };
  auto edge_mask = [&](f32x16& sv, int kb2) {
    if (kb2 < q0w - 96 || kb2 > q0w + 96) {
#pragma unroll
      for (int rg = 0; rg < 16; ++rg) {
        const int kp = kb2 + (rg & 3) + 8 * (rg >> 2) + 4 * hh;
        const int dl = qpos - kp;
        sv[rg] = ((dl <= 128) && (dl >= -128)) ? sv[rg] : -1e30f;
      }
    }
  };
  auto max16 = [&](const f32x16& sv) -> float {
    float mt = fmaxf(fmaxf(sv[0], sv[1]), sv[2]);
#pragma unroll
    for (int rg = 3; rg < 15; rg += 2) mt = fmaxf(fmaxf(mt, sv[rg]), sv[rg + 1]);
    return fmaxf(mt, sv[15]);
  };
  auto new_max = [&](float mt) {
    mt = fmaxf(mt, __shfl_xor(mt, 32));
    const float m_new = fmaxf(m_run, mt * c2);
    if (__ballot(m_new > m_run) != 0ull) {
      const float corr = __builtin_amdgcn_exp2f(m_run - m_new);
      l_run *= corr;
      m_run = m_new;
#pragma unroll
      for (int i = 0; i < 16; ++i) { o0[i] *= corr; o1[i] *= corr; }
    }
  };
  auto exp16 = [&](f32x16& sv) -> float {
    float ps = 0.f;
#pragma unroll
    for (int rg = 0; rg < 16; ++rg) { const float pv = __builtin_amdgcn_exp2f(__builtin_fmaf(sv[rg], c2, -m_run)); sv[rg] = pv; ps += pv; }
    return ps;
  };
  auto pv_acc = [&](int buf, int sub, const f32x16& sv) {
#pragma unroll
    for (int sp = 0; sp < 2; ++sp) {
      const uint4 pw = make_uint4(pack2(sv[8 * sp], sv[8 * sp + 1]), pack2(sv[8 * sp + 2], sv[8 * sp + 3]), pack2(sv[8 * sp + 4], sv[8 * sp + 5]), pack2(sv[8 * sp + 6], sv[8 * sp + 7]));
      const bf16x8 pf = __builtin_bit_cast(bf16x8, pw);
      const int kc = sub * 32 + 16 * sp + 4 * hh;
      uint2 va = *(const uint2*)&Vt[buf][qn][kc], vb = *(const uint2*)&Vt[buf][qn][kc + 8];
      uint2 vc = *(const uint2*)&Vt[buf][32 + qn][kc], vd = *(const uint2*)&Vt[buf][32 + qn][kc + 8];
      uint4 w0 = make_uint4(va.x, va.y, vb.x, vb.y), w1 = make_uint4(vc.x, vc.y, vd.x, vd.y);
      bf16x8 v0 = __builtin_bit_cast(bf16x8, w0), v1 = __builtin_bit_cast(bf16x8, w1);
      o0 = mfma32(v0, pf, o0);
      o1 = mfma32(v1, pf, o1);
    }
  };
  auto compute = [&](int kt) {
    const int buf = kt & 1;
    const bool ctxk = kt >= ntl;
    const int kbase = ctxk ? (kt - ntl) * 64 : qb * 128 - 128 + kt * 64;
    bool n0 = true, n1 = true;
    if (!ctxk) {
      const int k1 = kbase + 32;
      n0 = !(kbase + 31 < q0w - 128 || kbase > q0w + 31 + 128 || kbase + 31 < 0 || kbase >= T);
      n1 = !(k1 + 31 < q0w - 128 || k1 > q0w + 31 + 128 || k1 + 31 < 0 || k1 >= T);
    }
    if (n0 && n1) {
      f32x16 s0, s1;
#pragma unroll
      for (int i = 0; i < 16; ++i) { s0[i] = 0.f; s1[i] = 0.f; }
#pragma unroll
      for (int ks = 0; ks < 4; ++ks) {
        const bf16x8 kf0 = *(const bf16x8*)&Ks[buf][qn][16 * ks + 8 * hh];
        const bf16x8 kf1 = *(const bf16x8*)&Ks[buf][32 + qn][16 * ks + 8 * hh];
        s0 = mfma32(kf0, qf[ks], s0);
        s1 = mfma32(kf1, qf[ks], s1);
      }
      if (!ctxk) { edge_mask(s0, kbase); edge_mask(s1, kbase + 32); }
      new_max(fmaxf(max16(s0), max16(s1)));
      float ps = exp16(s0) + exp16(s1);
      ps += __shfl_xor(ps, 32);
      l_run += ps;
      pv_acc(buf, 0, s0);
      pv_acc(buf, 1, s1);
    } else if (n0 || n1) {
      const int sub = n0 ? 0 : 1;
      f32x16 sv;
#pragma unroll
      for (int i = 0; i < 16; ++i) sv[i] = 0.f;
#pragma unroll
      for (int ks = 0; ks < 4; ++ks) {
        const bf16x8 kf = *(const bf16x8*)&Ks[buf][sub * 32 + qn][16 * ks + 8 * hh];
        sv = mfma32(kf, qf[ks], sv);
      }
      if (!ctxk) edge_mask(sv, kbase + sub * 32);
      new_max(max16(sv));
      float ps = exp16(sv);
      ps += __shfl_xor(ps, 32);
      l_run += ps;
      pv_acc(buf, sub, sv);
    }
  };
  uint4 ak0, ak1, av0, av1, bk0, bk1, bv0, bv1;
  ldtile(0, ak0, ak1, av0, av1);
  ldtile(1, bk0, bk1, bv0, bv1);
  __syncthreads();
#pragma unroll 1
  for (int kt = 0; kt < ntiles; kt += 2) {
    sttile(0, ak0, ak1, av0, av1);
    lds_barrier();
    ldtile(min(kt + 2, ntiles - 1), ak0, ak1, av0, av1);
    compute(kt);
    sttile(1, bk0, bk1, bv0, bv1);
    lds_barrier();
    ldtile(min(kt + 3, ntiles - 1), bk0, bk1, bv0, bv1);
    compute(kt + 1);
  }
  __syncthreads();
  const float inv = 1.f / l_run;
  bf16_t* optr = p.Y + qrow * D + 512 + hq * 64;
#pragma unroll
  for (int rg = 0; rg < 4; ++rg) {
    int d0 = 8 * rg + 4 * hh;
    *(uint2*)(optr + d0) = make_uint2(pack2(o0[4 * rg] * inv, o0[4 * rg + 1] * inv), pack2(o0[4 * rg + 2] * inv, o0[4 * rg + 3] * inv));
    *(uint2*)(optr + 32 + d0) = make_uint2(pack2(o1[4 * rg] * inv, o1[4 * rg + 1] * inv), pack2(o1[4 * rg + 2] * inv, o1[4 * rg + 3] * inv));
  }
}

DEV void ph_attn_post(const P& p, int layer) {
  const int lane = tid_() & 63;
  int r0, r1;
  wave_range(r0, r1, NTOK);
  float gv[8];
#pragma unroll
  for (int i = 0; i < 8; ++i) gv[i] = p.at_out_g[layer * 512 + 8 * lane + i];
  uint4 nx = make_uint4(0, 0, 0, 0);
  if (r0 < r1) nx = *(const uint4*)(p.Y + (size_t)r0 * D + 512 + 8 * lane);
#pragma unroll 1
  for (int row = r0; row < r1; ++row) {
    const uint4 u = nx;
    if (row + 1 < r1) nx = *(const uint4*)(p.Y + (size_t)(row + 1) * D + 512 + 8 * lane);
    float v[8];
    unpack8(u, v);
    float ss = 0.f;
#pragma unroll
    for (int i = 0; i < 8; ++i) ss += v[i] * v[i];
    ss = wave_sum(ss);
    const float rstd = rsqrtf(ss * (1.f / 512.f) + 1e-6f);
#pragma unroll
    for (int i = 0; i < 8; ++i) {
      v[i] = v[i] * rstd * gv[i];
    }
    *(uint4*)(p.Y + (size_t)row * D + 512 + 8 * lane) = pack8(v);
  }
}

struct Epi2 {
  const P& p; int layer, row0, col0;
  uint4 xq[8];
  DEV void pre(int wr, int wc, int lane) {
#pragma unroll
    for (int i = 0; i < 8; ++i) {
      const int rl = i * 8 + (lane >> 3), ch = lane & 7;
      xq[i] = *(const uint4*)(p.X + (size_t)(row0 + wr * 64 + rl) * D + col0 + wc * 64 + ch * 8);
    }
  }
  DEV void operator()(f32x4 (&acc)[4][4], int wr, int wc, int fr, int fq, char* smem) const {
    const int b = row0 / LT, pp = row0 % LT;
    const int mr = pp < LC ? 16 : b;
    const float* g1 = p.modv + ((size_t)layer * 17 + mr) * 6144 + 2048 + col0 + wc * 64;
#pragma unroll
    for (int n = 0; n < 4; ++n) {
      const float4 gv = *(const float4*)(g1 + n * 16 + 4 * fq);
#pragma unroll
      for (int m = 0; m < 4; ++m) { acc[m][n][0] *= gv.x; acc[m][n][1] *= gv.y; acc[m][n][2] *= gv.z; acc[m][n][3] *= gv.w; }
    }
    const int wid = wr * 2 + wc, lane = fq * 16 + fr;
    stage_tile_bf16(acc, smem, wid, fr, fq);
    const bf16_t (*t)[72] = (const bf16_t (*)[72])(smem + wid * 9216);
#pragma unroll
    for (int i = 0; i < 8; ++i) {
      const int rl = i * 8 + (lane >> 3), ch = lane & 7;
      bf16_t* xp = p.X + (size_t)(row0 + wr * 64 + rl) * D + col0 + wc * 64 + ch * 8;
      float xv[8], dv[8];
      uint4 xu = xq[i], du = *(const uint4*)&t[rl][ch * 8];
      unpack8(xu, xv); unpack8(du, dv);
#pragma unroll
      for (int q = 0; q < 8; ++q) xv[q] += dv[q];
      *(uint4*)xp = pack8(xv);
    }
  }
};
DEV void ph_gemm2(const P& p, int layer, char* smem) {
  int rt, ct;
  for (int it = 0; gemm_unit(it, 8, rt, ct); ++it) {
    Epi2 epi{p, layer, rt * 128, ct * 128};
    gemm_tile(p.Y + (size_t)rt * 128 * D, D, p.W2t + (size_t)ct * 128 * D, D, D, smem, epi);
  }
}

DEV void ph_peerconv(const P& p, int layer) {
  const int gw = (bid_() * 256 + tid_()) >> 6, nw = gridDim.x * 4, lane = tid_() & 63;
  const float* su = opq(p.peer_u) + (size_t)layer * 16384 * 1024;
  const float* sv = opq(p.peer_v) + (size_t)layer * 16384 * 1024;
  unsigned char* pu = opq(p.PU); unsigned char* pv = opq(p.PV);
  float* psu = opq(p.PSU); float* psv = opq(p.PSV);
  auto ldrow = [&](int r, float4& a0, float4& a1, float4& a2, float4& a3) {
    const float* src = ((r >= 16384) ? sv : su) + (size_t)(r & 16383) * 1024 + 16 * lane;
    a0 = *(const float4*)src; a1 = *(const float4*)(src + 4); a2 = *(const float4*)(src + 8); a3 = *(const float4*)(src + 12);
  };
  float4 n0 = make_float4(0, 0, 0, 0), n1 = n0, n2 = n0, n3 = n0;
  if (gw < 32768) ldrow(gw, n0, n1, n2, n3);
#pragma unroll 1
  for (int r = gw; r < 32768; r += nw) {
    const bool isv = r >= 16384;
    const int e = r & 16383;
    const float4 f0 = n0, f1 = n1, f2 = n2, f3 = n3;
    if (r + nw < 32768) ldrow(r + nw, n0, n1, n2, n3);
    float am = fmaxf(fmaxf(fmaxf(fabsf(f0.x), fabsf(f0.y)), fmaxf(fabsf(f0.z), fabsf(f0.w))), fmaxf(fmaxf(fabsf(f1.x), fabsf(f1.y)), fmaxf(fabsf(f1.z), fabsf(f1.w))));
    am = fmaxf(am, fmaxf(fmaxf(fmaxf(fabsf(f2.x), fabsf(f2.y)), fmaxf(fabsf(f2.z), fabsf(f2.w))), fmaxf(fmaxf(fabsf(f3.x), fabsf(f3.y)), fmaxf(fabsf(f3.z), fabsf(f3.w)))));
    am = wave_max(am);
    int w0, w1, w2, w3;
    float inv;
    if (isv) {
      const float sc = am > 0.f ? 224.f / am : 1.f;
      inv = am > 0.f ? am * (1.f / 224.f) : 1.f;
      w0 = __builtin_amdgcn_cvt_pk_fp8_f32(f0.x * sc, f0.y * sc, 0, false); w0 = __builtin_amdgcn_cvt_pk_fp8_f32(f0.z * sc, f0.w * sc, w0, true);
      w1 = __builtin_amdgcn_cvt_pk_fp8_f32(f1.x * sc, f1.y * sc, 0, false); w1 = __builtin_amdgcn_cvt_pk_fp8_f32(f1.z * sc, f1.w * sc, w1, true);
      w2 = __builtin_amdgcn_cvt_pk_fp8_f32(f2.x * sc, f2.y * sc, 0, false); w2 = __builtin_amdgcn_cvt_pk_fp8_f32(f2.z * sc, f2.w * sc, w2, true);
      w3 = __builtin_amdgcn_cvt_pk_fp8_f32(f3.x * sc, f3.y * sc, 0, false); w3 = __builtin_amdgcn_cvt_pk_fp8_f32(f3.z * sc, f3.w * sc, w3, true);
    } else {
      const float sc = am > 0.f ? 127.f / am : 1.f;
      inv = am > 0.f ? am * (1.f / 127.f) : 1.f;
      w0 = pack_i8(f0.x * sc, f0.y * sc, f0.z * sc, f0.w * sc); w1 = pack_i8(f1.x * sc, f1.y * sc, f1.z * sc, f1.w * sc);
      w2 = pack_i8(f2.x * sc, f2.y * sc, f2.z * sc, f2.w * sc); w3 = pack_i8(f3.x * sc, f3.y * sc, f3.z * sc, f3.w * sc);
    }
    *(uint4*)((isv ? pv : pu) + (size_t)(lane >> 3) * PSLICE + (size_t)e * 128 + 16 * (lane & 7)) = make_uint4((unsigned)w0, (unsigned)w1, (unsigned)w2, (unsigned)w3);
    if (lane == 0) (isv ? psv : psu)[e] = inv;
  }
}
DEV void unpack16_fp8x2(const uint4& u, f32x2* f) {
  f[0] = __builtin_amdgcn_cvt_pk_f32_fp8((int)u.x, false); f[1] = __builtin_amdgcn_cvt_pk_f32_fp8((int)u.x, true);
  f[2] = __builtin_amdgcn_cvt_pk_f32_fp8((int)u.y, false); f[3] = __builtin_amdgcn_cvt_pk_f32_fp8((int)u.y, true);
  f[4] = __builtin_amdgcn_cvt_pk_f32_fp8((int)u.z, false); f[5] = __builtin_amdgcn_cvt_pk_f32_fp8((int)u.z, true);
  f[6] = __builtin_amdgcn_cvt_pk_f32_fp8((int)u.w, false); f[7] = __builtin_amdgcn_cvt_pk_f32_fp8((int)u.w, true);
}

DEV void bitonic_sort16_desc(float (&v)[16]) {
#pragma unroll
  for (int k = 2; k <= 16; k <<= 1)
#pragma unroll
    for (int j = k >> 1; j >= 1; j >>= 1)
#pragma unroll
      for (int i = 0; i < 16; ++i) {
        const int l = i ^ j;
        if (l > i) {
          const float hi = fmaxf(v[i], v[l]), lo = fminf(v[i], v[l]);
          if ((i & k) == 0) { v[i] = hi; v[l] = lo; } else { v[i] = lo; v[l] = hi; }
        }
      }
}
DEV void peer_cand_ij(int c, int& ci, int& cj) {
  if (c < 16) { ci = 0; cj = c; } else if (c < 24) { ci = 1; cj = c - 16; } else if (c < 29) { ci = 2; cj = c - 24; }
  else if (c < 33) { ci = 3; cj = c - 29; } else if (c < 36) { ci = 4; cj = c - 33; } else if (c < 38) { ci = 5; cj = c - 36; }
  else if (c < 40) { ci = 6; cj = c - 38; } else if (c < 42) { ci = 7; cj = c - 40; } else { ci = (c - 42 + 8) & 15; cj = 0; }
}
DEV void ce_desc(float& a, float& b) { const float hi = fmaxf(a, b), lo = fminf(a, b); a = hi; b = lo; }
DEV void bitonic_merge16_desc(float (&v)[16]) {
#pragma unroll
  for (int d = 8; d >= 1; d >>= 1)
#pragma unroll
    for (int i = 0; i < 16; ++i)
      if ((i & d) == 0) ce_desc(v[i], v[i + d]);
}
template <int N>
DEV void merge_trunc16(float (&T)[16], const float (&B)[N]) {
#pragma unroll
  for (int k = 0; k < N; ++k) T[15 - k] = fmaxf(T[15 - k], B[k]);
  bitonic_merge16_desc(T);
}
DEV float pk_sum(float a, float b, int i, int j) {
  return __uint_as_float((__float_as_uint(a + b) & ~255u) | (unsigned)(255 - (i * 16 + j)));
}
template <int S>
struct Epi3K {
  const P& p; int row0, head; float (&keep)[2][16];
  DEV void pre(int, int, int) {}
  DEV void operator()(f32x4 (&acc)[4][4], int wr, int wc, int fr, int fq, char* smem) const {
    float* sc = (float*)smem;
    float* L1s = (float*)(smem + 36864);
    float* L2s = (float*)(smem + 47104);
    const int tid = tid_();
#pragma unroll
    for (int pass = 0; pass < 2; ++pass) {
      __syncthreads();
      if (wr == pass) {
#pragma unroll
        for (int m = 0; m < 4; ++m)
#pragma unroll
          for (int n = 0; n < 4; ++n)
#pragma unroll
            for (int j = 0; j < 4; ++j) {
              int rl = m * 16 + fr, col = wc * 64 + n * 16 + 4 * fq + j;
              unsigned bits = (__float_as_uint(acc[m][n][j]) & ~127u) | (unsigned)col;
              sc[rl * 133 + (col >> 5) * 33 + (col & 31)] = __uint_as_float(bits);
            }
      }
      __syncthreads();
      const int rl = tid >> 2, q = tid & 3;
      const float* src = sc + rl * 133 + q * 33;
      float Ls[16], Hs[16];
#pragma unroll
      for (int i = 0; i < 16; ++i) { Ls[i] = src[i]; Hs[i] = src[16 + i]; }
      bitonic_sort16_desc(Ls);
      bitonic_sort16_desc(Hs);
#pragma unroll
      for (int i = 0; i < 16; ++i) Ls[i] = fmaxf(Ls[i], Hs[15 - i]);
#pragma unroll
      for (int d = 8; d >= 1; d >>= 1)
#pragma unroll
        for (int i = 0; i < 16; ++i)
          if ((i & d) == 0) { float hi = fmaxf(Ls[i], Ls[i + d]), lo = fminf(Ls[i], Ls[i + d]); Ls[i] = hi; Ls[i + d] = lo; }
      float Cs[16];
#pragma unroll
      for (int i = 0; i < 16; ++i) Cs[i] = fmaxf(Ls[i], dppself<0xB1, 0xF>(Ls[15 - i]));
#pragma unroll
      for (int d = 8; d >= 1; d >>= 1)
#pragma unroll
        for (int i = 0; i < 16; ++i)
          if ((i & d) == 0) { float hi = fmaxf(Cs[i], Cs[i + d]), lo = fminf(Cs[i], Cs[i + d]); Cs[i] = hi; Cs[i + d] = lo; }
      float Ds[16];
#pragma unroll
      for (int i = 0; i < 16; ++i) Ds[i] = fmaxf(Cs[i], dppself<0x4E, 0xF>(Cs[15 - i]));
#pragma unroll
      for (int d = 8; d >= 1; d >>= 1)
#pragma unroll
        for (int i = 0; i < 16; ++i)
          if ((i & d) == 0) { float hi = fmaxf(Ds[i], Ds[i + d]), lo = fminf(Ds[i], Ds[i + d]); Ds[i] = hi; Ds[i + d] = lo; }
      if (S == 0) {
#pragma unroll
        for (int i = 0; i < 16; ++i) keep[pass][i] = Ds[i];
      } else if (q == 0) {
        float* d1 = L1s + (pass * 64 + rl) * 20;
        float* d2 = L2s + (pass * 64 + rl) * 20;
#pragma unroll
        for (int i = 0; i < 4; ++i) {
          *(float4*)(d1 + 4 * i) = make_float4(keep[pass][4 * i], keep[pass][4 * i + 1], keep[pass][4 * i + 2], keep[pass][4 * i + 3]);
          *(float4*)(d2 + 4 * i) = make_float4(Ds[4 * i], Ds[4 * i + 1], Ds[4 * i + 2], Ds[4 * i + 3]);
        }
      }
    }
    if (S == 1) {
      __syncthreads();
      if (tid < 128) {
        const int row = tid;
        float A[16], Bv[16];
        const float* l1 = L1s + row * 20;
        const float* l2 = L2s + row * 20;
#pragma unroll
        for (int i = 0; i < 4; ++i) {
          const float4 x = *(const float4*)(l1 + 4 * i), y = *(const float4*)(l2 + 4 * i);
          A[4 * i] = x.x; A[4 * i + 1] = x.y; A[4 * i + 2] = x.z; A[4 * i + 3] = x.w;
          Bv[4 * i] = y.x; Bv[4 * i + 1] = y.y; Bv[4 * i + 2] = y.z; Bv[4 * i + 3] = y.w;
        }
        float T[16];
#pragma unroll
        for (int j = 0; j < 16; ++j) T[j] = pk_sum(A[0], Bv[j], 0, j);
        {
          float C0[15];
#pragma unroll
          for (int i = 1; i < 16; ++i) C0[i - 1] = pk_sum(A[i], Bv[0], i, 0);
          merge_trunc16(T, C0);
        }
        {
          float R1[7];
#pragma unroll
          for (int j = 1; j < 8; ++j) R1[j - 1] = pk_sum(A[1], Bv[j], 1, j);
          merge_trunc16(T, R1);
        }
        {
          float C1[6];
#pragma unroll
          for (int i = 2; i < 8; ++i) C1[i - 2] = pk_sum(A[i], Bv[1], i, 1);
          merge_trunc16(T, C1);
        }
        {
          float R2[3];
#pragma unroll
          for (int j = 2; j < 5; ++j) R2[j - 2] = pk_sum(A[2], Bv[j], 2, j);
          merge_trunc16(T, R2);
        }
        {
          float C2[2] = {pk_sum(A[3], Bv[2], 3, 2), pk_sum(A[4], Bv[2], 4, 2)};
          merge_trunc16(T, C2);
        }
        {
          float X3[1] = {pk_sum(A[3], Bv[3], 3, 3)};
          merge_trunc16(T, X3);
        }
        const float mx = T[0];
        float ex[16], sm = 0.f;
        unsigned ee[16];
#pragma unroll
        for (int k = 0; k < 16; ++k) {
          const unsigned tg = 255u - (__float_as_uint(T[k]) & 255u);
          const unsigned k1 = __float_as_uint(l1[tg >> 4]) & 127u, k2 = __float_as_uint(l2[tg & 15u]) & 127u;
          ee[k] = k1 * 128u + k2;
          ex[k] = __expf(T[k] - mx);
          sm += ex[k];
        }
        const float rs = 1.f / sm;
        const size_t o = (size_t)(row0 + row) * 128 + head * 16;
        uint4* elp = (uint4*)(p.EL + o);
        elp[0] = make_uint4(ee[0] | (ee[1] << 16), ee[2] | (ee[3] << 16), ee[4] | (ee[5] << 16), ee[6] | (ee[7] << 16));
        elp[1] = make_uint4(ee[8] | (ee[9] << 16), ee[10] | (ee[11] << 16), ee[12] | (ee[13] << 16), ee[14] | (ee[15] << 16));
        float4* gtp = (float4*)(p.GT + o);
#pragma unroll
        for (int i = 0; i < 4; ++i) gtp[i] = make_float4(ex[4 * i] * rs, ex[4 * i + 1] * rs, ex[4 * i + 2] * rs, ex[4 * i + 3] * rs);
      }
    }
  }
};
DEV void ph_gemm3(const P& p, char* smem) {
  int rt, hd;
  for (int it = 0; gemm_unit(it, 8, rt, hd); ++it) {
    float keep[2][16];
    {
      Epi3K<0> epi{p, rt * 128, hd, keep};
      gemm_tile(p.H + (size_t)rt * 128 * D, D, p.Wft + (size_t)(2 * hd) * 128 * D, D, D, smem, epi);
    }
    {
      Epi3K<1> epi{p, rt * 128, hd, keep};
      gemm_tile(p.H + (size_t)rt * 128 * D, D, p.Wft + (size_t)(2 * hd + 1) * 128 * D, D, D, smem, epi);
    }
  }
}

DEV float peer_gate(float scr) {
  float mx = row16_max(scr);
  float ex = __expf(scr - mx);
  float sm = row16_sum(ex);
  return ex / sm;
}
DEV float gelu_exact(float x) { return 0.5f * x * (1.f + erff(x * 0.7071067811865476f)); }

struct PeerPre { uint4 e0, e1, a0, a1; };
DEV unsigned peer_eid(const PeerPre& s, int j) {
  const unsigned w = (j < 8) ? ((j >> 1) == 0 ? s.e0.x : (j >> 1) == 1 ? s.e0.y : (j >> 1) == 2 ? s.e0.z : s.e0.w)
                             : (((j - 8) >> 1) == 0 ? s.e1.x : ((j - 8) >> 1) == 1 ? s.e1.y : ((j - 8) >> 1) == 2 ? s.e1.z : s.e1.w);
  return (j & 1) ? (w >> 16) : (w & 0xFFFFu);
}
template <int WHICH>
DEV void peer_wave_run(const P& p, int layer, int x, int tok0, int lane, float* wbuf) {
  const int r = lane >> 3, c = lane & 7;
  const unsigned char* tb = (WHICH == 0 ? p.PU : p.PV) + (size_t)x * PSLICE + c * 16;
  PeerPre S[3];
  uint4 R[16];
  auto ld_pre = [&](int tok, PeerPre& s) {
    const uint4* elp = (const uint4*)(p.EL + (size_t)tok * 128 + r * 16);
    s.e0 = elp[0]; s.e1 = elp[1];
    if (WHICH == 0) {
      s.a0 = *(const uint4*)(p.H8 + (size_t)tok * 1024 + x * 128 + c * 16);
    } else {
      const uint4* wtp = (const uint4*)(p.GW + (size_t)tok * 128 + r * 16);
      s.a0 = wtp[0]; s.a1 = wtp[1];
    }
  };
  auto comp = [&](int tok, const PeerPre& s, const PeerPre& sn, bool more) {
    if (WHICH == 0) {
      int keep0 = 0, keep1 = 0;
#pragma unroll
      for (int j = 0; j < 16; ++j) {
        const uint4 rw = R[j];
        if (more) R[j] = *(const uint4*)(tb + (size_t)peer_eid(sn, j) * 128);
        int d = __builtin_amdgcn_sdot4((int)rw.x, (int)s.a0.x, 0, false);
        d = __builtin_amdgcn_sdot4((int)rw.y, (int)s.a0.y, d, false);
        d = __builtin_amdgcn_sdot4((int)rw.z, (int)s.a0.z, d, false);
        d = __builtin_amdgcn_sdot4((int)rw.w, (int)s.a0.w, d, false);
        d += __builtin_amdgcn_update_dpp(0, d, 0xB1, 0xF, 0xF, false);
        d += __builtin_amdgcn_update_dpp(0, d, 0x4E, 0xF, 0xF, false);
        d += __builtin_amdgcn_update_dpp(0, d, 0x141, 0xF, 0xF, false);
        if (j < 8) keep0 = (c == j) ? d : keep0; else keep1 = (c == j - 8) ? d : keep1;
      }
      bf16_t* pd = p.PD + ((size_t)x * NTOK + tok) * 128 + r * 16 + c;
      pd[0] = f2bf((float)keep0); pd[8] = f2bf((float)keep1);
    } else {
      const int b = tok / LT, pp = tok % LT;
      const int mr = pp < LC ? 16 : b;
      const int col = x * 128 + 2 * lane;
      const float2 g2v = *(const float2*)(p.modv + ((size_t)layer * 17 + mr) * 6144 + 5120 + col);
      unsigned* xp = (unsigned*)(p.X + (size_t)tok * D + col);
      const unsigned xu = *xp;
      float wsv[16];
      unpack8(s.a0, wsv); unpack8(s.a1, wsv + 8);
      f32x2 acc2[8];
#pragma unroll
      for (int i = 0; i < 8; ++i) acc2[i] = (f32x2){0.f, 0.f};
#pragma unroll
      for (int j = 0; j < 16; ++j) {
        f32x2 f[8];
        unpack16_fp8x2(R[j], f);
        if (more) R[j] = *(const uint4*)(tb + (size_t)peer_eid(sn, j) * 128);
        const f32x2 w2 = (f32x2){wsv[j], wsv[j]};
#pragma unroll
        for (int i = 0; i < 8; ++i) acc2[i] += w2 * f[i];
      }
      float* slab = wbuf + (r * 8 + c) * 16;
      *(float4*)(slab) = make_float4(acc2[0][0], acc2[0][1], acc2[1][0], acc2[1][1]);
      *(float4*)(slab + 4) = make_float4(acc2[2][0], acc2[2][1], acc2[3][0], acc2[3][1]);
      *(float4*)(slab + 8) = make_float4(acc2[4][0], acc2[4][1], acc2[5][0], acc2[5][1]);
      *(float4*)(slab + 12) = make_float4(acc2[6][0], acc2[6][1], acc2[7][0], acc2[7][1]);
      asm volatile("s_waitcnt lgkmcnt(0)" ::: "memory");
      float o0 = 0.f, o1 = 0.f;
#pragma unroll
      for (int rr = 0; rr < 8; ++rr) {
        const float2 t = *(const float2*)(wbuf + (rr * 8 + (lane >> 3)) * 16 + 2 * (lane & 7));
        o0 += t.x; o1 += t.y;
      }
      asm volatile("s_waitcnt lgkmcnt(0)" ::: "memory");
      *xp = pack2(bflo(xu) + g2v.x * o0, bfhi(xu) + g2v.y * o1);
    }
  };
  ld_pre(tok0, S[0]);
  ld_pre(tok0 + 1, S[1]);
#pragma unroll
  for (int j = 0; j < 16; ++j) R[j] = *(const uint4*)(tb + (size_t)peer_eid(S[0], j) * 128);
  ld_pre(tok0 + 2, S[2]);
#pragma unroll
  for (int t = 0; t < 8; ++t) {
    comp(tok0 + t, S[t % 3], S[(t + 1) % 3], t + 1 < 8);
    if (t + 3 < 8) ld_pre(tok0 + t + 3, S[t % 3]);
  }
}
DEV void ph_peer_w(const P& p) {
  struct It { uint4 pd[8]; uint4 eu; float hinv; float4 g0, g1; };
  const size_t stride = (size_t)gridDim.x * 256, n8 = (size_t)NTOK * 16;
  auto ld = [&](size_t i8, It& t) {
    const size_t i = i8 * 8;
#pragma unroll
    for (int x = 0; x < 8; ++x) t.pd[x] = *(const uint4*)(p.PD + (size_t)x * NTOK * 128 + i);
    t.eu = *(const uint4*)(p.EL + i);
    t.hinv = p.HINV[i >> 7];
    t.g0 = *(const float4*)(p.GT + i); t.g1 = *(const float4*)(p.GT + i + 4);
  };
  size_t i8 = (size_t)bid_() * 256 + tid_();
  It cur;
  if (i8 < n8) ld(i8, cur);
#pragma unroll 1
  for (; i8 < n8; i8 += stride) {
    const unsigned ew[4] = {cur.eu.x, cur.eu.y, cur.eu.z, cur.eu.w};
    float su[8], sv[8];
#pragma unroll
    for (int q = 0; q < 8; ++q) {
      const unsigned e = (q & 1) ? (ew[q >> 1] >> 16) : (ew[q >> 1] & 0xFFFFu);
      su[q] = p.PSU[e]; sv[q] = p.PSV[e];
    }
    float d[8];
#pragma unroll
    for (int q = 0; q < 8; ++q) d[q] = 0.f;
#pragma unroll
    for (int x = 0; x < 8; ++x) {
      float f[8];
      unpack8(cur.pd[x], f);
#pragma unroll
      for (int q = 0; q < 8; ++q) d[q] += f[q];
    }
    float g[8] = {cur.g0.x, cur.g0.y, cur.g0.z, cur.g0.w, cur.g1.x, cur.g1.y, cur.g1.z, cur.g1.w};
    const float hinv = cur.hinv;
    const size_t nx = i8 + stride;
    if (nx < n8) ld(nx, cur);
#pragma unroll
    for (int q = 0; q < 8; ++q) g[q] = g[q] * gelu_exact(d[q] * su[q] * hinv) * sv[q];
    *(uint4*)(p.GW + i8 * 8) = pack8(g);
  }
}
template <int WHICH>
DEV void ph_peer_gather(const P& p, int layer, char* smem, volatile LAS unsigned* slot) {
  const int tid = tid_(), lane = tid & 63, wid = tid >> 6;
  unsigned* q = p.wq + 1024 + layer * 256 + WHICH * 128;
  const int my = (int)(xb_xcc_id() & 7u);
  float* wbuf = (float*)smem + wid * 1024;
#pragma unroll 1
  for (int rot = 0; rot < 8; ++rot) {
    const int x = (my + rot) & 7;
    for (;;) {
      __syncthreads();
      if (tid == 0) *slot = atomicAdd(q + x * 16, 1u);
      __syncthreads();
      const int it = (int)*slot;
      if (it >= NTOK / 64) break;
      peer_wave_run<WHICH>(p, layer, x, it * 64 + wid * 16, lane, wbuf);
      peer_wave_run<WHICH>(p, layer, x, it * 64 + wid * 16 + 8, lane, wbuf);
    }
  }
}

DEV void ph_final(const P& p) {
  const int lane = tid_() & 63;
  int r0, r1;
  wave_range(r0, r1, NB * T);
  float gv[16];
#pragma unroll
  for (int hh = 0; hh < 2; ++hh)
#pragma unroll
    for (int i = 0; i < 8; ++i) gv[hh * 8 + i] = p.final_g[hh * 512 + 8 * lane + i];
  auto xrow = [&](int r) -> const bf16_t* { const int b = r / T, t = r % T; return p.X + ((size_t)b * LT + LC + t) * D; };
  uint4 n0 = make_uint4(0, 0, 0, 0), n1 = n0;
  if (r0 < r1) { const bf16_t* xr = xrow(r0); n0 = *(const uint4*)(xr + 8 * lane); n1 = *(const uint4*)(xr + 512 + 8 * lane); }
#pragma unroll 1
  for (int r = r0; r < r1; ++r) {
    const uint4 u0 = n0, u1 = n1;
    if (r + 1 < r1) { const bf16_t* xr = xrow(r + 1); n0 = *(const uint4*)(xr + 8 * lane); n1 = *(const uint4*)(xr + 512 + 8 * lane); }
    float v[16];
    unpack8(u0, v); unpack8(u1, v + 8);
    float ss = 0.f;
#pragma unroll
    for (int i = 0; i < 16; ++i) ss += v[i] * v[i];
    ss = wave_sum(ss);
    const float rstd = rsqrtf(ss * (1.f / 1024.f) + 1e-6f);
    float* o = p.out + (size_t)r * D;
#pragma unroll
    for (int hh = 0; hh < 2; ++hh) {
      const int col = hh * 512 + 8 * lane;
      *(float4*)(o + col) = make_float4(v[hh * 8 + 0] * rstd * gv[hh * 8 + 0], v[hh * 8 + 1] * rstd * gv[hh * 8 + 1], v[hh * 8 + 2] * rstd * gv[hh * 8 + 2], v[hh * 8 + 3] * rstd * gv[hh * 8 + 3]);
      *(float4*)(o + col + 4) = make_float4(v[hh * 8 + 4] * rstd * gv[hh * 8 + 4], v[hh * 8 + 5] * rstd * gv[hh * 8 + 5], v[hh * 8 + 6] * rstd * gv[hh * 8 + 6], v[hh * 8 + 7] * rstd * gv[hh * 8 + 7]);
    }
  }
}

DEV unsigned hw_cu_key() {
  const unsigned hwid = (unsigned)__builtin_amdgcn_s_getreg(((8 - 1) << 11) | (8 << 6) | 4);
  return (xb_xcc_id() << 8) | (hwid & 0xFFu);
}
DEV void mixB(const P& p, int layer, char* smem, volatile LAS unsigned* slot) {
  unsigned* qa = p.wq + layer * 64;
  unsigned* qs = qa + 16;
  unsigned* claim = p.cuclaim + layer * 4096;
  __syncthreads();
  if (tid_() == 0) {
    unsigned u = 0xFFFFFFFFu;
    if (atomicAdd(&claim[hw_cu_key() & 4095u], 1u) == 0u) u = atomicAdd(qs, 1u);
    *slot = u;
  }
  __syncthreads();
  {
    const unsigned u = *slot;
    if (u < 128u) scanc_unit(p, layer, (int)u, smem);
  }
  for (;;) {
    __syncthreads();
    if (tid_() == 0) *slot = atomicAdd(qa, 1u);
    __syncthreads();
    const int u = (int)*slot;
    if (u >= 8704) break;
    if (u < 4352) attn_unit(p, layer, u, smem); else hyena_conv_unit(p, layer, u - 4352, smem);
  }
  if (layer + 1 < DEPTH) {
    unsigned* qp = qa + 32;
    for (;;) {
      __syncthreads();
      if (tid_() == 0) *slot = atomicAdd(qp, 1u);
      __syncthreads();
      const int u = (int)*slot;
      if (u >= PREPA_N) break;
      prep_unit(p, layer + 1, prepA_unit_index(u), smem);
    }
  }
  for (;;) {
    __syncthreads();
    if (tid_() == 0) *slot = atomicAdd(qs, 1u);
    __syncthreads();
    const unsigned u = *slot;
    if (u >= 128u) break;
    scanc_unit(p, layer, (int)u, smem);
  }
}
DEV void mixA(const P& p, int layer, char* smem) {
  for (int u = bid_(); u < 1088; u += gridDim.x) hyena_pre_unit(p, layer, u);
  for (int u = bid_(); u < 512; u += gridDim.x) hyena_scale_unit(p, layer, u, smem);
  ph_lora(p, layer, smem);
  ph_rwkv_prep(p, layer);
}
DEV void mixC(const P& p, int layer, char* smem) {
  for (int u = bid_(); u < 1088; u += gridDim.x) hyena_post_unit(p, layer, u, smem);
  ph_rwkv_post(p, layer);
  ph_attn_post(p, layer);
}

__global__ void __launch_bounds__(256, 2) k_mega(P p) {
  extern __shared__ __attribute__((aligned(16))) char smem_all[];
  char* smem = smem_all;
  volatile LAS unsigned* xbw = (volatile LAS unsigned*)(smem_all + SMEM_BYTES);
  if (threadIdx.x == 0) { xbw[0] = 0u; xbw[1] = 0u; xbw[2] = 0u; xbw[3] = 0u; }
  __syncthreads();
  XcdBarrier bar = xcd_barrier_post(p.bar, xbw);
  ph_rope(p);
  for (int u = blockIdx.x; u < 96; u += gridDim.x) modv_unit(p, u, smem);
  ph_prep(p, 0, smem, false);
  xcd_barrier(bar);
  for (int layer = 0; layer < DEPTH; ++layer) {
    if (layer == 0) ph_norm_first(p); else ph_norm(p, layer, 0);
    xcd_barrier(bar);
    ph_gemm1(p, smem);
    xcd_barrier(bar);
    mixA(p, layer, smem);
    xcd_barrier(bar);
    mixB(p, layer, smem, (volatile LAS unsigned*)(smem_all + SMEM_BYTES + 16));
    xcd_barrier(bar);
    mixC(p, layer, smem);
    xcd_barrier(bar);
    ph_gemm2(p, layer, smem);
    ph_peerconv(p, layer);
    xcd_barrier(bar);
    ph_norm(p, layer, 1);
    xcd_barrier(bar);
    ph_gemm3(p, smem);
    xcd_barrier(bar);
    ph_peer_gather<0>(p, layer, smem, (volatile LAS unsigned*)(smem_all + SMEM_BYTES + 16));
    xcd_barrier(bar);
    ph_peer_w(p);
    xcd_barrier(bar);
    ph_peer_gather<1>(p, layer, smem, (volatile LAS unsigned*)(smem_all + SMEM_BYTES + 16));
    if (layer + 1 < DEPTH) ph_prep(p, layer + 1, smem, true);
    xcd_barrier(bar);
  }
  ph_final(p);
}

static inline size_t al256(size_t x) { return (x + 255) & ~(size_t)255; }

extern "C" void kernel_launch(void* const* d_in, const int* in_sizes, int n_in, void* d_out, int out_size, void* d_ws, size_t ws_size,
                              hipStream_t stream) {
  (void)in_sizes; (void)n_in; (void)out_size; (void)ws_size;
  P p{};
  const float** f = (const float**)&p;
  for (int i = 0; i < 39; ++i) f[i] = (const float*)d_in[i];
  p.out = (float*)d_out;
  char* w = (char*)d_ws;
  size_t off = 0;
  auto take = [&](size_t bytes) { char* r = w + off; off += al256(bytes); return r; };
  p.bar = (unsigned*)take(16384);
  p.modv = (float*)take((size_t)DEPTH * 17 * 6144 * 4);
  p.SSQ = (float*)take((size_t)DEPTH * 2 * 256 * 4);
  p.wq = (unsigned*)take(4096 + DEPTH * 1024);
  p.cuclaim = (unsigned*)take((size_t)DEPTH * 4096 * 4);
  const size_t zero_bytes = off;
  p.rope = (float*)take(64 * 16 * 2 * 4);
  p.X = (bf16_t*)take((size_t)NTOK * D * 2);
  p.H = (bf16_t*)take((size_t)NTOK * D * 2);
  p.Y = (bf16_t*)take((size_t)NTOK * D * 2);
  p.SC = (bf16_t*)take((size_t)NTOK * 1024 * 2);
  p.Z = (bf16_t*)take((size_t)NTOK * INW * 2);
  p.UTl = (bf16_t*)take((size_t)256 * 16 * T * 2);
  p.UTc = (bf16_t*)take((size_t)256 * 16 * LC * 2);
  p.YTl = (bf16_t*)take((size_t)256 * 16 * T * 2);
  p.YTc = (bf16_t*)take((size_t)256 * 16 * LC * 2);
  p.FL = (float*)take((size_t)256 * 2 * T * 4);
  p.FC = (float*)take((size_t)256 * 2 * LC * 4);
  p.W1t = (bf16_t*)take((size_t)INW * D * 2);
  p.W2t = (bf16_t*)take((size_t)D * D * 2);
  p.Wft = (bf16_t*)take((size_t)2048 * D * 2);
  p.Wlt = (bf16_t*)take((size_t)1024 * 256 * 2);
  p.Wgt = (bf16_t*)take((size_t)256 * 128 * 2);
  p.TK = (float*)p.Z;
  p.PU = (unsigned char*)p.Z + al256((size_t)NTOK * 256 * 4);
  p.PV = p.PU + (size_t)16384 * 1024;
  p.PSU = (float*)(p.PV + (size_t)16384 * 1024);
  p.PSV = p.PSU + 16384;
  p.GT = p.PSV + 16384;
  p.EL = (unsigned short*)(p.GT + (size_t)NTOK * 128);
  p.H8 = (unsigned char*)p.EL + al256((size_t)NTOK * 128 * 2);
  p.HINV = (float*)(p.H8 + (size_t)NTOK * 1024);
  p.GW = (bf16_t*)((char*)p.HINV + al256((size_t)NTOK * 4));
  p.PD = p.Y;

  (void)hipMemsetAsync(d_ws, 0, zero_bytes, stream);
  constexpr size_t kDynLds = SMEM_BYTES + 32;
  static int grid = 0;
  if (!grid) {
    int dev = 0, cus = 0, per_cu = 0;
    (void)hipGetDevice(&dev);
    (void)hipDeviceGetAttribute(&cus, hipDeviceAttributeMultiprocessorCount, dev);
    (void)hipFuncSetAttribute((const void*)k_mega, hipFuncAttributeMaxDynamicSharedMemorySize, (int)kDynLds);
    (void)hipOccupancyMaxActiveBlocksPerMultiprocessor(&per_cu, k_mega, 256, kDynLds);
    if (cus <= 0) cus = 256;
    if (per_cu > 2) per_cu = 2;
    if (per_cu < 1) per_cu = 1;
    grid = cus * per_cu;
  }
  k_mega<<<grid, 256, kDynLds, stream>>>(p);
}
```
